# Optimizing an MI355X kernel written in HIP

```python
import math
import jax
import jax.numpy as jnp
from jax import lax
import numpy as np

D_MODEL = 2048
BATCH = 1
SEQ = 16384
DEPTH = 2

CTX_LEN = 256
GRID_W = 64
NORM_EPS = 1e-6

HY_C = D_MODEL // 2
HY_SHORT = 3
HY_EMB = 33
HY_BANDS = (HY_EMB - 1) // 2
HY_FH = 64
HY_DECAY_TARGET = 1e-2
HY_FAST_PCT = 0.3
HY_SLOW_PCT = 1.5
HY_MOD_SHIFT = 0.05

HG_HEADS = 8
HG_DK = 128
HG_DV = 128
HG_K = HG_HEADS * HG_DK
HG_V = HG_HEADS * HG_DV

GL_HEADS = 4
GL_DK = 128
GL_DV = 256
GL_K = GL_HEADS * GL_DK
GL_V = GL_HEADS * GL_DV
GL_RANK = 16
GL_TAU = 16.0

CHUNK = 64
N_BRANCH = 3
BR_W = D_MODEL // 2

HG_COLS = 3 * HG_K + 2 * HG_V
GL_COLS = 2 * GL_K + 2 * GL_V + 2 * GL_RANK
REC_COLS = HG_COLS + GL_COLS
HY_COLS = 3 * HY_C
MERGE_COLS = N_BRANCH * D_MODEL
N_COLS = REC_COLS + HY_COLS + MERGE_COLS

N_GROUPS = 4
EXP_PER_GROUP = 8
N_EXPERTS = N_GROUPS * EXP_PER_GROUP
TOP_K = 2
D_FF = D_MODEL // 4
MOE_BLOCK = 256

kernel_name = 'hybrid_hyena_hgrn2_gla_hmoe_dit'


def _split(a, sizes):
    return jnp.split(a, np.cumsum(sizes)[:-1].tolist(), axis=-1)


def rms_norm(x, w):
    x32 = x.astype(jnp.float32)
    y = x32 * lax.rsqrt(jnp.mean(x32 * x32, axis=-1, keepdims=True) + NORM_EPS)
    return (y * w.astype(jnp.float32)).astype(x.dtype)


def modulate(x, w, shift, scale):
    return rms_norm(x, w) * (1.0 + scale) + shift


def chunk_gated_scan(q, k, v, log_a, s0, with_out):
    B, L, H, dk = q.shape
    dv = v.shape[-1]
    n = L // CHUNK

    def chunks(a):
        return a.astype(jnp.float32).reshape(B, n, CHUNK, H, a.shape[-1]).transpose(1, 0, 3, 2, 4)

    lower = jnp.tril(jnp.ones((CHUNK, CHUNK), dtype=bool))[:, :, None]

    def step(s, inp):
        qc, kc, vc, gc = inp
        b = jnp.cumsum(gc, axis=2)
        b_last = b[:, :, -1:, :]
        s_new = jnp.exp(b_last[:, :, 0, :])[..., None] * s + jnp.einsum('bhsk,bhsv->bhkv', kc * jnp.exp(b_last - b), vc)
        if not with_out:
            return s_new, None
        o_inter = jnp.einsum('bhtk,bhkv->bhtv', qc * jnp.exp(b), s)
        rel = b[:, :, :, None, :] - b[:, :, None, :, :]
        decay = jnp.exp(jnp.where(lower, rel, -jnp.inf))
        scores = jnp.einsum('bhtk,bhsk,bhtsk->bhts', qc, kc, decay)
        return s_new, o_inter + jnp.einsum('bhts,bhsv->bhtv', scores, vc)

    s_fin, o = lax.scan(step, s0, (chunks(q), chunks(k), chunks(v), chunks(log_a)))
    if not with_out:
        return None, s_fin
    return o.transpose(1, 0, 3, 2, 4).reshape(B, L, H, dv), s_fin


def bidir_scan(q, v, k_f, g_f, k_b, g_b, s0_f, s0_b, with_out):
    flip = lambda a: jnp.flip(a, axis=1)
    o_f, s_f = chunk_gated_scan(q, k_f, v, g_f, s0_f, with_out)
    o_b, s_b = chunk_gated_scan(flip(q), flip(k_b), flip(v), flip(g_b), s0_b, with_out)
    o = (o_f + flip(o_b)) if with_out else None
    return o, s_f, s_b


def hgrn2_branch(z_hg, lb, norm_w, s0_f, s0_b, with_out):
    q, f_f, f_b, i, g = _split(z_hg, [HG_K, HG_K, HG_K, HG_V, HG_V])
    B, L, _ = q.shape
    heads = lambda a, d: a.reshape(B, L, HG_HEADS, d)

    def forget(zf, lbd):
        zf32 = zf.astype(jnp.float32)
        log_f = jnp.logaddexp(jnp.log(lbd), jnp.log1p(-lbd) + jax.nn.log_sigmoid(zf32))
        key = (1.0 - lbd) * jax.nn.sigmoid(-zf32)
        return heads(key, HG_DK), heads(log_f, HG_DK)

    k_f, g_f = forget(f_f, lb[0])
    k_b, g_b = forget(f_b, lb[1])
    o, s_f, s_b = bidir_scan(heads(jax.nn.silu(q), HG_DK), heads(i, HG_DV), k_f, g_f, k_b, g_b, s0_f, s0_b, with_out)
    if not with_out:
        return None, s_f, s_b
    y = rms_norm(o, norm_w).reshape(B, L, HG_V) * jax.nn.sigmoid(g.astype(jnp.float32))
    return y.astype(z_hg.dtype), s_f, s_b


def gla_branch(z_gl, w_a2, b_a, norm_w, s0_f, s0_b, with_out):
    q, k, v, r, a_f, a_b = _split(z_gl, [GL_K, GL_K, GL_V, GL_V, GL_RANK, GL_RANK])
    B, L, _ = q.shape
    heads = lambda a, d: a.reshape(B, L, GL_HEADS, d)

    def log_alpha(a, d):
        return heads(jax.nn.log_sigmoid((a @ w_a2[d] + b_a[d]).astype(jnp.float32)) / GL_TAU, GL_DK)

    kh = heads(k, GL_DK)
    o, s_f, s_b = bidir_scan(heads(q, GL_DK) * GL_DK ** -0.5, heads(v, GL_DV), kh, log_alpha(a_f, 0), kh, log_alpha(a_b, 1), s0_f, s0_b, with_out)
    if not with_out:
        return None, s_f, s_b
    y = rms_norm(o, norm_w).reshape(B, L, GL_V) * jax.nn.silu(r.astype(jnp.float32))
    return y.astype(z_gl.dtype), s_f, s_b


def hyena_filters(L, w1, b1, w2, b2, w3, b3, freq):
    t = jnp.linspace(0.0, 1.0, L, dtype=jnp.float32)[:, None]
    ang = 2.0 * math.pi * jnp.arange(L, dtype=jnp.float32)[:, None] / L
    bands = jnp.linspace(1e-4, HY_BANDS - 1, HY_BANDS, dtype=jnp.float32)[None, :]
    feats = jnp.concatenate([t, jnp.cos(bands * ang), -jnp.sin(bands * ang)], axis=-1)
    h = jnp.sin(freq * (feats @ w1 + b1))
    h = jnp.sin(freq * (h @ w2 + b2))
    h = (h @ w3 + b3).astype(jnp.float32)
    deltas = jnp.abs(jnp.linspace(math.log(HY_DECAY_TARGET) / HY_SLOW_PCT, math.log(HY_DECAY_TARGET) / HY_FAST_PCT, HY_C, dtype=jnp.float32))
    decay = jnp.exp(-t * deltas)
    h = h * (jnp.tile(decay, (1, 2)) + HY_MOD_SHIFT)
    h = h / jnp.sum(jnp.abs(h), axis=0, keepdims=True)
    return h[:, :HY_C], h[:, HY_C:]


def fft_long_conv(v, h):
    L = v.shape[1]
    n = 2 * L
    v_f = jnp.fft.rfft(v.astype(jnp.float32), n=n, axis=1)
    h_f = jnp.fft.rfft(h, n=n, axis=0)
    return jnp.fft.irfft(v_f * h_f[None], n=n, axis=1)[:, :L]


def short_conv_centered(x, w, b):
    L = x.shape[1]
    pad = HY_SHORT // 2
    xp = jnp.pad(x, ((0, 0), (pad, pad), (0, 0)))
    return sum(w[j] * xp[:, j:j + L] for j in range(HY_SHORT)) + b


def hyena_branch(z_hy, conv_w, conv_b, w1, b1, w2, b2, w3, b3, freq, skip):
    L = z_hy.shape[1]
    x0, x1, v = _split(short_conv_centered(z_hy, conv_w, conv_b), [HY_C, HY_C, HY_C])
    h_f, h_b = hyena_filters(L, w1, b1, w2, b2, w3, b3, freq)
    v = v * x1
    y = fft_long_conv(v, h_f) + jnp.flip(fft_long_conv(jnp.flip(v, axis=1), h_b), axis=1) + v * skip
    return y.astype(z_hy.dtype) * x0


def merge_branches(z_gate, ys, w_branch, w_out):
    B, L, _ = z_gate.shape
    gates = jax.nn.sigmoid(z_gate.reshape(B, L, N_BRANCH, D_MODEL))
    merged = sum(gates[:, :, br] * (ys[br] @ w_branch[br]) for br in range(N_BRANCH))
    return merged @ w_out


def token_mixer(u, uc, w_in, b_in, hy_params, lb, hg_norm_w, gl_w_a2, gl_b_a, gl_norm_w, w_branch, w_out, need_ctx):
    B = u.shape[0]
    z = u @ w_in + b_in
    zc = (uc @ w_in + b_in) if need_ctx else (uc @ w_in[:, :REC_COLS] + b_in[:REC_COLS])
    zeros = lambda h, dk, dv: jnp.zeros((B, h, dk, dv), jnp.float32)
    yc_hg, hg_sf, hg_sb = hgrn2_branch(zc[..., :HG_COLS], lb, hg_norm_w, zeros(HG_HEADS, HG_DK, HG_DV), zeros(HG_HEADS, HG_DK, HG_DV), need_ctx)
    yc_gl, gl_sf, gl_sb = gla_branch(zc[..., HG_COLS:REC_COLS], gl_w_a2, gl_b_a, gl_norm_w, zeros(GL_HEADS, GL_DK, GL_DV), zeros(GL_HEADS, GL_DK, GL_DV), need_ctx)
    y_hg, _, _ = hgrn2_branch(z[..., :HG_COLS], lb, hg_norm_w, hg_sf, hg_sb, True)
    y_gl, _, _ = gla_branch(z[..., HG_COLS:REC_COLS], gl_w_a2, gl_b_a, gl_norm_w, gl_sf, gl_sb, True)
    y_hy = hyena_branch(z[..., REC_COLS:REC_COLS + HY_COLS], *hy_params)
    out = merge_branches(z[..., REC_COLS + HY_COLS:], (y_hy, y_hg, y_gl), w_branch, w_out)
    if not need_ctx:
        return out, None
    yc_hy = hyena_branch(zc[..., REC_COLS:REC_COLS + HY_COLS], *hy_params)
    out_c = merge_branches(zc[..., REC_COLS + HY_COLS:], (yc_hy, yc_hg, yc_gl), w_branch, w_out)
    return out, out_c


def hier_moe(u, w_rg, b_rg, w_re, b_re, w_gate, w_up, w_down):
    B, L, D = u.shape
    n = B * L
    x = u.reshape(n, D)
    p_grp = jax.nn.softmax((x @ w_rg + b_rg).astype(jnp.float32), axis=-1)
    grp = jnp.argmax(p_grp, axis=-1).astype(jnp.int32)
    p_top = jnp.max(p_grp, axis=-1)
    le = (x @ w_re + b_re).reshape(n, N_GROUPS, EXP_PER_GROUP)
    le = jnp.take_along_axis(le, grp[:, None, None], axis=1)[:, 0]
    top_p, top_i = lax.top_k(jax.nn.softmax(le.astype(jnp.float32), axis=-1), TOP_K)
    weight = p_top[:, None] * top_p / jnp.sum(top_p, axis=-1, keepdims=True)
    expert = grp[:, None] * EXP_PER_GROUP + top_i.astype(jnp.int32)
    a = n * TOP_K
    e_flat = expert.reshape(a)
    tok_flat = jnp.repeat(jnp.arange(n, dtype=jnp.int32), TOP_K)
    order = jnp.argsort(e_flat)
    e_s, tok_s, w_s = e_flat[order], tok_flat[order], weight.reshape(a)[order]
    counts = jnp.zeros((N_EXPERTS,), jnp.int32).at[e_flat].add(1)
    off = jnp.cumsum(counts) - counts
    padded = (counts + MOE_BLOCK - 1) // MOE_BLOCK * MOE_BLOCK
    pad_end = jnp.cumsum(padded)
    pad_off = pad_end - padded
    pos = pad_off[e_s] + jnp.arange(a, dtype=jnp.int32) - off[e_s]
    p_len = a + N_EXPERTS * MOE_BLOCK
    n_blk = p_len // MOE_BLOCK
    buf_tok = jnp.zeros((p_len,), jnp.int32).at[pos].set(tok_s)
    buf_w = jnp.zeros((p_len,), x.dtype).at[pos].set(w_s.astype(x.dtype))
    blk_start = jnp.arange(n_blk, dtype=jnp.int32) * MOE_BLOCK
    blk_exp = jnp.minimum(jnp.sum(pad_end[None, :] <= blk_start[:, None], axis=1), N_EXPERTS - 1)

    def run_block(args):
        tok, e = args
        xb = x[tok]
        return (jax.nn.silu(xb @ w_gate[e]) * (xb @ w_up[e])) @ w_down[e]

    y = lax.map(run_block, (buf_tok.reshape(n_blk, MOE_BLOCK), blk_exp)).reshape(p_len, D) * buf_w[:, None]
    return jnp.zeros_like(x).at[buf_tok].add(y).reshape(B, L, D)


def setup_inputs(seed: int = 0) -> dict:
    key = jax.random.key(seed)
    ks = iter(jax.random.split(key, 48))
    D = D_MODEL

    def nrm(shape, scale):
        return jax.random.normal(next(ks), shape, jnp.float32) * scale

    def gain(shape):
        return 1.0 + nrm(shape, 0.05)

    return {
        'x': nrm((BATCH, SEQ, D), 1.0),
        'c': nrm((BATCH, D), 1.0),
        'ctx': nrm((BATCH, CTX_LEN, D), 1.0),
        'c_ctx': nrm((D,), 1.0),
        'w_mod': nrm((DEPTH, D, 6 * D), 0.5 * D ** -0.5),
        'b_mod': nrm((DEPTH, 6 * D), 0.02),
        'norm_mix_w': gain((DEPTH, D)),
        'norm_ffn_w': gain((DEPTH, D)),
        'w_in': nrm((DEPTH, D, N_COLS), D ** -0.5),
        'b_in': nrm((DEPTH, N_COLS), 0.02),
        'hy_conv_w': nrm((DEPTH, HY_SHORT, HY_COLS), HY_SHORT ** -0.5),
        'hy_conv_b': nrm((DEPTH, HY_COLS), 0.02),
        'hy_f_w1': nrm((DEPTH, HY_EMB, HY_FH), HY_EMB ** -0.5),
        'hy_f_b1': nrm((DEPTH, HY_FH), 0.02),
        'hy_f_w2': nrm((DEPTH, HY_FH, HY_FH), HY_FH ** -0.5),
        'hy_f_b2': nrm((DEPTH, HY_FH), 0.02),
        'hy_f_w3': nrm((DEPTH, HY_FH, 2 * HY_C), HY_FH ** -0.5),
        'hy_f_b3': nrm((DEPTH, 2 * HY_C), 0.02),
        'hy_f_freq': gain((DEPTH, HY_FH)),
        'hy_skip': nrm((DEPTH, HY_C), 0.5),
        'hg_lb_raw': nrm((DEPTH, 2, HG_K), 0.5),
        'hg_norm_w': gain((DEPTH, HG_DV)),
        'gl_w_a2': nrm((DEPTH, 2, GL_RANK, GL_K), GL_RANK ** -0.5),
        'gl_b_a': nrm((DEPTH, 2, GL_K), 0.1),
        'gl_norm_w': gain((DEPTH, GL_DV)),
        'w_branch': nrm((DEPTH, N_BRANCH, BR_W, D), BR_W ** -0.5),
        'w_out': nrm((DEPTH, D, D), D ** -0.5),
        'w_rg': nrm((DEPTH, D, N_GROUPS), D ** -0.5),
        'b_rg': nrm((DEPTH, N_GROUPS), 0.01),
        'w_re': nrm((DEPTH, D, N_EXPERTS), D ** -0.5),
        'b_re': nrm((DEPTH, N_EXPERTS), 0.01),
        'w_gate': nrm((DEPTH, N_EXPERTS, D, D_FF), D ** -0.5),
        'w_up': nrm((DEPTH, N_EXPERTS, D, D_FF), D ** -0.5),
        'w_down': nrm((DEPTH, N_EXPERTS, D_FF, D), D_FF ** -0.5),
        'final_norm_w': gain((D,)),
    }


def reference(x, c, ctx, c_ctx, w_mod, b_mod, norm_mix_w, norm_ffn_w, w_in, b_in, hy_conv_w, hy_conv_b, hy_f_w1, hy_f_b1, hy_f_w2, hy_f_b2, hy_f_w3, hy_f_b3, hy_f_freq, hy_skip, hg_lb_raw, hg_norm_w, gl_w_a2, gl_b_a, gl_norm_w, w_branch, w_out, w_rg, b_rg, w_re, b_re, w_gate, w_up, w_down, final_norm_w):
    lb_all = jnp.cumsum(jax.nn.softmax(hg_lb_raw.astype(jnp.float32), axis=0), axis=0)
    lb_all = lb_all - lb_all[:1]
    h, hc = x, ctx
    for l in range(DEPTH):
        need_ctx = l < DEPTH - 1
        mod = jax.nn.silu(c) @ w_mod[l] + b_mod[l]
        mod_c = jax.nn.silu(c_ctx) @ w_mod[l] + b_mod[l]
        sh1, sc1, gt1, sh2, sc2, gt2 = jnp.split(mod[:, None, :], 6, axis=-1)
        sh1c, sc1c, gt1c, sh2c, sc2c, gt2c = jnp.split(mod_c, 6)
        hy_params = (hy_conv_w[l], hy_conv_b[l], hy_f_w1[l], hy_f_b1[l], hy_f_w2[l], hy_f_b2[l], hy_f_w3[l], hy_f_b3[l], hy_f_freq[l], hy_skip[l])
        u = modulate(h, norm_mix_w[l], sh1, sc1)
        uc = modulate(hc, norm_mix_w[l], sh1c, sc1c)
        mix, mix_c = token_mixer(u, uc, w_in[l], b_in[l], hy_params, lb_all[l], hg_norm_w[l], gl_w_a2[l], gl_b_a[l], gl_norm_w[l], w_branch[l], w_out[l], need_ctx)
        h = h + gt1 * mix
        moe_args = (w_rg[l], b_rg[l], w_re[l], b_re[l], w_gate[l], w_up[l], w_down[l])
        h = h + gt2 * hier_moe(modulate(h, norm_ffn_w[l], sh2, sc2), *moe_args)
        if need_ctx:
            hc = hc + gt1c * mix_c
            hc = hc + gt2c * hier_moe(modulate(hc, norm_ffn_w[l], sh2c, sc2c), *moe_args)
    return rms_norm(h, final_norm_w)
```

```cpp
#include <hip/hip_runtime.h>
#include <cstdio>
#include <cstdint>
#define DI __device__ __forceinline__
#define LAS __attribute__((address_space(3)))
typedef unsigned short bf16;
typedef float f32x4 __attribute__((ext_vector_type(4)));
typedef unsigned u32x4 __attribute__((ext_vector_type(4)));
typedef unsigned u32x2 __attribute__((ext_vector_type(2)));

constexpr int D = 2048, SEQ = 16384, CTXL = 256, MT = SEQ + CTXL  , DEPTH = 2;
constexpr int NCOLS_IN = 17440;
constexpr int ZC = 17664;
constexpr int Z_HG = 0, Z_GL = 5120, Z_HY = 8192, Z_MG = 11264, Z_LR = 17408;
constexpr int NEXP = 32, DFF = 512, MOE_MAXROWS = 41472;
constexpr float NORM_EPS = 1e-6f;

constexpr size_t MiB = 1u << 20;
constexpr size_t WS_CTL = 0, CTL_BYTES = 1 * MiB;
constexpr size_t WS_SMALL = 1 * MiB;
constexpr size_t WS_MOD   = WS_SMALL;
constexpr size_t WS_ZBIAS = WS_MOD + (size_t)DEPTH * 2 * 12288 * 4;
constexpr size_t WS_LB    = WS_ZBIAS + (size_t)DEPTH * ZC * 4;
constexpr size_t WS_TW    = WS_LB + (size_t)DEPTH * 2 * 1024 * 4;
constexpr size_t WS_TW2   = WS_TW + 16384 * 8;
constexpr size_t WS_H2    = WS_TW2 + (8192 + 64) * 8;
constexpr size_t WS_ROUTE = WS_H2 + (size_t)DEPTH * MT * 64 * 4;
constexpr size_t WS_ROWW  = WS_ROUTE + (size_t)MT * 8 * 4;
constexpr size_t WS_TILEE = WS_ROWW + (size_t)MOE_MAXROWS * 4;
constexpr size_t WS_HYC   = WS_TILEE + 1024;
constexpr size_t WS_SMALL_END = WS_HYC + (size_t)2048 * 256 * 4;
static_assert(WS_SMALL_END <= 40 * MiB, "small tables");
constexpr size_t WS_WIN  = 40 * MiB;
constexpr size_t WS_WBR  = 109 * MiB;
constexpr size_t WS_WOUT = 121 * MiB;
constexpr size_t WS_WGU  = 129 * MiB;
constexpr size_t WS_WD   = 257 * MiB;
constexpr size_t WS_H    = 321 * MiB;
constexpr size_t WS_U    = 451 * MiB;
constexpr size_t WS_Z    = 516 * MiB;
constexpr size_t WS_XP   = WS_Z;
constexpr size_t WS_HMID = WS_Z + 162 * MiB;
constexpr size_t WS_YP   = WS_Z + 203 * MiB;
constexpr size_t WS_YMIX = 1077 * MiB;
constexpr size_t WS_OSC  = 1175 * MiB;
constexpr size_t WS_END  = 1435 * MiB;
static_assert(WS_WIN + (size_t)ZC * D * 2 <= WS_WBR && WS_Z + (size_t)MT * ZC * 2 <= WS_YMIX && WS_YMIX + (size_t)3 * MT * 1024 * 2 <= WS_OSC && WS_OSC + (size_t)4 * MT * 1024 * 4 <= WS_END, "ws map");
static_assert(WS_YP + (size_t)MOE_MAXROWS * D * 2 <= WS_YMIX && WS_H + (size_t)MT * D * 4 <= WS_U && WS_U + (size_t)MT * D * 2 <= WS_Z, "ws map 2");
constexpr int CW_BAR = 4096;
constexpr int CW_CNT = 16384;

DI float bf2f(bf16 v) { return __uint_as_float(((unsigned)v) << 16); }
DI float bflo(unsigned w) { return __uint_as_float(w << 16); }
DI float bfhi(unsigned w) { return __uint_as_float(w & 0xffff0000u); }
DI unsigned pk_bf16(float lo, float hi) { unsigned r; asm volatile("v_cvt_pk_bf16_f32 %0, %1, %2" : "=v"(r) : "v"(lo), "v"(hi)); return r; }
DI bf16 f2bf(float f) { return (bf16)(pk_bf16(f, 0.f) & 0xffffu); }
DI float sigmoidf_(float x) { return 1.0f / (1.0f + __expf(-x)); }
DI float siluf_(float x) { return x / (1.0f + __expf(-x)); }
DI float wave_sum(float v) {
#pragma unroll
    for (int o = 32; o >= 1; o >>= 1) v += __shfl_xor(v, o);
    return v;
}
DI int otid() { int t = __builtin_amdgcn_workitem_id_x(); asm volatile("" : "+v"(t)); return t; }
DI int obid() { int b = __builtin_amdgcn_workgroup_id_x(); asm volatile("" : "+s"(b)); return b; }
namespace pg8 {
#define PG8_LAS __attribute__((address_space(3)))
typedef unsigned short bf16_t;
typedef short bf16x8 __attribute__((ext_vector_type(8)));
typedef float f32x4 __attribute__((ext_vector_type(4)));
typedef unsigned u32x4 __attribute__((ext_vector_type(4)));
constexpr int BM = 256, BK = 64, HALF = 128, HTB = HALF * BK * 2  , STAGE_BYTES = 8 * HTB, NXCD = 8, WGM = 8;

__host__ __device__ __forceinline__ int lds_byte(int r, int c) { const int st = (r >> 4) * 2 + (c >> 5), rr = r & 15, cc = c & 31, ob = rr * 64 + cc * 2; return st * 1024 + (ob ^ (((ob >> 9) & 1) << 5)); }
__host__ __device__ __forceinline__ void stage_rc(int b, int& R, int& C) { const int st = b / 1024, sb = b % 1024, swz = sb ^ (((sb >> 9) & 1) << 5); R = (st >> 1) * 16 + swz / 64; C = (st & 1) * 32 + (swz % 64) / 2; }
__host__ __device__ __forceinline__ int perm32(int rho) { const int n = rho >> 4, i = rho & 15; return 8 * (i >> 2) + 4 * n + (i & 3); }

struct Unit { int pm, pn; };
struct Gemm { const bf16_t* A; const bf16_t* Bt; int M, N, K; };

struct StaticOrder {
    int nM, nN, nwg, G, c;
    __host__ __device__ void init(int M, int N, int G_, int c_) { nM = M / BM; nN = N / BM; nwg = nM * nN; G = G_; c = c_; }
    __host__ __device__ bool next(int i, Unit& u) const {
        const long L = (long)i * G + c; if (L >= nwg) return false;
        int wgid = (int)L; { const int q = nwg / NXCD, r = nwg % NXCD, xcd = wgid % NXCD, off = wgid / NXCD; wgid = (xcd < r ? xcd * (q + 1) : r * (q + 1) + (xcd - r) * q) + off; }
        const int nig = WGM * nN, gid = wgid / nig, fm = gid * WGM, gsz = (nM - fm) < WGM ? (nM - fm) : WGM;
        u.pm = fm + ((wgid % nig) % gsz); u.pn = (wgid % nig) / gsz; return true;
    }
    __device__ __forceinline__ void a_ready(const Unit&) const {}
    __device__ __forceinline__ void done(const Unit&) const {}
};

template <class Epi, class Sched, bool ALIGN_EPI = false, bool SP2 = false>
__device__ __forceinline__ void gemm_phase(PG8_LAS unsigned char* lds, const Gemm g, const Sched& S, const Epi& E) {
    const int tid = otid(), wid = __builtin_amdgcn_readfirstlane(tid >> 6), lane = tid & 63, wr = wid >> 2, wc = wid & 3, fr = lane & 15, fq = lane >> 4;
    const int K = g.K, nt = K / BK;
    unsigned voffA[2], voffB[2];
#pragma unroll
    for (int i = 0; i < 2; ++i) { int R, C; stage_rc(tid * 16 + i * 8192, R, C); const int Rb = Epi::PERM ? ((R & ~31) + perm32(R & 31)) : R;
        voffA[i] = (unsigned)(R * K + C) * 2u; voffB[i] = (unsigned)(Rb * K + C) * 2u; }
    const size_t kstep = (size_t)(BK * 2);
    const size_t hstep = (size_t)HALF * K * 2;
    const size_t tstep = 2 * hstep;
    const unsigned ldsw = (unsigned)wid * 1024u;
    const int aoff = lds_byte(wr * 64 + fr, fq * 8), boff = lds_byte(wc * 32 + fr, fq * 8);
#define PG8_SA(b, h) (((b) * 2 + (h)) * HTB)
#define PG8_SB(b, h) ((4 + (b) * 2 + (h)) * HTB)
#define PG8_STAGE(bufoff, gbase, voff) do { _Pragma("unroll") for (int _i = 0; _i < 2; ++_i) \
        __builtin_amdgcn_global_load_lds((const unsigned*)((const char*)(gbase) + (voff)[_i]), (PG8_LAS unsigned*)(lds + (bufoff) + ldsw + _i * 8192), 16, 0, 0); } while (0)
#define PG8_LDA(dst, b, h) do { _Pragma("unroll") for (int m = 0; m < 4; ++m) _Pragma("unroll") for (int k = 0; k < 2; ++k) dst[m][k] = *(const PG8_LAS bf16x8*)(lds + PG8_SA(b, h) + aoff + m * 2048 + k * 1024); } while (0)
#define PG8_LDB(dst, b, h) do { _Pragma("unroll") for (int n = 0; n < 2; ++n) _Pragma("unroll") for (int k = 0; k < 2; ++k) dst[n][k] = *(const PG8_LAS bf16x8*)(lds + PG8_SB(b, h) + boff + n * 2048 + k * 1024); } while (0)
#define PG8_MMA(ai, bj, At, Bt) do { __builtin_amdgcn_s_setprio(1); _Pragma("unroll") for (int m = 0; m < 4; ++m) _Pragma("unroll") for (int n = 0; n < 2; ++n) _Pragma("unroll") for (int k = 0; k < 2; ++k) \
        acc[ai][bj][m][n] = __builtin_amdgcn_mfma_f32_16x16x32_bf16(Bt[n][k], At[m][k], acc[ai][bj][m][n], 0, 0, 0); __builtin_amdgcn_s_setprio(0); } while (0)
#define PG8_WAIT_V(n) asm volatile("s_waitcnt vmcnt(" #n ")" ::: "memory")
#define PG8_WAIT_L(n) asm volatile("s_waitcnt lgkmcnt(" #n ")" ::: "memory")
#define PG8_BAR __builtin_amdgcn_s_barrier()
#define PG8_SCHED __builtin_amdgcn_sched_barrier(0)
    Unit cur, nxt; int ui = 0;
    if (!S.next(0, cur)) return;
    f32x4 acc[2][2][4][2];
#pragma unroll
    for (int a = 0; a < 2; ++a)
#pragma unroll
        for (int b = 0; b < 2; ++b)
#pragma unroll
            for (int m = 0; m < 4; ++m)
#pragma unroll
                for (int n = 0; n < 2; ++n) acc[a][b][m][n] = (f32x4){0.f, 0.f, 0.f, 0.f};
    bf16x8 At[4][2], B0[2][2], B1[2][2];
    const char* cA = (const char*)g.A + (size_t)cur.pm * tstep; const char* cB = (const char*)g.Bt + (size_t)cur.pn * tstep;
    S.a_ready(cur);
    if constexpr (SP2) {
        PG8_STAGE(PG8_SB(0, 0), cB, voffB); PG8_STAGE(PG8_SB(0, 1), cB + hstep, voffB); PG8_STAGE(PG8_SA(0, 0), cA, voffA); PG8_STAGE(PG8_SA(0, 1), cA + hstep, voffA);
        if (wr == 1) PG8_BAR;
        PG8_WAIT_V(2); PG8_BAR;
        PG8_STAGE(PG8_SB(1, 0), cB + kstep, voffB); PG8_STAGE(PG8_SA(1, 0), cA + kstep, voffA); PG8_STAGE(PG8_SB(1, 1), cB + hstep + kstep, voffB);
        PG8_WAIT_V(6); PG8_BAR;
    } else {
        PG8_STAGE(PG8_SB(0, 0), cB, voffB); PG8_STAGE(PG8_SA(0, 0), cA, voffA); PG8_STAGE(PG8_SB(0, 1), cB + hstep, voffB); PG8_STAGE(PG8_SA(0, 1), cA + hstep, voffA);
        if (wr == 1) PG8_BAR;
        PG8_WAIT_V(4); PG8_BAR;
        PG8_STAGE(PG8_SB(1, 0), cB + kstep, voffB); PG8_STAGE(PG8_SA(1, 0), cA + kstep, voffA); PG8_STAGE(PG8_SB(1, 1), cB + hstep + kstep, voffB);
        PG8_WAIT_V(6); PG8_BAR;
    }
    for (;;) {
        const bool has_next = S.next(ui + 1, nxt);
        const char* nA = has_next ? (const char*)g.A + (size_t)nxt.pm * tstep : cA; const char* nB = has_next ? (const char*)g.Bt + (size_t)nxt.pn * tstep : cB;
        for (int t = 0; t < nt; t += 2) {
            const bool last = (t == nt - 2);
            const char* a1 = cA + (size_t)(t + 1) * kstep;
            const char* a2 = last ? nA : cA + (size_t)(t + 2) * kstep; const char* b2 = last ? nB : cB + (size_t)(t + 2) * kstep;
            const char* a3 = a2 + kstep; const char* b3 = b2 + kstep;
            if (last && has_next) S.a_ready(nxt);
            if constexpr (SP2) {
            PG8_LDB(B0, 0, 0); PG8_LDB(B1, 0, 1); PG8_SCHED; PG8_LDA(At, 0, 0); PG8_STAGE(PG8_SA(1, 1), a1 + hstep, voffA);
            PG8_WAIT_V(8); PG8_WAIT_L(0); PG8_BAR; PG8_MMA(0, 0, At, B0); PG8_MMA(0, 1, At, B1); PG8_BAR; PG8_SCHED;
            PG8_LDA(At, 0, 1); PG8_STAGE(PG8_SB(0, 0), b2, voffB); PG8_STAGE(PG8_SB(0, 1), b2 + hstep, voffB); PG8_STAGE(PG8_SA(0, 0), a2, voffA);
            PG8_WAIT_V(8); PG8_WAIT_L(0); PG8_BAR; PG8_MMA(1, 0, At, B0); PG8_MMA(1, 1, At, B1); PG8_BAR; PG8_SCHED;
            PG8_LDB(B0, 1, 0); PG8_LDB(B1, 1, 1); PG8_SCHED; PG8_LDA(At, 1, 0); PG8_STAGE(PG8_SA(0, 1), a2 + hstep, voffA);
            PG8_WAIT_V(8); PG8_WAIT_L(0); PG8_BAR; PG8_MMA(0, 0, At, B0); PG8_MMA(0, 1, At, B1); PG8_BAR; PG8_SCHED;
            PG8_LDA(At, 1, 1); PG8_STAGE(PG8_SB(1, 0), b3, voffB); PG8_STAGE(PG8_SB(1, 1), b3 + hstep, voffB); PG8_STAGE(PG8_SA(1, 0), a3, voffA);
            PG8_WAIT_V(8); PG8_WAIT_L(0); PG8_BAR; PG8_MMA(1, 0, At, B0); PG8_MMA(1, 1, At, B1); PG8_BAR; PG8_SCHED;
            } else {
            PG8_LDB(B0, 0, 0); PG8_SCHED; PG8_LDA(At, 0, 0); PG8_STAGE(PG8_SA(1, 1), a1 + hstep, voffA);
            PG8_WAIT_L(8); PG8_BAR; PG8_WAIT_L(0); PG8_MMA(0, 0, At, B0); PG8_BAR; PG8_SCHED;
            PG8_LDB(B1, 0, 1); PG8_STAGE(PG8_SB(0, 0), b2, voffB);
            PG8_BAR; PG8_WAIT_L(0); PG8_MMA(0, 1, At, B1); PG8_BAR;
            PG8_LDA(At, 0, 1); PG8_STAGE(PG8_SA(0, 0), a2, voffA);
            PG8_BAR; PG8_WAIT_L(0); PG8_MMA(1, 0, At, B0); PG8_BAR; PG8_SCHED;
            PG8_STAGE(PG8_SB(0, 1), b2 + hstep, voffB);
            PG8_WAIT_V(6); PG8_BAR; PG8_MMA(1, 1, At, B1); PG8_BAR;
            PG8_LDB(B0, 1, 0); PG8_SCHED; PG8_LDA(At, 1, 0); PG8_STAGE(PG8_SA(0, 1), a2 + hstep, voffA);
            PG8_WAIT_L(8); PG8_BAR; PG8_WAIT_L(0); PG8_MMA(0, 0, At, B0); PG8_BAR; PG8_SCHED;
            PG8_LDB(B1, 1, 1); PG8_STAGE(PG8_SB(1, 0), b3, voffB);
            PG8_BAR; PG8_WAIT_L(0); PG8_MMA(0, 1, At, B1); PG8_BAR;
            PG8_LDA(At, 1, 1); PG8_STAGE(PG8_SA(1, 0), a3, voffA);
            PG8_BAR; PG8_WAIT_L(0); PG8_MMA(1, 0, At, B0); PG8_BAR; PG8_SCHED;
            PG8_STAGE(PG8_SB(1, 1), b3 + hstep, voffB);
            PG8_WAIT_V(6); PG8_BAR; PG8_MMA(1, 1, At, B1); PG8_BAR;
            }
        }
        if constexpr (ALIGN_EPI) { if (wr == 0) PG8_BAR; }
        if constexpr (!Epi::AFTER_DRAIN) { E(acc, cur, wr, wc, fr, fq); S.done(cur); }
        if (!has_next) break;
#pragma unroll
        for (int a = 0; a < 2; ++a)
#pragma unroll
            for (int b = 0; b < 2; ++b)
#pragma unroll
                for (int m = 0; m < 4; ++m)
#pragma unroll
                    for (int n = 0; n < 2; ++n) acc[a][b][m][n] = (f32x4){0.f, 0.f, 0.f, 0.f};
        cur = nxt; cA = nA; cB = nB; ++ui;
        if constexpr (ALIGN_EPI) { if (wr == 1) PG8_BAR; }
    }
    PG8_WAIT_V(0);
    if constexpr (!ALIGN_EPI) { if (wr == 0) PG8_BAR; }
    PG8_BAR;
    if constexpr (Epi::AFTER_DRAIN) { E.fused(acc, cur, wr, wc, fr, fq, lds, wid, lane); S.done(cur); }
#undef PG8_SA
#undef PG8_SB
#undef PG8_STAGE
#undef PG8_LDA
#undef PG8_LDB
#undef PG8_MMA
#undef PG8_WAIT_V
#undef PG8_WAIT_L
#undef PG8_BAR
#undef PG8_SCHED
}
}
#define XB_TMO      128
#define XB_XCNT(j)  (256  + 64 * (j))
#define XB_XSUB(j)  (1280 + 64 * (j))
#define XB_XGEN(j)  (2304 + 64 * (j))
#define XB_TOP      3328
#define XB_TOPGEN   3392
#define XCD_BAR_WORDS 3456
#define XB_SPIN_CAP (1u << 18)

__device__ __forceinline__ unsigned xb_ld(unsigned* p)              { return __hip_atomic_load(p, __ATOMIC_RELAXED, __HIP_MEMORY_SCOPE_AGENT); }
__device__ __forceinline__ unsigned xb_add(unsigned* p, unsigned v) { return __hip_atomic_fetch_add(p, v, __ATOMIC_RELAXED, __HIP_MEMORY_SCOPE_AGENT); }
__device__ __forceinline__ unsigned xb_xcc_id() { return (unsigned)__builtin_amdgcn_s_getreg((3 << 11) | 20) & 0xFu; }
#define XB_SPIN(cond, bar) do { unsigned _sp = 0; while (cond) { __builtin_amdgcn_s_sleep(1); \
    if ((++_sp & 255u) == 0u) { if (xb_ld(&(bar)[XB_TMO])) break; if (_sp > XB_SPIN_CAP) { atomicAdd(&(bar)[XB_TMO], 1u); break; } } } } while (0)

struct XcdBarrier {
    unsigned* bar; unsigned x;
    volatile LAS unsigned* st;
};

__device__ __forceinline__ XcdBarrier xcd_barrier_post(unsigned* bar, volatile LAS unsigned* st) {
    XcdBarrier b; b.bar = bar; b.x = xb_xcc_id(); b.st = st;
    if (otid() == 0) (void)xb_add(&bar[XB_XCNT(b.x)], 1u);
    return b;
}
__device__ __forceinline__ void xcd_barrier_complete(unsigned* bar, unsigned x, unsigned& nloc, unsigned& nx) {
    const unsigned G = gridDim.x * gridDim.y * gridDim.z;
    unsigned sum, cnt, mine, sp = 0u;
    for (;;) {
        sum = 0u; cnt = 0u; mine = 0u;
#pragma unroll
        for (unsigned j = 0; j < 16; ++j) { const unsigned c = xb_ld(&bar[XB_XCNT(j)]); sum += c; cnt += (c > 0u) ? 1u : 0u; mine = (j == x) ? c : mine; }
        if (sum == G) break;
        __builtin_amdgcn_s_sleep(1);
        if ((++sp & 255u) == 0u) { if (xb_ld(&bar[XB_TMO])) break; if (sp > XB_SPIN_CAP) { atomicAdd(&bar[XB_TMO], 1u); break; } }
    }
    nloc = mine > 0u ? mine : 1u; nx = cnt > 0u ? cnt : 1u;
}

__device__ __forceinline__ void xcd_barrier(const XcdBarrier& b) {
    asm volatile("s_waitcnt vmcnt(0)" ::: "memory");
    __syncthreads();
    if (otid() == 0) {
        unsigned* bar = b.bar;
        __builtin_amdgcn_s_waitcnt(0);
        unsigned nloc = b.st[0], nx = b.st[1];
        if (nloc == 0u) { xcd_barrier_complete(bar, b.x, nloc, nx); b.st[0] = nloc; b.st[1] = nx; }
        const unsigned old = xb_add(&bar[XB_XSUB(b.x)], 1u);
        const unsigned gen = old / nloc;
        if (old + 1u == (gen + 1u) * nloc) {
            __builtin_amdgcn_fence(__ATOMIC_RELEASE, "agent");
            asm volatile("s_waitcnt vmcnt(0)" ::: "memory");
            const unsigned og = xb_add(&bar[XB_TOP], 1u);
            const unsigned tg = og / nx;
            if (og + 1u == (tg + 1u) * nx) xb_add(&bar[XB_TOPGEN], 1u);
            else XB_SPIN(xb_ld(&bar[XB_TOPGEN]) == tg, bar);
            __builtin_amdgcn_fence(__ATOMIC_ACQUIRE, "agent");
            xb_add(&bar[XB_XGEN(b.x)], 1u);
            asm volatile("s_waitcnt vmcnt(0)" ::: "memory");
        } else {
            XB_SPIN(xb_ld(&bar[XB_XGEN(b.x)]) == gen, bar);
            __builtin_amdgcn_fence(__ATOMIC_ACQUIRE, "agent");
            asm volatile("s_waitcnt vmcnt(0)" ::: "memory");
        }
    }
    __syncthreads();
}

#define FFT_DI DI
#define FFT_M 16384
#define FFT_NT 512
struct cpx { float x, y; };
FFT_DI cpx cmul(cpx a, cpx b) { cpx r; r.x = a.x * b.x - a.y * b.y; r.y = a.x * b.y + a.y * b.x; return r; }
FFT_DI cpx cmulc(cpx a, cpx b) { cpx r; r.x = a.x * b.x + a.y * b.y; r.y = a.y * b.x - a.x * b.y; return r; }
FFT_DI int rev4_14(int k) {
    int r = 0;
#pragma unroll
    for (int d = 0; d < 7; ++d) { r = (r << 2) | (k & 3); k >>= 2; }
    return r;
}
template <class LP, class TP> FFT_DI void fft_fwd_pass(LP lds, TP tw, int s, int tid) {
    const int tws = FFT_M / (4 * s);
#pragma unroll 2
    for (int b = tid; b < FFT_M / 4; b += FFT_NT) {
        const int pos = b % s, base = (b / s) * 4 * s + pos;
        cpx a0, a1, a2, a3;
        a0.x = lds[2 * base]; a0.y = lds[2 * base + 1];
        a1.x = lds[2 * (base + s)]; a1.y = lds[2 * (base + s) + 1];
        a2.x = lds[2 * (base + 2 * s)]; a2.y = lds[2 * (base + 2 * s) + 1];
        a3.x = lds[2 * (base + 3 * s)]; a3.y = lds[2 * (base + 3 * s) + 1];
        cpx t0, t1, t2, t3;
        t0.x = a0.x + a2.x; t0.y = a0.y + a2.y;
        t1.x = a0.x - a2.x; t1.y = a0.y - a2.y;
        t2.x = a1.x + a3.x; t2.y = a1.y + a3.y;
        t3.x = a1.x - a3.x; t3.y = a1.y - a3.y;
        cpx y0, y1, y2, y3;
        y0.x = t0.x + t2.x; y0.y = t0.y + t2.y;
        y2.x = t0.x - t2.x; y2.y = t0.y - t2.y;
        y1.x = t1.x + t3.y; y1.y = t1.y - t3.x;
        y3.x = t1.x - t3.y; y3.y = t1.y + t3.x;
        if (s > 1) {
            cpx w1, w2, w3;
            w1.x = tw[2 * (pos * tws)]; w1.y = tw[2 * (pos * tws) + 1];
            w2.x = tw[2 * (2 * pos * tws)]; w2.y = tw[2 * (2 * pos * tws) + 1];
            w3.x = tw[2 * (3 * pos * tws)]; w3.y = tw[2 * (3 * pos * tws) + 1];
            y1 = cmul(y1, w1); y2 = cmul(y2, w2); y3 = cmul(y3, w3);
        }
        lds[2 * base] = y0.x; lds[2 * base + 1] = y0.y;
        lds[2 * (base + s)] = y1.x; lds[2 * (base + s) + 1] = y1.y;
        lds[2 * (base + 2 * s)] = y2.x; lds[2 * (base + 2 * s) + 1] = y2.y;
        lds[2 * (base + 3 * s)] = y3.x; lds[2 * (base + 3 * s) + 1] = y3.y;
    }
}
template <class LP, class TP> FFT_DI void fft_inv_pass(LP lds, TP tw, int s, int tid) {
    const int tws = FFT_M / (4 * s);
#pragma unroll 2
    for (int b = tid; b < FFT_M / 4; b += FFT_NT) {
        const int pos = b % s, base = (b / s) * 4 * s + pos;
        cpx b0, c1, c2, c3;
        b0.x = lds[2 * base]; b0.y = lds[2 * base + 1];
        c1.x = lds[2 * (base + s)]; c1.y = lds[2 * (base + s) + 1];
        c2.x = lds[2 * (base + 2 * s)]; c2.y = lds[2 * (base + 2 * s) + 1];
        c3.x = lds[2 * (base + 3 * s)]; c3.y = lds[2 * (base + 3 * s) + 1];
        if (s > 1) {
            cpx w1, w2, w3;
            w1.x = tw[2 * (pos * tws)]; w1.y = tw[2 * (pos * tws) + 1];
            w2.x = tw[2 * (2 * pos * tws)]; w2.y = tw[2 * (2 * pos * tws) + 1];
            w3.x = tw[2 * (3 * pos * tws)]; w3.y = tw[2 * (3 * pos * tws) + 1];
            c1 = cmulc(c1, w1); c2 = cmulc(c2, w2); c3 = cmulc(c3, w3);
        }
        cpx t0, t1, t2, t3;
        t0.x = b0.x + c2.x; t0.y = b0.y + c2.y;
        t1.x = b0.x - c2.x; t1.y = b0.y - c2.y;
        t2.x = c1.x + c3.x; t2.y = c1.y + c3.y;
        t3.x = c1.x - c3.x; t3.y = c1.y - c3.y;
        cpx x0, x1, x2, x3;
        x0.x = t0.x + t2.x; x0.y = t0.y + t2.y;
        x2.x = t0.x - t2.x; x2.y = t0.y - t2.y;
        x1.x = t1.x - t3.y; x1.y = t1.y + t3.x;
        x3.x = t1.x + t3.y; x3.y = t1.y - t3.x;
        lds[2 * base] = x0.x; lds[2 * base + 1] = x0.y;
        lds[2 * (base + s)] = x1.x; lds[2 * (base + s) + 1] = x1.y;
        lds[2 * (base + 2 * s)] = x2.x; lds[2 * (base + 2 * s) + 1] = x2.y;
        lds[2 * (base + 3 * s)] = x3.x; lds[2 * (base + 3 * s) + 1] = x3.y;
    }
}
template <class LP, class TP> FFT_DI void rfft_untangle(LP lds, TP tw2, int k, cpx& Xk, cpx& Xm) {
    if (k == 0) {
        const float zr = lds[0], zi = lds[1];
        Xk.x = zr + zi; Xk.y = zr - zi;
        const int p = rev4_14(FFT_M / 2);
        Xm.x = lds[2 * p]; Xm.y = -lds[2 * p + 1];
        return;
    }
    const int pk = rev4_14(k), pm = rev4_14(FFT_M - k);
    cpx Zk, Zm; Zk.x = lds[2 * pk]; Zk.y = lds[2 * pk + 1]; Zm.x = lds[2 * pm]; Zm.y = lds[2 * pm + 1];
    cpx E, O, W, WO;
    E.x = 0.5f * (Zk.x + Zm.x); E.y = 0.5f * (Zk.y - Zm.y);
    O.x = 0.5f * (Zk.y + Zm.y); O.y = -0.5f * (Zk.x - Zm.x);
    W.x = tw2[2 * k]; W.y = tw2[2 * k + 1];
    WO = cmul(W, O);
    Xk.x = E.x + WO.x; Xk.y = E.y + WO.y;
    Xm.x = E.x - WO.x; Xm.y = -(E.y - WO.y);
}
template <class LP, class TP> FFT_DI void rfft_mul_retangle(LP lds, TP tw2, int k, cpx Gk, cpx Gm) {
    cpx Xk, Xm; rfft_untangle(lds, tw2, k, Xk, Xm);
    if (k == 0) {
        const float y0 = Xk.x * Gk.x, yM = Xk.y * Gk.y;
        lds[0] = 0.5f * (y0 + yM); lds[1] = 0.5f * (y0 - yM);
        const cpx Y = cmul(Xm, Gm);
        const int p = rev4_14(FFT_M / 2);
        lds[2 * p] = Y.x; lds[2 * p + 1] = -Y.y;
        return;
    }
    const cpx Yk = cmul(Xk, Gk), Ym = cmul(Xm, Gm);
    cpx W; W.x = tw2[2 * k]; W.y = tw2[2 * k + 1];
    cpx A, D, T;
    A.x = 0.5f * (Yk.x + Ym.x); A.y = 0.5f * (Yk.y - Ym.y);
    D.x = 0.5f * (Yk.x - Ym.x); D.y = 0.5f * (Yk.y + Ym.y);
    T = cmulc(D, W);
    const int pk = rev4_14(k), pm = rev4_14(FFT_M - k);
    lds[2 * pk] = A.x - T.y; lds[2 * pk + 1] = A.y + T.x;
    cpx Dc; Dc.x = -D.x; Dc.y = D.y;
    const cpx T2 = cmul(W, Dc);
    lds[2 * pm] = A.x + T2.y; lds[2 * pm + 1] = -A.y - T2.x;
}
enum { I_X = 0, I_C, I_CTX, I_CCTX, I_WMOD, I_BMOD, I_NMIXW, I_NFFNW, I_WIN, I_BIN, I_HYCW, I_HYCB, I_HYW1, I_HYB1, I_HYW2, I_HYB2, I_HYW3, I_HYB3, I_HYFREQ, I_HYSKIP,
       I_HGLB, I_HGNW, I_GLWA2, I_GLBA, I_GLNW, I_WBR, I_WOUT, I_WRG, I_BRG, I_WRE, I_BRE, I_WGATE, I_WUP, I_WDOWN, I_FNW, N_IN };
struct Args { const float* in[N_IN]; float* out; unsigned char* ws; int ph_lo, ph_hi; };
constexpr int NTHR = 512;
constexpr int LDS_BYTES = 150 * 1024;
constexpr int LDS_X = 131072;
constexpr int LDS_BARW = LDS_BYTES - 64;

DI int z_srccol(int zc) { return zc < 8192 ? zc : (zc < Z_LR ? zc + 32 : (zc < Z_LR + 32 ? zc - Z_LR + 8192 : -1)); }

DI void cvt_tile(const float* __restrict__ src, size_t ld, int sc, bf16* __restrict__ dst, int K, int row0, int kb, LAS float* t) {
    const int tid = otid(), nn = tid & 63, kk = tid >> 6;
#pragma unroll
    for (int p = 0; p < 8; ++p) { const int k = kb * 64 + p * 8 + kk; t[(p * 8 + kk) * 65 + nn] = sc >= 0 ? src[(size_t)k * ld + sc] : 0.f; }
    __syncthreads();
    const int rr = tid >> 3, k8 = tid & 7; float v[8];
#pragma unroll
    for (int j = 0; j < 8; ++j) v[j] = t[(k8 * 8 + j) * 65 + rr];
    u32x4 w; w.x = pk_bf16(v[0], v[1]); w.y = pk_bf16(v[2], v[3]); w.z = pk_bf16(v[4], v[5]); w.w = pk_bf16(v[6], v[7]);
    *(u32x4*)(dst + (size_t)(row0 + rr) * K + kb * 64 + k8 * 8) = w;
    __syncthreads();
}
constexpr int CVT_MIX_TILES = 276 * 32 + 3 * 32 * 16 + 32 * 32;
DI void cvt_mix_item(const Args& a, int l, int it, LAS float* t) {
    const int nn = otid() & 63;
    if (it < 276 * 32) { const int nb = it >> 5, kb = it & 31; cvt_tile(a.in[I_WIN] + (size_t)l * D * NCOLS_IN, NCOLS_IN, z_srccol(nb * 64 + nn), (bf16*)(a.ws + WS_WIN), D, nb * 64, kb, t); return; }
    it -= 276 * 32;
    if (it < 3 * 32 * 16) { const int br = it / 512, r = it % 512, nb = r >> 4, kb = r & 15;
        cvt_tile(a.in[I_WBR] + ((size_t)l * 3 + br) * 1024 * D, D, nb * 64 + nn, (bf16*)(a.ws + WS_WBR) + (size_t)br * D * 1024, 1024, nb * 64, kb, t); return; }
    it -= 3 * 32 * 16;
    { const int nb = it >> 5, kb = it & 31; cvt_tile(a.in[I_WOUT] + (size_t)l * D * D, D, nb * 64 + nn, (bf16*)(a.ws + WS_WOUT), D, nb * 64, kb, t); }
}
constexpr int CVT_MOE_TILES = 32 * 16 * 32 + 32 * 32 * 8;
DI void cvt_moe_item(const Args& a, int l, int it, LAS float* t) {
    const int nn = otid() & 63;
    if (it < 32 * 16 * 32) { const int e = it >> 9, r = it & 511, nb = r >> 5, kb = r & 31, nt = nb >> 2, sub = nb & 3;
        const float* src = (sub < 2 ? a.in[I_WGATE] : a.in[I_WUP]) + ((size_t)l * NEXP + e) * D * DFF;
        cvt_tile(src, DFF, nt * 128 + (sub & 1) * 64 + nn, (bf16*)(a.ws + WS_WGU) + (size_t)e * 1024 * D, D, nb * 64, kb, t); return; }
    it -= 32 * 16 * 32;
    { const int e = it >> 8, r = it & 255, nb = r >> 3, kb = r & 7;
      cvt_tile(a.in[I_WDOWN] + ((size_t)l * NEXP + e) * DFF * D, D, nb * 64 + nn, (bf16*)(a.ws + WS_WD) + (size_t)e * D * DFF, DFF, nb * 64, kb, t); }
}

DI void mod_item(const Args& a, int j, LAS float* lds) {
    const int tid = otid(), l = j >> 7, col0 = (j & 127) * 96;
    LAS float* sil = lds;
    LAS float* red = lds + 4096;
    for (int k = tid; k < 2 * D; k += NTHR) { const float c = (k < D) ? a.in[I_C][k] : a.in[I_CCTX][k - D]; sil[k] = siluf_(c); }
    __syncthreads();
    const int cg = tid % 24, rg = tid / 24;
    f32x4 a0 = {0.f, 0.f, 0.f, 0.f}, a1 = {0.f, 0.f, 0.f, 0.f};
    if (rg < 21) {
        const float* w = a.in[I_WMOD] + (size_t)l * D * 12288 + col0 + cg * 4;
        for (int k = rg; k < D; k += 21) { const f32x4 wv = *(const f32x4*)(w + (size_t)k * 12288); a0 += wv * sil[k]; a1 += wv * sil[D + k]; }
#pragma unroll
        for (int q = 0; q < 4; ++q) { red[(rg * 2 + 0) * 96 + cg * 4 + q] = a0[q]; red[(rg * 2 + 1) * 96 + cg * 4 + q] = a1[q]; }
    }
    __syncthreads();
    if (tid < 192) { const int set = tid / 96, c = tid % 96; float s = 0.f;
        for (int r = 0; r < 21; ++r) s += red[(r * 2 + set) * 96 + c];
        ((float*)(a.ws + WS_MOD))[((size_t)l * 2 + set) * 12288 + col0 + c] = s + a.in[I_BMOD][(size_t)l * 12288 + col0 + c]; }
    __syncthreads();
}
DI void h2_item(const Args& a, int it, LAS float* lds) {
    const int tid = otid(), l = it / (MT / 8), r0 = (it % (MT / 8)) * 8;
    LAS float* feats = lds;
    LAS float* h1 = lds + 8 * 36;
    if (tid < 8 * 33) { const int rr = tid / 33, i = tid % 33, r = r0 + rr; const int Lq = r < SEQ ? SEQ : CTXL, t = r < SEQ ? r : r - SEQ;
        float f;
        if (i == 0) f = (float)t / (float)(Lq - 1);
        else { const int bi = (i - 1) & 15; const float band = 1e-4f + (float)bi * ((15.0f - 1e-4f) / 15.0f); const float rev2 = 2.0f * band * (float)t / (float)Lq;
            f = (i <= 16) ? cospif(rev2) : -sinpif(rev2); }
        feats[rr * 36 + i] = f; }
    __syncthreads();
    const int rr = tid >> 6, j = tid & 63;
    { const float* w1 = a.in[I_HYW1] + (size_t)l * 33 * 64; float s = a.in[I_HYB1][l * 64 + j];
      for (int i = 0; i < 33; ++i) s += feats[rr * 36 + i] * w1[i * 64 + j];
      h1[rr * 64 + j] = sinf(a.in[I_HYFREQ][l * 64 + j] * s); }
    __syncthreads();
    { const float* w2 = a.in[I_HYW2] + (size_t)l * 64 * 64; float s = a.in[I_HYB2][l * 64 + j];
      for (int i = 0; i < 64; ++i) s += h1[rr * 64 + i] * w2[i * 64 + j];
      ((float*)(a.ws + WS_H2))[((size_t)l * MT + r0 + rr) * 64 + j] = sinf(a.in[I_HYFREQ][l * 64 + j] * s); }
    __syncthreads();
}
DI void prologue_small(const Args& a) {
    const size_t gt = (size_t)obid() * NTHR + otid(), gs = (size_t)gridDim.x * NTHR;
    float* zb = (float*)(a.ws + WS_ZBIAS);
    for (size_t i = gt; i < (size_t)DEPTH * ZC; i += gs) { const int l = (int)(i / ZC), zc = (int)(i % ZC), sc = z_srccol(zc); zb[i] = sc >= 0 ? a.in[I_BIN][(size_t)l * NCOLS_IN + sc] : 0.f; }
    float* lb = (float*)(a.ws + WS_LB);
    for (size_t i = gt; i < (size_t)DEPTH * 2048; i += gs) { const int l = (int)(i / 2048), j = (int)(i % 2048);
        float v = 0.f; if (l == 1) { const float r0 = a.in[I_HGLB][j], r1 = a.in[I_HGLB][2048 + j]; v = 1.0f / (1.0f + expf(r0 - r1)); }
        lb[i] = v; }
    float* tw = (float*)(a.ws + WS_TW);
    for (size_t i = gt; i < 16384; i += gs) { float s, c; sincospif(-2.0f * (float)i / 16384.0f, &s, &c); tw[2 * i] = c; tw[2 * i + 1] = s; }
    float* tw2 = (float*)(a.ws + WS_TW2);
    for (size_t i = gt; i <= 8192; i += gs) { float s, c; sincospif(-(float)i / 16384.0f, &s, &c); tw2[2 * i] = c; tw2[2 * i + 1] = s; }
}
DI void hyc_filters(const Args& a, int l) {
    const int lane = otid() & 63, wave = otid() >> 6;
    const float* h2 = (const float*)(a.ws + WS_H2) + ((size_t)l * MT + SEQ) * 64;
    const float* w3 = a.in[I_HYW3] + (size_t)l * 64 * 2048;
    float* hyc = (float*)(a.ws + WS_HYC);
    const float a0 = -4.605170186f / 1.5f, a1 = -4.605170186f / 0.3f;
    for (int fc = obid() * 8 + wave; fc < 2048; fc += gridDim.x * 8) {
        const int c = fc & 1023; const float delta = fabsf(a0 + (float)c * ((a1 - a0) / 1023.0f)); const float b3 = a.in[I_HYB3][l * 2048 + fc];
        float hv[4], ssum = 0.f;
#pragma unroll
        for (int i = 0; i < 4; ++i) { const int t = lane + 64 * i; float s = b3;
            for (int j = 0; j < 64; ++j) s += h2[t * 64 + j] * w3[j * 2048 + fc];
            const float tl = (float)t / 255.0f; hv[i] = s * (expf(-tl * delta) + 0.05f); ssum += fabsf(hv[i]); }
        ssum = wave_sum(ssum); const float inv = 1.0f / ssum;
#pragma unroll
        for (int i = 0; i < 4; ++i) hyc[(size_t)fc * 256 + lane + 64 * i] = hv[i] * inv;
    }
}
template <int MODE> DI void norm_phase(const Args& a, int l, int nrows, LAS float* ldsf) {
    const int lane = otid() & 63, wave = otid() >> 6;
    float* H = (float*)(a.ws + WS_H); bf16* U = (bf16*)(a.ws + WS_U);
    const float* modall = (const float*)(a.ws + WS_MOD);
    int* route = (int*)(a.ws + WS_ROUTE);
    const bf16* YP = (const bf16*)(a.ws + WS_YP);
    const bool combine = (MODE == 0 && l > 0) || MODE == 2;
    for (int r = obid() * 8 + wave; r < nrows; r += gridDim.x * 8) {
        const int set = r >= SEQ ? 1 : 0;
        const float* src = (MODE == 0 && l == 0) ? (set ? a.in[I_CTX] + (size_t)(r - SEQ) * D : a.in[I_X] + (size_t)r * D) : H + (size_t)r * D;
        f32x4 v[8];
#pragma unroll
        for (int j = 0; j < 8; ++j) v[j] = *(const f32x4*)(src + j * 256 + lane * 4);
        if (combine) {
            const float* gt2 = modall + ((size_t)(l - 1) * 2 + set) * 12288 + 10240;
            const int p0 = route[r * 8 + 6], p1 = route[r * 8 + 7];
#pragma unroll
            for (int j = 0; j < 8; ++j) { const int col = j * 256 + lane * 4;
                const u32x2 y0 = *(const u32x2*)(YP + (size_t)p0 * D + col), y1 = *(const u32x2*)(YP + (size_t)p1 * D + col); const f32x4 g = *(const f32x4*)(gt2 + col);
                v[j][0] += g[0] * (bflo(y0.x) + bflo(y1.x)); v[j][1] += g[1] * (bfhi(y0.x) + bfhi(y1.x)); v[j][2] += g[2] * (bflo(y0.y) + bflo(y1.y)); v[j][3] += g[3] * (bfhi(y0.y) + bfhi(y1.y)); }
            if (MODE == 0) {
#pragma unroll
                for (int j = 0; j < 8; ++j) *(f32x4*)(H + (size_t)r * D + j * 256 + lane * 4) = v[j];
            }
        }
        float ss = 0.f;
#pragma unroll
        for (int j = 0; j < 8; ++j) ss += (v[j][0] * v[j][0] + v[j][1] * v[j][1]) + (v[j][2] * v[j][2] + v[j][3] * v[j][3]);
        ss = wave_sum(ss);
        const float rstd = rsqrtf(ss * (1.0f / D) + NORM_EPS);
        if (MODE == 2) {
            const float* fw = a.in[I_FNW];
#pragma unroll
            for (int j = 0; j < 8; ++j) { const int col = j * 256 + lane * 4; const f32x4 w = *(const f32x4*)(fw + col); *(f32x4*)(a.out + (size_t)r * D + col) = v[j] * rstd * w; }
        } else {
            const float* nw = (MODE == 0 ? a.in[I_NMIXW] : a.in[I_NFFNW]) + (size_t)l * D;
            const float* md = modall + ((size_t)l * 2 + set) * 12288 + (MODE == 0 ? 0 : 6144);
#pragma unroll
            for (int j = 0; j < 8; ++j) { const int col = j * 256 + lane * 4; const f32x4 w = *(const f32x4*)(nw + col), sh = *(const f32x4*)(md + col), sc = *(const f32x4*)(md + 2048 + col);
                v[j] = (v[j] * rstd * w) * (sc + 1.0f) + sh;
                u32x2 o; o.x = pk_bf16(v[j][0], v[j][1]); o.y = pk_bf16(v[j][2], v[j][3]); *(u32x2*)(U + (size_t)r * D + col) = o; }
            if (MODE == 1) {
                const float* wrg = a.in[I_WRG] + (size_t)l * D * 4; const float* wre = a.in[I_WRE] + (size_t)l * D * 32;
                float lg[36];
#pragma unroll
                for (int i = 0; i < 36; ++i) lg[i] = 0.f;
                LAS float* wu = ldsf + wave * 2048;
#pragma unroll
                for (int j = 0; j < 8; ++j) *(LAS f32x4*)(wu + j * 256 + lane * 4) = v[j];
                asm volatile("s_waitcnt lgkmcnt(0)" ::: "memory");
#pragma unroll 2
                for (int cc = 0; cc < 32; ++cc) { const int col = cc * 64 + lane; const float uv = wu[col];
                    const f32x4 g = *(const f32x4*)(wrg + (size_t)col * 4);
                    lg[0] += uv * g[0]; lg[1] += uv * g[1]; lg[2] += uv * g[2]; lg[3] += uv * g[3];
#pragma unroll
                    for (int e4 = 0; e4 < 8; ++e4) { const f32x4 w = *(const f32x4*)(wre + (size_t)col * 32 + e4 * 4);
                        lg[4 + e4 * 4 + 0] += uv * w[0]; lg[4 + e4 * 4 + 1] += uv * w[1]; lg[4 + e4 * 4 + 2] += uv * w[2]; lg[4 + e4 * 4 + 3] += uv * w[3]; } }
                asm volatile("s_waitcnt lgkmcnt(0)" ::: "memory");
#pragma unroll
                for (int i = 0; i < 36; ++i) lg[i] = wave_sum(lg[i]);
                float gl[4]; int grp = 0; float gmax;
#pragma unroll
                for (int g = 0; g < 4; ++g) gl[g] = lg[g] + a.in[I_BRG][l * 4 + g];
                gmax = gl[0];
#pragma unroll
                for (int g = 1; g < 4; ++g) if (gl[g] > gmax) { gmax = gl[g]; grp = g; }
                float gden = 0.f;
#pragma unroll
                for (int g = 0; g < 4; ++g) gden += expf(gl[g] - gmax);
                const float ptop = 1.0f / gden;
                float le[8];
#pragma unroll
                for (int i = 0; i < 8; ++i) { float x = lg[4 + i];
#pragma unroll
                    for (int g = 1; g < 4; ++g) x = (grp == g) ? lg[4 + g * 8 + i] : x;
                    le[i] = x + a.in[I_BRE][l * 32 + grp * 8 + i]; }
                int i0 = 0; float m0 = le[0];
#pragma unroll
                for (int i = 1; i < 8; ++i) if (le[i] > m0) { m0 = le[i]; i0 = i; }
                int i1 = -1; float m1 = -3.0e38f;
#pragma unroll
                for (int i = 0; i < 8; ++i) if (i != i0 && le[i] > m1) { m1 = le[i]; i1 = i; }
                const float e1v = expf(m1 - m0);
                const float w0 = ptop / (1.0f + e1v), w1 = ptop * e1v / (1.0f + e1v);
                if (lane == 0) {
                    unsigned* cnt = (unsigned*)(a.ws + WS_CTL) + CW_CNT + l * 64;
                    const int ex0 = grp * 8 + i0, ex1 = grp * 8 + i1;
                    const unsigned s0 = atomicAdd(cnt + ex0, 1u), s1 = atomicAdd(cnt + ex1, 1u);
                    route[r * 8 + 0] = ex0; route[r * 8 + 1] = ex1; route[r * 8 + 2] = (int)s0; route[r * 8 + 3] = (int)s1;
                    route[r * 8 + 4] = __float_as_int(w0); route[r * 8 + 5] = __float_as_int(w1);
                }
            }
        }
    }
}
DI void permute_phase(const Args& a, int l, int nrows, LAS unsigned char* ldsb) {
    LAS int* poff = (LAS int*)ldsb;
    const int tid = otid(), lane = tid & 63, wave = tid >> 6;
    const unsigned* cnt = (const unsigned*)(a.ws + WS_CTL) + CW_CNT + l * 64;
    if (tid == 0) { int off = 0; for (int e = 0; e < NEXP; ++e) { poff[e] = off; off += (int)((cnt[e] + 255u) / 256u) * 256; } poff[32] = off; }
    __syncthreads();
    if (obid() == 0) { int* tile_e = (int*)(a.ws + WS_TILEE); const int nt = poff[32] >> 8;
        if (tid < 200) { int e = -1; if (tid < nt) { for (int q = 0; q < NEXP; ++q) if (poff[q] <= tid * 256) e = q; } tile_e[tid] = e < 0 ? 0 : e; }
        if (tid == 0) tile_e[200] = nt; }
    int* route = (int*)(a.ws + WS_ROUTE); float* roww = (float*)(a.ws + WS_ROWW);
    const bf16* U = (const bf16*)(a.ws + WS_U); bf16* XP = (bf16*)(a.ws + WS_XP);
    for (int r = obid() * 8 + wave; r < nrows; r += gridDim.x * 8) {
        const int e0 = route[r * 8 + 0], e1 = route[r * 8 + 1], s0 = route[r * 8 + 2], s1 = route[r * 8 + 3];
        const int p0 = poff[e0] + s0, p1 = poff[e1] + s1;
        u32x4 x[4];
#pragma unroll
        for (int i = 0; i < 4; ++i) x[i] = *(const u32x4*)(U + (size_t)r * D + (i * 64 + lane) * 8);
#pragma unroll
        for (int i = 0; i < 4; ++i) { *(u32x4*)(XP + (size_t)p0 * D + (i * 64 + lane) * 8) = x[i]; *(u32x4*)(XP + (size_t)p1 * D + (i * 64 + lane) * 8) = x[i]; }
        if (lane == 0) { route[r * 8 + 6] = p0; route[r * 8 + 7] = p1; roww[p0] = __int_as_float(route[r * 8 + 4]); roww[p1] = __int_as_float(route[r * 8 + 5]); }
    }
}
DI int stream_row(int p, int dir) { return dir == 0 ? (p < CTXL ? SEQ + p : p - CTXL) : (p < CTXL ? SEQ + (CTXL - 1 - p) : (SEQ - 1) - (p - CTXL)); }

DI void scan_item(const Args& a, int l, int it, LAS unsigned char* ldsb) {
    const int tid = otid(), lane = tid & 63, wave = tid >> 6;
    LAS float* sA = (LAS float*)ldsb;
    LAS float* sK = sA + 64 * 128;
    LAS float* sQ = sK + 64 * 128;
    LAS float* sV = sQ + 64 * 128;
    LAS float* sO = sV + 64 * 16;
    LAS float* sW = sO + 64 * 16;
    LAS float* sB = sW + 16 * 128;
    const bool gla = it >= 128; int head, dir, slice;
    if (!gla) { head = it >> 4; dir = (it >> 3) & 1; slice = it & 7; } else { const int j = it - 128; head = j >> 5; dir = (j >> 4) & 1; slice = j & 15; }
    const bf16* Z = (const bf16*)(a.ws + WS_Z);
    float* O = (float*)(a.ws + WS_OSC) + (size_t)((gla ? 2 : 0) + dir) * MT * 1024;
    const int ocol0 = (gla ? head * 256 : head * 128) + slice * 16;
    if (gla) { for (int i = tid; i < 16 * 128; i += NTHR) sW[i] = a.in[I_GLWA2][(((size_t)l * 2 + dir) * 16 + (i >> 7)) * 512 + head * 128 + (i & 127)];
               if (tid < 128) sB[tid] = a.in[I_GLBA][((size_t)l * 2 + dir) * 512 + head * 128 + tid]; }
    else { if (tid < 128) sB[tid] = ((const float*)(a.ws + WS_LB))[((size_t)l * 2 + dir) * 1024 + head * 128 + tid]; }
    __syncthreads();
    const int vi = lane >> 5, kg = lane & 31, vcol = wave * 2 + vi;
    float S0 = 0.f, S1 = 0.f, S2 = 0.f, S3 = 0.f;
    for (int pb = 0; pb < MT / 64; ++pb) {
        { const int tt = tid >> 3, kc = tid & 7, r = stream_row(pb * 64 + tt, dir);
          const bf16* zr = Z + (size_t)r * ZC;
          if (!gla) {
              const bf16* zq = zr + Z_HG + head * 128 + kc * 16; const bf16* zf = zr + Z_HG + 1024 * (1 + dir) + head * 128 + kc * 16;
#pragma unroll
              for (int j = 0; j < 16; ++j) { const int k = kc * 16 + j; const float q = bf2f(zq[j]), f = bf2f(zf[j]), lbv = sB[k];
                  sA[tt * 128 + k] = lbv + (1.0f - lbv) * sigmoidf_(f); sK[tt * 128 + k] = (1.0f - lbv) * sigmoidf_(-f); sQ[tt * 128 + k] = siluf_(q); }
              if (kc < 2) {
#pragma unroll
                  for (int j = 0; j < 8; ++j) sV[tt * 16 + kc * 8 + j] = bf2f(zr[Z_HG + 3072 + head * 128 + slice * 16 + kc * 8 + j]); }
          } else {
              float af[16];
#pragma unroll
              for (int rr = 0; rr < 16; ++rr) af[rr] = bf2f(zr[Z_LR + dir * 16 + rr]);
              const bf16* zq = zr + Z_GL + head * 128 + kc * 16; const bf16* zk = zr + Z_GL + 512 + head * 128 + kc * 16;
#pragma unroll
              for (int j = 0; j < 16; ++j) { const int k = kc * 16 + j; float x = sB[k];
#pragma unroll
                  for (int rr = 0; rr < 16; ++rr) x += af[rr] * sW[rr * 128 + k];
                  const float ls = fminf(x, 0.f) - log1pf(__expf(-fabsf(x)));
                  sA[tt * 128 + k] = __expf(ls * 0.0625f); sK[tt * 128 + k] = bf2f(zk[j]); sQ[tt * 128 + k] = bf2f(zq[j]) * 0.08838834764831845f; }
              if (kc < 2) {
#pragma unroll
                  for (int j = 0; j < 8; ++j) sV[tt * 16 + kc * 8 + j] = bf2f(zr[Z_GL + 1024 + head * 256 + slice * 16 + kc * 8 + j]); }
          } }
        __syncthreads();
#pragma unroll
        for (int half = 0; half < 2; ++half) {
            float keep = 0.f;
#pragma unroll 8
            for (int t2 = 0; t2 < 32; ++t2) { const int tt = half * 32 + t2;
                const f32x4 av = *(const LAS f32x4*)(sA + tt * 128 + kg * 4), kv = *(const LAS f32x4*)(sK + tt * 128 + kg * 4), qv = *(const LAS f32x4*)(sQ + tt * 128 + kg * 4);
                const float vv = sV[tt * 16 + vcol];
                S0 = av[0] * S0 + kv[0] * vv; S1 = av[1] * S1 + kv[1] * vv; S2 = av[2] * S2 + kv[2] * vv; S3 = av[3] * S3 + kv[3] * vv;
                float part = (qv[0] * S0 + qv[1] * S1) + (qv[2] * S2 + qv[3] * S3);
                part += __shfl_xor(part, 16); part += __shfl_xor(part, 8); part += __shfl_xor(part, 4); part += __shfl_xor(part, 2); part += __shfl_xor(part, 1);
                keep = (kg == t2) ? part : keep; }
            sO[(half * 32 + kg) * 16 + vcol] = keep;
        }
        __syncthreads();
        if (tid < 256) { const int tt = tid >> 2, c4 = (tid & 3) * 4, r = stream_row(pb * 64 + tt, dir);
            *(f32x4*)(O + (size_t)r * 1024 + ocol0 + c4) = *(const LAS f32x4*)(sO + tt * 16 + c4); }
        __syncthreads();
    }
}

DI void shortconv8(const bf16* Z, const float* cw, const float* cb, int l, int seg, int c, int r0, int lo, int hi, float (&out)[8]) {
    const int col = Z_HY + seg * 1024 + c; float zz[10];
#pragma unroll
    for (int i = 0; i < 10; ++i) { const int r = r0 - 1 + i; zz[i] = (r >= lo && r < hi) ? bf2f(Z[(size_t)r * ZC + col]) : 0.f; }
    const float w0 = cw[((size_t)l * 3 + 0) * 3072 + seg * 1024 + c], w1 = cw[((size_t)l * 3 + 1) * 3072 + seg * 1024 + c], w2 = cw[((size_t)l * 3 + 2) * 3072 + seg * 1024 + c], b = cb[(size_t)l * 3072 + seg * 1024 + c];
#pragma unroll
    for (int i = 0; i < 8; ++i) out[i] = w0 * zz[i] + w1 * zz[i + 1] + w2 * zz[i + 2] + b;
}
DI void hyprep_item(const Args& a, int l, int it, LAS float* t) {
    const int tid = otid(), tb = it >> 4, cb = it & 15, r0 = tb * 64, lo = r0 < SEQ ? 0 : SEQ, hi = r0 < SEQ ? SEQ : MT;
    const bf16* Z = (const bf16*)(a.ws + WS_Z); float* VXT = (float*)(a.ws + WS_U);
    { const int cc = tid & 63, tq = tid >> 6, c = cb * 64 + cc; float x1[8], vv[8];
      shortconv8(Z, a.in[I_HYCW], a.in[I_HYCB], l, 1, c, r0 + tq * 8, lo, hi, x1); shortconv8(Z, a.in[I_HYCW], a.in[I_HYCB], l, 2, c, r0 + tq * 8, lo, hi, vv);
#pragma unroll
      for (int i = 0; i < 8; ++i) t[cc * 65 + tq * 8 + i] = vv[i] * x1[i]; }
    __syncthreads();
    { const int cw = tid >> 3, t8 = tid & 7; f32x4 o0, o1;
#pragma unroll
      for (int i = 0; i < 4; ++i) { o0[i] = t[cw * 65 + t8 * 8 + i]; o1[i] = t[cw * 65 + t8 * 8 + 4 + i]; }
      float* dst = VXT + (size_t)(cb * 64 + cw) * MT + r0 + t8 * 8; *(f32x4*)dst = o0; *(f32x4*)(dst + 4) = o1; }
    __syncthreads();
}
DI void hycomb_item(const Args& a, int l, int it, LAS float* t) {
    const int tid = otid(), tb = it >> 4, cb = it & 15, r0 = tb * 64, lo = r0 < SEQ ? 0 : SEQ, hi = r0 < SEQ ? SEQ : MT;
    const bf16* Z = (const bf16*)(a.ws + WS_Z); const float* VXT = (const float*)(a.ws + WS_U); bf16* Y0 = (bf16*)(a.ws + WS_YMIX);
    { const int cw = tid >> 3, t8 = tid & 7; const float* srcp = VXT + (size_t)(cb * 64 + cw) * MT + r0 + t8 * 8; const f32x4 i0 = *(const f32x4*)srcp, i1 = *(const f32x4*)(srcp + 4);
#pragma unroll
      for (int i = 0; i < 4; ++i) { t[cw * 65 + t8 * 8 + i] = i0[i]; t[cw * 65 + t8 * 8 + 4 + i] = i1[i]; } }
    __syncthreads();
    { const int cc = tid & 63, tq = tid >> 6, c = cb * 64 + cc; float x0[8];
      shortconv8(Z, a.in[I_HYCW], a.in[I_HYCB], l, 0, c, r0 + tq * 8, lo, hi, x0);
#pragma unroll
      for (int i = 0; i < 8; ++i) Y0[(size_t)(r0 + tq * 8 + i) * 1024 + c] = f2bf(t[cc * 65 + tq * 8 + i] * x0[i]); }
    __syncthreads();
}
DI void scancomb_rows(const Args& a, int l, int nrows) {
    const int lane = otid() & 63, wave = otid() >> 6;
    const bf16* Z = (const bf16*)(a.ws + WS_Z); const float* O = (const float*)(a.ws + WS_OSC);
    bf16* Y1 = (bf16*)(a.ws + WS_YMIX) + (size_t)MT * 1024; bf16* Y2 = Y1 + (size_t)MT * 1024;
    for (int r = obid() * 8 + wave; r < nrows; r += gridDim.x * 8) {
#pragma unroll
        for (int i = 0; i < 4; ++i) { const int col = i * 256 + lane * 4;
            { const f32x4 of = *(const f32x4*)(O + (size_t)r * 1024 + col), ob = *(const f32x4*)(O + ((size_t)MT + r) * 1024 + col); const f32x4 o = of + ob;
              float ss = (o[0] * o[0] + o[1] * o[1]) + (o[2] * o[2] + o[3] * o[3]);
              ss += __shfl_xor(ss, 16); ss += __shfl_xor(ss, 8); ss += __shfl_xor(ss, 4); ss += __shfl_xor(ss, 2); ss += __shfl_xor(ss, 1);
              const float rstd = rsqrtf(ss * (1.0f / 128.0f) + NORM_EPS);
              const f32x4 nw = *(const f32x4*)(a.in[I_HGNW] + (size_t)l * 128 + (col & 127));
              const u32x2 g = *(const u32x2*)(Z + (size_t)r * ZC + Z_HG + 4096 + col);
              u32x2 w; w.x = pk_bf16(o[0] * rstd * nw[0] * sigmoidf_(bflo(g.x)), o[1] * rstd * nw[1] * sigmoidf_(bfhi(g.x)));
              w.y = pk_bf16(o[2] * rstd * nw[2] * sigmoidf_(bflo(g.y)), o[3] * rstd * nw[3] * sigmoidf_(bfhi(g.y)));
              *(u32x2*)(Y1 + (size_t)r * 1024 + col) = w; }
            { const f32x4 of = *(const f32x4*)(O + ((size_t)2 * MT + r) * 1024 + col), ob = *(const f32x4*)(O + ((size_t)3 * MT + r) * 1024 + col); const f32x4 o = of + ob;
              float ss = (o[0] * o[0] + o[1] * o[1]) + (o[2] * o[2] + o[3] * o[3]); ss = wave_sum(ss);
              const float rstd = rsqrtf(ss * (1.0f / 256.0f) + NORM_EPS);
              const f32x4 nw = *(const f32x4*)(a.in[I_GLNW] + (size_t)l * 256 + (col & 255));
              const u32x2 g = *(const u32x2*)(Z + (size_t)r * ZC + Z_GL + 2048 + col);
              u32x2 w; w.x = pk_bf16(o[0] * rstd * nw[0] * siluf_(bflo(g.x)), o[1] * rstd * nw[1] * siluf_(bfhi(g.x)));
              w.y = pk_bf16(o[2] * rstd * nw[2] * siluf_(bflo(g.y)), o[3] * rstd * nw[3] * siluf_(bfhi(g.y)));
              *(u32x2*)(Y2 + (size_t)r * 1024 + col) = w; }
        }
    }
}
DI void hyconv_item(const Args& a, int l, int c, LAS unsigned char* ldsb) {
    const int tid = otid();
    LAS float* lds = (LAS float*)ldsb;
    LAS float* xs = (LAS float*)(ldsb + LDS_X);
    const float* tw = (const float*)(a.ws + WS_TW); const float* tw2 = (const float*)(a.ws + WS_TW2);
    const float* h2 = (const float*)(a.ws + WS_H2) + (size_t)l * MT * 64;
    float* VX = (float*)(a.ws + WS_U) + (size_t)c * MT;
    if (tid < 128) xs[tid] = a.in[I_HYW3][((size_t)l * 64 + (tid & 63)) * 2048 + (tid >> 6) * 1024 + c];
    __syncthreads();
    const float a0 = -4.605170186f / 1.5f, a1 = -4.605170186f / 0.3f;
    const float delta = fabsf(a0 + (float)c * ((a1 - a0) / 1023.0f));
    const float b3f = a.in[I_HYB3][l * 2048 + c], b3b = a.in[I_HYB3][l * 2048 + 1024 + c];
    float sf = 0.f, sb = 0.f;
    for (int i = 0; i < 32; ++i) { const int t = tid + 512 * i; const float* hr = h2 + (size_t)t * 64; float hf = b3f, hb = b3b;
#pragma unroll
        for (int j4 = 0; j4 < 16; ++j4) { const f32x4 hv = *(const f32x4*)(hr + j4 * 4);
#pragma unroll
            for (int q = 0; q < 4; ++q) { hf += hv[q] * xs[j4 * 4 + q]; hb += hv[q] * xs[64 + j4 * 4 + q]; } }
        const float dec = expf(-((float)t / (float)(SEQ - 1)) * delta) + 0.05f;
        hf *= dec; hb *= dec; sf += fabsf(hf); sb += fabsf(hb);
        lds[t] = hf; if (t > 0) lds[32768 - t] = hb; else xs[160] = hb; }
    sf = wave_sum(sf); sb = wave_sum(sb);
    if ((tid & 63) == 0) { xs[128 + (tid >> 6)] = sf; xs[136 + (tid >> 6)] = sb; }
    __syncthreads();
    float tf = 0.f, tb = 0.f;
#pragma unroll
    for (int w = 0; w < 8; ++w) { tf += xs[128 + w]; tb += xs[136 + w]; }
    const float inf_ = 1.0f / tf, inb_ = 1.0f / tb;
    for (int i = 0; i < 64; ++i) { const int m = tid + 512 * i; float v = lds[m];
        if (m == 0) v = v * inf_ + xs[160] * inb_ + a.in[I_HYSKIP][l * 1024 + c];
        else if (m < SEQ) v *= inf_; else if (m == SEQ) v = 0.f; else v *= inb_;
        lds[m] = v; }
    __syncthreads();
    for (int s = FFT_M / 4; s >= 1; s >>= 2) { fft_fwd_pass(lds, tw, s, tid); __syncthreads(); }
    float* Gs = (float*)(a.ws + WS_YMIX) + (size_t)obid() * 32768;
#pragma unroll 1
    for (int j = 0; j < 16; ++j) { const int k = tid + 512 * j; cpx gk, gm; rfft_untangle(lds, tw2, k, gk, gm); f32x4 g4; g4[0] = gk.x; g4[1] = gk.y; g4[2] = gm.x; g4[3] = gm.y; *(f32x4*)(Gs + (size_t)k * 4) = g4; }
    __syncthreads();
    for (int i = 0; i < 16; ++i) { const int m4 = tid + 512 * i; f32x4 v = {0.f, 0.f, 0.f, 0.f}; if (m4 < SEQ / 4) v = *(const f32x4*)(VX + m4 * 4); *(LAS f32x4*)(lds + m4 * 4) = v; }
    __syncthreads();
    for (int s = FFT_M / 4; s >= 1; s >>= 2) { fft_fwd_pass(lds, tw, s, tid); __syncthreads(); }
#pragma unroll 1
    for (int j = 0; j < 16; ++j) { const int k = tid + 512 * j; const f32x4 g4 = *(const f32x4*)(Gs + (size_t)k * 4); cpx gk, gm; gk.x = g4[0]; gk.y = g4[1]; gm.x = g4[2]; gm.y = g4[3]; rfft_mul_retangle(lds, tw2, k, gk, gm); }
    __syncthreads();
    for (int s = 1; s <= FFT_M / 4; s <<= 2) { fft_inv_pass(lds, tw, s, tid); __syncthreads(); }
    for (int i = 0; i < 8; ++i) { const int m4 = tid + 512 * i; f32x4 v = *(const LAS f32x4*)(lds + m4 * 4); *(f32x4*)(VX + m4 * 4) = v * (1.0f / FFT_M); }
    __syncthreads();
}
DI void hycctx_item(const Args& a, int l, int it, LAS unsigned char* ldsb) {
    const int tid = otid(), c0 = it * 16;
    LAS float* sv = (LAS float*)ldsb;
    LAS float* sf = sv + 16 * 256;
    LAS float* sb = sf + 16 * 256;
    const float* hyc = (const float*)(a.ws + WS_HYC); float* VXT = (float*)(a.ws + WS_U);
    for (int i = tid; i < 16 * 256; i += NTHR) { const int ch = i >> 8, t = i & 255; sv[i] = VXT[(size_t)(c0 + ch) * MT + SEQ + t]; sf[i] = hyc[(size_t)(c0 + ch) * 256 + t]; sb[i] = hyc[(size_t)(1024 + c0 + ch) * 256 + t]; }
    __syncthreads();
    const int ch = tid >> 5, tq = tid & 31; const float g0 = sf[ch * 256] + sb[ch * 256] + a.in[I_HYSKIP][l * 1024 + c0 + ch];
    float acc[8];
#pragma unroll
    for (int i = 0; i < 8; ++i) acc[i] = 0.f;
    for (int s = 0; s < 256; ++s) { const float vv = sv[ch * 256 + s];
#pragma unroll
        for (int i = 0; i < 8; ++i) { const int d = tq * 8 + i - s; const float g = d > 0 ? sf[ch * 256 + d] : (d < 0 ? sb[ch * 256 - d] : g0); acc[i] += g * vv; } }
    __syncthreads();
#pragma unroll
    for (int i = 0; i < 8; ++i) VXT[(size_t)(c0 + ch) * MT + SEQ + tq * 8 + i] = acc[i];
    __syncthreads();
}

struct EpiZ {
    static constexpr bool PERM = true, AFTER_DRAIN = false; bf16* O; const float* bias;
    DI void operator()(const f32x4 (&acc)[2][2][4][2], const pg8::Unit& u, int wr, int wc, int fr, int fq) const {
        const int row0 = u.pm * 256 + wr * 64 + fr, col0 = u.pn * 256 + wc * 32 + 8 * fq;
        f32x4 bv[2][2];
#pragma unroll
        for (int bj = 0; bj < 2; ++bj)
#pragma unroll
            for (int n = 0; n < 2; ++n) bv[bj][n] = *(const f32x4*)(bias + col0 + bj * 128 + 4 * n);
#pragma unroll
        for (int ai = 0; ai < 2; ++ai)
#pragma unroll
            for (int m = 0; m < 4; ++m) { bf16* rowp = O + (size_t)(row0 + ai * 128 + m * 16) * ZC + col0;
#pragma unroll
                for (int bj = 0; bj < 2; ++bj) { const f32x4 v0 = acc[ai][bj][m][0] + bv[bj][0], v1 = acc[ai][bj][m][1] + bv[bj][1];
                    u32x4 w; w.x = pk_bf16(v0[0], v0[1]); w.y = pk_bf16(v0[2], v0[3]); w.z = pk_bf16(v1[0], v1[1]); w.w = pk_bf16(v1[2], v1[3]);
                    *(u32x4*)(rowp + bj * 128) = w; } }
    }
};
template <int BR> struct EpiBr {
    static constexpr bool PERM = true, AFTER_DRAIN = false; bf16* Mg; const bf16* Zg;
    DI void operator()(const f32x4 (&acc)[2][2][4][2], const pg8::Unit& u, int wr, int wc, int fr, int fq) const {
        const int row0 = u.pm * 256 + wr * 64 + fr, col0 = u.pn * 256 + wc * 32 + 8 * fq;
#pragma unroll
        for (int ai = 0; ai < 2; ++ai)
#pragma unroll
            for (int m = 0; m < 4; ++m) { const size_t row = (size_t)(row0 + ai * 128 + m * 16);
#pragma unroll
                for (int bj = 0; bj < 2; ++bj) { const int col = col0 + bj * 128;
                    const u32x4 g = *(const u32x4*)(Zg + row * ZC + col);
                    f32x4 v0 = acc[ai][bj][m][0], v1 = acc[ai][bj][m][1];
                    v0[0] *= sigmoidf_(bflo(g.x)); v0[1] *= sigmoidf_(bfhi(g.x)); v0[2] *= sigmoidf_(bflo(g.y)); v0[3] *= sigmoidf_(bfhi(g.y));
                    v1[0] *= sigmoidf_(bflo(g.z)); v1[1] *= sigmoidf_(bfhi(g.z)); v1[2] *= sigmoidf_(bflo(g.w)); v1[3] *= sigmoidf_(bfhi(g.w));
                    if (BR > 0) { const u32x4 p = *(const u32x4*)(Mg + row * D + col);
                        v0[0] += bflo(p.x); v0[1] += bfhi(p.x); v0[2] += bflo(p.y); v0[3] += bfhi(p.y); v1[0] += bflo(p.z); v1[1] += bfhi(p.z); v1[2] += bflo(p.w); v1[3] += bfhi(p.w); }
                    u32x4 w; w.x = pk_bf16(v0[0], v0[1]); w.y = pk_bf16(v0[2], v0[3]); w.z = pk_bf16(v1[0], v1[1]); w.w = pk_bf16(v1[2], v1[3]);
                    *(u32x4*)(Mg + row * D + col) = w; } }
    }
};
struct EpiOut {
    static constexpr bool PERM = false, AFTER_DRAIN = false; const float* hin_main; const float* hin_ctx; float* hout; const float* gt1;
    DI void operator()(const f32x4 (&acc)[2][2][4][2], const pg8::Unit& u, int wr, int wc, int fr, int fq) const {
        const int row0 = u.pm * 256 + wr * 64 + fr, col0 = u.pn * 256 + wc * 32 + 4 * fq; const bool isctx = u.pm >= SEQ / 256;
        const float* g = gt1 + (isctx ? 12288 : 0);
        f32x4 gv[2][2];
#pragma unroll
        for (int bj = 0; bj < 2; ++bj)
#pragma unroll
            for (int n = 0; n < 2; ++n) gv[bj][n] = *(const f32x4*)(g + col0 + bj * 128 + n * 16);
#pragma unroll
        for (int ai = 0; ai < 2; ++ai)
#pragma unroll
            for (int m = 0; m < 4; ++m) { const int row = row0 + ai * 128 + m * 16;
                const float* ip = (isctx ? hin_ctx + (size_t)(row - SEQ) * D : hin_main + (size_t)row * D) + col0; float* op = hout + (size_t)row * D + col0;
#pragma unroll
                for (int bj = 0; bj < 2; ++bj)
#pragma unroll
                    for (int n = 0; n < 2; ++n) { const f32x4 b = *(const f32x4*)(ip + bj * 128 + n * 16); *(f32x4*)(op + bj * 128 + n * 16) = b + gv[bj][n] * acc[ai][bj][m][n]; } }
    }
};
struct EpiGU {
    static constexpr bool PERM = true, AFTER_DRAIN = false; bf16* Hm;
    DI void operator()(const f32x4 (&acc)[2][2][4][2], const pg8::Unit& u, int wr, int wc, int fr, int fq) const {
        const int row0 = u.pm * 256 + wr * 64 + fr, col0 = (u.pn & 3) * 128 + wc * 32 + 8 * fq;
#pragma unroll
        for (int ai = 0; ai < 2; ++ai)
#pragma unroll
            for (int m = 0; m < 4; ++m) { const f32x4 g0 = acc[ai][0][m][0], g1 = acc[ai][0][m][1], u0 = acc[ai][1][m][0], u1 = acc[ai][1][m][1];
                u32x4 w; w.x = pk_bf16(siluf_(g0[0]) * u0[0], siluf_(g0[1]) * u0[1]); w.y = pk_bf16(siluf_(g0[2]) * u0[2], siluf_(g0[3]) * u0[3]);
                w.z = pk_bf16(siluf_(g1[0]) * u1[0], siluf_(g1[1]) * u1[1]); w.w = pk_bf16(siluf_(g1[2]) * u1[2], siluf_(g1[3]) * u1[3]);
                *(u32x4*)(Hm + (size_t)(row0 + ai * 128 + m * 16) * DFF + col0) = w; }
    }
};
struct EpiDn {
    static constexpr bool PERM = true, AFTER_DRAIN = false; bf16* Y; const float* roww;
    DI void operator()(const f32x4 (&acc)[2][2][4][2], const pg8::Unit& u, int wr, int wc, int fr, int fq) const {
        const int row0 = u.pm * 256 + wr * 64 + fr, col0 = (u.pn & 7) * 256 + wc * 32 + 8 * fq;
#pragma unroll
        for (int ai = 0; ai < 2; ++ai)
#pragma unroll
            for (int m = 0; m < 4; ++m) { const int row = row0 + ai * 128 + m * 16; const float rw = roww[row];
#pragma unroll
                for (int bj = 0; bj < 2; ++bj) { const f32x4 v0 = acc[ai][bj][m][0] * rw, v1 = acc[ai][bj][m][1] * rw;
                    u32x4 w; w.x = pk_bf16(v0[0], v0[1]); w.y = pk_bf16(v0[2], v0[3]); w.z = pk_bf16(v1[0], v1[1]); w.w = pk_bf16(v1[2], v1[3]);
                    *(u32x4*)(Y + (size_t)row * D + col0 + bj * 128) = w; } }
    }
};
struct MoeOrder {
    const int* tile_e; int ntiles, nsub, G, c;
    DI bool next(int i, pg8::Unit& u) const { const int j = i * G + c; if (j >= ntiles * nsub) return false; const int ti = j / nsub; u.pm = ti; u.pn = tile_e[ti] * nsub + (j - ti * nsub); return true; }
    DI void a_ready(const pg8::Unit&) const {}
    DI void done(const pg8::Unit&) const {}
};
constexpr int NPH_LAYER = 11, PH_FINAL = 1 + NPH_LAYER * DEPTH, NPHASES = PH_FINAL + 1;
struct KArgs { Args a; int li, pad; };
__global__ void __launch_bounds__(NTHR, 2) fwd_kernel(KArgs ka) {
    extern __shared__ __attribute__((aligned(16))) unsigned char lds_raw[];
    LAS unsigned char* lds = (LAS unsigned char*)lds_raw;
    LAS float* ldsf = (LAS float*)lds_raw;
    const Args& a = ka.a;
    const int tid = otid(), bid = obid(), G = gridDim.x;
    if (tid == 0) { ((LAS unsigned*)(lds + LDS_BARW))[0] = 0u; ((LAS unsigned*)(lds + LDS_BARW))[1] = 0u; }
    __syncthreads();
    XcdBarrier bar = xcd_barrier_post((unsigned*)(a.ws + WS_CTL) + CW_BAR + ka.li * XCD_BAR_WORDS, (volatile LAS unsigned*)(lds + LDS_BARW));
    const int lo = a.ph_lo, hi = a.ph_hi;
#ifndef PHMASK
#define PHMASK 0xFFFF
#endif
#define EN(i) (((PHMASK) >> (i)) & 1)
#define IN(k) (lo <= (k) && (k) < hi)
#define SEAM(k) do { if (IN(k) && IN((k) + 1)) xcd_barrier(bar); } while (0)
    unsigned char* ws = a.ws;
    bf16* U = (bf16*)(ws + WS_U); bf16* Z = (bf16*)(ws + WS_Z); float* H = (float*)(ws + WS_H);
    const float* modall = (const float*)(ws + WS_MOD);

    if (EN(0) && IN(0)) {
        prologue_small(a);
        for (int it = bid; it < 256; it += G) mod_item(a, it, ldsf);
        for (int it = bid; it < DEPTH * (MT / 8); it += G) h2_item(a, it, ldsf);
    }
    SEAM(0);
    for (int l = 0; l < DEPTH; ++l) {
        const int pb = 1 + NPH_LAYER * l;
        const int nrows = (l == 0) ? MT : SEQ;
        if (EN(1) && IN(pb + 0)) {
            norm_phase<0>(a, l, MT, ldsf);
            if (l == 0) hyc_filters(a, 0);
            for (int it = bid; it < CVT_MIX_TILES; it += G) cvt_mix_item(a, l, it, ldsf);
        }
        SEAM(pb + 0);
        if (EN(2) && IN(pb + 1)) {
            pg8::Gemm g{U, (const bf16*)(ws + WS_WIN), MT, ZC, D}; pg8::StaticOrder S; S.init(MT, ZC, G, bid);
            EpiZ E{Z, (const float*)(ws + WS_ZBIAS) + (size_t)l * ZC};
            pg8::gemm_phase<EpiZ, pg8::StaticOrder, true, true>(lds, g, S, E);
        }
        SEAM(pb + 1);
        if (EN(3) && IN(pb + 2)) { const int nit = (nrows / 64) * 16; for (int it = bid; it < nit; it += G) hyprep_item(a, l, it, ldsf); }
        SEAM(pb + 2);
        if (EN(4) && IN(pb + 3)) {
            for (int it = bid; it < 256; it += G) scan_item(a, l, it, lds);
            for (int c = bid; c < 1024; c += G) hyconv_item(a, l, c, lds);
            if (l == 0) for (int it = bid; it < 64; it += G) hycctx_item(a, l, it, lds);
        }
        SEAM(pb + 3);
        if (EN(5) && IN(pb + 4)) {
            scancomb_rows(a, l, nrows);
            const int nit = (nrows / 64) * 16; for (int it = bid; it < nit; it += G) hycomb_item(a, l, it, ldsf);
        }
        SEAM(pb + 4);
        if (EN(6) && IN(pb + 5)) {
            const bf16* Y = (const bf16*)(ws + WS_YMIX); const bf16* WB = (const bf16*)(ws + WS_WBR);
            pg8::StaticOrder S; S.init(nrows, D, G, bid);
            { pg8::Gemm g{Y, WB, nrows, D, 1024}; EpiBr<0> E{U, Z + Z_MG}; pg8::gemm_phase<EpiBr<0>, pg8::StaticOrder, true, true>(lds, g, S, E); }
            __syncthreads();
            { pg8::Gemm g{Y + (size_t)MT * 1024, WB + (size_t)D * 1024, nrows, D, 1024}; EpiBr<1> E{U, Z + Z_MG + D}; pg8::gemm_phase<EpiBr<1>, pg8::StaticOrder, true, true>(lds, g, S, E); }
            __syncthreads();
            { pg8::Gemm g{Y + (size_t)2 * MT * 1024, WB + (size_t)2 * D * 1024, nrows, D, 1024}; EpiBr<2> E{U, Z + Z_MG + 2 * D}; pg8::gemm_phase<EpiBr<2>, pg8::StaticOrder, true, true>(lds, g, S, E); }
        }
        SEAM(pb + 5);
        if (EN(7) && IN(pb + 6)) {
            pg8::Gemm g{U, (const bf16*)(ws + WS_WOUT), nrows, D, D}; pg8::StaticOrder S; S.init(nrows, D, G, bid);
            EpiOut E{l == 0 ? a.in[I_X] : H, l == 0 ? a.in[I_CTX] : H + (size_t)SEQ * D, H, modall + (size_t)l * 2 * 12288 + 4096};
            pg8::gemm_phase<EpiOut, pg8::StaticOrder, true, true>(lds, g, S, E);
        }
        SEAM(pb + 6);
        if (EN(8) && IN(pb + 7)) {
            norm_phase<1>(a, l, nrows, ldsf);
            __syncthreads();
            for (int it = bid; it < CVT_MOE_TILES; it += G) cvt_moe_item(a, l, it, ldsf);
        }
        SEAM(pb + 7);
        if (EN(9) && IN(pb + 8)) permute_phase(a, l, nrows, lds);
        SEAM(pb + 8);
        if (EN(10) && IN(pb + 9)) {
            const int* tile_e = (const int*)(ws + WS_TILEE); const int ntiles = tile_e[200];
            pg8::Gemm g{(const bf16*)(ws + WS_XP), (const bf16*)(ws + WS_WGU), MOE_MAXROWS, NEXP * 1024, D}; MoeOrder S{tile_e, ntiles, 4, G, bid};
            EpiGU E{(bf16*)(ws + WS_HMID)};
            pg8::gemm_phase<EpiGU, MoeOrder, true, true>(lds, g, S, E);
        }
        SEAM(pb + 9);
        if (EN(11) && IN(pb + 10)) {
            const int* tile_e = (const int*)(ws + WS_TILEE); const int ntiles = tile_e[200];
            pg8::Gemm g{(const bf16*)(ws + WS_HMID), (const bf16*)(ws + WS_WD), MOE_MAXROWS, NEXP * D, DFF}; MoeOrder S{tile_e, ntiles, 8, G, bid};
            EpiDn E{(bf16*)(ws + WS_YP), (const float*)(ws + WS_ROWW)};
            pg8::gemm_phase<EpiDn, MoeOrder, true, true>(lds, g, S, E);
        }
        SEAM(pb + 10);
    }
    if (EN(12) && IN(PH_FINAL)) norm_phase<2>(a, DEPTH, SEQ, ldsf);
#undef IN
#undef SEAM
}

#ifndef MK_SINGLE
#define MK_SINGLE 0
#endif
extern "C" void kernel_launch(void* const* d_in, const int* in_sizes, int n_in, void* d_out, int out_size, void* d_ws, size_t ws_size, hipStream_t stream) {
    static int grid = 0;
    if (grid == 0) {
        if (n_in != N_IN || out_size != SEQ * D || ws_size < WS_END) { fprintf(stderr, "kernel_launch: unexpected problem shape (n_in %d, out %d, ws %zu < %zu)\n", n_in, out_size, ws_size, (size_t)WS_END); grid = -1; return; }
        int dev = 0, cus = 0;
        if (hipGetDevice(&dev) != hipSuccess || hipDeviceGetAttribute(&cus, hipDeviceAttributeMultiprocessorCount, dev) != hipSuccess) { grid = -1; return; }
        if (hipFuncSetAttribute((const void*)fwd_kernel, hipFuncAttributeMaxDynamicSharedMemorySize, LDS_BYTES) != hipSuccess) { fprintf(stderr, "kernel_launch: hipFuncSetAttribute failed\n"); grid = -1; return; }
        int per_cu = 0;
        if (hipOccupancyMaxActiveBlocksPerMultiprocessor(&per_cu, (const void*)fwd_kernel, NTHR, LDS_BYTES) != hipSuccess || per_cu < 1) fprintf(stderr, "kernel_launch: occupancy query says %d\n", per_cu);
        (void)hipGetLastError();
        grid = cus;
    }
    if (grid < 0) return;
    (void)hipMemsetAsync((char*)d_ws + WS_CTL, 0, CTL_BYTES, stream);
    KArgs ka{};
    for (int i = 0; i < N_IN; ++i) ka.a.in[i] = (const float*)d_in[i];
    ka.a.out = (float*)d_out; ka.a.ws = (unsigned char*)d_ws;
#if MK_SINGLE
    ka.a.ph_lo = 0; ka.a.ph_hi = NPHASES; ka.li = 0; ka.pad = 0;
    hipLaunchKernelGGL(fwd_kernel, dim3(grid), dim3(NTHR), LDS_BYTES, stream, ka);
#else
    for (int ph = 0; ph < NPHASES; ++ph) { ka.a.ph_lo = ph; ka.a.ph_hi = ph + 1; ka.li = 0; ka.pad = 0; hipLaunchKernelGGL(fwd_kernel, dim3(grid), dim3(NTHR), LDS_BYTES, stream, ka); }
#endif
}
```

```cpp
#include <hip/hip_runtime.h>
#include <cstdio>
#include <cstdint>
#define DI __device__ __forceinline__
#define LAS __attribute__((address_space(3)))
typedef unsigned short bf16;
typedef float f32x4 __attribute__((ext_vector_type(4)));
typedef unsigned u32x4 __attribute__((ext_vector_type(4)));
typedef unsigned u32x2 __attribute__((ext_vector_type(2)));

constexpr int D = 2048, SEQ = 16384, CTXL = 256, MT = SEQ + CTXL  , DEPTH = 2;
constexpr int NCOLS_IN = 17440;
constexpr int ZC = 17664;
constexpr int Z_HG = 0, Z_GL = 5120, Z_HY = 8192, Z_MG = 11264, Z_LR = 17408;
constexpr int NEXP = 32, DFF = 512, MOE_MAXROWS = 41472;
constexpr float NORM_EPS = 1e-6f;

constexpr size_t MiB = 1u << 20;
constexpr size_t WS_CTL = 0, CTL_BYTES = 1 * MiB;
constexpr size_t WS_SMALL = 1 * MiB;
constexpr size_t WS_MOD   = WS_SMALL;
constexpr size_t WS_ZBIAS = WS_MOD + (size_t)DEPTH * 2 * 12288 * 4;
constexpr size_t WS_LB    = WS_ZBIAS + (size_t)DEPTH * ZC * 4;
constexpr size_t WS_TW    = WS_LB + (size_t)DEPTH * 2 * 1024 * 4;
constexpr size_t WS_TW2   = WS_TW + 16384 * 8;
constexpr size_t WS_H2    = WS_TW2 + (8192 + 64) * 8;
constexpr size_t WS_ROUTE = WS_H2 + (size_t)DEPTH * MT * 64 * 4;
constexpr size_t WS_ROWW  = WS_ROUTE + (size_t)MT * 8 * 4;
constexpr size_t WS_TILEE = WS_ROWW + (size_t)MOE_MAXROWS * 4;
constexpr size_t WS_HYC   = WS_TILEE + 1024;
constexpr size_t WS_SMALL_END = WS_HYC + (size_t)2048 * 256 * 4;
static_assert(WS_SMALL_END <= 40 * MiB, "small tables");
constexpr size_t WS_WIN  = 40 * MiB;
constexpr size_t WS_WBR  = 109 * MiB;
constexpr size_t WS_WOUT = 121 * MiB;
constexpr size_t WS_WGU  = 129 * MiB;
constexpr size_t WS_WD   = 257 * MiB;
constexpr size_t WS_H    = 321 * MiB;
constexpr size_t WS_U    = 451 * MiB;
constexpr size_t WS_Z    = 516 * MiB;
constexpr size_t WS_XP   = WS_Z;
constexpr size_t WS_HMID = WS_Z + 162 * MiB;
constexpr size_t WS_YP   = WS_Z + 203 * MiB;
constexpr size_t WS_YMIX = 1077 * MiB;
constexpr size_t WS_OSC  = 1175 * MiB;
constexpr size_t WS_END  = 1435 * MiB;
static_assert(WS_WIN + (size_t)ZC * D * 2 <= WS_WBR && WS_Z + (size_t)MT * ZC * 2 <= WS_YMIX && WS_YMIX + (size_t)3 * MT * 1024 * 2 <= WS_OSC && WS_OSC + (size_t)4 * MT * 1024 * 4 <= WS_END, "ws map");
static_assert(WS_YP + (size_t)MOE_MAXROWS * D * 2 <= WS_YMIX && WS_H + (size_t)MT * D * 4 <= WS_U && WS_U + (size_t)MT * D * 2 <= WS_Z, "ws map 2");
constexpr int CW_BAR = 4096;
constexpr int CW_CNT = 16384;

DI float bf2f(bf16 v) { return __uint_as_float(((unsigned)v) << 16); }
DI float bflo(unsigned w) { return __uint_as_float(w << 16); }
DI float bfhi(unsigned w) { return __uint_as_float(w & 0xffff0000u); }
DI unsigned pk_bf16(float lo, float hi) { unsigned r; asm volatile("v_cvt_pk_bf16_f32 %0, %1, %2" : "=v"(r) : "v"(lo), "v"(hi)); return r; }
DI bf16 f2bf(float f) { return (bf16)(pk_bf16(f, 0.f) & 0xffffu); }
DI float sigmoidf_(float x) { return 1.0f / (1.0f + __expf(-x)); }
DI float siluf_(float x) { return x / (1.0f + __expf(-x)); }
DI float wave_sum(float v) {
#pragma unroll
    for (int o = 32; o >= 1; o >>= 1) v += __shfl_xor(v, o);
    return v;
}
DI int otid() { int t = __builtin_amdgcn_workitem_id_x(); asm volatile("" : "+v"(t)); return t; }
DI int obid() { int b = __builtin_amdgcn_workgroup_id_x(); asm volatile("" : "+s"(b)); return b; }
namespace pg8 {
#define PG8_LAS __attribute__((address_space(3)))
typedef unsigned short bf16_t;
typedef short bf16x8 __attribute__((ext_vector_type(8)));
typedef float f32x4 __attribute__((ext_vector_type(4)));
typedef unsigned u32x4 __attribute__((ext_vector_type(4)));
constexpr int BM = 256, BK = 64, HALF = 128, HTB = HALF * BK * 2  , STAGE_BYTES = 8 * HTB, NXCD = 8, WGM = 8;

__host__ __device__ __forceinline__ int lds_byte(int r, int c) { const int st = (r >> 4) * 2 + (c >> 5), rr = r & 15, cc = c & 31, ob = rr * 64 + cc * 2; return st * 1024 + (ob ^ (((ob >> 9) & 1) << 5)); }
__host__ __device__ __forceinline__ void stage_rc(int b, int& R, int& C) { const int st = b / 1024, sb = b % 1024, swz = sb ^ (((sb >> 9) & 1) << 5); R = (st >> 1) * 16 + swz / 64; C = (st & 1) * 32 + (swz % 64) / 2; }
__host__ __device__ __forceinline__ int perm32(int rho) { const int n = rho >> 4, i = rho & 15; return 8 * (i >> 2) + 4 * n + (i & 3); }

struct Unit { int pm, pn; };
struct Gemm { const bf16_t* A; const bf16_t* Bt; int M, N, K; };

struct StaticOrder {
    int nM, nN, nwg, G, c;
    __host__ __device__ void init(int M, int N, int G_, int c_) { nM = M / BM; nN = N / BM; nwg = nM * nN; G = G_; c = c_; }
    __host__ __device__ bool next(int i, Unit& u) const {
        const long L = (long)i * G + c; if (L >= nwg) return false;
        int wgid = (int)L; { const int q = nwg / NXCD, r = nwg % NXCD, xcd = wgid % NXCD, off = wgid / NXCD; wgid = (xcd < r ? xcd * (q + 1) : r * (q + 1) + (xcd - r) * q) + off; }
        const int nig = WGM * nN, gid = wgid / nig, fm = gid * WGM, gsz = (nM - fm) < WGM ? (nM - fm) : WGM;
        u.pm = fm + ((wgid % nig) % gsz); u.pn = (wgid % nig) / gsz; return true;
    }
    __device__ __forceinline__ void a_ready(const Unit&) const {}
    __device__ __forceinline__ void done(const Unit&) const {}
};

template <class Epi, class Sched, bool ALIGN_EPI = false, bool SP2 = false>
__device__ __forceinline__ void gemm_phase(PG8_LAS unsigned char* lds, const Gemm g, const Sched& S, const Epi& E) {
    const int tid = otid(), wid = __builtin_amdgcn_readfirstlane(tid >> 6), lane = tid & 63, wr = wid >> 2, wc = wid & 3, fr = lane & 15, fq = lane >> 4;
    const int K = g.K, nt = K / BK;
    unsigned voffA[2], voffB[2];
#pragma unroll
    for (int i = 0; i < 2; ++i) { int R, C; stage_rc(tid * 16 + i * 8192, R, C); const int Rb = Epi::PERM ? ((R & ~31) + perm32(R & 31)) : R;
        voffA[i] = (unsigned)(R * K + C) * 2u; voffB[i] = (unsigned)(Rb * K + C) * 2u; }
    const size_t kstep = (size_t)(BK * 2);
    const size_t hstep = (size_t)HALF * K * 2;
    const size_t tstep = 2 * hstep;
    const unsigned ldsw = (unsigned)wid * 1024u;
    const int aoff = lds_byte(wr * 64 + fr, fq * 8), boff = lds_byte(wc * 32 + fr, fq * 8);
#define PG8_SA(b, h) (((b) * 2 + (h)) * HTB)
#define PG8_SB(b, h) ((4 + (b) * 2 + (h)) * HTB)
#define PG8_STAGE(bufoff, gbase, voff) do { _Pragma("unroll") for (int _i = 0; _i < 2; ++_i) \
        __builtin_amdgcn_global_load_lds((const unsigned*)((const char*)(gbase) + (voff)[_i]), (PG8_LAS unsigned*)(lds + (bufoff) + ldsw + _i * 8192), 16, 0, 0); } while (0)
#define PG8_LDA(dst, b, h) do { _Pragma("unroll") for (int m = 0; m < 4; ++m) _Pragma("unroll") for (int k = 0; k < 2; ++k) dst[m][k] = *(const PG8_LAS bf16x8*)(lds + PG8_SA(b, h) + aoff + m * 2048 + k * 1024); } while (0)
#define PG8_LDB(dst, b, h) do { _Pragma("unroll") for (int n = 0; n < 2; ++n) _Pragma("unroll") for (int k = 0; k < 2; ++k) dst[n][k] = *(const PG8_LAS bf16x8*)(lds + PG8_SB(b, h) + boff + n * 2048 + k * 1024); } while (0)
#define PG8_MMA(ai, bj, At, Bt) do { __builtin_amdgcn_s_setprio(1); _Pragma("unroll") for (int m = 0; m < 4; ++m) _Pragma("unroll") for (int n = 0; n < 2; ++n) _Pragma("unroll") for (int k = 0; k < 2; ++k) \
        acc[ai][bj][m][n] = __builtin_amdgcn_mfma_f32_16x16x32_bf16(Bt[n][k], At[m][k], acc[ai][bj][m][n], 0, 0, 0); __builtin_amdgcn_s_setprio(0); } while (0)
#define PG8_WAIT_V(n) asm volatile("s_waitcnt vmcnt(" #n ")" ::: "memory")
#define PG8_WAIT_L(n) asm volatile("s_waitcnt lgkmcnt(" #n ")" ::: "memory")
#define PG8_BAR __builtin_amdgcn_s_barrier()
#define PG8_SCHED __builtin_amdgcn_sched_barrier(0)
    Unit cur, nxt; int ui = 0;
    if (!S.next(0, cur)) return;
    f32x4 acc[2][2][4][2];
#pragma unroll
    for (int a = 0; a < 2; ++a)
#pragma unroll
        for (int b = 0; b < 2; ++b)
#pragma unroll
            for (int m = 0; m < 4; ++m)
#pragma unroll
                for (int n = 0; n < 2; ++n) acc[a][b][m][n] = (f32x4){0.f, 0.f, 0.f, 0.f};
    bf16x8 At[4][2], B0[2][2], B1[2][2];
    const char* cA = (const char*)g.A + (size_t)cur.pm * tstep; const char* cB = (const char*)g.Bt + (size_t)cur.pn * tstep;
    S.a_ready(cur);
    if constexpr (SP2) {
        PG8_STAGE(PG8_SB(0, 0), cB, voffB); PG8_STAGE(PG8_SB(0, 1), cB + hstep, voffB); PG8_STAGE(PG8_SA(0, 0), cA, voffA); PG8_STAGE(PG8_SA(0, 1), cA + hstep, voffA);
        if (wr == 1) PG8_BAR;
        PG8_WAIT_V(2); PG8_BAR;
        PG8_STAGE(PG8_SB(1, 0), cB + kstep, voffB); PG8_STAGE(PG8_SA(1, 0), cA + kstep, voffA); PG8_STAGE(PG8_SB(1, 1), cB + hstep + kstep, voffB);
        PG8_WAIT_V(6); PG8_BAR;
    } else {
        PG8_STAGE(PG8_SB(0, 0), cB, voffB); PG8_STAGE(PG8_SA(0, 0), cA, voffA); PG8_STAGE(PG8_SB(0, 1), cB + hstep, voffB); PG8_STAGE(PG8_SA(0, 1), cA + hstep, voffA);
        if (wr == 1) PG8_BAR;
        PG8_WAIT_V(4); PG8_BAR;
        PG8_STAGE(PG8_SB(1, 0), cB + kstep, voffB); PG8_STAGE(PG8_SA(1, 0), cA + kstep, voffA); PG8_STAGE(PG8_SB(1, 1), cB + hstep + kstep, voffB);
        PG8_WAIT_V(6); PG8_BAR;
    }
    for (;;) {
        const bool has_next = S.next(ui + 1, nxt);
        const char* nA = has_next ? (const char*)g.A + (size_t)nxt.pm * tstep : cA; const char* nB = has_next ? (const char*)g.Bt + (size_t)nxt.pn * tstep : cB;
        for (int t = 0; t < nt; t += 2) {
            const bool last = (t == nt - 2);
            const char* a1 = cA + (size_t)(t + 1) * kstep;
            const char* a2 = last ? nA : cA + (size_t)(t + 2) * kstep; const char* b2 = last ? nB : cB + (size_t)(t + 2) * kstep;
            const char* a3 = a2 + kstep; const char* b3 = b2 + kstep;
            if (last && has_next) S.a_ready(nxt);
            if constexpr (SP2) {
            PG8_LDB(B0, 0, 0); PG8_LDB(B1, 0, 1); PG8_SCHED; PG8_LDA(At, 0, 0); PG8_STAGE(PG8_SA(1, 1), a1 + hstep, voffA);
            PG8_WAIT_V(8); PG8_WAIT_L(0); PG8_BAR; PG8_MMA(0, 0, At, B0); PG8_MMA(0, 1, At, B1); PG8_BAR; PG8_SCHED;
            PG8_LDA(At, 0, 1); PG8_STAGE(PG8_SB(0, 0), b2, voffB); PG8_STAGE(PG8_SB(0, 1), b2 + hstep, voffB); PG8_STAGE(PG8_SA(0, 0), a2, voffA);
            PG8_WAIT_V(8); PG8_WAIT_L(0); PG8_BAR; PG8_MMA(1, 0, At, B0); PG8_MMA(1, 1, At, B1); PG8_BAR; PG8_SCHED;
            PG8_LDB(B0, 1, 0); PG8_LDB(B1, 1, 1); PG8_SCHED; PG8_LDA(At, 1, 0); PG8_STAGE(PG8_SA(0, 1), a2 + hstep, voffA);
            PG8_WAIT_V(8); PG8_WAIT_L(0); PG8_BAR; PG8_MMA(0, 0, At, B0); PG8_MMA(0, 1, At, B1); PG8_BAR; PG8_SCHED;
            PG8_LDA(At, 1, 1); PG8_STAGE(PG8_SB(1, 0), b3, voffB); PG8_STAGE(PG8_SB(1, 1), b3 + hstep, voffB); PG8_STAGE(PG8_SA(1, 0), a3, voffA);
            PG8_WAIT_V(8); PG8_WAIT_L(0); PG8_BAR; PG8_MMA(1, 0, At, B0); PG8_MMA(1, 1, At, B1); PG8_BAR; PG8_SCHED;
            } else {
            PG8_LDB(B0, 0, 0); PG8_SCHED; PG8_LDA(At, 0, 0); PG8_STAGE(PG8_SA(1, 1), a1 + hstep, voffA);
            PG8_WAIT_L(8); PG8_BAR; PG8_WAIT_L(0); PG8_MMA(0, 0, At, B0); PG8_BAR; PG8_SCHED;
            PG8_LDB(B1, 0, 1); PG8_STAGE(PG8_SB(0, 0), b2, voffB);
            PG8_BAR; PG8_WAIT_L(0); PG8_MMA(0, 1, At, B1); PG8_BAR;
            PG8_LDA(At, 0, 1); PG8_STAGE(PG8_SA(0, 0), a2, voffA);
            PG8_BAR; PG8_WAIT_L(0); PG8_MMA(1, 0, At, B0); PG8_BAR; PG8_SCHED;
            PG8_STAGE(PG8_SB(0, 1), b2 + hstep, voffB);
            PG8_WAIT_V(6); PG8_BAR; PG8_MMA(1, 1, At, B1); PG8_BAR;
            PG8_LDB(B0, 1, 0); PG8_SCHED; PG8_LDA(At, 1, 0); PG8_STAGE(PG8_SA(0, 1), a2 + hstep, voffA);
            PG8_WAIT_L(8); PG8_BAR; PG8_WAIT_L(0); PG8_MMA(0, 0, At, B0); PG8_BAR; PG8_SCHED;
            PG8_LDB(B1, 1, 1); PG8_STAGE(PG8_SB(1, 0), b3, voffB);
            PG8_BAR; PG8_WAIT_L(0); PG8_MMA(0, 1, At, B1); PG8_BAR;
            PG8_LDA(At, 1, 1); PG8_STAGE(PG8_SA(1, 0), a3, voffA);
            PG8_BAR; PG8_WAIT_L(0); PG8_MMA(1, 0, At, B0); PG8_BAR; PG8_SCHED;
            PG8_STAGE(PG8_SB(1, 1), b3 + hstep, voffB);
            PG8_WAIT_V(6); PG8_BAR; PG8_MMA(1, 1, At, B1); PG8_BAR;
            }
        }
        if constexpr (ALIGN_EPI) { if (wr == 0) PG8_BAR; }
        if constexpr (!Epi::AFTER_DRAIN) { E(acc, cur, wr, wc, fr, fq); S.done(cur); }
        if (!has_next) break;
#pragma unroll
        for (int a = 0; a < 2; ++a)
#pragma unroll
            for (int b = 0; b < 2; ++b)
#pragma unroll
                for (int m = 0; m < 4; ++m)
#pragma unroll
                    for (int n = 0; n < 2; ++n) acc[a][b][m][n] = (f32x4){0.f, 0.f, 0.f, 0.f};
        cur = nxt; cA = nA; cB = nB; ++ui;
        if constexpr (ALIGN_EPI) { if (wr == 1) PG8_BAR; }
    }
    PG8_WAIT_V(0);
    if constexpr (!ALIGN_EPI) { if (wr == 0) PG8_BAR; }
    PG8_BAR;
    if constexpr (Epi::AFTER_DRAIN) { E.fused(acc, cur, wr, wc, fr, fq, lds, wid, lane); S.done(cur); }
#undef PG8_SA
#undef PG8_SB
#undef PG8_STAGE
#undef PG8_LDA
#undef PG8_LDB
#undef PG8_MMA
#undef PG8_WAIT_V
#undef PG8_WAIT_L
#undef PG8_BAR
#undef PG8_SCHED
}
}
#define XB_TMO      128
#define XB_XCNT(j)  (256  + 64 * (j))
#define XB_XSUB(j)  (1280 + 64 * (j))
#define XB_XGEN(j)  (2304 + 64 * (j))
#define XB_TOP      3328
#define XB_TOPGEN   3392
#define XCD_BAR_WORDS 3456
#define XB_SPIN_CAP (1u << 18)

__device__ __forceinline__ unsigned xb_ld(unsigned* p)              { return __hip_atomic_load(p, __ATOMIC_RELAXED, __HIP_MEMORY_SCOPE_AGENT); }
__device__ __forceinline__ unsigned xb_add(unsigned* p, unsigned v) { return __hip_atomic_fetch_add(p, v, __ATOMIC_RELAXED, __HIP_MEMORY_SCOPE_AGENT); }
__device__ __forceinline__ unsigned xb_xcc_id() { return (unsigned)__builtin_amdgcn_s_getreg((3 << 11) | 20) & 0xFu; }
#define XB_SPIN(cond, bar) do { unsigned _sp = 0; while (cond) { __builtin_amdgcn_s_sleep(1); \
    if ((++_sp & 255u) == 0u) { if (xb_ld(&(bar)[XB_TMO])) break; if (_sp > XB_SPIN_CAP) { atomicAdd(&(bar)[XB_TMO], 1u); break; } } } } while (0)

struct XcdBarrier {
    unsigned* bar; unsigned x;
    volatile LAS unsigned* st;
};

__device__ __forceinline__ XcdBarrier xcd_barrier_post(unsigned* bar, volatile LAS unsigned* st) {
    XcdBarrier b; b.bar = bar; b.x = xb_xcc_id(); b.st = st;
    if (otid() == 0) (void)xb_add(&bar[XB_XCNT(b.x)], 1u);
    return b;
}
__device__ __forceinline__ void xcd_barrier_complete(unsigned* bar, unsigned x, unsigned& nloc, unsigned& nx) {
    const unsigned G = gridDim.x * gridDim.y * gridDim.z;
    unsigned sum, cnt, mine, sp = 0u;
    for (;;) {
        sum = 0u; cnt = 0u; mine = 0u;
#pragma unroll
        for (unsigned j = 0; j < 16; ++j) { const unsigned c = xb_ld(&bar[XB_XCNT(j)]); sum += c; cnt += (c > 0u) ? 1u : 0u; mine = (j == x) ? c : mine; }
        if (sum == G) break;
        __builtin_amdgcn_s_sleep(1);
        if ((++sp & 255u) == 0u) { if (xb_ld(&bar[XB_TMO])) break; if (sp > XB_SPIN_CAP) { atomicAdd(&bar[XB_TMO], 1u); break; } }
    }
    nloc = mine > 0u ? mine : 1u; nx = cnt > 0u ? cnt : 1u;
}

__device__ __forceinline__ void xcd_barrier(const XcdBarrier& b) {
    asm volatile("s_waitcnt vmcnt(0)" ::: "memory");
    __syncthreads();
    if (otid() == 0) {
        unsigned* bar = b.bar;
        __builtin_amdgcn_s_waitcnt(0);
        unsigned nloc = b.st[0], nx = b.st[1];
        if (nloc == 0u) { xcd_barrier_complete(bar, b.x, nloc, nx); b.st[0] = nloc; b.st[1] = nx; }
        const unsigned old = xb_add(&bar[XB_XSUB(b.x)], 1u);
        const unsigned gen = old / nloc;
        if (old + 1u == (gen + 1u) * nloc) {
            __builtin_amdgcn_fence(__ATOMIC_RELEASE, "agent");
            asm volatile("s_waitcnt vmcnt(0)" ::: "memory");
            const unsigned og = xb_add(&bar[XB_TOP], 1u);
            const unsigned tg = og / nx;
            if (og + 1u == (tg + 1u) * nx) xb_add(&bar[XB_TOPGEN], 1u);
            else XB_SPIN(xb_ld(&bar[XB_TOPGEN]) == tg, bar);
            __builtin_amdgcn_fence(__ATOMIC_ACQUIRE, "agent");
            xb_add(&bar[XB_XGEN(b.x)], 1u);
            asm volatile("s_waitcnt vmcnt(0)" ::: "memory");
        } else {
            XB_SPIN(xb_ld(&bar[XB_XGEN(b.x)]) == gen, bar);
            __builtin_amdgcn_fence(__ATOMIC_ACQUIRE, "agent");
            asm volatile("s_waitcnt vmcnt(0)" ::: "memory");
        }
    }
    __syncthreads();
}

#define FFT_DI DI
#define FFT_M 16384
#define FFT_NT 512
struct cpx { float x, y; };
FFT_DI cpx cmul(cpx a, cpx b) { cpx r; r.x = a.x * b.x - a.y * b.y; r.y = a.x * b.y + a.y * b.x; return r; }
FFT_DI cpx cmulc(cpx a, cpx b) { cpx r; r.x = a.x * b.x + a.y * b.y; r.y = a.y * b.x - a.x * b.y; return r; }
FFT_DI int rev4_14(int k) {
    int r = 0;
#pragma unroll
    for (int d = 0; d < 7; ++d) { r = (r << 2) | (k & 3); k >>= 2; }
    return r;
}
template <class LP, class TP> FFT_DI void fft_fwd_pass(LP lds, TP tw, int s, int tid) {
    const int tws = FFT_M / (4 * s);
#pragma unroll 2
    for (int b = tid; b < FFT_M / 4; b += FFT_NT) {
        const int pos = b % s, base = (b / s) * 4 * s + pos;
        cpx a0, a1, a2, a3;
        a0.x = lds[2 * base]; a0.y = lds[2 * base + 1];
        a1.x = lds[2 * (base + s)]; a1.y = lds[2 * (base + s) + 1];
        a2.x = lds[2 * (base + 2 * s)]; a2.y = lds[2 * (base + 2 * s) + 1];
        a3.x = lds[2 * (base + 3 * s)]; a3.y = lds[2 * (base + 3 * s) + 1];
        cpx t0, t1, t2, t3;
        t0.x = a0.x + a2.x; t0.y = a0.y + a2.y;
        t1.x = a0.x - a2.x; t1.y = a0.y - a2.y;
        t2.x = a1.x + a3.x; t2.y = a1.y + a3.y;
        t3.x = a1.x - a3.x; t3.y = a1.y - a3.y;
        cpx y0, y1, y2, y3;
        y0.x = t0.x + t2.x; y0.y = t0.y + t2.y;
        y2.x = t0.x - t2.x; y2.y = t0.y - t2.y;
        y1.x = t1.x + t3.y; y1.y = t1.y - t3.x;
        y3.x = t1.x - t3.y; y3.y = t1.y + t3.x;
        if (s > 1) {
            cpx w1, w2, w3;
            w1.x = tw[2 * (pos * tws)]; w1.y = tw[2 * (pos * tws) + 1];
            w2.x = tw[2 * (2 * pos * tws)]; w2.y = tw[2 * (2 * pos * tws) + 1];
            w3.x = tw[2 * (3 * pos * tws)]; w3.y = tw[2 * (3 * pos * tws) + 1];
            y1 = cmul(y1, w1); y2 = cmul(y2, w2); y3 = cmul(y3, w3);
        }
        lds[2 * base] = y0.x; lds[2 * base + 1] = y0.y;
        lds[2 * (base + s)] = y1.x; lds[2 * (base + s) + 1] = y1.y;
        lds[2 * (base + 2 * s)] = y2.x; lds[2 * (base + 2 * s) + 1] = y2.y;
        lds[2 * (base + 3 * s)] = y3.x; lds[2 * (base + 3 * s) + 1] = y3.y;
    }
}
template <class LP, class TP> FFT_DI void fft_inv_pass(LP lds, TP tw, int s, int tid) {
    const int tws = FFT_M / (4 * s);
#pragma unroll 2
    for (int b = tid; b < FFT_M / 4; b += FFT_NT) {
        const int pos = b % s, base = (b / s) * 4 * s + pos;
        cpx b0, c1, c2, c3;
        b0.x = lds[2 * base]; b0.y = lds[2 * base + 1];
        c1.x = lds[2 * (base + s)]; c1.y = lds[2 * (base + s) + 1];
        c2.x = lds[2 * (base + 2 * s)]; c2.y = lds[2 * (base + 2 * s) + 1];
        c3.x = lds[2 * (base + 3 * s)]; c3.y = lds[2 * (base + 3 * s) + 1];
        if (s > 1) {
            cpx w1, w2, w3;
            w1.x = tw[2 * (pos * tws)]; w1.y = tw[2 * (pos * tws) + 1];
            w2.x = tw[2 * (2 * pos * tws)]; w2.y = tw[2 * (2 * pos * tws) + 1];
            w3.x = tw[2 * (3 * pos * tws)]; w3.y = tw[2 * (3 * pos * tws) + 1];
            c1 = cmulc(c1, w1); c2 = cmulc(c2, w2); c3 = cmulc(c3, w3);
        }
        cpx t0, t1, t2, t3;
        t0.x = b0.x + c2.x; t0.y = b0.y + c2.y;
        t1.x = b0.x - c2.x; t1.y = b0.y - c2.y;
        t2.x = c1.x + c3.x; t2.y = c1.y + c3.y;
        t3.x = c1.x - c3.x; t3.y = c1.y - c3.y;
        cpx x0, x1, x2, x3;
        x0.x = t0.x + t2.x; x0.y = t0.y + t2.y;
        x2.x = t0.x - t2.x; x2.y = t0.y - t2.y;
        x1.x = t1.x - t3.y; x1.y = t1.y + t3.x;
        x3.x = t1.x + t3.y; x3.y = t1.y - t3.x;
        lds[2 * base] = x0.x; lds[2 * base + 1] = x0.y;
        lds[2 * (base + s)] = x1.x; lds[2 * (base + s) + 1] = x1.y;
        lds[2 * (base + 2 * s)] = x2.x; lds[2 * (base + 2 * s) + 1] = x2.y;
        lds[2 * (base + 3 * s)] = x3.x; lds[2 * (base + 3 * s) + 1] = x3.y;
    }
}
template <class LP, class TP> FFT_DI void rfft_untangle(LP lds, TP tw2, int k, cpx& Xk, cpx& Xm) {
    if (k == 0) {
        const float zr = lds[0], zi = lds[1];
        Xk.x = zr + zi; Xk.y = zr - zi;
        const int p = rev4_14(FFT_M / 2);
        Xm.x = lds[2 * p]; Xm.y = -lds[2 * p + 1];
        return;
    }
    const int pk = rev4_14(k), pm = rev4_14(FFT_M - k);
    cpx Zk, Zm; Zk.x = lds[2 * pk]; Zk.y = lds[2 * pk + 1]; Zm.x = lds[2 * pm]; Zm.y = lds[2 * pm + 1];
    cpx E, O, W, WO;
    E.x = 0.5f * (Zk.x + Zm.x); E.y = 0.5f * (Zk.y - Zm.y);
    O.x = 0.5f * (Zk.y + Zm.y); O.y = -0.5f * (Zk.x - Zm.x);
    W.x = tw2[2 * k]; W.y = tw2[2 * k + 1];
    WO = cmul(W, O);
    Xk.x = E.x + WO.x; Xk.y = E.y + WO.y;
    Xm.x = E.x - WO.x; Xm.y = -(E.y - WO.y);
}
template <class LP, class TP> FFT_DI void rfft_mul_retangle(LP lds, TP tw2, int k, cpx Gk, cpx Gm) {
    cpx Xk, Xm; rfft_untangle(lds, tw2, k, Xk, Xm);
    if (k == 0) {
        const float y0 = Xk.x * Gk.x, yM = Xk.y * Gk.y;
        lds[0] = 0.5f * (y0 + yM); lds[1] = 0.5f * (y0 - yM);
        const cpx Y = cmul(Xm, Gm);
        const int p = rev4_14(FFT_M / 2);
        lds[2 * p] = Y.x; lds[2 * p + 1] = -Y.y;
        return;
    }
    const cpx Yk = cmul(Xk, Gk), Ym = cmul(Xm, Gm);
    cpx W; W.x = tw2[2 * k]; W.y = tw2[2 * k + 1];
    cpx A, D, T;
    A.x = 0.5f * (Yk.x + Ym.x); A.y = 0.5f * (Yk.y - Ym.y);
    D.x = 0.5f * (Yk.x - Ym.x); D.y = 0.5f * (Yk.y + Ym.y);
    T = cmulc(D, W);
    const int pk = rev4_14(k), pm = rev4_14(FFT_M - k);
    lds[2 * pk] = A.x - T.y; lds[2 * pk + 1] = A.y + T.x;
    cpx Dc; Dc.x = -D.x; Dc.y = D.y;
    const cpx T2 = cmul(W, Dc);
    lds[2 * pm] = A.x + T2.y; lds[2 * pm + 1] = -A.y - T2.x;
}
enum { I_X = 0, I_C, I_CTX, I_CCTX, I_WMOD, I_BMOD, I_NMIXW, I_NFFNW, I_WIN, I_BIN, I_HYCW, I_HYCB, I_HYW1, I_HYB1, I_HYW2, I_HYB2, I_HYW3, I_HYB3, I_HYFREQ, I_HYSKIP,
       I_HGLB, I_HGNW, I_GLWA2, I_GLBA, I_GLNW, I_WBR, I_WOUT, I_WRG, I_BRG, I_WRE, I_BRE, I_WGATE, I_WUP, I_WDOWN, I_FNW, N_IN };
struct Args { const float* in[N_IN]; float* out; unsigned char* ws; int ph_lo, ph_hi; };
constexpr int NTHR = 512;
constexpr int LDS_BYTES = 150 * 1024;
constexpr int LDS_X = 131072;
constexpr int LDS_BARW = LDS_BYTES - 64;

DI int z_srccol(int zc) { return zc < 8192 ? zc : (zc < Z_LR ? zc + 32 : (zc < Z_LR + 32 ? zc - Z_LR + 8192 : -1)); }

DI void cvt_tile(const float* __restrict__ src, size_t ld, int sc, bf16* __restrict__ dst, int K, int row0, int kb, LAS float* t) {
    const int tid = otid(), nn = tid & 63, kk = tid >> 6;
#pragma unroll
    for (int p = 0; p < 8; ++p) { const int k = kb * 64 + p * 8 + kk; t[(p * 8 + kk) * 65 + nn] = sc >= 0 ? src[(size_t)k * ld + sc] : 0.f; }
    __syncthreads();
    const int rr = tid >> 3, k8 = tid & 7; float v[8];
#pragma unroll
    for (int j = 0; j < 8; ++j) v[j] = t[(k8 * 8 + j) * 65 + rr];
    u32x4 w; w.x = pk_bf16(v[0], v[1]); w.y = pk_bf16(v[2], v[3]); w.z = pk_bf16(v[4], v[5]); w.w = pk_bf16(v[6], v[7]);
    *(u32x4*)(dst + (size_t)(row0 + rr) * K + kb * 64 + k8 * 8) = w;
    __syncthreads();
}
constexpr int CVT_MIX_TILES = 276 * 32 + 3 * 32 * 16 + 32 * 32;
DI void cvt_mix_item(const Args& a, int l, int it, LAS float* t) {
    const int nn = otid() & 63;
    if (it < 276 * 32) { const int nb = it >> 5, kb = it & 31; cvt_tile(a.in[I_WIN] + (size_t)l * D * NCOLS_IN, NCOLS_IN, z_srccol(nb * 64 + nn), (bf16*)(a.ws + WS_WIN), D, nb * 64, kb, t); return; }
    it -= 276 * 32;
    if (it < 3 * 32 * 16) { const int br = it / 512, r = it % 512, nb = r >> 4, kb = r & 15;
        cvt_tile(a.in[I_WBR] + ((size_t)l * 3 + br) * 1024 * D, D, nb * 64 + nn, (bf16*)(a.ws + WS_WBR) + (size_t)br * D * 1024, 1024, nb * 64, kb, t); return; }
    it -= 3 * 32 * 16;
    { const int nb = it >> 5, kb = it & 31; cvt_tile(a.in[I_WOUT] + (size_t)l * D * D, D, nb * 64 + nn, (bf16*)(a.ws + WS_WOUT), D, nb * 64, kb, t); }
}
constexpr int CVT_MOE_TILES = 32 * 16 * 32 + 32 * 32 * 8;
DI void cvt_moe_item(const Args& a, int l, int it, LAS float* t) {
    const int nn = otid() & 63;
    if (it < 32 * 16 * 32) { const int e = it >> 9, r = it & 511, nb = r >> 5, kb = r & 31, nt = nb >> 2, sub = nb & 3;
        const float* src = (sub < 2 ? a.in[I_WGATE] : a.in[I_WUP]) + ((size_t)l * NEXP + e) * D * DFF;
        cvt_tile(src, DFF, nt * 128 + (sub & 1) * 64 + nn, (bf16*)(a.ws + WS_WGU) + (size_t)e * 1024 * D, D, nb * 64, kb, t); return; }
    it -= 32 * 16 * 32;
    { const int e = it >> 8, r = it & 255, nb = r >> 3, kb = r & 7;
      cvt_tile(a.in[I_WDOWN] + ((size_t)l * NEXP + e) * DFF * D, D, nb * 64 + nn, (bf16*)(a.ws + WS_WD) + (size_t)e * D * DFF, DFF, nb * 64, kb, t); }
}

DI void mod_item(const Args& a, int j, LAS float* lds) {
    const int tid = otid(), l = j >> 7, col0 = (j & 127) * 96;
    LAS float* sil = lds;
    LAS float* red = lds + 4096;
    for (int k = tid; k < 2 * D; k += NTHR) { const float c = (k < D) ? a.in[I_C][k] : a.in[I_CCTX][k - D]; sil[k] = siluf_(c); }
    __syncthreads();
    const int cg = tid % 24, rg = tid / 24;
    f32x4 a0 = {0.f, 0.f, 0.f, 0.f}, a1 = {0.f, 0.f, 0.f, 0.f};
    if (rg < 21) {
        const float* w = a.in[I_WMOD] + (size_t)l * D * 12288 + col0 + cg * 4;
        for (int k = rg; k < D; k += 21) { const f32x4 wv = *(const f32x4*)(w + (size_t)k * 12288); a0 += wv * sil[k]; a1 += wv * sil[D + k]; }
#pragma unroll
        for (int q = 0; q < 4; ++q) { red[(rg * 2 + 0) * 96 + cg * 4 + q] = a0[q]; red[(rg * 2 + 1) * 96 + cg * 4 + q] = a1[q]; }
    }
    __syncthreads();
    if (tid < 192) { const int set = tid / 96, c = tid % 96; float s = 0.f;
        for (int r = 0; r < 21; ++r) s += red[(r * 2 + set) * 96 + c];
        ((float*)(a.ws + WS_MOD))[((size_t)l * 2 + set) * 12288 + col0 + c] = s + a.in[I_BMOD][(size_t)l * 12288 + col0 + c]; }
    __syncthreads();
}
DI void h2_item(const Args& a, int it, LAS float* lds) {
    const int tid = otid(), l = it / (MT / 8), r0 = (it % (MT / 8)) * 8;
    LAS float* feats = lds;
    LAS float* h1 = lds + 8 * 36;
    if (tid < 8 * 33) { const int rr = tid / 33, i = tid % 33, r = r0 + rr; const int Lq = r < SEQ ? SEQ : CTXL, t = r < SEQ ? r : r - SEQ;
        float f;
        if (i == 0) f = (float)t / (float)(Lq - 1);
        else { const int bi = (i - 1) & 15; const float band = 1e-4f + (float)bi * ((15.0f - 1e-4f) / 15.0f); const float rev2 = 2.0f * band * (float)t / (float)Lq;
            f = (i <= 16) ? cospif(rev2) : -sinpif(rev2); }
        feats[rr * 36 + i] = f; }
    __syncthreads();
    const int rr = tid >> 6, j = tid & 63;
    { const float* w1 = a.in[I_HYW1] + (size_t)l * 33 * 64; float s = a.in[I_HYB1][l * 64 + j];
      for (int i = 0; i < 33; ++i) s += feats[rr * 36 + i] * w1[i * 64 + j];
      h1[rr * 64 + j] = sinf(a.in[I_HYFREQ][l * 64 + j] * s); }
    __syncthreads();
    { const float* w2 = a.in[I_HYW2] + (size_t)l * 64 * 64; float s = a.in[I_HYB2][l * 64 + j];
      for (int i = 0; i < 64; ++i) s += h1[rr * 64 + i] * w2[i * 64 + j];
      ((float*)(a.ws + WS_H2))[((size_t)l * MT + r0 + rr) * 64 + j] = sinf(a.in[I_HYFREQ][l * 64 + j] * s); }
    __syncthreads();
}
DI void prologue_small(const Args& a) {
    const size_t gt = (size_t)obid() * NTHR + otid(), gs = (size_t)gridDim.x * NTHR;
    float* zb = (float*)(a.ws + WS_ZBIAS);
    for (size_t i = gt; i < (size_t)DEPTH * ZC; i += gs) { const int l = (int)(i / ZC), zc = (int)(i % ZC), sc = z_srccol(zc); zb[i] = sc >= 0 ? a.in[I_BIN][(size_t)l * NCOLS_IN + sc] : 0.f; }
    float* lb = (float*)(a.ws + WS_LB);
    for (size_t i = gt; i < (size_t)DEPTH * 2048; i += gs) { const int l = (int)(i / 2048), j = (int)(i % 2048);
        float v = 0.f; if (l == 1) { const float r0 = a.in[I_HGLB][j], r1 = a.in[I_HGLB][2048 + j]; v = 1.0f / (1.0f + expf(r0 - r1)); }
        lb[i] = v; }
    float* tw = (float*)(a.ws + WS_TW);
    for (size_t i = gt; i < 16384; i += gs) { float s, c; sincospif(-2.0f * (float)i / 16384.0f, &s, &c); tw[2 * i] = c; tw[2 * i + 1] = s; }
    float* tw2 = (float*)(a.ws + WS_TW2);
    for (size_t i = gt; i <= 8192; i += gs) { float s, c; sincospif(-(float)i / 16384.0f, &s, &c); tw2[2 * i] = c; tw2[2 * i + 1] = s; }
}
DI void hyc_filters(const Args& a, int l) {
    const int lane = otid() & 63, wave = otid() >> 6;
    const float* h2 = (const float*)(a.ws + WS_H2) + ((size_t)l * MT + SEQ) * 64;
    const float* w3 = a.in[I_HYW3] + (size_t)l * 64 * 2048;
    float* hyc = (float*)(a.ws + WS_HYC);
    const float a0 = -4.605170186f / 1.5f, a1 = -4.605170186f / 0.3f;
    for (int fc = obid() * 8 + wave; fc < 2048; fc += gridDim.x * 8) {
        const int c = fc & 1023; const float delta = fabsf(a0 + (float)c * ((a1 - a0) / 1023.0f)); const float b3 = a.in[I_HYB3][l * 2048 + fc];
        float hv[4], ssum = 0.f;
#pragma unroll
        for (int i = 0; i < 4; ++i) { const int t = lane + 64 * i; float s = b3;
            for (int j = 0; j < 64; ++j) s += h2[t * 64 + j] * w3[j * 2048 + fc];
            const float tl = (float)t / 255.0f; hv[i] = s * (expf(-tl * delta) + 0.05f); ssum += fabsf(hv[i]); }
        ssum = wave_sum(ssum); const float inv = 1.0f / ssum;
#pragma unroll
        for (int i = 0; i < 4; ++i) hyc[(size_t)fc * 256 + lane + 64 * i] = hv[i] * inv;
    }
}
template <int MODE> DI void norm_phase(const Args& a, int l, int nrows, LAS float* ldsf) {
    const int lane = otid() & 63, wave = otid() >> 6;
    float* H = (float*)(a.ws + WS_H); bf16* U = (bf16*)(a.ws + WS_U);
    const float* modall = (const float*)(a.ws + WS_MOD);
    int* route = (int*)(a.ws + WS_ROUTE);
    const bf16* YP = (const bf16*)(a.ws + WS_YP);
    const bool combine = (MODE == 0 && l > 0) || MODE == 2;
    for (int r = obid() * 8 + wave; r < nrows; r += gridDim.x * 8) {
        const int set = r >= SEQ ? 1 : 0;
        const float* src = (MODE == 0 && l == 0) ? (set ? a.in[I_CTX] + (size_t)(r - SEQ) * D : a.in[I_X] + (size_t)r * D) : H + (size_t)r * D;
        f32x4 v[8];
#pragma unroll
        for (int j = 0; j < 8; ++j) v[j] = *(const f32x4*)(src + j * 256 + lane * 4);
        if (combine) {
            const float* gt2 = modall + ((size_t)(l - 1) * 2 + set) * 12288 + 10240;
            const int p0 = route[r * 8 + 6], p1 = route[r * 8 + 7];
#pragma unroll
            for (int j = 0; j < 8; ++j) { const int col = j * 256 + lane * 4;
                const u32x2 y0 = *(const u32x2*)(YP + (size_t)p0 * D + col), y1 = *(const u32x2*)(YP + (size_t)p1 * D + col); const f32x4 g = *(const f32x4*)(gt2 + col);
                v[j][0] += g[0] * (bflo(y0.x) + bflo(y1.x)); v[j][1] += g[1] * (bfhi(y0.x) + bfhi(y1.x)); v[j][2] += g[2] * (bflo(y0.y) + bflo(y1.y)); v[j][3] += g[3] * (bfhi(y0.y) + bfhi(y1.y)); }
            if (MODE == 0) {
#pragma unroll
                for (int j = 0; j < 8; ++j) *(f32x4*)(H + (size_t)r * D + j * 256 + lane * 4) = v[j];
            }
        }
        float ss = 0.f;
#pragma unroll
        for (int j = 0; j < 8; ++j) ss += (v[j][0] * v[j][0] + v[j][1] * v[j][1]) + (v[j][2] * v[j][2] + v[j][3] * v[j][3]);
        ss = wave_sum(ss);
        const float rstd = rsqrtf(ss * (1.0f / D) + NORM_EPS);
        if (MODE == 2) {
            const float* fw = a.in[I_FNW];
#pragma unroll
            for (int j = 0; j < 8; ++j) { const int col = j * 256 + lane * 4; const f32x4 w = *(const f32x4*)(fw + col); *(f32x4*)(a.out + (size_t)r * D + col) = v[j] * rstd * w; }
        } else {
            const float* nw = (MODE == 0 ? a.in[I_NMIXW] : a.in[I_NFFNW]) + (size_t)l * D;
            const float* md = modall + ((size_t)l * 2 + set) * 12288 + (MODE == 0 ? 0 : 6144);
#pragma unroll
            for (int j = 0; j < 8; ++j) { const int col = j * 256 + lane * 4; const f32x4 w = *(const f32x4*)(nw + col), sh = *(const f32x4*)(md + col), sc = *(const f32x4*)(md + 2048 + col);
                v[j] = (v[j] * rstd * w) * (sc + 1.0f) + sh;
                u32x2 o; o.x = pk_bf16(v[j][0], v[j][1]); o.y = pk_bf16(v[j][2], v[j][3]); *(u32x2*)(U + (size_t)r * D + col) = o; }
            if (MODE == 1) {
                const float* wrg = a.in[I_WRG] + (size_t)l * D * 4; const float* wre = a.in[I_WRE] + (size_t)l * D * 32;
                float lg[36];
#pragma unroll
                for (int i = 0; i < 36; ++i) lg[i] = 0.f;
                LAS float* wu = ldsf + wave * 2048;
#pragma unroll
                for (int j = 0; j < 8; ++j) *(LAS f32x4*)(wu + j * 256 + lane * 4) = v[j];
                asm volatile("s_waitcnt lgkmcnt(0)" ::: "memory");
#pragma unroll 2
                for (int cc = 0; cc < 32; ++cc) { const int col = cc * 64 + lane; const float uv = wu[col];
                    const f32x4 g = *(const f32x4*)(wrg + (size_t)col * 4);
                    lg[0] += uv * g[0]; lg[1] += uv * g[1]; lg[2] += uv * g[2]; lg[3] += uv * g[3];
#pragma unroll
                    for (int e4 = 0; e4 < 8; ++e4) { const f32x4 w = *(const f32x4*)(wre + (size_t)col * 32 + e4 * 4);
                        lg[4 + e4 * 4 + 0] += uv * w[0]; lg[4 + e4 * 4 + 1] += uv * w[1]; lg[4 + e4 * 4 + 2] += uv * w[2]; lg[4 + e4 * 4 + 3] += uv * w[3]; } }
                asm volatile("s_waitcnt lgkmcnt(0)" ::: "memory");
#pragma unroll
                for (int i = 0; i < 36; ++i) lg[i] = wave_sum(lg[i]);
                float gl[4]; int grp = 0; float gmax;
#pragma unroll
                for (int g = 0; g < 4; ++g) gl[g] = lg[g] + a.in[I_BRG][l * 4 + g];
                gmax = gl[0];
#pragma unroll
                for (int g = 1; g < 4; ++g) if (gl[g] > gmax) { gmax = gl[g]; grp = g; }
                float gden = 0.f;
#pragma unroll
                for (int g = 0; g < 4; ++g) gden += expf(gl[g] - gmax);
                const float ptop = 1.0f / gden;
                float le[8];
#pragma unroll
                for (int i = 0; i < 8; ++i) { float x = lg[4 + i];
#pragma unroll
                    for (int g = 1; g < 4; ++g) x = (grp == g) ? lg[4 + g * 8 + i] : x;
                    le[i] = x + a.in[I_BRE][l * 32 + grp * 8 + i]; }
                int i0 = 0; float m0 = le[0];
#pragma unroll
                for (int i = 1; i < 8; ++i) if (le[i] > m0) { m0 = le[i]; i0 = i; }
                int i1 = -1; float m1 = -3.0e38f;
#pragma unroll
                for (int i = 0; i < 8; ++i) if (i != i0 && le[i] > m1) { m1 = le[i]; i1 = i; }
                const float e1v = expf(m1 - m0);
                const float w0 = ptop / (1.0f + e1v), w1 = ptop * e1v / (1.0f + e1v);
                if (lane == 0) {
                    unsigned* cnt = (unsigned*)(a.ws + WS_CTL) + CW_CNT + l * 64;
                    const int ex0 = grp * 8 + i0, ex1 = grp * 8 + i1;
                    const unsigned s0 = atomicAdd(cnt + ex0, 1u), s1 = atomicAdd(cnt + ex1, 1u);
                    route[r * 8 + 0] = ex0; route[r * 8 + 1] = ex1; route[r * 8 + 2] = (int)s0; route[r * 8 + 3] = (int)s1;
                    route[r * 8 + 4] = __float_as_int(w0); route[r * 8 + 5] = __float_as_int(w1);
                }
            }
        }
    }
}
DI void permute_phase(const Args& a, int l, int nrows, LAS unsigned char* ldsb) {
    LAS int* poff = (LAS int*)ldsb;
    const int tid = otid(), lane = tid & 63, wave = tid >> 6;
    const unsigned* cnt = (const unsigned*)(a.ws + WS_CTL) + CW_CNT + l * 64;
    if (tid == 0) { int off = 0; for (int e = 0; e < NEXP; ++e) { poff[e] = off; off += (int)((cnt[e] + 255u) / 256u) * 256; } poff[32] = off; }
    __syncthreads();
    if (obid() == 0) { int* tile_e = (int*)(a.ws + WS_TILEE); const int nt = poff[32] >> 8;
        if (tid < 200) { int e = -1; if (tid < nt) { for (int q = 0; q < NEXP; ++q) if (poff[q] <= tid * 256) e = q; } tile_e[tid] = e < 0 ? 0 : e; }
        if (tid == 0) tile_e[200] = nt; }
    int* route = (int*)(a.ws + WS_ROUTE); float* roww = (float*)(a.ws + WS_ROWW);
    const bf16* U = (const bf16*)(a.ws + WS_U); bf16* XP = (bf16*)(a.ws + WS_XP);
    for (int r = obid() * 8 + wave; r < nrows; r += gridDim.x * 8) {
        const int e0 = route[r * 8 + 0], e1 = route[r * 8 + 1], s0 = route[r * 8 + 2], s1 = route[r * 8 + 3];
        const int p0 = poff[e0] + s0, p1 = poff[e1] + s1;
        u32x4 x[4];
#pragma unroll
        for (int i = 0; i < 4; ++i) x[i] = *(const u32x4*)(U + (size_t)r * D + (i * 64 + lane) * 8);
#pragma unroll
        for (int i = 0; i < 4; ++i) { *(u32x4*)(XP + (size_t)p0 * D + (i * 64 + lane) * 8) = x[i]; *(u32x4*)(XP + (size_t)p1 * D + (i * 64 + lane) * 8) = x[i]; }
        if (lane == 0) { route[r * 8 + 6] = p0; route[r * 8 + 7] = p1; roww[p0] = __int_as_float(route[r * 8 + 4]); roww[p1] = __int_as_float(route[r * 8 + 5]); }
    }
}
DI int stream_row(int p, int dir) { return dir == 0 ? (p < CTXL ? SEQ + p : p - CTXL) : (p < CTXL ? SEQ + (CTXL - 1 - p) : (SEQ - 1) - (p - CTXL)); }

DI void scan_item(const Args& a, int l, int it, LAS unsigned char* ldsb) {
    const int tid = otid(), lane = tid & 63, wave = tid >> 6;
    LAS float* sA = (LAS float*)ldsb;
    LAS float* sK = sA + 64 * 128;
    LAS float* sQ = sK + 64 * 128;
    LAS float* sV = sQ + 64 * 128;
    LAS float* sO = sV + 64 * 16;
    LAS float* sW = sO + 64 * 16;
    LAS float* sB = sW + 16 * 128;
    const bool gla = it >= 128; int head, dir, slice;
    if (!gla) { head = it >> 4; dir = (it >> 3) & 1; slice = it & 7; } else { const int j = it - 128; head = j >> 5; dir = (j >> 4) & 1; slice = j & 15; }
    const bf16* Z = (const bf16*)(a.ws + WS_Z);
    float* O = (float*)(a.ws + WS_OSC) + (size_t)((gla ? 2 : 0) + dir) * MT * 1024;
    const int ocol0 = (gla ? head * 256 : head * 128) + slice * 16;
    if (gla) { for (int i = tid; i < 16 * 128; i += NTHR) sW[i] = a.in[I_GLWA2][(((size_t)l * 2 + dir) * 16 + (i >> 7)) * 512 + head * 128 + (i & 127)];
               if (tid < 128) sB[tid] = a.in[I_GLBA][((size_t)l * 2 + dir) * 512 + head * 128 + tid]; }
    else { if (tid < 128) sB[tid] = ((const float*)(a.ws + WS_LB))[((size_t)l * 2 + dir) * 1024 + head * 128 + tid]; }
    __syncthreads();
    const int vi = lane >> 5, kg = lane & 31, vcol = wave * 2 + vi;
    float S0 = 0.f, S1 = 0.f, S2 = 0.f, S3 = 0.f;
    for (int pb = 0; pb < MT / 64; ++pb) {
        { const int tt = tid >> 3, kc = tid & 7, r = stream_row(pb * 64 + tt, dir);
          const bf16* zr = Z + (size_t)r * ZC;
          if (!gla) {
              const bf16* zq = zr + Z_HG + head * 128 + kc * 16; const bf16* zf = zr + Z_HG + 1024 * (1 + dir) + head * 128 + kc * 16;
#pragma unroll
              for (int j = 0; j < 16; ++j) { const int k = kc * 16 + j; const float q = bf2f(zq[j]), f = bf2f(zf[j]), lbv = sB[k];
                  sA[tt * 128 + k] = lbv + (1.0f - lbv) * sigmoidf_(f); sK[tt * 128 + k] = (1.0f - lbv) * sigmoidf_(-f); sQ[tt * 128 + k] = siluf_(q); }
              if (kc < 2) {
#pragma unroll
                  for (int j = 0; j < 8; ++j) sV[tt * 16 + kc * 8 + j] = bf2f(zr[Z_HG + 3072 + head * 128 + slice * 16 + kc * 8 + j]); }
          } else {
              float af[16];
#pragma unroll
              for (int rr = 0; rr < 16; ++rr) af[rr] = bf2f(zr[Z_LR + dir * 16 + rr]);
              const bf16* zq = zr + Z_GL + head * 128 + kc * 16; const bf16* zk = zr + Z_GL + 512 + head * 128 + kc * 16;
#pragma unroll
              for (int j = 0; j < 16; ++j) { const int k = kc * 16 + j; float x = sB[k];
#pragma unroll
                  for (int rr = 0; rr < 16; ++rr) x += af[rr] * sW[rr * 128 + k];
                  const float ls = fminf(x, 0.f) - log1pf(__expf(-fabsf(x)));
                  sA[tt * 128 + k] = __expf(ls * 0.0625f); sK[tt * 128 + k] = bf2f(zk[j]); sQ[tt * 128 + k] = bf2f(zq[j]) * 0.08838834764831845f; }
              if (kc < 2) {
#pragma unroll
                  for (int j = 0; j < 8; ++j) sV[tt * 16 + kc * 8 + j] = bf2f(zr[Z_GL + 1024 + head * 256 + slice * 16 + kc * 8 + j]); }
          } }
        __syncthreads();
#pragma unroll
        for (int half = 0; half < 2; ++half) {
            float keep = 0.f;
#pragma unroll 8
            for (int t2 = 0; t2 < 32; ++t2) { const int tt = half * 32 + t2;
                const f32x4 av = *(const LAS f32x4*)(sA + tt * 128 + kg * 4), kv = *(const LAS f32x4*)(sK + tt * 128 + kg * 4), qv = *(const LAS f32x4*)(sQ + tt * 128 + kg * 4);
                const float vv = sV[tt * 16 + vcol];
                S0 = av[0] * S0 + kv[0] * vv; S1 = av[1] * S1 + kv[1] * vv; S2 = av[2] * S2 + kv[2] * vv; S3 = av[3] * S3 + kv[3] * vv;
                float part = (qv[0] * S0 + qv[1] * S1) + (qv[2] * S2 + qv[3] * S3);
                part += __shfl_xor(part, 16); part += __shfl_xor(part, 8); part += __shfl_xor(part, 4); part += __shfl_xor(part, 2); part += __shfl_xor(part, 1);
                keep = (kg == t2) ? part : keep; }
            sO[(half * 32 + kg) * 16 + vcol] = keep;
        }
        __syncthreads();
        if (tid < 256) { const int tt = tid >> 2, c4 = (tid & 3) * 4, r = stream_row(pb * 64 + tt, dir);
            *(f32x4*)(O + (size_t)r * 1024 + ocol0 + c4) = *(const LAS f32x4*)(sO + tt * 16 + c4); }
        __syncthreads();
    }
}

DI void shortconv8(const bf16* Z, const float* cw, const float* cb, int l, int seg, int c, int r0, int lo, int hi, float (&out)[8]) {
    const int col = Z_HY + seg * 1024 + c; float zz[10];
#pragma unroll
    for (int i = 0; i < 10; ++i) { const int r = r0 - 1 + i; zz[i] = (r >= lo && r < hi) ? bf2f(Z[(size_t)r * ZC + col]) : 0.f; }
    const float w0 = cw[((size_t)l * 3 + 0) * 3072 + seg * 1024 + c], w1 = cw[((size_t)l * 3 + 1) * 3072 + seg * 1024 + c], w2 = cw[((size_t)l * 3 + 2) * 3072 + seg * 1024 + c], b = cb[(size_t)l * 3072 + seg * 1024 + c];
#pragma unroll
    for (int i = 0; i < 8; ++i) out[i] = w0 * zz[i] + w1 * zz[i + 1] + w2 * zz[i + 2] + b;
}
DI void hyprep_item(const Args& a, int l, int it, LAS float* t) {
    const int tid = otid(), tb = it >> 4, cb = it & 15, r0 = tb * 64, lo = r0 < SEQ ? 0 : SEQ, hi = r0 < SEQ ? SEQ : MT;
    const bf16* Z = (const bf16*)(a.ws + WS_Z); float* VXT = (float*)(a.ws + WS_U);
    { const int cc = tid & 63, tq = tid >> 6, c = cb * 64 + cc; float x1[8], vv[8];
      shortconv8(Z, a.in[I_HYCW], a.in[I_HYCB], l, 1, c, r0 + tq * 8, lo, hi, x1); shortconv8(Z, a.in[I_HYCW], a.in[I_HYCB], l, 2, c, r0 + tq * 8, lo, hi, vv);
#pragma unroll
      for (int i = 0; i < 8; ++i) t[cc * 65 + tq * 8 + i] = vv[i] * x1[i]; }
    __syncthreads();
    { const int cw = tid >> 3, t8 = tid & 7; f32x4 o0, o1;
#pragma unroll
      for (int i = 0; i < 4; ++i) { o0[i] = t[cw * 65 + t8 * 8 + i]; o1[i] = t[cw * 65 + t8 * 8 + 4 + i]; }
      float* dst = VXT + (size_t)(cb * 64 + cw) * MT + r0 + t8 * 8; *(f32x4*)dst = o0; *(f32x4*)(dst + 4) = o1; }
    __syncthreads();
}
DI void hycomb_item(const Args& a, int l, int it, LAS float* t) {
    const int tid = otid(), tb = it >> 4, cb = it & 15, r0 = tb * 64, lo = r0 < SEQ ? 0 : SEQ, hi = r0 < SEQ ? SEQ : MT;
    const bf16* Z = (const bf16*)(a.ws + WS_Z); const float* VXT = (const float*)(a.ws + WS_U); bf16* Y0 = (bf16*)(a.ws + WS_YMIX);
    { const int cw = tid >> 3, t8 = tid & 7; const float* srcp = VXT + (size_t)(cb * 64 + cw) * MT + r0 + t8 * 8; const f32x4 i0 = *(const f32x4*)srcp, i1 = *(const f32x4*)(srcp + 4);
#pragma unroll
      for (int i = 0; i < 4; ++i) { t[cw * 65 + t8 * 8 + i] = i0[i]; t[cw * 65 + t8 * 8 + 4 + i] = i1[i]; } }
    __syncthreads();
    { const int cc = tid & 63, tq = tid >> 6, c = cb * 64 + cc; float x0[8];
      shortconv8(Z, a.in[I_HYCW], a.in[I_HYCB], l, 0, c, r0 + tq * 8, lo, hi, x0);
#pragma unroll
      for (int i = 0; i < 8; ++i) Y0[(size_t)(r0 + tq * 8 + i) * 1024 + c] = f2bf(t[cc * 65 + tq * 8 + i] * x0[i]); }
    __syncthreads();
}
DI void scancomb_rows(const Args& a, int l, int nrows) {
    const int lane = otid() & 63, wave = otid() >> 6;
    const bf16* Z = (const bf16*)(a.ws + WS_Z); const float* O = (const float*)(a.ws + WS_OSC);
    bf16* Y1 = (bf16*)(a.ws + WS_YMIX) + (size_t)MT * 1024; bf16* Y2 = Y1 + (size_t)MT * 1024;
    for (int r = obid() * 8 + wave; r < nrows; r += gridDim.x * 8) {
#pragma unroll
        for (int i = 0; i < 4; ++i) { const int col = i * 256 + lane * 4;
            { const f32x4 of = *(const f32x4*)(O + (size_t)r * 1024 + col), ob = *(const f32x4*)(O + ((size_t)MT + r) * 1024 + col); const f32x4 o = of + ob;
              float ss = (o[0] * o[0] + o[1] * o[1]) + (o[2] * o[2] + o[3] * o[3]);
              ss += __shfl_xor(ss, 16); ss += __shfl_xor(ss, 8); ss += __shfl_xor(ss, 4); ss += __shfl_xor(ss, 2); ss += __shfl_xor(ss, 1);
              const float rstd = rsqrtf(ss * (1.0f / 128.0f) + NORM_EPS);
              const f32x4 nw = *(const f32x4*)(a.in[I_HGNW] + (size_t)l * 128 + (col & 127));
              const u32x2 g = *(const u32x2*)(Z + (size_t)r * ZC + Z_HG + 4096 + col);
              u32x2 w; w.x = pk_bf16(o[0] * rstd * nw[0] * sigmoidf_(bflo(g.x)), o[1] * rstd * nw[1] * sigmoidf_(bfhi(g.x)));
              w.y = pk_bf16(o[2] * rstd * nw[2] * sigmoidf_(bflo(g.y)), o[3] * rstd * nw[3] * sigmoidf_(bfhi(g.y)));
              *(u32x2*)(Y1 + (size_t)r * 1024 + col) = w; }
            { const f32x4 of = *(const f32x4*)(O + ((size_t)2 * MT + r) * 1024 + col), ob = *(const f32x4*)(O + ((size_t)3 * MT + r) * 1024 + col); const f32x4 o = of + ob;
              float ss = (o[0] * o[0] + o[1] * o[1]) + (o[2] * o[2] + o[3] * o[3]); ss = wave_sum(ss);
              const float rstd = rsqrtf(ss * (1.0f / 256.0f) + NORM_EPS);
              const f32x4 nw = *(const f32x4*)(a.in[I_GLNW] + (size_t)l * 256 + (col & 255));
              const u32x2 g = *(const u32x2*)(Z + (size_t)r * ZC + Z_GL + 2048 + col);
              u32x2 w; w.x = pk_bf16(o[0] * rstd * nw[0] * siluf_(bflo(g.x)), o[1] * rstd * nw[1] * siluf_(bfhi(g.x)));
              w.y = pk_bf16(o[2] * rstd * nw[2] * siluf_(bflo(g.y)), o[3] * rstd * nw[3] * siluf_(bfhi(g.y)));
              *(u32x2*)(Y2 + (size_t)r * 1024 + col) = w; }
        }
    }
}
DI void hyconv_item(const Args& a, int l, int c, LAS unsigned char* ldsb) {
    const int tid = otid();
    LAS float* lds = (LAS float*)ldsb;
    LAS float* xs = (LAS float*)(ldsb + LDS_X);
    const float* tw = (const float*)(a.ws + WS_TW); const float* tw2 = (const float*)(a.ws + WS_TW2);
    const float* h2 = (const float*)(a.ws + WS_H2) + (size_t)l * MT * 64;
    float* VX = (float*)(a.ws + WS_U) + (size_t)c * MT;
    if (tid < 128) xs[tid] = a.in[I_HYW3][((size_t)l * 64 + (tid & 63)) * 2048 + (tid >> 6) * 1024 + c];
    __syncthreads();
    const float a0 = -4.605170186f / 1.5f, a1 = -4.605170186f / 0.3f;
    const float delta = fabsf(a0 + (float)c * ((a1 - a0) / 1023.0f));
    const float b3f = a.in[I_HYB3][l * 2048 + c], b3b = a.in[I_HYB3][l * 2048 + 1024 + c];
    float sf = 0.f, sb = 0.f;
    for (int i = 0; i < 32; ++i) { const int t = tid + 512 * i; const float* hr = h2 + (size_t)t * 64; float hf = b3f, hb = b3b;
#pragma unroll
        for (int j4 = 0; j4 < 16; ++j4) { const f32x4 hv = *(const f32x4*)(hr + j4 * 4);
#pragma unroll
            for (int q = 0; q < 4; ++q) { hf += hv[q] * xs[j4 * 4 + q]; hb += hv[q] * xs[64 + j4 * 4 + q]; } }
        const float dec = expf(-((float)t / (float)(SEQ - 1)) * delta) + 0.05f;
        hf *= dec; hb *= dec; sf += fabsf(hf); sb += fabsf(hb);
        lds[t] = hf; if (t > 0) lds[32768 - t] = hb; else xs[160] = hb; }
    sf = wave_sum(sf); sb = wave_sum(sb);
    if ((tid & 63) == 0) { xs[128 + (tid >> 6)] = sf; xs[136 + (tid >> 6)] = sb; }
    __syncthreads();
    float tf = 0.f, tb = 0.f;
#pragma unroll
    for (int w = 0; w < 8; ++w) { tf += xs[128 + w]; tb += xs[136 + w]; }
    const float inf_ = 1.0f / tf, inb_ = 1.0f / tb;
    for (int i = 0; i < 64; ++i) { const int m = tid + 512 * i; float v = lds[m];
        if (m == 0) v = v * inf_ + xs[160] * inb_ + a.in[I_HYSKIP][l * 1024 + c];
        else if (m < SEQ) v *= inf_; else if (m == SEQ) v = 0.f; else v *= inb_;
        lds[m] = v; }
    __syncthreads();
    for (int s = FFT_M / 4; s >= 1; s >>= 2) { fft_fwd_pass(lds, tw, s, tid); __syncthreads(); }
    float* Gs = (float*)(a.ws + WS_YMIX) + (size_t)obid() * 32768;
#pragma unroll 1
    for (int j = 0; j < 16; ++j) { const int k = tid + 512 * j; cpx gk, gm; rfft_untangle(lds, tw2, k, gk, gm); f32x4 g4; g4[0] = gk.x; g4[1] = gk.y; g4[2] = gm.x; g4[3] = gm.y; *(f32x4*)(Gs + (size_t)k * 4) = g4; }
    __syncthreads();
    for (int i = 0; i < 16; ++i) { const int m4 = tid + 512 * i; f32x4 v = {0.f, 0.f, 0.f, 0.f}; if (m4 < SEQ / 4) v = *(const f32x4*)(VX + m4 * 4); *(LAS f32x4*)(lds + m4 * 4) = v; }
    __syncthreads();
    for (int s = FFT_M / 4; s >= 1; s >>= 2) { fft_fwd_pass(lds, tw, s, tid); __syncthreads(); }
#pragma unroll 1
    for (int j = 0; j < 16; ++j) { const int k = tid + 512 * j; const f32x4 g4 = *(const f32x4*)(Gs + (size_t)k * 4); cpx gk, gm; gk.x = g4[0]; gk.y = g4[1]; gm.x = g4[2]; gm.y = g4[3]; rfft_mul_retangle(lds, tw2, k, gk, gm); }
    __syncthreads();
    for (int s = 1; s <= FFT_M / 4; s <<= 2) { fft_inv_pass(lds, tw, s, tid); __syncthreads(); }
    for (int i = 0; i < 8; ++i) { const int m4 = tid + 512 * i; f32x4 v = *(const LAS f32x4*)(lds + m4 * 4); *(f32x4*)(VX + m4 * 4) = v * (1.0f / FFT_M); }
    __syncthreads();
}
DI void hycctx_item(const Args& a, int l, int it, LAS unsigned char* ldsb) {
    const int tid = otid(), c0 = it * 16;
    LAS float* sv = (LAS float*)ldsb;
    LAS float* sf = sv + 16 * 256;
    LAS float* sb = sf + 16 * 256;
    const float* hyc = (const float*)(a.ws + WS_HYC); float* VXT = (float*)(a.ws + WS_U);
    for (int i = tid; i < 16 * 256; i += NTHR) { const int ch = i >> 8, t = i & 255; sv[i] = VXT[(size_t)(c0 + ch) * MT + SEQ + t]; sf[i] = hyc[(size_t)(c0 + ch) * 256 + t]; sb[i] = hyc[(size_t)(1024 + c0 + ch) * 256 + t]; }
    __syncthreads();
    const int ch = tid >> 5, tq = tid & 31; const float g0 = sf[ch * 256] + sb[ch * 256] + a.in[I_HYSKIP][l * 1024 + c0 + ch];
    float acc[8];
#pragma unroll
    for (int i = 0; i < 8; ++i) acc[i] = 0.f;
    for (int s = 0; s < 256; ++s) { const float vv = sv[ch * 256 + s];
#pragma unroll
        for (int i = 0; i < 8; ++i) { const int d = tq * 8 + i - s; const float g = d > 0 ? sf[ch * 256 + d] : (d < 0 ? sb[ch * 256 - d] : g0); acc[i] += g * vv; } }
    __syncthreads();
#pragma unroll
    for (int i = 0; i < 8; ++i) VXT[(size_t)(c0 + ch) * MT + SEQ + tq * 8 + i] = acc[i];
    __syncthreads();
}

struct EpiZ {
    static constexpr bool PERM = true, AFTER_DRAIN = false; bf16* O; const float* bias;
    DI void operator()(const f32x4 (&acc)[2][2][4][2], const pg8::Unit& u, int wr, int wc, int fr, int fq) const {
        const int row0 = u.pm * 256 + wr * 64 + fr, col0 = u.pn * 256 + wc * 32 + 8 * fq;
        f32x4 bv[2][2];
#pragma unroll
        for (int bj = 0; bj < 2; ++bj)
#pragma unroll
            for (int n = 0; n < 2; ++n) bv[bj][n] = *(const f32x4*)(bias + col0 + bj * 128 + 4 * n);
#pragma unroll
        for (int ai = 0; ai < 2; ++ai)
#pragma unroll
            for (int m = 0; m < 4; ++m) { bf16* rowp = O + (size_t)(row0 + ai * 128 + m * 16) * ZC + col0;
#pragma unroll
                for (int bj = 0; bj < 2; ++bj) { const f32x4 v0 = acc[ai][bj][m][0] + bv[bj][0], v1 = acc[ai][bj][m][1] + bv[bj][1];
                    u32x4 w; w.x = pk_bf16(v0[0], v0[1]); w.y = pk_bf16(v0[2], v0[3]); w.z = pk_bf16(v1[0], v1[1]); w.w = pk_bf16(v1[2], v1[3]);
                    *(u32x4*)(rowp + bj * 128) = w; } }
    }
};
template <int BR> struct EpiBr {
    static constexpr bool PERM = true, AFTER_DRAIN = false; bf16* Mg; const bf16* Zg;
    DI void operator()(const f32x4 (&acc)[2][2][4][2], const pg8::Unit& u, int wr, int wc, int fr, int fq) const {
        const int row0 = u.pm * 256 + wr * 64 + fr, col0 = u.pn * 256 + wc * 32 + 8 * fq;
#pragma unroll
        for (int ai = 0; ai < 2; ++ai)
#pragma unroll
            for (int m = 0; m < 4; ++m) { const size_t row = (size_t)(row0 + ai * 128 + m * 16);
#pragma unroll
                for (int bj = 0; bj < 2; ++bj) { const int col = col0 + bj * 128;
                    const u32x4 g = *(const u32x4*)(Zg + row * ZC + col);
                    f32x4 v0 = acc[ai][bj][m][0], v1 = acc[ai][bj][m][1];
                    v0[0] *= sigmoidf_(bflo(g.x)); v0[1] *= sigmoidf_(bfhi(g.x)); v0[2] *= sigmoidf_(bflo(g.y)); v0[3] *= sigmoidf_(bfhi(g.y));
                    v1[0] *= sigmoidf_(bflo(g.z)); v1[1] *= sigmoidf_(bfhi(g.z)); v1[2] *= sigmoidf_(bflo(g.w)); v1[3] *= sigmoidf_(bfhi(g.w));
                    if (BR > 0) { const u32x4 p = *(const u32x4*)(Mg + row * D + col);
                        v0[0] += bflo(p.x); v0[1] += bfhi(p.x); v0[2] += bflo(p.y); v0[3] += bfhi(p.y); v1[0] += bflo(p.z); v1[1] += bfhi(p.z); v1[2] += bflo(p.w); v1[3] += bfhi(p.w); }
                    u32x4 w; w.x = pk_bf16(v0[0], v0[1]); w.y = pk_bf16(v0[2], v0[3]); w.z = pk_bf16(v1[0], v1[1]); w.w = pk_bf16(v1[2], v1[3]);
                    *(u32x4*)(Mg + row * D + col) = w; } }
    }
};
struct EpiOut {
    static constexpr bool PERM = false, AFTER_DRAIN = false; const float* hin_main; const float* hin_ctx; float* hout; const float* gt1;
    DI void operator()(const f32x4 (&acc)[2][2][4][2], const pg8::Unit& u, int wr, int wc, int fr, int fq) const {
        const int row0 = u.pm * 256 + wr * 64 + fr, col0 = u.pn * 256 + wc * 32 + 4 * fq; const bool isctx = u.pm >= SEQ / 256;
        const float* g = gt1 + (isctx ? 12288 : 0);
        f32x4 gv[2][2];
#pragma unroll
        for (int bj = 0; bj < 2; ++bj)
#pragma unroll
            for (int n = 0; n < 2; ++n) gv[bj][n] = *(const f32x4*)(g + col0 + bj * 128 + n * 16);
#pragma unroll
        for (int ai = 0; ai < 2; ++ai)
#pragma unroll
            for (int m = 0; m < 4; ++m) { const int row = row0 + ai * 128 + m * 16;
                const float* ip = (isctx ? hin_ctx + (size_t)(row - SEQ) * D : hin_main + (size_t)row * D) + col0; float* op = hout + (size_t)row * D + col0;
#pragma unroll
                for (int bj = 0; bj < 2; ++bj)
#pragma unroll
                    for (int n = 0; n < 2; ++n) { const f32x4 b = *(const f32x4*)(ip + bj * 128 + n * 16); *(f32x4*)(op + bj * 128 + n * 16) = b + gv[bj][n] * acc[ai][bj][m][n]; } }
    }
};
struct EpiGU {
    static constexpr bool PERM = true, AFTER_DRAIN = false; bf16* Hm;
    DI void operator()(const f32x4 (&acc)[2][2][4][2], const pg8::Unit& u, int wr, int wc, int fr, int fq) const {
        const int row0 = u.pm * 256 + wr * 64 + fr, col0 = (u.pn & 3) * 128 + wc * 32 + 8 * fq;
#pragma unroll
        for (int ai = 0; ai < 2; ++ai)
#pragma unroll
            for (int m = 0; m < 4; ++m) { const f32x4 g0 = acc[ai][0][m][0], g1 = acc[ai][0][m][1], u0 = acc[ai][1][m][0], u1 = acc[ai][1][m][1];
                u32x4 w; w.x = pk_bf16(siluf_(g0[0]) * u0[0], siluf_(g0[1]) * u0[1]); w.y = pk_bf16(siluf_(g0[2]) * u0[2], siluf_(g0[3]) * u0[3]);
                w.z = pk_bf16(siluf_(g1[0]) * u1[0], siluf_(g1[1]) * u1[1]); w.w = pk_bf16(siluf_(g1[2]) * u1[2], siluf_(g1[3]) * u1[3]);
                *(u32x4*)(Hm + (size_t)(row0 + ai * 128 + m * 16) * DFF + col0) = w; }
    }
};
struct EpiDn {
    static constexpr bool PERM = true, AFTER_DRAIN = false; bf16* Y; const float* roww;
    DI void operator()(const f32x4 (&acc)[2][2][4][2], const pg8::Unit& u, int wr, int wc, int fr, int fq) const {
        const int row0 = u.pm * 256 + wr * 64 + fr, col0 = (u.pn & 7) * 256 + wc * 32 + 8 * fq;
#pragma unroll
        for (int ai = 0; ai < 2; ++ai)
#pragma unroll
            for (int m = 0; m < 4; ++m) { const int row = row0 + ai * 128 + m * 16; const float rw = roww[row];
#pragma unroll
                for (int bj = 0; bj < 2; ++bj) { const f32x4 v0 = acc[ai][bj][m][0] * rw, v1 = acc[ai][bj][m][1] * rw;
                    u32x4 w; w.x = pk_bf16(v0[0], v0[1]); w.y = pk_bf16(v0[2], v0[3]); w.z = pk_bf16(v1[0], v1[1]); w.w = pk_bf16(v1[2], v1[3]);
                    *(u32x4*)(Y + (size_t)row * D + col0 + bj * 128) = w; } }
    }
};
struct MoeOrder {
    const int* tile_e; int ntiles, nsub, G, c;
    DI bool next(int i, pg8::Unit& u) const { const int j = i * G + c; if (j >= ntiles * nsub) return false; const int ti = j / nsub; u.pm = ti; u.pn = tile_e[ti] * nsub + (j - ti * nsub); return true; }
    DI void a_ready(const pg8::Unit&) const {}
    DI void done(const pg8::Unit&) const {}
};
constexpr int NPH_LAYER = 11, PH_FINAL = 1 + NPH_LAYER * DEPTH, NPHASES = PH_FINAL + 1;
struct KArgs { Args a; int li, pad; };
__global__ void __launch_bounds__(NTHR, 2) fwd_kernel(KArgs ka) {
    extern __shared__ __attribute__((aligned(16))) unsigned char lds_raw[];
    LAS unsigned char* lds = (LAS unsigned char*)lds_raw;
    LAS float* ldsf = (LAS float*)lds_raw;
    const Args& a = ka.a;
    const int tid = otid(), bid = obid(), G = gridDim.x;
    if (tid == 0) { ((LAS unsigned*)(lds + LDS_BARW))[0] = 0u; ((LAS unsigned*)(lds + LDS_BARW))[1] = 0u; }
    __syncthreads();
    XcdBarrier bar = xcd_barrier_post((unsigned*)(a.ws + WS_CTL) + CW_BAR + ka.li * XCD_BAR_WORDS, (volatile LAS unsigned*)(lds + LDS_BARW));
    const int lo = a.ph_lo, hi = a.ph_hi;
#ifndef PHMASK
#define PHMASK 0xFFFF
#endif
#define EN(i) (((PHMASK) >> (i)) & 1)
#define IN(k) (lo <= (k) && (k) < hi)
#define SEAM(k) do { if (IN(k) && IN((k) + 1)) xcd_barrier(bar); } while (0)
    unsigned char* ws = a.ws;
    bf16* U = (bf16*)(ws + WS_U); bf16* Z = (bf16*)(ws + WS_Z); float* H = (float*)(ws + WS_H);
    const float* modall = (const float*)(ws + WS_MOD);

    if (EN(0) && IN(0)) {
        prologue_small(a);
        for (int it = bid; it < 256; it += G) mod_item(a, it, ldsf);
        for (int it = bid; it < DEPTH * (MT / 8); it += G) h2_item(a, it, ldsf);
    }
    SEAM(0);
    for (int l = 0; l < DEPTH; ++l) {
        const int pb = 1 + NPH_LAYER * l;
        const int nrows = (l == 0) ? MT : SEQ;
        if (EN(1) && IN(pb + 0)) {
            norm_phase<0>(a, l, MT, ldsf);
            if (l == 0) hyc_filters(a, 0);
            for (int it = bid; it < CVT_MIX_TILES; it += G) cvt_mix_item(a, l, it, ldsf);
        }
        SEAM(pb + 0);
        if (EN(2) && IN(pb + 1)) {
            pg8::Gemm g{U, (const bf16*)(ws + WS_WIN), MT, ZC, D}; pg8::StaticOrder S; S.init(MT, ZC, G, bid);
            EpiZ E{Z, (const float*)(ws + WS_ZBIAS) + (size_t)l * ZC};
            pg8::gemm_phase<EpiZ, pg8::StaticOrder, true, true>(lds, g, S, E);
        }
        SEAM(pb + 1);
        if (EN(3) && IN(pb + 2)) { const int nit = (nrows / 64) * 16; for (int it = bid; it < nit; it += G) hyprep_item(a, l, it, ldsf); }
        SEAM(pb + 2);
        if (EN(4) && IN(pb + 3)) {
            for (int it = bid; it < 256; it += G) scan_item(a, l, it, lds);
            for (int c = bid; c < 1024; c += G) hyconv_item(a, l, c, lds);
            if (l == 0) for (int it = bid; it < 64; it += G) hycctx_item(a, l, it, lds);
        }
        SEAM(pb + 3);
        if (EN(5) && IN(pb + 4)) {
            scancomb_rows(a, l, nrows);
            const int nit = (nrows / 64) * 16; for (int it = bid; it < nit; it += G) hycomb_item(a, l, it, ldsf);
        }
        SEAM(pb + 4);
        if (EN(6) && IN(pb + 5)) {
            const bf16* Y = (const bf16*)(ws + WS_YMIX); const bf16* WB = (const bf16*)(ws + WS_WBR);
            pg8::StaticOrder S; S.init(nrows, D, G, bid);
            { pg8::Gemm g{Y, WB, nrows, D, 1024}; EpiBr<0> E{U, Z + Z_MG}; pg8::gemm_phase<EpiBr<0>, pg8::StaticOrder, true, true>(lds, g, S, E); }
            __syncthreads();
            { pg8::Gemm g{Y + (size_t)MT * 1024, WB + (size_t)D * 1024, nrows, D, 1024}; EpiBr<1> E{U, Z + Z_MG + D}; pg8::gemm_phase<EpiBr<1>, pg8::StaticOrder, true, true>(lds, g, S, E); }
            __syncthreads();
            { pg8::Gemm g{Y + (size_t)2 * MT * 1024, WB + (size_t)2 * D * 1024, nrows, D, 1024}; EpiBr<2> E{U, Z + Z_MG + 2 * D}; pg8::gemm_phase<EpiBr<2>, pg8::StaticOrder, true, true>(lds, g, S, E); }
        }
        SEAM(pb + 5);
        if (EN(7) && IN(pb + 6)) {
            pg8::Gemm g{U, (const bf16*)(ws + WS_WOUT), nrows, D, D}; pg8::StaticOrder S; S.init(nrows, D, G, bid);
            EpiOut E{l == 0 ? a.in[I_X] : H, l == 0 ? a.in[I_CTX] : H + (size_t)SEQ * D, H, modall + (size_t)l * 2 * 12288 + 4096};
            pg8::gemm_phase<EpiOut, pg8::StaticOrder, true, true>(lds, g, S, E);
        }
        SEAM(pb + 6);
        if (EN(8) && IN(pb + 7)) {
            norm_phase<1>(a, l, nrows, ldsf);
            __syncthreads();
            for (int it = bid; it < CVT_MOE_TILES; it += G) cvt_moe_item(a, l, it, ldsf);
        }
        SEAM(pb + 7);
        if (EN(9) && IN(pb + 8)) permute_phase(a, l, nrows, lds);
        SEAM(pb + 8);
        if (EN(10) && IN(pb + 9)) {
            const int* tile_e = (const int*)(ws + WS_TILEE); const int ntiles = tile_e[200];
            pg8::Gemm g{(const bf16*)(ws + WS_XP), (const bf16*)(ws + WS_WGU), MOE_MAXROWS, NEXP * 1024, D}; MoeOrder S{tile_e, ntiles, 4, G, bid};
            EpiGU E{(bf16*)(ws + WS_HMID)};
            pg8::gemm_phase<EpiGU, MoeOrder, true, true>(lds, g, S, E);
        }
        SEAM(pb + 9);
        if (EN(11) && IN(pb + 10)) {
            const int* tile_e = (const int*)(ws + WS_TILEE); const int ntiles = tile_e[200];
            pg8::Gemm g{(const bf16*)(ws + WS_HMID), (const bf16*)(ws + WS_WD), MOE_MAXROWS, NEXP * D, DFF}; MoeOrder S{tile_e, ntiles, 8, G, bid};
            EpiDn E{(bf16*)(ws + WS_YP), (const float*)(ws + WS_ROWW)};
            pg8::gemm_phase<EpiDn, MoeOrder, true, true>(lds, g, S, E);
        }
        SEAM(pb + 10);
    }
    if (EN(12) && IN(PH_FINAL)) norm_phase<2>(a, DEPTH, SEQ, ldsf);
#undef IN
#undef SEAM
}

#ifndef MK_SINGLE
#define MK_SINGLE 1
#endif
extern "C" void kernel_launch(void* const* d_in, const int* in_sizes, int n_in, void* d_out, int out_size, void* d_ws, size_t ws_size, hipStream_t stream) {
    static int grid = 0;
    if (grid == 0) {
        if (n_in != N_IN || out_size != SEQ * D || ws_size < WS_END) { fprintf(stderr, "kernel_launch: unexpected problem shape (n_in %d, out %d, ws %zu < %zu)\n", n_in, out_size, ws_size, (size_t)WS_END); grid = -1; return; }
        int dev = 0, cus = 0;
        if (hipGetDevice(&dev) != hipSuccess || hipDeviceGetAttribute(&cus, hipDeviceAttributeMultiprocessorCount, dev) != hipSuccess) { grid = -1; return; }
        if (hipFuncSetAttribute((const void*)fwd_kernel, hipFuncAttributeMaxDynamicSharedMemorySize, LDS_BYTES) != hipSuccess) { fprintf(stderr, "kernel_launch: hipFuncSetAttribute failed\n"); grid = -1; return; }
        int per_cu = 0;
        if (hipOccupancyMaxActiveBlocksPerMultiprocessor(&per_cu, (const void*)fwd_kernel, NTHR, LDS_BYTES) != hipSuccess || per_cu < 1) fprintf(stderr, "kernel_launch: occupancy query says %d\n", per_cu);
        (void)hipGetLastError();
        grid = cus;
    }
    if (grid < 0) return;
    (void)hipMemsetAsync((char*)d_ws + WS_CTL, 0, CTL_BYTES, stream);
    KArgs ka{};
    for (int i = 0; i < N_IN; ++i) ka.a.in[i] = (const float*)d_in[i];
    ka.a.out = (float*)d_out; ka.a.ws = (unsigned char*)d_ws;
#if MK_SINGLE
    ka.a.ph_lo = 0; ka.a.ph_hi = NPHASES; ka.li = 0; ka.pad = 0;
    hipLaunchKernelGGL(fwd_kernel, dim3(grid), dim3(NTHR), LDS_BYTES, stream, ka);
#else
    for (int ph = 0; ph < NPHASES; ++ph) { ka.a.ph_lo = ph; ka.a.ph_hi = ph + 1; ka.li = 0; ka.pad = 0; hipLaunchKernelGGL(fwd_kernel, dim3(grid), dim3(NTHR), LDS_BYTES, stream, ka); }
#endif
}
```

```cpp
#include <hip/hip_runtime.h>
#include <cstdio>
#include <cstdint>
#define DI __device__ __forceinline__
#define LAS __attribute__((address_space(3)))
typedef unsigned short bf16;
typedef float f32x4 __attribute__((ext_vector_type(4)));
typedef unsigned u32x4 __attribute__((ext_vector_type(4)));
typedef unsigned u32x2 __attribute__((ext_vector_type(2)));

constexpr int D = 2048, SEQ = 16384, CTXL = 256, MT = SEQ + CTXL  , DEPTH = 2;
constexpr int NCOLS_IN = 17440;
constexpr int ZC = 17664;
constexpr int Z_HG = 0, Z_GL = 5120, Z_HY = 8192, Z_MG = 11264, Z_LR = 17408;
constexpr int NEXP = 32, DFF = 512, MOE_MAXROWS = 41472;
constexpr float NORM_EPS = 1e-6f;

constexpr size_t MiB = 1u << 20;
constexpr size_t WS_CTL = 0, CTL_BYTES = 1 * MiB;
constexpr size_t WS_SMALL = 1 * MiB;
constexpr size_t WS_MOD   = WS_SMALL;
constexpr size_t WS_ZBIAS = WS_MOD + (size_t)DEPTH * 2 * 12288 * 4;
constexpr size_t WS_LB    = WS_ZBIAS + (size_t)DEPTH * ZC * 4;
constexpr size_t WS_TW    = WS_LB + (size_t)DEPTH * 2 * 1024 * 4;
constexpr size_t WS_TW2   = WS_TW + 16384 * 8;
constexpr size_t WS_H2    = WS_TW2 + (8192 + 64) * 8;
constexpr size_t WS_ROUTE = WS_H2 + (size_t)DEPTH * MT * 64 * 4;
constexpr size_t WS_ROWW  = WS_ROUTE + (size_t)MT * 8 * 4;
constexpr size_t WS_TILEE = WS_ROWW + (size_t)MOE_MAXROWS * 4;
constexpr size_t WS_HYC   = WS_TILEE + 1024;
constexpr size_t WS_SMALL_END = WS_HYC + (size_t)2048 * 256 * 4;
static_assert(WS_SMALL_END <= 40 * MiB, "small tables");
constexpr size_t WS_WIN  = 40 * MiB;
constexpr size_t WS_WBR  = 109 * MiB;
constexpr size_t WS_WOUT = 121 * MiB;
constexpr size_t WS_WGU  = 129 * MiB;
constexpr size_t WS_CVO  = WS_WIN;
constexpr size_t WS_WD   = 257 * MiB;
constexpr size_t WS_H    = 321 * MiB;
constexpr size_t WS_U    = 451 * MiB;
constexpr size_t WS_Z    = 516 * MiB;
constexpr size_t WS_XP   = WS_Z;
constexpr size_t WS_HMID = WS_Z + 162 * MiB;
constexpr size_t WS_YP   = WS_Z + 203 * MiB;
constexpr size_t WS_YMIX = 1077 * MiB;
constexpr size_t WS_OSC  = 1175 * MiB;
constexpr size_t WS_END  = 1435 * MiB;
static_assert(WS_WIN + (size_t)ZC * D * 2 <= WS_WBR && WS_Z + (size_t)MT * ZC * 2 <= WS_YMIX && WS_YMIX + (size_t)3 * MT * 1024 * 2 <= WS_OSC && WS_OSC + (size_t)4 * MT * 1024 * 4 <= WS_END, "ws map");
static_assert(WS_YP + (size_t)MOE_MAXROWS * D * 2 <= WS_YMIX && WS_H + (size_t)MT * D * 4 <= WS_U && WS_U + (size_t)MT * D * 2 <= WS_Z, "ws map 2");
constexpr int CW_BAR = 4096;
constexpr int CW_CNT = 16384;

DI float bf2f(bf16 v) { return __uint_as_float(((unsigned)v) << 16); }
DI float bflo(unsigned w) { return __uint_as_float(w << 16); }
DI float bfhi(unsigned w) { return __uint_as_float(w & 0xffff0000u); }
typedef float f32x2_t __attribute__((ext_vector_type(2))); typedef __bf16 bf16x2_t __attribute__((ext_vector_type(2)));
DI unsigned pk_bf16(float lo, float hi) { f32x2_t v = {lo, hi}; bf16x2_t b = __builtin_convertvector(v, bf16x2_t); return __builtin_bit_cast(unsigned, b); }
DI bf16 f2bf(float f) { return (bf16)(pk_bf16(f, 0.f) & 0xffffu); }
DI float sigmoidf_(float x) { return 1.0f / (1.0f + __expf(-x)); }
DI float siluf_(float x) { return x / (1.0f + __expf(-x)); }
DI float wave_sum(float v) {
#pragma unroll
    for (int o = 32; o >= 1; o >>= 1) v += __shfl_xor(v, o);
    return v;
}
DI int otid() { int t = __builtin_amdgcn_workitem_id_x(); asm volatile("" : "+v"(t)); return t; }
DI int obid() { int b = __builtin_amdgcn_workgroup_id_x(); asm volatile("" : "+s"(b)); return b; }
#define AIN_DECL 1
namespace pg8 {
#define PG8_LAS __attribute__((address_space(3)))
typedef unsigned short bf16_t;
typedef short bf16x8 __attribute__((ext_vector_type(8)));
typedef float f32x4 __attribute__((ext_vector_type(4)));
typedef unsigned u32x4 __attribute__((ext_vector_type(4)));
constexpr int BM = 256, BK = 64, HALF = 128, HTB = HALF * BK * 2  , STAGE_BYTES = 8 * HTB, NXCD = 8, WGM = 8;

__host__ __device__ __forceinline__ int lds_byte(int r, int c) { const int st = (r >> 4) * 2 + (c >> 5), rr = r & 15, cc = c & 31, ob = rr * 64 + cc * 2; return st * 1024 + (ob ^ (((ob >> 9) & 1) << 5)); }
__host__ __device__ __forceinline__ void stage_rc(int b, int& R, int& C) { const int st = b / 1024, sb = b % 1024, swz = sb ^ (((sb >> 9) & 1) << 5); R = (st >> 1) * 16 + swz / 64; C = (st & 1) * 32 + (swz % 64) / 2; }
__host__ __device__ __forceinline__ int perm32(int rho) { const int n = rho >> 4, i = rho & 15; return 8 * (i >> 2) + 4 * n + (i & 3); }

struct Unit { int pm, pn; };
struct Gemm { const bf16_t* A; const bf16_t* Bt; int M, N, K; };

struct StaticOrder {
    int nM, nN, nwg, G, c;
    __host__ __device__ void init(int M, int N, int G_, int c_) { nM = M / BM; nN = N / BM; nwg = nM * nN; G = G_; c = c_; }
    __host__ __device__ bool next(int i, Unit& u) const {
        const long L = (long)i * G + c; if (L >= nwg) return false;
        int wgid = (int)L; { const int q = nwg / NXCD, r = nwg % NXCD, xcd = wgid % NXCD, off = wgid / NXCD; wgid = (xcd < r ? xcd * (q + 1) : r * (q + 1) + (xcd - r) * q) + off; }
        const int nig = WGM * nN, gid = wgid / nig, fm = gid * WGM, gsz = (nM - fm) < WGM ? (nM - fm) : WGM;
        u.pm = fm + ((wgid % nig) % gsz); u.pn = (wgid % nig) / gsz; return true;
    }
    __device__ __forceinline__ void a_ready(const Unit&) const {}
    __device__ __forceinline__ void done(const Unit&) const {}
};

template <class Epi, class Sched, bool ALIGN_EPI = false, bool SP2 = false>
__device__ __forceinline__ void gemm_phase(PG8_LAS unsigned char* lds, const Gemm g, const Sched& S, const Epi& E) {
    const int tid = otid(), wid = __builtin_amdgcn_readfirstlane(tid >> 6), lane = tid & 63, wr = wid >> 2, wc = wid & 3, fr = lane & 15, fq = lane >> 4;
    const int K = g.K, nt = K / BK;
    unsigned voffA[2], voffB[2];
#pragma unroll
    for (int i = 0; i < 2; ++i) { int R, C; stage_rc(tid * 16 + i * 8192, R, C); const int Rb = Epi::PERM ? ((R & ~31) + perm32(R & 31)) : R;
        voffA[i] = (unsigned)(R * K + C) * 2u; voffB[i] = (unsigned)(Rb * K + C) * 2u; }
    const size_t kstep = (size_t)(BK * 2);
    const size_t hstep = (size_t)HALF * K * 2;
    const size_t tstep = 2 * hstep;
    const unsigned ldsw = (unsigned)wid * 1024u;
    const int aoff = lds_byte(wr * 64 + fr, fq * 8), boff = lds_byte(wc * 32 + fr, fq * 8);
#define PG8_SA(b, h) (((b) * 2 + (h)) * HTB)
#define PG8_SB(b, h) ((4 + (b) * 2 + (h)) * HTB)
#define PG8_STAGE(bufoff, gbase, voff) do { _Pragma("unroll") for (int _i = 0; _i < 2; ++_i) \
        __builtin_amdgcn_global_load_lds((const unsigned*)((const char*)(gbase) + (voff)[_i]), (PG8_LAS unsigned*)(lds + (bufoff) + ldsw + _i * 8192), 16, 0, 0); } while (0)
#define PG8_LDA(dst, b, h) do { _Pragma("unroll") for (int m = 0; m < 4; ++m) _Pragma("unroll") for (int k = 0; k < 2; ++k) dst[m][k] = *(const PG8_LAS bf16x8*)(lds + PG8_SA(b, h) + aoff + m * 2048 + k * 1024); } while (0)
#define PG8_LDB(dst, b, h) do { _Pragma("unroll") for (int n = 0; n < 2; ++n) _Pragma("unroll") for (int k = 0; k < 2; ++k) dst[n][k] = *(const PG8_LAS bf16x8*)(lds + PG8_SB(b, h) + boff + n * 2048 + k * 1024); } while (0)
#define PG8_MMA(ai, bj, At, Bt) do { __builtin_amdgcn_s_setprio(1); _Pragma("unroll") for (int m = 0; m < 4; ++m) _Pragma("unroll") for (int n = 0; n < 2; ++n) _Pragma("unroll") for (int k = 0; k < 2; ++k) \
        acc[ai][bj][m][n] = __builtin_amdgcn_mfma_f32_16x16x32_bf16(Bt[n][k], At[m][k], acc[ai][bj][m][n], 0, 0, 0); __builtin_amdgcn_s_setprio(0); } while (0)
#define PG8_WAIT_V(n) asm volatile("s_waitcnt vmcnt(" #n ")" ::: "memory")
#define PG8_WAIT_L(n) asm volatile("s_waitcnt lgkmcnt(" #n ")" ::: "memory")
#define PG8_BAR __builtin_amdgcn_s_barrier()
#define PG8_SCHED __builtin_amdgcn_sched_barrier(0)
    Unit cur, nxt; int ui = 0;
    if (!S.next(0, cur)) return;
    f32x4 acc[2][2][4][2];
#pragma unroll
    for (int a = 0; a < 2; ++a)
#pragma unroll
        for (int b = 0; b < 2; ++b)
#pragma unroll
            for (int m = 0; m < 4; ++m)
#pragma unroll
                for (int n = 0; n < 2; ++n) acc[a][b][m][n] = (f32x4){0.f, 0.f, 0.f, 0.f};
    bf16x8 At[4][2], B0[2][2], B1[2][2];
    const char* cA = (const char*)g.A + (size_t)cur.pm * tstep; const char* cB = (const char*)g.Bt + (size_t)cur.pn * tstep;
    S.a_ready(cur);
    if constexpr (SP2) {
        PG8_STAGE(PG8_SB(0, 0), cB, voffB); PG8_STAGE(PG8_SB(0, 1), cB + hstep, voffB); PG8_STAGE(PG8_SA(0, 0), cA, voffA); PG8_STAGE(PG8_SA(0, 1), cA + hstep, voffA);
        if (wr == 1) PG8_BAR;
        PG8_WAIT_V(2); PG8_BAR;
        PG8_STAGE(PG8_SB(1, 0), cB + kstep, voffB); PG8_STAGE(PG8_SA(1, 0), cA + kstep, voffA); PG8_STAGE(PG8_SB(1, 1), cB + hstep + kstep, voffB);
        PG8_WAIT_V(6); PG8_BAR;
    } else {
        PG8_STAGE(PG8_SB(0, 0), cB, voffB); PG8_STAGE(PG8_SA(0, 0), cA, voffA); PG8_STAGE(PG8_SB(0, 1), cB + hstep, voffB); PG8_STAGE(PG8_SA(0, 1), cA + hstep, voffA);
        if (wr == 1) PG8_BAR;
        PG8_WAIT_V(4); PG8_BAR;
        PG8_STAGE(PG8_SB(1, 0), cB + kstep, voffB); PG8_STAGE(PG8_SA(1, 0), cA + kstep, voffA); PG8_STAGE(PG8_SB(1, 1), cB + hstep + kstep, voffB);
        PG8_WAIT_V(6); PG8_BAR;
    }
    for (;;) {
        const bool has_next = S.next(ui + 1, nxt);
        const char* nA = has_next ? (const char*)g.A + (size_t)nxt.pm * tstep : cA; const char* nB = has_next ? (const char*)g.Bt + (size_t)nxt.pn * tstep : cB;
        for (int t = 0; t < nt; t += 2) {
            const bool last = (t == nt - 2);
            const char* a1 = cA + (size_t)(t + 1) * kstep;
            const char* a2 = last ? nA : cA + (size_t)(t + 2) * kstep; const char* b2 = last ? nB : cB + (size_t)(t + 2) * kstep;
            const char* a3 = a2 + kstep; const char* b3 = b2 + kstep;
            if (last && has_next) S.a_ready(nxt);
            if constexpr (SP2) {
            PG8_LDB(B0, 0, 0); PG8_LDB(B1, 0, 1); PG8_SCHED; PG8_LDA(At, 0, 0); PG8_STAGE(PG8_SA(1, 1), a1 + hstep, voffA);
            PG8_WAIT_V(8); PG8_WAIT_L(0); PG8_BAR; PG8_MMA(0, 0, At, B0); PG8_MMA(0, 1, At, B1); PG8_BAR; PG8_SCHED;
            PG8_LDA(At, 0, 1); PG8_STAGE(PG8_SB(0, 0), b2, voffB); PG8_STAGE(PG8_SB(0, 1), b2 + hstep, voffB); PG8_STAGE(PG8_SA(0, 0), a2, voffA);
            PG8_WAIT_V(8); PG8_WAIT_L(0); PG8_BAR; PG8_MMA(1, 0, At, B0); PG8_MMA(1, 1, At, B1); PG8_BAR; PG8_SCHED;
            PG8_LDB(B0, 1, 0); PG8_LDB(B1, 1, 1); PG8_SCHED; PG8_LDA(At, 1, 0); PG8_STAGE(PG8_SA(0, 1), a2 + hstep, voffA);
            PG8_WAIT_V(8); PG8_WAIT_L(0); PG8_BAR; PG8_MMA(0, 0, At, B0); PG8_MMA(0, 1, At, B1); PG8_BAR; PG8_SCHED;
            PG8_LDA(At, 1, 1); PG8_STAGE(PG8_SB(1, 0), b3, voffB); PG8_STAGE(PG8_SB(1, 1), b3 + hstep, voffB); PG8_STAGE(PG8_SA(1, 0), a3, voffA);
            PG8_WAIT_V(8); PG8_WAIT_L(0); PG8_BAR; PG8_MMA(1, 0, At, B0); PG8_MMA(1, 1, At, B1); PG8_BAR; PG8_SCHED;
            } else {
            PG8_LDB(B0, 0, 0); PG8_SCHED; PG8_LDA(At, 0, 0); PG8_STAGE(PG8_SA(1, 1), a1 + hstep, voffA);
            PG8_WAIT_L(8); PG8_BAR; PG8_WAIT_L(0); PG8_MMA(0, 0, At, B0); PG8_BAR; PG8_SCHED;
            PG8_LDB(B1, 0, 1); PG8_STAGE(PG8_SB(0, 0), b2, voffB);
            PG8_BAR; PG8_WAIT_L(0); PG8_MMA(0, 1, At, B1); PG8_BAR;
            PG8_LDA(At, 0, 1); PG8_STAGE(PG8_SA(0, 0), a2, voffA);
            PG8_BAR; PG8_WAIT_L(0); PG8_MMA(1, 0, At, B0); PG8_BAR; PG8_SCHED;
            PG8_STAGE(PG8_SB(0, 1), b2 + hstep, voffB);
            PG8_WAIT_V(6); PG8_BAR; PG8_MMA(1, 1, At, B1); PG8_BAR;
            PG8_LDB(B0, 1, 0); PG8_SCHED; PG8_LDA(At, 1, 0); PG8_STAGE(PG8_SA(0, 1), a2 + hstep, voffA);
            PG8_WAIT_L(8); PG8_BAR; PG8_WAIT_L(0); PG8_MMA(0, 0, At, B0); PG8_BAR; PG8_SCHED;
            PG8_LDB(B1, 1, 1); PG8_STAGE(PG8_SB(1, 0), b3, voffB);
            PG8_BAR; PG8_WAIT_L(0); PG8_MMA(0, 1, At, B1); PG8_BAR;
            PG8_LDA(At, 1, 1); PG8_STAGE(PG8_SA(1, 0), a3, voffA);
            PG8_BAR; PG8_WAIT_L(0); PG8_MMA(1, 0, At, B0); PG8_BAR; PG8_SCHED;
            PG8_STAGE(PG8_SB(1, 1), b3 + hstep, voffB);
            PG8_WAIT_V(6); PG8_BAR; PG8_MMA(1, 1, At, B1); PG8_BAR;
            }
        }
        if constexpr (ALIGN_EPI) { if (wr == 0) PG8_BAR; }
        if constexpr (!Epi::AFTER_DRAIN) { E(acc, cur, wr, wc, fr, fq); S.done(cur); }
        if (!has_next) break;
#pragma unroll
        for (int a = 0; a < 2; ++a)
#pragma unroll
            for (int b = 0; b < 2; ++b)
#pragma unroll
                for (int m = 0; m < 4; ++m)
#pragma unroll
                    for (int n = 0; n < 2; ++n) acc[a][b][m][n] = (f32x4){0.f, 0.f, 0.f, 0.f};
        cur = nxt; cA = nA; cB = nB; ++ui;
        if constexpr (ALIGN_EPI) { if (wr == 1) PG8_BAR; }
    }
    PG8_WAIT_V(0);
    if constexpr (!ALIGN_EPI) { if (wr == 0) PG8_BAR; }
    PG8_BAR;
    if constexpr (Epi::AFTER_DRAIN) { E.fused(acc, cur, wr, wc, fr, fq, lds, wid, lane); S.done(cur); }
#undef PG8_SA
#undef PG8_SB
#undef PG8_STAGE
#undef PG8_LDA
#undef PG8_LDB
#undef PG8_MMA
#undef PG8_WAIT_V
#undef PG8_WAIT_L
#undef PG8_BAR
#undef PG8_SCHED
}
}
#define XB_TMO      128
#define XB_XCNT(j)  (256  + 64 * (j))
#define XB_XSUB(j)  (1280 + 64 * (j))
#define XB_XGEN(j)  (2304 + 64 * (j))
#define XB_TOP      3328
#define XB_TOPGEN   3392
#define XCD_BAR_WORDS 3456
#define XB_SPIN_CAP (1u << 18)

__device__ __forceinline__ unsigned xb_ld(unsigned* p)              { return __hip_atomic_load(p, __ATOMIC_RELAXED, __HIP_MEMORY_SCOPE_AGENT); }
__device__ __forceinline__ unsigned xb_add(unsigned* p, unsigned v) { return __hip_atomic_fetch_add(p, v, __ATOMIC_RELAXED, __HIP_MEMORY_SCOPE_AGENT); }
__device__ __forceinline__ unsigned xb_xcc_id() { return (unsigned)__builtin_amdgcn_s_getreg((3 << 11) | 20) & 0xFu; }
#define XB_SPIN(cond, bar) do { unsigned _sp = 0; while (cond) { __builtin_amdgcn_s_sleep(1); \
    if ((++_sp & 255u) == 0u) { if (xb_ld(&(bar)[XB_TMO])) break; if (_sp > XB_SPIN_CAP) { atomicAdd(&(bar)[XB_TMO], 1u); break; } } } } while (0)

struct XcdBarrier {
    unsigned* bar; unsigned x;
    volatile LAS unsigned* st;
};

__device__ __forceinline__ XcdBarrier xcd_barrier_post(unsigned* bar, volatile LAS unsigned* st) {
    XcdBarrier b; b.bar = bar; b.x = xb_xcc_id(); b.st = st;
    if (otid() == 0) (void)xb_add(&bar[XB_XCNT(b.x)], 1u);
    return b;
}
__device__ __forceinline__ void xcd_barrier_complete(unsigned* bar, unsigned x, unsigned& nloc, unsigned& nx) {
    asm volatile("" : "+s"(x));
    const unsigned G = gridDim.x * gridDim.y * gridDim.z;
    unsigned sum, cnt, mine, sp = 0u;
    for (;;) {
        sum = 0u; cnt = 0u; mine = 0u;
#pragma unroll
        for (unsigned j = 0; j < 16; ++j) { const unsigned c = xb_ld(&bar[XB_XCNT(j)]); sum += c; cnt += (c > 0u) ? 1u : 0u; mine = (j == x) ? c : mine; }
        if (sum == G) break;
        __builtin_amdgcn_s_sleep(1);
        if ((++sp & 255u) == 0u) { if (xb_ld(&bar[XB_TMO])) break; if (sp > XB_SPIN_CAP) { atomicAdd(&bar[XB_TMO], 1u); break; } }
    }
    nloc = mine > 0u ? mine : 1u; nx = cnt > 0u ? cnt : 1u;
}

__device__ __forceinline__ void xcd_barrier(const XcdBarrier& b) {
    asm volatile("s_waitcnt vmcnt(0)" ::: "memory");
    __syncthreads();
    if (otid() == 0) {
        unsigned* bar = b.bar;
        __builtin_amdgcn_s_waitcnt(0);
        unsigned nloc = b.st[0], nx = b.st[1];
        if (nloc == 0u) { xcd_barrier_complete(bar, b.x, nloc, nx); b.st[0] = nloc; b.st[1] = nx; }
        const unsigned old = xb_add(&bar[XB_XSUB(b.x)], 1u);
        const unsigned gen = old / nloc;
        if (old + 1u == (gen + 1u) * nloc) {
            __builtin_amdgcn_fence(__ATOMIC_RELEASE, "agent");
            asm volatile("s_waitcnt vmcnt(0)" ::: "memory");
            const unsigned og = xb_add(&bar[XB_TOP], 1u);
            const unsigned tg = og / nx;
            if (og + 1u == (tg + 1u) * nx) xb_add(&bar[XB_TOPGEN], 1u);
            else XB_SPIN(xb_ld(&bar[XB_TOPGEN]) == tg, bar);
            __builtin_amdgcn_fence(__ATOMIC_ACQUIRE, "agent");
            xb_add(&bar[XB_XGEN(b.x)], 1u);
            asm volatile("s_waitcnt vmcnt(0)" ::: "memory");
        } else {
            XB_SPIN(xb_ld(&bar[XB_XGEN(b.x)]) == gen, bar);
            __builtin_amdgcn_fence(__ATOMIC_ACQUIRE, "agent");
            asm volatile("s_waitcnt vmcnt(0)" ::: "memory");
        }
    }
    __syncthreads();
}

#define FFT_DI DI
#define FFT_M 16384
#define FFT_NT 512
struct cpx { float x, y; };
FFT_DI cpx cmul(cpx a, cpx b) { cpx r; r.x = a.x * b.x - a.y * b.y; r.y = a.x * b.y + a.y * b.x; return r; }
FFT_DI cpx cmulc(cpx a, cpx b) { cpx r; r.x = a.x * b.x + a.y * b.y; r.y = a.y * b.x - a.x * b.y; return r; }
FFT_DI int rev4_14(int k) {
    int r = 0;
#pragma unroll
    for (int d = 0; d < 7; ++d) { r = (r << 2) | (k & 3); k >>= 2; }
    return r;
}
template <class LP, class TP> FFT_DI void fft_fwd_pass(LP lds, TP tw, int s, int tid) {
    const int tws = FFT_M / (4 * s);
#pragma unroll 2
    for (int b = tid; b < FFT_M / 4; b += FFT_NT) {
        const int pos = b % s, base = (b / s) * 4 * s + pos;
        cpx a0, a1, a2, a3;
        a0.x = lds[2 * base]; a0.y = lds[2 * base + 1];
        a1.x = lds[2 * (base + s)]; a1.y = lds[2 * (base + s) + 1];
        a2.x = lds[2 * (base + 2 * s)]; a2.y = lds[2 * (base + 2 * s) + 1];
        a3.x = lds[2 * (base + 3 * s)]; a3.y = lds[2 * (base + 3 * s) + 1];
        cpx t0, t1, t2, t3;
        t0.x = a0.x + a2.x; t0.y = a0.y + a2.y;
        t1.x = a0.x - a2.x; t1.y = a0.y - a2.y;
        t2.x = a1.x + a3.x; t2.y = a1.y + a3.y;
        t3.x = a1.x - a3.x; t3.y = a1.y - a3.y;
        cpx y0, y1, y2, y3;
        y0.x = t0.x + t2.x; y0.y = t0.y + t2.y;
        y2.x = t0.x - t2.x; y2.y = t0.y - t2.y;
        y1.x = t1.x + t3.y; y1.y = t1.y - t3.x;
        y3.x = t1.x - t3.y; y3.y = t1.y + t3.x;
        if (s > 1) {
            cpx w1, w2, w3;
            w1.x = tw[2 * (pos * tws)]; w1.y = tw[2 * (pos * tws) + 1];
            w2.x = tw[2 * (2 * pos * tws)]; w2.y = tw[2 * (2 * pos * tws) + 1];
            w3.x = tw[2 * (3 * pos * tws)]; w3.y = tw[2 * (3 * pos * tws) + 1];
            y1 = cmul(y1, w1); y2 = cmul(y2, w2); y3 = cmul(y3, w3);
        }
        lds[2 * base] = y0.x; lds[2 * base + 1] = y0.y;
        lds[2 * (base + s)] = y1.x; lds[2 * (base + s) + 1] = y1.y;
        lds[2 * (base + 2 * s)] = y2.x; lds[2 * (base + 2 * s) + 1] = y2.y;
        lds[2 * (base + 3 * s)] = y3.x; lds[2 * (base + 3 * s) + 1] = y3.y;
    }
}
template <class LP, class TP> FFT_DI void fft_inv_pass(LP lds, TP tw, int s, int tid) {
    const int tws = FFT_M / (4 * s);
#pragma unroll 2
    for (int b = tid; b < FFT_M / 4; b += FFT_NT) {
        const int pos = b % s, base = (b / s) * 4 * s + pos;
        cpx b0, c1, c2, c3;
        b0.x = lds[2 * base]; b0.y = lds[2 * base + 1];
        c1.x = lds[2 * (base + s)]; c1.y = lds[2 * (base + s) + 1];
        c2.x = lds[2 * (base + 2 * s)]; c2.y = lds[2 * (base + 2 * s) + 1];
        c3.x = lds[2 * (base + 3 * s)]; c3.y = lds[2 * (base + 3 * s) + 1];
        if (s > 1) {
            cpx w1, w2, w3;
            w1.x = tw[2 * (pos * tws)]; w1.y = tw[2 * (pos * tws) + 1];
            w2.x = tw[2 * (2 * pos * tws)]; w2.y = tw[2 * (2 * pos * tws) + 1];
            w3.x = tw[2 * (3 * pos * tws)]; w3.y = tw[2 * (3 * pos * tws) + 1];
            c1 = cmulc(c1, w1); c2 = cmulc(c2, w2); c3 = cmulc(c3, w3);
        }
        cpx t0, t1, t2, t3;
        t0.x = b0.x + c2.x; t0.y = b0.y + c2.y;
        t1.x = b0.x - c2.x; t1.y = b0.y - c2.y;
        t2.x = c1.x + c3.x; t2.y = c1.y + c3.y;
        t3.x = c1.x - c3.x; t3.y = c1.y - c3.y;
        cpx x0, x1, x2, x3;
        x0.x = t0.x + t2.x; x0.y = t0.y + t2.y;
        x2.x = t0.x - t2.x; x2.y = t0.y - t2.y;
        x1.x = t1.x - t3.y; x1.y = t1.y + t3.x;
        x3.x = t1.x + t3.y; x3.y = t1.y - t3.x;
        lds[2 * base] = x0.x; lds[2 * base + 1] = x0.y;
        lds[2 * (base + s)] = x1.x; lds[2 * (base + s) + 1] = x1.y;
        lds[2 * (base + 2 * s)] = x2.x; lds[2 * (base + 2 * s) + 1] = x2.y;
        lds[2 * (base + 3 * s)] = x3.x; lds[2 * (base + 3 * s) + 1] = x3.y;
    }
}
template <class LP, class TP> FFT_DI void rfft_untangle(LP lds, TP tw2, int k, cpx& Xk, cpx& Xm) {
    if (k == 0) {
        const float zr = lds[0], zi = lds[1];
        Xk.x = zr + zi; Xk.y = zr - zi;
        const int p = rev4_14(FFT_M / 2);
        Xm.x = lds[2 * p]; Xm.y = -lds[2 * p + 1];
        return;
    }
    const int pk = rev4_14(k), pm = rev4_14(FFT_M - k);
    cpx Zk, Zm; Zk.x = lds[2 * pk]; Zk.y = lds[2 * pk + 1]; Zm.x = lds[2 * pm]; Zm.y = lds[2 * pm + 1];
    cpx E, O, W, WO;
    E.x = 0.5f * (Zk.x + Zm.x); E.y = 0.5f * (Zk.y - Zm.y);
    O.x = 0.5f * (Zk.y + Zm.y); O.y = -0.5f * (Zk.x - Zm.x);
    W.x = tw2[2 * k]; W.y = tw2[2 * k + 1];
    WO = cmul(W, O);
    Xk.x = E.x + WO.x; Xk.y = E.y + WO.y;
    Xm.x = E.x - WO.x; Xm.y = -(E.y - WO.y);
}
template <class LP, class TP> FFT_DI void rfft_mul_retangle(LP lds, TP tw2, int k, cpx Gk, cpx Gm) {
    cpx Xk, Xm; rfft_untangle(lds, tw2, k, Xk, Xm);
    if (k == 0) {
        const float y0 = Xk.x * Gk.x, yM = Xk.y * Gk.y;
        lds[0] = 0.5f * (y0 + yM); lds[1] = 0.5f * (y0 - yM);
        const cpx Y = cmul(Xm, Gm);
        const int p = rev4_14(FFT_M / 2);
        lds[2 * p] = Y.x; lds[2 * p + 1] = -Y.y;
        return;
    }
    const cpx Yk = cmul(Xk, Gk), Ym = cmul(Xm, Gm);
    cpx W; W.x = tw2[2 * k]; W.y = tw2[2 * k + 1];
    cpx A, D, T;
    A.x = 0.5f * (Yk.x + Ym.x); A.y = 0.5f * (Yk.y - Ym.y);
    D.x = 0.5f * (Yk.x - Ym.x); D.y = 0.5f * (Yk.y + Ym.y);
    T = cmulc(D, W);
    const int pk = rev4_14(k), pm = rev4_14(FFT_M - k);
    lds[2 * pk] = A.x - T.y; lds[2 * pk + 1] = A.y + T.x;
    cpx Dc; Dc.x = -D.x; Dc.y = D.y;
    const cpx T2 = cmul(W, Dc);
    lds[2 * pm] = A.x + T2.y; lds[2 * pm + 1] = -A.y - T2.x;
}
enum { I_X = 0, I_C, I_CTX, I_CCTX, I_WMOD, I_BMOD, I_NMIXW, I_NFFNW, I_WIN, I_BIN, I_HYCW, I_HYCB, I_HYW1, I_HYB1, I_HYW2, I_HYB2, I_HYW3, I_HYB3, I_HYFREQ, I_HYSKIP,
       I_HGLB, I_HGNW, I_GLWA2, I_GLBA, I_GLNW, I_WBR, I_WOUT, I_WRG, I_BRG, I_WRE, I_BRE, I_WGATE, I_WUP, I_WDOWN, I_FNW, N_IN };
struct Args { const float* in[N_IN]; float* out; unsigned char* ws; int ph_lo, ph_hi; };
extern __shared__ __attribute__((aligned(16))) unsigned char lds_raw[];
constexpr int LDS_PTAB = 150 * 1024 - 64 - 320;
DI LAS unsigned char* ldsbase() { unsigned p = (unsigned)(unsigned long long)(LAS unsigned char*)lds_raw; asm volatile("" : "+s"(p)); return (LAS unsigned char*)(unsigned long long)p; }
DI const float* ain(const Args&, int i) { const unsigned long long v = ((LAS unsigned long long*)(ldsbase() + LDS_PTAB))[i];
    const unsigned lo = __builtin_amdgcn_readfirstlane((unsigned)v), hi = __builtin_amdgcn_readfirstlane((unsigned)(v >> 32)); return (const float*)(((unsigned long long)hi << 32) | lo); }
DI unsigned char* wsp(const Args& a) { unsigned long long p = (unsigned long long)(a).ws; asm volatile("" : "+s"(p)); return (unsigned char*)p; }
DI int opq(int x) { asm volatile("" : "+s"(x)); return x; }
constexpr int NTHR = 512;
constexpr int LDS_BYTES = 150 * 1024;
constexpr int LDS_X = 131072;
constexpr int LDS_BARW = LDS_BYTES - 64;

DI int z_srccol(int zc) { return zc < 8192 ? zc : (zc < Z_LR ? zc + 32 : (zc < Z_LR + 32 ? zc - Z_LR + 8192 : -1)); }

DI void cvt_tile(const float* __restrict__ src, size_t ld, int sc, bf16* __restrict__ dst, int K, int row0, int kb, LAS float* t) {
    const int tid = otid(), nn = tid & 63, kk = tid >> 6;
#pragma unroll
    for (int p = 0; p < 8; ++p) { const int k = kb * 64 + p * 8 + kk; t[(p * 8 + kk) * 65 + nn] = sc >= 0 ? src[(size_t)k * ld + sc] : 0.f; }
    __syncthreads();
    const int rr = tid >> 3, k8 = tid & 7; float v[8];
#pragma unroll
    for (int j = 0; j < 8; ++j) v[j] = t[(k8 * 8 + j) * 65 + rr];
    u32x4 w; w.x = pk_bf16(v[0], v[1]); w.y = pk_bf16(v[2], v[3]); w.z = pk_bf16(v[4], v[5]); w.w = pk_bf16(v[6], v[7]);
    *(u32x4*)(dst + (size_t)(row0 + rr) * K + kb * 64 + k8 * 8) = w;
    __syncthreads();
}
constexpr int CVT_MIX_TILES = 276 * 32 + 3 * 32 * 16 + 32 * 32;
DI void cvt_mix_item(const Args& a, int l, int it, LAS float* t) {
    const int nn = otid() & 63;
    if (it < 276 * 32) { const int nb = it >> 5, kb = it & 31; cvt_tile(ain(a, I_WIN) + (size_t)l * D * NCOLS_IN, NCOLS_IN, z_srccol(nb * 64 + nn), (bf16*)(wsp(a) + WS_WIN), D, nb * 64, kb, t); return; }
    it -= 276 * 32;
    if (it < 3 * 32 * 16) { const int br = it / 512, r = it % 512, nb = r >> 4, kb = r & 15;
        cvt_tile(ain(a, I_WBR) + ((size_t)l * 3 + br) * 1024 * D, D, nb * 64 + nn, (bf16*)(wsp(a) + WS_WBR) + (size_t)br * D * 1024, 1024, nb * 64, kb, t); return; }
    it -= 3 * 32 * 16;
    { const int nb = it >> 5, kb = it & 31; cvt_tile(ain(a, I_WOUT) + (size_t)l * D * D, D, nb * 64 + nn, (bf16*)(wsp(a) + WS_WOUT), D, nb * 64, kb, t); }
}
constexpr int CVT_MOE_TILES = 32 * 16 * 32 + 32 * 32 * 8;
DI void cvt_moe_item(const Args& a, int l, int it, LAS float* t) {
    const int nn = otid() & 63;
    if (it < 32 * 16 * 32) { const int e = it >> 9, r = it & 511, nb = r >> 5, kb = r & 31, nt = nb >> 2, sub = nb & 3;
        const float* src = (sub < 2 ? ain(a, I_WGATE) : ain(a, I_WUP)) + ((size_t)l * NEXP + e) * D * DFF;
        cvt_tile(src, DFF, nt * 128 + (sub & 1) * 64 + nn, (bf16*)(wsp(a) + WS_WGU) + (size_t)e * 1024 * D, D, nb * 64, kb, t); return; }
    it -= 32 * 16 * 32;
    { const int e = it >> 8, r = it & 255, nb = r >> 3, kb = r & 7;
      cvt_tile(ain(a, I_WDOWN) + ((size_t)l * NEXP + e) * DFF * D, D, nb * 64 + nn, (bf16*)(wsp(a) + WS_WD) + (size_t)e * D * DFF, DFF, nb * 64, kb, t); }
}

DI void mod_item(const Args& a, int j, LAS float* lds) {
    const int tid = otid(), l = j >> 7, col0 = (j & 127) * 96;
    LAS float* sil = lds;
    LAS float* red = lds + 4096;
    for (int k = tid; k < 2 * D; k += NTHR) { const float c = (k < D) ? ain(a, I_C)[k] : ain(a, I_CCTX)[k - D]; sil[k] = siluf_(c); }
    __syncthreads();
    const int cg = tid % 24, rg = tid / 24;
    f32x4 a0 = {0.f, 0.f, 0.f, 0.f}, a1 = {0.f, 0.f, 0.f, 0.f};
    if (rg < 21) {
        const float* w = ain(a, I_WMOD) + (size_t)l * D * 12288 + col0 + cg * 4;
        for (int k = rg; k < D; k += 21) { const f32x4 wv = *(const f32x4*)(w + (size_t)k * 12288); a0 += wv * sil[k]; a1 += wv * sil[D + k]; }
#pragma unroll
        for (int q = 0; q < 4; ++q) { red[(rg * 2 + 0) * 96 + cg * 4 + q] = a0[q]; red[(rg * 2 + 1) * 96 + cg * 4 + q] = a1[q]; }
    }
    __syncthreads();
    if (tid < 192) { const int set = tid / 96, c = tid % 96; float s = 0.f;
        for (int r = 0; r < 21; ++r) s += red[(r * 2 + set) * 96 + c];
        ((float*)(wsp(a) + WS_MOD))[((size_t)l * 2 + set) * 12288 + col0 + c] = s + ain(a, I_BMOD)[(size_t)l * 12288 + col0 + c]; }
    __syncthreads();
}
DI void h2_item(const Args& a, int it, LAS float* lds) {
    const int tid = otid(), l = it / (MT / 8), r0 = (it % (MT / 8)) * 8;
    LAS float* feats = lds;
    LAS float* h1 = lds + 8 * 36;
    if (tid < 8 * 33) { const int rr = tid / 33, i = tid % 33, r = r0 + rr; const int Lq = r < SEQ ? SEQ : CTXL, t = r < SEQ ? r : r - SEQ;
        float f;
        if (i == 0) f = (float)t / (float)(Lq - 1);
        else { const int bi = (i - 1) & 15; const float band = 1e-4f + (float)bi * ((15.0f - 1e-4f) / 15.0f); const float rev2 = 2.0f * band * (float)t / (float)Lq;
            f = (i <= 16) ? cospif(rev2) : -sinpif(rev2); }
        feats[rr * 36 + i] = f; }
    __syncthreads();
    const int rr = tid >> 6, j = tid & 63;
    { const float* w1 = ain(a, I_HYW1) + (size_t)l * 33 * 64; float s = ain(a, I_HYB1)[l * 64 + j];
      for (int i = 0; i < 33; ++i) s += feats[rr * 36 + i] * w1[i * 64 + j];
      h1[rr * 64 + j] = sinf(ain(a, I_HYFREQ)[l * 64 + j] * s); }
    __syncthreads();
    { const float* w2 = ain(a, I_HYW2) + (size_t)l * 64 * 64; float s = ain(a, I_HYB2)[l * 64 + j];
      for (int i = 0; i < 64; ++i) s += h1[rr * 64 + i] * w2[i * 64 + j];
      ((float*)(wsp(a) + WS_H2))[((size_t)l * MT + r0 + rr) * 64 + j] = sinf(ain(a, I_HYFREQ)[l * 64 + j] * s); }
    __syncthreads();
}
DI void prologue_small(const Args& a) {
    const size_t gt = (size_t)obid() * NTHR + otid(), gs = (size_t)gridDim.x * NTHR;
    float* zb = (float*)(wsp(a) + WS_ZBIAS);
    for (size_t i = gt; i < (size_t)DEPTH * ZC; i += gs) { const int l = (int)(i / ZC), zc = (int)(i % ZC), sc = z_srccol(zc); zb[i] = sc >= 0 ? ain(a, I_BIN)[(size_t)l * NCOLS_IN + sc] : 0.f; }
    float* lb = (float*)(wsp(a) + WS_LB);
    for (size_t i = gt; i < (size_t)DEPTH * 2048; i += gs) { const int l = (int)(i / 2048), j = (int)(i % 2048);
        float v = 0.f; if (l == 1) { const float r0 = ain(a, I_HGLB)[j], r1 = ain(a, I_HGLB)[2048 + j]; v = 1.0f / (1.0f + expf(r0 - r1)); }
        lb[i] = v; }
    float* tw = (float*)(wsp(a) + WS_TW);
    for (size_t i = gt; i < 16384; i += gs) { float s, c; sincospif(-2.0f * (float)i / 16384.0f, &s, &c); tw[2 * i] = c; tw[2 * i + 1] = s; }
    float* tw2 = (float*)(wsp(a) + WS_TW2);
    for (size_t i = gt; i <= 8192; i += gs) { float s, c; sincospif(-(float)i / 16384.0f, &s, &c); tw2[2 * i] = c; tw2[2 * i + 1] = s; }
}
DI void hyc_filters(const Args& a, int l) {
    const int lane = otid() & 63, wave = otid() >> 6;
    const float* h2 = (const float*)(wsp(a) + WS_H2) + ((size_t)l * MT + SEQ) * 64;
    const float* w3 = ain(a, I_HYW3) + (size_t)l * 64 * 2048;
    float* hyc = (float*)(wsp(a) + WS_HYC);
    const float a0 = -4.605170186f / 1.5f, a1 = -4.605170186f / 0.3f;
    for (int fc = obid() * 8 + wave; fc < 2048; fc += gridDim.x * 8) {
        const int c = fc & 1023; const float delta = fabsf(a0 + (float)c * ((a1 - a0) / 1023.0f)); const float b3 = ain(a, I_HYB3)[l * 2048 + fc];
        float hv[4], ssum = 0.f;
#pragma unroll
        for (int i = 0; i < 4; ++i) { const int t = lane + 64 * i; float s = b3;
            for (int j = 0; j < 64; ++j) s += h2[t * 64 + j] * w3[j * 2048 + fc];
            const float tl = (float)t / 255.0f; hv[i] = s * (expf(-tl * delta) + 0.05f); ssum += fabsf(hv[i]); }
        ssum = wave_sum(ssum); const float inv = 1.0f / ssum;
#pragma unroll
        for (int i = 0; i < 4; ++i) hyc[(size_t)fc * 256 + lane + 64 * i] = hv[i] * inv;
    }
}
template <int MODE> DI void norm_phase(const Args& a, int l, int nrows, LAS float* ldsf) {
    const int lane = otid() & 63, wave = otid() >> 6;
    float* H = (float*)(wsp(a) + WS_H); bf16* U = (bf16*)(wsp(a) + WS_U);
    const float* modall = (const float*)(wsp(a) + WS_MOD);
    int* route = (int*)(wsp(a) + WS_ROUTE);
    const bf16* YP = (const bf16*)(wsp(a) + WS_YP);
    const bool combine = (MODE == 0 && l > 0) || MODE == 2;
    for (int r = obid() * 8 + wave; r < nrows; r += gridDim.x * 8) {
        const int set = r >= SEQ ? 1 : 0;
        const float* src = (MODE == 0 && l == 0) ? (set ? ain(a, I_CTX) + (size_t)(r - SEQ) * D : ain(a, I_X) + (size_t)r * D) : H + (size_t)r * D;
        f32x4 v[8];
#pragma unroll
        for (int j = 0; j < 8; ++j) v[j] = *(const f32x4*)(src + j * 256 + lane * 4);
        if (combine) {
            const float* gt2 = modall + ((size_t)(l - 1) * 2 + set) * 12288 + 10240;
            const int p0 = route[r * 8 + 6], p1 = route[r * 8 + 7];
#pragma unroll
            for (int j = 0; j < 8; ++j) { const int col = j * 256 + lane * 4;
                const u32x2 y0 = *(const u32x2*)(YP + (size_t)p0 * D + col), y1 = *(const u32x2*)(YP + (size_t)p1 * D + col); const f32x4 g = *(const f32x4*)(gt2 + col);
                v[j][0] += g[0] * (bflo(y0.x) + bflo(y1.x)); v[j][1] += g[1] * (bfhi(y0.x) + bfhi(y1.x)); v[j][2] += g[2] * (bflo(y0.y) + bflo(y1.y)); v[j][3] += g[3] * (bfhi(y0.y) + bfhi(y1.y)); }
            if (MODE == 0) {
#pragma unroll
                for (int j = 0; j < 8; ++j) *(f32x4*)(H + (size_t)r * D + j * 256 + lane * 4) = v[j];
            }
        }
        float ss = 0.f;
#pragma unroll
        for (int j = 0; j < 8; ++j) ss += (v[j][0] * v[j][0] + v[j][1] * v[j][1]) + (v[j][2] * v[j][2] + v[j][3] * v[j][3]);
        ss = wave_sum(ss);
        const float rstd = rsqrtf(ss * (1.0f / D) + NORM_EPS);
        if (MODE == 2) {
            const float* fw = ain(a, I_FNW);
#pragma unroll
            for (int j = 0; j < 8; ++j) { const int col = j * 256 + lane * 4; const f32x4 w = *(const f32x4*)(fw + col); *(f32x4*)(a.out + (size_t)r * D + col) = v[j] * rstd * w; }
        } else {
            const float* nw = (MODE == 0 ? ain(a, I_NMIXW) : ain(a, I_NFFNW)) + (size_t)l * D;
            const float* md = modall + ((size_t)l * 2 + set) * 12288 + (MODE == 0 ? 0 : 6144);
#pragma unroll
            for (int j = 0; j < 8; ++j) { const int col = j * 256 + lane * 4; const f32x4 w = *(const f32x4*)(nw + col), sh = *(const f32x4*)(md + col), sc = *(const f32x4*)(md + 2048 + col);
                v[j] = (v[j] * rstd * w) * (sc + 1.0f) + sh;
                u32x2 o; o.x = pk_bf16(v[j][0], v[j][1]); o.y = pk_bf16(v[j][2], v[j][3]); *(u32x2*)(U + (size_t)r * D + col) = o; }
            if (MODE == 1) {
                const float* wrg = ain(a, I_WRG) + (size_t)l * D * 4; const float* wre = ain(a, I_WRE) + (size_t)l * D * 32;
                float lg[36];
#pragma unroll
                for (int i = 0; i < 36; ++i) lg[i] = 0.f;
                LAS float* wu = ldsf + wave * 2048;
#pragma unroll
                for (int j = 0; j < 8; ++j) *(LAS f32x4*)(wu + j * 256 + lane * 4) = v[j];
                asm volatile("s_waitcnt lgkmcnt(0)" ::: "memory");
#pragma unroll 2
                for (int cc = 0; cc < 32; ++cc) { const int col = cc * 64 + lane; const float uv = wu[col];
                    const f32x4 g = *(const f32x4*)(wrg + (size_t)col * 4);
                    lg[0] += uv * g[0]; lg[1] += uv * g[1]; lg[2] += uv * g[2]; lg[3] += uv * g[3];
#pragma unroll
                    for (int e4 = 0; e4 < 8; ++e4) { const f32x4 w = *(const f32x4*)(wre + (size_t)col * 32 + e4 * 4);
                        lg[4 + e4 * 4 + 0] += uv * w[0]; lg[4 + e4 * 4 + 1] += uv * w[1]; lg[4 + e4 * 4 + 2] += uv * w[2]; lg[4 + e4 * 4 + 3] += uv * w[3]; } }
                asm volatile("s_waitcnt lgkmcnt(0)" ::: "memory");
#pragma unroll
                for (int i = 0; i < 36; ++i) lg[i] = wave_sum(lg[i]);
                float gl[4]; int grp = 0; float gmax;
#pragma unroll
                for (int g = 0; g < 4; ++g) gl[g] = lg[g] + ain(a, I_BRG)[l * 4 + g];
                gmax = gl[0];
#pragma unroll
                for (int g = 1; g < 4; ++g) if (gl[g] > gmax) { gmax = gl[g]; grp = g; }
                float gden = 0.f;
#pragma unroll
                for (int g = 0; g < 4; ++g) gden += expf(gl[g] - gmax);
                const float ptop = 1.0f / gden;
                float le[8];
#pragma unroll
                for (int i = 0; i < 8; ++i) { float x = lg[4 + i];
#pragma unroll
                    for (int g = 1; g < 4; ++g) x = (grp == g) ? lg[4 + g * 8 + i] : x;
                    le[i] = x + ain(a, I_BRE)[l * 32 + grp * 8 + i]; }
                int i0 = 0; float m0 = le[0];
#pragma unroll
                for (int i = 1; i < 8; ++i) if (le[i] > m0) { m0 = le[i]; i0 = i; }
                int i1 = -1; float m1 = -3.0e38f;
#pragma unroll
                for (int i = 0; i < 8; ++i) if (i != i0 && le[i] > m1) { m1 = le[i]; i1 = i; }
                const float e1v = expf(m1 - m0);
                const float w0 = ptop / (1.0f + e1v), w1 = ptop * e1v / (1.0f + e1v);
                if (lane == 0) {
                    unsigned* cnt = (unsigned*)(wsp(a) + WS_CTL) + CW_CNT + l * 64;
                    const int ex0 = grp * 8 + i0, ex1 = grp * 8 + i1;
                    const unsigned s0 = atomicAdd(cnt + ex0, 1u), s1 = atomicAdd(cnt + ex1, 1u);
                    route[r * 8 + 0] = ex0; route[r * 8 + 1] = ex1; route[r * 8 + 2] = (int)s0; route[r * 8 + 3] = (int)s1;
                    route[r * 8 + 4] = __float_as_int(w0); route[r * 8 + 5] = __float_as_int(w1);
                }
            }
        }
    }
}
DI void permute_phase(const Args& a, int l, int nrows, LAS unsigned char* ldsb) {
    LAS int* poff = (LAS int*)ldsb;
    const int tid = otid(), lane = tid & 63, wave = tid >> 6;
    const unsigned* cnt = (const unsigned*)(wsp(a) + WS_CTL) + CW_CNT + l * 64;
    if (tid == 0) { int off = 0; for (int e = 0; e < NEXP; ++e) { poff[e] = off; off += (int)((cnt[e] + 255u) / 256u) * 256; } poff[32] = off; }
    __syncthreads();
    if (obid() == 0) { int* tile_e = (int*)(wsp(a) + WS_TILEE); const int nt = poff[32] >> 8;
        if (tid < 200) { int e = -1; if (tid < nt) { for (int q = 0; q < NEXP; ++q) if (poff[q] <= tid * 256) e = q; } tile_e[tid] = e < 0 ? 0 : e; }
        if (tid == 0) tile_e[200] = nt; }
    int* route = (int*)(wsp(a) + WS_ROUTE); float* roww = (float*)(wsp(a) + WS_ROWW);
    const bf16* U = (const bf16*)(wsp(a) + WS_U); bf16* XP = (bf16*)(wsp(a) + WS_XP);
    for (int r = obid() * 8 + wave; r < nrows; r += gridDim.x * 8) {
        const int e0 = route[r * 8 + 0], e1 = route[r * 8 + 1], s0 = route[r * 8 + 2], s1 = route[r * 8 + 3];
        const int p0 = poff[e0] + s0, p1 = poff[e1] + s1;
        u32x4 x[4];
#pragma unroll
        for (int i = 0; i < 4; ++i) x[i] = *(const u32x4*)(U + (size_t)r * D + (i * 64 + lane) * 8);
#pragma unroll
        for (int i = 0; i < 4; ++i) { *(u32x4*)(XP + (size_t)p0 * D + (i * 64 + lane) * 8) = x[i]; *(u32x4*)(XP + (size_t)p1 * D + (i * 64 + lane) * 8) = x[i]; }
        if (lane == 0) { route[r * 8 + 6] = p0; route[r * 8 + 7] = p1; roww[p0] = __int_as_float(route[r * 8 + 4]); roww[p1] = __int_as_float(route[r * 8 + 5]); }
    }
}
DI int stream_row(int p, int dir) { return dir == 0 ? (p < CTXL ? SEQ + p : p - CTXL) : (p < CTXL ? SEQ + (CTXL - 1 - p) : (SEQ - 1) - (p - CTXL)); }

DI void shortconv8(const bf16* Z, const float* cw, const float* cb, int l, int seg, int c, int r0, int lo, int hi, float (&out)[8]) {
    const int col = Z_HY + seg * 1024 + c; float zz[10];
#pragma unroll
    for (int i = 0; i < 10; ++i) { const int r = r0 - 1 + i; zz[i] = (r >= lo && r < hi) ? bf2f(Z[(size_t)r * ZC + col]) : 0.f; }
    const float w0 = cw[((size_t)l * 3 + 0) * 3072 + seg * 1024 + c], w1 = cw[((size_t)l * 3 + 1) * 3072 + seg * 1024 + c], w2 = cw[((size_t)l * 3 + 2) * 3072 + seg * 1024 + c], b = cb[(size_t)l * 3072 + seg * 1024 + c];
#pragma unroll
    for (int i = 0; i < 8; ++i) out[i] = w0 * zz[i] + w1 * zz[i + 1] + w2 * zz[i + 2] + b;
}
DI void hyprep_item(const Args& a, int l, int it, LAS float* t) {
    const int tid = otid(), tb = it >> 4, cb = it & 15, r0 = tb * 64, lo = r0 < SEQ ? 0 : SEQ, hi = r0 < SEQ ? SEQ : MT;
    const bf16* Z = (const bf16*)(wsp(a) + WS_Z); float* VXT = (float*)(wsp(a) + WS_U);
    { const int cc = tid & 63, tq = tid >> 6, c = cb * 64 + cc; float x1[8], vv[8];
      shortconv8(Z, ain(a, I_HYCW), ain(a, I_HYCB), l, 1, c, r0 + tq * 8, lo, hi, x1); shortconv8(Z, ain(a, I_HYCW), ain(a, I_HYCB), l, 2, c, r0 + tq * 8, lo, hi, vv);
#pragma unroll
      for (int i = 0; i < 8; ++i) t[cc * 65 + tq * 8 + i] = vv[i] * x1[i]; }
    __syncthreads();
    { const int cw = tid >> 3, t8 = tid & 7; f32x4 o0, o1;
#pragma unroll
      for (int i = 0; i < 4; ++i) { o0[i] = t[cw * 65 + t8 * 8 + i]; o1[i] = t[cw * 65 + t8 * 8 + 4 + i]; }
      float* dst = VXT + (size_t)(cb * 64 + cw) * MT + r0 + t8 * 8; *(f32x4*)dst = o0; *(f32x4*)(dst + 4) = o1; }
    __syncthreads();
}
DI void hycomb_item(const Args& a, int l, int it, LAS float* t) {
    const int tid = otid(), tb = it >> 4, cb = it & 15, r0 = tb * 64, lo = r0 < SEQ ? 0 : SEQ, hi = r0 < SEQ ? SEQ : MT;
    const bf16* Z = (const bf16*)(wsp(a) + WS_Z); const float* VXT = (const float*)(wsp(a) + WS_CVO); bf16* Y0 = (bf16*)(wsp(a) + WS_YMIX);
    { const int cw = tid >> 3, t8 = tid & 7; const float* srcp = VXT + (size_t)(cb * 64 + cw) * MT + r0 + t8 * 8; const f32x4 i0 = *(const f32x4*)srcp, i1 = *(const f32x4*)(srcp + 4);
#pragma unroll
      for (int i = 0; i < 4; ++i) { t[cw * 65 + t8 * 8 + i] = i0[i]; t[cw * 65 + t8 * 8 + 4 + i] = i1[i]; } }
    __syncthreads();
    { const int cc = tid & 63, tq = tid >> 6, c = cb * 64 + cc; float x0[8];
      shortconv8(Z, ain(a, I_HYCW), ain(a, I_HYCB), l, 0, c, r0 + tq * 8, lo, hi, x0);
#pragma unroll
      for (int i = 0; i < 8; ++i) Y0[(size_t)(r0 + tq * 8 + i) * 1024 + c] = f2bf(t[cc * 65 + tq * 8 + i] * x0[i]); }
    __syncthreads();
}
DI void scancomb_rows(const Args& a, int l, int nrows) {
    const int lane = otid() & 63, wave = otid() >> 6;
    const bf16* Z = (const bf16*)(wsp(a) + WS_Z); const float* O = (const float*)(wsp(a) + WS_OSC);
    bf16* Y1 = (bf16*)(wsp(a) + WS_YMIX) + (size_t)MT * 1024; bf16* Y2 = Y1 + (size_t)MT * 1024;
    for (int r = obid() * 8 + wave; r < nrows; r += gridDim.x * 8) {
#pragma unroll
        for (int i = 0; i < 4; ++i) { const int col = i * 256 + lane * 4;
            { const f32x4 of = *(const f32x4*)(O + (size_t)r * 1024 + col), ob = *(const f32x4*)(O + ((size_t)MT + r) * 1024 + col); const f32x4 o = of + ob;
              float ss = (o[0] * o[0] + o[1] * o[1]) + (o[2] * o[2] + o[3] * o[3]);
              ss += __shfl_xor(ss, 16); ss += __shfl_xor(ss, 8); ss += __shfl_xor(ss, 4); ss += __shfl_xor(ss, 2); ss += __shfl_xor(ss, 1);
              const float rstd = rsqrtf(ss * (1.0f / 128.0f) + NORM_EPS);
              const f32x4 nw = *(const f32x4*)(ain(a, I_HGNW) + (size_t)l * 128 + (col & 127));
              const u32x2 g = *(const u32x2*)(Z + (size_t)r * ZC + Z_HG + 4096 + col);
              u32x2 w; w.x = pk_bf16(o[0] * rstd * nw[0] * sigmoidf_(bflo(g.x)), o[1] * rstd * nw[1] * sigmoidf_(bfhi(g.x)));
              w.y = pk_bf16(o[2] * rstd * nw[2] * sigmoidf_(bflo(g.y)), o[3] * rstd * nw[3] * sigmoidf_(bfhi(g.y)));
              *(u32x2*)(Y1 + (size_t)r * 1024 + col) = w; }
            { const f32x4 of = *(const f32x4*)(O + ((size_t)2 * MT + r) * 1024 + col), ob = *(const f32x4*)(O + ((size_t)3 * MT + r) * 1024 + col); const f32x4 o = of + ob;
              float ss = (o[0] * o[0] + o[1] * o[1]) + (o[2] * o[2] + o[3] * o[3]); ss = wave_sum(ss);
              const float rstd = rsqrtf(ss * (1.0f / 256.0f) + NORM_EPS);
              const f32x4 nw = *(const f32x4*)(ain(a, I_GLNW) + (size_t)l * 256 + (col & 255));
              const u32x2 g = *(const u32x2*)(Z + (size_t)r * ZC + Z_GL + 2048 + col);
              u32x2 w; w.x = pk_bf16(o[0] * rstd * nw[0] * siluf_(bflo(g.x)), o[1] * rstd * nw[1] * siluf_(bfhi(g.x)));
              w.y = pk_bf16(o[2] * rstd * nw[2] * siluf_(bflo(g.y)), o[3] * rstd * nw[3] * siluf_(bfhi(g.y)));
              *(u32x2*)(Y2 + (size_t)r * 1024 + col) = w; }
        }
    }
}
typedef short bf16x8_t __attribute__((ext_vector_type(8)));
constexpr int SC_N = 65;
constexpr size_t KVS_GL_OFF = (size_t)16 * SC_N * 16384;
constexpr size_t WS_KVS = WS_WGU;
constexpr size_t WS_KD  = WS_WGU + 130 * MiB;
constexpr int SL_QM = 0, SL_KM = 17408, SL_Q0 = 34816, SL_KE = 52224, SL_VT = 70656, SL_PP = 107520, SL_TOT = 116736, SL_DD = 118784, SL_AFB = 119296;
static_assert(SL_AFB + 2048 <= 131072 && WS_KD + (size_t)24 * SC_N * 128 * 4 <= WS_H, "scan maps");
DI bf16x8_t lds_frag16(LAS unsigned char* p) { return *(LAS bf16x8_t*)p; }
DI bf16x8_t pack_bf16x8(const f32x4& lo, const f32x4& hi) { u32x4 w; w.x = pk_bf16(lo[0], lo[1]); w.y = pk_bf16(lo[2], lo[3]); w.z = pk_bf16(hi[0], hi[1]); w.w = pk_bf16(hi[2], hi[3]); return __builtin_bit_cast(bf16x8_t, w); }

template <bool GLA, bool OUT> DI void scan_walk(const Args& a, int l, int head, int dir, int sc, int dvh, LAS unsigned char* lds) {
    constexpr int NB = 1, DV = GLA ? 256 : 128;
    const int tid = otid(), lane = tid & 63, wave = tid >> 6, fr = lane & 15, fq = lane >> 4, nbase = dvh * 8 + wave;
    const bf16* Z = (const bf16*)(wsp(a) + WS_Z);
    const int stream = GLA ? 16 + head * 2 + dir : head * 2 + dir;
    float* kvs = (float*)(wsp(a) + WS_KVS) + (GLA ? KVS_GL_OFF + ((size_t)(stream - 16) * SC_N + sc) * 32768 : ((size_t)stream * SC_N + sc) * 16384);
    float* kd = (float*)(wsp(a) + WS_KD) + ((size_t)stream * SC_N + sc) * 128;
    LAS bf16* QM = (LAS bf16*)(lds + SL_QM); LAS bf16* KM = (LAS bf16*)(lds + SL_KM); LAS bf16* Q0 = (LAS bf16*)(lds + SL_Q0);
    LAS bf16* KE = (LAS bf16*)(lds + SL_KE); LAS bf16* VT = (LAS bf16*)(lds + SL_VT); LAS bf16* PP = (LAS bf16*)(lds + SL_PP);
    LAS float* TOT = (LAS float*)(lds + SL_TOT); LAS float* DD = (LAS float*)(lds + SL_DD); LAS bf16* AFB = (LAS bf16*)(lds + SL_AFB);
    const int k = (wave & 1) * 64 + lane, seg = wave >> 1;
    float lbv = 0.f, ba = 0.f, wa[16];
    if (!GLA) lbv = ((const float*)(wsp(a) + WS_LB))[((size_t)l * 2 + dir) * 1024 + head * 128 + k];
    else { ba = ain(a, I_GLBA)[((size_t)l * 2 + dir) * 512 + head * 128 + k];
#pragma unroll
        for (int rr = 0; rr < 16; ++rr) wa[rr] = ain(a, I_GLWA2)[(((size_t)l * 2 + dir) * 16 + rr) * 512 + head * 128 + k]; }
    f32x4 S[NB][8];
#pragma unroll
    for (int nb = 0; nb < NB; ++nb)
#pragma unroll
        for (int mb = 0; mb < 8; ++mb) { if (OUT) S[nb][mb] = *(const f32x4*)(kvs + (size_t)((nbase + nb) * 16 + fr) * 128 + mb * 16 + fq * 4); else S[nb][mb] = (f32x4){0.f, 0.f, 0.f, 0.f}; }
    float dlog = 0.f;
    const int which = (GLA ? 2 : 0) + dir;
    float* Odir = (float*)(wsp(a) + WS_OSC) + (size_t)which * MT * 1024;
    for (int cc = 0; cc < 4; ++cc) {
        const int c = sc * 4 + cc; const int r0 = dir ? stream_row(c * 64 + 63, 1) : stream_row(c * 64, 0);
        { const bf16* vr = Z + (size_t)(r0 + lane) * ZC + (GLA ? Z_GL + 1024 + head * 256 + dvh * 128 : Z_HG + 3072 + head * 128) + wave * 16;
#pragma unroll
          for (int q8 = 0; q8 < 2; ++q8) { const u32x4 v = *(const u32x4*)(vr + q8 * 8); const int d0 = wave * 16 + q8 * 8;
              VT[(d0 + 0) * 72 + lane] = (bf16)(v.x & 0xffff); VT[(d0 + 1) * 72 + lane] = (bf16)(v.x >> 16); VT[(d0 + 2) * 72 + lane] = (bf16)(v.y & 0xffff); VT[(d0 + 3) * 72 + lane] = (bf16)(v.y >> 16);
              VT[(d0 + 4) * 72 + lane] = (bf16)(v.z & 0xffff); VT[(d0 + 5) * 72 + lane] = (bf16)(v.z >> 16); VT[(d0 + 6) * 72 + lane] = (bf16)(v.w & 0xffff); VT[(d0 + 7) * 72 + lane] = (bf16)(v.w >> 16); }
          const int srow = tid >> 3, spc = (tid & 7) * 16; const bf16* zr = Z + (size_t)(r0 + srow) * ZC;
          const bf16* fsrc = zr + (GLA ? Z_GL + 512 + head * 128 : Z_HG + 1024 * (1 + dir) + head * 128) + spc;
          const u32x4 f0 = *(const u32x4*)fsrc, f1 = *(const u32x4*)(fsrc + 8);
          *(LAS u32x4*)(KM + srow * 136 + spc) = f0; *(LAS u32x4*)(KM + srow * 136 + spc + 8) = f1;
          if (OUT) { const bf16* qsrc = zr + (GLA ? Z_GL + head * 128 : Z_HG + head * 128) + spc; const u32x4 q0 = *(const u32x4*)qsrc, q1 = *(const u32x4*)(qsrc + 8);
              *(LAS u32x4*)(QM + srow * 136 + spc) = q0; *(LAS u32x4*)(QM + srow * 136 + spc + 8) = q1; }
          if (GLA && tid < 128) { const u32x4 av = *(const u32x4*)(Z + (size_t)(r0 + (tid >> 1)) * ZC + Z_LR + dir * 16 + (tid & 1) * 8); *(LAS u32x4*)(AFB + (tid >> 1) * 16 + (tid & 1) * 8) = av; } }
        __syncthreads();
        const int tstart = dir ? 63 - seg * 16 : seg * 16, tstep = dir ? -1 : 1;
        float cs[16]; float run = 0.f;
#pragma unroll
        for (int i = 0; i < 16; ++i) { const int t = tstart + i * tstep; float la;
            if (!GLA) { const float zf = bf2f(KM[t * 136 + k]); la = __logf(lbv + (1.0f - lbv) * sigmoidf_(zf)); }
            else { float x = ba; const u32x4 a0 = *(LAS u32x4*)(AFB + t * 16), a1 = *(LAS u32x4*)(AFB + t * 16 + 8);
                x += bflo(a0.x) * wa[0] + bfhi(a0.x) * wa[1] + bflo(a0.y) * wa[2] + bfhi(a0.y) * wa[3] + bflo(a0.z) * wa[4] + bfhi(a0.z) * wa[5] + bflo(a0.w) * wa[6] + bfhi(a0.w) * wa[7];
                x += bflo(a1.x) * wa[8] + bfhi(a1.x) * wa[9] + bflo(a1.y) * wa[10] + bfhi(a1.y) * wa[11] + bflo(a1.z) * wa[12] + bfhi(a1.z) * wa[13] + bflo(a1.w) * wa[14] + bfhi(a1.w) * wa[15];
                la = (fminf(x, 0.f) - log1pf(__expf(-fabsf(x)))) * 0.0625f; }
            run += la; cs[i] = run; if (GLA || (i & 3) == 3) asm volatile("" ::: "memory"); }
        TOT[seg * 128 + k] = run;
        __syncthreads();
        { const float t0 = TOT[k], t1 = TOT[128 + k], t2 = TOT[256 + k], t3 = TOT[384 + k];
          const float off = seg == 0 ? 0.f : (seg == 1 ? t0 : (seg == 2 ? t0 + t1 : t0 + t1 + t2)), blast = (t0 + t1) + (t2 + t3), bref = t0 + t1;
          float ke[16];
#pragma unroll
          for (int i = 0; i < 16; ++i) { const int t = tstart + i * tstep; const float b = off + cs[i]; const float raw = bf2f(KM[t * 136 + k]);
              const float kk = GLA ? raw : (1.0f - lbv) * sigmoidf_(-raw);
              if (OUT) { const float qr = bf2f(QM[t * 136 + k]); const float qv = GLA ? qr * 0.08838834764831845f : siluf_(qr);
                  QM[t * 136 + k] = f2bf(qv * __expf(b - bref)); KM[t * 136 + k] = f2bf(kk * __expf(bref - b)); Q0[t * 136 + k] = f2bf(qv * __expf(b)); }
              ke[i] = kk * __expf(blast - b); if ((i & 3) == 3) asm volatile("" ::: "memory"); }
          const int tb0 = dir ? 48 - seg * 16 : seg * 16; u32x4 w0, w1;
          if (dir) { w0.x = pk_bf16(ke[15], ke[14]); w0.y = pk_bf16(ke[13], ke[12]); w0.z = pk_bf16(ke[11], ke[10]); w0.w = pk_bf16(ke[9], ke[8]); w1.x = pk_bf16(ke[7], ke[6]); w1.y = pk_bf16(ke[5], ke[4]); w1.z = pk_bf16(ke[3], ke[2]); w1.w = pk_bf16(ke[1], ke[0]); }
          else     { w0.x = pk_bf16(ke[0], ke[1]); w0.y = pk_bf16(ke[2], ke[3]); w0.z = pk_bf16(ke[4], ke[5]); w0.w = pk_bf16(ke[6], ke[7]); w1.x = pk_bf16(ke[8], ke[9]); w1.y = pk_bf16(ke[10], ke[11]); w1.z = pk_bf16(ke[12], ke[13]); w1.w = pk_bf16(ke[14], ke[15]); }
          *(LAS u32x4*)(KE + k * 72 + tb0) = w0; *(LAS u32x4*)(KE + k * 72 + tb0 + 8) = w1;
          if (seg == 0) DD[k] = __expf(blast);
          dlog += blast; }
        __syncthreads();
        bf16x8_t Bv[NB][2];
#pragma unroll
        for (int nb = 0; nb < NB; ++nb)
#pragma unroll
            for (int ks = 0; ks < 2; ++ks) Bv[nb][ks] = lds_frag16(lds + SL_VT + ((wave * 16 + fr) * 72 + ks * 32 + fq * 8) * 2);
        if (OUT) {
            { const int tb = wave >> 1;
#pragma unroll
              for (int sbi = 0; sbi < 2; ++sbi) { const int sb = (wave & 1) * 2 + sbi; f32x4 acc = {0.f, 0.f, 0.f, 0.f};
#pragma unroll
                  for (int ks = 0; ks < 4; ++ks) acc = __builtin_amdgcn_mfma_f32_16x16x32_bf16(lds_frag16(lds + SL_QM + ((tb * 16 + fr) * 136 + ks * 32 + fq * 8) * 2), lds_frag16(lds + SL_KM + ((sb * 16 + fr) * 136 + ks * 32 + fq * 8) * 2), acc, 0, 0, 0);
#pragma unroll
                  for (int j = 0; j < 4; ++j) { const int t = tb * 16 + fq * 4 + j, s = sb * 16 + fr; const bool keep = dir ? (s >= t) : (s <= t); PP[t * 72 + s] = keep ? f2bf(acc[j]) : (bf16)0; } } }
            __syncthreads();
#pragma unroll
            for (int nb = 0; nb < NB; ++nb) {
                bf16x8_t Bs[4];
#pragma unroll
                for (int ks = 0; ks < 4; ++ks) Bs[ks] = pack_bf16x8(S[nb][2 * ks], S[nb][2 * ks + 1]);
#pragma unroll
                for (int mb = 0; mb < 4; ++mb) {
                    f32x4 O = {0.f, 0.f, 0.f, 0.f};
#pragma unroll
                    for (int ks = 0; ks < 2; ++ks) O = __builtin_amdgcn_mfma_f32_16x16x32_bf16(lds_frag16(lds + SL_PP + ((mb * 16 + fr) * 72 + ks * 32 + fq * 8) * 2), Bv[nb][ks], O, 0, 0, 0);
#pragma unroll
                    for (int ks = 0; ks < 4; ++ks) { u32x4 aw; const u32x2 lo = *(LAS u32x2*)(lds + SL_Q0 + ((mb * 16 + fr) * 136 + (2 * ks) * 16 + fq * 4) * 2), hi = *(LAS u32x2*)(lds + SL_Q0 + ((mb * 16 + fr) * 136 + (2 * ks + 1) * 16 + fq * 4) * 2);
                        aw.x = lo.x; aw.y = lo.y; aw.z = hi.x; aw.w = hi.y;
                        O = __builtin_amdgcn_mfma_f32_16x16x32_bf16(__builtin_bit_cast(bf16x8_t, aw), Bs[ks], O, 0, 0, 0); }
#pragma unroll
                    for (int j = 0; j < 4; ++j) Odir[(size_t)(r0 + mb * 16 + fq * 4 + j) * 1024 + head * DV + (nbase + nb) * 16 + fr] = O[j];
                    asm volatile("" ::: "memory");
                }
            }
        }
        if (!OUT || cc < 3) {
#pragma unroll
            for (int mb = 0; mb < 8; ++mb) { const f32x4 dd = *(LAS f32x4*)(DD + mb * 16 + fq * 4);
                const bf16x8_t A0 = lds_frag16(lds + SL_KE + ((mb * 16 + fr) * 72 + fq * 8) * 2), A1 = lds_frag16(lds + SL_KE + ((mb * 16 + fr) * 72 + 32 + fq * 8) * 2);
#pragma unroll
                for (int nb = 0; nb < NB; ++nb) { S[nb][mb] = S[nb][mb] * dd; S[nb][mb] = __builtin_amdgcn_mfma_f32_16x16x32_bf16(A0, Bv[nb][0], S[nb][mb], 0, 0, 0); S[nb][mb] = __builtin_amdgcn_mfma_f32_16x16x32_bf16(A1, Bv[nb][1], S[nb][mb], 0, 0, 0); }
                asm volatile("" ::: "memory"); }
        }
        __syncthreads();
    }
    if (!OUT) {
#pragma unroll
        for (int nb = 0; nb < NB; ++nb)
#pragma unroll
            for (int mb = 0; mb < 8; ++mb) *(f32x4*)(kvs + (size_t)((nbase + nb) * 16 + fr) * 128 + mb * 16 + fq * 4) = S[nb][mb];
        if (seg == 0) kd[k] = __expf(dlog);
    }
}
DI void scan_prop(const Args& a) {
    float* kvs = (float*)(wsp(a) + WS_KVS); const float* kd = (const float*)(wsp(a) + WS_KD);
    for (int g = obid() * NTHR + otid(); g < 131072; g += gridDim.x * NTHR) {
        float* p; size_t stride; const float* dp;
        if (g < 65536) { const int stream = g >> 12, e = g & 4095; p = kvs + (size_t)stream * SC_N * 16384 + (size_t)e * 4; stride = 16384; dp = kd + (size_t)stream * SC_N * 128 + (e & 31) * 4; }
        else { const int q = g - 65536, stream = q >> 13, e = q & 8191; p = kvs + KVS_GL_OFF + (size_t)stream * SC_N * 32768 + (size_t)e * 4; stride = 32768; dp = kd + (size_t)(16 + stream) * SC_N * 128 + (e & 31) * 4; }
        f32x4 S = {0.f, 0.f, 0.f, 0.f};
#pragma unroll 5
        for (int sc = 0; sc < SC_N; ++sc) { const f32x4 kv = *(const f32x4*)(p + sc * stride), d = *(const f32x4*)(dp + sc * 128); *(f32x4*)(p + sc * stride) = S; S = d * S + kv; }
    }
}
constexpr int SCAN_ITEMS = 32 * SC_N;
template <bool OUT> DI void scan_item2(const Args& a, int l, int it, LAS unsigned char* lds) {
    if (it < 16 * SC_N) { const int s = it / SC_N, sc = it % SC_N; if (OUT && l == DEPTH - 1 && sc == 0) return; scan_walk<true, OUT>(a, l, s >> 2, (s >> 1) & 1, sc, s & 1, lds); }
    else { const int j = it - 16 * SC_N, s = j / SC_N, sc = j % SC_N; if (OUT && l == DEPTH - 1 && sc == 0) return; scan_walk<false, OUT>(a, l, s >> 1, s & 1, sc, 0, lds); }
}
DI void hyconv_item(const Args& a, int l, int c, LAS unsigned char* ldsb) {
    const int tid = otid();
    LAS float* lds = (LAS float*)ldsb;
    LAS float* xs = (LAS float*)(ldsb + LDS_X);
    const float* tw = (const float*)(wsp(a) + WS_TW); const float* tw2 = (const float*)(wsp(a) + WS_TW2);
    const float* h2 = (const float*)(wsp(a) + WS_H2) + (size_t)l * MT * 64;
    const float* VX = (const float*)(wsp(a) + WS_U) + (size_t)c * MT; float* VO = (float*)(wsp(a) + WS_CVO) + (size_t)c * MT;
    if (tid < 128) xs[tid] = ain(a, I_HYW3)[((size_t)l * 64 + (tid & 63)) * 2048 + (tid >> 6) * 1024 + c];
    __syncthreads();
    const float a0 = -4.605170186f / 1.5f, a1 = -4.605170186f / 0.3f;
    const float delta = fabsf(a0 + (float)c * ((a1 - a0) / 1023.0f));
    const float b3f = ain(a, I_HYB3)[l * 2048 + c], b3b = ain(a, I_HYB3)[l * 2048 + 1024 + c];
    float sf = 0.f, sb = 0.f;
    for (int i = 0; i < 32; ++i) { const int t = tid + 512 * i; const float* hr = h2 + (size_t)t * 64; float hf = b3f, hb = b3b;
#pragma unroll
        for (int j4 = 0; j4 < 16; ++j4) { const f32x4 hv = *(const f32x4*)(hr + j4 * 4);
#pragma unroll
            for (int q = 0; q < 4; ++q) { hf += hv[q] * xs[j4 * 4 + q]; hb += hv[q] * xs[64 + j4 * 4 + q]; } }
        const float dec = expf(-((float)t / (float)(SEQ - 1)) * delta) + 0.05f;
        hf *= dec; hb *= dec; sf += fabsf(hf); sb += fabsf(hb);
        lds[t] = hf; if (t > 0) lds[32768 - t] = hb; else xs[160] = hb; }
    sf = wave_sum(sf); sb = wave_sum(sb);
    if ((tid & 63) == 0) { xs[128 + (tid >> 6)] = sf; xs[136 + (tid >> 6)] = sb; }
    __syncthreads();
    float tf = 0.f, tb = 0.f;
#pragma unroll
    for (int w = 0; w < 8; ++w) { tf += xs[128 + w]; tb += xs[136 + w]; }
    const float inf_ = 1.0f / tf, inb_ = 1.0f / tb;
    for (int i = 0; i < 64; ++i) { const int m = tid + 512 * i; float v = lds[m];
        if (m == 0) v = v * inf_ + xs[160] * inb_ + ain(a, I_HYSKIP)[l * 1024 + c];
        else if (m < SEQ) v *= inf_; else if (m == SEQ) v = 0.f; else v *= inb_;
        lds[m] = v; }
    __syncthreads();
    for (int s = FFT_M / 4; s >= 1; s >>= 2) { fft_fwd_pass(lds, tw, s, tid); __syncthreads(); }
    float* Gs = (float*)(wsp(a) + WS_YMIX) + (size_t)obid() * 32768;
#pragma unroll 1
    for (int j = 0; j < 16; ++j) { const int k = tid + 512 * j; cpx gk, gm; rfft_untangle(lds, tw2, k, gk, gm); f32x4 g4; g4[0] = gk.x; g4[1] = gk.y; g4[2] = gm.x; g4[3] = gm.y; *(f32x4*)(Gs + (size_t)k * 4) = g4; }
    __syncthreads();
    for (int i = 0; i < 16; ++i) { const int m4 = tid + 512 * i; f32x4 v = {0.f, 0.f, 0.f, 0.f}; if (m4 < SEQ / 4) v = *(const f32x4*)(VX + m4 * 4); *(LAS f32x4*)(lds + m4 * 4) = v; }
    __syncthreads();
    for (int s = FFT_M / 4; s >= 1; s >>= 2) { fft_fwd_pass(lds, tw, s, tid); __syncthreads(); }
#pragma unroll 1
    for (int j = 0; j < 16; ++j) { const int k = tid + 512 * j; const f32x4 g4 = *(const f32x4*)(Gs + (size_t)k * 4); cpx gk, gm; gk.x = g4[0]; gk.y = g4[1]; gm.x = g4[2]; gm.y = g4[3]; rfft_mul_retangle(lds, tw2, k, gk, gm); }
    __syncthreads();
    for (int s = 1; s <= FFT_M / 4; s <<= 2) { fft_inv_pass(lds, tw, s, tid); __syncthreads(); }
    for (int i = 0; i < 8; ++i) { const int m4 = tid + 512 * i; f32x4 v = *(const LAS f32x4*)(lds + m4 * 4); *(f32x4*)(VO + m4 * 4) = v * (1.0f / FFT_M); }
    __syncthreads();
}
DI void hycctx_item(const Args& a, int l, int it, LAS unsigned char* ldsb) {
    const int tid = otid(), c0 = it * 16;
    LAS float* sv = (LAS float*)ldsb;
    LAS float* sf = sv + 16 * 256;
    LAS float* sb = sf + 16 * 256;
    const float* hyc = (const float*)(wsp(a) + WS_HYC); const float* VXT = (const float*)(wsp(a) + WS_U); float* CVO = (float*)(wsp(a) + WS_CVO);
    for (int i = tid; i < 16 * 256; i += NTHR) { const int ch = i >> 8, t = i & 255; sv[i] = VXT[(size_t)(c0 + ch) * MT + SEQ + t]; sf[i] = hyc[(size_t)(c0 + ch) * 256 + t]; sb[i] = hyc[(size_t)(1024 + c0 + ch) * 256 + t]; }
    __syncthreads();
    const int ch = tid >> 5, tq = tid & 31; const float g0 = sf[ch * 256] + sb[ch * 256] + ain(a, I_HYSKIP)[l * 1024 + c0 + ch];
    float acc[8];
#pragma unroll
    for (int i = 0; i < 8; ++i) acc[i] = 0.f;
    for (int s = 0; s < 256; ++s) { const float vv = sv[ch * 256 + s];
#pragma unroll
        for (int i = 0; i < 8; ++i) { const int d = tq * 8 + i - s; const float g = d > 0 ? sf[ch * 256 + d] : (d < 0 ? sb[ch * 256 - d] : g0); acc[i] += g * vv; } }
    __syncthreads();
#pragma unroll
    for (int i = 0; i < 8; ++i) CVO[(size_t)(c0 + ch) * MT + SEQ + tq * 8 + i] = acc[i];
    __syncthreads();
}

struct EpiZ {
    static constexpr bool PERM = true, AFTER_DRAIN = false; bf16* O; const float* bias;
    DI void operator()(const f32x4 (&acc)[2][2][4][2], const pg8::Unit& u, int wr, int wc, int fr, int fq) const {
        const int row0 = u.pm * 256 + wr * 64 + fr, col0 = u.pn * 256 + wc * 32 + 8 * fq;
        f32x4 bv[2][2];
#pragma unroll
        for (int bj = 0; bj < 2; ++bj)
#pragma unroll
            for (int n = 0; n < 2; ++n) bv[bj][n] = *(const f32x4*)(bias + col0 + bj * 128 + 4 * n);
#pragma unroll
        for (int ai = 0; ai < 2; ++ai)
#pragma unroll
            for (int m = 0; m < 4; ++m) { bf16* rowp = O + (size_t)(row0 + ai * 128 + m * 16) * ZC + col0;
#pragma unroll
                for (int bj = 0; bj < 2; ++bj) { const f32x4 v0 = acc[ai][bj][m][0] + bv[bj][0], v1 = acc[ai][bj][m][1] + bv[bj][1];
                    u32x4 w; w.x = pk_bf16(v0[0], v0[1]); w.y = pk_bf16(v0[2], v0[3]); w.z = pk_bf16(v1[0], v1[1]); w.w = pk_bf16(v1[2], v1[3]);
                    *(u32x4*)(rowp + bj * 128) = w; } }
    }
};
template <int BR> struct EpiBr {
    static constexpr bool PERM = true, AFTER_DRAIN = false; bf16* Mg; const bf16* Zg;
    DI void operator()(const f32x4 (&acc)[2][2][4][2], const pg8::Unit& u, int wr, int wc, int fr, int fq) const {
        const int row0 = u.pm * 256 + wr * 64 + fr, col0 = u.pn * 256 + wc * 32 + 8 * fq;
#pragma unroll
        for (int ai = 0; ai < 2; ++ai)
#pragma unroll
            for (int m = 0; m < 4; ++m) { const size_t row = (size_t)(row0 + ai * 128 + m * 16);
#pragma unroll
                for (int bj = 0; bj < 2; ++bj) { const int col = col0 + bj * 128;
                    const u32x4 g = *(const u32x4*)(Zg + row * ZC + col);
                    f32x4 v0 = acc[ai][bj][m][0], v1 = acc[ai][bj][m][1];
                    v0[0] *= sigmoidf_(bflo(g.x)); v0[1] *= sigmoidf_(bfhi(g.x)); v0[2] *= sigmoidf_(bflo(g.y)); v0[3] *= sigmoidf_(bfhi(g.y));
                    v1[0] *= sigmoidf_(bflo(g.z)); v1[1] *= sigmoidf_(bfhi(g.z)); v1[2] *= sigmoidf_(bflo(g.w)); v1[3] *= sigmoidf_(bfhi(g.w));
                    if (BR > 0) { const u32x4 p = *(const u32x4*)(Mg + row * D + col);
                        v0[0] += bflo(p.x); v0[1] += bfhi(p.x); v0[2] += bflo(p.y); v0[3] += bfhi(p.y); v1[0] += bflo(p.z); v1[1] += bfhi(p.z); v1[2] += bflo(p.w); v1[3] += bfhi(p.w); }
                    u32x4 w; w.x = pk_bf16(v0[0], v0[1]); w.y = pk_bf16(v0[2], v0[3]); w.z = pk_bf16(v1[0], v1[1]); w.w = pk_bf16(v1[2], v1[3]);
                    *(u32x4*)(Mg + row * D + col) = w; } }
    }
};
struct EpiOut {
    static constexpr bool PERM = false, AFTER_DRAIN = false; const float* hin_main; const float* hin_ctx; float* hout; const float* gt1;
    DI void operator()(const f32x4 (&acc)[2][2][4][2], const pg8::Unit& u, int wr, int wc, int fr, int fq) const {
        const int row0 = u.pm * 256 + wr * 64 + fr, col0 = u.pn * 256 + wc * 32 + 4 * fq; const bool isctx = u.pm >= SEQ / 256;
        const float* g = gt1 + (isctx ? 12288 : 0);
        f32x4 gv[2][2];
#pragma unroll
        for (int bj = 0; bj < 2; ++bj)
#pragma unroll
            for (int n = 0; n < 2; ++n) gv[bj][n] = *(const f32x4*)(g + col0 + bj * 128 + n * 16);
#pragma unroll
        for (int ai = 0; ai < 2; ++ai)
#pragma unroll
            for (int m = 0; m < 4; ++m) { const int row = row0 + ai * 128 + m * 16;
                const float* ip = (isctx ? hin_ctx + (size_t)(row - SEQ) * D : hin_main + (size_t)row * D) + col0; float* op = hout + (size_t)row * D + col0;
#pragma unroll
                for (int bj = 0; bj < 2; ++bj)
#pragma unroll
                    for (int n = 0; n < 2; ++n) { const f32x4 b = *(const f32x4*)(ip + bj * 128 + n * 16); *(f32x4*)(op + bj * 128 + n * 16) = b + gv[bj][n] * acc[ai][bj][m][n]; } }
    }
};
struct EpiGU {
    static constexpr bool PERM = true, AFTER_DRAIN = false; bf16* Hm;
    DI void operator()(const f32x4 (&acc)[2][2][4][2], const pg8::Unit& u, int wr, int wc, int fr, int fq) const {
        const int row0 = u.pm * 256 + wr * 64 + fr, col0 = (u.pn & 3) * 128 + wc * 32 + 8 * fq;
#pragma unroll
        for (int ai = 0; ai < 2; ++ai)
#pragma unroll
            for (int m = 0; m < 4; ++m) { const f32x4 g0 = acc[ai][0][m][0], g1 = acc[ai][0][m][1], u0 = acc[ai][1][m][0], u1 = acc[ai][1][m][1];
                u32x4 w; w.x = pk_bf16(siluf_(g0[0]) * u0[0], siluf_(g0[1]) * u0[1]); w.y = pk_bf16(siluf_(g0[2]) * u0[2], siluf_(g0[3]) * u0[3]);
                w.z = pk_bf16(siluf_(g1[0]) * u1[0], siluf_(g1[1]) * u1[1]); w.w = pk_bf16(siluf_(g1[2]) * u1[2], siluf_(g1[3]) * u1[3]);
                *(u32x4*)(Hm + (size_t)(row0 + ai * 128 + m * 16) * DFF + col0) = w; }
    }
};
struct EpiDn {
    static constexpr bool PERM = true, AFTER_DRAIN = false; bf16* Y; const float* roww;
    DI void operator()(const f32x4 (&acc)[2][2][4][2], const pg8::Unit& u, int wr, int wc, int fr, int fq) const {
        const int row0 = u.pm * 256 + wr * 64 + fr, col0 = (u.pn & 7) * 256 + wc * 32 + 8 * fq;
#pragma unroll
        for (int ai = 0; ai < 2; ++ai)
#pragma unroll
            for (int m = 0; m < 4; ++m) { const int row = row0 + ai * 128 + m * 16; const float rw = roww[row];
#pragma unroll
                for (int bj = 0; bj < 2; ++bj) { const f32x4 v0 = acc[ai][bj][m][0] * rw, v1 = acc[ai][bj][m][1] * rw;
                    u32x4 w; w.x = pk_bf16(v0[0], v0[1]); w.y = pk_bf16(v0[2], v0[3]); w.z = pk_bf16(v1[0], v1[1]); w.w = pk_bf16(v1[2], v1[3]);
                    *(u32x4*)(Y + (size_t)row * D + col0 + bj * 128) = w; } }
    }
};
struct MoeOrder {
    const int* tile_e; int ntiles, nsub, G, c;
    DI bool next(int i, pg8::Unit& u) const { const int j = i * G + c; if (j >= ntiles * nsub) return false; const int ti = j / nsub; u.pm = ti; u.pn = tile_e[ti] * nsub + (j - ti * nsub); return true; }
    DI void a_ready(const pg8::Unit&) const {}
    DI void done(const pg8::Unit&) const {}
};
constexpr int NPH_LAYER = 13, PH_FINAL = 1 + NPH_LAYER * DEPTH, NPHASES = PH_FINAL + 1;
struct KArgs { Args a; int li, pad; };
__global__ void __launch_bounds__(NTHR, 2) fwd_kernel(KArgs ka) {
    const Args& a = ka.a;
    const int tid = otid(), bid = obid(), G = gridDim.x;
    if (tid == 0) { ((LAS unsigned*)(ldsbase() + LDS_BARW))[0] = 0u; ((LAS unsigned*)(ldsbase() + LDS_BARW))[1] = 0u;
        LAS unsigned long long* ptab = (LAS unsigned long long*)(ldsbase() + LDS_PTAB);
#pragma unroll
        for (int i = 0; i < N_IN; ++i) ptab[i] = (unsigned long long)ka.a.in[i]; }
    __syncthreads();
    XcdBarrier bar = xcd_barrier_post((unsigned*)(wsp(a) + WS_CTL) + CW_BAR + ka.li * XCD_BAR_WORDS, (volatile LAS unsigned*)(ldsbase() + LDS_BARW));
    const int lo = a.ph_lo, hi = a.ph_hi;
#ifndef PHMASK
#define PHMASK 0xFFFF
#endif
#define EN(i) (((PHMASK) >> (i)) & 1)
#ifndef REPMASK
#define REPMASK 0
#endif
#define REP(i) (((REPMASK) >> (i)) & 1)
#define RUN(i, cond, ...) do { __VA_ARGS__; if (REP(i) && (cond)) { __syncthreads(); __VA_ARGS__; } } while (0)
#define IN(k) (opq(lo) <= (k) && (k) < opq(hi))
#define SEAM(k) do { if (IN(k) && IN((k) + 1)) xcd_barrier(bar); } while (0)
#define ws wsp(a)
#define lds ldsbase()
#define ldsf ((LAS float*)ldsbase())
#define U ((bf16*)(wsp(a) + WS_U))
#define Z ((bf16*)(wsp(a) + WS_Z))
#define H ((float*)(wsp(a) + WS_H))
#define modall ((const float*)(wsp(a) + WS_MOD))

    if (EN(0) && IN(0)) {
        RUN(0, true, prologue_small(a);
        for (int it = bid; it < 256; it += G) mod_item(a, it, ldsf);
        for (int it = bid; it < DEPTH * (MT / 8); it += G) h2_item(a, it, ldsf));
    }
    SEAM(0);
    for (int l = 0; l < DEPTH; ++l) {
        const int pb = 1 + NPH_LAYER * l;
        const int nrows = (l == 0) ? MT : SEQ;
        if (EN(1) && IN(pb + 0)) {
            RUN(1, l == 0, norm_phase<0>(a, l, MT, ldsf));
            RUN(16, true, if (l == 0) hyc_filters(a, 0));
            RUN(2, true, for (int it = bid; it < CVT_MIX_TILES; it += G) cvt_mix_item(a, l, it, ldsf));
        }
        SEAM(pb + 0);
        if (EN(2) && IN(pb + 1)) {
            pg8::Gemm g{U, (const bf16*)(ws + WS_WIN), MT, ZC, D}; pg8::StaticOrder S; S.init(MT, ZC, G, bid);
            EpiZ E{Z, (const float*)(ws + WS_ZBIAS) + (size_t)l * ZC};
            RUN(3, true, pg8::gemm_phase<EpiZ, pg8::StaticOrder, true, true>(lds, g, S, E));
        }
        SEAM(pb + 1);
        if (EN(3) && IN(pb + 2)) { const int nit = (nrows / 64) * 16; RUN(4, true, for (int it = bid; it < nit; it += G) hyprep_item(a, l, it, ldsf)); }
        SEAM(pb + 2);
        if (EN(4) && IN(pb + 3)) {
            RUN(5, true, for (int it = bid; it < SCAN_ITEMS; it += G) scan_item2<false>(a, l, it, lds));
            RUN(6, true, for (int c = bid; c < 1024; c += G) hyconv_item(a, l, c, lds));
            RUN(15, true, if (l == 0) for (int it = bid; it < 64; it += G) hycctx_item(a, l, it, lds));
        }
        SEAM(pb + 3);
        if (EN(13) && IN(pb + 4)) scan_prop(a);
        SEAM(pb + 4);
        if (EN(14) && IN(pb + 5)) { RUN(17, true, for (int it = bid; it < SCAN_ITEMS; it += G) scan_item2<true>(a, l, it, lds)); }
        SEAM(pb + 5);
        if (EN(5) && IN(pb + 6)) {
            const int nit = (nrows / 64) * 16;
            RUN(7, true, scancomb_rows(a, l, nrows); for (int it = bid; it < nit; it += G) hycomb_item(a, l, it, ldsf));
        }
        SEAM(pb + 6);
        if (EN(6) && IN(pb + 7)) {
            const bf16* Y = (const bf16*)(ws + WS_YMIX); const bf16* WB = (const bf16*)(ws + WS_WBR);
            pg8::StaticOrder S; S.init(nrows, D, G, bid);
            { pg8::Gemm g{Y, WB, nrows, D, 1024}; EpiBr<0> E{U, Z + Z_MG}; pg8::gemm_phase<EpiBr<0>, pg8::StaticOrder, true, true>(lds, g, S, E); }
            __syncthreads();
            { pg8::Gemm g{Y + (size_t)MT * 1024, WB + (size_t)D * 1024, nrows, D, 1024}; EpiBr<1> E{U, Z + Z_MG + D}; pg8::gemm_phase<EpiBr<1>, pg8::StaticOrder, true, true>(lds, g, S, E); }
            __syncthreads();
            { pg8::Gemm g{Y + (size_t)2 * MT * 1024, WB + (size_t)2 * D * 1024, nrows, D, 1024}; EpiBr<2> E{U, Z + Z_MG + 2 * D}; pg8::gemm_phase<EpiBr<2>, pg8::StaticOrder, true, true>(lds, g, S, E); }
        }
        SEAM(pb + 7);
        if (EN(7) && IN(pb + 8)) {
            pg8::Gemm g{U, (const bf16*)(ws + WS_WOUT), nrows, D, D}; pg8::StaticOrder S; S.init(nrows, D, G, bid);
            EpiOut E{l == 0 ? ain(a, I_X) : H, l == 0 ? ain(a, I_CTX) : H + (size_t)SEQ * D, H, modall + (size_t)l * 2 * 12288 + 4096};
            RUN(9, l == 0, pg8::gemm_phase<EpiOut, pg8::StaticOrder, true, true>(lds, g, S, E));
        }
        SEAM(pb + 8);
        if (EN(8) && IN(pb + 9)) {
            norm_phase<1>(a, l, nrows, ldsf);
            __syncthreads();
            RUN(10, true, for (int it = bid; it < CVT_MOE_TILES; it += G) cvt_moe_item(a, l, it, ldsf));
        }
        SEAM(pb + 9);
        if (EN(9) && IN(pb + 10)) { RUN(11, true, permute_phase(a, l, nrows, lds)); }
        SEAM(pb + 10);
        if (EN(10) && IN(pb + 11)) {
            const int* tile_e = (const int*)(ws + WS_TILEE); const int ntiles = tile_e[200];
            pg8::Gemm g{(const bf16*)(ws + WS_XP), (const bf16*)(ws + WS_WGU), MOE_MAXROWS, NEXP * 1024, D}; MoeOrder S{tile_e, ntiles, 4, G, bid};
            EpiGU E{(bf16*)(ws + WS_HMID)};
            RUN(12, true, pg8::gemm_phase<EpiGU, MoeOrder, true, true>(lds, g, S, E));
        }
        SEAM(pb + 11);
        if (EN(11) && IN(pb + 12)) {
            const int* tile_e = (const int*)(ws + WS_TILEE); const int ntiles = tile_e[200];
            pg8::Gemm g{(const bf16*)(ws + WS_HMID), (const bf16*)(ws + WS_WD), MOE_MAXROWS, NEXP * D, DFF}; MoeOrder S{tile_e, ntiles, 8, G, bid};
            EpiDn E{(bf16*)(ws + WS_YP), (const float*)(ws + WS_ROWW)};
            RUN(13, true, pg8::gemm_phase<EpiDn, MoeOrder, true, true>(lds, g, S, E));
        }
        SEAM(pb + 12);
    }
    if (EN(12) && IN(PH_FINAL)) norm_phase<2>(a, DEPTH, SEQ, ldsf);
#undef IN
#undef SEAM
#undef ws
#undef lds
#undef ldsf
#undef U
#undef Z
#undef H
#undef modall
}

#ifndef MK_SINGLE
#define MK_SINGLE 1
#endif
extern "C" void kernel_launch(void* const* d_in, const int* in_sizes, int n_in, void* d_out, int out_size, void* d_ws, size_t ws_size, hipStream_t stream) {
    static int grid = 0;
    if (grid == 0) {
        if (n_in != N_IN || out_size != SEQ * D || ws_size < WS_END) { fprintf(stderr, "kernel_launch: unexpected problem shape (n_in %d, out %d, ws %zu < %zu)\n", n_in, out_size, ws_size, (size_t)WS_END); grid = -1; return; }
        int dev = 0, cus = 0;
        if (hipGetDevice(&dev) != hipSuccess || hipDeviceGetAttribute(&cus, hipDeviceAttributeMultiprocessorCount, dev) != hipSuccess) { grid = -1; return; }
        if (hipFuncSetAttribute((const void*)fwd_kernel, hipFuncAttributeMaxDynamicSharedMemorySize, LDS_BYTES) != hipSuccess) { fprintf(stderr, "kernel_launch: hipFuncSetAttribute failed\n"); grid = -1; return; }
        int per_cu = 0;
        if (hipOccupancyMaxActiveBlocksPerMultiprocessor(&per_cu, (const void*)fwd_kernel, NTHR, LDS_BYTES) != hipSuccess || per_cu < 1) fprintf(stderr, "kernel_launch: occupancy query says %d\n", per_cu);
        (void)hipGetLastError();
        grid = cus;
    }
    if (grid < 0) return;
    (void)hipMemsetAsync((char*)d_ws + WS_CTL, 0, CTL_BYTES, stream);
    KArgs ka{};
    for (int i = 0; i < N_IN; ++i) ka.a.in[i] = (const float*)d_in[i];
    ka.a.out = (float*)d_out; ka.a.ws = (unsigned char*)d_ws;
#if MK_SINGLE
    ka.a.ph_lo = 0; ka.a.ph_hi = NPHASES; ka.li = 0; ka.pad = 0;
    hipLaunchKernelGGL(fwd_kernel, dim3(grid), dim3(NTHR), LDS_BYTES, stream, ka);
#else
    for (int ph = 0; ph < NPHASES; ++ph) { ka.a.ph_lo = ph; ka.a.ph_hi = ph + 1; ka.li = 0; ka.pad = 0; hipLaunchKernelGGL(fwd_kernel, dim3(grid), dim3(NTHR), LDS_BYTES, stream, ka); }
#endif
}
```

```cpp
#include <hip/hip_runtime.h>
#include <cstdio>
#include <cstdint>
#define DI __device__ __forceinline__
#define LAS __attribute__((address_space(3)))
typedef unsigned short bf16;
typedef float f32x4 __attribute__((ext_vector_type(4)));
typedef unsigned u32x4 __attribute__((ext_vector_type(4)));
typedef unsigned u32x2 __attribute__((ext_vector_type(2)));

constexpr int D = 2048, SEQ = 16384, CTXL = 256, MT = SEQ + CTXL  , DEPTH = 2;
constexpr int NCOLS_IN = 17440;
constexpr int ZC = 17664;
constexpr int Z_HG = 0, Z_GL = 5120, Z_HY = 8192, Z_MG = 11264, Z_LR = 17408;
constexpr int NEXP = 32, DFF = 512, MOE_MAXROWS = 41472;
constexpr float NORM_EPS = 1e-6f;

constexpr size_t MiB = 1u << 20;
constexpr size_t WS_CTL = 0, CTL_BYTES = 1 * MiB;
constexpr size_t WS_SMALL = 1 * MiB;
constexpr size_t WS_MOD   = WS_SMALL;
constexpr size_t WS_ZBIAS = WS_MOD + (size_t)DEPTH * 2 * 12288 * 4;
constexpr size_t WS_LB    = WS_ZBIAS + (size_t)DEPTH * ZC * 4;
constexpr size_t WS_TW    = WS_LB + (size_t)DEPTH * 2 * 1024 * 4;
constexpr size_t WS_TW2   = WS_TW + 16384 * 8;
constexpr size_t WS_H2    = WS_TW2 + (8192 + 64) * 8;
constexpr size_t WS_ROUTE = WS_H2 + (size_t)DEPTH * MT * 64 * 4;
constexpr size_t WS_ROWW  = WS_ROUTE + (size_t)MT * 8 * 4;
constexpr size_t WS_TILEE = WS_ROWW + (size_t)MOE_MAXROWS * 4;
constexpr size_t WS_HYC   = WS_TILEE + 1024;
constexpr size_t WS_W3T   = WS_HYC + (size_t)2048 * 256 * 4;
constexpr size_t WS_H2B   = WS_W3T + (size_t)DEPTH * 2048 * 256 * 2;
constexpr size_t WS_SMALL_END = WS_H2B + (size_t)DEPTH * SEQ * 256 * 2;
static_assert(WS_SMALL_END <= 40 * MiB, "small tables");
constexpr size_t WS_WIN  = 40 * MiB;
constexpr size_t WS_WBR  = 109 * MiB;
constexpr size_t WS_WOUT = 121 * MiB;
constexpr size_t WS_WGU  = 129 * MiB;
constexpr size_t WS_CVO  = WS_WIN;
constexpr size_t WS_WD   = 257 * MiB;
constexpr size_t WS_H    = 321 * MiB;
constexpr size_t WS_U    = 451 * MiB;
constexpr size_t WS_Z    = 516 * MiB;
constexpr size_t WS_XP   = WS_Z;
constexpr size_t WS_HMID = WS_Z + 162 * MiB;
constexpr size_t WS_YP   = WS_Z + 203 * MiB;
constexpr size_t WS_YMIX = 1077 * MiB;
constexpr size_t WS_HF   = 1175 * MiB;
constexpr size_t WS_OSC  = 1175 * MiB;
constexpr size_t WS_END  = 1435 * MiB;
static_assert(WS_WIN + (size_t)ZC * D * 2 <= WS_WBR && WS_Z + (size_t)MT * ZC * 2 <= WS_YMIX && WS_YMIX + (size_t)3 * MT * 1024 * 2 <= WS_OSC && WS_OSC + (size_t)4 * MT * 1024 * 4 <= WS_END, "ws map");
static_assert(WS_YP + (size_t)MOE_MAXROWS * D * 2 <= WS_YMIX && WS_H + (size_t)MT * D * 4 <= WS_U && WS_U + (size_t)MT * D * 2 <= WS_Z, "ws map 2");
constexpr int CW_BAR = 4096;
constexpr int CW_CNT = 16384;

DI float bf2f(bf16 v) { return __uint_as_float(((unsigned)v) << 16); }
DI float bflo(unsigned w) { return __uint_as_float(w << 16); }
DI float bfhi(unsigned w) { return __uint_as_float(w & 0xffff0000u); }
typedef float f32x2_t __attribute__((ext_vector_type(2))); typedef __bf16 bf16x2_t __attribute__((ext_vector_type(2)));
DI unsigned pk_bf16(float lo, float hi) { f32x2_t v = {lo, hi}; bf16x2_t b = __builtin_convertvector(v, bf16x2_t); return __builtin_bit_cast(unsigned, b); }
DI bf16 f2bf(float f) { return (bf16)(pk_bf16(f, 0.f) & 0xffffu); }
DI float sigmoidf_(float x) { return 1.0f / (1.0f + __expf(-x)); }
DI float siluf_(float x) { return x / (1.0f + __expf(-x)); }
DI float wave_sum(float v) {
#pragma unroll
    for (int o = 32; o >= 1; o >>= 1) v += __shfl_xor(v, o);
    return v;
}
DI int otid() { int t = __builtin_amdgcn_workitem_id_x(); asm volatile("" : "+v"(t)); return t; }
DI int ogdim() { int g = __builtin_amdgcn_workgroup_id_x(); g = (int)gridDim.x; asm volatile("" : "+s"(g)); return g; }
DI int obid() { int b = __builtin_amdgcn_workgroup_id_x(); asm volatile("" : "+s"(b)); return b; }
#define AIN_DECL 1
namespace pg8 {
#define PG8_LAS __attribute__((address_space(3)))
typedef unsigned short bf16_t;
typedef short bf16x8 __attribute__((ext_vector_type(8)));
typedef float f32x4 __attribute__((ext_vector_type(4)));
typedef unsigned u32x4 __attribute__((ext_vector_type(4)));
constexpr int BM = 256, BK = 64, HALF = 128, HTB = HALF * BK * 2  , STAGE_BYTES = 8 * HTB, NXCD = 8, WGM = 8;

__host__ __device__ __forceinline__ int lds_byte(int r, int c) { const int st = (r >> 4) * 2 + (c >> 5), rr = r & 15, cc = c & 31, ob = rr * 64 + cc * 2; return st * 1024 + (ob ^ (((ob >> 9) & 1) << 5)); }
__host__ __device__ __forceinline__ void stage_rc(int b, int& R, int& C) { const int st = b / 1024, sb = b % 1024, swz = sb ^ (((sb >> 9) & 1) << 5); R = (st >> 1) * 16 + swz / 64; C = (st & 1) * 32 + (swz % 64) / 2; }
__host__ __device__ __forceinline__ int perm32(int rho) { const int n = rho >> 4, i = rho & 15; return 8 * (i >> 2) + 4 * n + (i & 3); }

struct Unit { int pm, pn; };
struct Gemm { const bf16_t* A; const bf16_t* Bt; int M, N, K; };

struct StaticOrder {
    int nM, nN, nwg, G, c;
    __host__ __device__ void init(int M, int N, int G_, int c_) { nM = M / BM; nN = N / BM; nwg = nM * nN; G = G_; c = c_; }
    __host__ __device__ bool next(int i, Unit& u) const {
        const long L = (long)i * G + c; if (L >= nwg) return false;
        int wgid = (int)L; { const int q = nwg / NXCD, r = nwg % NXCD, xcd = wgid % NXCD, off = wgid / NXCD; wgid = (xcd < r ? xcd * (q + 1) : r * (q + 1) + (xcd - r) * q) + off; }
        const int nig = WGM * nN, gid = wgid / nig, fm = gid * WGM, gsz = (nM - fm) < WGM ? (nM - fm) : WGM;
        u.pm = fm + ((wgid % nig) % gsz); u.pn = (wgid % nig) / gsz; return true;
    }
    __device__ __forceinline__ void a_ready(const Unit&) const {}
    __device__ __forceinline__ void done(const Unit&) const {}
};

template <class Epi, class Sched, bool ALIGN_EPI = false, bool SP2 = false>
__device__ __forceinline__ void gemm_phase(PG8_LAS unsigned char* lds, const Gemm g, const Sched& S, const Epi& E) {
    const int tid = otid(), wid = __builtin_amdgcn_readfirstlane(tid >> 6), lane = tid & 63, wr = wid >> 2, wc = wid & 3, fr = lane & 15, fq = lane >> 4;
    const int K = g.K, nt = K / BK;
    unsigned voffA[2], voffB[2];
#pragma unroll
    for (int i = 0; i < 2; ++i) { int R, C; stage_rc(tid * 16 + i * 8192, R, C); const int Rb = Epi::PERM ? ((R & ~31) + perm32(R & 31)) : R;
        voffA[i] = (unsigned)(R * K + C) * 2u; voffB[i] = (unsigned)(Rb * K + C) * 2u; }
    const size_t kstep = (size_t)(BK * 2);
    const size_t hstep = (size_t)HALF * K * 2;
    const size_t tstep = 2 * hstep;
    const unsigned ldsw = (unsigned)wid * 1024u;
    const int aoff = lds_byte(wr * 64 + fr, fq * 8), boff = lds_byte(wc * 32 + fr, fq * 8);
#define PG8_SA(b, h) (((b) * 2 + (h)) * HTB)
#define PG8_SB(b, h) ((4 + (b) * 2 + (h)) * HTB)
#define PG8_STAGE(bufoff, gbase, voff) do { _Pragma("unroll") for (int _i = 0; _i < 2; ++_i) \
        __builtin_amdgcn_global_load_lds((const unsigned*)((const char*)(gbase) + (voff)[_i]), (PG8_LAS unsigned*)(lds + (bufoff) + ldsw + _i * 8192), 16, 0, 0); } while (0)
#define PG8_LDA(dst, b, h) do { _Pragma("unroll") for (int m = 0; m < 4; ++m) _Pragma("unroll") for (int k = 0; k < 2; ++k) dst[m][k] = *(const PG8_LAS bf16x8*)(lds + PG8_SA(b, h) + aoff + m * 2048 + k * 1024); } while (0)
#define PG8_LDB(dst, b, h) do { _Pragma("unroll") for (int n = 0; n < 2; ++n) _Pragma("unroll") for (int k = 0; k < 2; ++k) dst[n][k] = *(const PG8_LAS bf16x8*)(lds + PG8_SB(b, h) + boff + n * 2048 + k * 1024); } while (0)
#define PG8_MMA(ai, bj, At, Bt) do { __builtin_amdgcn_s_setprio(1); _Pragma("unroll") for (int m = 0; m < 4; ++m) _Pragma("unroll") for (int n = 0; n < 2; ++n) _Pragma("unroll") for (int k = 0; k < 2; ++k) \
        acc[ai][bj][m][n] = __builtin_amdgcn_mfma_f32_16x16x32_bf16(Bt[n][k], At[m][k], acc[ai][bj][m][n], 0, 0, 0); __builtin_amdgcn_s_setprio(0); } while (0)
#define PG8_WAIT_V(n) asm volatile("s_waitcnt vmcnt(" #n ")" ::: "memory")
#define PG8_WAIT_L(n) asm volatile("s_waitcnt lgkmcnt(" #n ")" ::: "memory")
#define PG8_BAR __builtin_amdgcn_s_barrier()
#define PG8_SCHED __builtin_amdgcn_sched_barrier(0)
    Unit cur, nxt; int ui = 0;
    if (!S.next(0, cur)) return;
    f32x4 acc[2][2][4][2];
#pragma unroll
    for (int a = 0; a < 2; ++a)
#pragma unroll
        for (int b = 0; b < 2; ++b)
#pragma unroll
            for (int m = 0; m < 4; ++m)
#pragma unroll
                for (int n = 0; n < 2; ++n) acc[a][b][m][n] = (f32x4){0.f, 0.f, 0.f, 0.f};
    bf16x8 At[4][2], B0[2][2], B1[2][2];
    const char* cA = (const char*)g.A + (size_t)cur.pm * tstep; const char* cB = (const char*)g.Bt + (size_t)cur.pn * tstep;
    S.a_ready(cur);
    if constexpr (SP2) {
        PG8_STAGE(PG8_SB(0, 0), cB, voffB); PG8_STAGE(PG8_SB(0, 1), cB + hstep, voffB); PG8_STAGE(PG8_SA(0, 0), cA, voffA); PG8_STAGE(PG8_SA(0, 1), cA + hstep, voffA);
        if (wr == 1) PG8_BAR;
        PG8_WAIT_V(2); PG8_BAR;
        PG8_STAGE(PG8_SB(1, 0), cB + kstep, voffB); PG8_STAGE(PG8_SA(1, 0), cA + kstep, voffA); PG8_STAGE(PG8_SB(1, 1), cB + hstep + kstep, voffB);
        PG8_WAIT_V(6); PG8_BAR;
    } else {
        PG8_STAGE(PG8_SB(0, 0), cB, voffB); PG8_STAGE(PG8_SA(0, 0), cA, voffA); PG8_STAGE(PG8_SB(0, 1), cB + hstep, voffB); PG8_STAGE(PG8_SA(0, 1), cA + hstep, voffA);
        if (wr == 1) PG8_BAR;
        PG8_WAIT_V(4); PG8_BAR;
        PG8_STAGE(PG8_SB(1, 0), cB + kstep, voffB); PG8_STAGE(PG8_SA(1, 0), cA + kstep, voffA); PG8_STAGE(PG8_SB(1, 1), cB + hstep + kstep, voffB);
        PG8_WAIT_V(6); PG8_BAR;
    }
    for (;;) {
        const bool has_next = S.next(ui + 1, nxt);
        const char* nA = has_next ? (const char*)g.A + (size_t)nxt.pm * tstep : cA; const char* nB = has_next ? (const char*)g.Bt + (size_t)nxt.pn * tstep : cB;
        for (int t = 0; t < nt; t += 2) {
            const bool last = (t == nt - 2);
            const char* a1 = cA + (size_t)(t + 1) * kstep;
            const char* a2 = last ? nA : cA + (size_t)(t + 2) * kstep; const char* b2 = last ? nB : cB + (size_t)(t + 2) * kstep;
            const char* a3 = a2 + kstep; const char* b3 = b2 + kstep;
            if (last && has_next) S.a_ready(nxt);
            if constexpr (SP2) {
            PG8_LDB(B0, 0, 0); PG8_LDB(B1, 0, 1); PG8_SCHED; PG8_LDA(At, 0, 0); PG8_STAGE(PG8_SA(1, 1), a1 + hstep, voffA);
            PG8_WAIT_V(8); PG8_WAIT_L(0); PG8_BAR; PG8_MMA(0, 0, At, B0); PG8_MMA(0, 1, At, B1); PG8_BAR; PG8_SCHED;
            PG8_LDA(At, 0, 1); PG8_STAGE(PG8_SB(0, 0), b2, voffB); PG8_STAGE(PG8_SB(0, 1), b2 + hstep, voffB); PG8_STAGE(PG8_SA(0, 0), a2, voffA);
            PG8_WAIT_V(8); PG8_WAIT_L(0); PG8_BAR; PG8_MMA(1, 0, At, B0); PG8_MMA(1, 1, At, B1); PG8_BAR; PG8_SCHED;
            PG8_LDB(B0, 1, 0); PG8_LDB(B1, 1, 1); PG8_SCHED; PG8_LDA(At, 1, 0); PG8_STAGE(PG8_SA(0, 1), a2 + hstep, voffA);
            PG8_WAIT_V(8); PG8_WAIT_L(0); PG8_BAR; PG8_MMA(0, 0, At, B0); PG8_MMA(0, 1, At, B1); PG8_BAR; PG8_SCHED;
            PG8_LDA(At, 1, 1); PG8_STAGE(PG8_SB(1, 0), b3, voffB); PG8_STAGE(PG8_SB(1, 1), b3 + hstep, voffB); PG8_STAGE(PG8_SA(1, 0), a3, voffA);
            PG8_WAIT_V(8); PG8_WAIT_L(0); PG8_BAR; PG8_MMA(1, 0, At, B0); PG8_MMA(1, 1, At, B1); PG8_BAR; PG8_SCHED;
            } else {
            PG8_LDB(B0, 0, 0); PG8_SCHED; PG8_LDA(At, 0, 0); PG8_STAGE(PG8_SA(1, 1), a1 + hstep, voffA);
            PG8_WAIT_L(8); PG8_BAR; PG8_WAIT_L(0); PG8_MMA(0, 0, At, B0); PG8_BAR; PG8_SCHED;
            PG8_LDB(B1, 0, 1); PG8_STAGE(PG8_SB(0, 0), b2, voffB);
            PG8_BAR; PG8_WAIT_L(0); PG8_MMA(0, 1, At, B1); PG8_BAR;
            PG8_LDA(At, 0, 1); PG8_STAGE(PG8_SA(0, 0), a2, voffA);
            PG8_BAR; PG8_WAIT_L(0); PG8_MMA(1, 0, At, B0); PG8_BAR; PG8_SCHED;
            PG8_STAGE(PG8_SB(0, 1), b2 + hstep, voffB);
            PG8_WAIT_V(6); PG8_BAR; PG8_MMA(1, 1, At, B1); PG8_BAR;
            PG8_LDB(B0, 1, 0); PG8_SCHED; PG8_LDA(At, 1, 0); PG8_STAGE(PG8_SA(0, 1), a2 + hstep, voffA);
            PG8_WAIT_L(8); PG8_BAR; PG8_WAIT_L(0); PG8_MMA(0, 0, At, B0); PG8_BAR; PG8_SCHED;
            PG8_LDB(B1, 1, 1); PG8_STAGE(PG8_SB(1, 0), b3, voffB);
            PG8_BAR; PG8_WAIT_L(0); PG8_MMA(0, 1, At, B1); PG8_BAR;
            PG8_LDA(At, 1, 1); PG8_STAGE(PG8_SA(1, 0), a3, voffA);
            PG8_BAR; PG8_WAIT_L(0); PG8_MMA(1, 0, At, B0); PG8_BAR; PG8_SCHED;
            PG8_STAGE(PG8_SB(1, 1), b3 + hstep, voffB);
            PG8_WAIT_V(6); PG8_BAR; PG8_MMA(1, 1, At, B1); PG8_BAR;
            }
        }
        if constexpr (ALIGN_EPI) { if (wr == 0) PG8_BAR; }
        if constexpr (!Epi::AFTER_DRAIN) { E(acc, cur, wr, wc, fr, fq); S.done(cur); }
        if (!has_next) break;
#pragma unroll
        for (int a = 0; a < 2; ++a)
#pragma unroll
            for (int b = 0; b < 2; ++b)
#pragma unroll
                for (int m = 0; m < 4; ++m)
#pragma unroll
                    for (int n = 0; n < 2; ++n) acc[a][b][m][n] = (f32x4){0.f, 0.f, 0.f, 0.f};
        cur = nxt; cA = nA; cB = nB; ++ui;
        if constexpr (ALIGN_EPI) { if (wr == 1) PG8_BAR; }
    }
    PG8_WAIT_V(0);
    if constexpr (!ALIGN_EPI) { if (wr == 0) PG8_BAR; }
    PG8_BAR;
    if constexpr (Epi::AFTER_DRAIN) { E.fused(acc, cur, wr, wc, fr, fq, lds, wid, lane); S.done(cur); }
#undef PG8_SA
#undef PG8_SB
#undef PG8_STAGE
#undef PG8_LDA
#undef PG8_LDB
#undef PG8_MMA
#undef PG8_WAIT_V
#undef PG8_WAIT_L
#undef PG8_BAR
#undef PG8_SCHED
}
}
#define XB_TMO      128
#define XB_XCNT(j)  (256  + 64 * (j))
#define XB_XSUB(j)  (1280 + 64 * (j))
#define XB_XGEN(j)  (2304 + 64 * (j))
#define XB_TOP      3328
#define XB_TOPGEN   3392
#define XCD_BAR_WORDS 3456
#define XB_SPIN_CAP (1u << 18)

__device__ __forceinline__ unsigned xb_ld(unsigned* p)              { return __hip_atomic_load(p, __ATOMIC_RELAXED, __HIP_MEMORY_SCOPE_AGENT); }
__device__ __forceinline__ unsigned xb_add(unsigned* p, unsigned v) { return __hip_atomic_fetch_add(p, v, __ATOMIC_RELAXED, __HIP_MEMORY_SCOPE_AGENT); }
__device__ __forceinline__ unsigned xb_xcc_id() { return (unsigned)__builtin_amdgcn_s_getreg((3 << 11) | 20) & 0xFu; }
#define XB_SPIN(cond, bar) do { unsigned _sp = 0; while (cond) { __builtin_amdgcn_s_sleep(1); \
    if ((++_sp & 255u) == 0u) { if (xb_ld(&(bar)[XB_TMO])) break; if (_sp > XB_SPIN_CAP) { atomicAdd(&(bar)[XB_TMO], 1u); break; } } } } while (0)

struct XcdBarrier {
    unsigned* bar; unsigned x;
    volatile LAS unsigned* st;
};

__device__ __forceinline__ XcdBarrier xcd_barrier_post(unsigned* bar, volatile LAS unsigned* st) {
    XcdBarrier b; b.bar = bar; b.x = xb_xcc_id(); b.st = st;
    if (otid() == 0) (void)xb_add(&bar[XB_XCNT(b.x)], 1u);
    return b;
}
__device__ __forceinline__ void xcd_barrier_complete(unsigned* bar, unsigned x, unsigned& nloc, unsigned& nx) {
    asm volatile("" : "+s"(x));
    const unsigned G = ogdim();
    unsigned sum, cnt, mine, sp = 0u;
    for (;;) {
        sum = 0u; cnt = 0u; mine = 0u;
#pragma unroll
        for (unsigned j = 0; j < 16; ++j) { const unsigned c = xb_ld(&bar[XB_XCNT(j)]); sum += c; cnt += (c > 0u) ? 1u : 0u; mine = (j == x) ? c : mine; }
        if (sum == G) break;
        __builtin_amdgcn_s_sleep(1);
        if ((++sp & 255u) == 0u) { if (xb_ld(&bar[XB_TMO])) break; if (sp > XB_SPIN_CAP) { atomicAdd(&bar[XB_TMO], 1u); break; } }
    }
    nloc = mine > 0u ? mine : 1u; nx = cnt > 0u ? cnt : 1u;
}

__device__ __forceinline__ void xcd_barrier(const XcdBarrier& b) {
    asm volatile("s_waitcnt vmcnt(0)" ::: "memory");
    __syncthreads();
    if (otid() == 0) {
        unsigned* bar = b.bar;
        __builtin_amdgcn_s_waitcnt(0);
        unsigned nloc = b.st[0], nx = b.st[1];
        if (nloc == 0u) { xcd_barrier_complete(bar, b.x, nloc, nx); b.st[0] = nloc; b.st[1] = nx; }
        const unsigned old = xb_add(&bar[XB_XSUB(b.x)], 1u);
        const unsigned gen = old / nloc;
        if (old + 1u == (gen + 1u) * nloc) {
            __builtin_amdgcn_fence(__ATOMIC_RELEASE, "agent");
            asm volatile("s_waitcnt vmcnt(0)" ::: "memory");
            const unsigned og = xb_add(&bar[XB_TOP], 1u);
            const unsigned tg = og / nx;
            if (og + 1u == (tg + 1u) * nx) xb_add(&bar[XB_TOPGEN], 1u);
            else XB_SPIN(xb_ld(&bar[XB_TOPGEN]) == tg, bar);
            __builtin_amdgcn_fence(__ATOMIC_ACQUIRE, "agent");
            xb_add(&bar[XB_XGEN(b.x)], 1u);
            asm volatile("s_waitcnt vmcnt(0)" ::: "memory");
        } else {
            XB_SPIN(xb_ld(&bar[XB_XGEN(b.x)]) == gen, bar);
            __builtin_amdgcn_fence(__ATOMIC_ACQUIRE, "agent");
            asm volatile("s_waitcnt vmcnt(0)" ::: "memory");
        }
    }
    __syncthreads();
}

#define FFT_DI DI
#define FFT_M 16384
#define FFT_NT 512
struct cpx { float x, y; };
FFT_DI cpx cmul(cpx a, cpx b) { cpx r; r.x = a.x * b.x - a.y * b.y; r.y = a.x * b.y + a.y * b.x; return r; }
FFT_DI cpx cmulc(cpx a, cpx b) { cpx r; r.x = a.x * b.x + a.y * b.y; r.y = a.y * b.x - a.x * b.y; return r; }
FFT_DI int rev4_14(int k) {
    int r = 0;
#pragma unroll
    for (int d = 0; d < 7; ++d) { r = (r << 2) | (k & 3); k >>= 2; }
    return r;
}
template <int s, class LP, class TP> FFT_DI void fft_fwd_pass(LP lds, TP tw, int tid) {
    constexpr int tws = FFT_M / (4 * s);
#pragma unroll
    for (int b = tid; b < FFT_M / 4; b += FFT_NT) {
        const int pos = b & (s - 1), base = ((b & ~(s - 1)) << 2) + pos;
        cpx a0, a1, a2, a3;
        a0.x = lds[2 * base]; a0.y = lds[2 * base + 1];
        a1.x = lds[2 * (base + s)]; a1.y = lds[2 * (base + s) + 1];
        a2.x = lds[2 * (base + 2 * s)]; a2.y = lds[2 * (base + 2 * s) + 1];
        a3.x = lds[2 * (base + 3 * s)]; a3.y = lds[2 * (base + 3 * s) + 1];
        cpx t0, t1, t2, t3;
        t0.x = a0.x + a2.x; t0.y = a0.y + a2.y;
        t1.x = a0.x - a2.x; t1.y = a0.y - a2.y;
        t2.x = a1.x + a3.x; t2.y = a1.y + a3.y;
        t3.x = a1.x - a3.x; t3.y = a1.y - a3.y;
        cpx y0, y1, y2, y3;
        y0.x = t0.x + t2.x; y0.y = t0.y + t2.y;
        y2.x = t0.x - t2.x; y2.y = t0.y - t2.y;
        y1.x = t1.x + t3.y; y1.y = t1.y - t3.x;
        y3.x = t1.x - t3.y; y3.y = t1.y + t3.x;
        if (s > 1) {
            cpx w1, w2, w3;
            w1.x = tw[2 * (pos * tws)]; w1.y = tw[2 * (pos * tws) + 1];
            w2.x = tw[2 * (2 * pos * tws)]; w2.y = tw[2 * (2 * pos * tws) + 1];
            w3.x = tw[2 * (3 * pos * tws)]; w3.y = tw[2 * (3 * pos * tws) + 1];
            y1 = cmul(y1, w1); y2 = cmul(y2, w2); y3 = cmul(y3, w3);
        }
        lds[2 * base] = y0.x; lds[2 * base + 1] = y0.y;
        lds[2 * (base + s)] = y1.x; lds[2 * (base + s) + 1] = y1.y;
        lds[2 * (base + 2 * s)] = y2.x; lds[2 * (base + 2 * s) + 1] = y2.y;
        lds[2 * (base + 3 * s)] = y3.x; lds[2 * (base + 3 * s) + 1] = y3.y;
    }
}
template <int s, class LP, class TP> FFT_DI void fft_inv_pass(LP lds, TP tw, int tid) {
    constexpr int tws = FFT_M / (4 * s);
#pragma unroll
    for (int b = tid; b < FFT_M / 4; b += FFT_NT) {
        const int pos = b & (s - 1), base = ((b & ~(s - 1)) << 2) + pos;
        cpx b0, c1, c2, c3;
        b0.x = lds[2 * base]; b0.y = lds[2 * base + 1];
        c1.x = lds[2 * (base + s)]; c1.y = lds[2 * (base + s) + 1];
        c2.x = lds[2 * (base + 2 * s)]; c2.y = lds[2 * (base + 2 * s) + 1];
        c3.x = lds[2 * (base + 3 * s)]; c3.y = lds[2 * (base + 3 * s) + 1];
        if (s > 1) {
            cpx w1, w2, w3;
            w1.x = tw[2 * (pos * tws)]; w1.y = tw[2 * (pos * tws) + 1];
            w2.x = tw[2 * (2 * pos * tws)]; w2.y = tw[2 * (2 * pos * tws) + 1];
            w3.x = tw[2 * (3 * pos * tws)]; w3.y = tw[2 * (3 * pos * tws) + 1];
            c1 = cmulc(c1, w1); c2 = cmulc(c2, w2); c3 = cmulc(c3, w3);
        }
        cpx t0, t1, t2, t3;
        t0.x = b0.x + c2.x; t0.y = b0.y + c2.y;
        t1.x = b0.x - c2.x; t1.y = b0.y - c2.y;
        t2.x = c1.x + c3.x; t2.y = c1.y + c3.y;
        t3.x = c1.x - c3.x; t3.y = c1.y - c3.y;
        cpx x0, x1, x2, x3;
        x0.x = t0.x + t2.x; x0.y = t0.y + t2.y;
        x2.x = t0.x - t2.x; x2.y = t0.y - t2.y;
        x1.x = t1.x - t3.y; x1.y = t1.y + t3.x;
        x3.x = t1.x + t3.y; x3.y = t1.y - t3.x;
        lds[2 * base] = x0.x; lds[2 * base + 1] = x0.y;
        lds[2 * (base + s)] = x1.x; lds[2 * (base + s) + 1] = x1.y;
        lds[2 * (base + 2 * s)] = x2.x; lds[2 * (base + 2 * s) + 1] = x2.y;
        lds[2 * (base + 3 * s)] = x3.x; lds[2 * (base + 3 * s) + 1] = x3.y;
    }
}
template <class LP, class TP> FFT_DI void rfft_untangle(LP lds, TP tw2, int k, cpx& Xk, cpx& Xm) {
    if (k == 0) {
        const float zr = lds[0], zi = lds[1];
        Xk.x = zr + zi; Xk.y = zr - zi;
        const int p = rev4_14(FFT_M / 2);
        Xm.x = lds[2 * p]; Xm.y = -lds[2 * p + 1];
        return;
    }
    const int pk = rev4_14(k), pm = rev4_14(FFT_M - k);
    cpx Zk, Zm; Zk.x = lds[2 * pk]; Zk.y = lds[2 * pk + 1]; Zm.x = lds[2 * pm]; Zm.y = lds[2 * pm + 1];
    cpx E, O, W, WO;
    E.x = 0.5f * (Zk.x + Zm.x); E.y = 0.5f * (Zk.y - Zm.y);
    O.x = 0.5f * (Zk.y + Zm.y); O.y = -0.5f * (Zk.x - Zm.x);
    W.x = tw2[2 * k]; W.y = tw2[2 * k + 1];
    WO = cmul(W, O);
    Xk.x = E.x + WO.x; Xk.y = E.y + WO.y;
    Xm.x = E.x - WO.x; Xm.y = -(E.y - WO.y);
}
template <class LP, class TP> FFT_DI void rfft_mul_retangle(LP lds, TP tw2, int k, cpx Gk, cpx Gm) {
    cpx Xk, Xm; rfft_untangle(lds, tw2, k, Xk, Xm);
    if (k == 0) {
        const float y0 = Xk.x * Gk.x, yM = Xk.y * Gk.y;
        lds[0] = 0.5f * (y0 + yM); lds[1] = 0.5f * (y0 - yM);
        const cpx Y = cmul(Xm, Gm);
        const int p = rev4_14(FFT_M / 2);
        lds[2 * p] = Y.x; lds[2 * p + 1] = -Y.y;
        return;
    }
    const cpx Yk = cmul(Xk, Gk), Ym = cmul(Xm, Gm);
    cpx W; W.x = tw2[2 * k]; W.y = tw2[2 * k + 1];
    cpx A, D, T;
    A.x = 0.5f * (Yk.x + Ym.x); A.y = 0.5f * (Yk.y - Ym.y);
    D.x = 0.5f * (Yk.x - Ym.x); D.y = 0.5f * (Yk.y + Ym.y);
    T = cmulc(D, W);
    const int pk = rev4_14(k), pm = rev4_14(FFT_M - k);
    lds[2 * pk] = A.x - T.y; lds[2 * pk + 1] = A.y + T.x;
    cpx Dc; Dc.x = -D.x; Dc.y = D.y;
    const cpx T2 = cmul(W, Dc);
    lds[2 * pm] = A.x + T2.y; lds[2 * pm + 1] = -A.y - T2.x;
}
enum { I_X = 0, I_C, I_CTX, I_CCTX, I_WMOD, I_BMOD, I_NMIXW, I_NFFNW, I_WIN, I_BIN, I_HYCW, I_HYCB, I_HYW1, I_HYB1, I_HYW2, I_HYB2, I_HYW3, I_HYB3, I_HYFREQ, I_HYSKIP,
       I_HGLB, I_HGNW, I_GLWA2, I_GLBA, I_GLNW, I_WBR, I_WOUT, I_WRG, I_BRG, I_WRE, I_BRE, I_WGATE, I_WUP, I_WDOWN, I_FNW, N_IN };
struct Args { const float* in[N_IN]; float* out; unsigned char* ws; int ph_lo, ph_hi; };
extern __shared__ __attribute__((aligned(16))) unsigned char lds_raw[];
constexpr int LDS_PTAB = 150 * 1024 - 64 - 320;
DI LAS unsigned char* ldsbase() { unsigned p = (unsigned)(unsigned long long)(LAS unsigned char*)lds_raw; asm volatile("" : "+s"(p)); return (LAS unsigned char*)(unsigned long long)p; }
DI const float* ain(const Args&, int i) { const unsigned long long v = ((LAS unsigned long long*)(ldsbase() + LDS_PTAB))[i];
    const unsigned lo = __builtin_amdgcn_readfirstlane((unsigned)v), hi = __builtin_amdgcn_readfirstlane((unsigned)(v >> 32)); return (const float*)(((unsigned long long)hi << 32) | lo); }
DI unsigned char* wsp(const Args& a) { unsigned long long p = (unsigned long long)(a).ws; asm volatile("" : "+s"(p)); return (unsigned char*)p; }
DI int opq(int x) { asm volatile("" : "+s"(x)); return x; }
constexpr int NTHR = 512;
constexpr int LDS_BYTES = 150 * 1024;
constexpr int LDS_X = 131072;
constexpr int LDS_BARW = LDS_BYTES - 64;

DI int z_srccol(int zc) { return zc < 8192 ? zc : (zc < Z_LR ? zc + 32 : (zc < Z_LR + 32 ? zc - Z_LR + 8192 : -1)); }

DI void cvt_block(const float* __restrict__ s0, const float* __restrict__ s1, const float* __restrict__ s2, const float* __restrict__ s3, size_t ld, int c0, int c1, int c2, int c3,
                  bf16* __restrict__ dst, int K, int row0, int kb, LAS float* t) {
    const int tid = otid(), nn = tid & 63, kk = tid >> 6;
    float v[8][4];
#pragma unroll
    for (int p = 0; p < 8; ++p) { const size_t ko = (size_t)(kb * 64 + p * 8 + kk) * ld;
        v[p][0] = c0 >= 0 ? s0[ko + c0] : 0.f; v[p][1] = c1 >= 0 ? s1[ko + c1] : 0.f; v[p][2] = c2 >= 0 ? s2[ko + c2] : 0.f; v[p][3] = c3 >= 0 ? s3[ko + c3] : 0.f; }
#pragma unroll
    for (int p = 0; p < 8; ++p)
#pragma unroll
        for (int g = 0; g < 4; ++g) t[(p * 8 + kk) * 257 + g * 64 + nn] = v[p][g];
    __syncthreads();
    const int rr = tid & 255, hk = tid >> 8;
#pragma unroll
    for (int q = 0; q < 4; ++q) { float w[8];
#pragma unroll
        for (int j = 0; j < 8; ++j) w[j] = t[(hk * 32 + q * 8 + j) * 257 + rr];
        u32x4 o; o.x = pk_bf16(w[0], w[1]); o.y = pk_bf16(w[2], w[3]); o.z = pk_bf16(w[4], w[5]); o.w = pk_bf16(w[6], w[7]);
        *(u32x4*)(dst + (size_t)(row0 + rr) * K + kb * 64 + hk * 32 + q * 8) = o; }
    __syncthreads();
}
constexpr int CVT_MIX_TILES = 69 * 32 + 3 * 8 * 16 + 8 * 32;
DI void cvt_mix_item(const Args& a, int l, int it, LAS float* t) {
    const int nn = otid() & 63;
    if (it < 69 * 32) { const int nb = it >> 5, kb = it & 31; const float* s = ain(a, I_WIN) + (size_t)l * D * NCOLS_IN;
        cvt_block(s, s, s, s, NCOLS_IN, z_srccol(nb * 256 + nn), z_srccol(nb * 256 + 64 + nn), z_srccol(nb * 256 + 128 + nn), z_srccol(nb * 256 + 192 + nn), (bf16*)(wsp(a) + WS_WIN), D, nb * 256, kb, t); return; }
    it -= 69 * 32;
    if (it < 3 * 8 * 16) { const int br = it / 128, r = it % 128, nb = r >> 4, kb = r & 15; const float* s = ain(a, I_WBR) + ((size_t)l * 3 + br) * 1024 * D; const int c = nb * 256 + nn;
        cvt_block(s, s, s, s, D, c, c + 64, c + 128, c + 192, (bf16*)(wsp(a) + WS_WBR) + (size_t)br * D * 1024, 1024, nb * 256, kb, t); return; }
    it -= 3 * 8 * 16;
    { const int nb = it >> 5, kb = it & 31; const float* s = ain(a, I_WOUT) + (size_t)l * D * D; const int c = nb * 256 + nn;
      cvt_block(s, s, s, s, D, c, c + 64, c + 128, c + 192, (bf16*)(wsp(a) + WS_WOUT), D, nb * 256, kb, t); }
}
constexpr int CVT_MOE_TILES = 32 * 4 * 32 + 32 * 8 * 8;
DI void cvt_moe_item(const Args& a, int l, int it, LAS float* t) {
    const int nn = otid() & 63;
    if (it < 32 * 4 * 32) { const int e = it >> 7, r = it & 127, nt = r >> 5, kb = r & 31;
        const float* sg = ain(a, I_WGATE) + ((size_t)l * NEXP + e) * D * DFF; const float* su = ain(a, I_WUP) + ((size_t)l * NEXP + e) * D * DFF; const int c = nt * 128 + nn;
        cvt_block(sg, sg, su, su, DFF, c, c + 64, c, c + 64, (bf16*)(wsp(a) + WS_WGU) + (size_t)e * 1024 * D, D, nt * 256, kb, t); return; }
    it -= 32 * 4 * 32;
    { const int e = it >> 6, r = it & 63, nb = r >> 3, kb = r & 7; const float* s = ain(a, I_WDOWN) + ((size_t)l * NEXP + e) * DFF * D; const int c = nb * 256 + nn;
      cvt_block(s, s, s, s, D, c, c + 64, c + 128, c + 192, (bf16*)(wsp(a) + WS_WD) + (size_t)e * D * DFF, DFF, nb * 256, kb, t); }
}

DI void mod_item(const Args& a, int j, LAS float* lds) {
    const int tid = otid(), l = j >> 7, col0 = (j & 127) * 96;
    LAS float* sil = lds;
    LAS float* red = lds + 4096;
    for (int k = tid; k < 2 * D; k += NTHR) { const float c = (k < D) ? ain(a, I_C)[k] : ain(a, I_CCTX)[k - D]; sil[k] = siluf_(c); }
    __syncthreads();
    const int cg = tid % 24, rg = tid / 24;
    f32x4 a0 = {0.f, 0.f, 0.f, 0.f}, a1 = {0.f, 0.f, 0.f, 0.f};
    if (rg < 21) {
        const float* w = ain(a, I_WMOD) + (size_t)l * D * 12288 + col0 + cg * 4;
        for (int k = rg; k < D; k += 21) { const f32x4 wv = *(const f32x4*)(w + (size_t)k * 12288); a0 += wv * sil[k]; a1 += wv * sil[D + k]; }
#pragma unroll
        for (int q = 0; q < 4; ++q) { red[(rg * 2 + 0) * 96 + cg * 4 + q] = a0[q]; red[(rg * 2 + 1) * 96 + cg * 4 + q] = a1[q]; }
    }
    __syncthreads();
    if (tid < 192) { const int set = tid / 96, c = tid % 96; float s = 0.f;
        for (int r = 0; r < 21; ++r) s += red[(r * 2 + set) * 96 + c];
        ((float*)(wsp(a) + WS_MOD))[((size_t)l * 2 + set) * 12288 + col0 + c] = s + ain(a, I_BMOD)[(size_t)l * 12288 + col0 + c]; }
    __syncthreads();
}
DI void h2_item(const Args& a, int it, LAS float* lds) {
    const int tid = otid(), l = it / (MT / 8), r0 = (it % (MT / 8)) * 8;
    LAS float* feats = lds;
    LAS float* h1 = lds + 8 * 36;
    if (tid < 8 * 33) { const int rr = tid / 33, i = tid % 33, r = r0 + rr; const int Lq = r < SEQ ? SEQ : CTXL, t = r < SEQ ? r : r - SEQ;
        float f;
        if (i == 0) f = (float)t / (float)(Lq - 1);
        else { const int bi = (i - 1) & 15; const float band = 1e-4f + (float)bi * ((15.0f - 1e-4f) / 15.0f); const float rev2 = 2.0f * band * (float)t / (float)Lq;
            f = (i <= 16) ? cospif(rev2) : -sinpif(rev2); }
        feats[rr * 36 + i] = f; }
    __syncthreads();
    const int rr = tid >> 6, j = tid & 63;
    { const float* w1 = ain(a, I_HYW1) + (size_t)l * 33 * 64; float s = ain(a, I_HYB1)[l * 64 + j];
      for (int i = 0; i < 33; ++i) s += feats[rr * 36 + i] * w1[i * 64 + j];
      h1[rr * 64 + j] = sinf(ain(a, I_HYFREQ)[l * 64 + j] * s); }
    __syncthreads();
    { const float* w2 = ain(a, I_HYW2) + (size_t)l * 64 * 64; float s = ain(a, I_HYB2)[l * 64 + j];
      for (int i = 0; i < 64; ++i) s += h1[rr * 64 + i] * w2[i * 64 + j];
      const float hv = sinf(ain(a, I_HYFREQ)[l * 64 + j] * s);
      ((float*)(wsp(a) + WS_H2))[((size_t)l * MT + r0 + rr) * 64 + j] = hv;
      if (r0 + rr < SEQ) { bf16* hb = (bf16*)(wsp(a) + WS_H2B) + ((size_t)l * SEQ + r0 + rr) * 256; hb[j] = f2bf(hv); hb[64 + j] = 0; hb[128 + j] = 0; hb[192 + j] = 0; } }
    __syncthreads();
}
DI void prologue_small(const Args& a) {
    const size_t gt = (size_t)obid() * NTHR + otid(), gs = (size_t)ogdim() * NTHR;
    float* zb = (float*)(wsp(a) + WS_ZBIAS);
    for (size_t i = gt; i < (size_t)DEPTH * ZC; i += gs) { const int l = (int)(i / ZC), zc = (int)(i % ZC), sc = z_srccol(zc); zb[i] = sc >= 0 ? ain(a, I_BIN)[(size_t)l * NCOLS_IN + sc] : 0.f; }
    float* lb = (float*)(wsp(a) + WS_LB);
    for (size_t i = gt; i < (size_t)DEPTH * 2048; i += gs) { const int l = (int)(i / 2048), j = (int)(i % 2048);
        float v = 0.f; if (l == 1) { const float r0 = ain(a, I_HGLB)[j], r1 = ain(a, I_HGLB)[2048 + j]; v = 1.0f / (1.0f + expf(r0 - r1)); }
        lb[i] = v; }
    bf16* w3t = (bf16*)(wsp(a) + WS_W3T);
    for (size_t i = gt; i < (size_t)DEPTH * 2048 * 256; i += gs) { const int l = (int)(i >> 19), fc = (int)((i >> 8) & 2047), j = (int)(i & 255); w3t[i] = j < 64 ? f2bf(ain(a, I_HYW3)[((size_t)l * 64 + j) * 2048 + fc]) : (bf16)0; }
    float* tw = (float*)(wsp(a) + WS_TW);
    for (size_t i = gt; i < 16384; i += gs) { float s, c; sincospif(-2.0f * (float)i / 16384.0f, &s, &c); tw[2 * i] = c; tw[2 * i + 1] = s; }
    float* tw2 = (float*)(wsp(a) + WS_TW2);
    for (size_t i = gt; i <= 8192; i += gs) { float s, c; sincospif(-(float)i / 16384.0f, &s, &c); tw2[2 * i] = c; tw2[2 * i + 1] = s; }
}
DI void hyc_filters(const Args& a, int l) {
    const int lane = otid() & 63, wave = otid() >> 6;
    const float* h2 = (const float*)(wsp(a) + WS_H2) + ((size_t)l * MT + SEQ) * 64;
    const float* w3 = ain(a, I_HYW3) + (size_t)l * 64 * 2048;
    float* hyc = (float*)(wsp(a) + WS_HYC);
    const float a0 = -4.605170186f / 1.5f, a1 = -4.605170186f / 0.3f;
    for (int fc = obid() * 8 + wave; fc < 2048; fc += ogdim() * 8) {
        const int c = fc & 1023; const float delta = fabsf(a0 + (float)c * ((a1 - a0) / 1023.0f)); const float b3 = ain(a, I_HYB3)[l * 2048 + fc];
        float hv[4], ssum = 0.f;
#pragma unroll
        for (int i = 0; i < 4; ++i) { const int t = lane + 64 * i; float s = b3;
            for (int j = 0; j < 64; ++j) s += h2[t * 64 + j] * w3[j * 2048 + fc];
            const float tl = (float)t / 255.0f; hv[i] = s * (expf(-tl * delta) + 0.05f); ssum += fabsf(hv[i]); }
        ssum = wave_sum(ssum); const float inv = 1.0f / ssum;
#pragma unroll
        for (int i = 0; i < 4; ++i) hyc[(size_t)fc * 256 + lane + 64 * i] = hv[i] * inv;
    }
}
template <int MODE> DI void norm_phase(const Args& a, int l, int nrows, LAS float* ldsf) {
    const int lane = otid() & 63, wave = otid() >> 6;
    float* H = (float*)(wsp(a) + WS_H); bf16* U = (bf16*)(wsp(a) + WS_U);
    const float* modall = (const float*)(wsp(a) + WS_MOD);
    int* route = (int*)(wsp(a) + WS_ROUTE);
    const bf16* YP = (const bf16*)(wsp(a) + WS_YP);
    const bool combine = (MODE == 0 && l > 0) || MODE == 2;
    for (int r = obid() * 8 + wave; r < nrows; r += ogdim() * 8) {
        const int set = r >= SEQ ? 1 : 0;
        const float* src = (MODE == 0 && l == 0) ? (set ? ain(a, I_CTX) + (size_t)(r - SEQ) * D : ain(a, I_X) + (size_t)r * D) : H + (size_t)r * D;
        f32x4 v[8];
#pragma unroll
        for (int j = 0; j < 8; ++j) v[j] = *(const f32x4*)(src + j * 256 + lane * 4);
        if (combine) {
            const float* gt2 = modall + ((size_t)(l - 1) * 2 + set) * 12288 + 10240;
            const int p0 = route[r * 8 + 6], p1 = route[r * 8 + 7];
#pragma unroll
            for (int j = 0; j < 8; ++j) { const int col = j * 256 + lane * 4;
                const u32x2 y0 = *(const u32x2*)(YP + (size_t)p0 * D + col), y1 = *(const u32x2*)(YP + (size_t)p1 * D + col); const f32x4 g = *(const f32x4*)(gt2 + col);
                v[j][0] += g[0] * (bflo(y0.x) + bflo(y1.x)); v[j][1] += g[1] * (bfhi(y0.x) + bfhi(y1.x)); v[j][2] += g[2] * (bflo(y0.y) + bflo(y1.y)); v[j][3] += g[3] * (bfhi(y0.y) + bfhi(y1.y)); }
            if (MODE == 0) {
#pragma unroll
                for (int j = 0; j < 8; ++j) *(f32x4*)(H + (size_t)r * D + j * 256 + lane * 4) = v[j];
            }
        }
        float ss = 0.f;
#pragma unroll
        for (int j = 0; j < 8; ++j) ss += (v[j][0] * v[j][0] + v[j][1] * v[j][1]) + (v[j][2] * v[j][2] + v[j][3] * v[j][3]);
        ss = wave_sum(ss);
        const float rstd = rsqrtf(ss * (1.0f / D) + NORM_EPS);
        if (MODE == 2) {
            const float* fw = ain(a, I_FNW);
#pragma unroll
            for (int j = 0; j < 8; ++j) { const int col = j * 256 + lane * 4; const f32x4 w = *(const f32x4*)(fw + col); *(f32x4*)(a.out + (size_t)r * D + col) = v[j] * rstd * w; }
        } else {
            const float* nw = (MODE == 0 ? ain(a, I_NMIXW) : ain(a, I_NFFNW)) + (size_t)l * D;
            const float* md = modall + ((size_t)l * 2 + set) * 12288 + (MODE == 0 ? 0 : 6144);
#pragma unroll
            for (int j = 0; j < 8; ++j) { const int col = j * 256 + lane * 4; const f32x4 w = *(const f32x4*)(nw + col), sh = *(const f32x4*)(md + col), sc = *(const f32x4*)(md + 2048 + col);
                v[j] = (v[j] * rstd * w) * (sc + 1.0f) + sh;
                u32x2 o; o.x = pk_bf16(v[j][0], v[j][1]); o.y = pk_bf16(v[j][2], v[j][3]); *(u32x2*)(U + (size_t)r * D + col) = o; }
            if (MODE == 1) {
                const float* wrg = ain(a, I_WRG) + (size_t)l * D * 4; const float* wre = ain(a, I_WRE) + (size_t)l * D * 32;
                float lg[36];
#pragma unroll
                for (int i = 0; i < 36; ++i) lg[i] = 0.f;
                LAS float* wu = ldsf + wave * 2048;
#pragma unroll
                for (int j = 0; j < 8; ++j) *(LAS f32x4*)(wu + j * 256 + lane * 4) = v[j];
                asm volatile("s_waitcnt lgkmcnt(0)" ::: "memory");
#pragma unroll 2
                for (int cc = 0; cc < 32; ++cc) { const int col = cc * 64 + lane; const float uv = wu[col];
                    const f32x4 g = *(const f32x4*)(wrg + (size_t)col * 4);
                    lg[0] += uv * g[0]; lg[1] += uv * g[1]; lg[2] += uv * g[2]; lg[3] += uv * g[3];
#pragma unroll
                    for (int e4 = 0; e4 < 8; ++e4) { const f32x4 w = *(const f32x4*)(wre + (size_t)col * 32 + e4 * 4);
                        lg[4 + e4 * 4 + 0] += uv * w[0]; lg[4 + e4 * 4 + 1] += uv * w[1]; lg[4 + e4 * 4 + 2] += uv * w[2]; lg[4 + e4 * 4 + 3] += uv * w[3]; } }
                asm volatile("s_waitcnt lgkmcnt(0)" ::: "memory");
#pragma unroll
                for (int i = 0; i < 36; ++i) lg[i] = wave_sum(lg[i]);
                float gl[4]; int grp = 0; float gmax;
#pragma unroll
                for (int g = 0; g < 4; ++g) gl[g] = lg[g] + ain(a, I_BRG)[l * 4 + g];
                gmax = gl[0];
#pragma unroll
                for (int g = 1; g < 4; ++g) if (gl[g] > gmax) { gmax = gl[g]; grp = g; }
                float gden = 0.f;
#pragma unroll
                for (int g = 0; g < 4; ++g) gden += expf(gl[g] - gmax);
                const float ptop = 1.0f / gden;
                float le[8];
#pragma unroll
                for (int i = 0; i < 8; ++i) { float x = lg[4 + i];
#pragma unroll
                    for (int g = 1; g < 4; ++g) x = (grp == g) ? lg[4 + g * 8 + i] : x;
                    le[i] = x + ain(a, I_BRE)[l * 32 + grp * 8 + i]; }
                int i0 = 0; float m0 = le[0];
#pragma unroll
                for (int i = 1; i < 8; ++i) if (le[i] > m0) { m0 = le[i]; i0 = i; }
                int i1 = -1; float m1 = -3.0e38f;
#pragma unroll
                for (int i = 0; i < 8; ++i) if (i != i0 && le[i] > m1) { m1 = le[i]; i1 = i; }
                const float e1v = expf(m1 - m0);
                const float w0 = ptop / (1.0f + e1v), w1 = ptop * e1v / (1.0f + e1v);
                if (lane == 0) {
                    unsigned* cnt = (unsigned*)(wsp(a) + WS_CTL) + CW_CNT + l * 64;
                    const int ex0 = grp * 8 + i0, ex1 = grp * 8 + i1;
                    const unsigned s0 = atomicAdd(cnt + ex0, 1u), s1 = atomicAdd(cnt + ex1, 1u);
                    route[r * 8 + 0] = ex0; route[r * 8 + 1] = ex1; route[r * 8 + 2] = (int)s0; route[r * 8 + 3] = (int)s1;
                    route[r * 8 + 4] = __float_as_int(w0); route[r * 8 + 5] = __float_as_int(w1);
                }
            }
        }
    }
}
DI void permute_phase(const Args& a, int l, int nrows, LAS unsigned char* ldsb) {
    LAS int* poff = (LAS int*)ldsb;
    const int tid = otid(), lane = tid & 63, wave = tid >> 6;
    const unsigned* cnt = (const unsigned*)(wsp(a) + WS_CTL) + CW_CNT + l * 64;
    if (tid == 0) { int off = 0; for (int e = 0; e < NEXP; ++e) { poff[e] = off; off += (int)((cnt[e] + 255u) / 256u) * 256; } poff[32] = off; }
    __syncthreads();
    if (obid() == 0) { int* tile_e = (int*)(wsp(a) + WS_TILEE); const int nt = poff[32] >> 8;
        if (tid < 200) { int e = -1; if (tid < nt) { for (int q = 0; q < NEXP; ++q) if (poff[q] <= tid * 256) e = q; } tile_e[tid] = e < 0 ? 0 : e; }
        if (tid == 0) tile_e[200] = nt; }
    int* route = (int*)(wsp(a) + WS_ROUTE); float* roww = (float*)(wsp(a) + WS_ROWW);
    const bf16* U = (const bf16*)(wsp(a) + WS_U); bf16* XP = (bf16*)(wsp(a) + WS_XP);
    for (int r = obid() * 8 + wave; r < nrows; r += ogdim() * 8) {
        const int e0 = route[r * 8 + 0], e1 = route[r * 8 + 1], s0 = route[r * 8 + 2], s1 = route[r * 8 + 3];
        const int p0 = poff[e0] + s0, p1 = poff[e1] + s1;
        u32x4 x[4];
#pragma unroll
        for (int i = 0; i < 4; ++i) x[i] = *(const u32x4*)(U + (size_t)r * D + (i * 64 + lane) * 8);
#pragma unroll
        for (int i = 0; i < 4; ++i) { *(u32x4*)(XP + (size_t)p0 * D + (i * 64 + lane) * 8) = x[i]; *(u32x4*)(XP + (size_t)p1 * D + (i * 64 + lane) * 8) = x[i]; }
        if (lane == 0) { route[r * 8 + 6] = p0; route[r * 8 + 7] = p1; roww[p0] = __int_as_float(route[r * 8 + 4]); roww[p1] = __int_as_float(route[r * 8 + 5]); }
    }
}
DI int stream_row(int p, int dir) { return dir == 0 ? (p < CTXL ? SEQ + p : p - CTXL) : (p < CTXL ? SEQ + (CTXL - 1 - p) : (SEQ - 1) - (p - CTXL)); }

DI void shortconv8(const bf16* Z, const float* cw, const float* cb, int l, int seg, int c, int r0, int lo, int hi, float (&out)[8]) {
    const int col = Z_HY + seg * 1024 + c; float zz[10];
#pragma unroll
    for (int i = 0; i < 10; ++i) { const int r = r0 - 1 + i; zz[i] = (r >= lo && r < hi) ? bf2f(Z[(size_t)r * ZC + col]) : 0.f; }
    const float w0 = cw[((size_t)l * 3 + 0) * 3072 + seg * 1024 + c], w1 = cw[((size_t)l * 3 + 1) * 3072 + seg * 1024 + c], w2 = cw[((size_t)l * 3 + 2) * 3072 + seg * 1024 + c], b = cb[(size_t)l * 3072 + seg * 1024 + c];
#pragma unroll
    for (int i = 0; i < 8; ++i) out[i] = w0 * zz[i] + w1 * zz[i + 1] + w2 * zz[i + 2] + b;
}
DI void hyprep_item(const Args& a, int l, int it, LAS float* t) {
    const int tid = otid(), tb = it >> 4, cb = it & 15, r0 = tb * 64, lo = r0 < SEQ ? 0 : SEQ, hi = r0 < SEQ ? SEQ : MT;
    const bf16* Z = (const bf16*)(wsp(a) + WS_Z); float* VXT = (float*)(wsp(a) + WS_U);
    { const int cc = tid & 63, tq = tid >> 6, c = cb * 64 + cc; float x1[8], vv[8];
      shortconv8(Z, ain(a, I_HYCW), ain(a, I_HYCB), l, 1, c, r0 + tq * 8, lo, hi, x1); shortconv8(Z, ain(a, I_HYCW), ain(a, I_HYCB), l, 2, c, r0 + tq * 8, lo, hi, vv);
#pragma unroll
      for (int i = 0; i < 8; ++i) t[cc * 65 + tq * 8 + i] = vv[i] * x1[i]; }
    __syncthreads();
    { const int cw = tid >> 3, t8 = tid & 7; f32x4 o0, o1;
#pragma unroll
      for (int i = 0; i < 4; ++i) { o0[i] = t[cw * 65 + t8 * 8 + i]; o1[i] = t[cw * 65 + t8 * 8 + 4 + i]; }
      float* dst = VXT + (size_t)(cb * 64 + cw) * MT + r0 + t8 * 8; *(f32x4*)dst = o0; *(f32x4*)(dst + 4) = o1; }
    __syncthreads();
}
DI void hycomb_item(const Args& a, int l, int it, LAS float* t) {
    const int tid = otid(), tb = it >> 4, cb = it & 15, r0 = tb * 64, lo = r0 < SEQ ? 0 : SEQ, hi = r0 < SEQ ? SEQ : MT;
    const bf16* Z = (const bf16*)(wsp(a) + WS_Z); const float* VXT = (const float*)(wsp(a) + WS_CVO); bf16* Y0 = (bf16*)(wsp(a) + WS_YMIX);
    { const int cw = tid >> 3, t8 = tid & 7; const float* srcp = VXT + (size_t)(cb * 64 + cw) * MT + r0 + t8 * 8; const f32x4 i0 = *(const f32x4*)srcp, i1 = *(const f32x4*)(srcp + 4);
#pragma unroll
      for (int i = 0; i < 4; ++i) { t[cw * 65 + t8 * 8 + i] = i0[i]; t[cw * 65 + t8 * 8 + 4 + i] = i1[i]; } }
    __syncthreads();
    { const int cc = tid & 63, tq = tid >> 6, c = cb * 64 + cc; float x0[8];
      shortconv8(Z, ain(a, I_HYCW), ain(a, I_HYCB), l, 0, c, r0 + tq * 8, lo, hi, x0);
#pragma unroll
      for (int i = 0; i < 8; ++i) Y0[(size_t)(r0 + tq * 8 + i) * 1024 + c] = f2bf(t[cc * 65 + tq * 8 + i] * x0[i]); }
    __syncthreads();
}
DI void scancomb_rows(const Args& a, int l, int nrows) {
    const int lane = otid() & 63, wave = otid() >> 6;
    const bf16* Z = (const bf16*)(wsp(a) + WS_Z); const float* O = (const float*)(wsp(a) + WS_OSC);
    bf16* Y1 = (bf16*)(wsp(a) + WS_YMIX) + (size_t)MT * 1024; bf16* Y2 = Y1 + (size_t)MT * 1024;
    for (int r = obid() * 8 + wave; r < nrows; r += ogdim() * 8) {
#pragma unroll
        for (int i = 0; i < 4; ++i) { const int col = i * 256 + lane * 4;
            { const f32x4 of = *(const f32x4*)(O + (size_t)r * 1024 + col), ob = *(const f32x4*)(O + ((size_t)MT + r) * 1024 + col); const f32x4 o = of + ob;
              float ss = (o[0] * o[0] + o[1] * o[1]) + (o[2] * o[2] + o[3] * o[3]);
              ss += __shfl_xor(ss, 16); ss += __shfl_xor(ss, 8); ss += __shfl_xor(ss, 4); ss += __shfl_xor(ss, 2); ss += __shfl_xor(ss, 1);
              const float rstd = rsqrtf(ss * (1.0f / 128.0f) + NORM_EPS);
              const f32x4 nw = *(const f32x4*)(ain(a, I_HGNW) + (size_t)l * 128 + (col & 127));
              const u32x2 g = *(const u32x2*)(Z + (size_t)r * ZC + Z_HG + 4096 + col);
              u32x2 w; w.x = pk_bf16(o[0] * rstd * nw[0] * sigmoidf_(bflo(g.x)), o[1] * rstd * nw[1] * sigmoidf_(bfhi(g.x)));
              w.y = pk_bf16(o[2] * rstd * nw[2] * sigmoidf_(bflo(g.y)), o[3] * rstd * nw[3] * sigmoidf_(bfhi(g.y)));
              *(u32x2*)(Y1 + (size_t)r * 1024 + col) = w; }
            { const f32x4 of = *(const f32x4*)(O + ((size_t)2 * MT + r) * 1024 + col), ob = *(const f32x4*)(O + ((size_t)3 * MT + r) * 1024 + col); const f32x4 o = of + ob;
              float ss = (o[0] * o[0] + o[1] * o[1]) + (o[2] * o[2] + o[3] * o[3]); ss = wave_sum(ss);
              const float rstd = rsqrtf(ss * (1.0f / 256.0f) + NORM_EPS);
              const f32x4 nw = *(const f32x4*)(ain(a, I_GLNW) + (size_t)l * 256 + (col & 255));
              const u32x2 g = *(const u32x2*)(Z + (size_t)r * ZC + Z_GL + 2048 + col);
              u32x2 w; w.x = pk_bf16(o[0] * rstd * nw[0] * siluf_(bflo(g.x)), o[1] * rstd * nw[1] * siluf_(bfhi(g.x)));
              w.y = pk_bf16(o[2] * rstd * nw[2] * siluf_(bflo(g.y)), o[3] * rstd * nw[3] * siluf_(bfhi(g.y)));
              *(u32x2*)(Y2 + (size_t)r * 1024 + col) = w; }
        }
    }
}
typedef short bf16x8_t __attribute__((ext_vector_type(8)));
constexpr int SC_N = 65;
constexpr size_t KVS_GL_OFF = (size_t)16 * SC_N * 16384;
constexpr size_t WS_KVS = WS_WGU;
constexpr size_t WS_KD  = WS_WGU + 130 * MiB;
constexpr int SL_QM = 0, SL_KM = 17408, SL_Q0 = 34816, SL_KE = 52224, SL_VT = 70656, SL_PP = 107520, SL_TOT = 116736, SL_DD = 118784, SL_AFB = 119296;
static_assert(SL_AFB + 2048 <= 131072 && WS_KD + (size_t)24 * SC_N * 128 * 4 <= WS_H, "scan maps");
DI bf16x8_t lds_frag16(LAS unsigned char* p) { return *(LAS bf16x8_t*)p; }
DI bf16x8_t pack_bf16x8(const f32x4& lo, const f32x4& hi) { u32x4 w; w.x = pk_bf16(lo[0], lo[1]); w.y = pk_bf16(lo[2], lo[3]); w.z = pk_bf16(hi[0], hi[1]); w.w = pk_bf16(hi[2], hi[3]); return __builtin_bit_cast(bf16x8_t, w); }

template <bool GLA, bool OUT> DI void scan_walk(const Args& a, int l, int head, int dir, int sc, int dvh, LAS unsigned char* lds) {
    constexpr int NB = 1, DV = GLA ? 256 : 128;
    const int tid = otid(), lane = tid & 63, wave = tid >> 6, fr = lane & 15, fq = lane >> 4, nbase = dvh * 8 + wave;
    const bf16* Z = (const bf16*)(wsp(a) + WS_Z);
    const int stream = GLA ? 16 + head * 2 + dir : head * 2 + dir;
    float* kvs = (float*)(wsp(a) + WS_KVS) + (GLA ? KVS_GL_OFF + ((size_t)(stream - 16) * SC_N + sc) * 32768 : ((size_t)stream * SC_N + sc) * 16384);
    float* kd = (float*)(wsp(a) + WS_KD) + ((size_t)stream * SC_N + sc) * 128;
    LAS bf16* QM = (LAS bf16*)(lds + SL_QM); LAS bf16* KM = (LAS bf16*)(lds + SL_KM); LAS bf16* Q0 = (LAS bf16*)(lds + SL_Q0);
    LAS bf16* KE = (LAS bf16*)(lds + SL_KE); LAS bf16* VT = (LAS bf16*)(lds + SL_VT); LAS bf16* PP = (LAS bf16*)(lds + SL_PP);
    LAS float* TOT = (LAS float*)(lds + SL_TOT); LAS float* DD = (LAS float*)(lds + SL_DD); LAS bf16* AFB = (LAS bf16*)(lds + SL_AFB);
    const int k = (wave & 1) * 64 + lane, seg = wave >> 1;
    float lbv = 0.f, ba = 0.f, wa[16];
    if (!GLA) lbv = ((const float*)(wsp(a) + WS_LB))[((size_t)l * 2 + dir) * 1024 + head * 128 + k];
    else { ba = ain(a, I_GLBA)[((size_t)l * 2 + dir) * 512 + head * 128 + k];
#pragma unroll
        for (int rr = 0; rr < 16; ++rr) wa[rr] = ain(a, I_GLWA2)[(((size_t)l * 2 + dir) * 16 + rr) * 512 + head * 128 + k]; }
    f32x4 S[NB][8];
#pragma unroll
    for (int nb = 0; nb < NB; ++nb)
#pragma unroll
        for (int mb = 0; mb < 8; ++mb) { if (OUT) S[nb][mb] = *(const f32x4*)(kvs + (size_t)((nbase + nb) * 16 + fr) * 128 + mb * 16 + fq * 4); else S[nb][mb] = (f32x4){0.f, 0.f, 0.f, 0.f}; }
    float dlog = 0.f;
    const int which = (GLA ? 2 : 0) + dir;
    float* Odir = (float*)(wsp(a) + WS_OSC) + (size_t)which * MT * 1024;
    for (int cc = 0; cc < 4; ++cc) {
        const int c = sc * 4 + cc; const int r0 = dir ? stream_row(c * 64 + 63, 1) : stream_row(c * 64, 0);
        { const bf16* vr = Z + (size_t)(r0 + lane) * ZC + (GLA ? Z_GL + 1024 + head * 256 + dvh * 128 : Z_HG + 3072 + head * 128) + wave * 16;
#pragma unroll
          for (int q8 = 0; q8 < 2; ++q8) { const u32x4 v = *(const u32x4*)(vr + q8 * 8); const int d0 = wave * 16 + q8 * 8;
              VT[(d0 + 0) * 72 + lane] = (bf16)(v.x & 0xffff); VT[(d0 + 1) * 72 + lane] = (bf16)(v.x >> 16); VT[(d0 + 2) * 72 + lane] = (bf16)(v.y & 0xffff); VT[(d0 + 3) * 72 + lane] = (bf16)(v.y >> 16);
              VT[(d0 + 4) * 72 + lane] = (bf16)(v.z & 0xffff); VT[(d0 + 5) * 72 + lane] = (bf16)(v.z >> 16); VT[(d0 + 6) * 72 + lane] = (bf16)(v.w & 0xffff); VT[(d0 + 7) * 72 + lane] = (bf16)(v.w >> 16); }
          const int srow = tid >> 3, spc = (tid & 7) * 16; const bf16* zr = Z + (size_t)(r0 + srow) * ZC;
          const bf16* fsrc = zr + (GLA ? Z_GL + 512 + head * 128 : Z_HG + 1024 * (1 + dir) + head * 128) + spc;
          const u32x4 f0 = *(const u32x4*)fsrc, f1 = *(const u32x4*)(fsrc + 8);
          *(LAS u32x4*)(KM + srow * 136 + spc) = f0; *(LAS u32x4*)(KM + srow * 136 + spc + 8) = f1;
          if (OUT) { const bf16* qsrc = zr + (GLA ? Z_GL + head * 128 : Z_HG + head * 128) + spc; const u32x4 q0 = *(const u32x4*)qsrc, q1 = *(const u32x4*)(qsrc + 8);
              *(LAS u32x4*)(QM + srow * 136 + spc) = q0; *(LAS u32x4*)(QM + srow * 136 + spc + 8) = q1; }
          if (GLA && tid < 128) { const u32x4 av = *(const u32x4*)(Z + (size_t)(r0 + (tid >> 1)) * ZC + Z_LR + dir * 16 + (tid & 1) * 8); *(LAS u32x4*)(AFB + (tid >> 1) * 16 + (tid & 1) * 8) = av; } }
        __syncthreads();
        const int tstart = dir ? 63 - seg * 16 : seg * 16, tstep = dir ? -1 : 1;
        float cs[16]; float run = 0.f;
#pragma unroll
        for (int i = 0; i < 16; ++i) { const int t = tstart + i * tstep; float la;
            if (!GLA) { const float zf = bf2f(KM[t * 136 + k]); la = __logf(lbv + (1.0f - lbv) * sigmoidf_(zf)); }
            else { float x = ba; const u32x4 a0 = *(LAS u32x4*)(AFB + t * 16), a1 = *(LAS u32x4*)(AFB + t * 16 + 8);
                x += bflo(a0.x) * wa[0] + bfhi(a0.x) * wa[1] + bflo(a0.y) * wa[2] + bfhi(a0.y) * wa[3] + bflo(a0.z) * wa[4] + bfhi(a0.z) * wa[5] + bflo(a0.w) * wa[6] + bfhi(a0.w) * wa[7];
                x += bflo(a1.x) * wa[8] + bfhi(a1.x) * wa[9] + bflo(a1.y) * wa[10] + bfhi(a1.y) * wa[11] + bflo(a1.z) * wa[12] + bfhi(a1.z) * wa[13] + bflo(a1.w) * wa[14] + bfhi(a1.w) * wa[15];
                la = (fminf(x, 0.f) - log1pf(__expf(-fabsf(x)))) * 0.0625f; }
            run += la; cs[i] = run; if (GLA || (i & 3) == 3) asm volatile("" ::: "memory"); }
        TOT[seg * 128 + k] = run;
        __syncthreads();
        { const float t0 = TOT[k], t1 = TOT[128 + k], t2 = TOT[256 + k], t3 = TOT[384 + k];
          const float off = seg == 0 ? 0.f : (seg == 1 ? t0 : (seg == 2 ? t0 + t1 : t0 + t1 + t2)), blast = (t0 + t1) + (t2 + t3), bref = t0 + t1;
          float ke[16];
#pragma unroll
          for (int i = 0; i < 16; ++i) { const int t = tstart + i * tstep; const float b = off + cs[i]; const float raw = bf2f(KM[t * 136 + k]);
              const float kk = GLA ? raw : (1.0f - lbv) * sigmoidf_(-raw);
              if (OUT) { const float qr = bf2f(QM[t * 136 + k]); const float qv = GLA ? qr * 0.08838834764831845f : siluf_(qr);
                  QM[t * 136 + k] = f2bf(qv * __expf(b - bref)); KM[t * 136 + k] = f2bf(kk * __expf(bref - b)); Q0[t * 136 + k] = f2bf(qv * __expf(b)); }
              ke[i] = kk * __expf(blast - b); if ((i & 3) == 3) asm volatile("" ::: "memory"); }
          const int tb0 = dir ? 48 - seg * 16 : seg * 16; u32x4 w0, w1;
          if (dir) { w0.x = pk_bf16(ke[15], ke[14]); w0.y = pk_bf16(ke[13], ke[12]); w0.z = pk_bf16(ke[11], ke[10]); w0.w = pk_bf16(ke[9], ke[8]); w1.x = pk_bf16(ke[7], ke[6]); w1.y = pk_bf16(ke[5], ke[4]); w1.z = pk_bf16(ke[3], ke[2]); w1.w = pk_bf16(ke[1], ke[0]); }
          else     { w0.x = pk_bf16(ke[0], ke[1]); w0.y = pk_bf16(ke[2], ke[3]); w0.z = pk_bf16(ke[4], ke[5]); w0.w = pk_bf16(ke[6], ke[7]); w1.x = pk_bf16(ke[8], ke[9]); w1.y = pk_bf16(ke[10], ke[11]); w1.z = pk_bf16(ke[12], ke[13]); w1.w = pk_bf16(ke[14], ke[15]); }
          *(LAS u32x4*)(KE + k * 72 + tb0) = w0; *(LAS u32x4*)(KE + k * 72 + tb0 + 8) = w1;
          if (seg == 0) DD[k] = __expf(blast);
          dlog += blast; }
        __syncthreads();
        bf16x8_t Bv[NB][2];
#pragma unroll
        for (int nb = 0; nb < NB; ++nb)
#pragma unroll
            for (int ks = 0; ks < 2; ++ks) Bv[nb][ks] = lds_frag16(lds + SL_VT + ((wave * 16 + fr) * 72 + ks * 32 + fq * 8) * 2);
        if (OUT) {
            { const int tb = wave >> 1;
#pragma unroll
              for (int sbi = 0; sbi < 2; ++sbi) { const int sb = (wave & 1) * 2 + sbi; f32x4 acc = {0.f, 0.f, 0.f, 0.f};
#pragma unroll
                  for (int ks = 0; ks < 4; ++ks) acc = __builtin_amdgcn_mfma_f32_16x16x32_bf16(lds_frag16(lds + SL_QM + ((tb * 16 + fr) * 136 + ks * 32 + fq * 8) * 2), lds_frag16(lds + SL_KM + ((sb * 16 + fr) * 136 + ks * 32 + fq * 8) * 2), acc, 0, 0, 0);
#pragma unroll
                  for (int j = 0; j < 4; ++j) { const int t = tb * 16 + fq * 4 + j, s = sb * 16 + fr; const bool keep = dir ? (s >= t) : (s <= t); PP[t * 72 + s] = keep ? f2bf(acc[j]) : (bf16)0; } } }
            __syncthreads();
#pragma unroll
            for (int nb = 0; nb < NB; ++nb) {
                bf16x8_t Bs[4];
#pragma unroll
                for (int ks = 0; ks < 4; ++ks) Bs[ks] = pack_bf16x8(S[nb][2 * ks], S[nb][2 * ks + 1]);
#pragma unroll
                for (int mb = 0; mb < 4; ++mb) {
                    f32x4 O = {0.f, 0.f, 0.f, 0.f};
#pragma unroll
                    for (int ks = 0; ks < 2; ++ks) O = __builtin_amdgcn_mfma_f32_16x16x32_bf16(lds_frag16(lds + SL_PP + ((mb * 16 + fr) * 72 + ks * 32 + fq * 8) * 2), Bv[nb][ks], O, 0, 0, 0);
#pragma unroll
                    for (int ks = 0; ks < 4; ++ks) { u32x4 aw; const u32x2 lo = *(LAS u32x2*)(lds + SL_Q0 + ((mb * 16 + fr) * 136 + (2 * ks) * 16 + fq * 4) * 2), hi = *(LAS u32x2*)(lds + SL_Q0 + ((mb * 16 + fr) * 136 + (2 * ks + 1) * 16 + fq * 4) * 2);
                        aw.x = lo.x; aw.y = lo.y; aw.z = hi.x; aw.w = hi.y;
                        O = __builtin_amdgcn_mfma_f32_16x16x32_bf16(__builtin_bit_cast(bf16x8_t, aw), Bs[ks], O, 0, 0, 0); }
#pragma unroll
                    for (int j = 0; j < 4; ++j) Odir[(size_t)(r0 + mb * 16 + fq * 4 + j) * 1024 + head * DV + (nbase + nb) * 16 + fr] = O[j];
                    asm volatile("" ::: "memory");
                }
            }
        }
        if (!OUT || cc < 3) {
#pragma unroll
            for (int mb = 0; mb < 8; ++mb) { const f32x4 dd = *(LAS f32x4*)(DD + mb * 16 + fq * 4);
                const bf16x8_t A0 = lds_frag16(lds + SL_KE + ((mb * 16 + fr) * 72 + fq * 8) * 2), A1 = lds_frag16(lds + SL_KE + ((mb * 16 + fr) * 72 + 32 + fq * 8) * 2);
#pragma unroll
                for (int nb = 0; nb < NB; ++nb) { S[nb][mb] = S[nb][mb] * dd; S[nb][mb] = __builtin_amdgcn_mfma_f32_16x16x32_bf16(A0, Bv[nb][0], S[nb][mb], 0, 0, 0); S[nb][mb] = __builtin_amdgcn_mfma_f32_16x16x32_bf16(A1, Bv[nb][1], S[nb][mb], 0, 0, 0); }
                asm volatile("" ::: "memory"); }
        }
        __syncthreads();
    }
    if (!OUT) {
#pragma unroll
        for (int nb = 0; nb < NB; ++nb)
#pragma unroll
            for (int mb = 0; mb < 8; ++mb) *(f32x4*)(kvs + (size_t)((nbase + nb) * 16 + fr) * 128 + mb * 16 + fq * 4) = S[nb][mb];
        if (seg == 0) kd[k] = __expf(dlog);
    }
}
DI void scan_prop(const Args& a) {
    float* kvs = (float*)(wsp(a) + WS_KVS); const float* kd = (const float*)(wsp(a) + WS_KD);
    for (int g = obid() * NTHR + otid(); g < 131072; g += ogdim() * NTHR) {
        float* p; size_t stride; const float* dp;
        if (g < 65536) { const int stream = g >> 12, e = g & 4095; p = kvs + (size_t)stream * SC_N * 16384 + (size_t)e * 4; stride = 16384; dp = kd + (size_t)stream * SC_N * 128 + (e & 31) * 4; }
        else { const int q = g - 65536, stream = q >> 13, e = q & 8191; p = kvs + KVS_GL_OFF + (size_t)stream * SC_N * 32768 + (size_t)e * 4; stride = 32768; dp = kd + (size_t)(16 + stream) * SC_N * 128 + (e & 31) * 4; }
        f32x4 S = {0.f, 0.f, 0.f, 0.f};
#pragma unroll 5
        for (int sc = 0; sc < SC_N; ++sc) { const f32x4 kv = *(const f32x4*)(p + sc * stride), d = *(const f32x4*)(dp + sc * 128); *(f32x4*)(p + sc * stride) = S; S = d * S + kv; }
    }
}
constexpr int SCAN_ITEMS = 32 * SC_N;
template <bool OUT> DI void scan_item2(const Args& a, int l, int it, LAS unsigned char* lds) {
    if (it < 16 * SC_N) { const int s = it / SC_N, sc = it % SC_N; if (OUT && l == DEPTH - 1 && sc == 0) return; scan_walk<true, OUT>(a, l, s >> 2, (s >> 1) & 1, sc, s & 1, lds); }
    else { const int j = it - 16 * SC_N, s = j / SC_N, sc = j % SC_N; if (OUT && l == DEPTH - 1 && sc == 0) return; scan_walk<false, OUT>(a, l, s >> 1, s & 1, sc, 0, lds); }
}
DI void hyconv_item(const Args& a, int l, int c, LAS unsigned char* ldsb) {
    const int tid = otid();
    LAS float* lds = (LAS float*)ldsb;
    LAS float* xs = (LAS float*)(ldsb + LDS_X);
    const float* tw = (const float*)(wsp(a) + WS_TW); const float* tw2 = (const float*)(wsp(a) + WS_TW2);
    const float* h2 = (const float*)(wsp(a) + WS_H2) + (size_t)l * MT * 64;
    const float* VX = (const float*)(wsp(a) + WS_U) + (size_t)c * MT; float* VO = (float*)(wsp(a) + WS_CVO) + (size_t)c * MT;
    const float* HFf = (const float*)(wsp(a) + WS_HF) + (size_t)c * SEQ; const float* HFb = HFf + (size_t)1024 * SEQ;
    const float a0 = -4.605170186f / 1.5f, a1 = -4.605170186f / 0.3f;
    const float nd = -fabsf(a0 + (float)c * ((a1 - a0) / 1023.0f)) * (1.0f / (float)(SEQ - 1));
    const float b3f = ain(a, I_HYB3)[l * 2048 + c], b3b = ain(a, I_HYB3)[l * 2048 + 1024 + c];
    float sf = 0.f, sb = 0.f;
    for (int i = 0; i < 8; ++i) { const int t4 = (tid + 512 * i) * 4; f32x4 hf = *(const f32x4*)(HFf + t4), hb = *(const f32x4*)(HFb + t4);
#pragma unroll
        for (int q = 0; q < 4; ++q) { const float dec = __expf(nd * (float)(t4 + q)) + 0.05f; hf[q] = (hf[q] + b3f) * dec; hb[q] = (hb[q] + b3b) * dec; }
        sf += (fabsf(hf[0]) + fabsf(hf[1])) + (fabsf(hf[2]) + fabsf(hf[3])); sb += (fabsf(hb[0]) + fabsf(hb[1])) + (fabsf(hb[2]) + fabsf(hb[3]));
        *(LAS f32x4*)(lds + t4) = hf;
#pragma unroll
        for (int q = 0; q < 4; ++q) { const int t = t4 + q; if (t > 0) lds[32768 - t] = hb[q]; else xs[160] = hb[q]; } }
    sf = wave_sum(sf); sb = wave_sum(sb);
    if ((tid & 63) == 0) { xs[128 + (tid >> 6)] = sf; xs[136 + (tid >> 6)] = sb; }
    __syncthreads();
    float tf = 0.f, tb = 0.f;
#pragma unroll
    for (int w = 0; w < 8; ++w) { tf += xs[128 + w]; tb += xs[136 + w]; }
    const float inf_ = 1.0f / tf, inb_ = 1.0f / tb;
    for (int i = 0; i < 64; ++i) { const int m = tid + 512 * i; float v = lds[m];
        if (m == 0) v = v * inf_ + xs[160] * inb_ + ain(a, I_HYSKIP)[l * 1024 + c];
        else if (m < SEQ) v *= inf_; else if (m == SEQ) v = 0.f; else v *= inb_;
        lds[m] = v; }
    __syncthreads();
    fft_fwd_pass<4096>(lds, tw, tid); __syncthreads(); fft_fwd_pass<1024>(lds, tw, tid); __syncthreads(); fft_fwd_pass<256>(lds, tw, tid); __syncthreads(); fft_fwd_pass<64>(lds, tw, tid); __syncthreads();
    fft_fwd_pass<16>(lds, tw, tid); __syncthreads(); fft_fwd_pass<4>(lds, tw, tid); __syncthreads(); fft_fwd_pass<1>(lds, tw, tid); __syncthreads();
    float* Gs = (float*)(wsp(a) + WS_YMIX) + (size_t)obid() * 32768;
#pragma unroll 1
    for (int j = 0; j < 16; ++j) { const int k = tid + 512 * j; cpx gk, gm; rfft_untangle(lds, tw2, k, gk, gm); f32x4 g4; g4[0] = gk.x; g4[1] = gk.y; g4[2] = gm.x; g4[3] = gm.y; *(f32x4*)(Gs + (size_t)k * 4) = g4; }
    __syncthreads();
    for (int i = 0; i < 16; ++i) { const int m4 = tid + 512 * i; f32x4 v = {0.f, 0.f, 0.f, 0.f}; if (m4 < SEQ / 4) v = *(const f32x4*)(VX + m4 * 4); *(LAS f32x4*)(lds + m4 * 4) = v; }
    __syncthreads();
    fft_fwd_pass<4096>(lds, tw, tid); __syncthreads(); fft_fwd_pass<1024>(lds, tw, tid); __syncthreads(); fft_fwd_pass<256>(lds, tw, tid); __syncthreads(); fft_fwd_pass<64>(lds, tw, tid); __syncthreads();
    fft_fwd_pass<16>(lds, tw, tid); __syncthreads(); fft_fwd_pass<4>(lds, tw, tid); __syncthreads(); fft_fwd_pass<1>(lds, tw, tid); __syncthreads();
#pragma unroll 1
    for (int j = 0; j < 16; ++j) { const int k = tid + 512 * j; const f32x4 g4 = *(const f32x4*)(Gs + (size_t)k * 4); cpx gk, gm; gk.x = g4[0]; gk.y = g4[1]; gm.x = g4[2]; gm.y = g4[3]; rfft_mul_retangle(lds, tw2, k, gk, gm); }
    __syncthreads();
    fft_inv_pass<1>(lds, tw, tid); __syncthreads(); fft_inv_pass<4>(lds, tw, tid); __syncthreads(); fft_inv_pass<16>(lds, tw, tid); __syncthreads(); fft_inv_pass<64>(lds, tw, tid); __syncthreads();
    fft_inv_pass<256>(lds, tw, tid); __syncthreads(); fft_inv_pass<1024>(lds, tw, tid); __syncthreads(); fft_inv_pass<4096>(lds, tw, tid); __syncthreads();
    for (int i = 0; i < 8; ++i) { const int m4 = tid + 512 * i; f32x4 v = *(const LAS f32x4*)(lds + m4 * 4); *(f32x4*)(VO + m4 * 4) = v * (1.0f / FFT_M); }
    __syncthreads();
}
DI void hycctx_item(const Args& a, int l, int it, LAS unsigned char* ldsb) {
    const int tid = otid(), c0 = it * 16;
    LAS float* sv = (LAS float*)ldsb;
    LAS float* sf = sv + 16 * 256;
    LAS float* sb = sf + 16 * 256;
    const float* hyc = (const float*)(wsp(a) + WS_HYC); const float* VXT = (const float*)(wsp(a) + WS_U); float* CVO = (float*)(wsp(a) + WS_CVO);
    for (int i = tid; i < 16 * 256; i += NTHR) { const int ch = i >> 8, t = i & 255; sv[i] = VXT[(size_t)(c0 + ch) * MT + SEQ + t]; sf[i] = hyc[(size_t)(c0 + ch) * 256 + t]; sb[i] = hyc[(size_t)(1024 + c0 + ch) * 256 + t]; }
    __syncthreads();
    const int ch = tid >> 5, tq = tid & 31; const float g0 = sf[ch * 256] + sb[ch * 256] + ain(a, I_HYSKIP)[l * 1024 + c0 + ch];
    float acc[8];
#pragma unroll
    for (int i = 0; i < 8; ++i) acc[i] = 0.f;
    for (int s = 0; s < 256; ++s) { const float vv = sv[ch * 256 + s];
#pragma unroll
        for (int i = 0; i < 8; ++i) { const int d = tq * 8 + i - s; const float g = d > 0 ? sf[ch * 256 + d] : (d < 0 ? sb[ch * 256 - d] : g0); acc[i] += g * vv; } }
    __syncthreads();
#pragma unroll
    for (int i = 0; i < 8; ++i) CVO[(size_t)(c0 + ch) * MT + SEQ + tq * 8 + i] = acc[i];
    __syncthreads();
}

struct EpiHF {
    static constexpr bool PERM = false, AFTER_DRAIN = false; float* O;
    DI void operator()(const f32x4 (&acc)[2][2][4][2], const pg8::Unit& u, int wr, int wc, int fr, int fq) const {
        const int row0 = u.pm * 256 + wr * 64 + fr, col0 = u.pn * 256 + wc * 32 + 4 * fq;
#pragma unroll
        for (int ai = 0; ai < 2; ++ai)
#pragma unroll
            for (int m = 0; m < 4; ++m) { float* rowp = O + (size_t)(row0 + ai * 128 + m * 16) * SEQ + col0;
#pragma unroll
                for (int bj = 0; bj < 2; ++bj)
#pragma unroll
                    for (int n = 0; n < 2; ++n) *(f32x4*)(rowp + bj * 128 + n * 16) = acc[ai][bj][m][n]; }
    }
};
struct EpiZ {
    static constexpr bool PERM = true, AFTER_DRAIN = false; bf16* O; const float* bias;
    DI void operator()(const f32x4 (&acc)[2][2][4][2], const pg8::Unit& u, int wr, int wc, int fr, int fq) const {
        const int row0 = u.pm * 256 + wr * 64 + fr, col0 = u.pn * 256 + wc * 32 + 8 * fq;
        f32x4 bv[2][2];
#pragma unroll
        for (int bj = 0; bj < 2; ++bj)
#pragma unroll
            for (int n = 0; n < 2; ++n) bv[bj][n] = *(const f32x4*)(bias + col0 + bj * 128 + 4 * n);
#pragma unroll
        for (int ai = 0; ai < 2; ++ai)
#pragma unroll
            for (int m = 0; m < 4; ++m) { bf16* rowp = O + (size_t)(row0 + ai * 128 + m * 16) * ZC + col0;
#pragma unroll
                for (int bj = 0; bj < 2; ++bj) { const f32x4 v0 = acc[ai][bj][m][0] + bv[bj][0], v1 = acc[ai][bj][m][1] + bv[bj][1];
                    u32x4 w; w.x = pk_bf16(v0[0], v0[1]); w.y = pk_bf16(v0[2], v0[3]); w.z = pk_bf16(v1[0], v1[1]); w.w = pk_bf16(v1[2], v1[3]);
                    *(u32x4*)(rowp + bj * 128) = w; } }
    }
};
template <int BR> struct EpiBr {
    static constexpr bool PERM = true, AFTER_DRAIN = false; bf16* Mg; const bf16* Zg;
    DI void operator()(const f32x4 (&acc)[2][2][4][2], const pg8::Unit& u, int wr, int wc, int fr, int fq) const {
        const int row0 = u.pm * 256 + wr * 64 + fr, col0 = u.pn * 256 + wc * 32 + 8 * fq;
#pragma unroll
        for (int ai = 0; ai < 2; ++ai)
#pragma unroll
            for (int m = 0; m < 4; ++m) { const size_t row = (size_t)(row0 + ai * 128 + m * 16);
#pragma unroll
                for (int bj = 0; bj < 2; ++bj) { const int col = col0 + bj * 128;
                    const u32x4 g = *(const u32x4*)(Zg + row * ZC + col);
                    f32x4 v0 = acc[ai][bj][m][0], v1 = acc[ai][bj][m][1];
                    v0[0] *= sigmoidf_(bflo(g.x)); v0[1] *= sigmoidf_(bfhi(g.x)); v0[2] *= sigmoidf_(bflo(g.y)); v0[3] *= sigmoidf_(bfhi(g.y));
                    v1[0] *= sigmoidf_(bflo(g.z)); v1[1] *= sigmoidf_(bfhi(g.z)); v1[2] *= sigmoidf_(bflo(g.w)); v1[3] *= sigmoidf_(bfhi(g.w));
                    if (BR > 0) { const u32x4 p = *(const u32x4*)(Mg + row * D + col);
                        v0[0] += bflo(p.x); v0[1] += bfhi(p.x); v0[2] += bflo(p.y); v0[3] += bfhi(p.y); v1[0] += bflo(p.z); v1[1] += bfhi(p.z); v1[2] += bflo(p.w); v1[3] += bfhi(p.w); }
                    u32x4 w; w.x = pk_bf16(v0[0], v0[1]); w.y = pk_bf16(v0[2], v0[3]); w.z = pk_bf16(v1[0], v1[1]); w.w = pk_bf16(v1[2], v1[3]);
                    *(u32x4*)(Mg + row * D + col) = w; } }
    }
};
struct EpiOut {
    static constexpr bool PERM = false, AFTER_DRAIN = false; const float* hin_main; const float* hin_ctx; float* hout; const float* gt1;
    DI void operator()(const f32x4 (&acc)[2][2][4][2], const pg8::Unit& u, int wr, int wc, int fr, int fq) const {
        const int row0 = u.pm * 256 + wr * 64 + fr, col0 = u.pn * 256 + wc * 32 + 4 * fq; const bool isctx = u.pm >= SEQ / 256;
        const float* g = gt1 + (isctx ? 12288 : 0);
        f32x4 gv[2][2];
#pragma unroll
        for (int bj = 0; bj < 2; ++bj)
#pragma unroll
            for (int n = 0; n < 2; ++n) gv[bj][n] = *(const f32x4*)(g + col0 + bj * 128 + n * 16);
#pragma unroll
        for (int ai = 0; ai < 2; ++ai)
#pragma unroll
            for (int m = 0; m < 4; ++m) { const int row = row0 + ai * 128 + m * 16;
                const float* ip = (isctx ? hin_ctx + (size_t)(row - SEQ) * D : hin_main + (size_t)row * D) + col0; float* op = hout + (size_t)row * D + col0;
#pragma unroll
                for (int bj = 0; bj < 2; ++bj)
#pragma unroll
                    for (int n = 0; n < 2; ++n) { const f32x4 b = *(const f32x4*)(ip + bj * 128 + n * 16); *(f32x4*)(op + bj * 128 + n * 16) = b + gv[bj][n] * acc[ai][bj][m][n]; } }
    }
};
struct EpiGU {
    static constexpr bool PERM = true, AFTER_DRAIN = false; bf16* Hm;
    DI void operator()(const f32x4 (&acc)[2][2][4][2], const pg8::Unit& u, int wr, int wc, int fr, int fq) const {
        const int row0 = u.pm * 256 + wr * 64 + fr, col0 = (u.pn & 3) * 128 + wc * 32 + 8 * fq;
#pragma unroll
        for (int ai = 0; ai < 2; ++ai)
#pragma unroll
            for (int m = 0; m < 4; ++m) { const f32x4 g0 = acc[ai][0][m][0], g1 = acc[ai][0][m][1], u0 = acc[ai][1][m][0], u1 = acc[ai][1][m][1];
                u32x4 w; w.x = pk_bf16(siluf_(g0[0]) * u0[0], siluf_(g0[1]) * u0[1]); w.y = pk_bf16(siluf_(g0[2]) * u0[2], siluf_(g0[3]) * u0[3]);
                w.z = pk_bf16(siluf_(g1[0]) * u1[0], siluf_(g1[1]) * u1[1]); w.w = pk_bf16(siluf_(g1[2]) * u1[2], siluf_(g1[3]) * u1[3]);
                *(u32x4*)(Hm + (size_t)(row0 + ai * 128 + m * 16) * DFF + col0) = w; }
    }
};
struct EpiDn {
    static constexpr bool PERM = true, AFTER_DRAIN = false; bf16* Y; const float* roww;
    DI void operator()(const f32x4 (&acc)[2][2][4][2], const pg8::Unit& u, int wr, int wc, int fr, int fq) const {
        const int row0 = u.pm * 256 + wr * 64 + fr, col0 = (u.pn & 7) * 256 + wc * 32 + 8 * fq;
#pragma unroll
        for (int ai = 0; ai < 2; ++ai)
#pragma unroll
            for (int m = 0; m < 4; ++m) { const int row = row0 + ai * 128 + m * 16; const float rw = roww[row];
#pragma unroll
                for (int bj = 0; bj < 2; ++bj) { const f32x4 v0 = acc[ai][bj][m][0] * rw, v1 = acc[ai][bj][m][1] * rw;
                    u32x4 w; w.x = pk_bf16(v0[0], v0[1]); w.y = pk_bf16(v0[2], v0[3]); w.z = pk_bf16(v1[0], v1[1]); w.w = pk_bf16(v1[2], v1[3]);
                    *(u32x4*)(Y + (size_t)row * D + col0 + bj * 128) = w; } }
    }
};
struct MoeOrder {
    const int* tile_e; int ntiles, nsub, G, c;
    DI bool next(int i, pg8::Unit& u) const { const int j = i * G + c; if (j >= ntiles * nsub) return false; const int ti = j / nsub; u.pm = ti; u.pn = tile_e[ti] * nsub + (j - ti * nsub); return true; }
    DI void a_ready(const pg8::Unit&) const {}
    DI void done(const pg8::Unit&) const {}
};
constexpr int NPH_LAYER = 13, PH_FINAL = 1 + NPH_LAYER * DEPTH, NPHASES = PH_FINAL + 1;
struct KArgs { Args a; int li, pad; };
__global__ void __launch_bounds__(NTHR, 2) fwd_kernel(KArgs ka) {
    const Args& a = ka.a;
    const int tid = otid();
#define bid ((int)obid())
#define G ((int)ogdim())
    if (tid == 0) { ((LAS unsigned*)(ldsbase() + LDS_BARW))[0] = 0u; ((LAS unsigned*)(ldsbase() + LDS_BARW))[1] = 0u;
        LAS unsigned long long* ptab = (LAS unsigned long long*)(ldsbase() + LDS_PTAB);
#pragma unroll
        for (int i = 0; i < N_IN; ++i) ptab[i] = (unsigned long long)ka.a.in[i]; }
    __syncthreads();
    XcdBarrier bar = xcd_barrier_post((unsigned*)(wsp(a) + WS_CTL) + CW_BAR + ka.li * XCD_BAR_WORDS, (volatile LAS unsigned*)(ldsbase() + LDS_BARW));
    const int lo = a.ph_lo, hi = a.ph_hi;
#ifndef PHMASK
#define PHMASK 0xFFFF
#endif
#define EN(i) (((PHMASK) >> (i)) & 1)
#ifndef REPMASK
#define REPMASK 0
#endif
#define REP(i) (((REPMASK) >> (i)) & 1)
#define RUN(i, cond, ...) do { __VA_ARGS__; if (REP(i) && (cond)) { __syncthreads(); __VA_ARGS__; } } while (0)
#define IN(k) (opq(lo) <= (k) && (k) < opq(hi))
#define SEAM(k) do { if (IN(k) && IN((k) + 1)) xcd_barrier(bar); } while (0)
#define ws wsp(a)
#define lds ldsbase()
#define ldsf ((LAS float*)ldsbase())
#define U ((bf16*)(wsp(a) + WS_U))
#define Z ((bf16*)(wsp(a) + WS_Z))
#define H ((float*)(wsp(a) + WS_H))
#define modall ((const float*)(wsp(a) + WS_MOD))

    if (EN(0) && IN(0)) {
        RUN(0, true, prologue_small(a);
        for (int it = bid; it < 256; it += G) mod_item(a, it, ldsf);
        for (int it = bid; it < DEPTH * (MT / 8); it += G) h2_item(a, it, ldsf));
    }
    SEAM(0);
    for (int l = 0; l < DEPTH; ++l) {
        const int pb = 1 + NPH_LAYER * l;
        const int nrows = (l == 0) ? MT : SEQ;
        if (EN(1) && IN(pb + 0)) {
            RUN(1, l == 0, norm_phase<0>(a, l, MT, ldsf));
            RUN(16, true, if (l == 0) hyc_filters(a, 0));
            RUN(2, true, for (int it = bid; it < CVT_MIX_TILES; it += G) cvt_mix_item(a, l, it, ldsf));
        }
        SEAM(pb + 0);
        if (EN(2) && IN(pb + 1)) {
            pg8::Gemm g{U, (const bf16*)(ws + WS_WIN), MT, ZC, D}; pg8::StaticOrder S; S.init(MT, ZC, G, bid);
            EpiZ E{Z, (const float*)(ws + WS_ZBIAS) + (size_t)l * ZC};
            RUN(3, true, pg8::gemm_phase<EpiZ, pg8::StaticOrder, true, true>(lds, g, S, E));
        }
        SEAM(pb + 1);
        if (EN(3) && IN(pb + 2)) { const int nit = (nrows / 64) * 16; RUN(4, true, for (int it = bid; it < nit; it += G) hyprep_item(a, l, it, ldsf));
            __syncthreads();
            pg8::Gemm g{(const bf16*)(ws + WS_W3T) + (size_t)l * 2048 * 256, (const bf16*)(ws + WS_H2B) + (size_t)l * SEQ * 256, 2048, SEQ, 256}; pg8::StaticOrder S; S.init(2048, SEQ, G, bid);
            EpiHF E{(float*)(ws + WS_HF)};
            RUN(18, true, pg8::gemm_phase<EpiHF, pg8::StaticOrder, true, true>(lds, g, S, E)); }
        SEAM(pb + 2);
        if (EN(4) && IN(pb + 3)) {
            RUN(5, true, for (int it = bid; it < SCAN_ITEMS; it += G) scan_item2<false>(a, l, it, lds));
            RUN(6, true, for (int c = bid; c < 1024; c += G) hyconv_item(a, l, c, lds));
            RUN(15, true, if (l == 0) for (int it = bid; it < 64; it += G) hycctx_item(a, l, it, lds));
        }
        SEAM(pb + 3);
        if (EN(13) && IN(pb + 4)) scan_prop(a);
        SEAM(pb + 4);
        if (EN(14) && IN(pb + 5)) { RUN(17, true, for (int it = bid; it < SCAN_ITEMS; it += G) scan_item2<true>(a, l, it, lds)); }
        SEAM(pb + 5);
        if (EN(5) && IN(pb + 6)) {
            const int nit = (nrows / 64) * 16;
            RUN(7, true, scancomb_rows(a, l, nrows); for (int it = bid; it < nit; it += G) hycomb_item(a, l, it, ldsf));
        }
        SEAM(pb + 6);
        if (EN(6) && IN(pb + 7)) {
            const bf16* Y = (const bf16*)(ws + WS_YMIX); const bf16* WB = (const bf16*)(ws + WS_WBR);
            pg8::StaticOrder S; S.init(nrows, D, G, bid);
            RUN(8, true,
            { pg8::Gemm g{Y, WB, nrows, D, 1024}; EpiBr<0> E{U, Z + Z_MG}; pg8::gemm_phase<EpiBr<0>, pg8::StaticOrder, true, true>(lds, g, S, E); }
            __syncthreads();
            { pg8::Gemm g{Y + (size_t)MT * 1024, WB + (size_t)D * 1024, nrows, D, 1024}; EpiBr<1> E{U, Z + Z_MG + D}; pg8::gemm_phase<EpiBr<1>, pg8::StaticOrder, true, true>(lds, g, S, E); }
            __syncthreads();
            { pg8::Gemm g{Y + (size_t)2 * MT * 1024, WB + (size_t)2 * D * 1024, nrows, D, 1024}; EpiBr<2> E{U, Z + Z_MG + 2 * D}; pg8::gemm_phase<EpiBr<2>, pg8::StaticOrder, true, true>(lds, g, S, E); });
        }
        SEAM(pb + 7);
        if (EN(7) && IN(pb + 8)) {
            pg8::Gemm g{U, (const bf16*)(ws + WS_WOUT), nrows, D, D}; pg8::StaticOrder S; S.init(nrows, D, G, bid);
            EpiOut E{l == 0 ? ain(a, I_X) : H, l == 0 ? ain(a, I_CTX) : H + (size_t)SEQ * D, H, modall + (size_t)l * 2 * 12288 + 4096};
            RUN(9, l == 0, pg8::gemm_phase<EpiOut, pg8::StaticOrder, true, true>(lds, g, S, E));
        }
        SEAM(pb + 8);
        if (EN(8) && IN(pb + 9)) {
            norm_phase<1>(a, l, nrows, ldsf);
            __syncthreads();
            RUN(10, true, for (int it = bid; it < CVT_MOE_TILES; it += G) cvt_moe_item(a, l, it, ldsf));
        }
        SEAM(pb + 9);
        if (EN(9) && IN(pb + 10)) { RUN(11, true, permute_phase(a, l, nrows, lds)); }
        SEAM(pb + 10);
        if (EN(10) && IN(pb + 11)) {
            const int* tile_e = (const int*)(ws + WS_TILEE); const int ntiles = tile_e[200];
            pg8::Gemm g{(const bf16*)(ws + WS_XP), (const bf16*)(ws + WS_WGU), MOE_MAXROWS, NEXP * 1024, D}; MoeOrder S{tile_e, ntiles, 4, G, bid};
            EpiGU E{(bf16*)(ws + WS_HMID)};
            RUN(12, true, pg8::gemm_phase<EpiGU, MoeOrder, true, true>(lds, g, S, E));
        }
        SEAM(pb + 11);
        if (EN(11) && IN(pb + 12)) {
            const int* tile_e = (const int*)(ws + WS_TILEE); const int ntiles = tile_e[200];
            pg8::Gemm g{(const bf16*)(ws + WS_HMID), (const bf16*)(ws + WS_WD), MOE_MAXROWS, NEXP * D, DFF}; MoeOrder S{tile_e, ntiles, 8, G, bid};
            EpiDn E{(bf16*)(ws + WS_YP), (const float*)(ws + WS_ROWW)};
            RUN(13, true, pg8::gemm_phase<EpiDn, MoeOrder, true, true>(lds, g, S, E));
        }
        SEAM(pb + 12);
    }
    if (EN(12) && IN(PH_FINAL)) norm_phase<2>(a, DEPTH, SEQ, ldsf);
#undef IN
#undef SEAM
#undef ws
#undef bid
#undef G
#undef lds
#undef ldsf
#undef U
#undef Z
#undef H
#undef modall
}

#ifndef MK_SINGLE
#define MK_SINGLE 1
#endif
extern "C" void kernel_launch(void* const* d_in, const int* in_sizes, int n_in, void* d_out, int out_size, void* d_ws, size_t ws_size, hipStream_t stream) {
    static int grid = 0;
    if (grid == 0) {
        if (n_in != N_IN || out_size != SEQ * D || ws_size < WS_END) { fprintf(stderr, "kernel_launch: unexpected problem shape (n_in %d, out %d, ws %zu < %zu)\n", n_in, out_size, ws_size, (size_t)WS_END); grid = -1; return; }
        int dev = 0, cus = 0;
        if (hipGetDevice(&dev) != hipSuccess || hipDeviceGetAttribute(&cus, hipDeviceAttributeMultiprocessorCount, dev) != hipSuccess) { grid = -1; return; }
        if (hipFuncSetAttribute((const void*)fwd_kernel, hipFuncAttributeMaxDynamicSharedMemorySize, LDS_BYTES) != hipSuccess) { fprintf(stderr, "kernel_launch: hipFuncSetAttribute failed\n"); grid = -1; return; }
        int per_cu = 0;
        if (hipOccupancyMaxActiveBlocksPerMultiprocessor(&per_cu, (const void*)fwd_kernel, NTHR, LDS_BYTES) != hipSuccess || per_cu < 1) fprintf(stderr, "kernel_launch: occupancy query says %d\n", per_cu);
        (void)hipGetLastError();
        grid = cus;
    }
    if (grid < 0) return;
    (void)hipMemsetAsync((char*)d_ws + WS_CTL, 0, CTL_BYTES, stream);
    KArgs ka{};
    for (int i = 0; i < N_IN; ++i) ka.a.in[i] = (const float*)d_in[i];
    ka.a.out = (float*)d_out; ka.a.ws = (unsigned char*)d_ws;
#if MK_SINGLE
    ka.a.ph_lo = 0; ka.a.ph_hi = NPHASES; ka.li = 0; ka.pad = 0;
    hipLaunchKernelGGL(fwd_kernel, dim3(grid), dim3(NTHR), LDS_BYTES, stream, ka);
#else
    for (int ph = 0; ph < NPHASES; ++ph) { ka.a.ph_lo = ph; ka.a.ph_hi = ph + 1; ka.li = 0; ka.pad = 0; hipLaunchKernelGGL(fwd_kernel, dim3(grid), dim3(NTHR), LDS_BYTES, stream, ka); }
#endif
}
```

```cpp
#include <hip/hip_runtime.h>
#include <cstdio>
#include <cstdint>
#define DI __device__ __forceinline__
#define LAS __attribute__((address_space(3)))
typedef unsigned short bf16;
typedef float f32x4 __attribute__((ext_vector_type(4)));
typedef unsigned u32x4 __attribute__((ext_vector_type(4)));
typedef unsigned u32x2 __attribute__((ext_vector_type(2)));

constexpr int D = 2048, SEQ = 16384, CTXL = 256, MT = SEQ + CTXL  , DEPTH = 2;
constexpr int NCOLS_IN = 17440;
constexpr int ZC = 17664;
constexpr int Z_HG = 0, Z_GL = 5120, Z_HY = 8192, Z_MG = 11264, Z_LR = 17408;
constexpr int NEXP = 32, DFF = 512, MOE_MAXROWS = 41472;
constexpr float NORM_EPS = 1e-6f;

constexpr size_t MiB = 1u << 20;
constexpr size_t WS_CTL = 0, CTL_BYTES = 1 * MiB;
constexpr size_t WS_SMALL = 1 * MiB;
constexpr size_t WS_MOD   = WS_SMALL;
constexpr size_t WS_ZBIAS = WS_MOD + (size_t)DEPTH * 2 * 12288 * 4;
constexpr size_t WS_LB    = WS_ZBIAS + (size_t)DEPTH * ZC * 4;
constexpr size_t WS_TW    = WS_LB + (size_t)DEPTH * 2 * 1024 * 4;
constexpr size_t WS_TW2   = WS_TW + 16384 * 8;
constexpr size_t WS_H2    = WS_TW2 + (8192 + 64) * 8;
constexpr size_t WS_ROUTE = WS_H2 + (size_t)DEPTH * MT * 64 * 4;
constexpr size_t WS_ROWW  = WS_ROUTE + (size_t)MT * 8 * 4;
constexpr size_t WS_TILEE = WS_ROWW + (size_t)MOE_MAXROWS * 4;
constexpr size_t WS_HYC   = WS_TILEE + 1024;
constexpr size_t WS_W3T   = WS_HYC + (size_t)2048 * 256 * 4;
constexpr size_t WS_H2B   = WS_W3T + (size_t)DEPTH * 2048 * 256 * 2;
constexpr size_t WS_WRT   = WS_H2B + (size_t)DEPTH * SEQ * 256 * 2;
constexpr size_t WS_SMALL_END = WS_WRT + (size_t)DEPTH * 2 * 48 * 2048 * 2;
static_assert(WS_SMALL_END <= 40 * MiB, "small tables");
constexpr size_t WS_WIN  = 40 * MiB;
constexpr size_t WS_WBR  = 109 * MiB;
constexpr size_t WS_WOUT = 121 * MiB;
constexpr size_t WS_WGU  = 129 * MiB;
constexpr size_t WS_CVO  = WS_WIN;
constexpr size_t WS_WD   = 257 * MiB;
constexpr size_t WS_H    = 321 * MiB;
constexpr size_t WS_U    = 451 * MiB;
constexpr size_t WS_Z    = 516 * MiB;
constexpr size_t WS_XP   = WS_Z;
constexpr size_t WS_HMID = WS_Z + 162 * MiB;
constexpr size_t WS_YP   = WS_Z + 203 * MiB;
constexpr size_t WS_YMIX = 1077 * MiB;
constexpr size_t WS_HF   = 1175 * MiB;
constexpr size_t WS_OSC  = 1175 * MiB;
constexpr size_t WS_END  = 1435 * MiB;
static_assert(WS_WIN + (size_t)ZC * D * 2 <= WS_WBR && WS_Z + (size_t)MT * ZC * 2 <= WS_YMIX && WS_YMIX + (size_t)3 * MT * 1024 * 2 <= WS_OSC && WS_OSC + (size_t)4 * MT * 1024 * 4 <= WS_END, "ws map");
static_assert(WS_YP + (size_t)MOE_MAXROWS * D * 2 <= WS_YMIX && WS_H + (size_t)MT * D * 4 <= WS_U && WS_U + (size_t)MT * D * 2 <= WS_Z, "ws map 2");
constexpr int CW_BAR = 4096;
constexpr int CW_CNT = 16384;

DI float bf2f(bf16 v) { return __uint_as_float(((unsigned)v) << 16); }
DI float bflo(unsigned w) { return __uint_as_float(w << 16); }
DI float bfhi(unsigned w) { return __uint_as_float(w & 0xffff0000u); }
typedef float f32x2_t __attribute__((ext_vector_type(2))); typedef __bf16 bf16x2_t __attribute__((ext_vector_type(2)));
DI unsigned pk_bf16(float lo, float hi) { f32x2_t v = {lo, hi}; bf16x2_t b = __builtin_convertvector(v, bf16x2_t); return __builtin_bit_cast(unsigned, b); }
DI bf16 f2bf(float f) { return (bf16)(pk_bf16(f, 0.f) & 0xffffu); }
DI float sigmoidf_(float x) { return 1.0f / (1.0f + __expf(-x)); }
DI float siluf_(float x) { return x / (1.0f + __expf(-x)); }
DI float wave_sum(float v) {
#pragma unroll
    for (int o = 32; o >= 1; o >>= 1) v += __shfl_xor(v, o);
    return v;
}
DI int otid() { int t = __builtin_amdgcn_workitem_id_x(); asm volatile("" : "+v"(t)); return t; }
DI int ogdim() { int g = __builtin_amdgcn_workgroup_id_x(); g = (int)gridDim.x; asm volatile("" : "+s"(g)); return g; }
DI int obid() { int b = __builtin_amdgcn_workgroup_id_x(); asm volatile("" : "+s"(b)); return b; }
#define AIN_DECL 1
namespace pg8 {
#define PG8_LAS __attribute__((address_space(3)))
typedef unsigned short bf16_t;
typedef short bf16x8 __attribute__((ext_vector_type(8)));
typedef float f32x4 __attribute__((ext_vector_type(4)));
typedef unsigned u32x4 __attribute__((ext_vector_type(4)));
constexpr int BM = 256, BK = 64, HALF = 128, HTB = HALF * BK * 2  , STAGE_BYTES = 8 * HTB, NXCD = 8, WGM = 8;

__host__ __device__ __forceinline__ int lds_byte(int r, int c) { const int st = (r >> 4) * 2 + (c >> 5), rr = r & 15, cc = c & 31, ob = rr * 64 + cc * 2; return st * 1024 + (ob ^ (((ob >> 9) & 1) << 5)); }
__host__ __device__ __forceinline__ void stage_rc(int b, int& R, int& C) { const int st = b / 1024, sb = b % 1024, swz = sb ^ (((sb >> 9) & 1) << 5); R = (st >> 1) * 16 + swz / 64; C = (st & 1) * 32 + (swz % 64) / 2; }
__host__ __device__ __forceinline__ int perm32(int rho) { const int n = rho >> 4, i = rho & 15; return 8 * (i >> 2) + 4 * n + (i & 3); }

struct Unit { int pm, pn; };
struct Gemm { const bf16_t* A; const bf16_t* Bt; int M, N, K; };

struct StaticOrder {
    int nM, nN, nwg, G, c;
    __host__ __device__ void init(int M, int N, int G_, int c_) { nM = M / BM; nN = N / BM; nwg = nM * nN; G = G_; c = c_; }
    __host__ __device__ bool next(int i, Unit& u) const {
        const long L = (long)i * G + c; if (L >= nwg) return false;
        int wgid = (int)L; { const int q = nwg / NXCD, r = nwg % NXCD, xcd = wgid % NXCD, off = wgid / NXCD; wgid = (xcd < r ? xcd * (q + 1) : r * (q + 1) + (xcd - r) * q) + off; }
        const int nig = WGM * nN, gid = wgid / nig, fm = gid * WGM, gsz = (nM - fm) < WGM ? (nM - fm) : WGM;
        u.pm = fm + ((wgid % nig) % gsz); u.pn = (wgid % nig) / gsz; return true;
    }
    __device__ __forceinline__ void a_ready(const Unit&) const {}
    __device__ __forceinline__ void done(const Unit&) const {}
};

template <class Epi, class Sched, bool ALIGN_EPI = false, bool SP2 = false>
__device__ __forceinline__ void gemm_phase(PG8_LAS unsigned char* lds, const Gemm g, const Sched& S, const Epi& E) {
    const int tid = otid(), wid = __builtin_amdgcn_readfirstlane(tid >> 6), lane = tid & 63, wr = wid >> 2, wc = wid & 3, fr = lane & 15, fq = lane >> 4;
    const int K = g.K, nt = K / BK;
    unsigned voffA[2], voffB[2];
#pragma unroll
    for (int i = 0; i < 2; ++i) { int R, C; stage_rc(tid * 16 + i * 8192, R, C); const int Rb = Epi::PERM ? ((R & ~31) + perm32(R & 31)) : R;
        voffA[i] = (unsigned)(R * K + C) * 2u; voffB[i] = (unsigned)(Rb * K + C) * 2u; }
    const size_t kstep = (size_t)(BK * 2);
    const size_t hstep = (size_t)HALF * K * 2;
    const size_t tstep = 2 * hstep;
    const unsigned ldsw = (unsigned)wid * 1024u;
    const int aoff = lds_byte(wr * 64 + fr, fq * 8), boff = lds_byte(wc * 32 + fr, fq * 8);
#define PG8_SA(b, h) (((b) * 2 + (h)) * HTB)
#define PG8_SB(b, h) ((4 + (b) * 2 + (h)) * HTB)
#define PG8_STAGE(bufoff, gbase, voff) do { _Pragma("unroll") for (int _i = 0; _i < 2; ++_i) \
        __builtin_amdgcn_global_load_lds((const unsigned*)((const char*)(gbase) + (voff)[_i]), (PG8_LAS unsigned*)(lds + (bufoff) + ldsw + _i * 8192), 16, 0, 0); } while (0)
#define PG8_LDA(dst, b, h) do { _Pragma("unroll") for (int m = 0; m < 4; ++m) _Pragma("unroll") for (int k = 0; k < 2; ++k) dst[m][k] = *(const PG8_LAS bf16x8*)(lds + PG8_SA(b, h) + aoff + m * 2048 + k * 1024); } while (0)
#define PG8_LDB(dst, b, h) do { _Pragma("unroll") for (int n = 0; n < 2; ++n) _Pragma("unroll") for (int k = 0; k < 2; ++k) dst[n][k] = *(const PG8_LAS bf16x8*)(lds + PG8_SB(b, h) + boff + n * 2048 + k * 1024); } while (0)
#define PG8_MMA(ai, bj, At, Bt) do { __builtin_amdgcn_s_setprio(1); _Pragma("unroll") for (int m = 0; m < 4; ++m) _Pragma("unroll") for (int n = 0; n < 2; ++n) _Pragma("unroll") for (int k = 0; k < 2; ++k) \
        acc[ai][bj][m][n] = __builtin_amdgcn_mfma_f32_16x16x32_bf16(Bt[n][k], At[m][k], acc[ai][bj][m][n], 0, 0, 0); __builtin_amdgcn_s_setprio(0); } while (0)
#define PG8_WAIT_V(n) asm volatile("s_waitcnt vmcnt(" #n ")" ::: "memory")
#define PG8_WAIT_L(n) asm volatile("s_waitcnt lgkmcnt(" #n ")" ::: "memory")
#define PG8_BAR __builtin_amdgcn_s_barrier()
#define PG8_SCHED __builtin_amdgcn_sched_barrier(0)
    Unit cur, nxt; int ui = 0;
    if (!S.next(0, cur)) return;
    f32x4 acc[2][2][4][2];
#pragma unroll
    for (int a = 0; a < 2; ++a)
#pragma unroll
        for (int b = 0; b < 2; ++b)
#pragma unroll
            for (int m = 0; m < 4; ++m)
#pragma unroll
                for (int n = 0; n < 2; ++n) acc[a][b][m][n] = (f32x4){0.f, 0.f, 0.f, 0.f};
    bf16x8 At[4][2], B0[2][2], B1[2][2];
    const char* cA = (const char*)g.A + (size_t)cur.pm * tstep; const char* cB = (const char*)g.Bt + (size_t)cur.pn * tstep;
    S.a_ready(cur);
    if constexpr (SP2) {
        PG8_STAGE(PG8_SB(0, 0), cB, voffB); PG8_STAGE(PG8_SB(0, 1), cB + hstep, voffB); PG8_STAGE(PG8_SA(0, 0), cA, voffA); PG8_STAGE(PG8_SA(0, 1), cA + hstep, voffA);
        if (wr == 1) PG8_BAR;
        PG8_WAIT_V(2); PG8_BAR;
        PG8_STAGE(PG8_SB(1, 0), cB + kstep, voffB); PG8_STAGE(PG8_SA(1, 0), cA + kstep, voffA); PG8_STAGE(PG8_SB(1, 1), cB + hstep + kstep, voffB);
        PG8_WAIT_V(6); PG8_BAR;
    } else {
        PG8_STAGE(PG8_SB(0, 0), cB, voffB); PG8_STAGE(PG8_SA(0, 0), cA, voffA); PG8_STAGE(PG8_SB(0, 1), cB + hstep, voffB); PG8_STAGE(PG8_SA(0, 1), cA + hstep, voffA);
        if (wr == 1) PG8_BAR;
        PG8_WAIT_V(4); PG8_BAR;
        PG8_STAGE(PG8_SB(1, 0), cB + kstep, voffB); PG8_STAGE(PG8_SA(1, 0), cA + kstep, voffA); PG8_STAGE(PG8_SB(1, 1), cB + hstep + kstep, voffB);
        PG8_WAIT_V(6); PG8_BAR;
    }
    for (;;) {
        const bool has_next = S.next(ui + 1, nxt);
        const char* nA = has_next ? (const char*)g.A + (size_t)nxt.pm * tstep : cA; const char* nB = has_next ? (const char*)g.Bt + (size_t)nxt.pn * tstep : cB;
        for (int t = 0; t < nt; t += 2) {
            const bool last = (t == nt - 2);
            const char* a1 = cA + (size_t)(t + 1) * kstep;
            const char* a2 = last ? nA : cA + (size_t)(t + 2) * kstep; const char* b2 = last ? nB : cB + (size_t)(t + 2) * kstep;
            const char* a3 = a2 + kstep; const char* b3 = b2 + kstep;
            if (last && has_next) S.a_ready(nxt);
            if constexpr (SP2) {
            PG8_LDB(B0, 0, 0); PG8_LDB(B1, 0, 1); PG8_SCHED; PG8_LDA(At, 0, 0); PG8_STAGE(PG8_SA(1, 1), a1 + hstep, voffA);
            PG8_WAIT_V(8); PG8_WAIT_L(0); PG8_BAR; PG8_MMA(0, 0, At, B0); PG8_MMA(0, 1, At, B1); PG8_BAR; PG8_SCHED;
            PG8_LDA(At, 0, 1); PG8_STAGE(PG8_SB(0, 0), b2, voffB); PG8_STAGE(PG8_SB(0, 1), b2 + hstep, voffB); PG8_STAGE(PG8_SA(0, 0), a2, voffA);
            PG8_WAIT_V(8); PG8_WAIT_L(0); PG8_BAR; PG8_MMA(1, 0, At, B0); PG8_MMA(1, 1, At, B1); PG8_BAR; PG8_SCHED;
            PG8_LDB(B0, 1, 0); PG8_LDB(B1, 1, 1); PG8_SCHED; PG8_LDA(At, 1, 0); PG8_STAGE(PG8_SA(0, 1), a2 + hstep, voffA);
            PG8_WAIT_V(8); PG8_WAIT_L(0); PG8_BAR; PG8_MMA(0, 0, At, B0); PG8_MMA(0, 1, At, B1); PG8_BAR; PG8_SCHED;
            PG8_LDA(At, 1, 1); PG8_STAGE(PG8_SB(1, 0), b3, voffB); PG8_STAGE(PG8_SB(1, 1), b3 + hstep, voffB); PG8_STAGE(PG8_SA(1, 0), a3, voffA);
            PG8_WAIT_V(8); PG8_WAIT_L(0); PG8_BAR; PG8_MMA(1, 0, At, B0); PG8_MMA(1, 1, At, B1); PG8_BAR; PG8_SCHED;
            } else {
            PG8_LDB(B0, 0, 0); PG8_SCHED; PG8_LDA(At, 0, 0); PG8_STAGE(PG8_SA(1, 1), a1 + hstep, voffA);
            PG8_WAIT_L(8); PG8_BAR; PG8_WAIT_L(0); PG8_MMA(0, 0, At, B0); PG8_BAR; PG8_SCHED;
            PG8_LDB(B1, 0, 1); PG8_STAGE(PG8_SB(0, 0), b2, voffB);
            PG8_BAR; PG8_WAIT_L(0); PG8_MMA(0, 1, At, B1); PG8_BAR;
            PG8_LDA(At, 0, 1); PG8_STAGE(PG8_SA(0, 0), a2, voffA);
            PG8_BAR; PG8_WAIT_L(0); PG8_MMA(1, 0, At, B0); PG8_BAR; PG8_SCHED;
            PG8_STAGE(PG8_SB(0, 1), b2 + hstep, voffB);
            PG8_WAIT_V(6); PG8_BAR; PG8_MMA(1, 1, At, B1); PG8_BAR;
            PG8_LDB(B0, 1, 0); PG8_SCHED; PG8_LDA(At, 1, 0); PG8_STAGE(PG8_SA(0, 1), a2 + hstep, voffA);
            PG8_WAIT_L(8); PG8_BAR; PG8_WAIT_L(0); PG8_MMA(0, 0, At, B0); PG8_BAR; PG8_SCHED;
            PG8_LDB(B1, 1, 1); PG8_STAGE(PG8_SB(1, 0), b3, voffB);
            PG8_BAR; PG8_WAIT_L(0); PG8_MMA(0, 1, At, B1); PG8_BAR;
            PG8_LDA(At, 1, 1); PG8_STAGE(PG8_SA(1, 0), a3, voffA);
            PG8_BAR; PG8_WAIT_L(0); PG8_MMA(1, 0, At, B0); PG8_BAR; PG8_SCHED;
            PG8_STAGE(PG8_SB(1, 1), b3 + hstep, voffB);
            PG8_WAIT_V(6); PG8_BAR; PG8_MMA(1, 1, At, B1); PG8_BAR;
            }
        }
        if constexpr (ALIGN_EPI) { if (wr == 0) PG8_BAR; }
        if constexpr (!Epi::AFTER_DRAIN) { E(acc, cur, wr, wc, fr, fq); S.done(cur); }
        if (!has_next) break;
#pragma unroll
        for (int a = 0; a < 2; ++a)
#pragma unroll
            for (int b = 0; b < 2; ++b)
#pragma unroll
                for (int m = 0; m < 4; ++m)
#pragma unroll
                    for (int n = 0; n < 2; ++n) acc[a][b][m][n] = (f32x4){0.f, 0.f, 0.f, 0.f};
        cur = nxt; cA = nA; cB = nB; ++ui;
        if constexpr (ALIGN_EPI) { if (wr == 1) PG8_BAR; }
    }
    PG8_WAIT_V(0);
    if constexpr (!ALIGN_EPI) { if (wr == 0) PG8_BAR; }
    PG8_BAR;
    if constexpr (Epi::AFTER_DRAIN) { E.fused(acc, cur, wr, wc, fr, fq, lds, wid, lane); S.done(cur); }
#undef PG8_SA
#undef PG8_SB
#undef PG8_STAGE
#undef PG8_LDA
#undef PG8_LDB
#undef PG8_MMA
#undef PG8_WAIT_V
#undef PG8_WAIT_L
#undef PG8_BAR
#undef PG8_SCHED
}
}
#define XB_TMO      128
#define XB_XCNT(j)  (256  + 64 * (j))
#define XB_XSUB(j)  (1280 + 64 * (j))
#define XB_XGEN(j)  (2304 + 64 * (j))
#define XB_TOP      3328
#define XB_TOPGEN   3392
#define XCD_BAR_WORDS 3456
#define XB_SPIN_CAP (1u << 18)

__device__ __forceinline__ unsigned xb_ld(unsigned* p)              { return __hip_atomic_load(p, __ATOMIC_RELAXED, __HIP_MEMORY_SCOPE_AGENT); }
__device__ __forceinline__ unsigned xb_add(unsigned* p, unsigned v) { return __hip_atomic_fetch_add(p, v, __ATOMIC_RELAXED, __HIP_MEMORY_SCOPE_AGENT); }
__device__ __forceinline__ unsigned xb_xcc_id() { return (unsigned)__builtin_amdgcn_s_getreg((3 << 11) | 20) & 0xFu; }
#define XB_SPIN(cond, bar) do { unsigned _sp = 0; while (cond) { __builtin_amdgcn_s_sleep(1); \
    if ((++_sp & 255u) == 0u) { if (xb_ld(&(bar)[XB_TMO])) break; if (_sp > XB_SPIN_CAP) { atomicAdd(&(bar)[XB_TMO], 1u); break; } } } } while (0)

struct XcdBarrier {
    unsigned* bar; unsigned x;
    volatile LAS unsigned* st;
};

__device__ __forceinline__ XcdBarrier xcd_barrier_post(unsigned* bar, volatile LAS unsigned* st) {
    XcdBarrier b; b.bar = bar; b.x = xb_xcc_id(); b.st = st;
    if (otid() == 0) (void)xb_add(&bar[XB_XCNT(b.x)], 1u);
    return b;
}
__device__ __forceinline__ void xcd_barrier_complete(unsigned* bar, unsigned x, unsigned& nloc, unsigned& nx) {
    asm volatile("" : "+s"(x));
    const unsigned G = ogdim();
    unsigned sum, cnt, mine, sp = 0u;
    for (;;) {
        sum = 0u; cnt = 0u; mine = 0u;
#pragma unroll
        for (unsigned j = 0; j < 16; ++j) { const unsigned c = xb_ld(&bar[XB_XCNT(j)]); sum += c; cnt += (c > 0u) ? 1u : 0u; mine = (j == x) ? c : mine; }
        if (sum == G) break;
        __builtin_amdgcn_s_sleep(1);
        if ((++sp & 255u) == 0u) { if (xb_ld(&bar[XB_TMO])) break; if (sp > XB_SPIN_CAP) { atomicAdd(&bar[XB_TMO], 1u); break; } }
    }
    nloc = mine > 0u ? mine : 1u; nx = cnt > 0u ? cnt : 1u;
}

__device__ __forceinline__ void xcd_barrier(const XcdBarrier& b) {
    asm volatile("s_waitcnt vmcnt(0)" ::: "memory");
    __syncthreads();
    if (otid() == 0) {
        unsigned* bar = b.bar;
        __builtin_amdgcn_s_waitcnt(0);
        unsigned nloc = b.st[0], nx = b.st[1];
        if (nloc == 0u) { xcd_barrier_complete(bar, b.x, nloc, nx); b.st[0] = nloc; b.st[1] = nx; }
        const unsigned old = xb_add(&bar[XB_XSUB(b.x)], 1u);
        const unsigned gen = old / nloc;
        if (old + 1u == (gen + 1u) * nloc) {
            __builtin_amdgcn_fence(__ATOMIC_RELEASE, "agent");
            asm volatile("s_waitcnt vmcnt(0)" ::: "memory");
            const unsigned og = xb_add(&bar[XB_TOP], 1u);
            const unsigned tg = og / nx;
            if (og + 1u == (tg + 1u) * nx) xb_add(&bar[XB_TOPGEN], 1u);
            else XB_SPIN(xb_ld(&bar[XB_TOPGEN]) == tg, bar);
            __builtin_amdgcn_fence(__ATOMIC_ACQUIRE, "agent");
            xb_add(&bar[XB_XGEN(b.x)], 1u);
            asm volatile("s_waitcnt vmcnt(0)" ::: "memory");
        } else {
            XB_SPIN(xb_ld(&bar[XB_XGEN(b.x)]) == gen, bar);
            __builtin_amdgcn_fence(__ATOMIC_ACQUIRE, "agent");
            asm volatile("s_waitcnt vmcnt(0)" ::: "memory");
        }
    }
    __syncthreads();
}

#define FFT_DI DI
#define FFT_M 16384
#define FFT_NT 512
struct cpx { float x, y; };
FFT_DI cpx cmul(cpx a, cpx b) { cpx r; r.x = a.x * b.x - a.y * b.y; r.y = a.x * b.y + a.y * b.x; return r; }
FFT_DI cpx cmulc(cpx a, cpx b) { cpx r; r.x = a.x * b.x + a.y * b.y; r.y = a.y * b.x - a.x * b.y; return r; }
FFT_DI int rev4_14(int k) {
    int r = 0;
#pragma unroll
    for (int d = 0; d < 7; ++d) { r = (r << 2) | (k & 3); k >>= 2; }
    return r;
}
template <int s, class LP, class TP> FFT_DI void fft_fwd_pass(LP lds, TP tw, int tid) {
    constexpr int tws = FFT_M / (4 * s);
#pragma unroll
    for (int b = tid; b < FFT_M / 4; b += FFT_NT) {
        const int pos = b & (s - 1), base = ((b & ~(s - 1)) << 2) + pos;
        cpx a0, a1, a2, a3;
        a0.x = lds[2 * base]; a0.y = lds[2 * base + 1];
        a1.x = lds[2 * (base + s)]; a1.y = lds[2 * (base + s) + 1];
        a2.x = lds[2 * (base + 2 * s)]; a2.y = lds[2 * (base + 2 * s) + 1];
        a3.x = lds[2 * (base + 3 * s)]; a3.y = lds[2 * (base + 3 * s) + 1];
        cpx t0, t1, t2, t3;
        t0.x = a0.x + a2.x; t0.y = a0.y + a2.y;
        t1.x = a0.x - a2.x; t1.y = a0.y - a2.y;
        t2.x = a1.x + a3.x; t2.y = a1.y + a3.y;
        t3.x = a1.x - a3.x; t3.y = a1.y - a3.y;
        cpx y0, y1, y2, y3;
        y0.x = t0.x + t2.x; y0.y = t0.y + t2.y;
        y2.x = t0.x - t2.x; y2.y = t0.y - t2.y;
        y1.x = t1.x + t3.y; y1.y = t1.y - t3.x;
        y3.x = t1.x - t3.y; y3.y = t1.y + t3.x;
        if (s > 1) {
            cpx w1, w2, w3;
            w1.x = tw[2 * (pos * tws)]; w1.y = tw[2 * (pos * tws) + 1];
            w2.x = tw[2 * (2 * pos * tws)]; w2.y = tw[2 * (2 * pos * tws) + 1];
            w3.x = tw[2 * (3 * pos * tws)]; w3.y = tw[2 * (3 * pos * tws) + 1];
            y1 = cmul(y1, w1); y2 = cmul(y2, w2); y3 = cmul(y3, w3);
        }
        lds[2 * base] = y0.x; lds[2 * base + 1] = y0.y;
        lds[2 * (base + s)] = y1.x; lds[2 * (base + s) + 1] = y1.y;
        lds[2 * (base + 2 * s)] = y2.x; lds[2 * (base + 2 * s) + 1] = y2.y;
        lds[2 * (base + 3 * s)] = y3.x; lds[2 * (base + 3 * s) + 1] = y3.y;
    }
}
template <int s, class LP, class TP> FFT_DI void fft_inv_pass(LP lds, TP tw, int tid) {
    constexpr int tws = FFT_M / (4 * s);
#pragma unroll
    for (int b = tid; b < FFT_M / 4; b += FFT_NT) {
        const int pos = b & (s - 1), base = ((b & ~(s - 1)) << 2) + pos;
        cpx b0, c1, c2, c3;
        b0.x = lds[2 * base]; b0.y = lds[2 * base + 1];
        c1.x = lds[2 * (base + s)]; c1.y = lds[2 * (base + s) + 1];
        c2.x = lds[2 * (base + 2 * s)]; c2.y = lds[2 * (base + 2 * s) + 1];
        c3.x = lds[2 * (base + 3 * s)]; c3.y = lds[2 * (base + 3 * s) + 1];
        if (s > 1) {
            cpx w1, w2, w3;
            w1.x = tw[2 * (pos * tws)]; w1.y = tw[2 * (pos * tws) + 1];
            w2.x = tw[2 * (2 * pos * tws)]; w2.y = tw[2 * (2 * pos * tws) + 1];
            w3.x = tw[2 * (3 * pos * tws)]; w3.y = tw[2 * (3 * pos * tws) + 1];
            c1 = cmulc(c1, w1); c2 = cmulc(c2, w2); c3 = cmulc(c3, w3);
        }
        cpx t0, t1, t2, t3;
        t0.x = b0.x + c2.x; t0.y = b0.y + c2.y;
        t1.x = b0.x - c2.x; t1.y = b0.y - c2.y;
        t2.x = c1.x + c3.x; t2.y = c1.y + c3.y;
        t3.x = c1.x - c3.x; t3.y = c1.y - c3.y;
        cpx x0, x1, x2, x3;
        x0.x = t0.x + t2.x; x0.y = t0.y + t2.y;
        x2.x = t0.x - t2.x; x2.y = t0.y - t2.y;
        x1.x = t1.x - t3.y; x1.y = t1.y + t3.x;
        x3.x = t1.x + t3.y; x3.y = t1.y - t3.x;
        lds[2 * base] = x0.x; lds[2 * base + 1] = x0.y;
        lds[2 * (base + s)] = x1.x; lds[2 * (base + s) + 1] = x1.y;
        lds[2 * (base + 2 * s)] = x2.x; lds[2 * (base + 2 * s) + 1] = x2.y;
        lds[2 * (base + 3 * s)] = x3.x; lds[2 * (base + 3 * s) + 1] = x3.y;
    }
}
template <class LP, class TP> FFT_DI void rfft_untangle(LP lds, TP tw2, int k, cpx& Xk, cpx& Xm) {
    if (k == 0) {
        const float zr = lds[0], zi = lds[1];
        Xk.x = zr + zi; Xk.y = zr - zi;
        const int p = rev4_14(FFT_M / 2);
        Xm.x = lds[2 * p]; Xm.y = -lds[2 * p + 1];
        return;
    }
    const int pk = rev4_14(k), pm = rev4_14(FFT_M - k);
    cpx Zk, Zm; Zk.x = lds[2 * pk]; Zk.y = lds[2 * pk + 1]; Zm.x = lds[2 * pm]; Zm.y = lds[2 * pm + 1];
    cpx E, O, W, WO;
    E.x = 0.5f * (Zk.x + Zm.x); E.y = 0.5f * (Zk.y - Zm.y);
    O.x = 0.5f * (Zk.y + Zm.y); O.y = -0.5f * (Zk.x - Zm.x);
    W.x = tw2[2 * k]; W.y = tw2[2 * k + 1];
    WO = cmul(W, O);
    Xk.x = E.x + WO.x; Xk.y = E.y + WO.y;
    Xm.x = E.x - WO.x; Xm.y = -(E.y - WO.y);
}
template <class LP, class TP> FFT_DI void rfft_mul_retangle(LP lds, TP tw2, int k, cpx Gk, cpx Gm) {
    cpx Xk, Xm; rfft_untangle(lds, tw2, k, Xk, Xm);
    if (k == 0) {
        const float y0 = Xk.x * Gk.x, yM = Xk.y * Gk.y;
        lds[0] = 0.5f * (y0 + yM); lds[1] = 0.5f * (y0 - yM);
        const cpx Y = cmul(Xm, Gm);
        const int p = rev4_14(FFT_M / 2);
        lds[2 * p] = Y.x; lds[2 * p + 1] = -Y.y;
        return;
    }
    const cpx Yk = cmul(Xk, Gk), Ym = cmul(Xm, Gm);
    cpx W; W.x = tw2[2 * k]; W.y = tw2[2 * k + 1];
    cpx A, D, T;
    A.x = 0.5f * (Yk.x + Ym.x); A.y = 0.5f * (Yk.y - Ym.y);
    D.x = 0.5f * (Yk.x - Ym.x); D.y = 0.5f * (Yk.y + Ym.y);
    T = cmulc(D, W);
    const int pk = rev4_14(k), pm = rev4_14(FFT_M - k);
    lds[2 * pk] = A.x - T.y; lds[2 * pk + 1] = A.y + T.x;
    cpx Dc; Dc.x = -D.x; Dc.y = D.y;
    const cpx T2 = cmul(W, Dc);
    lds[2 * pm] = A.x + T2.y; lds[2 * pm + 1] = -A.y - T2.x;
}
enum { I_X = 0, I_C, I_CTX, I_CCTX, I_WMOD, I_BMOD, I_NMIXW, I_NFFNW, I_WIN, I_BIN, I_HYCW, I_HYCB, I_HYW1, I_HYB1, I_HYW2, I_HYB2, I_HYW3, I_HYB3, I_HYFREQ, I_HYSKIP,
       I_HGLB, I_HGNW, I_GLWA2, I_GLBA, I_GLNW, I_WBR, I_WOUT, I_WRG, I_BRG, I_WRE, I_BRE, I_WGATE, I_WUP, I_WDOWN, I_FNW, N_IN };
struct Args { const float* in[N_IN]; float* out; unsigned char* ws; int ph_lo, ph_hi; };
extern __shared__ __attribute__((aligned(16))) unsigned char lds_raw[];
constexpr int LDS_PTAB = 150 * 1024 - 64 - 320;
DI LAS unsigned char* ldsbase() { unsigned p = (unsigned)(unsigned long long)(LAS unsigned char*)lds_raw; asm volatile("" : "+s"(p)); return (LAS unsigned char*)(unsigned long long)p; }
DI const float* ain(const Args&, int i) { const unsigned long long v = ((LAS unsigned long long*)(ldsbase() + LDS_PTAB))[i];
    const unsigned lo = __builtin_amdgcn_readfirstlane((unsigned)v), hi = __builtin_amdgcn_readfirstlane((unsigned)(v >> 32)); return (const float*)(((unsigned long long)hi << 32) | lo); }
DI unsigned char* wsp(const Args& a) { unsigned long long p = (unsigned long long)(a).ws; asm volatile("" : "+s"(p)); return (unsigned char*)p; }
DI int opq(int x) { asm volatile("" : "+s"(x)); return x; }
constexpr int NTHR = 512;
constexpr int LDS_BYTES = 150 * 1024;
constexpr int LDS_X = 131072;
constexpr int LDS_BARW = LDS_BYTES - 64;

DI int z_srccol(int zc) { return zc < 8192 ? zc : (zc < Z_LR ? zc + 32 : (zc < Z_LR + 32 ? zc - Z_LR + 8192 : -1)); }

DI void cvt_block(const float* __restrict__ s0, const float* __restrict__ s1, const float* __restrict__ s2, const float* __restrict__ s3, size_t ld, int c0, int c1, int c2, int c3,
                  bf16* __restrict__ dst, int K, int row0, int kb, LAS float* t) {
    const int tid = otid(), nn = tid & 63, kk = tid >> 6;
    float v[8][4];
#pragma unroll
    for (int p = 0; p < 8; ++p) { const size_t ko = (size_t)(kb * 64 + p * 8 + kk) * ld;
        v[p][0] = c0 >= 0 ? s0[ko + c0] : 0.f; v[p][1] = c1 >= 0 ? s1[ko + c1] : 0.f; v[p][2] = c2 >= 0 ? s2[ko + c2] : 0.f; v[p][3] = c3 >= 0 ? s3[ko + c3] : 0.f; }
#pragma unroll
    for (int p = 0; p < 8; ++p)
#pragma unroll
        for (int g = 0; g < 4; ++g) t[(p * 8 + kk) * 257 + g * 64 + nn] = v[p][g];
    __syncthreads();
    const int rr = tid & 255, hk = tid >> 8;
#pragma unroll
    for (int q = 0; q < 4; ++q) { float w[8];
#pragma unroll
        for (int j = 0; j < 8; ++j) w[j] = t[(hk * 32 + q * 8 + j) * 257 + rr];
        u32x4 o; o.x = pk_bf16(w[0], w[1]); o.y = pk_bf16(w[2], w[3]); o.z = pk_bf16(w[4], w[5]); o.w = pk_bf16(w[6], w[7]);
        *(u32x4*)(dst + (size_t)(row0 + rr) * K + kb * 64 + hk * 32 + q * 8) = o; }
    __syncthreads();
}
constexpr int CVT_MIX_TILES = 69 * 32 + 3 * 8 * 16 + 8 * 32;
DI void cvt_mix_item(const Args& a, int l, int it, LAS float* t) {
    const int nn = otid() & 63;
    if (it < 69 * 32) { const int nb = it >> 5, kb = it & 31; const float* s = ain(a, I_WIN) + (size_t)l * D * NCOLS_IN;
        cvt_block(s, s, s, s, NCOLS_IN, z_srccol(nb * 256 + nn), z_srccol(nb * 256 + 64 + nn), z_srccol(nb * 256 + 128 + nn), z_srccol(nb * 256 + 192 + nn), (bf16*)(wsp(a) + WS_WIN), D, nb * 256, kb, t); return; }
    it -= 69 * 32;
    if (it < 3 * 8 * 16) { const int br = it / 128, r = it % 128, nb = r >> 4, kb = r & 15; const float* s = ain(a, I_WBR) + ((size_t)l * 3 + br) * 1024 * D; const int c = nb * 256 + nn;
        cvt_block(s, s, s, s, D, c, c + 64, c + 128, c + 192, (bf16*)(wsp(a) + WS_WBR) + (size_t)br * D * 1024, 1024, nb * 256, kb, t); return; }
    it -= 3 * 8 * 16;
    { const int nb = it >> 5, kb = it & 31; const float* s = ain(a, I_WOUT) + (size_t)l * D * D; const int c = nb * 256 + nn;
      cvt_block(s, s, s, s, D, c, c + 64, c + 128, c + 192, (bf16*)(wsp(a) + WS_WOUT), D, nb * 256, kb, t); }
}
constexpr int CVT_MOE_TILES = 32 * 4 * 32 + 32 * 8 * 8;
DI void cvt_moe_item(const Args& a, int l, int it, LAS float* t) {
    const int nn = otid() & 63;
    if (it < 32 * 4 * 32) { const int e = it >> 7, r = it & 127, nt = r >> 5, kb = r & 31;
        const float* sg = ain(a, I_WGATE) + ((size_t)l * NEXP + e) * D * DFF; const float* su = ain(a, I_WUP) + ((size_t)l * NEXP + e) * D * DFF; const int c = nt * 128 + nn;
        cvt_block(sg, sg, su, su, DFF, c, c + 64, c, c + 64, (bf16*)(wsp(a) + WS_WGU) + (size_t)e * 1024 * D, D, nt * 256, kb, t); return; }
    it -= 32 * 4 * 32;
    { const int e = it >> 6, r = it & 63, nb = r >> 3, kb = r & 7; const float* s = ain(a, I_WDOWN) + ((size_t)l * NEXP + e) * DFF * D; const int c = nb * 256 + nn;
      cvt_block(s, s, s, s, D, c, c + 64, c + 128, c + 192, (bf16*)(wsp(a) + WS_WD) + (size_t)e * D * DFF, DFF, nb * 256, kb, t); }
}

DI void mod_item(const Args& a, int j, LAS float* lds) {
    const int tid = otid(), l = j >> 7, col0 = (j & 127) * 96;
    LAS float* sil = lds;
    LAS float* red = lds + 4096;
    for (int k = tid; k < 2 * D; k += NTHR) { const float c = (k < D) ? ain(a, I_C)[k] : ain(a, I_CCTX)[k - D]; sil[k] = siluf_(c); }
    __syncthreads();
    const int cg = tid % 24, rg = tid / 24;
    f32x4 a0 = {0.f, 0.f, 0.f, 0.f}, a1 = {0.f, 0.f, 0.f, 0.f};
    if (rg < 21) {
        const float* w = ain(a, I_WMOD) + (size_t)l * D * 12288 + col0 + cg * 4;
        for (int k = rg; k < D; k += 21) { const f32x4 wv = *(const f32x4*)(w + (size_t)k * 12288); a0 += wv * sil[k]; a1 += wv * sil[D + k]; }
#pragma unroll
        for (int q = 0; q < 4; ++q) { red[(rg * 2 + 0) * 96 + cg * 4 + q] = a0[q]; red[(rg * 2 + 1) * 96 + cg * 4 + q] = a1[q]; }
    }
    __syncthreads();
    if (tid < 192) { const int set = tid / 96, c = tid % 96; float s = 0.f;
        for (int r = 0; r < 21; ++r) s += red[(r * 2 + set) * 96 + c];
        ((float*)(wsp(a) + WS_MOD))[((size_t)l * 2 + set) * 12288 + col0 + c] = s + ain(a, I_BMOD)[(size_t)l * 12288 + col0 + c]; }
    __syncthreads();
}
DI void h2_item(const Args& a, int it, LAS float* lds) {
    const int tid = otid(), l = it / (MT / 8), r0 = (it % (MT / 8)) * 8;
    LAS float* feats = lds;
    LAS float* h1 = lds + 8 * 36;
    if (tid < 8 * 33) { const int rr = tid / 33, i = tid % 33, r = r0 + rr; const int Lq = r < SEQ ? SEQ : CTXL, t = r < SEQ ? r : r - SEQ;
        float f;
        if (i == 0) f = (float)t / (float)(Lq - 1);
        else { const int bi = (i - 1) & 15; const float band = 1e-4f + (float)bi * ((15.0f - 1e-4f) / 15.0f); const float rev2 = 2.0f * band * (float)t / (float)Lq;
            f = (i <= 16) ? cospif(rev2) : -sinpif(rev2); }
        feats[rr * 36 + i] = f; }
    __syncthreads();
    const int rr = tid >> 6, j = tid & 63;
    { const float* w1 = ain(a, I_HYW1) + (size_t)l * 33 * 64; float s = ain(a, I_HYB1)[l * 64 + j];
      for (int i = 0; i < 33; ++i) s += feats[rr * 36 + i] * w1[i * 64 + j];
      h1[rr * 64 + j] = sinf(ain(a, I_HYFREQ)[l * 64 + j] * s); }
    __syncthreads();
    { const float* w2 = ain(a, I_HYW2) + (size_t)l * 64 * 64; float s = ain(a, I_HYB2)[l * 64 + j];
      for (int i = 0; i < 64; ++i) s += h1[rr * 64 + i] * w2[i * 64 + j];
      const float hv = sinf(ain(a, I_HYFREQ)[l * 64 + j] * s);
      ((float*)(wsp(a) + WS_H2))[((size_t)l * MT + r0 + rr) * 64 + j] = hv;
      if (r0 + rr < SEQ) { bf16* hb = (bf16*)(wsp(a) + WS_H2B) + ((size_t)l * SEQ + r0 + rr) * 256; hb[j] = f2bf(hv); hb[64 + j] = 0; hb[128 + j] = 0; hb[192 + j] = 0; } }
    __syncthreads();
}
DI void prologue_small(const Args& a) {
    const size_t gt = (size_t)obid() * NTHR + otid(), gs = (size_t)ogdim() * NTHR;
    float* zb = (float*)(wsp(a) + WS_ZBIAS);
    for (size_t i = gt; i < (size_t)DEPTH * ZC; i += gs) { const int l = (int)(i / ZC), zc = (int)(i % ZC), sc = z_srccol(zc); zb[i] = sc >= 0 ? ain(a, I_BIN)[(size_t)l * NCOLS_IN + sc] : 0.f; }
    float* lb = (float*)(wsp(a) + WS_LB);
    for (size_t i = gt; i < (size_t)DEPTH * 2048; i += gs) { const int l = (int)(i / 2048), j = (int)(i % 2048);
        float v = 0.f; if (l == 1) { const float r0 = ain(a, I_HGLB)[j], r1 = ain(a, I_HGLB)[2048 + j]; v = 1.0f / (1.0f + expf(r0 - r1)); }
        lb[i] = v; }
    bf16* w3t = (bf16*)(wsp(a) + WS_W3T);
    for (size_t i = gt; i < (size_t)DEPTH * 2048 * 256; i += gs) { const int l = (int)(i >> 19), fc = (int)((i >> 8) & 2047), j = (int)(i & 255); w3t[i] = j < 64 ? f2bf(ain(a, I_HYW3)[((size_t)l * 64 + j) * 2048 + fc]) : (bf16)0; }
    bf16* wrt = (bf16*)(wsp(a) + WS_WRT);
    for (size_t i = gt; i < (size_t)DEPTH * 48 * 2048; i += gs) { const int l = (int)(i / (48 * 2048)), c = (int)((i / 2048) % 48), k = (int)(i & 2047);
        const float w = c < 4 ? ain(a, I_WRG)[((size_t)l * D + k) * 4 + c] : (c < 36 ? ain(a, I_WRE)[((size_t)l * D + k) * 32 + (c - 4)] : 0.f);
        const bf16 hi = f2bf(w); wrt[((size_t)l * 2 + 0) * 48 * 2048 + (size_t)c * 2048 + k] = hi; wrt[((size_t)l * 2 + 1) * 48 * 2048 + (size_t)c * 2048 + k] = f2bf(w - bf2f(hi)); }
    float* tw = (float*)(wsp(a) + WS_TW);
    for (size_t i = gt; i < 16384; i += gs) { float s, c; sincospif(-2.0f * (float)i / 16384.0f, &s, &c); tw[2 * i] = c; tw[2 * i + 1] = s; }
    float* tw2 = (float*)(wsp(a) + WS_TW2);
    for (size_t i = gt; i <= 8192; i += gs) { float s, c; sincospif(-(float)i / 16384.0f, &s, &c); tw2[2 * i] = c; tw2[2 * i + 1] = s; }
}
DI void hyc_filters(const Args& a, int l) {
    const int lane = otid() & 63, wave = otid() >> 6;
    const float* h2 = (const float*)(wsp(a) + WS_H2) + ((size_t)l * MT + SEQ) * 64;
    const float* w3 = ain(a, I_HYW3) + (size_t)l * 64 * 2048;
    float* hyc = (float*)(wsp(a) + WS_HYC);
    const float a0 = -4.605170186f / 1.5f, a1 = -4.605170186f / 0.3f;
    for (int fc = obid() * 8 + wave; fc < 2048; fc += ogdim() * 8) {
        const int c = fc & 1023; const float delta = fabsf(a0 + (float)c * ((a1 - a0) / 1023.0f)); const float b3 = ain(a, I_HYB3)[l * 2048 + fc];
        float hv[4], ssum = 0.f;
#pragma unroll
        for (int i = 0; i < 4; ++i) { const int t = lane + 64 * i; float s = b3;
            for (int j = 0; j < 64; ++j) s += h2[t * 64 + j] * w3[j * 2048 + fc];
            const float tl = (float)t / 255.0f; hv[i] = s * (expf(-tl * delta) + 0.05f); ssum += fabsf(hv[i]); }
        ssum = wave_sum(ssum); const float inv = 1.0f / ssum;
#pragma unroll
        for (int i = 0; i < 4; ++i) hyc[(size_t)fc * 256 + lane + 64 * i] = hv[i] * inv;
    }
}
template <int MODE, bool DRY = false> DI void norm_phase(const Args& a, int l, int nrows, LAS float* ldsf) {
    const int lane = otid() & 63, wave = otid() >> 6;
    float* H = (float*)(wsp(a) + WS_H); bf16* U = (bf16*)(wsp(a) + WS_U);
    const float* modall = (const float*)(wsp(a) + WS_MOD);
    int* route = (int*)(wsp(a) + WS_ROUTE);
    const bf16* YP = (const bf16*)(wsp(a) + WS_YP);
    const bool combine = (MODE == 0 && l > 0) || MODE == 2;
    for (int r = obid() * 8 + wave; r < nrows; r += ogdim() * 8) {
        const int set = r >= SEQ ? 1 : 0;
        const float* src = (MODE == 0 && l == 0) ? (set ? ain(a, I_CTX) + (size_t)(r - SEQ) * D : ain(a, I_X) + (size_t)r * D) : H + (size_t)r * D;
        f32x4 v[8];
#pragma unroll
        for (int j = 0; j < 8; ++j) v[j] = *(const f32x4*)(src + j * 256 + lane * 4);
        if (combine) {
            const float* gt2 = modall + ((size_t)(l - 1) * 2 + set) * 12288 + 10240;
            const int p0 = route[r * 8 + 6], p1 = route[r * 8 + 7];
#pragma unroll
            for (int j = 0; j < 8; ++j) { const int col = j * 256 + lane * 4;
                const u32x2 y0 = *(const u32x2*)(YP + (size_t)p0 * D + col), y1 = *(const u32x2*)(YP + (size_t)p1 * D + col); const f32x4 g = *(const f32x4*)(gt2 + col);
                v[j][0] += g[0] * (bflo(y0.x) + bflo(y1.x)); v[j][1] += g[1] * (bfhi(y0.x) + bfhi(y1.x)); v[j][2] += g[2] * (bflo(y0.y) + bflo(y1.y)); v[j][3] += g[3] * (bfhi(y0.y) + bfhi(y1.y)); }
            if (MODE == 0) {
#pragma unroll
                for (int j = 0; j < 8; ++j) *(f32x4*)(H + (size_t)r * D + j * 256 + lane * 4) = v[j];
            }
        }
        float ss = 0.f;
#pragma unroll
        for (int j = 0; j < 8; ++j) ss += (v[j][0] * v[j][0] + v[j][1] * v[j][1]) + (v[j][2] * v[j][2] + v[j][3] * v[j][3]);
        ss = wave_sum(ss);
        const float rstd = rsqrtf(ss * (1.0f / D) + NORM_EPS);
        if (MODE == 2) {
            const float* fw = ain(a, I_FNW);
#pragma unroll
            for (int j = 0; j < 8; ++j) { const int col = j * 256 + lane * 4; const f32x4 w = *(const f32x4*)(fw + col); *(f32x4*)(a.out + (size_t)r * D + col) = v[j] * rstd * w; }
        } else {
            const float* nw = (MODE == 0 ? ain(a, I_NMIXW) : ain(a, I_NFFNW)) + (size_t)l * D;
            const float* md = modall + ((size_t)l * 2 + set) * 12288 + (MODE == 0 ? 0 : 6144);
#pragma unroll
            for (int j = 0; j < 8; ++j) { const int col = j * 256 + lane * 4; const f32x4 w = *(const f32x4*)(nw + col), sh = *(const f32x4*)(md + col), sc = *(const f32x4*)(md + 2048 + col);
                v[j] = (v[j] * rstd * w) * (sc + 1.0f) + sh;
                u32x2 o; o.x = pk_bf16(v[j][0], v[j][1]); o.y = pk_bf16(v[j][2], v[j][3]); *(u32x2*)(U + (size_t)r * D + col) = o; }
            if (MODE == 1) {
                const float* wrg = ain(a, I_WRG) + (size_t)l * D * 4; const float* wre = ain(a, I_WRE) + (size_t)l * D * 32;
                float lg[36];
#pragma unroll
                for (int i = 0; i < 36; ++i) lg[i] = 0.f;
                LAS float* wu = ldsf + wave * 2048;
#pragma unroll
                for (int j = 0; j < 8; ++j) *(LAS f32x4*)(wu + j * 256 + lane * 4) = v[j];
                asm volatile("s_waitcnt lgkmcnt(0)" ::: "memory");
#pragma unroll 2
                for (int cc = 0; cc < 32; ++cc) { const int col = cc * 64 + lane; const float uv = wu[col];
                    const f32x4 g = *(const f32x4*)(wrg + (size_t)col * 4);
                    lg[0] += uv * g[0]; lg[1] += uv * g[1]; lg[2] += uv * g[2]; lg[3] += uv * g[3];
#pragma unroll
                    for (int e4 = 0; e4 < 8; ++e4) { const f32x4 w = *(const f32x4*)(wre + (size_t)col * 32 + e4 * 4);
                        lg[4 + e4 * 4 + 0] += uv * w[0]; lg[4 + e4 * 4 + 1] += uv * w[1]; lg[4 + e4 * 4 + 2] += uv * w[2]; lg[4 + e4 * 4 + 3] += uv * w[3]; } }
                asm volatile("s_waitcnt lgkmcnt(0)" ::: "memory");
#pragma unroll
                for (int i = 0; i < 36; ++i) lg[i] = wave_sum(lg[i]);
                float gl[4]; int grp = 0; float gmax;
#pragma unroll
                for (int g = 0; g < 4; ++g) gl[g] = lg[g] + ain(a, I_BRG)[l * 4 + g];
                gmax = gl[0];
#pragma unroll
                for (int g = 1; g < 4; ++g) if (gl[g] > gmax) { gmax = gl[g]; grp = g; }
                float gden = 0.f;
#pragma unroll
                for (int g = 0; g < 4; ++g) gden += expf(gl[g] - gmax);
                const float ptop = 1.0f / gden;
                float le[8];
#pragma unroll
                for (int i = 0; i < 8; ++i) { float x = lg[4 + i];
#pragma unroll
                    for (int g = 1; g < 4; ++g) x = (grp == g) ? lg[4 + g * 8 + i] : x;
                    le[i] = x + ain(a, I_BRE)[l * 32 + grp * 8 + i]; }
                int i0 = 0; float m0 = le[0];
#pragma unroll
                for (int i = 1; i < 8; ++i) if (le[i] > m0) { m0 = le[i]; i0 = i; }
                int i1 = -1; float m1 = -3.0e38f;
#pragma unroll
                for (int i = 0; i < 8; ++i) if (i != i0 && le[i] > m1) { m1 = le[i]; i1 = i; }
                const float e1v = expf(m1 - m0);
                const float w0 = ptop / (1.0f + e1v), w1 = ptop * e1v / (1.0f + e1v);
                if (DRY) { asm volatile("" :: "v"(w0), "v"(w1), "v"(i0), "v"(i1), "v"(grp)); }
                else if (lane == 0) {
                    unsigned* cnt = (unsigned*)(wsp(a) + WS_CTL) + CW_CNT + l * 64;
                    const int ex0 = grp * 8 + i0, ex1 = grp * 8 + i1;
                    const unsigned s0 = atomicAdd(cnt + ex0, 1u), s1 = atomicAdd(cnt + ex1, 1u);
                    route[r * 8 + 0] = ex0; route[r * 8 + 1] = ex1; route[r * 8 + 2] = (int)s0; route[r * 8 + 3] = (int)s1;
                    route[r * 8 + 4] = __float_as_int(w0); route[r * 8 + 5] = __float_as_int(w1);
                }
            }
        }
    }
}
typedef short bf16x8r_t __attribute__((ext_vector_type(8)));
template <bool DRY> DI void route_phase(const Args& a, int l, int nrows, LAS float* ldsf) {
    const int lane = otid() & 63, wave = otid() >> 6, fr = lane & 15, fq = lane >> 4;
    const float* H = (const float*)(wsp(a) + WS_H); bf16* U = (bf16*)(wsp(a) + WS_U); int* route = (int*)(wsp(a) + WS_ROUTE);
    const float* nw = ain(a, I_NFFNW) + (size_t)l * D;
    const bf16* Wh = (const bf16*)(wsp(a) + WS_WRT) + (size_t)l * 2 * 48 * 2048; const bf16* Wl = Wh + 48 * 2048;
    LAS float* lt = ldsf + wave * 1024;
    const int G = ogdim();
    for (int tile = wave * G + (int)obid(); tile < nrows / 16; tile += 8 * G) {
        const int row = tile * 16 + fr, set = row >= SEQ ? 1 : 0;
        const float* hr = H + (size_t)row * D + fq * 8;
        const float* md = (const float*)(wsp(a) + WS_MOD) + ((size_t)l * 2 + set) * 12288 + 6144 + fq * 8;
        float ss = 0.f;
#pragma unroll 8
        for (int ks = 0; ks < 64; ++ks) { const f32x4 x0 = *(const f32x4*)(hr + ks * 32), x1 = *(const f32x4*)(hr + ks * 32 + 4);
            ss += (x0[0] * x0[0] + x0[1] * x0[1]) + (x0[2] * x0[2] + x0[3] * x0[3]) + (x1[0] * x1[0] + x1[1] * x1[1]) + (x1[2] * x1[2] + x1[3] * x1[3]); }
        ss += __shfl_xor(ss, 16); ss += __shfl_xor(ss, 32);
        const float rstd = rsqrtf(ss * (1.0f / D) + NORM_EPS);
        f32x4 acc[3];
#pragma unroll
        for (int cb = 0; cb < 3; ++cb) acc[cb] = (f32x4){0.f, 0.f, 0.f, 0.f};
#pragma unroll 2
        for (int ks = 0; ks < 64; ++ks) { const int c0 = ks * 32;
            const f32x4 x0 = *(const f32x4*)(hr + c0), x1 = *(const f32x4*)(hr + c0 + 4);
            const f32x4 w0 = *(const f32x4*)(nw + fq * 8 + c0), w1 = *(const f32x4*)(nw + fq * 8 + c0 + 4);
            const f32x4 h0 = *(const f32x4*)(md + c0), h1 = *(const f32x4*)(md + c0 + 4), s0 = *(const f32x4*)(md + 2048 + c0), s1 = *(const f32x4*)(md + 2048 + c0 + 4);
            const f32x4 u0 = (x0 * rstd * w0) * (s0 + 1.0f) + h0, u1 = (x1 * rstd * w1) * (s1 + 1.0f) + h1;
            u32x4 hi; hi.x = pk_bf16(u0[0], u0[1]); hi.y = pk_bf16(u0[2], u0[3]); hi.z = pk_bf16(u1[0], u1[1]); hi.w = pk_bf16(u1[2], u1[3]);
            *(u32x4*)(U + (size_t)row * D + fq * 8 + c0) = hi;
            u32x4 lo; lo.x = pk_bf16(u0[0] - bflo(hi.x), u0[1] - bfhi(hi.x)); lo.y = pk_bf16(u0[2] - bflo(hi.y), u0[3] - bfhi(hi.y)); lo.z = pk_bf16(u1[0] - bflo(hi.z), u1[1] - bfhi(hi.z)); lo.w = pk_bf16(u1[2] - bflo(hi.w), u1[3] - bfhi(hi.w));
            const bf16x8r_t ah = __builtin_bit_cast(bf16x8r_t, hi), al = __builtin_bit_cast(bf16x8r_t, lo);
#pragma unroll
            for (int cb = 0; cb < 3; ++cb) { const bf16x8r_t bh = *(const bf16x8r_t*)(Wh + (size_t)(cb * 16 + fr) * 2048 + c0 + fq * 8), bl = *(const bf16x8r_t*)(Wl + (size_t)(cb * 16 + fr) * 2048 + c0 + fq * 8);
                acc[cb] = __builtin_amdgcn_mfma_f32_16x16x32_bf16(ah, bh, acc[cb], 0, 0, 0); acc[cb] = __builtin_amdgcn_mfma_f32_16x16x32_bf16(ah, bl, acc[cb], 0, 0, 0); acc[cb] = __builtin_amdgcn_mfma_f32_16x16x32_bf16(al, bh, acc[cb], 0, 0, 0); } }
#pragma unroll
        for (int cb = 0; cb < 3; ++cb)
#pragma unroll
            for (int j = 0; j < 4; ++j) lt[(fq * 4 + j) * 48 + cb * 16 + fr] = acc[cb][j];
        asm volatile("s_waitcnt lgkmcnt(0)" ::: "memory");
        if (lane < 16) {
            const int r = tile * 16 + lane; float lg[36];
#pragma unroll
            for (int i = 0; i < 36; ++i) lg[i] = lt[lane * 48 + i];
            float gl[4]; int grp = 0; float gmax;
#pragma unroll
            for (int g = 0; g < 4; ++g) gl[g] = lg[g] + ain(a, I_BRG)[l * 4 + g];
            gmax = gl[0];
#pragma unroll
            for (int g = 1; g < 4; ++g) if (gl[g] > gmax) { gmax = gl[g]; grp = g; }
            float gden = 0.f;
#pragma unroll
            for (int g = 0; g < 4; ++g) gden += expf(gl[g] - gmax);
            const float ptop = 1.0f / gden;
            float le[8];
#pragma unroll
            for (int i = 0; i < 8; ++i) { float x = lg[4 + i];
#pragma unroll
                for (int g = 1; g < 4; ++g) x = (grp == g) ? lg[4 + g * 8 + i] : x;
                le[i] = x + ain(a, I_BRE)[l * 32 + grp * 8 + i]; }
            int i0 = 0; float m0 = le[0];
#pragma unroll
            for (int i = 1; i < 8; ++i) if (le[i] > m0) { m0 = le[i]; i0 = i; }
            int i1 = -1; float m1 = -3.0e38f;
#pragma unroll
            for (int i = 0; i < 8; ++i) if (i != i0 && le[i] > m1) { m1 = le[i]; i1 = i; }
            const float e1v = expf(m1 - m0);
            const float w0 = ptop / (1.0f + e1v), w1 = ptop * e1v / (1.0f + e1v);
            if (DRY) { asm volatile("" :: "v"(w0), "v"(w1), "v"(i0), "v"(i1), "v"(grp)); }
            else { unsigned* cnt = (unsigned*)(wsp(a) + WS_CTL) + CW_CNT + l * 64; const int ex0 = grp * 8 + i0, ex1 = grp * 8 + i1;
                const unsigned s0 = atomicAdd(cnt + ex0, 1u), s1 = atomicAdd(cnt + ex1, 1u);
                route[r * 8 + 0] = ex0; route[r * 8 + 1] = ex1; route[r * 8 + 2] = (int)s0; route[r * 8 + 3] = (int)s1; route[r * 8 + 4] = __float_as_int(w0); route[r * 8 + 5] = __float_as_int(w1); }
        }
        asm volatile("s_waitcnt lgkmcnt(0)" ::: "memory");
    }
}
DI void permute_phase(const Args& a, int l, int nrows, LAS unsigned char* ldsb) {
    LAS int* poff = (LAS int*)ldsb;
    const int tid = otid(), lane = tid & 63, wave = tid >> 6;
    const unsigned* cnt = (const unsigned*)(wsp(a) + WS_CTL) + CW_CNT + l * 64;
    if (tid == 0) { int off = 0; for (int e = 0; e < NEXP; ++e) { poff[e] = off; off += (int)((cnt[e] + 255u) / 256u) * 256; } poff[32] = off; }
    __syncthreads();
    if (obid() == 0) { int* tile_e = (int*)(wsp(a) + WS_TILEE); const int nt = poff[32] >> 8;
        if (tid < 200) { int e = -1; if (tid < nt) { for (int q = 0; q < NEXP; ++q) if (poff[q] <= tid * 256) e = q; } tile_e[tid] = e < 0 ? 0 : e; }
        if (tid == 0) tile_e[200] = nt; }
    int* route = (int*)(wsp(a) + WS_ROUTE); float* roww = (float*)(wsp(a) + WS_ROWW);
    const bf16* U = (const bf16*)(wsp(a) + WS_U); bf16* XP = (bf16*)(wsp(a) + WS_XP);
    for (int r = obid() * 8 + wave; r < nrows; r += ogdim() * 8) {
        const int e0 = route[r * 8 + 0], e1 = route[r * 8 + 1], s0 = route[r * 8 + 2], s1 = route[r * 8 + 3];
        const int p0 = poff[e0] + s0, p1 = poff[e1] + s1;
        u32x4 x[4];
#pragma unroll
        for (int i = 0; i < 4; ++i) x[i] = *(const u32x4*)(U + (size_t)r * D + (i * 64 + lane) * 8);
#pragma unroll
        for (int i = 0; i < 4; ++i) { *(u32x4*)(XP + (size_t)p0 * D + (i * 64 + lane) * 8) = x[i]; *(u32x4*)(XP + (size_t)p1 * D + (i * 64 + lane) * 8) = x[i]; }
        if (lane == 0) { route[r * 8 + 6] = p0; route[r * 8 + 7] = p1; roww[p0] = __int_as_float(route[r * 8 + 4]); roww[p1] = __int_as_float(route[r * 8 + 5]); }
    }
}
DI int stream_row(int p, int dir) { return dir == 0 ? (p < CTXL ? SEQ + p : p - CTXL) : (p < CTXL ? SEQ + (CTXL - 1 - p) : (SEQ - 1) - (p - CTXL)); }

DI void shortconv8(const bf16* Z, const float* cw, const float* cb, int l, int seg, int c, int r0, int lo, int hi, float (&out)[8]) {
    const int col = Z_HY + seg * 1024 + c; float zz[10];
#pragma unroll
    for (int i = 0; i < 10; ++i) { const int r = r0 - 1 + i; zz[i] = (r >= lo && r < hi) ? bf2f(Z[(size_t)r * ZC + col]) : 0.f; }
    const float w0 = cw[((size_t)l * 3 + 0) * 3072 + seg * 1024 + c], w1 = cw[((size_t)l * 3 + 1) * 3072 + seg * 1024 + c], w2 = cw[((size_t)l * 3 + 2) * 3072 + seg * 1024 + c], b = cb[(size_t)l * 3072 + seg * 1024 + c];
#pragma unroll
    for (int i = 0; i < 8; ++i) out[i] = w0 * zz[i] + w1 * zz[i + 1] + w2 * zz[i + 2] + b;
}
DI void hyprep_item(const Args& a, int l, int it, LAS float* t) {
    const int tid = otid(), tb = it >> 4, cb = it & 15, r0 = tb * 64, lo = r0 < SEQ ? 0 : SEQ, hi = r0 < SEQ ? SEQ : MT;
    const bf16* Z = (const bf16*)(wsp(a) + WS_Z); float* VXT = (float*)(wsp(a) + WS_U);
    { const int cc = tid & 63, tq = tid >> 6, c = cb * 64 + cc; float x1[8], vv[8];
      shortconv8(Z, ain(a, I_HYCW), ain(a, I_HYCB), l, 1, c, r0 + tq * 8, lo, hi, x1); shortconv8(Z, ain(a, I_HYCW), ain(a, I_HYCB), l, 2, c, r0 + tq * 8, lo, hi, vv);
#pragma unroll
      for (int i = 0; i < 8; ++i) t[cc * 65 + tq * 8 + i] = vv[i] * x1[i]; }
    __syncthreads();
    { const int cw = tid >> 3, t8 = tid & 7; f32x4 o0, o1;
#pragma unroll
      for (int i = 0; i < 4; ++i) { o0[i] = t[cw * 65 + t8 * 8 + i]; o1[i] = t[cw * 65 + t8 * 8 + 4 + i]; }
      float* dst = VXT + (size_t)(cb * 64 + cw) * MT + r0 + t8 * 8; *(f32x4*)dst = o0; *(f32x4*)(dst + 4) = o1; }
    __syncthreads();
}
DI void hycomb_item(const Args& a, int l, int it, LAS float* t) {
    const int tid = otid(), tb = it >> 4, cb = it & 15, r0 = tb * 64, lo = r0 < SEQ ? 0 : SEQ, hi = r0 < SEQ ? SEQ : MT;
    const bf16* Z = (const bf16*)(wsp(a) + WS_Z); const float* VXT = (const float*)(wsp(a) + WS_CVO); bf16* Y0 = (bf16*)(wsp(a) + WS_YMIX);
    { const int cw = tid >> 3, t8 = tid & 7; const float* srcp = VXT + (size_t)(cb * 64 + cw) * MT + r0 + t8 * 8; const f32x4 i0 = *(const f32x4*)srcp, i1 = *(const f32x4*)(srcp + 4);
#pragma unroll
      for (int i = 0; i < 4; ++i) { t[cw * 65 + t8 * 8 + i] = i0[i]; t[cw * 65 + t8 * 8 + 4 + i] = i1[i]; } }
    __syncthreads();
    { const int cc = tid & 63, tq = tid >> 6, c = cb * 64 + cc; float x0[8];
      shortconv8(Z, ain(a, I_HYCW), ain(a, I_HYCB), l, 0, c, r0 + tq * 8, lo, hi, x0);
#pragma unroll
      for (int i = 0; i < 8; ++i) Y0[(size_t)(r0 + tq * 8 + i) * 1024 + c] = f2bf(t[cc * 65 + tq * 8 + i] * x0[i]); }
    __syncthreads();
}
DI void scancomb_rows(const Args& a, int l, int nrows) {
    const int lane = otid() & 63, wave = otid() >> 6;
    const bf16* Z = (const bf16*)(wsp(a) + WS_Z); const float* O = (const float*)(wsp(a) + WS_OSC);
    bf16* Y1 = (bf16*)(wsp(a) + WS_YMIX) + (size_t)MT * 1024; bf16* Y2 = Y1 + (size_t)MT * 1024;
    for (int r = obid() * 8 + wave; r < nrows; r += ogdim() * 8) {
#pragma unroll
        for (int i = 0; i < 4; ++i) { const int col = i * 256 + lane * 4;
            { const f32x4 of = *(const f32x4*)(O + (size_t)r * 1024 + col), ob = *(const f32x4*)(O + ((size_t)MT + r) * 1024 + col); const f32x4 o = of + ob;
              float ss = (o[0] * o[0] + o[1] * o[1]) + (o[2] * o[2] + o[3] * o[3]);
              ss += __shfl_xor(ss, 16); ss += __shfl_xor(ss, 8); ss += __shfl_xor(ss, 4); ss += __shfl_xor(ss, 2); ss += __shfl_xor(ss, 1);
              const float rstd = rsqrtf(ss * (1.0f / 128.0f) + NORM_EPS);
              const f32x4 nw = *(const f32x4*)(ain(a, I_HGNW) + (size_t)l * 128 + (col & 127));
              const u32x2 g = *(const u32x2*)(Z + (size_t)r * ZC + Z_HG + 4096 + col);
              u32x2 w; w.x = pk_bf16(o[0] * rstd * nw[0] * sigmoidf_(bflo(g.x)), o[1] * rstd * nw[1] * sigmoidf_(bfhi(g.x)));
              w.y = pk_bf16(o[2] * rstd * nw[2] * sigmoidf_(bflo(g.y)), o[3] * rstd * nw[3] * sigmoidf_(bfhi(g.y)));
              *(u32x2*)(Y1 + (size_t)r * 1024 + col) = w; }
            { const f32x4 of = *(const f32x4*)(O + ((size_t)2 * MT + r) * 1024 + col), ob = *(const f32x4*)(O + ((size_t)3 * MT + r) * 1024 + col); const f32x4 o = of + ob;
              float ss = (o[0] * o[0] + o[1] * o[1]) + (o[2] * o[2] + o[3] * o[3]); ss = wave_sum(ss);
              const float rstd = rsqrtf(ss * (1.0f / 256.0f) + NORM_EPS);
              const f32x4 nw = *(const f32x4*)(ain(a, I_GLNW) + (size_t)l * 256 + (col & 255));
              const u32x2 g = *(const u32x2*)(Z + (size_t)r * ZC + Z_GL + 2048 + col);
              u32x2 w; w.x = pk_bf16(o[0] * rstd * nw[0] * siluf_(bflo(g.x)), o[1] * rstd * nw[1] * siluf_(bfhi(g.x)));
              w.y = pk_bf16(o[2] * rstd * nw[2] * siluf_(bflo(g.y)), o[3] * rstd * nw[3] * siluf_(bfhi(g.y)));
              *(u32x2*)(Y2 + (size_t)r * 1024 + col) = w; }
        }
    }
}
typedef short bf16x8_t __attribute__((ext_vector_type(8)));
constexpr int SC_N = 65;
constexpr size_t KVS_GL_OFF = (size_t)16 * SC_N * 16384;
constexpr size_t WS_KVS = WS_WGU;
constexpr size_t WS_KD  = WS_WGU + 130 * MiB;
constexpr int SL_QM = 0, SL_KM = 17408, SL_Q0 = 34816, SL_KE = 52224, SL_VT = 70656, SL_PP = 107520, SL_TOT = 116736, SL_DD = 118784, SL_AFB = 119296;
static_assert(SL_AFB + 2048 <= 131072 && WS_KD + (size_t)24 * SC_N * 128 * 4 <= WS_H, "scan maps");
DI bf16x8_t lds_frag16(LAS unsigned char* p) { return *(LAS bf16x8_t*)p; }
DI bf16x8_t pack_bf16x8(const f32x4& lo, const f32x4& hi) { u32x4 w; w.x = pk_bf16(lo[0], lo[1]); w.y = pk_bf16(lo[2], lo[3]); w.z = pk_bf16(hi[0], hi[1]); w.w = pk_bf16(hi[2], hi[3]); return __builtin_bit_cast(bf16x8_t, w); }

template <bool GLA, bool OUT> DI void scan_walk(const Args& a, int l, int head, int dir, int sc, int dvh, LAS unsigned char* lds) {
    constexpr int NB = 1, DV = GLA ? 256 : 128;
    const int tid = otid(), lane = tid & 63, wave = tid >> 6, fr = lane & 15, fq = lane >> 4, nbase = dvh * 8 + wave;
    const bf16* Z = (const bf16*)(wsp(a) + WS_Z);
    const int stream = GLA ? 16 + head * 2 + dir : head * 2 + dir;
    float* kvs = (float*)(wsp(a) + WS_KVS) + (GLA ? KVS_GL_OFF + ((size_t)(stream - 16) * SC_N + sc) * 32768 : ((size_t)stream * SC_N + sc) * 16384);
    float* kd = (float*)(wsp(a) + WS_KD) + ((size_t)stream * SC_N + sc) * 128;
    LAS bf16* QM = (LAS bf16*)(lds + SL_QM); LAS bf16* KM = (LAS bf16*)(lds + SL_KM); LAS bf16* Q0 = (LAS bf16*)(lds + SL_Q0);
    LAS bf16* KE = (LAS bf16*)(lds + SL_KE); LAS bf16* VT = (LAS bf16*)(lds + SL_VT); LAS bf16* PP = (LAS bf16*)(lds + SL_PP);
    LAS float* TOT = (LAS float*)(lds + SL_TOT); LAS float* DD = (LAS float*)(lds + SL_DD); LAS bf16* AFB = (LAS bf16*)(lds + SL_AFB);
    const int k = (wave & 1) * 64 + lane, seg = wave >> 1;
    float lbv = 0.f, ba = 0.f, wa[16];
    if (!GLA) lbv = ((const float*)(wsp(a) + WS_LB))[((size_t)l * 2 + dir) * 1024 + head * 128 + k];
    else { ba = ain(a, I_GLBA)[((size_t)l * 2 + dir) * 512 + head * 128 + k];
#pragma unroll
        for (int rr = 0; rr < 16; ++rr) wa[rr] = ain(a, I_GLWA2)[(((size_t)l * 2 + dir) * 16 + rr) * 512 + head * 128 + k]; }
    f32x4 S[NB][8];
#pragma unroll
    for (int nb = 0; nb < NB; ++nb)
#pragma unroll
        for (int mb = 0; mb < 8; ++mb) { if (OUT) S[nb][mb] = *(const f32x4*)(kvs + (size_t)((nbase + nb) * 16 + fr) * 128 + mb * 16 + fq * 4); else S[nb][mb] = (f32x4){0.f, 0.f, 0.f, 0.f}; }
    float dlog = 0.f;
    const int which = (GLA ? 2 : 0) + dir;
    float* Odir = (float*)(wsp(a) + WS_OSC) + (size_t)which * MT * 1024;
    const int srow = tid >> 3, spc = (tid & 7) * 16;
    const int vcol = (GLA ? Z_GL + 1024 + head * 256 + dvh * 128 : Z_HG + 3072 + head * 128) + wave * 16;
    const int fcol = (GLA ? Z_GL + 512 + head * 128 : Z_HG + 1024 * (1 + dir) + head * 128) + spc, qcol = (GLA ? Z_GL + head * 128 : Z_HG + head * 128) + spc;
    u32x4 pv0, pv1, pf0, pf1, pq0 = {0u, 0u, 0u, 0u}, pq1 = {0u, 0u, 0u, 0u}, pa = {0u, 0u, 0u, 0u};
#define SCAN_ISSUE(cidx) do { const int r0n_ = dir ? stream_row((cidx) * 64 + 63, 1) : stream_row((cidx) * 64, 0); \
        const bf16* vr_ = Z + (size_t)(r0n_ + lane) * ZC + vcol; pv0 = *(const u32x4*)vr_; pv1 = *(const u32x4*)(vr_ + 8); \
        const bf16* zr_ = Z + (size_t)(r0n_ + srow) * ZC; pf0 = *(const u32x4*)(zr_ + fcol); pf1 = *(const u32x4*)(zr_ + fcol + 8); \
        if (OUT) { pq0 = *(const u32x4*)(zr_ + qcol); pq1 = *(const u32x4*)(zr_ + qcol + 8); } \
        if (GLA && tid < 128) pa = *(const u32x4*)(Z + (size_t)(r0n_ + (tid >> 1)) * ZC + Z_LR + dir * 16 + (tid & 1) * 8); } while (0)
    SCAN_ISSUE(sc * 4);
    for (int cc = 0; cc < 4; ++cc) {
        const int c = sc * 4 + cc; const int r0 = dir ? stream_row(c * 64 + 63, 1) : stream_row(c * 64, 0);
        {
#pragma unroll
          for (int q8 = 0; q8 < 2; ++q8) { const u32x4 v = q8 ? pv1 : pv0; const int d0 = wave * 16 + q8 * 8;
              VT[(d0 + 0) * 72 + lane] = (bf16)(v.x & 0xffff); VT[(d0 + 1) * 72 + lane] = (bf16)(v.x >> 16); VT[(d0 + 2) * 72 + lane] = (bf16)(v.y & 0xffff); VT[(d0 + 3) * 72 + lane] = (bf16)(v.y >> 16);
              VT[(d0 + 4) * 72 + lane] = (bf16)(v.z & 0xffff); VT[(d0 + 5) * 72 + lane] = (bf16)(v.z >> 16); VT[(d0 + 6) * 72 + lane] = (bf16)(v.w & 0xffff); VT[(d0 + 7) * 72 + lane] = (bf16)(v.w >> 16); }
          *(LAS u32x4*)(KM + srow * 136 + spc) = pf0; *(LAS u32x4*)(KM + srow * 136 + spc + 8) = pf1;
          if (OUT) { *(LAS u32x4*)(QM + srow * 136 + spc) = pq0; *(LAS u32x4*)(QM + srow * 136 + spc + 8) = pq1; }
          if (GLA && tid < 128) *(LAS u32x4*)(AFB + (tid >> 1) * 16 + (tid & 1) * 8) = pa;
          if (cc < 3) SCAN_ISSUE(c + 1); }
        __syncthreads();
        const int tstart = dir ? 63 - seg * 16 : seg * 16, tstep = dir ? -1 : 1;
        float cs[16]; float run = 0.f;
#pragma unroll
        for (int i = 0; i < 16; ++i) { const int t = tstart + i * tstep; float la;
            if (!GLA) { const float zf = bf2f(KM[t * 136 + k]); la = __logf(lbv + (1.0f - lbv) * sigmoidf_(zf)); }
            else { float x = ba; const u32x4 a0 = *(LAS u32x4*)(AFB + t * 16), a1 = *(LAS u32x4*)(AFB + t * 16 + 8);
                x += bflo(a0.x) * wa[0] + bfhi(a0.x) * wa[1] + bflo(a0.y) * wa[2] + bfhi(a0.y) * wa[3] + bflo(a0.z) * wa[4] + bfhi(a0.z) * wa[5] + bflo(a0.w) * wa[6] + bfhi(a0.w) * wa[7];
                x += bflo(a1.x) * wa[8] + bfhi(a1.x) * wa[9] + bflo(a1.y) * wa[10] + bfhi(a1.y) * wa[11] + bflo(a1.z) * wa[12] + bfhi(a1.z) * wa[13] + bflo(a1.w) * wa[14] + bfhi(a1.w) * wa[15];
                la = (fminf(x, 0.f) - log1pf(__expf(-fabsf(x)))) * 0.0625f; }
            run += la; cs[i] = run; if (GLA || (i & 3) == 3) asm volatile("" ::: "memory"); }
        TOT[seg * 128 + k] = run;
        __syncthreads();
        { const float t0 = TOT[k], t1 = TOT[128 + k], t2 = TOT[256 + k], t3 = TOT[384 + k];
          const float off = seg == 0 ? 0.f : (seg == 1 ? t0 : (seg == 2 ? t0 + t1 : t0 + t1 + t2)), blast = (t0 + t1) + (t2 + t3), bref = t0 + t1;
          float ke[16];
#pragma unroll
          for (int i = 0; i < 16; ++i) { const int t = tstart + i * tstep; const float b = off + cs[i]; const float raw = bf2f(KM[t * 136 + k]);
              const float kk = GLA ? raw : (1.0f - lbv) * sigmoidf_(-raw);
              if (OUT) { const float qr = bf2f(QM[t * 136 + k]); const float qv = GLA ? qr * 0.08838834764831845f : siluf_(qr);
                  QM[t * 136 + k] = f2bf(qv * __expf(b - bref)); KM[t * 136 + k] = f2bf(kk * __expf(bref - b)); Q0[t * 136 + k] = f2bf(qv * __expf(b)); }
              ke[i] = kk * __expf(blast - b); if ((i & 3) == 3) asm volatile("" ::: "memory"); }
          const int tb0 = dir ? 48 - seg * 16 : seg * 16; u32x4 w0, w1;
          if (dir) { w0.x = pk_bf16(ke[15], ke[14]); w0.y = pk_bf16(ke[13], ke[12]); w0.z = pk_bf16(ke[11], ke[10]); w0.w = pk_bf16(ke[9], ke[8]); w1.x = pk_bf16(ke[7], ke[6]); w1.y = pk_bf16(ke[5], ke[4]); w1.z = pk_bf16(ke[3], ke[2]); w1.w = pk_bf16(ke[1], ke[0]); }
          else     { w0.x = pk_bf16(ke[0], ke[1]); w0.y = pk_bf16(ke[2], ke[3]); w0.z = pk_bf16(ke[4], ke[5]); w0.w = pk_bf16(ke[6], ke[7]); w1.x = pk_bf16(ke[8], ke[9]); w1.y = pk_bf16(ke[10], ke[11]); w1.z = pk_bf16(ke[12], ke[13]); w1.w = pk_bf16(ke[14], ke[15]); }
          *(LAS u32x4*)(KE + k * 72 + tb0) = w0; *(LAS u32x4*)(KE + k * 72 + tb0 + 8) = w1;
          if (seg == 0) DD[k] = __expf(blast);
          dlog += blast; }
        __syncthreads();
        bf16x8_t Bv[NB][2];
#pragma unroll
        for (int nb = 0; nb < NB; ++nb)
#pragma unroll
            for (int ks = 0; ks < 2; ++ks) Bv[nb][ks] = lds_frag16(lds + SL_VT + ((wave * 16 + fr) * 72 + ks * 32 + fq * 8) * 2);
        if (OUT) {
            { const int tb = wave >> 1;
#pragma unroll
              for (int sbi = 0; sbi < 2; ++sbi) { const int sb = (wave & 1) * 2 + sbi; f32x4 acc = {0.f, 0.f, 0.f, 0.f};
#pragma unroll
                  for (int ks = 0; ks < 4; ++ks) acc = __builtin_amdgcn_mfma_f32_16x16x32_bf16(lds_frag16(lds + SL_QM + ((tb * 16 + fr) * 136 + ks * 32 + fq * 8) * 2), lds_frag16(lds + SL_KM + ((sb * 16 + fr) * 136 + ks * 32 + fq * 8) * 2), acc, 0, 0, 0);
#pragma unroll
                  for (int j = 0; j < 4; ++j) { const int t = tb * 16 + fq * 4 + j, s = sb * 16 + fr; const bool keep = dir ? (s >= t) : (s <= t); PP[t * 72 + s] = keep ? f2bf(acc[j]) : (bf16)0; } } }
            __syncthreads();
#pragma unroll
            for (int nb = 0; nb < NB; ++nb) {
                bf16x8_t Bs[4];
#pragma unroll
                for (int ks = 0; ks < 4; ++ks) Bs[ks] = pack_bf16x8(S[nb][2 * ks], S[nb][2 * ks + 1]);
#pragma unroll
                for (int mb = 0; mb < 4; ++mb) {
                    f32x4 O = {0.f, 0.f, 0.f, 0.f};
#pragma unroll
                    for (int ks = 0; ks < 2; ++ks) O = __builtin_amdgcn_mfma_f32_16x16x32_bf16(lds_frag16(lds + SL_PP + ((mb * 16 + fr) * 72 + ks * 32 + fq * 8) * 2), Bv[nb][ks], O, 0, 0, 0);
#pragma unroll
                    for (int ks = 0; ks < 4; ++ks) { u32x4 aw; const u32x2 lo = *(LAS u32x2*)(lds + SL_Q0 + ((mb * 16 + fr) * 136 + (2 * ks) * 16 + fq * 4) * 2), hi = *(LAS u32x2*)(lds + SL_Q0 + ((mb * 16 + fr) * 136 + (2 * ks + 1) * 16 + fq * 4) * 2);
                        aw.x = lo.x; aw.y = lo.y; aw.z = hi.x; aw.w = hi.y;
                        O = __builtin_amdgcn_mfma_f32_16x16x32_bf16(__builtin_bit_cast(bf16x8_t, aw), Bs[ks], O, 0, 0, 0); }
#pragma unroll
                    for (int j = 0; j < 4; ++j) Odir[(size_t)(r0 + mb * 16 + fq * 4 + j) * 1024 + head * DV + (nbase + nb) * 16 + fr] = O[j];
                    asm volatile("" ::: "memory");
                }
            }
        }
        if (!OUT || cc < 3) {
#pragma unroll
            for (int mb = 0; mb < 8; ++mb) { const f32x4 dd = *(LAS f32x4*)(DD + mb * 16 + fq * 4);
                const bf16x8_t A0 = lds_frag16(lds + SL_KE + ((mb * 16 + fr) * 72 + fq * 8) * 2), A1 = lds_frag16(lds + SL_KE + ((mb * 16 + fr) * 72 + 32 + fq * 8) * 2);
#pragma unroll
                for (int nb = 0; nb < NB; ++nb) { S[nb][mb] = S[nb][mb] * dd; S[nb][mb] = __builtin_amdgcn_mfma_f32_16x16x32_bf16(A0, Bv[nb][0], S[nb][mb], 0, 0, 0); S[nb][mb] = __builtin_amdgcn_mfma_f32_16x16x32_bf16(A1, Bv[nb][1], S[nb][mb], 0, 0, 0); }
                asm volatile("" ::: "memory"); }
        }
        __syncthreads();
    }
    if (!OUT) {
#pragma unroll
        for (int nb = 0; nb < NB; ++nb)
#pragma unroll
            for (int mb = 0; mb < 8; ++mb) *(f32x4*)(kvs + (size_t)((nbase + nb) * 16 + fr) * 128 + mb * 16 + fq * 4) = S[nb][mb];
        if (seg == 0) kd[k] = __expf(dlog);
    }
}
#undef SCAN_ISSUE
DI void scan_prop(const Args& a) {
    float* kvs = (float*)(wsp(a) + WS_KVS); const float* kd = (const float*)(wsp(a) + WS_KD);
    for (int g = obid() * NTHR + otid(); g < 131072; g += ogdim() * NTHR) {
        float* p; size_t stride; const float* dp;
        if (g < 65536) { const int stream = g >> 12, e = g & 4095; p = kvs + (size_t)stream * SC_N * 16384 + (size_t)e * 4; stride = 16384; dp = kd + (size_t)stream * SC_N * 128 + (e & 31) * 4; }
        else { const int q = g - 65536, stream = q >> 13, e = q & 8191; p = kvs + KVS_GL_OFF + (size_t)stream * SC_N * 32768 + (size_t)e * 4; stride = 32768; dp = kd + (size_t)(16 + stream) * SC_N * 128 + (e & 31) * 4; }
        f32x4 S = {0.f, 0.f, 0.f, 0.f};
#pragma unroll 5
        for (int sc = 0; sc < SC_N; ++sc) { const f32x4 kv = *(const f32x4*)(p + sc * stride), d = *(const f32x4*)(dp + sc * 128); *(f32x4*)(p + sc * stride) = S; S = d * S + kv; }
    }
}
constexpr int SCAN_ITEMS = 32 * SC_N;
template <bool OUT> DI void scan_item2(const Args& a, int l, int it, LAS unsigned char* lds) {
    if (it < 16 * SC_N) { const int s = it / SC_N, sc = it % SC_N; if (OUT && l == DEPTH - 1 && sc == 0) return; scan_walk<true, OUT>(a, l, s >> 2, (s >> 1) & 1, sc, s & 1, lds); }
    else { const int j = it - 16 * SC_N, s = j / SC_N, sc = j % SC_N; if (OUT && l == DEPTH - 1 && sc == 0) return; scan_walk<false, OUT>(a, l, s >> 1, s & 1, sc, 0, lds); }
}
DI void hyconv_item(const Args& a, int l, int c, LAS unsigned char* ldsb) {
    const int tid = otid();
    LAS float* lds = (LAS float*)ldsb;
    LAS float* xs = (LAS float*)(ldsb + LDS_X);
    const float* tw = (const float*)(wsp(a) + WS_TW); const float* tw2 = (const float*)(wsp(a) + WS_TW2);
    const float* h2 = (const float*)(wsp(a) + WS_H2) + (size_t)l * MT * 64;
    const float* VX = (const float*)(wsp(a) + WS_U) + (size_t)c * MT; float* VO = (float*)(wsp(a) + WS_CVO) + (size_t)c * MT;
    const float* HFf = (const float*)(wsp(a) + WS_HF) + (size_t)c * SEQ; const float* HFb = HFf + (size_t)1024 * SEQ;
    const float a0 = -4.605170186f / 1.5f, a1 = -4.605170186f / 0.3f;
    const float nd = -fabsf(a0 + (float)c * ((a1 - a0) / 1023.0f)) * (1.0f / (float)(SEQ - 1));
    const float b3f = ain(a, I_HYB3)[l * 2048 + c], b3b = ain(a, I_HYB3)[l * 2048 + 1024 + c];
    float sf = 0.f, sb = 0.f;
    for (int i = 0; i < 8; ++i) { const int t4 = (tid + 512 * i) * 4; f32x4 hf = *(const f32x4*)(HFf + t4), hb = *(const f32x4*)(HFb + t4);
#pragma unroll
        for (int q = 0; q < 4; ++q) { const float dec = __expf(nd * (float)(t4 + q)) + 0.05f; hf[q] = (hf[q] + b3f) * dec; hb[q] = (hb[q] + b3b) * dec; }
        sf += (fabsf(hf[0]) + fabsf(hf[1])) + (fabsf(hf[2]) + fabsf(hf[3])); sb += (fabsf(hb[0]) + fabsf(hb[1])) + (fabsf(hb[2]) + fabsf(hb[3]));
        *(LAS f32x4*)(lds + t4) = hf;
#pragma unroll
        for (int q = 0; q < 4; ++q) { const int t = t4 + q; if (t > 0) lds[32768 - t] = hb[q]; else xs[160] = hb[q]; } }
    sf = wave_sum(sf); sb = wave_sum(sb);
    if ((tid & 63) == 0) { xs[128 + (tid >> 6)] = sf; xs[136 + (tid >> 6)] = sb; }
    __syncthreads();
    float tf = 0.f, tb = 0.f;
#pragma unroll
    for (int w = 0; w < 8; ++w) { tf += xs[128 + w]; tb += xs[136 + w]; }
    const float inf_ = 1.0f / tf, inb_ = 1.0f / tb;
    for (int i = 0; i < 64; ++i) { const int m = tid + 512 * i; float v = lds[m];
        if (m == 0) v = v * inf_ + xs[160] * inb_ + ain(a, I_HYSKIP)[l * 1024 + c];
        else if (m < SEQ) v *= inf_; else if (m == SEQ) v = 0.f; else v *= inb_;
        lds[m] = v; }
    __syncthreads();
    fft_fwd_pass<4096>(lds, tw, tid); __syncthreads(); fft_fwd_pass<1024>(lds, tw, tid); __syncthreads(); fft_fwd_pass<256>(lds, tw, tid); __syncthreads(); fft_fwd_pass<64>(lds, tw, tid); __syncthreads();
    fft_fwd_pass<16>(lds, tw, tid); __syncthreads(); fft_fwd_pass<4>(lds, tw, tid); __syncthreads(); fft_fwd_pass<1>(lds, tw, tid); __syncthreads();
    float* Gs = (float*)(wsp(a) + WS_YMIX) + (size_t)obid() * 32768;
#pragma unroll 1
    for (int j = 0; j < 16; ++j) { const int k = tid + 512 * j; cpx gk, gm; rfft_untangle(lds, tw2, k, gk, gm); f32x4 g4; g4[0] = gk.x; g4[1] = gk.y; g4[2] = gm.x; g4[3] = gm.y; *(f32x4*)(Gs + (size_t)k * 4) = g4; }
    __syncthreads();
    for (int i = 0; i < 16; ++i) { const int m4 = tid + 512 * i; f32x4 v = {0.f, 0.f, 0.f, 0.f}; if (m4 < SEQ / 4) v = *(const f32x4*)(VX + m4 * 4); *(LAS f32x4*)(lds + m4 * 4) = v; }
    __syncthreads();
    fft_fwd_pass<4096>(lds, tw, tid); __syncthreads(); fft_fwd_pass<1024>(lds, tw, tid); __syncthreads(); fft_fwd_pass<256>(lds, tw, tid); __syncthreads(); fft_fwd_pass<64>(lds, tw, tid); __syncthreads();
    fft_fwd_pass<16>(lds, tw, tid); __syncthreads(); fft_fwd_pass<4>(lds, tw, tid); __syncthreads(); fft_fwd_pass<1>(lds, tw, tid); __syncthreads();
#pragma unroll 1
    for (int j = 0; j < 16; ++j) { const int k = tid + 512 * j; const f32x4 g4 = *(const f32x4*)(Gs + (size_t)k * 4); cpx gk, gm; gk.x = g4[0]; gk.y = g4[1]; gm.x = g4[2]; gm.y = g4[3]; rfft_mul_retangle(lds, tw2, k, gk, gm); }
    __syncthreads();
    fft_inv_pass<1>(lds, tw, tid); __syncthreads(); fft_inv_pass<4>(lds, tw, tid); __syncthreads(); fft_inv_pass<16>(lds, tw, tid); __syncthreads(); fft_inv_pass<64>(lds, tw, tid); __syncthreads();
    fft_inv_pass<256>(lds, tw, tid); __syncthreads(); fft_inv_pass<1024>(lds, tw, tid); __syncthreads(); fft_inv_pass<4096>(lds, tw, tid); __syncthreads();
    for (int i = 0; i < 8; ++i) { const int m4 = tid + 512 * i; f32x4 v = *(const LAS f32x4*)(lds + m4 * 4); *(f32x4*)(VO + m4 * 4) = v * (1.0f / FFT_M); }
    __syncthreads();
}
DI void hycctx_item(const Args& a, int l, int it, LAS unsigned char* ldsb) {
    const int tid = otid(), c0 = it * 16;
    LAS float* sv = (LAS float*)ldsb;
    LAS float* sf = sv + 16 * 256;
    LAS float* sb = sf + 16 * 256;
    const float* hyc = (const float*)(wsp(a) + WS_HYC); const float* VXT = (const float*)(wsp(a) + WS_U); float* CVO = (float*)(wsp(a) + WS_CVO);
    for (int i = tid; i < 16 * 256; i += NTHR) { const int ch = i >> 8, t = i & 255; sv[i] = VXT[(size_t)(c0 + ch) * MT + SEQ + t]; sf[i] = hyc[(size_t)(c0 + ch) * 256 + t]; sb[i] = hyc[(size_t)(1024 + c0 + ch) * 256 + t]; }
    __syncthreads();
    const int ch = tid >> 5, tq = tid & 31; const float g0 = sf[ch * 256] + sb[ch * 256] + ain(a, I_HYSKIP)[l * 1024 + c0 + ch];
    float acc[8];
#pragma unroll
    for (int i = 0; i < 8; ++i) acc[i] = 0.f;
    for (int s = 0; s < 256; ++s) { const float vv = sv[ch * 256 + s];
#pragma unroll
        for (int i = 0; i < 8; ++i) { const int d = tq * 8 + i - s; const float g = d > 0 ? sf[ch * 256 + d] : (d < 0 ? sb[ch * 256 - d] : g0); acc[i] += g * vv; } }
    __syncthreads();
#pragma unroll
    for (int i = 0; i < 8; ++i) CVO[(size_t)(c0 + ch) * MT + SEQ + tq * 8 + i] = acc[i];
    __syncthreads();
}

struct EpiHF {
    static constexpr bool PERM = false, AFTER_DRAIN = false; float* O;
    DI void operator()(const f32x4 (&acc)[2][2][4][2], const pg8::Unit& u, int wr, int wc, int fr, int fq) const {
        const int row0 = u.pm * 256 + wr * 64 + fr, col0 = u.pn * 256 + wc * 32 + 4 * fq;
#pragma unroll
        for (int ai = 0; ai < 2; ++ai)
#pragma unroll
            for (int m = 0; m < 4; ++m) { float* rowp = O + (size_t)(row0 + ai * 128 + m * 16) * SEQ + col0;
#pragma unroll
                for (int bj = 0; bj < 2; ++bj)
#pragma unroll
                    for (int n = 0; n < 2; ++n) *(f32x4*)(rowp + bj * 128 + n * 16) = acc[ai][bj][m][n]; }
    }
};
struct EpiZ {
    static constexpr bool PERM = true, AFTER_DRAIN = false; bf16* O; const float* bias;
    DI void operator()(const f32x4 (&acc)[2][2][4][2], const pg8::Unit& u, int wr, int wc, int fr, int fq) const {
        const int row0 = u.pm * 256 + wr * 64 + fr, col0 = u.pn * 256 + wc * 32 + 8 * fq;
        f32x4 bv[2][2];
#pragma unroll
        for (int bj = 0; bj < 2; ++bj)
#pragma unroll
            for (int n = 0; n < 2; ++n) bv[bj][n] = *(const f32x4*)(bias + col0 + bj * 128 + 4 * n);
#pragma unroll
        for (int ai = 0; ai < 2; ++ai)
#pragma unroll
            for (int m = 0; m < 4; ++m) { bf16* rowp = O + (size_t)(row0 + ai * 128 + m * 16) * ZC + col0;
#pragma unroll
                for (int bj = 0; bj < 2; ++bj) { const f32x4 v0 = acc[ai][bj][m][0] + bv[bj][0], v1 = acc[ai][bj][m][1] + bv[bj][1];
                    u32x4 w; w.x = pk_bf16(v0[0], v0[1]); w.y = pk_bf16(v0[2], v0[3]); w.z = pk_bf16(v1[0], v1[1]); w.w = pk_bf16(v1[2], v1[3]);
                    *(u32x4*)(rowp + bj * 128) = w; } }
    }
};
template <int BR> struct EpiBr {
    static constexpr bool PERM = true, AFTER_DRAIN = false; bf16* Mg; const bf16* Zg;
    DI void operator()(const f32x4 (&acc)[2][2][4][2], const pg8::Unit& u, int wr, int wc, int fr, int fq) const {
        const int row0 = u.pm * 256 + wr * 64 + fr, col0 = u.pn * 256 + wc * 32 + 8 * fq;
#pragma unroll
        for (int ai = 0; ai < 2; ++ai)
#pragma unroll
            for (int m = 0; m < 4; ++m) { const size_t row = (size_t)(row0 + ai * 128 + m * 16);
#pragma unroll
                for (int bj = 0; bj < 2; ++bj) { const int col = col0 + bj * 128;
                    const u32x4 g = *(const u32x4*)(Zg + row * ZC + col);
                    f32x4 v0 = acc[ai][bj][m][0], v1 = acc[ai][bj][m][1];
                    v0[0] *= sigmoidf_(bflo(g.x)); v0[1] *= sigmoidf_(bfhi(g.x)); v0[2] *= sigmoidf_(bflo(g.y)); v0[3] *= sigmoidf_(bfhi(g.y));
                    v1[0] *= sigmoidf_(bflo(g.z)); v1[1] *= sigmoidf_(bfhi(g.z)); v1[2] *= sigmoidf_(bflo(g.w)); v1[3] *= sigmoidf_(bfhi(g.w));
                    if (BR > 0) { const u32x4 p = *(const u32x4*)(Mg + row * D + col);
                        v0[0] += bflo(p.x); v0[1] += bfhi(p.x); v0[2] += bflo(p.y); v0[3] += bfhi(p.y); v1[0] += bflo(p.z); v1[1] += bfhi(p.z); v1[2] += bflo(p.w); v1[3] += bfhi(p.w); }
                    u32x4 w; w.x = pk_bf16(v0[0], v0[1]); w.y = pk_bf16(v0[2], v0[3]); w.z = pk_bf16(v1[0], v1[1]); w.w = pk_bf16(v1[2], v1[3]);
                    *(u32x4*)(Mg + row * D + col) = w; } }
    }
};
struct EpiOut {
    static constexpr bool PERM = false, AFTER_DRAIN = false; const float* hin_main; const float* hin_ctx; float* hout; const float* gt1;
    DI void operator()(const f32x4 (&acc)[2][2][4][2], const pg8::Unit& u, int wr, int wc, int fr, int fq) const {
        const int row0 = u.pm * 256 + wr * 64 + fr, col0 = u.pn * 256 + wc * 32 + 4 * fq; const bool isctx = u.pm >= SEQ / 256;
        const float* g = gt1 + (isctx ? 12288 : 0);
        f32x4 gv[2][2];
#pragma unroll
        for (int bj = 0; bj < 2; ++bj)
#pragma unroll
            for (int n = 0; n < 2; ++n) gv[bj][n] = *(const f32x4*)(g + col0 + bj * 128 + n * 16);
#pragma unroll
        for (int ai = 0; ai < 2; ++ai)
#pragma unroll
            for (int m = 0; m < 4; ++m) { const int row = row0 + ai * 128 + m * 16;
                const float* ip = (isctx ? hin_ctx + (size_t)(row - SEQ) * D : hin_main + (size_t)row * D) + col0; float* op = hout + (size_t)row * D + col0;
#pragma unroll
                for (int bj = 0; bj < 2; ++bj)
#pragma unroll
                    for (int n = 0; n < 2; ++n) { const f32x4 b = *(const f32x4*)(ip + bj * 128 + n * 16); *(f32x4*)(op + bj * 128 + n * 16) = b + gv[bj][n] * acc[ai][bj][m][n]; } }
    }
};
struct EpiGU {
    static constexpr bool PERM = true, AFTER_DRAIN = false; bf16* Hm;
    DI void operator()(const f32x4 (&acc)[2][2][4][2], const pg8::Unit& u, int wr, int wc, int fr, int fq) const {
        const int row0 = u.pm * 256 + wr * 64 + fr, col0 = (u.pn & 3) * 128 + wc * 32 + 8 * fq;
#pragma unroll
        for (int ai = 0; ai < 2; ++ai)
#pragma unroll
            for (int m = 0; m < 4; ++m) { const f32x4 g0 = acc[ai][0][m][0], g1 = acc[ai][0][m][1], u0 = acc[ai][1][m][0], u1 = acc[ai][1][m][1];
                u32x4 w; w.x = pk_bf16(siluf_(g0[0]) * u0[0], siluf_(g0[1]) * u0[1]); w.y = pk_bf16(siluf_(g0[2]) * u0[2], siluf_(g0[3]) * u0[3]);
                w.z = pk_bf16(siluf_(g1[0]) * u1[0], siluf_(g1[1]) * u1[1]); w.w = pk_bf16(siluf_(g1[2]) * u1[2], siluf_(g1[3]) * u1[3]);
                *(u32x4*)(Hm + (size_t)(row0 + ai * 128 + m * 16) * DFF + col0) = w; }
    }
};
struct EpiDn {
    static constexpr bool PERM = true, AFTER_DRAIN = false; bf16* Y; const float* roww;
    DI void operator()(const f32x4 (&acc)[2][2][4][2], const pg8::Unit& u, int wr, int wc, int fr, int fq) const {
        const int row0 = u.pm * 256 + wr * 64 + fr, col0 = (u.pn & 7) * 256 + wc * 32 + 8 * fq;
#pragma unroll
        for (int ai = 0; ai < 2; ++ai)
#pragma unroll
            for (int m = 0; m < 4; ++m) { const int row = row0 + ai * 128 + m * 16; const float rw = roww[row];
#pragma unroll
                for (int bj = 0; bj < 2; ++bj) { const f32x4 v0 = acc[ai][bj][m][0] * rw, v1 = acc[ai][bj][m][1] * rw;
                    u32x4 w; w.x = pk_bf16(v0[0], v0[1]); w.y = pk_bf16(v0[2], v0[3]); w.z = pk_bf16(v1[0], v1[1]); w.w = pk_bf16(v1[2], v1[3]);
                    *(u32x4*)(Y + (size_t)row * D + col0 + bj * 128) = w; } }
    }
};
struct MoeOrder {
    const int* tile_e; int ntiles, nsub, G, c;
    DI bool next(int i, pg8::Unit& u) const { const int j = i * G + c; if (j >= ntiles * nsub) return false; const int ti = j / nsub; u.pm = ti; u.pn = tile_e[ti] * nsub + (j - ti * nsub); return true; }
    DI void a_ready(const pg8::Unit&) const {}
    DI void done(const pg8::Unit&) const {}
};
constexpr int NPH_LAYER = 13, PH_FINAL = 1 + NPH_LAYER * DEPTH, NPHASES = PH_FINAL + 1;
struct KArgs { Args a; int li, pad; };
__global__ void __launch_bounds__(NTHR, 2) fwd_kernel(KArgs ka) {
    const Args& a = ka.a;
    const int tid = otid();
#define bid ((int)obid())
#define G ((int)ogdim())
    if (tid == 0) { ((LAS unsigned*)(ldsbase() + LDS_BARW))[0] = 0u; ((LAS unsigned*)(ldsbase() + LDS_BARW))[1] = 0u;
        LAS unsigned long long* ptab = (LAS unsigned long long*)(ldsbase() + LDS_PTAB);
#pragma unroll
        for (int i = 0; i < N_IN; ++i) ptab[i] = (unsigned long long)ka.a.in[i]; }
    __syncthreads();
    XcdBarrier bar = xcd_barrier_post((unsigned*)(wsp(a) + WS_CTL) + CW_BAR + ka.li * XCD_BAR_WORDS, (volatile LAS unsigned*)(ldsbase() + LDS_BARW));
    const int lo = a.ph_lo, hi = a.ph_hi;
#ifndef PHMASK
#define PHMASK 0xFFFF
#endif
#define EN(i) (((PHMASK) >> (i)) & 1)
#ifndef REPMASK
#define REPMASK 0
#endif
#define REP(i) (((REPMASK) >> (i)) & 1)
#define RUN(i, cond, ...) do { __VA_ARGS__; if (REP(i) && (cond)) { __syncthreads(); __VA_ARGS__; } } while (0)
#define IN(k) (opq(lo) <= (k) && (k) < opq(hi))
#define SEAM(k) do { if (IN(k) && IN((k) + 1)) xcd_barrier(bar); } while (0)
#define ws wsp(a)
#define lds ldsbase()
#define ldsf ((LAS float*)ldsbase())
#define U ((bf16*)(wsp(a) + WS_U))
#define Z ((bf16*)(wsp(a) + WS_Z))
#define H ((float*)(wsp(a) + WS_H))
#define modall ((const float*)(wsp(a) + WS_MOD))

    if (EN(0) && IN(0)) {
        RUN(0, true, prologue_small(a);
        for (int it = bid; it < 256; it += G) mod_item(a, it, ldsf);
        for (int it = bid; it < DEPTH * (MT / 8); it += G) h2_item(a, it, ldsf));
    }
    SEAM(0);
    for (int l = 0; l < DEPTH; ++l) {
        const int pb = 1 + NPH_LAYER * l;
        const int nrows = (l == 0) ? MT : SEQ;
        if (EN(1) && IN(pb + 0)) {
            RUN(1, l == 0, norm_phase<0>(a, l, MT, ldsf));
            RUN(16, true, if (l == 0) hyc_filters(a, 0));
            RUN(2, true, for (int it = bid; it < CVT_MIX_TILES; it += G) cvt_mix_item(a, l, it, ldsf));
        }
        SEAM(pb + 0);
        if (EN(2) && IN(pb + 1)) {
            pg8::Gemm g{U, (const bf16*)(ws + WS_WIN), MT, ZC, D}; pg8::StaticOrder S; S.init(MT, ZC, G, bid);
            EpiZ E{Z, (const float*)(ws + WS_ZBIAS) + (size_t)l * ZC};
            RUN(3, true, pg8::gemm_phase<EpiZ, pg8::StaticOrder, true, true>(lds, g, S, E));
        }
        SEAM(pb + 1);
        if (EN(3) && IN(pb + 2)) { const int nit = (nrows / 64) * 16; RUN(4, true, for (int it = bid; it < nit; it += G) hyprep_item(a, l, it, ldsf));
            __syncthreads();
            pg8::Gemm g{(const bf16*)(ws + WS_W3T) + (size_t)l * 2048 * 256, (const bf16*)(ws + WS_H2B) + (size_t)l * SEQ * 256, 2048, SEQ, 256}; pg8::StaticOrder S; S.init(2048, SEQ, G, bid);
            EpiHF E{(float*)(ws + WS_HF)};
            RUN(18, true, pg8::gemm_phase<EpiHF, pg8::StaticOrder, true, true>(lds, g, S, E)); }
        SEAM(pb + 2);
        if (EN(4) && IN(pb + 3)) {
            RUN(5, true, for (int it = bid; it < SCAN_ITEMS; it += G) scan_item2<false>(a, l, it, lds));
            RUN(6, true, for (int c = bid; c < 1024; c += G) hyconv_item(a, l, c, lds));
            RUN(15, true, if (l == 0) for (int it = bid; it < 64; it += G) hycctx_item(a, l, it, lds));
        }
        SEAM(pb + 3);
        if (EN(13) && IN(pb + 4)) { scan_prop(a); if (REP(20)) { __syncthreads(); scan_prop(a); scan_prop(a); } }
        SEAM(pb + 4);
        if (EN(14) && IN(pb + 5)) { RUN(17, true, for (int it = bid; it < SCAN_ITEMS; it += G) scan_item2<true>(a, l, it, lds)); }
        SEAM(pb + 5);
        if (EN(5) && IN(pb + 6)) {
            const int nit = (nrows / 64) * 16;
            RUN(7, true, scancomb_rows(a, l, nrows); for (int it = bid; it < nit; it += G) hycomb_item(a, l, it, ldsf));
        }
        SEAM(pb + 6);
        if (EN(6) && IN(pb + 7)) {
            const bf16* Y = (const bf16*)(ws + WS_YMIX); const bf16* WB = (const bf16*)(ws + WS_WBR);
            pg8::StaticOrder S; S.init(nrows, D, G, bid);
            RUN(8, true,
            { pg8::Gemm g{Y, WB, nrows, D, 1024}; EpiBr<0> E{U, Z + Z_MG}; pg8::gemm_phase<EpiBr<0>, pg8::StaticOrder, true, true>(lds, g, S, E); }
            __syncthreads();
            { pg8::Gemm g{Y + (size_t)MT * 1024, WB + (size_t)D * 1024, nrows, D, 1024}; EpiBr<1> E{U, Z + Z_MG + D}; pg8::gemm_phase<EpiBr<1>, pg8::StaticOrder, true, true>(lds, g, S, E); }
            __syncthreads();
            { pg8::Gemm g{Y + (size_t)2 * MT * 1024, WB + (size_t)2 * D * 1024, nrows, D, 1024}; EpiBr<2> E{U, Z + Z_MG + 2 * D}; pg8::gemm_phase<EpiBr<2>, pg8::StaticOrder, true, true>(lds, g, S, E); });
        }
        SEAM(pb + 7);
        if (EN(7) && IN(pb + 8)) {
            pg8::Gemm g{U, (const bf16*)(ws + WS_WOUT), nrows, D, D}; pg8::StaticOrder S; S.init(nrows, D, G, bid);
            EpiOut E{l == 0 ? ain(a, I_X) : H, l == 0 ? ain(a, I_CTX) : H + (size_t)SEQ * D, H, modall + (size_t)l * 2 * 12288 + 4096};
            RUN(9, l == 0, pg8::gemm_phase<EpiOut, pg8::StaticOrder, true, true>(lds, g, S, E));
        }
        SEAM(pb + 8);
        if (EN(8) && IN(pb + 9)) {
            route_phase<false>(a, l, nrows, ldsf);
            __syncthreads();
            if (REP(19)) { route_phase<true>(a, l, nrows, ldsf); __syncthreads(); }
            RUN(10, true, for (int it = bid; it < CVT_MOE_TILES; it += G) cvt_moe_item(a, l, it, ldsf));
        }
        SEAM(pb + 9);
        if (EN(9) && IN(pb + 10)) { RUN(11, true, permute_phase(a, l, nrows, lds)); }
        SEAM(pb + 10);
        if (EN(10) && IN(pb + 11)) {
            const int* tile_e = (const int*)(ws + WS_TILEE); const int ntiles = tile_e[200];
            pg8::Gemm g{(const bf16*)(ws + WS_XP), (const bf16*)(ws + WS_WGU), MOE_MAXROWS, NEXP * 1024, D}; MoeOrder S{tile_e, ntiles, 4, G, bid};
            EpiGU E{(bf16*)(ws + WS_HMID)};
            RUN(12, true, pg8::gemm_phase<EpiGU, MoeOrder, true, true>(lds, g, S, E));
        }
        SEAM(pb + 11);
        if (EN(11) && IN(pb + 12)) {
            const int* tile_e = (const int*)(ws + WS_TILEE); const int ntiles = tile_e[200];
            pg8::Gemm g{(const bf16*)(ws + WS_HMID), (const bf16*)(ws + WS_WD), MOE_MAXROWS, NEXP * D, DFF}; MoeOrder S{tile_e, ntiles, 8, G, bid};
            EpiDn E{(bf16*)(ws + WS_YP), (const float*)(ws + WS_ROWW)};
            RUN(13, true, pg8::gemm_phase<EpiDn, MoeOrder, true, true>(lds, g, S, E));
        }
        SEAM(pb + 12);
    }
    if (EN(12) && IN(PH_FINAL)) norm_phase<2>(a, DEPTH, SEQ, ldsf);
#undef IN
#undef SEAM
#undef ws
#undef bid
#undef G
#undef lds
#undef ldsf
#undef U
#undef Z
#undef H
#undef modall
}

#ifndef MK_SINGLE
#define MK_SINGLE 1
#endif
extern "C" void kernel_launch(void* const* d_in, const int* in_sizes, int n_in, void* d_out, int out_size, void* d_ws, size_t ws_size, hipStream_t stream) {
    static int grid = 0;
    if (grid == 0) {
        if (n_in != N_IN || out_size != SEQ * D || ws_size < WS_END) { fprintf(stderr, "kernel_launch: unexpected problem shape (n_in %d, out %d, ws %zu < %zu)\n", n_in, out_size, ws_size, (size_t)WS_END); grid = -1; return; }
        int dev = 0, cus = 0;
        if (hipGetDevice(&dev) != hipSuccess || hipDeviceGetAttribute(&cus, hipDeviceAttributeMultiprocessorCount, dev) != hipSuccess) { grid = -1; return; }
        if (hipFuncSetAttribute((const void*)fwd_kernel, hipFuncAttributeMaxDynamicSharedMemorySize, LDS_BYTES) != hipSuccess) { fprintf(stderr, "kernel_launch: hipFuncSetAttribute failed\n"); grid = -1; return; }
        int per_cu = 0;
        if (hipOccupancyMaxActiveBlocksPerMultiprocessor(&per_cu, (const void*)fwd_kernel, NTHR, LDS_BYTES) != hipSuccess || per_cu < 1) fprintf(stderr, "kernel_launch: occupancy query says %d\n", per_cu);
        (void)hipGetLastError();
        grid = cus;
    }
    if (grid < 0) return;
    (void)hipMemsetAsync((char*)d_ws + WS_CTL, 0, CTL_BYTES, stream);
    KArgs ka{};
    for (int i = 0; i < N_IN; ++i) ka.a.in[i] = (const float*)d_in[i];
    ka.a.out = (float*)d_out; ka.a.ws = (unsigned char*)d_ws;
#if MK_SINGLE
    ka.a.ph_lo = 0; ka.a.ph_hi = NPHASES; ka.li = 0; ka.pad = 0;
    hipLaunchKernelGGL(fwd_kernel, dim3(grid), dim3(NTHR), LDS_BYTES, stream, ka);
#else
    for (int ph = 0; ph < NPHASES; ++ph) { ka.a.ph_lo = ph; ka.a.ph_hi = ph + 1; ka.li = 0; ka.pad = 0; hipLaunchKernelGGL(fwd_kernel, dim3(grid), dim3(NTHR), LDS_BYTES, stream, ka); }
#endif
}
```

```cpp
#include <hip/hip_runtime.h>
#include <cstdio>
#include <cstdint>
#define DI __device__ __forceinline__
#define LAS __attribute__((address_space(3)))
typedef unsigned short bf16;
typedef float f32x4 __attribute__((ext_vector_type(4)));
typedef unsigned u32x4 __attribute__((ext_vector_type(4)));
typedef unsigned u32x2 __attribute__((ext_vector_type(2)));

constexpr int D = 2048, SEQ = 16384, CTXL = 256, MT = SEQ + CTXL  , DEPTH = 2;
constexpr int NCOLS_IN = 17440;
constexpr int ZC = 17664;
constexpr int Z_HG = 0, Z_GL = 5120, Z_HY = 8192, Z_MG = 11264, Z_LR = 17408;
constexpr int NEXP = 32, DFF = 512, MOE_MAXROWS = 41472;
constexpr float NORM_EPS = 1e-6f;

constexpr size_t MiB = 1u << 20;
constexpr size_t WS_CTL = 0, CTL_BYTES = 1 * MiB;
constexpr size_t WS_SMALL = 1 * MiB;
constexpr size_t WS_MOD   = WS_SMALL;
constexpr size_t WS_ZBIAS = WS_MOD + (size_t)DEPTH * 2 * 12288 * 4;
constexpr size_t WS_LB    = WS_ZBIAS + (size_t)DEPTH * ZC * 4;
constexpr size_t WS_TW    = WS_LB + (size_t)DEPTH * 2 * 1024 * 4;
constexpr size_t WS_TW2   = WS_TW + 16384 * 8;
constexpr size_t WS_H2    = WS_TW2 + (8192 + 64) * 8;
constexpr size_t WS_ROUTE = WS_H2 + (size_t)DEPTH * MT * 64 * 4;
constexpr size_t WS_ROWW  = WS_ROUTE + (size_t)MT * 8 * 4;
constexpr size_t WS_TILEE = WS_ROWW + (size_t)MOE_MAXROWS * 4;
constexpr size_t WS_HYC   = WS_TILEE + 1024;
constexpr size_t WS_W3T   = WS_HYC + (size_t)2048 * 256 * 4;
constexpr size_t WS_H2B   = WS_W3T + (size_t)DEPTH * 2048 * 256 * 2;
constexpr size_t WS_WRT   = WS_H2B + (size_t)DEPTH * SEQ * 256 * 2;
constexpr size_t WS_SMALL_END = WS_WRT + (size_t)DEPTH * 2 * 48 * 2048 * 2;
static_assert(WS_SMALL_END <= 40 * MiB, "small tables");
constexpr size_t WS_WIN  = 40 * MiB;
constexpr size_t WS_WBR  = 109 * MiB;
constexpr size_t WS_WOUT = 121 * MiB;
constexpr size_t WS_WGU  = 129 * MiB;
constexpr size_t WS_CVO  = WS_WIN;
constexpr size_t WS_WD   = 257 * MiB;
constexpr size_t WS_H    = 321 * MiB;
constexpr size_t WS_U    = 451 * MiB;
constexpr size_t WS_Z    = 516 * MiB;
constexpr size_t WS_XP   = WS_Z;
constexpr size_t WS_HMID = WS_Z + 162 * MiB;
constexpr size_t WS_YP   = WS_Z + 203 * MiB;
constexpr size_t WS_YMIX = 1077 * MiB;
constexpr size_t WS_HF   = 1175 * MiB;
constexpr size_t WS_OSC  = 1175 * MiB;
constexpr size_t WS_END  = 1435 * MiB;
static_assert(WS_WIN + (size_t)ZC * D * 2 <= WS_WBR && WS_Z + (size_t)MT * ZC * 2 <= WS_YMIX && WS_YMIX + (size_t)3 * MT * 1024 * 2 <= WS_OSC && WS_OSC + (size_t)4 * MT * 1024 * 4 <= WS_END, "ws map");
static_assert(WS_YP + (size_t)MOE_MAXROWS * D * 2 <= WS_YMIX && WS_H + (size_t)MT * D * 4 <= WS_U && WS_U + (size_t)MT * D * 2 <= WS_Z, "ws map 2");
constexpr int CW_BAR = 4096;
constexpr int CW_CNT = 16384;

DI float bf2f(bf16 v) { return __uint_as_float(((unsigned)v) << 16); }
DI float bflo(unsigned w) { return __uint_as_float(w << 16); }
DI float bfhi(unsigned w) { return __uint_as_float(w & 0xffff0000u); }
typedef float f32x2_t __attribute__((ext_vector_type(2))); typedef __bf16 bf16x2_t __attribute__((ext_vector_type(2)));
DI unsigned pk_bf16(float lo, float hi) { f32x2_t v = {lo, hi}; bf16x2_t b = __builtin_convertvector(v, bf16x2_t); return __builtin_bit_cast(unsigned, b); }
DI bf16 f2bf(float f) { return (bf16)(pk_bf16(f, 0.f) & 0xffffu); }
DI float sigmoidf_(float x) { return 1.0f / (1.0f + __expf(-x)); }
DI float siluf_(float x) { return x / (1.0f + __expf(-x)); }
DI float wave_sum(float v) {
#pragma unroll
    for (int o = 32; o >= 1; o >>= 1) v += __shfl_xor(v, o);
    return v;
}
DI int otid() { int t = __builtin_amdgcn_workitem_id_x(); asm volatile("" : "+v"(t)); return t; }
DI int ogdim() { int g = __builtin_amdgcn_workgroup_id_x(); g = (int)gridDim.x; asm volatile("" : "+s"(g)); return g; }
DI int obid() { int b = __builtin_amdgcn_workgroup_id_x(); asm volatile("" : "+s"(b)); return b; }
#define AIN_DECL 1
namespace pg8 {
#define PG8_LAS __attribute__((address_space(3)))
typedef unsigned short bf16_t;
typedef short bf16x8 __attribute__((ext_vector_type(8)));
typedef float f32x4 __attribute__((ext_vector_type(4)));
typedef unsigned u32x4 __attribute__((ext_vector_type(4)));
constexpr int BM = 256, BK = 64, HALF = 128, HTB = HALF * BK * 2  , STAGE_BYTES = 8 * HTB, NXCD = 8, WGM = 8;

__host__ __device__ __forceinline__ int lds_byte(int r, int c) { const int st = (r >> 4) * 2 + (c >> 5), rr = r & 15, cc = c & 31, ob = rr * 64 + cc * 2; return st * 1024 + (ob ^ (((ob >> 9) & 1) << 5)); }
__host__ __device__ __forceinline__ void stage_rc(int b, int& R, int& C) { const int st = b / 1024, sb = b % 1024, swz = sb ^ (((sb >> 9) & 1) << 5); R = (st >> 1) * 16 + swz / 64; C = (st & 1) * 32 + (swz % 64) / 2; }
__host__ __device__ __forceinline__ int perm32(int rho) { const int n = rho >> 4, i = rho & 15; return 8 * (i >> 2) + 4 * n + (i & 3); }

struct Unit { int pm, pn; };
struct Gemm { const bf16_t* A; const bf16_t* Bt; int M, N, K; };

struct StaticOrder {
    int nM, nN, nwg, G, c;
    __host__ __device__ void init(int M, int N, int G_, int c_) { nM = M / BM; nN = N / BM; nwg = nM * nN; G = G_; c = c_; }
    __host__ __device__ bool next(int i, Unit& u) const {
        const long L = (long)i * G + c; if (L >= nwg) return false;
        int wgid = (int)L; { const int q = nwg / NXCD, r = nwg % NXCD, xcd = wgid % NXCD, off = wgid / NXCD; wgid = (xcd < r ? xcd * (q + 1) : r * (q + 1) + (xcd - r) * q) + off; }
        const int nig = WGM * nN, gid = wgid / nig, fm = gid * WGM, gsz = (nM - fm) < WGM ? (nM - fm) : WGM;
        u.pm = fm + ((wgid % nig) % gsz); u.pn = (wgid % nig) / gsz; return true;
    }
    __device__ __forceinline__ void a_ready(const Unit&) const {}
    __device__ __forceinline__ void done(const Unit&) const {}
};

template <class Epi, class Sched, bool ALIGN_EPI = false, bool SP2 = false>
__device__ __forceinline__ void gemm_phase(PG8_LAS unsigned char* lds, const Gemm g, const Sched& S, const Epi& E) {
    const int tid = otid(), wid = __builtin_amdgcn_readfirstlane(tid >> 6), lane = tid & 63, wr = wid >> 2, wc = wid & 3, fr = lane & 15, fq = lane >> 4;
    const int K = g.K, nt = K / BK;
    unsigned voffA[2], voffB[2];
#pragma unroll
    for (int i = 0; i < 2; ++i) { int R, C; stage_rc(tid * 16 + i * 8192, R, C); const int Rb = Epi::PERM ? ((R & ~31) + perm32(R & 31)) : R;
        voffA[i] = (unsigned)(R * K + C) * 2u; voffB[i] = (unsigned)(Rb * K + C) * 2u; }
    const size_t kstep = (size_t)(BK * 2);
    const size_t hstep = (size_t)HALF * K * 2;
    const size_t tstep = 2 * hstep;
    const unsigned ldsw = (unsigned)wid * 1024u;
    const int aoff = lds_byte(wr * 64 + fr, fq * 8), boff = lds_byte(wc * 32 + fr, fq * 8);
#define PG8_SA(b, h) (((b) * 2 + (h)) * HTB)
#define PG8_SB(b, h) ((4 + (b) * 2 + (h)) * HTB)
#define PG8_STAGE(bufoff, gbase, voff) do { _Pragma("unroll") for (int _i = 0; _i < 2; ++_i) \
        __builtin_amdgcn_global_load_lds((const unsigned*)((const char*)(gbase) + (voff)[_i]), (PG8_LAS unsigned*)(lds + (bufoff) + ldsw + _i * 8192), 16, 0, 0); } while (0)
#define PG8_LDA(dst, b, h) do { _Pragma("unroll") for (int m = 0; m < 4; ++m) _Pragma("unroll") for (int k = 0; k < 2; ++k) dst[m][k] = *(const PG8_LAS bf16x8*)(lds + PG8_SA(b, h) + aoff + m * 2048 + k * 1024); } while (0)
#define PG8_LDB(dst, b, h) do { _Pragma("unroll") for (int n = 0; n < 2; ++n) _Pragma("unroll") for (int k = 0; k < 2; ++k) dst[n][k] = *(const PG8_LAS bf16x8*)(lds + PG8_SB(b, h) + boff + n * 2048 + k * 1024); } while (0)
#define PG8_MMA(ai, bj, At, Bt) do { __builtin_amdgcn_s_setprio(1); _Pragma("unroll") for (int m = 0; m < 4; ++m) _Pragma("unroll") for (int n = 0; n < 2; ++n) _Pragma("unroll") for (int k = 0; k < 2; ++k) \
        acc[ai][bj][m][n] = __builtin_amdgcn_mfma_f32_16x16x32_bf16(Bt[n][k], At[m][k], acc[ai][bj][m][n], 0, 0, 0); __builtin_amdgcn_s_setprio(0); } while (0)
#define PG8_WAIT_V(n) asm volatile("s_waitcnt vmcnt(" #n ")" ::: "memory")
#define PG8_WAIT_L(n) asm volatile("s_waitcnt lgkmcnt(" #n ")" ::: "memory")
#define PG8_BAR __builtin_amdgcn_s_barrier()
#define PG8_SCHED __builtin_amdgcn_sched_barrier(0)
    Unit cur, nxt; int ui = 0;
    if (!S.next(0, cur)) return;
    f32x4 acc[2][2][4][2];
#pragma unroll
    for (int a = 0; a < 2; ++a)
#pragma unroll
        for (int b = 0; b < 2; ++b)
#pragma unroll
            for (int m = 0; m < 4; ++m)
#pragma unroll
                for (int n = 0; n < 2; ++n) acc[a][b][m][n] = (f32x4){0.f, 0.f, 0.f, 0.f};
    bf16x8 At[4][2], B0[2][2], B1[2][2];
    const char* cA = (const char*)g.A + (size_t)cur.pm * tstep; const char* cB = (const char*)g.Bt + (size_t)cur.pn * tstep;
    S.a_ready(cur);
    if constexpr (SP2) {
        PG8_STAGE(PG8_SB(0, 0), cB, voffB); PG8_STAGE(PG8_SB(0, 1), cB + hstep, voffB); PG8_STAGE(PG8_SA(0, 0), cA, voffA); PG8_STAGE(PG8_SA(0, 1), cA + hstep, voffA);
        if (wr == 1) PG8_BAR;
        PG8_WAIT_V(2); PG8_BAR;
        PG8_STAGE(PG8_SB(1, 0), cB + kstep, voffB); PG8_STAGE(PG8_SA(1, 0), cA + kstep, voffA); PG8_STAGE(PG8_SB(1, 1), cB + hstep + kstep, voffB);
        PG8_WAIT_V(6); PG8_BAR;
    } else {
        PG8_STAGE(PG8_SB(0, 0), cB, voffB); PG8_STAGE(PG8_SA(0, 0), cA, voffA); PG8_STAGE(PG8_SB(0, 1), cB + hstep, voffB); PG8_STAGE(PG8_SA(0, 1), cA + hstep, voffA);
        if (wr == 1) PG8_BAR;
        PG8_WAIT_V(4); PG8_BAR;
        PG8_STAGE(PG8_SB(1, 0), cB + kstep, voffB); PG8_STAGE(PG8_SA(1, 0), cA + kstep, voffA); PG8_STAGE(PG8_SB(1, 1), cB + hstep + kstep, voffB);
        PG8_WAIT_V(6); PG8_BAR;
    }
    for (;;) {
        const bool has_next = S.next(ui + 1, nxt);
        const char* nA = has_next ? (const char*)g.A + (size_t)nxt.pm * tstep : cA; const char* nB = has_next ? (const char*)g.Bt + (size_t)nxt.pn * tstep : cB;
        for (int t = 0; t < nt; t += 2) {
            const bool last = (t == nt - 2);
            const char* a1 = cA + (size_t)(t + 1) * kstep;
            const char* a2 = last ? nA : cA + (size_t)(t + 2) * kstep; const char* b2 = last ? nB : cB + (size_t)(t + 2) * kstep;
            const char* a3 = a2 + kstep; const char* b3 = b2 + kstep;
            if (last && has_next) S.a_ready(nxt);
            if constexpr (SP2) {
            PG8_LDB(B0, 0, 0); PG8_LDB(B1, 0, 1); PG8_SCHED; PG8_LDA(At, 0, 0); PG8_STAGE(PG8_SA(1, 1), a1 + hstep, voffA);
            PG8_WAIT_V(8); PG8_WAIT_L(0); PG8_BAR; PG8_MMA(0, 0, At, B0); PG8_MMA(0, 1, At, B1); PG8_BAR; PG8_SCHED;
            PG8_LDA(At, 0, 1); PG8_STAGE(PG8_SB(0, 0), b2, voffB); PG8_STAGE(PG8_SB(0, 1), b2 + hstep, voffB); PG8_STAGE(PG8_SA(0, 0), a2, voffA);
            PG8_WAIT_V(8); PG8_WAIT_L(0); PG8_BAR; PG8_MMA(1, 0, At, B0); PG8_MMA(1, 1, At, B1); PG8_BAR; PG8_SCHED;
            PG8_LDB(B0, 1, 0); PG8_LDB(B1, 1, 1); PG8_SCHED; PG8_LDA(At, 1, 0); PG8_STAGE(PG8_SA(0, 1), a2 + hstep, voffA);
            PG8_WAIT_V(8); PG8_WAIT_L(0); PG8_BAR; PG8_MMA(0, 0, At, B0); PG8_MMA(0, 1, At, B1); PG8_BAR; PG8_SCHED;
            PG8_LDA(At, 1, 1); PG8_STAGE(PG8_SB(1, 0), b3, voffB); PG8_STAGE(PG8_SB(1, 1), b3 + hstep, voffB); PG8_STAGE(PG8_SA(1, 0), a3, voffA);
            PG8_WAIT_V(8); PG8_WAIT_L(0); PG8_BAR; PG8_MMA(1, 0, At, B0); PG8_MMA(1, 1, At, B1); PG8_BAR; PG8_SCHED;
            } else {
            PG8_LDB(B0, 0, 0); PG8_SCHED; PG8_LDA(At, 0, 0); PG8_STAGE(PG8_SA(1, 1), a1 + hstep, voffA);
            PG8_WAIT_L(8); PG8_BAR; PG8_WAIT_L(0); PG8_MMA(0, 0, At, B0); PG8_BAR; PG8_SCHED;
            PG8_LDB(B1, 0, 1); PG8_STAGE(PG8_SB(0, 0), b2, voffB);
            PG8_BAR; PG8_WAIT_L(0); PG8_MMA(0, 1, At, B1); PG8_BAR;
            PG8_LDA(At, 0, 1); PG8_STAGE(PG8_SA(0, 0), a2, voffA);
            PG8_BAR; PG8_WAIT_L(0); PG8_MMA(1, 0, At, B0); PG8_BAR; PG8_SCHED;
            PG8_STAGE(PG8_SB(0, 1), b2 + hstep, voffB);
            PG8_WAIT_V(6); PG8_BAR; PG8_MMA(1, 1, At, B1); PG8_BAR;
            PG8_LDB(B0, 1, 0); PG8_SCHED; PG8_LDA(At, 1, 0); PG8_STAGE(PG8_SA(0, 1), a2 + hstep, voffA);
            PG8_WAIT_L(8); PG8_BAR; PG8_WAIT_L(0); PG8_MMA(0, 0, At, B0); PG8_BAR; PG8_SCHED;
            PG8_LDB(B1, 1, 1); PG8_STAGE(PG8_SB(1, 0), b3, voffB);
            PG8_BAR; PG8_WAIT_L(0); PG8_MMA(0, 1, At, B1); PG8_BAR;
            PG8_LDA(At, 1, 1); PG8_STAGE(PG8_SA(1, 0), a3, voffA);
            PG8_BAR; PG8_WAIT_L(0); PG8_MMA(1, 0, At, B0); PG8_BAR; PG8_SCHED;
            PG8_STAGE(PG8_SB(1, 1), b3 + hstep, voffB);
            PG8_WAIT_V(6); PG8_BAR; PG8_MMA(1, 1, At, B1); PG8_BAR;
            }
        }
        if constexpr (ALIGN_EPI) { if (wr == 0) PG8_BAR; }
        if constexpr (!Epi::AFTER_DRAIN) { E(acc, cur, wr, wc, fr, fq); S.done(cur); }
        if (!has_next) break;
#pragma unroll
        for (int a = 0; a < 2; ++a)
#pragma unroll
            for (int b = 0; b < 2; ++b)
#pragma unroll
                for (int m = 0; m < 4; ++m)
#pragma unroll
                    for (int n = 0; n < 2; ++n) acc[a][b][m][n] = (f32x4){0.f, 0.f, 0.f, 0.f};
        cur = nxt; cA = nA; cB = nB; ++ui;
        if constexpr (ALIGN_EPI) { if (wr == 1) PG8_BAR; }
    }
    PG8_WAIT_V(0);
    if constexpr (!ALIGN_EPI) { if (wr == 0) PG8_BAR; }
    PG8_BAR;
    if constexpr (Epi::AFTER_DRAIN) { E.fused(acc, cur, wr, wc, fr, fq, lds, wid, lane); S.done(cur); }
#undef PG8_SA
#undef PG8_SB
#undef PG8_STAGE
#undef PG8_LDA
#undef PG8_LDB
#undef PG8_MMA
#undef PG8_WAIT_V
#undef PG8_WAIT_L
#undef PG8_BAR
#undef PG8_SCHED
}
}
#define XB_TMO      128
#define XB_XCNT(j)  (256  + 64 * (j))
#define XB_XSUB(j)  (1280 + 64 * (j))
#define XB_XGEN(j)  (2304 + 64 * (j))
#define XB_TOP      3328
#define XB_TOPGEN   3392
#define XCD_BAR_WORDS 3456
#define XB_SPIN_CAP (1u << 18)

__device__ __forceinline__ unsigned xb_ld(unsigned* p)              { return __hip_atomic_load(p, __ATOMIC_RELAXED, __HIP_MEMORY_SCOPE_AGENT); }
__device__ __forceinline__ unsigned xb_add(unsigned* p, unsigned v) { return __hip_atomic_fetch_add(p, v, __ATOMIC_RELAXED, __HIP_MEMORY_SCOPE_AGENT); }
__device__ __forceinline__ unsigned xb_xcc_id() { return (unsigned)__builtin_amdgcn_s_getreg((3 << 11) | 20) & 0xFu; }
#define XB_SPIN(cond, bar) do { unsigned _sp = 0; while (cond) { __builtin_amdgcn_s_sleep(1); \
    if ((++_sp & 255u) == 0u) { if (xb_ld(&(bar)[XB_TMO])) break; if (_sp > XB_SPIN_CAP) { atomicAdd(&(bar)[XB_TMO], 1u); break; } } } } while (0)

struct XcdBarrier {
    unsigned* bar; unsigned x;
    volatile LAS unsigned* st;
};

__device__ __forceinline__ XcdBarrier xcd_barrier_post(unsigned* bar, volatile LAS unsigned* st) {
    XcdBarrier b; b.bar = bar; b.x = xb_xcc_id(); b.st = st;
    if (otid() == 0) (void)xb_add(&bar[XB_XCNT(b.x)], 1u);
    return b;
}
__device__ __forceinline__ void xcd_barrier_complete(unsigned* bar, unsigned x, unsigned& nloc, unsigned& nx) {
    asm volatile("" : "+s"(x));
    const unsigned G = ogdim();
    unsigned sum, cnt, mine, sp = 0u;
    for (;;) {
        sum = 0u; cnt = 0u; mine = 0u;
#pragma unroll
        for (unsigned j = 0; j < 16; ++j) { const unsigned c = xb_ld(&bar[XB_XCNT(j)]); sum += c; cnt += (c > 0u) ? 1u : 0u; mine = (j == x) ? c : mine; }
        if (sum == G) break;
        __builtin_amdgcn_s_sleep(1);
        if ((++sp & 255u) == 0u) { if (xb_ld(&bar[XB_TMO])) break; if (sp > XB_SPIN_CAP) { atomicAdd(&bar[XB_TMO], 1u); break; } }
    }
    nloc = mine > 0u ? mine : 1u; nx = cnt > 0u ? cnt : 1u;
}

__device__ __forceinline__ void xcd_barrier(const XcdBarrier& b) {
    asm volatile("s_waitcnt vmcnt(0)" ::: "memory");
    __syncthreads();
    if (otid() == 0) {
        unsigned* bar = b.bar;
        __builtin_amdgcn_s_waitcnt(0);
        unsigned nloc = b.st[0], nx = b.st[1];
        if (nloc == 0u) { xcd_barrier_complete(bar, b.x, nloc, nx); b.st[0] = nloc; b.st[1] = nx; }
        const unsigned old = xb_add(&bar[XB_XSUB(b.x)], 1u);
        const unsigned gen = old / nloc;
        if (old + 1u == (gen + 1u) * nloc) {
            __builtin_amdgcn_fence(__ATOMIC_RELEASE, "agent");
            asm volatile("s_waitcnt vmcnt(0)" ::: "memory");
            const unsigned og = xb_add(&bar[XB_TOP], 1u);
            const unsigned tg = og / nx;
            if (og + 1u == (tg + 1u) * nx) xb_add(&bar[XB_TOPGEN], 1u);
            else XB_SPIN(xb_ld(&bar[XB_TOPGEN]) == tg, bar);
            __builtin_amdgcn_fence(__ATOMIC_ACQUIRE, "agent");
            xb_add(&bar[XB_XGEN(b.x)], 1u);
            asm volatile("s_waitcnt vmcnt(0)" ::: "memory");
        } else {
            XB_SPIN(xb_ld(&bar[XB_XGEN(b.x)]) == gen, bar);
            __builtin_amdgcn_fence(__ATOMIC_ACQUIRE, "agent");
            asm volatile("s_waitcnt vmcnt(0)" ::: "memory");
        }
    }
    __syncthreads();
}

#define FFT_DI DI
#define FFT_M 16384
#define FFT_NT 512
struct cpx { float x, y; };
FFT_DI cpx cmul(cpx a, cpx b) { cpx r; r.x = a.x * b.x - a.y * b.y; r.y = a.x * b.y + a.y * b.x; return r; }
FFT_DI cpx cmulc(cpx a, cpx b) { cpx r; r.x = a.x * b.x + a.y * b.y; r.y = a.y * b.x - a.x * b.y; return r; }
FFT_DI int rev4_14(int k) {
    int r = 0;
#pragma unroll
    for (int d = 0; d < 7; ++d) { r = (r << 2) | (k & 3); k >>= 2; }
    return r;
}
template <int s, class LP, class TP> FFT_DI void fft_fwd_pass(LP lds, TP tw, int tid) {
    constexpr int tws = FFT_M / (4 * s);
#pragma unroll
    for (int b = tid; b < FFT_M / 4; b += FFT_NT) {
        const int pos = b & (s - 1), base = ((b & ~(s - 1)) << 2) + pos;
        cpx a0, a1, a2, a3;
        a0.x = lds[2 * base]; a0.y = lds[2 * base + 1];
        a1.x = lds[2 * (base + s)]; a1.y = lds[2 * (base + s) + 1];
        a2.x = lds[2 * (base + 2 * s)]; a2.y = lds[2 * (base + 2 * s) + 1];
        a3.x = lds[2 * (base + 3 * s)]; a3.y = lds[2 * (base + 3 * s) + 1];
        cpx t0, t1, t2, t3;
        t0.x = a0.x + a2.x; t0.y = a0.y + a2.y;
        t1.x = a0.x - a2.x; t1.y = a0.y - a2.y;
        t2.x = a1.x + a3.x; t2.y = a1.y + a3.y;
        t3.x = a1.x - a3.x; t3.y = a1.y - a3.y;
        cpx y0, y1, y2, y3;
        y0.x = t0.x + t2.x; y0.y = t0.y + t2.y;
        y2.x = t0.x - t2.x; y2.y = t0.y - t2.y;
        y1.x = t1.x + t3.y; y1.y = t1.y - t3.x;
        y3.x = t1.x - t3.y; y3.y = t1.y + t3.x;
        if (s > 1) {
            cpx w1, w2, w3;
            w1.x = tw[2 * (pos * tws)]; w1.y = tw[2 * (pos * tws) + 1];
            w2.x = tw[2 * (2 * pos * tws)]; w2.y = tw[2 * (2 * pos * tws) + 1];
            w3.x = tw[2 * (3 * pos * tws)]; w3.y = tw[2 * (3 * pos * tws) + 1];
            y1 = cmul(y1, w1); y2 = cmul(y2, w2); y3 = cmul(y3, w3);
        }
        lds[2 * base] = y0.x; lds[2 * base + 1] = y0.y;
        lds[2 * (base + s)] = y1.x; lds[2 * (base + s) + 1] = y1.y;
        lds[2 * (base + 2 * s)] = y2.x; lds[2 * (base + 2 * s) + 1] = y2.y;
        lds[2 * (base + 3 * s)] = y3.x; lds[2 * (base + 3 * s) + 1] = y3.y;
    }
}
template <int s, class LP, class TP> FFT_DI void fft_inv_pass(LP lds, TP tw, int tid) {
    constexpr int tws = FFT_M / (4 * s);
#pragma unroll
    for (int b = tid; b < FFT_M / 4; b += FFT_NT) {
        const int pos = b & (s - 1), base = ((b & ~(s - 1)) << 2) + pos;
        cpx b0, c1, c2, c3;
        b0.x = lds[2 * base]; b0.y = lds[2 * base + 1];
        c1.x = lds[2 * (base + s)]; c1.y = lds[2 * (base + s) + 1];
        c2.x = lds[2 * (base + 2 * s)]; c2.y = lds[2 * (base + 2 * s) + 1];
        c3.x = lds[2 * (base + 3 * s)]; c3.y = lds[2 * (base + 3 * s) + 1];
        if (s > 1) {
            cpx w1, w2, w3;
            w1.x = tw[2 * (pos * tws)]; w1.y = tw[2 * (pos * tws) + 1];
            w2.x = tw[2 * (2 * pos * tws)]; w2.y = tw[2 * (2 * pos * tws) + 1];
            w3.x = tw[2 * (3 * pos * tws)]; w3.y = tw[2 * (3 * pos * tws) + 1];
            c1 = cmulc(c1, w1); c2 = cmulc(c2, w2); c3 = cmulc(c3, w3);
        }
        cpx t0, t1, t2, t3;
        t0.x = b0.x + c2.x; t0.y = b0.y + c2.y;
        t1.x = b0.x - c2.x; t1.y = b0.y - c2.y;
        t2.x = c1.x + c3.x; t2.y = c1.y + c3.y;
        t3.x = c1.x - c3.x; t3.y = c1.y - c3.y;
        cpx x0, x1, x2, x3;
        x0.x = t0.x + t2.x; x0.y = t0.y + t2.y;
        x2.x = t0.x - t2.x; x2.y = t0.y - t2.y;
        x1.x = t1.x - t3.y; x1.y = t1.y + t3.x;
        x3.x = t1.x + t3.y; x3.y = t1.y - t3.x;
        lds[2 * base] = x0.x; lds[2 * base + 1] = x0.y;
        lds[2 * (base + s)] = x1.x; lds[2 * (base + s) + 1] = x1.y;
        lds[2 * (base + 2 * s)] = x2.x; lds[2 * (base + 2 * s) + 1] = x2.y;
        lds[2 * (base + 3 * s)] = x3.x; lds[2 * (base + 3 * s) + 1] = x3.y;
    }
}
template <class LP, class TP> FFT_DI void rfft_untangle(LP lds, TP tw2, int k, cpx& Xk, cpx& Xm) {
    if (k == 0) {
        const float zr = lds[0], zi = lds[1];
        Xk.x = zr + zi; Xk.y = zr - zi;
        const int p = rev4_14(FFT_M / 2);
        Xm.x = lds[2 * p]; Xm.y = -lds[2 * p + 1];
        return;
    }
    const int pk = rev4_14(k), pm = rev4_14(FFT_M - k);
    cpx Zk, Zm; Zk.x = lds[2 * pk]; Zk.y = lds[2 * pk + 1]; Zm.x = lds[2 * pm]; Zm.y = lds[2 * pm + 1];
    cpx E, O, W, WO;
    E.x = 0.5f * (Zk.x + Zm.x); E.y = 0.5f * (Zk.y - Zm.y);
    O.x = 0.5f * (Zk.y + Zm.y); O.y = -0.5f * (Zk.x - Zm.x);
    W.x = tw2[2 * k]; W.y = tw2[2 * k + 1];
    WO = cmul(W, O);
    Xk.x = E.x + WO.x; Xk.y = E.y + WO.y;
    Xm.x = E.x - WO.x; Xm.y = -(E.y - WO.y);
}
template <class LP, class TP> FFT_DI void rfft_mul_retangle(LP lds, TP tw2, int k, cpx Gk, cpx Gm) {
    cpx Xk, Xm; rfft_untangle(lds, tw2, k, Xk, Xm);
    if (k == 0) {
        const float y0 = Xk.x * Gk.x, yM = Xk.y * Gk.y;
        lds[0] = 0.5f * (y0 + yM); lds[1] = 0.5f * (y0 - yM);
        const cpx Y = cmul(Xm, Gm);
        const int p = rev4_14(FFT_M / 2);
        lds[2 * p] = Y.x; lds[2 * p + 1] = -Y.y;
        return;
    }
    const cpx Yk = cmul(Xk, Gk), Ym = cmul(Xm, Gm);
    cpx W; W.x = tw2[2 * k]; W.y = tw2[2 * k + 1];
    cpx A, D, T;
    A.x = 0.5f * (Yk.x + Ym.x); A.y = 0.5f * (Yk.y - Ym.y);
    D.x = 0.5f * (Yk.x - Ym.x); D.y = 0.5f * (Yk.y + Ym.y);
    T = cmulc(D, W);
    const int pk = rev4_14(k), pm = rev4_14(FFT_M - k);
    lds[2 * pk] = A.x - T.y; lds[2 * pk + 1] = A.y + T.x;
    cpx Dc; Dc.x = -D.x; Dc.y = D.y;
    const cpx T2 = cmul(W, Dc);
    lds[2 * pm] = A.x + T2.y; lds[2 * pm + 1] = -A.y - T2.x;
}
enum { I_X = 0, I_C, I_CTX, I_CCTX, I_WMOD, I_BMOD, I_NMIXW, I_NFFNW, I_WIN, I_BIN, I_HYCW, I_HYCB, I_HYW1, I_HYB1, I_HYW2, I_HYB2, I_HYW3, I_HYB3, I_HYFREQ, I_HYSKIP,
       I_HGLB, I_HGNW, I_GLWA2, I_GLBA, I_GLNW, I_WBR, I_WOUT, I_WRG, I_BRG, I_WRE, I_BRE, I_WGATE, I_WUP, I_WDOWN, I_FNW, N_IN };
struct Args { const float* in[N_IN]; float* out; unsigned char* ws; int ph_lo, ph_hi; };
#define GAS __attribute__((address_space(1)))
extern __shared__ __attribute__((aligned(16))) unsigned char lds_raw[];
constexpr int LDS_PTAB = 150 * 1024 - 64 - 320;
DI LAS unsigned char* ldsbase() { unsigned p = (unsigned)(unsigned long long)(LAS unsigned char*)lds_raw; asm volatile("" : "+s"(p)); return (LAS unsigned char*)(unsigned long long)p; }
DI const float* ain(const Args&, int i) { const unsigned long long v = ((LAS unsigned long long*)(ldsbase() + LDS_PTAB))[i];
    const unsigned lo = __builtin_amdgcn_readfirstlane((unsigned)v), hi = __builtin_amdgcn_readfirstlane((unsigned)(v >> 32)); return (const float*)(GAS const float*)(((unsigned long long)hi << 32) | lo); }
DI unsigned char* wsp(const Args& a) { unsigned long long p = (unsigned long long)(a).ws; asm volatile("" : "+s"(p)); return (unsigned char*)(GAS unsigned char*)p; }
DI int opq(int x) { asm volatile("" : "+s"(x)); return x; }
constexpr int NTHR = 512;
constexpr int LDS_BYTES = 150 * 1024;
constexpr int LDS_X = 131072;
constexpr int LDS_BARW = LDS_BYTES - 64;

DI int z_srccol(int zc) { return zc < 8192 ? zc : (zc < Z_LR ? zc + 32 : (zc < Z_LR + 32 ? zc - Z_LR + 8192 : -1)); }

DI void cvt_block(const float* __restrict__ s0, const float* __restrict__ s1, const float* __restrict__ s2, const float* __restrict__ s3, size_t ld, int c0, int c1, int c2, int c3,
                  bf16* __restrict__ dst, int K, int row0, int kb, LAS float* t) {
    const int tid = otid(), nn = tid & 63, kk = tid >> 6;
    float v[8][4];
#pragma unroll
    for (int p = 0; p < 8; ++p) { const size_t ko = (size_t)(kb * 64 + p * 8 + kk) * ld;
        v[p][0] = c0 >= 0 ? s0[ko + c0] : 0.f; v[p][1] = c1 >= 0 ? s1[ko + c1] : 0.f; v[p][2] = c2 >= 0 ? s2[ko + c2] : 0.f; v[p][3] = c3 >= 0 ? s3[ko + c3] : 0.f; }
#pragma unroll
    for (int p = 0; p < 8; ++p)
#pragma unroll
        for (int g = 0; g < 4; ++g) t[(p * 8 + kk) * 257 + g * 64 + nn] = v[p][g];
    __syncthreads();
    const int rr = tid & 255, hk = tid >> 8;
#pragma unroll
    for (int q = 0; q < 4; ++q) { float w[8];
#pragma unroll
        for (int j = 0; j < 8; ++j) w[j] = t[(hk * 32 + q * 8 + j) * 257 + rr];
        u32x4 o; o.x = pk_bf16(w[0], w[1]); o.y = pk_bf16(w[2], w[3]); o.z = pk_bf16(w[4], w[5]); o.w = pk_bf16(w[6], w[7]);
        *(u32x4*)(dst + (size_t)(row0 + rr) * K + kb * 64 + hk * 32 + q * 8) = o; }
    __syncthreads();
}
constexpr int CVT_MIX_TILES = 69 * 32 + 3 * 8 * 16 + 8 * 32;
DI void cvt_mix_item(const Args& a, int l, int it, LAS float* t) {
    const int nn = otid() & 63;
    if (it < 69 * 32) { const int nb = it >> 5, kb = it & 31; const float* s = ain(a, I_WIN) + (size_t)l * D * NCOLS_IN;
        cvt_block(s, s, s, s, NCOLS_IN, z_srccol(nb * 256 + nn), z_srccol(nb * 256 + 64 + nn), z_srccol(nb * 256 + 128 + nn), z_srccol(nb * 256 + 192 + nn), (bf16*)(wsp(a) + WS_WIN), D, nb * 256, kb, t); return; }
    it -= 69 * 32;
    if (it < 3 * 8 * 16) { const int br = it / 128, r = it % 128, nb = r >> 4, kb = r & 15; const float* s = ain(a, I_WBR) + ((size_t)l * 3 + br) * 1024 * D; const int c = nb * 256 + nn;
        cvt_block(s, s, s, s, D, c, c + 64, c + 128, c + 192, (bf16*)(wsp(a) + WS_WBR) + (size_t)br * D * 1024, 1024, nb * 256, kb, t); return; }
    it -= 3 * 8 * 16;
    { const int nb = it >> 5, kb = it & 31; const float* s = ain(a, I_WOUT) + (size_t)l * D * D; const int c = nb * 256 + nn;
      cvt_block(s, s, s, s, D, c, c + 64, c + 128, c + 192, (bf16*)(wsp(a) + WS_WOUT), D, nb * 256, kb, t); }
}
constexpr int CVT_MOE_TILES = 32 * 4 * 32 + 32 * 8 * 8;
DI void cvt_moe_item(const Args& a, int l, int it, LAS float* t) {
    const int nn = otid() & 63;
    if (it < 32 * 4 * 32) { const int e = it >> 7, r = it & 127, nt = r >> 5, kb = r & 31;
        const float* sg = ain(a, I_WGATE) + ((size_t)l * NEXP + e) * D * DFF; const float* su = ain(a, I_WUP) + ((size_t)l * NEXP + e) * D * DFF; const int c = nt * 128 + nn;
        cvt_block(sg, sg, su, su, DFF, c, c + 64, c, c + 64, (bf16*)(wsp(a) + WS_WGU) + (size_t)e * 1024 * D, D, nt * 256, kb, t); return; }
    it -= 32 * 4 * 32;
    { const int e = it >> 6, r = it & 63, nb = r >> 3, kb = r & 7; const float* s = ain(a, I_WDOWN) + ((size_t)l * NEXP + e) * DFF * D; const int c = nb * 256 + nn;
      cvt_block(s, s, s, s, D, c, c + 64, c + 128, c + 192, (bf16*)(wsp(a) + WS_WD) + (size_t)e * D * DFF, DFF, nb * 256, kb, t); }
}

DI void mod_item(const Args& a, int j, LAS float* lds) {
    const int tid = otid(), l = j >> 7, col0 = (j & 127) * 96;
    LAS float* sil = lds;
    LAS float* red = lds + 4096;
    for (int k = tid; k < 2 * D; k += NTHR) { const float c = (k < D) ? ain(a, I_C)[k] : ain(a, I_CCTX)[k - D]; sil[k] = siluf_(c); }
    __syncthreads();
    const int cg = tid % 24, rg = tid / 24;
    f32x4 a0 = {0.f, 0.f, 0.f, 0.f}, a1 = {0.f, 0.f, 0.f, 0.f};
    if (rg < 21) {
        const float* w = ain(a, I_WMOD) + (size_t)l * D * 12288 + col0 + cg * 4;
        for (int k = rg; k < D; k += 21) { const f32x4 wv = *(const f32x4*)(w + (size_t)k * 12288); a0 += wv * sil[k]; a1 += wv * sil[D + k]; }
#pragma unroll
        for (int q = 0; q < 4; ++q) { red[(rg * 2 + 0) * 96 + cg * 4 + q] = a0[q]; red[(rg * 2 + 1) * 96 + cg * 4 + q] = a1[q]; }
    }
    __syncthreads();
    if (tid < 192) { const int set = tid / 96, c = tid % 96; float s = 0.f;
        for (int r = 0; r < 21; ++r) s += red[(r * 2 + set) * 96 + c];
        ((float*)(wsp(a) + WS_MOD))[((size_t)l * 2 + set) * 12288 + col0 + c] = s + ain(a, I_BMOD)[(size_t)l * 12288 + col0 + c]; }
    __syncthreads();
}
DI void h2_item(const Args& a, int it, LAS float* lds) {
    const int tid = otid(), l = it / (MT / 8), r0 = (it % (MT / 8)) * 8;
    LAS float* feats = lds;
    LAS float* h1 = lds + 8 * 36;
    if (tid < 8 * 33) { const int rr = tid / 33, i = tid % 33, r = r0 + rr; const int Lq = r < SEQ ? SEQ : CTXL, t = r < SEQ ? r : r - SEQ;
        float f;
        if (i == 0) f = (float)t / (float)(Lq - 1);
        else { const int bi = (i - 1) & 15; const float band = 1e-4f + (float)bi * ((15.0f - 1e-4f) / 15.0f); const float rev2 = 2.0f * band * (float)t / (float)Lq;
            f = (i <= 16) ? cospif(rev2) : -sinpif(rev2); }
        feats[rr * 36 + i] = f; }
    __syncthreads();
    const int rr = tid >> 6, j = tid & 63;
    { const float* w1 = ain(a, I_HYW1) + (size_t)l * 33 * 64; float s = ain(a, I_HYB1)[l * 64 + j];
      for (int i = 0; i < 33; ++i) s += feats[rr * 36 + i] * w1[i * 64 + j];
      h1[rr * 64 + j] = sinf(ain(a, I_HYFREQ)[l * 64 + j] * s); }
    __syncthreads();
    { const float* w2 = ain(a, I_HYW2) + (size_t)l * 64 * 64; float s = ain(a, I_HYB2)[l * 64 + j];
      for (int i = 0; i < 64; ++i) s += h1[rr * 64 + i] * w2[i * 64 + j];
      const float hv = sinf(ain(a, I_HYFREQ)[l * 64 + j] * s);
      ((float*)(wsp(a) + WS_H2))[((size_t)l * MT + r0 + rr) * 64 + j] = hv;
      if (r0 + rr < SEQ) { bf16* hb = (bf16*)(wsp(a) + WS_H2B) + ((size_t)l * SEQ + r0 + rr) * 256; hb[j] = f2bf(hv); hb[64 + j] = 0; hb[128 + j] = 0; hb[192 + j] = 0; } }
    __syncthreads();
}
DI void prologue_small(const Args& a) {
    const size_t gt = (size_t)obid() * NTHR + otid(), gs = (size_t)ogdim() * NTHR;
    float* zb = (float*)(wsp(a) + WS_ZBIAS);
    for (size_t i = gt; i < (size_t)DEPTH * ZC; i += gs) { const int l = (int)(i / ZC), zc = (int)(i % ZC), sc = z_srccol(zc); zb[i] = sc >= 0 ? ain(a, I_BIN)[(size_t)l * NCOLS_IN + sc] : 0.f; }
    float* lb = (float*)(wsp(a) + WS_LB);
    for (size_t i = gt; i < (size_t)DEPTH * 2048; i += gs) { const int l = (int)(i / 2048), j = (int)(i % 2048);
        float v = 0.f; if (l == 1) { const float r0 = ain(a, I_HGLB)[j], r1 = ain(a, I_HGLB)[2048 + j]; v = 1.0f / (1.0f + expf(r0 - r1)); }
        lb[i] = v; }
    bf16* w3t = (bf16*)(wsp(a) + WS_W3T);
    for (size_t i = gt; i < (size_t)DEPTH * 2048 * 256; i += gs) { const int l = (int)(i >> 19), fc = (int)((i >> 8) & 2047), j = (int)(i & 255); w3t[i] = j < 64 ? f2bf(ain(a, I_HYW3)[((size_t)l * 64 + j) * 2048 + fc]) : (bf16)0; }
    bf16* wrt = (bf16*)(wsp(a) + WS_WRT);
    for (size_t i = gt; i < (size_t)DEPTH * 48 * 2048; i += gs) { const int l = (int)(i / (48 * 2048)), c = (int)((i / 2048) % 48), k = (int)(i & 2047);
        const float w = c < 4 ? ain(a, I_WRG)[((size_t)l * D + k) * 4 + c] : (c < 36 ? ain(a, I_WRE)[((size_t)l * D + k) * 32 + (c - 4)] : 0.f);
        const bf16 hi = f2bf(w); wrt[((size_t)l * 2 + 0) * 48 * 2048 + (size_t)c * 2048 + k] = hi; wrt[((size_t)l * 2 + 1) * 48 * 2048 + (size_t)c * 2048 + k] = f2bf(w - bf2f(hi)); }
    float* tw = (float*)(wsp(a) + WS_TW);
    for (size_t i = gt; i < 16384; i += gs) { float s, c; sincospif(-2.0f * (float)i / 16384.0f, &s, &c); tw[2 * i] = c; tw[2 * i + 1] = s; }
    float* tw2 = (float*)(wsp(a) + WS_TW2);
    for (size_t i = gt; i <= 8192; i += gs) { float s, c; sincospif(-(float)i / 16384.0f, &s, &c); tw2[2 * i] = c; tw2[2 * i + 1] = s; }
}
DI void hyc_filters(const Args& a, int l) {
    const int lane = otid() & 63, wave = otid() >> 6;
    const float* h2 = (const float*)(wsp(a) + WS_H2) + ((size_t)l * MT + SEQ) * 64;
    const float* w3 = ain(a, I_HYW3) + (size_t)l * 64 * 2048;
    float* hyc = (float*)(wsp(a) + WS_HYC);
    const float a0 = -4.605170186f / 1.5f, a1 = -4.605170186f / 0.3f;
    for (int fc = obid() * 8 + wave; fc < 2048; fc += ogdim() * 8) {
        const int c = fc & 1023; const float delta = fabsf(a0 + (float)c * ((a1 - a0) / 1023.0f)); const float b3 = ain(a, I_HYB3)[l * 2048 + fc];
        float hv[4], ssum = 0.f;
#pragma unroll
        for (int i = 0; i < 4; ++i) { const int t = lane + 64 * i; float s = b3;
            for (int j = 0; j < 64; ++j) s += h2[t * 64 + j] * w3[j * 2048 + fc];
            const float tl = (float)t / 255.0f; hv[i] = s * (expf(-tl * delta) + 0.05f); ssum += fabsf(hv[i]); }
        ssum = wave_sum(ssum); const float inv = 1.0f / ssum;
#pragma unroll
        for (int i = 0; i < 4; ++i) hyc[(size_t)fc * 256 + lane + 64 * i] = hv[i] * inv;
    }
}
template <int MODE, bool DRY = false> DI void norm_phase(const Args& a, int l, int nrows, LAS float* ldsf) {
    const int lane = otid() & 63, wave = otid() >> 6;
    float* H = (float*)(wsp(a) + WS_H); bf16* U = (bf16*)(wsp(a) + WS_U);
    const float* modall = (const float*)(wsp(a) + WS_MOD);
    int* route = (int*)(wsp(a) + WS_ROUTE);
    const bf16* YP = (const bf16*)(wsp(a) + WS_YP);
    const bool combine = (MODE == 0 && l > 0) || MODE == 2;
    for (int r = obid() * 8 + wave; r < nrows; r += ogdim() * 8) {
        const int set = r >= SEQ ? 1 : 0;
        const float* src = (MODE == 0 && l == 0) ? (set ? ain(a, I_CTX) + (size_t)(r - SEQ) * D : ain(a, I_X) + (size_t)r * D) : H + (size_t)r * D;
        f32x4 v[8];
#pragma unroll
        for (int j = 0; j < 8; ++j) v[j] = *(const f32x4*)(src + j * 256 + lane * 4);
        if (combine) {
            const float* gt2 = modall + ((size_t)(l - 1) * 2 + set) * 12288 + 10240;
            const int p0 = route[r * 8 + 6], p1 = route[r * 8 + 7];
#pragma unroll
            for (int j = 0; j < 8; ++j) { const int col = j * 256 + lane * 4;
                const u32x2 y0 = *(const u32x2*)(YP + (size_t)p0 * D + col), y1 = *(const u32x2*)(YP + (size_t)p1 * D + col); const f32x4 g = *(const f32x4*)(gt2 + col);
                v[j][0] += g[0] * (bflo(y0.x) + bflo(y1.x)); v[j][1] += g[1] * (bfhi(y0.x) + bfhi(y1.x)); v[j][2] += g[2] * (bflo(y0.y) + bflo(y1.y)); v[j][3] += g[3] * (bfhi(y0.y) + bfhi(y1.y)); }
            if (MODE == 0) {
#pragma unroll
                for (int j = 0; j < 8; ++j) *(f32x4*)(H + (size_t)r * D + j * 256 + lane * 4) = v[j];
            }
        }
        float ss = 0.f;
#pragma unroll
        for (int j = 0; j < 8; ++j) ss += (v[j][0] * v[j][0] + v[j][1] * v[j][1]) + (v[j][2] * v[j][2] + v[j][3] * v[j][3]);
        ss = wave_sum(ss);
        const float rstd = rsqrtf(ss * (1.0f / D) + NORM_EPS);
        if (MODE == 2) {
            const float* fw = ain(a, I_FNW);
#pragma unroll
            for (int j = 0; j < 8; ++j) { const int col = j * 256 + lane * 4; const f32x4 w = *(const f32x4*)(fw + col); *(f32x4*)(a.out + (size_t)r * D + col) = v[j] * rstd * w; }
        } else {
            const float* nw = (MODE == 0 ? ain(a, I_NMIXW) : ain(a, I_NFFNW)) + (size_t)l * D;
            const float* md = modall + ((size_t)l * 2 + set) * 12288 + (MODE == 0 ? 0 : 6144);
#pragma unroll
            for (int j = 0; j < 8; ++j) { const int col = j * 256 + lane * 4; const f32x4 w = *(const f32x4*)(nw + col), sh = *(const f32x4*)(md + col), sc = *(const f32x4*)(md + 2048 + col);
                v[j] = (v[j] * rstd * w) * (sc + 1.0f) + sh;
                u32x2 o; o.x = pk_bf16(v[j][0], v[j][1]); o.y = pk_bf16(v[j][2], v[j][3]); *(u32x2*)(U + (size_t)r * D + col) = o; }
            if (MODE == 1) {
                const float* wrg = ain(a, I_WRG) + (size_t)l * D * 4; const float* wre = ain(a, I_WRE) + (size_t)l * D * 32;
                float lg[36];
#pragma unroll
                for (int i = 0; i < 36; ++i) lg[i] = 0.f;
                LAS float* wu = ldsf + wave * 2048;
#pragma unroll
                for (int j = 0; j < 8; ++j) *(LAS f32x4*)(wu + j * 256 + lane * 4) = v[j];
                asm volatile("s_waitcnt lgkmcnt(0)" ::: "memory");
#pragma unroll 2
                for (int cc = 0; cc < 32; ++cc) { const int col = cc * 64 + lane; const float uv = wu[col];
                    const f32x4 g = *(const f32x4*)(wrg + (size_t)col * 4);
                    lg[0] += uv * g[0]; lg[1] += uv * g[1]; lg[2] += uv * g[2]; lg[3] += uv * g[3];
#pragma unroll
                    for (int e4 = 0; e4 < 8; ++e4) { const f32x4 w = *(const f32x4*)(wre + (size_t)col * 32 + e4 * 4);
                        lg[4 + e4 * 4 + 0] += uv * w[0]; lg[4 + e4 * 4 + 1] += uv * w[1]; lg[4 + e4 * 4 + 2] += uv * w[2]; lg[4 + e4 * 4 + 3] += uv * w[3]; } }
                asm volatile("s_waitcnt lgkmcnt(0)" ::: "memory");
#pragma unroll
                for (int i = 0; i < 36; ++i) lg[i] = wave_sum(lg[i]);
                float gl[4]; int grp = 0; float gmax;
#pragma unroll
                for (int g = 0; g < 4; ++g) gl[g] = lg[g] + ain(a, I_BRG)[l * 4 + g];
                gmax = gl[0];
#pragma unroll
                for (int g = 1; g < 4; ++g) if (gl[g] > gmax) { gmax = gl[g]; grp = g; }
                float gden = 0.f;
#pragma unroll
                for (int g = 0; g < 4; ++g) gden += expf(gl[g] - gmax);
                const float ptop = 1.0f / gden;
                float le[8];
#pragma unroll
                for (int i = 0; i < 8; ++i) { float x = lg[4 + i];
#pragma unroll
                    for (int g = 1; g < 4; ++g) x = (grp == g) ? lg[4 + g * 8 + i] : x;
                    le[i] = x + ain(a, I_BRE)[l * 32 + grp * 8 + i]; }
                int i0 = 0; float m0 = le[0];
#pragma unroll
                for (int i = 1; i < 8; ++i) if (le[i] > m0) { m0 = le[i]; i0 = i; }
                int i1 = -1; float m1 = -3.0e38f;
#pragma unroll
                for (int i = 0; i < 8; ++i) if (i != i0 && le[i] > m1) { m1 = le[i]; i1 = i; }
                const float e1v = expf(m1 - m0);
                const float w0 = ptop / (1.0f + e1v), w1 = ptop * e1v / (1.0f + e1v);
                if (DRY) { asm volatile("" :: "v"(w0), "v"(w1), "v"(i0), "v"(i1), "v"(grp)); }
                else if (lane == 0) {
                    unsigned* cnt = (unsigned*)(wsp(a) + WS_CTL) + CW_CNT + l * 64;
                    const int ex0 = grp * 8 + i0, ex1 = grp * 8 + i1;
                    const unsigned s0 = atomicAdd(cnt + ex0, 1u), s1 = atomicAdd(cnt + ex1, 1u);
                    route[r * 8 + 0] = ex0; route[r * 8 + 1] = ex1; route[r * 8 + 2] = (int)s0; route[r * 8 + 3] = (int)s1;
                    route[r * 8 + 4] = __float_as_int(w0); route[r * 8 + 5] = __float_as_int(w1);
                }
            }
        }
    }
}
typedef short bf16x8r_t __attribute__((ext_vector_type(8)));
template <bool DRY> DI void route_phase(const Args& a, int l, int nrows, LAS float* ldsf) {
    const int lane = otid() & 63, wave = otid() >> 6, fr = lane & 15, fq = lane >> 4;
    const float* H = (const float*)(wsp(a) + WS_H); bf16* U = (bf16*)(wsp(a) + WS_U); int* route = (int*)(wsp(a) + WS_ROUTE);
    const float* nw = ain(a, I_NFFNW) + (size_t)l * D;
    const bf16* Wh = (const bf16*)(wsp(a) + WS_WRT) + (size_t)l * 2 * 48 * 2048; const bf16* Wl = Wh + 48 * 2048;
    LAS float* lt = ldsf + wave * 1024;
    const int G = ogdim();
    for (int tile = wave * G + (int)obid(); tile < nrows / 16; tile += 8 * G) {
        const int row = tile * 16 + fr, set = row >= SEQ ? 1 : 0;
        const float* hr = H + (size_t)row * D + fq * 8;
        const float* md = (const float*)(wsp(a) + WS_MOD) + ((size_t)l * 2 + set) * 12288 + 6144 + fq * 8;
        float ss = 0.f;
#pragma unroll 8
        for (int ks = 0; ks < 64; ++ks) { const f32x4 x0 = *(const f32x4*)(hr + ks * 32), x1 = *(const f32x4*)(hr + ks * 32 + 4);
            ss += (x0[0] * x0[0] + x0[1] * x0[1]) + (x0[2] * x0[2] + x0[3] * x0[3]) + (x1[0] * x1[0] + x1[1] * x1[1]) + (x1[2] * x1[2] + x1[3] * x1[3]); }
        ss += __shfl_xor(ss, 16); ss += __shfl_xor(ss, 32);
        const float rstd = rsqrtf(ss * (1.0f / D) + NORM_EPS);
        f32x4 acc[3];
#pragma unroll
        for (int cb = 0; cb < 3; ++cb) acc[cb] = (f32x4){0.f, 0.f, 0.f, 0.f};
#pragma unroll 2
        for (int ks = 0; ks < 64; ++ks) { const int c0 = ks * 32;
            const f32x4 x0 = *(const f32x4*)(hr + c0), x1 = *(const f32x4*)(hr + c0 + 4);
            const f32x4 w0 = *(const f32x4*)(nw + fq * 8 + c0), w1 = *(const f32x4*)(nw + fq * 8 + c0 + 4);
            const f32x4 h0 = *(const f32x4*)(md + c0), h1 = *(const f32x4*)(md + c0 + 4), s0 = *(const f32x4*)(md + 2048 + c0), s1 = *(const f32x4*)(md + 2048 + c0 + 4);
            const f32x4 u0 = (x0 * rstd * w0) * (s0 + 1.0f) + h0, u1 = (x1 * rstd * w1) * (s1 + 1.0f) + h1;
            u32x4 hi; hi.x = pk_bf16(u0[0], u0[1]); hi.y = pk_bf16(u0[2], u0[3]); hi.z = pk_bf16(u1[0], u1[1]); hi.w = pk_bf16(u1[2], u1[3]);
            *(u32x4*)(U + (size_t)row * D + fq * 8 + c0) = hi;
            u32x4 lo; lo.x = pk_bf16(u0[0] - bflo(hi.x), u0[1] - bfhi(hi.x)); lo.y = pk_bf16(u0[2] - bflo(hi.y), u0[3] - bfhi(hi.y)); lo.z = pk_bf16(u1[0] - bflo(hi.z), u1[1] - bfhi(hi.z)); lo.w = pk_bf16(u1[2] - bflo(hi.w), u1[3] - bfhi(hi.w));
            const bf16x8r_t ah = __builtin_bit_cast(bf16x8r_t, hi), al = __builtin_bit_cast(bf16x8r_t, lo);
#pragma unroll
            for (int cb = 0; cb < 3; ++cb) { const bf16x8r_t bh = *(const bf16x8r_t*)(Wh + (size_t)(cb * 16 + fr) * 2048 + c0 + fq * 8), bl = *(const bf16x8r_t*)(Wl + (size_t)(cb * 16 + fr) * 2048 + c0 + fq * 8);
                acc[cb] = __builtin_amdgcn_mfma_f32_16x16x32_bf16(ah, bh, acc[cb], 0, 0, 0); acc[cb] = __builtin_amdgcn_mfma_f32_16x16x32_bf16(ah, bl, acc[cb], 0, 0, 0); acc[cb] = __builtin_amdgcn_mfma_f32_16x16x32_bf16(al, bh, acc[cb], 0, 0, 0); } }
#pragma unroll
        for (int cb = 0; cb < 3; ++cb)
#pragma unroll
            for (int j = 0; j < 4; ++j) lt[(fq * 4 + j) * 48 + cb * 16 + fr] = acc[cb][j];
        asm volatile("s_waitcnt lgkmcnt(0)" ::: "memory");
        if (lane < 16) {
            const int r = tile * 16 + lane; float lg[36];
#pragma unroll
            for (int i = 0; i < 36; ++i) lg[i] = lt[lane * 48 + i];
            float gl[4]; int grp = 0; float gmax;
#pragma unroll
            for (int g = 0; g < 4; ++g) gl[g] = lg[g] + ain(a, I_BRG)[l * 4 + g];
            gmax = gl[0];
#pragma unroll
            for (int g = 1; g < 4; ++g) if (gl[g] > gmax) { gmax = gl[g]; grp = g; }
            float gden = 0.f;
#pragma unroll
            for (int g = 0; g < 4; ++g) gden += expf(gl[g] - gmax);
            const float ptop = 1.0f / gden;
            float le[8];
#pragma unroll
            for (int i = 0; i < 8; ++i) { float x = lg[4 + i];
#pragma unroll
                for (int g = 1; g < 4; ++g) x = (grp == g) ? lg[4 + g * 8 + i] : x;
                le[i] = x + ain(a, I_BRE)[l * 32 + grp * 8 + i]; }
            int i0 = 0; float m0 = le[0];
#pragma unroll
            for (int i = 1; i < 8; ++i) if (le[i] > m0) { m0 = le[i]; i0 = i; }
            int i1 = -1; float m1 = -3.0e38f;
#pragma unroll
            for (int i = 0; i < 8; ++i) if (i != i0 && le[i] > m1) { m1 = le[i]; i1 = i; }
            const float e1v = expf(m1 - m0);
            const float w0 = ptop / (1.0f + e1v), w1 = ptop * e1v / (1.0f + e1v);
            if (DRY) { asm volatile("" :: "v"(w0), "v"(w1), "v"(i0), "v"(i1), "v"(grp)); }
            else { unsigned* cnt = (unsigned*)(wsp(a) + WS_CTL) + CW_CNT + l * 64; const int ex0 = grp * 8 + i0, ex1 = grp * 8 + i1;
                const unsigned s0 = atomicAdd(cnt + ex0, 1u), s1 = atomicAdd(cnt + ex1, 1u);
                route[r * 8 + 0] = ex0; route[r * 8 + 1] = ex1; route[r * 8 + 2] = (int)s0; route[r * 8 + 3] = (int)s1; route[r * 8 + 4] = __float_as_int(w0); route[r * 8 + 5] = __float_as_int(w1); }
        }
        asm volatile("s_waitcnt lgkmcnt(0)" ::: "memory");
    }
}
DI void permute_phase(const Args& a, int l, int nrows, LAS unsigned char* ldsb) {
    LAS int* poff = (LAS int*)ldsb;
    const int tid = otid(), lane = tid & 63, wave = tid >> 6;
    const unsigned* cnt = (const unsigned*)(wsp(a) + WS_CTL) + CW_CNT + l * 64;
    if (tid == 0) { int off = 0; for (int e = 0; e < NEXP; ++e) { poff[e] = off; off += (int)((cnt[e] + 255u) / 256u) * 256; } poff[32] = off; }
    __syncthreads();
    if (obid() == 0) { int* tile_e = (int*)(wsp(a) + WS_TILEE); const int nt = poff[32] >> 8;
        if (tid < 200) { int e = -1; if (tid < nt) { for (int q = 0; q < NEXP; ++q) if (poff[q] <= tid * 256) e = q; } tile_e[tid] = e < 0 ? 0 : e; }
        if (tid == 0) tile_e[200] = nt; }
    int* route = (int*)(wsp(a) + WS_ROUTE); float* roww = (float*)(wsp(a) + WS_ROWW);
    const bf16* U = (const bf16*)(wsp(a) + WS_U); bf16* XP = (bf16*)(wsp(a) + WS_XP);
    for (int r = obid() * 8 + wave; r < nrows; r += ogdim() * 8) {
        const int e0 = route[r * 8 + 0], e1 = route[r * 8 + 1], s0 = route[r * 8 + 2], s1 = route[r * 8 + 3];
        const int p0 = poff[e0] + s0, p1 = poff[e1] + s1;
        u32x4 x[4];
#pragma unroll
        for (int i = 0; i < 4; ++i) x[i] = *(const u32x4*)(U + (size_t)r * D + (i * 64 + lane) * 8);
#pragma unroll
        for (int i = 0; i < 4; ++i) { *(u32x4*)(XP + (size_t)p0 * D + (i * 64 + lane) * 8) = x[i]; *(u32x4*)(XP + (size_t)p1 * D + (i * 64 + lane) * 8) = x[i]; }
        if (lane == 0) { route[r * 8 + 6] = p0; route[r * 8 + 7] = p1; roww[p0] = __int_as_float(route[r * 8 + 4]); roww[p1] = __int_as_float(route[r * 8 + 5]); }
    }
}
DI int stream_row(int p, int dir) { return dir == 0 ? (p < CTXL ? SEQ + p : p - CTXL) : (p < CTXL ? SEQ + (CTXL - 1 - p) : (SEQ - 1) - (p - CTXL)); }

DI void shortconv8(const bf16* Z, const float* cw, const float* cb, int l, int seg, int c, int r0, int lo, int hi, float (&out)[8]) {
    const int col = Z_HY + seg * 1024 + c; float zz[10];
#pragma unroll
    for (int i = 0; i < 10; ++i) { const int r = r0 - 1 + i; zz[i] = (r >= lo && r < hi) ? bf2f(Z[(size_t)r * ZC + col]) : 0.f; }
    const float w0 = cw[((size_t)l * 3 + 0) * 3072 + seg * 1024 + c], w1 = cw[((size_t)l * 3 + 1) * 3072 + seg * 1024 + c], w2 = cw[((size_t)l * 3 + 2) * 3072 + seg * 1024 + c], b = cb[(size_t)l * 3072 + seg * 1024 + c];
#pragma unroll
    for (int i = 0; i < 8; ++i) out[i] = w0 * zz[i] + w1 * zz[i + 1] + w2 * zz[i + 2] + b;
}
DI void hyprep_item(const Args& a, int l, int it, LAS float* t) {
    const int tid = otid(), tb = it >> 4, cb = it & 15, r0 = tb * 64, lo = r0 < SEQ ? 0 : SEQ, hi = r0 < SEQ ? SEQ : MT;
    const bf16* Z = (const bf16*)(wsp(a) + WS_Z); float* VXT = (float*)(wsp(a) + WS_U);
    { const int cc = tid & 63, tq = tid >> 6, c = cb * 64 + cc; float x1[8], vv[8];
      shortconv8(Z, ain(a, I_HYCW), ain(a, I_HYCB), l, 1, c, r0 + tq * 8, lo, hi, x1); shortconv8(Z, ain(a, I_HYCW), ain(a, I_HYCB), l, 2, c, r0 + tq * 8, lo, hi, vv);
#pragma unroll
      for (int i = 0; i < 8; ++i) t[cc * 65 + tq * 8 + i] = vv[i] * x1[i]; }
    __syncthreads();
    { const int cw = tid >> 3, t8 = tid & 7; f32x4 o0, o1;
#pragma unroll
      for (int i = 0; i < 4; ++i) { o0[i] = t[cw * 65 + t8 * 8 + i]; o1[i] = t[cw * 65 + t8 * 8 + 4 + i]; }
      float* dst = VXT + (size_t)(cb * 64 + cw) * MT + r0 + t8 * 8; *(f32x4*)dst = o0; *(f32x4*)(dst + 4) = o1; }
    __syncthreads();
}
DI void hycomb_item(const Args& a, int l, int it, LAS float* t) {
    const int tid = otid(), tb = it >> 4, cb = it & 15, r0 = tb * 64, lo = r0 < SEQ ? 0 : SEQ, hi = r0 < SEQ ? SEQ : MT;
    const bf16* Z = (const bf16*)(wsp(a) + WS_Z); const float* VXT = (const float*)(wsp(a) + WS_CVO); bf16* Y0 = (bf16*)(wsp(a) + WS_YMIX);
    { const int cw = tid >> 3, t8 = tid & 7; const float* srcp = VXT + (size_t)(cb * 64 + cw) * MT + r0 + t8 * 8; const f32x4 i0 = *(const f32x4*)srcp, i1 = *(const f32x4*)(srcp + 4);
#pragma unroll
      for (int i = 0; i < 4; ++i) { t[cw * 65 + t8 * 8 + i] = i0[i]; t[cw * 65 + t8 * 8 + 4 + i] = i1[i]; } }
    __syncthreads();
    { const int cc = tid & 63, tq = tid >> 6, c = cb * 64 + cc; float x0[8];
      shortconv8(Z, ain(a, I_HYCW), ain(a, I_HYCB), l, 0, c, r0 + tq * 8, lo, hi, x0);
#pragma unroll
      for (int i = 0; i < 8; ++i) Y0[(size_t)(r0 + tq * 8 + i) * 1024 + c] = f2bf(t[cc * 65 + tq * 8 + i] * x0[i]); }
    __syncthreads();
}
DI void scancomb_rows(const Args& a, int l, int nrows) {
    const int lane = otid() & 63, wave = otid() >> 6;
    const bf16* Z = (const bf16*)(wsp(a) + WS_Z); const float* O = (const float*)(wsp(a) + WS_OSC);
    bf16* Y1 = (bf16*)(wsp(a) + WS_YMIX) + (size_t)MT * 1024; bf16* Y2 = Y1 + (size_t)MT * 1024;
    for (int r = obid() * 8 + wave; r < nrows; r += ogdim() * 8) {
#pragma unroll
        for (int i = 0; i < 4; ++i) { const int col = i * 256 + lane * 4;
            { const f32x4 of = *(const f32x4*)(O + (size_t)r * 1024 + col), ob = *(const f32x4*)(O + ((size_t)MT + r) * 1024 + col); const f32x4 o = of + ob;
              float ss = (o[0] * o[0] + o[1] * o[1]) + (o[2] * o[2] + o[3] * o[3]);
              ss += __shfl_xor(ss, 16); ss += __shfl_xor(ss, 8); ss += __shfl_xor(ss, 4); ss += __shfl_xor(ss, 2); ss += __shfl_xor(ss, 1);
              const float rstd = rsqrtf(ss * (1.0f / 128.0f) + NORM_EPS);
              const f32x4 nw = *(const f32x4*)(ain(a, I_HGNW) + (size_t)l * 128 + (col & 127));
              const u32x2 g = *(const u32x2*)(Z + (size_t)r * ZC + Z_HG + 4096 + col);
              u32x2 w; w.x = pk_bf16(o[0] * rstd * nw[0] * sigmoidf_(bflo(g.x)), o[1] * rstd * nw[1] * sigmoidf_(bfhi(g.x)));
              w.y = pk_bf16(o[2] * rstd * nw[2] * sigmoidf_(bflo(g.y)), o[3] * rstd * nw[3] * sigmoidf_(bfhi(g.y)));
              *(u32x2*)(Y1 + (size_t)r * 1024 + col) = w; }
            { const f32x4 of = *(const f32x4*)(O + ((size_t)2 * MT + r) * 1024 + col), ob = *(const f32x4*)(O + ((size_t)3 * MT + r) * 1024 + col); const f32x4 o = of + ob;
              float ss = (o[0] * o[0] + o[1] * o[1]) + (o[2] * o[2] + o[3] * o[3]); ss = wave_sum(ss);
              const float rstd = rsqrtf(ss * (1.0f / 256.0f) + NORM_EPS);
              const f32x4 nw = *(const f32x4*)(ain(a, I_GLNW) + (size_t)l * 256 + (col & 255));
              const u32x2 g = *(const u32x2*)(Z + (size_t)r * ZC + Z_GL + 2048 + col);
              u32x2 w; w.x = pk_bf16(o[0] * rstd * nw[0] * siluf_(bflo(g.x)), o[1] * rstd * nw[1] * siluf_(bfhi(g.x)));
              w.y = pk_bf16(o[2] * rstd * nw[2] * siluf_(bflo(g.y)), o[3] * rstd * nw[3] * siluf_(bfhi(g.y)));
              *(u32x2*)(Y2 + (size_t)r * 1024 + col) = w; }
        }
    }
}
typedef short bf16x8_t __attribute__((ext_vector_type(8)));
constexpr int SC_N = 65;
constexpr size_t KVS_GL_OFF = (size_t)16 * SC_N * 16384;
constexpr size_t WS_KVS = WS_WGU;
constexpr size_t WS_KD  = WS_WGU + 130 * MiB;
constexpr int SL_QM = 0, SL_KM = 17408, SL_Q0 = 34816, SL_KE = 52224, SL_VT = 70656, SL_PP = 107520, SL_TOT = 116736, SL_DD = 118784, SL_AFB = 119296;
static_assert(SL_AFB + 2048 <= 131072 && WS_KD + (size_t)24 * SC_N * 128 * 4 <= WS_H, "scan maps");
DI bf16x8_t lds_frag16(LAS unsigned char* p) { return *(LAS bf16x8_t*)p; }
DI bf16x8_t pack_bf16x8(const f32x4& lo, const f32x4& hi) { u32x4 w; w.x = pk_bf16(lo[0], lo[1]); w.y = pk_bf16(lo[2], lo[3]); w.z = pk_bf16(hi[0], hi[1]); w.w = pk_bf16(hi[2], hi[3]); return __builtin_bit_cast(bf16x8_t, w); }

template <bool GLA, bool OUT> DI void scan_walk(const Args& a, int l, int head, int dir, int sc, int dvh, LAS unsigned char* lds) {
    constexpr int NB = 1, DV = GLA ? 256 : 128;
    const int tid = otid(), lane = tid & 63, wave = tid >> 6, fr = lane & 15, fq = lane >> 4, nbase = dvh * 8 + wave;
    const bf16* Z = (const bf16*)(wsp(a) + WS_Z);
    const int stream = GLA ? 16 + head * 2 + dir : head * 2 + dir;
    float* kvs = (float*)(wsp(a) + WS_KVS) + (GLA ? KVS_GL_OFF + ((size_t)(stream - 16) * SC_N + sc) * 32768 : ((size_t)stream * SC_N + sc) * 16384);
    float* kd = (float*)(wsp(a) + WS_KD) + ((size_t)stream * SC_N + sc) * 128;
    LAS bf16* QM = (LAS bf16*)(lds + SL_QM); LAS bf16* KM = (LAS bf16*)(lds + SL_KM); LAS float* EB = (LAS float*)(lds + SL_Q0);
    LAS bf16* KE = (LAS bf16*)(lds + SL_KE); LAS bf16* VT = (LAS bf16*)(lds + SL_VT); LAS bf16* PP = (LAS bf16*)(lds + SL_PP);
    LAS float* TOT = (LAS float*)(lds + SL_TOT); LAS float* DD = (LAS float*)(lds + SL_DD); LAS bf16* AFB = (LAS bf16*)(lds + SL_AFB);
    const int k = (wave & 1) * 64 + lane, seg = wave >> 1;
    float lbv = 0.f, ba = 0.f, wa[16];
    if (!GLA) lbv = ((const float*)(wsp(a) + WS_LB))[((size_t)l * 2 + dir) * 1024 + head * 128 + k];
    else { ba = ain(a, I_GLBA)[((size_t)l * 2 + dir) * 512 + head * 128 + k];
#pragma unroll
        for (int rr = 0; rr < 16; ++rr) wa[rr] = ain(a, I_GLWA2)[(((size_t)l * 2 + dir) * 16 + rr) * 512 + head * 128 + k]; }
    f32x4 S[NB][8];
#pragma unroll
    for (int nb = 0; nb < NB; ++nb)
#pragma unroll
        for (int mb = 0; mb < 8; ++mb) { if (OUT) S[nb][mb] = *(const f32x4*)(kvs + (size_t)((nbase + nb) * 16 + fr) * 128 + mb * 16 + fq * 4); else S[nb][mb] = (f32x4){0.f, 0.f, 0.f, 0.f}; }
    float dlog = 0.f;
    const int which = (GLA ? 2 : 0) + dir;
    float* Odir = (float*)(wsp(a) + WS_OSC) + (size_t)which * MT * 1024;
    const int srow = tid >> 3, spc = (tid & 7) * 16;
    const int vcol = (GLA ? Z_GL + 1024 + head * 256 + dvh * 128 : Z_HG + 3072 + head * 128) + wave * 16;
    const int fcol = (GLA ? Z_GL + 512 + head * 128 : Z_HG + 1024 * (1 + dir) + head * 128) + spc, qcol = (GLA ? Z_GL + head * 128 : Z_HG + head * 128) + spc;
    u32x4 pv0, pv1, pf0, pf1, pq0 = {0u, 0u, 0u, 0u}, pq1 = {0u, 0u, 0u, 0u}, pa = {0u, 0u, 0u, 0u};
#define SCAN_ISSUE(cidx) do { const int r0n_ = dir ? stream_row((cidx) * 64 + 63, 1) : stream_row((cidx) * 64, 0); \
        const bf16* vr_ = Z + (size_t)(r0n_ + lane) * ZC + vcol; pv0 = *(const u32x4*)vr_; pv1 = *(const u32x4*)(vr_ + 8); \
        const bf16* zr_ = Z + (size_t)(r0n_ + srow) * ZC; pf0 = *(const u32x4*)(zr_ + fcol); pf1 = *(const u32x4*)(zr_ + fcol + 8); \
        if (OUT) { pq0 = *(const u32x4*)(zr_ + qcol); pq1 = *(const u32x4*)(zr_ + qcol + 8); } \
        if (GLA && tid < 128) pa = *(const u32x4*)(Z + (size_t)(r0n_ + (tid >> 1)) * ZC + Z_LR + dir * 16 + (tid & 1) * 8); } while (0)
    SCAN_ISSUE(sc * 4);
    for (int cc = 0; cc < 4; ++cc) {
        const int c = sc * 4 + cc; const int r0 = dir ? stream_row(c * 64 + 63, 1) : stream_row(c * 64, 0);
        {
#pragma unroll
          for (int q8 = 0; q8 < 2; ++q8) { const u32x4 v = q8 ? pv1 : pv0; const int d0 = wave * 16 + q8 * 8;
              VT[(d0 + 0) * 72 + lane] = (bf16)(v.x & 0xffff); VT[(d0 + 1) * 72 + lane] = (bf16)(v.x >> 16); VT[(d0 + 2) * 72 + lane] = (bf16)(v.y & 0xffff); VT[(d0 + 3) * 72 + lane] = (bf16)(v.y >> 16);
              VT[(d0 + 4) * 72 + lane] = (bf16)(v.z & 0xffff); VT[(d0 + 5) * 72 + lane] = (bf16)(v.z >> 16); VT[(d0 + 6) * 72 + lane] = (bf16)(v.w & 0xffff); VT[(d0 + 7) * 72 + lane] = (bf16)(v.w >> 16); }
          *(LAS u32x4*)(KM + srow * 136 + spc) = pf0; *(LAS u32x4*)(KM + srow * 136 + spc + 8) = pf1;
          if (OUT) { *(LAS u32x4*)(QM + srow * 136 + spc) = pq0; *(LAS u32x4*)(QM + srow * 136 + spc + 8) = pq1; }
          if (GLA && tid < 128) *(LAS u32x4*)(AFB + (tid >> 1) * 16 + (tid & 1) * 8) = pa;
          if (cc < 3) SCAN_ISSUE(c + 1); }
        __syncthreads();
        const int tstart = dir ? 63 - seg * 16 : seg * 16, tstep = dir ? -1 : 1;
        float cs[16], kkv[GLA ? 1 : 16]; float run = 0.f;
#pragma unroll
        for (int i = 0; i < 16; ++i) { const int t = tstart + i * tstep; float la;
            if (!GLA) { const float zf = bf2f(KM[t * 136 + k]); const float sg = sigmoidf_(zf); la = __logf(lbv + (1.0f - lbv) * sg); kkv[i] = (1.0f - lbv) * (1.0f - sg); }
            else { float x = ba; const u32x4 a0 = *(LAS u32x4*)(AFB + t * 16), a1 = *(LAS u32x4*)(AFB + t * 16 + 8);
                x += bflo(a0.x) * wa[0] + bfhi(a0.x) * wa[1] + bflo(a0.y) * wa[2] + bfhi(a0.y) * wa[3] + bflo(a0.z) * wa[4] + bfhi(a0.z) * wa[5] + bflo(a0.w) * wa[6] + bfhi(a0.w) * wa[7];
                x += bflo(a1.x) * wa[8] + bfhi(a1.x) * wa[9] + bflo(a1.y) * wa[10] + bfhi(a1.y) * wa[11] + bflo(a1.z) * wa[12] + bfhi(a1.z) * wa[13] + bflo(a1.w) * wa[14] + bfhi(a1.w) * wa[15];
                la = (fminf(x, 0.f) - log1pf(__expf(-fabsf(x)))) * 0.0625f; }
            run += la; cs[i] = run; if (GLA || (i & 3) == 3) asm volatile("" ::: "memory"); }
        TOT[seg * 128 + k] = run;
        __syncthreads();
        { const float t0 = TOT[k], t1 = TOT[128 + k], t2 = TOT[256 + k], t3 = TOT[384 + k];
          const float off = seg == 0 ? 0.f : (seg == 1 ? t0 : (seg == 2 ? t0 + t1 : t0 + t1 + t2)), blast = (t0 + t1) + (t2 + t3), bref = t0 + t1;
          float ke[16];
#pragma unroll
          for (int i = 0; i < 16; ++i) { const int t = tstart + i * tstep; const float b = off + cs[i];
              float kk; if (GLA) kk = bf2f(KM[t * 136 + k]); else kk = kkv[i];
              if (OUT) { const float qr = bf2f(QM[t * 136 + k]); const float qv = GLA ? qr * 0.08838834764831845f : siluf_(qr);
                  QM[t * 136 + k] = f2bf(qv * __expf(b - bref)); KM[t * 136 + k] = f2bf(kk * __expf(bref - b)); }
              ke[i] = kk * __expf(blast - b); if ((i & 3) == 3) asm volatile("" ::: "memory"); }
          if (OUT && seg == 0) EB[k] = __expf(bref);
          const int tb0 = dir ? 48 - seg * 16 : seg * 16; u32x4 w0, w1;
          if (dir) { w0.x = pk_bf16(ke[15], ke[14]); w0.y = pk_bf16(ke[13], ke[12]); w0.z = pk_bf16(ke[11], ke[10]); w0.w = pk_bf16(ke[9], ke[8]); w1.x = pk_bf16(ke[7], ke[6]); w1.y = pk_bf16(ke[5], ke[4]); w1.z = pk_bf16(ke[3], ke[2]); w1.w = pk_bf16(ke[1], ke[0]); }
          else     { w0.x = pk_bf16(ke[0], ke[1]); w0.y = pk_bf16(ke[2], ke[3]); w0.z = pk_bf16(ke[4], ke[5]); w0.w = pk_bf16(ke[6], ke[7]); w1.x = pk_bf16(ke[8], ke[9]); w1.y = pk_bf16(ke[10], ke[11]); w1.z = pk_bf16(ke[12], ke[13]); w1.w = pk_bf16(ke[14], ke[15]); }
          *(LAS u32x4*)(KE + k * 72 + tb0) = w0; *(LAS u32x4*)(KE + k * 72 + tb0 + 8) = w1;
          if (seg == 0) DD[k] = __expf(blast);
          dlog += blast; }
        __syncthreads();
        bf16x8_t Bv[NB][2];
#pragma unroll
        for (int nb = 0; nb < NB; ++nb)
#pragma unroll
            for (int ks = 0; ks < 2; ++ks) Bv[nb][ks] = lds_frag16(lds + SL_VT + ((wave * 16 + fr) * 72 + ks * 32 + fq * 8) * 2);
        if (OUT) {
            { const int tb = wave >> 1;
#pragma unroll
              for (int sbi = 0; sbi < 2; ++sbi) { const int sb = (wave & 1) * 2 + sbi; f32x4 acc = {0.f, 0.f, 0.f, 0.f};
#pragma unroll
                  for (int ks = 0; ks < 4; ++ks) acc = __builtin_amdgcn_mfma_f32_16x16x32_bf16(lds_frag16(lds + SL_QM + ((tb * 16 + fr) * 136 + ks * 32 + fq * 8) * 2), lds_frag16(lds + SL_KM + ((sb * 16 + fr) * 136 + ks * 32 + fq * 8) * 2), acc, 0, 0, 0);
#pragma unroll
                  for (int j = 0; j < 4; ++j) { const int t = tb * 16 + fq * 4 + j, s = sb * 16 + fr; const bool keep = dir ? (s >= t) : (s <= t); PP[t * 72 + s] = keep ? f2bf(acc[j]) : (bf16)0; } } }
            __syncthreads();
#pragma unroll
            for (int nb = 0; nb < NB; ++nb) {
                bf16x8_t Bs[4];
#pragma unroll
                for (int ks = 0; ks < 4; ++ks) { const f32x4 e0 = *(LAS f32x4*)(EB + (2 * ks) * 16 + fq * 4), e1 = *(LAS f32x4*)(EB + (2 * ks + 1) * 16 + fq * 4); Bs[ks] = pack_bf16x8(S[nb][2 * ks] * e0, S[nb][2 * ks + 1] * e1); }
#pragma unroll
                for (int mb = 0; mb < 4; ++mb) {
                    f32x4 O = {0.f, 0.f, 0.f, 0.f};
#pragma unroll
                    for (int ks = 0; ks < 2; ++ks) O = __builtin_amdgcn_mfma_f32_16x16x32_bf16(lds_frag16(lds + SL_PP + ((mb * 16 + fr) * 72 + ks * 32 + fq * 8) * 2), Bv[nb][ks], O, 0, 0, 0);
#pragma unroll
                    for (int ks = 0; ks < 4; ++ks) { u32x4 aw; const u32x2 lo = *(LAS u32x2*)(lds + SL_QM + ((mb * 16 + fr) * 136 + (2 * ks) * 16 + fq * 4) * 2), hi = *(LAS u32x2*)(lds + SL_QM + ((mb * 16 + fr) * 136 + (2 * ks + 1) * 16 + fq * 4) * 2);
                        aw.x = lo.x; aw.y = lo.y; aw.z = hi.x; aw.w = hi.y;
                        O = __builtin_amdgcn_mfma_f32_16x16x32_bf16(__builtin_bit_cast(bf16x8_t, aw), Bs[ks], O, 0, 0, 0); }
#pragma unroll
                    for (int j = 0; j < 4; ++j) Odir[(size_t)(r0 + mb * 16 + fq * 4 + j) * 1024 + head * DV + (nbase + nb) * 16 + fr] = O[j];
                    asm volatile("" ::: "memory");
                }
            }
        }
        if (!OUT || cc < 3) {
#pragma unroll
            for (int mb = 0; mb < 8; ++mb) { const f32x4 dd = *(LAS f32x4*)(DD + mb * 16 + fq * 4);
                const bf16x8_t A0 = lds_frag16(lds + SL_KE + ((mb * 16 + fr) * 72 + fq * 8) * 2), A1 = lds_frag16(lds + SL_KE + ((mb * 16 + fr) * 72 + 32 + fq * 8) * 2);
#pragma unroll
                for (int nb = 0; nb < NB; ++nb) { S[nb][mb] = S[nb][mb] * dd; S[nb][mb] = __builtin_amdgcn_mfma_f32_16x16x32_bf16(A0, Bv[nb][0], S[nb][mb], 0, 0, 0); S[nb][mb] = __builtin_amdgcn_mfma_f32_16x16x32_bf16(A1, Bv[nb][1], S[nb][mb], 0, 0, 0); }
                asm volatile("" ::: "memory"); }
        }
        __syncthreads();
    }
    if (!OUT) {
#pragma unroll
        for (int nb = 0; nb < NB; ++nb)
#pragma unroll
            for (int mb = 0; mb < 8; ++mb) *(f32x4*)(kvs + (size_t)((nbase + nb) * 16 + fr) * 128 + mb * 16 + fq * 4) = S[nb][mb];
        if (seg == 0) kd[k] = __expf(dlog);
    }
}
#undef SCAN_ISSUE
DI void scan_prop(const Args& a) {
    float* kvs = (float*)(wsp(a) + WS_KVS); const float* kd = (const float*)(wsp(a) + WS_KD);
    for (int g = obid() * NTHR + otid(); g < 131072; g += ogdim() * NTHR) {
        float* p; size_t stride; const float* dp;
        if (g < 65536) { const int stream = g >> 12, e = g & 4095; p = kvs + (size_t)stream * SC_N * 16384 + (size_t)e * 4; stride = 16384; dp = kd + (size_t)stream * SC_N * 128 + (e & 31) * 4; }
        else { const int q = g - 65536, stream = q >> 13, e = q & 8191; p = kvs + KVS_GL_OFF + (size_t)stream * SC_N * 32768 + (size_t)e * 4; stride = 32768; dp = kd + (size_t)(16 + stream) * SC_N * 128 + (e & 31) * 4; }
        f32x4 S = {0.f, 0.f, 0.f, 0.f};
#pragma unroll 5
        for (int sc = 0; sc < SC_N; ++sc) { const f32x4 kv = *(const f32x4*)(p + sc * stride), d = *(const f32x4*)(dp + sc * 128); *(f32x4*)(p + sc * stride) = S; S = d * S + kv; }
    }
}
constexpr int SCAN_ITEMS = 32 * SC_N;
template <bool OUT> DI void scan_item2(const Args& a, int l, int it, LAS unsigned char* lds) {
    if (it < 16 * SC_N) { const int s = it / SC_N, sc = it % SC_N; if (OUT && l == DEPTH - 1 && sc == 0) return; scan_walk<true, OUT>(a, l, s >> 2, (s >> 1) & 1, sc, s & 1, lds); }
    else { const int j = it - 16 * SC_N, s = j / SC_N, sc = j % SC_N; if (OUT && l == DEPTH - 1 && sc == 0) return; scan_walk<false, OUT>(a, l, s >> 1, s & 1, sc, 0, lds); }
}
DI void hyconv_item(const Args& a, int l, int c, LAS unsigned char* ldsb) {
    const int tid = otid();
    LAS float* lds = (LAS float*)ldsb;
    LAS float* xs = (LAS float*)(ldsb + LDS_X);
    const float* tw = (const float*)(wsp(a) + WS_TW); const float* tw2 = (const float*)(wsp(a) + WS_TW2);
    const float* h2 = (const float*)(wsp(a) + WS_H2) + (size_t)l * MT * 64;
    const float* VX = (const float*)(wsp(a) + WS_U) + (size_t)c * MT; float* VO = (float*)(wsp(a) + WS_CVO) + (size_t)c * MT;
    const float* HFf = (const float*)(wsp(a) + WS_HF) + (size_t)c * SEQ; const float* HFb = HFf + (size_t)1024 * SEQ;
    const float a0 = -4.605170186f / 1.5f, a1 = -4.605170186f / 0.3f;
    const float nd = -fabsf(a0 + (float)c * ((a1 - a0) / 1023.0f)) * (1.0f / (float)(SEQ - 1));
    const float b3f = ain(a, I_HYB3)[l * 2048 + c], b3b = ain(a, I_HYB3)[l * 2048 + 1024 + c];
    float sf = 0.f, sb = 0.f;
    for (int i = 0; i < 8; ++i) { const int t4 = (tid + 512 * i) * 4; f32x4 hf = *(const f32x4*)(HFf + t4), hb = *(const f32x4*)(HFb + t4);
#pragma unroll
        for (int q = 0; q < 4; ++q) { const float dec = __expf(nd * (float)(t4 + q)) + 0.05f; hf[q] = (hf[q] + b3f) * dec; hb[q] = (hb[q] + b3b) * dec; }
        sf += (fabsf(hf[0]) + fabsf(hf[1])) + (fabsf(hf[2]) + fabsf(hf[3])); sb += (fabsf(hb[0]) + fabsf(hb[1])) + (fabsf(hb[2]) + fabsf(hb[3]));
        *(LAS f32x4*)(lds + t4) = hf;
#pragma unroll
        for (int q = 0; q < 4; ++q) { const int t = t4 + q; if (t > 0) lds[32768 - t] = hb[q]; else xs[160] = hb[q]; } }
    sf = wave_sum(sf); sb = wave_sum(sb);
    if ((tid & 63) == 0) { xs[128 + (tid >> 6)] = sf; xs[136 + (tid >> 6)] = sb; }
    __syncthreads();
    float tf = 0.f, tb = 0.f;
#pragma unroll
    for (int w = 0; w < 8; ++w) { tf += xs[128 + w]; tb += xs[136 + w]; }
    const float inf_ = 1.0f / tf, inb_ = 1.0f / tb;
    for (int i = 0; i < 64; ++i) { const int m = tid + 512 * i; float v = lds[m];
        if (m == 0) v = v * inf_ + xs[160] * inb_ + ain(a, I_HYSKIP)[l * 1024 + c];
        else if (m < SEQ) v *= inf_; else if (m == SEQ) v = 0.f; else v *= inb_;
        lds[m] = v; }
    __syncthreads();
    fft_fwd_pass<4096>(lds, tw, tid); __syncthreads(); fft_fwd_pass<1024>(lds, tw, tid); __syncthreads(); fft_fwd_pass<256>(lds, tw, tid); __syncthreads(); fft_fwd_pass<64>(lds, tw, tid); __syncthreads();
    fft_fwd_pass<16>(lds, tw, tid); __syncthreads(); fft_fwd_pass<4>(lds, tw, tid); __syncthreads(); fft_fwd_pass<1>(lds, tw, tid); __syncthreads();
    float* Gs = (float*)(wsp(a) + WS_YMIX) + (size_t)obid() * 32768;
#pragma unroll 1
    for (int j = 0; j < 16; ++j) { const int k = tid + 512 * j; cpx gk, gm; rfft_untangle(lds, tw2, k, gk, gm); f32x4 g4; g4[0] = gk.x; g4[1] = gk.y; g4[2] = gm.x; g4[3] = gm.y; *(f32x4*)(Gs + (size_t)k * 4) = g4; }
    __syncthreads();
    for (int i = 0; i < 16; ++i) { const int m4 = tid + 512 * i; f32x4 v = {0.f, 0.f, 0.f, 0.f}; if (m4 < SEQ / 4) v = *(const f32x4*)(VX + m4 * 4); *(LAS f32x4*)(lds + m4 * 4) = v; }
    __syncthreads();
    fft_fwd_pass<4096>(lds, tw, tid); __syncthreads(); fft_fwd_pass<1024>(lds, tw, tid); __syncthreads(); fft_fwd_pass<256>(lds, tw, tid); __syncthreads(); fft_fwd_pass<64>(lds, tw, tid); __syncthreads();
    fft_fwd_pass<16>(lds, tw, tid); __syncthreads(); fft_fwd_pass<4>(lds, tw, tid); __syncthreads(); fft_fwd_pass<1>(lds, tw, tid); __syncthreads();
#pragma unroll 1
    for (int j = 0; j < 16; ++j) { const int k = tid + 512 * j; const f32x4 g4 = *(const f32x4*)(Gs + (size_t)k * 4); cpx gk, gm; gk.x = g4[0]; gk.y = g4[1]; gm.x = g4[2]; gm.y = g4[3]; rfft_mul_retangle(lds, tw2, k, gk, gm); }
    __syncthreads();
    fft_inv_pass<1>(lds, tw, tid); __syncthreads(); fft_inv_pass<4>(lds, tw, tid); __syncthreads(); fft_inv_pass<16>(lds, tw, tid); __syncthreads(); fft_inv_pass<64>(lds, tw, tid); __syncthreads();
    fft_inv_pass<256>(lds, tw, tid); __syncthreads(); fft_inv_pass<1024>(lds, tw, tid); __syncthreads(); fft_inv_pass<4096>(lds, tw, tid); __syncthreads();
    for (int i = 0; i < 8; ++i) { const int m4 = tid + 512 * i; f32x4 v = *(const LAS f32x4*)(lds + m4 * 4); *(f32x4*)(VO + m4 * 4) = v * (1.0f / FFT_M); }
    __syncthreads();
}
DI void hycctx_item(const Args& a, int l, int it, LAS unsigned char* ldsb) {
    const int tid = otid(), c0 = it * 16;
    LAS float* sv = (LAS float*)ldsb;
    LAS float* sf = sv + 16 * 256;
    LAS float* sb = sf + 16 * 256;
    const float* hyc = (const float*)(wsp(a) + WS_HYC); const float* VXT = (const float*)(wsp(a) + WS_U); float* CVO = (float*)(wsp(a) + WS_CVO);
    for (int i = tid; i < 16 * 256; i += NTHR) { const int ch = i >> 8, t = i & 255; sv[i] = VXT[(size_t)(c0 + ch) * MT + SEQ + t]; sf[i] = hyc[(size_t)(c0 + ch) * 256 + t]; sb[i] = hyc[(size_t)(1024 + c0 + ch) * 256 + t]; }
    __syncthreads();
    const int ch = tid >> 5, tq = tid & 31; const float g0 = sf[ch * 256] + sb[ch * 256] + ain(a, I_HYSKIP)[l * 1024 + c0 + ch];
    float acc[8];
#pragma unroll
    for (int i = 0; i < 8; ++i) acc[i] = 0.f;
    for (int s = 0; s < 256; ++s) { const float vv = sv[ch * 256 + s];
#pragma unroll
        for (int i = 0; i < 8; ++i) { const int d = tq * 8 + i - s; const float g = d > 0 ? sf[ch * 256 + d] : (d < 0 ? sb[ch * 256 - d] : g0); acc[i] += g * vv; } }
    __syncthreads();
#pragma unroll
    for (int i = 0; i < 8; ++i) CVO[(size_t)(c0 + ch) * MT + SEQ + tq * 8 + i] = acc[i];
    __syncthreads();
}

struct EpiHF {
    static constexpr bool PERM = false, AFTER_DRAIN = false; float* O;
    DI void operator()(const f32x4 (&acc)[2][2][4][2], const pg8::Unit& u, int wr, int wc, int fr, int fq) const {
        const int row0 = u.pm * 256 + wr * 64 + fr, col0 = u.pn * 256 + wc * 32 + 4 * fq;
#pragma unroll
        for (int ai = 0; ai < 2; ++ai)
#pragma unroll
            for (int m = 0; m < 4; ++m) { float* rowp = O + (size_t)(row0 + ai * 128 + m * 16) * SEQ + col0;
#pragma unroll
                for (int bj = 0; bj < 2; ++bj)
#pragma unroll
                    for (int n = 0; n < 2; ++n) *(f32x4*)(rowp + bj * 128 + n * 16) = acc[ai][bj][m][n]; }
    }
};
struct EpiZ {
    static constexpr bool PERM = true, AFTER_DRAIN = false; bf16* O; const float* bias;
    DI void operator()(const f32x4 (&acc)[2][2][4][2], const pg8::Unit& u, int wr, int wc, int fr, int fq) const {
        const int row0 = u.pm * 256 + wr * 64 + fr, col0 = u.pn * 256 + wc * 32 + 8 * fq;
        f32x4 bv[2][2];
#pragma unroll
        for (int bj = 0; bj < 2; ++bj)
#pragma unroll
            for (int n = 0; n < 2; ++n) bv[bj][n] = *(const f32x4*)(bias + col0 + bj * 128 + 4 * n);
#pragma unroll
        for (int ai = 0; ai < 2; ++ai)
#pragma unroll
            for (int m = 0; m < 4; ++m) { bf16* rowp = O + (size_t)(row0 + ai * 128 + m * 16) * ZC + col0;
#pragma unroll
                for (int bj = 0; bj < 2; ++bj) { const f32x4 v0 = acc[ai][bj][m][0] + bv[bj][0], v1 = acc[ai][bj][m][1] + bv[bj][1];
                    u32x4 w; w.x = pk_bf16(v0[0], v0[1]); w.y = pk_bf16(v0[2], v0[3]); w.z = pk_bf16(v1[0], v1[1]); w.w = pk_bf16(v1[2], v1[3]);
                    *(u32x4*)(rowp + bj * 128) = w; } }
    }
};
template <int BR> struct EpiBr {
    static constexpr bool PERM = true, AFTER_DRAIN = false; bf16* Mg; const bf16* Zg;
    DI void operator()(const f32x4 (&acc)[2][2][4][2], const pg8::Unit& u, int wr, int wc, int fr, int fq) const {
        const int row0 = u.pm * 256 + wr * 64 + fr, col0 = u.pn * 256 + wc * 32 + 8 * fq;
#pragma unroll
        for (int ai = 0; ai < 2; ++ai)
#pragma unroll
            for (int m = 0; m < 4; ++m) { const size_t row = (size_t)(row0 + ai * 128 + m * 16);
#pragma unroll
                for (int bj = 0; bj < 2; ++bj) { const int col = col0 + bj * 128;
                    const u32x4 g = *(const u32x4*)(Zg + row * ZC + col);
                    f32x4 v0 = acc[ai][bj][m][0], v1 = acc[ai][bj][m][1];
                    v0[0] *= sigmoidf_(bflo(g.x)); v0[1] *= sigmoidf_(bfhi(g.x)); v0[2] *= sigmoidf_(bflo(g.y)); v0[3] *= sigmoidf_(bfhi(g.y));
                    v1[0] *= sigmoidf_(bflo(g.z)); v1[1] *= sigmoidf_(bfhi(g.z)); v1[2] *= sigmoidf_(bflo(g.w)); v1[3] *= sigmoidf_(bfhi(g.w));
                    if (BR > 0) { const u32x4 p = *(const u32x4*)(Mg + row * D + col);
                        v0[0] += bflo(p.x); v0[1] += bfhi(p.x); v0[2] += bflo(p.y); v0[3] += bfhi(p.y); v1[0] += bflo(p.z); v1[1] += bfhi(p.z); v1[2] += bflo(p.w); v1[3] += bfhi(p.w); }
                    u32x4 w; w.x = pk_bf16(v0[0], v0[1]); w.y = pk_bf16(v0[2], v0[3]); w.z = pk_bf16(v1[0], v1[1]); w.w = pk_bf16(v1[2], v1[3]);
                    *(u32x4*)(Mg + row * D + col) = w; } }
    }
};
struct EpiOut {
    static constexpr bool PERM = false, AFTER_DRAIN = false; const float* hin_main; const float* hin_ctx; float* hout; const float* gt1;
    DI void operator()(const f32x4 (&acc)[2][2][4][2], const pg8::Unit& u, int wr, int wc, int fr, int fq) const {
        const int row0 = u.pm * 256 + wr * 64 + fr, col0 = u.pn * 256 + wc * 32 + 4 * fq; const bool isctx = u.pm >= SEQ / 256;
        const float* g = gt1 + (isctx ? 12288 : 0);
        f32x4 gv[2][2];
#pragma unroll
        for (int bj = 0; bj < 2; ++bj)
#pragma unroll
            for (int n = 0; n < 2; ++n) gv[bj][n] = *(const f32x4*)(g + col0 + bj * 128 + n * 16);
#pragma unroll
        for (int ai = 0; ai < 2; ++ai)
#pragma unroll
            for (int m = 0; m < 4; ++m) { const int row = row0 + ai * 128 + m * 16;
                const float* ip = (isctx ? hin_ctx + (size_t)(row - SEQ) * D : hin_main + (size_t)row * D) + col0; float* op = hout + (size_t)row * D + col0;
#pragma unroll
                for (int bj = 0; bj < 2; ++bj)
#pragma unroll
                    for (int n = 0; n < 2; ++n) { const f32x4 b = *(const f32x4*)(ip + bj * 128 + n * 16); *(f32x4*)(op + bj * 128 + n * 16) = b + gv[bj][n] * acc[ai][bj][m][n]; } }
    }
};
struct EpiGU {
    static constexpr bool PERM = true, AFTER_DRAIN = false; bf16* Hm;
    DI void operator()(const f32x4 (&acc)[2][2][4][2], const pg8::Unit& u, int wr, int wc, int fr, int fq) const {
        const int row0 = u.pm * 256 + wr * 64 + fr, col0 = (u.pn & 3) * 128 + wc * 32 + 8 * fq;
#pragma unroll
        for (int ai = 0; ai < 2; ++ai)
#pragma unroll
            for (int m = 0; m < 4; ++m) { const f32x4 g0 = acc[ai][0][m][0], g1 = acc[ai][0][m][1], u0 = acc[ai][1][m][0], u1 = acc[ai][1][m][1];
                u32x4 w; w.x = pk_bf16(siluf_(g0[0]) * u0[0], siluf_(g0[1]) * u0[1]); w.y = pk_bf16(siluf_(g0[2]) * u0[2], siluf_(g0[3]) * u0[3]);
                w.z = pk_bf16(siluf_(g1[0]) * u1[0], siluf_(g1[1]) * u1[1]); w.w = pk_bf16(siluf_(g1[2]) * u1[2], siluf_(g1[3]) * u1[3]);
                *(u32x4*)(Hm + (size_t)(row0 + ai * 128 + m * 16) * DFF + col0) = w; }
    }
};
struct EpiDn {
    static constexpr bool PERM = true, AFTER_DRAIN = false; bf16* Y; const float* roww;
    DI void operator()(const f32x4 (&acc)[2][2][4][2], const pg8::Unit& u, int wr, int wc, int fr, int fq) const {
        const int row0 = u.pm * 256 + wr * 64 + fr, col0 = (u.pn & 7) * 256 + wc * 32 + 8 * fq;
#pragma unroll
        for (int ai = 0; ai < 2; ++ai)
#pragma unroll
            for (int m = 0; m < 4; ++m) { const int row = row0 + ai * 128 + m * 16; const float rw = roww[row];
#pragma unroll
                for (int bj = 0; bj < 2; ++bj) { const f32x4 v0 = acc[ai][bj][m][0] * rw, v1 = acc[ai][bj][m][1] * rw;
                    u32x4 w; w.x = pk_bf16(v0[0], v0[1]); w.y = pk_bf16(v0[2], v0[3]); w.z = pk_bf16(v1[0], v1[1]); w.w = pk_bf16(v1[2], v1[3]);
                    *(u32x4*)(Y + (size_t)row * D + col0 + bj * 128) = w; } }
    }
};
struct MoeOrder {
    const int* tile_e; int ntiles, nsub, G, c;
    DI bool next(int i, pg8::Unit& u) const { const int j = i * G + c; if (j >= ntiles * nsub) return false; const int ti = j / nsub; u.pm = ti; u.pn = tile_e[ti] * nsub + (j - ti * nsub); return true; }
    DI void a_ready(const pg8::Unit&) const {}
    DI void done(const pg8::Unit&) const {}
};
constexpr int NPH_LAYER = 13, PH_FINAL = 1 + NPH_LAYER * DEPTH, NPHASES = PH_FINAL + 1;
struct KArgs { Args a; int li, pad; };
__global__ void __launch_bounds__(NTHR, 2) fwd_kernel(KArgs ka) {
    const Args& a = ka.a;
    const int tid = otid();
#define bid ((int)obid())
#define G ((int)ogdim())
    if (tid == 0) { ((LAS unsigned*)(ldsbase() + LDS_BARW))[0] = 0u; ((LAS unsigned*)(ldsbase() + LDS_BARW))[1] = 0u;
        LAS unsigned long long* ptab = (LAS unsigned long long*)(ldsbase() + LDS_PTAB);
#pragma unroll
        for (int i = 0; i < N_IN; ++i) ptab[i] = (unsigned long long)ka.a.in[i]; }
    __syncthreads();
    XcdBarrier bar = xcd_barrier_post((unsigned*)(wsp(a) + WS_CTL) + CW_BAR + ka.li * XCD_BAR_WORDS, (volatile LAS unsigned*)(ldsbase() + LDS_BARW));
    const int lo = a.ph_lo, hi = a.ph_hi;
#ifndef PHMASK
#define PHMASK 0xFFFF
#endif
#define EN(i) (((PHMASK) >> (i)) & 1)
#ifndef REPMASK
#define REPMASK 0
#endif
#define REP(i) (((REPMASK) >> (i)) & 1)
#define RUN(i, cond, ...) do { _Pragma("unroll 1") for (int rep_ = 0; rep_ < ((REP(i) && (cond)) ? REPN : 1); ++rep_) { if (rep_) __syncthreads(); __VA_ARGS__; } } while (0)
#ifndef REPN
#define REPN 2
#endif
#define IN(k) (opq(lo) <= (k) && (k) < opq(hi))
#define SEAM(k) do { if (IN(k) && IN((k) + 1)) xcd_barrier(bar); } while (0)
#define ws wsp(a)
#define lds ldsbase()
#define ldsf ((LAS float*)ldsbase())
#define U ((bf16*)(wsp(a) + WS_U))
#define Z ((bf16*)(wsp(a) + WS_Z))
#define H ((float*)(wsp(a) + WS_H))
#define modall ((const float*)(wsp(a) + WS_MOD))

    if (EN(0) && IN(0)) {
        RUN(0, true, prologue_small(a);
        for (int it = bid; it < 256; it += G) mod_item(a, it, ldsf);
        for (int it = bid; it < DEPTH * (MT / 8); it += G) h2_item(a, it, ldsf));
    }
    SEAM(0);
    for (int l = 0; l < DEPTH; ++l) {
        const int pb = 1 + NPH_LAYER * l;
        const int nrows = (l == 0) ? MT : SEQ;
        if (EN(1) && IN(pb + 0)) {
            RUN(1, l == 0, norm_phase<0>(a, l, MT, ldsf));
            RUN(16, true, if (l == 0) hyc_filters(a, 0));
            RUN(2, true, for (int it = bid; it < CVT_MIX_TILES; it += G) cvt_mix_item(a, l, it, ldsf));
        }
        SEAM(pb + 0);
        if (EN(2) && IN(pb + 1)) {
            pg8::Gemm g{U, (const bf16*)(ws + WS_WIN), MT, ZC, D}; pg8::StaticOrder S; S.init(MT, ZC, G, bid);
            EpiZ E{Z, (const float*)(ws + WS_ZBIAS) + (size_t)l * ZC};
            RUN(3, true, pg8::gemm_phase<EpiZ, pg8::StaticOrder, true, true>(lds, g, S, E));
        }
        SEAM(pb + 1);
        if (EN(3) && IN(pb + 2)) { const int nit = (nrows / 64) * 16; RUN(4, true, for (int it = bid; it < nit; it += G) hyprep_item(a, l, it, ldsf));
            __syncthreads();
            pg8::Gemm g{(const bf16*)(ws + WS_W3T) + (size_t)l * 2048 * 256, (const bf16*)(ws + WS_H2B) + (size_t)l * SEQ * 256, 2048, SEQ, 256}; pg8::StaticOrder S; S.init(2048, SEQ, G, bid);
            EpiHF E{(float*)(ws + WS_HF)};
            RUN(18, true, pg8::gemm_phase<EpiHF, pg8::StaticOrder, true, true>(lds, g, S, E)); }
        SEAM(pb + 2);
        if (EN(4) && IN(pb + 3)) {
            RUN(5, true, for (int it = bid; it < SCAN_ITEMS; it += G) scan_item2<false>(a, l, it, lds));
            RUN(6, true, for (int c = bid; c < 1024; c += G) hyconv_item(a, l, c, lds));
            RUN(15, true, if (l == 0) for (int it = bid; it < 64; it += G) hycctx_item(a, l, it, lds));
        }
        SEAM(pb + 3);
        if (EN(13) && IN(pb + 4)) { scan_prop(a); if (REP(20)) { __syncthreads(); scan_prop(a); scan_prop(a); } }
        SEAM(pb + 4);
        if (EN(14) && IN(pb + 5)) { RUN(17, true, for (int it = bid; it < SCAN_ITEMS; it += G) scan_item2<true>(a, l, it, lds)); }
        SEAM(pb + 5);
        if (EN(5) && IN(pb + 6)) {
            const int nit = (nrows / 64) * 16;
            RUN(7, true, scancomb_rows(a, l, nrows); for (int it = bid; it < nit; it += G) hycomb_item(a, l, it, ldsf));
        }
        SEAM(pb + 6);
        if (EN(6) && IN(pb + 7)) {
            const bf16* Y = (const bf16*)(ws + WS_YMIX); const bf16* WB = (const bf16*)(ws + WS_WBR);
            pg8::StaticOrder S; S.init(nrows, D, G, bid);
            RUN(8, true,
            { pg8::Gemm g{Y, WB, nrows, D, 1024}; EpiBr<0> E{U, Z + Z_MG}; pg8::gemm_phase<EpiBr<0>, pg8::StaticOrder, true, true>(lds, g, S, E); }
            __syncthreads();
            { pg8::Gemm g{Y + (size_t)MT * 1024, WB + (size_t)D * 1024, nrows, D, 1024}; EpiBr<1> E{U, Z + Z_MG + D}; pg8::gemm_phase<EpiBr<1>, pg8::StaticOrder, true, true>(lds, g, S, E); }
            __syncthreads();
            { pg8::Gemm g{Y + (size_t)2 * MT * 1024, WB + (size_t)2 * D * 1024, nrows, D, 1024}; EpiBr<2> E{U, Z + Z_MG + 2 * D}; pg8::gemm_phase<EpiBr<2>, pg8::StaticOrder, true, true>(lds, g, S, E); });
        }
        SEAM(pb + 7);
        if (EN(7) && IN(pb + 8)) {
            pg8::Gemm g{U, (const bf16*)(ws + WS_WOUT), nrows, D, D}; pg8::StaticOrder S; S.init(nrows, D, G, bid);
            EpiOut E{l == 0 ? ain(a, I_X) : H, l == 0 ? ain(a, I_CTX) : H + (size_t)SEQ * D, H, modall + (size_t)l * 2 * 12288 + 4096};
            RUN(9, l == 0, pg8::gemm_phase<EpiOut, pg8::StaticOrder, true, true>(lds, g, S, E));
        }
        SEAM(pb + 8);
        if (EN(8) && IN(pb + 9)) {
            route_phase<false>(a, l, nrows, ldsf);
            __syncthreads();
            if (REP(19)) { route_phase<true>(a, l, nrows, ldsf); __syncthreads(); }
            RUN(10, true, for (int it = bid; it < CVT_MOE_TILES; it += G) cvt_moe_item(a, l, it, ldsf));
        }
        SEAM(pb + 9);
        if (EN(9) && IN(pb + 10)) { RUN(11, true, permute_phase(a, l, nrows, lds)); }
        SEAM(pb + 10);
        if (EN(10) && IN(pb + 11)) {
            const int* tile_e = (const int*)(ws + WS_TILEE); const int ntiles = tile_e[200];
            pg8::Gemm g{(const bf16*)(ws + WS_XP), (const bf16*)(ws + WS_WGU), MOE_MAXROWS, NEXP * 1024, D}; MoeOrder S{tile_e, ntiles, 4, G, bid};
            EpiGU E{(bf16*)(ws + WS_HMID)};
            RUN(12, true, pg8::gemm_phase<EpiGU, MoeOrder, true, true>(lds, g, S, E));
        }
        SEAM(pb + 11);
        if (EN(11) && IN(pb + 12)) {
            const int* tile_e = (const int*)(ws + WS_TILEE); const int ntiles = tile_e[200];
            pg8::Gemm g{(const bf16*)(ws + WS_HMID), (const bf16*)(ws + WS_WD), MOE_MAXROWS, NEXP * D, DFF}; MoeOrder S{tile_e, ntiles, 8, G, bid};
            EpiDn E{(bf16*)(ws + WS_YP), (const float*)(ws + WS_ROWW)};
            RUN(13, true, pg8::gemm_phase<EpiDn, MoeOrder, true, true>(lds, g, S, E));
        }
        SEAM(pb + 12);
    }
    if (EN(12) && IN(PH_FINAL)) norm_phase<2>(a, DEPTH, SEQ, ldsf);
#undef IN
#undef SEAM
#undef ws
#undef bid
#undef G
#undef lds
#undef ldsf
#undef U
#undef Z
#undef H
#undef modall
}

#ifndef MK_SINGLE
#define MK_SINGLE 1
#endif
extern "C" void kernel_launch(void* const* d_in, const int* in_sizes, int n_in, void* d_out, int out_size, void* d_ws, size_t ws_size, hipStream_t stream) {
    static int grid = 0;
    if (grid == 0) {
        if (n_in != N_IN || out_size != SEQ * D || ws_size < WS_END) { fprintf(stderr, "kernel_launch: unexpected problem shape (n_in %d, out %d, ws %zu < %zu)\n", n_in, out_size, ws_size, (size_t)WS_END); grid = -1; return; }
        int dev = 0, cus = 0;
        if (hipGetDevice(&dev) != hipSuccess || hipDeviceGetAttribute(&cus, hipDeviceAttributeMultiprocessorCount, dev) != hipSuccess) { grid = -1; return; }
        if (hipFuncSetAttribute((const void*)fwd_kernel, hipFuncAttributeMaxDynamicSharedMemorySize, LDS_BYTES) != hipSuccess) { fprintf(stderr, "kernel_launch: hipFuncSetAttribute failed\n"); grid = -1; return; }
        int per_cu = 0;
        if (hipOccupancyMaxActiveBlocksPerMultiprocessor(&per_cu, (const void*)fwd_kernel, NTHR, LDS_BYTES) != hipSuccess || per_cu < 1) fprintf(stderr, "kernel_launch: occupancy query says %d\n", per_cu);
        (void)hipGetLastError();
        grid = cus;
    }
    if (grid < 0) return;
    (void)hipMemsetAsync((char*)d_ws + WS_CTL, 0, CTL_BYTES, stream);
    KArgs ka{};
    for (int i = 0; i < N_IN; ++i) ka.a.in[i] = (const float*)d_in[i];
    ka.a.out = (float*)d_out; ka.a.ws = (unsigned char*)d_ws;
#if MK_SINGLE
    ka.a.ph_lo = 0; ka.a.ph_hi = NPHASES; ka.li = 0; ka.pad = 0;
    hipLaunchKernelGGL(fwd_kernel, dim3(grid), dim3(NTHR), LDS_BYTES, stream, ka);
#else
    for (int ph = 0; ph < NPHASES; ++ph) { ka.a.ph_lo = ph; ka.a.ph_hi = ph + 1; ka.li = 0; ka.pad = 0; hipLaunchKernelGGL(fwd_kernel, dim3(grid), dim3(NTHR), LDS_BYTES, stream, ka); }
#endif
}
```

```cpp
#include <hip/hip_runtime.h>
#include <cstdio>
#include <cstdint>
#define DI __device__ __forceinline__
#define LAS __attribute__((address_space(3)))
typedef unsigned short bf16;
typedef float f32x4 __attribute__((ext_vector_type(4)));
typedef unsigned u32x4 __attribute__((ext_vector_type(4)));
typedef unsigned u32x2 __attribute__((ext_vector_type(2)));

constexpr int D = 2048, SEQ = 16384, CTXL = 256, MT = SEQ + CTXL  , DEPTH = 2;
constexpr int NCOLS_IN = 17440;
constexpr int ZC = 17664;
constexpr int Z_HG = 0, Z_GL = 5120, Z_HY = 8192, Z_MG = 11264, Z_LR = 17408;
constexpr int NEXP = 32, DFF = 512, MOE_MAXROWS = 41472;
constexpr float NORM_EPS = 1e-6f;

constexpr size_t MiB = 1u << 20;
constexpr size_t WS_CTL = 0, CTL_BYTES = 1 * MiB;
constexpr size_t WS_SMALL = 1 * MiB;
constexpr size_t WS_MOD   = WS_SMALL;
constexpr size_t WS_ZBIAS = WS_MOD + (size_t)DEPTH * 2 * 12288 * 4;
constexpr size_t WS_LB    = WS_ZBIAS + (size_t)DEPTH * ZC * 4;
constexpr size_t WS_TW    = WS_LB + (size_t)DEPTH * 2 * 1024 * 4;
constexpr size_t WS_TW2   = WS_TW + 16384 * 8;
constexpr size_t WS_H2    = WS_TW2 + (8192 + 64) * 8;
constexpr size_t WS_ROUTE = WS_H2 + (size_t)DEPTH * MT * 64 * 4;
constexpr size_t WS_ROWW  = WS_ROUTE + (size_t)MT * 8 * 4;
constexpr size_t WS_TILEE = WS_ROWW + (size_t)MOE_MAXROWS * 4;
constexpr size_t WS_HYC   = WS_TILEE + 1024;
constexpr size_t WS_W3T   = WS_HYC + (size_t)2048 * 256 * 4;
constexpr size_t WS_H2B   = WS_W3T + (size_t)DEPTH * 2048 * 256 * 2;
constexpr size_t WS_WRT   = WS_H2B + (size_t)DEPTH * SEQ * 256 * 2;
constexpr size_t WS_SMALL_END = WS_WRT + (size_t)DEPTH * 2 * 48 * 2048 * 2;
static_assert(WS_SMALL_END <= 40 * MiB, "small tables");
constexpr size_t WS_WIN  = 40 * MiB;
constexpr size_t WS_WBR  = 109 * MiB;
constexpr size_t WS_WOUT = 121 * MiB;
constexpr size_t WS_WGU  = 129 * MiB;
constexpr size_t WS_CVO  = WS_WIN;
constexpr size_t WS_WD   = 257 * MiB;
constexpr size_t WS_H    = 321 * MiB;
constexpr size_t WS_U    = 451 * MiB;
constexpr size_t WS_Z    = 516 * MiB;
constexpr size_t WS_XP   = WS_Z;
constexpr size_t WS_HMID = WS_Z + 162 * MiB;
constexpr size_t WS_YP   = WS_Z + 203 * MiB;
constexpr size_t WS_YMIX = 1077 * MiB;
constexpr size_t WS_HF   = 1175 * MiB;
constexpr size_t WS_OSC  = 1175 * MiB;
constexpr size_t WS_END  = 1435 * MiB;
static_assert(WS_WIN + (size_t)ZC * D * 2 <= WS_WBR && WS_Z + (size_t)MT * ZC * 2 <= WS_YMIX && WS_YMIX + (size_t)3 * MT * 1024 * 2 <= WS_OSC && WS_OSC + (size_t)4 * MT * 1024 * 4 <= WS_END, "ws map");
static_assert(WS_YP + (size_t)MOE_MAXROWS * D * 2 <= WS_YMIX && WS_H + (size_t)MT * D * 4 <= WS_U && WS_U + (size_t)MT * D * 2 <= WS_Z, "ws map 2");
constexpr int CW_BAR = 4096;
constexpr int CW_CNT = 16384;

DI float bf2f(bf16 v) { return __uint_as_float(((unsigned)v) << 16); }
DI float bflo(unsigned w) { return __uint_as_float(w << 16); }
DI float bfhi(unsigned w) { return __uint_as_float(w & 0xffff0000u); }
typedef float f32x2_t __attribute__((ext_vector_type(2))); typedef __bf16 bf16x2_t __attribute__((ext_vector_type(2)));
DI unsigned pk_bf16(float lo, float hi) { f32x2_t v = {lo, hi}; bf16x2_t b = __builtin_convertvector(v, bf16x2_t); return __builtin_bit_cast(unsigned, b); }
DI bf16 f2bf(float f) { return (bf16)(pk_bf16(f, 0.f) & 0xffffu); }
DI float sigmoidf_(float x) { return 1.0f / (1.0f + __expf(-x)); }
DI float siluf_(float x) { return x / (1.0f + __expf(-x)); }
DI float wave_sum(float v) {
#pragma unroll
    for (int o = 32; o >= 1; o >>= 1) v += __shfl_xor(v, o);
    return v;
}
DI int otid() { int t = __builtin_amdgcn_workitem_id_x(); asm volatile("" : "+v"(t)); return t; }
DI int ogdim() { int g = __builtin_amdgcn_workgroup_id_x(); g = (int)gridDim.x; asm volatile("" : "+s"(g)); return g; }
DI int obid() { int b = __builtin_amdgcn_workgroup_id_x(); asm volatile("" : "+s"(b)); return b; }
#define AIN_DECL 1
DI LAS f32x2_t* fft_vec2_(LAS float* p) { return (LAS f32x2_t*)p; }
DI const f32x2_t* fft_vec2_(const float* p) { return (const f32x2_t*)p; }
DI f32x2_t* fft_vec2_(float* p) { return (f32x2_t*)p; }
namespace pg8 {
#define PG8_LAS __attribute__((address_space(3)))
typedef unsigned short bf16_t;
typedef short bf16x8 __attribute__((ext_vector_type(8)));
typedef float f32x4 __attribute__((ext_vector_type(4)));
typedef unsigned u32x4 __attribute__((ext_vector_type(4)));
constexpr int BM = 256, BK = 64, HALF = 128, HTB = HALF * BK * 2  , STAGE_BYTES = 8 * HTB, NXCD = 8, WGM = 8;

__host__ __device__ __forceinline__ int lds_byte(int r, int c) { const int st = (r >> 4) * 2 + (c >> 5), rr = r & 15, cc = c & 31, ob = rr * 64 + cc * 2; return st * 1024 + (ob ^ (((ob >> 9) & 1) << 5)); }
__host__ __device__ __forceinline__ void stage_rc(int b, int& R, int& C) { const int st = b / 1024, sb = b % 1024, swz = sb ^ (((sb >> 9) & 1) << 5); R = (st >> 1) * 16 + swz / 64; C = (st & 1) * 32 + (swz % 64) / 2; }
__host__ __device__ __forceinline__ int perm32(int rho) { const int n = rho >> 4, i = rho & 15; return 8 * (i >> 2) + 4 * n + (i & 3); }

struct Unit { int pm, pn; };
struct Gemm { const bf16_t* A; const bf16_t* Bt; int M, N, K; };

struct StaticOrder {
    int nM, nN, nwg, G, c;
    __host__ __device__ void init(int M, int N, int G_, int c_) { nM = M / BM; nN = N / BM; nwg = nM * nN; G = G_; c = c_; }
    __host__ __device__ bool next(int i, Unit& u) const {
        const long L = (long)i * G + c; if (L >= nwg) return false;
        int wgid = (int)L; { const int q = nwg / NXCD, r = nwg % NXCD, xcd = wgid % NXCD, off = wgid / NXCD; wgid = (xcd < r ? xcd * (q + 1) : r * (q + 1) + (xcd - r) * q) + off; }
        const int nig = WGM * nN, gid = wgid / nig, fm = gid * WGM, gsz = (nM - fm) < WGM ? (nM - fm) : WGM;
        u.pm = fm + ((wgid % nig) % gsz); u.pn = (wgid % nig) / gsz; return true;
    }
    __device__ __forceinline__ void a_ready(const Unit&) const {}
    __device__ __forceinline__ void done(const Unit&) const {}
};

template <class Epi, class Sched, bool ALIGN_EPI = false, bool SP2 = false>
__device__ __forceinline__ void gemm_phase(PG8_LAS unsigned char* lds, const Gemm g, const Sched& S, const Epi& E) {
    const int tid = otid(), wid = __builtin_amdgcn_readfirstlane(tid >> 6), lane = tid & 63, wr = wid >> 2, wc = wid & 3, fr = lane & 15, fq = lane >> 4;
    const int K = g.K, nt = K / BK;
    unsigned voffA[2], voffB[2];
#pragma unroll
    for (int i = 0; i < 2; ++i) { int R, C; stage_rc(tid * 16 + i * 8192, R, C); const int Rb = Epi::PERM ? ((R & ~31) + perm32(R & 31)) : R;
        voffA[i] = (unsigned)(R * K + C) * 2u; voffB[i] = (unsigned)(Rb * K + C) * 2u; }
    const size_t kstep = (size_t)(BK * 2);
    const size_t hstep = (size_t)HALF * K * 2;
    const size_t tstep = 2 * hstep;
    const unsigned ldsw = (unsigned)wid * 1024u;
    const int aoff = lds_byte(wr * 64 + fr, fq * 8), boff = lds_byte(wc * 32 + fr, fq * 8);
#define PG8_SA(b, h) (((b) * 2 + (h)) * HTB)
#define PG8_SB(b, h) ((4 + (b) * 2 + (h)) * HTB)
#define PG8_STAGE(bufoff, gbase, voff) do { _Pragma("unroll") for (int _i = 0; _i < 2; ++_i) \
        __builtin_amdgcn_global_load_lds((const unsigned*)((const char*)(gbase) + (voff)[_i]), (PG8_LAS unsigned*)(lds + (bufoff) + ldsw + _i * 8192), 16, 0, 0); } while (0)
#define PG8_LDA(dst, b, h) do { _Pragma("unroll") for (int m = 0; m < 4; ++m) _Pragma("unroll") for (int k = 0; k < 2; ++k) dst[m][k] = *(const PG8_LAS bf16x8*)(lds + PG8_SA(b, h) + aoff + m * 2048 + k * 1024); } while (0)
#define PG8_LDB(dst, b, h) do { _Pragma("unroll") for (int n = 0; n < 2; ++n) _Pragma("unroll") for (int k = 0; k < 2; ++k) dst[n][k] = *(const PG8_LAS bf16x8*)(lds + PG8_SB(b, h) + boff + n * 2048 + k * 1024); } while (0)
#define PG8_MMA(ai, bj, At, Bt) do { __builtin_amdgcn_s_setprio(1); _Pragma("unroll") for (int m = 0; m < 4; ++m) _Pragma("unroll") for (int n = 0; n < 2; ++n) _Pragma("unroll") for (int k = 0; k < 2; ++k) \
        acc[ai][bj][m][n] = __builtin_amdgcn_mfma_f32_16x16x32_bf16(Bt[n][k], At[m][k], acc[ai][bj][m][n], 0, 0, 0); __builtin_amdgcn_s_setprio(0); } while (0)
#define PG8_WAIT_V(n) asm volatile("s_waitcnt vmcnt(" #n ")" ::: "memory")
#define PG8_WAIT_L(n) asm volatile("s_waitcnt lgkmcnt(" #n ")" ::: "memory")
#define PG8_BAR __builtin_amdgcn_s_barrier()
#define PG8_SCHED __builtin_amdgcn_sched_barrier(0)
    Unit cur, nxt; int ui = 0;
    if (!S.next(0, cur)) return;
    f32x4 acc[2][2][4][2];
#pragma unroll
    for (int a = 0; a < 2; ++a)
#pragma unroll
        for (int b = 0; b < 2; ++b)
#pragma unroll
            for (int m = 0; m < 4; ++m)
#pragma unroll
                for (int n = 0; n < 2; ++n) acc[a][b][m][n] = (f32x4){0.f, 0.f, 0.f, 0.f};
    bf16x8 At[4][2], B0[2][2], B1[2][2];
    const char* cA = (const char*)g.A + (size_t)cur.pm * tstep; const char* cB = (const char*)g.Bt + (size_t)cur.pn * tstep;
    S.a_ready(cur);
    if constexpr (SP2) {
        PG8_STAGE(PG8_SB(0, 0), cB, voffB); PG8_STAGE(PG8_SB(0, 1), cB + hstep, voffB); PG8_STAGE(PG8_SA(0, 0), cA, voffA); PG8_STAGE(PG8_SA(0, 1), cA + hstep, voffA);
        if (wr == 1) PG8_BAR;
        PG8_WAIT_V(2); PG8_BAR;
        PG8_STAGE(PG8_SB(1, 0), cB + kstep, voffB); PG8_STAGE(PG8_SA(1, 0), cA + kstep, voffA); PG8_STAGE(PG8_SB(1, 1), cB + hstep + kstep, voffB);
        PG8_WAIT_V(6); PG8_BAR;
    } else {
        PG8_STAGE(PG8_SB(0, 0), cB, voffB); PG8_STAGE(PG8_SA(0, 0), cA, voffA); PG8_STAGE(PG8_SB(0, 1), cB + hstep, voffB); PG8_STAGE(PG8_SA(0, 1), cA + hstep, voffA);
        if (wr == 1) PG8_BAR;
        PG8_WAIT_V(4); PG8_BAR;
        PG8_STAGE(PG8_SB(1, 0), cB + kstep, voffB); PG8_STAGE(PG8_SA(1, 0), cA + kstep, voffA); PG8_STAGE(PG8_SB(1, 1), cB + hstep + kstep, voffB);
        PG8_WAIT_V(6); PG8_BAR;
    }
    for (;;) {
        const bool has_next = S.next(ui + 1, nxt);
        const char* nA = has_next ? (const char*)g.A + (size_t)nxt.pm * tstep : cA; const char* nB = has_next ? (const char*)g.Bt + (size_t)nxt.pn * tstep : cB;
        for (int t = 0; t < nt; t += 2) {
            const bool last = (t == nt - 2);
            const char* a1 = cA + (size_t)(t + 1) * kstep;
            const char* a2 = last ? nA : cA + (size_t)(t + 2) * kstep; const char* b2 = last ? nB : cB + (size_t)(t + 2) * kstep;
            const char* a3 = a2 + kstep; const char* b3 = b2 + kstep;
            if (last && has_next) S.a_ready(nxt);
            if constexpr (SP2) {
            PG8_LDB(B0, 0, 0); PG8_LDB(B1, 0, 1); PG8_SCHED; PG8_LDA(At, 0, 0); PG8_STAGE(PG8_SA(1, 1), a1 + hstep, voffA);
            PG8_WAIT_V(8); PG8_WAIT_L(0); PG8_BAR; PG8_MMA(0, 0, At, B0); PG8_MMA(0, 1, At, B1); PG8_BAR; PG8_SCHED;
            PG8_LDA(At, 0, 1); PG8_STAGE(PG8_SB(0, 0), b2, voffB); PG8_STAGE(PG8_SB(0, 1), b2 + hstep, voffB); PG8_STAGE(PG8_SA(0, 0), a2, voffA);
            PG8_WAIT_V(8); PG8_WAIT_L(0); PG8_BAR; PG8_MMA(1, 0, At, B0); PG8_MMA(1, 1, At, B1); PG8_BAR; PG8_SCHED;
            PG8_LDB(B0, 1, 0); PG8_LDB(B1, 1, 1); PG8_SCHED; PG8_LDA(At, 1, 0); PG8_STAGE(PG8_SA(0, 1), a2 + hstep, voffA);
            PG8_WAIT_V(8); PG8_WAIT_L(0); PG8_BAR; PG8_MMA(0, 0, At, B0); PG8_MMA(0, 1, At, B1); PG8_BAR; PG8_SCHED;
            PG8_LDA(At, 1, 1); PG8_STAGE(PG8_SB(1, 0), b3, voffB); PG8_STAGE(PG8_SB(1, 1), b3 + hstep, voffB); PG8_STAGE(PG8_SA(1, 0), a3, voffA);
            PG8_WAIT_V(8); PG8_WAIT_L(0); PG8_BAR; PG8_MMA(1, 0, At, B0); PG8_MMA(1, 1, At, B1); PG8_BAR; PG8_SCHED;
            } else {
            PG8_LDB(B0, 0, 0); PG8_SCHED; PG8_LDA(At, 0, 0); PG8_STAGE(PG8_SA(1, 1), a1 + hstep, voffA);
            PG8_WAIT_L(8); PG8_BAR; PG8_WAIT_L(0); PG8_MMA(0, 0, At, B0); PG8_BAR; PG8_SCHED;
            PG8_LDB(B1, 0, 1); PG8_STAGE(PG8_SB(0, 0), b2, voffB);
            PG8_BAR; PG8_WAIT_L(0); PG8_MMA(0, 1, At, B1); PG8_BAR;
            PG8_LDA(At, 0, 1); PG8_STAGE(PG8_SA(0, 0), a2, voffA);
            PG8_BAR; PG8_WAIT_L(0); PG8_MMA(1, 0, At, B0); PG8_BAR; PG8_SCHED;
            PG8_STAGE(PG8_SB(0, 1), b2 + hstep, voffB);
            PG8_WAIT_V(6); PG8_BAR; PG8_MMA(1, 1, At, B1); PG8_BAR;
            PG8_LDB(B0, 1, 0); PG8_SCHED; PG8_LDA(At, 1, 0); PG8_STAGE(PG8_SA(0, 1), a2 + hstep, voffA);
            PG8_WAIT_L(8); PG8_BAR; PG8_WAIT_L(0); PG8_MMA(0, 0, At, B0); PG8_BAR; PG8_SCHED;
            PG8_LDB(B1, 1, 1); PG8_STAGE(PG8_SB(1, 0), b3, voffB);
            PG8_BAR; PG8_WAIT_L(0); PG8_MMA(0, 1, At, B1); PG8_BAR;
            PG8_LDA(At, 1, 1); PG8_STAGE(PG8_SA(1, 0), a3, voffA);
            PG8_BAR; PG8_WAIT_L(0); PG8_MMA(1, 0, At, B0); PG8_BAR; PG8_SCHED;
            PG8_STAGE(PG8_SB(1, 1), b3 + hstep, voffB);
            PG8_WAIT_V(6); PG8_BAR; PG8_MMA(1, 1, At, B1); PG8_BAR;
            }
        }
        if constexpr (ALIGN_EPI) { if (wr == 0) PG8_BAR; }
        if constexpr (!Epi::AFTER_DRAIN) { E(acc, cur, wr, wc, fr, fq); S.done(cur); }
        if (!has_next) break;
#pragma unroll
        for (int a = 0; a < 2; ++a)
#pragma unroll
            for (int b = 0; b < 2; ++b)
#pragma unroll
                for (int m = 0; m < 4; ++m)
#pragma unroll
                    for (int n = 0; n < 2; ++n) acc[a][b][m][n] = (f32x4){0.f, 0.f, 0.f, 0.f};
        cur = nxt; cA = nA; cB = nB; ++ui;
        if constexpr (ALIGN_EPI) { if (wr == 1) PG8_BAR; }
    }
    PG8_WAIT_V(0);
    if constexpr (!ALIGN_EPI) { if (wr == 0) PG8_BAR; }
    PG8_BAR;
    if constexpr (Epi::AFTER_DRAIN) { E.fused(acc, cur, wr, wc, fr, fq, lds, wid, lane); S.done(cur); }
#undef PG8_SA
#undef PG8_SB
#undef PG8_STAGE
#undef PG8_LDA
#undef PG8_LDB
#undef PG8_MMA
#undef PG8_WAIT_V
#undef PG8_WAIT_L
#undef PG8_BAR
#undef PG8_SCHED
}
}
#define XB_TMO      128
#define XB_XCNT(j)  (256  + 64 * (j))
#define XB_XSUB(j)  (1280 + 64 * (j))
#define XB_XGEN(j)  (2304 + 64 * (j))
#define XB_TOP      3328
#define XB_TOPGEN   3392
#define XCD_BAR_WORDS 3456
#define XB_SPIN_CAP (1u << 18)

__device__ __forceinline__ unsigned xb_ld(unsigned* p)              { return __hip_atomic_load(p, __ATOMIC_RELAXED, __HIP_MEMORY_SCOPE_AGENT); }
__device__ __forceinline__ unsigned xb_add(unsigned* p, unsigned v) { return __hip_atomic_fetch_add(p, v, __ATOMIC_RELAXED, __HIP_MEMORY_SCOPE_AGENT); }
__device__ __forceinline__ unsigned xb_xcc_id() { return (unsigned)__builtin_amdgcn_s_getreg((3 << 11) | 20) & 0xFu; }
#define XB_SPIN(cond, bar) do { unsigned _sp = 0; while (cond) { __builtin_amdgcn_s_sleep(1); \
    if ((++_sp & 255u) == 0u) { if (xb_ld(&(bar)[XB_TMO])) break; if (_sp > XB_SPIN_CAP) { atomicAdd(&(bar)[XB_TMO], 1u); break; } } } } while (0)

struct XcdBarrier {
    unsigned* bar; unsigned x;
    volatile LAS unsigned* st;
};

__device__ __forceinline__ XcdBarrier xcd_barrier_post(unsigned* bar, volatile LAS unsigned* st) {
    XcdBarrier b; b.bar = bar; b.x = xb_xcc_id(); b.st = st;
    if (otid() == 0) (void)xb_add(&bar[XB_XCNT(b.x)], 1u);
    return b;
}
__device__ __forceinline__ void xcd_barrier_complete(unsigned* bar, unsigned x, unsigned& nloc, unsigned& nx) {
    asm volatile("" : "+s"(x));
    const unsigned G = ogdim();
    unsigned sum, cnt, mine, sp = 0u;
    for (;;) {
        sum = 0u; cnt = 0u; mine = 0u;
#pragma unroll
        for (unsigned j = 0; j < 16; ++j) { const unsigned c = xb_ld(&bar[XB_XCNT(j)]); sum += c; cnt += (c > 0u) ? 1u : 0u; mine = (j == x) ? c : mine; }
        if (sum == G) break;
        __builtin_amdgcn_s_sleep(1);
        if ((++sp & 255u) == 0u) { if (xb_ld(&bar[XB_TMO])) break; if (sp > XB_SPIN_CAP) { atomicAdd(&bar[XB_TMO], 1u); break; } }
    }
    nloc = mine > 0u ? mine : 1u; nx = cnt > 0u ? cnt : 1u;
}

__device__ __forceinline__ void xcd_barrier(const XcdBarrier& b) {
    asm volatile("s_waitcnt vmcnt(0)" ::: "memory");
    __syncthreads();
    if (otid() == 0) {
        unsigned* bar = b.bar;
        __builtin_amdgcn_s_waitcnt(0);
        unsigned nloc = b.st[0], nx = b.st[1];
        if (nloc == 0u) { xcd_barrier_complete(bar, b.x, nloc, nx); b.st[0] = nloc; b.st[1] = nx; }
        const unsigned old = xb_add(&bar[XB_XSUB(b.x)], 1u);
        const unsigned gen = old / nloc;
        if (old + 1u == (gen + 1u) * nloc) {
            __builtin_amdgcn_fence(__ATOMIC_RELEASE, "agent");
            asm volatile("s_waitcnt vmcnt(0)" ::: "memory");
            const unsigned og = xb_add(&bar[XB_TOP], 1u);
            const unsigned tg = og / nx;
            if (og + 1u == (tg + 1u) * nx) xb_add(&bar[XB_TOPGEN], 1u);
            else XB_SPIN(xb_ld(&bar[XB_TOPGEN]) == tg, bar);
            __builtin_amdgcn_fence(__ATOMIC_ACQUIRE, "agent");
            xb_add(&bar[XB_XGEN(b.x)], 1u);
            asm volatile("s_waitcnt vmcnt(0)" ::: "memory");
        } else {
            XB_SPIN(xb_ld(&bar[XB_XGEN(b.x)]) == gen, bar);
            __builtin_amdgcn_fence(__ATOMIC_ACQUIRE, "agent");
            asm volatile("s_waitcnt vmcnt(0)" ::: "memory");
        }
    }
    __syncthreads();
}

#define FFT_DI DI
struct cpx; template <class P> DI cpx fft_ldc_(P p, int i); template <class P> DI void fft_stc_(P p, int i, const cpx& v);
#define FFT_LDC(p, i) fft_ldc_((p), (i))
#define FFT_STC(p, i, v) fft_stc_((p), (i), (v))
#define FFT_M 16384
#define FFT_NT 512
struct cpx { float x, y; };
#ifdef FFT_LDC
template <class P> FFT_DI cpx fft_ldc_(P p, int i) { const f32x2_t v = *(const decltype(fft_vec2_(p)))(p + 2 * i); cpx r; r.x = v[0]; r.y = v[1]; return r; }
template <class P> FFT_DI void fft_stc_(P p, int i, const cpx& v) { f32x2_t w = {v.x, v.y}; *(decltype(fft_vec2_(p)))(p + 2 * i) = w; }
#endif
#ifndef FFT_LDC
#define FFT_LDC(p, i) ([&]{ cpx r_; r_.x = (p)[2 * (i)]; r_.y = (p)[2 * (i) + 1]; return r_; }())
#define FFT_STC(p, i, v) do { (p)[2 * (i)] = (v).x; (p)[2 * (i) + 1] = (v).y; } while (0)
#endif
FFT_DI cpx cmul(cpx a, cpx b) { cpx r; r.x = a.x * b.x - a.y * b.y; r.y = a.x * b.y + a.y * b.x; return r; }
FFT_DI cpx cmulc(cpx a, cpx b) { cpx r; r.x = a.x * b.x + a.y * b.y; r.y = a.y * b.x - a.x * b.y; return r; }
FFT_DI int rev4_14(int k) {
    int r = 0;
#pragma unroll
    for (int d = 0; d < 7; ++d) { r = (r << 2) | (k & 3); k >>= 2; }
    return r;
}
struct FftTw { cpx c256[3], c64[3], c16[3], c4[3]; };
template <class TP> FFT_DI void fft_load_tw(FftTw& T, TP tw, int tid) {
#pragma unroll
    for (int q = 0; q < 3; ++q) { T.c256[q] = FFT_LDC(tw, (q + 1) * (tid & 255) * 16); T.c64[q] = FFT_LDC(tw, (q + 1) * (tid & 63) * 64); T.c16[q] = FFT_LDC(tw, (q + 1) * (tid & 15) * 256); T.c4[q] = FFT_LDC(tw, (q + 1) * (tid & 3) * 1024); }
}
template <int s, class TP> FFT_DI void fft_pick_tw(const FftTw& T, TP tw, int pos, int j, cpx& w1, cpx& w2, cpx& w3) {
    if (s == 4096) { w1 = FFT_LDC(tw, pos); w2 = FFT_LDC(tw, 2 * pos); w3 = FFT_LDC(tw, 3 * pos); }
    else if (s == 1024) { w1 = FFT_LDC(tw, 4 * pos); w2 = FFT_LDC(tw, 8 * pos); w3 = FFT_LDC(tw, 12 * pos); }
    else if (s == 256) { w1 = T.c256[0]; w2 = T.c256[1]; w3 = T.c256[2]; }
    else if (s == 64) { w1 = T.c64[0]; w2 = T.c64[1]; w3 = T.c64[2]; }
    else if (s == 16) { w1 = T.c16[0]; w2 = T.c16[1]; w3 = T.c16[2]; }
    else if (s == 4) { w1 = T.c4[0]; w2 = T.c4[1]; w3 = T.c4[2]; }
}
template <int s, class LP, class TP> FFT_DI void fft_fwd_pass(LP lds, const FftTw& T, TP tw, int tid) {
    cpx w1, w2, w3;
#pragma unroll 2
    for (int jj = 0; jj < FFT_M / 4 / FFT_NT; ++jj) { const int b = tid + FFT_NT * jj;
        const int pos = b & (s - 1), base = ((b & ~(s - 1)) << 2) + pos;
        const cpx a0 = FFT_LDC(lds, base), a1 = FFT_LDC(lds, base + s), a2 = FFT_LDC(lds, base + 2 * s), a3 = FFT_LDC(lds, base + 3 * s);
        cpx t0, t1, t2, t3;
        t0.x = a0.x + a2.x; t0.y = a0.y + a2.y;
        t1.x = a0.x - a2.x; t1.y = a0.y - a2.y;
        t2.x = a1.x + a3.x; t2.y = a1.y + a3.y;
        t3.x = a1.x - a3.x; t3.y = a1.y - a3.y;
        cpx y0, y1, y2, y3;
        y0.x = t0.x + t2.x; y0.y = t0.y + t2.y;
        y2.x = t0.x - t2.x; y2.y = t0.y - t2.y;
        y1.x = t1.x + t3.y; y1.y = t1.y - t3.x;
        y3.x = t1.x - t3.y; y3.y = t1.y + t3.x;
        if (s > 1) {
            fft_pick_tw<s>(T, tw, pos, jj, w1, w2, w3);
            y1 = cmul(y1, w1); y2 = cmul(y2, w2); y3 = cmul(y3, w3);
        }
        FFT_STC(lds, base, y0); FFT_STC(lds, base + s, y1); FFT_STC(lds, base + 2 * s, y2); FFT_STC(lds, base + 3 * s, y3);
    }
}
template <int s, class LP, class TP> FFT_DI void fft_inv_pass(LP lds, const FftTw& T, TP tw, int tid) {
    cpx w1, w2, w3;
#pragma unroll 2
    for (int jj = 0; jj < FFT_M / 4 / FFT_NT; ++jj) { const int b = tid + FFT_NT * jj;
        const int pos = b & (s - 1), base = ((b & ~(s - 1)) << 2) + pos;
        const cpx b0 = FFT_LDC(lds, base); cpx c1 = FFT_LDC(lds, base + s), c2 = FFT_LDC(lds, base + 2 * s), c3 = FFT_LDC(lds, base + 3 * s);
        if (s > 1) {
            fft_pick_tw<s>(T, tw, pos, jj, w1, w2, w3);
            c1 = cmulc(c1, w1); c2 = cmulc(c2, w2); c3 = cmulc(c3, w3);
        }
        cpx t0, t1, t2, t3;
        t0.x = b0.x + c2.x; t0.y = b0.y + c2.y;
        t1.x = b0.x - c2.x; t1.y = b0.y - c2.y;
        t2.x = c1.x + c3.x; t2.y = c1.y + c3.y;
        t3.x = c1.x - c3.x; t3.y = c1.y - c3.y;
        cpx x0, x1, x2, x3;
        x0.x = t0.x + t2.x; x0.y = t0.y + t2.y;
        x2.x = t0.x - t2.x; x2.y = t0.y - t2.y;
        x1.x = t1.x - t3.y; x1.y = t1.y + t3.x;
        x3.x = t1.x + t3.y; x3.y = t1.y - t3.x;
        FFT_STC(lds, base, x0); FFT_STC(lds, base + s, x1); FFT_STC(lds, base + 2 * s, x2); FFT_STC(lds, base + 3 * s, x3);
    }
}
template <class LP, class TP> FFT_DI void rfft_untangle(LP lds, TP tw2, int k, cpx& Xk, cpx& Xm) {
    if (k == 0) {
        const float zr = lds[0], zi = lds[1];
        Xk.x = zr + zi; Xk.y = zr - zi;
        const int p = rev4_14(FFT_M / 2);
        Xm.x = lds[2 * p]; Xm.y = -lds[2 * p + 1];
        return;
    }
    const int pk = rev4_14(k), pm = rev4_14(FFT_M - k);
    cpx Zk, Zm; Zk.x = lds[2 * pk]; Zk.y = lds[2 * pk + 1]; Zm.x = lds[2 * pm]; Zm.y = lds[2 * pm + 1];
    cpx E, O, W, WO;
    E.x = 0.5f * (Zk.x + Zm.x); E.y = 0.5f * (Zk.y - Zm.y);
    O.x = 0.5f * (Zk.y + Zm.y); O.y = -0.5f * (Zk.x - Zm.x);
    W.x = tw2[2 * k]; W.y = tw2[2 * k + 1];
    WO = cmul(W, O);
    Xk.x = E.x + WO.x; Xk.y = E.y + WO.y;
    Xm.x = E.x - WO.x; Xm.y = -(E.y - WO.y);
}
template <class LP, class TP> FFT_DI void rfft_mul_retangle(LP lds, TP tw2, int k, cpx Gk, cpx Gm) {
    cpx Xk, Xm; rfft_untangle(lds, tw2, k, Xk, Xm);
    if (k == 0) {
        const float y0 = Xk.x * Gk.x, yM = Xk.y * Gk.y;
        lds[0] = 0.5f * (y0 + yM); lds[1] = 0.5f * (y0 - yM);
        const cpx Y = cmul(Xm, Gm);
        const int p = rev4_14(FFT_M / 2);
        lds[2 * p] = Y.x; lds[2 * p + 1] = -Y.y;
        return;
    }
    const cpx Yk = cmul(Xk, Gk), Ym = cmul(Xm, Gm);
    cpx W; W.x = tw2[2 * k]; W.y = tw2[2 * k + 1];
    cpx A, D, T;
    A.x = 0.5f * (Yk.x + Ym.x); A.y = 0.5f * (Yk.y - Ym.y);
    D.x = 0.5f * (Yk.x - Ym.x); D.y = 0.5f * (Yk.y + Ym.y);
    T = cmulc(D, W);
    const int pk = rev4_14(k), pm = rev4_14(FFT_M - k);
    lds[2 * pk] = A.x - T.y; lds[2 * pk + 1] = A.y + T.x;
    cpx Dc; Dc.x = -D.x; Dc.y = D.y;
    const cpx T2 = cmul(W, Dc);
    lds[2 * pm] = A.x + T2.y; lds[2 * pm + 1] = -A.y - T2.x;
}
enum { I_X = 0, I_C, I_CTX, I_CCTX, I_WMOD, I_BMOD, I_NMIXW, I_NFFNW, I_WIN, I_BIN, I_HYCW, I_HYCB, I_HYW1, I_HYB1, I_HYW2, I_HYB2, I_HYW3, I_HYB3, I_HYFREQ, I_HYSKIP,
       I_HGLB, I_HGNW, I_GLWA2, I_GLBA, I_GLNW, I_WBR, I_WOUT, I_WRG, I_BRG, I_WRE, I_BRE, I_WGATE, I_WUP, I_WDOWN, I_FNW, N_IN };
struct Args { const float* in[N_IN]; float* out; unsigned char* ws; int ph_lo, ph_hi; };
#define GAS __attribute__((address_space(1)))
extern __shared__ __attribute__((aligned(16))) unsigned char lds_raw[];
constexpr int LDS_PTAB = 150 * 1024 - 64 - 320;
DI LAS unsigned char* ldsbase() { unsigned p = (unsigned)(unsigned long long)(LAS unsigned char*)lds_raw; asm volatile("" : "+s"(p)); return (LAS unsigned char*)(unsigned long long)p; }
DI const float* ain(const Args&, int i) { const unsigned long long v = ((LAS unsigned long long*)(ldsbase() + LDS_PTAB))[i];
    const unsigned lo = __builtin_amdgcn_readfirstlane((unsigned)v), hi = __builtin_amdgcn_readfirstlane((unsigned)(v >> 32)); return (const float*)(GAS const float*)(((unsigned long long)hi << 32) | lo); }
DI unsigned char* wsp(const Args& a) { unsigned long long p = (unsigned long long)(a).ws; asm volatile("" : "+s"(p)); return (unsigned char*)(GAS unsigned char*)p; }
DI int opq(int x) { asm volatile("" : "+s"(x)); return x; }
#ifdef PROBE_SEL
constexpr int LDS_TIM = 150 * 1024 - 64 - 320 - 512;
#define TIC() const unsigned long long tic_ = __builtin_amdgcn_s_memrealtime()
#define TOC(i) do { if (otid() == 0) ((LAS unsigned long long*)(ldsbase() + LDS_TIM))[i] += __builtin_amdgcn_s_memrealtime() - tic_; } while (0)
#else
#define TIC() do {} while (0)
#define TOC(i) do {} while (0)
#endif
#define LDS_BAR() do { asm volatile("s_waitcnt lgkmcnt(0)" ::: "memory"); __builtin_amdgcn_s_barrier(); asm volatile("" ::: "memory"); } while (0)
constexpr int NTHR = 512;
constexpr int LDS_BYTES = 150 * 1024;
constexpr int LDS_X = 131072;
constexpr int LDS_BARW = LDS_BYTES - 64;

DI int z_srccol(int zc) { return zc < 8192 ? zc : (zc < Z_LR ? zc + 32 : (zc < Z_LR + 32 ? zc - Z_LR + 8192 : -1)); }

DI void cvt_block(const float* __restrict__ s0, const float* __restrict__ s1, const float* __restrict__ s2, const float* __restrict__ s3, size_t ld, int c0, int c1, int c2, int c3,
                  bf16* __restrict__ dst, int K, int row0, int kb, LAS float* t) {
    const int tid = otid(), nn = tid & 63, kk = tid >> 6;
    float v[8][4];
#pragma unroll
    for (int p = 0; p < 8; ++p) { const size_t ko = (size_t)(kb * 64 + p * 8 + kk) * ld;
        v[p][0] = c0 >= 0 ? s0[ko + c0] : 0.f; v[p][1] = c1 >= 0 ? s1[ko + c1] : 0.f; v[p][2] = c2 >= 0 ? s2[ko + c2] : 0.f; v[p][3] = c3 >= 0 ? s3[ko + c3] : 0.f; }
#pragma unroll
    for (int p = 0; p < 8; ++p)
#pragma unroll
        for (int g = 0; g < 4; ++g) t[(p * 8 + kk) * 257 + g * 64 + nn] = v[p][g];
    __syncthreads();
    const int rr = tid & 255, hk = tid >> 8;
#pragma unroll
    for (int q = 0; q < 4; ++q) { float w[8];
#pragma unroll
        for (int j = 0; j < 8; ++j) w[j] = t[(hk * 32 + q * 8 + j) * 257 + rr];
        u32x4 o; o.x = pk_bf16(w[0], w[1]); o.y = pk_bf16(w[2], w[3]); o.z = pk_bf16(w[4], w[5]); o.w = pk_bf16(w[6], w[7]);
        *(u32x4*)(dst + (size_t)(row0 + rr) * K + kb * 64 + hk * 32 + q * 8) = o; }
    __syncthreads();
}
constexpr int CVT_MIX_TILES = 69 * 32 + 3 * 8 * 16 + 8 * 32;
DI void cvt_mix_item(const Args& a, int l, int it, LAS float* t) {
    const int nn = otid() & 63;
    if (it < 69 * 32) { const int nb = it >> 5, kb = it & 31; const float* s = ain(a, I_WIN) + (size_t)l * D * NCOLS_IN;
        cvt_block(s, s, s, s, NCOLS_IN, z_srccol(nb * 256 + nn), z_srccol(nb * 256 + 64 + nn), z_srccol(nb * 256 + 128 + nn), z_srccol(nb * 256 + 192 + nn), (bf16*)(wsp(a) + WS_WIN), D, nb * 256, kb, t); return; }
    it -= 69 * 32;
    if (it < 3 * 8 * 16) { const int br = it / 128, r = it % 128, nb = r >> 4, kb = r & 15; const float* s = ain(a, I_WBR) + ((size_t)l * 3 + br) * 1024 * D; const int c = nb * 256 + nn;
        cvt_block(s, s, s, s, D, c, c + 64, c + 128, c + 192, (bf16*)(wsp(a) + WS_WBR) + (size_t)br * D * 1024, 1024, nb * 256, kb, t); return; }
    it -= 3 * 8 * 16;
    { const int nb = it >> 5, kb = it & 31; const float* s = ain(a, I_WOUT) + (size_t)l * D * D; const int c = nb * 256 + nn;
      cvt_block(s, s, s, s, D, c, c + 64, c + 128, c + 192, (bf16*)(wsp(a) + WS_WOUT), D, nb * 256, kb, t); }
}
constexpr int CVT_MOE_TILES = 32 * 4 * 32 + 32 * 8 * 8;
DI void cvt_moe_item(const Args& a, int l, int it, LAS float* t) {
    const int nn = otid() & 63;
    if (it < 32 * 4 * 32) { const int e = it >> 7, r = it & 127, nt = r >> 5, kb = r & 31;
        const float* sg = ain(a, I_WGATE) + ((size_t)l * NEXP + e) * D * DFF; const float* su = ain(a, I_WUP) + ((size_t)l * NEXP + e) * D * DFF; const int c = nt * 128 + nn;
        cvt_block(sg, sg, su, su, DFF, c, c + 64, c, c + 64, (bf16*)(wsp(a) + WS_WGU) + (size_t)e * 1024 * D, D, nt * 256, kb, t); return; }
    it -= 32 * 4 * 32;
    { const int e = it >> 6, r = it & 63, nb = r >> 3, kb = r & 7; const float* s = ain(a, I_WDOWN) + ((size_t)l * NEXP + e) * DFF * D; const int c = nb * 256 + nn;
      cvt_block(s, s, s, s, D, c, c + 64, c + 128, c + 192, (bf16*)(wsp(a) + WS_WD) + (size_t)e * D * DFF, DFF, nb * 256, kb, t); }
}

DI void mod_item(const Args& a, int j, LAS float* lds) {
    const int tid = otid(), l = j >> 7, col0 = (j & 127) * 96;
    LAS float* sil = lds;
    LAS float* red = lds + 4096;
    for (int k = tid; k < 2 * D; k += NTHR) { const float c = (k < D) ? ain(a, I_C)[k] : ain(a, I_CCTX)[k - D]; sil[k] = siluf_(c); }
    __syncthreads();
    const int cg = tid % 24, rg = tid / 24;
    f32x4 a0 = {0.f, 0.f, 0.f, 0.f}, a1 = {0.f, 0.f, 0.f, 0.f};
    if (rg < 21) {
        const float* w = ain(a, I_WMOD) + (size_t)l * D * 12288 + col0 + cg * 4;
        for (int k = rg; k < D; k += 21) { const f32x4 wv = *(const f32x4*)(w + (size_t)k * 12288); a0 += wv * sil[k]; a1 += wv * sil[D + k]; }
#pragma unroll
        for (int q = 0; q < 4; ++q) { red[(rg * 2 + 0) * 96 + cg * 4 + q] = a0[q]; red[(rg * 2 + 1) * 96 + cg * 4 + q] = a1[q]; }
    }
    __syncthreads();
    if (tid < 192) { const int set = tid / 96, c = tid % 96; float s = 0.f;
        for (int r = 0; r < 21; ++r) s += red[(r * 2 + set) * 96 + c];
        ((float*)(wsp(a) + WS_MOD))[((size_t)l * 2 + set) * 12288 + col0 + c] = s + ain(a, I_BMOD)[(size_t)l * 12288 + col0 + c]; }
    __syncthreads();
}
DI void h2_item(const Args& a, int it, LAS float* lds) {
    const int tid = otid(), l = it / (MT / 8), r0 = (it % (MT / 8)) * 8;
    LAS float* feats = lds;
    LAS float* h1 = lds + 8 * 36;
    if (tid < 8 * 33) { const int rr = tid / 33, i = tid % 33, r = r0 + rr; const int Lq = r < SEQ ? SEQ : CTXL, t = r < SEQ ? r : r - SEQ;
        float f;
        if (i == 0) f = (float)t / (float)(Lq - 1);
        else { const int bi = (i - 1) & 15; const float band = 1e-4f + (float)bi * ((15.0f - 1e-4f) / 15.0f); const float rev2 = 2.0f * band * (float)t / (float)Lq;
            f = (i <= 16) ? cospif(rev2) : -sinpif(rev2); }
        feats[rr * 36 + i] = f; }
    __syncthreads();
    const int rr = tid >> 6, j = tid & 63;
    { const float* w1 = ain(a, I_HYW1) + (size_t)l * 33 * 64; float s = ain(a, I_HYB1)[l * 64 + j];
      for (int i = 0; i < 33; ++i) s += feats[rr * 36 + i] * w1[i * 64 + j];
      h1[rr * 64 + j] = sinf(ain(a, I_HYFREQ)[l * 64 + j] * s); }
    __syncthreads();
    { const float* w2 = ain(a, I_HYW2) + (size_t)l * 64 * 64; float s = ain(a, I_HYB2)[l * 64 + j];
      for (int i = 0; i < 64; ++i) s += h1[rr * 64 + i] * w2[i * 64 + j];
      const float hv = sinf(ain(a, I_HYFREQ)[l * 64 + j] * s);
      ((float*)(wsp(a) + WS_H2))[((size_t)l * MT + r0 + rr) * 64 + j] = hv;
      if (r0 + rr < SEQ) { bf16* hb = (bf16*)(wsp(a) + WS_H2B) + ((size_t)l * SEQ + r0 + rr) * 256; hb[j] = f2bf(hv); hb[64 + j] = 0; hb[128 + j] = 0; hb[192 + j] = 0; } }
    __syncthreads();
}
DI void prologue_small(const Args& a) {
    const size_t gt = (size_t)obid() * NTHR + otid(), gs = (size_t)ogdim() * NTHR;
    float* zb = (float*)(wsp(a) + WS_ZBIAS);
    for (size_t i = gt; i < (size_t)DEPTH * ZC; i += gs) { const int l = (int)(i / ZC), zc = (int)(i % ZC), sc = z_srccol(zc); zb[i] = sc >= 0 ? ain(a, I_BIN)[(size_t)l * NCOLS_IN + sc] : 0.f; }
    float* lb = (float*)(wsp(a) + WS_LB);
    for (size_t i = gt; i < (size_t)DEPTH * 2048; i += gs) { const int l = (int)(i / 2048), j = (int)(i % 2048);
        float v = 0.f; if (l == 1) { const float r0 = ain(a, I_HGLB)[j], r1 = ain(a, I_HGLB)[2048 + j]; v = 1.0f / (1.0f + expf(r0 - r1)); }
        lb[i] = v; }
    bf16* w3t = (bf16*)(wsp(a) + WS_W3T);
    for (size_t i = gt; i < (size_t)DEPTH * 2048 * 256; i += gs) { const int l = (int)(i >> 19), fc = (int)((i >> 8) & 2047), j = (int)(i & 255); w3t[i] = j < 64 ? f2bf(ain(a, I_HYW3)[((size_t)l * 64 + j) * 2048 + fc]) : (bf16)0; }
    bf16* wrt = (bf16*)(wsp(a) + WS_WRT);
    for (size_t i = gt; i < (size_t)DEPTH * 48 * 2048; i += gs) { const int l = (int)(i / (48 * 2048)), c = (int)((i / 2048) % 48), k = (int)(i & 2047);
        const float w = c < 4 ? ain(a, I_WRG)[((size_t)l * D + k) * 4 + c] : (c < 36 ? ain(a, I_WRE)[((size_t)l * D + k) * 32 + (c - 4)] : 0.f);
        const bf16 hi = f2bf(w); wrt[((size_t)l * 2 + 0) * 48 * 2048 + (size_t)c * 2048 + k] = hi; wrt[((size_t)l * 2 + 1) * 48 * 2048 + (size_t)c * 2048 + k] = f2bf(w - bf2f(hi)); }
    float* tw = (float*)(wsp(a) + WS_TW);
    for (size_t i = gt; i < 16384; i += gs) { float s, c; sincospif(-2.0f * (float)i / 16384.0f, &s, &c); tw[2 * i] = c; tw[2 * i + 1] = s; }
    float* tw2 = (float*)(wsp(a) + WS_TW2);
    for (size_t i = gt; i <= 8192; i += gs) { float s, c; sincospif(-(float)i / 16384.0f, &s, &c); tw2[2 * i] = c; tw2[2 * i + 1] = s; }
}
DI void hyc_filters(const Args& a, int l) {
    const int lane = otid() & 63, wave = otid() >> 6;
    const float* h2 = (const float*)(wsp(a) + WS_H2) + ((size_t)l * MT + SEQ) * 64;
    const float* w3 = ain(a, I_HYW3) + (size_t)l * 64 * 2048;
    float* hyc = (float*)(wsp(a) + WS_HYC);
    const float a0 = -4.605170186f / 1.5f, a1 = -4.605170186f / 0.3f;
    for (int fc = obid() * 8 + wave; fc < 2048; fc += ogdim() * 8) {
        const int c = fc & 1023; const float delta = fabsf(a0 + (float)c * ((a1 - a0) / 1023.0f)); const float b3 = ain(a, I_HYB3)[l * 2048 + fc];
        float hv[4], ssum = 0.f;
#pragma unroll
        for (int i = 0; i < 4; ++i) { const int t = lane + 64 * i; float s = b3;
            for (int j = 0; j < 64; ++j) s += h2[t * 64 + j] * w3[j * 2048 + fc];
            const float tl = (float)t / 255.0f; hv[i] = s * (expf(-tl * delta) + 0.05f); ssum += fabsf(hv[i]); }
        ssum = wave_sum(ssum); const float inv = 1.0f / ssum;
#pragma unroll
        for (int i = 0; i < 4; ++i) hyc[(size_t)fc * 256 + lane + 64 * i] = hv[i] * inv;
    }
}
template <int MODE, bool DRY = false> DI void norm_phase(const Args& a, int l, int nrows, LAS float* ldsf) {
    const int lane = otid() & 63, wave = otid() >> 6;
    float* H = (float*)(wsp(a) + WS_H); bf16* U = (bf16*)(wsp(a) + WS_U);
    const float* modall = (const float*)(wsp(a) + WS_MOD);
    int* route = (int*)(wsp(a) + WS_ROUTE);
    const bf16* YP = (const bf16*)(wsp(a) + WS_YP);
    const bool combine = (MODE == 0 && l > 0) || MODE == 2;
    for (int r = obid() * 8 + wave; r < nrows; r += ogdim() * 8) {
        const int set = r >= SEQ ? 1 : 0;
        const float* src = (MODE == 0 && l == 0) ? (set ? ain(a, I_CTX) + (size_t)(r - SEQ) * D : ain(a, I_X) + (size_t)r * D) : H + (size_t)r * D;
        f32x4 v[8];
#pragma unroll
        for (int j = 0; j < 8; ++j) v[j] = *(const f32x4*)(src + j * 256 + lane * 4);
        if (combine) {
            const float* gt2 = modall + ((size_t)(l - 1) * 2 + set) * 12288 + 10240;
            const int p0 = route[r * 8 + 6], p1 = route[r * 8 + 7];
#pragma unroll
            for (int j = 0; j < 8; ++j) { const int col = j * 256 + lane * 4;
                const u32x2 y0 = *(const u32x2*)(YP + (size_t)p0 * D + col), y1 = *(const u32x2*)(YP + (size_t)p1 * D + col); const f32x4 g = *(const f32x4*)(gt2 + col);
                v[j][0] += g[0] * (bflo(y0.x) + bflo(y1.x)); v[j][1] += g[1] * (bfhi(y0.x) + bfhi(y1.x)); v[j][2] += g[2] * (bflo(y0.y) + bflo(y1.y)); v[j][3] += g[3] * (bfhi(y0.y) + bfhi(y1.y)); }
            if (MODE == 0) {
#pragma unroll
                for (int j = 0; j < 8; ++j) *(f32x4*)(H + (size_t)r * D + j * 256 + lane * 4) = v[j];
            }
        }
        float ss = 0.f;
#pragma unroll
        for (int j = 0; j < 8; ++j) ss += (v[j][0] * v[j][0] + v[j][1] * v[j][1]) + (v[j][2] * v[j][2] + v[j][3] * v[j][3]);
        ss = wave_sum(ss);
        const float rstd = rsqrtf(ss * (1.0f / D) + NORM_EPS);
        if (MODE == 2) {
            const float* fw = ain(a, I_FNW);
#ifdef PROBE_SEL
            const float pscale = 1.0f + (float)((LAS unsigned long long*)(ldsbase() + LDS_TIM))[PROBE_SEL] / (float)((LAS unsigned long long*)(ldsbase() + LDS_TIM))[0];
#else
            const float pscale = 1.0f;
#endif
#pragma unroll
            for (int j = 0; j < 8; ++j) { const int col = j * 256 + lane * 4; const f32x4 w = *(const f32x4*)(fw + col); *(f32x4*)(a.out + (size_t)r * D + col) = v[j] * rstd * w * pscale; }
        } else {
            const float* nw = (MODE == 0 ? ain(a, I_NMIXW) : ain(a, I_NFFNW)) + (size_t)l * D;
            const float* md = modall + ((size_t)l * 2 + set) * 12288 + (MODE == 0 ? 0 : 6144);
#pragma unroll
            for (int j = 0; j < 8; ++j) { const int col = j * 256 + lane * 4; const f32x4 w = *(const f32x4*)(nw + col), sh = *(const f32x4*)(md + col), sc = *(const f32x4*)(md + 2048 + col);
                v[j] = (v[j] * rstd * w) * (sc + 1.0f) + sh;
                u32x2 o; o.x = pk_bf16(v[j][0], v[j][1]); o.y = pk_bf16(v[j][2], v[j][3]); *(u32x2*)(U + (size_t)r * D + col) = o; }
            if (MODE == 1) {
                const float* wrg = ain(a, I_WRG) + (size_t)l * D * 4; const float* wre = ain(a, I_WRE) + (size_t)l * D * 32;
                float lg[36];
#pragma unroll
                for (int i = 0; i < 36; ++i) lg[i] = 0.f;
                LAS float* wu = ldsf + wave * 2048;
#pragma unroll
                for (int j = 0; j < 8; ++j) *(LAS f32x4*)(wu + j * 256 + lane * 4) = v[j];
                asm volatile("s_waitcnt lgkmcnt(0)" ::: "memory");
#pragma unroll 2
                for (int cc = 0; cc < 32; ++cc) { const int col = cc * 64 + lane; const float uv = wu[col];
                    const f32x4 g = *(const f32x4*)(wrg + (size_t)col * 4);
                    lg[0] += uv * g[0]; lg[1] += uv * g[1]; lg[2] += uv * g[2]; lg[3] += uv * g[3];
#pragma unroll
                    for (int e4 = 0; e4 < 8; ++e4) { const f32x4 w = *(const f32x4*)(wre + (size_t)col * 32 + e4 * 4);
                        lg[4 + e4 * 4 + 0] += uv * w[0]; lg[4 + e4 * 4 + 1] += uv * w[1]; lg[4 + e4 * 4 + 2] += uv * w[2]; lg[4 + e4 * 4 + 3] += uv * w[3]; } }
                asm volatile("s_waitcnt lgkmcnt(0)" ::: "memory");
#pragma unroll
                for (int i = 0; i < 36; ++i) lg[i] = wave_sum(lg[i]);
                float gl[4]; int grp = 0; float gmax;
#pragma unroll
                for (int g = 0; g < 4; ++g) gl[g] = lg[g] + ain(a, I_BRG)[l * 4 + g];
                gmax = gl[0];
#pragma unroll
                for (int g = 1; g < 4; ++g) if (gl[g] > gmax) { gmax = gl[g]; grp = g; }
                float gden = 0.f;
#pragma unroll
                for (int g = 0; g < 4; ++g) gden += expf(gl[g] - gmax);
                const float ptop = 1.0f / gden;
                float le[8];
#pragma unroll
                for (int i = 0; i < 8; ++i) { float x = lg[4 + i];
#pragma unroll
                    for (int g = 1; g < 4; ++g) x = (grp == g) ? lg[4 + g * 8 + i] : x;
                    le[i] = x + ain(a, I_BRE)[l * 32 + grp * 8 + i]; }
                int i0 = 0; float m0 = le[0];
#pragma unroll
                for (int i = 1; i < 8; ++i) if (le[i] > m0) { m0 = le[i]; i0 = i; }
                int i1 = -1; float m1 = -3.0e38f;
#pragma unroll
                for (int i = 0; i < 8; ++i) if (i != i0 && le[i] > m1) { m1 = le[i]; i1 = i; }
                const float e1v = expf(m1 - m0);
                const float w0 = ptop / (1.0f + e1v), w1 = ptop * e1v / (1.0f + e1v);
                if (DRY) { asm volatile("" :: "v"(w0), "v"(w1), "v"(i0), "v"(i1), "v"(grp)); }
                else if (lane == 0) {
                    unsigned* cnt = (unsigned*)(wsp(a) + WS_CTL) + CW_CNT + l * 64;
                    const int ex0 = grp * 8 + i0, ex1 = grp * 8 + i1;
                    const unsigned s0 = atomicAdd(cnt + ex0, 1u), s1 = atomicAdd(cnt + ex1, 1u);
                    route[r * 8 + 0] = ex0; route[r * 8 + 1] = ex1; route[r * 8 + 2] = (int)s0; route[r * 8 + 3] = (int)s1;
                    route[r * 8 + 4] = __float_as_int(w0); route[r * 8 + 5] = __float_as_int(w1);
                }
            }
        }
    }
}
typedef short bf16x8r_t __attribute__((ext_vector_type(8)));
template <bool DRY> DI void route_phase(const Args& a, int l, int nrows, LAS float* ldsf) {
    const int lane = otid() & 63, wave = otid() >> 6, fr = lane & 15, fq = lane >> 4;
    const float* H = (const float*)(wsp(a) + WS_H); bf16* U = (bf16*)(wsp(a) + WS_U); int* route = (int*)(wsp(a) + WS_ROUTE);
    const float* nw = ain(a, I_NFFNW) + (size_t)l * D;
    const bf16* Wh = (const bf16*)(wsp(a) + WS_WRT) + (size_t)l * 2 * 48 * 2048; const bf16* Wl = Wh + 48 * 2048;
    LAS float* lt = ldsf + wave * 1024;
    const int G = ogdim();
    for (int tile = wave * G + (int)obid(); tile < nrows / 16; tile += 8 * G) {
        const int row = tile * 16 + fr, set = row >= SEQ ? 1 : 0;
        const float* hr = H + (size_t)row * D + fq * 8;
        const float* md = (const float*)(wsp(a) + WS_MOD) + ((size_t)l * 2 + set) * 12288 + 6144 + fq * 8;
        float ss = 0.f;
#pragma unroll 8
        for (int ks = 0; ks < 64; ++ks) { const f32x4 x0 = *(const f32x4*)(hr + ks * 32), x1 = *(const f32x4*)(hr + ks * 32 + 4);
            ss += (x0[0] * x0[0] + x0[1] * x0[1]) + (x0[2] * x0[2] + x0[3] * x0[3]) + (x1[0] * x1[0] + x1[1] * x1[1]) + (x1[2] * x1[2] + x1[3] * x1[3]); }
        ss += __shfl_xor(ss, 16); ss += __shfl_xor(ss, 32);
        const float rstd = rsqrtf(ss * (1.0f / D) + NORM_EPS);
        f32x4 acc[3];
#pragma unroll
        for (int cb = 0; cb < 3; ++cb) acc[cb] = (f32x4){0.f, 0.f, 0.f, 0.f};
#pragma unroll 2
        for (int ks = 0; ks < 64; ++ks) { const int c0 = ks * 32;
            const f32x4 x0 = *(const f32x4*)(hr + c0), x1 = *(const f32x4*)(hr + c0 + 4);
            const f32x4 w0 = *(const f32x4*)(nw + fq * 8 + c0), w1 = *(const f32x4*)(nw + fq * 8 + c0 + 4);
            const f32x4 h0 = *(const f32x4*)(md + c0), h1 = *(const f32x4*)(md + c0 + 4), s0 = *(const f32x4*)(md + 2048 + c0), s1 = *(const f32x4*)(md + 2048 + c0 + 4);
            const f32x4 u0 = (x0 * rstd * w0) * (s0 + 1.0f) + h0, u1 = (x1 * rstd * w1) * (s1 + 1.0f) + h1;
            u32x4 hi; hi.x = pk_bf16(u0[0], u0[1]); hi.y = pk_bf16(u0[2], u0[3]); hi.z = pk_bf16(u1[0], u1[1]); hi.w = pk_bf16(u1[2], u1[3]);
            *(u32x4*)(U + (size_t)row * D + fq * 8 + c0) = hi;
            u32x4 lo; lo.x = pk_bf16(u0[0] - bflo(hi.x), u0[1] - bfhi(hi.x)); lo.y = pk_bf16(u0[2] - bflo(hi.y), u0[3] - bfhi(hi.y)); lo.z = pk_bf16(u1[0] - bflo(hi.z), u1[1] - bfhi(hi.z)); lo.w = pk_bf16(u1[2] - bflo(hi.w), u1[3] - bfhi(hi.w));
            const bf16x8r_t ah = __builtin_bit_cast(bf16x8r_t, hi), al = __builtin_bit_cast(bf16x8r_t, lo);
#pragma unroll
            for (int cb = 0; cb < 3; ++cb) { const bf16x8r_t bh = *(const bf16x8r_t*)(Wh + (size_t)(cb * 16 + fr) * 2048 + c0 + fq * 8), bl = *(const bf16x8r_t*)(Wl + (size_t)(cb * 16 + fr) * 2048 + c0 + fq * 8);
                acc[cb] = __builtin_amdgcn_mfma_f32_16x16x32_bf16(ah, bh, acc[cb], 0, 0, 0); acc[cb] = __builtin_amdgcn_mfma_f32_16x16x32_bf16(ah, bl, acc[cb], 0, 0, 0); acc[cb] = __builtin_amdgcn_mfma_f32_16x16x32_bf16(al, bh, acc[cb], 0, 0, 0); } }
#pragma unroll
        for (int cb = 0; cb < 3; ++cb)
#pragma unroll
            for (int j = 0; j < 4; ++j) lt[(fq * 4 + j) * 48 + cb * 16 + fr] = acc[cb][j];
        asm volatile("s_waitcnt lgkmcnt(0)" ::: "memory");
        if (lane < 16) {
            const int r = tile * 16 + lane; float lg[36];
#pragma unroll
            for (int i = 0; i < 36; ++i) lg[i] = lt[lane * 48 + i];
            float gl[4]; int grp = 0; float gmax;
#pragma unroll
            for (int g = 0; g < 4; ++g) gl[g] = lg[g] + ain(a, I_BRG)[l * 4 + g];
            gmax = gl[0];
#pragma unroll
            for (int g = 1; g < 4; ++g) if (gl[g] > gmax) { gmax = gl[g]; grp = g; }
            float gden = 0.f;
#pragma unroll
            for (int g = 0; g < 4; ++g) gden += expf(gl[g] - gmax);
            const float ptop = 1.0f / gden;
            float le[8];
#pragma unroll
            for (int i = 0; i < 8; ++i) { float x = lg[4 + i];
#pragma unroll
                for (int g = 1; g < 4; ++g) x = (grp == g) ? lg[4 + g * 8 + i] : x;
                le[i] = x + ain(a, I_BRE)[l * 32 + grp * 8 + i]; }
            int i0 = 0; float m0 = le[0];
#pragma unroll
            for (int i = 1; i < 8; ++i) if (le[i] > m0) { m0 = le[i]; i0 = i; }
            int i1 = -1; float m1 = -3.0e38f;
#pragma unroll
            for (int i = 0; i < 8; ++i) if (i != i0 && le[i] > m1) { m1 = le[i]; i1 = i; }
            const float e1v = expf(m1 - m0);
            const float w0 = ptop / (1.0f + e1v), w1 = ptop * e1v / (1.0f + e1v);
            if (DRY) { asm volatile("" :: "v"(w0), "v"(w1), "v"(i0), "v"(i1), "v"(grp)); }
            else { unsigned* cnt = (unsigned*)(wsp(a) + WS_CTL) + CW_CNT + l * 64; const int ex0 = grp * 8 + i0, ex1 = grp * 8 + i1;
                const unsigned s0 = atomicAdd(cnt + ex0, 1u), s1 = atomicAdd(cnt + ex1, 1u);
                route[r * 8 + 0] = ex0; route[r * 8 + 1] = ex1; route[r * 8 + 2] = (int)s0; route[r * 8 + 3] = (int)s1; route[r * 8 + 4] = __float_as_int(w0); route[r * 8 + 5] = __float_as_int(w1); }
        }
        asm volatile("s_waitcnt lgkmcnt(0)" ::: "memory");
    }
}
DI void permute_phase(const Args& a, int l, int nrows, LAS unsigned char* ldsb) {
    LAS int* poff = (LAS int*)ldsb;
    const int tid = otid(), lane = tid & 63, wave = tid >> 6;
    const unsigned* cnt = (const unsigned*)(wsp(a) + WS_CTL) + CW_CNT + l * 64;
    if (tid == 0) { int off = 0; for (int e = 0; e < NEXP; ++e) { poff[e] = off; off += (int)((cnt[e] + 255u) / 256u) * 256; } poff[32] = off; }
    __syncthreads();
    if (obid() == 0) { int* tile_e = (int*)(wsp(a) + WS_TILEE); const int nt = poff[32] >> 8;
        if (tid < 200) { int e = -1; if (tid < nt) { for (int q = 0; q < NEXP; ++q) if (poff[q] <= tid * 256) e = q; } tile_e[tid] = e < 0 ? 0 : e; }
        if (tid == 0) tile_e[200] = nt; }
    int* route = (int*)(wsp(a) + WS_ROUTE); float* roww = (float*)(wsp(a) + WS_ROWW);
    const bf16* U = (const bf16*)(wsp(a) + WS_U); bf16* XP = (bf16*)(wsp(a) + WS_XP);
    for (int r = obid() * 8 + wave; r < nrows; r += ogdim() * 8) {
        const int e0 = route[r * 8 + 0], e1 = route[r * 8 + 1], s0 = route[r * 8 + 2], s1 = route[r * 8 + 3];
        const int p0 = poff[e0] + s0, p1 = poff[e1] + s1;
        u32x4 x[4];
#pragma unroll
        for (int i = 0; i < 4; ++i) x[i] = *(const u32x4*)(U + (size_t)r * D + (i * 64 + lane) * 8);
#pragma unroll
        for (int i = 0; i < 4; ++i) { *(u32x4*)(XP + (size_t)p0 * D + (i * 64 + lane) * 8) = x[i]; *(u32x4*)(XP + (size_t)p1 * D + (i * 64 + lane) * 8) = x[i]; }
        if (lane == 0) { route[r * 8 + 6] = p0; route[r * 8 + 7] = p1; roww[p0] = __int_as_float(route[r * 8 + 4]); roww[p1] = __int_as_float(route[r * 8 + 5]); }
    }
}
DI int stream_row(int p, int dir) { return dir == 0 ? (p < CTXL ? SEQ + p : p - CTXL) : (p < CTXL ? SEQ + (CTXL - 1 - p) : (SEQ - 1) - (p - CTXL)); }

DI void shortconv8(const bf16* Z, const float* cw, const float* cb, int l, int seg, int c, int r0, int lo, int hi, float (&out)[8]) {
    const int col = Z_HY + seg * 1024 + c; float zz[10];
#pragma unroll
    for (int i = 0; i < 10; ++i) { const int r = r0 - 1 + i; zz[i] = (r >= lo && r < hi) ? bf2f(Z[(size_t)r * ZC + col]) : 0.f; }
    const float w0 = cw[((size_t)l * 3 + 0) * 3072 + seg * 1024 + c], w1 = cw[((size_t)l * 3 + 1) * 3072 + seg * 1024 + c], w2 = cw[((size_t)l * 3 + 2) * 3072 + seg * 1024 + c], b = cb[(size_t)l * 3072 + seg * 1024 + c];
#pragma unroll
    for (int i = 0; i < 8; ++i) out[i] = w0 * zz[i] + w1 * zz[i + 1] + w2 * zz[i + 2] + b;
}
DI void hyprep_item(const Args& a, int l, int it, LAS float* t) {
    const int tid = otid(), tb = it >> 4, cb = it & 15, r0 = tb * 64, lo = r0 < SEQ ? 0 : SEQ, hi = r0 < SEQ ? SEQ : MT;
    const bf16* Z = (const bf16*)(wsp(a) + WS_Z); float* VXT = (float*)(wsp(a) + WS_U);
    { const int cc = tid & 63, tq = tid >> 6, c = cb * 64 + cc; float x1[8], vv[8];
      shortconv8(Z, ain(a, I_HYCW), ain(a, I_HYCB), l, 1, c, r0 + tq * 8, lo, hi, x1); shortconv8(Z, ain(a, I_HYCW), ain(a, I_HYCB), l, 2, c, r0 + tq * 8, lo, hi, vv);
#pragma unroll
      for (int i = 0; i < 8; ++i) t[cc * 65 + tq * 8 + i] = vv[i] * x1[i]; }
    __syncthreads();
    { const int cw = tid >> 3, t8 = tid & 7; f32x4 o0, o1;
#pragma unroll
      for (int i = 0; i < 4; ++i) { o0[i] = t[cw * 65 + t8 * 8 + i]; o1[i] = t[cw * 65 + t8 * 8 + 4 + i]; }
      float* dst = VXT + (size_t)(cb * 64 + cw) * MT + r0 + t8 * 8; *(f32x4*)dst = o0; *(f32x4*)(dst + 4) = o1; }
    __syncthreads();
}
DI void hycomb_item(const Args& a, int l, int it, LAS float* t) {
    const int tid = otid(), tb = it >> 4, cb = it & 15, r0 = tb * 64, lo = r0 < SEQ ? 0 : SEQ, hi = r0 < SEQ ? SEQ : MT;
    const bf16* Z = (const bf16*)(wsp(a) + WS_Z); const float* VXT = (const float*)(wsp(a) + WS_CVO); bf16* Y0 = (bf16*)(wsp(a) + WS_YMIX);
    { const int cw = tid >> 3, t8 = tid & 7; const float* srcp = VXT + (size_t)(cb * 64 + cw) * MT + r0 + t8 * 8; const f32x4 i0 = *(const f32x4*)srcp, i1 = *(const f32x4*)(srcp + 4);
#pragma unroll
      for (int i = 0; i < 4; ++i) { t[cw * 65 + t8 * 8 + i] = i0[i]; t[cw * 65 + t8 * 8 + 4 + i] = i1[i]; } }
    __syncthreads();
    { const int cc = tid & 63, tq = tid >> 6, c = cb * 64 + cc; float x0[8];
      shortconv8(Z, ain(a, I_HYCW), ain(a, I_HYCB), l, 0, c, r0 + tq * 8, lo, hi, x0);
#pragma unroll
      for (int i = 0; i < 8; ++i) Y0[(size_t)(r0 + tq * 8 + i) * 1024 + c] = f2bf(t[cc * 65 + tq * 8 + i] * x0[i]); }
    __syncthreads();
}
DI void scancomb_rows(const Args& a, int l, int nrows) {
    const int lane = otid() & 63, wave = otid() >> 6;
    const bf16* Z = (const bf16*)(wsp(a) + WS_Z); const bf16* O = (const bf16*)(wsp(a) + WS_OSC);
    bf16* Y1 = (bf16*)(wsp(a) + WS_YMIX) + (size_t)MT * 1024; bf16* Y2 = Y1 + (size_t)MT * 1024;
    for (int r = obid() * 8 + wave; r < nrows; r += ogdim() * 8) {
#pragma unroll
        for (int i = 0; i < 4; ++i) { const int col = i * 256 + lane * 4;
            { const u32x2 pf = *(const u32x2*)(O + (size_t)r * 1024 + col), pb = *(const u32x2*)(O + ((size_t)MT + r) * 1024 + col); f32x4 o; o[0] = bflo(pf.x) + bflo(pb.x); o[1] = bfhi(pf.x) + bfhi(pb.x); o[2] = bflo(pf.y) + bflo(pb.y); o[3] = bfhi(pf.y) + bfhi(pb.y);
              float ss = (o[0] * o[0] + o[1] * o[1]) + (o[2] * o[2] + o[3] * o[3]);
              ss += __shfl_xor(ss, 16); ss += __shfl_xor(ss, 8); ss += __shfl_xor(ss, 4); ss += __shfl_xor(ss, 2); ss += __shfl_xor(ss, 1);
              const float rstd = rsqrtf(ss * (1.0f / 128.0f) + NORM_EPS);
              const f32x4 nw = *(const f32x4*)(ain(a, I_HGNW) + (size_t)l * 128 + (col & 127));
              const u32x2 g = *(const u32x2*)(Z + (size_t)r * ZC + Z_HG + 4096 + col);
              u32x2 w; w.x = pk_bf16(o[0] * rstd * nw[0] * sigmoidf_(bflo(g.x)), o[1] * rstd * nw[1] * sigmoidf_(bfhi(g.x)));
              w.y = pk_bf16(o[2] * rstd * nw[2] * sigmoidf_(bflo(g.y)), o[3] * rstd * nw[3] * sigmoidf_(bfhi(g.y)));
              *(u32x2*)(Y1 + (size_t)r * 1024 + col) = w; }
            { const u32x2 pf = *(const u32x2*)(O + ((size_t)2 * MT + r) * 1024 + col), pb = *(const u32x2*)(O + ((size_t)3 * MT + r) * 1024 + col); f32x4 o; o[0] = bflo(pf.x) + bflo(pb.x); o[1] = bfhi(pf.x) + bfhi(pb.x); o[2] = bflo(pf.y) + bflo(pb.y); o[3] = bfhi(pf.y) + bfhi(pb.y);
              float ss = (o[0] * o[0] + o[1] * o[1]) + (o[2] * o[2] + o[3] * o[3]); ss = wave_sum(ss);
              const float rstd = rsqrtf(ss * (1.0f / 256.0f) + NORM_EPS);
              const f32x4 nw = *(const f32x4*)(ain(a, I_GLNW) + (size_t)l * 256 + (col & 255));
              const u32x2 g = *(const u32x2*)(Z + (size_t)r * ZC + Z_GL + 2048 + col);
              u32x2 w; w.x = pk_bf16(o[0] * rstd * nw[0] * siluf_(bflo(g.x)), o[1] * rstd * nw[1] * siluf_(bfhi(g.x)));
              w.y = pk_bf16(o[2] * rstd * nw[2] * siluf_(bflo(g.y)), o[3] * rstd * nw[3] * siluf_(bfhi(g.y)));
              *(u32x2*)(Y2 + (size_t)r * 1024 + col) = w; }
        }
    }
}
typedef short bf16x8_t __attribute__((ext_vector_type(8)));
constexpr int SC_N = 65;
constexpr size_t KVS_GL_OFF = (size_t)16 * SC_N * 16384;
constexpr size_t WS_KVS = WS_WGU;
constexpr size_t WS_KD  = WS_WGU + 130 * MiB;
constexpr int SL_QM = 0, SL_KM = 17408, SL_Q0 = 34816, SL_KE = 52224, SL_VT = 70656, SL_PP = 107520, SL_TOT = 116736, SL_DD = 118784, SL_AFB = 119296;
static_assert(SL_AFB + 2048 <= 131072 && WS_KD + (size_t)24 * SC_N * 128 * 4 <= WS_H, "scan maps");
DI bf16x8_t lds_frag16(LAS unsigned char* p) { return *(LAS bf16x8_t*)p; }
DI bf16x8_t pack_bf16x8(const f32x4& lo, const f32x4& hi) { u32x4 w; w.x = pk_bf16(lo[0], lo[1]); w.y = pk_bf16(lo[2], lo[3]); w.z = pk_bf16(hi[0], hi[1]); w.w = pk_bf16(hi[2], hi[3]); return __builtin_bit_cast(bf16x8_t, w); }

template <bool GLA, bool OUT> DI void scan_walk(const Args& a, int l, int head, int dir, int sc, int dvh, LAS unsigned char* lds) {
    constexpr int NB = 1, DV = GLA ? 256 : 128;
    const int tid = otid(), lane = tid & 63, wave = tid >> 6, fr = lane & 15, fq = lane >> 4, nbase = dvh * 8 + wave;
    const bf16* Z = (const bf16*)(wsp(a) + WS_Z);
    const int stream = GLA ? 16 + head * 2 + dir : head * 2 + dir;
    float* kvs = (float*)(wsp(a) + WS_KVS) + (GLA ? KVS_GL_OFF + ((size_t)(stream - 16) * SC_N + sc) * 32768 : ((size_t)stream * SC_N + sc) * 16384);
    float* kd = (float*)(wsp(a) + WS_KD) + ((size_t)stream * SC_N + sc) * 128;
    LAS bf16* QM = (LAS bf16*)(lds + SL_QM); LAS bf16* KM = (LAS bf16*)(lds + SL_KM); LAS float* EB = (LAS float*)(lds + SL_Q0);
    LAS bf16* KE = (LAS bf16*)(lds + SL_KE); LAS bf16* VT = (LAS bf16*)(lds + SL_VT); LAS bf16* PP = (LAS bf16*)(lds + SL_PP);
    LAS float* TOT = (LAS float*)(lds + SL_TOT); LAS float* DD = (LAS float*)(lds + SL_DD); LAS bf16* AFB = (LAS bf16*)(lds + SL_AFB);
    const int k = (wave & 1) * 64 + lane, seg = wave >> 1;
    float lbv = 0.f, ba = 0.f, wa[16];
    if (!GLA) lbv = ((const float*)(wsp(a) + WS_LB))[((size_t)l * 2 + dir) * 1024 + head * 128 + k];
    else { ba = ain(a, I_GLBA)[((size_t)l * 2 + dir) * 512 + head * 128 + k];
#pragma unroll
        for (int rr = 0; rr < 16; ++rr) wa[rr] = ain(a, I_GLWA2)[(((size_t)l * 2 + dir) * 16 + rr) * 512 + head * 128 + k]; }
    f32x4 S[NB][8];
#pragma unroll
    for (int nb = 0; nb < NB; ++nb)
#pragma unroll
        for (int mb = 0; mb < 8; ++mb) { if (OUT) S[nb][mb] = *(const f32x4*)(kvs + (size_t)((nbase + nb) * 16 + fr) * 128 + mb * 16 + fq * 4); else S[nb][mb] = (f32x4){0.f, 0.f, 0.f, 0.f}; }
    float dlog = 0.f;
    const int which = (GLA ? 2 : 0) + dir;
    bf16* Odir = (bf16*)(wsp(a) + WS_OSC) + (size_t)which * MT * 1024;
    const int srow = tid >> 3, spc = (tid & 7) * 16;
    const int vcol = (GLA ? Z_GL + 1024 + head * 256 + dvh * 128 : Z_HG + 3072 + head * 128) + wave * 16;
    const int fcol = (GLA ? Z_GL + 512 + head * 128 : Z_HG + 1024 * (1 + dir) + head * 128) + spc, qcol = (GLA ? Z_GL + head * 128 : Z_HG + head * 128) + spc;
    u32x4 pv0, pv1, pf0, pf1, pq0 = {0u, 0u, 0u, 0u}, pq1 = {0u, 0u, 0u, 0u}, pa = {0u, 0u, 0u, 0u};
#define SCAN_ISSUE(cidx) do { const int r0n_ = dir ? stream_row((cidx) * 64 + 63, 1) : stream_row((cidx) * 64, 0); \
        const bf16* vr_ = Z + (size_t)(r0n_ + lane) * ZC + vcol; pv0 = *(const u32x4*)vr_; pv1 = *(const u32x4*)(vr_ + 8); \
        const bf16* zr_ = Z + (size_t)(r0n_ + srow) * ZC; pf0 = *(const u32x4*)(zr_ + fcol); pf1 = *(const u32x4*)(zr_ + fcol + 8); \
        if (OUT) { pq0 = *(const u32x4*)(zr_ + qcol); pq1 = *(const u32x4*)(zr_ + qcol + 8); } \
        if (GLA && tid < 128) pa = *(const u32x4*)(Z + (size_t)(r0n_ + (tid >> 1)) * ZC + Z_LR + dir * 16 + (tid & 1) * 8); } while (0)
    SCAN_ISSUE(sc * 4);
    for (int cc = 0; cc < 4; ++cc) {
        const int c = sc * 4 + cc; const int r0 = dir ? stream_row(c * 64 + 63, 1) : stream_row(c * 64, 0);
        {
#pragma unroll
          for (int q8 = 0; q8 < 2; ++q8) { const u32x4 v = q8 ? pv1 : pv0; const int d0 = wave * 16 + q8 * 8;
              VT[(d0 + 0) * 72 + lane] = (bf16)(v.x & 0xffff); VT[(d0 + 1) * 72 + lane] = (bf16)(v.x >> 16); VT[(d0 + 2) * 72 + lane] = (bf16)(v.y & 0xffff); VT[(d0 + 3) * 72 + lane] = (bf16)(v.y >> 16);
              VT[(d0 + 4) * 72 + lane] = (bf16)(v.z & 0xffff); VT[(d0 + 5) * 72 + lane] = (bf16)(v.z >> 16); VT[(d0 + 6) * 72 + lane] = (bf16)(v.w & 0xffff); VT[(d0 + 7) * 72 + lane] = (bf16)(v.w >> 16); }
          *(LAS u32x4*)(KM + srow * 136 + spc) = pf0; *(LAS u32x4*)(KM + srow * 136 + spc + 8) = pf1;
          if (OUT) { *(LAS u32x4*)(QM + srow * 136 + spc) = pq0; *(LAS u32x4*)(QM + srow * 136 + spc + 8) = pq1; }
          if (GLA && tid < 128) *(LAS u32x4*)(AFB + (tid >> 1) * 16 + (tid & 1) * 8) = pa;
          if (cc < 3) SCAN_ISSUE(c + 1); }
        LDS_BAR();
        const int tstart = dir ? 63 - seg * 16 : seg * 16, tstep = dir ? -1 : 1;
        float cs[16], kkv[GLA ? 1 : 16]; float run = 0.f;
#ifdef REPMASK
        _Pragma("unroll 1") for (int rp1 = 0; rp1 < (((REPMASK) >> 24) & 1 ? 3 : 1); ++rp1) { run = 0.f;
#else
        {
#endif
#pragma unroll
        for (int i = 0; i < 16; ++i) { const int t = tstart + i * tstep; float la;
            if (!GLA) { const float zf = bf2f(KM[t * 136 + k]); const float sg = sigmoidf_(zf); la = __logf(lbv + (1.0f - lbv) * sg); kkv[i] = (1.0f - lbv) * (1.0f - sg); }
            else { float x = ba; const u32x4 a0 = *(LAS u32x4*)(AFB + t * 16), a1 = *(LAS u32x4*)(AFB + t * 16 + 8);
                x += bflo(a0.x) * wa[0] + bfhi(a0.x) * wa[1] + bflo(a0.y) * wa[2] + bfhi(a0.y) * wa[3] + bflo(a0.z) * wa[4] + bfhi(a0.z) * wa[5] + bflo(a0.w) * wa[6] + bfhi(a0.w) * wa[7];
                x += bflo(a1.x) * wa[8] + bfhi(a1.x) * wa[9] + bflo(a1.y) * wa[10] + bfhi(a1.y) * wa[11] + bflo(a1.z) * wa[12] + bfhi(a1.z) * wa[13] + bflo(a1.w) * wa[14] + bfhi(a1.w) * wa[15];
                la = (fminf(x, 0.f) - log1pf(__expf(-fabsf(x)))) * 0.0625f; }
            run += la; cs[i] = run; if (GLA || (i & 3) == 3) asm volatile("" ::: "memory"); }
        }
        TOT[seg * 128 + k] = run;
        LDS_BAR();
        { const float t0 = TOT[k], t1 = TOT[128 + k], t2 = TOT[256 + k], t3 = TOT[384 + k];
          const float off = seg == 0 ? 0.f : (seg == 1 ? t0 : (seg == 2 ? t0 + t1 : t0 + t1 + t2)), blast = (t0 + t1) + (t2 + t3), bref = t0 + t1;
          float ke[16];
#pragma unroll
          for (int i = 0; i < 16; ++i) { const int t = tstart + i * tstep; const float b = off + cs[i];
              float kk; if (GLA) kk = bf2f(KM[t * 136 + k]); else kk = kkv[i];
              if (OUT) { const float qr = bf2f(QM[t * 136 + k]); const float qv = GLA ? qr * 0.08838834764831845f : siluf_(qr);
                  QM[t * 136 + k] = f2bf(qv * __expf(b - bref)); KM[t * 136 + k] = f2bf(kk * __expf(bref - b)); }
              ke[i] = kk * __expf(blast - b); if ((i & 3) == 3) asm volatile("" ::: "memory"); }
          if (OUT && seg == 0) EB[k] = __expf(bref);
          const int tb0 = dir ? 48 - seg * 16 : seg * 16; u32x4 w0, w1;
          if (dir) { w0.x = pk_bf16(ke[15], ke[14]); w0.y = pk_bf16(ke[13], ke[12]); w0.z = pk_bf16(ke[11], ke[10]); w0.w = pk_bf16(ke[9], ke[8]); w1.x = pk_bf16(ke[7], ke[6]); w1.y = pk_bf16(ke[5], ke[4]); w1.z = pk_bf16(ke[3], ke[2]); w1.w = pk_bf16(ke[1], ke[0]); }
          else     { w0.x = pk_bf16(ke[0], ke[1]); w0.y = pk_bf16(ke[2], ke[3]); w0.z = pk_bf16(ke[4], ke[5]); w0.w = pk_bf16(ke[6], ke[7]); w1.x = pk_bf16(ke[8], ke[9]); w1.y = pk_bf16(ke[10], ke[11]); w1.z = pk_bf16(ke[12], ke[13]); w1.w = pk_bf16(ke[14], ke[15]); }
          *(LAS u32x4*)(KE + k * 72 + tb0) = w0; *(LAS u32x4*)(KE + k * 72 + tb0 + 8) = w1;
          if (seg == 0) DD[k] = __expf(blast);
          dlog += blast; }
        LDS_BAR();
        bf16x8_t Bv[NB][2];
#pragma unroll
        for (int nb = 0; nb < NB; ++nb)
#pragma unroll
            for (int ks = 0; ks < 2; ++ks) Bv[nb][ks] = lds_frag16(lds + SL_VT + ((wave * 16 + fr) * 72 + ks * 32 + fq * 8) * 2);
        if (OUT) {
#ifdef REPMASK
          _Pragma("unroll 1") for (int rp2 = 0; rp2 < (((REPMASK) >> 25) & 1 ? 3 : 1); ++rp2) { if (rp2) LDS_BAR();
#else
          {
#endif
            { const int tb = wave >> 1;
#pragma unroll
              for (int sbi = 0; sbi < 2; ++sbi) { const int sb = (wave & 1) * 2 + sbi; f32x4 acc = {0.f, 0.f, 0.f, 0.f};
#pragma unroll
                  for (int ks = 0; ks < 4; ++ks) acc = __builtin_amdgcn_mfma_f32_16x16x32_bf16(lds_frag16(lds + SL_QM + ((tb * 16 + fr) * 136 + ks * 32 + fq * 8) * 2), lds_frag16(lds + SL_KM + ((sb * 16 + fr) * 136 + ks * 32 + fq * 8) * 2), acc, 0, 0, 0);
#pragma unroll
                  for (int j = 0; j < 4; ++j) { const int t = tb * 16 + fq * 4 + j, s = sb * 16 + fr; const bool keep = dir ? (s >= t) : (s <= t); PP[t * 72 + s] = keep ? f2bf(acc[j]) : (bf16)0; } } }
            LDS_BAR();
#pragma unroll
            for (int nb = 0; nb < NB; ++nb) {
                bf16x8_t Bs[4];
#pragma unroll
                for (int ks = 0; ks < 4; ++ks) { const f32x4 e0 = *(LAS f32x4*)(EB + (2 * ks) * 16 + fq * 4), e1 = *(LAS f32x4*)(EB + (2 * ks + 1) * 16 + fq * 4); Bs[ks] = pack_bf16x8(S[nb][2 * ks] * e0, S[nb][2 * ks + 1] * e1); }
#pragma unroll
                for (int mb = 0; mb < 4; ++mb) {
                    f32x4 O = {0.f, 0.f, 0.f, 0.f};
#pragma unroll
                    for (int ks = 0; ks < 2; ++ks) O = __builtin_amdgcn_mfma_f32_16x16x32_bf16(lds_frag16(lds + SL_PP + ((mb * 16 + fr) * 72 + ks * 32 + fq * 8) * 2), Bv[nb][ks], O, 0, 0, 0);
#pragma unroll
                    for (int ks = 0; ks < 4; ++ks) { u32x4 aw; const u32x2 lo = *(LAS u32x2*)(lds + SL_QM + ((mb * 16 + fr) * 136 + (2 * ks) * 16 + fq * 4) * 2), hi = *(LAS u32x2*)(lds + SL_QM + ((mb * 16 + fr) * 136 + (2 * ks + 1) * 16 + fq * 4) * 2);
                        aw.x = lo.x; aw.y = lo.y; aw.z = hi.x; aw.w = hi.y;
                        O = __builtin_amdgcn_mfma_f32_16x16x32_bf16(__builtin_bit_cast(bf16x8_t, aw), Bs[ks], O, 0, 0, 0); }
#pragma unroll
                    for (int j = 0; j < 4; ++j) Odir[(size_t)(r0 + mb * 16 + fq * 4 + j) * 1024 + head * DV + (nbase + nb) * 16 + fr] = f2bf(O[j]);
                    asm volatile("" ::: "memory");
                }
            }
          }
        }
        if (!OUT || cc < 3) {
#pragma unroll
            for (int mb = 0; mb < 8; ++mb) { const f32x4 dd = *(LAS f32x4*)(DD + mb * 16 + fq * 4);
                const bf16x8_t A0 = lds_frag16(lds + SL_KE + ((mb * 16 + fr) * 72 + fq * 8) * 2), A1 = lds_frag16(lds + SL_KE + ((mb * 16 + fr) * 72 + 32 + fq * 8) * 2);
#pragma unroll
                for (int nb = 0; nb < NB; ++nb) { S[nb][mb] = S[nb][mb] * dd; S[nb][mb] = __builtin_amdgcn_mfma_f32_16x16x32_bf16(A0, Bv[nb][0], S[nb][mb], 0, 0, 0); S[nb][mb] = __builtin_amdgcn_mfma_f32_16x16x32_bf16(A1, Bv[nb][1], S[nb][mb], 0, 0, 0); }
                asm volatile("" ::: "memory"); }
        }
        LDS_BAR();
    }
    if (!OUT) {
#pragma unroll
        for (int nb = 0; nb < NB; ++nb)
#pragma unroll
            for (int mb = 0; mb < 8; ++mb) *(f32x4*)(kvs + (size_t)((nbase + nb) * 16 + fr) * 128 + mb * 16 + fq * 4) = S[nb][mb];
        if (seg == 0) kd[k] = __expf(dlog);
    }
}
#undef SCAN_ISSUE
DI void scan_prop(const Args& a) {
    float* kvs = (float*)(wsp(a) + WS_KVS); const float* kd = (const float*)(wsp(a) + WS_KD);
    for (int g = obid() * NTHR + otid(); g < 131072; g += ogdim() * NTHR) {
        float* p; size_t stride; const float* dp;
        if (g < 65536) { const int stream = g >> 12, e = g & 4095; p = kvs + (size_t)stream * SC_N * 16384 + (size_t)e * 4; stride = 16384; dp = kd + (size_t)stream * SC_N * 128 + (e & 31) * 4; }
        else { const int q = g - 65536, stream = q >> 13, e = q & 8191; p = kvs + KVS_GL_OFF + (size_t)stream * SC_N * 32768 + (size_t)e * 4; stride = 32768; dp = kd + (size_t)(16 + stream) * SC_N * 128 + (e & 31) * 4; }
        f32x4 S = {0.f, 0.f, 0.f, 0.f};
#pragma unroll 5
        for (int sc = 0; sc < SC_N; ++sc) { const f32x4 kv = *(const f32x4*)(p + sc * stride), d = *(const f32x4*)(dp + sc * 128); *(f32x4*)(p + sc * stride) = S; S = d * S + kv; }
    }
}
constexpr int SCAN_ITEMS = 32 * SC_N;
template <bool OUT> DI void scan_item2(const Args& a, int l, int it, LAS unsigned char* lds) {
    if (it < 16 * SC_N) { const int s = it / SC_N, sc = it % SC_N; if (OUT && l == DEPTH - 1 && sc == 0) return; scan_walk<true, OUT>(a, l, s >> 2, (s >> 1) & 1, sc, s & 1, lds); }
    else { const int j = it - 16 * SC_N, s = j / SC_N, sc = j % SC_N; if (OUT && l == DEPTH - 1 && sc == 0) return; scan_walk<false, OUT>(a, l, s >> 1, s & 1, sc, 0, lds); }
}
DI void hyconv_item(const Args& a, int l, int c, LAS unsigned char* ldsb) {
    const int tid = otid();
    LAS float* lds = (LAS float*)ldsb;
    LAS float* xs = (LAS float*)(ldsb + LDS_X);
    const float* tw = (const float*)(wsp(a) + WS_TW); const float* tw2 = (const float*)(wsp(a) + WS_TW2);
    const float* h2 = (const float*)(wsp(a) + WS_H2) + (size_t)l * MT * 64;
    const float* VX = (const float*)(wsp(a) + WS_U) + (size_t)c * MT; float* VO = (float*)(wsp(a) + WS_CVO) + (size_t)c * MT;
#ifdef REPMASK
    _Pragma("unroll 1") for (int rpa = 0; rpa < (((REPMASK) >> 21) & 1 ? 2 : 1); ++rpa) { if (rpa) __syncthreads();
#else
    {
#endif
    const float* HFf = (const float*)(wsp(a) + WS_HF) + (size_t)c * SEQ; const float* HFb = HFf + (size_t)1024 * SEQ;
    const float a0 = -4.605170186f / 1.5f, a1 = -4.605170186f / 0.3f;
    const float nd = -fabsf(a0 + (float)c * ((a1 - a0) / 1023.0f)) * (1.0f / (float)(SEQ - 1));
    const float b3f = ain(a, I_HYB3)[l * 2048 + c], b3b = ain(a, I_HYB3)[l * 2048 + 1024 + c];
    float sf = 0.f, sb = 0.f;
    for (int i = 0; i < 8; ++i) { const int t4 = (tid + 512 * i) * 4; f32x4 hf = *(const f32x4*)(HFf + t4), hb = *(const f32x4*)(HFb + t4);
#pragma unroll
        for (int q = 0; q < 4; ++q) { const float dec = __expf(nd * (float)(t4 + q)) + 0.05f; hf[q] = (hf[q] + b3f) * dec; hb[q] = (hb[q] + b3b) * dec; }
        sf += (fabsf(hf[0]) + fabsf(hf[1])) + (fabsf(hf[2]) + fabsf(hf[3])); sb += (fabsf(hb[0]) + fabsf(hb[1])) + (fabsf(hb[2]) + fabsf(hb[3]));
        *(LAS f32x4*)(lds + t4) = hf;
#pragma unroll
        for (int q = 0; q < 4; ++q) { const int t = t4 + q; if (t > 0) lds[32768 - t] = hb[q]; else xs[160] = hb[q]; } }
    sf = wave_sum(sf); sb = wave_sum(sb);
    if ((tid & 63) == 0) { xs[128 + (tid >> 6)] = sf; xs[136 + (tid >> 6)] = sb; }
    __syncthreads();
    float tf = 0.f, tb = 0.f;
#pragma unroll
    for (int w = 0; w < 8; ++w) { tf += xs[128 + w]; tb += xs[136 + w]; }
    const float inf_ = 1.0f / tf, inb_ = 1.0f / tb;
    for (int i = 0; i < 64; ++i) { const int m = tid + 512 * i; float v = lds[m];
        if (m == 0) v = v * inf_ + xs[160] * inb_ + ain(a, I_HYSKIP)[l * 1024 + c];
        else if (m < SEQ) v *= inf_; else if (m == SEQ) v = 0.f; else v *= inb_;
        lds[m] = v; }
    __syncthreads();
    }
    { FftTw T; fft_load_tw(T, tw, tid);
    fft_fwd_pass<4096>(lds, T, tw, tid); LDS_BAR(); fft_fwd_pass<1024>(lds, T, tw, tid); LDS_BAR(); fft_fwd_pass<256>(lds, T, tw, tid); LDS_BAR(); fft_fwd_pass<64>(lds, T, tw, tid); LDS_BAR();
    fft_fwd_pass<16>(lds, T, tw, tid); LDS_BAR(); fft_fwd_pass<4>(lds, T, tw, tid); LDS_BAR(); fft_fwd_pass<1>(lds, T, tw, tid); LDS_BAR(); }
#ifdef REPMASK
    if (((REPMASK) >> 22) & 1) { FftTw T; fft_load_tw(T, tw, tid);
        fft_inv_pass<1>(lds, T, tw, tid); LDS_BAR(); fft_inv_pass<4>(lds, T, tw, tid); LDS_BAR(); fft_inv_pass<16>(lds, T, tw, tid); LDS_BAR(); fft_inv_pass<64>(lds, T, tw, tid); LDS_BAR();
        fft_inv_pass<256>(lds, T, tw, tid); LDS_BAR(); fft_inv_pass<1024>(lds, T, tw, tid); LDS_BAR(); fft_inv_pass<4096>(lds, T, tw, tid); LDS_BAR();
        for (int i = 0; i < 64; ++i) lds[tid + 512 * i] *= (1.0f / FFT_M);
        LDS_BAR();
        fft_fwd_pass<4096>(lds, T, tw, tid); LDS_BAR(); fft_fwd_pass<1024>(lds, T, tw, tid); LDS_BAR(); fft_fwd_pass<256>(lds, T, tw, tid); LDS_BAR(); fft_fwd_pass<64>(lds, T, tw, tid); LDS_BAR();
        fft_fwd_pass<16>(lds, T, tw, tid); LDS_BAR(); fft_fwd_pass<4>(lds, T, tw, tid); LDS_BAR(); fft_fwd_pass<1>(lds, T, tw, tid); LDS_BAR(); }
#endif

    float* Gs = (float*)(wsp(a) + WS_YMIX) + (size_t)obid() * 32768;
    const int kbase = ((tid & 63) << 7) | ((tid >> 6) << 4);
#ifdef REPMASK
    _Pragma("unroll 1") for (int rpc = 0; rpc < (((REPMASK) >> 23) & 1 ? 2 : 1); ++rpc)
#endif
#pragma unroll 4
    for (int j = 0; j < 16; ++j) { const int k = kbase | j; cpx gk, gm; rfft_untangle(lds, tw2, k, gk, gm); f32x4 g4; g4[0] = gk.x; g4[1] = gk.y; g4[2] = gm.x; g4[3] = gm.y; *(f32x4*)(Gs + (size_t)(j * 512 + tid) * 4) = g4; }
    __syncthreads();
    for (int i = 0; i < 16; ++i) { const int m4 = tid + 512 * i; f32x4 v = {0.f, 0.f, 0.f, 0.f}; if (m4 < SEQ / 4) v = *(const f32x4*)(VX + m4 * 4); *(LAS f32x4*)(lds + m4 * 4) = v; }
    __syncthreads();
    { FftTw T; fft_load_tw(T, tw, tid);
    fft_fwd_pass<4096>(lds, T, tw, tid); LDS_BAR(); fft_fwd_pass<1024>(lds, T, tw, tid); LDS_BAR(); fft_fwd_pass<256>(lds, T, tw, tid); LDS_BAR(); fft_fwd_pass<64>(lds, T, tw, tid); LDS_BAR();
    fft_fwd_pass<16>(lds, T, tw, tid); LDS_BAR(); fft_fwd_pass<4>(lds, T, tw, tid); LDS_BAR(); fft_fwd_pass<1>(lds, T, tw, tid); LDS_BAR(); }
#pragma unroll 4
    for (int j = 0; j < 16; ++j) { const int k = kbase | j; const f32x4 g4 = *(const f32x4*)(Gs + (size_t)(j * 512 + tid) * 4); cpx gk, gm; gk.x = g4[0]; gk.y = g4[1]; gm.x = g4[2]; gm.y = g4[3]; rfft_mul_retangle(lds, tw2, k, gk, gm); }
    __syncthreads();
    { FftTw T; fft_load_tw(T, tw, tid);
    fft_inv_pass<1>(lds, T, tw, tid); LDS_BAR(); fft_inv_pass<4>(lds, T, tw, tid); LDS_BAR(); fft_inv_pass<16>(lds, T, tw, tid); LDS_BAR(); fft_inv_pass<64>(lds, T, tw, tid); LDS_BAR();
    fft_inv_pass<256>(lds, T, tw, tid); LDS_BAR(); fft_inv_pass<1024>(lds, T, tw, tid); LDS_BAR(); fft_inv_pass<4096>(lds, T, tw, tid); LDS_BAR(); }
    for (int i = 0; i < 8; ++i) { const int m4 = tid + 512 * i; f32x4 v = *(const LAS f32x4*)(lds + m4 * 4); *(f32x4*)(VO + m4 * 4) = v * (1.0f / FFT_M); }
    __syncthreads();
}
DI void hycctx_item(const Args& a, int l, int it, LAS unsigned char* ldsb) {
    const int tid = otid(), c0 = it * 16;
    LAS float* sv = (LAS float*)ldsb;
    LAS float* sf = sv + 16 * 256;
    LAS float* sb = sf + 16 * 256;
    const float* hyc = (const float*)(wsp(a) + WS_HYC); const float* VXT = (const float*)(wsp(a) + WS_U); float* CVO = (float*)(wsp(a) + WS_CVO);
    for (int i = tid; i < 16 * 256; i += NTHR) { const int ch = i >> 8, t = i & 255; sv[i] = VXT[(size_t)(c0 + ch) * MT + SEQ + t]; sf[i] = hyc[(size_t)(c0 + ch) * 256 + t]; sb[i] = hyc[(size_t)(1024 + c0 + ch) * 256 + t]; }
    __syncthreads();
    const int ch = tid >> 5, tq = tid & 31; const float g0 = sf[ch * 256] + sb[ch * 256] + ain(a, I_HYSKIP)[l * 1024 + c0 + ch];
    float acc[8];
#pragma unroll
    for (int i = 0; i < 8; ++i) acc[i] = 0.f;
    for (int s = 0; s < 256; ++s) { const float vv = sv[ch * 256 + s];
#pragma unroll
        for (int i = 0; i < 8; ++i) { const int d = tq * 8 + i - s; const float g = d > 0 ? sf[ch * 256 + d] : (d < 0 ? sb[ch * 256 - d] : g0); acc[i] += g * vv; } }
    __syncthreads();
#pragma unroll
    for (int i = 0; i < 8; ++i) CVO[(size_t)(c0 + ch) * MT + SEQ + tq * 8 + i] = acc[i];
    __syncthreads();
}

struct EpiHF {
    static constexpr bool PERM = false, AFTER_DRAIN = false; float* O;
    DI void operator()(const f32x4 (&acc)[2][2][4][2], const pg8::Unit& u, int wr, int wc, int fr, int fq) const {
        const int row0 = u.pm * 256 + wr * 64 + fr, col0 = u.pn * 256 + wc * 32 + 4 * fq;
#pragma unroll
        for (int ai = 0; ai < 2; ++ai)
#pragma unroll
            for (int m = 0; m < 4; ++m) { float* rowp = O + (size_t)(row0 + ai * 128 + m * 16) * SEQ + col0;
#pragma unroll
                for (int bj = 0; bj < 2; ++bj)
#pragma unroll
                    for (int n = 0; n < 2; ++n) *(f32x4*)(rowp + bj * 128 + n * 16) = acc[ai][bj][m][n]; }
    }
};
struct EpiZ {
    static constexpr bool PERM = true, AFTER_DRAIN = false; bf16* O; const float* bias;
    DI void operator()(const f32x4 (&acc)[2][2][4][2], const pg8::Unit& u, int wr, int wc, int fr, int fq) const {
        const int row0 = u.pm * 256 + wr * 64 + fr, col0 = u.pn * 256 + wc * 32 + 8 * fq;
        f32x4 bv[2][2];
#pragma unroll
        for (int bj = 0; bj < 2; ++bj)
#pragma unroll
            for (int n = 0; n < 2; ++n) bv[bj][n] = *(const f32x4*)(bias + col0 + bj * 128 + 4 * n);
#pragma unroll
        for (int ai = 0; ai < 2; ++ai)
#pragma unroll
            for (int m = 0; m < 4; ++m) { bf16* rowp = O + (size_t)(row0 + ai * 128 + m * 16) * ZC + col0;
#pragma unroll
                for (int bj = 0; bj < 2; ++bj) { const f32x4 v0 = acc[ai][bj][m][0] + bv[bj][0], v1 = acc[ai][bj][m][1] + bv[bj][1];
                    u32x4 w; w.x = pk_bf16(v0[0], v0[1]); w.y = pk_bf16(v0[2], v0[3]); w.z = pk_bf16(v1[0], v1[1]); w.w = pk_bf16(v1[2], v1[3]);
                    *(u32x4*)(rowp + bj * 128) = w; } }
    }
};
template <int BR> struct EpiBr {
    static constexpr bool PERM = true, AFTER_DRAIN = false; bf16* Mg; const bf16* Zg;
    DI void operator()(const f32x4 (&acc)[2][2][4][2], const pg8::Unit& u, int wr, int wc, int fr, int fq) const {
        const int row0 = u.pm * 256 + wr * 64 + fr, col0 = u.pn * 256 + wc * 32 + 8 * fq;
#pragma unroll
        for (int ai = 0; ai < 2; ++ai)
#pragma unroll
            for (int m = 0; m < 4; ++m) { const size_t row = (size_t)(row0 + ai * 128 + m * 16);
#pragma unroll
                for (int bj = 0; bj < 2; ++bj) { const int col = col0 + bj * 128;
                    const u32x4 g = *(const u32x4*)(Zg + row * ZC + col);
                    f32x4 v0 = acc[ai][bj][m][0], v1 = acc[ai][bj][m][1];
                    v0[0] *= sigmoidf_(bflo(g.x)); v0[1] *= sigmoidf_(bfhi(g.x)); v0[2] *= sigmoidf_(bflo(g.y)); v0[3] *= sigmoidf_(bfhi(g.y));
                    v1[0] *= sigmoidf_(bflo(g.z)); v1[1] *= sigmoidf_(bfhi(g.z)); v1[2] *= sigmoidf_(bflo(g.w)); v1[3] *= sigmoidf_(bfhi(g.w));
                    if (BR > 0) { const u32x4 p = *(const u32x4*)(Mg + row * D + col);
                        v0[0] += bflo(p.x); v0[1] += bfhi(p.x); v0[2] += bflo(p.y); v0[3] += bfhi(p.y); v1[0] += bflo(p.z); v1[1] += bfhi(p.z); v1[2] += bflo(p.w); v1[3] += bfhi(p.w); }
                    u32x4 w; w.x = pk_bf16(v0[0], v0[1]); w.y = pk_bf16(v0[2], v0[3]); w.z = pk_bf16(v1[0], v1[1]); w.w = pk_bf16(v1[2], v1[3]);
                    *(u32x4*)(Mg + row * D + col) = w; } }
    }
};
struct EpiOut {
    static constexpr bool PERM = false, AFTER_DRAIN = false; const float* hin_main; const float* hin_ctx; float* hout; const float* gt1;
    DI void operator()(const f32x4 (&acc)[2][2][4][2], const pg8::Unit& u, int wr, int wc, int fr, int fq) const {
        const int row0 = u.pm * 256 + wr * 64 + fr, col0 = u.pn * 256 + wc * 32 + 4 * fq; const bool isctx = u.pm >= SEQ / 256;
        const float* g = gt1 + (isctx ? 12288 : 0);
        f32x4 gv[2][2];
#pragma unroll
        for (int bj = 0; bj < 2; ++bj)
#pragma unroll
            for (int n = 0; n < 2; ++n) gv[bj][n] = *(const f32x4*)(g + col0 + bj * 128 + n * 16);
#pragma unroll
        for (int ai = 0; ai < 2; ++ai)
#pragma unroll
            for (int m = 0; m < 4; ++m) { const int row = row0 + ai * 128 + m * 16;
                const float* ip = (isctx ? hin_ctx + (size_t)(row - SEQ) * D : hin_main + (size_t)row * D) + col0; float* op = hout + (size_t)row * D + col0;
#pragma unroll
                for (int bj = 0; bj < 2; ++bj)
#pragma unroll
                    for (int n = 0; n < 2; ++n) { const f32x4 b = *(const f32x4*)(ip + bj * 128 + n * 16); *(f32x4*)(op + bj * 128 + n * 16) = b + gv[bj][n] * acc[ai][bj][m][n]; } }
    }
};
struct EpiGU {
    static constexpr bool PERM = true, AFTER_DRAIN = false; bf16* Hm;
    DI void operator()(const f32x4 (&acc)[2][2][4][2], const pg8::Unit& u, int wr, int wc, int fr, int fq) const {
        const int row0 = u.pm * 256 + wr * 64 + fr, col0 = (u.pn & 3) * 128 + wc * 32 + 8 * fq;
#pragma unroll
        for (int ai = 0; ai < 2; ++ai)
#pragma unroll
            for (int m = 0; m < 4; ++m) { const f32x4 g0 = acc[ai][0][m][0], g1 = acc[ai][0][m][1], u0 = acc[ai][1][m][0], u1 = acc[ai][1][m][1];
                u32x4 w; w.x = pk_bf16(siluf_(g0[0]) * u0[0], siluf_(g0[1]) * u0[1]); w.y = pk_bf16(siluf_(g0[2]) * u0[2], siluf_(g0[3]) * u0[3]);
                w.z = pk_bf16(siluf_(g1[0]) * u1[0], siluf_(g1[1]) * u1[1]); w.w = pk_bf16(siluf_(g1[2]) * u1[2], siluf_(g1[3]) * u1[3]);
                *(u32x4*)(Hm + (size_t)(row0 + ai * 128 + m * 16) * DFF + col0) = w; }
    }
};
struct EpiDn {
    static constexpr bool PERM = true, AFTER_DRAIN = false; bf16* Y; const float* roww;
    DI void operator()(const f32x4 (&acc)[2][2][4][2], const pg8::Unit& u, int wr, int wc, int fr, int fq) const {
        const int row0 = u.pm * 256 + wr * 64 + fr, col0 = (u.pn & 7) * 256 + wc * 32 + 8 * fq;
#pragma unroll
        for (int ai = 0; ai < 2; ++ai)
#pragma unroll
            for (int m = 0; m < 4; ++m) { const int row = row0 + ai * 128 + m * 16; const float rw = roww[row];
#pragma unroll
                for (int bj = 0; bj < 2; ++bj) { const f32x4 v0 = acc[ai][bj][m][0] * rw, v1 = acc[ai][bj][m][1] * rw;
                    u32x4 w; w.x = pk_bf16(v0[0], v0[1]); w.y = pk_bf16(v0[2], v0[3]); w.z = pk_bf16(v1[0], v1[1]); w.w = pk_bf16(v1[2], v1[3]);
                    *(u32x4*)(Y + (size_t)row * D + col0 + bj * 128) = w; } }
    }
};
struct MoeOrder {
    const int* tile_e; int ntiles, nsub, G, c;
    DI bool next(int i, pg8::Unit& u) const { const int j = i * G + c; if (j >= ntiles * nsub) return false; const int ti = j / nsub; u.pm = ti; u.pn = tile_e[ti] * nsub + (j - ti * nsub); return true; }
    DI void a_ready(const pg8::Unit&) const {}
    DI void done(const pg8::Unit&) const {}
};
constexpr int NPH_LAYER = 13, PH_FINAL = 1 + NPH_LAYER * DEPTH, NPHASES = PH_FINAL + 1;
struct KArgs { Args a; int li, pad; };
__global__ void __launch_bounds__(NTHR, 2) fwd_kernel(KArgs ka) {
    const Args& a = ka.a;
    const int tid = otid();
#define bid ((int)obid())
#define G ((int)ogdim())
    if (tid == 0) { ((LAS unsigned*)(ldsbase() + LDS_BARW))[0] = 0u; ((LAS unsigned*)(ldsbase() + LDS_BARW))[1] = 0u;
        LAS unsigned long long* ptab = (LAS unsigned long long*)(ldsbase() + LDS_PTAB);
#pragma unroll
        for (int i = 0; i < N_IN; ++i) ptab[i] = (unsigned long long)ka.a.in[i]; }
    __syncthreads();
#ifdef PROBE_SEL
    if (tid < 64) ((LAS unsigned long long*)(ldsbase() + LDS_TIM))[tid] = 0ull;
    __syncthreads();
    const unsigned long long tkern_ = __builtin_amdgcn_s_memrealtime();
#endif
    XcdBarrier bar = xcd_barrier_post((unsigned*)(wsp(a) + WS_CTL) + CW_BAR + ka.li * XCD_BAR_WORDS, (volatile LAS unsigned*)(ldsbase() + LDS_BARW));
    const int lo = a.ph_lo, hi = a.ph_hi;
#ifndef PHMASK
#define PHMASK 0xFFFF
#endif
#define EN(i) (((PHMASK) >> (i)) & 1)
#ifndef REPMASK
#define REPMASK 0
#endif
#define REP(i) (((REPMASK) >> (i)) & 1)
#define RUN(i, cond, ...) do { _Pragma("unroll 1") for (int rep_ = 0; rep_ < ((REP(i) && (cond)) ? REPN : 1); ++rep_) { if (rep_) __syncthreads(); __VA_ARGS__; } } while (0)
#ifndef REPN
#define REPN 2
#endif
#define IN(k) (opq(lo) <= (k) && (k) < opq(hi))
#define SEAM(k) do { if (IN(k) && IN((k) + 1)) { TIC(); xcd_barrier(bar); TOC(30); } } while (0)
#define ws wsp(a)
#define lds ldsbase()
#define ldsf ((LAS float*)ldsbase())
#define U ((bf16*)(wsp(a) + WS_U))
#define Z ((bf16*)(wsp(a) + WS_Z))
#define H ((float*)(wsp(a) + WS_H))
#define modall ((const float*)(wsp(a) + WS_MOD))

    { TIC();
    if (EN(0) && IN(0)) {
        RUN(0, true, prologue_small(a);
        for (int it = bid; it < 256; it += G) mod_item(a, it, ldsf);
        for (int it = bid; it < DEPTH * (MT / 8); it += G) h2_item(a, it, ldsf));
    }
    TOC(31); } SEAM(0);
    for (int l = 0; l < DEPTH; ++l) {
        const int pb = 1 + NPH_LAYER * l;
        const int nrows = (l == 0) ? MT : SEQ;
        { TIC();
        if (EN(1) && IN(pb + 0)) {
            RUN(1, l == 0, norm_phase<0>(a, l, MT, ldsf));
            RUN(16, true, if (l == 0) hyc_filters(a, 0));
            RUN(2, true, for (int it = bid; it < CVT_MIX_TILES; it += G) cvt_mix_item(a, l, it, ldsf));
        }
        TOC(1); } SEAM(pb + 0); { TIC();
        if (EN(2) && IN(pb + 1)) {
            pg8::Gemm g{U, (const bf16*)(ws + WS_WIN), MT, ZC, D}; pg8::StaticOrder S; S.init(MT, ZC, G, bid);
            EpiZ E{Z, (const float*)(ws + WS_ZBIAS) + (size_t)l * ZC};
            RUN(3, true, pg8::gemm_phase<EpiZ, pg8::StaticOrder, true, true>(lds, g, S, E));
        }
        TOC(2); } SEAM(pb + 1); { TIC();
        if (EN(3) && IN(pb + 2)) { const int nit = (nrows / 64) * 16; RUN(4, true, for (int it = bid; it < nit; it += G) hyprep_item(a, l, it, ldsf));
            __syncthreads();
            pg8::Gemm g{(const bf16*)(ws + WS_W3T) + (size_t)l * 2048 * 256, (const bf16*)(ws + WS_H2B) + (size_t)l * SEQ * 256, 2048, SEQ, 256}; pg8::StaticOrder S; S.init(2048, SEQ, G, bid);
            EpiHF E{(float*)(ws + WS_HF)};
            RUN(18, true, pg8::gemm_phase<EpiHF, pg8::StaticOrder, true, true>(lds, g, S, E)); }
        TOC(3); } SEAM(pb + 2); { TIC();
        if (EN(4) && IN(pb + 3)) {
            RUN(5, true, for (int it = bid; it < SCAN_ITEMS; it += G) scan_item2<false>(a, l, it, lds));
            RUN(6, true, for (int c = bid; c < 1024; c += G) hyconv_item(a, l, c, lds));
            RUN(15, true, if (l == 0) for (int it = bid; it < 64; it += G) hycctx_item(a, l, it, lds));
        }
        TOC(4); } SEAM(pb + 3); { TIC();
        if (EN(13) && IN(pb + 4)) { scan_prop(a); if (REP(20)) { __syncthreads(); scan_prop(a); scan_prop(a); } }
        TOC(5); } SEAM(pb + 4); { TIC();
        if (EN(14) && IN(pb + 5)) { RUN(17, true, for (int it = bid; it < SCAN_ITEMS; it += G) scan_item2<true>(a, l, it, lds)); }
        TOC(6); } SEAM(pb + 5); { TIC();
        if (EN(5) && IN(pb + 6)) {
            const int nit = (nrows / 64) * 16;
            RUN(7, true, scancomb_rows(a, l, nrows); for (int it = bid; it < nit; it += G) hycomb_item(a, l, it, ldsf));
        }
        TOC(7); } SEAM(pb + 6); { TIC();
        if (EN(6) && IN(pb + 7)) {
            const bf16* Y = (const bf16*)(ws + WS_YMIX); const bf16* WB = (const bf16*)(ws + WS_WBR);
            pg8::StaticOrder S; S.init(nrows, D, G, bid);
            RUN(8, true,
            { pg8::Gemm g{Y, WB, nrows, D, 1024}; EpiBr<0> E{U, Z + Z_MG}; pg8::gemm_phase<EpiBr<0>, pg8::StaticOrder, true, true>(lds, g, S, E); }
            __syncthreads();
            { pg8::Gemm g{Y + (size_t)MT * 1024, WB + (size_t)D * 1024, nrows, D, 1024}; EpiBr<1> E{U, Z + Z_MG + D}; pg8::gemm_phase<EpiBr<1>, pg8::StaticOrder, true, true>(lds, g, S, E); }
            __syncthreads();
            { pg8::Gemm g{Y + (size_t)2 * MT * 1024, WB + (size_t)2 * D * 1024, nrows, D, 1024}; EpiBr<2> E{U, Z + Z_MG + 2 * D}; pg8::gemm_phase<EpiBr<2>, pg8::StaticOrder, true, true>(lds, g, S, E); });
        }
        TOC(8); } SEAM(pb + 7); { TIC();
        if (EN(7) && IN(pb + 8)) {
            pg8::Gemm g{U, (const bf16*)(ws + WS_WOUT), nrows, D, D}; pg8::StaticOrder S; S.init(nrows, D, G, bid);
            EpiOut E{l == 0 ? ain(a, I_X) : H, l == 0 ? ain(a, I_CTX) : H + (size_t)SEQ * D, H, modall + (size_t)l * 2 * 12288 + 4096};
            RUN(9, l == 0, pg8::gemm_phase<EpiOut, pg8::StaticOrder, true, true>(lds, g, S, E));
        }
        TOC(9); } SEAM(pb + 8); { TIC();
        if (EN(8) && IN(pb + 9)) {
            route_phase<false>(a, l, nrows, ldsf);
            __syncthreads();
            if (REP(19)) { route_phase<true>(a, l, nrows, ldsf); __syncthreads(); }
            RUN(10, true, for (int it = bid; it < CVT_MOE_TILES; it += G) cvt_moe_item(a, l, it, ldsf));
        }
        TOC(10); } SEAM(pb + 9); { TIC();
        if (EN(9) && IN(pb + 10)) { RUN(11, true, permute_phase(a, l, nrows, lds)); }
        TOC(11); } SEAM(pb + 10); { TIC();
        if (EN(10) && IN(pb + 11)) {
            const int* tile_e = (const int*)(ws + WS_TILEE); const int ntiles = tile_e[200];
            pg8::Gemm g{(const bf16*)(ws + WS_XP), (const bf16*)(ws + WS_WGU), MOE_MAXROWS, NEXP * 1024, D}; MoeOrder S{tile_e, ntiles, 4, G, bid};
            EpiGU E{(bf16*)(ws + WS_HMID)};
            RUN(12, true, pg8::gemm_phase<EpiGU, MoeOrder, true, true>(lds, g, S, E));
        }
        TOC(12); } SEAM(pb + 11); { TIC();
        if (EN(11) && IN(pb + 12)) {
            const int* tile_e = (const int*)(ws + WS_TILEE); const int ntiles = tile_e[200];
            pg8::Gemm g{(const bf16*)(ws + WS_HMID), (const bf16*)(ws + WS_WD), MOE_MAXROWS, NEXP * D, DFF}; MoeOrder S{tile_e, ntiles, 8, G, bid};
            EpiDn E{(bf16*)(ws + WS_YP), (const float*)(ws + WS_ROWW)};
            RUN(13, true, pg8::gemm_phase<EpiDn, MoeOrder, true, true>(lds, g, S, E));
        }
        TOC(13); } SEAM(pb + 12); { TIC();
        (void)0; }
    }
#ifdef PROBE_SEL
    if (tid == 0) ((LAS unsigned long long*)(ldsbase() + LDS_TIM))[0] = __builtin_amdgcn_s_memrealtime() - tkern_;
    __syncthreads();
#endif
    if (EN(12) && IN(PH_FINAL)) norm_phase<2>(a, DEPTH, SEQ, ldsf);
#undef IN
#undef SEAM
#undef ws
#undef bid
#undef G
#undef lds
#undef ldsf
#undef U
#undef Z
#undef H
#undef modall
}

#ifndef MK_SINGLE
#define MK_SINGLE 1
#endif
extern "C" void kernel_launch(void* const* d_in, const int* in_sizes, int n_in, void* d_out, int out_size, void* d_ws, size_t ws_size, hipStream_t stream) {
    static int grid = 0;
    if (grid == 0) {
        if (n_in != N_IN || out_size != SEQ * D || ws_size < WS_END) { fprintf(stderr, "kernel_launch: unexpected problem shape (n_in %d, out %d, ws %zu < %zu)\n", n_in, out_size, ws_size, (size_t)WS_END); grid = -1; return; }
        int dev = 0, cus = 0;
        if (hipGetDevice(&dev) != hipSuccess || hipDeviceGetAttribute(&cus, hipDeviceAttributeMultiprocessorCount, dev) != hipSuccess) { grid = -1; return; }
        if (hipFuncSetAttribute((const void*)fwd_kernel, hipFuncAttributeMaxDynamicSharedMemorySize, LDS_BYTES) != hipSuccess) { fprintf(stderr, "kernel_launch: hipFuncSetAttribute failed\n"); grid = -1; return; }
        int per_cu = 0;
        if (hipOccupancyMaxActiveBlocksPerMultiprocessor(&per_cu, (const void*)fwd_kernel, NTHR, LDS_BYTES) != hipSuccess || per_cu < 1) fprintf(stderr, "kernel_launch: occupancy query says %d\n", per_cu);
        (void)hipGetLastError();
        grid = cus;
    }
    if (grid < 0) return;
    (void)hipMemsetAsync((char*)d_ws + WS_CTL, 0, CTL_BYTES, stream);
    KArgs ka{};
    for (int i = 0; i < N_IN; ++i) ka.a.in[i] = (const float*)d_in[i];
    ka.a.out = (float*)d_out; ka.a.ws = (unsigned char*)d_ws;
#if MK_SINGLE
    ka.a.ph_lo = 0; ka.a.ph_hi = NPHASES; ka.li = 0; ka.pad = 0;
    hipLaunchKernelGGL(fwd_kernel, dim3(grid), dim3(NTHR), LDS_BYTES, stream, ka);
#else
    for (int ph = 0; ph < NPHASES; ++ph) { ka.a.ph_lo = ph; ka.a.ph_hi = ph + 1; ka.li = 0; ka.pad = 0; hipLaunchKernelGGL(fwd_kernel, dim3(grid), dim3(NTHR), LDS_BYTES, stream, ka); }
#endif
}
```

```cpp
#include <hip/hip_runtime.h>
#include <cstdio>
#include <cstdint>
#define DI __device__ __forceinline__
#define LAS __attribute__((address_space(3)))
typedef unsigned short bf16;
typedef float f32x4 __attribute__((ext_vector_type(4)));
typedef unsigned u32x4 __attribute__((ext_vector_type(4)));
typedef unsigned u32x2 __attribute__((ext_vector_type(2)));

constexpr int D = 2048, SEQ = 16384, CTXL = 256, MT = SEQ + CTXL  , DEPTH = 2;
constexpr int NCOLS_IN = 17440;
constexpr int ZC = 17664;
constexpr int Z_HG = 0, Z_GL = 5120, Z_HY = 8192, Z_MG = 11264, Z_LR = 17408;
constexpr int NEXP = 32, DFF = 512, MOE_MAXROWS = 41472;
constexpr float NORM_EPS = 1e-6f;

constexpr size_t MiB = 1u << 20;
constexpr size_t WS_CTL = 0, CTL_BYTES = 1 * MiB;
constexpr size_t WS_SMALL = 1 * MiB;
constexpr size_t WS_MOD   = WS_SMALL;
constexpr size_t WS_ZBIAS = WS_MOD + (size_t)DEPTH * 2 * 12288 * 4;
constexpr size_t WS_LB    = WS_ZBIAS + (size_t)DEPTH * ZC * 4;
constexpr size_t WS_TW    = WS_LB + (size_t)DEPTH * 2 * 1024 * 4;
constexpr size_t WS_TW2   = WS_TW + 16384 * 8;
constexpr size_t WS_H2    = WS_TW2 + (8192 + 64) * 8;
constexpr size_t WS_ROUTE = WS_H2 + (size_t)DEPTH * MT * 64 * 4;
constexpr size_t WS_ROWW  = WS_ROUTE + (size_t)MT * 8 * 4;
constexpr size_t WS_TILEE = WS_ROWW + (size_t)MOE_MAXROWS * 4;
constexpr size_t WS_HYC   = WS_TILEE + 1024;
constexpr size_t WS_W3T   = WS_HYC + (size_t)2048 * 256 * 4;
constexpr size_t WS_H2B   = WS_W3T + (size_t)DEPTH * 2048 * 256 * 2;
constexpr size_t WS_WRT   = WS_H2B + (size_t)DEPTH * SEQ * 256 * 2;
constexpr size_t WS_SMALL_END = WS_WRT + (size_t)DEPTH * 2 * 48 * 2048 * 2;
static_assert(WS_SMALL_END <= 40 * MiB, "small tables");
constexpr size_t WS_WIN  = 40 * MiB;
constexpr size_t WS_WBR  = 109 * MiB;
constexpr size_t WS_WOUT = 121 * MiB;
constexpr size_t WS_WGU  = 129 * MiB;
constexpr size_t WS_CVO  = WS_WIN;
constexpr size_t WS_WD   = 257 * MiB;
constexpr size_t WS_H    = 321 * MiB;
constexpr size_t WS_U    = 451 * MiB;
constexpr size_t WS_Z    = 516 * MiB;
constexpr size_t WS_XP   = WS_Z;
constexpr size_t WS_HMID = WS_Z + 162 * MiB;
constexpr size_t WS_YP   = WS_Z + 203 * MiB;
constexpr size_t WS_YMIX = 1077 * MiB;
constexpr size_t WS_HF   = 1175 * MiB;
constexpr size_t WS_OSC  = 1175 * MiB;
constexpr size_t WS_END  = 1435 * MiB;
static_assert(WS_WIN + (size_t)ZC * D * 2 <= WS_WBR && WS_Z + (size_t)MT * ZC * 2 <= WS_YMIX && WS_YMIX + (size_t)3 * MT * 1024 * 2 <= WS_OSC && WS_OSC + (size_t)4 * MT * 1024 * 4 <= WS_END, "ws map");
static_assert(WS_YP + (size_t)MOE_MAXROWS * D * 2 <= WS_YMIX && WS_H + (size_t)MT * D * 4 <= WS_U && WS_U + (size_t)MT * D * 2 <= WS_Z, "ws map 2");
constexpr int CW_BAR = 4096;
constexpr int CW_CNT = 16384;

DI float bf2f(bf16 v) { return __uint_as_float(((unsigned)v) << 16); }
DI float bflo(unsigned w) { return __uint_as_float(w << 16); }
DI float bfhi(unsigned w) { return __uint_as_float(w & 0xffff0000u); }
typedef float f32x2_t __attribute__((ext_vector_type(2))); typedef __bf16 bf16x2_t __attribute__((ext_vector_type(2)));
DI unsigned pk_bf16(float lo, float hi) { f32x2_t v = {lo, hi}; bf16x2_t b = __builtin_convertvector(v, bf16x2_t); return __builtin_bit_cast(unsigned, b); }
DI bf16 f2bf(float f) { return (bf16)(pk_bf16(f, 0.f) & 0xffffu); }
DI float sigmoidf_(float x) { return 1.0f / (1.0f + __expf(-x)); }
DI float siluf_(float x) { return x / (1.0f + __expf(-x)); }
DI float wave_sum(float v) {
#pragma unroll
    for (int o = 32; o >= 1; o >>= 1) v += __shfl_xor(v, o);
    return v;
}
DI int otid() { int t = __builtin_amdgcn_workitem_id_x(); asm volatile("" : "+v"(t)); return t; }
DI int ogdim() { int g = __builtin_amdgcn_workgroup_id_x(); g = (int)gridDim.x; asm volatile("" : "+s"(g)); return g; }
DI int obid() { int b = __builtin_amdgcn_workgroup_id_x(); asm volatile("" : "+s"(b)); return b; }
#define AIN_DECL 1
DI LAS f32x2_t* fft_vec2_(LAS float* p) { return (LAS f32x2_t*)p; }
DI const f32x2_t* fft_vec2_(const float* p) { return (const f32x2_t*)p; }
DI f32x2_t* fft_vec2_(float* p) { return (f32x2_t*)p; }
namespace pg8 {
#define PG8_LAS __attribute__((address_space(3)))
typedef unsigned short bf16_t;
typedef short bf16x8 __attribute__((ext_vector_type(8)));
typedef float f32x4 __attribute__((ext_vector_type(4)));
typedef unsigned u32x4 __attribute__((ext_vector_type(4)));
constexpr int BM = 256, BK = 64, HALF = 128, HTB = HALF * BK * 2  , STAGE_BYTES = 8 * HTB, NXCD = 8, WGM = 8;

__host__ __device__ __forceinline__ int lds_byte(int r, int c) { const int st = (r >> 4) * 2 + (c >> 5), rr = r & 15, cc = c & 31, ob = rr * 64 + cc * 2; return st * 1024 + (ob ^ (((ob >> 9) & 1) << 5)); }
__host__ __device__ __forceinline__ void stage_rc(int b, int& R, int& C) { const int st = b / 1024, sb = b % 1024, swz = sb ^ (((sb >> 9) & 1) << 5); R = (st >> 1) * 16 + swz / 64; C = (st & 1) * 32 + (swz % 64) / 2; }
__host__ __device__ __forceinline__ int perm32(int rho) { const int n = rho >> 4, i = rho & 15; return 8 * (i >> 2) + 4 * n + (i & 3); }

struct Unit { int pm, pn; };
struct Gemm { const bf16_t* A; const bf16_t* Bt; int M, N, K; };

struct StaticOrder {
    int nM, nN, nwg, G, c;
    __host__ __device__ void init(int M, int N, int G_, int c_) { nM = M / BM; nN = N / BM; nwg = nM * nN; G = G_; c = c_; }
    __host__ __device__ bool next(int i, Unit& u) const {
        const long L = (long)i * G + c; if (L >= nwg) return false;
        int wgid = (int)L; { const int q = nwg / NXCD, r = nwg % NXCD, xcd = wgid % NXCD, off = wgid / NXCD; wgid = (xcd < r ? xcd * (q + 1) : r * (q + 1) + (xcd - r) * q) + off; }
        const int nig = WGM * nN, gid = wgid / nig, fm = gid * WGM, gsz = (nM - fm) < WGM ? (nM - fm) : WGM;
        u.pm = fm + ((wgid % nig) % gsz); u.pn = (wgid % nig) / gsz; return true;
    }
    __device__ __forceinline__ void a_ready(const Unit&) const {}
    __device__ __forceinline__ void done(const Unit&) const {}
};

template <class Epi, class Sched, bool ALIGN_EPI = false, bool SP2 = false>
__device__ __forceinline__ void gemm_phase(PG8_LAS unsigned char* lds, const Gemm g, const Sched& S, const Epi& E) {
    const int tid = otid(), wid = __builtin_amdgcn_readfirstlane(tid >> 6), lane = tid & 63, wr = wid >> 2, wc = wid & 3, fr = lane & 15, fq = lane >> 4;
    const int K = g.K, nt = K / BK;
    unsigned voffA[2], voffB[2];
#pragma unroll
    for (int i = 0; i < 2; ++i) { int R, C; stage_rc(tid * 16 + i * 8192, R, C); const int Rb = Epi::PERM ? ((R & ~31) + perm32(R & 31)) : R;
        voffA[i] = (unsigned)(R * K + C) * 2u; voffB[i] = (unsigned)(Rb * K + C) * 2u; }
    const size_t kstep = (size_t)(BK * 2);
    const size_t hstep = (size_t)HALF * K * 2;
    const size_t tstep = 2 * hstep;
    const unsigned ldsw = (unsigned)wid * 1024u;
    const int aoff = lds_byte(wr * 64 + fr, fq * 8), boff = lds_byte(wc * 32 + fr, fq * 8);
#define PG8_SA(b, h) (((b) * 2 + (h)) * HTB)
#define PG8_SB(b, h) ((4 + (b) * 2 + (h)) * HTB)
#define PG8_STAGE(bufoff, gbase, voff) do { _Pragma("unroll") for (int _i = 0; _i < 2; ++_i) \
        __builtin_amdgcn_global_load_lds((const unsigned*)((const char*)(gbase) + (voff)[_i]), (PG8_LAS unsigned*)(lds + (bufoff) + ldsw + _i * 8192), 16, 0, 0); } while (0)
#define PG8_LDA(dst, b, h) do { _Pragma("unroll") for (int m = 0; m < 4; ++m) _Pragma("unroll") for (int k = 0; k < 2; ++k) dst[m][k] = *(const PG8_LAS bf16x8*)(lds + PG8_SA(b, h) + aoff + m * 2048 + k * 1024); } while (0)
#define PG8_LDB(dst, b, h) do { _Pragma("unroll") for (int n = 0; n < 2; ++n) _Pragma("unroll") for (int k = 0; k < 2; ++k) dst[n][k] = *(const PG8_LAS bf16x8*)(lds + PG8_SB(b, h) + boff + n * 2048 + k * 1024); } while (0)
#define PG8_MMA(ai, bj, At, Bt) do { __builtin_amdgcn_s_setprio(1); _Pragma("unroll") for (int m = 0; m < 4; ++m) _Pragma("unroll") for (int n = 0; n < 2; ++n) _Pragma("unroll") for (int k = 0; k < 2; ++k) \
        acc[ai][bj][m][n] = __builtin_amdgcn_mfma_f32_16x16x32_bf16(Bt[n][k], At[m][k], acc[ai][bj][m][n], 0, 0, 0); __builtin_amdgcn_s_setprio(0); } while (0)
#define PG8_WAIT_V(n) asm volatile("s_waitcnt vmcnt(" #n ")" ::: "memory")
#define PG8_WAIT_L(n) asm volatile("s_waitcnt lgkmcnt(" #n ")" ::: "memory")
#define PG8_BAR __builtin_amdgcn_s_barrier()
#define PG8_SCHED __builtin_amdgcn_sched_barrier(0)
    Unit cur, nxt; int ui = 0;
    if (!S.next(0, cur)) return;
    f32x4 acc[2][2][4][2];
#pragma unroll
    for (int a = 0; a < 2; ++a)
#pragma unroll
        for (int b = 0; b < 2; ++b)
#pragma unroll
            for (int m = 0; m < 4; ++m)
#pragma unroll
                for (int n = 0; n < 2; ++n) acc[a][b][m][n] = (f32x4){0.f, 0.f, 0.f, 0.f};
    bf16x8 At[4][2], B0[2][2], B1[2][2];
    const char* cA = (const char*)g.A + (size_t)cur.pm * tstep; const char* cB = (const char*)g.Bt + (size_t)cur.pn * tstep;
    S.a_ready(cur);
    if constexpr (SP2) {
        PG8_STAGE(PG8_SB(0, 0), cB, voffB); PG8_STAGE(PG8_SB(0, 1), cB + hstep, voffB); PG8_STAGE(PG8_SA(0, 0), cA, voffA); PG8_STAGE(PG8_SA(0, 1), cA + hstep, voffA);
        if (wr == 1) PG8_BAR;
        PG8_WAIT_V(2); PG8_BAR;
        PG8_STAGE(PG8_SB(1, 0), cB + kstep, voffB); PG8_STAGE(PG8_SA(1, 0), cA + kstep, voffA); PG8_STAGE(PG8_SB(1, 1), cB + hstep + kstep, voffB);
        PG8_WAIT_V(6); PG8_BAR;
    } else {
        PG8_STAGE(PG8_SB(0, 0), cB, voffB); PG8_STAGE(PG8_SA(0, 0), cA, voffA); PG8_STAGE(PG8_SB(0, 1), cB + hstep, voffB); PG8_STAGE(PG8_SA(0, 1), cA + hstep, voffA);
        if (wr == 1) PG8_BAR;
        PG8_WAIT_V(4); PG8_BAR;
        PG8_STAGE(PG8_SB(1, 0), cB + kstep, voffB); PG8_STAGE(PG8_SA(1, 0), cA + kstep, voffA); PG8_STAGE(PG8_SB(1, 1), cB + hstep + kstep, voffB);
        PG8_WAIT_V(6); PG8_BAR;
    }
    for (;;) {
        const bool has_next = S.next(ui + 1, nxt);
        const char* nA = has_next ? (const char*)g.A + (size_t)nxt.pm * tstep : cA; const char* nB = has_next ? (const char*)g.Bt + (size_t)nxt.pn * tstep : cB;
        for (int t = 0; t < nt; t += 2) {
            const bool last = (t == nt - 2);
            const char* a1 = cA + (size_t)(t + 1) * kstep;
            const char* a2 = last ? nA : cA + (size_t)(t + 2) * kstep; const char* b2 = last ? nB : cB + (size_t)(t + 2) * kstep;
            const char* a3 = a2 + kstep; const char* b3 = b2 + kstep;
            if (last && has_next) S.a_ready(nxt);
            if constexpr (SP2) {
            PG8_LDB(B0, 0, 0); PG8_LDB(B1, 0, 1); PG8_SCHED; PG8_LDA(At, 0, 0); PG8_STAGE(PG8_SA(1, 1), a1 + hstep, voffA);
            PG8_WAIT_V(8); PG8_WAIT_L(0); PG8_BAR; PG8_MMA(0, 0, At, B0); PG8_MMA(0, 1, At, B1); PG8_BAR; PG8_SCHED;
            PG8_LDA(At, 0, 1); PG8_STAGE(PG8_SB(0, 0), b2, voffB); PG8_STAGE(PG8_SB(0, 1), b2 + hstep, voffB); PG8_STAGE(PG8_SA(0, 0), a2, voffA);
            PG8_WAIT_V(8); PG8_WAIT_L(0); PG8_BAR; PG8_MMA(1, 0, At, B0); PG8_MMA(1, 1, At, B1); PG8_BAR; PG8_SCHED;
            PG8_LDB(B0, 1, 0); PG8_LDB(B1, 1, 1); PG8_SCHED; PG8_LDA(At, 1, 0); PG8_STAGE(PG8_SA(0, 1), a2 + hstep, voffA);
            PG8_WAIT_V(8); PG8_WAIT_L(0); PG8_BAR; PG8_MMA(0, 0, At, B0); PG8_MMA(0, 1, At, B1); PG8_BAR; PG8_SCHED;
            PG8_LDA(At, 1, 1); PG8_STAGE(PG8_SB(1, 0), b3, voffB); PG8_STAGE(PG8_SB(1, 1), b3 + hstep, voffB); PG8_STAGE(PG8_SA(1, 0), a3, voffA);
            PG8_WAIT_V(8); PG8_WAIT_L(0); PG8_BAR; PG8_MMA(1, 0, At, B0); PG8_MMA(1, 1, At, B1); PG8_BAR; PG8_SCHED;
            } else {
            PG8_LDB(B0, 0, 0); PG8_SCHED; PG8_LDA(At, 0, 0); PG8_STAGE(PG8_SA(1, 1), a1 + hstep, voffA);
            PG8_WAIT_L(8); PG8_BAR; PG8_WAIT_L(0); PG8_MMA(0, 0, At, B0); PG8_BAR; PG8_SCHED;
            PG8_LDB(B1, 0, 1); PG8_STAGE(PG8_SB(0, 0), b2, voffB);
            PG8_BAR; PG8_WAIT_L(0); PG8_MMA(0, 1, At, B1); PG8_BAR;
            PG8_LDA(At, 0, 1); PG8_STAGE(PG8_SA(0, 0), a2, voffA);
            PG8_BAR; PG8_WAIT_L(0); PG8_MMA(1, 0, At, B0); PG8_BAR; PG8_SCHED;
            PG8_STAGE(PG8_SB(0, 1), b2 + hstep, voffB);
            PG8_WAIT_V(6); PG8_BAR; PG8_MMA(1, 1, At, B1); PG8_BAR;
            PG8_LDB(B0, 1, 0); PG8_SCHED; PG8_LDA(At, 1, 0); PG8_STAGE(PG8_SA(0, 1), a2 + hstep, voffA);
            PG8_WAIT_L(8); PG8_BAR; PG8_WAIT_L(0); PG8_MMA(0, 0, At, B0); PG8_BAR; PG8_SCHED;
            PG8_LDB(B1, 1, 1); PG8_STAGE(PG8_SB(1, 0), b3, voffB);
            PG8_BAR; PG8_WAIT_L(0); PG8_MMA(0, 1, At, B1); PG8_BAR;
            PG8_LDA(At, 1, 1); PG8_STAGE(PG8_SA(1, 0), a3, voffA);
            PG8_BAR; PG8_WAIT_L(0); PG8_MMA(1, 0, At, B0); PG8_BAR; PG8_SCHED;
            PG8_STAGE(PG8_SB(1, 1), b3 + hstep, voffB);
            PG8_WAIT_V(6); PG8_BAR; PG8_MMA(1, 1, At, B1); PG8_BAR;
            }
        }
        if constexpr (ALIGN_EPI) { if (wr == 0) PG8_BAR; }
        if constexpr (!Epi::AFTER_DRAIN) { E(acc, cur, wr, wc, fr, fq); S.done(cur); }
        if (!has_next) break;
#pragma unroll
        for (int a = 0; a < 2; ++a)
#pragma unroll
            for (int b = 0; b < 2; ++b)
#pragma unroll
                for (int m = 0; m < 4; ++m)
#pragma unroll
                    for (int n = 0; n < 2; ++n) acc[a][b][m][n] = (f32x4){0.f, 0.f, 0.f, 0.f};
        cur = nxt; cA = nA; cB = nB; ++ui;
        if constexpr (ALIGN_EPI) { if (wr == 1) PG8_BAR; }
    }
    PG8_WAIT_V(0);
    if constexpr (!ALIGN_EPI) { if (wr == 0) PG8_BAR; }
    PG8_BAR;
    if constexpr (Epi::AFTER_DRAIN) { E.fused(acc, cur, wr, wc, fr, fq, lds, wid, lane); S.done(cur); }
#undef PG8_SA
#undef PG8_SB
#undef PG8_STAGE
#undef PG8_LDA
#undef PG8_LDB
#undef PG8_MMA
#undef PG8_WAIT_V
#undef PG8_WAIT_L
#undef PG8_BAR
#undef PG8_SCHED
}
}
#define XB_TMO      128
#define XB_XCNT(j)  (256  + 64 * (j))
#define XB_XSUB(j)  (1280 + 64 * (j))
#define XB_XGEN(j)  (2304 + 64 * (j))
#define XB_TOP      3328
#define XB_TOPGEN   3392
#define XCD_BAR_WORDS 3456
#define XB_SPIN_CAP (1u << 18)

__device__ __forceinline__ unsigned xb_ld(unsigned* p)              { return __hip_atomic_load(p, __ATOMIC_RELAXED, __HIP_MEMORY_SCOPE_AGENT); }
__device__ __forceinline__ unsigned xb_add(unsigned* p, unsigned v) { return __hip_atomic_fetch_add(p, v, __ATOMIC_RELAXED, __HIP_MEMORY_SCOPE_AGENT); }
__device__ __forceinline__ unsigned xb_xcc_id() { return (unsigned)__builtin_amdgcn_s_getreg((3 << 11) | 20) & 0xFu; }
#define XB_SPIN(cond, bar) do { unsigned _sp = 0; while (cond) { __builtin_amdgcn_s_sleep(1); \
    if ((++_sp & 255u) == 0u) { if (xb_ld(&(bar)[XB_TMO])) break; if (_sp > XB_SPIN_CAP) { atomicAdd(&(bar)[XB_TMO], 1u); break; } } } } while (0)

struct XcdBarrier {
    unsigned* bar; unsigned x;
    volatile LAS unsigned* st;
};

__device__ __forceinline__ XcdBarrier xcd_barrier_post(unsigned* bar, volatile LAS unsigned* st) {
    XcdBarrier b; b.bar = bar; b.x = xb_xcc_id(); b.st = st;
    if (otid() == 0) (void)xb_add(&bar[XB_XCNT(b.x)], 1u);
    return b;
}
__device__ __forceinline__ void xcd_barrier_complete(unsigned* bar, unsigned x, unsigned& nloc, unsigned& nx) {
    asm volatile("" : "+s"(x));
    const unsigned G = ogdim();
    unsigned sum, cnt, mine, sp = 0u;
    for (;;) {
        sum = 0u; cnt = 0u; mine = 0u;
#pragma unroll
        for (unsigned j = 0; j < 16; ++j) { const unsigned c = xb_ld(&bar[XB_XCNT(j)]); sum += c; cnt += (c > 0u) ? 1u : 0u; mine = (j == x) ? c : mine; }
        if (sum == G) break;
        __builtin_amdgcn_s_sleep(1);
        if ((++sp & 255u) == 0u) { if (xb_ld(&bar[XB_TMO])) break; if (sp > XB_SPIN_CAP) { atomicAdd(&bar[XB_TMO], 1u); break; } }
    }
    nloc = mine > 0u ? mine : 1u; nx = cnt > 0u ? cnt : 1u;
}

__device__ __forceinline__ void xcd_barrier(const XcdBarrier& b) {
    asm volatile("s_waitcnt vmcnt(0)" ::: "memory");
    __syncthreads();
    if (otid() == 0) {
        unsigned* bar = b.bar;
        __builtin_amdgcn_s_waitcnt(0);
        unsigned nloc = b.st[0], nx = b.st[1];
        if (nloc == 0u) { xcd_barrier_complete(bar, b.x, nloc, nx); b.st[0] = nloc; b.st[1] = nx; }
        const unsigned old = xb_add(&bar[XB_XSUB(b.x)], 1u);
        const unsigned gen = old / nloc;
        if (old + 1u == (gen + 1u) * nloc) {
            __builtin_amdgcn_fence(__ATOMIC_RELEASE, "agent");
            asm volatile("s_waitcnt vmcnt(0)" ::: "memory");
            const unsigned og = xb_add(&bar[XB_TOP], 1u);
            const unsigned tg = og / nx;
            if (og + 1u == (tg + 1u) * nx) xb_add(&bar[XB_TOPGEN], 1u);
            else XB_SPIN(xb_ld(&bar[XB_TOPGEN]) == tg, bar);
            __builtin_amdgcn_fence(__ATOMIC_ACQUIRE, "agent");
            xb_add(&bar[XB_XGEN(b.x)], 1u);
            asm volatile("s_waitcnt vmcnt(0)" ::: "memory");
        } else {
            XB_SPIN(xb_ld(&bar[XB_XGEN(b.x)]) == gen, bar);
            __builtin_amdgcn_fence(__ATOMIC_ACQUIRE, "agent");
            asm volatile("s_waitcnt vmcnt(0)" ::: "memory");
        }
    }
    __syncthreads();
}

#define FFT_DI DI
struct cpx; template <class P> DI cpx fft_ldc_(P p, int i); template <class P> DI void fft_stc_(P p, int i, const cpx& v);
#define FFT_LDC(p, i) fft_ldc_((p), (i))
#define FFT_STC(p, i, v) fft_stc_((p), (i), (v))
#define FFT_M 16384
#define FFT_NT 512
struct cpx { float x, y; };
#ifdef FFT_LDC
template <class P> FFT_DI cpx fft_ldc_(P p, int i) { const f32x2_t v = *(const decltype(fft_vec2_(p)))(p + 2 * i); cpx r; r.x = v[0]; r.y = v[1]; return r; }
template <class P> FFT_DI void fft_stc_(P p, int i, const cpx& v) { f32x2_t w = {v.x, v.y}; *(decltype(fft_vec2_(p)))(p + 2 * i) = w; }
#endif
#ifndef FFT_LDC
#define FFT_LDC(p, i) ([&]{ cpx r_; r_.x = (p)[2 * (i)]; r_.y = (p)[2 * (i) + 1]; return r_; }())
#define FFT_STC(p, i, v) do { (p)[2 * (i)] = (v).x; (p)[2 * (i) + 1] = (v).y; } while (0)
#endif
FFT_DI cpx cmul(cpx a, cpx b) { cpx r; r.x = a.x * b.x - a.y * b.y; r.y = a.x * b.y + a.y * b.x; return r; }
FFT_DI cpx cmulc(cpx a, cpx b) { cpx r; r.x = a.x * b.x + a.y * b.y; r.y = a.y * b.x - a.x * b.y; return r; }
FFT_DI int rev4_14(int k) {
    int r = 0;
#pragma unroll
    for (int d = 0; d < 7; ++d) { r = (r << 2) | (k & 3); k >>= 2; }
    return r;
}
struct FftTw { cpx c256[3], c64[3], c16[3], c4[3]; };
template <class TP> FFT_DI void fft_load_tw(FftTw& T, TP tw, int tid) {
#pragma unroll
    for (int q = 0; q < 3; ++q) { T.c256[q] = FFT_LDC(tw, (q + 1) * (tid & 255) * 16); T.c64[q] = FFT_LDC(tw, (q + 1) * (tid & 63) * 64); T.c16[q] = FFT_LDC(tw, (q + 1) * (tid & 15) * 256); T.c4[q] = FFT_LDC(tw, (q + 1) * (tid & 3) * 1024); }
}
template <int s, class TP> FFT_DI void fft_pick_tw(const FftTw& T, TP tw, int pos, int j, cpx& w1, cpx& w2, cpx& w3) {
    if (s == 4096) { w1 = FFT_LDC(tw, pos); w2 = FFT_LDC(tw, 2 * pos); w3 = FFT_LDC(tw, 3 * pos); }
    else if (s == 1024) { w1 = FFT_LDC(tw, 4 * pos); w2 = FFT_LDC(tw, 8 * pos); w3 = FFT_LDC(tw, 12 * pos); }
    else if (s == 256) { w1 = T.c256[0]; w2 = T.c256[1]; w3 = T.c256[2]; }
    else if (s == 64) { w1 = T.c64[0]; w2 = T.c64[1]; w3 = T.c64[2]; }
    else if (s == 16) { w1 = T.c16[0]; w2 = T.c16[1]; w3 = T.c16[2]; }
    else if (s == 4) { w1 = T.c4[0]; w2 = T.c4[1]; w3 = T.c4[2]; }
}
template <int s, class LP, class TP> FFT_DI void fft_fwd_pass(LP lds, const FftTw& T, TP tw, int tid) {
    cpx w1, w2, w3;
#pragma unroll 2
    for (int jj = 0; jj < FFT_M / 4 / FFT_NT; ++jj) { const int b = tid + FFT_NT * jj;
        const int pos = b & (s - 1), base = ((b & ~(s - 1)) << 2) + pos;
        const cpx a0 = FFT_LDC(lds, base), a1 = FFT_LDC(lds, base + s), a2 = FFT_LDC(lds, base + 2 * s), a3 = FFT_LDC(lds, base + 3 * s);
        cpx t0, t1, t2, t3;
        t0.x = a0.x + a2.x; t0.y = a0.y + a2.y;
        t1.x = a0.x - a2.x; t1.y = a0.y - a2.y;
        t2.x = a1.x + a3.x; t2.y = a1.y + a3.y;
        t3.x = a1.x - a3.x; t3.y = a1.y - a3.y;
        cpx y0, y1, y2, y3;
        y0.x = t0.x + t2.x; y0.y = t0.y + t2.y;
        y2.x = t0.x - t2.x; y2.y = t0.y - t2.y;
        y1.x = t1.x + t3.y; y1.y = t1.y - t3.x;
        y3.x = t1.x - t3.y; y3.y = t1.y + t3.x;
        if (s > 1) {
            fft_pick_tw<s>(T, tw, pos, jj, w1, w2, w3);
            y1 = cmul(y1, w1); y2 = cmul(y2, w2); y3 = cmul(y3, w3);
        }
        FFT_STC(lds, base, y0); FFT_STC(lds, base + s, y1); FFT_STC(lds, base + 2 * s, y2); FFT_STC(lds, base + 3 * s, y3);
    }
}
template <int s, class LP, class TP> FFT_DI void fft_inv_pass(LP lds, const FftTw& T, TP tw, int tid) {
    cpx w1, w2, w3;
#pragma unroll 2
    for (int jj = 0; jj < FFT_M / 4 / FFT_NT; ++jj) { const int b = tid + FFT_NT * jj;
        const int pos = b & (s - 1), base = ((b & ~(s - 1)) << 2) + pos;
        const cpx b0 = FFT_LDC(lds, base); cpx c1 = FFT_LDC(lds, base + s), c2 = FFT_LDC(lds, base + 2 * s), c3 = FFT_LDC(lds, base + 3 * s);
        if (s > 1) {
            fft_pick_tw<s>(T, tw, pos, jj, w1, w2, w3);
            c1 = cmulc(c1, w1); c2 = cmulc(c2, w2); c3 = cmulc(c3, w3);
        }
        cpx t0, t1, t2, t3;
        t0.x = b0.x + c2.x; t0.y = b0.y + c2.y;
        t1.x = b0.x - c2.x; t1.y = b0.y - c2.y;
        t2.x = c1.x + c3.x; t2.y = c1.y + c3.y;
        t3.x = c1.x - c3.x; t3.y = c1.y - c3.y;
        cpx x0, x1, x2, x3;
        x0.x = t0.x + t2.x; x0.y = t0.y + t2.y;
        x2.x = t0.x - t2.x; x2.y = t0.y - t2.y;
        x1.x = t1.x - t3.y; x1.y = t1.y + t3.x;
        x3.x = t1.x + t3.y; x3.y = t1.y - t3.x;
        FFT_STC(lds, base, x0); FFT_STC(lds, base + s, x1); FFT_STC(lds, base + 2 * s, x2); FFT_STC(lds, base + 3 * s, x3);
    }
}
template <class LP, class TP> FFT_DI void rfft_untangle(LP lds, TP tw2, int k, cpx& Xk, cpx& Xm) {
    if (k == 0) {
        const float zr = lds[0], zi = lds[1];
        Xk.x = zr + zi; Xk.y = zr - zi;
        const int p = rev4_14(FFT_M / 2);
        Xm.x = lds[2 * p]; Xm.y = -lds[2 * p + 1];
        return;
    }
    const int pk = rev4_14(k), pm = rev4_14(FFT_M - k);
    cpx Zk, Zm; Zk.x = lds[2 * pk]; Zk.y = lds[2 * pk + 1]; Zm.x = lds[2 * pm]; Zm.y = lds[2 * pm + 1];
    cpx E, O, W, WO;
    E.x = 0.5f * (Zk.x + Zm.x); E.y = 0.5f * (Zk.y - Zm.y);
    O.x = 0.5f * (Zk.y + Zm.y); O.y = -0.5f * (Zk.x - Zm.x);
    W.x = tw2[2 * k]; W.y = tw2[2 * k + 1];
    WO = cmul(W, O);
    Xk.x = E.x + WO.x; Xk.y = E.y + WO.y;
    Xm.x = E.x - WO.x; Xm.y = -(E.y - WO.y);
}
template <class LP, class TP> FFT_DI void rfft_mul_retangle(LP lds, TP tw2, int k, cpx Gk, cpx Gm) {
    cpx Xk, Xm; rfft_untangle(lds, tw2, k, Xk, Xm);
    if (k == 0) {
        const float y0 = Xk.x * Gk.x, yM = Xk.y * Gk.y;
        lds[0] = 0.5f * (y0 + yM); lds[1] = 0.5f * (y0 - yM);
        const cpx Y = cmul(Xm, Gm);
        const int p = rev4_14(FFT_M / 2);
        lds[2 * p] = Y.x; lds[2 * p + 1] = -Y.y;
        return;
    }
    const cpx Yk = cmul(Xk, Gk), Ym = cmul(Xm, Gm);
    cpx W; W.x = tw2[2 * k]; W.y = tw2[2 * k + 1];
    cpx A, D, T;
    A.x = 0.5f * (Yk.x + Ym.x); A.y = 0.5f * (Yk.y - Ym.y);
    D.x = 0.5f * (Yk.x - Ym.x); D.y = 0.5f * (Yk.y + Ym.y);
    T = cmulc(D, W);
    const int pk = rev4_14(k), pm = rev4_14(FFT_M - k);
    lds[2 * pk] = A.x - T.y; lds[2 * pk + 1] = A.y + T.x;
    cpx Dc; Dc.x = -D.x; Dc.y = D.y;
    const cpx T2 = cmul(W, Dc);
    lds[2 * pm] = A.x + T2.y; lds[2 * pm + 1] = -A.y - T2.x;
}
enum { I_X = 0, I_C, I_CTX, I_CCTX, I_WMOD, I_BMOD, I_NMIXW, I_NFFNW, I_WIN, I_BIN, I_HYCW, I_HYCB, I_HYW1, I_HYB1, I_HYW2, I_HYB2, I_HYW3, I_HYB3, I_HYFREQ, I_HYSKIP,
       I_HGLB, I_HGNW, I_GLWA2, I_GLBA, I_GLNW, I_WBR, I_WOUT, I_WRG, I_BRG, I_WRE, I_BRE, I_WGATE, I_WUP, I_WDOWN, I_FNW, N_IN };
struct Args { const float* in[N_IN]; float* out; unsigned char* ws; int ph_lo, ph_hi; };
#define GAS __attribute__((address_space(1)))
extern __shared__ __attribute__((aligned(16))) unsigned char lds_raw[];
constexpr int LDS_PTAB = 150 * 1024 - 64 - 320;
DI LAS unsigned char* ldsbase() { unsigned p = (unsigned)(unsigned long long)(LAS unsigned char*)lds_raw; asm volatile("" : "+s"(p)); return (LAS unsigned char*)(unsigned long long)p; }
DI const float* ain(const Args&, int i) { const unsigned long long v = ((LAS unsigned long long*)(ldsbase() + LDS_PTAB))[i];
    const unsigned lo = __builtin_amdgcn_readfirstlane((unsigned)v), hi = __builtin_amdgcn_readfirstlane((unsigned)(v >> 32)); return (const float*)(GAS const float*)(((unsigned long long)hi << 32) | lo); }
DI unsigned char* wsp(const Args& a) { unsigned long long p = (unsigned long long)(a).ws; asm volatile("" : "+s"(p)); return (unsigned char*)(GAS unsigned char*)p; }
DI int opq(int x) { asm volatile("" : "+s"(x)); return x; }
#ifdef PROBE_SEL
constexpr int LDS_TIM = 150 * 1024 - 64 - 320 - 512;
#define TIC() const unsigned long long tic_ = __builtin_amdgcn_s_memrealtime()
#define TOC(i) do { if (otid() == 0) ((LAS unsigned long long*)(ldsbase() + LDS_TIM))[i] += __builtin_amdgcn_s_memrealtime() - tic_; } while (0)
#else
#define TIC() do {} while (0)
#define TOC(i) do {} while (0)
#endif
#define LDS_BAR() do { asm volatile("s_waitcnt lgkmcnt(0)" ::: "memory"); __builtin_amdgcn_s_barrier(); asm volatile("" ::: "memory"); } while (0)
constexpr int NTHR = 512;
constexpr int LDS_BYTES = 150 * 1024;
constexpr int LDS_X = 131072;
constexpr int LDS_BARW = LDS_BYTES - 64;

DI int z_srccol(int zc) { return zc < 8192 ? zc : (zc < Z_LR ? zc + 32 : (zc < Z_LR + 32 ? zc - Z_LR + 8192 : -1)); }

DI void cvt_block(const float* __restrict__ s0, const float* __restrict__ s1, const float* __restrict__ s2, const float* __restrict__ s3, size_t ld, int c0, int c1, int c2, int c3,
                  bf16* __restrict__ dst, int K, int row0, int kb, LAS float* t) {
    const int tid = otid(), nn = tid & 63, kk = tid >> 6;
    float v[8][4];
#pragma unroll
    for (int p = 0; p < 8; ++p) { const size_t ko = (size_t)(kb * 64 + p * 8 + kk) * ld;
        v[p][0] = c0 >= 0 ? s0[ko + c0] : 0.f; v[p][1] = c1 >= 0 ? s1[ko + c1] : 0.f; v[p][2] = c2 >= 0 ? s2[ko + c2] : 0.f; v[p][3] = c3 >= 0 ? s3[ko + c3] : 0.f; }
#pragma unroll
    for (int p = 0; p < 8; ++p)
#pragma unroll
        for (int g = 0; g < 4; ++g) t[(p * 8 + kk) * 257 + g * 64 + nn] = v[p][g];
    __syncthreads();
    const int rr = tid & 255, hk = tid >> 8;
#pragma unroll
    for (int q = 0; q < 4; ++q) { float w[8];
#pragma unroll
        for (int j = 0; j < 8; ++j) w[j] = t[(hk * 32 + q * 8 + j) * 257 + rr];
        u32x4 o; o.x = pk_bf16(w[0], w[1]); o.y = pk_bf16(w[2], w[3]); o.z = pk_bf16(w[4], w[5]); o.w = pk_bf16(w[6], w[7]);
        *(u32x4*)(dst + (size_t)(row0 + rr) * K + kb * 64 + hk * 32 + q * 8) = o; }
    __syncthreads();
}
constexpr int CVT_MIX_TILES = 69 * 32 + 3 * 8 * 16 + 8 * 32;
DI void cvt_mix_item(const Args& a, int l, int it, LAS float* t) {
    const int nn = otid() & 63;
    if (it < 69 * 32) { const int nb = it >> 5, kb = it & 31; const float* s = ain(a, I_WIN) + (size_t)l * D * NCOLS_IN;
        cvt_block(s, s, s, s, NCOLS_IN, z_srccol(nb * 256 + nn), z_srccol(nb * 256 + 64 + nn), z_srccol(nb * 256 + 128 + nn), z_srccol(nb * 256 + 192 + nn), (bf16*)(wsp(a) + WS_WIN), D, nb * 256, kb, t); return; }
    it -= 69 * 32;
    if (it < 3 * 8 * 16) { const int br = it / 128, r = it % 128, nb = r >> 4, kb = r & 15; const float* s = ain(a, I_WBR) + ((size_t)l * 3 + br) * 1024 * D; const int c = nb * 256 + nn;
        cvt_block(s, s, s, s, D, c, c + 64, c + 128, c + 192, (bf16*)(wsp(a) + WS_WBR) + (size_t)br * D * 1024, 1024, nb * 256, kb, t); return; }
    it -= 3 * 8 * 16;
    { const int nb = it >> 5, kb = it & 31; const float* s = ain(a, I_WOUT) + (size_t)l * D * D; const int c = nb * 256 + nn;
      cvt_block(s, s, s, s, D, c, c + 64, c + 128, c + 192, (bf16*)(wsp(a) + WS_WOUT), D, nb * 256, kb, t); }
}
constexpr int CVT_MOE_TILES = 32 * 4 * 32 + 32 * 8 * 8;
DI void cvt_moe_item(const Args& a, int l, int it, LAS float* t) {
    const int nn = otid() & 63;
    if (it < 32 * 4 * 32) { const int e = it >> 7, r = it & 127, nt = r >> 5, kb = r & 31;
        const float* sg = ain(a, I_WGATE) + ((size_t)l * NEXP + e) * D * DFF; const float* su = ain(a, I_WUP) + ((size_t)l * NEXP + e) * D * DFF; const int c = nt * 128 + nn;
        cvt_block(sg, sg, su, su, DFF, c, c + 64, c, c + 64, (bf16*)(wsp(a) + WS_WGU) + (size_t)e * 1024 * D, D, nt * 256, kb, t); return; }
    it -= 32 * 4 * 32;
    { const int e = it >> 6, r = it & 63, nb = r >> 3, kb = r & 7; const float* s = ain(a, I_WDOWN) + ((size_t)l * NEXP + e) * DFF * D; const int c = nb * 256 + nn;
      cvt_block(s, s, s, s, D, c, c + 64, c + 128, c + 192, (bf16*)(wsp(a) + WS_WD) + (size_t)e * D * DFF, DFF, nb * 256, kb, t); }
}

DI void mod_item(const Args& a, int j, LAS float* lds) {
    const int tid = otid(), l = j >> 7, col0 = (j & 127) * 96;
    LAS float* sil = lds;
    LAS float* red = lds + 4096;
    for (int k = tid; k < 2 * D; k += NTHR) { const float c = (k < D) ? ain(a, I_C)[k] : ain(a, I_CCTX)[k - D]; sil[k] = siluf_(c); }
    __syncthreads();
    const int cg = tid % 24, rg = tid / 24;
    f32x4 a0 = {0.f, 0.f, 0.f, 0.f}, a1 = {0.f, 0.f, 0.f, 0.f};
    if (rg < 21) {
        const float* w = ain(a, I_WMOD) + (size_t)l * D * 12288 + col0 + cg * 4;
        for (int k = rg; k < D; k += 21) { const f32x4 wv = *(const f32x4*)(w + (size_t)k * 12288); a0 += wv * sil[k]; a1 += wv * sil[D + k]; }
#pragma unroll
        for (int q = 0; q < 4; ++q) { red[(rg * 2 + 0) * 96 + cg * 4 + q] = a0[q]; red[(rg * 2 + 1) * 96 + cg * 4 + q] = a1[q]; }
    }
    __syncthreads();
    if (tid < 192) { const int set = tid / 96, c = tid % 96; float s = 0.f;
        for (int r = 0; r < 21; ++r) s += red[(r * 2 + set) * 96 + c];
        ((float*)(wsp(a) + WS_MOD))[((size_t)l * 2 + set) * 12288 + col0 + c] = s + ain(a, I_BMOD)[(size_t)l * 12288 + col0 + c]; }
    __syncthreads();
}
DI void h2_item(const Args& a, int it, LAS float* lds) {
    const int tid = otid(), l = it / (MT / 8), r0 = (it % (MT / 8)) * 8;
    LAS float* feats = lds;
    LAS float* h1 = lds + 8 * 36;
    if (tid < 8 * 33) { const int rr = tid / 33, i = tid % 33, r = r0 + rr; const int Lq = r < SEQ ? SEQ : CTXL, t = r < SEQ ? r : r - SEQ;
        float f;
        if (i == 0) f = (float)t / (float)(Lq - 1);
        else { const int bi = (i - 1) & 15; const float band = 1e-4f + (float)bi * ((15.0f - 1e-4f) / 15.0f); const float rev2 = 2.0f * band * (float)t / (float)Lq;
            f = (i <= 16) ? cospif(rev2) : -sinpif(rev2); }
        feats[rr * 36 + i] = f; }
    __syncthreads();
    const int rr = tid >> 6, j = tid & 63;
    { const float* w1 = ain(a, I_HYW1) + (size_t)l * 33 * 64; float s = ain(a, I_HYB1)[l * 64 + j];
      for (int i = 0; i < 33; ++i) s += feats[rr * 36 + i] * w1[i * 64 + j];
      h1[rr * 64 + j] = sinf(ain(a, I_HYFREQ)[l * 64 + j] * s); }
    __syncthreads();
    { const float* w2 = ain(a, I_HYW2) + (size_t)l * 64 * 64; float s = ain(a, I_HYB2)[l * 64 + j];
      for (int i = 0; i < 64; ++i) s += h1[rr * 64 + i] * w2[i * 64 + j];
      const float hv = sinf(ain(a, I_HYFREQ)[l * 64 + j] * s);
      ((float*)(wsp(a) + WS_H2))[((size_t)l * MT + r0 + rr) * 64 + j] = hv;
      if (r0 + rr < SEQ) { bf16* hb = (bf16*)(wsp(a) + WS_H2B) + ((size_t)l * SEQ + r0 + rr) * 256; hb[j] = f2bf(hv); hb[64 + j] = 0; hb[128 + j] = 0; hb[192 + j] = 0; } }
    __syncthreads();
}
DI void prologue_small(const Args& a) {
    const size_t gt = (size_t)obid() * NTHR + otid(), gs = (size_t)ogdim() * NTHR;
    float* zb = (float*)(wsp(a) + WS_ZBIAS);
    for (size_t i = gt; i < (size_t)DEPTH * ZC; i += gs) { const int l = (int)(i / ZC), zc = (int)(i % ZC), sc = z_srccol(zc); zb[i] = sc >= 0 ? ain(a, I_BIN)[(size_t)l * NCOLS_IN + sc] : 0.f; }
    float* lb = (float*)(wsp(a) + WS_LB);
    for (size_t i = gt; i < (size_t)DEPTH * 2048; i += gs) { const int l = (int)(i / 2048), j = (int)(i % 2048);
        float v = 0.f; if (l == 1) { const float r0 = ain(a, I_HGLB)[j], r1 = ain(a, I_HGLB)[2048 + j]; v = 1.0f / (1.0f + expf(r0 - r1)); }
        lb[i] = v; }
    bf16* w3t = (bf16*)(wsp(a) + WS_W3T);
    for (size_t i = gt; i < (size_t)DEPTH * 2048 * 256; i += gs) { const int l = (int)(i >> 19), fc = (int)((i >> 8) & 2047), j = (int)(i & 255); w3t[i] = j < 64 ? f2bf(ain(a, I_HYW3)[((size_t)l * 64 + j) * 2048 + fc]) : (bf16)0; }
    bf16* wrt = (bf16*)(wsp(a) + WS_WRT);
    for (size_t i = gt; i < (size_t)DEPTH * 48 * 2048; i += gs) { const int l = (int)(i / (48 * 2048)), c = (int)((i / 2048) % 48), k = (int)(i & 2047);
        const float w = c < 4 ? ain(a, I_WRG)[((size_t)l * D + k) * 4 + c] : (c < 36 ? ain(a, I_WRE)[((size_t)l * D + k) * 32 + (c - 4)] : 0.f);
        const bf16 hi = f2bf(w); wrt[((size_t)l * 2 + 0) * 48 * 2048 + (size_t)c * 2048 + k] = hi; wrt[((size_t)l * 2 + 1) * 48 * 2048 + (size_t)c * 2048 + k] = f2bf(w - bf2f(hi)); }
    float* tw = (float*)(wsp(a) + WS_TW);
    for (size_t i = gt; i < 16384; i += gs) { float s, c; sincospif(-2.0f * (float)i / 16384.0f, &s, &c); tw[2 * i] = c; tw[2 * i + 1] = s; }
    float* tw2 = (float*)(wsp(a) + WS_TW2);
    for (size_t i = gt; i <= 8192; i += gs) { float s, c; sincospif(-(float)i / 16384.0f, &s, &c); tw2[2 * i] = c; tw2[2 * i + 1] = s; }
}
DI void hyc_filters(const Args& a, int l) {
    const int lane = otid() & 63, wave = otid() >> 6;
    const float* h2 = (const float*)(wsp(a) + WS_H2) + ((size_t)l * MT + SEQ) * 64;
    const float* w3 = ain(a, I_HYW3) + (size_t)l * 64 * 2048;
    float* hyc = (float*)(wsp(a) + WS_HYC);
    const float a0 = -4.605170186f / 1.5f, a1 = -4.605170186f / 0.3f;
    for (int fc = obid() * 8 + wave; fc < 2048; fc += ogdim() * 8) {
        const int c = fc & 1023; const float delta = fabsf(a0 + (float)c * ((a1 - a0) / 1023.0f)); const float b3 = ain(a, I_HYB3)[l * 2048 + fc];
        float hv[4], ssum = 0.f;
#pragma unroll
        for (int i = 0; i < 4; ++i) { const int t = lane + 64 * i; float s = b3;
            for (int j = 0; j < 64; ++j) s += h2[t * 64 + j] * w3[j * 2048 + fc];
            const float tl = (float)t / 255.0f; hv[i] = s * (expf(-tl * delta) + 0.05f); ssum += fabsf(hv[i]); }
        ssum = wave_sum(ssum); const float inv = 1.0f / ssum;
#pragma unroll
        for (int i = 0; i < 4; ++i) hyc[(size_t)fc * 256 + lane + 64 * i] = hv[i] * inv;
    }
}
template <int MODE, bool DRY = false> DI void norm_phase(const Args& a, int l, int nrows, LAS float* ldsf) {
    const int lane = otid() & 63, wave = otid() >> 6;
    float* H = (float*)(wsp(a) + WS_H); bf16* U = (bf16*)(wsp(a) + WS_U);
    const float* modall = (const float*)(wsp(a) + WS_MOD);
    int* route = (int*)(wsp(a) + WS_ROUTE);
    const bf16* YP = (const bf16*)(wsp(a) + WS_YP);
    const bool combine = (MODE == 0 && l > 0) || MODE == 2;
    for (int r = obid() * 8 + wave; r < nrows; r += ogdim() * 8) {
        const int set = r >= SEQ ? 1 : 0;
        const float* src = (MODE == 0 && l == 0) ? (set ? ain(a, I_CTX) + (size_t)(r - SEQ) * D : ain(a, I_X) + (size_t)r * D) : H + (size_t)r * D;
        f32x4 v[8];
#pragma unroll
        for (int j = 0; j < 8; ++j) v[j] = *(const f32x4*)(src + j * 256 + lane * 4);
        if (combine) {
            const float* gt2 = modall + ((size_t)(l - 1) * 2 + set) * 12288 + 10240;
            const int p0 = route[r * 8 + 6], p1 = route[r * 8 + 7];
#pragma unroll
            for (int j = 0; j < 8; ++j) { const int col = j * 256 + lane * 4;
                const u32x2 y0 = *(const u32x2*)(YP + (size_t)p0 * D + col), y1 = *(const u32x2*)(YP + (size_t)p1 * D + col); const f32x4 g = *(const f32x4*)(gt2 + col);
                v[j][0] += g[0] * (bflo(y0.x) + bflo(y1.x)); v[j][1] += g[1] * (bfhi(y0.x) + bfhi(y1.x)); v[j][2] += g[2] * (bflo(y0.y) + bflo(y1.y)); v[j][3] += g[3] * (bfhi(y0.y) + bfhi(y1.y)); }
            if (MODE == 0) {
#pragma unroll
                for (int j = 0; j < 8; ++j) *(f32x4*)(H + (size_t)r * D + j * 256 + lane * 4) = v[j];
            }
        }
        float ss = 0.f;
#pragma unroll
        for (int j = 0; j < 8; ++j) ss += (v[j][0] * v[j][0] + v[j][1] * v[j][1]) + (v[j][2] * v[j][2] + v[j][3] * v[j][3]);
        ss = wave_sum(ss);
        const float rstd = rsqrtf(ss * (1.0f / D) + NORM_EPS);
        if (MODE == 2) {
            const float* fw = ain(a, I_FNW);
#ifdef PROBE_SEL
            const float pscale = 1.0f + 0.5f * (float)((LAS unsigned long long*)(ldsbase() + LDS_TIM))[PROBE_SEL] / (float)((LAS unsigned long long*)(ldsbase() + LDS_TIM))[0];
#else
            const float pscale = 1.0f;
#endif
#pragma unroll
            for (int j = 0; j < 8; ++j) { const int col = j * 256 + lane * 4; const f32x4 w = *(const f32x4*)(fw + col); *(f32x4*)(a.out + (size_t)r * D + col) = v[j] * rstd * w * pscale; }
        } else {
            const float* nw = (MODE == 0 ? ain(a, I_NMIXW) : ain(a, I_NFFNW)) + (size_t)l * D;
            const float* md = modall + ((size_t)l * 2 + set) * 12288 + (MODE == 0 ? 0 : 6144);
#pragma unroll
            for (int j = 0; j < 8; ++j) { const int col = j * 256 + lane * 4; const f32x4 w = *(const f32x4*)(nw + col), sh = *(const f32x4*)(md + col), sc = *(const f32x4*)(md + 2048 + col);
                v[j] = (v[j] * rstd * w) * (sc + 1.0f) + sh;
                u32x2 o; o.x = pk_bf16(v[j][0], v[j][1]); o.y = pk_bf16(v[j][2], v[j][3]); *(u32x2*)(U + (size_t)r * D + col) = o; }
            if (MODE == 1) {
                const float* wrg = ain(a, I_WRG) + (size_t)l * D * 4; const float* wre = ain(a, I_WRE) + (size_t)l * D * 32;
                float lg[36];
#pragma unroll
                for (int i = 0; i < 36; ++i) lg[i] = 0.f;
                LAS float* wu = ldsf + wave * 2048;
#pragma unroll
                for (int j = 0; j < 8; ++j) *(LAS f32x4*)(wu + j * 256 + lane * 4) = v[j];
                asm volatile("s_waitcnt lgkmcnt(0)" ::: "memory");
#pragma unroll 2
                for (int cc = 0; cc < 32; ++cc) { const int col = cc * 64 + lane; const float uv = wu[col];
                    const f32x4 g = *(const f32x4*)(wrg + (size_t)col * 4);
                    lg[0] += uv * g[0]; lg[1] += uv * g[1]; lg[2] += uv * g[2]; lg[3] += uv * g[3];
#pragma unroll
                    for (int e4 = 0; e4 < 8; ++e4) { const f32x4 w = *(const f32x4*)(wre + (size_t)col * 32 + e4 * 4);
                        lg[4 + e4 * 4 + 0] += uv * w[0]; lg[4 + e4 * 4 + 1] += uv * w[1]; lg[4 + e4 * 4 + 2] += uv * w[2]; lg[4 + e4 * 4 + 3] += uv * w[3]; } }
                asm volatile("s_waitcnt lgkmcnt(0)" ::: "memory");
#pragma unroll
                for (int i = 0; i < 36; ++i) lg[i] = wave_sum(lg[i]);
                float gl[4]; int grp = 0; float gmax;
#pragma unroll
                for (int g = 0; g < 4; ++g) gl[g] = lg[g] + ain(a, I_BRG)[l * 4 + g];
                gmax = gl[0];
#pragma unroll
                for (int g = 1; g < 4; ++g) if (gl[g] > gmax) { gmax = gl[g]; grp = g; }
                float gden = 0.f;
#pragma unroll
                for (int g = 0; g < 4; ++g) gden += expf(gl[g] - gmax);
                const float ptop = 1.0f / gden;
                float le[8];
#pragma unroll
                for (int i = 0; i < 8; ++i) { float x = lg[4 + i];
#pragma unroll
                    for (int g = 1; g < 4; ++g) x = (grp == g) ? lg[4 + g * 8 + i] : x;
                    le[i] = x + ain(a, I_BRE)[l * 32 + grp * 8 + i]; }
                int i0 = 0; float m0 = le[0];
#pragma unroll
                for (int i = 1; i < 8; ++i) if (le[i] > m0) { m0 = le[i]; i0 = i; }
                int i1 = -1; float m1 = -3.0e38f;
#pragma unroll
                for (int i = 0; i < 8; ++i) if (i != i0 && le[i] > m1) { m1 = le[i]; i1 = i; }
                const float e1v = expf(m1 - m0);
                const float w0 = ptop / (1.0f + e1v), w1 = ptop * e1v / (1.0f + e1v);
                if (DRY) { asm volatile("" :: "v"(w0), "v"(w1), "v"(i0), "v"(i1), "v"(grp)); }
                else if (lane == 0) {
                    unsigned* cnt = (unsigned*)(wsp(a) + WS_CTL) + CW_CNT + l * 64;
                    const int ex0 = grp * 8 + i0, ex1 = grp * 8 + i1;
                    const unsigned s0 = atomicAdd(cnt + ex0, 1u), s1 = atomicAdd(cnt + ex1, 1u);
                    route[r * 8 + 0] = ex0; route[r * 8 + 1] = ex1; route[r * 8 + 2] = (int)s0; route[r * 8 + 3] = (int)s1;
                    route[r * 8 + 4] = __float_as_int(w0); route[r * 8 + 5] = __float_as_int(w1);
                }
            }
        }
    }
}
typedef short bf16x8r_t __attribute__((ext_vector_type(8)));
template <bool DRY> DI void route_phase(const Args& a, int l, int nrows, LAS float* ldsf) {
    const int lane = otid() & 63, wave = otid() >> 6, fr = lane & 15, fq = lane >> 4;
    const float* H = (const float*)(wsp(a) + WS_H); bf16* U = (bf16*)(wsp(a) + WS_U); int* route = (int*)(wsp(a) + WS_ROUTE);
    const float* nw = ain(a, I_NFFNW) + (size_t)l * D;
    const bf16* Wh = (const bf16*)(wsp(a) + WS_WRT) + (size_t)l * 2 * 48 * 2048; const bf16* Wl = Wh + 48 * 2048;
    LAS float* lt = ldsf + wave * 1024;
    const int G = ogdim();
    for (int tile = wave * G + (int)obid(); tile < nrows / 16; tile += 8 * G) {
        const int row = tile * 16 + fr, set = row >= SEQ ? 1 : 0;
        const float* hr = H + (size_t)row * D + fq * 8;
        const float* md = (const float*)(wsp(a) + WS_MOD) + ((size_t)l * 2 + set) * 12288 + 6144 + fq * 8;
        float ss = 0.f;
#pragma unroll 8
        for (int ks = 0; ks < 64; ++ks) { const f32x4 x0 = *(const f32x4*)(hr + ks * 32), x1 = *(const f32x4*)(hr + ks * 32 + 4);
            ss += (x0[0] * x0[0] + x0[1] * x0[1]) + (x0[2] * x0[2] + x0[3] * x0[3]) + (x1[0] * x1[0] + x1[1] * x1[1]) + (x1[2] * x1[2] + x1[3] * x1[3]); }
        ss += __shfl_xor(ss, 16); ss += __shfl_xor(ss, 32);
        const float rstd = rsqrtf(ss * (1.0f / D) + NORM_EPS);
        f32x4 acc[3];
#pragma unroll
        for (int cb = 0; cb < 3; ++cb) acc[cb] = (f32x4){0.f, 0.f, 0.f, 0.f};
#pragma unroll 2
        for (int ks = 0; ks < 64; ++ks) { const int c0 = ks * 32;
            const f32x4 x0 = *(const f32x4*)(hr + c0), x1 = *(const f32x4*)(hr + c0 + 4);
            const f32x4 w0 = *(const f32x4*)(nw + fq * 8 + c0), w1 = *(const f32x4*)(nw + fq * 8 + c0 + 4);
            const f32x4 h0 = *(const f32x4*)(md + c0), h1 = *(const f32x4*)(md + c0 + 4), s0 = *(const f32x4*)(md + 2048 + c0), s1 = *(const f32x4*)(md + 2048 + c0 + 4);
            const f32x4 u0 = (x0 * rstd * w0) * (s0 + 1.0f) + h0, u1 = (x1 * rstd * w1) * (s1 + 1.0f) + h1;
            u32x4 hi; hi.x = pk_bf16(u0[0], u0[1]); hi.y = pk_bf16(u0[2], u0[3]); hi.z = pk_bf16(u1[0], u1[1]); hi.w = pk_bf16(u1[2], u1[3]);
            *(u32x4*)(U + (size_t)row * D + fq * 8 + c0) = hi;
            u32x4 lo; lo.x = pk_bf16(u0[0] - bflo(hi.x), u0[1] - bfhi(hi.x)); lo.y = pk_bf16(u0[2] - bflo(hi.y), u0[3] - bfhi(hi.y)); lo.z = pk_bf16(u1[0] - bflo(hi.z), u1[1] - bfhi(hi.z)); lo.w = pk_bf16(u1[2] - bflo(hi.w), u1[3] - bfhi(hi.w));
            const bf16x8r_t ah = __builtin_bit_cast(bf16x8r_t, hi), al = __builtin_bit_cast(bf16x8r_t, lo);
#pragma unroll
            for (int cb = 0; cb < 3; ++cb) { const bf16x8r_t bh = *(const bf16x8r_t*)(Wh + (size_t)(cb * 16 + fr) * 2048 + c0 + fq * 8), bl = *(const bf16x8r_t*)(Wl + (size_t)(cb * 16 + fr) * 2048 + c0 + fq * 8);
                acc[cb] = __builtin_amdgcn_mfma_f32_16x16x32_bf16(ah, bh, acc[cb], 0, 0, 0); acc[cb] = __builtin_amdgcn_mfma_f32_16x16x32_bf16(ah, bl, acc[cb], 0, 0, 0); acc[cb] = __builtin_amdgcn_mfma_f32_16x16x32_bf16(al, bh, acc[cb], 0, 0, 0); } }
#pragma unroll
        for (int cb = 0; cb < 3; ++cb)
#pragma unroll
            for (int j = 0; j < 4; ++j) lt[(fq * 4 + j) * 48 + cb * 16 + fr] = acc[cb][j];
        asm volatile("s_waitcnt lgkmcnt(0)" ::: "memory");
        if (lane < 16) {
            const int r = tile * 16 + lane; float lg[36];
#pragma unroll
            for (int i = 0; i < 36; ++i) lg[i] = lt[lane * 48 + i];
            float gl[4]; int grp = 0; float gmax;
#pragma unroll
            for (int g = 0; g < 4; ++g) gl[g] = lg[g] + ain(a, I_BRG)[l * 4 + g];
            gmax = gl[0];
#pragma unroll
            for (int g = 1; g < 4; ++g) if (gl[g] > gmax) { gmax = gl[g]; grp = g; }
            float gden = 0.f;
#pragma unroll
            for (int g = 0; g < 4; ++g) gden += expf(gl[g] - gmax);
            const float ptop = 1.0f / gden;
            float le[8];
#pragma unroll
            for (int i = 0; i < 8; ++i) { float x = lg[4 + i];
#pragma unroll
                for (int g = 1; g < 4; ++g) x = (grp == g) ? lg[4 + g * 8 + i] : x;
                le[i] = x + ain(a, I_BRE)[l * 32 + grp * 8 + i]; }
            int i0 = 0; float m0 = le[0];
#pragma unroll
            for (int i = 1; i < 8; ++i) if (le[i] > m0) { m0 = le[i]; i0 = i; }
            int i1 = -1; float m1 = -3.0e38f;
#pragma unroll
            for (int i = 0; i < 8; ++i) if (i != i0 && le[i] > m1) { m1 = le[i]; i1 = i; }
            const float e1v = expf(m1 - m0);
            const float w0 = ptop / (1.0f + e1v), w1 = ptop * e1v / (1.0f + e1v);
            if (DRY) { asm volatile("" :: "v"(w0), "v"(w1), "v"(i0), "v"(i1), "v"(grp)); }
            else { unsigned* cnt = (unsigned*)(wsp(a) + WS_CTL) + CW_CNT + l * 64; const int ex0 = grp * 8 + i0, ex1 = grp * 8 + i1;
                const unsigned s0 = atomicAdd(cnt + ex0, 1u), s1 = atomicAdd(cnt + ex1, 1u);
                route[r * 8 + 0] = ex0; route[r * 8 + 1] = ex1; route[r * 8 + 2] = (int)s0; route[r * 8 + 3] = (int)s1; route[r * 8 + 4] = __float_as_int(w0); route[r * 8 + 5] = __float_as_int(w1); }
        }
        asm volatile("s_waitcnt lgkmcnt(0)" ::: "memory");
    }
}
DI void permute_phase(const Args& a, int l, int nrows, LAS unsigned char* ldsb) {
    LAS int* poff = (LAS int*)ldsb;
    const int tid = otid(), lane = tid & 63, wave = tid >> 6;
    const unsigned* cnt = (const unsigned*)(wsp(a) + WS_CTL) + CW_CNT + l * 64;
    if (tid == 0) { int off = 0; for (int e = 0; e < NEXP; ++e) { poff[e] = off; off += (int)((cnt[e] + 255u) / 256u) * 256; } poff[32] = off; }
    __syncthreads();
    if (obid() == 0) { int* tile_e = (int*)(wsp(a) + WS_TILEE); const int nt = poff[32] >> 8;
        if (tid < 200) { int e = -1; if (tid < nt) { for (int q = 0; q < NEXP; ++q) if (poff[q] <= tid * 256) e = q; } tile_e[tid] = e < 0 ? 0 : e; }
        if (tid == 0) tile_e[200] = nt; }
    int* route = (int*)(wsp(a) + WS_ROUTE); float* roww = (float*)(wsp(a) + WS_ROWW);
    const bf16* U = (const bf16*)(wsp(a) + WS_U); bf16* XP = (bf16*)(wsp(a) + WS_XP);
    for (int r = obid() * 8 + wave; r < nrows; r += ogdim() * 8) {
        const int e0 = route[r * 8 + 0], e1 = route[r * 8 + 1], s0 = route[r * 8 + 2], s1 = route[r * 8 + 3];
        const int p0 = poff[e0] + s0, p1 = poff[e1] + s1;
        u32x4 x[4];
#pragma unroll
        for (int i = 0; i < 4; ++i) x[i] = *(const u32x4*)(U + (size_t)r * D + (i * 64 + lane) * 8);
#pragma unroll
        for (int i = 0; i < 4; ++i) { *(u32x4*)(XP + (size_t)p0 * D + (i * 64 + lane) * 8) = x[i]; *(u32x4*)(XP + (size_t)p1 * D + (i * 64 + lane) * 8) = x[i]; }
        if (lane == 0) { route[r * 8 + 6] = p0; route[r * 8 + 7] = p1; roww[p0] = __int_as_float(route[r * 8 + 4]); roww[p1] = __int_as_float(route[r * 8 + 5]); }
    }
}
DI int stream_row(int p, int dir) { return dir == 0 ? (p < CTXL ? SEQ + p : p - CTXL) : (p < CTXL ? SEQ + (CTXL - 1 - p) : (SEQ - 1) - (p - CTXL)); }

DI void shortconv8(const bf16* Z, const float* cw, const float* cb, int l, int seg, int c, int r0, int lo, int hi, float (&out)[8]) {
    const int col = Z_HY + seg * 1024 + c; float zz[10];
#pragma unroll
    for (int i = 0; i < 10; ++i) { const int r = r0 - 1 + i; zz[i] = (r >= lo && r < hi) ? bf2f(Z[(size_t)r * ZC + col]) : 0.f; }
    const float w0 = cw[((size_t)l * 3 + 0) * 3072 + seg * 1024 + c], w1 = cw[((size_t)l * 3 + 1) * 3072 + seg * 1024 + c], w2 = cw[((size_t)l * 3 + 2) * 3072 + seg * 1024 + c], b = cb[(size_t)l * 3072 + seg * 1024 + c];
#pragma unroll
    for (int i = 0; i < 8; ++i) out[i] = w0 * zz[i] + w1 * zz[i + 1] + w2 * zz[i + 2] + b;
}
DI void hyprep_item(const Args& a, int l, int it, LAS float* t) {
    const int tid = otid(), tb = it >> 4, cb = it & 15, r0 = tb * 64, lo = r0 < SEQ ? 0 : SEQ, hi = r0 < SEQ ? SEQ : MT;
    const bf16* Z = (const bf16*)(wsp(a) + WS_Z); bf16* VXT = (bf16*)(wsp(a) + WS_U);
    { const int cc = tid & 63, tq = tid >> 6, c = cb * 64 + cc; float x1[8], vv[8];
      shortconv8(Z, ain(a, I_HYCW), ain(a, I_HYCB), l, 1, c, r0 + tq * 8, lo, hi, x1); shortconv8(Z, ain(a, I_HYCW), ain(a, I_HYCB), l, 2, c, r0 + tq * 8, lo, hi, vv);
#pragma unroll
      for (int i = 0; i < 8; ++i) t[cc * 65 + tq * 8 + i] = vv[i] * x1[i]; }
    __syncthreads();
    { const int cw = tid >> 3, t8 = tid & 7; float o[8];
#pragma unroll
      for (int i = 0; i < 8; ++i) o[i] = t[cw * 65 + t8 * 8 + i];
      u32x4 w; w.x = pk_bf16(o[0], o[1]); w.y = pk_bf16(o[2], o[3]); w.z = pk_bf16(o[4], o[5]); w.w = pk_bf16(o[6], o[7]);
      *(u32x4*)(VXT + (size_t)(cb * 64 + cw) * MT + r0 + t8 * 8) = w; }
    __syncthreads();
}
DI void hycomb_item(const Args& a, int l, int it, LAS float* t) {
    const int tid = otid(), tb = it >> 4, cb = it & 15, r0 = tb * 64, lo = r0 < SEQ ? 0 : SEQ, hi = r0 < SEQ ? SEQ : MT;
    const bf16* Z = (const bf16*)(wsp(a) + WS_Z); const bf16* VXT = (const bf16*)(wsp(a) + WS_CVO); bf16* Y0 = (bf16*)(wsp(a) + WS_YMIX);
    { const int cw = tid >> 3, t8 = tid & 7; const u32x4 r = *(const u32x4*)(VXT + (size_t)(cb * 64 + cw) * MT + r0 + t8 * 8);
      LAS float* tp = t + cw * 65 + t8 * 8; tp[0] = bflo(r.x); tp[1] = bfhi(r.x); tp[2] = bflo(r.y); tp[3] = bfhi(r.y); tp[4] = bflo(r.z); tp[5] = bfhi(r.z); tp[6] = bflo(r.w); tp[7] = bfhi(r.w); }
    __syncthreads();
    { const int cc = tid & 63, tq = tid >> 6, c = cb * 64 + cc; float x0[8];
      shortconv8(Z, ain(a, I_HYCW), ain(a, I_HYCB), l, 0, c, r0 + tq * 8, lo, hi, x0);
#pragma unroll
      for (int i = 0; i < 8; ++i) Y0[(size_t)(r0 + tq * 8 + i) * 1024 + c] = f2bf(t[cc * 65 + tq * 8 + i] * x0[i]); }
    __syncthreads();
}
DI void scancomb_rows(const Args& a, int l, int nrows) {
    const int lane = otid() & 63, wave = otid() >> 6;
    const bf16* Z = (const bf16*)(wsp(a) + WS_Z); const bf16* O = (const bf16*)(wsp(a) + WS_OSC);
    bf16* Y1 = (bf16*)(wsp(a) + WS_YMIX) + (size_t)MT * 1024; bf16* Y2 = Y1 + (size_t)MT * 1024;
    for (int r = obid() * 8 + wave; r < nrows; r += ogdim() * 8) {
#pragma unroll
        for (int i = 0; i < 4; ++i) { const int col = i * 256 + lane * 4;
            { const u32x2 pf = *(const u32x2*)(O + (size_t)r * 1024 + col), pb = *(const u32x2*)(O + ((size_t)MT + r) * 1024 + col); f32x4 o; o[0] = bflo(pf.x) + bflo(pb.x); o[1] = bfhi(pf.x) + bfhi(pb.x); o[2] = bflo(pf.y) + bflo(pb.y); o[3] = bfhi(pf.y) + bfhi(pb.y);
              float ss = (o[0] * o[0] + o[1] * o[1]) + (o[2] * o[2] + o[3] * o[3]);
              ss += __shfl_xor(ss, 16); ss += __shfl_xor(ss, 8); ss += __shfl_xor(ss, 4); ss += __shfl_xor(ss, 2); ss += __shfl_xor(ss, 1);
              const float rstd = rsqrtf(ss * (1.0f / 128.0f) + NORM_EPS);
              const f32x4 nw = *(const f32x4*)(ain(a, I_HGNW) + (size_t)l * 128 + (col & 127));
              const u32x2 g = *(const u32x2*)(Z + (size_t)r * ZC + Z_HG + 4096 + col);
              u32x2 w; w.x = pk_bf16(o[0] * rstd * nw[0] * sigmoidf_(bflo(g.x)), o[1] * rstd * nw[1] * sigmoidf_(bfhi(g.x)));
              w.y = pk_bf16(o[2] * rstd * nw[2] * sigmoidf_(bflo(g.y)), o[3] * rstd * nw[3] * sigmoidf_(bfhi(g.y)));
              *(u32x2*)(Y1 + (size_t)r * 1024 + col) = w; }
            { const u32x2 pf = *(const u32x2*)(O + ((size_t)2 * MT + r) * 1024 + col), pb = *(const u32x2*)(O + ((size_t)3 * MT + r) * 1024 + col); f32x4 o; o[0] = bflo(pf.x) + bflo(pb.x); o[1] = bfhi(pf.x) + bfhi(pb.x); o[2] = bflo(pf.y) + bflo(pb.y); o[3] = bfhi(pf.y) + bfhi(pb.y);
              float ss = (o[0] * o[0] + o[1] * o[1]) + (o[2] * o[2] + o[3] * o[3]); ss = wave_sum(ss);
              const float rstd = rsqrtf(ss * (1.0f / 256.0f) + NORM_EPS);
              const f32x4 nw = *(const f32x4*)(ain(a, I_GLNW) + (size_t)l * 256 + (col & 255));
              const u32x2 g = *(const u32x2*)(Z + (size_t)r * ZC + Z_GL + 2048 + col);
              u32x2 w; w.x = pk_bf16(o[0] * rstd * nw[0] * siluf_(bflo(g.x)), o[1] * rstd * nw[1] * siluf_(bfhi(g.x)));
              w.y = pk_bf16(o[2] * rstd * nw[2] * siluf_(bflo(g.y)), o[3] * rstd * nw[3] * siluf_(bfhi(g.y)));
              *(u32x2*)(Y2 + (size_t)r * 1024 + col) = w; }
        }
    }
}
typedef short bf16x8_t __attribute__((ext_vector_type(8)));
constexpr int SC_N = 65;
constexpr size_t KVS_GL_OFF = (size_t)16 * SC_N * 16384;
constexpr size_t WS_KVS = WS_WGU;
constexpr size_t WS_KD  = WS_WGU + 130 * MiB;
constexpr int SL_QM = 0, SL_KM = 17408, SL_Q0 = 34816, SL_KE = 52224, SL_VT = 70656, SL_PP = 107520, SL_TOT = 116736, SL_DD = 118784, SL_AFB = 119296, SL_EB = 121344;
static_assert(SL_EB + 512 <= 131072 && WS_KD + (size_t)24 * SC_N * 128 * 4 <= WS_H, "scan maps");
DI bf16x8_t lds_frag16(LAS unsigned char* p) { return *(LAS bf16x8_t*)p; }
DI bf16x8_t pack_bf16x8(const f32x4& lo, const f32x4& hi) { u32x4 w; w.x = pk_bf16(lo[0], lo[1]); w.y = pk_bf16(lo[2], lo[3]); w.z = pk_bf16(hi[0], hi[1]); w.w = pk_bf16(hi[2], hi[3]); return __builtin_bit_cast(bf16x8_t, w); }

template <bool GLA, bool OUT> DI void scan_walk(const Args& a, int l, int head, int dir, int sc, int dvh, LAS unsigned char* lds) {
    constexpr int NB = 1, DV = GLA ? 256 : 128;
    const int tid = otid(), lane = tid & 63, wave = tid >> 6, fr = lane & 15, fq = lane >> 4, nbase = dvh * 8 + wave;
    const bf16* Z = (const bf16*)(wsp(a) + WS_Z);
    const int stream = GLA ? 16 + head * 2 + dir : head * 2 + dir;
    float* kvs = (float*)(wsp(a) + WS_KVS) + (GLA ? KVS_GL_OFF + ((size_t)(stream - 16) * SC_N + sc) * 32768 : ((size_t)stream * SC_N + sc) * 16384);
    float* kd = (float*)(wsp(a) + WS_KD) + ((size_t)stream * SC_N + sc) * 128;
    LAS bf16* QM = (LAS bf16*)(lds + SL_QM); LAS bf16* KM = (LAS bf16*)(lds + SL_KM); LAS float* EB = (LAS float*)(lds + SL_EB); LAS bf16* XG = (LAS bf16*)(lds + SL_Q0);
    LAS bf16* KE = (LAS bf16*)(lds + SL_KE); LAS bf16* VT = (LAS bf16*)(lds + SL_VT); LAS bf16* PP = (LAS bf16*)(lds + SL_PP);
    LAS float* TOT = (LAS float*)(lds + SL_TOT); LAS float* DD = (LAS float*)(lds + SL_DD); LAS bf16* AFB = (LAS bf16*)(lds + SL_AFB);
    const int k = (wave & 1) * 64 + lane, seg = wave >> 1;
    float lbv = 0.f, bag = 0.f; bf16x8_t Bg = {0, 0, 0, 0, 0, 0, 0, 0};
    if (!GLA) lbv = ((const float*)(wsp(a) + WS_LB))[((size_t)l * 2 + dir) * 1024 + head * 128 + k];
    else {
        bag = ain(a, I_GLBA)[((size_t)l * 2 + dir) * 512 + head * 128 + wave * 16 + fr];
        if (fq < 2) { const float* wp = ain(a, I_GLWA2) + (((size_t)l * 2 + dir) * 16 + fq * 8) * 512 + head * 128 + wave * 16 + fr; float w8[8];
#pragma unroll
            for (int j = 0; j < 8; ++j) w8[j] = wp[(size_t)j * 512];
            u32x4 pw; pw.x = pk_bf16(w8[0], w8[1]); pw.y = pk_bf16(w8[2], w8[3]); pw.z = pk_bf16(w8[4], w8[5]); pw.w = pk_bf16(w8[6], w8[7]); Bg = __builtin_bit_cast(bf16x8_t, pw); } }
    f32x4 S[NB][8];
#pragma unroll
    for (int nb = 0; nb < NB; ++nb)
#pragma unroll
        for (int mb = 0; mb < 8; ++mb) { if (OUT) S[nb][mb] = *(const f32x4*)(kvs + (size_t)((nbase + nb) * 16 + fr) * 128 + mb * 16 + fq * 4); else S[nb][mb] = (f32x4){0.f, 0.f, 0.f, 0.f}; }
    float dlog = 0.f;
    const int which = (GLA ? 2 : 0) + dir;
    bf16* Odir = (bf16*)(wsp(a) + WS_OSC) + (size_t)which * MT * 1024;
    const int srow = tid >> 3, spc = (tid & 7) * 16;
    const int vcol = (GLA ? Z_GL + 1024 + head * 256 + dvh * 128 : Z_HG + 3072 + head * 128) + wave * 16;
    const int fcol = (GLA ? Z_GL + 512 + head * 128 : Z_HG + 1024 * (1 + dir) + head * 128) + spc, qcol = (GLA ? Z_GL + head * 128 : Z_HG + head * 128) + spc;
    u32x4 pv0, pv1, pf0, pf1, pq0 = {0u, 0u, 0u, 0u}, pq1 = {0u, 0u, 0u, 0u}, pa = {0u, 0u, 0u, 0u};
#define SCAN_ISSUE(cidx) do { const int r0n_ = dir ? stream_row((cidx) * 64 + 63, 1) : stream_row((cidx) * 64, 0); \
        const bf16* vr_ = Z + (size_t)(r0n_ + lane) * ZC + vcol; pv0 = *(const u32x4*)vr_; pv1 = *(const u32x4*)(vr_ + 8); \
        const bf16* zr_ = Z + (size_t)(r0n_ + srow) * ZC; pf0 = *(const u32x4*)(zr_ + fcol); pf1 = *(const u32x4*)(zr_ + fcol + 8); \
        if (OUT) { pq0 = *(const u32x4*)(zr_ + qcol); pq1 = *(const u32x4*)(zr_ + qcol + 8); } \
        if (GLA && tid < 128) pa = *(const u32x4*)(Z + (size_t)(r0n_ + (tid >> 1)) * ZC + Z_LR + dir * 16 + (tid & 1) * 8); } while (0)
    SCAN_ISSUE(sc * 4);
    for (int cc = 0; cc < 4; ++cc) {
        const int c = sc * 4 + cc; const int r0 = dir ? stream_row(c * 64 + 63, 1) : stream_row(c * 64, 0);
        {
#pragma unroll
          for (int q8 = 0; q8 < 2; ++q8) { const u32x4 v = q8 ? pv1 : pv0; const int d0 = wave * 16 + q8 * 8;
              VT[(d0 + 0) * 72 + lane] = (bf16)(v.x & 0xffff); VT[(d0 + 1) * 72 + lane] = (bf16)(v.x >> 16); VT[(d0 + 2) * 72 + lane] = (bf16)(v.y & 0xffff); VT[(d0 + 3) * 72 + lane] = (bf16)(v.y >> 16);
              VT[(d0 + 4) * 72 + lane] = (bf16)(v.z & 0xffff); VT[(d0 + 5) * 72 + lane] = (bf16)(v.z >> 16); VT[(d0 + 6) * 72 + lane] = (bf16)(v.w & 0xffff); VT[(d0 + 7) * 72 + lane] = (bf16)(v.w >> 16); }
          *(LAS u32x4*)(KM + srow * 136 + spc) = pf0; *(LAS u32x4*)(KM + srow * 136 + spc + 8) = pf1;
          if (OUT) { *(LAS u32x4*)(QM + srow * 136 + spc) = pq0; *(LAS u32x4*)(QM + srow * 136 + spc + 8) = pq1; }
          if (GLA && tid < 128) *(LAS u32x4*)(AFB + (tid >> 1) * 16 + (tid & 1) * 8) = pa;
          if (cc < 3) SCAN_ISSUE(c + 1); }
        LDS_BAR();
        if (GLA) {
#pragma unroll
            for (int tb = 0; tb < 4; ++tb) { bf16x8_t Ag = {0, 0, 0, 0, 0, 0, 0, 0}; if (fq < 2) Ag = lds_frag16(lds + SL_AFB + ((tb * 16 + fr) * 16 + fq * 8) * 2);
                f32x4 xg = {bag, bag, bag, bag}; xg = __builtin_amdgcn_mfma_f32_16x16x32_bf16(Ag, Bg, xg, 0, 0, 0);
#pragma unroll
                for (int j = 0; j < 4; ++j) XG[(tb * 16 + fq * 4 + j) * 136 + wave * 16 + fr] = f2bf(xg[j]); }
            LDS_BAR();
        }
        const int tstart = dir ? 63 - seg * 16 : seg * 16, tstep = dir ? -1 : 1;
        float cs[16], kkv[GLA ? 1 : 16]; float run = 0.f;
#ifdef REPMASK
        _Pragma("unroll 1") for (int rp1 = 0; rp1 < (((REPMASK) >> 24) & 1 ? 3 : 1); ++rp1) { run = 0.f;
#else
        {
#endif
#pragma unroll
        for (int i = 0; i < 16; ++i) { const int t = tstart + i * tstep; float la;
            if (!GLA) { const float zf = bf2f(KM[t * 136 + k]); const float sg = sigmoidf_(zf); la = __logf(lbv + (1.0f - lbv) * sg); kkv[i] = (1.0f - lbv) * (1.0f - sg); }
            else { const float x = bf2f(XG[t * 136 + k]); la = (fminf(x, 0.f) - __logf(1.0f + __expf(-fabsf(x)))) * 0.0625f; }
            run += la; cs[i] = run; if ((i & 3) == 3) asm volatile("" ::: "memory"); }
        }
        TOT[seg * 128 + k] = run;
        LDS_BAR();
        { const float t0 = TOT[k], t1 = TOT[128 + k], t2 = TOT[256 + k], t3 = TOT[384 + k];
          const float off = seg == 0 ? 0.f : (seg == 1 ? t0 : (seg == 2 ? t0 + t1 : t0 + t1 + t2)), blast = (t0 + t1) + (t2 + t3), bref = t0 + t1;
          float ke[16]; const float ebl = __expf(blast - bref);
#pragma unroll
          for (int i = 0; i < 16; ++i) { const int t = tstart + i * tstep; const float b = off + cs[i];
              float kk; if (GLA) kk = bf2f(KM[t * 136 + k]); else kk = kkv[i];
              const float e1 = __expf(b - bref), r1 = __builtin_amdgcn_rcpf(e1), kr = kk * r1;
              if (OUT) { const float qr = bf2f(QM[t * 136 + k]); const float qv = GLA ? qr * 0.08838834764831845f : siluf_(qr);
                  QM[t * 136 + k] = f2bf(qv * e1); KM[t * 136 + k] = f2bf(kr); }
              ke[i] = kr * ebl; if ((i & 3) == 3) asm volatile("" ::: "memory"); }
          if (OUT && seg == 0) EB[k] = __expf(bref);
          const int tb0 = dir ? 48 - seg * 16 : seg * 16; u32x4 w0, w1;
          if (dir) { w0.x = pk_bf16(ke[15], ke[14]); w0.y = pk_bf16(ke[13], ke[12]); w0.z = pk_bf16(ke[11], ke[10]); w0.w = pk_bf16(ke[9], ke[8]); w1.x = pk_bf16(ke[7], ke[6]); w1.y = pk_bf16(ke[5], ke[4]); w1.z = pk_bf16(ke[3], ke[2]); w1.w = pk_bf16(ke[1], ke[0]); }
          else     { w0.x = pk_bf16(ke[0], ke[1]); w0.y = pk_bf16(ke[2], ke[3]); w0.z = pk_bf16(ke[4], ke[5]); w0.w = pk_bf16(ke[6], ke[7]); w1.x = pk_bf16(ke[8], ke[9]); w1.y = pk_bf16(ke[10], ke[11]); w1.z = pk_bf16(ke[12], ke[13]); w1.w = pk_bf16(ke[14], ke[15]); }
          *(LAS u32x4*)(KE + k * 72 + tb0) = w0; *(LAS u32x4*)(KE + k * 72 + tb0 + 8) = w1;
          if (seg == 0) DD[k] = __expf(blast);
          dlog += blast; }
        LDS_BAR();
        bf16x8_t Bv[NB][2];
#pragma unroll
        for (int nb = 0; nb < NB; ++nb)
#pragma unroll
            for (int ks = 0; ks < 2; ++ks) Bv[nb][ks] = lds_frag16(lds + SL_VT + ((wave * 16 + fr) * 72 + ks * 32 + fq * 8) * 2);
        if (OUT) {
#ifdef REPMASK
          _Pragma("unroll 1") for (int rp2 = 0; rp2 < (((REPMASK) >> 25) & 1 ? 3 : 1); ++rp2) { if (rp2) LDS_BAR();
#else
          {
#endif
            { const int tb = wave >> 1;
#pragma unroll
              for (int sbi = 0; sbi < 2; ++sbi) { const int sb = (wave & 1) * 2 + sbi; f32x4 acc = {0.f, 0.f, 0.f, 0.f};
#pragma unroll
                  for (int ks = 0; ks < 4; ++ks) acc = __builtin_amdgcn_mfma_f32_16x16x32_bf16(lds_frag16(lds + SL_QM + ((tb * 16 + fr) * 136 + ks * 32 + fq * 8) * 2), lds_frag16(lds + SL_KM + ((sb * 16 + fr) * 136 + ks * 32 + fq * 8) * 2), acc, 0, 0, 0);
#pragma unroll
                  for (int j = 0; j < 4; ++j) { const int t = tb * 16 + fq * 4 + j, s = sb * 16 + fr; const bool keep = dir ? (s >= t) : (s <= t); PP[t * 72 + s] = keep ? f2bf(acc[j]) : (bf16)0; } } }
            LDS_BAR();
#pragma unroll
            for (int nb = 0; nb < NB; ++nb) {
                bf16x8_t Bs[4];
#pragma unroll
                for (int ks = 0; ks < 4; ++ks) { const f32x4 e0 = *(LAS f32x4*)(EB + (2 * ks) * 16 + fq * 4), e1 = *(LAS f32x4*)(EB + (2 * ks + 1) * 16 + fq * 4); Bs[ks] = pack_bf16x8(S[nb][2 * ks] * e0, S[nb][2 * ks + 1] * e1); }
#pragma unroll
                for (int mb = 0; mb < 4; ++mb) {
                    f32x4 O = {0.f, 0.f, 0.f, 0.f};
#pragma unroll
                    for (int ks = 0; ks < 2; ++ks) O = __builtin_amdgcn_mfma_f32_16x16x32_bf16(lds_frag16(lds + SL_PP + ((mb * 16 + fr) * 72 + ks * 32 + fq * 8) * 2), Bv[nb][ks], O, 0, 0, 0);
#pragma unroll
                    for (int ks = 0; ks < 4; ++ks) { u32x4 aw; const u32x2 lo = *(LAS u32x2*)(lds + SL_QM + ((mb * 16 + fr) * 136 + (2 * ks) * 16 + fq * 4) * 2), hi = *(LAS u32x2*)(lds + SL_QM + ((mb * 16 + fr) * 136 + (2 * ks + 1) * 16 + fq * 4) * 2);
                        aw.x = lo.x; aw.y = lo.y; aw.z = hi.x; aw.w = hi.y;
                        O = __builtin_amdgcn_mfma_f32_16x16x32_bf16(__builtin_bit_cast(bf16x8_t, aw), Bs[ks], O, 0, 0, 0); }
#pragma unroll
                    for (int j = 0; j < 4; ++j) Odir[(size_t)(r0 + mb * 16 + fq * 4 + j) * 1024 + head * DV + (nbase + nb) * 16 + fr] = f2bf(O[j]);
                    asm volatile("" ::: "memory");
                }
            }
          }
        }
        if (!OUT || cc < 3) {
#pragma unroll
            for (int mb = 0; mb < 8; ++mb) { const f32x4 dd = *(LAS f32x4*)(DD + mb * 16 + fq * 4);
                const bf16x8_t A0 = lds_frag16(lds + SL_KE + ((mb * 16 + fr) * 72 + fq * 8) * 2), A1 = lds_frag16(lds + SL_KE + ((mb * 16 + fr) * 72 + 32 + fq * 8) * 2);
#pragma unroll
                for (int nb = 0; nb < NB; ++nb) { S[nb][mb] = S[nb][mb] * dd; S[nb][mb] = __builtin_amdgcn_mfma_f32_16x16x32_bf16(A0, Bv[nb][0], S[nb][mb], 0, 0, 0); S[nb][mb] = __builtin_amdgcn_mfma_f32_16x16x32_bf16(A1, Bv[nb][1], S[nb][mb], 0, 0, 0); }
                asm volatile("" ::: "memory"); }
        }
        LDS_BAR();
    }
    if (!OUT) {
#pragma unroll
        for (int nb = 0; nb < NB; ++nb)
#pragma unroll
            for (int mb = 0; mb < 8; ++mb) *(f32x4*)(kvs + (size_t)((nbase + nb) * 16 + fr) * 128 + mb * 16 + fq * 4) = S[nb][mb];
        if (seg == 0) kd[k] = __expf(dlog);
    }
}
#undef SCAN_ISSUE
DI void scan_prop(const Args& a) {
    float* kvs = (float*)(wsp(a) + WS_KVS); const float* kd = (const float*)(wsp(a) + WS_KD);
    for (int g = obid() * NTHR + otid(); g < 131072; g += ogdim() * NTHR) {
        float* p; size_t stride; const float* dp;
        if (g < 65536) { const int stream = g >> 12, e = g & 4095; p = kvs + (size_t)stream * SC_N * 16384 + (size_t)e * 4; stride = 16384; dp = kd + (size_t)stream * SC_N * 128 + (e & 31) * 4; }
        else { const int q = g - 65536, stream = q >> 13, e = q & 8191; p = kvs + KVS_GL_OFF + (size_t)stream * SC_N * 32768 + (size_t)e * 4; stride = 32768; dp = kd + (size_t)(16 + stream) * SC_N * 128 + (e & 31) * 4; }
        f32x4 S = {0.f, 0.f, 0.f, 0.f};
#pragma unroll 5
        for (int sc = 0; sc < SC_N; ++sc) { const f32x4 kv = *(const f32x4*)(p + sc * stride), d = *(const f32x4*)(dp + sc * 128); *(f32x4*)(p + sc * stride) = S; S = d * S + kv; }
    }
}
constexpr int SCAN_ITEMS = 32 * SC_N;
template <bool OUT> DI void scan_item2(const Args& a, int l, int it, LAS unsigned char* lds) {
    if (it < 16 * SC_N) { const int s = it / SC_N, sc = it % SC_N; if (OUT && l == DEPTH - 1 && sc == 0) return; scan_walk<true, OUT>(a, l, s >> 2, (s >> 1) & 1, sc, s & 1, lds); }
    else { const int j = it - 16 * SC_N, s = j / SC_N, sc = j % SC_N; if (OUT && l == DEPTH - 1 && sc == 0) return; scan_walk<false, OUT>(a, l, s >> 1, s & 1, sc, 0, lds); }
}
DI void hyconv_item(const Args& a, int l, int c, LAS unsigned char* ldsb) {
    const int tid = otid();
    LAS float* lds = (LAS float*)ldsb;
    LAS float* xs = (LAS float*)(ldsb + LDS_X);
    const float* tw = (const float*)(wsp(a) + WS_TW); const float* tw2 = (const float*)(wsp(a) + WS_TW2);
    const float* h2 = (const float*)(wsp(a) + WS_H2) + (size_t)l * MT * 64;
    const bf16* VX = (const bf16*)(wsp(a) + WS_U) + (size_t)c * MT; bf16* VO = (bf16*)(wsp(a) + WS_CVO) + (size_t)c * MT;
#ifdef REPMASK
    _Pragma("unroll 1") for (int rpa = 0; rpa < (((REPMASK) >> 21) & 1 ? 2 : 1); ++rpa) { if (rpa) __syncthreads();
#else
    {
#endif
    const bf16* HFf = (const bf16*)(wsp(a) + WS_HF) + (size_t)c * SEQ; const bf16* HFb = HFf + (size_t)1024 * SEQ;
    const float a0 = -4.605170186f / 1.5f, a1 = -4.605170186f / 0.3f;
    const float nd = -fabsf(a0 + (float)c * ((a1 - a0) / 1023.0f)) * (1.0f / (float)(SEQ - 1));
    const float b3f = ain(a, I_HYB3)[l * 2048 + c], b3b = ain(a, I_HYB3)[l * 2048 + 1024 + c];
    float sf = 0.f, sb = 0.f;
#pragma unroll
    for (int i = 0; i < 8; ++i) { const int t4 = (tid + 512 * i) * 4; const u32x2 rf = *(const u32x2*)(HFf + t4), rb = *(const u32x2*)(HFb + t4);
        f32x4 hf, hb; hf[0] = bflo(rf.x); hf[1] = bfhi(rf.x); hf[2] = bflo(rf.y); hf[3] = bfhi(rf.y); hb[0] = bflo(rb.x); hb[1] = bfhi(rb.x); hb[2] = bflo(rb.y); hb[3] = bfhi(rb.y);
#pragma unroll
        for (int q = 0; q < 4; ++q) { const float dec = __expf(nd * (float)(t4 + q)) + 0.05f; hf[q] = (hf[q] + b3f) * dec; hb[q] = (hb[q] + b3b) * dec; }
        sf += (fabsf(hf[0]) + fabsf(hf[1])) + (fabsf(hf[2]) + fabsf(hf[3])); sb += (fabsf(hb[0]) + fabsf(hb[1])) + (fabsf(hb[2]) + fabsf(hb[3]));
        *(LAS f32x4*)(lds + t4) = hf;
#pragma unroll
        for (int q = 0; q < 4; ++q) { const int t = t4 + q; if (t > 0) lds[32768 - t] = hb[q]; else xs[160] = hb[q]; } }
    sf = wave_sum(sf); sb = wave_sum(sb);
    if ((tid & 63) == 0) { xs[128 + (tid >> 6)] = sf; xs[136 + (tid >> 6)] = sb; }
    __syncthreads();
    float tf = 0.f, tb = 0.f;
#pragma unroll
    for (int w = 0; w < 8; ++w) { tf += xs[128 + w]; tb += xs[136 + w]; }
    const float inf_ = 1.0f / tf, inb_ = 1.0f / tb;
#pragma unroll 8
    for (int i = 0; i < 64; ++i) { const int m = tid + 512 * i; float v = lds[m];
        if (m == 0) v = v * inf_ + xs[160] * inb_ + ain(a, I_HYSKIP)[l * 1024 + c];
        else if (m < SEQ) v *= inf_; else if (m == SEQ) v = 0.f; else v *= inb_;
        lds[m] = v; }
    __syncthreads();
    }
    { FftTw T; fft_load_tw(T, tw, tid);
    fft_fwd_pass<4096>(lds, T, tw, tid); LDS_BAR(); fft_fwd_pass<1024>(lds, T, tw, tid); LDS_BAR(); fft_fwd_pass<256>(lds, T, tw, tid); LDS_BAR(); fft_fwd_pass<64>(lds, T, tw, tid); LDS_BAR();
    fft_fwd_pass<16>(lds, T, tw, tid); LDS_BAR(); fft_fwd_pass<4>(lds, T, tw, tid); LDS_BAR(); fft_fwd_pass<1>(lds, T, tw, tid); LDS_BAR(); }
#ifdef REPMASK
    if (((REPMASK) >> 22) & 1) { FftTw T; fft_load_tw(T, tw, tid);
        fft_inv_pass<1>(lds, T, tw, tid); LDS_BAR(); fft_inv_pass<4>(lds, T, tw, tid); LDS_BAR(); fft_inv_pass<16>(lds, T, tw, tid); LDS_BAR(); fft_inv_pass<64>(lds, T, tw, tid); LDS_BAR();
        fft_inv_pass<256>(lds, T, tw, tid); LDS_BAR(); fft_inv_pass<1024>(lds, T, tw, tid); LDS_BAR(); fft_inv_pass<4096>(lds, T, tw, tid); LDS_BAR();
        for (int i = 0; i < 64; ++i) lds[tid + 512 * i] *= (1.0f / FFT_M);
        LDS_BAR();
        fft_fwd_pass<4096>(lds, T, tw, tid); LDS_BAR(); fft_fwd_pass<1024>(lds, T, tw, tid); LDS_BAR(); fft_fwd_pass<256>(lds, T, tw, tid); LDS_BAR(); fft_fwd_pass<64>(lds, T, tw, tid); LDS_BAR();
        fft_fwd_pass<16>(lds, T, tw, tid); LDS_BAR(); fft_fwd_pass<4>(lds, T, tw, tid); LDS_BAR(); fft_fwd_pass<1>(lds, T, tw, tid); LDS_BAR(); }
#endif

    float* Gs = (float*)(wsp(a) + WS_YMIX) + (size_t)obid() * 32768;
    const int kbase = ((tid & 63) << 7) | ((tid >> 6) << 4);
#ifdef REPMASK
    _Pragma("unroll 1") for (int rpc = 0; rpc < (((REPMASK) >> 23) & 1 ? 2 : 1); ++rpc)
#endif
#pragma unroll 4
    for (int j = 0; j < 16; ++j) { const int k = kbase | j; cpx gk, gm; rfft_untangle(lds, tw2, k, gk, gm); f32x4 g4; g4[0] = gk.x; g4[1] = gk.y; g4[2] = gm.x; g4[3] = gm.y; *(f32x4*)(Gs + (size_t)(j * 512 + tid) * 4) = g4; }
    __syncthreads();
#pragma unroll
    for (int i = 0; i < 16; ++i) { const int m4 = tid + 512 * i; f32x4 v = {0.f, 0.f, 0.f, 0.f}; if (m4 < SEQ / 4) { const u32x2 r = *(const u32x2*)(VX + m4 * 4); v[0] = bflo(r.x); v[1] = bfhi(r.x); v[2] = bflo(r.y); v[3] = bfhi(r.y); } *(LAS f32x4*)(lds + m4 * 4) = v; }
    __syncthreads();
    { FftTw T; fft_load_tw(T, tw, tid);
    fft_fwd_pass<4096>(lds, T, tw, tid); LDS_BAR(); fft_fwd_pass<1024>(lds, T, tw, tid); LDS_BAR(); fft_fwd_pass<256>(lds, T, tw, tid); LDS_BAR(); fft_fwd_pass<64>(lds, T, tw, tid); LDS_BAR();
    fft_fwd_pass<16>(lds, T, tw, tid); LDS_BAR(); fft_fwd_pass<4>(lds, T, tw, tid); LDS_BAR(); fft_fwd_pass<1>(lds, T, tw, tid); LDS_BAR(); }
#pragma unroll 4
    for (int j = 0; j < 16; ++j) { const int k = kbase | j; const f32x4 g4 = *(const f32x4*)(Gs + (size_t)(j * 512 + tid) * 4); cpx gk, gm; gk.x = g4[0]; gk.y = g4[1]; gm.x = g4[2]; gm.y = g4[3]; rfft_mul_retangle(lds, tw2, k, gk, gm); }
    __syncthreads();
    { FftTw T; fft_load_tw(T, tw, tid);
    fft_inv_pass<1>(lds, T, tw, tid); LDS_BAR(); fft_inv_pass<4>(lds, T, tw, tid); LDS_BAR(); fft_inv_pass<16>(lds, T, tw, tid); LDS_BAR(); fft_inv_pass<64>(lds, T, tw, tid); LDS_BAR();
    fft_inv_pass<256>(lds, T, tw, tid); LDS_BAR(); fft_inv_pass<1024>(lds, T, tw, tid); LDS_BAR(); fft_inv_pass<4096>(lds, T, tw, tid); LDS_BAR(); }
#pragma unroll
    for (int i = 0; i < 8; ++i) { const int m4 = tid + 512 * i; const f32x4 v = *(const LAS f32x4*)(lds + m4 * 4) * (1.0f / FFT_M); u32x2 o; o.x = pk_bf16(v[0], v[1]); o.y = pk_bf16(v[2], v[3]); *(u32x2*)(VO + m4 * 4) = o; }
    __syncthreads();
}
DI void hycctx_item(const Args& a, int l, int it, LAS unsigned char* ldsb) {
    const int tid = otid(), c0 = it * 16;
    LAS float* sv = (LAS float*)ldsb;
    LAS float* sf = sv + 16 * 256;
    LAS float* sb = sf + 16 * 256;
    const float* hyc = (const float*)(wsp(a) + WS_HYC); const bf16* VXT = (const bf16*)(wsp(a) + WS_U); bf16* CVO = (bf16*)(wsp(a) + WS_CVO);
    for (int i = tid; i < 16 * 256; i += NTHR) { const int ch = i >> 8, t = i & 255; sv[i] = bf2f(VXT[(size_t)(c0 + ch) * MT + SEQ + t]); sf[i] = hyc[(size_t)(c0 + ch) * 256 + t]; sb[i] = hyc[(size_t)(1024 + c0 + ch) * 256 + t]; }
    __syncthreads();
    const int ch = tid >> 5, tq = tid & 31; const float g0 = sf[ch * 256] + sb[ch * 256] + ain(a, I_HYSKIP)[l * 1024 + c0 + ch];
    float acc[8];
#pragma unroll
    for (int i = 0; i < 8; ++i) acc[i] = 0.f;
    for (int s = 0; s < 256; ++s) { const float vv = sv[ch * 256 + s];
#pragma unroll
        for (int i = 0; i < 8; ++i) { const int d = tq * 8 + i - s; const float g = d > 0 ? sf[ch * 256 + d] : (d < 0 ? sb[ch * 256 - d] : g0); acc[i] += g * vv; } }
    __syncthreads();
#pragma unroll
    for (int i = 0; i < 8; ++i) CVO[(size_t)(c0 + ch) * MT + SEQ + tq * 8 + i] = f2bf(acc[i]);
    __syncthreads();
}

struct EpiHF {
    static constexpr bool PERM = true, AFTER_DRAIN = false; bf16* O;
    DI void operator()(const f32x4 (&acc)[2][2][4][2], const pg8::Unit& u, int wr, int wc, int fr, int fq) const {
        const int row0 = u.pm * 256 + wr * 64 + fr, col0 = u.pn * 256 + wc * 32 + 8 * fq;
#pragma unroll
        for (int ai = 0; ai < 2; ++ai)
#pragma unroll
            for (int m = 0; m < 4; ++m) { bf16* rowp = O + (size_t)(row0 + ai * 128 + m * 16) * SEQ + col0;
#pragma unroll
                for (int bj = 0; bj < 2; ++bj) { const f32x4 v0 = acc[ai][bj][m][0], v1 = acc[ai][bj][m][1];
                    u32x4 w; w.x = pk_bf16(v0[0], v0[1]); w.y = pk_bf16(v0[2], v0[3]); w.z = pk_bf16(v1[0], v1[1]); w.w = pk_bf16(v1[2], v1[3]);
                    *(u32x4*)(rowp + bj * 128) = w; } }
    }
};
struct EpiZ {
    static constexpr bool PERM = true, AFTER_DRAIN = false; bf16* O; const float* bias;
    DI void operator()(const f32x4 (&acc)[2][2][4][2], const pg8::Unit& u, int wr, int wc, int fr, int fq) const {
        const int row0 = u.pm * 256 + wr * 64 + fr, col0 = u.pn * 256 + wc * 32 + 8 * fq;
        f32x4 bv[2][2];
#pragma unroll
        for (int bj = 0; bj < 2; ++bj)
#pragma unroll
            for (int n = 0; n < 2; ++n) bv[bj][n] = *(const f32x4*)(bias + col0 + bj * 128 + 4 * n);
#pragma unroll
        for (int ai = 0; ai < 2; ++ai)
#pragma unroll
            for (int m = 0; m < 4; ++m) { bf16* rowp = O + (size_t)(row0 + ai * 128 + m * 16) * ZC + col0;
#pragma unroll
                for (int bj = 0; bj < 2; ++bj) { const f32x4 v0 = acc[ai][bj][m][0] + bv[bj][0], v1 = acc[ai][bj][m][1] + bv[bj][1];
                    u32x4 w; w.x = pk_bf16(v0[0], v0[1]); w.y = pk_bf16(v0[2], v0[3]); w.z = pk_bf16(v1[0], v1[1]); w.w = pk_bf16(v1[2], v1[3]);
                    *(u32x4*)(rowp + bj * 128) = w; } }
    }
};
template <int BR> struct EpiBr {
    static constexpr bool PERM = true, AFTER_DRAIN = false; bf16* Mg; const bf16* Zg;
    DI void operator()(const f32x4 (&acc)[2][2][4][2], const pg8::Unit& u, int wr, int wc, int fr, int fq) const {
        const int row0 = u.pm * 256 + wr * 64 + fr, col0 = u.pn * 256 + wc * 32 + 8 * fq;
#pragma unroll
        for (int ai = 0; ai < 2; ++ai)
#pragma unroll
            for (int m = 0; m < 4; ++m) { const size_t row = (size_t)(row0 + ai * 128 + m * 16);
#pragma unroll
                for (int bj = 0; bj < 2; ++bj) { const int col = col0 + bj * 128;
                    const u32x4 g = *(const u32x4*)(Zg + row * ZC + col);
                    f32x4 v0 = acc[ai][bj][m][0], v1 = acc[ai][bj][m][1];
                    v0[0] *= sigmoidf_(bflo(g.x)); v0[1] *= sigmoidf_(bfhi(g.x)); v0[2] *= sigmoidf_(bflo(g.y)); v0[3] *= sigmoidf_(bfhi(g.y));
                    v1[0] *= sigmoidf_(bflo(g.z)); v1[1] *= sigmoidf_(bfhi(g.z)); v1[2] *= sigmoidf_(bflo(g.w)); v1[3] *= sigmoidf_(bfhi(g.w));
                    if (BR > 0) { const u32x4 p = *(const u32x4*)(Mg + row * D + col);
                        v0[0] += bflo(p.x); v0[1] += bfhi(p.x); v0[2] += bflo(p.y); v0[3] += bfhi(p.y); v1[0] += bflo(p.z); v1[1] += bfhi(p.z); v1[2] += bflo(p.w); v1[3] += bfhi(p.w); }
                    u32x4 w; w.x = pk_bf16(v0[0], v0[1]); w.y = pk_bf16(v0[2], v0[3]); w.z = pk_bf16(v1[0], v1[1]); w.w = pk_bf16(v1[2], v1[3]);
                    *(u32x4*)(Mg + row * D + col) = w; } }
    }
};
struct EpiOut {
    static constexpr bool PERM = false, AFTER_DRAIN = false; const float* hin_main; const float* hin_ctx; float* hout; const float* gt1;
    DI void operator()(const f32x4 (&acc)[2][2][4][2], const pg8::Unit& u, int wr, int wc, int fr, int fq) const {
        const int row0 = u.pm * 256 + wr * 64 + fr, col0 = u.pn * 256 + wc * 32 + 4 * fq; const bool isctx = u.pm >= SEQ / 256;
        const float* g = gt1 + (isctx ? 12288 : 0);
        f32x4 gv[2][2];
#pragma unroll
        for (int bj = 0; bj < 2; ++bj)
#pragma unroll
            for (int n = 0; n < 2; ++n) gv[bj][n] = *(const f32x4*)(g + col0 + bj * 128 + n * 16);
#pragma unroll
        for (int ai = 0; ai < 2; ++ai)
#pragma unroll
            for (int m = 0; m < 4; ++m) { const int row = row0 + ai * 128 + m * 16;
                const float* ip = (isctx ? hin_ctx + (size_t)(row - SEQ) * D : hin_main + (size_t)row * D) + col0; float* op = hout + (size_t)row * D + col0;
#pragma unroll
                for (int bj = 0; bj < 2; ++bj)
#pragma unroll
                    for (int n = 0; n < 2; ++n) { const f32x4 b = *(const f32x4*)(ip + bj * 128 + n * 16); *(f32x4*)(op + bj * 128 + n * 16) = b + gv[bj][n] * acc[ai][bj][m][n]; } }
    }
};
struct EpiGU {
    static constexpr bool PERM = true, AFTER_DRAIN = false; bf16* Hm;
    DI void operator()(const f32x4 (&acc)[2][2][4][2], const pg8::Unit& u, int wr, int wc, int fr, int fq) const {
        const int row0 = u.pm * 256 + wr * 64 + fr, col0 = (u.pn & 3) * 128 + wc * 32 + 8 * fq;
#pragma unroll
        for (int ai = 0; ai < 2; ++ai)
#pragma unroll
            for (int m = 0; m < 4; ++m) { const f32x4 g0 = acc[ai][0][m][0], g1 = acc[ai][0][m][1], u0 = acc[ai][1][m][0], u1 = acc[ai][1][m][1];
                u32x4 w; w.x = pk_bf16(siluf_(g0[0]) * u0[0], siluf_(g0[1]) * u0[1]); w.y = pk_bf16(siluf_(g0[2]) * u0[2], siluf_(g0[3]) * u0[3]);
                w.z = pk_bf16(siluf_(g1[0]) * u1[0], siluf_(g1[1]) * u1[1]); w.w = pk_bf16(siluf_(g1[2]) * u1[2], siluf_(g1[3]) * u1[3]);
                *(u32x4*)(Hm + (size_t)(row0 + ai * 128 + m * 16) * DFF + col0) = w; }
    }
};
struct EpiDn {
    static constexpr bool PERM = true, AFTER_DRAIN = false; bf16* Y; const float* roww;
    DI void operator()(const f32x4 (&acc)[2][2][4][2], const pg8::Unit& u, int wr, int wc, int fr, int fq) const {
        const int row0 = u.pm * 256 + wr * 64 + fr, col0 = (u.pn & 7) * 256 + wc * 32 + 8 * fq;
#pragma unroll
        for (int ai = 0; ai < 2; ++ai)
#pragma unroll
            for (int m = 0; m < 4; ++m) { const int row = row0 + ai * 128 + m * 16; const float rw = roww[row];
#pragma unroll
                for (int bj = 0; bj < 2; ++bj) { const f32x4 v0 = acc[ai][bj][m][0] * rw, v1 = acc[ai][bj][m][1] * rw;
                    u32x4 w; w.x = pk_bf16(v0[0], v0[1]); w.y = pk_bf16(v0[2], v0[3]); w.z = pk_bf16(v1[0], v1[1]); w.w = pk_bf16(v1[2], v1[3]);
                    *(u32x4*)(Y + (size_t)row * D + col0 + bj * 128) = w; } }
    }
};
struct MoeOrder {
    const int* tile_e; int ntiles, nsub, G, c;
    DI bool next(int i, pg8::Unit& u) const { const int j = i * G + c; if (j >= ntiles * nsub) return false; const int ti = j / nsub; u.pm = ti; u.pn = tile_e[ti] * nsub + (j - ti * nsub); return true; }
    DI void a_ready(const pg8::Unit&) const {}
    DI void done(const pg8::Unit&) const {}
};
constexpr int NPH_LAYER = 13, PH_FINAL = 1 + NPH_LAYER * DEPTH, NPHASES = PH_FINAL + 1;
struct KArgs { Args a; int li, pad; };
__global__ void __launch_bounds__(NTHR, 2) fwd_kernel(KArgs ka) {
    const Args& a = ka.a;
    const int tid = otid();
#define bid ((int)obid())
#define G ((int)ogdim())
    if (tid == 0) { ((LAS unsigned*)(ldsbase() + LDS_BARW))[0] = 0u; ((LAS unsigned*)(ldsbase() + LDS_BARW))[1] = 0u;
        LAS unsigned long long* ptab = (LAS unsigned long long*)(ldsbase() + LDS_PTAB);
#pragma unroll
        for (int i = 0; i < N_IN; ++i) ptab[i] = (unsigned long long)ka.a.in[i]; }
    __syncthreads();
#ifdef PROBE_SEL
    if (tid < 64) ((LAS unsigned long long*)(ldsbase() + LDS_TIM))[tid] = 0ull;
    __syncthreads();
    const unsigned long long tkern_ = __builtin_amdgcn_s_memrealtime();
#endif
    XcdBarrier bar = xcd_barrier_post((unsigned*)(wsp(a) + WS_CTL) + CW_BAR + ka.li * XCD_BAR_WORDS, (volatile LAS unsigned*)(ldsbase() + LDS_BARW));
    const int lo = a.ph_lo, hi = a.ph_hi;
#ifndef PHMASK
#define PHMASK 0xFFFF
#endif
#define EN(i) (((PHMASK) >> (i)) & 1)
#ifndef REPMASK
#define REPMASK 0
#endif
#define REP(i) (((REPMASK) >> (i)) & 1)
#define RUN(i, cond, ...) do { _Pragma("unroll 1") for (int rep_ = 0; rep_ < ((REP(i) && (cond)) ? REPN : 1); ++rep_) { if (rep_) __syncthreads(); __VA_ARGS__; } } while (0)
#ifndef REPN
#define REPN 2
#endif
#define IN(k) (opq(lo) <= (k) && (k) < opq(hi))
#define SEAM(k) do { if (IN(k) && IN((k) + 1)) { TIC(); xcd_barrier(bar); TOC(30); } } while (0)
#define ws wsp(a)
#define lds ldsbase()
#define ldsf ((LAS float*)ldsbase())
#define U ((bf16*)(wsp(a) + WS_U))
#define Z ((bf16*)(wsp(a) + WS_Z))
#define H ((float*)(wsp(a) + WS_H))
#define modall ((const float*)(wsp(a) + WS_MOD))

    { TIC();
    if (EN(0) && IN(0)) {
        RUN(0, true, prologue_small(a);
        for (int it = bid; it < 256; it += G) mod_item(a, it, ldsf);
        for (int it = bid; it < DEPTH * (MT / 8); it += G) h2_item(a, it, ldsf));
    }
    TOC(31); } SEAM(0);
    for (int l = 0; l < DEPTH; ++l) {
        const int pb = 1 + NPH_LAYER * l;
        const int nrows = (l == 0) ? MT : SEQ;
        { TIC();
        if (EN(1) && IN(pb + 0)) {
            RUN(1, l == 0, norm_phase<0>(a, l, MT, ldsf));
            RUN(16, true, if (l == 0) hyc_filters(a, 0));
            RUN(2, true, for (int it = bid; it < CVT_MIX_TILES; it += G) cvt_mix_item(a, l, it, ldsf));
        }
        TOC(1); } SEAM(pb + 0); { TIC();
        if (EN(2) && IN(pb + 1)) {
            pg8::Gemm g{U, (const bf16*)(ws + WS_WIN), MT, ZC, D}; pg8::StaticOrder S; S.init(MT, ZC, G, bid);
            EpiZ E{Z, (const float*)(ws + WS_ZBIAS) + (size_t)l * ZC};
            RUN(3, true, pg8::gemm_phase<EpiZ, pg8::StaticOrder, true, true>(lds, g, S, E));
        }
        TOC(2); } SEAM(pb + 1); { TIC();
        if (EN(3) && IN(pb + 2)) { const int nit = (nrows / 64) * 16; RUN(4, true, for (int it = bid; it < nit; it += G) hyprep_item(a, l, it, ldsf));
            __syncthreads();
            pg8::Gemm g{(const bf16*)(ws + WS_W3T) + (size_t)l * 2048 * 256, (const bf16*)(ws + WS_H2B) + (size_t)l * SEQ * 256, 2048, SEQ, opq(256)  }; pg8::StaticOrder S; S.init(2048, SEQ, G, bid);
            EpiHF E{(bf16*)(ws + WS_HF)};
            RUN(18, true, pg8::gemm_phase<EpiHF, pg8::StaticOrder, true, true>(lds, g, S, E)); }
        TOC(3); } SEAM(pb + 2); { TIC();
        if (EN(4) && IN(pb + 3)) {
            RUN(5, true, for (int it = bid; it < SCAN_ITEMS; it += G) scan_item2<false>(a, l, it, lds));
            RUN(6, true, for (int c = bid; c < 1024; c += G) hyconv_item(a, l, c, lds));
            RUN(15, true, if (l == 0) for (int it = bid; it < 64; it += G) hycctx_item(a, l, it, lds));
        }
        TOC(4); } SEAM(pb + 3); { TIC();
        if (EN(13) && IN(pb + 4)) { scan_prop(a); if (REP(20)) { __syncthreads(); scan_prop(a); scan_prop(a); } }
        TOC(5); } SEAM(pb + 4); { TIC();
        if (EN(14) && IN(pb + 5)) { RUN(17, true, for (int it = bid; it < SCAN_ITEMS; it += G) scan_item2<true>(a, l, it, lds)); }
        TOC(6); } SEAM(pb + 5); { TIC();
        if (EN(5) && IN(pb + 6)) {
            const int nit = (nrows / 64) * 16;
            RUN(7, true, scancomb_rows(a, l, nrows); for (int it = bid; it < nit; it += G) hycomb_item(a, l, it, ldsf));
        }
        TOC(7); } SEAM(pb + 6); { TIC();
        if (EN(6) && IN(pb + 7)) {
            const bf16* Y = (const bf16*)(ws + WS_YMIX); const bf16* WB = (const bf16*)(ws + WS_WBR);
            pg8::StaticOrder S; S.init(nrows, D, G, bid);
            RUN(8, true,
            { pg8::Gemm g{Y, WB, nrows, D, 1024}; EpiBr<0> E{U, Z + Z_MG}; pg8::gemm_phase<EpiBr<0>, pg8::StaticOrder, true, true>(lds, g, S, E); }
            __syncthreads();
            { pg8::Gemm g{Y + (size_t)MT * 1024, WB + (size_t)D * 1024, nrows, D, 1024}; EpiBr<1> E{U, Z + Z_MG + D}; pg8::gemm_phase<EpiBr<1>, pg8::StaticOrder, true, true>(lds, g, S, E); }
            __syncthreads();
            { pg8::Gemm g{Y + (size_t)2 * MT * 1024, WB + (size_t)2 * D * 1024, nrows, D, 1024}; EpiBr<2> E{U, Z + Z_MG + 2 * D}; pg8::gemm_phase<EpiBr<2>, pg8::StaticOrder, true, true>(lds, g, S, E); });
        }
        TOC(8); } SEAM(pb + 7); { TIC();
        if (EN(7) && IN(pb + 8)) {
            pg8::Gemm g{U, (const bf16*)(ws + WS_WOUT), nrows, D, D}; pg8::StaticOrder S; S.init(nrows, D, G, bid);
            EpiOut E{l == 0 ? ain(a, I_X) : H, l == 0 ? ain(a, I_CTX) : H + (size_t)SEQ * D, H, modall + (size_t)l * 2 * 12288 + 4096};
            RUN(9, l == 0, pg8::gemm_phase<EpiOut, pg8::StaticOrder, true, true>(lds, g, S, E));
        }
        TOC(9); } SEAM(pb + 8); { TIC();
        if (EN(8) && IN(pb + 9)) {
            route_phase<false>(a, l, nrows, ldsf);
            __syncthreads();
            if (REP(19)) { route_phase<true>(a, l, nrows, ldsf); __syncthreads(); }
            RUN(10, true, for (int it = bid; it < CVT_MOE_TILES; it += G) cvt_moe_item(a, l, it, ldsf));
        }
        TOC(10); } SEAM(pb + 9); { TIC();
        if (EN(9) && IN(pb + 10)) { RUN(11, true, permute_phase(a, l, nrows, lds)); }
        TOC(11); } SEAM(pb + 10); { TIC();
        if (EN(10) && IN(pb + 11)) {
            const int* tile_e = (const int*)(ws + WS_TILEE); const int ntiles = tile_e[200];
            pg8::Gemm g{(const bf16*)(ws + WS_XP), (const bf16*)(ws + WS_WGU), MOE_MAXROWS, NEXP * 1024, D}; MoeOrder S{tile_e, ntiles, 4, G, bid};
            EpiGU E{(bf16*)(ws + WS_HMID)};
            RUN(12, true, pg8::gemm_phase<EpiGU, MoeOrder, true, true>(lds, g, S, E));
        }
        TOC(12); } SEAM(pb + 11); { TIC();
        if (EN(11) && IN(pb + 12)) {
            const int* tile_e = (const int*)(ws + WS_TILEE); const int ntiles = tile_e[200];
            pg8::Gemm g{(const bf16*)(ws + WS_HMID), (const bf16*)(ws + WS_WD), MOE_MAXROWS, NEXP * D, DFF}; MoeOrder S{tile_e, ntiles, 8, G, bid};
            EpiDn E{(bf16*)(ws + WS_YP), (const float*)(ws + WS_ROWW)};
            RUN(13, true, pg8::gemm_phase<EpiDn, MoeOrder, true, true>(lds, g, S, E));
        }
        TOC(13); } SEAM(pb + 12); { TIC();
        (void)0; }
    }
#ifdef PROBE_SEL
    if (tid == 0) ((LAS unsigned long long*)(ldsbase() + LDS_TIM))[0] = __builtin_amdgcn_s_memrealtime() - tkern_;
    __syncthreads();
#endif
    if (EN(12) && IN(PH_FINAL)) norm_phase<2>(a, DEPTH, SEQ, ldsf);
#undef IN
#undef SEAM
#undef ws
#undef bid
#undef G
#undef lds
#undef ldsf
#undef U
#undef Z
#undef H
#undef modall
}

#ifndef MK_SINGLE
#define MK_SINGLE 1
#endif
extern "C" void kernel_launch(void* const* d_in, const int* in_sizes, int n_in, void* d_out, int out_size, void* d_ws, size_t ws_size, hipStream_t stream) {
    static int grid = 0;
    if (grid == 0) {
        if (n_in != N_IN || out_size != SEQ * D || ws_size < WS_END) { fprintf(stderr, "kernel_launch: unexpected problem shape (n_in %d, out %d, ws %zu < %zu)\n", n_in, out_size, ws_size, (size_t)WS_END); grid = -1; return; }
        int dev = 0, cus = 0;
        if (hipGetDevice(&dev) != hipSuccess || hipDeviceGetAttribute(&cus, hipDeviceAttributeMultiprocessorCount, dev) != hipSuccess) { grid = -1; return; }
        if (hipFuncSetAttribute((const void*)fwd_kernel, hipFuncAttributeMaxDynamicSharedMemorySize, LDS_BYTES) != hipSuccess) { fprintf(stderr, "kernel_launch: hipFuncSetAttribute failed\n"); grid = -1; return; }
        int per_cu = 0;
        if (hipOccupancyMaxActiveBlocksPerMultiprocessor(&per_cu, (const void*)fwd_kernel, NTHR, LDS_BYTES) != hipSuccess || per_cu < 1) fprintf(stderr, "kernel_launch: occupancy query says %d\n", per_cu);
        (void)hipGetLastError();
        grid = cus;
    }
    if (grid < 0) return;
    (void)hipMemsetAsync((char*)d_ws + WS_CTL, 0, CTL_BYTES, stream);
    KArgs ka{};
    for (int i = 0; i < N_IN; ++i) ka.a.in[i] = (const float*)d_in[i];
    ka.a.out = (float*)d_out; ka.a.ws = (unsigned char*)d_ws;
#if MK_SINGLE
    ka.a.ph_lo = 0; ka.a.ph_hi = NPHASES; ka.li = 0; ka.pad = 0;
    hipLaunchKernelGGL(fwd_kernel, dim3(grid), dim3(NTHR), LDS_BYTES, stream, ka);
#else
    for (int ph = 0; ph < NPHASES; ++ph) { ka.a.ph_lo = ph; ka.a.ph_hi = ph + 1; ka.li = 0; ka.pad = 0; hipLaunchKernelGGL(fwd_kernel, dim3(grid), dim3(NTHR), LDS_BYTES, stream, ka); }
#endif
}
```

```cpp
#include <hip/hip_runtime.h>
#include <cstdio>
#include <cstdint>
#define DI __device__ __forceinline__
#define LAS __attribute__((address_space(3)))
typedef unsigned short bf16;
typedef float f32x4 __attribute__((ext_vector_type(4)));
typedef unsigned u32x4 __attribute__((ext_vector_type(4)));
typedef unsigned u32x2 __attribute__((ext_vector_type(2)));

constexpr int D = 2048, SEQ = 16384, CTXL = 256, MT = SEQ + CTXL  , DEPTH = 2;
constexpr int NCOLS_IN = 17440;
constexpr int ZC = 17664;
constexpr int Z_HG = 0, Z_GL = 5120, Z_HY = 8192, Z_MG = 11264, Z_LR = 17408;
constexpr int NEXP = 32, DFF = 512, MOE_MAXROWS = 41472;
constexpr float NORM_EPS = 1e-6f;

constexpr size_t MiB = 1u << 20;
constexpr size_t WS_CTL = 0, CTL_BYTES = 1 * MiB;
constexpr size_t WS_SMALL = 1 * MiB;
constexpr size_t WS_MOD   = WS_SMALL;
constexpr size_t WS_ZBIAS = WS_MOD + (size_t)DEPTH * 2 * 12288 * 4;
constexpr size_t WS_LB    = WS_ZBIAS + (size_t)DEPTH * ZC * 4;
constexpr size_t WS_TW    = WS_LB + (size_t)DEPTH * 2 * 1024 * 4;
constexpr size_t WS_TW2   = WS_TW + 16384 * 8;
constexpr size_t WS_H2    = WS_TW2 + (8192 + 64) * 8;
constexpr size_t WS_ROUTE = WS_H2 + (size_t)DEPTH * MT * 64 * 4;
constexpr size_t WS_ROWW  = WS_ROUTE + (size_t)MT * 8 * 4;
constexpr size_t WS_TILEE = WS_ROWW + (size_t)MOE_MAXROWS * 4;
constexpr size_t WS_HYC   = WS_TILEE + 1024;
constexpr size_t WS_W3T   = WS_HYC + (size_t)2048 * 256 * 4;
constexpr size_t WS_H2B   = WS_W3T + (size_t)DEPTH * 2048 * 256 * 2;
constexpr size_t WS_WRT   = WS_H2B + (size_t)DEPTH * SEQ * 256 * 2;
constexpr size_t WS_SMALL_END = WS_WRT + (size_t)DEPTH * 2 * 48 * 2048 * 2;
static_assert(WS_SMALL_END <= 40 * MiB, "small tables");
constexpr size_t WS_WIN  = 40 * MiB;
constexpr size_t WS_WBR  = 109 * MiB;
constexpr size_t WS_WOUT = 121 * MiB;
constexpr size_t WS_WGU  = 129 * MiB;
constexpr size_t WS_CVO  = WS_WIN;
constexpr size_t WS_WD   = 257 * MiB;
constexpr size_t WS_H    = 321 * MiB;
constexpr size_t WS_U    = 451 * MiB;
constexpr size_t WS_Z    = 516 * MiB;
constexpr size_t WS_XP   = WS_Z;
constexpr size_t WS_HMID = WS_Z + 162 * MiB;
constexpr size_t WS_YP   = WS_Z + 203 * MiB;
constexpr size_t WS_YMIX = 1077 * MiB;
constexpr size_t WS_HF   = 1175 * MiB;
constexpr size_t WS_OSC  = 1175 * MiB;
constexpr size_t WS_END  = 1435 * MiB;
static_assert(WS_WIN + (size_t)ZC * D * 2 <= WS_WBR && WS_Z + (size_t)MT * ZC * 2 <= WS_YMIX && WS_YMIX + (size_t)3 * MT * 1024 * 2 <= WS_OSC && WS_OSC + (size_t)4 * MT * 1024 * 4 <= WS_END, "ws map");
static_assert(WS_YP + (size_t)MOE_MAXROWS * D * 2 <= WS_YMIX && WS_H + (size_t)MT * D * 4 <= WS_U && WS_U + (size_t)MT * D * 2 <= WS_Z, "ws map 2");
constexpr int CW_BAR = 4096;
constexpr int CW_CNT = 16384;

DI float bf2f(bf16 v) { return __uint_as_float(((unsigned)v) << 16); }
DI float bflo(unsigned w) { return __uint_as_float(w << 16); }
DI float bfhi(unsigned w) { return __uint_as_float(w & 0xffff0000u); }
typedef float f32x2_t __attribute__((ext_vector_type(2))); typedef __bf16 bf16x2_t __attribute__((ext_vector_type(2)));
DI unsigned pk_bf16(float lo, float hi) { f32x2_t v = {lo, hi}; bf16x2_t b = __builtin_convertvector(v, bf16x2_t); return __builtin_bit_cast(unsigned, b); }
DI bf16 f2bf(float f) { return (bf16)(pk_bf16(f, 0.f) & 0xffffu); }
DI float sigmoidf_(float x) { return __builtin_amdgcn_rcpf(1.0f + __expf(-x)); }
DI float siluf_(float x) { return x * __builtin_amdgcn_rcpf(1.0f + __expf(-x)); }
DI float wave_sum(float v) {
#pragma unroll
    for (int o = 32; o >= 1; o >>= 1) v += __shfl_xor(v, o);
    return v;
}
DI int otid() { int t = __builtin_amdgcn_workitem_id_x(); asm volatile("" : "+v"(t)); return t; }
DI int ogdim() { int g = __builtin_amdgcn_workgroup_id_x(); g = (int)gridDim.x; asm volatile("" : "+s"(g)); return g; }
DI int obid() { int b = __builtin_amdgcn_workgroup_id_x(); asm volatile("" : "+s"(b)); return b; }
#define AIN_DECL 1
DI LAS f32x2_t* fft_vec2_(LAS float* p) { return (LAS f32x2_t*)p; }
DI const f32x2_t* fft_vec2_(const float* p) { return (const f32x2_t*)p; }
DI f32x2_t* fft_vec2_(float* p) { return (f32x2_t*)p; }
namespace pg8 {
#define PG8_LAS __attribute__((address_space(3)))
typedef unsigned short bf16_t;
typedef short bf16x8 __attribute__((ext_vector_type(8)));
typedef float f32x4 __attribute__((ext_vector_type(4)));
typedef unsigned u32x4 __attribute__((ext_vector_type(4)));
constexpr int BM = 256, BK = 64, HALF = 128, HTB = HALF * BK * 2  , STAGE_BYTES = 8 * HTB, NXCD = 8, WGM = 8;

__host__ __device__ __forceinline__ int lds_byte(int r, int c) { const int st = (r >> 4) * 2 + (c >> 5), rr = r & 15, cc = c & 31, ob = rr * 64 + cc * 2; return st * 1024 + (ob ^ (((ob >> 9) & 1) << 5)); }
__host__ __device__ __forceinline__ void stage_rc(int b, int& R, int& C) { const int st = b / 1024, sb = b % 1024, swz = sb ^ (((sb >> 9) & 1) << 5); R = (st >> 1) * 16 + swz / 64; C = (st & 1) * 32 + (swz % 64) / 2; }
__host__ __device__ __forceinline__ int perm32(int rho) { const int n = rho >> 4, i = rho & 15; return 8 * (i >> 2) + 4 * n + (i & 3); }

struct Unit { int pm, pn; };
struct Gemm { const bf16_t* A; const bf16_t* Bt; int M, N, K; };

struct StaticOrder {
    int nM, nN, nwg, G, c;
    __host__ __device__ void init(int M, int N, int G_, int c_) { nM = M / BM; nN = N / BM; nwg = nM * nN; G = G_; c = c_; }
    __host__ __device__ bool next(int i, Unit& u) const {
        const long L = (long)i * G + c; if (L >= nwg) return false;
        int wgid = (int)L; { const int q = nwg / NXCD, r = nwg % NXCD, xcd = wgid % NXCD, off = wgid / NXCD; wgid = (xcd < r ? xcd * (q + 1) : r * (q + 1) + (xcd - r) * q) + off; }
        const int nig = WGM * nN, gid = wgid / nig, fm = gid * WGM, gsz = (nM - fm) < WGM ? (nM - fm) : WGM;
        u.pm = fm + ((wgid % nig) % gsz); u.pn = (wgid % nig) / gsz; return true;
    }
    __device__ __forceinline__ void a_ready(const Unit&) const {}
    __device__ __forceinline__ void done(const Unit&) const {}
};

template <class Epi, class Sched, bool ALIGN_EPI = false, bool SP2 = false>
__device__ __forceinline__ void gemm_phase(PG8_LAS unsigned char* lds, const Gemm g, const Sched& S, const Epi& E) {
    const int tid = otid(), wid = __builtin_amdgcn_readfirstlane(tid >> 6), lane = tid & 63, wr = wid >> 2, wc = wid & 3, fr = lane & 15, fq = lane >> 4;
    const int K = g.K, nt = K / BK;
    unsigned voffA[2], voffB[2];
#pragma unroll
    for (int i = 0; i < 2; ++i) { int R, C; stage_rc(tid * 16 + i * 8192, R, C); const int Rb = Epi::PERM ? ((R & ~31) + perm32(R & 31)) : R;
        voffA[i] = (unsigned)(R * K + C) * 2u; voffB[i] = (unsigned)(Rb * K + C) * 2u; }
    const size_t kstep = (size_t)(BK * 2);
    const size_t hstep = (size_t)HALF * K * 2;
    const size_t tstep = 2 * hstep;
    const unsigned ldsw = (unsigned)wid * 1024u;
    const int aoff = lds_byte(wr * 64 + fr, fq * 8), boff = lds_byte(wc * 32 + fr, fq * 8);
#define PG8_SA(b, h) (((b) * 2 + (h)) * HTB)
#define PG8_SB(b, h) ((4 + (b) * 2 + (h)) * HTB)
#define PG8_STAGE(bufoff, gbase, voff) do { _Pragma("unroll") for (int _i = 0; _i < 2; ++_i) \
        __builtin_amdgcn_global_load_lds((const unsigned*)((const char*)(gbase) + (voff)[_i]), (PG8_LAS unsigned*)(lds + (bufoff) + ldsw + _i * 8192), 16, 0, 0); } while (0)
#define PG8_LDA(dst, b, h) do { _Pragma("unroll") for (int m = 0; m < 4; ++m) _Pragma("unroll") for (int k = 0; k < 2; ++k) dst[m][k] = *(const PG8_LAS bf16x8*)(lds + PG8_SA(b, h) + aoff + m * 2048 + k * 1024); } while (0)
#define PG8_LDB(dst, b, h) do { _Pragma("unroll") for (int n = 0; n < 2; ++n) _Pragma("unroll") for (int k = 0; k < 2; ++k) dst[n][k] = *(const PG8_LAS bf16x8*)(lds + PG8_SB(b, h) + boff + n * 2048 + k * 1024); } while (0)
#define PG8_MMA(ai, bj, At, Bt) do { __builtin_amdgcn_s_setprio(1); _Pragma("unroll") for (int m = 0; m < 4; ++m) _Pragma("unroll") for (int n = 0; n < 2; ++n) _Pragma("unroll") for (int k = 0; k < 2; ++k) \
        acc[ai][bj][m][n] = __builtin_amdgcn_mfma_f32_16x16x32_bf16(Bt[n][k], At[m][k], acc[ai][bj][m][n], 0, 0, 0); __builtin_amdgcn_s_setprio(0); } while (0)
#define PG8_WAIT_V(n) asm volatile("s_waitcnt vmcnt(" #n ")" ::: "memory")
#define PG8_WAIT_L(n) asm volatile("s_waitcnt lgkmcnt(" #n ")" ::: "memory")
#define PG8_BAR __builtin_amdgcn_s_barrier()
#define PG8_SCHED __builtin_amdgcn_sched_barrier(0)
    Unit cur, nxt; int ui = 0;
    if (!S.next(0, cur)) return;
    f32x4 acc[2][2][4][2];
#pragma unroll
    for (int a = 0; a < 2; ++a)
#pragma unroll
        for (int b = 0; b < 2; ++b)
#pragma unroll
            for (int m = 0; m < 4; ++m)
#pragma unroll
                for (int n = 0; n < 2; ++n) acc[a][b][m][n] = (f32x4){0.f, 0.f, 0.f, 0.f};
    bf16x8 At[4][2], B0[2][2], B1[2][2];
    const char* cA = (const char*)g.A + (size_t)cur.pm * tstep; const char* cB = (const char*)g.Bt + (size_t)cur.pn * tstep;
    S.a_ready(cur);
    if constexpr (SP2) {
        PG8_STAGE(PG8_SB(0, 0), cB, voffB); PG8_STAGE(PG8_SB(0, 1), cB + hstep, voffB); PG8_STAGE(PG8_SA(0, 0), cA, voffA); PG8_STAGE(PG8_SA(0, 1), cA + hstep, voffA);
        if (wr == 1) PG8_BAR;
        PG8_WAIT_V(2); PG8_BAR;
        PG8_STAGE(PG8_SB(1, 0), cB + kstep, voffB); PG8_STAGE(PG8_SA(1, 0), cA + kstep, voffA); PG8_STAGE(PG8_SB(1, 1), cB + hstep + kstep, voffB);
        PG8_WAIT_V(6); PG8_BAR;
    } else {
        PG8_STAGE(PG8_SB(0, 0), cB, voffB); PG8_STAGE(PG8_SA(0, 0), cA, voffA); PG8_STAGE(PG8_SB(0, 1), cB + hstep, voffB); PG8_STAGE(PG8_SA(0, 1), cA + hstep, voffA);
        if (wr == 1) PG8_BAR;
        PG8_WAIT_V(4); PG8_BAR;
        PG8_STAGE(PG8_SB(1, 0), cB + kstep, voffB); PG8_STAGE(PG8_SA(1, 0), cA + kstep, voffA); PG8_STAGE(PG8_SB(1, 1), cB + hstep + kstep, voffB);
        PG8_WAIT_V(6); PG8_BAR;
    }
    for (;;) {
        const bool has_next = S.next(ui + 1, nxt);
        const char* nA = has_next ? (const char*)g.A + (size_t)nxt.pm * tstep : cA; const char* nB = has_next ? (const char*)g.Bt + (size_t)nxt.pn * tstep : cB;
        for (int t = 0; t < nt; t += 2) {
            const bool last = (t == nt - 2);
            const char* a1 = cA + (size_t)(t + 1) * kstep;
            const char* a2 = last ? nA : cA + (size_t)(t + 2) * kstep; const char* b2 = last ? nB : cB + (size_t)(t + 2) * kstep;
            const char* a3 = a2 + kstep; const char* b3 = b2 + kstep;
            if (last && has_next) S.a_ready(nxt);
            if constexpr (SP2) {
            PG8_LDB(B0, 0, 0); PG8_LDB(B1, 0, 1); PG8_SCHED; PG8_LDA(At, 0, 0); PG8_STAGE(PG8_SA(1, 1), a1 + hstep, voffA);
            PG8_WAIT_V(8); PG8_WAIT_L(0); PG8_BAR; PG8_MMA(0, 0, At, B0); PG8_MMA(0, 1, At, B1); PG8_BAR; PG8_SCHED;
            PG8_LDA(At, 0, 1); PG8_STAGE(PG8_SB(0, 0), b2, voffB); PG8_STAGE(PG8_SB(0, 1), b2 + hstep, voffB); PG8_STAGE(PG8_SA(0, 0), a2, voffA);
            PG8_WAIT_V(8); PG8_WAIT_L(0); PG8_BAR; PG8_MMA(1, 0, At, B0); PG8_MMA(1, 1, At, B1); PG8_BAR; PG8_SCHED;
            PG8_LDB(B0, 1, 0); PG8_LDB(B1, 1, 1); PG8_SCHED; PG8_LDA(At, 1, 0); PG8_STAGE(PG8_SA(0, 1), a2 + hstep, voffA);
            PG8_WAIT_V(8); PG8_WAIT_L(0); PG8_BAR; PG8_MMA(0, 0, At, B0); PG8_MMA(0, 1, At, B1); PG8_BAR; PG8_SCHED;
            PG8_LDA(At, 1, 1); PG8_STAGE(PG8_SB(1, 0), b3, voffB); PG8_STAGE(PG8_SB(1, 1), b3 + hstep, voffB); PG8_STAGE(PG8_SA(1, 0), a3, voffA);
            PG8_WAIT_V(8); PG8_WAIT_L(0); PG8_BAR; PG8_MMA(1, 0, At, B0); PG8_MMA(1, 1, At, B1); PG8_BAR; PG8_SCHED;
            } else {
            PG8_LDB(B0, 0, 0); PG8_SCHED; PG8_LDA(At, 0, 0); PG8_STAGE(PG8_SA(1, 1), a1 + hstep, voffA);
            PG8_WAIT_L(8); PG8_BAR; PG8_WAIT_L(0); PG8_MMA(0, 0, At, B0); PG8_BAR; PG8_SCHED;
            PG8_LDB(B1, 0, 1); PG8_STAGE(PG8_SB(0, 0), b2, voffB);
            PG8_BAR; PG8_WAIT_L(0); PG8_MMA(0, 1, At, B1); PG8_BAR;
            PG8_LDA(At, 0, 1); PG8_STAGE(PG8_SA(0, 0), a2, voffA);
            PG8_BAR; PG8_WAIT_L(0); PG8_MMA(1, 0, At, B0); PG8_BAR; PG8_SCHED;
            PG8_STAGE(PG8_SB(0, 1), b2 + hstep, voffB);
            PG8_WAIT_V(6); PG8_BAR; PG8_MMA(1, 1, At, B1); PG8_BAR;
            PG8_LDB(B0, 1, 0); PG8_SCHED; PG8_LDA(At, 1, 0); PG8_STAGE(PG8_SA(0, 1), a2 + hstep, voffA);
            PG8_WAIT_L(8); PG8_BAR; PG8_WAIT_L(0); PG8_MMA(0, 0, At, B0); PG8_BAR; PG8_SCHED;
            PG8_LDB(B1, 1, 1); PG8_STAGE(PG8_SB(1, 0), b3, voffB);
            PG8_BAR; PG8_WAIT_L(0); PG8_MMA(0, 1, At, B1); PG8_BAR;
            PG8_LDA(At, 1, 1); PG8_STAGE(PG8_SA(1, 0), a3, voffA);
            PG8_BAR; PG8_WAIT_L(0); PG8_MMA(1, 0, At, B0); PG8_BAR; PG8_SCHED;
            PG8_STAGE(PG8_SB(1, 1), b3 + hstep, voffB);
            PG8_WAIT_V(6); PG8_BAR; PG8_MMA(1, 1, At, B1); PG8_BAR;
            }
        }
        if constexpr (ALIGN_EPI) { if (wr == 0) PG8_BAR; }
        if constexpr (!Epi::AFTER_DRAIN) { E(acc, cur, wr, wc, fr, fq); S.done(cur); }
        if (!has_next) break;
#pragma unroll
        for (int a = 0; a < 2; ++a)
#pragma unroll
            for (int b = 0; b < 2; ++b)
#pragma unroll
                for (int m = 0; m < 4; ++m)
#pragma unroll
                    for (int n = 0; n < 2; ++n) acc[a][b][m][n] = (f32x4){0.f, 0.f, 0.f, 0.f};
        cur = nxt; cA = nA; cB = nB; ++ui;
        if constexpr (ALIGN_EPI) { if (wr == 1) PG8_BAR; }
    }
    PG8_WAIT_V(0);
    if constexpr (!ALIGN_EPI) { if (wr == 0) PG8_BAR; }
    PG8_BAR;
    if constexpr (Epi::AFTER_DRAIN) { E.fused(acc, cur, wr, wc, fr, fq, lds, wid, lane); S.done(cur); }
#undef PG8_SA
#undef PG8_SB
#undef PG8_STAGE
#undef PG8_LDA
#undef PG8_LDB
#undef PG8_MMA
#undef PG8_WAIT_V
#undef PG8_WAIT_L
#undef PG8_BAR
#undef PG8_SCHED
}
}
#define XB_TMO      128
#define XB_XCNT(j)  (256  + 64 * (j))
#define XB_XSUB(j)  (1280 + 64 * (j))
#define XB_XGEN(j)  (2304 + 64 * (j))
#define XB_TOP      3328
#define XB_TOPGEN   3392
#define XCD_BAR_WORDS 3456
#define XB_SPIN_CAP (1u << 18)

__device__ __forceinline__ unsigned xb_ld(unsigned* p)              { return __hip_atomic_load(p, __ATOMIC_RELAXED, __HIP_MEMORY_SCOPE_AGENT); }
__device__ __forceinline__ unsigned xb_add(unsigned* p, unsigned v) { return __hip_atomic_fetch_add(p, v, __ATOMIC_RELAXED, __HIP_MEMORY_SCOPE_AGENT); }
__device__ __forceinline__ unsigned xb_xcc_id() { return (unsigned)__builtin_amdgcn_s_getreg((3 << 11) | 20) & 0xFu; }
#define XB_SPIN(cond, bar) do { unsigned _sp = 0; while (cond) { __builtin_amdgcn_s_sleep(1); \
    if ((++_sp & 255u) == 0u) { if (xb_ld(&(bar)[XB_TMO])) break; if (_sp > XB_SPIN_CAP) { atomicAdd(&(bar)[XB_TMO], 1u); break; } } } } while (0)

struct XcdBarrier {
    unsigned* bar; unsigned x;
    volatile LAS unsigned* st;
};

__device__ __forceinline__ XcdBarrier xcd_barrier_post(unsigned* bar, volatile LAS unsigned* st) {
    XcdBarrier b; b.bar = bar; b.x = xb_xcc_id(); b.st = st;
    if (otid() == 0) (void)xb_add(&bar[XB_XCNT(b.x)], 1u);
    return b;
}
__device__ __forceinline__ void xcd_barrier_complete(unsigned* bar, unsigned x, unsigned& nloc, unsigned& nx) {
    asm volatile("" : "+s"(x));
    const unsigned G = ogdim();
    unsigned sum, cnt, mine, sp = 0u;
    for (;;) {
        sum = 0u; cnt = 0u; mine = 0u;
#pragma unroll
        for (unsigned j = 0; j < 16; ++j) { const unsigned c = xb_ld(&bar[XB_XCNT(j)]); sum += c; cnt += (c > 0u) ? 1u : 0u; mine = (j == x) ? c : mine; }
        if (sum == G) break;
        __builtin_amdgcn_s_sleep(1);
        if ((++sp & 255u) == 0u) { if (xb_ld(&bar[XB_TMO])) break; if (sp > XB_SPIN_CAP) { atomicAdd(&bar[XB_TMO], 1u); break; } }
    }
    nloc = mine > 0u ? mine : 1u; nx = cnt > 0u ? cnt : 1u;
}

__device__ __forceinline__ void xcd_barrier(const XcdBarrier& b) {
    asm volatile("s_waitcnt vmcnt(0)" ::: "memory");
    __syncthreads();
    if (otid() == 0) {
        unsigned* bar = b.bar;
        __builtin_amdgcn_s_waitcnt(0);
        unsigned nloc = b.st[0], nx = b.st[1];
        if (nloc == 0u) { xcd_barrier_complete(bar, b.x, nloc, nx); b.st[0] = nloc; b.st[1] = nx; }
        const unsigned old = xb_add(&bar[XB_XSUB(b.x)], 1u);
        const unsigned gen = old / nloc;
        if (old + 1u == (gen + 1u) * nloc) {
            __builtin_amdgcn_fence(__ATOMIC_RELEASE, "agent");
            asm volatile("s_waitcnt vmcnt(0)" ::: "memory");
            const unsigned og = xb_add(&bar[XB_TOP], 1u);
            const unsigned tg = og / nx;
            if (og + 1u == (tg + 1u) * nx) xb_add(&bar[XB_TOPGEN], 1u);
            else XB_SPIN(xb_ld(&bar[XB_TOPGEN]) == tg, bar);
            __builtin_amdgcn_fence(__ATOMIC_ACQUIRE, "agent");
            xb_add(&bar[XB_XGEN(b.x)], 1u);
            asm volatile("s_waitcnt vmcnt(0)" ::: "memory");
        } else {
            XB_SPIN(xb_ld(&bar[XB_XGEN(b.x)]) == gen, bar);
            __builtin_amdgcn_fence(__ATOMIC_ACQUIRE, "agent");
            asm volatile("s_waitcnt vmcnt(0)" ::: "memory");
        }
    }
    __syncthreads();
}

#define FFT_DI DI
struct cpx; template <class P> DI cpx fft_ldc_(P p, int i); template <class P> DI void fft_stc_(P p, int i, const cpx& v);
#define FFT_LDC(p, i) fft_ldc_((p), (i))
#define FFT_STC(p, i, v) fft_stc_((p), (i), (v))
#define FFT_M 16384
#define FFT_NT 512
struct cpx { float x, y; };
#ifdef FFT_LDC
template <class P> FFT_DI cpx fft_ldc_(P p, int i) { const f32x2_t v = *(const decltype(fft_vec2_(p)))(p + 2 * i); cpx r; r.x = v[0]; r.y = v[1]; return r; }
template <class P> FFT_DI void fft_stc_(P p, int i, const cpx& v) { f32x2_t w = {v.x, v.y}; *(decltype(fft_vec2_(p)))(p + 2 * i) = w; }
#endif
#ifndef FFT_LDC
#define FFT_LDC(p, i) ([&]{ cpx r_; r_.x = (p)[2 * (i)]; r_.y = (p)[2 * (i) + 1]; return r_; }())
#define FFT_STC(p, i, v) do { (p)[2 * (i)] = (v).x; (p)[2 * (i) + 1] = (v).y; } while (0)
#endif
FFT_DI cpx cmul(cpx a, cpx b) { cpx r; r.x = a.x * b.x - a.y * b.y; r.y = a.x * b.y + a.y * b.x; return r; }
FFT_DI cpx cmulc(cpx a, cpx b) { cpx r; r.x = a.x * b.x + a.y * b.y; r.y = a.y * b.x - a.x * b.y; return r; }
FFT_DI int rev4_14(int k) {
    int r = 0;
#pragma unroll
    for (int d = 0; d < 7; ++d) { r = (r << 2) | (k & 3); k >>= 2; }
    return r;
}
struct FftTw { cpx c256[3], c64[3], c16[3], c4[3]; };
template <class TP> FFT_DI void fft_load_tw(FftTw& T, TP tw, int tid) {
#pragma unroll
    for (int q = 0; q < 3; ++q) { T.c256[q] = FFT_LDC(tw, (q + 1) * (tid & 255) * 16); T.c64[q] = FFT_LDC(tw, (q + 1) * (tid & 63) * 64); T.c16[q] = FFT_LDC(tw, (q + 1) * (tid & 15) * 256); T.c4[q] = FFT_LDC(tw, (q + 1) * (tid & 3) * 1024); }
}
template <int s, class TP> FFT_DI void fft_pick_tw(const FftTw& T, TP tw, int pos, int j, cpx& w1, cpx& w2, cpx& w3) {
    if (s == 4096) { w1 = FFT_LDC(tw, pos); w2 = FFT_LDC(tw, 2 * pos); w3 = FFT_LDC(tw, 3 * pos); }
    else if (s == 1024) { w1 = FFT_LDC(tw, 4 * pos); w2 = FFT_LDC(tw, 8 * pos); w3 = FFT_LDC(tw, 12 * pos); }
    else if (s == 256) { w1 = T.c256[0]; w2 = T.c256[1]; w3 = T.c256[2]; }
    else if (s == 64) { w1 = T.c64[0]; w2 = T.c64[1]; w3 = T.c64[2]; }
    else if (s == 16) { w1 = T.c16[0]; w2 = T.c16[1]; w3 = T.c16[2]; }
    else if (s == 4) { w1 = T.c4[0]; w2 = T.c4[1]; w3 = T.c4[2]; }
}
template <int s, class LP, class TP> FFT_DI void fft_fwd_pass(LP lds, const FftTw& T, TP tw, int tid) {
    cpx w1, w2, w3;
#pragma unroll 2
    for (int jj = 0; jj < FFT_M / 4 / FFT_NT; ++jj) { const int b = tid + FFT_NT * jj;
        const int pos = b & (s - 1), base = ((b & ~(s - 1)) << 2) + pos;
        const cpx a0 = FFT_LDC(lds, base), a1 = FFT_LDC(lds, base + s), a2 = FFT_LDC(lds, base + 2 * s), a3 = FFT_LDC(lds, base + 3 * s);
        cpx t0, t1, t2, t3;
        t0.x = a0.x + a2.x; t0.y = a0.y + a2.y;
        t1.x = a0.x - a2.x; t1.y = a0.y - a2.y;
        t2.x = a1.x + a3.x; t2.y = a1.y + a3.y;
        t3.x = a1.x - a3.x; t3.y = a1.y - a3.y;
        cpx y0, y1, y2, y3;
        y0.x = t0.x + t2.x; y0.y = t0.y + t2.y;
        y2.x = t0.x - t2.x; y2.y = t0.y - t2.y;
        y1.x = t1.x + t3.y; y1.y = t1.y - t3.x;
        y3.x = t1.x - t3.y; y3.y = t1.y + t3.x;
        if (s > 1) {
            fft_pick_tw<s>(T, tw, pos, jj, w1, w2, w3);
            y1 = cmul(y1, w1); y2 = cmul(y2, w2); y3 = cmul(y3, w3);
        }
        FFT_STC(lds, base, y0); FFT_STC(lds, base + s, y1); FFT_STC(lds, base + 2 * s, y2); FFT_STC(lds, base + 3 * s, y3);
    }
}
template <int s, class LP, class TP> FFT_DI void fft_inv_pass(LP lds, const FftTw& T, TP tw, int tid) {
    cpx w1, w2, w3;
#pragma unroll 2
    for (int jj = 0; jj < FFT_M / 4 / FFT_NT; ++jj) { const int b = tid + FFT_NT * jj;
        const int pos = b & (s - 1), base = ((b & ~(s - 1)) << 2) + pos;
        const cpx b0 = FFT_LDC(lds, base); cpx c1 = FFT_LDC(lds, base + s), c2 = FFT_LDC(lds, base + 2 * s), c3 = FFT_LDC(lds, base + 3 * s);
        if (s > 1) {
            fft_pick_tw<s>(T, tw, pos, jj, w1, w2, w3);
            c1 = cmulc(c1, w1); c2 = cmulc(c2, w2); c3 = cmulc(c3, w3);
        }
        cpx t0, t1, t2, t3;
        t0.x = b0.x + c2.x; t0.y = b0.y + c2.y;
        t1.x = b0.x - c2.x; t1.y = b0.y - c2.y;
        t2.x = c1.x + c3.x; t2.y = c1.y + c3.y;
        t3.x = c1.x - c3.x; t3.y = c1.y - c3.y;
        cpx x0, x1, x2, x3;
        x0.x = t0.x + t2.x; x0.y = t0.y + t2.y;
        x2.x = t0.x - t2.x; x2.y = t0.y - t2.y;
        x1.x = t1.x - t3.y; x1.y = t1.y + t3.x;
        x3.x = t1.x + t3.y; x3.y = t1.y - t3.x;
        FFT_STC(lds, base, x0); FFT_STC(lds, base + s, x1); FFT_STC(lds, base + 2 * s, x2); FFT_STC(lds, base + 3 * s, x3);
    }
}
template <class LP, class TP> FFT_DI void rfft_untangle(LP lds, TP tw2, int k, cpx& Xk, cpx& Xm) {
    if (k == 0) {
        const float zr = lds[0], zi = lds[1];
        Xk.x = zr + zi; Xk.y = zr - zi;
        const int p = rev4_14(FFT_M / 2);
        Xm.x = lds[2 * p]; Xm.y = -lds[2 * p + 1];
        return;
    }
    const int pk = rev4_14(k), pm = rev4_14(FFT_M - k);
    cpx Zk, Zm; Zk.x = lds[2 * pk]; Zk.y = lds[2 * pk + 1]; Zm.x = lds[2 * pm]; Zm.y = lds[2 * pm + 1];
    cpx E, O, W, WO;
    E.x = 0.5f * (Zk.x + Zm.x); E.y = 0.5f * (Zk.y - Zm.y);
    O.x = 0.5f * (Zk.y + Zm.y); O.y = -0.5f * (Zk.x - Zm.x);
    W.x = tw2[2 * k]; W.y = tw2[2 * k + 1];
    WO = cmul(W, O);
    Xk.x = E.x + WO.x; Xk.y = E.y + WO.y;
    Xm.x = E.x - WO.x; Xm.y = -(E.y - WO.y);
}
template <class LP, class TP> FFT_DI void rfft_mul_retangle(LP lds, TP tw2, int k, cpx Gk, cpx Gm) {
    cpx Xk, Xm; rfft_untangle(lds, tw2, k, Xk, Xm);
    if (k == 0) {
        const float y0 = Xk.x * Gk.x, yM = Xk.y * Gk.y;
        lds[0] = 0.5f * (y0 + yM); lds[1] = 0.5f * (y0 - yM);
        const cpx Y = cmul(Xm, Gm);
        const int p = rev4_14(FFT_M / 2);
        lds[2 * p] = Y.x; lds[2 * p + 1] = -Y.y;
        return;
    }
    const cpx Yk = cmul(Xk, Gk), Ym = cmul(Xm, Gm);
    cpx W; W.x = tw2[2 * k]; W.y = tw2[2 * k + 1];
    cpx A, D, T;
    A.x = 0.5f * (Yk.x + Ym.x); A.y = 0.5f * (Yk.y - Ym.y);
    D.x = 0.5f * (Yk.x - Ym.x); D.y = 0.5f * (Yk.y + Ym.y);
    T = cmulc(D, W);
    const int pk = rev4_14(k), pm = rev4_14(FFT_M - k);
    lds[2 * pk] = A.x - T.y; lds[2 * pk + 1] = A.y + T.x;
    cpx Dc; Dc.x = -D.x; Dc.y = D.y;
    const cpx T2 = cmul(W, Dc);
    lds[2 * pm] = A.x + T2.y; lds[2 * pm + 1] = -A.y - T2.x;
}
enum { I_X = 0, I_C, I_CTX, I_CCTX, I_WMOD, I_BMOD, I_NMIXW, I_NFFNW, I_WIN, I_BIN, I_HYCW, I_HYCB, I_HYW1, I_HYB1, I_HYW2, I_HYB2, I_HYW3, I_HYB3, I_HYFREQ, I_HYSKIP,
       I_HGLB, I_HGNW, I_GLWA2, I_GLBA, I_GLNW, I_WBR, I_WOUT, I_WRG, I_BRG, I_WRE, I_BRE, I_WGATE, I_WUP, I_WDOWN, I_FNW, N_IN };
struct Args { const float* in[N_IN]; float* out; unsigned char* ws; int ph_lo, ph_hi; };
#define GAS __attribute__((address_space(1)))
extern __shared__ __attribute__((aligned(16))) unsigned char lds_raw[];
constexpr int LDS_PTAB = 150 * 1024 - 64 - 320;
DI LAS unsigned char* ldsbase() { unsigned p = (unsigned)(unsigned long long)(LAS unsigned char*)lds_raw; asm volatile("" : "+s"(p)); return (LAS unsigned char*)(unsigned long long)p; }
DI const float* ain(const Args&, int i) { const unsigned long long v = ((LAS unsigned long long*)(ldsbase() + LDS_PTAB))[i];
    const unsigned lo = __builtin_amdgcn_readfirstlane((unsigned)v), hi = __builtin_amdgcn_readfirstlane((unsigned)(v >> 32)); return (const float*)(GAS const float*)(((unsigned long long)hi << 32) | lo); }
DI unsigned char* wsp(const Args& a) { unsigned long long p = (unsigned long long)(a).ws; asm volatile("" : "+s"(p)); return (unsigned char*)(GAS unsigned char*)p; }
DI int opq(int x) { asm volatile("" : "+s"(x)); return x; }
#ifdef PROBE_SEL
constexpr int LDS_TIM = 150 * 1024 - 64 - 320 - 512;
#define TIC() const unsigned long long tic_ = __builtin_amdgcn_s_memrealtime()
#define TOC(i) do { if (otid() == 0) ((LAS unsigned long long*)(ldsbase() + LDS_TIM))[i] += __builtin_amdgcn_s_memrealtime() - tic_; } while (0)
#else
#define TIC() do {} while (0)
#define TOC(i) do {} while (0)
#endif
#define LDS_BAR() do { asm volatile("s_waitcnt lgkmcnt(0)" ::: "memory"); __builtin_amdgcn_s_barrier(); asm volatile("" ::: "memory"); } while (0)
constexpr int NTHR = 512;
constexpr int LDS_BYTES = 150 * 1024;
constexpr int LDS_X = 131072;
constexpr int LDS_BARW = LDS_BYTES - 64;

DI int z_srccol(int zc) { return zc < 8192 ? zc : (zc < Z_LR ? zc + 32 : (zc < Z_LR + 32 ? zc - Z_LR + 8192 : -1)); }

DI void cvt_block(const float* __restrict__ s0, const float* __restrict__ s1, const float* __restrict__ s2, const float* __restrict__ s3, size_t ld, int c0, int c1, int c2, int c3,
                  bf16* __restrict__ dst, int K, int row0, int kb, LAS float* t) {
    const int tid = otid(), nn = tid & 63, kk = tid >> 6;
    float v[8][4];
#pragma unroll
    for (int p = 0; p < 8; ++p) { const size_t ko = (size_t)(kb * 64 + p * 8 + kk) * ld;
        v[p][0] = c0 >= 0 ? s0[ko + c0] : 0.f; v[p][1] = c1 >= 0 ? s1[ko + c1] : 0.f; v[p][2] = c2 >= 0 ? s2[ko + c2] : 0.f; v[p][3] = c3 >= 0 ? s3[ko + c3] : 0.f; }
#pragma unroll
    for (int p = 0; p < 8; ++p)
#pragma unroll
        for (int g = 0; g < 4; ++g) t[(p * 8 + kk) * 257 + g * 64 + nn] = v[p][g];
    __syncthreads();
    const int rr = tid & 255, hk = tid >> 8;
#pragma unroll
    for (int q = 0; q < 4; ++q) { float w[8];
#pragma unroll
        for (int j = 0; j < 8; ++j) w[j] = t[(hk * 32 + q * 8 + j) * 257 + rr];
        u32x4 o; o.x = pk_bf16(w[0], w[1]); o.y = pk_bf16(w[2], w[3]); o.z = pk_bf16(w[4], w[5]); o.w = pk_bf16(w[6], w[7]);
        *(u32x4*)(dst + (size_t)(row0 + rr) * K + kb * 64 + hk * 32 + q * 8) = o; }
    __syncthreads();
}
constexpr int CVT_MIX_TILES = 69 * 32 + 3 * 8 * 16 + 8 * 32;
DI void cvt_mix_item(const Args& a, int l, int it, LAS float* t) {
    const int nn = otid() & 63;
    if (it < 69 * 32) { const int nb = it >> 5, kb = it & 31; const float* s = ain(a, I_WIN) + (size_t)l * D * NCOLS_IN;
        cvt_block(s, s, s, s, NCOLS_IN, z_srccol(nb * 256 + nn), z_srccol(nb * 256 + 64 + nn), z_srccol(nb * 256 + 128 + nn), z_srccol(nb * 256 + 192 + nn), (bf16*)(wsp(a) + WS_WIN), D, nb * 256, kb, t); return; }
    it -= 69 * 32;
    if (it < 3 * 8 * 16) { const int br = it / 128, r = it % 128, nb = r >> 4, kb = r & 15; const float* s = ain(a, I_WBR) + ((size_t)l * 3 + br) * 1024 * D; const int c = nb * 256 + nn;
        cvt_block(s, s, s, s, D, c, c + 64, c + 128, c + 192, (bf16*)(wsp(a) + WS_WBR) + (size_t)br * D * 1024, 1024, nb * 256, kb, t); return; }
    it -= 3 * 8 * 16;
    { const int nb = it >> 5, kb = it & 31; const float* s = ain(a, I_WOUT) + (size_t)l * D * D; const int c = nb * 256 + nn;
      cvt_block(s, s, s, s, D, c, c + 64, c + 128, c + 192, (bf16*)(wsp(a) + WS_WOUT), D, nb * 256, kb, t); }
}
constexpr int CVT_MOE_TILES = 32 * 4 * 32 + 32 * 8 * 8;
DI void cvt_moe_item(const Args& a, int l, int it, LAS float* t) {
    const int nn = otid() & 63;
    if (it < 32 * 4 * 32) { const int e = it >> 7, r = it & 127, nt = r >> 5, kb = r & 31;
        const float* sg = ain(a, I_WGATE) + ((size_t)l * NEXP + e) * D * DFF; const float* su = ain(a, I_WUP) + ((size_t)l * NEXP + e) * D * DFF; const int c = nt * 128 + nn;
        cvt_block(sg, sg, su, su, DFF, c, c + 64, c, c + 64, (bf16*)(wsp(a) + WS_WGU) + (size_t)e * 1024 * D, D, nt * 256, kb, t); return; }
    it -= 32 * 4 * 32;
    { const int e = it >> 6, r = it & 63, nb = r >> 3, kb = r & 7; const float* s = ain(a, I_WDOWN) + ((size_t)l * NEXP + e) * DFF * D; const int c = nb * 256 + nn;
      cvt_block(s, s, s, s, D, c, c + 64, c + 128, c + 192, (bf16*)(wsp(a) + WS_WD) + (size_t)e * D * DFF, DFF, nb * 256, kb, t); }
}

DI void mod_item(const Args& a, int j, LAS float* lds) {
    const int tid = otid(), l = j >> 7, col0 = (j & 127) * 96;
    LAS float* sil = lds;
    LAS float* red = lds + 4096;
    for (int k = tid; k < 2 * D; k += NTHR) { const float c = (k < D) ? ain(a, I_C)[k] : ain(a, I_CCTX)[k - D]; sil[k] = siluf_(c); }
    __syncthreads();
    const int cg = tid % 24, rg = tid / 24;
    f32x4 a0 = {0.f, 0.f, 0.f, 0.f}, a1 = {0.f, 0.f, 0.f, 0.f};
    if (rg < 21) {
        const float* w = ain(a, I_WMOD) + (size_t)l * D * 12288 + col0 + cg * 4;
        for (int k = rg; k < D; k += 21) { const f32x4 wv = *(const f32x4*)(w + (size_t)k * 12288); a0 += wv * sil[k]; a1 += wv * sil[D + k]; }
#pragma unroll
        for (int q = 0; q < 4; ++q) { red[(rg * 2 + 0) * 96 + cg * 4 + q] = a0[q]; red[(rg * 2 + 1) * 96 + cg * 4 + q] = a1[q]; }
    }
    __syncthreads();
    if (tid < 192) { const int set = tid / 96, c = tid % 96; float s = 0.f;
        for (int r = 0; r < 21; ++r) s += red[(r * 2 + set) * 96 + c];
        ((float*)(wsp(a) + WS_MOD))[((size_t)l * 2 + set) * 12288 + col0 + c] = s + ain(a, I_BMOD)[(size_t)l * 12288 + col0 + c]; }
    __syncthreads();
}
DI void h2_item(const Args& a, int it, LAS float* lds) {
    const int tid = otid(), l = it / (MT / 8), r0 = (it % (MT / 8)) * 8;
    LAS float* feats = lds;
    LAS float* h1 = lds + 8 * 36;
    if (tid < 8 * 33) { const int rr = tid / 33, i = tid % 33, r = r0 + rr; const int Lq = r < SEQ ? SEQ : CTXL, t = r < SEQ ? r : r - SEQ;
        float f;
        if (i == 0) f = (float)t / (float)(Lq - 1);
        else { const int bi = (i - 1) & 15; const float band = 1e-4f + (float)bi * ((15.0f - 1e-4f) / 15.0f); const float rev2 = 2.0f * band * (float)t / (float)Lq;
            f = (i <= 16) ? cospif(rev2) : -sinpif(rev2); }
        feats[rr * 36 + i] = f; }
    __syncthreads();
    const int rr = tid >> 6, j = tid & 63;
    { const float* w1 = ain(a, I_HYW1) + (size_t)l * 33 * 64; float s = ain(a, I_HYB1)[l * 64 + j];
      for (int i = 0; i < 33; ++i) s += feats[rr * 36 + i] * w1[i * 64 + j];
      h1[rr * 64 + j] = sinf(ain(a, I_HYFREQ)[l * 64 + j] * s); }
    __syncthreads();
    { const float* w2 = ain(a, I_HYW2) + (size_t)l * 64 * 64; float s = ain(a, I_HYB2)[l * 64 + j];
      for (int i = 0; i < 64; ++i) s += h1[rr * 64 + i] * w2[i * 64 + j];
      const float hv = sinf(ain(a, I_HYFREQ)[l * 64 + j] * s);
      ((float*)(wsp(a) + WS_H2))[((size_t)l * MT + r0 + rr) * 64 + j] = hv;
      if (r0 + rr < SEQ) { bf16* hb = (bf16*)(wsp(a) + WS_H2B) + ((size_t)l * SEQ + r0 + rr) * 256; hb[j] = f2bf(hv); hb[64 + j] = 0; hb[128 + j] = 0; hb[192 + j] = 0; } }
    __syncthreads();
}
DI void prologue_small(const Args& a) {
    const size_t gt = (size_t)obid() * NTHR + otid(), gs = (size_t)ogdim() * NTHR;
    float* zb = (float*)(wsp(a) + WS_ZBIAS);
    for (size_t i = gt; i < (size_t)DEPTH * ZC; i += gs) { const int l = (int)(i / ZC), zc = (int)(i % ZC), sc = z_srccol(zc); zb[i] = sc >= 0 ? ain(a, I_BIN)[(size_t)l * NCOLS_IN + sc] : 0.f; }
    float* lb = (float*)(wsp(a) + WS_LB);
    for (size_t i = gt; i < (size_t)DEPTH * 2048; i += gs) { const int l = (int)(i / 2048), j = (int)(i % 2048);
        float v = 0.f; if (l == 1) { const float r0 = ain(a, I_HGLB)[j], r1 = ain(a, I_HGLB)[2048 + j]; v = 1.0f / (1.0f + expf(r0 - r1)); }
        lb[i] = v; }
    bf16* w3t = (bf16*)(wsp(a) + WS_W3T);
    for (size_t i = gt; i < (size_t)DEPTH * 2048 * 256; i += gs) { const int l = (int)(i >> 19), fc = (int)((i >> 8) & 2047), j = (int)(i & 255); w3t[i] = j < 64 ? f2bf(ain(a, I_HYW3)[((size_t)l * 64 + j) * 2048 + fc]) : (bf16)0; }
    bf16* wrt = (bf16*)(wsp(a) + WS_WRT);
    for (size_t i = gt; i < (size_t)DEPTH * 48 * 2048; i += gs) { const int l = (int)(i / (48 * 2048)), c = (int)((i / 2048) % 48), k = (int)(i & 2047);
        const float w = c < 4 ? ain(a, I_WRG)[((size_t)l * D + k) * 4 + c] : (c < 36 ? ain(a, I_WRE)[((size_t)l * D + k) * 32 + (c - 4)] : 0.f);
        const bf16 hi = f2bf(w); wrt[((size_t)l * 2 + 0) * 48 * 2048 + (size_t)c * 2048 + k] = hi; wrt[((size_t)l * 2 + 1) * 48 * 2048 + (size_t)c * 2048 + k] = f2bf(w - bf2f(hi)); }
    float* tw = (float*)(wsp(a) + WS_TW);
    for (size_t i = gt; i < 16384; i += gs) { float s, c; sincospif(-2.0f * (float)i / 16384.0f, &s, &c); tw[2 * i] = c; tw[2 * i + 1] = s; }
    float* tw2 = (float*)(wsp(a) + WS_TW2);
    for (size_t i = gt; i <= 8192; i += gs) { float s, c; sincospif(-(float)i / 16384.0f, &s, &c); tw2[2 * i] = c; tw2[2 * i + 1] = s; }
}
DI void hyc_filters(const Args& a, int l) {
    const int lane = otid() & 63, wave = otid() >> 6;
    const float* h2 = (const float*)(wsp(a) + WS_H2) + ((size_t)l * MT + SEQ) * 64;
    const float* w3 = ain(a, I_HYW3) + (size_t)l * 64 * 2048;
    float* hyc = (float*)(wsp(a) + WS_HYC);
    const float a0 = -4.605170186f / 1.5f, a1 = -4.605170186f / 0.3f;
    for (int fc = obid() * 8 + wave; fc < 2048; fc += ogdim() * 8) {
        const int c = fc & 1023; const float delta = fabsf(a0 + (float)c * ((a1 - a0) / 1023.0f)); const float b3 = ain(a, I_HYB3)[l * 2048 + fc];
        float hv[4], ssum = 0.f;
#pragma unroll
        for (int i = 0; i < 4; ++i) { const int t = lane + 64 * i; float s = b3;
            for (int j = 0; j < 64; ++j) s += h2[t * 64 + j] * w3[j * 2048 + fc];
            const float tl = (float)t / 255.0f; hv[i] = s * (expf(-tl * delta) + 0.05f); ssum += fabsf(hv[i]); }
        ssum = wave_sum(ssum); const float inv = 1.0f / ssum;
#pragma unroll
        for (int i = 0; i < 4; ++i) hyc[(size_t)fc * 256 + lane + 64 * i] = hv[i] * inv;
    }
}
template <int MODE, bool DRY = false> DI void norm_phase(const Args& a, int l, int nrows, LAS float* ldsf) {
    const int lane = otid() & 63, wave = otid() >> 6;
    float* H = (float*)(wsp(a) + WS_H); bf16* U = (bf16*)(wsp(a) + WS_U);
    const float* modall = (const float*)(wsp(a) + WS_MOD);
    int* route = (int*)(wsp(a) + WS_ROUTE);
    const bf16* YP = (const bf16*)(wsp(a) + WS_YP);
    const bool combine = (MODE == 0 && l > 0) || MODE == 2;
    for (int r = obid() * 8 + wave; r < nrows; r += ogdim() * 8) {
        const int set = r >= SEQ ? 1 : 0;
        const float* src = (MODE == 0 && l == 0) ? (set ? ain(a, I_CTX) + (size_t)(r - SEQ) * D : ain(a, I_X) + (size_t)r * D) : H + (size_t)r * D;
        f32x4 v[8];
#pragma unroll
        for (int j = 0; j < 8; ++j) v[j] = *(const f32x4*)(src + j * 256 + lane * 4);
        if (combine) {
            const float* gt2 = modall + ((size_t)(l - 1) * 2 + set) * 12288 + 10240;
            const int p0 = route[r * 8 + 6], p1 = route[r * 8 + 7];
#pragma unroll
            for (int j = 0; j < 8; ++j) { const int col = j * 256 + lane * 4;
                const u32x2 y0 = *(const u32x2*)(YP + (size_t)p0 * D + col), y1 = *(const u32x2*)(YP + (size_t)p1 * D + col); const f32x4 g = *(const f32x4*)(gt2 + col);
                v[j][0] += g[0] * (bflo(y0.x) + bflo(y1.x)); v[j][1] += g[1] * (bfhi(y0.x) + bfhi(y1.x)); v[j][2] += g[2] * (bflo(y0.y) + bflo(y1.y)); v[j][3] += g[3] * (bfhi(y0.y) + bfhi(y1.y)); }
            if (MODE == 0) {
#pragma unroll
                for (int j = 0; j < 8; ++j) *(f32x4*)(H + (size_t)r * D + j * 256 + lane * 4) = v[j];
            }
        }
        float ss = 0.f;
#pragma unroll
        for (int j = 0; j < 8; ++j) ss += (v[j][0] * v[j][0] + v[j][1] * v[j][1]) + (v[j][2] * v[j][2] + v[j][3] * v[j][3]);
        ss = wave_sum(ss);
        const float rstd = rsqrtf(ss * (1.0f / D) + NORM_EPS);
        if (MODE == 2) {
            const float* fw = ain(a, I_FNW);
#ifdef PROBE_SEL
            const float pscale = 1.0f + 0.5f * (float)((LAS unsigned long long*)(ldsbase() + LDS_TIM))[PROBE_SEL] / (float)((LAS unsigned long long*)(ldsbase() + LDS_TIM))[0];
#else
            const float pscale = 1.0f;
#endif
#pragma unroll
            for (int j = 0; j < 8; ++j) { const int col = j * 256 + lane * 4; const f32x4 w = *(const f32x4*)(fw + col); *(f32x4*)(a.out + (size_t)r * D + col) = v[j] * rstd * w * pscale; }
        } else {
            const float* nw = (MODE == 0 ? ain(a, I_NMIXW) : ain(a, I_NFFNW)) + (size_t)l * D;
            const float* md = modall + ((size_t)l * 2 + set) * 12288 + (MODE == 0 ? 0 : 6144);
#pragma unroll
            for (int j = 0; j < 8; ++j) { const int col = j * 256 + lane * 4; const f32x4 w = *(const f32x4*)(nw + col), sh = *(const f32x4*)(md + col), sc = *(const f32x4*)(md + 2048 + col);
                v[j] = (v[j] * rstd * w) * (sc + 1.0f) + sh;
                u32x2 o; o.x = pk_bf16(v[j][0], v[j][1]); o.y = pk_bf16(v[j][2], v[j][3]); *(u32x2*)(U + (size_t)r * D + col) = o; }
            if (MODE == 1) {
                const float* wrg = ain(a, I_WRG) + (size_t)l * D * 4; const float* wre = ain(a, I_WRE) + (size_t)l * D * 32;
                float lg[36];
#pragma unroll
                for (int i = 0; i < 36; ++i) lg[i] = 0.f;
                LAS float* wu = ldsf + wave * 2048;
#pragma unroll
                for (int j = 0; j < 8; ++j) *(LAS f32x4*)(wu + j * 256 + lane * 4) = v[j];
                asm volatile("s_waitcnt lgkmcnt(0)" ::: "memory");
#pragma unroll 2
                for (int cc = 0; cc < 32; ++cc) { const int col = cc * 64 + lane; const float uv = wu[col];
                    const f32x4 g = *(const f32x4*)(wrg + (size_t)col * 4);
                    lg[0] += uv * g[0]; lg[1] += uv * g[1]; lg[2] += uv * g[2]; lg[3] += uv * g[3];
#pragma unroll
                    for (int e4 = 0; e4 < 8; ++e4) { const f32x4 w = *(const f32x4*)(wre + (size_t)col * 32 + e4 * 4);
                        lg[4 + e4 * 4 + 0] += uv * w[0]; lg[4 + e4 * 4 + 1] += uv * w[1]; lg[4 + e4 * 4 + 2] += uv * w[2]; lg[4 + e4 * 4 + 3] += uv * w[3]; } }
                asm volatile("s_waitcnt lgkmcnt(0)" ::: "memory");
#pragma unroll
                for (int i = 0; i < 36; ++i) lg[i] = wave_sum(lg[i]);
                float gl[4]; int grp = 0; float gmax;
#pragma unroll
                for (int g = 0; g < 4; ++g) gl[g] = lg[g] + ain(a, I_BRG)[l * 4 + g];
                gmax = gl[0];
#pragma unroll
                for (int g = 1; g < 4; ++g) if (gl[g] > gmax) { gmax = gl[g]; grp = g; }
                float gden = 0.f;
#pragma unroll
                for (int g = 0; g < 4; ++g) gden += expf(gl[g] - gmax);
                const float ptop = 1.0f / gden;
                float le[8];
#pragma unroll
                for (int i = 0; i < 8; ++i) { float x = lg[4 + i];
#pragma unroll
                    for (int g = 1; g < 4; ++g) x = (grp == g) ? lg[4 + g * 8 + i] : x;
                    le[i] = x + ain(a, I_BRE)[l * 32 + grp * 8 + i]; }
                int i0 = 0; float m0 = le[0];
#pragma unroll
                for (int i = 1; i < 8; ++i) if (le[i] > m0) { m0 = le[i]; i0 = i; }
                int i1 = -1; float m1 = -3.0e38f;
#pragma unroll
                for (int i = 0; i < 8; ++i) if (i != i0 && le[i] > m1) { m1 = le[i]; i1 = i; }
                const float e1v = expf(m1 - m0);
                const float w0 = ptop / (1.0f + e1v), w1 = ptop * e1v / (1.0f + e1v);
                if (DRY) { asm volatile("" :: "v"(w0), "v"(w1), "v"(i0), "v"(i1), "v"(grp)); }
                else if (lane == 0) {
                    unsigned* cnt = (unsigned*)(wsp(a) + WS_CTL) + CW_CNT + l * 64;
                    const int ex0 = grp * 8 + i0, ex1 = grp * 8 + i1;
                    const unsigned s0 = atomicAdd(cnt + ex0, 1u), s1 = atomicAdd(cnt + ex1, 1u);
                    route[r * 8 + 0] = ex0; route[r * 8 + 1] = ex1; route[r * 8 + 2] = (int)s0; route[r * 8 + 3] = (int)s1;
                    route[r * 8 + 4] = __float_as_int(w0); route[r * 8 + 5] = __float_as_int(w1);
                }
            }
        }
    }
}
typedef short bf16x8r_t __attribute__((ext_vector_type(8)));
template <bool DRY> DI void route_phase(const Args& a, int l, int nrows, LAS float* ldsf) {
    const int lane = otid() & 63, wave = otid() >> 6, fr = lane & 15, fq = lane >> 4;
    const float* H = (const float*)(wsp(a) + WS_H); bf16* U = (bf16*)(wsp(a) + WS_U); int* route = (int*)(wsp(a) + WS_ROUTE);
    const float* nw = ain(a, I_NFFNW) + (size_t)l * D;
    const bf16* Wh = (const bf16*)(wsp(a) + WS_WRT) + (size_t)l * 2 * 48 * 2048; const bf16* Wl = Wh + 48 * 2048;
    LAS float* lt = ldsf + wave * 1024;
    const int G = ogdim();
    for (int tile = wave * G + (int)obid(); tile < nrows / 16; tile += 8 * G) {
        const int row = tile * 16 + fr, set = row >= SEQ ? 1 : 0;
        const float* hr = H + (size_t)row * D + fq * 8;
        const float* md = (const float*)(wsp(a) + WS_MOD) + ((size_t)l * 2 + set) * 12288 + 6144 + fq * 8;
        float ss = 0.f;
#pragma unroll 8
        for (int ks = 0; ks < 64; ++ks) { const f32x4 x0 = *(const f32x4*)(hr + ks * 32), x1 = *(const f32x4*)(hr + ks * 32 + 4);
            ss += (x0[0] * x0[0] + x0[1] * x0[1]) + (x0[2] * x0[2] + x0[3] * x0[3]) + (x1[0] * x1[0] + x1[1] * x1[1]) + (x1[2] * x1[2] + x1[3] * x1[3]); }
        ss += __shfl_xor(ss, 16); ss += __shfl_xor(ss, 32);
        const float rstd = rsqrtf(ss * (1.0f / D) + NORM_EPS);
        f32x4 acc[3];
#pragma unroll
        for (int cb = 0; cb < 3; ++cb) acc[cb] = (f32x4){0.f, 0.f, 0.f, 0.f};
#pragma unroll 2
        for (int ks = 0; ks < 64; ++ks) { const int c0 = ks * 32;
            const f32x4 x0 = *(const f32x4*)(hr + c0), x1 = *(const f32x4*)(hr + c0 + 4);
            const f32x4 w0 = *(const f32x4*)(nw + fq * 8 + c0), w1 = *(const f32x4*)(nw + fq * 8 + c0 + 4);
            const f32x4 h0 = *(const f32x4*)(md + c0), h1 = *(const f32x4*)(md + c0 + 4), s0 = *(const f32x4*)(md + 2048 + c0), s1 = *(const f32x4*)(md + 2048 + c0 + 4);
            const f32x4 u0 = (x0 * rstd * w0) * (s0 + 1.0f) + h0, u1 = (x1 * rstd * w1) * (s1 + 1.0f) + h1;
            u32x4 hi; hi.x = pk_bf16(u0[0], u0[1]); hi.y = pk_bf16(u0[2], u0[3]); hi.z = pk_bf16(u1[0], u1[1]); hi.w = pk_bf16(u1[2], u1[3]);
            *(u32x4*)(U + (size_t)row * D + fq * 8 + c0) = hi;
            u32x4 lo; lo.x = pk_bf16(u0[0] - bflo(hi.x), u0[1] - bfhi(hi.x)); lo.y = pk_bf16(u0[2] - bflo(hi.y), u0[3] - bfhi(hi.y)); lo.z = pk_bf16(u1[0] - bflo(hi.z), u1[1] - bfhi(hi.z)); lo.w = pk_bf16(u1[2] - bflo(hi.w), u1[3] - bfhi(hi.w));
            const bf16x8r_t ah = __builtin_bit_cast(bf16x8r_t, hi), al = __builtin_bit_cast(bf16x8r_t, lo);
#pragma unroll
            for (int cb = 0; cb < 3; ++cb) { const bf16x8r_t bh = *(const bf16x8r_t*)(Wh + (size_t)(cb * 16 + fr) * 2048 + c0 + fq * 8), bl = *(const bf16x8r_t*)(Wl + (size_t)(cb * 16 + fr) * 2048 + c0 + fq * 8);
                acc[cb] = __builtin_amdgcn_mfma_f32_16x16x32_bf16(ah, bh, acc[cb], 0, 0, 0); acc[cb] = __builtin_amdgcn_mfma_f32_16x16x32_bf16(ah, bl, acc[cb], 0, 0, 0); acc[cb] = __builtin_amdgcn_mfma_f32_16x16x32_bf16(al, bh, acc[cb], 0, 0, 0); } }
#pragma unroll
        for (int cb = 0; cb < 3; ++cb)
#pragma unroll
            for (int j = 0; j < 4; ++j) lt[(fq * 4 + j) * 48 + cb * 16 + fr] = acc[cb][j];
        asm volatile("s_waitcnt lgkmcnt(0)" ::: "memory");
        if (lane < 16) {
            const int r = tile * 16 + lane; float lg[36];
#pragma unroll
            for (int i = 0; i < 36; ++i) lg[i] = lt[lane * 48 + i];
            float gl[4]; int grp = 0; float gmax;
#pragma unroll
            for (int g = 0; g < 4; ++g) gl[g] = lg[g] + ain(a, I_BRG)[l * 4 + g];
            gmax = gl[0];
#pragma unroll
            for (int g = 1; g < 4; ++g) if (gl[g] > gmax) { gmax = gl[g]; grp = g; }
            float gden = 0.f;
#pragma unroll
            for (int g = 0; g < 4; ++g) gden += expf(gl[g] - gmax);
            const float ptop = 1.0f / gden;
            float le[8];
#pragma unroll
            for (int i = 0; i < 8; ++i) { float x = lg[4 + i];
#pragma unroll
                for (int g = 1; g < 4; ++g) x = (grp == g) ? lg[4 + g * 8 + i] : x;
                le[i] = x + ain(a, I_BRE)[l * 32 + grp * 8 + i]; }
            int i0 = 0; float m0 = le[0];
#pragma unroll
            for (int i = 1; i < 8; ++i) if (le[i] > m0) { m0 = le[i]; i0 = i; }
            int i1 = -1; float m1 = -3.0e38f;
#pragma unroll
            for (int i = 0; i < 8; ++i) if (i != i0 && le[i] > m1) { m1 = le[i]; i1 = i; }
            const float e1v = expf(m1 - m0);
            const float w0 = ptop / (1.0f + e1v), w1 = ptop * e1v / (1.0f + e1v);
            if (DRY) { asm volatile("" :: "v"(w0), "v"(w1), "v"(i0), "v"(i1), "v"(grp)); }
            else { unsigned* cnt = (unsigned*)(wsp(a) + WS_CTL) + CW_CNT + l * 64; const int ex0 = grp * 8 + i0, ex1 = grp * 8 + i1;
                const unsigned s0 = atomicAdd(cnt + ex0, 1u), s1 = atomicAdd(cnt + ex1, 1u);
                route[r * 8 + 0] = ex0; route[r * 8 + 1] = ex1; route[r * 8 + 2] = (int)s0; route[r * 8 + 3] = (int)s1; route[r * 8 + 4] = __float_as_int(w0); route[r * 8 + 5] = __float_as_int(w1); }
        }
        asm volatile("s_waitcnt lgkmcnt(0)" ::: "memory");
    }
}
DI void permute_phase(const Args& a, int l, int nrows, LAS unsigned char* ldsb) {
    LAS int* poff = (LAS int*)ldsb;
    const int tid = otid(), lane = tid & 63, wave = tid >> 6;
    const unsigned* cnt = (const unsigned*)(wsp(a) + WS_CTL) + CW_CNT + l * 64;
    if (tid == 0) { int off = 0; for (int e = 0; e < NEXP; ++e) { poff[e] = off; off += (int)((cnt[e] + 255u) / 256u) * 256; } poff[32] = off; }
    __syncthreads();
    if (obid() == 0) { int* tile_e = (int*)(wsp(a) + WS_TILEE); const int nt = poff[32] >> 8;
        if (tid < 200) { int e = -1; if (tid < nt) { for (int q = 0; q < NEXP; ++q) if (poff[q] <= tid * 256) e = q; } tile_e[tid] = e < 0 ? 0 : e; }
        if (tid == 0) tile_e[200] = nt; }
    int* route = (int*)(wsp(a) + WS_ROUTE); float* roww = (float*)(wsp(a) + WS_ROWW);
    const bf16* U = (const bf16*)(wsp(a) + WS_U); bf16* XP = (bf16*)(wsp(a) + WS_XP);
    for (int r = obid() * 8 + wave; r < nrows; r += ogdim() * 8) {
        const int e0 = route[r * 8 + 0], e1 = route[r * 8 + 1], s0 = route[r * 8 + 2], s1 = route[r * 8 + 3];
        const int p0 = poff[e0] + s0, p1 = poff[e1] + s1;
        u32x4 x[4];
#pragma unroll
        for (int i = 0; i < 4; ++i) x[i] = *(const u32x4*)(U + (size_t)r * D + (i * 64 + lane) * 8);
#pragma unroll
        for (int i = 0; i < 4; ++i) { *(u32x4*)(XP + (size_t)p0 * D + (i * 64 + lane) * 8) = x[i]; *(u32x4*)(XP + (size_t)p1 * D + (i * 64 + lane) * 8) = x[i]; }
        if (lane == 0) { route[r * 8 + 6] = p0; route[r * 8 + 7] = p1; roww[p0] = __int_as_float(route[r * 8 + 4]); roww[p1] = __int_as_float(route[r * 8 + 5]); }
    }
}
DI int stream_row(int p, int dir) { return dir == 0 ? (p < CTXL ? SEQ + p : p - CTXL) : (p < CTXL ? SEQ + (CTXL - 1 - p) : (SEQ - 1) - (p - CTXL)); }

DI void shortconv8(const bf16* Z, const float* cw, const float* cb, int l, int seg, int c, int r0, int lo, int hi, float (&out)[8]) {
    const int col = Z_HY + seg * 1024 + c; float zz[10];
#pragma unroll
    for (int i = 0; i < 10; ++i) { const int r = r0 - 1 + i; zz[i] = (r >= lo && r < hi) ? bf2f(Z[(size_t)r * ZC + col]) : 0.f; }
    const float w0 = cw[((size_t)l * 3 + 0) * 3072 + seg * 1024 + c], w1 = cw[((size_t)l * 3 + 1) * 3072 + seg * 1024 + c], w2 = cw[((size_t)l * 3 + 2) * 3072 + seg * 1024 + c], b = cb[(size_t)l * 3072 + seg * 1024 + c];
#pragma unroll
    for (int i = 0; i < 8; ++i) out[i] = w0 * zz[i] + w1 * zz[i + 1] + w2 * zz[i + 2] + b;
}
DI void hyprep_item(const Args& a, int l, int it, LAS float* t) {
    const int tid = otid(), tb = it >> 4, cb = it & 15, r0 = tb * 64, lo = r0 < SEQ ? 0 : SEQ, hi = r0 < SEQ ? SEQ : MT;
    const bf16* Z = (const bf16*)(wsp(a) + WS_Z); bf16* VXT = (bf16*)(wsp(a) + WS_U);
    { const int cc = tid & 63, tq = tid >> 6, c = cb * 64 + cc; float x1[8], vv[8];
      shortconv8(Z, ain(a, I_HYCW), ain(a, I_HYCB), l, 1, c, r0 + tq * 8, lo, hi, x1); shortconv8(Z, ain(a, I_HYCW), ain(a, I_HYCB), l, 2, c, r0 + tq * 8, lo, hi, vv);
#pragma unroll
      for (int i = 0; i < 8; ++i) t[cc * 65 + tq * 8 + i] = vv[i] * x1[i]; }
    __syncthreads();
    { const int cw = tid >> 3, t8 = tid & 7; float o[8];
#pragma unroll
      for (int i = 0; i < 8; ++i) o[i] = t[cw * 65 + t8 * 8 + i];
      u32x4 w; w.x = pk_bf16(o[0], o[1]); w.y = pk_bf16(o[2], o[3]); w.z = pk_bf16(o[4], o[5]); w.w = pk_bf16(o[6], o[7]);
      *(u32x4*)(VXT + (size_t)(cb * 64 + cw) * MT + r0 + t8 * 8) = w; }
    __syncthreads();
}
DI void hycomb_item(const Args& a, int l, int it, LAS float* t) {
    const int tid = otid(), tb = it >> 4, cb = it & 15, r0 = tb * 64, lo = r0 < SEQ ? 0 : SEQ, hi = r0 < SEQ ? SEQ : MT;
    const bf16* Z = (const bf16*)(wsp(a) + WS_Z); const bf16* VXT = (const bf16*)(wsp(a) + WS_CVO); bf16* Y0 = (bf16*)(wsp(a) + WS_YMIX);
    { const int cw = tid >> 3, t8 = tid & 7; const u32x4 r = *(const u32x4*)(VXT + (size_t)(cb * 64 + cw) * MT + r0 + t8 * 8);
      LAS float* tp = t + cw * 65 + t8 * 8; tp[0] = bflo(r.x); tp[1] = bfhi(r.x); tp[2] = bflo(r.y); tp[3] = bfhi(r.y); tp[4] = bflo(r.z); tp[5] = bfhi(r.z); tp[6] = bflo(r.w); tp[7] = bfhi(r.w); }
    __syncthreads();
    { const int cc = tid & 63, tq = tid >> 6, c = cb * 64 + cc; float x0[8];
      shortconv8(Z, ain(a, I_HYCW), ain(a, I_HYCB), l, 0, c, r0 + tq * 8, lo, hi, x0);
#pragma unroll
      for (int i = 0; i < 8; ++i) Y0[(size_t)(r0 + tq * 8 + i) * 1024 + c] = f2bf(t[cc * 65 + tq * 8 + i] * x0[i]); }
    __syncthreads();
}
DI void unpack8(const u32x4& p, float (&v)[8]) { v[0] = bflo(p.x); v[1] = bfhi(p.x); v[2] = bflo(p.y); v[3] = bfhi(p.y); v[4] = bflo(p.z); v[5] = bfhi(p.z); v[6] = bflo(p.w); v[7] = bfhi(p.w); }
DI void scancomb_rows(const Args& a, int l, int nrows) {
    const int lane = otid() & 63, wave = otid() >> 6;
    const bf16* Z = (const bf16*)(wsp(a) + WS_Z); const bf16* O = (const bf16*)(wsp(a) + WS_OSC);
    bf16* Y1 = (bf16*)(wsp(a) + WS_YMIX) + (size_t)MT * 1024; bf16* Y2 = Y1 + (size_t)MT * 1024;
    const float* hnw = ain(a, I_HGNW) + (size_t)l * 128; const float* gnw = ain(a, I_GLNW) + (size_t)l * 256;
    for (int r = obid() * 8 + wave; r < nrows; r += ogdim() * 8) {
#pragma unroll
        for (int i = 0; i < 2; ++i) { const int col = i * 512 + lane * 8;
            { float of[8], ob[8], g[8], o[8]; unpack8(*(const u32x4*)(O + (size_t)r * 1024 + col), of); unpack8(*(const u32x4*)(O + ((size_t)MT + r) * 1024 + col), ob); unpack8(*(const u32x4*)(Z + (size_t)r * ZC + Z_HG + 4096 + col), g);
              float ss = 0.f;
#pragma unroll
              for (int q = 0; q < 8; ++q) { o[q] = of[q] + ob[q]; ss += o[q] * o[q]; }
              ss += __shfl_xor(ss, 8); ss += __shfl_xor(ss, 4); ss += __shfl_xor(ss, 2); ss += __shfl_xor(ss, 1);
              const float rstd = rsqrtf(ss * (1.0f / 128.0f) + NORM_EPS);
              const f32x4 n0 = *(const f32x4*)(hnw + (col & 127)), n1 = *(const f32x4*)(hnw + (col & 127) + 4);
              u32x4 w; w.x = pk_bf16(o[0] * rstd * n0[0] * sigmoidf_(g[0]), o[1] * rstd * n0[1] * sigmoidf_(g[1])); w.y = pk_bf16(o[2] * rstd * n0[2] * sigmoidf_(g[2]), o[3] * rstd * n0[3] * sigmoidf_(g[3]));
              w.z = pk_bf16(o[4] * rstd * n1[0] * sigmoidf_(g[4]), o[5] * rstd * n1[1] * sigmoidf_(g[5])); w.w = pk_bf16(o[6] * rstd * n1[2] * sigmoidf_(g[6]), o[7] * rstd * n1[3] * sigmoidf_(g[7]));
              *(u32x4*)(Y1 + (size_t)r * 1024 + col) = w; }
            { float of[8], ob[8], g[8], o[8]; unpack8(*(const u32x4*)(O + ((size_t)2 * MT + r) * 1024 + col), of); unpack8(*(const u32x4*)(O + ((size_t)3 * MT + r) * 1024 + col), ob); unpack8(*(const u32x4*)(Z + (size_t)r * ZC + Z_GL + 2048 + col), g);
              float ss = 0.f;
#pragma unroll
              for (int q = 0; q < 8; ++q) { o[q] = of[q] + ob[q]; ss += o[q] * o[q]; }
              ss += __shfl_xor(ss, 16); ss += __shfl_xor(ss, 8); ss += __shfl_xor(ss, 4); ss += __shfl_xor(ss, 2); ss += __shfl_xor(ss, 1);
              const float rstd = rsqrtf(ss * (1.0f / 256.0f) + NORM_EPS);
              const f32x4 n0 = *(const f32x4*)(gnw + (col & 255)), n1 = *(const f32x4*)(gnw + (col & 255) + 4);
              u32x4 w; w.x = pk_bf16(o[0] * rstd * n0[0] * siluf_(g[0]), o[1] * rstd * n0[1] * siluf_(g[1])); w.y = pk_bf16(o[2] * rstd * n0[2] * siluf_(g[2]), o[3] * rstd * n0[3] * siluf_(g[3]));
              w.z = pk_bf16(o[4] * rstd * n1[0] * siluf_(g[4]), o[5] * rstd * n1[1] * siluf_(g[5])); w.w = pk_bf16(o[6] * rstd * n1[2] * siluf_(g[6]), o[7] * rstd * n1[3] * siluf_(g[7]));
              *(u32x4*)(Y2 + (size_t)r * 1024 + col) = w; }
        }
    }
}
typedef short bf16x8_t __attribute__((ext_vector_type(8)));
constexpr int SC_N = 65;
constexpr size_t KVS_GL_OFF = (size_t)16 * SC_N * 16384;
constexpr size_t WS_KVS = WS_WGU;
constexpr size_t WS_KD  = WS_WGU + 130 * MiB;
constexpr int SL_QM = 0, SL_KM = 17408, SL_Q0 = 34816, SL_KE = 52224, SL_VT = 70656, SL_PP = 107520, SL_TOT = 116736, SL_DD = 118784, SL_AFB = 119296, SL_EB = 121344;
static_assert(SL_EB + 512 <= 131072 && WS_KD + (size_t)24 * SC_N * 128 * 4 <= WS_H, "scan maps");
DI bf16x8_t lds_frag16(LAS unsigned char* p) { return *(LAS bf16x8_t*)p; }
DI bf16x8_t pack_bf16x8(const f32x4& lo, const f32x4& hi) { u32x4 w; w.x = pk_bf16(lo[0], lo[1]); w.y = pk_bf16(lo[2], lo[3]); w.z = pk_bf16(hi[0], hi[1]); w.w = pk_bf16(hi[2], hi[3]); return __builtin_bit_cast(bf16x8_t, w); }

template <bool GLA, bool OUT> DI void scan_walk(const Args& a, int l, int head, int dir, int sc, int dvh, LAS unsigned char* lds) {
    constexpr int NB = 1, DV = GLA ? 256 : 128;
    const int tid = otid(), lane = tid & 63, wave = tid >> 6, fr = lane & 15, fq = lane >> 4, nbase = dvh * 8 + wave;
    const bf16* Z = (const bf16*)(wsp(a) + WS_Z);
    const int stream = GLA ? 16 + head * 2 + dir : head * 2 + dir;
    float* kvs = (float*)(wsp(a) + WS_KVS) + (GLA ? KVS_GL_OFF + ((size_t)(stream - 16) * SC_N + sc) * 32768 : ((size_t)stream * SC_N + sc) * 16384);
    float* kd = (float*)(wsp(a) + WS_KD) + ((size_t)stream * SC_N + sc) * 128;
    LAS bf16* QM = (LAS bf16*)(lds + SL_QM); LAS bf16* KM = (LAS bf16*)(lds + SL_KM); LAS float* EB = (LAS float*)(lds + SL_EB); LAS bf16* XG = (LAS bf16*)(lds + SL_Q0);
    LAS bf16* KE = (LAS bf16*)(lds + SL_KE); LAS bf16* VT = (LAS bf16*)(lds + SL_VT); LAS bf16* PP = (LAS bf16*)(lds + SL_PP);
    LAS float* TOT = (LAS float*)(lds + SL_TOT); LAS float* DD = (LAS float*)(lds + SL_DD); LAS bf16* AFB = (LAS bf16*)(lds + SL_AFB);
    const int k = (wave & 1) * 64 + lane, seg = wave >> 1;
    float lbv = 0.f, bag = 0.f; bf16x8_t Bg = {0, 0, 0, 0, 0, 0, 0, 0};
    if (!GLA) lbv = ((const float*)(wsp(a) + WS_LB))[((size_t)l * 2 + dir) * 1024 + head * 128 + k];
    else {
        bag = ain(a, I_GLBA)[((size_t)l * 2 + dir) * 512 + head * 128 + wave * 16 + fr];
        if (fq < 2) { const float* wp = ain(a, I_GLWA2) + (((size_t)l * 2 + dir) * 16 + fq * 8) * 512 + head * 128 + wave * 16 + fr; float w8[8];
#pragma unroll
            for (int j = 0; j < 8; ++j) w8[j] = wp[(size_t)j * 512];
            u32x4 pw; pw.x = pk_bf16(w8[0], w8[1]); pw.y = pk_bf16(w8[2], w8[3]); pw.z = pk_bf16(w8[4], w8[5]); pw.w = pk_bf16(w8[6], w8[7]); Bg = __builtin_bit_cast(bf16x8_t, pw); } }
    f32x4 S[NB][8];
#pragma unroll
    for (int nb = 0; nb < NB; ++nb)
#pragma unroll
        for (int mb = 0; mb < 8; ++mb) { if (OUT) S[nb][mb] = *(const f32x4*)(kvs + (size_t)((nbase + nb) * 16 + fr) * 128 + mb * 16 + fq * 4); else S[nb][mb] = (f32x4){0.f, 0.f, 0.f, 0.f}; }
    float dlog = 0.f;
    const int which = (GLA ? 2 : 0) + dir;
    bf16* Odir = (bf16*)(wsp(a) + WS_OSC) + (size_t)which * MT * 1024;
    const int srow = tid >> 3, spc = (tid & 7) * 16;
    const int vcol = (GLA ? Z_GL + 1024 + head * 256 + dvh * 128 : Z_HG + 3072 + head * 128) + wave * 16;
    const int fcol = (GLA ? Z_GL + 512 + head * 128 : Z_HG + 1024 * (1 + dir) + head * 128) + spc, qcol = (GLA ? Z_GL + head * 128 : Z_HG + head * 128) + spc;
    u32x4 pv0, pv1, pf0, pf1, pq0 = {0u, 0u, 0u, 0u}, pq1 = {0u, 0u, 0u, 0u}, pa = {0u, 0u, 0u, 0u};
#define SCAN_ISSUE(cidx) do { const int r0n_ = dir ? stream_row((cidx) * 64 + 63, 1) : stream_row((cidx) * 64, 0); \
        const bf16* vr_ = Z + (size_t)(r0n_ + lane) * ZC + vcol; pv0 = *(const u32x4*)vr_; pv1 = *(const u32x4*)(vr_ + 8); \
        const bf16* zr_ = Z + (size_t)(r0n_ + srow) * ZC; pf0 = *(const u32x4*)(zr_ + fcol); pf1 = *(const u32x4*)(zr_ + fcol + 8); \
        if (OUT) { pq0 = *(const u32x4*)(zr_ + qcol); pq1 = *(const u32x4*)(zr_ + qcol + 8); } \
        if (GLA && tid < 128) pa = *(const u32x4*)(Z + (size_t)(r0n_ + (tid >> 1)) * ZC + Z_LR + dir * 16 + (tid & 1) * 8); } while (0)
    SCAN_ISSUE(sc * 4);
    for (int cc = 0; cc < 4; ++cc) {
        const int c = sc * 4 + cc; const int r0 = dir ? stream_row(c * 64 + 63, 1) : stream_row(c * 64, 0);
        {
#pragma unroll
          for (int q8 = 0; q8 < 2; ++q8) { const u32x4 v = q8 ? pv1 : pv0; const int d0 = wave * 16 + q8 * 8;
              VT[(d0 + 0) * 72 + lane] = (bf16)(v.x & 0xffff); VT[(d0 + 1) * 72 + lane] = (bf16)(v.x >> 16); VT[(d0 + 2) * 72 + lane] = (bf16)(v.y & 0xffff); VT[(d0 + 3) * 72 + lane] = (bf16)(v.y >> 16);
              VT[(d0 + 4) * 72 + lane] = (bf16)(v.z & 0xffff); VT[(d0 + 5) * 72 + lane] = (bf16)(v.z >> 16); VT[(d0 + 6) * 72 + lane] = (bf16)(v.w & 0xffff); VT[(d0 + 7) * 72 + lane] = (bf16)(v.w >> 16); }
          *(LAS u32x4*)(KM + srow * 136 + spc) = pf0; *(LAS u32x4*)(KM + srow * 136 + spc + 8) = pf1;
          if (OUT) { *(LAS u32x4*)(QM + srow * 136 + spc) = pq0; *(LAS u32x4*)(QM + srow * 136 + spc + 8) = pq1; }
          if (GLA && tid < 128) *(LAS u32x4*)(AFB + (tid >> 1) * 16 + (tid & 1) * 8) = pa;
          if (cc < 3) SCAN_ISSUE(c + 1); }
        LDS_BAR();
        if (GLA) {
#pragma unroll
            for (int tb = 0; tb < 4; ++tb) { bf16x8_t Ag = {0, 0, 0, 0, 0, 0, 0, 0}; if (fq < 2) Ag = lds_frag16(lds + SL_AFB + ((tb * 16 + fr) * 16 + fq * 8) * 2);
                f32x4 xg = {bag, bag, bag, bag}; xg = __builtin_amdgcn_mfma_f32_16x16x32_bf16(Ag, Bg, xg, 0, 0, 0);
#pragma unroll
                for (int j = 0; j < 4; ++j) XG[(tb * 16 + fq * 4 + j) * 136 + wave * 16 + fr] = f2bf(xg[j]); }
            LDS_BAR();
        }
        const int tstart = dir ? 63 - seg * 16 : seg * 16, tstep = dir ? -1 : 1;
        float cs[16], kkv[GLA ? 1 : 16]; float run = 0.f;
#ifdef REPMASK
        _Pragma("unroll 1") for (int rp1 = 0; rp1 < (((REPMASK) >> 24) & 1 ? 3 : 1); ++rp1) { run = 0.f;
#else
        {
#endif
#pragma unroll
        for (int i = 0; i < 16; ++i) { const int t = tstart + i * tstep; float la;
            if (!GLA) { const float zf = bf2f(KM[t * 136 + k]); const float sg = sigmoidf_(zf); la = __logf(lbv + (1.0f - lbv) * sg); kkv[i] = (1.0f - lbv) * (1.0f - sg); }
            else { const float x = bf2f(XG[t * 136 + k]); la = (fminf(x, 0.f) - __logf(1.0f + __expf(-fabsf(x)))) * 0.0625f; }
            run += la; cs[i] = run; }
        }
        TOT[seg * 128 + k] = run;
        LDS_BAR();
        { const float t0 = TOT[k], t1 = TOT[128 + k], t2 = TOT[256 + k], t3 = TOT[384 + k];
          const float off = seg == 0 ? 0.f : (seg == 1 ? t0 : (seg == 2 ? t0 + t1 : t0 + t1 + t2)), blast = (t0 + t1) + (t2 + t3), bref = t0 + t1;
          float ke[16]; const float ebl = __expf(blast - bref);
#pragma unroll
          for (int i = 0; i < 16; ++i) { const int t = tstart + i * tstep; const float b = off + cs[i];
              float kk; if (GLA) kk = bf2f(KM[t * 136 + k]); else kk = kkv[i];
              const float e1 = __expf(fminf(fmaxf(b - bref, -80.0f), 80.0f)), r1 = __builtin_amdgcn_rcpf(e1), kr = kk * r1;
              if (OUT) { const float qr = bf2f(QM[t * 136 + k]); const float qv = GLA ? qr * 0.08838834764831845f : siluf_(qr);
                  QM[t * 136 + k] = f2bf(qv * e1); KM[t * 136 + k] = f2bf(kr); }
              ke[i] = kr * ebl; }
          if (OUT && seg == 0) EB[k] = __expf(bref);
          const int tb0 = dir ? 48 - seg * 16 : seg * 16; u32x4 w0, w1;
          if (dir) { w0.x = pk_bf16(ke[15], ke[14]); w0.y = pk_bf16(ke[13], ke[12]); w0.z = pk_bf16(ke[11], ke[10]); w0.w = pk_bf16(ke[9], ke[8]); w1.x = pk_bf16(ke[7], ke[6]); w1.y = pk_bf16(ke[5], ke[4]); w1.z = pk_bf16(ke[3], ke[2]); w1.w = pk_bf16(ke[1], ke[0]); }
          else     { w0.x = pk_bf16(ke[0], ke[1]); w0.y = pk_bf16(ke[2], ke[3]); w0.z = pk_bf16(ke[4], ke[5]); w0.w = pk_bf16(ke[6], ke[7]); w1.x = pk_bf16(ke[8], ke[9]); w1.y = pk_bf16(ke[10], ke[11]); w1.z = pk_bf16(ke[12], ke[13]); w1.w = pk_bf16(ke[14], ke[15]); }
          *(LAS u32x4*)(KE + k * 72 + tb0) = w0; *(LAS u32x4*)(KE + k * 72 + tb0 + 8) = w1;
          if (seg == 0) DD[k] = __expf(blast);
          dlog += blast; }
        LDS_BAR();
        bf16x8_t Bv[NB][2];
#pragma unroll
        for (int nb = 0; nb < NB; ++nb)
#pragma unroll
            for (int ks = 0; ks < 2; ++ks) Bv[nb][ks] = lds_frag16(lds + SL_VT + ((wave * 16 + fr) * 72 + ks * 32 + fq * 8) * 2);
        if (OUT) {
#ifdef REPMASK
          _Pragma("unroll 1") for (int rp2 = 0; rp2 < (((REPMASK) >> 25) & 1 ? 3 : 1); ++rp2) { if (rp2) LDS_BAR();
#else
          {
#endif
            { const int tb = wave >> 1;
#pragma unroll
              for (int sbi = 0; sbi < 2; ++sbi) { const int sb = (wave & 1) * 2 + sbi; f32x4 acc = {0.f, 0.f, 0.f, 0.f};
#pragma unroll
                  for (int ks = 0; ks < 4; ++ks) acc = __builtin_amdgcn_mfma_f32_16x16x32_bf16(lds_frag16(lds + SL_QM + ((tb * 16 + fr) * 136 + ks * 32 + fq * 8) * 2), lds_frag16(lds + SL_KM + ((sb * 16 + fr) * 136 + ks * 32 + fq * 8) * 2), acc, 0, 0, 0);
#pragma unroll
                  for (int j = 0; j < 4; ++j) { const int t = tb * 16 + fq * 4 + j, s = sb * 16 + fr; const bool keep = dir ? (s >= t) : (s <= t); PP[t * 72 + s] = keep ? f2bf(acc[j]) : (bf16)0; } } }
            LDS_BAR();
#pragma unroll
            for (int nb = 0; nb < NB; ++nb) {
                bf16x8_t Bs[4];
#pragma unroll
                for (int ks = 0; ks < 4; ++ks) { const f32x4 e0 = *(LAS f32x4*)(EB + (2 * ks) * 16 + fq * 4), e1 = *(LAS f32x4*)(EB + (2 * ks + 1) * 16 + fq * 4); Bs[ks] = pack_bf16x8(S[nb][2 * ks] * e0, S[nb][2 * ks + 1] * e1); }
#pragma unroll
                for (int mb = 0; mb < 4; ++mb) {
                    f32x4 O = {0.f, 0.f, 0.f, 0.f};
#pragma unroll
                    for (int ks = 0; ks < 2; ++ks) O = __builtin_amdgcn_mfma_f32_16x16x32_bf16(lds_frag16(lds + SL_PP + ((mb * 16 + fr) * 72 + ks * 32 + fq * 8) * 2), Bv[nb][ks], O, 0, 0, 0);
#pragma unroll
                    for (int ks = 0; ks < 4; ++ks) { u32x4 aw; const u32x2 lo = *(LAS u32x2*)(lds + SL_QM + ((mb * 16 + fr) * 136 + (2 * ks) * 16 + fq * 4) * 2), hi = *(LAS u32x2*)(lds + SL_QM + ((mb * 16 + fr) * 136 + (2 * ks + 1) * 16 + fq * 4) * 2);
                        aw.x = lo.x; aw.y = lo.y; aw.z = hi.x; aw.w = hi.y;
                        O = __builtin_amdgcn_mfma_f32_16x16x32_bf16(__builtin_bit_cast(bf16x8_t, aw), Bs[ks], O, 0, 0, 0); }
#pragma unroll
                    for (int j = 0; j < 4; ++j) Odir[(size_t)(r0 + mb * 16 + fq * 4 + j) * 1024 + head * DV + (nbase + nb) * 16 + fr] = f2bf(O[j]);
                    asm volatile("" ::: "memory");
                }
            }
          }
        }
        if (!OUT || cc < 3) {
#pragma unroll
            for (int mb = 0; mb < 8; ++mb) { const f32x4 dd = *(LAS f32x4*)(DD + mb * 16 + fq * 4);
                const bf16x8_t A0 = lds_frag16(lds + SL_KE + ((mb * 16 + fr) * 72 + fq * 8) * 2), A1 = lds_frag16(lds + SL_KE + ((mb * 16 + fr) * 72 + 32 + fq * 8) * 2);
#pragma unroll
                for (int nb = 0; nb < NB; ++nb) { S[nb][mb] = S[nb][mb] * dd; S[nb][mb] = __builtin_amdgcn_mfma_f32_16x16x32_bf16(A0, Bv[nb][0], S[nb][mb], 0, 0, 0); S[nb][mb] = __builtin_amdgcn_mfma_f32_16x16x32_bf16(A1, Bv[nb][1], S[nb][mb], 0, 0, 0); }
                asm volatile("" ::: "memory"); }
        }
        LDS_BAR();
    }
    if (!OUT) {
#pragma unroll
        for (int nb = 0; nb < NB; ++nb)
#pragma unroll
            for (int mb = 0; mb < 8; ++mb) *(f32x4*)(kvs + (size_t)((nbase + nb) * 16 + fr) * 128 + mb * 16 + fq * 4) = S[nb][mb];
        if (seg == 0) kd[k] = __expf(dlog);
    }
}
#undef SCAN_ISSUE
DI void scan_prop(const Args& a) {
    float* kvs = (float*)(wsp(a) + WS_KVS); const float* kd = (const float*)(wsp(a) + WS_KD);
    for (int g = obid() * NTHR + otid(); g < 131072; g += ogdim() * NTHR) {
        float* p; size_t stride; const float* dp;
        if (g < 65536) { const int stream = g >> 12, e = g & 4095; p = kvs + (size_t)stream * SC_N * 16384 + (size_t)e * 4; stride = 16384; dp = kd + (size_t)stream * SC_N * 128 + (e & 31) * 4; }
        else { const int q = g - 65536, stream = q >> 13, e = q & 8191; p = kvs + KVS_GL_OFF + (size_t)stream * SC_N * 32768 + (size_t)e * 4; stride = 32768; dp = kd + (size_t)(16 + stream) * SC_N * 128 + (e & 31) * 4; }
        f32x4 S = {0.f, 0.f, 0.f, 0.f};
#pragma unroll 5
        for (int sc = 0; sc < SC_N; ++sc) { const f32x4 kv = *(const f32x4*)(p + sc * stride), d = *(const f32x4*)(dp + sc * 128); *(f32x4*)(p + sc * stride) = S; S = d * S + kv; }
    }
}
constexpr int SCAN_ITEMS = 32 * SC_N;
template <bool OUT> DI void scan_item2(const Args& a, int l, int it, LAS unsigned char* lds) {
    if (it < 16 * SC_N) { const int s = it / SC_N, sc = it % SC_N; if (OUT && l == DEPTH - 1 && sc == 0) return; scan_walk<true, OUT>(a, l, s >> 2, (s >> 1) & 1, sc, s & 1, lds); }
    else { const int j = it - 16 * SC_N, s = j / SC_N, sc = j % SC_N; if (OUT && l == DEPTH - 1 && sc == 0) return; scan_walk<false, OUT>(a, l, s >> 1, s & 1, sc, 0, lds); }
}
DI void hyconv_item(const Args& a, int l, int c, LAS unsigned char* ldsb) {
    const int tid = otid();
    LAS float* lds = (LAS float*)ldsb;
    LAS float* xs = (LAS float*)(ldsb + LDS_X);
    const float* tw = (const float*)(wsp(a) + WS_TW); const float* tw2 = (const float*)(wsp(a) + WS_TW2);
    const float* h2 = (const float*)(wsp(a) + WS_H2) + (size_t)l * MT * 64;
    const bf16* VX = (const bf16*)(wsp(a) + WS_U) + (size_t)c * MT; bf16* VO = (bf16*)(wsp(a) + WS_CVO) + (size_t)c * MT;
#ifdef REPMASK
    _Pragma("unroll 1") for (int rpa = 0; rpa < (((REPMASK) >> 21) & 1 ? 2 : 1); ++rpa) { if (rpa) __syncthreads();
#else
    {
#endif
    const bf16* HFf = (const bf16*)(wsp(a) + WS_HF) + (size_t)c * SEQ; const bf16* HFb = HFf + (size_t)1024 * SEQ;
    const float a0 = -4.605170186f / 1.5f, a1 = -4.605170186f / 0.3f;
    const float nd = -fabsf(a0 + (float)c * ((a1 - a0) / 1023.0f)) * (1.0f / (float)(SEQ - 1));
    const float b3f = ain(a, I_HYB3)[l * 2048 + c], b3b = ain(a, I_HYB3)[l * 2048 + 1024 + c];
    float sf = 0.f, sb = 0.f;
#pragma unroll
    for (int i = 0; i < 8; ++i) { const int t4 = (tid + 512 * i) * 4; const u32x2 rf = *(const u32x2*)(HFf + t4), rb = *(const u32x2*)(HFb + t4);
        f32x4 hf, hb; hf[0] = bflo(rf.x); hf[1] = bfhi(rf.x); hf[2] = bflo(rf.y); hf[3] = bfhi(rf.y); hb[0] = bflo(rb.x); hb[1] = bfhi(rb.x); hb[2] = bflo(rb.y); hb[3] = bfhi(rb.y);
#pragma unroll
        for (int q = 0; q < 4; ++q) { const float dec = __expf(nd * (float)(t4 + q)) + 0.05f; hf[q] = (hf[q] + b3f) * dec; hb[q] = (hb[q] + b3b) * dec; }
        sf += (fabsf(hf[0]) + fabsf(hf[1])) + (fabsf(hf[2]) + fabsf(hf[3])); sb += (fabsf(hb[0]) + fabsf(hb[1])) + (fabsf(hb[2]) + fabsf(hb[3]));
        *(LAS f32x4*)(lds + t4) = hf;
#pragma unroll
        for (int q = 0; q < 4; ++q) { const int t = t4 + q; if (t > 0) lds[32768 - t] = hb[q]; else xs[160] = hb[q]; } }
    sf = wave_sum(sf); sb = wave_sum(sb);
    if ((tid & 63) == 0) { xs[128 + (tid >> 6)] = sf; xs[136 + (tid >> 6)] = sb; }
    __syncthreads();
    float tf = 0.f, tb = 0.f;
#pragma unroll
    for (int w = 0; w < 8; ++w) { tf += xs[128 + w]; tb += xs[136 + w]; }
    const float inf_ = 1.0f / tf, inb_ = 1.0f / tb;
#pragma unroll 8
    for (int i = 0; i < 64; ++i) { const int m = tid + 512 * i; float v = lds[m];
        if (m == 0) v = v * inf_ + xs[160] * inb_ + ain(a, I_HYSKIP)[l * 1024 + c];
        else if (m < SEQ) v *= inf_; else if (m == SEQ) v = 0.f; else v *= inb_;
        lds[m] = v; }
    __syncthreads();
    }
    { FftTw T; fft_load_tw(T, tw, tid);
    fft_fwd_pass<4096>(lds, T, tw, tid); LDS_BAR(); fft_fwd_pass<1024>(lds, T, tw, tid); LDS_BAR(); fft_fwd_pass<256>(lds, T, tw, tid); LDS_BAR(); fft_fwd_pass<64>(lds, T, tw, tid); LDS_BAR();
    fft_fwd_pass<16>(lds, T, tw, tid); LDS_BAR(); fft_fwd_pass<4>(lds, T, tw, tid); LDS_BAR(); fft_fwd_pass<1>(lds, T, tw, tid); LDS_BAR(); }
#ifdef REPMASK
    if (((REPMASK) >> 22) & 1) { FftTw T; fft_load_tw(T, tw, tid);
        fft_inv_pass<1>(lds, T, tw, tid); LDS_BAR(); fft_inv_pass<4>(lds, T, tw, tid); LDS_BAR(); fft_inv_pass<16>(lds, T, tw, tid); LDS_BAR(); fft_inv_pass<64>(lds, T, tw, tid); LDS_BAR();
        fft_inv_pass<256>(lds, T, tw, tid); LDS_BAR(); fft_inv_pass<1024>(lds, T, tw, tid); LDS_BAR(); fft_inv_pass<4096>(lds, T, tw, tid); LDS_BAR();
        for (int i = 0; i < 64; ++i) lds[tid + 512 * i] *= (1.0f / FFT_M);
        LDS_BAR();
        fft_fwd_pass<4096>(lds, T, tw, tid); LDS_BAR(); fft_fwd_pass<1024>(lds, T, tw, tid); LDS_BAR(); fft_fwd_pass<256>(lds, T, tw, tid); LDS_BAR(); fft_fwd_pass<64>(lds, T, tw, tid); LDS_BAR();
        fft_fwd_pass<16>(lds, T, tw, tid); LDS_BAR(); fft_fwd_pass<4>(lds, T, tw, tid); LDS_BAR(); fft_fwd_pass<1>(lds, T, tw, tid); LDS_BAR(); }
#endif

    float* Gs = (float*)(wsp(a) + WS_YMIX) + (size_t)obid() * 32768;
    const int kbase = ((tid & 63) << 7) | ((tid >> 6) << 4);
#ifdef REPMASK
    _Pragma("unroll 1") for (int rpc = 0; rpc < (((REPMASK) >> 23) & 1 ? 2 : 1); ++rpc)
#endif
#pragma unroll 4
    for (int j = 0; j < 16; ++j) { const int k = kbase | j; cpx gk, gm; rfft_untangle(lds, tw2, k, gk, gm); f32x4 g4; g4[0] = gk.x; g4[1] = gk.y; g4[2] = gm.x; g4[3] = gm.y; *(f32x4*)(Gs + (size_t)(j * 512 + tid) * 4) = g4; }
    __syncthreads();
#pragma unroll
    for (int i = 0; i < 16; ++i) { const int m4 = tid + 512 * i; f32x4 v = {0.f, 0.f, 0.f, 0.f}; if (m4 < SEQ / 4) { const u32x2 r = *(const u32x2*)(VX + m4 * 4); v[0] = bflo(r.x); v[1] = bfhi(r.x); v[2] = bflo(r.y); v[3] = bfhi(r.y); } *(LAS f32x4*)(lds + m4 * 4) = v; }
    __syncthreads();
    { FftTw T; fft_load_tw(T, tw, tid);
    fft_fwd_pass<4096>(lds, T, tw, tid); LDS_BAR(); fft_fwd_pass<1024>(lds, T, tw, tid); LDS_BAR(); fft_fwd_pass<256>(lds, T, tw, tid); LDS_BAR(); fft_fwd_pass<64>(lds, T, tw, tid); LDS_BAR();
    fft_fwd_pass<16>(lds, T, tw, tid); LDS_BAR(); fft_fwd_pass<4>(lds, T, tw, tid); LDS_BAR(); fft_fwd_pass<1>(lds, T, tw, tid); LDS_BAR(); }
#pragma unroll 4
    for (int j = 0; j < 16; ++j) { const int k = kbase | j; const f32x4 g4 = *(const f32x4*)(Gs + (size_t)(j * 512 + tid) * 4); cpx gk, gm; gk.x = g4[0]; gk.y = g4[1]; gm.x = g4[2]; gm.y = g4[3]; rfft_mul_retangle(lds, tw2, k, gk, gm); }
    __syncthreads();
    { FftTw T; fft_load_tw(T, tw, tid);
    fft_inv_pass<1>(lds, T, tw, tid); LDS_BAR(); fft_inv_pass<4>(lds, T, tw, tid); LDS_BAR(); fft_inv_pass<16>(lds, T, tw, tid); LDS_BAR(); fft_inv_pass<64>(lds, T, tw, tid); LDS_BAR();
    fft_inv_pass<256>(lds, T, tw, tid); LDS_BAR(); fft_inv_pass<1024>(lds, T, tw, tid); LDS_BAR(); fft_inv_pass<4096>(lds, T, tw, tid); LDS_BAR(); }
#pragma unroll
    for (int i = 0; i < 8; ++i) { const int m4 = tid + 512 * i; const f32x4 v = *(const LAS f32x4*)(lds + m4 * 4) * (1.0f / FFT_M); u32x2 o; o.x = pk_bf16(v[0], v[1]); o.y = pk_bf16(v[2], v[3]); *(u32x2*)(VO + m4 * 4) = o; }
    __syncthreads();
}
DI void hycctx_item(const Args& a, int l, int it, LAS unsigned char* ldsb) {
    const int tid = otid(), c0 = it * 4;
    LAS float* sv = (LAS float*)ldsb;
    LAS float* sf = sv + 4 * 256;
    LAS float* sb = sf + 4 * 256;
    const float* hyc = (const float*)(wsp(a) + WS_HYC); const bf16* VXT = (const bf16*)(wsp(a) + WS_U); bf16* CVO = (bf16*)(wsp(a) + WS_CVO);
    for (int i = tid; i < 4 * 256; i += NTHR) { const int ch = i >> 8, t = i & 255; sv[i] = bf2f(VXT[(size_t)(c0 + ch) * MT + SEQ + t]); sf[i] = hyc[(size_t)(c0 + ch) * 256 + t]; sb[i] = hyc[(size_t)(1024 + c0 + ch) * 256 + t]; }
    __syncthreads();
    const int ch = tid >> 7, tq = tid & 127; const float g0 = sf[ch * 256] + sb[ch * 256] + ain(a, I_HYSKIP)[l * 1024 + c0 + ch];
    float acc0 = 0.f, acc1 = 0.f; const int t0 = tq * 2;
    for (int s = 0; s < 256; ++s) { const float vv = sv[ch * 256 + s]; const int d0 = t0 - s, d1 = d0 + 1;
        const float ga = d0 > 0 ? sf[ch * 256 + d0] : (d0 < 0 ? sb[ch * 256 - d0] : g0), gb = d1 > 0 ? sf[ch * 256 + d1] : (d1 < 0 ? sb[ch * 256 - d1] : g0);
        acc0 += ga * vv; acc1 += gb * vv; }
    *(unsigned*)(CVO + (size_t)(c0 + ch) * MT + SEQ + t0) = pk_bf16(acc0, acc1);
    __syncthreads();
}

struct EpiHF {
    static constexpr bool PERM = true, AFTER_DRAIN = false; bf16* O;
    DI void operator()(const f32x4 (&acc)[2][2][4][2], const pg8::Unit& u, int wr, int wc, int fr, int fq) const {
        const int row0 = u.pm * 256 + wr * 64 + fr, col0 = u.pn * 256 + wc * 32 + 8 * fq;
#pragma unroll
        for (int ai = 0; ai < 2; ++ai)
#pragma unroll
            for (int m = 0; m < 4; ++m) { bf16* rowp = O + (size_t)(row0 + ai * 128 + m * 16) * SEQ + col0;
#pragma unroll
                for (int bj = 0; bj < 2; ++bj) { const f32x4 v0 = acc[ai][bj][m][0], v1 = acc[ai][bj][m][1];
                    u32x4 w; w.x = pk_bf16(v0[0], v0[1]); w.y = pk_bf16(v0[2], v0[3]); w.z = pk_bf16(v1[0], v1[1]); w.w = pk_bf16(v1[2], v1[3]);
                    *(u32x4*)(rowp + bj * 128) = w; } }
    }
};
struct EpiZ {
    static constexpr bool PERM = true, AFTER_DRAIN = false; bf16* O; const float* bias;
    DI void operator()(const f32x4 (&acc)[2][2][4][2], const pg8::Unit& u, int wr, int wc, int fr, int fq) const {
        const int row0 = u.pm * 256 + wr * 64 + fr, col0 = u.pn * 256 + wc * 32 + 8 * fq;
        f32x4 bv[2][2];
#pragma unroll
        for (int bj = 0; bj < 2; ++bj)
#pragma unroll
            for (int n = 0; n < 2; ++n) bv[bj][n] = *(const f32x4*)(bias + col0 + bj * 128 + 4 * n);
#pragma unroll
        for (int ai = 0; ai < 2; ++ai)
#pragma unroll
            for (int m = 0; m < 4; ++m) { bf16* rowp = O + (size_t)(row0 + ai * 128 + m * 16) * ZC + col0;
#pragma unroll
                for (int bj = 0; bj < 2; ++bj) { const f32x4 v0 = acc[ai][bj][m][0] + bv[bj][0], v1 = acc[ai][bj][m][1] + bv[bj][1];
                    u32x4 w; w.x = pk_bf16(v0[0], v0[1]); w.y = pk_bf16(v0[2], v0[3]); w.z = pk_bf16(v1[0], v1[1]); w.w = pk_bf16(v1[2], v1[3]);
                    *(u32x4*)(rowp + bj * 128) = w; } }
    }
};
template <int BR> struct EpiBr {
    static constexpr bool PERM = true, AFTER_DRAIN = false; bf16* Mg; const bf16* Zg;
    DI void operator()(const f32x4 (&acc)[2][2][4][2], const pg8::Unit& u, int wr, int wc, int fr, int fq) const {
        const int row0 = u.pm * 256 + wr * 64 + fr, col0 = u.pn * 256 + wc * 32 + 8 * fq;
#pragma unroll
        for (int ai = 0; ai < 2; ++ai)
#pragma unroll
            for (int m = 0; m < 4; ++m) { const size_t row = (size_t)(row0 + ai * 128 + m * 16);
#pragma unroll
                for (int bj = 0; bj < 2; ++bj) { const int col = col0 + bj * 128;
                    const u32x4 g = *(const u32x4*)(Zg + row * ZC + col);
                    f32x4 v0 = acc[ai][bj][m][0], v1 = acc[ai][bj][m][1];
                    v0[0] *= sigmoidf_(bflo(g.x)); v0[1] *= sigmoidf_(bfhi(g.x)); v0[2] *= sigmoidf_(bflo(g.y)); v0[3] *= sigmoidf_(bfhi(g.y));
                    v1[0] *= sigmoidf_(bflo(g.z)); v1[1] *= sigmoidf_(bfhi(g.z)); v1[2] *= sigmoidf_(bflo(g.w)); v1[3] *= sigmoidf_(bfhi(g.w));
                    if (BR > 0) { const u32x4 p = *(const u32x4*)(Mg + row * D + col);
                        v0[0] += bflo(p.x); v0[1] += bfhi(p.x); v0[2] += bflo(p.y); v0[3] += bfhi(p.y); v1[0] += bflo(p.z); v1[1] += bfhi(p.z); v1[2] += bflo(p.w); v1[3] += bfhi(p.w); }
                    u32x4 w; w.x = pk_bf16(v0[0], v0[1]); w.y = pk_bf16(v0[2], v0[3]); w.z = pk_bf16(v1[0], v1[1]); w.w = pk_bf16(v1[2], v1[3]);
                    *(u32x4*)(Mg + row * D + col) = w; } }
    }
};
struct EpiOut {
    static constexpr bool PERM = false, AFTER_DRAIN = false; const float* hin_main; const float* hin_ctx; float* hout; const float* gt1;
    DI void operator()(const f32x4 (&acc)[2][2][4][2], const pg8::Unit& u, int wr, int wc, int fr, int fq) const {
        const int row0 = u.pm * 256 + wr * 64 + fr, col0 = u.pn * 256 + wc * 32 + 4 * fq; const bool isctx = u.pm >= SEQ / 256;
        const float* g = gt1 + (isctx ? 12288 : 0);
        f32x4 gv[2][2];
#pragma unroll
        for (int bj = 0; bj < 2; ++bj)
#pragma unroll
            for (int n = 0; n < 2; ++n) gv[bj][n] = *(const f32x4*)(g + col0 + bj * 128 + n * 16);
#pragma unroll
        for (int ai = 0; ai < 2; ++ai)
#pragma unroll
            for (int m = 0; m < 4; ++m) { const int row = row0 + ai * 128 + m * 16;
                const float* ip = (isctx ? hin_ctx + (size_t)(row - SEQ) * D : hin_main + (size_t)row * D) + col0; float* op = hout + (size_t)row * D + col0;
#pragma unroll
                for (int bj = 0; bj < 2; ++bj)
#pragma unroll
                    for (int n = 0; n < 2; ++n) { const f32x4 b = *(const f32x4*)(ip + bj * 128 + n * 16); *(f32x4*)(op + bj * 128 + n * 16) = b + gv[bj][n] * acc[ai][bj][m][n]; } }
    }
};
struct EpiGU {
    static constexpr bool PERM = true, AFTER_DRAIN = false; bf16* Hm;
    DI void operator()(const f32x4 (&acc)[2][2][4][2], const pg8::Unit& u, int wr, int wc, int fr, int fq) const {
        const int row0 = u.pm * 256 + wr * 64 + fr, col0 = (u.pn & 3) * 128 + wc * 32 + 8 * fq;
#pragma unroll
        for (int ai = 0; ai < 2; ++ai)
#pragma unroll
            for (int m = 0; m < 4; ++m) { const f32x4 g0 = acc[ai][0][m][0], g1 = acc[ai][0][m][1], u0 = acc[ai][1][m][0], u1 = acc[ai][1][m][1];
                u32x4 w; w.x = pk_bf16(siluf_(g0[0]) * u0[0], siluf_(g0[1]) * u0[1]); w.y = pk_bf16(siluf_(g0[2]) * u0[2], siluf_(g0[3]) * u0[3]);
                w.z = pk_bf16(siluf_(g1[0]) * u1[0], siluf_(g1[1]) * u1[1]); w.w = pk_bf16(siluf_(g1[2]) * u1[2], siluf_(g1[3]) * u1[3]);
                *(u32x4*)(Hm + (size_t)(row0 + ai * 128 + m * 16) * DFF + col0) = w; }
    }
};
struct EpiDn {
    static constexpr bool PERM = true, AFTER_DRAIN = false; bf16* Y; const float* roww;
    DI void operator()(const f32x4 (&acc)[2][2][4][2], const pg8::Unit& u, int wr, int wc, int fr, int fq) const {
        const int row0 = u.pm * 256 + wr * 64 + fr, col0 = (u.pn & 7) * 256 + wc * 32 + 8 * fq;
#pragma unroll
        for (int ai = 0; ai < 2; ++ai)
#pragma unroll
            for (int m = 0; m < 4; ++m) { const int row = row0 + ai * 128 + m * 16; const float rw = roww[row];
#pragma unroll
                for (int bj = 0; bj < 2; ++bj) { const f32x4 v0 = acc[ai][bj][m][0] * rw, v1 = acc[ai][bj][m][1] * rw;
                    u32x4 w; w.x = pk_bf16(v0[0], v0[1]); w.y = pk_bf16(v0[2], v0[3]); w.z = pk_bf16(v1[0], v1[1]); w.w = pk_bf16(v1[2], v1[3]);
                    *(u32x4*)(Y + (size_t)row * D + col0 + bj * 128) = w; } }
    }
};
struct MoeOrder {
    const int* tile_e; int ntiles, nsub, G, c;
    DI bool next(int i, pg8::Unit& u) const { const int j = i * G + c; if (j >= ntiles * nsub) return false; const int ti = j / nsub; u.pm = ti; u.pn = tile_e[ti] * nsub + (j - ti * nsub); return true; }
    DI void a_ready(const pg8::Unit&) const {}
    DI void done(const pg8::Unit&) const {}
};
constexpr int NPH_LAYER = 13, PH_FINAL = 1 + NPH_LAYER * DEPTH, NPHASES = PH_FINAL + 1;
struct KArgs { Args a; int li, pad; };
__global__ void __launch_bounds__(NTHR, 2) fwd_kernel(KArgs ka) {
    const Args& a = ka.a;
    const int tid = otid();
#define bid ((int)obid())
#define G ((int)ogdim())
    if (tid == 0) { ((LAS unsigned*)(ldsbase() + LDS_BARW))[0] = 0u; ((LAS unsigned*)(ldsbase() + LDS_BARW))[1] = 0u;
        LAS unsigned long long* ptab = (LAS unsigned long long*)(ldsbase() + LDS_PTAB);
#pragma unroll
        for (int i = 0; i < N_IN; ++i) ptab[i] = (unsigned long long)ka.a.in[i]; }
    __syncthreads();
#ifdef PROBE_SEL
    if (tid < 64) ((LAS unsigned long long*)(ldsbase() + LDS_TIM))[tid] = 0ull;
    __syncthreads();
    const unsigned long long tkern_ = __builtin_amdgcn_s_memrealtime();
#endif
    XcdBarrier bar = xcd_barrier_post((unsigned*)(wsp(a) + WS_CTL) + CW_BAR + ka.li * XCD_BAR_WORDS, (volatile LAS unsigned*)(ldsbase() + LDS_BARW));
    const int lo = a.ph_lo, hi = a.ph_hi;
#ifndef PHMASK
#define PHMASK 0xFFFF
#endif
#define EN(i) (((PHMASK) >> (i)) & 1)
#ifndef REPMASK
#define REPMASK 0
#endif
#define REP(i) (((REPMASK) >> (i)) & 1)
#define RUN(i, cond, ...) do { _Pragma("unroll 1") for (int rep_ = 0; rep_ < ((REP(i) && (cond)) ? REPN : 1); ++rep_) { if (rep_) __syncthreads(); __VA_ARGS__; } } while (0)
#ifndef REPN
#define REPN 2
#endif
#define IN(k) (opq(lo) <= (k) && (k) < opq(hi))
#define SEAM(k) do { if (IN(k) && IN((k) + 1)) { TIC(); xcd_barrier(bar); TOC(30); } } while (0)
#define ws wsp(a)
#define lds ldsbase()
#define ldsf ((LAS float*)ldsbase())
#define U ((bf16*)(wsp(a) + WS_U))
#define Z ((bf16*)(wsp(a) + WS_Z))
#define H ((float*)(wsp(a) + WS_H))
#define modall ((const float*)(wsp(a) + WS_MOD))

    { TIC();
    if (EN(0) && IN(0)) {
        RUN(0, true, prologue_small(a);
        for (int it = bid; it < 256; it += G) mod_item(a, it, ldsf);
        for (int it = bid; it < DEPTH * (MT / 8); it += G) h2_item(a, it, ldsf));
    }
    TOC(31); } SEAM(0);
    for (int l = 0; l < DEPTH; ++l) {
        const int pb = 1 + NPH_LAYER * l;
        const int nrows = (l == 0) ? MT : SEQ;
        { TIC();
        if (EN(1) && IN(pb + 0)) {
            RUN(1, l == 0, norm_phase<0>(a, l, MT, ldsf));
            RUN(16, true, if (l == 0) hyc_filters(a, 0));
            RUN(2, true, for (int it = bid; it < CVT_MIX_TILES; it += G) cvt_mix_item(a, l, it, ldsf));
        }
        TOC(1); } SEAM(pb + 0); { TIC();
        if (EN(2) && IN(pb + 1)) {
            pg8::Gemm g{U, (const bf16*)(ws + WS_WIN), MT, ZC, D}; pg8::StaticOrder S; S.init(MT, ZC, G, bid);
            EpiZ E{Z, (const float*)(ws + WS_ZBIAS) + (size_t)l * ZC};
            RUN(3, true, pg8::gemm_phase<EpiZ, pg8::StaticOrder, true, true>(lds, g, S, E));
        }
        TOC(2); } SEAM(pb + 1); { TIC();
        if (EN(3) && IN(pb + 2)) { const int nit = (nrows / 64) * 16; RUN(4, true, for (int it = bid; it < nit; it += G) hyprep_item(a, l, it, ldsf));
            __syncthreads();
            pg8::Gemm g{(const bf16*)(ws + WS_W3T) + (size_t)l * 2048 * 256, (const bf16*)(ws + WS_H2B) + (size_t)l * SEQ * 256, 2048, SEQ, opq(256)  }; pg8::StaticOrder S; S.init(2048, SEQ, G, bid);
            EpiHF E{(bf16*)(ws + WS_HF)};
            RUN(18, true, pg8::gemm_phase<EpiHF, pg8::StaticOrder, true, true>(lds, g, S, E)); }
        TOC(3); } SEAM(pb + 2); { TIC();
        if (EN(4) && IN(pb + 3)) {
            RUN(5, true, for (int it = bid; it < SCAN_ITEMS; it += G) scan_item2<false>(a, l, it, lds));
            RUN(6, true, for (int c = bid; c < 1024; c += G) hyconv_item(a, l, c, lds));
            RUN(15, true, if (l == 0) for (int it = bid; it < 256; it += G) hycctx_item(a, l, it, lds));
        }
        TOC(4); } SEAM(pb + 3); { TIC();
        if (EN(13) && IN(pb + 4)) { scan_prop(a); if (REP(20)) { __syncthreads(); scan_prop(a); scan_prop(a); } }
        TOC(5); } SEAM(pb + 4); { TIC();
        if (EN(14) && IN(pb + 5)) { RUN(17, true, for (int it = bid; it < SCAN_ITEMS; it += G) scan_item2<true>(a, l, it, lds)); }
        TOC(6); } SEAM(pb + 5); { TIC();
        if (EN(5) && IN(pb + 6)) {
            const int nit = (nrows / 64) * 16;
            RUN(7, true, scancomb_rows(a, l, nrows); for (int it = bid; it < nit; it += G) hycomb_item(a, l, it, ldsf));
        }
        TOC(7); } SEAM(pb + 6); { TIC();
        if (EN(6) && IN(pb + 7)) {
            const bf16* Y = (const bf16*)(ws + WS_YMIX); const bf16* WB = (const bf16*)(ws + WS_WBR);
            pg8::StaticOrder S; S.init(nrows, D, G, bid);
            RUN(8, true,
            { pg8::Gemm g{Y, WB, nrows, D, 1024}; EpiBr<0> E{U, Z + Z_MG}; pg8::gemm_phase<EpiBr<0>, pg8::StaticOrder, true, true>(lds, g, S, E); }
            __syncthreads();
            { pg8::Gemm g{Y + (size_t)MT * 1024, WB + (size_t)D * 1024, nrows, D, 1024}; EpiBr<1> E{U, Z + Z_MG + D}; pg8::gemm_phase<EpiBr<1>, pg8::StaticOrder, true, true>(lds, g, S, E); }
            __syncthreads();
            { pg8::Gemm g{Y + (size_t)2 * MT * 1024, WB + (size_t)2 * D * 1024, nrows, D, 1024}; EpiBr<2> E{U, Z + Z_MG + 2 * D}; pg8::gemm_phase<EpiBr<2>, pg8::StaticOrder, true, true>(lds, g, S, E); });
        }
        TOC(8); } SEAM(pb + 7); { TIC();
        if (EN(7) && IN(pb + 8)) {
            pg8::Gemm g{U, (const bf16*)(ws + WS_WOUT), nrows, D, D}; pg8::StaticOrder S; S.init(nrows, D, G, bid);
            EpiOut E{l == 0 ? ain(a, I_X) : H, l == 0 ? ain(a, I_CTX) : H + (size_t)SEQ * D, H, modall + (size_t)l * 2 * 12288 + 4096};
            RUN(9, l == 0, pg8::gemm_phase<EpiOut, pg8::StaticOrder, true, true>(lds, g, S, E));
        }
        TOC(9); } SEAM(pb + 8); { TIC();
        if (EN(8) && IN(pb + 9)) {
            route_phase<false>(a, l, nrows, ldsf);
            __syncthreads();
            if (REP(19)) { route_phase<true>(a, l, nrows, ldsf); __syncthreads(); }
            RUN(10, true, for (int it = bid; it < CVT_MOE_TILES; it += G) cvt_moe_item(a, l, it, ldsf));
        }
        TOC(10); } SEAM(pb + 9); { TIC();
        if (EN(9) && IN(pb + 10)) { RUN(11, true, permute_phase(a, l, nrows, lds)); }
        TOC(11); } SEAM(pb + 10); { TIC();
        if (EN(10) && IN(pb + 11)) {
            const int* tile_e = (const int*)(ws + WS_TILEE); const int ntiles = tile_e[200];
            pg8::Gemm g{(const bf16*)(ws + WS_XP), (const bf16*)(ws + WS_WGU), MOE_MAXROWS, NEXP * 1024, D}; MoeOrder S{tile_e, ntiles, 4, G, bid};
            EpiGU E{(bf16*)(ws + WS_HMID)};
            RUN(12, true, pg8::gemm_phase<EpiGU, MoeOrder, true, true>(lds, g, S, E));
        }
        TOC(12); } SEAM(pb + 11); { TIC();
        if (EN(11) && IN(pb + 12)) {
            const int* tile_e = (const int*)(ws + WS_TILEE); const int ntiles = tile_e[200];
            pg8::Gemm g{(const bf16*)(ws + WS_HMID), (const bf16*)(ws + WS_WD), MOE_MAXROWS, NEXP * D, DFF}; MoeOrder S{tile_e, ntiles, 8, G, bid};
            EpiDn E{(bf16*)(ws + WS_YP), (const float*)(ws + WS_ROWW)};
            RUN(13, true, pg8::gemm_phase<EpiDn, MoeOrder, true, true>(lds, g, S, E));
        }
        TOC(13); } SEAM(pb + 12); { TIC();
        (void)0; }
    }
#ifdef PROBE_SEL
    if (tid == 0) ((LAS unsigned long long*)(ldsbase() + LDS_TIM))[0] = __builtin_amdgcn_s_memrealtime() - tkern_;
    __syncthreads();
#endif
    if (EN(12) && IN(PH_FINAL)) norm_phase<2>(a, DEPTH, SEQ, ldsf);
#undef IN
#undef SEAM
#undef ws
#undef bid
#undef G
#undef lds
#undef ldsf
#undef U
#undef Z
#undef H
#undef modall
}

#ifndef MK_SINGLE
#define MK_SINGLE 1
#endif
extern "C" void kernel_launch(void* const* d_in, const int* in_sizes, int n_in, void* d_out, int out_size, void* d_ws, size_t ws_size, hipStream_t stream) {
    static int grid = 0;
    if (grid == 0) {
        if (n_in != N_IN || out_size != SEQ * D || ws_size < WS_END) { fprintf(stderr, "kernel_launch: unexpected problem shape (n_in %d, out %d, ws %zu < %zu)\n", n_in, out_size, ws_size, (size_t)WS_END); grid = -1; return; }
        int dev = 0, cus = 0;
        if (hipGetDevice(&dev) != hipSuccess || hipDeviceGetAttribute(&cus, hipDeviceAttributeMultiprocessorCount, dev) != hipSuccess) { grid = -1; return; }
        if (hipFuncSetAttribute((const void*)fwd_kernel, hipFuncAttributeMaxDynamicSharedMemorySize, LDS_BYTES) != hipSuccess) { fprintf(stderr, "kernel_launch: hipFuncSetAttribute failed\n"); grid = -1; return; }
        int per_cu = 0;
        if (hipOccupancyMaxActiveBlocksPerMultiprocessor(&per_cu, (const void*)fwd_kernel, NTHR, LDS_BYTES) != hipSuccess || per_cu < 1) fprintf(stderr, "kernel_launch: occupancy query says %d\n", per_cu);
        (void)hipGetLastError();
        grid = cus;
    }
    if (grid < 0) return;
    (void)hipMemsetAsync((char*)d_ws + WS_CTL, 0, CTL_BYTES, stream);
    KArgs ka{};
    for (int i = 0; i < N_IN; ++i) ka.a.in[i] = (const float*)d_in[i];
    ka.a.out = (float*)d_out; ka.a.ws = (unsigned char*)d_ws;
#if MK_SINGLE
    ka.a.ph_lo = 0; ka.a.ph_hi = NPHASES; ka.li = 0; ka.pad = 0;
    hipLaunchKernelGGL(fwd_kernel, dim3(grid), dim3(NTHR), LDS_BYTES, stream, ka);
#else
    for (int ph = 0; ph < NPHASES; ++ph) { ka.a.ph_lo = ph; ka.a.ph_hi = ph + 1; ka.li = 0; ka.pad = 0; hipLaunchKernelGGL(fwd_kernel, dim3(grid), dim3(NTHR), LDS_BYTES, stream, ka); }
#endif
}
```

```cpp
#include <hip/hip_runtime.h>
#include <cstdio>
#include <cstdint>
#define DI __device__ __forceinline__
#define LAS __attribute__((address_space(3)))
typedef unsigned short bf16;
typedef float f32x4 __attribute__((ext_vector_type(4)));
typedef unsigned u32x4 __attribute__((ext_vector_type(4)));
typedef unsigned u32x2 __attribute__((ext_vector_type(2)));

constexpr int D = 2048, SEQ = 16384, CTXL = 256, MT = SEQ + CTXL  , DEPTH = 2;
constexpr int NCOLS_IN = 17440;
constexpr int ZC = 17664;
constexpr int Z_HG = 0, Z_GL = 5120, Z_HY = 8192, Z_MG = 11264, Z_LR = 17408;
constexpr int NEXP = 32, DFF = 512, MOE_MAXROWS = 41472;
constexpr float NORM_EPS = 1e-6f;

constexpr size_t MiB = 1u << 20;
constexpr size_t WS_CTL = 0, CTL_BYTES = 1 * MiB;
constexpr size_t WS_SMALL = 1 * MiB;
constexpr size_t WS_MOD   = WS_SMALL;
constexpr size_t WS_ZBIAS = WS_MOD + (size_t)DEPTH * 2 * 12288 * 4;
constexpr size_t WS_LB    = WS_ZBIAS + (size_t)DEPTH * ZC * 4;
constexpr size_t WS_TW    = WS_LB + (size_t)DEPTH * 2 * 1024 * 4;
constexpr size_t WS_TW2   = WS_TW + 16384 * 8;
constexpr size_t WS_H2    = WS_TW2 + (8192 + 64) * 8;
constexpr size_t WS_ROUTE = WS_H2 + (size_t)DEPTH * MT * 64 * 4;
constexpr size_t WS_ROWW  = WS_ROUTE + (size_t)MT * 8 * 4;
constexpr size_t WS_TILEE = WS_ROWW + (size_t)MOE_MAXROWS * 4;
constexpr size_t WS_HYC   = WS_TILEE + 1024;
constexpr size_t WS_W3T   = WS_HYC + (size_t)2048 * 256 * 4;
constexpr size_t WS_H2B   = WS_W3T + (size_t)DEPTH * 2048 * 256 * 2;
constexpr size_t WS_WRT   = WS_H2B + (size_t)DEPTH * SEQ * 256 * 2;
constexpr size_t WS_SMALL_END = WS_WRT + (size_t)DEPTH * 2 * 48 * 2048 * 2;
static_assert(WS_SMALL_END <= 40 * MiB, "small tables");
constexpr size_t WS_WIN  = 40 * MiB;
constexpr size_t WS_WBR  = 109 * MiB;
constexpr size_t WS_WOUT = 121 * MiB;
constexpr size_t WS_WGU  = 129 * MiB;
constexpr size_t WS_CVO  = WS_WIN;
constexpr size_t WS_WD   = 257 * MiB;
constexpr size_t WS_H    = 321 * MiB;
constexpr size_t WS_U    = 451 * MiB;
constexpr size_t WS_Z    = 516 * MiB;
constexpr size_t WS_XP   = WS_Z;
constexpr size_t WS_HMID = WS_Z + 162 * MiB;
constexpr size_t WS_YP   = WS_Z + 203 * MiB;
constexpr size_t WS_YMIX = 1077 * MiB;
constexpr size_t WS_HF   = 1175 * MiB;
constexpr size_t WS_OSC  = 1175 * MiB;
constexpr size_t WS_END  = 1435 * MiB;
static_assert(WS_WIN + (size_t)ZC * D * 2 <= WS_WBR && WS_Z + (size_t)MT * ZC * 2 <= WS_YMIX && WS_YMIX + (size_t)3 * MT * 1024 * 2 <= WS_OSC && WS_OSC + (size_t)4 * MT * 1024 * 4 <= WS_END, "ws map");
static_assert(WS_YP + (size_t)MOE_MAXROWS * D * 2 <= WS_YMIX && WS_H + (size_t)MT * D * 4 <= WS_U && WS_U + (size_t)MT * D * 2 <= WS_Z, "ws map 2");
constexpr int CW_BAR = 4096;
constexpr int CW_CNT = 16384;

DI float bf2f(bf16 v) { return __uint_as_float(((unsigned)v) << 16); }
DI float bflo(unsigned w) { return __uint_as_float(w << 16); }
DI float bfhi(unsigned w) { return __uint_as_float(w & 0xffff0000u); }
typedef float f32x2_t __attribute__((ext_vector_type(2))); typedef __bf16 bf16x2_t __attribute__((ext_vector_type(2)));
DI unsigned pk_bf16(float lo, float hi) { f32x2_t v = {lo, hi}; bf16x2_t b = __builtin_convertvector(v, bf16x2_t); return __builtin_bit_cast(unsigned, b); }
DI bf16 f2bf(float f) { return (bf16)(pk_bf16(f, 0.f) & 0xffffu); }
DI float sigmoidf_(float x) { return __builtin_amdgcn_rcpf(1.0f + __expf(-x)); }
DI float siluf_(float x) { return x * __builtin_amdgcn_rcpf(1.0f + __expf(-x)); }
DI float wave_sum(float v) {
#pragma unroll
    for (int o = 32; o >= 1; o >>= 1) v += __shfl_xor(v, o);
    return v;
}
DI int otid() { int t = __builtin_amdgcn_workitem_id_x(); asm volatile("" : "+v"(t)); return t; }
DI int ogdim() { int g = __builtin_amdgcn_workgroup_id_x(); g = (int)gridDim.x; asm volatile("" : "+s"(g)); return g; }
DI int obid() { int b = __builtin_amdgcn_workgroup_id_x(); asm volatile("" : "+s"(b)); return b; }
#define AIN_DECL 1
DI LAS f32x2_t* fft_vec2_(LAS float* p) { return (LAS f32x2_t*)p; }
DI const f32x2_t* fft_vec2_(const float* p) { return (const f32x2_t*)p; }
DI f32x2_t* fft_vec2_(float* p) { return (f32x2_t*)p; }
namespace pg8 {
#define PG8_LAS __attribute__((address_space(3)))
typedef unsigned short bf16_t;
typedef short bf16x8 __attribute__((ext_vector_type(8)));
typedef float f32x4 __attribute__((ext_vector_type(4)));
typedef unsigned u32x4 __attribute__((ext_vector_type(4)));
constexpr int BM = 256, BK = 64, HALF = 128, HTB = HALF * BK * 2  , STAGE_BYTES = 8 * HTB, NXCD = 8, WGM = 8;

__host__ __device__ __forceinline__ int lds_byte(int r, int c) { const int st = (r >> 4) * 2 + (c >> 5), rr = r & 15, cc = c & 31, ob = rr * 64 + cc * 2; return st * 1024 + (ob ^ (((ob >> 9) & 1) << 5)); }
__host__ __device__ __forceinline__ void stage_rc(int b, int& R, int& C) { const int st = b / 1024, sb = b % 1024, swz = sb ^ (((sb >> 9) & 1) << 5); R = (st >> 1) * 16 + swz / 64; C = (st & 1) * 32 + (swz % 64) / 2; }
__host__ __device__ __forceinline__ int perm32(int rho) { const int n = rho >> 4, i = rho & 15; return 8 * (i >> 2) + 4 * n + (i & 3); }

struct Unit { int pm, pn; };
struct Gemm { const bf16_t* A; const bf16_t* Bt; int M, N, K; };

struct StaticOrder {
    int nM, nN, nwg, G, c;
    __host__ __device__ void init(int M, int N, int G_, int c_) { nM = M / BM; nN = N / BM; nwg = nM * nN; G = G_; c = c_; }
    __host__ __device__ bool next(int i, Unit& u) const {
        const long L = (long)i * G + c; if (L >= nwg) return false;
        int wgid = (int)L; { const int q = nwg / NXCD, r = nwg % NXCD, xcd = wgid % NXCD, off = wgid / NXCD; wgid = (xcd < r ? xcd * (q + 1) : r * (q + 1) + (xcd - r) * q) + off; }
        const int nig = WGM * nN, gid = wgid / nig, fm = gid * WGM, gsz = (nM - fm) < WGM ? (nM - fm) : WGM;
        u.pm = fm + ((wgid % nig) % gsz); u.pn = (wgid % nig) / gsz; return true;
    }
    __device__ __forceinline__ void a_ready(const Unit&) const {}
    __device__ __forceinline__ void done(const Unit&) const {}
};

template <class Epi, class Sched, bool ALIGN_EPI = false, bool SP2 = false>
__device__ __forceinline__ void gemm_phase(PG8_LAS unsigned char* lds, const Gemm g, const Sched& S, const Epi& E) {
    const int tid = otid(), wid = __builtin_amdgcn_readfirstlane(tid >> 6), lane = tid & 63, wr = wid >> 2, wc = wid & 3, fr = lane & 15, fq = lane >> 4;
    const int K = g.K, nt = K / BK;
    unsigned voffA[2], voffB[2];
#pragma unroll
    for (int i = 0; i < 2; ++i) { int R, C; stage_rc(tid * 16 + i * 8192, R, C); const int Rb = Epi::PERM ? ((R & ~31) + perm32(R & 31)) : R;
        voffA[i] = (unsigned)(R * K + C) * 2u; voffB[i] = (unsigned)(Rb * K + C) * 2u; }
    const size_t kstep = (size_t)(BK * 2);
    const size_t hstep = (size_t)HALF * K * 2;
    const size_t tstep = 2 * hstep;
    const unsigned ldsw = (unsigned)wid * 1024u;
    const int aoff = lds_byte(wr * 64 + fr, fq * 8), boff = lds_byte(wc * 32 + fr, fq * 8);
#define PG8_SA(b, h) (((b) * 2 + (h)) * HTB)
#define PG8_SB(b, h) ((4 + (b) * 2 + (h)) * HTB)
#define PG8_STAGE(bufoff, gbase, voff) do { _Pragma("unroll") for (int _i = 0; _i < 2; ++_i) \
        __builtin_amdgcn_global_load_lds((const unsigned*)((const char*)(gbase) + (voff)[_i]), (PG8_LAS unsigned*)(lds + (bufoff) + ldsw + _i * 8192), 16, 0, 0); } while (0)
#define PG8_LDA(dst, b, h) do { _Pragma("unroll") for (int m = 0; m < 4; ++m) _Pragma("unroll") for (int k = 0; k < 2; ++k) dst[m][k] = *(const PG8_LAS bf16x8*)(lds + PG8_SA(b, h) + aoff + m * 2048 + k * 1024); } while (0)
#define PG8_LDB(dst, b, h) do { _Pragma("unroll") for (int n = 0; n < 2; ++n) _Pragma("unroll") for (int k = 0; k < 2; ++k) dst[n][k] = *(const PG8_LAS bf16x8*)(lds + PG8_SB(b, h) + boff + n * 2048 + k * 1024); } while (0)
#define PG8_MMA(ai, bj, At, Bt) do { __builtin_amdgcn_s_setprio(1); _Pragma("unroll") for (int m = 0; m < 4; ++m) _Pragma("unroll") for (int n = 0; n < 2; ++n) _Pragma("unroll") for (int k = 0; k < 2; ++k) \
        acc[ai][bj][m][n] = __builtin_amdgcn_mfma_f32_16x16x32_bf16(Bt[n][k], At[m][k], acc[ai][bj][m][n], 0, 0, 0); __builtin_amdgcn_s_setprio(0); } while (0)
#define PG8_WAIT_V(n) asm volatile("s_waitcnt vmcnt(" #n ")" ::: "memory")
#define PG8_WAIT_L(n) asm volatile("s_waitcnt lgkmcnt(" #n ")" ::: "memory")
#define PG8_BAR __builtin_amdgcn_s_barrier()
#define PG8_SCHED __builtin_amdgcn_sched_barrier(0)
    Unit cur, nxt; int ui = 0;
    if (!S.next(0, cur)) return;
    f32x4 acc[2][2][4][2];
#pragma unroll
    for (int a = 0; a < 2; ++a)
#pragma unroll
        for (int b = 0; b < 2; ++b)
#pragma unroll
            for (int m = 0; m < 4; ++m)
#pragma unroll
                for (int n = 0; n < 2; ++n) acc[a][b][m][n] = (f32x4){0.f, 0.f, 0.f, 0.f};
    bf16x8 At[4][2], B0[2][2], B1[2][2];
    const char* cA = (const char*)g.A + (size_t)cur.pm * tstep; const char* cB = (const char*)g.Bt + (size_t)cur.pn * tstep;
    S.a_ready(cur);
    if constexpr (SP2) {
        PG8_STAGE(PG8_SB(0, 0), cB, voffB); PG8_STAGE(PG8_SB(0, 1), cB + hstep, voffB); PG8_STAGE(PG8_SA(0, 0), cA, voffA); PG8_STAGE(PG8_SA(0, 1), cA + hstep, voffA);
        if (wr == 1) PG8_BAR;
        PG8_WAIT_V(2); PG8_BAR;
        PG8_STAGE(PG8_SB(1, 0), cB + kstep, voffB); PG8_STAGE(PG8_SA(1, 0), cA + kstep, voffA); PG8_STAGE(PG8_SB(1, 1), cB + hstep + kstep, voffB);
        PG8_WAIT_V(6); PG8_BAR;
    } else {
        PG8_STAGE(PG8_SB(0, 0), cB, voffB); PG8_STAGE(PG8_SA(0, 0), cA, voffA); PG8_STAGE(PG8_SB(0, 1), cB + hstep, voffB); PG8_STAGE(PG8_SA(0, 1), cA + hstep, voffA);
        if (wr == 1) PG8_BAR;
        PG8_WAIT_V(4); PG8_BAR;
        PG8_STAGE(PG8_SB(1, 0), cB + kstep, voffB); PG8_STAGE(PG8_SA(1, 0), cA + kstep, voffA); PG8_STAGE(PG8_SB(1, 1), cB + hstep + kstep, voffB);
        PG8_WAIT_V(6); PG8_BAR;
    }
    for (;;) {
        const bool has_next = S.next(ui + 1, nxt);
        const char* nA = has_next ? (const char*)g.A + (size_t)nxt.pm * tstep : cA; const char* nB = has_next ? (const char*)g.Bt + (size_t)nxt.pn * tstep : cB;
        for (int t = 0; t < nt; t += 2) {
            const bool last = (t == nt - 2);
            const char* a1 = cA + (size_t)(t + 1) * kstep;
            const char* a2 = last ? nA : cA + (size_t)(t + 2) * kstep; const char* b2 = last ? nB : cB + (size_t)(t + 2) * kstep;
            const char* a3 = a2 + kstep; const char* b3 = b2 + kstep;
            if (last && has_next) S.a_ready(nxt);
            if constexpr (SP2) {
            PG8_LDB(B0, 0, 0); PG8_LDB(B1, 0, 1); PG8_SCHED; PG8_LDA(At, 0, 0); PG8_STAGE(PG8_SA(1, 1), a1 + hstep, voffA);
            PG8_WAIT_V(8); PG8_WAIT_L(0); PG8_BAR; PG8_MMA(0, 0, At, B0); PG8_MMA(0, 1, At, B1); PG8_BAR; PG8_SCHED;
            PG8_LDA(At, 0, 1); PG8_STAGE(PG8_SB(0, 0), b2, voffB); PG8_STAGE(PG8_SB(0, 1), b2 + hstep, voffB); PG8_STAGE(PG8_SA(0, 0), a2, voffA);
            PG8_WAIT_V(8); PG8_WAIT_L(0); PG8_BAR; PG8_MMA(1, 0, At, B0); PG8_MMA(1, 1, At, B1); PG8_BAR; PG8_SCHED;
            PG8_LDB(B0, 1, 0); PG8_LDB(B1, 1, 1); PG8_SCHED; PG8_LDA(At, 1, 0); PG8_STAGE(PG8_SA(0, 1), a2 + hstep, voffA);
            PG8_WAIT_V(8); PG8_WAIT_L(0); PG8_BAR; PG8_MMA(0, 0, At, B0); PG8_MMA(0, 1, At, B1); PG8_BAR; PG8_SCHED;
            PG8_LDA(At, 1, 1); PG8_STAGE(PG8_SB(1, 0), b3, voffB); PG8_STAGE(PG8_SB(1, 1), b3 + hstep, voffB); PG8_STAGE(PG8_SA(1, 0), a3, voffA);
            PG8_WAIT_V(8); PG8_WAIT_L(0); PG8_BAR; PG8_MMA(1, 0, At, B0); PG8_MMA(1, 1, At, B1); PG8_BAR; PG8_SCHED;
            } else {
            PG8_LDB(B0, 0, 0); PG8_SCHED; PG8_LDA(At, 0, 0); PG8_STAGE(PG8_SA(1, 1), a1 + hstep, voffA);
            PG8_WAIT_L(8); PG8_BAR; PG8_WAIT_L(0); PG8_MMA(0, 0, At, B0); PG8_BAR; PG8_SCHED;
            PG8_LDB(B1, 0, 1); PG8_STAGE(PG8_SB(0, 0), b2, voffB);
            PG8_BAR; PG8_WAIT_L(0); PG8_MMA(0, 1, At, B1); PG8_BAR;
            PG8_LDA(At, 0, 1); PG8_STAGE(PG8_SA(0, 0), a2, voffA);
            PG8_BAR; PG8_WAIT_L(0); PG8_MMA(1, 0, At, B0); PG8_BAR; PG8_SCHED;
            PG8_STAGE(PG8_SB(0, 1), b2 + hstep, voffB);
            PG8_WAIT_V(6); PG8_BAR; PG8_MMA(1, 1, At, B1); PG8_BAR;
            PG8_LDB(B0, 1, 0); PG8_SCHED; PG8_LDA(At, 1, 0); PG8_STAGE(PG8_SA(0, 1), a2 + hstep, voffA);
            PG8_WAIT_L(8); PG8_BAR; PG8_WAIT_L(0); PG8_MMA(0, 0, At, B0); PG8_BAR; PG8_SCHED;
            PG8_LDB(B1, 1, 1); PG8_STAGE(PG8_SB(1, 0), b3, voffB);
            PG8_BAR; PG8_WAIT_L(0); PG8_MMA(0, 1, At, B1); PG8_BAR;
            PG8_LDA(At, 1, 1); PG8_STAGE(PG8_SA(1, 0), a3, voffA);
            PG8_BAR; PG8_WAIT_L(0); PG8_MMA(1, 0, At, B0); PG8_BAR; PG8_SCHED;
            PG8_STAGE(PG8_SB(1, 1), b3 + hstep, voffB);
            PG8_WAIT_V(6); PG8_BAR; PG8_MMA(1, 1, At, B1); PG8_BAR;
            }
        }
        if constexpr (ALIGN_EPI) { if (wr == 0) PG8_BAR; }
        if constexpr (!Epi::AFTER_DRAIN) { E(acc, cur, wr, wc, fr, fq); S.done(cur); }
        if (!has_next) break;
#pragma unroll
        for (int a = 0; a < 2; ++a)
#pragma unroll
            for (int b = 0; b < 2; ++b)
#pragma unroll
                for (int m = 0; m < 4; ++m)
#pragma unroll
                    for (int n = 0; n < 2; ++n) acc[a][b][m][n] = (f32x4){0.f, 0.f, 0.f, 0.f};
        cur = nxt; cA = nA; cB = nB; ++ui;
        if constexpr (ALIGN_EPI) { if (wr == 1) PG8_BAR; }
    }
    PG8_WAIT_V(0);
    if constexpr (!ALIGN_EPI) { if (wr == 0) PG8_BAR; }
    PG8_BAR;
    if constexpr (Epi::AFTER_DRAIN) { E.fused(acc, cur, wr, wc, fr, fq, lds, wid, lane); S.done(cur); }
#undef PG8_SA
#undef PG8_SB
#undef PG8_STAGE
#undef PG8_LDA
#undef PG8_LDB
#undef PG8_MMA
#undef PG8_WAIT_V
#undef PG8_WAIT_L
#undef PG8_BAR
#undef PG8_SCHED
}
}
#define XB_TMO      128
#define XB_XCNT(j)  (256  + 64 * (j))
#define XB_XSUB(j)  (1280 + 64 * (j))
#define XB_XGEN(j)  (2304 + 64 * (j))
#define XB_TOP      3328
#define XB_TOPGEN   3392
#define XCD_BAR_WORDS 3456
#define XB_SPIN_CAP (1u << 18)

__device__ __forceinline__ unsigned xb_ld(unsigned* p)              { return __hip_atomic_load(p, __ATOMIC_RELAXED, __HIP_MEMORY_SCOPE_AGENT); }
__device__ __forceinline__ unsigned xb_add(unsigned* p, unsigned v) { return __hip_atomic_fetch_add(p, v, __ATOMIC_RELAXED, __HIP_MEMORY_SCOPE_AGENT); }
__device__ __forceinline__ unsigned xb_xcc_id() { return (unsigned)__builtin_amdgcn_s_getreg((3 << 11) | 20) & 0xFu; }
#define XB_SPIN(cond, bar) do { unsigned _sp = 0; while (cond) { __builtin_amdgcn_s_sleep(1); \
    if ((++_sp & 255u) == 0u) { if (xb_ld(&(bar)[XB_TMO])) break; if (_sp > XB_SPIN_CAP) { atomicAdd(&(bar)[XB_TMO], 1u); break; } } } } while (0)

struct XcdBarrier {
    unsigned* bar; unsigned x;
    volatile LAS unsigned* st;
};

__device__ __forceinline__ XcdBarrier xcd_barrier_post(unsigned* bar, volatile LAS unsigned* st) {
    XcdBarrier b; b.bar = bar; b.x = xb_xcc_id(); b.st = st;
    if (otid() == 0) (void)xb_add(&bar[XB_XCNT(b.x)], 1u);
    return b;
}
__device__ __forceinline__ void xcd_barrier_complete(unsigned* bar, unsigned x, unsigned& nloc, unsigned& nx) {
    asm volatile("" : "+s"(x));
    const unsigned G = ogdim();
    unsigned sum, cnt, mine, sp = 0u;
    for (;;) {
        sum = 0u; cnt = 0u; mine = 0u;
#pragma unroll
        for (unsigned j = 0; j < 16; ++j) { const unsigned c = xb_ld(&bar[XB_XCNT(j)]); sum += c; cnt += (c > 0u) ? 1u : 0u; mine = (j == x) ? c : mine; }
        if (sum == G) break;
        __builtin_amdgcn_s_sleep(1);
        if ((++sp & 255u) == 0u) { if (xb_ld(&bar[XB_TMO])) break; if (sp > XB_SPIN_CAP) { atomicAdd(&bar[XB_TMO], 1u); break; } }
    }
    nloc = mine > 0u ? mine : 1u; nx = cnt > 0u ? cnt : 1u;
}

__device__ __forceinline__ void xcd_barrier(const XcdBarrier& b) {
    asm volatile("s_waitcnt vmcnt(0)" ::: "memory");
    __syncthreads();
    if (otid() == 0) {
        unsigned* bar = b.bar;
        __builtin_amdgcn_s_waitcnt(0);
        unsigned nloc = b.st[0], nx = b.st[1];
        if (nloc == 0u) { xcd_barrier_complete(bar, b.x, nloc, nx); b.st[0] = nloc; b.st[1] = nx; }
        const unsigned old = xb_add(&bar[XB_XSUB(b.x)], 1u);
        const unsigned gen = old / nloc;
        if (old + 1u == (gen + 1u) * nloc) {
            __builtin_amdgcn_fence(__ATOMIC_RELEASE, "agent");
            asm volatile("s_waitcnt vmcnt(0)" ::: "memory");
            const unsigned og = xb_add(&bar[XB_TOP], 1u);
            const unsigned tg = og / nx;
            if (og + 1u == (tg + 1u) * nx) xb_add(&bar[XB_TOPGEN], 1u);
            else XB_SPIN(xb_ld(&bar[XB_TOPGEN]) == tg, bar);
            __builtin_amdgcn_fence(__ATOMIC_ACQUIRE, "agent");
            xb_add(&bar[XB_XGEN(b.x)], 1u);
            asm volatile("s_waitcnt vmcnt(0)" ::: "memory");
        } else {
            XB_SPIN(xb_ld(&bar[XB_XGEN(b.x)]) == gen, bar);
            __builtin_amdgcn_fence(__ATOMIC_ACQUIRE, "agent");
            asm volatile("s_waitcnt vmcnt(0)" ::: "memory");
        }
    }
    __syncthreads();
}

#define FFT_DI DI
struct cpx; template <class P> DI cpx fft_ldc_(P p, int i); template <class P> DI void fft_stc_(P p, int i, const cpx& v);
#define FFT_LDC(p, i) fft_ldc_((p), (i))
#define FFT_STC(p, i, v) fft_stc_((p), (i), (v))
#define FFT_M 16384
#define FFT_NT 512
struct cpx { float x, y; };
#ifdef FFT_LDC
template <class P> FFT_DI cpx fft_ldc_(P p, int i) { const f32x2_t v = *(const decltype(fft_vec2_(p)))(p + 2 * i); cpx r; r.x = v[0]; r.y = v[1]; return r; }
template <class P> FFT_DI void fft_stc_(P p, int i, const cpx& v) { f32x2_t w = {v.x, v.y}; *(decltype(fft_vec2_(p)))(p + 2 * i) = w; }
#endif
#ifndef FFT_LDC
#define FFT_LDC(p, i) ([&]{ cpx r_; r_.x = (p)[2 * (i)]; r_.y = (p)[2 * (i) + 1]; return r_; }())
#define FFT_STC(p, i, v) do { (p)[2 * (i)] = (v).x; (p)[2 * (i) + 1] = (v).y; } while (0)
#endif
FFT_DI cpx cmul(cpx a, cpx b) { cpx r; r.x = a.x * b.x - a.y * b.y; r.y = a.x * b.y + a.y * b.x; return r; }
FFT_DI cpx cmulc(cpx a, cpx b) { cpx r; r.x = a.x * b.x + a.y * b.y; r.y = a.y * b.x - a.x * b.y; return r; }
FFT_DI int rev4_14(int k) {
    int r = 0;
#pragma unroll
    for (int d = 0; d < 7; ++d) { r = (r << 2) | (k & 3); k >>= 2; }
    return r;
}
struct FftTw { cpx c256[3], c64[3], c16[3], c4[3]; };
template <class TP> FFT_DI void fft_load_tw(FftTw& T, TP tw, int tid) {
#pragma unroll
    for (int q = 0; q < 3; ++q) { T.c256[q] = FFT_LDC(tw, (q + 1) * (tid & 255) * 16); T.c64[q] = FFT_LDC(tw, (q + 1) * (tid & 63) * 64); T.c16[q] = FFT_LDC(tw, (q + 1) * (tid & 15) * 256); T.c4[q] = FFT_LDC(tw, (q + 1) * (tid & 3) * 1024); }
}
template <int s, class TP> FFT_DI void fft_pick_tw(const FftTw& T, TP tw, int pos, int j, cpx& w1, cpx& w2, cpx& w3) {
    if (s == 4096) { w1 = FFT_LDC(tw, pos); w2 = FFT_LDC(tw, 2 * pos); w3 = FFT_LDC(tw, 3 * pos); }
    else if (s == 1024) { w1 = FFT_LDC(tw, 4 * pos); w2 = FFT_LDC(tw, 8 * pos); w3 = FFT_LDC(tw, 12 * pos); }
    else if (s == 256) { w1 = T.c256[0]; w2 = T.c256[1]; w3 = T.c256[2]; }
    else if (s == 64) { w1 = T.c64[0]; w2 = T.c64[1]; w3 = T.c64[2]; }
    else if (s == 16) { w1 = T.c16[0]; w2 = T.c16[1]; w3 = T.c16[2]; }
    else if (s == 4) { w1 = T.c4[0]; w2 = T.c4[1]; w3 = T.c4[2]; }
}
template <int s, class LP, class TP> FFT_DI void fft_fwd_pass(LP lds, const FftTw& T, TP tw, int tid) {
    cpx w1, w2, w3;
#pragma unroll 2
    for (int jj = 0; jj < FFT_M / 4 / FFT_NT; ++jj) { const int b = tid + FFT_NT * jj;
        const int pos = b & (s - 1), base = ((b & ~(s - 1)) << 2) + pos;
        const cpx a0 = FFT_LDC(lds, base), a1 = FFT_LDC(lds, base + s), a2 = FFT_LDC(lds, base + 2 * s), a3 = FFT_LDC(lds, base + 3 * s);
        cpx t0, t1, t2, t3;
        t0.x = a0.x + a2.x; t0.y = a0.y + a2.y;
        t1.x = a0.x - a2.x; t1.y = a0.y - a2.y;
        t2.x = a1.x + a3.x; t2.y = a1.y + a3.y;
        t3.x = a1.x - a3.x; t3.y = a1.y - a3.y;
        cpx y0, y1, y2, y3;
        y0.x = t0.x + t2.x; y0.y = t0.y + t2.y;
        y2.x = t0.x - t2.x; y2.y = t0.y - t2.y;
        y1.x = t1.x + t3.y; y1.y = t1.y - t3.x;
        y3.x = t1.x - t3.y; y3.y = t1.y + t3.x;
        if (s > 1) {
            fft_pick_tw<s>(T, tw, pos, jj, w1, w2, w3);
            y1 = cmul(y1, w1); y2 = cmul(y2, w2); y3 = cmul(y3, w3);
        }
        FFT_STC(lds, base, y0); FFT_STC(lds, base + s, y1); FFT_STC(lds, base + 2 * s, y2); FFT_STC(lds, base + 3 * s, y3);
    }
}
template <int s, class LP, class TP> FFT_DI void fft_inv_pass(LP lds, const FftTw& T, TP tw, int tid) {
    cpx w1, w2, w3;
#pragma unroll 2
    for (int jj = 0; jj < FFT_M / 4 / FFT_NT; ++jj) { const int b = tid + FFT_NT * jj;
        const int pos = b & (s - 1), base = ((b & ~(s - 1)) << 2) + pos;
        const cpx b0 = FFT_LDC(lds, base); cpx c1 = FFT_LDC(lds, base + s), c2 = FFT_LDC(lds, base + 2 * s), c3 = FFT_LDC(lds, base + 3 * s);
        if (s > 1) {
            fft_pick_tw<s>(T, tw, pos, jj, w1, w2, w3);
            c1 = cmulc(c1, w1); c2 = cmulc(c2, w2); c3 = cmulc(c3, w3);
        }
        cpx t0, t1, t2, t3;
        t0.x = b0.x + c2.x; t0.y = b0.y + c2.y;
        t1.x = b0.x - c2.x; t1.y = b0.y - c2.y;
        t2.x = c1.x + c3.x; t2.y = c1.y + c3.y;
        t3.x = c1.x - c3.x; t3.y = c1.y - c3.y;
        cpx x0, x1, x2, x3;
        x0.x = t0.x + t2.x; x0.y = t0.y + t2.y;
        x2.x = t0.x - t2.x; x2.y = t0.y - t2.y;
        x1.x = t1.x - t3.y; x1.y = t1.y + t3.x;
        x3.x = t1.x + t3.y; x3.y = t1.y - t3.x;
        FFT_STC(lds, base, x0); FFT_STC(lds, base + s, x1); FFT_STC(lds, base + 2 * s, x2); FFT_STC(lds, base + 3 * s, x3);
    }
}
template <class LP, class TP> FFT_DI void rfft_untangle(LP lds, TP tw2, int k, cpx& Xk, cpx& Xm) {
    if (k == 0) {
        const float zr = lds[0], zi = lds[1];
        Xk.x = zr + zi; Xk.y = zr - zi;
        const int p = rev4_14(FFT_M / 2);
        Xm.x = lds[2 * p]; Xm.y = -lds[2 * p + 1];
        return;
    }
    const int pk = rev4_14(k), pm = rev4_14(FFT_M - k);
    cpx Zk, Zm; Zk.x = lds[2 * pk]; Zk.y = lds[2 * pk + 1]; Zm.x = lds[2 * pm]; Zm.y = lds[2 * pm + 1];
    cpx E, O, W, WO;
    E.x = 0.5f * (Zk.x + Zm.x); E.y = 0.5f * (Zk.y - Zm.y);
    O.x = 0.5f * (Zk.y + Zm.y); O.y = -0.5f * (Zk.x - Zm.x);
    W.x = tw2[2 * k]; W.y = tw2[2 * k + 1];
    WO = cmul(W, O);
    Xk.x = E.x + WO.x; Xk.y = E.y + WO.y;
    Xm.x = E.x - WO.x; Xm.y = -(E.y - WO.y);
}
template <class LP, class TP> FFT_DI void rfft_mul_retangle(LP lds, TP tw2, int k, cpx Gk, cpx Gm) {
    cpx Xk, Xm; rfft_untangle(lds, tw2, k, Xk, Xm);
    if (k == 0) {
        const float y0 = Xk.x * Gk.x, yM = Xk.y * Gk.y;
        lds[0] = 0.5f * (y0 + yM); lds[1] = 0.5f * (y0 - yM);
        const cpx Y = cmul(Xm, Gm);
        const int p = rev4_14(FFT_M / 2);
        lds[2 * p] = Y.x; lds[2 * p + 1] = -Y.y;
        return;
    }
    const cpx Yk = cmul(Xk, Gk), Ym = cmul(Xm, Gm);
    cpx W; W.x = tw2[2 * k]; W.y = tw2[2 * k + 1];
    cpx A, D, T;
    A.x = 0.5f * (Yk.x + Ym.x); A.y = 0.5f * (Yk.y - Ym.y);
    D.x = 0.5f * (Yk.x - Ym.x); D.y = 0.5f * (Yk.y + Ym.y);
    T = cmulc(D, W);
    const int pk = rev4_14(k), pm = rev4_14(FFT_M - k);
    lds[2 * pk] = A.x - T.y; lds[2 * pk + 1] = A.y + T.x;
    cpx Dc; Dc.x = -D.x; Dc.y = D.y;
    const cpx T2 = cmul(W, Dc);
    lds[2 * pm] = A.x + T2.y; lds[2 * pm + 1] = -A.y - T2.x;
}
enum { I_X = 0, I_C, I_CTX, I_CCTX, I_WMOD, I_BMOD, I_NMIXW, I_NFFNW, I_WIN, I_BIN, I_HYCW, I_HYCB, I_HYW1, I_HYB1, I_HYW2, I_HYB2, I_HYW3, I_HYB3, I_HYFREQ, I_HYSKIP,
       I_HGLB, I_HGNW, I_GLWA2, I_GLBA, I_GLNW, I_WBR, I_WOUT, I_WRG, I_BRG, I_WRE, I_BRE, I_WGATE, I_WUP, I_WDOWN, I_FNW, N_IN };
struct Args { const float* in[N_IN]; float* out; unsigned char* ws; int ph_lo, ph_hi; };
#define GAS __attribute__((address_space(1)))
extern __shared__ __attribute__((aligned(16))) unsigned char lds_raw[];
constexpr int LDS_PTAB = 150 * 1024 - 64 - 320;
DI LAS unsigned char* ldsbase() { unsigned p = (unsigned)(unsigned long long)(LAS unsigned char*)lds_raw; asm volatile("" : "+s"(p)); return (LAS unsigned char*)(unsigned long long)p; }
DI const float* ain(const Args&, int i) { const unsigned long long v = ((LAS unsigned long long*)(ldsbase() + LDS_PTAB))[i];
    const unsigned lo = __builtin_amdgcn_readfirstlane((unsigned)v), hi = __builtin_amdgcn_readfirstlane((unsigned)(v >> 32)); return (const float*)(GAS const float*)(((unsigned long long)hi << 32) | lo); }
DI unsigned char* wsp(const Args& a) { unsigned long long p = (unsigned long long)(a).ws; asm volatile("" : "+s"(p)); return (unsigned char*)(GAS unsigned char*)p; }
DI int opq(int x) { asm volatile("" : "+s"(x)); return x; }
#ifdef PROBE_SEL
constexpr int LDS_TIM = 150 * 1024 - 64 - 320 - 512;
#define TIC() const unsigned long long tic_ = __builtin_amdgcn_s_memrealtime()
#define TOC(i) do { if (otid() == 0) ((LAS unsigned long long*)(ldsbase() + LDS_TIM))[i] += __builtin_amdgcn_s_memrealtime() - tic_; } while (0)
#else
#define TIC() do {} while (0)
#define TOC(i) do {} while (0)
#endif
#define LDS_BAR() do { asm volatile("s_waitcnt lgkmcnt(0)" ::: "memory"); __builtin_amdgcn_s_barrier(); asm volatile("" ::: "memory"); } while (0)
constexpr int NTHR = 512;
constexpr int LDS_BYTES = 150 * 1024;
constexpr int LDS_X = 131072;
constexpr int LDS_BARW = LDS_BYTES - 64;

DI int z_srccol(int zc) { return zc < 8192 ? zc : (zc < Z_LR ? zc + 32 : (zc < Z_LR + 32 ? zc - Z_LR + 8192 : -1)); }

template <bool RDONLY = false> DI void cvt_wtile(const float* __restrict__ src, size_t ld, int sc, bf16* __restrict__ dst, int K, int row0, int kb, LAS float* t  ) {
    const int nn = otid() & 63;
    float v[64];
    if (sc >= 0) {
#pragma unroll
        for (int p = 0; p < 64; ++p) v[p] = src[(size_t)(kb * 64 + p) * ld + sc];
    } else {
#pragma unroll
        for (int p = 0; p < 64; ++p) v[p] = 0.f;
    }
    if (RDONLY) { float s = 0.f;
#pragma unroll
        for (int p = 0; p < 64; ++p) s += v[p];
        asm volatile("" :: "v"(s)); return; }
#pragma unroll
    for (int p = 0; p < 64; ++p) t[p * 65 + nn] = v[p];
    asm volatile("s_waitcnt lgkmcnt(0)" ::: "memory");
    const int rsub = nn >> 3, kp = nn & 7;
#pragma unroll
    for (int q = 0; q < 8; ++q) { const int row = q * 8 + rsub; float w[8];
#pragma unroll
        for (int j = 0; j < 8; ++j) w[j] = t[(kp * 8 + j) * 65 + row];
        u32x4 o; o.x = pk_bf16(w[0], w[1]); o.y = pk_bf16(w[2], w[3]); o.z = pk_bf16(w[4], w[5]); o.w = pk_bf16(w[6], w[7]);
        *(u32x4*)(dst + (size_t)(row0 + row) * K + kb * 64 + kp * 8) = o; }
    asm volatile("s_waitcnt lgkmcnt(0)" ::: "memory");
}
constexpr int CVT_MIX_TILES = 276 * 32 + 3 * 32 * 16 + 32 * 32;
DI void cvt_mix_wtile(const Args& a, int l, int it, LAS float* t) {
    const int nn = otid() & 63;
    if (it < 276 * 32) { const int nb = it >> 5, kb = it & 31; cvt_wtile(ain(a, I_WIN) + (size_t)l * D * NCOLS_IN, NCOLS_IN, z_srccol(nb * 64 + nn), (bf16*)(wsp(a) + WS_WIN), D, nb * 64, kb, t); return; }
    it -= 276 * 32;
    if (it < 3 * 32 * 16) { const int br = it / 512, r = it % 512, nb = r >> 4, kb = r & 15;
        cvt_wtile(ain(a, I_WBR) + ((size_t)l * 3 + br) * 1024 * D, D, nb * 64 + nn, (bf16*)(wsp(a) + WS_WBR) + (size_t)br * D * 1024, 1024, nb * 64, kb, t); return; }
    it -= 3 * 32 * 16;
    { const int nb = it >> 5, kb = it & 31; cvt_wtile(ain(a, I_WOUT) + (size_t)l * D * D, D, nb * 64 + nn, (bf16*)(wsp(a) + WS_WOUT), D, nb * 64, kb, t); }
}
constexpr int CVT_MOE_TILES = 32 * 16 * 32 + 32 * 32 * 8;
template <bool RDONLY = false> DI void cvt_moe_wtile(const Args& a, int l, int it, LAS float* t) {
    const int nn = otid() & 63;
    if (it < 32 * 16 * 32) { const int e = it >> 9, r = it & 511, nb = r >> 5, kb = r & 31, nt = nb >> 2, sub = nb & 3;
        const float* src = (sub < 2 ? ain(a, I_WGATE) : ain(a, I_WUP)) + ((size_t)l * NEXP + e) * D * DFF;
        cvt_wtile<RDONLY>(src, DFF, nt * 128 + (sub & 1) * 64 + nn, (bf16*)(wsp(a) + WS_WGU) + (size_t)e * 1024 * D, D, nb * 64, kb, t); return; }
    it -= 32 * 16 * 32;
    { const int e = it >> 8, r = it & 255, nb = r >> 3, kb = r & 7;
      cvt_wtile<RDONLY>(ain(a, I_WDOWN) + ((size_t)l * NEXP + e) * DFF * D, D, nb * 64 + nn, (bf16*)(wsp(a) + WS_WD) + (size_t)e * D * DFF, DFF, nb * 64, kb, t); }
}
template <bool MOE, bool RDONLY = false> DI void cvt_stream(const Args& a, int l, LAS float* ldsf) {
    const int wave = __builtin_amdgcn_readfirstlane(otid() >> 6), n = MOE ? CVT_MOE_TILES : CVT_MIX_TILES, g_ = ogdim(), nw = g_ * 8;
    LAS float* t = ldsf + wave * (64 * 65);
    for (int it = wave * g_ + (int)obid(); it < n; it += nw) { if (MOE) cvt_moe_wtile<RDONLY>(a, l, it, t); else cvt_mix_wtile(a, l, it, t); }
}

DI void mod_item(const Args& a, int j, LAS float* lds) {
    const int tid = otid(), l = j >> 7, col0 = (j & 127) * 96;
    LAS float* sil = lds;
    LAS float* red = lds + 4096;
    for (int k = tid; k < 2 * D; k += NTHR) { const float c = (k < D) ? ain(a, I_C)[k] : ain(a, I_CCTX)[k - D]; sil[k] = siluf_(c); }
    __syncthreads();
    const int cg = tid % 24, rg = tid / 24;
    f32x4 a0 = {0.f, 0.f, 0.f, 0.f}, a1 = {0.f, 0.f, 0.f, 0.f};
    if (rg < 21) {
        const float* w = ain(a, I_WMOD) + (size_t)l * D * 12288 + col0 + cg * 4;
        for (int k = rg; k < D; k += 21) { const f32x4 wv = *(const f32x4*)(w + (size_t)k * 12288); a0 += wv * sil[k]; a1 += wv * sil[D + k]; }
#pragma unroll
        for (int q = 0; q < 4; ++q) { red[(rg * 2 + 0) * 96 + cg * 4 + q] = a0[q]; red[(rg * 2 + 1) * 96 + cg * 4 + q] = a1[q]; }
    }
    __syncthreads();
    if (tid < 192) { const int set = tid / 96, c = tid % 96; float s = 0.f;
        for (int r = 0; r < 21; ++r) s += red[(r * 2 + set) * 96 + c];
        ((float*)(wsp(a) + WS_MOD))[((size_t)l * 2 + set) * 12288 + col0 + c] = s + ain(a, I_BMOD)[(size_t)l * 12288 + col0 + c]; }
    __syncthreads();
}
DI void h2_item(const Args& a, int it, LAS float* lds) {
    const int tid = otid(), l = it / (MT / 8), r0 = (it % (MT / 8)) * 8;
    LAS float* feats = lds;
    LAS float* h1 = lds + 8 * 36;
    if (tid < 8 * 33) { const int rr = tid / 33, i = tid % 33, r = r0 + rr; const int Lq = r < SEQ ? SEQ : CTXL, t = r < SEQ ? r : r - SEQ;
        float f;
        if (i == 0) f = (float)t / (float)(Lq - 1);
        else { const int bi = (i - 1) & 15; const float band = 1e-4f + (float)bi * ((15.0f - 1e-4f) / 15.0f); const float rev2 = 2.0f * band * (float)t / (float)Lq;
            f = (i <= 16) ? cospif(rev2) : -sinpif(rev2); }
        feats[rr * 36 + i] = f; }
    __syncthreads();
    const int rr = tid >> 6, j = tid & 63;
    { const float* w1 = ain(a, I_HYW1) + (size_t)l * 33 * 64; float s = ain(a, I_HYB1)[l * 64 + j];
      for (int i = 0; i < 33; ++i) s += feats[rr * 36 + i] * w1[i * 64 + j];
      h1[rr * 64 + j] = sinf(ain(a, I_HYFREQ)[l * 64 + j] * s); }
    __syncthreads();
    { const float* w2 = ain(a, I_HYW2) + (size_t)l * 64 * 64; float s = ain(a, I_HYB2)[l * 64 + j];
      for (int i = 0; i < 64; ++i) s += h1[rr * 64 + i] * w2[i * 64 + j];
      const float hv = sinf(ain(a, I_HYFREQ)[l * 64 + j] * s);
      ((float*)(wsp(a) + WS_H2))[((size_t)l * MT + r0 + rr) * 64 + j] = hv;
      if (r0 + rr < SEQ) { bf16* hb = (bf16*)(wsp(a) + WS_H2B) + ((size_t)l * SEQ + r0 + rr) * 256; hb[j] = f2bf(hv); hb[64 + j] = 0; hb[128 + j] = 0; hb[192 + j] = 0; } }
    __syncthreads();
}
DI void prologue_small(const Args& a) {
    const size_t gt = (size_t)obid() * NTHR + otid(), gs = (size_t)ogdim() * NTHR;
    float* zb = (float*)(wsp(a) + WS_ZBIAS);
    for (size_t i = gt; i < (size_t)DEPTH * ZC; i += gs) { const int l = (int)(i / ZC), zc = (int)(i % ZC), sc = z_srccol(zc); zb[i] = sc >= 0 ? ain(a, I_BIN)[(size_t)l * NCOLS_IN + sc] : 0.f; }
    float* lb = (float*)(wsp(a) + WS_LB);
    for (size_t i = gt; i < (size_t)DEPTH * 2048; i += gs) { const int l = (int)(i / 2048), j = (int)(i % 2048);
        float v = 0.f; if (l == 1) { const float r0 = ain(a, I_HGLB)[j], r1 = ain(a, I_HGLB)[2048 + j]; v = 1.0f / (1.0f + expf(r0 - r1)); }
        lb[i] = v; }
    bf16* w3t = (bf16*)(wsp(a) + WS_W3T);
    for (size_t i = gt; i < (size_t)DEPTH * 2048 * 256; i += gs) { const int l = (int)(i >> 19), fc = (int)((i >> 8) & 2047), j = (int)(i & 255); w3t[i] = j < 64 ? f2bf(ain(a, I_HYW3)[((size_t)l * 64 + j) * 2048 + fc]) : (bf16)0; }
    bf16* wrt = (bf16*)(wsp(a) + WS_WRT);
    for (size_t i = gt; i < (size_t)DEPTH * 48 * 2048; i += gs) { const int l = (int)(i / (48 * 2048)), c = (int)((i / 2048) % 48), k = (int)(i & 2047);
        const float w = c < 4 ? ain(a, I_WRG)[((size_t)l * D + k) * 4 + c] : (c < 36 ? ain(a, I_WRE)[((size_t)l * D + k) * 32 + (c - 4)] : 0.f);
        const bf16 hi = f2bf(w); wrt[((size_t)l * 2 + 0) * 48 * 2048 + (size_t)c * 2048 + k] = hi; wrt[((size_t)l * 2 + 1) * 48 * 2048 + (size_t)c * 2048 + k] = f2bf(w - bf2f(hi)); }
    float* tw = (float*)(wsp(a) + WS_TW);
    for (size_t i = gt; i < 16384; i += gs) { float s, c; sincospif(-2.0f * (float)i / 16384.0f, &s, &c); tw[2 * i] = c; tw[2 * i + 1] = s; }
    float* tw2 = (float*)(wsp(a) + WS_TW2);
    for (size_t i = gt; i <= 8192; i += gs) { float s, c; sincospif(-(float)i / 16384.0f, &s, &c); tw2[2 * i] = c; tw2[2 * i + 1] = s; }
}
DI void hyc_filters(const Args& a, int l) {
    const int lane = otid() & 63, wave = otid() >> 6;
    const float* h2 = (const float*)(wsp(a) + WS_H2) + ((size_t)l * MT + SEQ) * 64;
    const float* w3 = ain(a, I_HYW3) + (size_t)l * 64 * 2048;
    float* hyc = (float*)(wsp(a) + WS_HYC);
    const float a0 = -4.605170186f / 1.5f, a1 = -4.605170186f / 0.3f;
    for (int fc = obid() * 8 + wave; fc < 2048; fc += ogdim() * 8) {
        const int c = fc & 1023; const float delta = fabsf(a0 + (float)c * ((a1 - a0) / 1023.0f)); const float b3 = ain(a, I_HYB3)[l * 2048 + fc];
        float hv[4], ssum = 0.f;
#pragma unroll
        for (int i = 0; i < 4; ++i) { const int t = lane + 64 * i; float s = b3;
            for (int j = 0; j < 64; ++j) s += h2[t * 64 + j] * w3[j * 2048 + fc];
            const float tl = (float)t / 255.0f; hv[i] = s * (expf(-tl * delta) + 0.05f); ssum += fabsf(hv[i]); }
        ssum = wave_sum(ssum); const float inv = 1.0f / ssum;
#pragma unroll
        for (int i = 0; i < 4; ++i) hyc[(size_t)fc * 256 + lane + 64 * i] = hv[i] * inv;
    }
}
template <int MODE, bool DRY = false> DI void norm_phase(const Args& a, int l, int nrows, LAS float* ldsf) {
    const int lane = otid() & 63, wave = otid() >> 6;
    float* H = (float*)(wsp(a) + WS_H); bf16* U = (bf16*)(wsp(a) + WS_U);
    const float* modall = (const float*)(wsp(a) + WS_MOD);
    int* route = (int*)(wsp(a) + WS_ROUTE);
    const bf16* YP = (const bf16*)(wsp(a) + WS_YP);
    const bool combine = (MODE == 0 && l > 0) || MODE == 2;
    for (int r = obid() * 8 + wave; r < nrows; r += ogdim() * 8) {
        const int set = r >= SEQ ? 1 : 0;
        const float* src = (MODE == 0 && l == 0) ? (set ? ain(a, I_CTX) + (size_t)(r - SEQ) * D : ain(a, I_X) + (size_t)r * D) : H + (size_t)r * D;
        f32x4 v[8];
#pragma unroll
        for (int j = 0; j < 8; ++j) v[j] = *(const f32x4*)(src + j * 256 + lane * 4);
        if (combine) {
            const float* gt2 = modall + ((size_t)(l - 1) * 2 + set) * 12288 + 10240;
            const int p0 = route[r * 8 + 6], p1 = route[r * 8 + 7];
#pragma unroll
            for (int j = 0; j < 8; ++j) { const int col = j * 256 + lane * 4;
                const u32x2 y0 = *(const u32x2*)(YP + (size_t)p0 * D + col), y1 = *(const u32x2*)(YP + (size_t)p1 * D + col); const f32x4 g = *(const f32x4*)(gt2 + col);
                v[j][0] += g[0] * (bflo(y0.x) + bflo(y1.x)); v[j][1] += g[1] * (bfhi(y0.x) + bfhi(y1.x)); v[j][2] += g[2] * (bflo(y0.y) + bflo(y1.y)); v[j][3] += g[3] * (bfhi(y0.y) + bfhi(y1.y)); }
            if (MODE == 0) {
#pragma unroll
                for (int j = 0; j < 8; ++j) *(f32x4*)(H + (size_t)r * D + j * 256 + lane * 4) = v[j];
            }
        }
        float ss = 0.f;
#pragma unroll
        for (int j = 0; j < 8; ++j) ss += (v[j][0] * v[j][0] + v[j][1] * v[j][1]) + (v[j][2] * v[j][2] + v[j][3] * v[j][3]);
        ss = wave_sum(ss);
        const float rstd = rsqrtf(ss * (1.0f / D) + NORM_EPS);
        if (MODE == 2) {
            const float* fw = ain(a, I_FNW);
#ifdef PROBE_SEL
            const float pscale = 1.0f + 0.5f * (float)((LAS unsigned long long*)(ldsbase() + LDS_TIM))[PROBE_SEL] / (float)((LAS unsigned long long*)(ldsbase() + LDS_TIM))[0];
#else
            const float pscale = 1.0f;
#endif
#pragma unroll
            for (int j = 0; j < 8; ++j) { const int col = j * 256 + lane * 4; const f32x4 w = *(const f32x4*)(fw + col); *(f32x4*)(a.out + (size_t)r * D + col) = v[j] * rstd * w * pscale; }
        } else {
            const float* nw = (MODE == 0 ? ain(a, I_NMIXW) : ain(a, I_NFFNW)) + (size_t)l * D;
            const float* md = modall + ((size_t)l * 2 + set) * 12288 + (MODE == 0 ? 0 : 6144);
#pragma unroll
            for (int j = 0; j < 8; ++j) { const int col = j * 256 + lane * 4; const f32x4 w = *(const f32x4*)(nw + col), sh = *(const f32x4*)(md + col), sc = *(const f32x4*)(md + 2048 + col);
                v[j] = (v[j] * rstd * w) * (sc + 1.0f) + sh;
                u32x2 o; o.x = pk_bf16(v[j][0], v[j][1]); o.y = pk_bf16(v[j][2], v[j][3]); *(u32x2*)(U + (size_t)r * D + col) = o; }
            if (MODE == 1) {
                const float* wrg = ain(a, I_WRG) + (size_t)l * D * 4; const float* wre = ain(a, I_WRE) + (size_t)l * D * 32;
                float lg[36];
#pragma unroll
                for (int i = 0; i < 36; ++i) lg[i] = 0.f;
                LAS float* wu = ldsf + wave * 2048;
#pragma unroll
                for (int j = 0; j < 8; ++j) *(LAS f32x4*)(wu + j * 256 + lane * 4) = v[j];
                asm volatile("s_waitcnt lgkmcnt(0)" ::: "memory");
#pragma unroll 2
                for (int cc = 0; cc < 32; ++cc) { const int col = cc * 64 + lane; const float uv = wu[col];
                    const f32x4 g = *(const f32x4*)(wrg + (size_t)col * 4);
                    lg[0] += uv * g[0]; lg[1] += uv * g[1]; lg[2] += uv * g[2]; lg[3] += uv * g[3];
#pragma unroll
                    for (int e4 = 0; e4 < 8; ++e4) { const f32x4 w = *(const f32x4*)(wre + (size_t)col * 32 + e4 * 4);
                        lg[4 + e4 * 4 + 0] += uv * w[0]; lg[4 + e4 * 4 + 1] += uv * w[1]; lg[4 + e4 * 4 + 2] += uv * w[2]; lg[4 + e4 * 4 + 3] += uv * w[3]; } }
                asm volatile("s_waitcnt lgkmcnt(0)" ::: "memory");
#pragma unroll
                for (int i = 0; i < 36; ++i) lg[i] = wave_sum(lg[i]);
                float gl[4]; int grp = 0; float gmax;
#pragma unroll
                for (int g = 0; g < 4; ++g) gl[g] = lg[g] + ain(a, I_BRG)[l * 4 + g];
                gmax = gl[0];
#pragma unroll
                for (int g = 1; g < 4; ++g) if (gl[g] > gmax) { gmax = gl[g]; grp = g; }
                float gden = 0.f;
#pragma unroll
                for (int g = 0; g < 4; ++g) gden += expf(gl[g] - gmax);
                const float ptop = 1.0f / gden;
                float le[8];
#pragma unroll
                for (int i = 0; i < 8; ++i) { float x = lg[4 + i];
#pragma unroll
                    for (int g = 1; g < 4; ++g) x = (grp == g) ? lg[4 + g * 8 + i] : x;
                    le[i] = x + ain(a, I_BRE)[l * 32 + grp * 8 + i]; }
                int i0 = 0; float m0 = le[0];
#pragma unroll
                for (int i = 1; i < 8; ++i) if (le[i] > m0) { m0 = le[i]; i0 = i; }
                int i1 = -1; float m1 = -3.0e38f;
#pragma unroll
                for (int i = 0; i < 8; ++i) if (i != i0 && le[i] > m1) { m1 = le[i]; i1 = i; }
                const float e1v = expf(m1 - m0);
                const float w0 = ptop / (1.0f + e1v), w1 = ptop * e1v / (1.0f + e1v);
                if (DRY) { asm volatile("" :: "v"(w0), "v"(w1), "v"(i0), "v"(i1), "v"(grp)); }
                else if (lane == 0) {
                    unsigned* cnt = (unsigned*)(wsp(a) + WS_CTL) + CW_CNT + l * 64;
                    const int ex0 = grp * 8 + i0, ex1 = grp * 8 + i1;
                    const unsigned s0 = atomicAdd(cnt + ex0, 1u), s1 = atomicAdd(cnt + ex1, 1u);
                    route[r * 8 + 0] = ex0; route[r * 8 + 1] = ex1; route[r * 8 + 2] = (int)s0; route[r * 8 + 3] = (int)s1;
                    route[r * 8 + 4] = __float_as_int(w0); route[r * 8 + 5] = __float_as_int(w1);
                }
            }
        }
    }
}
typedef short bf16x8r_t __attribute__((ext_vector_type(8)));
template <bool DRY> DI void route_phase(const Args& a, int l, int nrows, LAS float* ldsf) {
    const int lane = otid() & 63, wave = otid() >> 6, fr = lane & 15, fq = lane >> 4;
    const float* H = (const float*)(wsp(a) + WS_H); bf16* U = (bf16*)(wsp(a) + WS_U); int* route = (int*)(wsp(a) + WS_ROUTE);
    const float* nw = ain(a, I_NFFNW) + (size_t)l * D;
    const bf16* Wh = (const bf16*)(wsp(a) + WS_WRT) + (size_t)l * 2 * 48 * 2048; const bf16* Wl = Wh + 48 * 2048;
    LAS float* lt = ldsf + wave * 1024;
    const int G = ogdim();
    for (int tile = wave * G + (int)obid(); tile < nrows / 16; tile += 8 * G) {
        const int row = tile * 16 + fr, set = row >= SEQ ? 1 : 0;
        const float* hr = H + (size_t)row * D + fq * 8;
        const float* md = (const float*)(wsp(a) + WS_MOD) + ((size_t)l * 2 + set) * 12288 + 6144 + fq * 8;
        float ss = 0.f;
#pragma unroll 8
        for (int ks = 0; ks < 64; ++ks) { const f32x4 x0 = *(const f32x4*)(hr + ks * 32), x1 = *(const f32x4*)(hr + ks * 32 + 4);
            ss += (x0[0] * x0[0] + x0[1] * x0[1]) + (x0[2] * x0[2] + x0[3] * x0[3]) + (x1[0] * x1[0] + x1[1] * x1[1]) + (x1[2] * x1[2] + x1[3] * x1[3]); }
        ss += __shfl_xor(ss, 16); ss += __shfl_xor(ss, 32);
        const float rstd = rsqrtf(ss * (1.0f / D) + NORM_EPS);
        f32x4 acc[3];
#pragma unroll
        for (int cb = 0; cb < 3; ++cb) acc[cb] = (f32x4){0.f, 0.f, 0.f, 0.f};
#pragma unroll 2
        for (int ks = 0; ks < 64; ++ks) { const int c0 = ks * 32;
            const f32x4 x0 = *(const f32x4*)(hr + c0), x1 = *(const f32x4*)(hr + c0 + 4);
            const f32x4 w0 = *(const f32x4*)(nw + fq * 8 + c0), w1 = *(const f32x4*)(nw + fq * 8 + c0 + 4);
            const f32x4 h0 = *(const f32x4*)(md + c0), h1 = *(const f32x4*)(md + c0 + 4), s0 = *(const f32x4*)(md + 2048 + c0), s1 = *(const f32x4*)(md + 2048 + c0 + 4);
            const f32x4 u0 = (x0 * rstd * w0) * (s0 + 1.0f) + h0, u1 = (x1 * rstd * w1) * (s1 + 1.0f) + h1;
            u32x4 hi; hi.x = pk_bf16(u0[0], u0[1]); hi.y = pk_bf16(u0[2], u0[3]); hi.z = pk_bf16(u1[0], u1[1]); hi.w = pk_bf16(u1[2], u1[3]);
            *(u32x4*)(U + (size_t)row * D + fq * 8 + c0) = hi;
            u32x4 lo; lo.x = pk_bf16(u0[0] - bflo(hi.x), u0[1] - bfhi(hi.x)); lo.y = pk_bf16(u0[2] - bflo(hi.y), u0[3] - bfhi(hi.y)); lo.z = pk_bf16(u1[0] - bflo(hi.z), u1[1] - bfhi(hi.z)); lo.w = pk_bf16(u1[2] - bflo(hi.w), u1[3] - bfhi(hi.w));
            const bf16x8r_t ah = __builtin_bit_cast(bf16x8r_t, hi), al = __builtin_bit_cast(bf16x8r_t, lo);
#pragma unroll
            for (int cb = 0; cb < 3; ++cb) { const bf16x8r_t bh = *(const bf16x8r_t*)(Wh + (size_t)(cb * 16 + fr) * 2048 + c0 + fq * 8), bl = *(const bf16x8r_t*)(Wl + (size_t)(cb * 16 + fr) * 2048 + c0 + fq * 8);
                acc[cb] = __builtin_amdgcn_mfma_f32_16x16x32_bf16(ah, bh, acc[cb], 0, 0, 0); acc[cb] = __builtin_amdgcn_mfma_f32_16x16x32_bf16(ah, bl, acc[cb], 0, 0, 0); acc[cb] = __builtin_amdgcn_mfma_f32_16x16x32_bf16(al, bh, acc[cb], 0, 0, 0); } }
#pragma unroll
        for (int cb = 0; cb < 3; ++cb)
#pragma unroll
            for (int j = 0; j < 4; ++j) lt[(fq * 4 + j) * 48 + cb * 16 + fr] = acc[cb][j];
        asm volatile("s_waitcnt lgkmcnt(0)" ::: "memory");
        if (lane < 16) {
            const int r = tile * 16 + lane; float lg[36];
#pragma unroll
            for (int i = 0; i < 36; ++i) lg[i] = lt[lane * 48 + i];
            float gl[4]; int grp = 0; float gmax;
#pragma unroll
            for (int g = 0; g < 4; ++g) gl[g] = lg[g] + ain(a, I_BRG)[l * 4 + g];
            gmax = gl[0];
#pragma unroll
            for (int g = 1; g < 4; ++g) if (gl[g] > gmax) { gmax = gl[g]; grp = g; }
            float gden = 0.f;
#pragma unroll
            for (int g = 0; g < 4; ++g) gden += expf(gl[g] - gmax);
            const float ptop = 1.0f / gden;
            float le[8];
#pragma unroll
            for (int i = 0; i < 8; ++i) { float x = lg[4 + i];
#pragma unroll
                for (int g = 1; g < 4; ++g) x = (grp == g) ? lg[4 + g * 8 + i] : x;
                le[i] = x + ain(a, I_BRE)[l * 32 + grp * 8 + i]; }
            int i0 = 0; float m0 = le[0];
#pragma unroll
            for (int i = 1; i < 8; ++i) if (le[i] > m0) { m0 = le[i]; i0 = i; }
            int i1 = -1; float m1 = -3.0e38f;
#pragma unroll
            for (int i = 0; i < 8; ++i) if (i != i0 && le[i] > m1) { m1 = le[i]; i1 = i; }
            const float e1v = expf(m1 - m0);
            const float w0 = ptop / (1.0f + e1v), w1 = ptop * e1v / (1.0f + e1v);
            if (DRY) { asm volatile("" :: "v"(w0), "v"(w1), "v"(i0), "v"(i1), "v"(grp)); }
            else { unsigned* cnt = (unsigned*)(wsp(a) + WS_CTL) + CW_CNT + l * 64; const int ex0 = grp * 8 + i0, ex1 = grp * 8 + i1;
                const unsigned s0 = atomicAdd(cnt + ex0, 1u), s1 = atomicAdd(cnt + ex1, 1u);
                route[r * 8 + 0] = ex0; route[r * 8 + 1] = ex1; route[r * 8 + 2] = (int)s0; route[r * 8 + 3] = (int)s1; route[r * 8 + 4] = __float_as_int(w0); route[r * 8 + 5] = __float_as_int(w1); }
        }
        asm volatile("s_waitcnt lgkmcnt(0)" ::: "memory");
    }
}
DI void permute_phase(const Args& a, int l, int nrows, LAS unsigned char* ldsb) {
    LAS int* poff = (LAS int*)ldsb;
    const int tid = otid(), lane = tid & 63, wave = tid >> 6;
    const unsigned* cnt = (const unsigned*)(wsp(a) + WS_CTL) + CW_CNT + l * 64;
    if (tid == 0) { int off = 0; for (int e = 0; e < NEXP; ++e) { poff[e] = off; off += (int)((cnt[e] + 255u) / 256u) * 256; } poff[32] = off; }
    __syncthreads();
    if (obid() == 0) { int* tile_e = (int*)(wsp(a) + WS_TILEE); const int nt = poff[32] >> 8;
        if (tid < 200) { int e = -1; if (tid < nt) { for (int q = 0; q < NEXP; ++q) if (poff[q] <= tid * 256) e = q; } tile_e[tid] = e < 0 ? 0 : e; }
        if (tid == 0) tile_e[200] = nt; }
    int* route = (int*)(wsp(a) + WS_ROUTE); float* roww = (float*)(wsp(a) + WS_ROWW);
    const bf16* U = (const bf16*)(wsp(a) + WS_U); bf16* XP = (bf16*)(wsp(a) + WS_XP);
    for (int r = obid() * 8 + wave; r < nrows; r += ogdim() * 8) {
        const int e0 = route[r * 8 + 0], e1 = route[r * 8 + 1], s0 = route[r * 8 + 2], s1 = route[r * 8 + 3];
        const int p0 = poff[e0] + s0, p1 = poff[e1] + s1;
        u32x4 x[4];
#pragma unroll
        for (int i = 0; i < 4; ++i) x[i] = *(const u32x4*)(U + (size_t)r * D + (i * 64 + lane) * 8);
#pragma unroll
        for (int i = 0; i < 4; ++i) { *(u32x4*)(XP + (size_t)p0 * D + (i * 64 + lane) * 8) = x[i]; *(u32x4*)(XP + (size_t)p1 * D + (i * 64 + lane) * 8) = x[i]; }
        if (lane == 0) { route[r * 8 + 6] = p0; route[r * 8 + 7] = p1; roww[p0] = __int_as_float(route[r * 8 + 4]); roww[p1] = __int_as_float(route[r * 8 + 5]); }
    }
}
DI int stream_row(int p, int dir) { return dir == 0 ? (p < CTXL ? SEQ + p : p - CTXL) : (p < CTXL ? SEQ + (CTXL - 1 - p) : (SEQ - 1) - (p - CTXL)); }

DI void unpack8(const u32x4& p, float (&v)[8]) { v[0] = bflo(p.x); v[1] = bfhi(p.x); v[2] = bflo(p.y); v[3] = bfhi(p.y); v[4] = bflo(p.z); v[5] = bfhi(p.z); v[6] = bflo(p.w); v[7] = bfhi(p.w); }
DI void shortconv_w8(const bf16* Z, const float* cw, const float* cb, int l, int seg, int c0, int r0, int lo, int hi, int lane, float (&out)[8]) {
    const int col = Z_HY + seg * 1024 + c0; float zc[8], zp[8], zn[8];
    unpack8(*(const u32x4*)(Z + (size_t)(r0 + lane) * ZC + col), zc);
    float ep[8], en[8];
    if (r0 - 1 >= lo) unpack8(*(const u32x4*)(Z + (size_t)(r0 - 1) * ZC + col), ep); else {
#pragma unroll
        for (int q = 0; q < 8; ++q) ep[q] = 0.f; }
    if (r0 + 64 < hi) unpack8(*(const u32x4*)(Z + (size_t)(r0 + 64) * ZC + col), en); else {
#pragma unroll
        for (int q = 0; q < 8; ++q) en[q] = 0.f; }
#pragma unroll
    for (int q = 0; q < 8; ++q) { const float up = __shfl_up(zc[q], 1), dn = __shfl_down(zc[q], 1); zp[q] = lane == 0 ? ep[q] : up; zn[q] = lane == 63 ? en[q] : dn; }
    const float* w = cw + (size_t)l * 3 * 3072 + seg * 1024 + c0; const float* bb = cb + (size_t)l * 3072 + seg * 1024 + c0;
    const f32x4 w0a = *(const f32x4*)w, w0b = *(const f32x4*)(w + 4), w1a = *(const f32x4*)(w + 3072), w1b = *(const f32x4*)(w + 3072 + 4), w2a = *(const f32x4*)(w + 6144), w2b = *(const f32x4*)(w + 6144 + 4), ba = *(const f32x4*)bb, b4 = *(const f32x4*)(bb + 4);
#pragma unroll
    for (int q = 0; q < 4; ++q) { out[q] = w0a[q] * zp[q] + w1a[q] * zc[q] + w2a[q] * zn[q] + ba[q]; out[4 + q] = w0b[q] * zp[4 + q] + w1b[q] * zc[4 + q] + w2b[q] * zn[4 + q] + b4[q]; }
}
DI void hyprep_witem(const Args& a, int l, int it) {
    const int lane = otid() & 63, tb = it >> 7, c0 = (it & 127) * 8, r0 = tb * 64, lo = r0 < SEQ ? 0 : SEQ, hi = r0 < SEQ ? SEQ : MT;
    const bf16* Z = (const bf16*)(wsp(a) + WS_Z); bf16* VXT = (bf16*)(wsp(a) + WS_U);
    float x1[8], vv[8];
    shortconv_w8(Z, ain(a, I_HYCW), ain(a, I_HYCB), l, 1, c0, r0, lo, hi, lane, x1); shortconv_w8(Z, ain(a, I_HYCW), ain(a, I_HYCB), l, 2, c0, r0, lo, hi, lane, vv);
#pragma unroll
    for (int q = 0; q < 8; ++q) VXT[(size_t)(c0 + q) * MT + r0 + lane] = f2bf(vv[q] * x1[q]);
}
DI void hycomb_witem(const Args& a, int l, int it) {
    const int lane = otid() & 63, tb = it >> 7, c0 = (it & 127) * 8, r0 = tb * 64, lo = r0 < SEQ ? 0 : SEQ, hi = r0 < SEQ ? SEQ : MT;
    const bf16* Z = (const bf16*)(wsp(a) + WS_Z); const bf16* CV = (const bf16*)(wsp(a) + WS_CVO); bf16* Y0 = (bf16*)(wsp(a) + WS_YMIX);
    float x0[8], y[8];
#pragma unroll
    for (int q = 0; q < 8; ++q) y[q] = bf2f(CV[(size_t)(c0 + q) * MT + r0 + lane]);
    shortconv_w8(Z, ain(a, I_HYCW), ain(a, I_HYCB), l, 0, c0, r0, lo, hi, lane, x0);
    u32x4 w; w.x = pk_bf16(y[0] * x0[0], y[1] * x0[1]); w.y = pk_bf16(y[2] * x0[2], y[3] * x0[3]); w.z = pk_bf16(y[4] * x0[4], y[5] * x0[5]); w.w = pk_bf16(y[6] * x0[6], y[7] * x0[7]);
    *(u32x4*)(Y0 + (size_t)(r0 + lane) * 1024 + c0) = w;
}
DI void scancomb_rows(const Args& a, int l, int nrows) {
    const int lane = otid() & 63, wave = otid() >> 6;
    const bf16* Z = (const bf16*)(wsp(a) + WS_Z); const bf16* O = (const bf16*)(wsp(a) + WS_OSC);
    bf16* Y1 = (bf16*)(wsp(a) + WS_YMIX) + (size_t)MT * 1024; bf16* Y2 = Y1 + (size_t)MT * 1024;
    const float* hnw = ain(a, I_HGNW) + (size_t)l * 128; const float* gnw = ain(a, I_GLNW) + (size_t)l * 256;
    for (int r = obid() * 8 + wave; r < nrows; r += ogdim() * 8) {
#pragma unroll
        for (int i = 0; i < 2; ++i) { const int col = i * 512 + lane * 8;
            { float of[8], ob[8], g[8], o[8]; unpack8(*(const u32x4*)(O + (size_t)r * 1024 + col), of); unpack8(*(const u32x4*)(O + ((size_t)MT + r) * 1024 + col), ob); unpack8(*(const u32x4*)(Z + (size_t)r * ZC + Z_HG + 4096 + col), g);
              float ss = 0.f;
#pragma unroll
              for (int q = 0; q < 8; ++q) { o[q] = of[q] + ob[q]; ss += o[q] * o[q]; }
              ss += __shfl_xor(ss, 8); ss += __shfl_xor(ss, 4); ss += __shfl_xor(ss, 2); ss += __shfl_xor(ss, 1);
              const float rstd = rsqrtf(ss * (1.0f / 128.0f) + NORM_EPS);
              const f32x4 n0 = *(const f32x4*)(hnw + (col & 127)), n1 = *(const f32x4*)(hnw + (col & 127) + 4);
              u32x4 w; w.x = pk_bf16(o[0] * rstd * n0[0] * sigmoidf_(g[0]), o[1] * rstd * n0[1] * sigmoidf_(g[1])); w.y = pk_bf16(o[2] * rstd * n0[2] * sigmoidf_(g[2]), o[3] * rstd * n0[3] * sigmoidf_(g[3]));
              w.z = pk_bf16(o[4] * rstd * n1[0] * sigmoidf_(g[4]), o[5] * rstd * n1[1] * sigmoidf_(g[5])); w.w = pk_bf16(o[6] * rstd * n1[2] * sigmoidf_(g[6]), o[7] * rstd * n1[3] * sigmoidf_(g[7]));
              *(u32x4*)(Y1 + (size_t)r * 1024 + col) = w; }
            { float of[8], ob[8], g[8], o[8]; unpack8(*(const u32x4*)(O + ((size_t)2 * MT + r) * 1024 + col), of); unpack8(*(const u32x4*)(O + ((size_t)3 * MT + r) * 1024 + col), ob); unpack8(*(const u32x4*)(Z + (size_t)r * ZC + Z_GL + 2048 + col), g);
              float ss = 0.f;
#pragma unroll
              for (int q = 0; q < 8; ++q) { o[q] = of[q] + ob[q]; ss += o[q] * o[q]; }
              ss += __shfl_xor(ss, 16); ss += __shfl_xor(ss, 8); ss += __shfl_xor(ss, 4); ss += __shfl_xor(ss, 2); ss += __shfl_xor(ss, 1);
              const float rstd = rsqrtf(ss * (1.0f / 256.0f) + NORM_EPS);
              const f32x4 n0 = *(const f32x4*)(gnw + (col & 255)), n1 = *(const f32x4*)(gnw + (col & 255) + 4);
              u32x4 w; w.x = pk_bf16(o[0] * rstd * n0[0] * siluf_(g[0]), o[1] * rstd * n0[1] * siluf_(g[1])); w.y = pk_bf16(o[2] * rstd * n0[2] * siluf_(g[2]), o[3] * rstd * n0[3] * siluf_(g[3]));
              w.z = pk_bf16(o[4] * rstd * n1[0] * siluf_(g[4]), o[5] * rstd * n1[1] * siluf_(g[5])); w.w = pk_bf16(o[6] * rstd * n1[2] * siluf_(g[6]), o[7] * rstd * n1[3] * siluf_(g[7]));
              *(u32x4*)(Y2 + (size_t)r * 1024 + col) = w; }
        }
    }
}
typedef short bf16x8_t __attribute__((ext_vector_type(8)));
constexpr int SC_N = 65;
constexpr size_t KVS_GL_OFF = (size_t)16 * SC_N * 16384;
constexpr size_t WS_KVS = WS_WGU;
constexpr size_t WS_KD  = WS_WGU + 130 * MiB;
constexpr int SL_QM = 0, SL_KM = 17408, SL_Q0 = 34816, SL_KE = 52224, SL_VT = 70656, SL_PP = 107520, SL_TOT = 116736, SL_DD = 118784, SL_AFB = 119296, SL_EB = 121344;
static_assert(SL_EB + 512 <= 131072 && WS_KD + (size_t)24 * SC_N * 128 * 4 <= WS_H, "scan maps");
DI bf16x8_t lds_frag16(LAS unsigned char* p) { return *(LAS bf16x8_t*)p; }
DI bf16x8_t pack_bf16x8(const f32x4& lo, const f32x4& hi) { u32x4 w; w.x = pk_bf16(lo[0], lo[1]); w.y = pk_bf16(lo[2], lo[3]); w.z = pk_bf16(hi[0], hi[1]); w.w = pk_bf16(hi[2], hi[3]); return __builtin_bit_cast(bf16x8_t, w); }

template <bool GLA, bool OUT> DI void scan_walk(const Args& a, int l, int head, int dir, int sc, int dvh, LAS unsigned char* lds) {
    constexpr int NB = 1, DV = GLA ? 256 : 128;
    const int tid = otid(), lane = tid & 63, wave = tid >> 6, fr = lane & 15, fq = lane >> 4, nbase = dvh * 8 + wave;
    const bf16* Z = (const bf16*)(wsp(a) + WS_Z);
    const int stream = GLA ? 16 + head * 2 + dir : head * 2 + dir;
    float* kvs = (float*)(wsp(a) + WS_KVS) + (GLA ? KVS_GL_OFF + ((size_t)(stream - 16) * SC_N + sc) * 32768 : ((size_t)stream * SC_N + sc) * 16384);
    float* kd = (float*)(wsp(a) + WS_KD) + ((size_t)stream * SC_N + sc) * 128;
    LAS bf16* QM = (LAS bf16*)(lds + SL_QM); LAS bf16* KM = (LAS bf16*)(lds + SL_KM); LAS float* EB = (LAS float*)(lds + SL_EB); LAS bf16* XG = (LAS bf16*)(lds + SL_Q0);
    LAS bf16* KE = (LAS bf16*)(lds + SL_KE); LAS bf16* VT = (LAS bf16*)(lds + SL_VT); LAS bf16* PP = (LAS bf16*)(lds + SL_PP);
    LAS float* TOT = (LAS float*)(lds + SL_TOT); LAS float* DD = (LAS float*)(lds + SL_DD); LAS bf16* AFB = (LAS bf16*)(lds + SL_AFB);
    const int k = (wave & 1) * 64 + lane, seg = wave >> 1;
    float lbv = 0.f, bag = 0.f; bf16x8_t Bg = {0, 0, 0, 0, 0, 0, 0, 0};
    if (!GLA) lbv = ((const float*)(wsp(a) + WS_LB))[((size_t)l * 2 + dir) * 1024 + head * 128 + k];
    else {
        bag = ain(a, I_GLBA)[((size_t)l * 2 + dir) * 512 + head * 128 + wave * 16 + fr];
        if (fq < 2) { const float* wp = ain(a, I_GLWA2) + (((size_t)l * 2 + dir) * 16 + fq * 8) * 512 + head * 128 + wave * 16 + fr; float w8[8];
#pragma unroll
            for (int j = 0; j < 8; ++j) w8[j] = wp[(size_t)j * 512];
            u32x4 pw; pw.x = pk_bf16(w8[0], w8[1]); pw.y = pk_bf16(w8[2], w8[3]); pw.z = pk_bf16(w8[4], w8[5]); pw.w = pk_bf16(w8[6], w8[7]); Bg = __builtin_bit_cast(bf16x8_t, pw); } }
    f32x4 S[NB][8];
#pragma unroll
    for (int nb = 0; nb < NB; ++nb)
#pragma unroll
        for (int mb = 0; mb < 8; ++mb) { if (OUT) S[nb][mb] = *(const f32x4*)(kvs + (size_t)((nbase + nb) * 16 + fr) * 128 + mb * 16 + fq * 4); else S[nb][mb] = (f32x4){0.f, 0.f, 0.f, 0.f}; }
    float dlog = 0.f;
    const int which = (GLA ? 2 : 0) + dir;
    bf16* Odir = (bf16*)(wsp(a) + WS_OSC) + (size_t)which * MT * 1024;
    const int srow = tid >> 3, spc = (tid & 7) * 16;
    const int vcol = (GLA ? Z_GL + 1024 + head * 256 + dvh * 128 : Z_HG + 3072 + head * 128) + wave * 16;
    const int fcol = (GLA ? Z_GL + 512 + head * 128 : Z_HG + 1024 * (1 + dir) + head * 128) + spc, qcol = (GLA ? Z_GL + head * 128 : Z_HG + head * 128) + spc;
    u32x4 pv0, pv1, pf0, pf1, pq0 = {0u, 0u, 0u, 0u}, pq1 = {0u, 0u, 0u, 0u}, pa = {0u, 0u, 0u, 0u};
#define SCAN_ISSUE(cidx) do { const int r0n_ = dir ? stream_row((cidx) * 64 + 63, 1) : stream_row((cidx) * 64, 0); \
        const bf16* vr_ = Z + (size_t)(r0n_ + lane) * ZC + vcol; pv0 = *(const u32x4*)vr_; pv1 = *(const u32x4*)(vr_ + 8); \
        const bf16* zr_ = Z + (size_t)(r0n_ + srow) * ZC; pf0 = *(const u32x4*)(zr_ + fcol); pf1 = *(const u32x4*)(zr_ + fcol + 8); \
        if (OUT) { pq0 = *(const u32x4*)(zr_ + qcol); pq1 = *(const u32x4*)(zr_ + qcol + 8); } \
        if (GLA && tid < 128) pa = *(const u32x4*)(Z + (size_t)(r0n_ + (tid >> 1)) * ZC + Z_LR + dir * 16 + (tid & 1) * 8); } while (0)
    SCAN_ISSUE(sc * 4);
    for (int cc = 0; cc < 4; ++cc) {
        const int c = sc * 4 + cc; const int r0 = dir ? stream_row(c * 64 + 63, 1) : stream_row(c * 64, 0);
        {
#pragma unroll
          for (int q8 = 0; q8 < 2; ++q8) { const u32x4 v = q8 ? pv1 : pv0; const int d0 = wave * 16 + q8 * 8;
              VT[(d0 + 0) * 72 + lane] = (bf16)(v.x & 0xffff); VT[(d0 + 1) * 72 + lane] = (bf16)(v.x >> 16); VT[(d0 + 2) * 72 + lane] = (bf16)(v.y & 0xffff); VT[(d0 + 3) * 72 + lane] = (bf16)(v.y >> 16);
              VT[(d0 + 4) * 72 + lane] = (bf16)(v.z & 0xffff); VT[(d0 + 5) * 72 + lane] = (bf16)(v.z >> 16); VT[(d0 + 6) * 72 + lane] = (bf16)(v.w & 0xffff); VT[(d0 + 7) * 72 + lane] = (bf16)(v.w >> 16); }
          *(LAS u32x4*)(KM + srow * 136 + spc) = pf0; *(LAS u32x4*)(KM + srow * 136 + spc + 8) = pf1;
          if (OUT) { *(LAS u32x4*)(QM + srow * 136 + spc) = pq0; *(LAS u32x4*)(QM + srow * 136 + spc + 8) = pq1; }
          if (GLA && tid < 128) *(LAS u32x4*)(AFB + (tid >> 1) * 16 + (tid & 1) * 8) = pa;
          if (cc < 3) SCAN_ISSUE(c + 1); }
        LDS_BAR();
        if (GLA) {
#pragma unroll
            for (int tb = 0; tb < 4; ++tb) { bf16x8_t Ag = {0, 0, 0, 0, 0, 0, 0, 0}; if (fq < 2) Ag = lds_frag16(lds + SL_AFB + ((tb * 16 + fr) * 16 + fq * 8) * 2);
                f32x4 xg = {bag, bag, bag, bag}; xg = __builtin_amdgcn_mfma_f32_16x16x32_bf16(Ag, Bg, xg, 0, 0, 0);
#pragma unroll
                for (int j = 0; j < 4; ++j) XG[(tb * 16 + fq * 4 + j) * 136 + wave * 16 + fr] = f2bf(xg[j]); }
            LDS_BAR();
        }
        const int tstart = dir ? 63 - seg * 16 : seg * 16, tstep = dir ? -1 : 1;
        float cs[16], kkv[GLA ? 1 : 16]; float run = 0.f;
#ifdef REPMASK
        _Pragma("unroll 1") for (int rp1 = 0; rp1 < (((REPMASK) >> 24) & 1 ? 3 : 1); ++rp1) { run = 0.f;
#else
        {
#endif
#pragma unroll
        for (int i = 0; i < 16; ++i) { const int t = tstart + i * tstep; float la;
            if (!GLA) { const float zf = bf2f(KM[t * 136 + k]); const float sg = sigmoidf_(zf); la = __logf(lbv + (1.0f - lbv) * sg); kkv[i] = (1.0f - lbv) * (1.0f - sg); }
            else { const float x = bf2f(XG[t * 136 + k]); la = (fminf(x, 0.f) - __logf(1.0f + __expf(-fabsf(x)))) * 0.0625f; }
            run += la; cs[i] = run; }
        }
        TOT[seg * 128 + k] = run;
        LDS_BAR();
        { const float t0 = TOT[k], t1 = TOT[128 + k], t2 = TOT[256 + k], t3 = TOT[384 + k];
          const float off = seg == 0 ? 0.f : (seg == 1 ? t0 : (seg == 2 ? t0 + t1 : t0 + t1 + t2)), blast = (t0 + t1) + (t2 + t3), bref = t0 + t1;
          float ke[16]; const float ebl = __expf(blast - bref);
#pragma unroll
          for (int i = 0; i < 16; ++i) { const int t = tstart + i * tstep; const float b = off + cs[i];
              float kk; if (GLA) kk = bf2f(KM[t * 136 + k]); else kk = kkv[i];
              const float e1 = __expf(fminf(fmaxf(b - bref, -80.0f), 80.0f)), r1 = __builtin_amdgcn_rcpf(e1), kr = kk * r1;
              if (OUT) { const float qr = bf2f(QM[t * 136 + k]); const float qv = GLA ? qr * 0.08838834764831845f : siluf_(qr);
                  QM[t * 136 + k] = f2bf(qv * e1); KM[t * 136 + k] = f2bf(kr); }
              ke[i] = kr * ebl; }
          if (OUT && seg == 0) EB[k] = __expf(bref);
          const int tb0 = dir ? 48 - seg * 16 : seg * 16; u32x4 w0, w1;
          if (dir) { w0.x = pk_bf16(ke[15], ke[14]); w0.y = pk_bf16(ke[13], ke[12]); w0.z = pk_bf16(ke[11], ke[10]); w0.w = pk_bf16(ke[9], ke[8]); w1.x = pk_bf16(ke[7], ke[6]); w1.y = pk_bf16(ke[5], ke[4]); w1.z = pk_bf16(ke[3], ke[2]); w1.w = pk_bf16(ke[1], ke[0]); }
          else     { w0.x = pk_bf16(ke[0], ke[1]); w0.y = pk_bf16(ke[2], ke[3]); w0.z = pk_bf16(ke[4], ke[5]); w0.w = pk_bf16(ke[6], ke[7]); w1.x = pk_bf16(ke[8], ke[9]); w1.y = pk_bf16(ke[10], ke[11]); w1.z = pk_bf16(ke[12], ke[13]); w1.w = pk_bf16(ke[14], ke[15]); }
          *(LAS u32x4*)(KE + k * 72 + tb0) = w0; *(LAS u32x4*)(KE + k * 72 + tb0 + 8) = w1;
          if (seg == 0) DD[k] = __expf(blast);
          dlog += blast; }
        LDS_BAR();
        bf16x8_t Bv[NB][2];
#pragma unroll
        for (int nb = 0; nb < NB; ++nb)
#pragma unroll
            for (int ks = 0; ks < 2; ++ks) Bv[nb][ks] = lds_frag16(lds + SL_VT + ((wave * 16 + fr) * 72 + ks * 32 + fq * 8) * 2);
        if (OUT) {
#ifdef REPMASK
          _Pragma("unroll 1") for (int rp2 = 0; rp2 < (((REPMASK) >> 25) & 1 ? 3 : 1); ++rp2) { if (rp2) LDS_BAR();
#else
          {
#endif
            { const int tb = wave >> 1;
#pragma unroll
              for (int sbi = 0; sbi < 2; ++sbi) { const int sb = (wave & 1) * 2 + sbi; f32x4 acc = {0.f, 0.f, 0.f, 0.f};
#pragma unroll
                  for (int ks = 0; ks < 4; ++ks) acc = __builtin_amdgcn_mfma_f32_16x16x32_bf16(lds_frag16(lds + SL_QM + ((tb * 16 + fr) * 136 + ks * 32 + fq * 8) * 2), lds_frag16(lds + SL_KM + ((sb * 16 + fr) * 136 + ks * 32 + fq * 8) * 2), acc, 0, 0, 0);
#pragma unroll
                  for (int j = 0; j < 4; ++j) { const int t = tb * 16 + fq * 4 + j, s = sb * 16 + fr; const bool keep = dir ? (s >= t) : (s <= t); PP[t * 72 + s] = keep ? f2bf(acc[j]) : (bf16)0; } } }
            LDS_BAR();
#pragma unroll
            for (int nb = 0; nb < NB; ++nb) {
                bf16x8_t Bs[4];
#pragma unroll
                for (int ks = 0; ks < 4; ++ks) { const f32x4 e0 = *(LAS f32x4*)(EB + (2 * ks) * 16 + fq * 4), e1 = *(LAS f32x4*)(EB + (2 * ks + 1) * 16 + fq * 4); Bs[ks] = pack_bf16x8(S[nb][2 * ks] * e0, S[nb][2 * ks + 1] * e1); }
#pragma unroll
                for (int mb = 0; mb < 4; ++mb) {
                    f32x4 O = {0.f, 0.f, 0.f, 0.f};
#pragma unroll
                    for (int ks = 0; ks < 2; ++ks) O = __builtin_amdgcn_mfma_f32_16x16x32_bf16(lds_frag16(lds + SL_PP + ((mb * 16 + fr) * 72 + ks * 32 + fq * 8) * 2), Bv[nb][ks], O, 0, 0, 0);
#pragma unroll
                    for (int ks = 0; ks < 4; ++ks) { u32x4 aw; const u32x2 lo = *(LAS u32x2*)(lds + SL_QM + ((mb * 16 + fr) * 136 + (2 * ks) * 16 + fq * 4) * 2), hi = *(LAS u32x2*)(lds + SL_QM + ((mb * 16 + fr) * 136 + (2 * ks + 1) * 16 + fq * 4) * 2);
                        aw.x = lo.x; aw.y = lo.y; aw.z = hi.x; aw.w = hi.y;
                        O = __builtin_amdgcn_mfma_f32_16x16x32_bf16(__builtin_bit_cast(bf16x8_t, aw), Bs[ks], O, 0, 0, 0); }
#pragma unroll
                    for (int j = 0; j < 4; ++j) Odir[(size_t)(r0 + mb * 16 + fq * 4 + j) * 1024 + head * DV + (nbase + nb) * 16 + fr] = f2bf(O[j]);
                    asm volatile("" ::: "memory");
                }
            }
          }
        }
        if (!OUT || cc < 3) {
#pragma unroll
            for (int mb = 0; mb < 8; ++mb) { const f32x4 dd = *(LAS f32x4*)(DD + mb * 16 + fq * 4);
                const bf16x8_t A0 = lds_frag16(lds + SL_KE + ((mb * 16 + fr) * 72 + fq * 8) * 2), A1 = lds_frag16(lds + SL_KE + ((mb * 16 + fr) * 72 + 32 + fq * 8) * 2);
#pragma unroll
                for (int nb = 0; nb < NB; ++nb) { S[nb][mb] = S[nb][mb] * dd; S[nb][mb] = __builtin_amdgcn_mfma_f32_16x16x32_bf16(A0, Bv[nb][0], S[nb][mb], 0, 0, 0); S[nb][mb] = __builtin_amdgcn_mfma_f32_16x16x32_bf16(A1, Bv[nb][1], S[nb][mb], 0, 0, 0); }
                asm volatile("" ::: "memory"); }
        }
        LDS_BAR();
    }
    if (!OUT) {
#pragma unroll
        for (int nb = 0; nb < NB; ++nb)
#pragma unroll
            for (int mb = 0; mb < 8; ++mb) *(f32x4*)(kvs + (size_t)((nbase + nb) * 16 + fr) * 128 + mb * 16 + fq * 4) = S[nb][mb];
        if (seg == 0) kd[k] = __expf(dlog);
    }
}
#undef SCAN_ISSUE
DI void scan_prop(const Args& a) {
    float* kvs = (float*)(wsp(a) + WS_KVS); const float* kd = (const float*)(wsp(a) + WS_KD);
    for (int g = obid() * NTHR + otid(); g < 131072; g += ogdim() * NTHR) {
        float* p; size_t stride; const float* dp;
        if (g < 65536) { const int stream = g >> 12, e = g & 4095; p = kvs + (size_t)stream * SC_N * 16384 + (size_t)e * 4; stride = 16384; dp = kd + (size_t)stream * SC_N * 128 + (e & 31) * 4; }
        else { const int q = g - 65536, stream = q >> 13, e = q & 8191; p = kvs + KVS_GL_OFF + (size_t)stream * SC_N * 32768 + (size_t)e * 4; stride = 32768; dp = kd + (size_t)(16 + stream) * SC_N * 128 + (e & 31) * 4; }
        f32x4 S = {0.f, 0.f, 0.f, 0.f};
#pragma unroll 5
        for (int sc = 0; sc < SC_N; ++sc) { const f32x4 kv = *(const f32x4*)(p + sc * stride), d = *(const f32x4*)(dp + sc * 128); *(f32x4*)(p + sc * stride) = S; S = d * S + kv; }
    }
}
constexpr int SCAN_ITEMS = 32 * SC_N;
template <bool OUT> DI void scan_item2(const Args& a, int l, int it, LAS unsigned char* lds) {
    if (it < 16 * SC_N) { const int s = it / SC_N, sc = it % SC_N; if (OUT && l == DEPTH - 1 && sc == 0) return; scan_walk<true, OUT>(a, l, s >> 2, (s >> 1) & 1, sc, s & 1, lds); }
    else { const int j = it - 16 * SC_N, s = j / SC_N, sc = j % SC_N; if (OUT && l == DEPTH - 1 && sc == 0) return; scan_walk<false, OUT>(a, l, s >> 1, s & 1, sc, 0, lds); }
}
DI void hyconv_item(const Args& a, int l, int c, LAS unsigned char* ldsb) {
    const int tid = otid();
    LAS float* lds = (LAS float*)ldsb;
    LAS float* xs = (LAS float*)(ldsb + LDS_X);
    const float* tw = (const float*)(wsp(a) + WS_TW); const float* tw2 = (const float*)(wsp(a) + WS_TW2);
    const float* h2 = (const float*)(wsp(a) + WS_H2) + (size_t)l * MT * 64;
    const bf16* VX = (const bf16*)(wsp(a) + WS_U) + (size_t)c * MT; bf16* VO = (bf16*)(wsp(a) + WS_CVO) + (size_t)c * MT;
#ifdef REPMASK
    _Pragma("unroll 1") for (int rpa = 0; rpa < (((REPMASK) >> 21) & 1 ? 2 : 1); ++rpa) { if (rpa) __syncthreads();
#else
    {
#endif
    const bf16* HFf = (const bf16*)(wsp(a) + WS_HF) + (size_t)c * SEQ; const bf16* HFb = HFf + (size_t)1024 * SEQ;
    const float a0 = -4.605170186f / 1.5f, a1 = -4.605170186f / 0.3f;
    const float nd = -fabsf(a0 + (float)c * ((a1 - a0) / 1023.0f)) * (1.0f / (float)(SEQ - 1));
    const float b3f = ain(a, I_HYB3)[l * 2048 + c], b3b = ain(a, I_HYB3)[l * 2048 + 1024 + c];
    float sf = 0.f, sb = 0.f;
#pragma unroll
    for (int i = 0; i < 8; ++i) { const int t4 = (tid + 512 * i) * 4; const u32x2 rf = *(const u32x2*)(HFf + t4), rb = *(const u32x2*)(HFb + t4);
        f32x4 hf, hb; hf[0] = bflo(rf.x); hf[1] = bfhi(rf.x); hf[2] = bflo(rf.y); hf[3] = bfhi(rf.y); hb[0] = bflo(rb.x); hb[1] = bfhi(rb.x); hb[2] = bflo(rb.y); hb[3] = bfhi(rb.y);
#pragma unroll
        for (int q = 0; q < 4; ++q) { const float dec = __expf(nd * (float)(t4 + q)) + 0.05f; hf[q] = (hf[q] + b3f) * dec; hb[q] = (hb[q] + b3b) * dec; }
        sf += (fabsf(hf[0]) + fabsf(hf[1])) + (fabsf(hf[2]) + fabsf(hf[3])); sb += (fabsf(hb[0]) + fabsf(hb[1])) + (fabsf(hb[2]) + fabsf(hb[3]));
        *(LAS f32x4*)(lds + t4) = hf;
#pragma unroll
        for (int q = 0; q < 4; ++q) { const int t = t4 + q; if (t > 0) lds[32768 - t] = hb[q]; else xs[160] = hb[q]; } }
    sf = wave_sum(sf); sb = wave_sum(sb);
    if ((tid & 63) == 0) { xs[128 + (tid >> 6)] = sf; xs[136 + (tid >> 6)] = sb; }
    __syncthreads();
    float tf = 0.f, tb = 0.f;
#pragma unroll
    for (int w = 0; w < 8; ++w) { tf += xs[128 + w]; tb += xs[136 + w]; }
    const float inf_ = 1.0f / tf, inb_ = 1.0f / tb;
#pragma unroll 8
    for (int i = 0; i < 64; ++i) { const int m = tid + 512 * i; float v = lds[m];
        if (m == 0) v = v * inf_ + xs[160] * inb_ + ain(a, I_HYSKIP)[l * 1024 + c];
        else if (m < SEQ) v *= inf_; else if (m == SEQ) v = 0.f; else v *= inb_;
        lds[m] = v; }
    __syncthreads();
    }
    { FftTw T; fft_load_tw(T, tw, tid);
    fft_fwd_pass<4096>(lds, T, tw, tid); LDS_BAR(); fft_fwd_pass<1024>(lds, T, tw, tid); LDS_BAR(); fft_fwd_pass<256>(lds, T, tw, tid); LDS_BAR(); fft_fwd_pass<64>(lds, T, tw, tid); LDS_BAR();
    fft_fwd_pass<16>(lds, T, tw, tid); LDS_BAR(); fft_fwd_pass<4>(lds, T, tw, tid); LDS_BAR(); fft_fwd_pass<1>(lds, T, tw, tid); LDS_BAR(); }
#ifdef REPMASK
    if (((REPMASK) >> 22) & 1) { FftTw T; fft_load_tw(T, tw, tid);
        fft_inv_pass<1>(lds, T, tw, tid); LDS_BAR(); fft_inv_pass<4>(lds, T, tw, tid); LDS_BAR(); fft_inv_pass<16>(lds, T, tw, tid); LDS_BAR(); fft_inv_pass<64>(lds, T, tw, tid); LDS_BAR();
        fft_inv_pass<256>(lds, T, tw, tid); LDS_BAR(); fft_inv_pass<1024>(lds, T, tw, tid); LDS_BAR(); fft_inv_pass<4096>(lds, T, tw, tid); LDS_BAR();
        for (int i = 0; i < 64; ++i) lds[tid + 512 * i] *= (1.0f / FFT_M);
        LDS_BAR();
        fft_fwd_pass<4096>(lds, T, tw, tid); LDS_BAR(); fft_fwd_pass<1024>(lds, T, tw, tid); LDS_BAR(); fft_fwd_pass<256>(lds, T, tw, tid); LDS_BAR(); fft_fwd_pass<64>(lds, T, tw, tid); LDS_BAR();
        fft_fwd_pass<16>(lds, T, tw, tid); LDS_BAR(); fft_fwd_pass<4>(lds, T, tw, tid); LDS_BAR(); fft_fwd_pass<1>(lds, T, tw, tid); LDS_BAR(); }
#endif

    float* Gs = (float*)(wsp(a) + WS_YMIX) + (size_t)obid() * 32768;
    const int kbase = ((tid & 63) << 7) | ((tid >> 6) << 4);
#ifdef REPMASK
    _Pragma("unroll 1") for (int rpc = 0; rpc < (((REPMASK) >> 23) & 1 ? 2 : 1); ++rpc)
#endif
#pragma unroll 4
    for (int j = 0; j < 16; ++j) { const int k = kbase | j; cpx gk, gm; rfft_untangle(lds, tw2, k, gk, gm); f32x4 g4; g4[0] = gk.x; g4[1] = gk.y; g4[2] = gm.x; g4[3] = gm.y; *(f32x4*)(Gs + (size_t)(j * 512 + tid) * 4) = g4; }
    __syncthreads();
#pragma unroll
    for (int i = 0; i < 16; ++i) { const int m4 = tid + 512 * i; f32x4 v = {0.f, 0.f, 0.f, 0.f}; if (m4 < SEQ / 4) { const u32x2 r = *(const u32x2*)(VX + m4 * 4); v[0] = bflo(r.x); v[1] = bfhi(r.x); v[2] = bflo(r.y); v[3] = bfhi(r.y); } *(LAS f32x4*)(lds + m4 * 4) = v; }
    __syncthreads();
    { FftTw T; fft_load_tw(T, tw, tid);
    fft_fwd_pass<4096>(lds, T, tw, tid); LDS_BAR(); fft_fwd_pass<1024>(lds, T, tw, tid); LDS_BAR(); fft_fwd_pass<256>(lds, T, tw, tid); LDS_BAR(); fft_fwd_pass<64>(lds, T, tw, tid); LDS_BAR();
    fft_fwd_pass<16>(lds, T, tw, tid); LDS_BAR(); fft_fwd_pass<4>(lds, T, tw, tid); LDS_BAR(); fft_fwd_pass<1>(lds, T, tw, tid); LDS_BAR(); }
#pragma unroll 4
    for (int j = 0; j < 16; ++j) { const int k = kbase | j; const f32x4 g4 = *(const f32x4*)(Gs + (size_t)(j * 512 + tid) * 4); cpx gk, gm; gk.x = g4[0]; gk.y = g4[1]; gm.x = g4[2]; gm.y = g4[3]; rfft_mul_retangle(lds, tw2, k, gk, gm); }
    __syncthreads();
    { FftTw T; fft_load_tw(T, tw, tid);
    fft_inv_pass<1>(lds, T, tw, tid); LDS_BAR(); fft_inv_pass<4>(lds, T, tw, tid); LDS_BAR(); fft_inv_pass<16>(lds, T, tw, tid); LDS_BAR(); fft_inv_pass<64>(lds, T, tw, tid); LDS_BAR();
    fft_inv_pass<256>(lds, T, tw, tid); LDS_BAR(); fft_inv_pass<1024>(lds, T, tw, tid); LDS_BAR(); fft_inv_pass<4096>(lds, T, tw, tid); LDS_BAR(); }
#pragma unroll
    for (int i = 0; i < 8; ++i) { const int m4 = tid + 512 * i; const f32x4 v = *(const LAS f32x4*)(lds + m4 * 4) * (1.0f / FFT_M); u32x2 o; o.x = pk_bf16(v[0], v[1]); o.y = pk_bf16(v[2], v[3]); *(u32x2*)(VO + m4 * 4) = o; }
    __syncthreads();
}
DI void hycctx_item(const Args& a, int l, int it, LAS unsigned char* ldsb) {
    const int tid = otid(), c0 = it * 4;
    LAS float* sv = (LAS float*)ldsb;
    LAS float* sf = sv + 4 * 256;
    LAS float* sb = sf + 4 * 256;
    const float* hyc = (const float*)(wsp(a) + WS_HYC); const bf16* VXT = (const bf16*)(wsp(a) + WS_U); bf16* CVO = (bf16*)(wsp(a) + WS_CVO);
    for (int i = tid; i < 4 * 256; i += NTHR) { const int ch = i >> 8, t = i & 255; sv[i] = bf2f(VXT[(size_t)(c0 + ch) * MT + SEQ + t]); sf[i] = hyc[(size_t)(c0 + ch) * 256 + t]; sb[i] = hyc[(size_t)(1024 + c0 + ch) * 256 + t]; }
    __syncthreads();
    const int ch = tid >> 7, tq = tid & 127; const float g0 = sf[ch * 256] + sb[ch * 256] + ain(a, I_HYSKIP)[l * 1024 + c0 + ch];
    float acc0 = 0.f, acc1 = 0.f; const int t0 = tq * 2;
    for (int s = 0; s < 256; ++s) { const float vv = sv[ch * 256 + s]; const int d0 = t0 - s, d1 = d0 + 1;
        const float ga = d0 > 0 ? sf[ch * 256 + d0] : (d0 < 0 ? sb[ch * 256 - d0] : g0), gb = d1 > 0 ? sf[ch * 256 + d1] : (d1 < 0 ? sb[ch * 256 - d1] : g0);
        acc0 += ga * vv; acc1 += gb * vv; }
    *(unsigned*)(CVO + (size_t)(c0 + ch) * MT + SEQ + t0) = pk_bf16(acc0, acc1);
    __syncthreads();
}

struct EpiHF {
    static constexpr bool PERM = true, AFTER_DRAIN = false; bf16* O;
    DI void operator()(const f32x4 (&acc)[2][2][4][2], const pg8::Unit& u, int wr, int wc, int fr, int fq) const {
        const int row0 = u.pm * 256 + wr * 64 + fr, col0 = u.pn * 256 + wc * 32 + 8 * fq;
#pragma unroll
        for (int ai = 0; ai < 2; ++ai)
#pragma unroll
            for (int m = 0; m < 4; ++m) { bf16* rowp = O + (size_t)(row0 + ai * 128 + m * 16) * SEQ + col0;
#pragma unroll
                for (int bj = 0; bj < 2; ++bj) { const f32x4 v0 = acc[ai][bj][m][0], v1 = acc[ai][bj][m][1];
                    u32x4 w; w.x = pk_bf16(v0[0], v0[1]); w.y = pk_bf16(v0[2], v0[3]); w.z = pk_bf16(v1[0], v1[1]); w.w = pk_bf16(v1[2], v1[3]);
                    *(u32x4*)(rowp + bj * 128) = w; } }
    }
};
struct EpiZ {
    static constexpr bool PERM = true, AFTER_DRAIN = false; bf16* O; const float* bias;
    DI void operator()(const f32x4 (&acc)[2][2][4][2], const pg8::Unit& u, int wr, int wc, int fr, int fq) const {
        const int row0 = u.pm * 256 + wr * 64 + fr, col0 = u.pn * 256 + wc * 32 + 8 * fq;
        f32x4 bv[2][2];
#pragma unroll
        for (int bj = 0; bj < 2; ++bj)
#pragma unroll
            for (int n = 0; n < 2; ++n) bv[bj][n] = *(const f32x4*)(bias + col0 + bj * 128 + 4 * n);
#pragma unroll
        for (int ai = 0; ai < 2; ++ai)
#pragma unroll
            for (int m = 0; m < 4; ++m) { bf16* rowp = O + (size_t)(row0 + ai * 128 + m * 16) * ZC + col0;
#pragma unroll
                for (int bj = 0; bj < 2; ++bj) { const f32x4 v0 = acc[ai][bj][m][0] + bv[bj][0], v1 = acc[ai][bj][m][1] + bv[bj][1];
                    u32x4 w; w.x = pk_bf16(v0[0], v0[1]); w.y = pk_bf16(v0[2], v0[3]); w.z = pk_bf16(v1[0], v1[1]); w.w = pk_bf16(v1[2], v1[3]);
                    *(u32x4*)(rowp + bj * 128) = w; } }
    }
};
template <int BR> struct EpiBr {
    static constexpr bool PERM = true, AFTER_DRAIN = false; bf16* Mg; const bf16* Zg;
    DI void operator()(const f32x4 (&acc)[2][2][4][2], const pg8::Unit& u, int wr, int wc, int fr, int fq) const {
        const int row0 = u.pm * 256 + wr * 64 + fr, col0 = u.pn * 256 + wc * 32 + 8 * fq;
#pragma unroll
        for (int ai = 0; ai < 2; ++ai)
#pragma unroll
            for (int m = 0; m < 4; ++m) { const size_t row = (size_t)(row0 + ai * 128 + m * 16);
#pragma unroll
                for (int bj = 0; bj < 2; ++bj) { const int col = col0 + bj * 128;
                    const u32x4 g = *(const u32x4*)(Zg + row * ZC + col);
                    f32x4 v0 = acc[ai][bj][m][0], v1 = acc[ai][bj][m][1];
                    v0[0] *= sigmoidf_(bflo(g.x)); v0[1] *= sigmoidf_(bfhi(g.x)); v0[2] *= sigmoidf_(bflo(g.y)); v0[3] *= sigmoidf_(bfhi(g.y));
                    v1[0] *= sigmoidf_(bflo(g.z)); v1[1] *= sigmoidf_(bfhi(g.z)); v1[2] *= sigmoidf_(bflo(g.w)); v1[3] *= sigmoidf_(bfhi(g.w));
                    if (BR > 0) { const u32x4 p = *(const u32x4*)(Mg + row * D + col);
                        v0[0] += bflo(p.x); v0[1] += bfhi(p.x); v0[2] += bflo(p.y); v0[3] += bfhi(p.y); v1[0] += bflo(p.z); v1[1] += bfhi(p.z); v1[2] += bflo(p.w); v1[3] += bfhi(p.w); }
                    u32x4 w; w.x = pk_bf16(v0[0], v0[1]); w.y = pk_bf16(v0[2], v0[3]); w.z = pk_bf16(v1[0], v1[1]); w.w = pk_bf16(v1[2], v1[3]);
                    *(u32x4*)(Mg + row * D + col) = w; } }
    }
};
struct EpiOut {
    static constexpr bool PERM = false, AFTER_DRAIN = false; const float* hin_main; const float* hin_ctx; float* hout; const float* gt1;
    DI void operator()(const f32x4 (&acc)[2][2][4][2], const pg8::Unit& u, int wr, int wc, int fr, int fq) const {
        const int row0 = u.pm * 256 + wr * 64 + fr, col0 = u.pn * 256 + wc * 32 + 4 * fq; const bool isctx = u.pm >= SEQ / 256;
        const float* g = gt1 + (isctx ? 12288 : 0);
        f32x4 gv[2][2];
#pragma unroll
        for (int bj = 0; bj < 2; ++bj)
#pragma unroll
            for (int n = 0; n < 2; ++n) gv[bj][n] = *(const f32x4*)(g + col0 + bj * 128 + n * 16);
#pragma unroll
        for (int ai = 0; ai < 2; ++ai)
#pragma unroll
            for (int m = 0; m < 4; ++m) { const int row = row0 + ai * 128 + m * 16;
                const float* ip = (isctx ? hin_ctx + (size_t)(row - SEQ) * D : hin_main + (size_t)row * D) + col0; float* op = hout + (size_t)row * D + col0;
#pragma unroll
                for (int bj = 0; bj < 2; ++bj)
#pragma unroll
                    for (int n = 0; n < 2; ++n) { const f32x4 b = *(const f32x4*)(ip + bj * 128 + n * 16); *(f32x4*)(op + bj * 128 + n * 16) = b + gv[bj][n] * acc[ai][bj][m][n]; } }
    }
};
struct EpiGU {
    static constexpr bool PERM = true, AFTER_DRAIN = false; bf16* Hm;
    DI void operator()(const f32x4 (&acc)[2][2][4][2], const pg8::Unit& u, int wr, int wc, int fr, int fq) const {
        const int row0 = u.pm * 256 + wr * 64 + fr, col0 = (u.pn & 3) * 128 + wc * 32 + 8 * fq;
#pragma unroll
        for (int ai = 0; ai < 2; ++ai)
#pragma unroll
            for (int m = 0; m < 4; ++m) { const f32x4 g0 = acc[ai][0][m][0], g1 = acc[ai][0][m][1], u0 = acc[ai][1][m][0], u1 = acc[ai][1][m][1];
                u32x4 w; w.x = pk_bf16(siluf_(g0[0]) * u0[0], siluf_(g0[1]) * u0[1]); w.y = pk_bf16(siluf_(g0[2]) * u0[2], siluf_(g0[3]) * u0[3]);
                w.z = pk_bf16(siluf_(g1[0]) * u1[0], siluf_(g1[1]) * u1[1]); w.w = pk_bf16(siluf_(g1[2]) * u1[2], siluf_(g1[3]) * u1[3]);
                *(u32x4*)(Hm + (size_t)(row0 + ai * 128 + m * 16) * DFF + col0) = w; }
    }
};
struct EpiDn {
    static constexpr bool PERM = true, AFTER_DRAIN = false; bf16* Y; const float* roww;
    DI void operator()(const f32x4 (&acc)[2][2][4][2], const pg8::Unit& u, int wr, int wc, int fr, int fq) const {
        const int row0 = u.pm * 256 + wr * 64 + fr, col0 = (u.pn & 7) * 256 + wc * 32 + 8 * fq;
#pragma unroll
        for (int ai = 0; ai < 2; ++ai)
#pragma unroll
            for (int m = 0; m < 4; ++m) { const int row = row0 + ai * 128 + m * 16; const float rw = roww[row];
#pragma unroll
                for (int bj = 0; bj < 2; ++bj) { const f32x4 v0 = acc[ai][bj][m][0] * rw, v1 = acc[ai][bj][m][1] * rw;
                    u32x4 w; w.x = pk_bf16(v0[0], v0[1]); w.y = pk_bf16(v0[2], v0[3]); w.z = pk_bf16(v1[0], v1[1]); w.w = pk_bf16(v1[2], v1[3]);
                    *(u32x4*)(Y + (size_t)row * D + col0 + bj * 128) = w; } }
    }
};
struct MoeOrder {
    const int* tile_e; int ntiles, nsub, G, c;
    DI bool next(int i, pg8::Unit& u) const { const int j = i * G + c; if (j >= ntiles * nsub) return false; const int ti = j / nsub; u.pm = ti; u.pn = tile_e[ti] * nsub + (j - ti * nsub); return true; }
    DI void a_ready(const pg8::Unit&) const {}
    DI void done(const pg8::Unit&) const {}
};
constexpr int NPH_LAYER = 13, PH_FINAL = 1 + NPH_LAYER * DEPTH, NPHASES = PH_FINAL + 1;
struct KArgs { Args a; int li, pad; };
__global__ void __launch_bounds__(NTHR, 2) fwd_kernel(KArgs ka) {
    const Args& a = ka.a;
    const int tid = otid();
#define bid ((int)obid())
#define G ((int)ogdim())
    if (tid == 0) { ((LAS unsigned*)(ldsbase() + LDS_BARW))[0] = 0u; ((LAS unsigned*)(ldsbase() + LDS_BARW))[1] = 0u;
        LAS unsigned long long* ptab = (LAS unsigned long long*)(ldsbase() + LDS_PTAB);
#pragma unroll
        for (int i = 0; i < N_IN; ++i) ptab[i] = (unsigned long long)ka.a.in[i]; }
    __syncthreads();
#ifdef PROBE_SEL
    if (tid < 64) ((LAS unsigned long long*)(ldsbase() + LDS_TIM))[tid] = 0ull;
    __syncthreads();
    const unsigned long long tkern_ = __builtin_amdgcn_s_memrealtime();
#endif
    XcdBarrier bar = xcd_barrier_post((unsigned*)(wsp(a) + WS_CTL) + CW_BAR + ka.li * XCD_BAR_WORDS, (volatile LAS unsigned*)(ldsbase() + LDS_BARW));
    const int lo = a.ph_lo, hi = a.ph_hi;
#ifndef PHMASK
#define PHMASK 0xFFFF
#endif
#define EN(i) (((PHMASK) >> (i)) & 1)
#ifndef REPMASK
#define REPMASK 0
#endif
#define REP(i) (((REPMASK) >> (i)) & 1)
#define RUN(i, cond, ...) do { _Pragma("unroll 1") for (int rep_ = 0; rep_ < ((REP(i) && (cond)) ? REPN : 1); ++rep_) { if (rep_) __syncthreads(); __VA_ARGS__; } } while (0)
#ifndef REPN
#define REPN 2
#endif
#define IN(k) (opq(lo) <= (k) && (k) < opq(hi))
#define SEAM(k) do { if (IN(k) && IN((k) + 1)) { TIC(); xcd_barrier(bar); TOC(30); } } while (0)
#define ws wsp(a)
#define lds ldsbase()
#define ldsf ((LAS float*)ldsbase())
#define U ((bf16*)(wsp(a) + WS_U))
#define Z ((bf16*)(wsp(a) + WS_Z))
#define H ((float*)(wsp(a) + WS_H))
#define modall ((const float*)(wsp(a) + WS_MOD))

    { TIC();
    if (EN(0) && IN(0)) {
        RUN(0, true, prologue_small(a);
        for (int it = bid; it < 256; it += G) mod_item(a, it, ldsf);
        for (int it = bid; it < DEPTH * (MT / 8); it += G) h2_item(a, it, ldsf));
    }
    TOC(31); } SEAM(0);
    for (int l = 0; l < DEPTH; ++l) {
        const int pb = 1 + NPH_LAYER * l;
        const int nrows = (l == 0) ? MT : SEQ;
        { TIC();
        if (EN(1) && IN(pb + 0)) {
            RUN(1, l == 0, norm_phase<0>(a, l, MT, ldsf));
            RUN(16, true, if (l == 0) hyc_filters(a, 0));
            __syncthreads(); RUN(2, true, cvt_stream<false>(a, l, ldsf)); __syncthreads();
        }
        TOC(1); } SEAM(pb + 0); { TIC();
        if (EN(2) && IN(pb + 1)) {
            pg8::Gemm g{U, (const bf16*)(ws + WS_WIN), MT, ZC, D}; pg8::StaticOrder S; S.init(MT, ZC, G, bid);
            EpiZ E{Z, (const float*)(ws + WS_ZBIAS) + (size_t)l * ZC};
            RUN(3, true, pg8::gemm_phase<EpiZ, pg8::StaticOrder, true, true>(lds, g, S, E));
        }
        TOC(2); } SEAM(pb + 1); { TIC();
        if (EN(3) && IN(pb + 2)) { const int nit = (nrows / 64) * 16; { const int g_ = G, w0_ = __builtin_amdgcn_readfirstlane(tid >> 6) * g_ + bid, n_ = (nrows / 64) * 128; RUN(4, true, for (int it = w0_; it < n_; it += 8 * g_) hyprep_witem(a, l, it)); }
            __syncthreads();
            pg8::Gemm g{(const bf16*)(ws + WS_W3T) + (size_t)l * 2048 * 256, (const bf16*)(ws + WS_H2B) + (size_t)l * SEQ * 256, 2048, SEQ, opq(256)  }; pg8::StaticOrder S; S.init(2048, SEQ, G, bid);
            EpiHF E{(bf16*)(ws + WS_HF)};
            RUN(18, true, pg8::gemm_phase<EpiHF, pg8::StaticOrder, true, true>(lds, g, S, E)); }
        TOC(3); } SEAM(pb + 2); { TIC();
        if (EN(4) && IN(pb + 3)) {
            RUN(5, true, for (int it = bid; it < SCAN_ITEMS; it += G) scan_item2<false>(a, l, it, lds));
            RUN(6, true, for (int c = bid; c < 1024; c += G) hyconv_item(a, l, c, lds));
            RUN(15, true, if (l == 0) for (int it = bid; it < 256; it += G) hycctx_item(a, l, it, lds));
        }
        TOC(4); } SEAM(pb + 3); { TIC();
        if (EN(13) && IN(pb + 4)) { scan_prop(a); if (REP(20)) { __syncthreads(); scan_prop(a); scan_prop(a); } }
        TOC(5); } SEAM(pb + 4); { TIC();
        if (EN(14) && IN(pb + 5)) { RUN(17, true, for (int it = bid; it < SCAN_ITEMS; it += G) scan_item2<true>(a, l, it, lds)); }
        TOC(6); } SEAM(pb + 5); { TIC();
        if (EN(5) && IN(pb + 6)) {
            const int nit = (nrows / 64) * 16;
            { const int g_ = G, w0_ = __builtin_amdgcn_readfirstlane(tid >> 6) * g_ + bid, n_ = (nrows / 64) * 128; RUN(7, true, scancomb_rows(a, l, nrows); for (int it = w0_; it < n_; it += 8 * g_) hycomb_witem(a, l, it)); }
        }
        TOC(7); } SEAM(pb + 6); { TIC();
        if (EN(6) && IN(pb + 7)) {
            const bf16* Y = (const bf16*)(ws + WS_YMIX); const bf16* WB = (const bf16*)(ws + WS_WBR);
            pg8::StaticOrder S; S.init(nrows, D, G, bid);
            RUN(8, true,
            { pg8::Gemm g{Y, WB, nrows, D, 1024}; EpiBr<0> E{U, Z + Z_MG}; pg8::gemm_phase<EpiBr<0>, pg8::StaticOrder, true, true>(lds, g, S, E); }
            __syncthreads();
            { pg8::Gemm g{Y + (size_t)MT * 1024, WB + (size_t)D * 1024, nrows, D, 1024}; EpiBr<1> E{U, Z + Z_MG + D}; pg8::gemm_phase<EpiBr<1>, pg8::StaticOrder, true, true>(lds, g, S, E); }
            __syncthreads();
            { pg8::Gemm g{Y + (size_t)2 * MT * 1024, WB + (size_t)2 * D * 1024, nrows, D, 1024}; EpiBr<2> E{U, Z + Z_MG + 2 * D}; pg8::gemm_phase<EpiBr<2>, pg8::StaticOrder, true, true>(lds, g, S, E); });
        }
        TOC(8); } SEAM(pb + 7); { TIC();
        if (EN(7) && IN(pb + 8)) {
            pg8::Gemm g{U, (const bf16*)(ws + WS_WOUT), nrows, D, D}; pg8::StaticOrder S; S.init(nrows, D, G, bid);
            EpiOut E{l == 0 ? ain(a, I_X) : H, l == 0 ? ain(a, I_CTX) : H + (size_t)SEQ * D, H, modall + (size_t)l * 2 * 12288 + 4096};
            RUN(9, l == 0, pg8::gemm_phase<EpiOut, pg8::StaticOrder, true, true>(lds, g, S, E));
        }
        TOC(9); } SEAM(pb + 8); { TIC();
        if (EN(8) && IN(pb + 9)) {
            route_phase<false>(a, l, nrows, ldsf);
            __syncthreads();
            if (REP(19)) { route_phase<true>(a, l, nrows, ldsf); __syncthreads(); }
            RUN(10, true, cvt_stream<true>(a, l, ldsf)); __syncthreads();
            if (REP(27)) { cvt_stream<true, true>(a, l, ldsf); __syncthreads(); }
        }
        TOC(10); } SEAM(pb + 9); { TIC();
        if (EN(9) && IN(pb + 10)) { RUN(11, true, permute_phase(a, l, nrows, lds)); }
        TOC(11); } SEAM(pb + 10); { TIC();
        if (EN(10) && IN(pb + 11)) {
            const int* tile_e = (const int*)(ws + WS_TILEE); const int ntiles = tile_e[200];
            pg8::Gemm g{(const bf16*)(ws + WS_XP), (const bf16*)(ws + WS_WGU), MOE_MAXROWS, NEXP * 1024, D}; MoeOrder S{tile_e, ntiles, 4, G, bid};
            EpiGU E{(bf16*)(ws + WS_HMID)};
            RUN(12, true, pg8::gemm_phase<EpiGU, MoeOrder, true, true>(lds, g, S, E));
        }
        TOC(12); } SEAM(pb + 11); { TIC();
        if (EN(11) && IN(pb + 12)) {
            const int* tile_e = (const int*)(ws + WS_TILEE); const int ntiles = tile_e[200];
            pg8::Gemm g{(const bf16*)(ws + WS_HMID), (const bf16*)(ws + WS_WD), MOE_MAXROWS, NEXP * D, DFF}; MoeOrder S{tile_e, ntiles, 8, G, bid};
            EpiDn E{(bf16*)(ws + WS_YP), (const float*)(ws + WS_ROWW)};
            RUN(13, true, pg8::gemm_phase<EpiDn, MoeOrder, true, true>(lds, g, S, E));
        }
        TOC(13); } SEAM(pb + 12); { TIC();
        (void)0; }
    }
#ifdef PROBE_SEL
    if (tid == 0) ((LAS unsigned long long*)(ldsbase() + LDS_TIM))[0] = __builtin_amdgcn_s_memrealtime() - tkern_;
    __syncthreads();
#endif
    if (EN(12) && IN(PH_FINAL)) norm_phase<2>(a, DEPTH, SEQ, ldsf);
#undef IN
#undef SEAM
#undef ws
#undef bid
#undef G
#undef lds
#undef ldsf
#undef U
#undef Z
#undef H
#undef modall
}

#ifndef MK_SINGLE
#define MK_SINGLE 1
#endif
extern "C" void kernel_launch(void* const* d_in, const int* in_sizes, int n_in, void* d_out, int out_size, void* d_ws, size_t ws_size, hipStream_t stream) {
    static int grid = 0;
    if (grid == 0) {
        if (n_in != N_IN || out_size != SEQ * D || ws_size < WS_END) { fprintf(stderr, "kernel_launch: unexpected problem shape (n_in %d, out %d, ws %zu < %zu)\n", n_in, out_size, ws_size, (size_t)WS_END); grid = -1; return; }
        int dev = 0, cus = 0;
        if (hipGetDevice(&dev) != hipSuccess || hipDeviceGetAttribute(&cus, hipDeviceAttributeMultiprocessorCount, dev) != hipSuccess) { grid = -1; return; }
        if (hipFuncSetAttribute((const void*)fwd_kernel, hipFuncAttributeMaxDynamicSharedMemorySize, LDS_BYTES) != hipSuccess) { fprintf(stderr, "kernel_launch: hipFuncSetAttribute failed\n"); grid = -1; return; }
        int per_cu = 0;
        if (hipOccupancyMaxActiveBlocksPerMultiprocessor(&per_cu, (const void*)fwd_kernel, NTHR, LDS_BYTES) != hipSuccess || per_cu < 1) fprintf(stderr, "kernel_launch: occupancy query says %d\n", per_cu);
        (void)hipGetLastError();
        grid = cus;
    }
    if (grid < 0) return;
    (void)hipMemsetAsync((char*)d_ws + WS_CTL, 0, CTL_BYTES, stream);
    KArgs ka{};
    for (int i = 0; i < N_IN; ++i) ka.a.in[i] = (const float*)d_in[i];
    ka.a.out = (float*)d_out; ka.a.ws = (unsigned char*)d_ws;
#if MK_SINGLE
    ka.a.ph_lo = 0; ka.a.ph_hi = NPHASES; ka.li = 0; ka.pad = 0;
    hipLaunchKernelGGL(fwd_kernel, dim3(grid), dim3(NTHR), LDS_BYTES, stream, ka);
#ifdef PROBE_K
    (void)hipMemsetAsync((char*)d_ws + WS_CTL + (size_t)CW_CNT * 4, 0, 4096, stream);
    ka.a.ph_lo = 0; ka.a.ph_hi = PROBE_K; ka.li = 1;
    hipLaunchKernelGGL(fwd_kernel, dim3(grid), dim3(NTHR), LDS_BYTES, stream, ka);
#endif
#else
    for (int ph = 0; ph < NPHASES; ++ph) { ka.a.ph_lo = ph; ka.a.ph_hi = ph + 1; ka.li = 0; ka.pad = 0; hipLaunchKernelGGL(fwd_kernel, dim3(grid), dim3(NTHR), LDS_BYTES, stream, ka); }
#endif
}
```

```cpp
#include <hip/hip_runtime.h>
#include <cstdio>
#include <cstdint>
#define DI __device__ __forceinline__
#define LAS __attribute__((address_space(3)))
typedef unsigned short bf16;
typedef float f32x4 __attribute__((ext_vector_type(4)));
typedef unsigned u32x4 __attribute__((ext_vector_type(4)));
typedef unsigned u32x2 __attribute__((ext_vector_type(2)));

constexpr int D = 2048, SEQ = 16384, CTXL = 256, MT = SEQ + CTXL  , DEPTH = 2;
constexpr int NCOLS_IN = 17440;
constexpr int ZC = 17664;
constexpr int Z_HG = 0, Z_GL = 5120, Z_HY = 8192, Z_MG = 11264, Z_LR = 17408;
constexpr int NEXP = 32, DFF = 512, MOE_MAXROWS = 41472;
constexpr float NORM_EPS = 1e-6f;

constexpr size_t MiB = 1u << 20;
constexpr size_t WS_CTL = 0, CTL_BYTES = 1 * MiB;
constexpr size_t WS_SMALL = 1 * MiB;
constexpr size_t WS_MOD   = WS_SMALL;
constexpr size_t WS_ZBIAS = WS_MOD + (size_t)DEPTH * 2 * 12288 * 4;
constexpr size_t WS_LB    = WS_ZBIAS + (size_t)DEPTH * ZC * 4;
constexpr size_t WS_TW    = WS_LB + (size_t)DEPTH * 2 * 1024 * 4;
constexpr size_t WS_TW2   = WS_TW + 16384 * 8;
constexpr size_t WS_H2    = WS_TW2 + (8192 + 64) * 8;
constexpr size_t WS_ROUTE = WS_H2 + (size_t)DEPTH * MT * 64 * 4;
constexpr size_t WS_ROWW  = WS_ROUTE + (size_t)MT * 8 * 4;
constexpr size_t WS_TILEE = WS_ROWW + (size_t)MOE_MAXROWS * 4;
constexpr size_t WS_HYC   = WS_TILEE + 1024;
constexpr size_t WS_W3T   = WS_HYC + (size_t)2048 * 256 * 4;
constexpr size_t WS_H2B   = WS_W3T + (size_t)DEPTH * 2048 * 256 * 2;
constexpr size_t WS_WRT   = WS_H2B + (size_t)DEPTH * SEQ * 256 * 2;
constexpr size_t WS_SMALL_END = WS_WRT + (size_t)DEPTH * 2 * 48 * 2048 * 2;
static_assert(WS_SMALL_END <= 40 * MiB, "small tables");
constexpr size_t WS_WIN  = 40 * MiB;
constexpr size_t WS_WBR  = 109 * MiB;
constexpr size_t WS_WOUT = 121 * MiB;
constexpr size_t WS_WGU  = 129 * MiB;
constexpr size_t WS_CVO  = WS_WIN;
constexpr size_t WS_WD   = 257 * MiB;
constexpr size_t WS_H    = 321 * MiB;
constexpr size_t WS_U    = 451 * MiB;
constexpr size_t WS_Z    = 516 * MiB;
constexpr size_t WS_XP   = WS_Z;
constexpr size_t WS_HMID = WS_Z + 162 * MiB;
constexpr size_t WS_YP   = WS_Z + 203 * MiB;
constexpr size_t WS_YMIX = 1077 * MiB;
constexpr size_t WS_HF   = 1175 * MiB;
constexpr size_t WS_OSC  = 1175 * MiB;
constexpr size_t WS_END  = 1435 * MiB;
static_assert(WS_WIN + (size_t)ZC * D * 2 <= WS_WBR && WS_Z + (size_t)MT * ZC * 2 <= WS_YMIX && WS_YMIX + (size_t)3 * MT * 1024 * 2 <= WS_OSC && WS_OSC + (size_t)4 * MT * 1024 * 4 <= WS_END, "ws map");
static_assert(WS_YP + (size_t)MOE_MAXROWS * D * 2 <= WS_YMIX && WS_H + (size_t)MT * D * 4 <= WS_U && WS_U + (size_t)MT * D * 2 <= WS_Z, "ws map 2");
constexpr int CW_BAR = 4096;
constexpr int CW_CNT = 16384;

DI float bf2f(bf16 v) { return __uint_as_float(((unsigned)v) << 16); }
DI float bflo(unsigned w) { return __uint_as_float(w << 16); }
DI float bfhi(unsigned w) { return __uint_as_float(w & 0xffff0000u); }
typedef float f32x2_t __attribute__((ext_vector_type(2))); typedef __bf16 bf16x2_t __attribute__((ext_vector_type(2)));
DI unsigned pk_bf16(float lo, float hi) { f32x2_t v = {lo, hi}; bf16x2_t b = __builtin_convertvector(v, bf16x2_t); return __builtin_bit_cast(unsigned, b); }
DI bf16 f2bf(float f) { return (bf16)(pk_bf16(f, 0.f) & 0xffffu); }
DI float sigmoidf_(float x) { return __builtin_amdgcn_rcpf(1.0f + __expf(-x)); }
DI float siluf_(float x) { return x * __builtin_amdgcn_rcpf(1.0f + __expf(-x)); }
DI float wave_sum(float v) {
#pragma unroll
    for (int o = 32; o >= 1; o >>= 1) v += __shfl_xor(v, o);
    return v;
}
DI int otid() { int t = __builtin_amdgcn_workitem_id_x(); asm volatile("" : "+v"(t)); return t; }
DI int ogdim() { int g = __builtin_amdgcn_workgroup_id_x(); g = (int)gridDim.x; asm volatile("" : "+s"(g)); return g; }
DI int obid() { int b = __builtin_amdgcn_workgroup_id_x(); asm volatile("" : "+s"(b)); return b; }
#define AIN_DECL 1
DI LAS f32x2_t* fft_vec2_(LAS float* p) { return (LAS f32x2_t*)p; }
DI const f32x2_t* fft_vec2_(const float* p) { return (const f32x2_t*)p; }
DI f32x2_t* fft_vec2_(float* p) { return (f32x2_t*)p; }
namespace pg8 {
#define PG8_LAS __attribute__((address_space(3)))
typedef unsigned short bf16_t;
typedef short bf16x8 __attribute__((ext_vector_type(8)));
typedef float f32x4 __attribute__((ext_vector_type(4)));
typedef unsigned u32x4 __attribute__((ext_vector_type(4)));
constexpr int BM = 256, BK = 64, HALF = 128, HTB = HALF * BK * 2  , STAGE_BYTES = 8 * HTB, NXCD = 8, WGM = 8;

__host__ __device__ __forceinline__ int lds_byte(int r, int c) { const int st = (r >> 4) * 2 + (c >> 5), rr = r & 15, cc = c & 31, ob = rr * 64 + cc * 2; return st * 1024 + (ob ^ (((ob >> 9) & 1) << 5)); }
__host__ __device__ __forceinline__ void stage_rc(int b, int& R, int& C) { const int st = b / 1024, sb = b % 1024, swz = sb ^ (((sb >> 9) & 1) << 5); R = (st >> 1) * 16 + swz / 64; C = (st & 1) * 32 + (swz % 64) / 2; }
__host__ __device__ __forceinline__ int perm32(int rho) { const int n = rho >> 4, i = rho & 15; return 8 * (i >> 2) + 4 * n + (i & 3); }

struct Unit { int pm, pn; };
struct Gemm { const bf16_t* A; const bf16_t* Bt; int M, N, K; };

struct StaticOrder {
    int nM, nN, nwg, G, c;
    __host__ __device__ void init(int M, int N, int G_, int c_) { nM = M / BM; nN = N / BM; nwg = nM * nN; G = G_; c = c_; }
    __host__ __device__ bool next(int i, Unit& u) const {
        const long L = (long)i * G + c; if (L >= nwg) return false;
        int wgid = (int)L; { const int q = nwg / NXCD, r = nwg % NXCD, xcd = wgid % NXCD, off = wgid / NXCD; wgid = (xcd < r ? xcd * (q + 1) : r * (q + 1) + (xcd - r) * q) + off; }
        const int nig = WGM * nN, gid = wgid / nig, fm = gid * WGM, gsz = (nM - fm) < WGM ? (nM - fm) : WGM;
        u.pm = fm + ((wgid % nig) % gsz); u.pn = (wgid % nig) / gsz; return true;
    }
    __device__ __forceinline__ void a_ready(const Unit&) const {}
    __device__ __forceinline__ void done(const Unit&) const {}
};

template <class Epi, class Sched, bool ALIGN_EPI = false, bool SP2 = false>
__device__ __forceinline__ void gemm_phase(PG8_LAS unsigned char* lds, const Gemm g, const Sched& S, const Epi& E) {
    const int tid = otid(), wid = __builtin_amdgcn_readfirstlane(tid >> 6), lane = tid & 63, wr = wid >> 2, wc = wid & 3, fr = lane & 15, fq = lane >> 4;
    const int K = g.K, nt = K / BK;
    unsigned voffA[2], voffB[2];
#pragma unroll
    for (int i = 0; i < 2; ++i) { int R, C; stage_rc(tid * 16 + i * 8192, R, C); const int Rb = Epi::PERM ? ((R & ~31) + perm32(R & 31)) : R;
        voffA[i] = (unsigned)(R * K + C) * 2u; voffB[i] = (unsigned)(Rb * K + C) * 2u; }
    const size_t kstep = (size_t)(BK * 2);
    const size_t hstep = (size_t)HALF * K * 2;
    const size_t tstep = 2 * hstep;
    const unsigned ldsw = (unsigned)wid * 1024u;
    const int aoff = lds_byte(wr * 64 + fr, fq * 8), boff = lds_byte(wc * 32 + fr, fq * 8);
#define PG8_SA(b, h) (((b) * 2 + (h)) * HTB)
#define PG8_SB(b, h) ((4 + (b) * 2 + (h)) * HTB)
#define PG8_STAGE(bufoff, gbase, voff) do { _Pragma("unroll") for (int _i = 0; _i < 2; ++_i) \
        __builtin_amdgcn_global_load_lds((const unsigned*)((const char*)(gbase) + (voff)[_i]), (PG8_LAS unsigned*)(lds + (bufoff) + ldsw + _i * 8192), 16, 0, 0); } while (0)
#define PG8_LDA(dst, b, h) do { _Pragma("unroll") for (int m = 0; m < 4; ++m) _Pragma("unroll") for (int k = 0; k < 2; ++k) dst[m][k] = *(const PG8_LAS bf16x8*)(lds + PG8_SA(b, h) + aoff + m * 2048 + k * 1024); } while (0)
#define PG8_LDB(dst, b, h) do { _Pragma("unroll") for (int n = 0; n < 2; ++n) _Pragma("unroll") for (int k = 0; k < 2; ++k) dst[n][k] = *(const PG8_LAS bf16x8*)(lds + PG8_SB(b, h) + boff + n * 2048 + k * 1024); } while (0)
#define PG8_MMA(ai, bj, At, Bt) do { __builtin_amdgcn_s_setprio(1); _Pragma("unroll") for (int m = 0; m < 4; ++m) _Pragma("unroll") for (int n = 0; n < 2; ++n) _Pragma("unroll") for (int k = 0; k < 2; ++k) \
        acc[ai][bj][m][n] = __builtin_amdgcn_mfma_f32_16x16x32_bf16(Bt[n][k], At[m][k], acc[ai][bj][m][n], 0, 0, 0); __builtin_amdgcn_s_setprio(0); } while (0)
#define PG8_WAIT_V(n) asm volatile("s_waitcnt vmcnt(" #n ")" ::: "memory")
#define PG8_WAIT_L(n) asm volatile("s_waitcnt lgkmcnt(" #n ")" ::: "memory")
#define PG8_BAR __builtin_amdgcn_s_barrier()
#define PG8_SCHED __builtin_amdgcn_sched_barrier(0)
    Unit cur, nxt; int ui = 0;
    if (!S.next(0, cur)) return;
    f32x4 acc[2][2][4][2];
#pragma unroll
    for (int a = 0; a < 2; ++a)
#pragma unroll
        for (int b = 0; b < 2; ++b)
#pragma unroll
            for (int m = 0; m < 4; ++m)
#pragma unroll
                for (int n = 0; n < 2; ++n) acc[a][b][m][n] = (f32x4){0.f, 0.f, 0.f, 0.f};
    bf16x8 At[4][2], B0[2][2], B1[2][2];
    const char* cA = (const char*)g.A + (size_t)cur.pm * tstep; const char* cB = (const char*)g.Bt + (size_t)cur.pn * tstep;
    S.a_ready(cur);
    if constexpr (SP2) {
        PG8_STAGE(PG8_SB(0, 0), cB, voffB); PG8_STAGE(PG8_SB(0, 1), cB + hstep, voffB); PG8_STAGE(PG8_SA(0, 0), cA, voffA); PG8_STAGE(PG8_SA(0, 1), cA + hstep, voffA);
        if (wr == 1) PG8_BAR;
        PG8_WAIT_V(2); PG8_BAR;
        PG8_STAGE(PG8_SB(1, 0), cB + kstep, voffB); PG8_STAGE(PG8_SA(1, 0), cA + kstep, voffA); PG8_STAGE(PG8_SB(1, 1), cB + hstep + kstep, voffB);
        PG8_WAIT_V(6); PG8_BAR;
    } else {
        PG8_STAGE(PG8_SB(0, 0), cB, voffB); PG8_STAGE(PG8_SA(0, 0), cA, voffA); PG8_STAGE(PG8_SB(0, 1), cB + hstep, voffB); PG8_STAGE(PG8_SA(0, 1), cA + hstep, voffA);
        if (wr == 1) PG8_BAR;
        PG8_WAIT_V(4); PG8_BAR;
        PG8_STAGE(PG8_SB(1, 0), cB + kstep, voffB); PG8_STAGE(PG8_SA(1, 0), cA + kstep, voffA); PG8_STAGE(PG8_SB(1, 1), cB + hstep + kstep, voffB);
        PG8_WAIT_V(6); PG8_BAR;
    }
    for (;;) {
        const bool has_next = S.next(ui + 1, nxt);
        const char* nA = has_next ? (const char*)g.A + (size_t)nxt.pm * tstep : cA; const char* nB = has_next ? (const char*)g.Bt + (size_t)nxt.pn * tstep : cB;
        for (int t = 0; t < nt; t += 2) {
            const bool last = (t == nt - 2);
            const char* a1 = cA + (size_t)(t + 1) * kstep;
            const char* a2 = last ? nA : cA + (size_t)(t + 2) * kstep; const char* b2 = last ? nB : cB + (size_t)(t + 2) * kstep;
            const char* a3 = a2 + kstep; const char* b3 = b2 + kstep;
            if (last && has_next) S.a_ready(nxt);
            if constexpr (SP2) {
            PG8_LDB(B0, 0, 0); PG8_LDB(B1, 0, 1); PG8_SCHED; PG8_LDA(At, 0, 0); PG8_STAGE(PG8_SA(1, 1), a1 + hstep, voffA);
            PG8_WAIT_V(8); PG8_WAIT_L(0); PG8_BAR; PG8_MMA(0, 0, At, B0); PG8_MMA(0, 1, At, B1); PG8_BAR; PG8_SCHED;
            PG8_LDA(At, 0, 1); PG8_STAGE(PG8_SB(0, 0), b2, voffB); PG8_STAGE(PG8_SB(0, 1), b2 + hstep, voffB); PG8_STAGE(PG8_SA(0, 0), a2, voffA);
            PG8_WAIT_V(8); PG8_WAIT_L(0); PG8_BAR; PG8_MMA(1, 0, At, B0); PG8_MMA(1, 1, At, B1); PG8_BAR; PG8_SCHED;
            PG8_LDB(B0, 1, 0); PG8_LDB(B1, 1, 1); PG8_SCHED; PG8_LDA(At, 1, 0); PG8_STAGE(PG8_SA(0, 1), a2 + hstep, voffA);
            PG8_WAIT_V(8); PG8_WAIT_L(0); PG8_BAR; PG8_MMA(0, 0, At, B0); PG8_MMA(0, 1, At, B1); PG8_BAR; PG8_SCHED;
            PG8_LDA(At, 1, 1); PG8_STAGE(PG8_SB(1, 0), b3, voffB); PG8_STAGE(PG8_SB(1, 1), b3 + hstep, voffB); PG8_STAGE(PG8_SA(1, 0), a3, voffA);
            PG8_WAIT_V(8); PG8_WAIT_L(0); PG8_BAR; PG8_MMA(1, 0, At, B0); PG8_MMA(1, 1, At, B1); PG8_BAR; PG8_SCHED;
            } else {
            PG8_LDB(B0, 0, 0); PG8_SCHED; PG8_LDA(At, 0, 0); PG8_STAGE(PG8_SA(1, 1), a1 + hstep, voffA);
            PG8_WAIT_L(8); PG8_BAR; PG8_WAIT_L(0); PG8_MMA(0, 0, At, B0); PG8_BAR; PG8_SCHED;
            PG8_LDB(B1, 0, 1); PG8_STAGE(PG8_SB(0, 0), b2, voffB);
            PG8_BAR; PG8_WAIT_L(0); PG8_MMA(0, 1, At, B1); PG8_BAR;
            PG8_LDA(At, 0, 1); PG8_STAGE(PG8_SA(0, 0), a2, voffA);
            PG8_BAR; PG8_WAIT_L(0); PG8_MMA(1, 0, At, B0); PG8_BAR; PG8_SCHED;
            PG8_STAGE(PG8_SB(0, 1), b2 + hstep, voffB);
            PG8_WAIT_V(6); PG8_BAR; PG8_MMA(1, 1, At, B1); PG8_BAR;
            PG8_LDB(B0, 1, 0); PG8_SCHED; PG8_LDA(At, 1, 0); PG8_STAGE(PG8_SA(0, 1), a2 + hstep, voffA);
            PG8_WAIT_L(8); PG8_BAR; PG8_WAIT_L(0); PG8_MMA(0, 0, At, B0); PG8_BAR; PG8_SCHED;
            PG8_LDB(B1, 1, 1); PG8_STAGE(PG8_SB(1, 0), b3, voffB);
            PG8_BAR; PG8_WAIT_L(0); PG8_MMA(0, 1, At, B1); PG8_BAR;
            PG8_LDA(At, 1, 1); PG8_STAGE(PG8_SA(1, 0), a3, voffA);
            PG8_BAR; PG8_WAIT_L(0); PG8_MMA(1, 0, At, B0); PG8_BAR; PG8_SCHED;
            PG8_STAGE(PG8_SB(1, 1), b3 + hstep, voffB);
            PG8_WAIT_V(6); PG8_BAR; PG8_MMA(1, 1, At, B1); PG8_BAR;
            }
        }
        if constexpr (ALIGN_EPI) { if (wr == 0) PG8_BAR; }
        if constexpr (!Epi::AFTER_DRAIN) { E(acc, cur, wr, wc, fr, fq); S.done(cur); }
        if (!has_next) break;
#pragma unroll
        for (int a = 0; a < 2; ++a)
#pragma unroll
            for (int b = 0; b < 2; ++b)
#pragma unroll
                for (int m = 0; m < 4; ++m)
#pragma unroll
                    for (int n = 0; n < 2; ++n) acc[a][b][m][n] = (f32x4){0.f, 0.f, 0.f, 0.f};
        cur = nxt; cA = nA; cB = nB; ++ui;
        if constexpr (ALIGN_EPI) { if (wr == 1) PG8_BAR; }
    }
    PG8_WAIT_V(0);
    if constexpr (!ALIGN_EPI) { if (wr == 0) PG8_BAR; }
    PG8_BAR;
    if constexpr (Epi::AFTER_DRAIN) { E.fused(acc, cur, wr, wc, fr, fq, lds, wid, lane); S.done(cur); }
#undef PG8_SA
#undef PG8_SB
#undef PG8_STAGE
#undef PG8_LDA
#undef PG8_LDB
#undef PG8_MMA
#undef PG8_WAIT_V
#undef PG8_WAIT_L
#undef PG8_BAR
#undef PG8_SCHED
}
}
#define XB_TMO      128
#define XB_XCNT(j)  (256  + 64 * (j))
#define XB_XSUB(j)  (1280 + 64 * (j))
#define XB_XGEN(j)  (2304 + 64 * (j))
#define XB_TOP      3328
#define XB_TOPGEN   3392
#define XCD_BAR_WORDS 3456
#define XB_SPIN_CAP (1u << 18)

__device__ __forceinline__ unsigned xb_ld(unsigned* p)              { return __hip_atomic_load(p, __ATOMIC_RELAXED, __HIP_MEMORY_SCOPE_AGENT); }
__device__ __forceinline__ unsigned xb_add(unsigned* p, unsigned v) { return __hip_atomic_fetch_add(p, v, __ATOMIC_RELAXED, __HIP_MEMORY_SCOPE_AGENT); }
__device__ __forceinline__ unsigned xb_xcc_id() { return (unsigned)__builtin_amdgcn_s_getreg((3 << 11) | 20) & 0xFu; }
#define XB_SPIN(cond, bar) do { unsigned _sp = 0; while (cond) { __builtin_amdgcn_s_sleep(1); \
    if ((++_sp & 255u) == 0u) { if (xb_ld(&(bar)[XB_TMO])) break; if (_sp > XB_SPIN_CAP) { atomicAdd(&(bar)[XB_TMO], 1u); break; } } } } while (0)

struct XcdBarrier {
    unsigned* bar; unsigned x;
    volatile LAS unsigned* st;
};

__device__ __forceinline__ XcdBarrier xcd_barrier_post(unsigned* bar, volatile LAS unsigned* st) {
    XcdBarrier b; b.bar = bar; b.x = xb_xcc_id(); b.st = st;
    if (otid() == 0) (void)xb_add(&bar[XB_XCNT(b.x)], 1u);
    return b;
}
__device__ __forceinline__ void xcd_barrier_complete(unsigned* bar, unsigned x, unsigned& nloc, unsigned& nx) {
    asm volatile("" : "+s"(x));
    const unsigned G = ogdim();
    unsigned sum, cnt, mine, sp = 0u;
    for (;;) {
        sum = 0u; cnt = 0u; mine = 0u;
#pragma unroll
        for (unsigned j = 0; j < 16; ++j) { const unsigned c = xb_ld(&bar[XB_XCNT(j)]); sum += c; cnt += (c > 0u) ? 1u : 0u; mine = (j == x) ? c : mine; }
        if (sum == G) break;
        __builtin_amdgcn_s_sleep(1);
        if ((++sp & 255u) == 0u) { if (xb_ld(&bar[XB_TMO])) break; if (sp > XB_SPIN_CAP) { atomicAdd(&bar[XB_TMO], 1u); break; } }
    }
    nloc = mine > 0u ? mine : 1u; nx = cnt > 0u ? cnt : 1u;
}

__device__ __forceinline__ void xcd_barrier(const XcdBarrier& b) {
    asm volatile("s_waitcnt vmcnt(0)" ::: "memory");
    __syncthreads();
    if (otid() == 0) {
        unsigned* bar = b.bar;
        __builtin_amdgcn_s_waitcnt(0);
        unsigned nloc = b.st[0], nx = b.st[1];
        if (nloc == 0u) { xcd_barrier_complete(bar, b.x, nloc, nx); b.st[0] = nloc; b.st[1] = nx; }
        const unsigned old = xb_add(&bar[XB_XSUB(b.x)], 1u);
        const unsigned gen = old / nloc;
        if (old + 1u == (gen + 1u) * nloc) {
            __builtin_amdgcn_fence(__ATOMIC_RELEASE, "agent");
            asm volatile("s_waitcnt vmcnt(0)" ::: "memory");
            const unsigned og = xb_add(&bar[XB_TOP], 1u);
            const unsigned tg = og / nx;
            if (og + 1u == (tg + 1u) * nx) xb_add(&bar[XB_TOPGEN], 1u);
            else XB_SPIN(xb_ld(&bar[XB_TOPGEN]) == tg, bar);
            __builtin_amdgcn_fence(__ATOMIC_ACQUIRE, "agent");
            xb_add(&bar[XB_XGEN(b.x)], 1u);
            asm volatile("s_waitcnt vmcnt(0)" ::: "memory");
        } else {
            XB_SPIN(xb_ld(&bar[XB_XGEN(b.x)]) == gen, bar);
            __builtin_amdgcn_fence(__ATOMIC_ACQUIRE, "agent");
            asm volatile("s_waitcnt vmcnt(0)" ::: "memory");
        }
    }
    __syncthreads();
}

#define FFT_DI DI
struct cpx; template <class P> DI cpx fft_ldc_(P p, int i); template <class P> DI void fft_stc_(P p, int i, const cpx& v);
#define FFT_LDC(p, i) fft_ldc_((p), (i))
#define FFT_STC(p, i, v) fft_stc_((p), (i), (v))
#define FFT_M 16384
#define FFT_NT 512
struct cpx { float x, y; };
#ifdef FFT_LDC
template <class P> FFT_DI cpx fft_ldc_(P p, int i) { const f32x2_t v = *(const decltype(fft_vec2_(p)))(p + 2 * i); cpx r; r.x = v[0]; r.y = v[1]; return r; }
template <class P> FFT_DI void fft_stc_(P p, int i, const cpx& v) { f32x2_t w = {v.x, v.y}; *(decltype(fft_vec2_(p)))(p + 2 * i) = w; }
#endif
#ifndef FFT_LDC
#define FFT_LDC(p, i) ([&]{ cpx r_; r_.x = (p)[2 * (i)]; r_.y = (p)[2 * (i) + 1]; return r_; }())
#define FFT_STC(p, i, v) do { (p)[2 * (i)] = (v).x; (p)[2 * (i) + 1] = (v).y; } while (0)
#endif
FFT_DI cpx cmul(cpx a, cpx b) { cpx r; r.x = a.x * b.x - a.y * b.y; r.y = a.x * b.y + a.y * b.x; return r; }
FFT_DI cpx cmulc(cpx a, cpx b) { cpx r; r.x = a.x * b.x + a.y * b.y; r.y = a.y * b.x - a.x * b.y; return r; }
FFT_DI int rev4_14(int k) {
    int r = 0;
#pragma unroll
    for (int d = 0; d < 7; ++d) { r = (r << 2) | (k & 3); k >>= 2; }
    return r;
}
struct FftTw { cpx c256[3], c64[3], c16[3], c4[3]; };
template <class TP> FFT_DI void fft_load_tw(FftTw& T, TP tw, int tid) {
#pragma unroll
    for (int q = 0; q < 3; ++q) { T.c256[q] = FFT_LDC(tw, (q + 1) * (tid & 255) * 16); T.c64[q] = FFT_LDC(tw, (q + 1) * (tid & 63) * 64); T.c16[q] = FFT_LDC(tw, (q + 1) * (tid & 15) * 256); T.c4[q] = FFT_LDC(tw, (q + 1) * (tid & 3) * 1024); }
}
template <int s, class TP> FFT_DI void fft_pick_tw(const FftTw& T, TP tw, int pos, int j, cpx& w1, cpx& w2, cpx& w3) {
    if (s == 4096) { w1 = FFT_LDC(tw, pos); w2 = FFT_LDC(tw, 2 * pos); w3 = FFT_LDC(tw, 3 * pos); }
    else if (s == 1024) { w1 = FFT_LDC(tw, 4 * pos); w2 = FFT_LDC(tw, 8 * pos); w3 = FFT_LDC(tw, 12 * pos); }
    else if (s == 256) { w1 = T.c256[0]; w2 = T.c256[1]; w3 = T.c256[2]; }
    else if (s == 64) { w1 = T.c64[0]; w2 = T.c64[1]; w3 = T.c64[2]; }
    else if (s == 16) { w1 = T.c16[0]; w2 = T.c16[1]; w3 = T.c16[2]; }
    else if (s == 4) { w1 = T.c4[0]; w2 = T.c4[1]; w3 = T.c4[2]; }
}
template <int s, class LP, class TP> FFT_DI void fft_fwd_pass(LP lds, const FftTw& T, TP tw, int tid) {
    cpx w1, w2, w3;
#pragma unroll 2
    for (int jj = 0; jj < FFT_M / 4 / FFT_NT; ++jj) { const int b = tid + FFT_NT * jj;
        const int pos = b & (s - 1), base = ((b & ~(s - 1)) << 2) + pos;
        const cpx a0 = FFT_LDC(lds, base), a1 = FFT_LDC(lds, base + s), a2 = FFT_LDC(lds, base + 2 * s), a3 = FFT_LDC(lds, base + 3 * s);
        cpx t0, t1, t2, t3;
        t0.x = a0.x + a2.x; t0.y = a0.y + a2.y;
        t1.x = a0.x - a2.x; t1.y = a0.y - a2.y;
        t2.x = a1.x + a3.x; t2.y = a1.y + a3.y;
        t3.x = a1.x - a3.x; t3.y = a1.y - a3.y;
        cpx y0, y1, y2, y3;
        y0.x = t0.x + t2.x; y0.y = t0.y + t2.y;
        y2.x = t0.x - t2.x; y2.y = t0.y - t2.y;
        y1.x = t1.x + t3.y; y1.y = t1.y - t3.x;
        y3.x = t1.x - t3.y; y3.y = t1.y + t3.x;
        if (s > 1) {
            fft_pick_tw<s>(T, tw, pos, jj, w1, w2, w3);
            y1 = cmul(y1, w1); y2 = cmul(y2, w2); y3 = cmul(y3, w3);
        }
        FFT_STC(lds, base, y0); FFT_STC(lds, base + s, y1); FFT_STC(lds, base + 2 * s, y2); FFT_STC(lds, base + 3 * s, y3);
    }
}
template <int s, class LP, class TP> FFT_DI void fft_inv_pass(LP lds, const FftTw& T, TP tw, int tid) {
    cpx w1, w2, w3;
#pragma unroll 2
    for (int jj = 0; jj < FFT_M / 4 / FFT_NT; ++jj) { const int b = tid + FFT_NT * jj;
        const int pos = b & (s - 1), base = ((b & ~(s - 1)) << 2) + pos;
        const cpx b0 = FFT_LDC(lds, base); cpx c1 = FFT_LDC(lds, base + s), c2 = FFT_LDC(lds, base + 2 * s), c3 = FFT_LDC(lds, base + 3 * s);
        if (s > 1) {
            fft_pick_tw<s>(T, tw, pos, jj, w1, w2, w3);
            c1 = cmulc(c1, w1); c2 = cmulc(c2, w2); c3 = cmulc(c3, w3);
        }
        cpx t0, t1, t2, t3;
        t0.x = b0.x + c2.x; t0.y = b0.y + c2.y;
        t1.x = b0.x - c2.x; t1.y = b0.y - c2.y;
        t2.x = c1.x + c3.x; t2.y = c1.y + c3.y;
        t3.x = c1.x - c3.x; t3.y = c1.y - c3.y;
        cpx x0, x1, x2, x3;
        x0.x = t0.x + t2.x; x0.y = t0.y + t2.y;
        x2.x = t0.x - t2.x; x2.y = t0.y - t2.y;
        x1.x = t1.x - t3.y; x1.y = t1.y + t3.x;
        x3.x = t1.x + t3.y; x3.y = t1.y - t3.x;
        FFT_STC(lds, base, x0); FFT_STC(lds, base + s, x1); FFT_STC(lds, base + 2 * s, x2); FFT_STC(lds, base + 3 * s, x3);
    }
}
template <class LP, class TP> FFT_DI void rfft_untangle(LP lds, TP tw2, int k, cpx& Xk, cpx& Xm) {
    if (k == 0) {
        const float zr = lds[0], zi = lds[1];
        Xk.x = zr + zi; Xk.y = zr - zi;
        const int p = rev4_14(FFT_M / 2);
        Xm.x = lds[2 * p]; Xm.y = -lds[2 * p + 1];
        return;
    }
    const int pk = rev4_14(k), pm = rev4_14(FFT_M - k);
    cpx Zk, Zm; Zk.x = lds[2 * pk]; Zk.y = lds[2 * pk + 1]; Zm.x = lds[2 * pm]; Zm.y = lds[2 * pm + 1];
    cpx E, O, W, WO;
    E.x = 0.5f * (Zk.x + Zm.x); E.y = 0.5f * (Zk.y - Zm.y);
    O.x = 0.5f * (Zk.y + Zm.y); O.y = -0.5f * (Zk.x - Zm.x);
    W.x = tw2[2 * k]; W.y = tw2[2 * k + 1];
    WO = cmul(W, O);
    Xk.x = E.x + WO.x; Xk.y = E.y + WO.y;
    Xm.x = E.x - WO.x; Xm.y = -(E.y - WO.y);
}
template <class LP, class TP> FFT_DI void rfft_mul_retangle(LP lds, TP tw2, int k, cpx Gk, cpx Gm) {
    cpx Xk, Xm; rfft_untangle(lds, tw2, k, Xk, Xm);
    if (k == 0) {
        const float y0 = Xk.x * Gk.x, yM = Xk.y * Gk.y;
        lds[0] = 0.5f * (y0 + yM); lds[1] = 0.5f * (y0 - yM);
        const cpx Y = cmul(Xm, Gm);
        const int p = rev4_14(FFT_M / 2);
        lds[2 * p] = Y.x; lds[2 * p + 1] = -Y.y;
        return;
    }
    const cpx Yk = cmul(Xk, Gk), Ym = cmul(Xm, Gm);
    cpx W; W.x = tw2[2 * k]; W.y = tw2[2 * k + 1];
    cpx A, D, T;
    A.x = 0.5f * (Yk.x + Ym.x); A.y = 0.5f * (Yk.y - Ym.y);
    D.x = 0.5f * (Yk.x - Ym.x); D.y = 0.5f * (Yk.y + Ym.y);
    T = cmulc(D, W);
    const int pk = rev4_14(k), pm = rev4_14(FFT_M - k);
    lds[2 * pk] = A.x - T.y; lds[2 * pk + 1] = A.y + T.x;
    cpx Dc; Dc.x = -D.x; Dc.y = D.y;
    const cpx T2 = cmul(W, Dc);
    lds[2 * pm] = A.x + T2.y; lds[2 * pm + 1] = -A.y - T2.x;
}
enum { I_X = 0, I_C, I_CTX, I_CCTX, I_WMOD, I_BMOD, I_NMIXW, I_NFFNW, I_WIN, I_BIN, I_HYCW, I_HYCB, I_HYW1, I_HYB1, I_HYW2, I_HYB2, I_HYW3, I_HYB3, I_HYFREQ, I_HYSKIP,
       I_HGLB, I_HGNW, I_GLWA2, I_GLBA, I_GLNW, I_WBR, I_WOUT, I_WRG, I_BRG, I_WRE, I_BRE, I_WGATE, I_WUP, I_WDOWN, I_FNW, N_IN };
struct Args { const float* in[N_IN]; float* out; unsigned char* ws; int ph_lo, ph_hi; };
#define GAS __attribute__((address_space(1)))
extern __shared__ __attribute__((aligned(16))) unsigned char lds_raw[];
constexpr int LDS_PTAB = 150 * 1024 - 64 - 320;
DI LAS unsigned char* ldsbase() { unsigned p = (unsigned)(unsigned long long)(LAS unsigned char*)lds_raw; asm volatile("" : "+s"(p)); return (LAS unsigned char*)(unsigned long long)p; }
DI const float* ain(const Args&, int i) { const unsigned long long v = ((LAS unsigned long long*)(ldsbase() + LDS_PTAB))[i];
    const unsigned lo = __builtin_amdgcn_readfirstlane((unsigned)v), hi = __builtin_amdgcn_readfirstlane((unsigned)(v >> 32)); return (const float*)(GAS const float*)(((unsigned long long)hi << 32) | lo); }
DI unsigned char* wsp(const Args& a) { unsigned long long p = (unsigned long long)(a).ws; asm volatile("" : "+s"(p)); return (unsigned char*)(GAS unsigned char*)p; }
DI int opq(int x) { asm volatile("" : "+s"(x)); return x; }
#ifdef PROBE_SEL
constexpr int LDS_TIM = 150 * 1024 - 64 - 320 - 512;
#define TIC() const unsigned long long tic_ = __builtin_amdgcn_s_memrealtime()
#define TOC(i) do { if (otid() == 0) ((LAS unsigned long long*)(ldsbase() + LDS_TIM))[i] += __builtin_amdgcn_s_memrealtime() - tic_; } while (0)
#else
#define TIC() do {} while (0)
#define TOC(i) do {} while (0)
#endif
#define LDS_BAR() do { asm volatile("s_waitcnt lgkmcnt(0)" ::: "memory"); __builtin_amdgcn_s_barrier(); asm volatile("" ::: "memory"); } while (0)
constexpr int NTHR = 512;
constexpr int LDS_BYTES = 150 * 1024;
constexpr int LDS_X = 131072;
constexpr int LDS_BARW = LDS_BYTES - 64;

DI int z_srccol(int zc) { return zc < 8192 ? zc : (zc < Z_LR ? zc + 32 : (zc < Z_LR + 32 ? zc - Z_LR + 8192 : -1)); }

template <bool RDONLY = false> DI void cvt_wtile(const float* __restrict__ src, size_t ld, int sc, bf16* __restrict__ dst, int K, int row0, int kb, LAS float* t  ) {
    const int nn = otid() & 63;
    float v[64];
    if (sc >= 0) {
#pragma unroll
        for (int p = 0; p < 64; ++p) v[p] = src[(size_t)(kb * 64 + p) * ld + sc];
    } else {
#pragma unroll
        for (int p = 0; p < 64; ++p) v[p] = 0.f;
    }
    if (RDONLY) { float s = 0.f;
#pragma unroll
        for (int p = 0; p < 64; ++p) s += v[p];
        asm volatile("" :: "v"(s)); return; }
#pragma unroll
    for (int p = 0; p < 64; ++p) t[p * 65 + nn] = v[p];
    asm volatile("s_waitcnt lgkmcnt(0)" ::: "memory");
    const int rsub = nn >> 3, kp = nn & 7;
#pragma unroll
    for (int q = 0; q < 8; ++q) { const int row = q * 8 + rsub; float w[8];
#pragma unroll
        for (int j = 0; j < 8; ++j) w[j] = t[(kp * 8 + j) * 65 + row];
        u32x4 o; o.x = pk_bf16(w[0], w[1]); o.y = pk_bf16(w[2], w[3]); o.z = pk_bf16(w[4], w[5]); o.w = pk_bf16(w[6], w[7]);
        *(u32x4*)(dst + (size_t)(row0 + row) * K + kb * 64 + kp * 8) = o; }
    asm volatile("s_waitcnt lgkmcnt(0)" ::: "memory");
}
constexpr int CVT_MIX_TILES = 276 * 32 + 3 * 32 * 16 + 32 * 32;
DI void cvt_mix_wtile(const Args& a, int l, int it, LAS float* t) {
    const int nn = otid() & 63;
    if (it < 276 * 32) { const int nb = it >> 5, kb = it & 31; cvt_wtile(ain(a, I_WIN) + (size_t)l * D * NCOLS_IN, NCOLS_IN, z_srccol(nb * 64 + nn), (bf16*)(wsp(a) + WS_WIN), D, nb * 64, kb, t); return; }
    it -= 276 * 32;
    if (it < 3 * 32 * 16) { const int br = it / 512, r = it % 512, nb = r >> 4, kb = r & 15;
        cvt_wtile(ain(a, I_WBR) + ((size_t)l * 3 + br) * 1024 * D, D, nb * 64 + nn, (bf16*)(wsp(a) + WS_WBR) + (size_t)br * D * 1024, 1024, nb * 64, kb, t); return; }
    it -= 3 * 32 * 16;
    { const int nb = it >> 5, kb = it & 31; cvt_wtile(ain(a, I_WOUT) + (size_t)l * D * D, D, nb * 64 + nn, (bf16*)(wsp(a) + WS_WOUT), D, nb * 64, kb, t); }
}
constexpr int CVT_MOE_TILES = 32 * 16 * 32 + 32 * 32 * 8;
template <bool RDONLY = false> DI void cvt_moe_wtile(const Args& a, int l, int it, LAS float* t) {
    const int nn = otid() & 63;
    if (it < 32 * 16 * 32) { const int e = it >> 9, r = it & 511, nb = r >> 5, kb = r & 31, nt = nb >> 2, sub = nb & 3;
        const float* src = (sub < 2 ? ain(a, I_WGATE) : ain(a, I_WUP)) + ((size_t)l * NEXP + e) * D * DFF;
        cvt_wtile<RDONLY>(src, DFF, nt * 128 + (sub & 1) * 64 + nn, (bf16*)(wsp(a) + WS_WGU) + (size_t)e * 1024 * D, D, nb * 64, kb, t); return; }
    it -= 32 * 16 * 32;
    { const int e = it >> 8, r = it & 255, nb = r >> 3, kb = r & 7;
      cvt_wtile<RDONLY>(ain(a, I_WDOWN) + ((size_t)l * NEXP + e) * DFF * D, D, nb * 64 + nn, (bf16*)(wsp(a) + WS_WD) + (size_t)e * D * DFF, DFF, nb * 64, kb, t); }
}
template <bool MOE, bool RDONLY = false> DI void cvt_stream(const Args& a, int l, LAS float* ldsf) {
    const int wave = __builtin_amdgcn_readfirstlane(otid() >> 6), n = MOE ? CVT_MOE_TILES : CVT_MIX_TILES, g_ = ogdim(), nw = g_ * 8;
    LAS float* t = ldsf + wave * (64 * 65);
    for (int it = wave * g_ + (int)obid(); it < n; it += nw) { if (MOE) cvt_moe_wtile<RDONLY>(a, l, it, t); else cvt_mix_wtile(a, l, it, t); }
}

DI void mod_item(const Args& a, int j, LAS float* lds) {
    const int tid = otid(), l = j >> 7, col0 = (j & 127) * 96;
    LAS float* sil = lds;
    LAS float* red = lds + 4096;
    for (int k = tid; k < 2 * D; k += NTHR) { const float c = (k < D) ? ain(a, I_C)[k] : ain(a, I_CCTX)[k - D]; sil[k] = siluf_(c); }
    __syncthreads();
    const int cg = tid % 24, rg = tid / 24;
    f32x4 a0 = {0.f, 0.f, 0.f, 0.f}, a1 = {0.f, 0.f, 0.f, 0.f};
    if (rg < 21) {
        const float* w = ain(a, I_WMOD) + (size_t)l * D * 12288 + col0 + cg * 4;
        for (int k = rg; k < D; k += 21) { const f32x4 wv = *(const f32x4*)(w + (size_t)k * 12288); a0 += wv * sil[k]; a1 += wv * sil[D + k]; }
#pragma unroll
        for (int q = 0; q < 4; ++q) { red[(rg * 2 + 0) * 96 + cg * 4 + q] = a0[q]; red[(rg * 2 + 1) * 96 + cg * 4 + q] = a1[q]; }
    }
    __syncthreads();
    if (tid < 192) { const int set = tid / 96, c = tid % 96; float s = 0.f;
        for (int r = 0; r < 21; ++r) s += red[(r * 2 + set) * 96 + c];
        ((float*)(wsp(a) + WS_MOD))[((size_t)l * 2 + set) * 12288 + col0 + c] = s + ain(a, I_BMOD)[(size_t)l * 12288 + col0 + c]; }
    __syncthreads();
}
DI void h2_rows(const Args& a, LAS float* ldsf) {
    const int lane = otid() & 63, wave = __builtin_amdgcn_readfirstlane(otid() >> 6), g_ = ogdim(), nw = g_ * 8, gw = wave * g_ + (int)obid();
    const int l = gw >= nw / 2 ? 1 : 0, w0 = gw - l * (nw / 2), wstep = nw / 2;
    LAS float* fe = ldsf + wave * 128; LAS float* h1 = fe + 64;
    float w1c[33], w2c[64];
    { const float* w1 = ain(a, I_HYW1) + (size_t)l * 33 * 64; const float* w2 = ain(a, I_HYW2) + (size_t)l * 64 * 64;
#pragma unroll
      for (int i = 0; i < 33; ++i) w1c[i] = w1[i * 64 + lane];
#pragma unroll
      for (int i = 0; i < 64; ++i) w2c[i] = w2[i * 64 + lane]; }
    const float b1 = ain(a, I_HYB1)[l * 64 + lane], b2 = ain(a, I_HYB2)[l * 64 + lane], fq_ = ain(a, I_HYFREQ)[l * 64 + lane];
    float* H2 = (float*)(wsp(a) + WS_H2) + (size_t)l * MT * 64; bf16* H2B = (bf16*)(wsp(a) + WS_H2B) + (size_t)l * SEQ * 256;
    for (int r = w0; r < MT; r += wstep) {
        const int Lq = r < SEQ ? SEQ : CTXL, t = r < SEQ ? r : r - SEQ;
        if (lane < 33) { float f;
            if (lane == 0) f = (float)t / (float)(Lq - 1);
            else { const int bi = (lane - 1) & 15; const float band = 1e-4f + (float)bi * ((15.0f - 1e-4f) / 15.0f); const float rev2 = 2.0f * band * (float)t / (float)Lq;
                f = (lane <= 16) ? cospif(rev2) : -sinpif(rev2); }
            fe[lane] = f; }
        asm volatile("s_waitcnt lgkmcnt(0)" ::: "memory");
        float s = b1;
#pragma unroll
        for (int i = 0; i < 33; ++i) s += fe[i] * w1c[i];
        h1[lane] = sinf(fq_ * s);
        asm volatile("s_waitcnt lgkmcnt(0)" ::: "memory");
        float s2 = b2;
#pragma unroll
        for (int i = 0; i < 64; ++i) s2 += h1[i] * w2c[i];
        const float hv = sinf(fq_ * s2);
        H2[(size_t)r * 64 + lane] = hv;
        if (r < SEQ) { bf16* hb = H2B + (size_t)r * 256; hb[lane] = f2bf(hv); hb[64 + lane] = 0; hb[128 + lane] = 0; hb[192 + lane] = 0; }
        asm volatile("s_waitcnt lgkmcnt(0)" ::: "memory");
    }
}
DI void prologue_small(const Args& a) {
    const size_t gt = (size_t)obid() * NTHR + otid(), gs = (size_t)ogdim() * NTHR;
    float* zb = (float*)(wsp(a) + WS_ZBIAS);
    for (size_t i = gt; i < (size_t)DEPTH * ZC; i += gs) { const int l = (int)(i / ZC), zc = (int)(i % ZC), sc = z_srccol(zc); zb[i] = sc >= 0 ? ain(a, I_BIN)[(size_t)l * NCOLS_IN + sc] : 0.f; }
    float* lb = (float*)(wsp(a) + WS_LB);
    for (size_t i = gt; i < (size_t)DEPTH * 2048; i += gs) { const int l = (int)(i / 2048), j = (int)(i % 2048);
        float v = 0.f; if (l == 1) { const float r0 = ain(a, I_HGLB)[j], r1 = ain(a, I_HGLB)[2048 + j]; v = 1.0f / (1.0f + expf(r0 - r1)); }
        lb[i] = v; }
    bf16* w3t = (bf16*)(wsp(a) + WS_W3T);
    for (size_t i = gt; i < (size_t)DEPTH * 2048 * 256; i += gs) { const int l = (int)(i >> 19), fc = (int)((i >> 8) & 2047), j = (int)(i & 255); w3t[i] = j < 64 ? f2bf(ain(a, I_HYW3)[((size_t)l * 64 + j) * 2048 + fc]) : (bf16)0; }
    bf16* wrt = (bf16*)(wsp(a) + WS_WRT);
    for (size_t i = gt; i < (size_t)DEPTH * 48 * 2048; i += gs) { const int l = (int)(i / (48 * 2048)), c = (int)((i / 2048) % 48), k = (int)(i & 2047);
        const float w = c < 4 ? ain(a, I_WRG)[((size_t)l * D + k) * 4 + c] : (c < 36 ? ain(a, I_WRE)[((size_t)l * D + k) * 32 + (c - 4)] : 0.f);
        const bf16 hi = f2bf(w); wrt[((size_t)l * 2 + 0) * 48 * 2048 + (size_t)c * 2048 + k] = hi; wrt[((size_t)l * 2 + 1) * 48 * 2048 + (size_t)c * 2048 + k] = f2bf(w - bf2f(hi)); }
    float* tw = (float*)(wsp(a) + WS_TW);
    for (size_t i = gt; i < 16384; i += gs) { float s, c; sincospif(-2.0f * (float)i / 16384.0f, &s, &c); tw[2 * i] = c; tw[2 * i + 1] = s; }
    float* tw2 = (float*)(wsp(a) + WS_TW2);
    for (size_t i = gt; i <= 8192; i += gs) { float s, c; sincospif(-(float)i / 16384.0f, &s, &c); tw2[2 * i] = c; tw2[2 * i + 1] = s; }
}
DI void hyc_filters(const Args& a, int l) {
    const int lane = otid() & 63, wave = otid() >> 6;
    const float* h2 = (const float*)(wsp(a) + WS_H2) + ((size_t)l * MT + SEQ) * 64;
    const float* w3 = ain(a, I_HYW3) + (size_t)l * 64 * 2048;
    float* hyc = (float*)(wsp(a) + WS_HYC);
    const float a0 = -4.605170186f / 1.5f, a1 = -4.605170186f / 0.3f;
    for (int fc = obid() * 8 + wave; fc < 2048; fc += ogdim() * 8) {
        const int c = fc & 1023; const float delta = fabsf(a0 + (float)c * ((a1 - a0) / 1023.0f)); const float b3 = ain(a, I_HYB3)[l * 2048 + fc];
        float hv[4], ssum = 0.f;
#pragma unroll
        for (int i = 0; i < 4; ++i) { const int t = lane + 64 * i; float s = b3;
            for (int j = 0; j < 64; ++j) s += h2[t * 64 + j] * w3[j * 2048 + fc];
            const float tl = (float)t / 255.0f; hv[i] = s * (expf(-tl * delta) + 0.05f); ssum += fabsf(hv[i]); }
        ssum = wave_sum(ssum); const float inv = 1.0f / ssum;
#pragma unroll
        for (int i = 0; i < 4; ++i) hyc[(size_t)fc * 256 + lane + 64 * i] = hv[i] * inv;
    }
}
template <int MODE, bool DRY = false> DI void norm_phase(const Args& a, int l, int nrows, LAS float* ldsf) {
    const int lane = otid() & 63, wave = otid() >> 6;
    float* H = (float*)(wsp(a) + WS_H); bf16* U = (bf16*)(wsp(a) + WS_U);
    const float* modall = (const float*)(wsp(a) + WS_MOD);
    int* route = (int*)(wsp(a) + WS_ROUTE);
    const bf16* YP = (const bf16*)(wsp(a) + WS_YP);
    const bool combine = (MODE == 0 && l > 0) || MODE == 2;
    for (int r = obid() * 8 + wave; r < nrows; r += ogdim() * 8) {
        const int set = r >= SEQ ? 1 : 0;
        const float* src = (MODE == 0 && l == 0) ? (set ? ain(a, I_CTX) + (size_t)(r - SEQ) * D : ain(a, I_X) + (size_t)r * D) : H + (size_t)r * D;
        f32x4 v[8];
#pragma unroll
        for (int j = 0; j < 8; ++j) v[j] = *(const f32x4*)(src + j * 256 + lane * 4);
        if (combine) {
            const float* gt2 = modall + ((size_t)(l - 1) * 2 + set) * 12288 + 10240;
            const int p0 = route[r * 8 + 6], p1 = route[r * 8 + 7];
#pragma unroll
            for (int j = 0; j < 8; ++j) { const int col = j * 256 + lane * 4;
                const u32x2 y0 = *(const u32x2*)(YP + (size_t)p0 * D + col), y1 = *(const u32x2*)(YP + (size_t)p1 * D + col); const f32x4 g = *(const f32x4*)(gt2 + col);
                v[j][0] += g[0] * (bflo(y0.x) + bflo(y1.x)); v[j][1] += g[1] * (bfhi(y0.x) + bfhi(y1.x)); v[j][2] += g[2] * (bflo(y0.y) + bflo(y1.y)); v[j][3] += g[3] * (bfhi(y0.y) + bfhi(y1.y)); }
            if (MODE == 0) {
#pragma unroll
                for (int j = 0; j < 8; ++j) *(f32x4*)(H + (size_t)r * D + j * 256 + lane * 4) = v[j];
            }
        }
        float ss = 0.f;
#pragma unroll
        for (int j = 0; j < 8; ++j) ss += (v[j][0] * v[j][0] + v[j][1] * v[j][1]) + (v[j][2] * v[j][2] + v[j][3] * v[j][3]);
        ss = wave_sum(ss);
        const float rstd = rsqrtf(ss * (1.0f / D) + NORM_EPS);
        if (MODE == 2) {
            const float* fw = ain(a, I_FNW);
#ifdef PROBE_SEL
            const float pscale = 1.0f + 0.5f * (float)((LAS unsigned long long*)(ldsbase() + LDS_TIM))[PROBE_SEL] / (float)((LAS unsigned long long*)(ldsbase() + LDS_TIM))[0];
#else
            const float pscale = 1.0f;
#endif
#pragma unroll
            for (int j = 0; j < 8; ++j) { const int col = j * 256 + lane * 4; const f32x4 w = *(const f32x4*)(fw + col); *(f32x4*)(a.out + (size_t)r * D + col) = v[j] * rstd * w * pscale; }
        } else {
            const float* nw = (MODE == 0 ? ain(a, I_NMIXW) : ain(a, I_NFFNW)) + (size_t)l * D;
            const float* md = modall + ((size_t)l * 2 + set) * 12288 + (MODE == 0 ? 0 : 6144);
#pragma unroll
            for (int j = 0; j < 8; ++j) { const int col = j * 256 + lane * 4; const f32x4 w = *(const f32x4*)(nw + col), sh = *(const f32x4*)(md + col), sc = *(const f32x4*)(md + 2048 + col);
                v[j] = (v[j] * rstd * w) * (sc + 1.0f) + sh;
                u32x2 o; o.x = pk_bf16(v[j][0], v[j][1]); o.y = pk_bf16(v[j][2], v[j][3]); *(u32x2*)(U + (size_t)r * D + col) = o; }
            if (MODE == 1) {
                const float* wrg = ain(a, I_WRG) + (size_t)l * D * 4; const float* wre = ain(a, I_WRE) + (size_t)l * D * 32;
                float lg[36];
#pragma unroll
                for (int i = 0; i < 36; ++i) lg[i] = 0.f;
                LAS float* wu = ldsf + wave * 2048;
#pragma unroll
                for (int j = 0; j < 8; ++j) *(LAS f32x4*)(wu + j * 256 + lane * 4) = v[j];
                asm volatile("s_waitcnt lgkmcnt(0)" ::: "memory");
#pragma unroll 2
                for (int cc = 0; cc < 32; ++cc) { const int col = cc * 64 + lane; const float uv = wu[col];
                    const f32x4 g = *(const f32x4*)(wrg + (size_t)col * 4);
                    lg[0] += uv * g[0]; lg[1] += uv * g[1]; lg[2] += uv * g[2]; lg[3] += uv * g[3];
#pragma unroll
                    for (int e4 = 0; e4 < 8; ++e4) { const f32x4 w = *(const f32x4*)(wre + (size_t)col * 32 + e4 * 4);
                        lg[4 + e4 * 4 + 0] += uv * w[0]; lg[4 + e4 * 4 + 1] += uv * w[1]; lg[4 + e4 * 4 + 2] += uv * w[2]; lg[4 + e4 * 4 + 3] += uv * w[3]; } }
                asm volatile("s_waitcnt lgkmcnt(0)" ::: "memory");
#pragma unroll
                for (int i = 0; i < 36; ++i) lg[i] = wave_sum(lg[i]);
                float gl[4]; int grp = 0; float gmax;
#pragma unroll
                for (int g = 0; g < 4; ++g) gl[g] = lg[g] + ain(a, I_BRG)[l * 4 + g];
                gmax = gl[0];
#pragma unroll
                for (int g = 1; g < 4; ++g) if (gl[g] > gmax) { gmax = gl[g]; grp = g; }
                float gden = 0.f;
#pragma unroll
                for (int g = 0; g < 4; ++g) gden += expf(gl[g] - gmax);
                const float ptop = 1.0f / gden;
                float le[8];
#pragma unroll
                for (int i = 0; i < 8; ++i) { float x = lg[4 + i];
#pragma unroll
                    for (int g = 1; g < 4; ++g) x = (grp == g) ? lg[4 + g * 8 + i] : x;
                    le[i] = x + ain(a, I_BRE)[l * 32 + grp * 8 + i]; }
                int i0 = 0; float m0 = le[0];
#pragma unroll
                for (int i = 1; i < 8; ++i) if (le[i] > m0) { m0 = le[i]; i0 = i; }
                int i1 = -1; float m1 = -3.0e38f;
#pragma unroll
                for (int i = 0; i < 8; ++i) if (i != i0 && le[i] > m1) { m1 = le[i]; i1 = i; }
                const float e1v = expf(m1 - m0);
                const float w0 = ptop / (1.0f + e1v), w1 = ptop * e1v / (1.0f + e1v);
                if (DRY) { asm volatile("" :: "v"(w0), "v"(w1), "v"(i0), "v"(i1), "v"(grp)); }
                else if (lane == 0) {
                    unsigned* cnt = (unsigned*)(wsp(a) + WS_CTL) + CW_CNT + l * 2048;
                    const int ex0 = grp * 8 + i0, ex1 = grp * 8 + i1;
                    const unsigned s0 = atomicAdd(cnt + ex0 * 64, 1u), s1 = atomicAdd(cnt + ex1 * 64, 1u);
                    route[r * 8 + 0] = ex0; route[r * 8 + 1] = ex1; route[r * 8 + 2] = (int)s0; route[r * 8 + 3] = (int)s1;
                    route[r * 8 + 4] = __float_as_int(w0); route[r * 8 + 5] = __float_as_int(w1);
                }
            }
        }
    }
}
typedef short bf16x8r_t __attribute__((ext_vector_type(8)));
template <bool DRY> DI void route_phase(const Args& a, int l, int nrows, LAS float* ldsf, int pv = 0) {
    const int lane = otid() & 63, wave = __builtin_amdgcn_readfirstlane(otid() >> 6), fr = lane & 15, fq = lane >> 4, slot = wave & 3, half = wave >> 2;
    const float* H = (const float*)(wsp(a) + WS_H); bf16* U = (bf16*)(wsp(a) + WS_U); int* route = (int*)(wsp(a) + WS_ROUTE);
    const float* nw = ain(a, I_NFFNW) + (size_t)l * D;
    const bf16* Wh = (const bf16*)(wsp(a) + WS_WRT) + (size_t)l * 2 * 48 * 2048; const bf16* Wl = Wh + 48 * 2048;
    LAS float* lt = ldsf + 128 + (slot * 2 + half) * 768;
    const int G = ogdim(), bidv = obid(), ntile4 = nrows / 64;
    for (int it4 = bidv; it4 < ntile4; it4 += G) {
#pragma unroll 2
        for (int rr = 0; rr < ((pv & 2) ? 0 : 8); ++rr) { const int r = it4 * 64 + wave * 8 + rr, set = r >= SEQ ? 1 : 0;
            const float* md = (const float*)(wsp(a) + WS_MOD) + ((size_t)l * 2 + set) * 12288 + 6144;
            f32x4 v[8];
#pragma unroll
            for (int j = 0; j < 8; ++j) v[j] = *(const f32x4*)(H + (size_t)r * D + j * 256 + lane * 4);
            float ss = 0.f;
#pragma unroll
            for (int j = 0; j < 8; ++j) ss += (v[j][0] * v[j][0] + v[j][1] * v[j][1]) + (v[j][2] * v[j][2] + v[j][3] * v[j][3]);
            ss = wave_sum(ss);
            const float rstd = rsqrtf(ss * (1.0f / D) + NORM_EPS);
#pragma unroll
            for (int j = 0; j < 8; ++j) { const int col = j * 256 + lane * 4; const f32x4 w = *(const f32x4*)(nw + col), sh = *(const f32x4*)(md + col), sc = *(const f32x4*)(md + 2048 + col);
                const f32x4 u = (v[j] * rstd * w) * (sc + 1.0f) + sh; u32x2 o; o.x = pk_bf16(u[0], u[1]); o.y = pk_bf16(u[2], u[3]); *(u32x2*)(U + (size_t)r * D + col) = o; } }
        __syncthreads();
        const int tile = it4 * 4 + slot, row = tile * 16 + fr, ks0 = half * 32;
        const bf16* ur = U + (size_t)row * D + fq * 8;
        f32x4 acc[3];
#pragma unroll
        for (int cb = 0; cb < 3; ++cb) acc[cb] = (f32x4){0.f, 0.f, 0.f, 0.f};
#pragma unroll 8
        for (int ks = ks0; ks < ((pv & 4) ? ks0 : ks0 + 32); ++ks) { const int c0 = ks * 32;
            const bf16x8r_t ah = *(const bf16x8r_t*)(ur + c0);
#pragma unroll
            for (int cb = 0; cb < 3; ++cb) { const bf16x8r_t bh = *(const bf16x8r_t*)(Wh + (size_t)(cb * 16 + fr) * 2048 + c0 + fq * 8), bl = *(const bf16x8r_t*)(Wl + (size_t)(cb * 16 + fr) * 2048 + c0 + fq * 8);
                acc[cb] = __builtin_amdgcn_mfma_f32_16x16x32_bf16(ah, bh, acc[cb], 0, 0, 0); acc[cb] = __builtin_amdgcn_mfma_f32_16x16x32_bf16(ah, bl, acc[cb], 0, 0, 0); } }
#pragma unroll
        for (int cb = 0; cb < 3; ++cb)
#pragma unroll
            for (int j = 0; j < 4; ++j) lt[(fq * 4 + j) * 48 + cb * 16 + fr] = acc[cb][j];
        __syncthreads();
        if (half == 0 && lane < 16) {
            const int r = tile * 16 + lane; float lg[36]; LAS float* l0 = ldsf + 128 + (slot * 2) * 768 + lane * 48; LAS float* l1 = l0 + 768;
#pragma unroll
            for (int i = 0; i < 36; ++i) lg[i] = l0[i] + l1[i];
            float gl[4]; int grp = 0; float gmax;
#pragma unroll
            for (int g = 0; g < 4; ++g) gl[g] = lg[g] + ain(a, I_BRG)[l * 4 + g];
            gmax = gl[0];
#pragma unroll
            for (int g = 1; g < 4; ++g) if (gl[g] > gmax) { gmax = gl[g]; grp = g; }
            float gden = 0.f;
#pragma unroll
            for (int g = 0; g < 4; ++g) gden += expf(gl[g] - gmax);
            const float ptop = 1.0f / gden;
            float le[8];
#pragma unroll
            for (int i = 0; i < 8; ++i) { float x = lg[4 + i];
#pragma unroll
                for (int g = 1; g < 4; ++g) x = (grp == g) ? lg[4 + g * 8 + i] : x;
                le[i] = x + ain(a, I_BRE)[l * 32 + grp * 8 + i]; }
            int i0 = 0; float m0 = le[0];
#pragma unroll
            for (int i = 1; i < 8; ++i) if (le[i] > m0) { m0 = le[i]; i0 = i; }
            int i1 = -1; float m1 = -3.0e38f;
#pragma unroll
            for (int i = 0; i < 8; ++i) if (i != i0 && le[i] > m1) { m1 = le[i]; i1 = i; }
            const float e1v = expf(m1 - m0);
            const float w0 = ptop / (1.0f + e1v), w1 = ptop * e1v / (1.0f + e1v);
            if (DRY || (pv & 1)) { asm volatile("" :: "v"(w0), "v"(w1), "v"(i0), "v"(i1), "v"(grp)); }
            else { unsigned* cnt = (unsigned*)(wsp(a) + WS_CTL) + CW_CNT + l * 2048; const int ex0 = grp * 8 + i0, ex1 = grp * 8 + i1;
                const unsigned s0 = atomicAdd(cnt + ex0 * 64, 1u), s1 = atomicAdd(cnt + ex1 * 64, 1u);
                route[r * 8 + 0] = ex0; route[r * 8 + 1] = ex1; route[r * 8 + 2] = (int)s0; route[r * 8 + 3] = (int)s1; route[r * 8 + 4] = __float_as_int(w0); route[r * 8 + 5] = __float_as_int(w1); }
        }
        __syncthreads();
    }
}
DI void permute_phase(const Args& a, int l, int nrows, LAS unsigned char* ldsb) {
    LAS int* poff = (LAS int*)ldsb;
    const int tid = otid(), lane = tid & 63, wave = tid >> 6;
    const unsigned* cnt = (const unsigned*)(wsp(a) + WS_CTL) + CW_CNT + l * 2048;
    if (tid == 0) { int off = 0; for (int e = 0; e < NEXP; ++e) { poff[e] = off; off += (int)((cnt[e * 64] + 255u) / 256u) * 256; } poff[32] = off; }
    __syncthreads();
    if (obid() == 0) { int* tile_e = (int*)(wsp(a) + WS_TILEE); const int nt = poff[32] >> 8;
        if (tid < 200) { int e = -1; if (tid < nt) { for (int q = 0; q < NEXP; ++q) if (poff[q] <= tid * 256) e = q; } tile_e[tid] = e < 0 ? 0 : e; }
        if (tid == 0) tile_e[200] = nt; }
    int* route = (int*)(wsp(a) + WS_ROUTE); float* roww = (float*)(wsp(a) + WS_ROWW);
    const bf16* U = (const bf16*)(wsp(a) + WS_U); bf16* XP = (bf16*)(wsp(a) + WS_XP);
    for (int r = obid() * 8 + wave; r < nrows; r += ogdim() * 8) {
        const int e0 = route[r * 8 + 0], e1 = route[r * 8 + 1], s0 = route[r * 8 + 2], s1 = route[r * 8 + 3];
        const int p0 = poff[e0] + s0, p1 = poff[e1] + s1;
        u32x4 x[4];
#pragma unroll
        for (int i = 0; i < 4; ++i) x[i] = *(const u32x4*)(U + (size_t)r * D + (i * 64 + lane) * 8);
#pragma unroll
        for (int i = 0; i < 4; ++i) { *(u32x4*)(XP + (size_t)p0 * D + (i * 64 + lane) * 8) = x[i]; *(u32x4*)(XP + (size_t)p1 * D + (i * 64 + lane) * 8) = x[i]; }
        if (lane == 0) { route[r * 8 + 6] = p0; route[r * 8 + 7] = p1; roww[p0] = __int_as_float(route[r * 8 + 4]); roww[p1] = __int_as_float(route[r * 8 + 5]); }
    }
}
DI int stream_row(int p, int dir) { return dir == 0 ? (p < CTXL ? SEQ + p : p - CTXL) : (p < CTXL ? SEQ + (CTXL - 1 - p) : (SEQ - 1) - (p - CTXL)); }

DI void unpack8(const u32x4& p, float (&v)[8]) { v[0] = bflo(p.x); v[1] = bfhi(p.x); v[2] = bflo(p.y); v[3] = bfhi(p.y); v[4] = bflo(p.z); v[5] = bfhi(p.z); v[6] = bflo(p.w); v[7] = bfhi(p.w); }
DI void shortconv_w8(const bf16* Z, const float* cw, const float* cb, int l, int seg, int c0, int r0, int lo, int hi, int lane, float (&out)[8]) {
    const int col = Z_HY + seg * 1024 + c0; float zc[8], zp[8], zn[8];
    unpack8(*(const u32x4*)(Z + (size_t)(r0 + lane) * ZC + col), zc);
    float ep[8], en[8];
    if (r0 - 1 >= lo) unpack8(*(const u32x4*)(Z + (size_t)(r0 - 1) * ZC + col), ep); else {
#pragma unroll
        for (int q = 0; q < 8; ++q) ep[q] = 0.f; }
    if (r0 + 64 < hi) unpack8(*(const u32x4*)(Z + (size_t)(r0 + 64) * ZC + col), en); else {
#pragma unroll
        for (int q = 0; q < 8; ++q) en[q] = 0.f; }
#pragma unroll
    for (int q = 0; q < 8; ++q) { const float up = __shfl_up(zc[q], 1), dn = __shfl_down(zc[q], 1); zp[q] = lane == 0 ? ep[q] : up; zn[q] = lane == 63 ? en[q] : dn; }
    const float* w = cw + (size_t)l * 3 * 3072 + seg * 1024 + c0; const float* bb = cb + (size_t)l * 3072 + seg * 1024 + c0;
    const f32x4 w0a = *(const f32x4*)w, w0b = *(const f32x4*)(w + 4), w1a = *(const f32x4*)(w + 3072), w1b = *(const f32x4*)(w + 3072 + 4), w2a = *(const f32x4*)(w + 6144), w2b = *(const f32x4*)(w + 6144 + 4), ba = *(const f32x4*)bb, b4 = *(const f32x4*)(bb + 4);
#pragma unroll
    for (int q = 0; q < 4; ++q) { out[q] = w0a[q] * zp[q] + w1a[q] * zc[q] + w2a[q] * zn[q] + ba[q]; out[4 + q] = w0b[q] * zp[4 + q] + w1b[q] * zc[4 + q] + w2b[q] * zn[4 + q] + b4[q]; }
}
DI void hyprep_witem(const Args& a, int l, int it) {
    const int lane = otid() & 63, tb = it >> 7, c0 = (it & 127) * 8, r0 = tb * 64, lo = r0 < SEQ ? 0 : SEQ, hi = r0 < SEQ ? SEQ : MT;
    const bf16* Z = (const bf16*)(wsp(a) + WS_Z); bf16* VXT = (bf16*)(wsp(a) + WS_U);
    float x1[8], vv[8];
    shortconv_w8(Z, ain(a, I_HYCW), ain(a, I_HYCB), l, 1, c0, r0, lo, hi, lane, x1); shortconv_w8(Z, ain(a, I_HYCW), ain(a, I_HYCB), l, 2, c0, r0, lo, hi, lane, vv);
#pragma unroll
    for (int q = 0; q < 8; ++q) VXT[(size_t)(c0 + q) * MT + r0 + lane] = f2bf(vv[q] * x1[q]);
}
DI void hycomb_witem(const Args& a, int l, int it) {
    const int lane = otid() & 63, tb = it >> 7, c0 = (it & 127) * 8, r0 = tb * 64, lo = r0 < SEQ ? 0 : SEQ, hi = r0 < SEQ ? SEQ : MT;
    const bf16* Z = (const bf16*)(wsp(a) + WS_Z); const bf16* CV = (const bf16*)(wsp(a) + WS_CVO); bf16* Y0 = (bf16*)(wsp(a) + WS_YMIX);
    float x0[8], y[8];
#pragma unroll
    for (int q = 0; q < 8; ++q) y[q] = bf2f(CV[(size_t)(c0 + q) * MT + r0 + lane]);
    shortconv_w8(Z, ain(a, I_HYCW), ain(a, I_HYCB), l, 0, c0, r0, lo, hi, lane, x0);
    u32x4 w; w.x = pk_bf16(y[0] * x0[0], y[1] * x0[1]); w.y = pk_bf16(y[2] * x0[2], y[3] * x0[3]); w.z = pk_bf16(y[4] * x0[4], y[5] * x0[5]); w.w = pk_bf16(y[6] * x0[6], y[7] * x0[7]);
    *(u32x4*)(Y0 + (size_t)(r0 + lane) * 1024 + c0) = w;
}
DI void scancomb_rows(const Args& a, int l, int nrows) {
    const int lane = otid() & 63, wave = otid() >> 6;
    const bf16* Z = (const bf16*)(wsp(a) + WS_Z); const bf16* O = (const bf16*)(wsp(a) + WS_OSC);
    bf16* Y1 = (bf16*)(wsp(a) + WS_YMIX) + (size_t)MT * 1024; bf16* Y2 = Y1 + (size_t)MT * 1024;
    const float* hnw = ain(a, I_HGNW) + (size_t)l * 128; const float* gnw = ain(a, I_GLNW) + (size_t)l * 256;
    for (int r = obid() * 8 + wave; r < nrows; r += ogdim() * 8) {
#pragma unroll
        for (int i = 0; i < 2; ++i) { const int col = i * 512 + lane * 8;
            { float of[8], ob[8], g[8], o[8]; unpack8(*(const u32x4*)(O + (size_t)r * 1024 + col), of); unpack8(*(const u32x4*)(O + ((size_t)MT + r) * 1024 + col), ob); unpack8(*(const u32x4*)(Z + (size_t)r * ZC + Z_HG + 4096 + col), g);
              float ss = 0.f;
#pragma unroll
              for (int q = 0; q < 8; ++q) { o[q] = of[q] + ob[q]; ss += o[q] * o[q]; }
              ss += __shfl_xor(ss, 8); ss += __shfl_xor(ss, 4); ss += __shfl_xor(ss, 2); ss += __shfl_xor(ss, 1);
              const float rstd = rsqrtf(ss * (1.0f / 128.0f) + NORM_EPS);
              const f32x4 n0 = *(const f32x4*)(hnw + (col & 127)), n1 = *(const f32x4*)(hnw + (col & 127) + 4);
              u32x4 w; w.x = pk_bf16(o[0] * rstd * n0[0] * sigmoidf_(g[0]), o[1] * rstd * n0[1] * sigmoidf_(g[1])); w.y = pk_bf16(o[2] * rstd * n0[2] * sigmoidf_(g[2]), o[3] * rstd * n0[3] * sigmoidf_(g[3]));
              w.z = pk_bf16(o[4] * rstd * n1[0] * sigmoidf_(g[4]), o[5] * rstd * n1[1] * sigmoidf_(g[5])); w.w = pk_bf16(o[6] * rstd * n1[2] * sigmoidf_(g[6]), o[7] * rstd * n1[3] * sigmoidf_(g[7]));
              *(u32x4*)(Y1 + (size_t)r * 1024 + col) = w; }
            { float of[8], ob[8], g[8], o[8]; unpack8(*(const u32x4*)(O + ((size_t)2 * MT + r) * 1024 + col), of); unpack8(*(const u32x4*)(O + ((size_t)3 * MT + r) * 1024 + col), ob); unpack8(*(const u32x4*)(Z + (size_t)r * ZC + Z_GL + 2048 + col), g);
              float ss = 0.f;
#pragma unroll
              for (int q = 0; q < 8; ++q) { o[q] = of[q] + ob[q]; ss += o[q] * o[q]; }
              ss += __shfl_xor(ss, 16); ss += __shfl_xor(ss, 8); ss += __shfl_xor(ss, 4); ss += __shfl_xor(ss, 2); ss += __shfl_xor(ss, 1);
              const float rstd = rsqrtf(ss * (1.0f / 256.0f) + NORM_EPS);
              const f32x4 n0 = *(const f32x4*)(gnw + (col & 255)), n1 = *(const f32x4*)(gnw + (col & 255) + 4);
              u32x4 w; w.x = pk_bf16(o[0] * rstd * n0[0] * siluf_(g[0]), o[1] * rstd * n0[1] * siluf_(g[1])); w.y = pk_bf16(o[2] * rstd * n0[2] * siluf_(g[2]), o[3] * rstd * n0[3] * siluf_(g[3]));
              w.z = pk_bf16(o[4] * rstd * n1[0] * siluf_(g[4]), o[5] * rstd * n1[1] * siluf_(g[5])); w.w = pk_bf16(o[6] * rstd * n1[2] * siluf_(g[6]), o[7] * rstd * n1[3] * siluf_(g[7]));
              *(u32x4*)(Y2 + (size_t)r * 1024 + col) = w; }
        }
    }
}
typedef short bf16x8_t __attribute__((ext_vector_type(8)));
constexpr int SC_N = 65;
constexpr size_t KVS_GL_OFF = (size_t)16 * SC_N * 16384;
constexpr size_t WS_KVS = WS_WGU;
constexpr size_t WS_KD  = WS_WGU + 130 * MiB;
constexpr int SL_QM = 0, SL_KM = 17408, SL_Q0 = 34816, SL_KE = 52224, SL_VT = 70656, SL_PP = 107520, SL_TOT = 116736, SL_DD = 118784, SL_AFB = 119296, SL_EB = 121344;
static_assert(SL_EB + 512 <= 131072 && WS_KD + (size_t)24 * SC_N * 128 * 4 <= WS_H, "scan maps");
DI bf16x8_t lds_frag16(LAS unsigned char* p) { return *(LAS bf16x8_t*)p; }
DI bf16x8_t pack_bf16x8(const f32x4& lo, const f32x4& hi) { u32x4 w; w.x = pk_bf16(lo[0], lo[1]); w.y = pk_bf16(lo[2], lo[3]); w.z = pk_bf16(hi[0], hi[1]); w.w = pk_bf16(hi[2], hi[3]); return __builtin_bit_cast(bf16x8_t, w); }

template <bool GLA, bool OUT> DI void scan_walk(const Args& a, int l, int head, int dir, int sc, int dvh, LAS unsigned char* lds) {
    constexpr int NB = 1, DV = GLA ? 256 : 128;
    const int tid = otid(), lane = tid & 63, wave = tid >> 6, fr = lane & 15, fq = lane >> 4, nbase = dvh * 8 + wave;
    const bf16* Z = (const bf16*)(wsp(a) + WS_Z);
    const int stream = GLA ? 16 + head * 2 + dir : head * 2 + dir;
    float* kvs = (float*)(wsp(a) + WS_KVS) + (GLA ? KVS_GL_OFF + ((size_t)(stream - 16) * SC_N + sc) * 32768 : ((size_t)stream * SC_N + sc) * 16384);
    float* kd = (float*)(wsp(a) + WS_KD) + ((size_t)stream * SC_N + sc) * 128;
    LAS bf16* QM = (LAS bf16*)(lds + SL_QM); LAS bf16* KM = (LAS bf16*)(lds + SL_KM); LAS float* EB = (LAS float*)(lds + SL_EB); LAS bf16* XG = (LAS bf16*)(lds + SL_Q0);
    LAS bf16* KE = (LAS bf16*)(lds + SL_KE); LAS bf16* VT = (LAS bf16*)(lds + SL_VT); LAS bf16* PP = (LAS bf16*)(lds + SL_PP);
    LAS float* TOT = (LAS float*)(lds + SL_TOT); LAS float* DD = (LAS float*)(lds + SL_DD); LAS bf16* AFB = (LAS bf16*)(lds + SL_AFB);
    const int k = (wave & 1) * 64 + lane, seg = wave >> 1;
    float lbv = 0.f, bag = 0.f; bf16x8_t Bg = {0, 0, 0, 0, 0, 0, 0, 0};
    if (!GLA) lbv = ((const float*)(wsp(a) + WS_LB))[((size_t)l * 2 + dir) * 1024 + head * 128 + k];
    else {
        bag = ain(a, I_GLBA)[((size_t)l * 2 + dir) * 512 + head * 128 + wave * 16 + fr];
        if (fq < 2) { const float* wp = ain(a, I_GLWA2) + (((size_t)l * 2 + dir) * 16 + fq * 8) * 512 + head * 128 + wave * 16 + fr; float w8[8];
#pragma unroll
            for (int j = 0; j < 8; ++j) w8[j] = wp[(size_t)j * 512];
            u32x4 pw; pw.x = pk_bf16(w8[0], w8[1]); pw.y = pk_bf16(w8[2], w8[3]); pw.z = pk_bf16(w8[4], w8[5]); pw.w = pk_bf16(w8[6], w8[7]); Bg = __builtin_bit_cast(bf16x8_t, pw); } }
    f32x4 S[NB][8];
#pragma unroll
    for (int nb = 0; nb < NB; ++nb)
#pragma unroll
        for (int mb = 0; mb < 8; ++mb) { if (OUT) S[nb][mb] = *(const f32x4*)(kvs + (size_t)((nbase + nb) * 16 + fr) * 128 + mb * 16 + fq * 4); else S[nb][mb] = (f32x4){0.f, 0.f, 0.f, 0.f}; }
    float dlog = 0.f;
    const int which = (GLA ? 2 : 0) + dir;
    bf16* Odir = (bf16*)(wsp(a) + WS_OSC) + (size_t)which * MT * 1024;
    const int srow = tid >> 3, spc = (tid & 7) * 16;
    const int vcol = (GLA ? Z_GL + 1024 + head * 256 + dvh * 128 : Z_HG + 3072 + head * 128) + wave * 16;
    const int fcol = (GLA ? Z_GL + 512 + head * 128 : Z_HG + 1024 * (1 + dir) + head * 128) + spc, qcol = (GLA ? Z_GL + head * 128 : Z_HG + head * 128) + spc;
    u32x4 pv0, pv1, pf0, pf1, pq0 = {0u, 0u, 0u, 0u}, pq1 = {0u, 0u, 0u, 0u}, pa = {0u, 0u, 0u, 0u};
#define SCAN_ISSUE(cidx) do { const int r0n_ = dir ? stream_row((cidx) * 64 + 63, 1) : stream_row((cidx) * 64, 0); \
        const bf16* vr_ = Z + (size_t)(r0n_ + lane) * ZC + vcol; pv0 = *(const u32x4*)vr_; pv1 = *(const u32x4*)(vr_ + 8); \
        const bf16* zr_ = Z + (size_t)(r0n_ + srow) * ZC; pf0 = *(const u32x4*)(zr_ + fcol); pf1 = *(const u32x4*)(zr_ + fcol + 8); \
        if (OUT) { pq0 = *(const u32x4*)(zr_ + qcol); pq1 = *(const u32x4*)(zr_ + qcol + 8); } \
        if (GLA && tid < 128) pa = *(const u32x4*)(Z + (size_t)(r0n_ + (tid >> 1)) * ZC + Z_LR + dir * 16 + (tid & 1) * 8); } while (0)
    SCAN_ISSUE(sc * 4);
    for (int cc = 0; cc < 4; ++cc) {
        const int c = sc * 4 + cc; const int r0 = dir ? stream_row(c * 64 + 63, 1) : stream_row(c * 64, 0);
        {
#pragma unroll
          for (int q8 = 0; q8 < 2; ++q8) { const u32x4 v = q8 ? pv1 : pv0; const int d0 = wave * 16 + q8 * 8;
              VT[(d0 + 0) * 72 + lane] = (bf16)(v.x & 0xffff); VT[(d0 + 1) * 72 + lane] = (bf16)(v.x >> 16); VT[(d0 + 2) * 72 + lane] = (bf16)(v.y & 0xffff); VT[(d0 + 3) * 72 + lane] = (bf16)(v.y >> 16);
              VT[(d0 + 4) * 72 + lane] = (bf16)(v.z & 0xffff); VT[(d0 + 5) * 72 + lane] = (bf16)(v.z >> 16); VT[(d0 + 6) * 72 + lane] = (bf16)(v.w & 0xffff); VT[(d0 + 7) * 72 + lane] = (bf16)(v.w >> 16); }
          *(LAS u32x4*)(KM + srow * 136 + spc) = pf0; *(LAS u32x4*)(KM + srow * 136 + spc + 8) = pf1;
          if (OUT) { *(LAS u32x4*)(QM + srow * 136 + spc) = pq0; *(LAS u32x4*)(QM + srow * 136 + spc + 8) = pq1; }
          if (GLA && tid < 128) *(LAS u32x4*)(AFB + (tid >> 1) * 16 + (tid & 1) * 8) = pa;
          if (cc < 3) SCAN_ISSUE(c + 1); }
        LDS_BAR();
        if (GLA) {
#pragma unroll
            for (int tb = 0; tb < 4; ++tb) { bf16x8_t Ag = {0, 0, 0, 0, 0, 0, 0, 0}; if (fq < 2) Ag = lds_frag16(lds + SL_AFB + ((tb * 16 + fr) * 16 + fq * 8) * 2);
                f32x4 xg = {bag, bag, bag, bag}; xg = __builtin_amdgcn_mfma_f32_16x16x32_bf16(Ag, Bg, xg, 0, 0, 0);
#pragma unroll
                for (int j = 0; j < 4; ++j) XG[(tb * 16 + fq * 4 + j) * 136 + wave * 16 + fr] = f2bf(xg[j]); }
            LDS_BAR();
        }
        const int tstart = dir ? 63 - seg * 16 : seg * 16, tstep = dir ? -1 : 1;
        float cs[16], kkv[GLA ? 1 : 16]; float run = 0.f;
#ifdef REPMASK
        _Pragma("unroll 1") for (int rp1 = 0; rp1 < (((REPMASK) >> 24) & 1 ? 3 : 1); ++rp1) { run = 0.f;
#else
        {
#endif
#pragma unroll
        for (int i = 0; i < 16; ++i) { const int t = tstart + i * tstep; float la;
            if (!GLA) { const float zf = bf2f(KM[t * 136 + k]); const float sg = sigmoidf_(zf); la = __logf(lbv + (1.0f - lbv) * sg); kkv[i] = (1.0f - lbv) * (1.0f - sg); }
            else { const float x = bf2f(XG[t * 136 + k]); la = (fminf(x, 0.f) - __logf(1.0f + __expf(-fabsf(x)))) * 0.0625f; }
            run += la; cs[i] = run; }
        }
        TOT[seg * 128 + k] = run;
        LDS_BAR();
        { const float t0 = TOT[k], t1 = TOT[128 + k], t2 = TOT[256 + k], t3 = TOT[384 + k];
          const float off = seg == 0 ? 0.f : (seg == 1 ? t0 : (seg == 2 ? t0 + t1 : t0 + t1 + t2)), blast = (t0 + t1) + (t2 + t3), bref = t0 + t1;
          float ke[16]; const float ebl = __expf(blast - bref);
#pragma unroll
          for (int i = 0; i < 16; ++i) { const int t = tstart + i * tstep; const float b = off + cs[i];
              float kk; if (GLA) kk = bf2f(KM[t * 136 + k]); else kk = kkv[i];
              const float e1 = __expf(fminf(fmaxf(b - bref, -80.0f), 80.0f)), r1 = __builtin_amdgcn_rcpf(e1), kr = kk * r1;
              if (OUT) { const float qr = bf2f(QM[t * 136 + k]); const float qv = GLA ? qr * 0.08838834764831845f : siluf_(qr);
                  QM[t * 136 + k] = f2bf(qv * e1); KM[t * 136 + k] = f2bf(kr); }
              ke[i] = kr * ebl; }
          if (OUT && seg == 0) EB[k] = __expf(bref);
          const int tb0 = dir ? 48 - seg * 16 : seg * 16; u32x4 w0, w1;
          if (dir) { w0.x = pk_bf16(ke[15], ke[14]); w0.y = pk_bf16(ke[13], ke[12]); w0.z = pk_bf16(ke[11], ke[10]); w0.w = pk_bf16(ke[9], ke[8]); w1.x = pk_bf16(ke[7], ke[6]); w1.y = pk_bf16(ke[5], ke[4]); w1.z = pk_bf16(ke[3], ke[2]); w1.w = pk_bf16(ke[1], ke[0]); }
          else     { w0.x = pk_bf16(ke[0], ke[1]); w0.y = pk_bf16(ke[2], ke[3]); w0.z = pk_bf16(ke[4], ke[5]); w0.w = pk_bf16(ke[6], ke[7]); w1.x = pk_bf16(ke[8], ke[9]); w1.y = pk_bf16(ke[10], ke[11]); w1.z = pk_bf16(ke[12], ke[13]); w1.w = pk_bf16(ke[14], ke[15]); }
          *(LAS u32x4*)(KE + k * 72 + tb0) = w0; *(LAS u32x4*)(KE + k * 72 + tb0 + 8) = w1;
          if (seg == 0) DD[k] = __expf(blast);
          dlog += blast; }
        LDS_BAR();
        bf16x8_t Bv[NB][2];
#pragma unroll
        for (int nb = 0; nb < NB; ++nb)
#pragma unroll
            for (int ks = 0; ks < 2; ++ks) Bv[nb][ks] = lds_frag16(lds + SL_VT + ((wave * 16 + fr) * 72 + ks * 32 + fq * 8) * 2);
        if (OUT) {
#ifdef REPMASK
          _Pragma("unroll 1") for (int rp2 = 0; rp2 < (((REPMASK) >> 25) & 1 ? 3 : 1); ++rp2) { if (rp2) LDS_BAR();
#else
          {
#endif
            { const int tb = wave >> 1;
#pragma unroll
              for (int sbi = 0; sbi < 2; ++sbi) { const int sb = (wave & 1) * 2 + sbi; f32x4 acc = {0.f, 0.f, 0.f, 0.f};
#pragma unroll
                  for (int ks = 0; ks < 4; ++ks) acc = __builtin_amdgcn_mfma_f32_16x16x32_bf16(lds_frag16(lds + SL_QM + ((tb * 16 + fr) * 136 + ks * 32 + fq * 8) * 2), lds_frag16(lds + SL_KM + ((sb * 16 + fr) * 136 + ks * 32 + fq * 8) * 2), acc, 0, 0, 0);
#pragma unroll
                  for (int j = 0; j < 4; ++j) { const int t = tb * 16 + fq * 4 + j, s = sb * 16 + fr; const bool keep = dir ? (s >= t) : (s <= t); PP[t * 72 + s] = keep ? f2bf(acc[j]) : (bf16)0; } } }
            LDS_BAR();
#pragma unroll
            for (int nb = 0; nb < NB; ++nb) {
                bf16x8_t Bs[4];
#pragma unroll
                for (int ks = 0; ks < 4; ++ks) { const f32x4 e0 = *(LAS f32x4*)(EB + (2 * ks) * 16 + fq * 4), e1 = *(LAS f32x4*)(EB + (2 * ks + 1) * 16 + fq * 4); Bs[ks] = pack_bf16x8(S[nb][2 * ks] * e0, S[nb][2 * ks + 1] * e1); }
#pragma unroll
                for (int mb = 0; mb < 4; ++mb) {
                    f32x4 O = {0.f, 0.f, 0.f, 0.f};
#pragma unroll
                    for (int ks = 0; ks < 2; ++ks) O = __builtin_amdgcn_mfma_f32_16x16x32_bf16(lds_frag16(lds + SL_PP + ((mb * 16 + fr) * 72 + ks * 32 + fq * 8) * 2), Bv[nb][ks], O, 0, 0, 0);
#pragma unroll
                    for (int ks = 0; ks < 4; ++ks) { u32x4 aw; const u32x2 lo = *(LAS u32x2*)(lds + SL_QM + ((mb * 16 + fr) * 136 + (2 * ks) * 16 + fq * 4) * 2), hi = *(LAS u32x2*)(lds + SL_QM + ((mb * 16 + fr) * 136 + (2 * ks + 1) * 16 + fq * 4) * 2);
                        aw.x = lo.x; aw.y = lo.y; aw.z = hi.x; aw.w = hi.y;
                        O = __builtin_amdgcn_mfma_f32_16x16x32_bf16(__builtin_bit_cast(bf16x8_t, aw), Bs[ks], O, 0, 0, 0); }
#pragma unroll
                    for (int j = 0; j < 4; ++j) Odir[(size_t)(r0 + mb * 16 + fq * 4 + j) * 1024 + head * DV + (nbase + nb) * 16 + fr] = f2bf(O[j]);
                    asm volatile("" ::: "memory");
                }
            }
          }
        }
        if (!OUT || cc < 3) {
#pragma unroll
            for (int mb = 0; mb < 8; ++mb) { const f32x4 dd = *(LAS f32x4*)(DD + mb * 16 + fq * 4);
                const bf16x8_t A0 = lds_frag16(lds + SL_KE + ((mb * 16 + fr) * 72 + fq * 8) * 2), A1 = lds_frag16(lds + SL_KE + ((mb * 16 + fr) * 72 + 32 + fq * 8) * 2);
#pragma unroll
                for (int nb = 0; nb < NB; ++nb) { S[nb][mb] = S[nb][mb] * dd; S[nb][mb] = __builtin_amdgcn_mfma_f32_16x16x32_bf16(A0, Bv[nb][0], S[nb][mb], 0, 0, 0); S[nb][mb] = __builtin_amdgcn_mfma_f32_16x16x32_bf16(A1, Bv[nb][1], S[nb][mb], 0, 0, 0); }
                asm volatile("" ::: "memory"); }
        }
        LDS_BAR();
    }
    if (!OUT) {
#pragma unroll
        for (int nb = 0; nb < NB; ++nb)
#pragma unroll
            for (int mb = 0; mb < 8; ++mb) *(f32x4*)(kvs + (size_t)((nbase + nb) * 16 + fr) * 128 + mb * 16 + fq * 4) = S[nb][mb];
        if (seg == 0) kd[k] = __expf(dlog);
    }
}
#undef SCAN_ISSUE
DI void scan_prop(const Args& a) {
    float* kvs = (float*)(wsp(a) + WS_KVS); const float* kd = (const float*)(wsp(a) + WS_KD);
    for (int g = obid() * NTHR + otid(); g < 131072; g += ogdim() * NTHR) {
        float* p; size_t stride; const float* dp;
        if (g < 65536) { const int stream = g >> 12, e = g & 4095; p = kvs + (size_t)stream * SC_N * 16384 + (size_t)e * 4; stride = 16384; dp = kd + (size_t)stream * SC_N * 128 + (e & 31) * 4; }
        else { const int q = g - 65536, stream = q >> 13, e = q & 8191; p = kvs + KVS_GL_OFF + (size_t)stream * SC_N * 32768 + (size_t)e * 4; stride = 32768; dp = kd + (size_t)(16 + stream) * SC_N * 128 + (e & 31) * 4; }
        f32x4 S = {0.f, 0.f, 0.f, 0.f};
#pragma unroll 5
        for (int sc = 0; sc < SC_N; ++sc) { const f32x4 kv = *(const f32x4*)(p + sc * stride), d = *(const f32x4*)(dp + sc * 128); *(f32x4*)(p + sc * stride) = S; S = d * S + kv; }
    }
}
constexpr int SCAN_ITEMS = 32 * SC_N;
template <bool OUT> DI void scan_item2(const Args& a, int l, int it, LAS unsigned char* lds) {
    if (it < 16 * SC_N) { const int s = it / SC_N, sc = it % SC_N; if (OUT && l == DEPTH - 1 && sc == 0) return; scan_walk<true, OUT>(a, l, s >> 2, (s >> 1) & 1, sc, s & 1, lds); }
    else { const int j = it - 16 * SC_N, s = j / SC_N, sc = j % SC_N; if (OUT && l == DEPTH - 1 && sc == 0) return; scan_walk<false, OUT>(a, l, s >> 1, s & 1, sc, 0, lds); }
}
DI void hyconv_item(const Args& a, int l, int c, LAS unsigned char* ldsb) {
    const int tid = otid();
    LAS float* lds = (LAS float*)ldsb;
    LAS float* xs = (LAS float*)(ldsb + LDS_X);
    const float* tw = (const float*)(wsp(a) + WS_TW); const float* tw2 = (const float*)(wsp(a) + WS_TW2);
    const float* h2 = (const float*)(wsp(a) + WS_H2) + (size_t)l * MT * 64;
    const bf16* VX = (const bf16*)(wsp(a) + WS_U) + (size_t)c * MT; bf16* VO = (bf16*)(wsp(a) + WS_CVO) + (size_t)c * MT;
#ifdef REPMASK
    _Pragma("unroll 1") for (int rpa = 0; rpa < (((REPMASK) >> 21) & 1 ? 2 : 1); ++rpa) { if (rpa) __syncthreads();
#else
    {
#endif
    const bf16* HFf = (const bf16*)(wsp(a) + WS_HF) + (size_t)c * SEQ; const bf16* HFb = HFf + (size_t)1024 * SEQ;
    const float a0 = -4.605170186f / 1.5f, a1 = -4.605170186f / 0.3f;
    const float nd = -fabsf(a0 + (float)c * ((a1 - a0) / 1023.0f)) * (1.0f / (float)(SEQ - 1));
    const float b3f = ain(a, I_HYB3)[l * 2048 + c], b3b = ain(a, I_HYB3)[l * 2048 + 1024 + c];
    float sf = 0.f, sb = 0.f;
#pragma unroll
    for (int i = 0; i < 8; ++i) { const int t4 = (tid + 512 * i) * 4; const u32x2 rf = *(const u32x2*)(HFf + t4), rb = *(const u32x2*)(HFb + t4);
        f32x4 hf, hb; hf[0] = bflo(rf.x); hf[1] = bfhi(rf.x); hf[2] = bflo(rf.y); hf[3] = bfhi(rf.y); hb[0] = bflo(rb.x); hb[1] = bfhi(rb.x); hb[2] = bflo(rb.y); hb[3] = bfhi(rb.y);
#pragma unroll
        for (int q = 0; q < 4; ++q) { const float dec = __expf(nd * (float)(t4 + q)) + 0.05f; hf[q] = (hf[q] + b3f) * dec; hb[q] = (hb[q] + b3b) * dec; }
        sf += (fabsf(hf[0]) + fabsf(hf[1])) + (fabsf(hf[2]) + fabsf(hf[3])); sb += (fabsf(hb[0]) + fabsf(hb[1])) + (fabsf(hb[2]) + fabsf(hb[3]));
        *(LAS f32x4*)(lds + t4) = hf;
#pragma unroll
        for (int q = 0; q < 4; ++q) { const int t = t4 + q; if (t > 0) lds[32768 - t] = hb[q]; else xs[160] = hb[q]; } }
    sf = wave_sum(sf); sb = wave_sum(sb);
    if ((tid & 63) == 0) { xs[128 + (tid >> 6)] = sf; xs[136 + (tid >> 6)] = sb; }
    __syncthreads();
    float tf = 0.f, tb = 0.f;
#pragma unroll
    for (int w = 0; w < 8; ++w) { tf += xs[128 + w]; tb += xs[136 + w]; }
    const float inf_ = 1.0f / tf, inb_ = 1.0f / tb;
#pragma unroll 8
    for (int i = 0; i < 64; ++i) { const int m = tid + 512 * i; float v = lds[m];
        if (m == 0) v = v * inf_ + xs[160] * inb_ + ain(a, I_HYSKIP)[l * 1024 + c];
        else if (m < SEQ) v *= inf_; else if (m == SEQ) v = 0.f; else v *= inb_;
        lds[m] = v; }
    __syncthreads();
    }
    { FftTw T; fft_load_tw(T, tw, tid);
    fft_fwd_pass<4096>(lds, T, tw, tid); LDS_BAR(); fft_fwd_pass<1024>(lds, T, tw, tid); LDS_BAR(); fft_fwd_pass<256>(lds, T, tw, tid); LDS_BAR(); fft_fwd_pass<64>(lds, T, tw, tid); LDS_BAR();
    fft_fwd_pass<16>(lds, T, tw, tid); LDS_BAR(); fft_fwd_pass<4>(lds, T, tw, tid); LDS_BAR(); fft_fwd_pass<1>(lds, T, tw, tid); LDS_BAR(); }
#ifdef REPMASK
    if (((REPMASK) >> 22) & 1) { FftTw T; fft_load_tw(T, tw, tid);
        fft_inv_pass<1>(lds, T, tw, tid); LDS_BAR(); fft_inv_pass<4>(lds, T, tw, tid); LDS_BAR(); fft_inv_pass<16>(lds, T, tw, tid); LDS_BAR(); fft_inv_pass<64>(lds, T, tw, tid); LDS_BAR();
        fft_inv_pass<256>(lds, T, tw, tid); LDS_BAR(); fft_inv_pass<1024>(lds, T, tw, tid); LDS_BAR(); fft_inv_pass<4096>(lds, T, tw, tid); LDS_BAR();
        for (int i = 0; i < 64; ++i) lds[tid + 512 * i] *= (1.0f / FFT_M);
        LDS_BAR();
        fft_fwd_pass<4096>(lds, T, tw, tid); LDS_BAR(); fft_fwd_pass<1024>(lds, T, tw, tid); LDS_BAR(); fft_fwd_pass<256>(lds, T, tw, tid); LDS_BAR(); fft_fwd_pass<64>(lds, T, tw, tid); LDS_BAR();
        fft_fwd_pass<16>(lds, T, tw, tid); LDS_BAR(); fft_fwd_pass<4>(lds, T, tw, tid); LDS_BAR(); fft_fwd_pass<1>(lds, T, tw, tid); LDS_BAR(); }
#endif

    float* Gs = (float*)(wsp(a) + WS_YMIX) + (size_t)obid() * 32768;
    const int kbase = ((tid & 63) << 7) | ((tid >> 6) << 4);
#ifdef REPMASK
    _Pragma("unroll 1") for (int rpc = 0; rpc < (((REPMASK) >> 23) & 1 ? 2 : 1); ++rpc)
#endif
#pragma unroll 4
    for (int j = 0; j < 16; ++j) { const int k = kbase | j; cpx gk, gm; rfft_untangle(lds, tw2, k, gk, gm); f32x4 g4; g4[0] = gk.x; g4[1] = gk.y; g4[2] = gm.x; g4[3] = gm.y; *(f32x4*)(Gs + (size_t)(j * 512 + tid) * 4) = g4; }
    __syncthreads();
#pragma unroll
    for (int i = 0; i < 16; ++i) { const int m4 = tid + 512 * i; f32x4 v = {0.f, 0.f, 0.f, 0.f}; if (m4 < SEQ / 4) { const u32x2 r = *(const u32x2*)(VX + m4 * 4); v[0] = bflo(r.x); v[1] = bfhi(r.x); v[2] = bflo(r.y); v[3] = bfhi(r.y); } *(LAS f32x4*)(lds + m4 * 4) = v; }
    __syncthreads();
    { FftTw T; fft_load_tw(T, tw, tid);
    fft_fwd_pass<4096>(lds, T, tw, tid); LDS_BAR(); fft_fwd_pass<1024>(lds, T, tw, tid); LDS_BAR(); fft_fwd_pass<256>(lds, T, tw, tid); LDS_BAR(); fft_fwd_pass<64>(lds, T, tw, tid); LDS_BAR();
    fft_fwd_pass<16>(lds, T, tw, tid); LDS_BAR(); fft_fwd_pass<4>(lds, T, tw, tid); LDS_BAR(); fft_fwd_pass<1>(lds, T, tw, tid); LDS_BAR(); }
#pragma unroll 4
    for (int j = 0; j < 16; ++j) { const int k = kbase | j; const f32x4 g4 = *(const f32x4*)(Gs + (size_t)(j * 512 + tid) * 4); cpx gk, gm; gk.x = g4[0]; gk.y = g4[1]; gm.x = g4[2]; gm.y = g4[3]; rfft_mul_retangle(lds, tw2, k, gk, gm); }
    __syncthreads();
    { FftTw T; fft_load_tw(T, tw, tid);
    fft_inv_pass<1>(lds, T, tw, tid); LDS_BAR(); fft_inv_pass<4>(lds, T, tw, tid); LDS_BAR(); fft_inv_pass<16>(lds, T, tw, tid); LDS_BAR(); fft_inv_pass<64>(lds, T, tw, tid); LDS_BAR();
    fft_inv_pass<256>(lds, T, tw, tid); LDS_BAR(); fft_inv_pass<1024>(lds, T, tw, tid); LDS_BAR(); fft_inv_pass<4096>(lds, T, tw, tid); LDS_BAR(); }
#pragma unroll
    for (int i = 0; i < 8; ++i) { const int m4 = tid + 512 * i; const f32x4 v = *(const LAS f32x4*)(lds + m4 * 4) * (1.0f / FFT_M); u32x2 o; o.x = pk_bf16(v[0], v[1]); o.y = pk_bf16(v[2], v[3]); *(u32x2*)(VO + m4 * 4) = o; }
    __syncthreads();
}
DI void hycctx_item(const Args& a, int l, int it, LAS unsigned char* ldsb) {
    const int tid = otid(), c0 = it * 4;
    LAS float* sv = (LAS float*)ldsb;
    LAS float* sf = sv + 4 * 256;
    LAS float* sb = sf + 4 * 256;
    const float* hyc = (const float*)(wsp(a) + WS_HYC); const bf16* VXT = (const bf16*)(wsp(a) + WS_U); bf16* CVO = (bf16*)(wsp(a) + WS_CVO);
    for (int i = tid; i < 4 * 256; i += NTHR) { const int ch = i >> 8, t = i & 255; sv[i] = bf2f(VXT[(size_t)(c0 + ch) * MT + SEQ + t]); sf[i] = hyc[(size_t)(c0 + ch) * 256 + t]; sb[i] = hyc[(size_t)(1024 + c0 + ch) * 256 + t]; }
    __syncthreads();
    const int ch = tid >> 7, tq = tid & 127; const float g0 = sf[ch * 256] + sb[ch * 256] + ain(a, I_HYSKIP)[l * 1024 + c0 + ch];
    float acc0 = 0.f, acc1 = 0.f; const int t0 = tq * 2;
    for (int s = 0; s < 256; ++s) { const float vv = sv[ch * 256 + s]; const int d0 = t0 - s, d1 = d0 + 1;
        const float ga = d0 > 0 ? sf[ch * 256 + d0] : (d0 < 0 ? sb[ch * 256 - d0] : g0), gb = d1 > 0 ? sf[ch * 256 + d1] : (d1 < 0 ? sb[ch * 256 - d1] : g0);
        acc0 += ga * vv; acc1 += gb * vv; }
    *(unsigned*)(CVO + (size_t)(c0 + ch) * MT + SEQ + t0) = pk_bf16(acc0, acc1);
    __syncthreads();
}

struct EpiHF {
    static constexpr bool PERM = true, AFTER_DRAIN = false; bf16* O;
    DI void operator()(const f32x4 (&acc)[2][2][4][2], const pg8::Unit& u, int wr, int wc, int fr, int fq) const {
        const int row0 = u.pm * 256 + wr * 64 + fr, col0 = u.pn * 256 + wc * 32 + 8 * fq;
#pragma unroll
        for (int ai = 0; ai < 2; ++ai)
#pragma unroll
            for (int m = 0; m < 4; ++m) { bf16* rowp = O + (size_t)(row0 + ai * 128 + m * 16) * SEQ + col0;
#pragma unroll
                for (int bj = 0; bj < 2; ++bj) { const f32x4 v0 = acc[ai][bj][m][0], v1 = acc[ai][bj][m][1];
                    u32x4 w; w.x = pk_bf16(v0[0], v0[1]); w.y = pk_bf16(v0[2], v0[3]); w.z = pk_bf16(v1[0], v1[1]); w.w = pk_bf16(v1[2], v1[3]);
                    *(u32x4*)(rowp + bj * 128) = w; } }
    }
};
struct EpiZ {
    static constexpr bool PERM = true, AFTER_DRAIN = false; bf16* O; const float* bias;
    DI void operator()(const f32x4 (&acc)[2][2][4][2], const pg8::Unit& u, int wr, int wc, int fr, int fq) const {
        const int row0 = u.pm * 256 + wr * 64 + fr, col0 = u.pn * 256 + wc * 32 + 8 * fq;
        f32x4 bv[2][2];
#pragma unroll
        for (int bj = 0; bj < 2; ++bj)
#pragma unroll
            for (int n = 0; n < 2; ++n) bv[bj][n] = *(const f32x4*)(bias + col0 + bj * 128 + 4 * n);
#pragma unroll
        for (int ai = 0; ai < 2; ++ai)
#pragma unroll
            for (int m = 0; m < 4; ++m) { bf16* rowp = O + (size_t)(row0 + ai * 128 + m * 16) * ZC + col0;
#pragma unroll
                for (int bj = 0; bj < 2; ++bj) { const f32x4 v0 = acc[ai][bj][m][0] + bv[bj][0], v1 = acc[ai][bj][m][1] + bv[bj][1];
                    u32x4 w; w.x = pk_bf16(v0[0], v0[1]); w.y = pk_bf16(v0[2], v0[3]); w.z = pk_bf16(v1[0], v1[1]); w.w = pk_bf16(v1[2], v1[3]);
                    *(u32x4*)(rowp + bj * 128) = w; } }
    }
};
template <int BR> struct EpiBr {
    static constexpr bool PERM = true, AFTER_DRAIN = false; bf16* Mg; const bf16* Zg;
    DI void operator()(const f32x4 (&acc)[2][2][4][2], const pg8::Unit& u, int wr, int wc, int fr, int fq) const {
        const int row0 = u.pm * 256 + wr * 64 + fr, col0 = u.pn * 256 + wc * 32 + 8 * fq;
#pragma unroll
        for (int ai = 0; ai < 2; ++ai)
#pragma unroll
            for (int m = 0; m < 4; ++m) { const size_t row = (size_t)(row0 + ai * 128 + m * 16);
#pragma unroll
                for (int bj = 0; bj < 2; ++bj) { const int col = col0 + bj * 128;
                    const u32x4 g = *(const u32x4*)(Zg + row * ZC + col);
                    f32x4 v0 = acc[ai][bj][m][0], v1 = acc[ai][bj][m][1];
                    v0[0] *= sigmoidf_(bflo(g.x)); v0[1] *= sigmoidf_(bfhi(g.x)); v0[2] *= sigmoidf_(bflo(g.y)); v0[3] *= sigmoidf_(bfhi(g.y));
                    v1[0] *= sigmoidf_(bflo(g.z)); v1[1] *= sigmoidf_(bfhi(g.z)); v1[2] *= sigmoidf_(bflo(g.w)); v1[3] *= sigmoidf_(bfhi(g.w));
                    if (BR > 0) { const u32x4 p = *(const u32x4*)(Mg + row * D + col);
                        v0[0] += bflo(p.x); v0[1] += bfhi(p.x); v0[2] += bflo(p.y); v0[3] += bfhi(p.y); v1[0] += bflo(p.z); v1[1] += bfhi(p.z); v1[2] += bflo(p.w); v1[3] += bfhi(p.w); }
                    u32x4 w; w.x = pk_bf16(v0[0], v0[1]); w.y = pk_bf16(v0[2], v0[3]); w.z = pk_bf16(v1[0], v1[1]); w.w = pk_bf16(v1[2], v1[3]);
                    *(u32x4*)(Mg + row * D + col) = w; } }
    }
};
struct EpiOut {
    static constexpr bool PERM = false, AFTER_DRAIN = false; const float* hin_main; const float* hin_ctx; float* hout; const float* gt1;
    DI void operator()(const f32x4 (&acc)[2][2][4][2], const pg8::Unit& u, int wr, int wc, int fr, int fq) const {
        const int row0 = u.pm * 256 + wr * 64 + fr, col0 = u.pn * 256 + wc * 32 + 4 * fq; const bool isctx = u.pm >= SEQ / 256;
        const float* g = gt1 + (isctx ? 12288 : 0);
        f32x4 gv[2][2];
#pragma unroll
        for (int bj = 0; bj < 2; ++bj)
#pragma unroll
            for (int n = 0; n < 2; ++n) gv[bj][n] = *(const f32x4*)(g + col0 + bj * 128 + n * 16);
#pragma unroll
        for (int ai = 0; ai < 2; ++ai)
#pragma unroll
            for (int m = 0; m < 4; ++m) { const int row = row0 + ai * 128 + m * 16;
                const float* ip = (isctx ? hin_ctx + (size_t)(row - SEQ) * D : hin_main + (size_t)row * D) + col0; float* op = hout + (size_t)row * D + col0;
#pragma unroll
                for (int bj = 0; bj < 2; ++bj)
#pragma unroll
                    for (int n = 0; n < 2; ++n) { const f32x4 b = *(const f32x4*)(ip + bj * 128 + n * 16); *(f32x4*)(op + bj * 128 + n * 16) = b + gv[bj][n] * acc[ai][bj][m][n]; } }
    }
};
struct EpiGU {
    static constexpr bool PERM = true, AFTER_DRAIN = false; bf16* Hm;
    DI void operator()(const f32x4 (&acc)[2][2][4][2], const pg8::Unit& u, int wr, int wc, int fr, int fq) const {
        const int row0 = u.pm * 256 + wr * 64 + fr, col0 = (u.pn & 3) * 128 + wc * 32 + 8 * fq;
#pragma unroll
        for (int ai = 0; ai < 2; ++ai)
#pragma unroll
            for (int m = 0; m < 4; ++m) { const f32x4 g0 = acc[ai][0][m][0], g1 = acc[ai][0][m][1], u0 = acc[ai][1][m][0], u1 = acc[ai][1][m][1];
                u32x4 w; w.x = pk_bf16(siluf_(g0[0]) * u0[0], siluf_(g0[1]) * u0[1]); w.y = pk_bf16(siluf_(g0[2]) * u0[2], siluf_(g0[3]) * u0[3]);
                w.z = pk_bf16(siluf_(g1[0]) * u1[0], siluf_(g1[1]) * u1[1]); w.w = pk_bf16(siluf_(g1[2]) * u1[2], siluf_(g1[3]) * u1[3]);
                *(u32x4*)(Hm + (size_t)(row0 + ai * 128 + m * 16) * DFF + col0) = w; }
    }
};
struct EpiDn {
    static constexpr bool PERM = true, AFTER_DRAIN = false; bf16* Y; const float* roww;
    DI void operator()(const f32x4 (&acc)[2][2][4][2], const pg8::Unit& u, int wr, int wc, int fr, int fq) const {
        const int row0 = u.pm * 256 + wr * 64 + fr, col0 = (u.pn & 7) * 256 + wc * 32 + 8 * fq;
#pragma unroll
        for (int ai = 0; ai < 2; ++ai)
#pragma unroll
            for (int m = 0; m < 4; ++m) { const int row = row0 + ai * 128 + m * 16; const float rw = roww[row];
#pragma unroll
                for (int bj = 0; bj < 2; ++bj) { const f32x4 v0 = acc[ai][bj][m][0] * rw, v1 = acc[ai][bj][m][1] * rw;
                    u32x4 w; w.x = pk_bf16(v0[0], v0[1]); w.y = pk_bf16(v0[2], v0[3]); w.z = pk_bf16(v1[0], v1[1]); w.w = pk_bf16(v1[2], v1[3]);
                    *(u32x4*)(Y + (size_t)row * D + col0 + bj * 128) = w; } }
    }
};
struct MoeOrder {
    const int* tile_e; int ntiles, nsub, G, c;
    DI bool next(int i, pg8::Unit& u) const { const int j = i * G + c; if (j >= ntiles * nsub) return false; const int ti = j / nsub; u.pm = ti; u.pn = tile_e[ti] * nsub + (j - ti * nsub); return true; }
    DI void a_ready(const pg8::Unit&) const {}
    DI void done(const pg8::Unit&) const {}
};
constexpr int NPH_LAYER = 13, PH_FINAL = 1 + NPH_LAYER * DEPTH, NPHASES = PH_FINAL + 1;
struct KArgs { Args a; int li, pad; };
__global__ void __launch_bounds__(NTHR, 2) fwd_kernel(KArgs ka) {
    const Args& a = ka.a;
    const int tid = otid();
#define bid ((int)obid())
#define G ((int)ogdim())
    if (tid == 0) { ((LAS unsigned*)(ldsbase() + LDS_BARW))[0] = 0u; ((LAS unsigned*)(ldsbase() + LDS_BARW))[1] = 0u;
        LAS unsigned long long* ptab = (LAS unsigned long long*)(ldsbase() + LDS_PTAB);
#pragma unroll
        for (int i = 0; i < N_IN; ++i) ptab[i] = (unsigned long long)ka.a.in[i]; }
    __syncthreads();
#ifdef PROBE_SEL
    if (tid < 64) ((LAS unsigned long long*)(ldsbase() + LDS_TIM))[tid] = 0ull;
    __syncthreads();
    const unsigned long long tkern_ = __builtin_amdgcn_s_memrealtime();
#endif
    XcdBarrier bar = xcd_barrier_post((unsigned*)(wsp(a) + WS_CTL) + CW_BAR + ka.li * XCD_BAR_WORDS, (volatile LAS unsigned*)(ldsbase() + LDS_BARW));
    const int lo = a.ph_lo, hi = a.ph_hi;
#ifndef PHMASK
#define PHMASK 0xFFFF
#endif
#define EN(i) (((PHMASK) >> (i)) & 1)
#ifndef REPMASK
#define REPMASK 0
#endif
#define REP(i) (((REPMASK) >> (i)) & 1)
#define RUN(i, cond, ...) do { _Pragma("unroll 1") for (int rep_ = 0; rep_ < ((REP(i) && (cond)) ? REPN : 1); ++rep_) { if (rep_) __syncthreads(); __VA_ARGS__; } } while (0)
#ifndef REPN
#define REPN 2
#endif
#define IN(k) (opq(lo) <= (k) && (k) < opq(hi))
#define SEAM(k) do { if (IN(k) && IN((k) + 1)) { TIC(); xcd_barrier(bar); TOC(30); } } while (0)
#define ws wsp(a)
#define lds ldsbase()
#define ldsf ((LAS float*)ldsbase())
#define U ((bf16*)(wsp(a) + WS_U))
#define Z ((bf16*)(wsp(a) + WS_Z))
#define H ((float*)(wsp(a) + WS_H))
#define modall ((const float*)(wsp(a) + WS_MOD))

    { TIC();
    if (EN(0) && IN(0)) {
        RUN(0, true, prologue_small(a);
        for (int it = bid; it < 256; it += G) mod_item(a, it, ldsf);
        __syncthreads(); h2_rows(a, ldsf); __syncthreads());
    }
    TOC(31); } SEAM(0);
    for (int l = 0; l < DEPTH; ++l) {
        const int pb = 1 + NPH_LAYER * l;
        const int nrows = (l == 0) ? MT : SEQ;
        { TIC();
        if (EN(1) && IN(pb + 0)) {
            RUN(1, l == 0, norm_phase<0>(a, l, MT, ldsf));
            RUN(16, true, if (l == 0) hyc_filters(a, 0));
            __syncthreads(); RUN(2, true, cvt_stream<false>(a, l, ldsf)); __syncthreads();
        }
        TOC(1); } SEAM(pb + 0); { TIC();
        if (EN(2) && IN(pb + 1)) {
            pg8::Gemm g{U, (const bf16*)(ws + WS_WIN), MT, ZC, D}; pg8::StaticOrder S; S.init(MT, ZC, G, bid);
            EpiZ E{Z, (const float*)(ws + WS_ZBIAS) + (size_t)l * ZC};
            RUN(3, true, pg8::gemm_phase<EpiZ, pg8::StaticOrder, true, true>(lds, g, S, E));
        }
        TOC(2); } SEAM(pb + 1); { TIC();
        if (EN(3) && IN(pb + 2)) { const int nit = (nrows / 64) * 16; { const int g_ = G, w0_ = __builtin_amdgcn_readfirstlane(tid >> 6) * g_ + bid, n_ = (nrows / 64) * 128; RUN(4, true, for (int it = w0_; it < n_; it += 8 * g_) hyprep_witem(a, l, it)); }
            __syncthreads();
            pg8::Gemm g{(const bf16*)(ws + WS_W3T) + (size_t)l * 2048 * 256, (const bf16*)(ws + WS_H2B) + (size_t)l * SEQ * 256, 2048, SEQ, opq(256)  }; pg8::StaticOrder S; S.init(2048, SEQ, G, bid);
            EpiHF E{(bf16*)(ws + WS_HF)};
            RUN(18, true, pg8::gemm_phase<EpiHF, pg8::StaticOrder, true, true>(lds, g, S, E)); }
        TOC(3); } SEAM(pb + 2); { TIC();
        if (EN(4) && IN(pb + 3)) {
            RUN(5, true, for (int it = bid; it < SCAN_ITEMS; it += G) scan_item2<false>(a, l, it, lds));
            RUN(6, true, for (int c = bid; c < 1024; c += G) hyconv_item(a, l, c, lds));
            RUN(15, true, if (l == 0) for (int it = bid; it < 256; it += G) hycctx_item(a, l, it, lds));
        }
        TOC(4); } SEAM(pb + 3); { TIC();
        if (EN(13) && IN(pb + 4)) { scan_prop(a); if (REP(20)) { xcd_barrier(bar); xcd_barrier(bar); xcd_barrier(bar); xcd_barrier(bar); xcd_barrier(bar); } }
        TOC(5); } SEAM(pb + 4); { TIC();
        if (EN(14) && IN(pb + 5)) { RUN(17, true, for (int it = bid; it < SCAN_ITEMS; it += G) scan_item2<true>(a, l, it, lds)); }
        TOC(6); } SEAM(pb + 5); { TIC();
        if (EN(5) && IN(pb + 6)) {
            const int nit = (nrows / 64) * 16;
            { const int g_ = G, w0_ = __builtin_amdgcn_readfirstlane(tid >> 6) * g_ + bid, n_ = (nrows / 64) * 128; RUN(7, true, scancomb_rows(a, l, nrows); for (int it = w0_; it < n_; it += 8 * g_) hycomb_witem(a, l, it)); }
        }
        TOC(7); } SEAM(pb + 6); { TIC();
        if (EN(6) && IN(pb + 7)) {
            const bf16* Y = (const bf16*)(ws + WS_YMIX); const bf16* WB = (const bf16*)(ws + WS_WBR);
            pg8::StaticOrder S; S.init(nrows, D, G, bid);
            RUN(8, true,
            { pg8::Gemm g{Y, WB, nrows, D, 1024}; EpiBr<0> E{U, Z + Z_MG}; pg8::gemm_phase<EpiBr<0>, pg8::StaticOrder, true, true>(lds, g, S, E); }
            __syncthreads();
            { pg8::Gemm g{Y + (size_t)MT * 1024, WB + (size_t)D * 1024, nrows, D, 1024}; EpiBr<1> E{U, Z + Z_MG + D}; pg8::gemm_phase<EpiBr<1>, pg8::StaticOrder, true, true>(lds, g, S, E); }
            __syncthreads();
            { pg8::Gemm g{Y + (size_t)2 * MT * 1024, WB + (size_t)2 * D * 1024, nrows, D, 1024}; EpiBr<2> E{U, Z + Z_MG + 2 * D}; pg8::gemm_phase<EpiBr<2>, pg8::StaticOrder, true, true>(lds, g, S, E); });
        }
        TOC(8); } SEAM(pb + 7); { TIC();
        if (EN(7) && IN(pb + 8)) {
            pg8::Gemm g{U, (const bf16*)(ws + WS_WOUT), nrows, D, D}; pg8::StaticOrder S; S.init(nrows, D, G, bid);
            EpiOut E{l == 0 ? ain(a, I_X) : H, l == 0 ? ain(a, I_CTX) : H + (size_t)SEQ * D, H, modall + (size_t)l * 2 * 12288 + 4096};
            RUN(9, l == 0, pg8::gemm_phase<EpiOut, pg8::StaticOrder, true, true>(lds, g, S, E));
        }
        TOC(9); } SEAM(pb + 8); { TIC();
        if (EN(8) && IN(pb + 9)) {
            route_phase<false>(a, l, nrows, ldsf, ka.pad);
            __syncthreads();
            if (REP(19)) { route_phase<true>(a, l, nrows, ldsf); __syncthreads(); }

        }
        TOC(10); } SEAM(pb + 9); { TIC();
        if (EN(9) && IN(pb + 10)) { RUN(11, true, permute_phase(a, l, nrows, lds)); __syncthreads(); RUN(10, true, cvt_stream<true>(a, l, ldsf)); __syncthreads(); }
        TOC(11); } SEAM(pb + 10); { TIC();
        if (EN(10) && IN(pb + 11)) {
            const int* tile_e = (const int*)(ws + WS_TILEE); const int ntiles = tile_e[200];
            pg8::Gemm g{(const bf16*)(ws + WS_XP), (const bf16*)(ws + WS_WGU), MOE_MAXROWS, NEXP * 1024, D}; MoeOrder S{tile_e, ntiles, 4, G, bid};
            EpiGU E{(bf16*)(ws + WS_HMID)};
            RUN(12, true, pg8::gemm_phase<EpiGU, MoeOrder, true, true>(lds, g, S, E));
        }
        TOC(12); } SEAM(pb + 11); { TIC();
        if (EN(11) && IN(pb + 12)) {
            const int* tile_e = (const int*)(ws + WS_TILEE); const int ntiles = tile_e[200];
            pg8::Gemm g{(const bf16*)(ws + WS_HMID), (const bf16*)(ws + WS_WD), MOE_MAXROWS, NEXP * D, DFF}; MoeOrder S{tile_e, ntiles, 8, G, bid};
            EpiDn E{(bf16*)(ws + WS_YP), (const float*)(ws + WS_ROWW)};
            RUN(13, true, pg8::gemm_phase<EpiDn, MoeOrder, true, true>(lds, g, S, E));
        }
        TOC(13); } SEAM(pb + 12); { TIC();
        (void)0; }
    }
#ifdef PROBE_SEL
    if (tid == 0) ((LAS unsigned long long*)(ldsbase() + LDS_TIM))[0] = __builtin_amdgcn_s_memrealtime() - tkern_;
    __syncthreads();
#endif
    if (EN(12) && IN(PH_FINAL)) norm_phase<2>(a, DEPTH, SEQ, ldsf);
#undef IN
#undef SEAM
#undef ws
#undef bid
#undef G
#undef lds
#undef ldsf
#undef U
#undef Z
#undef H
#undef modall
}

#ifndef MK_SINGLE
#define MK_SINGLE 1
#endif
extern "C" void kernel_launch(void* const* d_in, const int* in_sizes, int n_in, void* d_out, int out_size, void* d_ws, size_t ws_size, hipStream_t stream) {
    static int grid = 0;
    if (grid == 0) {
        if (n_in != N_IN || out_size != SEQ * D || ws_size < WS_END) { fprintf(stderr, "kernel_launch: unexpected problem shape (n_in %d, out %d, ws %zu < %zu)\n", n_in, out_size, ws_size, (size_t)WS_END); grid = -1; return; }
        int dev = 0, cus = 0;
        if (hipGetDevice(&dev) != hipSuccess || hipDeviceGetAttribute(&cus, hipDeviceAttributeMultiprocessorCount, dev) != hipSuccess) { grid = -1; return; }
        if (hipFuncSetAttribute((const void*)fwd_kernel, hipFuncAttributeMaxDynamicSharedMemorySize, LDS_BYTES) != hipSuccess) { fprintf(stderr, "kernel_launch: hipFuncSetAttribute failed\n"); grid = -1; return; }
        int per_cu = 0;
        if (hipOccupancyMaxActiveBlocksPerMultiprocessor(&per_cu, (const void*)fwd_kernel, NTHR, LDS_BYTES) != hipSuccess || per_cu < 1) fprintf(stderr, "kernel_launch: occupancy query says %d\n", per_cu);
        (void)hipGetLastError();
        grid = cus;
    }
    if (grid < 0) return;
    (void)hipMemsetAsync((char*)d_ws + WS_CTL, 0, CTL_BYTES, stream);
    KArgs ka{};
    for (int i = 0; i < N_IN; ++i) ka.a.in[i] = (const float*)d_in[i];
    ka.a.out = (float*)d_out; ka.a.ws = (unsigned char*)d_ws;
#if MK_SINGLE
    ka.a.ph_lo = 0; ka.a.ph_hi = NPHASES; ka.li = 0; ka.pad = 0;
    hipLaunchKernelGGL(fwd_kernel, dim3(grid), dim3(NTHR), LDS_BYTES, stream, ka);
#ifdef PROBE_K
    (void)hipMemsetAsync((char*)d_ws + WS_CTL + (size_t)CW_CNT * 4, 0, 16384, stream);
    ka.a.ph_lo = 0; ka.a.ph_hi = PROBE_K; ka.li = 1;
#ifdef PROBE_V
    ka.pad = PROBE_V;
#endif
    hipLaunchKernelGGL(fwd_kernel, dim3(grid), dim3(NTHR), LDS_BYTES, stream, ka);
#endif
#else
    for (int ph = 0; ph < NPHASES; ++ph) { ka.a.ph_lo = ph; ka.a.ph_hi = ph + 1; ka.li = 0; ka.pad = 0; hipLaunchKernelGGL(fwd_kernel, dim3(grid), dim3(NTHR), LDS_BYTES, stream, ka); }
#endif
}
```

```cpp
#include <hip/hip_runtime.h>
#include <cstdio>
#include <cstdint>
#define DI __device__ __forceinline__
#define LAS __attribute__((address_space(3)))
typedef unsigned short bf16;
typedef float f32x4 __attribute__((ext_vector_type(4)));
typedef unsigned u32x4 __attribute__((ext_vector_type(4)));
typedef unsigned u32x2 __attribute__((ext_vector_type(2)));

constexpr int D = 2048, SEQ = 16384, CTXL = 256, MT = SEQ + CTXL  , DEPTH = 2;
constexpr int NCOLS_IN = 17440;
constexpr int ZC = 17664;
constexpr int Z_HG = 0, Z_GL = 5120, Z_HY = 8192, Z_MG = 11264, Z_LR = 17408;
constexpr int NEXP = 32, DFF = 512, MOE_MAXROWS = 41472;
constexpr float NORM_EPS = 1e-6f;

constexpr size_t MiB = 1u << 20;
constexpr size_t WS_CTL = 0, CTL_BYTES = 1 * MiB;
constexpr size_t WS_SMALL = 1 * MiB;
constexpr size_t WS_MOD   = WS_SMALL;
constexpr size_t WS_ZBIAS = WS_MOD + (size_t)DEPTH * 2 * 12288 * 4;
constexpr size_t WS_LB    = WS_ZBIAS + (size_t)DEPTH * ZC * 4;
constexpr size_t WS_TW    = WS_LB + (size_t)DEPTH * 2 * 1024 * 4;
constexpr size_t WS_TW2   = WS_TW + 16384 * 8;
constexpr size_t WS_H2    = WS_TW2 + (8192 + 64) * 8;
constexpr size_t WS_ROUTE = WS_H2 + (size_t)DEPTH * MT * 64 * 4;
constexpr size_t WS_ROWW  = WS_ROUTE + (size_t)MT * 8 * 4;
constexpr size_t WS_TILEE = WS_ROWW + (size_t)MOE_MAXROWS * 4;
constexpr size_t WS_HYC   = WS_TILEE + 1024;
constexpr size_t WS_W3T   = WS_HYC + (size_t)2048 * 256 * 4;
constexpr size_t WS_H2B   = WS_W3T + (size_t)DEPTH * 2048 * 256 * 2;
constexpr size_t WS_WRT   = WS_H2B + (size_t)DEPTH * SEQ * 256 * 2;
constexpr size_t WS_SMALL_END = WS_WRT + (size_t)DEPTH * 2 * 48 * 2048 * 2;
static_assert(WS_SMALL_END <= 40 * MiB, "small tables");
constexpr size_t WS_WIN  = 40 * MiB;
constexpr size_t WS_WBR  = 109 * MiB;
constexpr size_t WS_WOUT = 121 * MiB;
constexpr size_t WS_WGU  = 129 * MiB;
constexpr size_t WS_CVO  = WS_WIN;
constexpr size_t WS_WD   = 257 * MiB;
constexpr size_t WS_H    = 321 * MiB;
constexpr size_t WS_U    = 451 * MiB;
constexpr size_t WS_Z    = 516 * MiB;
constexpr size_t WS_XP   = WS_Z;
constexpr size_t WS_HMID = WS_Z + 162 * MiB;
constexpr size_t WS_YP   = WS_Z + 203 * MiB;
constexpr size_t WS_YMIX = 1077 * MiB;
constexpr size_t WS_HF   = 1175 * MiB;
constexpr size_t WS_OSC  = 1175 * MiB;
constexpr size_t WS_END  = 1435 * MiB;
static_assert(WS_WIN + (size_t)ZC * D * 2 <= WS_WBR && WS_Z + (size_t)MT * ZC * 2 <= WS_YMIX && WS_YMIX + (size_t)3 * MT * 1024 * 2 <= WS_OSC && WS_OSC + (size_t)4 * MT * 1024 * 4 <= WS_END, "ws map");
static_assert(WS_YP + (size_t)MOE_MAXROWS * D * 2 <= WS_YMIX && WS_H + (size_t)MT * D * 4 <= WS_U && WS_U + (size_t)MT * D * 2 <= WS_Z, "ws map 2");
constexpr int CW_BAR = 4096;
constexpr int CW_CNT = 16384;

DI float bf2f(bf16 v) { return __uint_as_float(((unsigned)v) << 16); }
DI float bflo(unsigned w) { return __uint_as_float(w << 16); }
DI float bfhi(unsigned w) { return __uint_as_float(w & 0xffff0000u); }
typedef float f32x2_t __attribute__((ext_vector_type(2))); typedef __bf16 bf16x2_t __attribute__((ext_vector_type(2)));
DI unsigned pk_bf16(float lo, float hi) { f32x2_t v = {lo, hi}; bf16x2_t b = __builtin_convertvector(v, bf16x2_t); return __builtin_bit_cast(unsigned, b); }
DI bf16 f2bf(float f) { return (bf16)(pk_bf16(f, 0.f) & 0xffffu); }
DI float sigmoidf_(float x) { return __builtin_amdgcn_rcpf(1.0f + __expf(-x)); }
DI float siluf_(float x) { return x * __builtin_amdgcn_rcpf(1.0f + __expf(-x)); }
DI float wave_sum(float v) {
#pragma unroll
    for (int o = 32; o >= 1; o >>= 1) v += __shfl_xor(v, o);
    return v;
}
DI int otid() { int t = __builtin_amdgcn_workitem_id_x(); asm volatile("" : "+v"(t)); return t; }
DI int ogdim() { int g = __builtin_amdgcn_workgroup_id_x(); g = (int)gridDim.x; asm volatile("" : "+s"(g)); return g; }
DI int obid() { int b = __builtin_amdgcn_workgroup_id_x(); asm volatile("" : "+s"(b)); return b; }
#define AIN_DECL 1
DI LAS f32x2_t* fft_vec2_(LAS float* p) { return (LAS f32x2_t*)p; }
DI const f32x2_t* fft_vec2_(const float* p) { return (const f32x2_t*)p; }
DI f32x2_t* fft_vec2_(float* p) { return (f32x2_t*)p; }
namespace pg8 {
#define PG8_LAS __attribute__((address_space(3)))
typedef unsigned short bf16_t;
typedef short bf16x8 __attribute__((ext_vector_type(8)));
typedef float f32x4 __attribute__((ext_vector_type(4)));
typedef unsigned u32x4 __attribute__((ext_vector_type(4)));
constexpr int BM = 256, BK = 64, HALF = 128, HTB = HALF * BK * 2  , STAGE_BYTES = 8 * HTB, NXCD = 8, WGM = 8;

__host__ __device__ __forceinline__ int lds_byte(int r, int c) { const int st = (r >> 4) * 2 + (c >> 5), rr = r & 15, cc = c & 31, ob = rr * 64 + cc * 2; return st * 1024 + (ob ^ (((ob >> 9) & 1) << 5)); }
__host__ __device__ __forceinline__ void stage_rc(int b, int& R, int& C) { const int st = b / 1024, sb = b % 1024, swz = sb ^ (((sb >> 9) & 1) << 5); R = (st >> 1) * 16 + swz / 64; C = (st & 1) * 32 + (swz % 64) / 2; }
__host__ __device__ __forceinline__ int perm32(int rho) { const int n = rho >> 4, i = rho & 15; return 8 * (i >> 2) + 4 * n + (i & 3); }

struct Unit { int pm, pn; };
struct Gemm { const bf16_t* A; const bf16_t* Bt; int M, N, K; };

struct StaticOrder {
    int nM, nN, nwg, G, c;
    __host__ __device__ void init(int M, int N, int G_, int c_) { nM = M / BM; nN = N / BM; nwg = nM * nN; G = G_; c = c_; }
    __host__ __device__ bool next(int i, Unit& u) const {
        const long L = (long)i * G + c; if (L >= nwg) return false;
        int wgid = (int)L; { const int q = nwg / NXCD, r = nwg % NXCD, xcd = wgid % NXCD, off = wgid / NXCD; wgid = (xcd < r ? xcd * (q + 1) : r * (q + 1) + (xcd - r) * q) + off; }
        const int nig = WGM * nN, gid = wgid / nig, fm = gid * WGM, gsz = (nM - fm) < WGM ? (nM - fm) : WGM;
        u.pm = fm + ((wgid % nig) % gsz); u.pn = (wgid % nig) / gsz; return true;
    }
    __device__ __forceinline__ void a_ready(const Unit&) const {}
    __device__ __forceinline__ void done(const Unit&) const {}
};

template <class Epi, class Sched, bool ALIGN_EPI = false, bool SP2 = false>
__device__ __forceinline__ void gemm_phase(PG8_LAS unsigned char* lds, const Gemm g, const Sched& S, const Epi& E) {
    const int tid = otid(), wid = __builtin_amdgcn_readfirstlane(tid >> 6), lane = tid & 63, wr = wid >> 2, wc = wid & 3, fr = lane & 15, fq = lane >> 4;
    const int K = g.K, nt = K / BK;
    unsigned voffA[2], voffB[2];
#pragma unroll
    for (int i = 0; i < 2; ++i) { int R, C; stage_rc(tid * 16 + i * 8192, R, C); const int Rb = Epi::PERM ? ((R & ~31) + perm32(R & 31)) : R;
        voffA[i] = (unsigned)(R * K + C) * 2u; voffB[i] = (unsigned)(Rb * K + C) * 2u; }
    const size_t kstep = (size_t)(BK * 2);
    const size_t hstep = (size_t)HALF * K * 2;
    const size_t tstep = 2 * hstep;
    const unsigned ldsw = (unsigned)wid * 1024u;
    const int aoff = lds_byte(wr * 64 + fr, fq * 8), boff = lds_byte(wc * 32 + fr, fq * 8);
#define PG8_SA(b, h) (((b) * 2 + (h)) * HTB)
#define PG8_SB(b, h) ((4 + (b) * 2 + (h)) * HTB)
#define PG8_STAGE(bufoff, gbase, voff) do { _Pragma("unroll") for (int _i = 0; _i < 2; ++_i) \
        __builtin_amdgcn_global_load_lds((const unsigned*)((const char*)(gbase) + (voff)[_i]), (PG8_LAS unsigned*)(lds + (bufoff) + ldsw + _i * 8192), 16, 0, 0); } while (0)
#define PG8_LDA(dst, b, h) do { _Pragma("unroll") for (int m = 0; m < 4; ++m) _Pragma("unroll") for (int k = 0; k < 2; ++k) dst[m][k] = *(const PG8_LAS bf16x8*)(lds + PG8_SA(b, h) + aoff + m * 2048 + k * 1024); } while (0)
#define PG8_LDB(dst, b, h) do { _Pragma("unroll") for (int n = 0; n < 2; ++n) _Pragma("unroll") for (int k = 0; k < 2; ++k) dst[n][k] = *(const PG8_LAS bf16x8*)(lds + PG8_SB(b, h) + boff + n * 2048 + k * 1024); } while (0)
#define PG8_MMA(ai, bj, At, Bt) do { __builtin_amdgcn_s_setprio(1); _Pragma("unroll") for (int m = 0; m < 4; ++m) _Pragma("unroll") for (int n = 0; n < 2; ++n) _Pragma("unroll") for (int k = 0; k < 2; ++k) \
        acc[ai][bj][m][n] = __builtin_amdgcn_mfma_f32_16x16x32_bf16(Bt[n][k], At[m][k], acc[ai][bj][m][n], 0, 0, 0); __builtin_amdgcn_s_setprio(0); } while (0)
#define PG8_WAIT_V(n) asm volatile("s_waitcnt vmcnt(" #n ")" ::: "memory")
#define PG8_WAIT_L(n) asm volatile("s_waitcnt lgkmcnt(" #n ")" ::: "memory")
#define PG8_BAR __builtin_amdgcn_s_barrier()
#define PG8_SCHED __builtin_amdgcn_sched_barrier(0)
    Unit cur, nxt; int ui = 0;
    if (!S.next(0, cur)) return;
    f32x4 acc[2][2][4][2];
#pragma unroll
    for (int a = 0; a < 2; ++a)
#pragma unroll
        for (int b = 0; b < 2; ++b)
#pragma unroll
            for (int m = 0; m < 4; ++m)
#pragma unroll
                for (int n = 0; n < 2; ++n) acc[a][b][m][n] = (f32x4){0.f, 0.f, 0.f, 0.f};
    bf16x8 At[4][2], B0[2][2], B1[2][2];
    const char* cA = (const char*)g.A + (size_t)cur.pm * tstep; const char* cB = (const char*)g.Bt + (size_t)cur.pn * tstep;
    S.a_ready(cur);
    if constexpr (SP2) {
        PG8_STAGE(PG8_SB(0, 0), cB, voffB); PG8_STAGE(PG8_SB(0, 1), cB + hstep, voffB); PG8_STAGE(PG8_SA(0, 0), cA, voffA); PG8_STAGE(PG8_SA(0, 1), cA + hstep, voffA);
        if (wr == 1) PG8_BAR;
        PG8_WAIT_V(2); PG8_BAR;
        PG8_STAGE(PG8_SB(1, 0), cB + kstep, voffB); PG8_STAGE(PG8_SA(1, 0), cA + kstep, voffA); PG8_STAGE(PG8_SB(1, 1), cB + hstep + kstep, voffB);
        PG8_WAIT_V(6); PG8_BAR;
    } else {
        PG8_STAGE(PG8_SB(0, 0), cB, voffB); PG8_STAGE(PG8_SA(0, 0), cA, voffA); PG8_STAGE(PG8_SB(0, 1), cB + hstep, voffB); PG8_STAGE(PG8_SA(0, 1), cA + hstep, voffA);
        if (wr == 1) PG8_BAR;
        PG8_WAIT_V(4); PG8_BAR;
        PG8_STAGE(PG8_SB(1, 0), cB + kstep, voffB); PG8_STAGE(PG8_SA(1, 0), cA + kstep, voffA); PG8_STAGE(PG8_SB(1, 1), cB + hstep + kstep, voffB);
        PG8_WAIT_V(6); PG8_BAR;
    }
    for (;;) {
        const bool has_next = S.next(ui + 1, nxt);
        const char* nA = has_next ? (const char*)g.A + (size_t)nxt.pm * tstep : cA; const char* nB = has_next ? (const char*)g.Bt + (size_t)nxt.pn * tstep : cB;
        for (int t = 0; t < nt; t += 2) {
            const bool last = (t == nt - 2);
            const char* a1 = cA + (size_t)(t + 1) * kstep;
            const char* a2 = last ? nA : cA + (size_t)(t + 2) * kstep; const char* b2 = last ? nB : cB + (size_t)(t + 2) * kstep;
            const char* a3 = a2 + kstep; const char* b3 = b2 + kstep;
            if (last && has_next) S.a_ready(nxt);
            if constexpr (SP2) {
            PG8_LDB(B0, 0, 0); PG8_LDB(B1, 0, 1); PG8_SCHED; PG8_LDA(At, 0, 0); PG8_STAGE(PG8_SA(1, 1), a1 + hstep, voffA);
            PG8_WAIT_V(8); PG8_WAIT_L(0); PG8_BAR; PG8_MMA(0, 0, At, B0); PG8_MMA(0, 1, At, B1); PG8_BAR; PG8_SCHED;
            PG8_LDA(At, 0, 1); PG8_STAGE(PG8_SB(0, 0), b2, voffB); PG8_STAGE(PG8_SB(0, 1), b2 + hstep, voffB); PG8_STAGE(PG8_SA(0, 0), a2, voffA);
            PG8_WAIT_V(8); PG8_WAIT_L(0); PG8_BAR; PG8_MMA(1, 0, At, B0); PG8_MMA(1, 1, At, B1); PG8_BAR; PG8_SCHED;
            PG8_LDB(B0, 1, 0); PG8_LDB(B1, 1, 1); PG8_SCHED; PG8_LDA(At, 1, 0); PG8_STAGE(PG8_SA(0, 1), a2 + hstep, voffA);
            PG8_WAIT_V(8); PG8_WAIT_L(0); PG8_BAR; PG8_MMA(0, 0, At, B0); PG8_MMA(0, 1, At, B1); PG8_BAR; PG8_SCHED;
            PG8_LDA(At, 1, 1); PG8_STAGE(PG8_SB(1, 0), b3, voffB); PG8_STAGE(PG8_SB(1, 1), b3 + hstep, voffB); PG8_STAGE(PG8_SA(1, 0), a3, voffA);
            PG8_WAIT_V(8); PG8_WAIT_L(0); PG8_BAR; PG8_MMA(1, 0, At, B0); PG8_MMA(1, 1, At, B1); PG8_BAR; PG8_SCHED;
            } else {
            PG8_LDB(B0, 0, 0); PG8_SCHED; PG8_LDA(At, 0, 0); PG8_STAGE(PG8_SA(1, 1), a1 + hstep, voffA);
            PG8_WAIT_L(8); PG8_BAR; PG8_WAIT_L(0); PG8_MMA(0, 0, At, B0); PG8_BAR; PG8_SCHED;
            PG8_LDB(B1, 0, 1); PG8_STAGE(PG8_SB(0, 0), b2, voffB);
            PG8_BAR; PG8_WAIT_L(0); PG8_MMA(0, 1, At, B1); PG8_BAR;
            PG8_LDA(At, 0, 1); PG8_STAGE(PG8_SA(0, 0), a2, voffA);
            PG8_BAR; PG8_WAIT_L(0); PG8_MMA(1, 0, At, B0); PG8_BAR; PG8_SCHED;
            PG8_STAGE(PG8_SB(0, 1), b2 + hstep, voffB);
            PG8_WAIT_V(6); PG8_BAR; PG8_MMA(1, 1, At, B1); PG8_BAR;
            PG8_LDB(B0, 1, 0); PG8_SCHED; PG8_LDA(At, 1, 0); PG8_STAGE(PG8_SA(0, 1), a2 + hstep, voffA);
            PG8_WAIT_L(8); PG8_BAR; PG8_WAIT_L(0); PG8_MMA(0, 0, At, B0); PG8_BAR; PG8_SCHED;
            PG8_LDB(B1, 1, 1); PG8_STAGE(PG8_SB(1, 0), b3, voffB);
            PG8_BAR; PG8_WAIT_L(0); PG8_MMA(0, 1, At, B1); PG8_BAR;
            PG8_LDA(At, 1, 1); PG8_STAGE(PG8_SA(1, 0), a3, voffA);
            PG8_BAR; PG8_WAIT_L(0); PG8_MMA(1, 0, At, B0); PG8_BAR; PG8_SCHED;
            PG8_STAGE(PG8_SB(1, 1), b3 + hstep, voffB);
            PG8_WAIT_V(6); PG8_BAR; PG8_MMA(1, 1, At, B1); PG8_BAR;
            }
        }
        if constexpr (ALIGN_EPI) { if (wr == 0) PG8_BAR; }
        if constexpr (!Epi::AFTER_DRAIN) { E(acc, cur, wr, wc, fr, fq); S.done(cur); }
        if (!has_next) break;
#pragma unroll
        for (int a = 0; a < 2; ++a)
#pragma unroll
            for (int b = 0; b < 2; ++b)
#pragma unroll
                for (int m = 0; m < 4; ++m)
#pragma unroll
                    for (int n = 0; n < 2; ++n) acc[a][b][m][n] = (f32x4){0.f, 0.f, 0.f, 0.f};
        cur = nxt; cA = nA; cB = nB; ++ui;
        if constexpr (ALIGN_EPI) { if (wr == 1) PG8_BAR; }
    }
    PG8_WAIT_V(0);
    if constexpr (!ALIGN_EPI) { if (wr == 0) PG8_BAR; }
    PG8_BAR;
    if constexpr (Epi::AFTER_DRAIN) { E.fused(acc, cur, wr, wc, fr, fq, lds, wid, lane); S.done(cur); }
#undef PG8_SA
#undef PG8_SB
#undef PG8_STAGE
#undef PG8_LDA
#undef PG8_LDB
#undef PG8_MMA
#undef PG8_WAIT_V
#undef PG8_WAIT_L
#undef PG8_BAR
#undef PG8_SCHED
}
}
#define XB_TMO      128
#define XB_XCNT(j)  (256  + 64 * (j))
#define XB_XSUB(j)  (1280 + 64 * (j))
#define XB_XGEN(j)  (2304 + 64 * (j))
#define XB_TOP      3328
#define XB_TOPGEN   3392
#define XCD_BAR_WORDS 3456
#define XB_SPIN_CAP (1u << 18)

__device__ __forceinline__ unsigned xb_ld(unsigned* p)              { return __hip_atomic_load(p, __ATOMIC_RELAXED, __HIP_MEMORY_SCOPE_AGENT); }
__device__ __forceinline__ unsigned xb_add(unsigned* p, unsigned v) { return __hip_atomic_fetch_add(p, v, __ATOMIC_RELAXED, __HIP_MEMORY_SCOPE_AGENT); }
__device__ __forceinline__ unsigned xb_xcc_id() { return (unsigned)__builtin_amdgcn_s_getreg((3 << 11) | 20) & 0xFu; }
#define XB_SPIN(cond, bar) do { unsigned _sp = 0; while (cond) { __builtin_amdgcn_s_sleep(1); \
    if ((++_sp & 255u) == 0u) { if (xb_ld(&(bar)[XB_TMO])) break; if (_sp > XB_SPIN_CAP) { atomicAdd(&(bar)[XB_TMO], 1u); break; } } } } while (0)

struct XcdBarrier {
    unsigned* bar; unsigned x;
    volatile LAS unsigned* st;
};

__device__ __forceinline__ XcdBarrier xcd_barrier_post(unsigned* bar, volatile LAS unsigned* st) {
    XcdBarrier b; b.bar = bar; b.x = xb_xcc_id(); b.st = st;
    if (otid() == 0) (void)xb_add(&bar[XB_XCNT(b.x)], 1u);
    return b;
}
__device__ __forceinline__ void xcd_barrier_complete(unsigned* bar, unsigned x, unsigned& nloc, unsigned& nx) {
    asm volatile("" : "+s"(x));
    const unsigned G = ogdim();
    unsigned sum, cnt, mine, sp = 0u;
    for (;;) {
        sum = 0u; cnt = 0u; mine = 0u;
#pragma unroll
        for (unsigned j = 0; j < 16; ++j) { const unsigned c = xb_ld(&bar[XB_XCNT(j)]); sum += c; cnt += (c > 0u) ? 1u : 0u; mine = (j == x) ? c : mine; }
        if (sum == G) break;
        __builtin_amdgcn_s_sleep(1);
        if ((++sp & 255u) == 0u) { if (xb_ld(&bar[XB_TMO])) break; if (sp > XB_SPIN_CAP) { atomicAdd(&bar[XB_TMO], 1u); break; } }
    }
    nloc = mine > 0u ? mine : 1u; nx = cnt > 0u ? cnt : 1u;
}

__device__ __forceinline__ void xcd_barrier(const XcdBarrier& b) {
    asm volatile("s_waitcnt vmcnt(0)" ::: "memory");
    __syncthreads();
    if (otid() == 0) {
        unsigned* bar = b.bar;
        __builtin_amdgcn_s_waitcnt(0);
        unsigned nloc = b.st[0], nx = b.st[1];
        if (nloc == 0u) { xcd_barrier_complete(bar, b.x, nloc, nx); b.st[0] = nloc; b.st[1] = nx; }
        const unsigned old = xb_add(&bar[XB_XSUB(b.x)], 1u);
        const unsigned gen = old / nloc;
        if (old + 1u == (gen + 1u) * nloc) {
            __builtin_amdgcn_fence(__ATOMIC_RELEASE, "agent");
            asm volatile("s_waitcnt vmcnt(0)" ::: "memory");
            const unsigned og = xb_add(&bar[XB_TOP], 1u);
            const unsigned tg = og / nx;
            if (og + 1u == (tg + 1u) * nx) xb_add(&bar[XB_TOPGEN], 1u);
            else XB_SPIN(xb_ld(&bar[XB_TOPGEN]) == tg, bar);
            __builtin_amdgcn_fence(__ATOMIC_ACQUIRE, "agent");
            xb_add(&bar[XB_XGEN(b.x)], 1u);
            asm volatile("s_waitcnt vmcnt(0)" ::: "memory");
        } else {
            XB_SPIN(xb_ld(&bar[XB_XGEN(b.x)]) == gen, bar);
            __builtin_amdgcn_fence(__ATOMIC_ACQUIRE, "agent");
            asm volatile("s_waitcnt vmcnt(0)" ::: "memory");
        }
    }
    __syncthreads();
}

#define FFT_DI DI
struct cpx; template <class P> DI cpx fft_ldc_(P p, int i); template <class P> DI void fft_stc_(P p, int i, const cpx& v);
#define FFT_LDC(p, i) fft_ldc_((p), (i))
#define FFT_STC(p, i, v) fft_stc_((p), (i), (v))
#define FFT_M 16384
#define FFT_NT 512
struct cpx { float x, y; };
#ifdef FFT_LDC
template <class P> FFT_DI cpx fft_ldc_(P p, int i) { const f32x2_t v = *(const decltype(fft_vec2_(p)))(p + 2 * i); cpx r; r.x = v[0]; r.y = v[1]; return r; }
template <class P> FFT_DI void fft_stc_(P p, int i, const cpx& v) { f32x2_t w = {v.x, v.y}; *(decltype(fft_vec2_(p)))(p + 2 * i) = w; }
#endif
#ifndef FFT_LDC
#define FFT_LDC(p, i) ([&]{ cpx r_; r_.x = (p)[2 * (i)]; r_.y = (p)[2 * (i) + 1]; return r_; }())
#define FFT_STC(p, i, v) do { (p)[2 * (i)] = (v).x; (p)[2 * (i) + 1] = (v).y; } while (0)
#endif
FFT_DI cpx cmul(cpx a, cpx b) { cpx r; r.x = a.x * b.x - a.y * b.y; r.y = a.x * b.y + a.y * b.x; return r; }
FFT_DI cpx cmulc(cpx a, cpx b) { cpx r; r.x = a.x * b.x + a.y * b.y; r.y = a.y * b.x - a.x * b.y; return r; }
FFT_DI int rev4_14(int k) {
    int r = 0;
#pragma unroll
    for (int d = 0; d < 7; ++d) { r = (r << 2) | (k & 3); k >>= 2; }
    return r;
}
struct FftTw { cpx c256[3], c64[3], c16[3], c4[3]; };
template <class TP> FFT_DI void fft_load_tw(FftTw& T, TP tw, int tid) {
#pragma unroll
    for (int q = 0; q < 3; ++q) { T.c256[q] = FFT_LDC(tw, (q + 1) * (tid & 255) * 16); T.c64[q] = FFT_LDC(tw, (q + 1) * (tid & 63) * 64); T.c16[q] = FFT_LDC(tw, (q + 1) * (tid & 15) * 256); T.c4[q] = FFT_LDC(tw, (q + 1) * (tid & 3) * 1024); }
}
template <int s, class TP> FFT_DI void fft_pick_tw(const FftTw& T, TP tw, int pos, int j, cpx& w1, cpx& w2, cpx& w3) {
    if (s == 4096) { w1 = FFT_LDC(tw, pos); w2 = FFT_LDC(tw, 2 * pos); w3 = FFT_LDC(tw, 3 * pos); }
    else if (s == 1024) { w1 = FFT_LDC(tw, 4 * pos); w2 = FFT_LDC(tw, 8 * pos); w3 = FFT_LDC(tw, 12 * pos); }
    else if (s == 256) { w1 = T.c256[0]; w2 = T.c256[1]; w3 = T.c256[2]; }
    else if (s == 64) { w1 = T.c64[0]; w2 = T.c64[1]; w3 = T.c64[2]; }
    else if (s == 16) { w1 = T.c16[0]; w2 = T.c16[1]; w3 = T.c16[2]; }
    else if (s == 4) { w1 = T.c4[0]; w2 = T.c4[1]; w3 = T.c4[2]; }
}
template <int s, class LP, class TP> FFT_DI void fft_fwd_pass(LP lds, const FftTw& T, TP tw, int tid) {
    cpx w1, w2, w3;
#pragma unroll 2
    for (int jj = 0; jj < FFT_M / 4 / FFT_NT; ++jj) { const int b = tid + FFT_NT * jj;
        const int pos = b & (s - 1), base = ((b & ~(s - 1)) << 2) + pos;
        const cpx a0 = FFT_LDC(lds, base), a1 = FFT_LDC(lds, base + s), a2 = FFT_LDC(lds, base + 2 * s), a3 = FFT_LDC(lds, base + 3 * s);
        cpx t0, t1, t2, t3;
        t0.x = a0.x + a2.x; t0.y = a0.y + a2.y;
        t1.x = a0.x - a2.x; t1.y = a0.y - a2.y;
        t2.x = a1.x + a3.x; t2.y = a1.y + a3.y;
        t3.x = a1.x - a3.x; t3.y = a1.y - a3.y;
        cpx y0, y1, y2, y3;
        y0.x = t0.x + t2.x; y0.y = t0.y + t2.y;
        y2.x = t0.x - t2.x; y2.y = t0.y - t2.y;
        y1.x = t1.x + t3.y; y1.y = t1.y - t3.x;
        y3.x = t1.x - t3.y; y3.y = t1.y + t3.x;
        if (s > 1) {
            fft_pick_tw<s>(T, tw, pos, jj, w1, w2, w3);
            y1 = cmul(y1, w1); y2 = cmul(y2, w2); y3 = cmul(y3, w3);
        }
        FFT_STC(lds, base, y0); FFT_STC(lds, base + s, y1); FFT_STC(lds, base + 2 * s, y2); FFT_STC(lds, base + 3 * s, y3);
    }
}
template <int s, class LP, class TP> FFT_DI void fft_inv_pass(LP lds, const FftTw& T, TP tw, int tid) {
    cpx w1, w2, w3;
#pragma unroll 2
    for (int jj = 0; jj < FFT_M / 4 / FFT_NT; ++jj) { const int b = tid + FFT_NT * jj;
        const int pos = b & (s - 1), base = ((b & ~(s - 1)) << 2) + pos;
        const cpx b0 = FFT_LDC(lds, base); cpx c1 = FFT_LDC(lds, base + s), c2 = FFT_LDC(lds, base + 2 * s), c3 = FFT_LDC(lds, base + 3 * s);
        if (s > 1) {
            fft_pick_tw<s>(T, tw, pos, jj, w1, w2, w3);
            c1 = cmulc(c1, w1); c2 = cmulc(c2, w2); c3 = cmulc(c3, w3);
        }
        cpx t0, t1, t2, t3;
        t0.x = b0.x + c2.x; t0.y = b0.y + c2.y;
        t1.x = b0.x - c2.x; t1.y = b0.y - c2.y;
        t2.x = c1.x + c3.x; t2.y = c1.y + c3.y;
        t3.x = c1.x - c3.x; t3.y = c1.y - c3.y;
        cpx x0, x1, x2, x3;
        x0.x = t0.x + t2.x; x0.y = t0.y + t2.y;
        x2.x = t0.x - t2.x; x2.y = t0.y - t2.y;
        x1.x = t1.x - t3.y; x1.y = t1.y + t3.x;
        x3.x = t1.x + t3.y; x3.y = t1.y - t3.x;
        FFT_STC(lds, base, x0); FFT_STC(lds, base + s, x1); FFT_STC(lds, base + 2 * s, x2); FFT_STC(lds, base + 3 * s, x3);
    }
}
template <class LP, class TP> FFT_DI void rfft_untangle(LP lds, TP tw2, int k, cpx& Xk, cpx& Xm) {
    if (k == 0) {
        const float zr = lds[0], zi = lds[1];
        Xk.x = zr + zi; Xk.y = zr - zi;
        const int p = rev4_14(FFT_M / 2);
        Xm.x = lds[2 * p]; Xm.y = -lds[2 * p + 1];
        return;
    }
    const int pk = rev4_14(k), pm = rev4_14(FFT_M - k);
    cpx Zk, Zm; Zk.x = lds[2 * pk]; Zk.y = lds[2 * pk + 1]; Zm.x = lds[2 * pm]; Zm.y = lds[2 * pm + 1];
    cpx E, O, W, WO;
    E.x = 0.5f * (Zk.x + Zm.x); E.y = 0.5f * (Zk.y - Zm.y);
    O.x = 0.5f * (Zk.y + Zm.y); O.y = -0.5f * (Zk.x - Zm.x);
    W.x = tw2[2 * k]; W.y = tw2[2 * k + 1];
    WO = cmul(W, O);
    Xk.x = E.x + WO.x; Xk.y = E.y + WO.y;
    Xm.x = E.x - WO.x; Xm.y = -(E.y - WO.y);
}
template <class LP, class TP> FFT_DI void rfft_mul_retangle(LP lds, TP tw2, int k, cpx Gk, cpx Gm) {
    cpx Xk, Xm; rfft_untangle(lds, tw2, k, Xk, Xm);
    if (k == 0) {
        const float y0 = Xk.x * Gk.x, yM = Xk.y * Gk.y;
        lds[0] = 0.5f * (y0 + yM); lds[1] = 0.5f * (y0 - yM);
        const cpx Y = cmul(Xm, Gm);
        const int p = rev4_14(FFT_M / 2);
        lds[2 * p] = Y.x; lds[2 * p + 1] = -Y.y;
        return;
    }
    const cpx Yk = cmul(Xk, Gk), Ym = cmul(Xm, Gm);
    cpx W; W.x = tw2[2 * k]; W.y = tw2[2 * k + 1];
    cpx A, D, T;
    A.x = 0.5f * (Yk.x + Ym.x); A.y = 0.5f * (Yk.y - Ym.y);
    D.x = 0.5f * (Yk.x - Ym.x); D.y = 0.5f * (Yk.y + Ym.y);
    T = cmulc(D, W);
    const int pk = rev4_14(k), pm = rev4_14(FFT_M - k);
    lds[2 * pk] = A.x - T.y; lds[2 * pk + 1] = A.y + T.x;
    cpx Dc; Dc.x = -D.x; Dc.y = D.y;
    const cpx T2 = cmul(W, Dc);
    lds[2 * pm] = A.x + T2.y; lds[2 * pm + 1] = -A.y - T2.x;
}
enum { I_X = 0, I_C, I_CTX, I_CCTX, I_WMOD, I_BMOD, I_NMIXW, I_NFFNW, I_WIN, I_BIN, I_HYCW, I_HYCB, I_HYW1, I_HYB1, I_HYW2, I_HYB2, I_HYW3, I_HYB3, I_HYFREQ, I_HYSKIP,
       I_HGLB, I_HGNW, I_GLWA2, I_GLBA, I_GLNW, I_WBR, I_WOUT, I_WRG, I_BRG, I_WRE, I_BRE, I_WGATE, I_WUP, I_WDOWN, I_FNW, N_IN };
struct Args { const float* in[N_IN]; float* out; unsigned char* ws; int ph_lo, ph_hi; };
#define GAS __attribute__((address_space(1)))
extern __shared__ __attribute__((aligned(16))) unsigned char lds_raw[];
constexpr int LDS_PTAB = 150 * 1024 - 64 - 320;
DI LAS unsigned char* ldsbase() { unsigned p = (unsigned)(unsigned long long)(LAS unsigned char*)lds_raw; asm volatile("" : "+s"(p)); return (LAS unsigned char*)(unsigned long long)p; }
DI const float* ain(const Args&, int i) { const unsigned long long v = ((LAS unsigned long long*)(ldsbase() + LDS_PTAB))[i];
    const unsigned lo = __builtin_amdgcn_readfirstlane((unsigned)v), hi = __builtin_amdgcn_readfirstlane((unsigned)(v >> 32)); return (const float*)(GAS const float*)(((unsigned long long)hi << 32) | lo); }
DI unsigned char* wsp(const Args& a) { unsigned long long p = (unsigned long long)(a).ws; asm volatile("" : "+s"(p)); return (unsigned char*)(GAS unsigned char*)p; }
DI int opq(int x) { asm volatile("" : "+s"(x)); return x; }
#ifdef PROBE_SEL
constexpr int LDS_TIM = 150 * 1024 - 64 - 320 - 512;
#define TIC() const unsigned long long tic_ = __builtin_amdgcn_s_memrealtime()
#define TOC(i) do { if (otid() == 0) ((LAS unsigned long long*)(ldsbase() + LDS_TIM))[i] += __builtin_amdgcn_s_memrealtime() - tic_; } while (0)
#else
#define TIC() do {} while (0)
#define TOC(i) do {} while (0)
#endif
#define LDS_BAR() do { asm volatile("s_waitcnt lgkmcnt(0)" ::: "memory"); __builtin_amdgcn_s_barrier(); asm volatile("" ::: "memory"); } while (0)
constexpr int NTHR = 512;
constexpr int LDS_BYTES = 150 * 1024;
constexpr int LDS_X = 131072;
constexpr int LDS_BARW = LDS_BYTES - 64;

DI int z_srccol(int zc) { return zc < 8192 ? zc : (zc < Z_LR ? zc + 32 : (zc < Z_LR + 32 ? zc - Z_LR + 8192 : -1)); }

template <bool RDONLY = false> DI void cvt_wtile(const float* __restrict__ src, size_t ld, int sc, bf16* __restrict__ dst, int K, int row0, int kb, LAS float* t  ) {
    const int nn = otid() & 63;
    float v[64];
    if (sc >= 0) {
#pragma unroll
        for (int p = 0; p < 64; ++p) v[p] = src[(size_t)(kb * 64 + p) * ld + sc];
    } else {
#pragma unroll
        for (int p = 0; p < 64; ++p) v[p] = 0.f;
    }
    if (RDONLY) { float s = 0.f;
#pragma unroll
        for (int p = 0; p < 64; ++p) s += v[p];
        asm volatile("" :: "v"(s)); return; }
#pragma unroll
    for (int p = 0; p < 64; ++p) t[p * 65 + nn] = v[p];
    asm volatile("s_waitcnt lgkmcnt(0)" ::: "memory");
    const int rsub = nn >> 3, kp = nn & 7;
#pragma unroll
    for (int q = 0; q < 8; ++q) { const int row = q * 8 + rsub; float w[8];
#pragma unroll
        for (int j = 0; j < 8; ++j) w[j] = t[(kp * 8 + j) * 65 + row];
        u32x4 o; o.x = pk_bf16(w[0], w[1]); o.y = pk_bf16(w[2], w[3]); o.z = pk_bf16(w[4], w[5]); o.w = pk_bf16(w[6], w[7]);
        *(u32x4*)(dst + (size_t)(row0 + row) * K + kb * 64 + kp * 8) = o; }
    asm volatile("s_waitcnt lgkmcnt(0)" ::: "memory");
}
constexpr int CVT_MIX_TILES = 276 * 32 + 3 * 32 * 16 + 32 * 32;
DI void cvt_mix_wtile(const Args& a, int l, int it, LAS float* t) {
    const int nn = otid() & 63;
    if (it < 276 * 32) { const int nb = it >> 5, kb = it & 31; cvt_wtile(ain(a, I_WIN) + (size_t)l * D * NCOLS_IN, NCOLS_IN, z_srccol(nb * 64 + nn), (bf16*)(wsp(a) + WS_WIN), D, nb * 64, kb, t); return; }
    it -= 276 * 32;
    if (it < 3 * 32 * 16) { const int br = it / 512, r = it % 512, nb = r >> 4, kb = r & 15;
        cvt_wtile(ain(a, I_WBR) + ((size_t)l * 3 + br) * 1024 * D, D, nb * 64 + nn, (bf16*)(wsp(a) + WS_WBR) + (size_t)br * D * 1024, 1024, nb * 64, kb, t); return; }
    it -= 3 * 32 * 16;
    { const int nb = it >> 5, kb = it & 31; cvt_wtile(ain(a, I_WOUT) + (size_t)l * D * D, D, nb * 64 + nn, (bf16*)(wsp(a) + WS_WOUT), D, nb * 64, kb, t); }
}
constexpr int CVT_MOE_TILES = 32 * 16 * 32 + 32 * 32 * 8;
template <bool RDONLY = false> DI void cvt_moe_wtile(const Args& a, int l, int it, LAS float* t) {
    const int nn = otid() & 63;
    if (it < 32 * 16 * 32) { const int e = it >> 9, r = it & 511, nb = r >> 5, kb = r & 31, nt = nb >> 2, sub = nb & 3;
        const float* src = (sub < 2 ? ain(a, I_WGATE) : ain(a, I_WUP)) + ((size_t)l * NEXP + e) * D * DFF;
        cvt_wtile<RDONLY>(src, DFF, nt * 128 + (sub & 1) * 64 + nn, (bf16*)(wsp(a) + WS_WGU) + (size_t)e * 1024 * D, D, nb * 64, kb, t); return; }
    it -= 32 * 16 * 32;
    { const int e = it >> 8, r = it & 255, nb = r >> 3, kb = r & 7;
      cvt_wtile<RDONLY>(ain(a, I_WDOWN) + ((size_t)l * NEXP + e) * DFF * D, D, nb * 64 + nn, (bf16*)(wsp(a) + WS_WD) + (size_t)e * D * DFF, DFF, nb * 64, kb, t); }
}
template <bool MOE, bool RDONLY = false> DI void cvt_stream(const Args& a, int l, LAS float* ldsf) {
    const int wave = __builtin_amdgcn_readfirstlane(otid() >> 6), n = MOE ? CVT_MOE_TILES : CVT_MIX_TILES, g_ = ogdim(), nw = g_ * 8;
    LAS float* t = ldsf + wave * (64 * 65);
    for (int it = wave * g_ + (int)obid(); it < n; it += nw) { if (MOE) cvt_moe_wtile<RDONLY>(a, l, it, t); else cvt_mix_wtile(a, l, it, t); }
}

DI void mod_item(const Args& a, int j, LAS float* lds) {
    const int tid = otid(), l = j >> 7, col0 = (j & 127) * 96;
    LAS float* sil = lds;
    LAS float* red = lds + 4096;
    for (int k = tid; k < 2 * D; k += NTHR) { const float c = (k < D) ? ain(a, I_C)[k] : ain(a, I_CCTX)[k - D]; sil[k] = siluf_(c); }
    __syncthreads();
    const int cg = tid % 24, rg = tid / 24;
    f32x4 a0 = {0.f, 0.f, 0.f, 0.f}, a1 = {0.f, 0.f, 0.f, 0.f};
    if (rg < 21) {
        const float* w = ain(a, I_WMOD) + (size_t)l * D * 12288 + col0 + cg * 4;
        for (int k = rg; k < D; k += 21) { const f32x4 wv = *(const f32x4*)(w + (size_t)k * 12288); a0 += wv * sil[k]; a1 += wv * sil[D + k]; }
#pragma unroll
        for (int q = 0; q < 4; ++q) { red[(rg * 2 + 0) * 96 + cg * 4 + q] = a0[q]; red[(rg * 2 + 1) * 96 + cg * 4 + q] = a1[q]; }
    }
    __syncthreads();
    if (tid < 192) { const int set = tid / 96, c = tid % 96; float s = 0.f;
        for (int r = 0; r < 21; ++r) s += red[(r * 2 + set) * 96 + c];
        ((float*)(wsp(a) + WS_MOD))[((size_t)l * 2 + set) * 12288 + col0 + c] = s + ain(a, I_BMOD)[(size_t)l * 12288 + col0 + c]; }
    __syncthreads();
}
DI void h2_rows(const Args& a, LAS float* ldsf) {
    const int lane = otid() & 63, wave = __builtin_amdgcn_readfirstlane(otid() >> 6), g_ = ogdim(), nw = g_ * 8, gw = wave * g_ + (int)obid();
    const int l = gw >= nw / 2 ? 1 : 0, w0 = gw - l * (nw / 2), wstep = nw / 2;
    LAS float* fe = ldsf + wave * 128; LAS float* h1 = fe + 64;
    float w1c[33], w2c[64];
    { const float* w1 = ain(a, I_HYW1) + (size_t)l * 33 * 64; const float* w2 = ain(a, I_HYW2) + (size_t)l * 64 * 64;
#pragma unroll
      for (int i = 0; i < 33; ++i) w1c[i] = w1[i * 64 + lane];
#pragma unroll
      for (int i = 0; i < 64; ++i) w2c[i] = w2[i * 64 + lane]; }
    const float b1 = ain(a, I_HYB1)[l * 64 + lane], b2 = ain(a, I_HYB2)[l * 64 + lane], fq_ = ain(a, I_HYFREQ)[l * 64 + lane];
    float* H2 = (float*)(wsp(a) + WS_H2) + (size_t)l * MT * 64; bf16* H2B = (bf16*)(wsp(a) + WS_H2B) + (size_t)l * SEQ * 256;
    for (int r = w0; r < MT; r += wstep) {
        const int Lq = r < SEQ ? SEQ : CTXL, t = r < SEQ ? r : r - SEQ;
        if (lane < 33) { float f;
            if (lane == 0) f = (float)t / (float)(Lq - 1);
            else { const int bi = (lane - 1) & 15; const float band = 1e-4f + (float)bi * ((15.0f - 1e-4f) / 15.0f); const float rev2 = 2.0f * band * (float)t / (float)Lq;
                f = (lane <= 16) ? cospif(rev2) : -sinpif(rev2); }
            fe[lane] = f; }
        asm volatile("s_waitcnt lgkmcnt(0)" ::: "memory");
        float s = b1;
#pragma unroll
        for (int i = 0; i < 33; ++i) s += fe[i] * w1c[i];
        h1[lane] = sinf(fq_ * s);
        asm volatile("s_waitcnt lgkmcnt(0)" ::: "memory");
        float s2 = b2;
#pragma unroll
        for (int i = 0; i < 64; ++i) s2 += h1[i] * w2c[i];
        const float hv = sinf(fq_ * s2);
        H2[(size_t)r * 64 + lane] = hv;
        if (r < SEQ) { bf16* hb = H2B + (size_t)r * 256; hb[lane] = f2bf(hv); hb[64 + lane] = 0; hb[128 + lane] = 0; hb[192 + lane] = 0; }
        asm volatile("s_waitcnt lgkmcnt(0)" ::: "memory");
    }
}
DI void prologue_small(const Args& a) {
    const size_t gt = (size_t)obid() * NTHR + otid(), gs = (size_t)ogdim() * NTHR;
    float* zb = (float*)(wsp(a) + WS_ZBIAS);
    for (size_t i = gt; i < (size_t)DEPTH * ZC; i += gs) { const int l = (int)(i / ZC), zc = (int)(i % ZC), sc = z_srccol(zc); zb[i] = sc >= 0 ? ain(a, I_BIN)[(size_t)l * NCOLS_IN + sc] : 0.f; }
    float* lb = (float*)(wsp(a) + WS_LB);
    for (size_t i = gt; i < (size_t)DEPTH * 2048; i += gs) { const int l = (int)(i / 2048), j = (int)(i % 2048);
        float v = 0.f; if (l == 1) { const float r0 = ain(a, I_HGLB)[j], r1 = ain(a, I_HGLB)[2048 + j]; v = 1.0f / (1.0f + expf(r0 - r1)); }
        lb[i] = v; }
    bf16* w3t = (bf16*)(wsp(a) + WS_W3T);
    for (size_t i = gt; i < (size_t)DEPTH * 2048 * 256; i += gs) { const int l = (int)(i >> 19), fc = (int)((i >> 8) & 2047), j = (int)(i & 255); w3t[i] = j < 64 ? f2bf(ain(a, I_HYW3)[((size_t)l * 64 + j) * 2048 + fc]) : (bf16)0; }
    bf16* wrt = (bf16*)(wsp(a) + WS_WRT);
    for (size_t i = gt; i < (size_t)DEPTH * 48 * 2048; i += gs) { const int l = (int)(i / (48 * 2048)), c = (int)((i / 2048) % 48), k = (int)(i & 2047);
        const float w = c < 4 ? ain(a, I_WRG)[((size_t)l * D + k) * 4 + c] : (c < 36 ? ain(a, I_WRE)[((size_t)l * D + k) * 32 + (c - 4)] : 0.f);
        const bf16 hi = f2bf(w); wrt[((size_t)l * 2 + 0) * 48 * 2048 + (size_t)c * 2048 + k] = hi; wrt[((size_t)l * 2 + 1) * 48 * 2048 + (size_t)c * 2048 + k] = f2bf(w - bf2f(hi)); }
    float* tw = (float*)(wsp(a) + WS_TW);
    for (size_t i = gt; i < 16384; i += gs) { float s, c; sincospif(-2.0f * (float)i / 16384.0f, &s, &c); tw[2 * i] = c; tw[2 * i + 1] = s; }
    float* tw2 = (float*)(wsp(a) + WS_TW2);
    for (size_t i = gt; i <= 8192; i += gs) { float s, c; sincospif(-(float)i / 16384.0f, &s, &c); tw2[2 * i] = c; tw2[2 * i + 1] = s; }
}
DI void hyc_filters(const Args& a, int l) {
    const int lane = otid() & 63, wave = otid() >> 6;
    const float* h2 = (const float*)(wsp(a) + WS_H2) + ((size_t)l * MT + SEQ) * 64;
    const float* w3 = ain(a, I_HYW3) + (size_t)l * 64 * 2048;
    float* hyc = (float*)(wsp(a) + WS_HYC);
    const float a0 = -4.605170186f / 1.5f, a1 = -4.605170186f / 0.3f;
    for (int fc = obid() * 8 + wave; fc < 2048; fc += ogdim() * 8) {
        const int c = fc & 1023; const float delta = fabsf(a0 + (float)c * ((a1 - a0) / 1023.0f)); const float b3 = ain(a, I_HYB3)[l * 2048 + fc];
        float hv[4], ssum = 0.f;
#pragma unroll
        for (int i = 0; i < 4; ++i) { const int t = lane + 64 * i; float s = b3;
            for (int j = 0; j < 64; ++j) s += h2[t * 64 + j] * w3[j * 2048 + fc];
            const float tl = (float)t / 255.0f; hv[i] = s * (expf(-tl * delta) + 0.05f); ssum += fabsf(hv[i]); }
        ssum = wave_sum(ssum); const float inv = 1.0f / ssum;
#pragma unroll
        for (int i = 0; i < 4; ++i) hyc[(size_t)fc * 256 + lane + 64 * i] = hv[i] * inv;
    }
}
template <int MODE, bool DRY = false> DI void norm_phase(const Args& a, int l, int nrows, LAS float* ldsf) {
    const int lane = otid() & 63, wave = otid() >> 6;
    float* H = (float*)(wsp(a) + WS_H); bf16* U = (bf16*)(wsp(a) + WS_U);
    const float* modall = (const float*)(wsp(a) + WS_MOD);
    int* route = (int*)(wsp(a) + WS_ROUTE);
    const bf16* YP = (const bf16*)(wsp(a) + WS_YP);
    const bool combine = (MODE == 0 && l > 0) || MODE == 2;
    for (int r = obid() * 8 + wave; r < nrows; r += ogdim() * 8) {
        const int set = r >= SEQ ? 1 : 0;
        const float* src = (MODE == 0 && l == 0) ? (set ? ain(a, I_CTX) + (size_t)(r - SEQ) * D : ain(a, I_X) + (size_t)r * D) : H + (size_t)r * D;
        f32x4 v[8];
#pragma unroll
        for (int j = 0; j < 8; ++j) v[j] = *(const f32x4*)(src + j * 256 + lane * 4);
        if (combine) {
            const float* gt2 = modall + ((size_t)(l - 1) * 2 + set) * 12288 + 10240;
            const int p0 = route[r * 8 + 6], p1 = route[r * 8 + 7];
#pragma unroll
            for (int j = 0; j < 8; ++j) { const int col = j * 256 + lane * 4;
                const u32x2 y0 = *(const u32x2*)(YP + (size_t)p0 * D + col), y1 = *(const u32x2*)(YP + (size_t)p1 * D + col); const f32x4 g = *(const f32x4*)(gt2 + col);
                v[j][0] += g[0] * (bflo(y0.x) + bflo(y1.x)); v[j][1] += g[1] * (bfhi(y0.x) + bfhi(y1.x)); v[j][2] += g[2] * (bflo(y0.y) + bflo(y1.y)); v[j][3] += g[3] * (bfhi(y0.y) + bfhi(y1.y)); }
            if (MODE == 0) {
#pragma unroll
                for (int j = 0; j < 8; ++j) *(f32x4*)(H + (size_t)r * D + j * 256 + lane * 4) = v[j];
            }
        }
        float ss = 0.f;
#pragma unroll
        for (int j = 0; j < 8; ++j) ss += (v[j][0] * v[j][0] + v[j][1] * v[j][1]) + (v[j][2] * v[j][2] + v[j][3] * v[j][3]);
        ss = wave_sum(ss);
        const float rstd = rsqrtf(ss * (1.0f / D) + NORM_EPS);
        if (MODE == 2) {
            const float* fw = ain(a, I_FNW);
#ifdef PROBE_SEL
            const float pscale = 1.0f + 0.5f * (float)((LAS unsigned long long*)(ldsbase() + LDS_TIM))[PROBE_SEL] / (float)((LAS unsigned long long*)(ldsbase() + LDS_TIM))[0];
#else
            const float pscale = 1.0f;
#endif
#pragma unroll
            for (int j = 0; j < 8; ++j) { const int col = j * 256 + lane * 4; const f32x4 w = *(const f32x4*)(fw + col); *(f32x4*)(a.out + (size_t)r * D + col) = v[j] * rstd * w * pscale; }
        } else {
            const float* nw = (MODE == 0 ? ain(a, I_NMIXW) : ain(a, I_NFFNW)) + (size_t)l * D;
            const float* md = modall + ((size_t)l * 2 + set) * 12288 + (MODE == 0 ? 0 : 6144);
#pragma unroll
            for (int j = 0; j < 8; ++j) { const int col = j * 256 + lane * 4; const f32x4 w = *(const f32x4*)(nw + col), sh = *(const f32x4*)(md + col), sc = *(const f32x4*)(md + 2048 + col);
                v[j] = (v[j] * rstd * w) * (sc + 1.0f) + sh;
                u32x2 o; o.x = pk_bf16(v[j][0], v[j][1]); o.y = pk_bf16(v[j][2], v[j][3]); *(u32x2*)(U + (size_t)r * D + col) = o; }
            if (MODE == 1) {
                const float* wrg = ain(a, I_WRG) + (size_t)l * D * 4; const float* wre = ain(a, I_WRE) + (size_t)l * D * 32;
                float lg[36];
#pragma unroll
                for (int i = 0; i < 36; ++i) lg[i] = 0.f;
                LAS float* wu = ldsf + wave * 2048;
#pragma unroll
                for (int j = 0; j < 8; ++j) *(LAS f32x4*)(wu + j * 256 + lane * 4) = v[j];
                asm volatile("s_waitcnt lgkmcnt(0)" ::: "memory");
#pragma unroll 2
                for (int cc = 0; cc < 32; ++cc) { const int col = cc * 64 + lane; const float uv = wu[col];
                    const f32x4 g = *(const f32x4*)(wrg + (size_t)col * 4);
                    lg[0] += uv * g[0]; lg[1] += uv * g[1]; lg[2] += uv * g[2]; lg[3] += uv * g[3];
#pragma unroll
                    for (int e4 = 0; e4 < 8; ++e4) { const f32x4 w = *(const f32x4*)(wre + (size_t)col * 32 + e4 * 4);
                        lg[4 + e4 * 4 + 0] += uv * w[0]; lg[4 + e4 * 4 + 1] += uv * w[1]; lg[4 + e4 * 4 + 2] += uv * w[2]; lg[4 + e4 * 4 + 3] += uv * w[3]; } }
                asm volatile("s_waitcnt lgkmcnt(0)" ::: "memory");
#pragma unroll
                for (int i = 0; i < 36; ++i) lg[i] = wave_sum(lg[i]);
                float gl[4]; int grp = 0; float gmax;
#pragma unroll
                for (int g = 0; g < 4; ++g) gl[g] = lg[g] + ain(a, I_BRG)[l * 4 + g];
                gmax = gl[0];
#pragma unroll
                for (int g = 1; g < 4; ++g) if (gl[g] > gmax) { gmax = gl[g]; grp = g; }
                float gden = 0.f;
#pragma unroll
                for (int g = 0; g < 4; ++g) gden += expf(gl[g] - gmax);
                const float ptop = 1.0f / gden;
                float le[8];
#pragma unroll
                for (int i = 0; i < 8; ++i) { float x = lg[4 + i];
#pragma unroll
                    for (int g = 1; g < 4; ++g) x = (grp == g) ? lg[4 + g * 8 + i] : x;
                    le[i] = x + ain(a, I_BRE)[l * 32 + grp * 8 + i]; }
                int i0 = 0; float m0 = le[0];
#pragma unroll
                for (int i = 1; i < 8; ++i) if (le[i] > m0) { m0 = le[i]; i0 = i; }
                int i1 = -1; float m1 = -3.0e38f;
#pragma unroll
                for (int i = 0; i < 8; ++i) if (i != i0 && le[i] > m1) { m1 = le[i]; i1 = i; }
                const float e1v = expf(m1 - m0);
                const float w0 = ptop / (1.0f + e1v), w1 = ptop * e1v / (1.0f + e1v);
                if (DRY) { asm volatile("" :: "v"(w0), "v"(w1), "v"(i0), "v"(i1), "v"(grp)); }
                else if (lane == 0) {
                    unsigned* cnt = (unsigned*)(wsp(a) + WS_CTL) + CW_CNT + l * 2048;
                    const int ex0 = grp * 8 + i0, ex1 = grp * 8 + i1;
                    const unsigned s0 = atomicAdd(cnt + ex0 * 64, 1u), s1 = atomicAdd(cnt + ex1 * 64, 1u);
                    route[r * 8 + 0] = ex0; route[r * 8 + 1] = ex1; route[r * 8 + 2] = (int)s0; route[r * 8 + 3] = (int)s1;
                    route[r * 8 + 4] = __float_as_int(w0); route[r * 8 + 5] = __float_as_int(w1);
                }
            }
        }
    }
}
typedef short bf16x8r_t __attribute__((ext_vector_type(8)));
template <bool DRY> DI void route_phase(const Args& a, int l, int nrows, LAS float* ldsf, int pv = 0) {
    const int lane = otid() & 63, wave = __builtin_amdgcn_readfirstlane(otid() >> 6), fr = lane & 15, fq = lane >> 4, slot = wave & 3, half = wave >> 2;
    const float* H = (const float*)(wsp(a) + WS_H); bf16* U = (bf16*)(wsp(a) + WS_U); int* route = (int*)(wsp(a) + WS_ROUTE);
    const float* nw = ain(a, I_NFFNW) + (size_t)l * D;
    const bf16* Wh = (const bf16*)(wsp(a) + WS_WRT) + (size_t)l * 2 * 48 * 2048; const bf16* Wl = Wh + 48 * 2048;
    LAS float* lt = ldsf + 128 + (slot * 2 + half) * 768;
    const int G = ogdim(), bidv = obid(), ntile4 = nrows / 64;
    for (int it4 = bidv; it4 < ntile4; it4 += G) {
#pragma unroll 2
        for (int rr = 0; rr < ((pv & 2) ? 0 : 8); ++rr) { const int r = it4 * 64 + wave * 8 + rr, set = r >= SEQ ? 1 : 0;
            const float* md = (const float*)(wsp(a) + WS_MOD) + ((size_t)l * 2 + set) * 12288 + 6144;
            f32x4 v[8];
#pragma unroll
            for (int j = 0; j < 8; ++j) v[j] = *(const f32x4*)(H + (size_t)r * D + j * 256 + lane * 4);
            float ss = 0.f;
#pragma unroll
            for (int j = 0; j < 8; ++j) ss += (v[j][0] * v[j][0] + v[j][1] * v[j][1]) + (v[j][2] * v[j][2] + v[j][3] * v[j][3]);
            ss = wave_sum(ss);
            const float rstd = rsqrtf(ss * (1.0f / D) + NORM_EPS);
#pragma unroll
            for (int j = 0; j < 8; ++j) { const int col = j * 256 + lane * 4; const f32x4 w = *(const f32x4*)(nw + col), sh = *(const f32x4*)(md + col), sc = *(const f32x4*)(md + 2048 + col);
                const f32x4 u = (v[j] * rstd * w) * (sc + 1.0f) + sh; u32x2 o; o.x = pk_bf16(u[0], u[1]); o.y = pk_bf16(u[2], u[3]); *(u32x2*)(U + (size_t)r * D + col) = o; } }
        __syncthreads();
        const int tile = it4 * 4 + slot, row = tile * 16 + fr, ks0 = half * 32;
        const bf16* ur = U + (size_t)row * D + fq * 8;
        f32x4 acc[3];
#pragma unroll
        for (int cb = 0; cb < 3; ++cb) acc[cb] = (f32x4){0.f, 0.f, 0.f, 0.f};
#pragma unroll 8
        for (int ks = ks0; ks < ((pv & 4) ? ks0 : ks0 + 32); ++ks) { const int c0 = ks * 32;
            const bf16x8r_t ah = *(const bf16x8r_t*)(ur + c0);
#pragma unroll
            for (int cb = 0; cb < 3; ++cb) { const bf16x8r_t bh = *(const bf16x8r_t*)(Wh + (size_t)(cb * 16 + fr) * 2048 + c0 + fq * 8), bl = *(const bf16x8r_t*)(Wl + (size_t)(cb * 16 + fr) * 2048 + c0 + fq * 8);
                acc[cb] = __builtin_amdgcn_mfma_f32_16x16x32_bf16(ah, bh, acc[cb], 0, 0, 0); acc[cb] = __builtin_amdgcn_mfma_f32_16x16x32_bf16(ah, bl, acc[cb], 0, 0, 0); } }
#pragma unroll
        for (int cb = 0; cb < 3; ++cb)
#pragma unroll
            for (int j = 0; j < 4; ++j) lt[(fq * 4 + j) * 48 + cb * 16 + fr] = acc[cb][j];
        __syncthreads();
        if (half == 0 && lane < 16) {
            const int r = tile * 16 + lane; float lg[36]; LAS float* l0 = ldsf + 128 + (slot * 2) * 768 + lane * 48; LAS float* l1 = l0 + 768;
#pragma unroll
            for (int i = 0; i < 36; ++i) lg[i] = l0[i] + l1[i];
            float gl[4]; int grp = 0; float gmax;
#pragma unroll
            for (int g = 0; g < 4; ++g) gl[g] = lg[g] + ain(a, I_BRG)[l * 4 + g];
            gmax = gl[0];
#pragma unroll
            for (int g = 1; g < 4; ++g) if (gl[g] > gmax) { gmax = gl[g]; grp = g; }
            float gden = 0.f;
#pragma unroll
            for (int g = 0; g < 4; ++g) gden += expf(gl[g] - gmax);
            const float ptop = 1.0f / gden;
            float le[8];
#pragma unroll
            for (int i = 0; i < 8; ++i) { float x = lg[4 + i];
#pragma unroll
                for (int g = 1; g < 4; ++g) x = (grp == g) ? lg[4 + g * 8 + i] : x;
                le[i] = x + ain(a, I_BRE)[l * 32 + grp * 8 + i]; }
            int i0 = 0; float m0 = le[0];
#pragma unroll
            for (int i = 1; i < 8; ++i) if (le[i] > m0) { m0 = le[i]; i0 = i; }
            int i1 = -1; float m1 = -3.0e38f;
#pragma unroll
            for (int i = 0; i < 8; ++i) if (i != i0 && le[i] > m1) { m1 = le[i]; i1 = i; }
            const float e1v = expf(m1 - m0);
            const float w0 = ptop / (1.0f + e1v), w1 = ptop * e1v / (1.0f + e1v);
            if (DRY || (pv & 1)) { asm volatile("" :: "v"(w0), "v"(w1), "v"(i0), "v"(i1), "v"(grp)); }
            else { unsigned* cnt = (unsigned*)(wsp(a) + WS_CTL) + CW_CNT + l * 2048; const int ex0 = grp * 8 + i0, ex1 = grp * 8 + i1;
                const unsigned s0 = atomicAdd(cnt + ex0 * 64, 1u), s1 = atomicAdd(cnt + ex1 * 64, 1u);
                route[r * 8 + 0] = ex0; route[r * 8 + 1] = ex1; route[r * 8 + 2] = (int)s0; route[r * 8 + 3] = (int)s1; route[r * 8 + 4] = __float_as_int(w0); route[r * 8 + 5] = __float_as_int(w1); }
        }
        __syncthreads();
    }
}
DI void permute_phase(const Args& a, int l, int nrows, LAS unsigned char* ldsb) {
    LAS int* poff = (LAS int*)ldsb;
    const int tid = otid(), lane = tid & 63, wave = tid >> 6;
    const unsigned* cnt = (const unsigned*)(wsp(a) + WS_CTL) + CW_CNT + l * 2048;
    if (tid == 0) { int off = 0; for (int e = 0; e < NEXP; ++e) { poff[e] = off; off += (int)((cnt[e * 64] + 255u) / 256u) * 256; } poff[32] = off; }
    __syncthreads();
    if (obid() == 0) { int* tile_e = (int*)(wsp(a) + WS_TILEE); const int nt = poff[32] >> 8;
        if (tid < 200) { int e = -1; if (tid < nt) { for (int q = 0; q < NEXP; ++q) if (poff[q] <= tid * 256) e = q; } tile_e[tid] = e < 0 ? 0 : e; }
        if (tid == 0) tile_e[200] = nt; }
    int* route = (int*)(wsp(a) + WS_ROUTE); float* roww = (float*)(wsp(a) + WS_ROWW);
    const bf16* U = (const bf16*)(wsp(a) + WS_U); bf16* XP = (bf16*)(wsp(a) + WS_XP);
    for (int r = obid() * 8 + wave; r < nrows; r += ogdim() * 8) {
        const int e0 = route[r * 8 + 0], e1 = route[r * 8 + 1], s0 = route[r * 8 + 2], s1 = route[r * 8 + 3];
        const int p0 = poff[e0] + s0, p1 = poff[e1] + s1;
        u32x4 x[4];
#pragma unroll
        for (int i = 0; i < 4; ++i) x[i] = *(const u32x4*)(U + (size_t)r * D + (i * 64 + lane) * 8);
#pragma unroll
        for (int i = 0; i < 4; ++i) { *(u32x4*)(XP + (size_t)p0 * D + (i * 64 + lane) * 8) = x[i]; *(u32x4*)(XP + (size_t)p1 * D + (i * 64 + lane) * 8) = x[i]; }
        if (lane == 0) { route[r * 8 + 6] = p0; route[r * 8 + 7] = p1; roww[p0] = __int_as_float(route[r * 8 + 4]); roww[p1] = __int_as_float(route[r * 8 + 5]); }
    }
}
DI int stream_row(int p, int dir) { return dir == 0 ? (p < CTXL ? SEQ + p : p - CTXL) : (p < CTXL ? SEQ + (CTXL - 1 - p) : (SEQ - 1) - (p - CTXL)); }

DI void unpack8(const u32x4& p, float (&v)[8]) { v[0] = bflo(p.x); v[1] = bfhi(p.x); v[2] = bflo(p.y); v[3] = bfhi(p.y); v[4] = bflo(p.z); v[5] = bfhi(p.z); v[6] = bflo(p.w); v[7] = bfhi(p.w); }
DI void shortconv_w8(const bf16* Z, const float* cw, const float* cb, int l, int seg, int c0, int r0, int lo, int hi, int lane, float (&out)[8]) {
    const int col = Z_HY + seg * 1024 + c0; float zc[8], zp[8], zn[8];
    unpack8(*(const u32x4*)(Z + (size_t)(r0 + lane) * ZC + col), zc);
    float ep[8], en[8];
    if (r0 - 1 >= lo) unpack8(*(const u32x4*)(Z + (size_t)(r0 - 1) * ZC + col), ep); else {
#pragma unroll
        for (int q = 0; q < 8; ++q) ep[q] = 0.f; }
    if (r0 + 64 < hi) unpack8(*(const u32x4*)(Z + (size_t)(r0 + 64) * ZC + col), en); else {
#pragma unroll
        for (int q = 0; q < 8; ++q) en[q] = 0.f; }
#pragma unroll
    for (int q = 0; q < 8; ++q) { const float up = __shfl_up(zc[q], 1), dn = __shfl_down(zc[q], 1); zp[q] = lane == 0 ? ep[q] : up; zn[q] = lane == 63 ? en[q] : dn; }
    const float* w = cw + (size_t)l * 3 * 3072 + seg * 1024 + c0; const float* bb = cb + (size_t)l * 3072 + seg * 1024 + c0;
    const f32x4 w0a = *(const f32x4*)w, w0b = *(const f32x4*)(w + 4), w1a = *(const f32x4*)(w + 3072), w1b = *(const f32x4*)(w + 3072 + 4), w2a = *(const f32x4*)(w + 6144), w2b = *(const f32x4*)(w + 6144 + 4), ba = *(const f32x4*)bb, b4 = *(const f32x4*)(bb + 4);
#pragma unroll
    for (int q = 0; q < 4; ++q) { out[q] = w0a[q] * zp[q] + w1a[q] * zc[q] + w2a[q] * zn[q] + ba[q]; out[4 + q] = w0b[q] * zp[4 + q] + w1b[q] * zc[4 + q] + w2b[q] * zn[4 + q] + b4[q]; }
}
DI void hyprep_witem(const Args& a, int l, int it) {
    const int lane = otid() & 63, tb = it >> 7, c0 = (it & 127) * 8, r0 = tb * 64, lo = r0 < SEQ ? 0 : SEQ, hi = r0 < SEQ ? SEQ : MT;
    const bf16* Z = (const bf16*)(wsp(a) + WS_Z); bf16* VXT = (bf16*)(wsp(a) + WS_U);
    float x1[8], vv[8];
    shortconv_w8(Z, ain(a, I_HYCW), ain(a, I_HYCB), l, 1, c0, r0, lo, hi, lane, x1); shortconv_w8(Z, ain(a, I_HYCW), ain(a, I_HYCB), l, 2, c0, r0, lo, hi, lane, vv);
#pragma unroll
    for (int q = 0; q < 8; ++q) VXT[(size_t)(c0 + q) * MT + r0 + lane] = f2bf(vv[q] * x1[q]);
}
DI void hycomb_witem(const Args& a, int l, int it) {
    const int lane = otid() & 63, tb = it >> 7, c0 = (it & 127) * 8, r0 = tb * 64, lo = r0 < SEQ ? 0 : SEQ, hi = r0 < SEQ ? SEQ : MT;
    const bf16* Z = (const bf16*)(wsp(a) + WS_Z); const bf16* CV = (const bf16*)(wsp(a) + WS_CVO); bf16* Y0 = (bf16*)(wsp(a) + WS_YMIX);
    float x0[8], y[8];
#pragma unroll
    for (int q = 0; q < 8; ++q) y[q] = bf2f(CV[(size_t)(c0 + q) * MT + r0 + lane]);
    shortconv_w8(Z, ain(a, I_HYCW), ain(a, I_HYCB), l, 0, c0, r0, lo, hi, lane, x0);
    u32x4 w; w.x = pk_bf16(y[0] * x0[0], y[1] * x0[1]); w.y = pk_bf16(y[2] * x0[2], y[3] * x0[3]); w.z = pk_bf16(y[4] * x0[4], y[5] * x0[5]); w.w = pk_bf16(y[6] * x0[6], y[7] * x0[7]);
    *(u32x4*)(Y0 + (size_t)(r0 + lane) * 1024 + c0) = w;
}
DI void scancomb_rows(const Args& a, int l, int nrows) {
    const int lane = otid() & 63, wave = otid() >> 6;
    const bf16* Z = (const bf16*)(wsp(a) + WS_Z); const bf16* O = (const bf16*)(wsp(a) + WS_OSC);
    bf16* Y1 = (bf16*)(wsp(a) + WS_YMIX) + (size_t)MT * 1024; bf16* Y2 = Y1 + (size_t)MT * 1024;
    const float* hnw = ain(a, I_HGNW) + (size_t)l * 128; const float* gnw = ain(a, I_GLNW) + (size_t)l * 256;
    for (int r = obid() * 8 + wave; r < nrows; r += ogdim() * 8) {
#pragma unroll
        for (int i = 0; i < 2; ++i) { const int col = i * 512 + lane * 8;
            { float of[8], ob[8], g[8], o[8]; unpack8(*(const u32x4*)(O + (size_t)r * 1024 + col), of); unpack8(*(const u32x4*)(O + ((size_t)MT + r) * 1024 + col), ob); unpack8(*(const u32x4*)(Z + (size_t)r * ZC + Z_HG + 4096 + col), g);
              float ss = 0.f;
#pragma unroll
              for (int q = 0; q < 8; ++q) { o[q] = of[q] + ob[q]; ss += o[q] * o[q]; }
              ss += __shfl_xor(ss, 8); ss += __shfl_xor(ss, 4); ss += __shfl_xor(ss, 2); ss += __shfl_xor(ss, 1);
              const float rstd = rsqrtf(ss * (1.0f / 128.0f) + NORM_EPS);
              const f32x4 n0 = *(const f32x4*)(hnw + (col & 127)), n1 = *(const f32x4*)(hnw + (col & 127) + 4);
              u32x4 w; w.x = pk_bf16(o[0] * rstd * n0[0] * sigmoidf_(g[0]), o[1] * rstd * n0[1] * sigmoidf_(g[1])); w.y = pk_bf16(o[2] * rstd * n0[2] * sigmoidf_(g[2]), o[3] * rstd * n0[3] * sigmoidf_(g[3]));
              w.z = pk_bf16(o[4] * rstd * n1[0] * sigmoidf_(g[4]), o[5] * rstd * n1[1] * sigmoidf_(g[5])); w.w = pk_bf16(o[6] * rstd * n1[2] * sigmoidf_(g[6]), o[7] * rstd * n1[3] * sigmoidf_(g[7]));
              *(u32x4*)(Y1 + (size_t)r * 1024 + col) = w; }
            { float of[8], ob[8], g[8], o[8]; unpack8(*(const u32x4*)(O + ((size_t)2 * MT + r) * 1024 + col), of); unpack8(*(const u32x4*)(O + ((size_t)3 * MT + r) * 1024 + col), ob); unpack8(*(const u32x4*)(Z + (size_t)r * ZC + Z_GL + 2048 + col), g);
              float ss = 0.f;
#pragma unroll
              for (int q = 0; q < 8; ++q) { o[q] = of[q] + ob[q]; ss += o[q] * o[q]; }
              ss += __shfl_xor(ss, 16); ss += __shfl_xor(ss, 8); ss += __shfl_xor(ss, 4); ss += __shfl_xor(ss, 2); ss += __shfl_xor(ss, 1);
              const float rstd = rsqrtf(ss * (1.0f / 256.0f) + NORM_EPS);
              const f32x4 n0 = *(const f32x4*)(gnw + (col & 255)), n1 = *(const f32x4*)(gnw + (col & 255) + 4);
              u32x4 w; w.x = pk_bf16(o[0] * rstd * n0[0] * siluf_(g[0]), o[1] * rstd * n0[1] * siluf_(g[1])); w.y = pk_bf16(o[2] * rstd * n0[2] * siluf_(g[2]), o[3] * rstd * n0[3] * siluf_(g[3]));
              w.z = pk_bf16(o[4] * rstd * n1[0] * siluf_(g[4]), o[5] * rstd * n1[1] * siluf_(g[5])); w.w = pk_bf16(o[6] * rstd * n1[2] * siluf_(g[6]), o[7] * rstd * n1[3] * siluf_(g[7]));
              *(u32x4*)(Y2 + (size_t)r * 1024 + col) = w; }
        }
    }
}
typedef short bf16x8_t __attribute__((ext_vector_type(8)));
constexpr int SC_N = 65;
constexpr size_t KVS_GL_OFF = (size_t)16 * SC_N * 16384;
constexpr size_t WS_KVS = WS_WGU;
constexpr size_t WS_KD  = WS_WGU + 130 * MiB;
constexpr int SL_QM = 0, SL_KM = 17408, SL_Q0 = 34816, SL_KE = 52224, SL_VT = 70656, SL_PP = 107520, SL_TOT = 116736, SL_DD = 118784, SL_AFB = 119296, SL_EB = 121344, SL_BUF2 = SL_VT + 18432;
static_assert(SL_EB + 512 <= 131072 && WS_KD + (size_t)24 * SC_N * 128 * 4 <= WS_H, "scan maps");
DI bf16x8_t lds_frag16(LAS unsigned char* p) { return *(LAS bf16x8_t*)p; }
DI bf16x8_t pack_bf16x8(const f32x4& lo, const f32x4& hi) { u32x4 w; w.x = pk_bf16(lo[0], lo[1]); w.y = pk_bf16(lo[2], lo[3]); w.z = pk_bf16(hi[0], hi[1]); w.w = pk_bf16(hi[2], hi[3]); return __builtin_bit_cast(bf16x8_t, w); }

template <bool GLA, bool OUT> DI void scan_walk(const Args& a, int l, int head, int dir, int sc, int dvh, LAS unsigned char* lds, int pv = 0) {
    constexpr int NB = 1, DV = GLA ? 256 : 128;
    const int tid = otid(), lane = tid & 63, wave = tid >> 6, fr = lane & 15, fq = lane >> 4, nbase = dvh * 8 + wave;
    const bf16* Z = (const bf16*)(wsp(a) + WS_Z);
    const int stream = GLA ? 16 + head * 2 + dir : head * 2 + dir;
    float* kvs = (float*)(wsp(a) + WS_KVS) + (GLA ? KVS_GL_OFF + ((size_t)(stream - 16) * SC_N + sc) * 32768 : ((size_t)stream * SC_N + sc) * 16384);
    float* kd = (float*)(wsp(a) + WS_KD) + ((size_t)stream * SC_N + sc) * 128;
    LAS bf16* QM = (LAS bf16*)(lds + SL_QM); LAS bf16* KM = (LAS bf16*)(lds + SL_KM); LAS float* EB = (LAS float*)(lds + SL_EB); LAS bf16* XG = (LAS bf16*)(lds + SL_Q0);
    LAS bf16* KE = (LAS bf16*)(lds + SL_KE); LAS bf16* VT = (LAS bf16*)(lds + SL_VT); LAS bf16* PP = (LAS bf16*)(lds + SL_PP);
    LAS float* TOT = (LAS float*)(lds + SL_TOT); LAS float* DD = (LAS float*)(lds + SL_DD); LAS bf16* AFB = (LAS bf16*)(lds + SL_AFB);
    const int k = wave * 16 + fr, seg = fq;
    float lbv = 0.f, bag = 0.f; bf16x8_t Bg = {0, 0, 0, 0, 0, 0, 0, 0};
    if (!GLA) lbv = ((const float*)(wsp(a) + WS_LB))[((size_t)l * 2 + dir) * 1024 + head * 128 + k];
    else {
        bag = ain(a, I_GLBA)[((size_t)l * 2 + dir) * 512 + head * 128 + wave * 16 + fr];
        if (fq < 2) { const float* wp = ain(a, I_GLWA2) + (((size_t)l * 2 + dir) * 16 + fq * 8) * 512 + head * 128 + wave * 16 + fr; float w8[8];
#pragma unroll
            for (int j = 0; j < 8; ++j) w8[j] = wp[(size_t)j * 512];
            u32x4 pw; pw.x = pk_bf16(w8[0], w8[1]); pw.y = pk_bf16(w8[2], w8[3]); pw.z = pk_bf16(w8[4], w8[5]); pw.w = pk_bf16(w8[6], w8[7]); Bg = __builtin_bit_cast(bf16x8_t, pw); } }
    f32x4 S[NB][8];
#pragma unroll
    for (int nb = 0; nb < NB; ++nb)
#pragma unroll
        for (int mb = 0; mb < 8; ++mb) { if (OUT) S[nb][mb] = *(const f32x4*)(kvs + ((size_t)((nbase + nb) * 8 + mb) * 64 + lane) * 4); else S[nb][mb] = (f32x4){0.f, 0.f, 0.f, 0.f}; }
    float dlog = 0.f;
    const int which = (GLA ? 2 : 0) + dir;
    bf16* Odir = (bf16*)(wsp(a) + WS_OSC) + (size_t)which * MT * 1024;
    const int srow = tid >> 3, spc = (tid & 7) * 16;
    const int vcol = (GLA ? Z_GL + 1024 + head * 256 + dvh * 128 : Z_HG + 3072 + head * 128) + wave * 16;
    const int fcol = (GLA ? Z_GL + 512 + head * 128 : Z_HG + 1024 * (1 + dir) + head * 128) + spc, qcol = (GLA ? Z_GL + head * 128 : Z_HG + head * 128) + spc;
    u32x4 pv0, pv1, pf0, pf1, pq0 = {0u, 0u, 0u, 0u}, pq1 = {0u, 0u, 0u, 0u}, pa = {0u, 0u, 0u, 0u};
#define SCAN_ISSUE(cidx) do { const int r0n_ = dir ? stream_row((cidx) * 64 + 63, 1) : stream_row((cidx) * 64, 0); \
        const bf16* vr_ = Z + (size_t)(r0n_ + lane) * ZC + vcol; pv0 = *(const u32x4*)vr_; pv1 = *(const u32x4*)(vr_ + 8); \
        const bf16* zr_ = Z + (size_t)(r0n_ + srow) * ZC; pf0 = *(const u32x4*)(zr_ + fcol); pf1 = *(const u32x4*)(zr_ + fcol + 8); \
        if (OUT) { pq0 = *(const u32x4*)(zr_ + qcol); pq1 = *(const u32x4*)(zr_ + qcol + 8); } \
        if (GLA && tid < 128) pa = *(const u32x4*)(Z + (size_t)(r0n_ + (tid >> 1)) * ZC + Z_LR + dir * 16 + (tid & 1) * 8); } while (0)
    SCAN_ISSUE(sc * 4);
    for (int cc = 0; cc < 4; ++cc) {
        const int qmoff = (OUT && (cc & 1)) ? SL_BUF2 : SL_QM, vtoff = (!OUT && (cc & 1)) ? SL_BUF2 : SL_VT;
        LAS bf16* QMc = (LAS bf16*)(lds + qmoff); LAS bf16* VTc = (LAS bf16*)(lds + vtoff);
        const int c = sc * 4 + cc; const int r0 = dir ? stream_row(c * 64 + 63, 1) : stream_row(c * 64, 0);
        {
#pragma unroll
          for (int q8 = 0; q8 < 2; ++q8) { const u32x4 v = q8 ? pv1 : pv0; const int d0 = wave * 16 + q8 * 8;
              VTc[(d0 + 0) * 72 + lane] = (bf16)(v.x & 0xffff); VTc[(d0 + 1) * 72 + lane] = (bf16)(v.x >> 16); VTc[(d0 + 2) * 72 + lane] = (bf16)(v.y & 0xffff); VTc[(d0 + 3) * 72 + lane] = (bf16)(v.y >> 16);
              VTc[(d0 + 4) * 72 + lane] = (bf16)(v.z & 0xffff); VTc[(d0 + 5) * 72 + lane] = (bf16)(v.z >> 16); VTc[(d0 + 6) * 72 + lane] = (bf16)(v.w & 0xffff); VTc[(d0 + 7) * 72 + lane] = (bf16)(v.w >> 16); }
          *(LAS u32x4*)(KM + srow * 136 + spc) = pf0; *(LAS u32x4*)(KM + srow * 136 + spc + 8) = pf1;
          if (OUT) { *(LAS u32x4*)(QMc + srow * 136 + spc) = pq0; *(LAS u32x4*)(QMc + srow * 136 + spc + 8) = pq1; }
          if (GLA && tid < 128) *(LAS u32x4*)(AFB + (tid >> 1) * 16 + (tid & 1) * 8) = pa;
          if (cc < 3) SCAN_ISSUE(c + 1); }
        LDS_BAR();
        if (GLA) {
#pragma unroll
            for (int tb = 0; tb < 4; ++tb) { bf16x8_t Ag = {0, 0, 0, 0, 0, 0, 0, 0}; if (fq < 2) Ag = lds_frag16(lds + SL_AFB + ((tb * 16 + fr) * 16 + fq * 8) * 2);
                f32x4 xg = {bag, bag, bag, bag}; xg = __builtin_amdgcn_mfma_f32_16x16x32_bf16(Ag, Bg, xg, 0, 0, 0);
#pragma unroll
                for (int j = 0; j < 4; ++j) XG[(tb * 16 + fq * 4 + j) * 136 + wave * 16 + fr] = f2bf(xg[j]); }
            asm volatile("s_waitcnt lgkmcnt(0)" ::: "memory");
        }
        const int tstart = dir ? 63 - seg * 16 : seg * 16, tstep = dir ? -1 : 1;
        float cs[16], kkv[GLA ? 1 : 16]; float run = 0.f;
#ifdef REPMASK
        _Pragma("unroll 1") for (int rp1 = 0; rp1 < (((REPMASK) >> 24) & 1 ? 3 : 1); ++rp1) { run = 0.f;
#else
        {
#endif
#pragma unroll
        for (int i = 0; i < 16; ++i) { const int t = tstart + i * tstep; float la;
            if (!GLA) { const float zf = bf2f(KM[t * 136 + k]); const float sg = sigmoidf_(zf); la = __logf(lbv + (1.0f - lbv) * sg); kkv[i] = (1.0f - lbv) * (1.0f - sg); }
            else { const float x = bf2f(XG[t * 136 + k]); la = (fminf(x, 0.f) - __logf(1.0f + __expf(-fabsf(x)))) * 0.0625f; }
            run += la; cs[i] = run; }
        }
        { const float t0 = __shfl(run, fr), t1 = __shfl(run, 16 + fr), t2 = __shfl(run, 32 + fr), t3 = __shfl(run, 48 + fr);
          const float off = seg == 0 ? 0.f : (seg == 1 ? t0 : (seg == 2 ? t0 + t1 : t0 + t1 + t2)), blast = (t0 + t1) + (t2 + t3), bref = t0 + t1;
          float ke[16]; const float ebl = __expf(blast - bref);
#pragma unroll
          for (int i = 0; i < 16; ++i) { const int t = tstart + i * tstep; const float b = off + cs[i];
              float kk; if (GLA) kk = bf2f(KM[t * 136 + k]); else kk = kkv[i];
              const float e1 = __expf(fminf(fmaxf(b - bref, -80.0f), 80.0f)), r1 = __builtin_amdgcn_rcpf(e1), kr = kk * r1;
              if (OUT) { const float qr = bf2f(QMc[t * 136 + k]); const float qv = GLA ? qr * 0.08838834764831845f : siluf_(qr);
                  QMc[t * 136 + k] = f2bf(qv * e1); KM[t * 136 + k] = f2bf(kr); }
              ke[i] = kr * ebl; }
          if (OUT && seg == 0) EB[k] = __expf(bref);
          const int tb0 = dir ? 48 - seg * 16 : seg * 16; u32x4 w0, w1;
          if (dir) { w0.x = pk_bf16(ke[15], ke[14]); w0.y = pk_bf16(ke[13], ke[12]); w0.z = pk_bf16(ke[11], ke[10]); w0.w = pk_bf16(ke[9], ke[8]); w1.x = pk_bf16(ke[7], ke[6]); w1.y = pk_bf16(ke[5], ke[4]); w1.z = pk_bf16(ke[3], ke[2]); w1.w = pk_bf16(ke[1], ke[0]); }
          else     { w0.x = pk_bf16(ke[0], ke[1]); w0.y = pk_bf16(ke[2], ke[3]); w0.z = pk_bf16(ke[4], ke[5]); w0.w = pk_bf16(ke[6], ke[7]); w1.x = pk_bf16(ke[8], ke[9]); w1.y = pk_bf16(ke[10], ke[11]); w1.z = pk_bf16(ke[12], ke[13]); w1.w = pk_bf16(ke[14], ke[15]); }
          *(LAS u32x4*)(KE + k * 72 + tb0) = w0; *(LAS u32x4*)(KE + k * 72 + tb0 + 8) = w1;
          if (seg == 0) DD[k] = __expf(blast);
          dlog += blast; }
        LDS_BAR();
        bf16x8_t Bv[NB][2];
#pragma unroll
        for (int nb = 0; nb < NB; ++nb)
#pragma unroll
            for (int ks = 0; ks < 2; ++ks) Bv[nb][ks] = lds_frag16(lds + vtoff + ((wave * 16 + fr) * 72 + ks * 32 + fq * 8) * 2);
        if (OUT) {
#ifdef REPMASK
          _Pragma("unroll 1") for (int rp2 = 0; rp2 < (((REPMASK) >> 25) & 1 ? 3 : 1); ++rp2) { if (rp2) LDS_BAR();
#else
          {
#endif
            { const int tb = wave >> 1;
#pragma unroll
              for (int sbi = 0; sbi < 2; ++sbi) { const int sb = (wave & 1) * 2 + sbi; f32x4 acc = {0.f, 0.f, 0.f, 0.f};
#pragma unroll
                  for (int ks = 0; ks < 4; ++ks) acc = __builtin_amdgcn_mfma_f32_16x16x32_bf16(lds_frag16(lds + qmoff + ((tb * 16 + fr) * 136 + ks * 32 + fq * 8) * 2), lds_frag16(lds + SL_KM + ((sb * 16 + fr) * 136 + ks * 32 + fq * 8) * 2), acc, 0, 0, 0);
#pragma unroll
                  for (int j = 0; j < 4; ++j) { const int t = tb * 16 + fq * 4 + j, s = sb * 16 + fr; const bool keep = dir ? (s >= t) : (s <= t); PP[t * 72 + s] = keep ? f2bf(acc[j]) : (bf16)0; } } }
            LDS_BAR();
#pragma unroll
            for (int nb = 0; nb < NB; ++nb) {
                bf16x8_t Bs[4];
#pragma unroll
                for (int ks = 0; ks < 4; ++ks) { const f32x4 e0 = *(LAS f32x4*)(EB + (2 * ks) * 16 + fq * 4), e1 = *(LAS f32x4*)(EB + (2 * ks + 1) * 16 + fq * 4); Bs[ks] = pack_bf16x8(S[nb][2 * ks] * e0, S[nb][2 * ks + 1] * e1); }
#pragma unroll
                for (int mb = 0; mb < 4; ++mb) {
                    f32x4 O = {0.f, 0.f, 0.f, 0.f};
#pragma unroll
                    for (int ks = 0; ks < 2; ++ks) O = __builtin_amdgcn_mfma_f32_16x16x32_bf16(lds_frag16(lds + SL_PP + ((mb * 16 + fr) * 72 + ks * 32 + fq * 8) * 2), Bv[nb][ks], O, 0, 0, 0);
#pragma unroll
                    for (int ks = 0; ks < 4; ++ks) { u32x4 aw; const u32x2 lo = *(LAS u32x2*)(lds + qmoff + ((mb * 16 + fr) * 136 + (2 * ks) * 16 + fq * 4) * 2), hi = *(LAS u32x2*)(lds + qmoff + ((mb * 16 + fr) * 136 + (2 * ks + 1) * 16 + fq * 4) * 2);
                        aw.x = lo.x; aw.y = lo.y; aw.z = hi.x; aw.w = hi.y;
                        O = __builtin_amdgcn_mfma_f32_16x16x32_bf16(__builtin_bit_cast(bf16x8_t, aw), Bs[ks], O, 0, 0, 0); }
#pragma unroll
                    for (int j = 0; j < 4; ++j) Odir[(size_t)(r0 + mb * 16 + fq * 4 + j) * 1024 + head * DV + (nbase + nb) * 16 + fr] = f2bf(O[j]);
                    asm volatile("" ::: "memory");
                }
            }
          }
        }
        if (!OUT || cc < 3) {
#pragma unroll
            for (int mb = 0; mb < 8; ++mb) { const f32x4 dd = *(LAS f32x4*)(DD + mb * 16 + fq * 4);
                const bf16x8_t A0 = lds_frag16(lds + SL_KE + ((mb * 16 + fr) * 72 + fq * 8) * 2), A1 = lds_frag16(lds + SL_KE + ((mb * 16 + fr) * 72 + 32 + fq * 8) * 2);
#pragma unroll
                for (int nb = 0; nb < NB; ++nb) { S[nb][mb] = S[nb][mb] * dd; S[nb][mb] = __builtin_amdgcn_mfma_f32_16x16x32_bf16(A0, Bv[nb][0], S[nb][mb], 0, 0, 0); S[nb][mb] = __builtin_amdgcn_mfma_f32_16x16x32_bf16(A1, Bv[nb][1], S[nb][mb], 0, 0, 0); }
                asm volatile("" ::: "memory"); }
        }
    }
    LDS_BAR();
    if (!OUT) {
#pragma unroll
        for (int nb = 0; nb < NB; ++nb)
#pragma unroll
            for (int mb = 0; mb < 8; ++mb) *(f32x4*)(kvs + ((size_t)((nbase + nb) * 8 + mb) * 64 + lane) * 4) = S[nb][mb];
        if (seg == 0) kd[k] = __expf(dlog);
    }
}
#undef SCAN_ISSUE
DI void scan_prop(const Args& a) {
    float* kvs = (float*)(wsp(a) + WS_KVS); const float* kd = (const float*)(wsp(a) + WS_KD);
    for (int g = obid() * NTHR + otid(); g < 131072; g += ogdim() * NTHR) {
        float* p; size_t stride; const float* dp;
        if (g < 65536) { const int stream = g >> 12, e = g & 4095; p = kvs + (size_t)stream * SC_N * 16384 + (size_t)e * 4; stride = 16384; dp = kd + (size_t)stream * SC_N * 128 + (((e >> 6) & 7) * 4 + ((e & 63) >> 4)) * 4; }
        else { const int q = g - 65536, stream = q >> 13, e = q & 8191; p = kvs + KVS_GL_OFF + (size_t)stream * SC_N * 32768 + (size_t)e * 4; stride = 32768; dp = kd + (size_t)(16 + stream) * SC_N * 128 + (((e >> 6) & 7) * 4 + ((e & 63) >> 4)) * 4; }
        f32x4 S = {0.f, 0.f, 0.f, 0.f};
#pragma unroll 5
        for (int sc = 0; sc < SC_N; ++sc) { const f32x4 kv = *(const f32x4*)(p + sc * stride), d = *(const f32x4*)(dp + sc * 128); *(f32x4*)(p + sc * stride) = S; S = d * S + kv; }
    }
}
constexpr int SCAN_ITEMS = 32 * SC_N;
template <bool OUT> DI void scan_item2(const Args& a, int l, int it, LAS unsigned char* lds, int pv = 0) {
    if (it < 16 * SC_N) { const int s = it / SC_N, sc = it % SC_N; if (OUT && l == DEPTH - 1 && sc == 0) return; scan_walk<true, OUT>(a, l, s >> 2, (s >> 1) & 1, sc, s & 1, lds, pv); }
    else { const int j = it - 16 * SC_N, s = j / SC_N, sc = j % SC_N; if (OUT && l == DEPTH - 1 && sc == 0) return; scan_walk<false, OUT>(a, l, s >> 1, s & 1, sc, 0, lds, pv); }
}
DI void hyconv_item(const Args& a, int l, int c, LAS unsigned char* ldsb, int pv = 0) {
    const int tid = otid();
    LAS float* lds = (LAS float*)ldsb;
    LAS float* xs = (LAS float*)(ldsb + LDS_X);
    const float* tw = (const float*)(wsp(a) + WS_TW); const float* tw2 = (const float*)(wsp(a) + WS_TW2);
    const float* h2 = (const float*)(wsp(a) + WS_H2) + (size_t)l * MT * 64;
    const bf16* VX = (const bf16*)(wsp(a) + WS_U) + (size_t)c * MT; bf16* VO = (bf16*)(wsp(a) + WS_CVO) + (size_t)c * MT;
#ifdef REPMASK
    _Pragma("unroll 1") for (int rpa = 0; rpa < (((REPMASK) >> 21) & 1 ? 2 : 1); ++rpa) { if (rpa) __syncthreads();
#else
    if (!(pv & 64)) {
#endif
    const bf16* HFf = (const bf16*)(wsp(a) + WS_HF) + (size_t)c * SEQ; const bf16* HFb = HFf + (size_t)1024 * SEQ;
    const float a0 = -4.605170186f / 1.5f, a1 = -4.605170186f / 0.3f;
    const float nd = -fabsf(a0 + (float)c * ((a1 - a0) / 1023.0f)) * (1.0f / (float)(SEQ - 1));
    const float b3f = ain(a, I_HYB3)[l * 2048 + c], b3b = ain(a, I_HYB3)[l * 2048 + 1024 + c];
    float sf = 0.f, sb = 0.f; f32x4 hfv[8], hbv[8];
#pragma unroll
    for (int i = 0; i < 8; ++i) { const int t4 = (tid + 512 * i) * 4; const u32x2 rf = *(const u32x2*)(HFf + t4), rb = *(const u32x2*)(HFb + t4);
        f32x4 hf, hb; hf[0] = bflo(rf.x); hf[1] = bfhi(rf.x); hf[2] = bflo(rf.y); hf[3] = bfhi(rf.y); hb[0] = bflo(rb.x); hb[1] = bfhi(rb.x); hb[2] = bflo(rb.y); hb[3] = bfhi(rb.y);
#pragma unroll
        for (int q = 0; q < 4; ++q) { const float dec = __expf(nd * (float)(t4 + q)) + 0.05f; hf[q] = (hf[q] + b3f) * dec; hb[q] = (hb[q] + b3b) * dec; }
        sf += (fabsf(hf[0]) + fabsf(hf[1])) + (fabsf(hf[2]) + fabsf(hf[3])); sb += (fabsf(hb[0]) + fabsf(hb[1])) + (fabsf(hb[2]) + fabsf(hb[3]));
        hfv[i] = hf; hbv[i] = hb; }
    sf = wave_sum(sf); sb = wave_sum(sb);
    if ((tid & 63) == 0) { xs[128 + (tid >> 6)] = sf; xs[136 + (tid >> 6)] = sb; }
    __syncthreads();
    float tf = 0.f, tb = 0.f;
#pragma unroll
    for (int w = 0; w < 8; ++w) { tf += xs[128 + w]; tb += xs[136 + w]; }
    const float inf_ = 1.0f / tf, inb_ = 1.0f / tb; const float skipv = ain(a, I_HYSKIP)[l * 1024 + c];
#pragma unroll
    for (int i = 0; i < 8; ++i) { const int t4 = (tid + 512 * i) * 4; f32x4 hf = hfv[i] * inf_; const f32x4 hb = hbv[i] * inb_;
        if (t4 == 0) hf[0] += hb[0] + skipv;
        *(LAS f32x4*)(lds + t4) = hf;
#pragma unroll
        for (int q = 0; q < 4; ++q) { const int t = t4 + q; if (t > 0) lds[32768 - t] = hb[q]; } }
    if (tid == 0) lds[SEQ] = 0.f;
    __syncthreads();
    }
    if (!(pv & 128)) { FftTw T; fft_load_tw(T, tw, tid);
    fft_fwd_pass<4096>(lds, T, tw, tid); LDS_BAR(); fft_fwd_pass<1024>(lds, T, tw, tid); LDS_BAR(); fft_fwd_pass<256>(lds, T, tw, tid); LDS_BAR(); fft_fwd_pass<64>(lds, T, tw, tid); LDS_BAR();
    fft_fwd_pass<16>(lds, T, tw, tid); LDS_BAR(); fft_fwd_pass<4>(lds, T, tw, tid); LDS_BAR(); fft_fwd_pass<1>(lds, T, tw, tid); LDS_BAR(); }
#ifdef REPMASK
    if (((REPMASK) >> 22) & 1) { FftTw T; fft_load_tw(T, tw, tid);
        fft_inv_pass<1>(lds, T, tw, tid); LDS_BAR(); fft_inv_pass<4>(lds, T, tw, tid); LDS_BAR(); fft_inv_pass<16>(lds, T, tw, tid); LDS_BAR(); fft_inv_pass<64>(lds, T, tw, tid); LDS_BAR();
        fft_inv_pass<256>(lds, T, tw, tid); LDS_BAR(); fft_inv_pass<1024>(lds, T, tw, tid); LDS_BAR(); fft_inv_pass<4096>(lds, T, tw, tid); LDS_BAR();
        for (int i = 0; i < 64; ++i) lds[tid + 512 * i] *= (1.0f / FFT_M);
        LDS_BAR();
        fft_fwd_pass<4096>(lds, T, tw, tid); LDS_BAR(); fft_fwd_pass<1024>(lds, T, tw, tid); LDS_BAR(); fft_fwd_pass<256>(lds, T, tw, tid); LDS_BAR(); fft_fwd_pass<64>(lds, T, tw, tid); LDS_BAR();
        fft_fwd_pass<16>(lds, T, tw, tid); LDS_BAR(); fft_fwd_pass<4>(lds, T, tw, tid); LDS_BAR(); fft_fwd_pass<1>(lds, T, tw, tid); LDS_BAR(); }
#endif

    float* Gs = (float*)(wsp(a) + WS_YMIX) + (size_t)obid() * 32768;
    const int kbase = ((tid & 63) << 7) | ((tid >> 6) << 4);
#ifdef REPMASK
    _Pragma("unroll 1") for (int rpc = 0; rpc < (((REPMASK) >> 23) & 1 ? 2 : 1); ++rpc)
#endif
#pragma unroll 4
    for (int j = 0; j < ((pv & 256) ? 0 : 16); ++j) { const int k = kbase | j; cpx gk, gm; rfft_untangle(lds, tw2, k, gk, gm); f32x4 g4; g4[0] = gk.x; g4[1] = gk.y; g4[2] = gm.x; g4[3] = gm.y; *(f32x4*)(Gs + (size_t)(j * 512 + tid) * 4) = g4; }
    __syncthreads();
#pragma unroll
    for (int i = 0; i < 16; ++i) { if (pv & 512) break; const int m4 = tid + 512 * i; f32x4 v = {0.f, 0.f, 0.f, 0.f}; if (m4 < SEQ / 4) { const u32x2 r = *(const u32x2*)(VX + m4 * 4); v[0] = bflo(r.x); v[1] = bfhi(r.x); v[2] = bflo(r.y); v[3] = bfhi(r.y); } *(LAS f32x4*)(lds + m4 * 4) = v; }
    __syncthreads();
    if (!(pv & 128)) { FftTw T; fft_load_tw(T, tw, tid);
    fft_fwd_pass<4096>(lds, T, tw, tid); LDS_BAR(); fft_fwd_pass<1024>(lds, T, tw, tid); LDS_BAR(); fft_fwd_pass<256>(lds, T, tw, tid); LDS_BAR(); fft_fwd_pass<64>(lds, T, tw, tid); LDS_BAR();
    fft_fwd_pass<16>(lds, T, tw, tid); LDS_BAR(); fft_fwd_pass<4>(lds, T, tw, tid); LDS_BAR(); fft_fwd_pass<1>(lds, T, tw, tid); LDS_BAR(); }
#pragma unroll 8
    for (int j = 0; j < ((pv & 1024) ? 0 : 16); ++j) { const int k = kbase | j; const f32x4 g4 = *(const f32x4*)(Gs + (size_t)(j * 512 + tid) * 4); cpx gk, gm; gk.x = g4[0]; gk.y = g4[1]; gm.x = g4[2]; gm.y = g4[3]; rfft_mul_retangle(lds, tw2, k, gk, gm); }
    __syncthreads();
    if (!(pv & 128)) { FftTw T; fft_load_tw(T, tw, tid);
    fft_inv_pass<1>(lds, T, tw, tid); LDS_BAR(); fft_inv_pass<4>(lds, T, tw, tid); LDS_BAR(); fft_inv_pass<16>(lds, T, tw, tid); LDS_BAR(); fft_inv_pass<64>(lds, T, tw, tid); LDS_BAR();
    fft_inv_pass<256>(lds, T, tw, tid); LDS_BAR(); fft_inv_pass<1024>(lds, T, tw, tid); LDS_BAR(); fft_inv_pass<4096>(lds, T, tw, tid); LDS_BAR(); }
#pragma unroll
    for (int i = 0; i < 8; ++i) { if (pv & 2048) break; const int m4 = tid + 512 * i; const f32x4 v = *(const LAS f32x4*)(lds + m4 * 4) * (1.0f / FFT_M); u32x2 o; o.x = pk_bf16(v[0], v[1]); o.y = pk_bf16(v[2], v[3]); *(u32x2*)(VO + m4 * 4) = o; }
    __syncthreads();
}
DI void hycctx_item(const Args& a, int l, int it, LAS unsigned char* ldsb) {
    const int tid = otid(), c0 = it * 4;
    LAS float* sv = (LAS float*)ldsb;
    LAS float* sf = sv + 4 * 256;
    LAS float* sb = sf + 4 * 256;
    const float* hyc = (const float*)(wsp(a) + WS_HYC); const bf16* VXT = (const bf16*)(wsp(a) + WS_U); bf16* CVO = (bf16*)(wsp(a) + WS_CVO);
    for (int i = tid; i < 4 * 256; i += NTHR) { const int ch = i >> 8, t = i & 255; sv[i] = bf2f(VXT[(size_t)(c0 + ch) * MT + SEQ + t]); sf[i] = hyc[(size_t)(c0 + ch) * 256 + t]; sb[i] = hyc[(size_t)(1024 + c0 + ch) * 256 + t]; }
    __syncthreads();
    const int ch = tid >> 7, tq = tid & 127; const float g0 = sf[ch * 256] + sb[ch * 256] + ain(a, I_HYSKIP)[l * 1024 + c0 + ch];
    float acc0 = 0.f, acc1 = 0.f; const int t0 = tq * 2;
    for (int s = 0; s < 256; ++s) { const float vv = sv[ch * 256 + s]; const int d0 = t0 - s, d1 = d0 + 1;
        const float ga = d0 > 0 ? sf[ch * 256 + d0] : (d0 < 0 ? sb[ch * 256 - d0] : g0), gb = d1 > 0 ? sf[ch * 256 + d1] : (d1 < 0 ? sb[ch * 256 - d1] : g0);
        acc0 += ga * vv; acc1 += gb * vv; }
    *(unsigned*)(CVO + (size_t)(c0 + ch) * MT + SEQ + t0) = pk_bf16(acc0, acc1);
    __syncthreads();
}

struct EpiHF {
    static constexpr bool PERM = true, AFTER_DRAIN = false; bf16* O;
    DI void operator()(const f32x4 (&acc)[2][2][4][2], const pg8::Unit& u, int wr, int wc, int fr, int fq) const {
        const int row0 = u.pm * 256 + wr * 64 + fr, col0 = u.pn * 256 + wc * 32 + 8 * fq;
#pragma unroll
        for (int ai = 0; ai < 2; ++ai)
#pragma unroll
            for (int m = 0; m < 4; ++m) { bf16* rowp = O + (size_t)(row0 + ai * 128 + m * 16) * SEQ + col0;
#pragma unroll
                for (int bj = 0; bj < 2; ++bj) { const f32x4 v0 = acc[ai][bj][m][0], v1 = acc[ai][bj][m][1];
                    u32x4 w; w.x = pk_bf16(v0[0], v0[1]); w.y = pk_bf16(v0[2], v0[3]); w.z = pk_bf16(v1[0], v1[1]); w.w = pk_bf16(v1[2], v1[3]);
                    *(u32x4*)(rowp + bj * 128) = w; } }
    }
};
struct EpiZ {
    static constexpr bool PERM = true, AFTER_DRAIN = false; bf16* O; const float* bias;
    DI void operator()(const f32x4 (&acc)[2][2][4][2], const pg8::Unit& u, int wr, int wc, int fr, int fq) const {
        const int row0 = u.pm * 256 + wr * 64 + fr, col0 = u.pn * 256 + wc * 32 + 8 * fq;
        f32x4 bv[2][2];
#pragma unroll
        for (int bj = 0; bj < 2; ++bj)
#pragma unroll
            for (int n = 0; n < 2; ++n) bv[bj][n] = *(const f32x4*)(bias + col0 + bj * 128 + 4 * n);
#pragma unroll
        for (int ai = 0; ai < 2; ++ai)
#pragma unroll
            for (int m = 0; m < 4; ++m) { bf16* rowp = O + (size_t)(row0 + ai * 128 + m * 16) * ZC + col0;
#pragma unroll
                for (int bj = 0; bj < 2; ++bj) { const f32x4 v0 = acc[ai][bj][m][0] + bv[bj][0], v1 = acc[ai][bj][m][1] + bv[bj][1];
                    u32x4 w; w.x = pk_bf16(v0[0], v0[1]); w.y = pk_bf16(v0[2], v0[3]); w.z = pk_bf16(v1[0], v1[1]); w.w = pk_bf16(v1[2], v1[3]);
                    *(u32x4*)(rowp + bj * 128) = w; } }
    }
};
template <int BR> struct EpiBr {
    static constexpr bool PERM = true, AFTER_DRAIN = false; bf16* Mg; const bf16* Zg;
    DI void operator()(const f32x4 (&acc)[2][2][4][2], const pg8::Unit& u, int wr, int wc, int fr, int fq) const {
        const int row0 = u.pm * 256 + wr * 64 + fr, col0 = u.pn * 256 + wc * 32 + 8 * fq;
#pragma unroll
        for (int ai = 0; ai < 2; ++ai)
#pragma unroll
            for (int m = 0; m < 4; ++m) { const size_t row = (size_t)(row0 + ai * 128 + m * 16);
#pragma unroll
                for (int bj = 0; bj < 2; ++bj) { const int col = col0 + bj * 128;
                    const u32x4 g = *(const u32x4*)(Zg + row * ZC + col);
                    f32x4 v0 = acc[ai][bj][m][0], v1 = acc[ai][bj][m][1];
                    v0[0] *= sigmoidf_(bflo(g.x)); v0[1] *= sigmoidf_(bfhi(g.x)); v0[2] *= sigmoidf_(bflo(g.y)); v0[3] *= sigmoidf_(bfhi(g.y));
                    v1[0] *= sigmoidf_(bflo(g.z)); v1[1] *= sigmoidf_(bfhi(g.z)); v1[2] *= sigmoidf_(bflo(g.w)); v1[3] *= sigmoidf_(bfhi(g.w));
                    if (BR > 0) { const u32x4 p = *(const u32x4*)(Mg + row * D + col);
                        v0[0] += bflo(p.x); v0[1] += bfhi(p.x); v0[2] += bflo(p.y); v0[3] += bfhi(p.y); v1[0] += bflo(p.z); v1[1] += bfhi(p.z); v1[2] += bflo(p.w); v1[3] += bfhi(p.w); }
                    u32x4 w; w.x = pk_bf16(v0[0], v0[1]); w.y = pk_bf16(v0[2], v0[3]); w.z = pk_bf16(v1[0], v1[1]); w.w = pk_bf16(v1[2], v1[3]);
                    *(u32x4*)(Mg + row * D + col) = w; } }
    }
};
struct EpiOut {
    static constexpr bool PERM = false, AFTER_DRAIN = false; const float* hin_main; const float* hin_ctx; float* hout; const float* gt1;
    DI void operator()(const f32x4 (&acc)[2][2][4][2], const pg8::Unit& u, int wr, int wc, int fr, int fq) const {
        const int row0 = u.pm * 256 + wr * 64 + fr, col0 = u.pn * 256 + wc * 32 + 4 * fq; const bool isctx = u.pm >= SEQ / 256;
        const float* g = gt1 + (isctx ? 12288 : 0);
        f32x4 gv[2][2];
#pragma unroll
        for (int bj = 0; bj < 2; ++bj)
#pragma unroll
            for (int n = 0; n < 2; ++n) gv[bj][n] = *(const f32x4*)(g + col0 + bj * 128 + n * 16);
#pragma unroll
        for (int ai = 0; ai < 2; ++ai)
#pragma unroll
            for (int m = 0; m < 4; ++m) { const int row = row0 + ai * 128 + m * 16;
                const float* ip = (isctx ? hin_ctx + (size_t)(row - SEQ) * D : hin_main + (size_t)row * D) + col0; float* op = hout + (size_t)row * D + col0;
#pragma unroll
                for (int bj = 0; bj < 2; ++bj)
#pragma unroll
                    for (int n = 0; n < 2; ++n) { const f32x4 b = *(const f32x4*)(ip + bj * 128 + n * 16); *(f32x4*)(op + bj * 128 + n * 16) = b + gv[bj][n] * acc[ai][bj][m][n]; } }
    }
};
struct EpiGU {
    static constexpr bool PERM = true, AFTER_DRAIN = false; bf16* Hm;
    DI void operator()(const f32x4 (&acc)[2][2][4][2], const pg8::Unit& u, int wr, int wc, int fr, int fq) const {
        const int row0 = u.pm * 256 + wr * 64 + fr, col0 = (u.pn & 3) * 128 + wc * 32 + 8 * fq;
#pragma unroll
        for (int ai = 0; ai < 2; ++ai)
#pragma unroll
            for (int m = 0; m < 4; ++m) { const f32x4 g0 = acc[ai][0][m][0], g1 = acc[ai][0][m][1], u0 = acc[ai][1][m][0], u1 = acc[ai][1][m][1];
                u32x4 w; w.x = pk_bf16(siluf_(g0[0]) * u0[0], siluf_(g0[1]) * u0[1]); w.y = pk_bf16(siluf_(g0[2]) * u0[2], siluf_(g0[3]) * u0[3]);
                w.z = pk_bf16(siluf_(g1[0]) * u1[0], siluf_(g1[1]) * u1[1]); w.w = pk_bf16(siluf_(g1[2]) * u1[2], siluf_(g1[3]) * u1[3]);
                *(u32x4*)(Hm + (size_t)(row0 + ai * 128 + m * 16) * DFF + col0) = w; }
    }
};
struct EpiDn {
    static constexpr bool PERM = true, AFTER_DRAIN = false; bf16* Y; const float* roww;
    DI void operator()(const f32x4 (&acc)[2][2][4][2], const pg8::Unit& u, int wr, int wc, int fr, int fq) const {
        const int row0 = u.pm * 256 + wr * 64 + fr, col0 = (u.pn & 7) * 256 + wc * 32 + 8 * fq;
#pragma unroll
        for (int ai = 0; ai < 2; ++ai)
#pragma unroll
            for (int m = 0; m < 4; ++m) { const int row = row0 + ai * 128 + m * 16; const float rw = roww[row];
#pragma unroll
                for (int bj = 0; bj < 2; ++bj) { const f32x4 v0 = acc[ai][bj][m][0] * rw, v1 = acc[ai][bj][m][1] * rw;
                    u32x4 w; w.x = pk_bf16(v0[0], v0[1]); w.y = pk_bf16(v0[2], v0[3]); w.z = pk_bf16(v1[0], v1[1]); w.w = pk_bf16(v1[2], v1[3]);
                    *(u32x4*)(Y + (size_t)row * D + col0 + bj * 128) = w; } }
    }
};
struct MoeOrder {
    const int* tile_e; int ntiles, nsub, G, c;
    DI bool next(int i, pg8::Unit& u) const { const int j = i * G + c; if (j >= ntiles * nsub) return false; const int ti = j / nsub; u.pm = ti; u.pn = tile_e[ti] * nsub + (j - ti * nsub); return true; }
    DI void a_ready(const pg8::Unit&) const {}
    DI void done(const pg8::Unit&) const {}
};
constexpr int NPH_LAYER = 13, PH_FINAL = 1 + NPH_LAYER * DEPTH, NPHASES = PH_FINAL + 1;
struct KArgs { Args a; int li, pad; };
__global__ void __launch_bounds__(NTHR, 2) fwd_kernel(KArgs ka) {
    const Args& a = ka.a;
#define tid ((int)otid())
#define bid ((int)obid())
#define G ((int)ogdim())
    if (tid == 0) { ((LAS unsigned*)(ldsbase() + LDS_BARW))[0] = 0u; ((LAS unsigned*)(ldsbase() + LDS_BARW))[1] = 0u;
        LAS unsigned long long* ptab = (LAS unsigned long long*)(ldsbase() + LDS_PTAB);
#pragma unroll
        for (int i = 0; i < N_IN; ++i) ptab[i] = (unsigned long long)ka.a.in[i]; }
    __syncthreads();
#ifdef PROBE_SEL
    if (tid < 64) ((LAS unsigned long long*)(ldsbase() + LDS_TIM))[tid] = 0ull;
    __syncthreads();
    const unsigned long long tkern_ = __builtin_amdgcn_s_memrealtime();
#endif
    XcdBarrier bar = xcd_barrier_post((unsigned*)(wsp(a) + WS_CTL) + CW_BAR + ka.li * XCD_BAR_WORDS, (volatile LAS unsigned*)(ldsbase() + LDS_BARW));
    const int lo = a.ph_lo, hi = a.ph_hi;
#ifndef PHMASK
#define PHMASK 0xFFFF
#endif
#define EN(i) (((PHMASK) >> (i)) & 1)
#ifndef REPMASK
#define REPMASK 0
#endif
#define REP(i) (((REPMASK) >> (i)) & 1)
#define RUN(i, cond, ...) do { _Pragma("unroll 1") for (int rep_ = 0; rep_ < ((REP(i) && (cond)) ? REPN : 1); ++rep_) { if (rep_) __syncthreads(); __VA_ARGS__; } } while (0)
#ifndef REPN
#define REPN 2
#endif
#define IN(k) (opq(lo) <= (k) && (k) < opq(hi))
#define SEAM(k) do { if (IN(k) && IN((k) + 1)) { TIC(); xcd_barrier(bar); TOC(30); } } while (0)
#define ws wsp(a)
#define lds ldsbase()
#define ldsf ((LAS float*)ldsbase())
#define U ((bf16*)(wsp(a) + WS_U))
#define Z ((bf16*)(wsp(a) + WS_Z))
#define H ((float*)(wsp(a) + WS_H))
#define modall ((const float*)(wsp(a) + WS_MOD))

    { TIC();
    if (EN(0) && IN(0)) {
        RUN(0, true, prologue_small(a);
        for (int it = bid; it < 256; it += G) mod_item(a, it, ldsf);
        __syncthreads(); h2_rows(a, ldsf); __syncthreads());
    }
    TOC(31); } SEAM(0);
    for (int l = 0; l < DEPTH; ++l) {
        const int pb = 1 + NPH_LAYER * l;
        const int nrows = (l == 0) ? MT : SEQ;
        { TIC();
        if (EN(1) && IN(pb + 0)) {
            RUN(1, l == 0, norm_phase<0>(a, l, MT, ldsf));
            RUN(16, true, if (l == 0) hyc_filters(a, 0));
            __syncthreads(); RUN(2, true, cvt_stream<false>(a, l, ldsf)); __syncthreads();
        }
        TOC(1); } SEAM(pb + 0); { TIC();
        if (EN(2) && IN(pb + 1)) {
            pg8::Gemm g{U, (const bf16*)(ws + WS_WIN), MT, ZC, D}; pg8::StaticOrder S; S.init(MT, ZC, G, bid);
            EpiZ E{Z, (const float*)(ws + WS_ZBIAS) + (size_t)l * ZC};
            RUN(3, true, pg8::gemm_phase<EpiZ, pg8::StaticOrder, true, true>(lds, g, S, E));
        }
        TOC(2); } SEAM(pb + 1); { TIC();
        if (EN(3) && IN(pb + 2)) { const int nit = (nrows / 64) * 16; { const int g_ = G, w0_ = __builtin_amdgcn_readfirstlane(tid >> 6) * g_ + bid, n_ = (nrows / 64) * 128; RUN(4, true, for (int it = w0_; it < n_; it += 8 * g_) hyprep_witem(a, l, it)); }
            __syncthreads();
            pg8::Gemm g{(const bf16*)(ws + WS_W3T) + (size_t)l * 2048 * 256, (const bf16*)(ws + WS_H2B) + (size_t)l * SEQ * 256, 2048, SEQ, opq(256)  }; pg8::StaticOrder S; S.init(2048, SEQ, G, bid);
            EpiHF E{(bf16*)(ws + WS_HF)};
            RUN(18, true, pg8::gemm_phase<EpiHF, pg8::StaticOrder, true, true>(lds, g, S, E)); }
        TOC(3); } SEAM(pb + 2); { TIC();
        if (EN(4) && IN(pb + 3)) {
            if (!(ka.pad & 8)) { RUN(5, true, for (int it = bid; it < SCAN_ITEMS; it += G) scan_item2<false>(a, l, it, lds)); }
            if (!(ka.pad & 16)) { RUN(6, true, for (int c = bid; c < 1024; c += G) hyconv_item(a, l, c, lds, ka.pad)); }
            if (!(ka.pad & 32)) { RUN(15, true, if (l == 0) for (int it = bid; it < 256; it += G) hycctx_item(a, l, it, lds)); }
        }
        TOC(4); } SEAM(pb + 3); { TIC();
        if (EN(13) && IN(pb + 4)) { scan_prop(a); if (REP(20)) { xcd_barrier(bar); xcd_barrier(bar); xcd_barrier(bar); xcd_barrier(bar); xcd_barrier(bar); } }
        TOC(5); } SEAM(pb + 4); { TIC();
        if (EN(14) && IN(pb + 5)) { RUN(17, true, for (int it = bid; it < SCAN_ITEMS; it += G) scan_item2<true>(a, l, it, lds, ka.pad)); }
        TOC(6); } SEAM(pb + 5); { TIC();
        if (EN(5) && IN(pb + 6)) {
            const int nit = (nrows / 64) * 16;
            { const int g_ = G, w0_ = __builtin_amdgcn_readfirstlane(tid >> 6) * g_ + bid, n_ = (nrows / 64) * 128; RUN(7, true, scancomb_rows(a, l, nrows); for (int it = w0_; it < n_; it += 8 * g_) hycomb_witem(a, l, it)); }
        }
        TOC(7); } SEAM(pb + 6); { TIC();
        if (EN(6) && IN(pb + 7)) {
            const bf16* Y = (const bf16*)(ws + WS_YMIX); const bf16* WB = (const bf16*)(ws + WS_WBR);
            pg8::StaticOrder S; S.init(nrows, D, G, bid);
            RUN(8, true,
            { pg8::Gemm g{Y, WB, nrows, D, 1024}; EpiBr<0> E{U, Z + Z_MG}; pg8::gemm_phase<EpiBr<0>, pg8::StaticOrder, true, true>(lds, g, S, E); }
            __syncthreads();
            { pg8::Gemm g{Y + (size_t)MT * 1024, WB + (size_t)D * 1024, nrows, D, 1024}; EpiBr<1> E{U, Z + Z_MG + D}; pg8::gemm_phase<EpiBr<1>, pg8::StaticOrder, true, true>(lds, g, S, E); }
            __syncthreads();
            { pg8::Gemm g{Y + (size_t)2 * MT * 1024, WB + (size_t)2 * D * 1024, nrows, D, 1024}; EpiBr<2> E{U, Z + Z_MG + 2 * D}; pg8::gemm_phase<EpiBr<2>, pg8::StaticOrder, true, true>(lds, g, S, E); });
        }
        TOC(8); } SEAM(pb + 7); { TIC();
        if (EN(7) && IN(pb + 8)) {
            pg8::Gemm g{U, (const bf16*)(ws + WS_WOUT), nrows, D, D}; pg8::StaticOrder S; S.init(nrows, D, G, bid);
            EpiOut E{l == 0 ? ain(a, I_X) : H, l == 0 ? ain(a, I_CTX) : H + (size_t)SEQ * D, H, modall + (size_t)l * 2 * 12288 + 4096};
            RUN(9, l == 0, pg8::gemm_phase<EpiOut, pg8::StaticOrder, true, true>(lds, g, S, E));
        }
        TOC(9); } SEAM(pb + 8); { TIC();
        if (EN(8) && IN(pb + 9)) {
            route_phase<false>(a, l, nrows, ldsf, ka.pad);
            __syncthreads();
            if (REP(19)) { route_phase<true>(a, l, nrows, ldsf); __syncthreads(); }

        }
        TOC(10); } SEAM(pb + 9); { TIC();
        if (EN(9) && IN(pb + 10)) { RUN(11, true, permute_phase(a, l, nrows, lds)); __syncthreads(); RUN(10, true, cvt_stream<true>(a, l, ldsf)); __syncthreads(); }
        TOC(11); } SEAM(pb + 10); { TIC();
        if (EN(10) && IN(pb + 11)) {
            const int* tile_e = (const int*)(ws + WS_TILEE); const int ntiles = tile_e[200];
            pg8::Gemm g{(const bf16*)(ws + WS_XP), (const bf16*)(ws + WS_WGU), MOE_MAXROWS, NEXP * 1024, D}; MoeOrder S{tile_e, ntiles, 4, G, bid};
            EpiGU E{(bf16*)(ws + WS_HMID)};
            RUN(12, true, pg8::gemm_phase<EpiGU, MoeOrder, true, true>(lds, g, S, E));
        }
        TOC(12); } SEAM(pb + 11); { TIC();
        if (EN(11) && IN(pb + 12)) {
            const int* tile_e = (const int*)(ws + WS_TILEE); const int ntiles = tile_e[200];
            pg8::Gemm g{(const bf16*)(ws + WS_HMID), (const bf16*)(ws + WS_WD), MOE_MAXROWS, NEXP * D, DFF}; MoeOrder S{tile_e, ntiles, 8, G, bid};
            EpiDn E{(bf16*)(ws + WS_YP), (const float*)(ws + WS_ROWW)};
            RUN(13, true, pg8::gemm_phase<EpiDn, MoeOrder, true, true>(lds, g, S, E));
        }
        TOC(13); } SEAM(pb + 12); { TIC();
        (void)0; }
    }
#ifdef PROBE_SEL
    if (tid == 0) ((LAS unsigned long long*)(ldsbase() + LDS_TIM))[0] = __builtin_amdgcn_s_memrealtime() - tkern_;
    __syncthreads();
#endif
    if (EN(12) && IN(PH_FINAL)) norm_phase<2>(a, DEPTH, SEQ, ldsf);
#undef IN
#undef SEAM
#undef ws
#undef tid
#undef bid
#undef G
#undef lds
#undef ldsf
#undef U
#undef Z
#undef H
#undef modall
}

#ifndef MK_SINGLE
#define MK_SINGLE 1
#endif
extern "C" void kernel_launch(void* const* d_in, const int* in_sizes, int n_in, void* d_out, int out_size, void* d_ws, size_t ws_size, hipStream_t stream) {
    static int grid = 0;
    if (grid == 0) {
        if (n_in != N_IN || out_size != SEQ * D || ws_size < WS_END) { fprintf(stderr, "kernel_launch: unexpected problem shape (n_in %d, out %d, ws %zu < %zu)\n", n_in, out_size, ws_size, (size_t)WS_END); grid = -1; return; }
        int dev = 0, cus = 0;
        if (hipGetDevice(&dev) != hipSuccess || hipDeviceGetAttribute(&cus, hipDeviceAttributeMultiprocessorCount, dev) != hipSuccess) { grid = -1; return; }
        if (hipFuncSetAttribute((const void*)fwd_kernel, hipFuncAttributeMaxDynamicSharedMemorySize, LDS_BYTES) != hipSuccess) { fprintf(stderr, "kernel_launch: hipFuncSetAttribute failed\n"); grid = -1; return; }
        int per_cu = 0;
        if (hipOccupancyMaxActiveBlocksPerMultiprocessor(&per_cu, (const void*)fwd_kernel, NTHR, LDS_BYTES) != hipSuccess || per_cu < 1) fprintf(stderr, "kernel_launch: occupancy query says %d\n", per_cu);
        (void)hipGetLastError();
        grid = cus;
    }
    if (grid < 0) return;
    (void)hipMemsetAsync((char*)d_ws + WS_CTL, 0, CTL_BYTES, stream);
    KArgs ka{};
    for (int i = 0; i < N_IN; ++i) ka.a.in[i] = (const float*)d_in[i];
    ka.a.out = (float*)d_out; ka.a.ws = (unsigned char*)d_ws;
#if MK_SINGLE
    ka.a.ph_lo = 0; ka.a.ph_hi = NPHASES; ka.li = 0; ka.pad = 0;
    hipLaunchKernelGGL(fwd_kernel, dim3(grid), dim3(NTHR), LDS_BYTES, stream, ka);
#ifdef PROBE_K
    (void)hipMemsetAsync((char*)d_ws + WS_CTL + (size_t)CW_CNT * 4, 0, 16384, stream);
    ka.a.ph_lo = 0; ka.a.ph_hi = PROBE_K; ka.li = 1;
#ifdef PROBE_V
    ka.pad = PROBE_V;
#endif
    hipLaunchKernelGGL(fwd_kernel, dim3(grid), dim3(NTHR), LDS_BYTES, stream, ka);
#endif
#else
    for (int ph = 0; ph < NPHASES; ++ph) { ka.a.ph_lo = ph; ka.a.ph_hi = ph + 1; ka.li = 0; ka.pad = 0; hipLaunchKernelGGL(fwd_kernel, dim3(grid), dim3(NTHR), LDS_BYTES, stream, ka); }
#endif
}
```

```cpp
#include <hip/hip_runtime.h>
#include <cstdio>
#include <cstdint>
#define DI __device__ __forceinline__
#define LAS __attribute__((address_space(3)))
typedef unsigned short bf16;
typedef float f32x4 __attribute__((ext_vector_type(4)));
typedef unsigned u32x4 __attribute__((ext_vector_type(4)));
typedef unsigned u32x2 __attribute__((ext_vector_type(2)));

constexpr int D = 2048, SEQ = 16384, CTXL = 256, MT = SEQ + CTXL  , DEPTH = 2;
constexpr int NCOLS_IN = 17440;
constexpr int ZC = 17664;
constexpr int Z_HG = 0, Z_GL = 5120, Z_HY = 8192, Z_MG = 11264, Z_LR = 17408;
constexpr int NEXP = 32, DFF = 512, MOE_MAXROWS = 41472;
constexpr float NORM_EPS = 1e-6f;

constexpr size_t MiB = 1u << 20;
constexpr size_t WS_CTL = 0, CTL_BYTES = 1 * MiB;
constexpr size_t WS_SMALL = 1 * MiB;
constexpr size_t WS_MOD   = WS_SMALL;
constexpr size_t WS_ZBIAS = WS_MOD + (size_t)DEPTH * 2 * 12288 * 4;
constexpr size_t WS_LB    = WS_ZBIAS + (size_t)DEPTH * ZC * 4;
constexpr size_t WS_TW    = WS_LB + (size_t)DEPTH * 2 * 1024 * 4;
constexpr size_t WS_TW2   = WS_TW + 16384 * 8;
constexpr size_t WS_H2    = WS_TW2 + (8192 + 64) * 8;
constexpr size_t WS_ROUTE = WS_H2 + (size_t)DEPTH * MT * 64 * 4;
constexpr size_t WS_ROWW  = WS_ROUTE + (size_t)MT * 8 * 4;
constexpr size_t WS_TILEE = WS_ROWW + (size_t)MOE_MAXROWS * 4;
constexpr size_t WS_HYC   = WS_TILEE + 1024;
constexpr size_t WS_W3T   = WS_HYC + (size_t)2048 * 256 * 4;
constexpr size_t WS_H2B   = WS_W3T + (size_t)DEPTH * 2048 * 256 * 2;
constexpr size_t WS_WRT   = WS_H2B + (size_t)DEPTH * SEQ * 256 * 2;
constexpr size_t WS_SMALL_END = WS_WRT + (size_t)DEPTH * 2 * 48 * 2048 * 2;
static_assert(WS_SMALL_END <= 40 * MiB, "small tables");
constexpr size_t WS_WIN  = 40 * MiB;
constexpr size_t WS_WBR  = 109 * MiB;
constexpr size_t WS_WOUT = 121 * MiB;
constexpr size_t WS_WGU  = 129 * MiB;
constexpr size_t WS_CVO  = WS_WIN;
constexpr size_t WS_WD   = 257 * MiB;
constexpr size_t WS_H    = 321 * MiB;
constexpr size_t WS_U    = 451 * MiB;
constexpr size_t WS_Z    = 516 * MiB;
constexpr size_t WS_XP   = WS_Z;
constexpr size_t WS_HMID = WS_Z + 162 * MiB;
constexpr size_t WS_YP   = WS_Z + 203 * MiB;
constexpr size_t WS_YMIX = 1077 * MiB;
constexpr size_t WS_HF   = 1175 * MiB;
constexpr size_t WS_OSC  = 1175 * MiB;
constexpr size_t WS_END  = 1435 * MiB;
static_assert(WS_WIN + (size_t)ZC * D * 2 <= WS_WBR && WS_Z + (size_t)MT * ZC * 2 <= WS_YMIX && WS_YMIX + (size_t)3 * MT * 1024 * 2 <= WS_OSC && WS_OSC + (size_t)4 * MT * 1024 * 4 <= WS_END, "ws map");
static_assert(WS_YP + (size_t)MOE_MAXROWS * D * 2 <= WS_YMIX && WS_H + (size_t)MT * D * 4 <= WS_U && WS_U + (size_t)MT * D * 2 <= WS_Z, "ws map 2");
constexpr int CW_BAR = 4096;
constexpr int CW_CNT = 16384;

DI float bf2f(bf16 v) { return __uint_as_float(((unsigned)v) << 16); }
DI float bflo(unsigned w) { return __uint_as_float(w << 16); }
DI float bfhi(unsigned w) { return __uint_as_float(w & 0xffff0000u); }
typedef float f32x2_t __attribute__((ext_vector_type(2))); typedef __bf16 bf16x2_t __attribute__((ext_vector_type(2)));
DI unsigned pk_bf16(float lo, float hi) { f32x2_t v = {lo, hi}; bf16x2_t b = __builtin_convertvector(v, bf16x2_t); return __builtin_bit_cast(unsigned, b); }
DI bf16 f2bf(float f) { return (bf16)(pk_bf16(f, 0.f) & 0xffffu); }
DI float sigmoidf_(float x) { return __builtin_amdgcn_rcpf(1.0f + __expf(-x)); }
DI float siluf_(float x) { return x * __builtin_amdgcn_rcpf(1.0f + __expf(-x)); }
DI float wave_sum(float v) {
#pragma unroll
    for (int o = 32; o >= 1; o >>= 1) v += __shfl_xor(v, o);
    return v;
}
DI int otid() { int t = __builtin_amdgcn_workitem_id_x(); asm volatile("" : "+v"(t)); return t; }
DI int ogdim() { int g = __builtin_amdgcn_workgroup_id_x(); g = (int)gridDim.x; asm volatile("" : "+s"(g)); return g; }
DI int obid() { int b = __builtin_amdgcn_workgroup_id_x(); asm volatile("" : "+s"(b)); return b; }
#define AIN_DECL 1
DI LAS f32x2_t* fft_vec2_(LAS float* p) { return (LAS f32x2_t*)p; }
DI const f32x2_t* fft_vec2_(const float* p) { return (const f32x2_t*)p; }
DI f32x2_t* fft_vec2_(float* p) { return (f32x2_t*)p; }
namespace pg8 {
#define PG8_LAS __attribute__((address_space(3)))
typedef unsigned short bf16_t;
typedef short bf16x8 __attribute__((ext_vector_type(8)));
typedef float f32x4 __attribute__((ext_vector_type(4)));
typedef unsigned u32x4 __attribute__((ext_vector_type(4)));
constexpr int BM = 256, BK = 64, HALF = 128, HTB = HALF * BK * 2  , STAGE_BYTES = 8 * HTB, NXCD = 8, WGM = 8;

__host__ __device__ __forceinline__ int lds_byte(int r, int c) { const int st = (r >> 4) * 2 + (c >> 5), rr = r & 15, cc = c & 31, ob = rr * 64 + cc * 2; return st * 1024 + (ob ^ (((ob >> 9) & 1) << 5)); }
__host__ __device__ __forceinline__ void stage_rc(int b, int& R, int& C) { const int st = b / 1024, sb = b % 1024, swz = sb ^ (((sb >> 9) & 1) << 5); R = (st >> 1) * 16 + swz / 64; C = (st & 1) * 32 + (swz % 64) / 2; }
__host__ __device__ __forceinline__ int perm32(int rho) { const int n = rho >> 4, i = rho & 15; return 8 * (i >> 2) + 4 * n + (i & 3); }

struct Unit { int pm, pn; };
struct Gemm { const bf16_t* A; const bf16_t* Bt; int M, N, K; };

struct StaticOrder {
    int nM, nN, nwg, G, c;
    __host__ __device__ void init(int M, int N, int G_, int c_) { nM = M / BM; nN = N / BM; nwg = nM * nN; G = G_; c = c_; }
    __host__ __device__ bool next(int i, Unit& u) const {
        const long L = (long)i * G + c; if (L >= nwg) return false;
        int wgid = (int)L; { const int q = nwg / NXCD, r = nwg % NXCD, xcd = wgid % NXCD, off = wgid / NXCD; wgid = (xcd < r ? xcd * (q + 1) : r * (q + 1) + (xcd - r) * q) + off; }
        const int nig = WGM * nN, gid = wgid / nig, fm = gid * WGM, gsz = (nM - fm) < WGM ? (nM - fm) : WGM;
        u.pm = fm + ((wgid % nig) % gsz); u.pn = (wgid % nig) / gsz; return true;
    }
    __device__ __forceinline__ void a_ready(const Unit&) const {}
    __device__ __forceinline__ void done(const Unit&) const {}
};

template <class Epi, class Sched, bool ALIGN_EPI = false, bool SP2 = false>
__device__ __forceinline__ void gemm_phase(PG8_LAS unsigned char* lds, const Gemm g, const Sched& S, const Epi& E) {
    const int tid = otid(), wid = __builtin_amdgcn_readfirstlane(tid >> 6), lane = tid & 63, wr = wid >> 2, wc = wid & 3, fr = lane & 15, fq = lane >> 4;
    const int K = g.K, nt = K / BK;
    unsigned voffA[2], voffB[2];
#pragma unroll
    for (int i = 0; i < 2; ++i) { int R, C; stage_rc(tid * 16 + i * 8192, R, C); const int Rb = Epi::PERM ? ((R & ~31) + perm32(R & 31)) : R;
        voffA[i] = (unsigned)(R * K + C) * 2u; voffB[i] = (unsigned)(Rb * K + C) * 2u; }
    const size_t kstep = (size_t)(BK * 2);
    const size_t hstep = (size_t)HALF * K * 2;
    const size_t tstep = 2 * hstep;
    const unsigned ldsw = (unsigned)wid * 1024u;
    const int aoff = lds_byte(wr * 64 + fr, fq * 8), boff = lds_byte(wc * 32 + fr, fq * 8);
#define PG8_SA(b, h) (((b) * 2 + (h)) * HTB)
#define PG8_SB(b, h) ((4 + (b) * 2 + (h)) * HTB)
#define PG8_STAGE(bufoff, gbase, voff) do { _Pragma("unroll") for (int _i = 0; _i < 2; ++_i) \
        __builtin_amdgcn_global_load_lds((const unsigned*)((const char*)(gbase) + (voff)[_i]), (PG8_LAS unsigned*)(lds + (bufoff) + ldsw + _i * 8192), 16, 0, 0); } while (0)
#define PG8_LDA(dst, b, h) do { _Pragma("unroll") for (int m = 0; m < 4; ++m) _Pragma("unroll") for (int k = 0; k < 2; ++k) dst[m][k] = *(const PG8_LAS bf16x8*)(lds + PG8_SA(b, h) + aoff + m * 2048 + k * 1024); } while (0)
#define PG8_LDB(dst, b, h) do { _Pragma("unroll") for (int n = 0; n < 2; ++n) _Pragma("unroll") for (int k = 0; k < 2; ++k) dst[n][k] = *(const PG8_LAS bf16x8*)(lds + PG8_SB(b, h) + boff + n * 2048 + k * 1024); } while (0)
#define PG8_MMA(ai, bj, At, Bt) do { __builtin_amdgcn_s_setprio(1); _Pragma("unroll") for (int m = 0; m < 4; ++m) _Pragma("unroll") for (int n = 0; n < 2; ++n) _Pragma("unroll") for (int k = 0; k < 2; ++k) \
        acc[ai][bj][m][n] = __builtin_amdgcn_mfma_f32_16x16x32_bf16(Bt[n][k], At[m][k], acc[ai][bj][m][n], 0, 0, 0); __builtin_amdgcn_s_setprio(0); } while (0)
#define PG8_WAIT_V(n) asm volatile("s_waitcnt vmcnt(" #n ")" ::: "memory")
#define PG8_WAIT_L(n) asm volatile("s_waitcnt lgkmcnt(" #n ")" ::: "memory")
#define PG8_BAR __builtin_amdgcn_s_barrier()
#define PG8_SCHED __builtin_amdgcn_sched_barrier(0)
    Unit cur, nxt; int ui = 0;
    if (!S.next(0, cur)) return;
    f32x4 acc[2][2][4][2];
#pragma unroll
    for (int a = 0; a < 2; ++a)
#pragma unroll
        for (int b = 0; b < 2; ++b)
#pragma unroll
            for (int m = 0; m < 4; ++m)
#pragma unroll
                for (int n = 0; n < 2; ++n) acc[a][b][m][n] = (f32x4){0.f, 0.f, 0.f, 0.f};
    bf16x8 At[4][2], B0[2][2], B1[2][2];
    const char* cA = (const char*)g.A + (size_t)cur.pm * tstep; const char* cB = (const char*)g.Bt + (size_t)cur.pn * tstep;
    S.a_ready(cur);
    if constexpr (SP2) {
        PG8_STAGE(PG8_SB(0, 0), cB, voffB); PG8_STAGE(PG8_SB(0, 1), cB + hstep, voffB); PG8_STAGE(PG8_SA(0, 0), cA, voffA); PG8_STAGE(PG8_SA(0, 1), cA + hstep, voffA);
        if (wr == 1) PG8_BAR;
        PG8_WAIT_V(2); PG8_BAR;
        PG8_STAGE(PG8_SB(1, 0), cB + kstep, voffB); PG8_STAGE(PG8_SA(1, 0), cA + kstep, voffA); PG8_STAGE(PG8_SB(1, 1), cB + hstep + kstep, voffB);
        PG8_WAIT_V(6); PG8_BAR;
    } else {
        PG8_STAGE(PG8_SB(0, 0), cB, voffB); PG8_STAGE(PG8_SA(0, 0), cA, voffA); PG8_STAGE(PG8_SB(0, 1), cB + hstep, voffB); PG8_STAGE(PG8_SA(0, 1), cA + hstep, voffA);
        if (wr == 1) PG8_BAR;
        PG8_WAIT_V(4); PG8_BAR;
        PG8_STAGE(PG8_SB(1, 0), cB + kstep, voffB); PG8_STAGE(PG8_SA(1, 0), cA + kstep, voffA); PG8_STAGE(PG8_SB(1, 1), cB + hstep + kstep, voffB);
        PG8_WAIT_V(6); PG8_BAR;
    }
    for (;;) {
        const bool has_next = S.next(ui + 1, nxt);
        const char* nA = has_next ? (const char*)g.A + (size_t)nxt.pm * tstep : cA; const char* nB = has_next ? (const char*)g.Bt + (size_t)nxt.pn * tstep : cB;
        for (int t = 0; t < nt; t += 2) {
            const bool last = (t == nt - 2);
            const char* a1 = cA + (size_t)(t + 1) * kstep;
            const char* a2 = last ? nA : cA + (size_t)(t + 2) * kstep; const char* b2 = last ? nB : cB + (size_t)(t + 2) * kstep;
            const char* a3 = a2 + kstep; const char* b3 = b2 + kstep;
            if (last && has_next) S.a_ready(nxt);
            if constexpr (SP2) {
            PG8_LDB(B0, 0, 0); PG8_LDB(B1, 0, 1); PG8_SCHED; PG8_LDA(At, 0, 0); PG8_STAGE(PG8_SA(1, 1), a1 + hstep, voffA);
            PG8_WAIT_V(8); PG8_WAIT_L(0); PG8_BAR; PG8_MMA(0, 0, At, B0); PG8_MMA(0, 1, At, B1); PG8_BAR; PG8_SCHED;
            PG8_LDA(At, 0, 1); PG8_STAGE(PG8_SB(0, 0), b2, voffB); PG8_STAGE(PG8_SB(0, 1), b2 + hstep, voffB); PG8_STAGE(PG8_SA(0, 0), a2, voffA);
            PG8_WAIT_V(8); PG8_WAIT_L(0); PG8_BAR; PG8_MMA(1, 0, At, B0); PG8_MMA(1, 1, At, B1); PG8_BAR; PG8_SCHED;
            PG8_LDB(B0, 1, 0); PG8_LDB(B1, 1, 1); PG8_SCHED; PG8_LDA(At, 1, 0); PG8_STAGE(PG8_SA(0, 1), a2 + hstep, voffA);
            PG8_WAIT_V(8); PG8_WAIT_L(0); PG8_BAR; PG8_MMA(0, 0, At, B0); PG8_MMA(0, 1, At, B1); PG8_BAR; PG8_SCHED;
            PG8_LDA(At, 1, 1); PG8_STAGE(PG8_SB(1, 0), b3, voffB); PG8_STAGE(PG8_SB(1, 1), b3 + hstep, voffB); PG8_STAGE(PG8_SA(1, 0), a3, voffA);
            PG8_WAIT_V(8); PG8_WAIT_L(0); PG8_BAR; PG8_MMA(1, 0, At, B0); PG8_MMA(1, 1, At, B1); PG8_BAR; PG8_SCHED;
            } else {
            PG8_LDB(B0, 0, 0); PG8_SCHED; PG8_LDA(At, 0, 0); PG8_STAGE(PG8_SA(1, 1), a1 + hstep, voffA);
            PG8_WAIT_L(8); PG8_BAR; PG8_WAIT_L(0); PG8_MMA(0, 0, At, B0); PG8_BAR; PG8_SCHED;
            PG8_LDB(B1, 0, 1); PG8_STAGE(PG8_SB(0, 0), b2, voffB);
            PG8_BAR; PG8_WAIT_L(0); PG8_MMA(0, 1, At, B1); PG8_BAR;
            PG8_LDA(At, 0, 1); PG8_STAGE(PG8_SA(0, 0), a2, voffA);
            PG8_BAR; PG8_WAIT_L(0); PG8_MMA(1, 0, At, B0); PG8_BAR; PG8_SCHED;
            PG8_STAGE(PG8_SB(0, 1), b2 + hstep, voffB);
            PG8_WAIT_V(6); PG8_BAR; PG8_MMA(1, 1, At, B1); PG8_BAR;
            PG8_LDB(B0, 1, 0); PG8_SCHED; PG8_LDA(At, 1, 0); PG8_STAGE(PG8_SA(0, 1), a2 + hstep, voffA);
            PG8_WAIT_L(8); PG8_BAR; PG8_WAIT_L(0); PG8_MMA(0, 0, At, B0); PG8_BAR; PG8_SCHED;
            PG8_LDB(B1, 1, 1); PG8_STAGE(PG8_SB(1, 0), b3, voffB);
            PG8_BAR; PG8_WAIT_L(0); PG8_MMA(0, 1, At, B1); PG8_BAR;
            PG8_LDA(At, 1, 1); PG8_STAGE(PG8_SA(1, 0), a3, voffA);
            PG8_BAR; PG8_WAIT_L(0); PG8_MMA(1, 0, At, B0); PG8_BAR; PG8_SCHED;
            PG8_STAGE(PG8_SB(1, 1), b3 + hstep, voffB);
            PG8_WAIT_V(6); PG8_BAR; PG8_MMA(1, 1, At, B1); PG8_BAR;
            }
        }
        if constexpr (ALIGN_EPI) { if (wr == 0) PG8_BAR; }
        if constexpr (!Epi::AFTER_DRAIN) { E(acc, cur, wr, wc, fr, fq); S.done(cur); }
        if (!has_next) break;
#pragma unroll
        for (int a = 0; a < 2; ++a)
#pragma unroll
            for (int b = 0; b < 2; ++b)
#pragma unroll
                for (int m = 0; m < 4; ++m)
#pragma unroll
                    for (int n = 0; n < 2; ++n) acc[a][b][m][n] = (f32x4){0.f, 0.f, 0.f, 0.f};
        cur = nxt; cA = nA; cB = nB; ++ui;
        if constexpr (ALIGN_EPI) { if (wr == 1) PG8_BAR; }
    }
    PG8_WAIT_V(0);
    if constexpr (!ALIGN_EPI) { if (wr == 0) PG8_BAR; }
    PG8_BAR;
    if constexpr (Epi::AFTER_DRAIN) { E.fused(acc, cur, wr, wc, fr, fq, lds, wid, lane); S.done(cur); }
#undef PG8_SA
#undef PG8_SB
#undef PG8_STAGE
#undef PG8_LDA
#undef PG8_LDB
#undef PG8_MMA
#undef PG8_WAIT_V
#undef PG8_WAIT_L
#undef PG8_BAR
#undef PG8_SCHED
}
}
#define XB_TMO      128
#define XB_XCNT(j)  (256  + 64 * (j))
#define XB_XSUB(j)  (1280 + 64 * (j))
#define XB_XGEN(j)  (2304 + 64 * (j))
#define XB_TOP      3328
#define XB_TOPGEN   3392
#define XCD_BAR_WORDS 3456
#define XB_SPIN_CAP (1u << 18)

__device__ __forceinline__ unsigned xb_ld(unsigned* p)              { return __hip_atomic_load(p, __ATOMIC_RELAXED, __HIP_MEMORY_SCOPE_AGENT); }
__device__ __forceinline__ unsigned xb_add(unsigned* p, unsigned v) { return __hip_atomic_fetch_add(p, v, __ATOMIC_RELAXED, __HIP_MEMORY_SCOPE_AGENT); }
__device__ __forceinline__ unsigned xb_xcc_id() { return (unsigned)__builtin_amdgcn_s_getreg((3 << 11) | 20) & 0xFu; }
#define XB_SPIN(cond, bar) do { unsigned _sp = 0; while (cond) { __builtin_amdgcn_s_sleep(1); \
    if ((++_sp & 255u) == 0u) { if (xb_ld(&(bar)[XB_TMO])) break; if (_sp > XB_SPIN_CAP) { atomicAdd(&(bar)[XB_TMO], 1u); break; } } } } while (0)

struct XcdBarrier {
    unsigned* bar; unsigned x;
    volatile LAS unsigned* st;
};

__device__ __forceinline__ XcdBarrier xcd_barrier_post(unsigned* bar, volatile LAS unsigned* st) {
    XcdBarrier b; b.bar = bar; b.x = xb_xcc_id(); b.st = st;
    if (otid() == 0) (void)xb_add(&bar[XB_XCNT(b.x)], 1u);
    return b;
}
__device__ __forceinline__ void xcd_barrier_complete(unsigned* bar, unsigned x, unsigned& nloc, unsigned& nx) {
    asm volatile("" : "+s"(x));
    const unsigned G = ogdim();
    unsigned sum, cnt, mine, sp = 0u;
    for (;;) {
        sum = 0u; cnt = 0u; mine = 0u;
#pragma unroll
        for (unsigned j = 0; j < 16; ++j) { const unsigned c = xb_ld(&bar[XB_XCNT(j)]); sum += c; cnt += (c > 0u) ? 1u : 0u; mine = (j == x) ? c : mine; }
        if (sum == G) break;
        __builtin_amdgcn_s_sleep(1);
        if ((++sp & 255u) == 0u) { if (xb_ld(&bar[XB_TMO])) break; if (sp > XB_SPIN_CAP) { atomicAdd(&bar[XB_TMO], 1u); break; } }
    }
    nloc = mine > 0u ? mine : 1u; nx = cnt > 0u ? cnt : 1u;
}

__device__ __forceinline__ void xcd_barrier(const XcdBarrier& b) {
    asm volatile("s_waitcnt vmcnt(0)" ::: "memory");
    __syncthreads();
    if (otid() == 0) {
        unsigned* bar = b.bar;
        __builtin_amdgcn_s_waitcnt(0);
        unsigned nloc = b.st[0], nx = b.st[1];
        if (nloc == 0u) { xcd_barrier_complete(bar, b.x, nloc, nx); b.st[0] = nloc; b.st[1] = nx; }
        const unsigned old = xb_add(&bar[XB_XSUB(b.x)], 1u);
        const unsigned gen = old / nloc;
        if (old + 1u == (gen + 1u) * nloc) {
            __builtin_amdgcn_fence(__ATOMIC_RELEASE, "agent");
            asm volatile("s_waitcnt vmcnt(0)" ::: "memory");
            const unsigned og = xb_add(&bar[XB_TOP], 1u);
            const unsigned tg = og / nx;
            if (og + 1u == (tg + 1u) * nx) xb_add(&bar[XB_TOPGEN], 1u);
            else XB_SPIN(xb_ld(&bar[XB_TOPGEN]) == tg, bar);
            __builtin_amdgcn_fence(__ATOMIC_ACQUIRE, "agent");
            xb_add(&bar[XB_XGEN(b.x)], 1u);
            asm volatile("s_waitcnt vmcnt(0)" ::: "memory");
        } else {
            XB_SPIN(xb_ld(&bar[XB_XGEN(b.x)]) == gen, bar);
            __builtin_amdgcn_fence(__ATOMIC_ACQUIRE, "agent");
            asm volatile("s_waitcnt vmcnt(0)" ::: "memory");
        }
    }
    __syncthreads();
}

#define FFT_DI DI
struct cpx; template <class P> DI cpx fft_ldc_(P p, int i); template <class P> DI void fft_stc_(P p, int i, const cpx& v);
#define FFT_LDC(p, i) fft_ldc_((p), (i))
#define FFT_STC(p, i, v) fft_stc_((p), (i), (v))
#define FFT_M 16384
#define FFT_NT 512
struct cpx { float x, y; };
#ifdef FFT_LDC
template <class P> FFT_DI cpx fft_ldc_(P p, int i) { const f32x2_t v = *(const decltype(fft_vec2_(p)))(p + 2 * i); cpx r; r.x = v[0]; r.y = v[1]; return r; }
template <class P> FFT_DI void fft_stc_(P p, int i, const cpx& v) { f32x2_t w = {v.x, v.y}; *(decltype(fft_vec2_(p)))(p + 2 * i) = w; }
#endif
#ifndef FFT_LDC
#define FFT_LDC(p, i) ([&]{ cpx r_; r_.x = (p)[2 * (i)]; r_.y = (p)[2 * (i) + 1]; return r_; }())
#define FFT_STC(p, i, v) do { (p)[2 * (i)] = (v).x; (p)[2 * (i) + 1] = (v).y; } while (0)
#endif
FFT_DI cpx cmul(cpx a, cpx b) { cpx r; r.x = a.x * b.x - a.y * b.y; r.y = a.x * b.y + a.y * b.x; return r; }
FFT_DI cpx cmulc(cpx a, cpx b) { cpx r; r.x = a.x * b.x + a.y * b.y; r.y = a.y * b.x - a.x * b.y; return r; }
FFT_DI int rev4_14(int k) {
    int r = 0;
#pragma unroll
    for (int d = 0; d < 7; ++d) { r = (r << 2) | (k & 3); k >>= 2; }
    return r;
}
struct FftTw { cpx c256[3], c64[3], c16[3], c4[3]; };
template <class TP> FFT_DI void fft_load_tw(FftTw& T, TP tw, int tid) {
#pragma unroll
    for (int q = 0; q < 3; ++q) { T.c256[q] = FFT_LDC(tw, (q + 1) * (tid & 255) * 16); T.c64[q] = FFT_LDC(tw, (q + 1) * (tid & 63) * 64); T.c16[q] = FFT_LDC(tw, (q + 1) * (tid & 15) * 256); T.c4[q] = FFT_LDC(tw, (q + 1) * (tid & 3) * 1024); }
}
template <int s, class TP> FFT_DI void fft_pick_tw(const FftTw& T, TP tw, int pos, int j, cpx& w1, cpx& w2, cpx& w3) {
    if (s == 4096) { w1 = FFT_LDC(tw, pos); w2 = FFT_LDC(tw, 2 * pos); w3 = FFT_LDC(tw, 3 * pos); }
    else if (s == 1024) { w1 = FFT_LDC(tw, 4 * pos); w2 = FFT_LDC(tw, 8 * pos); w3 = FFT_LDC(tw, 12 * pos); }
    else if (s == 256) { w1 = T.c256[0]; w2 = T.c256[1]; w3 = T.c256[2]; }
    else if (s == 64) { w1 = T.c64[0]; w2 = T.c64[1]; w3 = T.c64[2]; }
    else if (s == 16) { w1 = T.c16[0]; w2 = T.c16[1]; w3 = T.c16[2]; }
    else if (s == 4) { w1 = T.c4[0]; w2 = T.c4[1]; w3 = T.c4[2]; }
}
template <int s, class LP, class TP> FFT_DI void fft_fwd_pass(LP lds, const FftTw& T, TP tw, int tid) {
    cpx w1, w2, w3;
#pragma unroll 2
    for (int jj = 0; jj < FFT_M / 4 / FFT_NT; ++jj) { const int b = tid + FFT_NT * jj;
        const int pos = b & (s - 1), base = ((b & ~(s - 1)) << 2) + pos;
        const cpx a0 = FFT_LDC(lds, base), a1 = FFT_LDC(lds, base + s), a2 = FFT_LDC(lds, base + 2 * s), a3 = FFT_LDC(lds, base + 3 * s);
        cpx t0, t1, t2, t3;
        t0.x = a0.x + a2.x; t0.y = a0.y + a2.y;
        t1.x = a0.x - a2.x; t1.y = a0.y - a2.y;
        t2.x = a1.x + a3.x; t2.y = a1.y + a3.y;
        t3.x = a1.x - a3.x; t3.y = a1.y - a3.y;
        cpx y0, y1, y2, y3;
        y0.x = t0.x + t2.x; y0.y = t0.y + t2.y;
        y2.x = t0.x - t2.x; y2.y = t0.y - t2.y;
        y1.x = t1.x + t3.y; y1.y = t1.y - t3.x;
        y3.x = t1.x - t3.y; y3.y = t1.y + t3.x;
        if (s > 1) {
            fft_pick_tw<s>(T, tw, pos, jj, w1, w2, w3);
            y1 = cmul(y1, w1); y2 = cmul(y2, w2); y3 = cmul(y3, w3);
        }
        FFT_STC(lds, base, y0); FFT_STC(lds, base + s, y1); FFT_STC(lds, base + 2 * s, y2); FFT_STC(lds, base + 3 * s, y3);
    }
}
template <int s, class LP, class TP> FFT_DI void fft_inv_pass(LP lds, const FftTw& T, TP tw, int tid) {
    cpx w1, w2, w3;
#pragma unroll 2
    for (int jj = 0; jj < FFT_M / 4 / FFT_NT; ++jj) { const int b = tid + FFT_NT * jj;
        const int pos = b & (s - 1), base = ((b & ~(s - 1)) << 2) + pos;
        const cpx b0 = FFT_LDC(lds, base); cpx c1 = FFT_LDC(lds, base + s), c2 = FFT_LDC(lds, base + 2 * s), c3 = FFT_LDC(lds, base + 3 * s);
        if (s > 1) {
            fft_pick_tw<s>(T, tw, pos, jj, w1, w2, w3);
            c1 = cmulc(c1, w1); c2 = cmulc(c2, w2); c3 = cmulc(c3, w3);
        }
        cpx t0, t1, t2, t3;
        t0.x = b0.x + c2.x; t0.y = b0.y + c2.y;
        t1.x = b0.x - c2.x; t1.y = b0.y - c2.y;
        t2.x = c1.x + c3.x; t2.y = c1.y + c3.y;
        t3.x = c1.x - c3.x; t3.y = c1.y - c3.y;
        cpx x0, x1, x2, x3;
        x0.x = t0.x + t2.x; x0.y = t0.y + t2.y;
        x2.x = t0.x - t2.x; x2.y = t0.y - t2.y;
        x1.x = t1.x - t3.y; x1.y = t1.y + t3.x;
        x3.x = t1.x + t3.y; x3.y = t1.y - t3.x;
        FFT_STC(lds, base, x0); FFT_STC(lds, base + s, x1); FFT_STC(lds, base + 2 * s, x2); FFT_STC(lds, base + 3 * s, x3);
    }
}
template <class LP, class TP> FFT_DI void rfft_untangle(LP lds, TP tw2, int k, cpx& Xk, cpx& Xm) {
    if (k == 0) {
        const float zr = lds[0], zi = lds[1];
        Xk.x = zr + zi; Xk.y = zr - zi;
        const int p = rev4_14(FFT_M / 2);
        Xm.x = lds[2 * p]; Xm.y = -lds[2 * p + 1];
        return;
    }
    const int pk = rev4_14(k), pm = rev4_14(FFT_M - k);
    cpx Zk, Zm; Zk.x = lds[2 * pk]; Zk.y = lds[2 * pk + 1]; Zm.x = lds[2 * pm]; Zm.y = lds[2 * pm + 1];
    cpx E, O, W, WO;
    E.x = 0.5f * (Zk.x + Zm.x); E.y = 0.5f * (Zk.y - Zm.y);
    O.x = 0.5f * (Zk.y + Zm.y); O.y = -0.5f * (Zk.x - Zm.x);
    W.x = tw2[2 * k]; W.y = tw2[2 * k + 1];
    WO = cmul(W, O);
    Xk.x = E.x + WO.x; Xk.y = E.y + WO.y;
    Xm.x = E.x - WO.x; Xm.y = -(E.y - WO.y);
}
template <class LP, class TP> FFT_DI void rfft_mul_retangle(LP lds, TP tw2, int k, cpx Gk, cpx Gm) {
    cpx Xk, Xm; rfft_untangle(lds, tw2, k, Xk, Xm);
    if (k == 0) {
        const float y0 = Xk.x * Gk.x, yM = Xk.y * Gk.y;
        lds[0] = 0.5f * (y0 + yM); lds[1] = 0.5f * (y0 - yM);
        const cpx Y = cmul(Xm, Gm);
        const int p = rev4_14(FFT_M / 2);
        lds[2 * p] = Y.x; lds[2 * p + 1] = -Y.y;
        return;
    }
    const cpx Yk = cmul(Xk, Gk), Ym = cmul(Xm, Gm);
    cpx W; W.x = tw2[2 * k]; W.y = tw2[2 * k + 1];
    cpx A, D, T;
    A.x = 0.5f * (Yk.x + Ym.x); A.y = 0.5f * (Yk.y - Ym.y);
    D.x = 0.5f * (Yk.x - Ym.x); D.y = 0.5f * (Yk.y + Ym.y);
    T = cmulc(D, W);
    const int pk = rev4_14(k), pm = rev4_14(FFT_M - k);
    lds[2 * pk] = A.x - T.y; lds[2 * pk + 1] = A.y + T.x;
    cpx Dc; Dc.x = -D.x; Dc.y = D.y;
    const cpx T2 = cmul(W, Dc);
    lds[2 * pm] = A.x + T2.y; lds[2 * pm + 1] = -A.y - T2.x;
}
enum { I_X = 0, I_C, I_CTX, I_CCTX, I_WMOD, I_BMOD, I_NMIXW, I_NFFNW, I_WIN, I_BIN, I_HYCW, I_HYCB, I_HYW1, I_HYB1, I_HYW2, I_HYB2, I_HYW3, I_HYB3, I_HYFREQ, I_HYSKIP,
       I_HGLB, I_HGNW, I_GLWA2, I_GLBA, I_GLNW, I_WBR, I_WOUT, I_WRG, I_BRG, I_WRE, I_BRE, I_WGATE, I_WUP, I_WDOWN, I_FNW, N_IN };
struct Args { const float* in[N_IN]; float* out; unsigned char* ws; int ph_lo, ph_hi; };
#define GAS __attribute__((address_space(1)))
extern __shared__ __attribute__((aligned(16))) unsigned char lds_raw[];
constexpr int LDS_PTAB = 150 * 1024 - 64 - 320;
DI LAS unsigned char* ldsbase() { unsigned p = (unsigned)(unsigned long long)(LAS unsigned char*)lds_raw; asm volatile("" : "+s"(p)); return (LAS unsigned char*)(unsigned long long)p; }
DI const float* ain(const Args&, int i) { const unsigned long long v = ((LAS unsigned long long*)(ldsbase() + LDS_PTAB))[i];
    const unsigned lo = __builtin_amdgcn_readfirstlane((unsigned)v), hi = __builtin_amdgcn_readfirstlane((unsigned)(v >> 32)); return (const float*)(GAS const float*)(((unsigned long long)hi << 32) | lo); }
DI unsigned char* wsp(const Args& a) { unsigned long long p = (unsigned long long)(a).ws; asm volatile("" : "+s"(p)); return (unsigned char*)(GAS unsigned char*)p; }
DI int opq(int x) { asm volatile("" : "+s"(x)); return x; }
#ifdef PROBE_SEL
constexpr int LDS_TIM = 150 * 1024 - 64 - 320 - 512;
#define TIC() const unsigned long long tic_ = __builtin_amdgcn_s_memrealtime()
#define TOC(i) do { if (otid() == 0) ((LAS unsigned long long*)(ldsbase() + LDS_TIM))[i] += __builtin_amdgcn_s_memrealtime() - tic_; } while (0)
#else
#define TIC() do {} while (0)
#define TOC(i) do {} while (0)
#endif
#define LDS_BAR() do { asm volatile("s_waitcnt lgkmcnt(0)" ::: "memory"); __builtin_amdgcn_s_barrier(); asm volatile("" ::: "memory"); } while (0)
constexpr int NTHR = 512;
constexpr int LDS_BYTES = 150 * 1024;
constexpr int LDS_X = 131072;
constexpr int LDS_BARW = LDS_BYTES - 64;

DI int z_srccol(int zc) { return zc < 8192 ? zc : (zc < Z_LR ? zc + 32 : (zc < Z_LR + 32 ? zc - Z_LR + 8192 : -1)); }

template <bool RDONLY = false> DI void cvt_wtile(const float* __restrict__ src, size_t ld, int sc, bf16* __restrict__ dst, int K, int row0, int kb, LAS float* t  ) {
    const int nn = otid() & 63;
    float v[64];
    if (sc >= 0) {
#pragma unroll
        for (int p = 0; p < 64; ++p) v[p] = src[(size_t)(kb * 64 + p) * ld + sc];
    } else {
#pragma unroll
        for (int p = 0; p < 64; ++p) v[p] = 0.f;
    }
    if (RDONLY) { float s = 0.f;
#pragma unroll
        for (int p = 0; p < 64; ++p) s += v[p];
        asm volatile("" :: "v"(s)); return; }
#pragma unroll
    for (int p = 0; p < 64; ++p) t[p * 65 + nn] = v[p];
    asm volatile("s_waitcnt lgkmcnt(0)" ::: "memory");
    const int rsub = nn >> 3, kp = nn & 7;
#pragma unroll
    for (int q = 0; q < 8; ++q) { const int row = q * 8 + rsub; float w[8];
#pragma unroll
        for (int j = 0; j < 8; ++j) w[j] = t[(kp * 8 + j) * 65 + row];
        u32x4 o; o.x = pk_bf16(w[0], w[1]); o.y = pk_bf16(w[2], w[3]); o.z = pk_bf16(w[4], w[5]); o.w = pk_bf16(w[6], w[7]);
        *(u32x4*)(dst + (size_t)(row0 + row) * K + kb * 64 + kp * 8) = o; }
    asm volatile("s_waitcnt lgkmcnt(0)" ::: "memory");
}
constexpr int CVT_MIX_TILES = 276 * 32 + 3 * 32 * 16 + 32 * 32;
DI void cvt_mix_wtile(const Args& a, int l, int it, LAS float* t) {
    const int nn = otid() & 63;
    if (it < 276 * 32) { const int nb = it >> 5, kb = it & 31; cvt_wtile(ain(a, I_WIN) + (size_t)l * D * NCOLS_IN, NCOLS_IN, z_srccol(nb * 64 + nn), (bf16*)(wsp(a) + WS_WIN), D, nb * 64, kb, t); return; }
    it -= 276 * 32;
    if (it < 3 * 32 * 16) { const int br = it / 512, r = it % 512, nb = r >> 4, kb = r & 15;
        cvt_wtile(ain(a, I_WBR) + ((size_t)l * 3 + br) * 1024 * D, D, nb * 64 + nn, (bf16*)(wsp(a) + WS_WBR) + (size_t)br * D * 1024, 1024, nb * 64, kb, t); return; }
    it -= 3 * 32 * 16;
    { const int nb = it >> 5, kb = it & 31; cvt_wtile(ain(a, I_WOUT) + (size_t)l * D * D, D, nb * 64 + nn, (bf16*)(wsp(a) + WS_WOUT), D, nb * 64, kb, t); }
}
constexpr int CVT_MOE_TILES = 32 * 16 * 32 + 32 * 32 * 8;
template <bool RDONLY = false> DI void cvt_moe_wtile(const Args& a, int l, int it, LAS float* t) {
    const int nn = otid() & 63;
    if (it < 32 * 16 * 32) { const int e = it >> 9, r = it & 511, nb = r >> 5, kb = r & 31, nt = nb >> 2, sub = nb & 3;
        const float* src = (sub < 2 ? ain(a, I_WGATE) : ain(a, I_WUP)) + ((size_t)l * NEXP + e) * D * DFF;
        cvt_wtile<RDONLY>(src, DFF, nt * 128 + (sub & 1) * 64 + nn, (bf16*)(wsp(a) + WS_WGU) + (size_t)e * 1024 * D, D, nb * 64, kb, t); return; }
    it -= 32 * 16 * 32;
    { const int e = it >> 8, r = it & 255, nb = r >> 3, kb = r & 7;
      cvt_wtile<RDONLY>(ain(a, I_WDOWN) + ((size_t)l * NEXP + e) * DFF * D, D, nb * 64 + nn, (bf16*)(wsp(a) + WS_WD) + (size_t)e * D * DFF, DFF, nb * 64, kb, t); }
}
template <bool MOE, bool RDONLY = false> DI void cvt_stream(const Args& a, int l, LAS float* ldsf) {
    const int wave = __builtin_amdgcn_readfirstlane(otid() >> 6), n = MOE ? CVT_MOE_TILES : CVT_MIX_TILES, g_ = ogdim(), nw = g_ * 8;
    LAS float* t = ldsf + wave * (64 * 65);
    for (int it = wave * g_ + (int)obid(); it < n; it += nw) { if (MOE) cvt_moe_wtile<RDONLY>(a, l, it, t); else cvt_mix_wtile(a, l, it, t); }
}

DI void mod_item(const Args& a, int j, LAS float* lds) {
    const int tid = otid(), l = j >> 7, col0 = (j & 127) * 96;
    LAS float* sil = lds;
    LAS float* red = lds + 4096;
    for (int k = tid; k < 2 * D; k += NTHR) { const float c = (k < D) ? ain(a, I_C)[k] : ain(a, I_CCTX)[k - D]; sil[k] = siluf_(c); }
    __syncthreads();
    const int cg = tid % 24, rg = tid / 24;
    f32x4 a0 = {0.f, 0.f, 0.f, 0.f}, a1 = {0.f, 0.f, 0.f, 0.f};
    if (rg < 21) {
        const float* w = ain(a, I_WMOD) + (size_t)l * D * 12288 + col0 + cg * 4;
        for (int k = rg; k < D; k += 21) { const f32x4 wv = *(const f32x4*)(w + (size_t)k * 12288); a0 += wv * sil[k]; a1 += wv * sil[D + k]; }
#pragma unroll
        for (int q = 0; q < 4; ++q) { red[(rg * 2 + 0) * 96 + cg * 4 + q] = a0[q]; red[(rg * 2 + 1) * 96 + cg * 4 + q] = a1[q]; }
    }
    __syncthreads();
    if (tid < 192) { const int set = tid / 96, c = tid % 96; float s = 0.f;
        for (int r = 0; r < 21; ++r) s += red[(r * 2 + set) * 96 + c];
        ((float*)(wsp(a) + WS_MOD))[((size_t)l * 2 + set) * 12288 + col0 + c] = s + ain(a, I_BMOD)[(size_t)l * 12288 + col0 + c]; }
    __syncthreads();
}
DI void h2_rows(const Args& a, LAS float* ldsf) {
    const int lane = otid() & 63, wave = __builtin_amdgcn_readfirstlane(otid() >> 6), g_ = ogdim(), nw = g_ * 8, gw = wave * g_ + (int)obid();
    const int l = gw >= nw / 2 ? 1 : 0, w0 = gw - l * (nw / 2), wstep = nw / 2;
    LAS float* fe = ldsf + wave * 128; LAS float* h1 = fe + 64;
    float w1c[33], w2c[64];
    { const float* w1 = ain(a, I_HYW1) + (size_t)l * 33 * 64; const float* w2 = ain(a, I_HYW2) + (size_t)l * 64 * 64;
#pragma unroll
      for (int i = 0; i < 33; ++i) w1c[i] = w1[i * 64 + lane];
#pragma unroll
      for (int i = 0; i < 64; ++i) w2c[i] = w2[i * 64 + lane]; }
    const float b1 = ain(a, I_HYB1)[l * 64 + lane], b2 = ain(a, I_HYB2)[l * 64 + lane], fq_ = ain(a, I_HYFREQ)[l * 64 + lane];
    float* H2 = (float*)(wsp(a) + WS_H2) + (size_t)l * MT * 64; bf16* H2B = (bf16*)(wsp(a) + WS_H2B) + (size_t)l * SEQ * 256;
    for (int r = w0; r < MT; r += wstep) {
        const int Lq = r < SEQ ? SEQ : CTXL, t = r < SEQ ? r : r - SEQ;
        if (lane < 33) { float f;
            if (lane == 0) f = (float)t / (float)(Lq - 1);
            else { const int bi = (lane - 1) & 15; const float band = 1e-4f + (float)bi * ((15.0f - 1e-4f) / 15.0f); const float rev2 = 2.0f * band * (float)t / (float)Lq;
                f = (lane <= 16) ? cospif(rev2) : -sinpif(rev2); }
            fe[lane] = f; }
        asm volatile("s_waitcnt lgkmcnt(0)" ::: "memory");
        float s = b1;
#pragma unroll
        for (int i = 0; i < 33; ++i) s += fe[i] * w1c[i];
        h1[lane] = sinf(fq_ * s);
        asm volatile("s_waitcnt lgkmcnt(0)" ::: "memory");
        float s2 = b2;
#pragma unroll
        for (int i = 0; i < 64; ++i) s2 += h1[i] * w2c[i];
        const float hv = sinf(fq_ * s2);
        H2[(size_t)r * 64 + lane] = hv;
        if (r < SEQ) { bf16* hb = H2B + (size_t)r * 256; hb[lane] = f2bf(hv); hb[64 + lane] = 0; hb[128 + lane] = 0; hb[192 + lane] = 0; }
        asm volatile("s_waitcnt lgkmcnt(0)" ::: "memory");
    }
}
DI void prologue_small(const Args& a) {
    const size_t gt = (size_t)obid() * NTHR + otid(), gs = (size_t)ogdim() * NTHR;
    float* zb = (float*)(wsp(a) + WS_ZBIAS);
    for (size_t i = gt; i < (size_t)DEPTH * ZC; i += gs) { const int l = (int)(i / ZC), zc = (int)(i % ZC), sc = z_srccol(zc); zb[i] = sc >= 0 ? ain(a, I_BIN)[(size_t)l * NCOLS_IN + sc] : 0.f; }
    float* lb = (float*)(wsp(a) + WS_LB);
    for (size_t i = gt; i < (size_t)DEPTH * 2048; i += gs) { const int l = (int)(i / 2048), j = (int)(i % 2048);
        float v = 0.f; if (l == 1) { const float r0 = ain(a, I_HGLB)[j], r1 = ain(a, I_HGLB)[2048 + j]; v = 1.0f / (1.0f + expf(r0 - r1)); }
        lb[i] = v; }
    bf16* w3t = (bf16*)(wsp(a) + WS_W3T);
    for (size_t i = gt; i < (size_t)DEPTH * 2048 * 256; i += gs) { const int l = (int)(i >> 19), fc = (int)((i >> 8) & 2047), j = (int)(i & 255); w3t[i] = j < 64 ? f2bf(ain(a, I_HYW3)[((size_t)l * 64 + j) * 2048 + fc]) : (bf16)0; }
    bf16* wrt = (bf16*)(wsp(a) + WS_WRT);
    for (size_t i = gt; i < (size_t)DEPTH * 48 * 2048; i += gs) { const int l = (int)(i / (48 * 2048)), c = (int)((i / 2048) % 48), k = (int)(i & 2047);
        const float w = c < 4 ? ain(a, I_WRG)[((size_t)l * D + k) * 4 + c] : (c < 36 ? ain(a, I_WRE)[((size_t)l * D + k) * 32 + (c - 4)] : 0.f);
        const bf16 hi = f2bf(w); wrt[((size_t)l * 2 + 0) * 48 * 2048 + (size_t)c * 2048 + k] = hi; wrt[((size_t)l * 2 + 1) * 48 * 2048 + (size_t)c * 2048 + k] = f2bf(w - bf2f(hi)); }
    float* tw = (float*)(wsp(a) + WS_TW);
    for (size_t i = gt; i < 16384; i += gs) { float s, c; sincospif(-2.0f * (float)i / 16384.0f, &s, &c); tw[2 * i] = c; tw[2 * i + 1] = s; }
    float* tw2 = (float*)(wsp(a) + WS_TW2);
    for (size_t i = gt; i <= 8192; i += gs) { float s, c; sincospif(-(float)i / 16384.0f, &s, &c); tw2[2 * i] = c; tw2[2 * i + 1] = s; }
}
DI void hyc_filters(const Args& a, int l) {
    const int lane = otid() & 63, wave = otid() >> 6;
    const float* h2 = (const float*)(wsp(a) + WS_H2) + ((size_t)l * MT + SEQ) * 64;
    const float* w3 = ain(a, I_HYW3) + (size_t)l * 64 * 2048;
    float* hyc = (float*)(wsp(a) + WS_HYC);
    const float a0 = -4.605170186f / 1.5f, a1 = -4.605170186f / 0.3f;
    for (int fc = obid() * 8 + wave; fc < 2048; fc += ogdim() * 8) {
        const int c = fc & 1023; const float delta = fabsf(a0 + (float)c * ((a1 - a0) / 1023.0f)); const float b3 = ain(a, I_HYB3)[l * 2048 + fc];
        float hv[4], ssum = 0.f;
#pragma unroll
        for (int i = 0; i < 4; ++i) { const int t = lane + 64 * i; float s = b3;
            for (int j = 0; j < 64; ++j) s += h2[t * 64 + j] * w3[j * 2048 + fc];
            const float tl = (float)t / 255.0f; hv[i] = s * (expf(-tl * delta) + 0.05f); ssum += fabsf(hv[i]); }
        ssum = wave_sum(ssum); const float inv = 1.0f / ssum;
#pragma unroll
        for (int i = 0; i < 4; ++i) hyc[(size_t)fc * 256 + lane + 64 * i] = hv[i] * inv;
    }
}
template <int MODE, bool DRY = false> DI void norm_phase(const Args& a, int l, int nrows, LAS float* ldsf) {
    const int lane = otid() & 63, wave = otid() >> 6;
    float* H = (float*)(wsp(a) + WS_H); bf16* U = (bf16*)(wsp(a) + WS_U);
    const float* modall = (const float*)(wsp(a) + WS_MOD);
    int* route = (int*)(wsp(a) + WS_ROUTE);
    const bf16* YP = (const bf16*)(wsp(a) + WS_YP);
    const bool combine = (MODE == 0 && l > 0) || MODE == 2;
    for (int r = obid() * 8 + wave; r < nrows; r += ogdim() * 8) {
        const int set = r >= SEQ ? 1 : 0;
        const float* src = (MODE == 0 && l == 0) ? (set ? ain(a, I_CTX) + (size_t)(r - SEQ) * D : ain(a, I_X) + (size_t)r * D) : H + (size_t)r * D;
        f32x4 v[8];
#pragma unroll
        for (int j = 0; j < 8; ++j) v[j] = *(const f32x4*)(src + j * 256 + lane * 4);
        if (combine) {
            const float* gt2 = modall + ((size_t)(l - 1) * 2 + set) * 12288 + 10240;
            const int p0 = route[r * 8 + 6], p1 = route[r * 8 + 7];
#pragma unroll
            for (int j = 0; j < 8; ++j) { const int col = j * 256 + lane * 4;
                const u32x2 y0 = *(const u32x2*)(YP + (size_t)p0 * D + col), y1 = *(const u32x2*)(YP + (size_t)p1 * D + col); const f32x4 g = *(const f32x4*)(gt2 + col);
                v[j][0] += g[0] * (bflo(y0.x) + bflo(y1.x)); v[j][1] += g[1] * (bfhi(y0.x) + bfhi(y1.x)); v[j][2] += g[2] * (bflo(y0.y) + bflo(y1.y)); v[j][3] += g[3] * (bfhi(y0.y) + bfhi(y1.y)); }
            if (MODE == 0) {
#pragma unroll
                for (int j = 0; j < 8; ++j) *(f32x4*)(H + (size_t)r * D + j * 256 + lane * 4) = v[j];
            }
        }
        float ss = 0.f;
#pragma unroll
        for (int j = 0; j < 8; ++j) ss += (v[j][0] * v[j][0] + v[j][1] * v[j][1]) + (v[j][2] * v[j][2] + v[j][3] * v[j][3]);
        ss = wave_sum(ss);
        const float rstd = rsqrtf(ss * (1.0f / D) + NORM_EPS);
        if (MODE == 2) {
            const float* fw = ain(a, I_FNW);
#ifdef PROBE_SEL
            const float pscale = 1.0f + 0.5f * (float)((LAS unsigned long long*)(ldsbase() + LDS_TIM))[PROBE_SEL] / (float)((LAS unsigned long long*)(ldsbase() + LDS_TIM))[0];
#else
            const float pscale = 1.0f;
#endif
#pragma unroll
            for (int j = 0; j < 8; ++j) { const int col = j * 256 + lane * 4; const f32x4 w = *(const f32x4*)(fw + col); *(f32x4*)(a.out + (size_t)r * D + col) = v[j] * rstd * w * pscale; }
        } else {
            const float* nw = (MODE == 0 ? ain(a, I_NMIXW) : ain(a, I_NFFNW)) + (size_t)l * D;
            const float* md = modall + ((size_t)l * 2 + set) * 12288 + (MODE == 0 ? 0 : 6144);
#pragma unroll
            for (int j = 0; j < 8; ++j) { const int col = j * 256 + lane * 4; const f32x4 w = *(const f32x4*)(nw + col), sh = *(const f32x4*)(md + col), sc = *(const f32x4*)(md + 2048 + col);
                v[j] = (v[j] * rstd * w) * (sc + 1.0f) + sh;
                u32x2 o; o.x = pk_bf16(v[j][0], v[j][1]); o.y = pk_bf16(v[j][2], v[j][3]); *(u32x2*)(U + (size_t)r * D + col) = o; }
            if (MODE == 1) {
                const float* wrg = ain(a, I_WRG) + (size_t)l * D * 4; const float* wre = ain(a, I_WRE) + (size_t)l * D * 32;
                float lg[36];
#pragma unroll
                for (int i = 0; i < 36; ++i) lg[i] = 0.f;
                LAS float* wu = ldsf + wave * 2048;
#pragma unroll
                for (int j = 0; j < 8; ++j) *(LAS f32x4*)(wu + j * 256 + lane * 4) = v[j];
                asm volatile("s_waitcnt lgkmcnt(0)" ::: "memory");
#pragma unroll 2
                for (int cc = 0; cc < 32; ++cc) { const int col = cc * 64 + lane; const float uv = wu[col];
                    const f32x4 g = *(const f32x4*)(wrg + (size_t)col * 4);
                    lg[0] += uv * g[0]; lg[1] += uv * g[1]; lg[2] += uv * g[2]; lg[3] += uv * g[3];
#pragma unroll
                    for (int e4 = 0; e4 < 8; ++e4) { const f32x4 w = *(const f32x4*)(wre + (size_t)col * 32 + e4 * 4);
                        lg[4 + e4 * 4 + 0] += uv * w[0]; lg[4 + e4 * 4 + 1] += uv * w[1]; lg[4 + e4 * 4 + 2] += uv * w[2]; lg[4 + e4 * 4 + 3] += uv * w[3]; } }
                asm volatile("s_waitcnt lgkmcnt(0)" ::: "memory");
#pragma unroll
                for (int i = 0; i < 36; ++i) lg[i] = wave_sum(lg[i]);
                float gl[4]; int grp = 0; float gmax;
#pragma unroll
                for (int g = 0; g < 4; ++g) gl[g] = lg[g] + ain(a, I_BRG)[l * 4 + g];
                gmax = gl[0];
#pragma unroll
                for (int g = 1; g < 4; ++g) if (gl[g] > gmax) { gmax = gl[g]; grp = g; }
                float gden = 0.f;
#pragma unroll
                for (int g = 0; g < 4; ++g) gden += expf(gl[g] - gmax);
                const float ptop = 1.0f / gden;
                float le[8];
#pragma unroll
                for (int i = 0; i < 8; ++i) { float x = lg[4 + i];
#pragma unroll
                    for (int g = 1; g < 4; ++g) x = (grp == g) ? lg[4 + g * 8 + i] : x;
                    le[i] = x + ain(a, I_BRE)[l * 32 + grp * 8 + i]; }
                int i0 = 0; float m0 = le[0];
#pragma unroll
                for (int i = 1; i < 8; ++i) if (le[i] > m0) { m0 = le[i]; i0 = i; }
                int i1 = -1; float m1 = -3.0e38f;
#pragma unroll
                for (int i = 0; i < 8; ++i) if (i != i0 && le[i] > m1) { m1 = le[i]; i1 = i; }
                const float e1v = expf(m1 - m0);
                const float w0 = ptop / (1.0f + e1v), w1 = ptop * e1v / (1.0f + e1v);
                if (DRY) { asm volatile("" :: "v"(w0), "v"(w1), "v"(i0), "v"(i1), "v"(grp)); }
                else if (lane == 0) {
                    unsigned* cnt = (unsigned*)(wsp(a) + WS_CTL) + CW_CNT + l * 2048;
                    const int ex0 = grp * 8 + i0, ex1 = grp * 8 + i1;
                    const unsigned s0 = atomicAdd(cnt + ex0 * 64, 1u), s1 = atomicAdd(cnt + ex1 * 64, 1u);
                    route[r * 8 + 0] = ex0; route[r * 8 + 1] = ex1; route[r * 8 + 2] = (int)s0; route[r * 8 + 3] = (int)s1;
                    route[r * 8 + 4] = __float_as_int(w0); route[r * 8 + 5] = __float_as_int(w1);
                }
            }
        }
    }
}
typedef short bf16x8r_t __attribute__((ext_vector_type(8)));
template <bool DRY> DI void route_phase(const Args& a, int l, int nrows, LAS float* ldsf, int pv = 0) {
    const int lane = otid() & 63, wave = __builtin_amdgcn_readfirstlane(otid() >> 6), fr = lane & 15, fq = lane >> 4, slot = wave & 3, half = wave >> 2;
    const float* H = (const float*)(wsp(a) + WS_H); bf16* U = (bf16*)(wsp(a) + WS_U); int* route = (int*)(wsp(a) + WS_ROUTE);
    const float* nw = ain(a, I_NFFNW) + (size_t)l * D;
    const bf16* Wh = (const bf16*)(wsp(a) + WS_WRT) + (size_t)l * 2 * 48 * 2048; const bf16* Wl = Wh + 48 * 2048;
    LAS float* lt = ldsf + 128 + (slot * 2 + half) * 768;
    const int G = ogdim(), bidv = obid(), ntile4 = nrows / 64;
    for (int it4 = bidv; it4 < ntile4; it4 += G) {
#pragma unroll 2
        for (int rr = 0; rr < ((pv & 2) ? 0 : 8); ++rr) { const int r = it4 * 64 + wave * 8 + rr, set = r >= SEQ ? 1 : 0;
            const float* md = (const float*)(wsp(a) + WS_MOD) + ((size_t)l * 2 + set) * 12288 + 6144;
            f32x4 v[8];
#pragma unroll
            for (int j = 0; j < 8; ++j) v[j] = *(const f32x4*)(H + (size_t)r * D + j * 256 + lane * 4);
            float ss = 0.f;
#pragma unroll
            for (int j = 0; j < 8; ++j) ss += (v[j][0] * v[j][0] + v[j][1] * v[j][1]) + (v[j][2] * v[j][2] + v[j][3] * v[j][3]);
            ss = wave_sum(ss);
            const float rstd = rsqrtf(ss * (1.0f / D) + NORM_EPS);
#pragma unroll
            for (int j = 0; j < 8; ++j) { const int col = j * 256 + lane * 4; const f32x4 w = *(const f32x4*)(nw + col), sh = *(const f32x4*)(md + col), sc = *(const f32x4*)(md + 2048 + col);
                const f32x4 u = (v[j] * rstd * w) * (sc + 1.0f) + sh; u32x2 o; o.x = pk_bf16(u[0], u[1]); o.y = pk_bf16(u[2], u[3]); *(u32x2*)(U + (size_t)r * D + col) = o; } }
        __syncthreads();
        const int tile = it4 * 4 + slot, row = tile * 16 + fr, ks0 = half * 32;
        const bf16* ur = U + (size_t)row * D + fq * 8;
        f32x4 acc[3];
#pragma unroll
        for (int cb = 0; cb < 3; ++cb) acc[cb] = (f32x4){0.f, 0.f, 0.f, 0.f};
#pragma unroll 8
        for (int ks = ks0; ks < ((pv & 4) ? ks0 : ks0 + 32); ++ks) { const int c0 = ks * 32;
            const bf16x8r_t ah = *(const bf16x8r_t*)(ur + c0);
#pragma unroll
            for (int cb = 0; cb < 3; ++cb) { const bf16x8r_t bh = *(const bf16x8r_t*)(Wh + (size_t)(cb * 16 + fr) * 2048 + c0 + fq * 8), bl = *(const bf16x8r_t*)(Wl + (size_t)(cb * 16 + fr) * 2048 + c0 + fq * 8);
                acc[cb] = __builtin_amdgcn_mfma_f32_16x16x32_bf16(ah, bh, acc[cb], 0, 0, 0); acc[cb] = __builtin_amdgcn_mfma_f32_16x16x32_bf16(ah, bl, acc[cb], 0, 0, 0); } }
#pragma unroll
        for (int cb = 0; cb < 3; ++cb)
#pragma unroll
            for (int j = 0; j < 4; ++j) lt[(fq * 4 + j) * 48 + cb * 16 + fr] = acc[cb][j];
        __syncthreads();
        if (half == 0 && lane < 16) {
            const int r = tile * 16 + lane; float lg[36]; LAS float* l0 = ldsf + 128 + (slot * 2) * 768 + lane * 48; LAS float* l1 = l0 + 768;
#pragma unroll
            for (int i = 0; i < 36; ++i) lg[i] = l0[i] + l1[i];
            float gl[4]; int grp = 0; float gmax;
#pragma unroll
            for (int g = 0; g < 4; ++g) gl[g] = lg[g] + ain(a, I_BRG)[l * 4 + g];
            gmax = gl[0];
#pragma unroll
            for (int g = 1; g < 4; ++g) if (gl[g] > gmax) { gmax = gl[g]; grp = g; }
            float gden = 0.f;
#pragma unroll
            for (int g = 0; g < 4; ++g) gden += expf(gl[g] - gmax);
            const float ptop = 1.0f / gden;
            float le[8];
#pragma unroll
            for (int i = 0; i < 8; ++i) { float x = lg[4 + i];
#pragma unroll
                for (int g = 1; g < 4; ++g) x = (grp == g) ? lg[4 + g * 8 + i] : x;
                le[i] = x + ain(a, I_BRE)[l * 32 + grp * 8 + i]; }
            int i0 = 0; float m0 = le[0];
#pragma unroll
            for (int i = 1; i < 8; ++i) if (le[i] > m0) { m0 = le[i]; i0 = i; }
            int i1 = -1; float m1 = -3.0e38f;
#pragma unroll
            for (int i = 0; i < 8; ++i) if (i != i0 && le[i] > m1) { m1 = le[i]; i1 = i; }
            const float e1v = expf(m1 - m0);
            const float w0 = ptop / (1.0f + e1v), w1 = ptop * e1v / (1.0f + e1v);
            if (DRY || (pv & 1)) { asm volatile("" :: "v"(w0), "v"(w1), "v"(i0), "v"(i1), "v"(grp)); }
            else { unsigned* cnt = (unsigned*)(wsp(a) + WS_CTL) + CW_CNT + l * 2048; const int ex0 = grp * 8 + i0, ex1 = grp * 8 + i1;
                const unsigned s0 = atomicAdd(cnt + ex0 * 64, 1u), s1 = atomicAdd(cnt + ex1 * 64, 1u);
                route[r * 8 + 0] = ex0; route[r * 8 + 1] = ex1; route[r * 8 + 2] = (int)s0; route[r * 8 + 3] = (int)s1; route[r * 8 + 4] = __float_as_int(w0); route[r * 8 + 5] = __float_as_int(w1); }
        }
        __syncthreads();
    }
}
DI void permute_phase(const Args& a, int l, int nrows, LAS unsigned char* ldsb) {
    LAS int* poff = (LAS int*)ldsb;
    const int tid = otid(), lane = tid & 63, wave = tid >> 6;
    const unsigned* cnt = (const unsigned*)(wsp(a) + WS_CTL) + CW_CNT + l * 2048;
    if (tid == 0) { int off = 0; for (int e = 0; e < NEXP; ++e) { poff[e] = off; off += (int)((cnt[e * 64] + 255u) / 256u) * 256; } poff[32] = off; }
    __syncthreads();
    if (obid() == 0) { int* tile_e = (int*)(wsp(a) + WS_TILEE); const int nt = poff[32] >> 8;
        if (tid < 200) { int e = -1; if (tid < nt) { for (int q = 0; q < NEXP; ++q) if (poff[q] <= tid * 256) e = q; } tile_e[tid] = e < 0 ? 0 : e; }
        if (tid == 0) tile_e[200] = nt; }
    int* route = (int*)(wsp(a) + WS_ROUTE); float* roww = (float*)(wsp(a) + WS_ROWW);
    const bf16* U = (const bf16*)(wsp(a) + WS_U); bf16* XP = (bf16*)(wsp(a) + WS_XP);
    for (int r = obid() * 8 + wave; r < nrows; r += ogdim() * 8) {
        const int e0 = route[r * 8 + 0], e1 = route[r * 8 + 1], s0 = route[r * 8 + 2], s1 = route[r * 8 + 3];
        const int p0 = poff[e0] + s0, p1 = poff[e1] + s1;
        u32x4 x[4];
#pragma unroll
        for (int i = 0; i < 4; ++i) x[i] = *(const u32x4*)(U + (size_t)r * D + (i * 64 + lane) * 8);
#pragma unroll
        for (int i = 0; i < 4; ++i) { *(u32x4*)(XP + (size_t)p0 * D + (i * 64 + lane) * 8) = x[i]; *(u32x4*)(XP + (size_t)p1 * D + (i * 64 + lane) * 8) = x[i]; }
        if (lane == 0) { route[r * 8 + 6] = p0; route[r * 8 + 7] = p1; roww[p0] = __int_as_float(route[r * 8 + 4]); roww[p1] = __int_as_float(route[r * 8 + 5]); }
    }
}
DI int stream_row(int p, int dir) { return dir == 0 ? (p < CTXL ? SEQ + p : p - CTXL) : (p < CTXL ? SEQ + (CTXL - 1 - p) : (SEQ - 1) - (p - CTXL)); }

DI void unpack8(const u32x4& p, float (&v)[8]) { v[0] = bflo(p.x); v[1] = bfhi(p.x); v[2] = bflo(p.y); v[3] = bfhi(p.y); v[4] = bflo(p.z); v[5] = bfhi(p.z); v[6] = bflo(p.w); v[7] = bfhi(p.w); }
DI void shortconv_w8(const bf16* Z, const float* cw, const float* cb, int l, int seg, int c0, int r0, int lo, int hi, int lane, float (&out)[8]) {
    const int col = Z_HY + seg * 1024 + c0; float zc[8], zp[8], zn[8];
    unpack8(*(const u32x4*)(Z + (size_t)(r0 + lane) * ZC + col), zc);
    float ep[8], en[8];
    if (r0 - 1 >= lo) unpack8(*(const u32x4*)(Z + (size_t)(r0 - 1) * ZC + col), ep); else {
#pragma unroll
        for (int q = 0; q < 8; ++q) ep[q] = 0.f; }
    if (r0 + 64 < hi) unpack8(*(const u32x4*)(Z + (size_t)(r0 + 64) * ZC + col), en); else {
#pragma unroll
        for (int q = 0; q < 8; ++q) en[q] = 0.f; }
#pragma unroll
    for (int q = 0; q < 8; ++q) { const float up = __shfl_up(zc[q], 1), dn = __shfl_down(zc[q], 1); zp[q] = lane == 0 ? ep[q] : up; zn[q] = lane == 63 ? en[q] : dn; }
    const float* w = cw + (size_t)l * 3 * 3072 + seg * 1024 + c0; const float* bb = cb + (size_t)l * 3072 + seg * 1024 + c0;
    const f32x4 w0a = *(const f32x4*)w, w0b = *(const f32x4*)(w + 4), w1a = *(const f32x4*)(w + 3072), w1b = *(const f32x4*)(w + 3072 + 4), w2a = *(const f32x4*)(w + 6144), w2b = *(const f32x4*)(w + 6144 + 4), ba = *(const f32x4*)bb, b4 = *(const f32x4*)(bb + 4);
#pragma unroll
    for (int q = 0; q < 4; ++q) { out[q] = w0a[q] * zp[q] + w1a[q] * zc[q] + w2a[q] * zn[q] + ba[q]; out[4 + q] = w0b[q] * zp[4 + q] + w1b[q] * zc[4 + q] + w2b[q] * zn[4 + q] + b4[q]; }
}
DI void hyprep_witem(const Args& a, int l, int it) {
    const int lane = otid() & 63, tb = it >> 7, c0 = (it & 127) * 8, r0 = tb * 64, lo = r0 < SEQ ? 0 : SEQ, hi = r0 < SEQ ? SEQ : MT;
    const bf16* Z = (const bf16*)(wsp(a) + WS_Z); bf16* VXT = (bf16*)(wsp(a) + WS_U);
    float x1[8], vv[8];
    shortconv_w8(Z, ain(a, I_HYCW), ain(a, I_HYCB), l, 1, c0, r0, lo, hi, lane, x1); shortconv_w8(Z, ain(a, I_HYCW), ain(a, I_HYCB), l, 2, c0, r0, lo, hi, lane, vv);
#pragma unroll
    for (int q = 0; q < 8; ++q) VXT[(size_t)(c0 + q) * MT + r0 + lane] = f2bf(vv[q] * x1[q]);
}
DI void hycomb_witem(const Args& a, int l, int it) {
    const int lane = otid() & 63, tb = it >> 7, c0 = (it & 127) * 8, r0 = tb * 64, lo = r0 < SEQ ? 0 : SEQ, hi = r0 < SEQ ? SEQ : MT;
    const bf16* Z = (const bf16*)(wsp(a) + WS_Z); const bf16* CV = (const bf16*)(wsp(a) + WS_CVO); bf16* Y0 = (bf16*)(wsp(a) + WS_YMIX);
    float x0[8], y[8];
#pragma unroll
    for (int q = 0; q < 8; ++q) y[q] = bf2f(CV[(size_t)(c0 + q) * MT + r0 + lane]);
    shortconv_w8(Z, ain(a, I_HYCW), ain(a, I_HYCB), l, 0, c0, r0, lo, hi, lane, x0);
    u32x4 w; w.x = pk_bf16(y[0] * x0[0], y[1] * x0[1]); w.y = pk_bf16(y[2] * x0[2], y[3] * x0[3]); w.z = pk_bf16(y[4] * x0[4], y[5] * x0[5]); w.w = pk_bf16(y[6] * x0[6], y[7] * x0[7]);
    *(u32x4*)(Y0 + (size_t)(r0 + lane) * 1024 + c0) = w;
}
DI void scancomb_rows(const Args& a, int l, int nrows) {
    const int lane = otid() & 63, wave = otid() >> 6;
    const bf16* Z = (const bf16*)(wsp(a) + WS_Z); const bf16* O = (const bf16*)(wsp(a) + WS_OSC);
    bf16* Y1 = (bf16*)(wsp(a) + WS_YMIX) + (size_t)MT * 1024; bf16* Y2 = Y1 + (size_t)MT * 1024;
    const float* hnw = ain(a, I_HGNW) + (size_t)l * 128; const float* gnw = ain(a, I_GLNW) + (size_t)l * 256;
    for (int r = obid() * 8 + wave; r < nrows; r += ogdim() * 8) {
#pragma unroll
        for (int i = 0; i < 2; ++i) { const int col = i * 512 + lane * 8;
            { float of[8], ob[8], g[8], o[8]; unpack8(*(const u32x4*)(O + (size_t)r * 1024 + col), of); unpack8(*(const u32x4*)(O + ((size_t)MT + r) * 1024 + col), ob); unpack8(*(const u32x4*)(Z + (size_t)r * ZC + Z_HG + 4096 + col), g);
              float ss = 0.f;
#pragma unroll
              for (int q = 0; q < 8; ++q) { o[q] = of[q] + ob[q]; ss += o[q] * o[q]; }
              ss += __shfl_xor(ss, 8); ss += __shfl_xor(ss, 4); ss += __shfl_xor(ss, 2); ss += __shfl_xor(ss, 1);
              const float rstd = rsqrtf(ss * (1.0f / 128.0f) + NORM_EPS);
              const f32x4 n0 = *(const f32x4*)(hnw + (col & 127)), n1 = *(const f32x4*)(hnw + (col & 127) + 4);
              u32x4 w; w.x = pk_bf16(o[0] * rstd * n0[0] * sigmoidf_(g[0]), o[1] * rstd * n0[1] * sigmoidf_(g[1])); w.y = pk_bf16(o[2] * rstd * n0[2] * sigmoidf_(g[2]), o[3] * rstd * n0[3] * sigmoidf_(g[3]));
              w.z = pk_bf16(o[4] * rstd * n1[0] * sigmoidf_(g[4]), o[5] * rstd * n1[1] * sigmoidf_(g[5])); w.w = pk_bf16(o[6] * rstd * n1[2] * sigmoidf_(g[6]), o[7] * rstd * n1[3] * sigmoidf_(g[7]));
              *(u32x4*)(Y1 + (size_t)r * 1024 + col) = w; }
            { float of[8], ob[8], g[8], o[8]; unpack8(*(const u32x4*)(O + ((size_t)2 * MT + r) * 1024 + col), of); unpack8(*(const u32x4*)(O + ((size_t)3 * MT + r) * 1024 + col), ob); unpack8(*(const u32x4*)(Z + (size_t)r * ZC + Z_GL + 2048 + col), g);
              float ss = 0.f;
#pragma unroll
              for (int q = 0; q < 8; ++q) { o[q] = of[q] + ob[q]; ss += o[q] * o[q]; }
              ss += __shfl_xor(ss, 16); ss += __shfl_xor(ss, 8); ss += __shfl_xor(ss, 4); ss += __shfl_xor(ss, 2); ss += __shfl_xor(ss, 1);
              const float rstd = rsqrtf(ss * (1.0f / 256.0f) + NORM_EPS);
              const f32x4 n0 = *(const f32x4*)(gnw + (col & 255)), n1 = *(const f32x4*)(gnw + (col & 255) + 4);
              u32x4 w; w.x = pk_bf16(o[0] * rstd * n0[0] * siluf_(g[0]), o[1] * rstd * n0[1] * siluf_(g[1])); w.y = pk_bf16(o[2] * rstd * n0[2] * siluf_(g[2]), o[3] * rstd * n0[3] * siluf_(g[3]));
              w.z = pk_bf16(o[4] * rstd * n1[0] * siluf_(g[4]), o[5] * rstd * n1[1] * siluf_(g[5])); w.w = pk_bf16(o[6] * rstd * n1[2] * siluf_(g[6]), o[7] * rstd * n1[3] * siluf_(g[7]));
              *(u32x4*)(Y2 + (size_t)r * 1024 + col) = w; }
        }
    }
}
typedef short bf16x8_t __attribute__((ext_vector_type(8)));
constexpr int SC_N = 65;
constexpr size_t KVS_GL_OFF = (size_t)16 * SC_N * 16384;
constexpr size_t WS_KVS = WS_WGU;
constexpr size_t WS_KD  = WS_WGU + 130 * MiB;
constexpr int SL_QM = 0, SL_KM = 17408, SL_Q0 = 34816, SL_KE = 52224, SL_VT = 70656, SL_PP = 107520, SL_TOT = 116736, SL_DD = 118784, SL_AFB = 119296, SL_EB = 121344, SL_BUF2 = SL_VT + 18432;
static_assert(SL_EB + 512 <= 131072 && WS_KD + (size_t)24 * SC_N * 128 * 4 <= WS_H, "scan maps");
DI bf16x8_t lds_frag16(LAS unsigned char* p) { return *(LAS bf16x8_t*)p; }
DI bf16x8_t pack_bf16x8(const f32x4& lo, const f32x4& hi) { u32x4 w; w.x = pk_bf16(lo[0], lo[1]); w.y = pk_bf16(lo[2], lo[3]); w.z = pk_bf16(hi[0], hi[1]); w.w = pk_bf16(hi[2], hi[3]); return __builtin_bit_cast(bf16x8_t, w); }

template <bool GLA, bool OUT> DI void scan_walk(const Args& a, int l, int head, int dir, int sc, int dvh, LAS unsigned char* lds, int pv = 0) {
    constexpr int NB = 1, DV = GLA ? 256 : 128;
    const int tid = otid(), lane = tid & 63, wave = tid >> 6, fr = lane & 15, fq = lane >> 4, nbase = dvh * 8 + wave;
    const bf16* Z = (const bf16*)(wsp(a) + WS_Z);
    const int stream = GLA ? 16 + head * 2 + dir : head * 2 + dir;
    float* kvs = (float*)(wsp(a) + WS_KVS) + (GLA ? KVS_GL_OFF + ((size_t)(stream - 16) * SC_N + sc) * 32768 : ((size_t)stream * SC_N + sc) * 16384);
    float* kd = (float*)(wsp(a) + WS_KD) + ((size_t)stream * SC_N + sc) * 128;
    LAS bf16* QM = (LAS bf16*)(lds + SL_QM); LAS bf16* KM = (LAS bf16*)(lds + SL_KM); LAS float* EB = (LAS float*)(lds + SL_EB); LAS bf16* XG = (LAS bf16*)(lds + SL_Q0);
    LAS bf16* KE = (LAS bf16*)(lds + SL_KE); LAS bf16* VT = (LAS bf16*)(lds + SL_VT); LAS bf16* PP = (LAS bf16*)(lds + SL_PP);
    LAS float* TOT = (LAS float*)(lds + SL_TOT); LAS float* DD = (LAS float*)(lds + SL_DD); LAS bf16* AFB = (LAS bf16*)(lds + SL_AFB);
    const int k = wave * 16 + fr, seg = fq;
    float lbv = 0.f, bag = 0.f; bf16x8_t Bg = {0, 0, 0, 0, 0, 0, 0, 0};
    if (!GLA) lbv = ((const float*)(wsp(a) + WS_LB))[((size_t)l * 2 + dir) * 1024 + head * 128 + k];
    else {
        bag = ain(a, I_GLBA)[((size_t)l * 2 + dir) * 512 + head * 128 + wave * 16 + fr];
        if (fq < 2) { const float* wp = ain(a, I_GLWA2) + (((size_t)l * 2 + dir) * 16 + fq * 8) * 512 + head * 128 + wave * 16 + fr; float w8[8];
#pragma unroll
            for (int j = 0; j < 8; ++j) w8[j] = wp[(size_t)j * 512];
            u32x4 pw; pw.x = pk_bf16(w8[0], w8[1]); pw.y = pk_bf16(w8[2], w8[3]); pw.z = pk_bf16(w8[4], w8[5]); pw.w = pk_bf16(w8[6], w8[7]); Bg = __builtin_bit_cast(bf16x8_t, pw); } }
    f32x4 S[NB][8];
#pragma unroll
    for (int nb = 0; nb < NB; ++nb)
#pragma unroll
        for (int mb = 0; mb < 8; ++mb) { if (OUT) S[nb][mb] = *(const f32x4*)(kvs + ((size_t)((nbase + nb) * 8 + mb) * 64 + lane) * 4); else S[nb][mb] = (f32x4){0.f, 0.f, 0.f, 0.f}; }
    float dlog = 0.f;
    const int which = (GLA ? 2 : 0) + dir;
    bf16* Odir = (bf16*)(wsp(a) + WS_OSC) + (size_t)which * MT * 1024;
    const int srow = tid >> 3, spc = (tid & 7) * 16;
    const int vcol = (GLA ? Z_GL + 1024 + head * 256 + dvh * 128 : Z_HG + 3072 + head * 128) + spc;
    const int fcol = (GLA ? Z_GL + 512 + head * 128 : Z_HG + 1024 * (1 + dir) + head * 128) + spc, qcol = (GLA ? Z_GL + head * 128 : Z_HG + head * 128) + spc;
    u32x4 pv0, pv1, pf0, pf1, pq0 = {0u, 0u, 0u, 0u}, pq1 = {0u, 0u, 0u, 0u}, pa = {0u, 0u, 0u, 0u};
#define SCAN_ISSUE(cidx) do { const int r0n_ = dir ? stream_row((cidx) * 64 + 63, 1) : stream_row((cidx) * 64, 0); \
        const bf16* zr_ = Z + (size_t)(r0n_ + srow) * ZC; pv0 = *(const u32x4*)(zr_ + vcol); pv1 = *(const u32x4*)(zr_ + vcol + 8); \
        pf0 = *(const u32x4*)(zr_ + fcol); pf1 = *(const u32x4*)(zr_ + fcol + 8); \
        if (OUT) { pq0 = *(const u32x4*)(zr_ + qcol); pq1 = *(const u32x4*)(zr_ + qcol + 8); } \
        if (GLA && tid < 128) pa = *(const u32x4*)(Z + (size_t)(r0n_ + (tid >> 1)) * ZC + Z_LR + dir * 16 + (tid & 1) * 8); } while (0)
    SCAN_ISSUE(sc * 4);
    for (int cc = 0; cc < 4; ++cc) {
        const int qmoff = (OUT && (cc & 1)) ? SL_BUF2 : SL_QM, vtoff = (!OUT && (cc & 1)) ? SL_BUF2 : SL_VT;
        LAS bf16* QMc = (LAS bf16*)(lds + qmoff); LAS bf16* VTc = (LAS bf16*)(lds + vtoff);
        const int c = sc * 4 + cc; const int r0 = dir ? stream_row(c * 64 + 63, 1) : stream_row(c * 64, 0);
        {
          *(LAS u32x4*)(VTc + srow * 136 + spc) = pv0; *(LAS u32x4*)(VTc + srow * 136 + spc + 8) = pv1;
          *(LAS u32x4*)(KM + srow * 136 + spc) = pf0; *(LAS u32x4*)(KM + srow * 136 + spc + 8) = pf1;
          if (OUT) { *(LAS u32x4*)(QMc + srow * 136 + spc) = pq0; *(LAS u32x4*)(QMc + srow * 136 + spc + 8) = pq1; }
          if (GLA && tid < 128) *(LAS u32x4*)(AFB + (tid >> 1) * 16 + (tid & 1) * 8) = pa;
          if (cc < 3) SCAN_ISSUE(c + 1); }
        LDS_BAR();
        if (GLA) {
#pragma unroll
            for (int tb = 0; tb < 4; ++tb) { bf16x8_t Ag = {0, 0, 0, 0, 0, 0, 0, 0}; if (fq < 2) Ag = lds_frag16(lds + SL_AFB + ((tb * 16 + fr) * 16 + fq * 8) * 2);
                f32x4 xg = {bag, bag, bag, bag}; xg = __builtin_amdgcn_mfma_f32_16x16x32_bf16(Ag, Bg, xg, 0, 0, 0);
#pragma unroll
                for (int j = 0; j < 4; ++j) XG[(tb * 16 + fq * 4 + j) * 136 + wave * 16 + fr] = f2bf(xg[j]); }
            asm volatile("s_waitcnt lgkmcnt(0)" ::: "memory");
        }
        const int tstart = dir ? 63 - seg * 16 : seg * 16, tstep = dir ? -1 : 1;
        float cs[16], kkv[GLA ? 1 : 16]; float run = 0.f;
#ifdef REPMASK
        _Pragma("unroll 1") for (int rp1 = 0; rp1 < (((REPMASK) >> 24) & 1 ? 3 : 1); ++rp1) { run = 0.f;
#else
        {
#endif
#pragma unroll
        for (int i = 0; i < 16; ++i) { const int t = tstart + i * tstep; float la;
            if (!GLA) { const float zf = bf2f(KM[t * 136 + k]); const float sg = sigmoidf_(zf); la = __logf(lbv + (1.0f - lbv) * sg); kkv[i] = (1.0f - lbv) * (1.0f - sg); }
            else { const float x = bf2f(XG[t * 136 + k]); la = (fminf(x, 0.f) - __logf(1.0f + __expf(-fabsf(x)))) * 0.0625f; }
            run += la; cs[i] = run; }
        }
        { const float t0 = __shfl(run, fr), t1 = __shfl(run, 16 + fr), t2 = __shfl(run, 32 + fr), t3 = __shfl(run, 48 + fr);
          const float off = seg == 0 ? 0.f : (seg == 1 ? t0 : (seg == 2 ? t0 + t1 : t0 + t1 + t2)), blast = (t0 + t1) + (t2 + t3), bref = t0 + t1;
          float ke[16]; const float ebl = __expf(blast - bref);
#pragma unroll
          for (int i = 0; i < 16; ++i) { const int t = tstart + i * tstep; const float b = off + cs[i];
              float kk; if (GLA) kk = bf2f(KM[t * 136 + k]); else kk = kkv[i];
              const float e1 = __expf(fminf(fmaxf(b - bref, -80.0f), 80.0f)), r1 = __builtin_amdgcn_rcpf(e1), kr = kk * r1;
              if (OUT) { const float qr = bf2f(QMc[t * 136 + k]); const float qv = GLA ? qr * 0.08838834764831845f : siluf_(qr);
                  QMc[t * 136 + k] = f2bf(qv * e1); KM[t * 136 + k] = f2bf(kr); }
              ke[i] = kr * ebl; }
          if (OUT && seg == 0) EB[k] = __expf(bref);
          const int tb0 = dir ? 48 - seg * 16 : seg * 16; u32x4 w0, w1;
          if (dir) { w0.x = pk_bf16(ke[15], ke[14]); w0.y = pk_bf16(ke[13], ke[12]); w0.z = pk_bf16(ke[11], ke[10]); w0.w = pk_bf16(ke[9], ke[8]); w1.x = pk_bf16(ke[7], ke[6]); w1.y = pk_bf16(ke[5], ke[4]); w1.z = pk_bf16(ke[3], ke[2]); w1.w = pk_bf16(ke[1], ke[0]); }
          else     { w0.x = pk_bf16(ke[0], ke[1]); w0.y = pk_bf16(ke[2], ke[3]); w0.z = pk_bf16(ke[4], ke[5]); w0.w = pk_bf16(ke[6], ke[7]); w1.x = pk_bf16(ke[8], ke[9]); w1.y = pk_bf16(ke[10], ke[11]); w1.z = pk_bf16(ke[12], ke[13]); w1.w = pk_bf16(ke[14], ke[15]); }
          *(LAS u32x4*)(KE + k * 72 + tb0) = w0; *(LAS u32x4*)(KE + k * 72 + tb0 + 8) = w1;
          if (seg == 0) DD[k] = __expf(blast);
          dlog += blast; }
        LDS_BAR();
        bf16x8_t Bv[NB][2];
#pragma unroll
        for (int nb = 0; nb < NB; ++nb)
#pragma unroll
            for (int ks = 0; ks < 2; ++ks) { const LAS bf16* vp = VTc + (ks * 32 + fq * 8) * 136 + wave * 16 + fr; u32x4 w;
                w.x = (unsigned)vp[0] | ((unsigned)vp[136] << 16); w.y = (unsigned)vp[2 * 136] | ((unsigned)vp[3 * 136] << 16); w.z = (unsigned)vp[4 * 136] | ((unsigned)vp[5 * 136] << 16); w.w = (unsigned)vp[6 * 136] | ((unsigned)vp[7 * 136] << 16);
                Bv[nb][ks] = __builtin_bit_cast(bf16x8_t, w); }
        if (OUT) {
#ifdef REPMASK
          _Pragma("unroll 1") for (int rp2 = 0; rp2 < (((REPMASK) >> 25) & 1 ? 3 : 1); ++rp2) { if (rp2) LDS_BAR();
#else
          {
#endif
            { const int tb = wave >> 1;
#pragma unroll
              for (int sbi = 0; sbi < 2; ++sbi) { const int sb = (wave & 1) * 2 + sbi; f32x4 acc = {0.f, 0.f, 0.f, 0.f};
#pragma unroll
                  for (int ks = 0; ks < 4; ++ks) acc = __builtin_amdgcn_mfma_f32_16x16x32_bf16(lds_frag16(lds + qmoff + ((tb * 16 + fr) * 136 + ks * 32 + fq * 8) * 2), lds_frag16(lds + SL_KM + ((sb * 16 + fr) * 136 + ks * 32 + fq * 8) * 2), acc, 0, 0, 0);
#pragma unroll
                  for (int j = 0; j < 4; ++j) { const int t = tb * 16 + fq * 4 + j, s = sb * 16 + fr; const bool keep = dir ? (s >= t) : (s <= t); PP[t * 72 + s] = keep ? f2bf(acc[j]) : (bf16)0; } } }
            LDS_BAR();
#pragma unroll
            for (int nb = 0; nb < NB; ++nb) {
                bf16x8_t Bs[4];
#pragma unroll
                for (int ks = 0; ks < 4; ++ks) { const f32x4 e0 = *(LAS f32x4*)(EB + (2 * ks) * 16 + fq * 4), e1 = *(LAS f32x4*)(EB + (2 * ks + 1) * 16 + fq * 4); Bs[ks] = pack_bf16x8(S[nb][2 * ks] * e0, S[nb][2 * ks + 1] * e1); }
#pragma unroll
                for (int mb = 0; mb < 4; ++mb) {
                    f32x4 O = {0.f, 0.f, 0.f, 0.f};
#pragma unroll
                    for (int ks = 0; ks < 2; ++ks) O = __builtin_amdgcn_mfma_f32_16x16x32_bf16(lds_frag16(lds + SL_PP + ((mb * 16 + fr) * 72 + ks * 32 + fq * 8) * 2), Bv[nb][ks], O, 0, 0, 0);
#pragma unroll
                    for (int ks = 0; ks < 4; ++ks) { u32x4 aw; const u32x2 lo = *(LAS u32x2*)(lds + qmoff + ((mb * 16 + fr) * 136 + (2 * ks) * 16 + fq * 4) * 2), hi = *(LAS u32x2*)(lds + qmoff + ((mb * 16 + fr) * 136 + (2 * ks + 1) * 16 + fq * 4) * 2);
                        aw.x = lo.x; aw.y = lo.y; aw.z = hi.x; aw.w = hi.y;
                        O = __builtin_amdgcn_mfma_f32_16x16x32_bf16(__builtin_bit_cast(bf16x8_t, aw), Bs[ks], O, 0, 0, 0); }
#pragma unroll
                    for (int j = 0; j < 4; ++j) Odir[(size_t)(r0 + mb * 16 + fq * 4 + j) * 1024 + head * DV + (nbase + nb) * 16 + fr] = f2bf(O[j]);
                    asm volatile("" ::: "memory");
                }
            }
          }
        }
        if (!OUT || cc < 3) {
#pragma unroll
            for (int mb = 0; mb < 8; ++mb) { const f32x4 dd = *(LAS f32x4*)(DD + mb * 16 + fq * 4);
                const bf16x8_t A0 = lds_frag16(lds + SL_KE + ((mb * 16 + fr) * 72 + fq * 8) * 2), A1 = lds_frag16(lds + SL_KE + ((mb * 16 + fr) * 72 + 32 + fq * 8) * 2);
#pragma unroll
                for (int nb = 0; nb < NB; ++nb) { S[nb][mb] = S[nb][mb] * dd; S[nb][mb] = __builtin_amdgcn_mfma_f32_16x16x32_bf16(A0, Bv[nb][0], S[nb][mb], 0, 0, 0); S[nb][mb] = __builtin_amdgcn_mfma_f32_16x16x32_bf16(A1, Bv[nb][1], S[nb][mb], 0, 0, 0); }
                asm volatile("" ::: "memory"); }
        }
    }
    LDS_BAR();
    if (!OUT) {
#pragma unroll
        for (int nb = 0; nb < NB; ++nb)
#pragma unroll
            for (int mb = 0; mb < 8; ++mb) *(f32x4*)(kvs + ((size_t)((nbase + nb) * 8 + mb) * 64 + lane) * 4) = S[nb][mb];
        if (seg == 0) kd[k] = __expf(dlog);
    }
}
#undef SCAN_ISSUE
DI void scan_prop(const Args& a) {
    float* kvs = (float*)(wsp(a) + WS_KVS); const float* kd = (const float*)(wsp(a) + WS_KD);
    for (int g = obid() * NTHR + otid(); g < 131072; g += ogdim() * NTHR) {
        float* p; size_t stride; const float* dp;
        if (g < 65536) { const int stream = g >> 12, e = g & 4095; p = kvs + (size_t)stream * SC_N * 16384 + (size_t)e * 4; stride = 16384; dp = kd + (size_t)stream * SC_N * 128 + (((e >> 6) & 7) * 4 + ((e & 63) >> 4)) * 4; }
        else { const int q = g - 65536, stream = q >> 13, e = q & 8191; p = kvs + KVS_GL_OFF + (size_t)stream * SC_N * 32768 + (size_t)e * 4; stride = 32768; dp = kd + (size_t)(16 + stream) * SC_N * 128 + (((e >> 6) & 7) * 4 + ((e & 63) >> 4)) * 4; }
        f32x4 S = {0.f, 0.f, 0.f, 0.f};
#pragma unroll 5
        for (int sc = 0; sc < SC_N; ++sc) { const f32x4 kv = *(const f32x4*)(p + sc * stride), d = *(const f32x4*)(dp + sc * 128); *(f32x4*)(p + sc * stride) = S; S = d * S + kv; }
    }
}
constexpr int SCAN_ITEMS = 32 * SC_N;
template <bool OUT> DI void scan_item2(const Args& a, int l, int it, LAS unsigned char* lds, int pv = 0) {
    if (it < 16 * SC_N) { const int s = it / SC_N, sc = it % SC_N; if (OUT && l == DEPTH - 1 && sc == 0) return; scan_walk<true, OUT>(a, l, s >> 2, (s >> 1) & 1, sc, s & 1, lds, pv); }
    else { const int j = it - 16 * SC_N, s = j / SC_N, sc = j % SC_N; if (OUT && l == DEPTH - 1 && sc == 0) return; scan_walk<false, OUT>(a, l, s >> 1, s & 1, sc, 0, lds, pv); }
}
DI void hyconv_item(const Args& a, int l, int c, LAS unsigned char* ldsb, int pv = 0) {
    const int tid = otid();
    LAS float* lds = (LAS float*)ldsb;
    LAS float* xs = (LAS float*)(ldsb + LDS_X);
    const float* tw = (const float*)(wsp(a) + WS_TW); const float* tw2 = (const float*)(wsp(a) + WS_TW2);
    const float* h2 = (const float*)(wsp(a) + WS_H2) + (size_t)l * MT * 64;
    const bf16* VX = (const bf16*)(wsp(a) + WS_U) + (size_t)c * MT; bf16* VO = (bf16*)(wsp(a) + WS_CVO) + (size_t)c * MT;
#ifdef REPMASK
    _Pragma("unroll 1") for (int rpa = 0; rpa < (((REPMASK) >> 21) & 1 ? 2 : 1); ++rpa) { if (rpa) __syncthreads();
#else
    if (!(pv & 64)) {
#endif
    const bf16* HFf = (const bf16*)(wsp(a) + WS_HF) + (size_t)c * SEQ; const bf16* HFb = HFf + (size_t)1024 * SEQ;
    const float a0 = -4.605170186f / 1.5f, a1 = -4.605170186f / 0.3f;
    const float nd = -fabsf(a0 + (float)c * ((a1 - a0) / 1023.0f)) * (1.0f / (float)(SEQ - 1));
    const float b3f = ain(a, I_HYB3)[l * 2048 + c], b3b = ain(a, I_HYB3)[l * 2048 + 1024 + c];
    float sf = 0.f, sb = 0.f; f32x4 hfv[8], hbv[8];
#pragma unroll
    for (int i = 0; i < 8; ++i) { const int t4 = (tid + 512 * i) * 4; const u32x2 rf = *(const u32x2*)(HFf + t4), rb = *(const u32x2*)(HFb + t4);
        f32x4 hf, hb; hf[0] = bflo(rf.x); hf[1] = bfhi(rf.x); hf[2] = bflo(rf.y); hf[3] = bfhi(rf.y); hb[0] = bflo(rb.x); hb[1] = bfhi(rb.x); hb[2] = bflo(rb.y); hb[3] = bfhi(rb.y);
#pragma unroll
        for (int q = 0; q < 4; ++q) { const float dec = __expf(nd * (float)(t4 + q)) + 0.05f; hf[q] = (hf[q] + b3f) * dec; hb[q] = (hb[q] + b3b) * dec; }
        sf += (fabsf(hf[0]) + fabsf(hf[1])) + (fabsf(hf[2]) + fabsf(hf[3])); sb += (fabsf(hb[0]) + fabsf(hb[1])) + (fabsf(hb[2]) + fabsf(hb[3]));
        hfv[i] = hf; hbv[i] = hb; }
    sf = wave_sum(sf); sb = wave_sum(sb);
    if ((tid & 63) == 0) { xs[128 + (tid >> 6)] = sf; xs[136 + (tid >> 6)] = sb; }
    __syncthreads();
    float tf = 0.f, tb = 0.f;
#pragma unroll
    for (int w = 0; w < 8; ++w) { tf += xs[128 + w]; tb += xs[136 + w]; }
    const float inf_ = 1.0f / tf, inb_ = 1.0f / tb; const float skipv = ain(a, I_HYSKIP)[l * 1024 + c];
#pragma unroll
    for (int i = 0; i < 8; ++i) { const int t4 = (tid + 512 * i) * 4; f32x4 hf = hfv[i] * inf_; const f32x4 hb = hbv[i] * inb_;
        if (t4 == 0) hf[0] += hb[0] + skipv;
        *(LAS f32x4*)(lds + t4) = hf;
#pragma unroll
        for (int q = 0; q < 4; ++q) { const int t = t4 + q; if (t > 0) lds[32768 - t] = hb[q]; } }
    if (tid == 0) lds[SEQ] = 0.f;
    __syncthreads();
    }
    if (!(pv & 128)) { FftTw T; fft_load_tw(T, tw, tid);
    fft_fwd_pass<4096>(lds, T, tw, tid); LDS_BAR(); fft_fwd_pass<1024>(lds, T, tw, tid); LDS_BAR(); fft_fwd_pass<256>(lds, T, tw, tid); LDS_BAR(); fft_fwd_pass<64>(lds, T, tw, tid); LDS_BAR();
    fft_fwd_pass<16>(lds, T, tw, tid); LDS_BAR(); fft_fwd_pass<4>(lds, T, tw, tid); LDS_BAR(); fft_fwd_pass<1>(lds, T, tw, tid); LDS_BAR(); }
#ifdef REPMASK
    if (((REPMASK) >> 22) & 1) { FftTw T; fft_load_tw(T, tw, tid);
        fft_inv_pass<1>(lds, T, tw, tid); LDS_BAR(); fft_inv_pass<4>(lds, T, tw, tid); LDS_BAR(); fft_inv_pass<16>(lds, T, tw, tid); LDS_BAR(); fft_inv_pass<64>(lds, T, tw, tid); LDS_BAR();
        fft_inv_pass<256>(lds, T, tw, tid); LDS_BAR(); fft_inv_pass<1024>(lds, T, tw, tid); LDS_BAR(); fft_inv_pass<4096>(lds, T, tw, tid); LDS_BAR();
        for (int i = 0; i < 64; ++i) lds[tid + 512 * i] *= (1.0f / FFT_M);
        LDS_BAR();
        fft_fwd_pass<4096>(lds, T, tw, tid); LDS_BAR(); fft_fwd_pass<1024>(lds, T, tw, tid); LDS_BAR(); fft_fwd_pass<256>(lds, T, tw, tid); LDS_BAR(); fft_fwd_pass<64>(lds, T, tw, tid); LDS_BAR();
        fft_fwd_pass<16>(lds, T, tw, tid); LDS_BAR(); fft_fwd_pass<4>(lds, T, tw, tid); LDS_BAR(); fft_fwd_pass<1>(lds, T, tw, tid); LDS_BAR(); }
#endif

    float* Gs = (float*)(wsp(a) + WS_YMIX) + (size_t)obid() * 32768;
    const int kbase = ((tid & 63) << 7) | ((tid >> 6) << 4);
#ifdef REPMASK
    _Pragma("unroll 1") for (int rpc = 0; rpc < (((REPMASK) >> 23) & 1 ? 2 : 1); ++rpc)
#endif
#pragma unroll 4
    for (int j = 0; j < ((pv & 256) ? 0 : 16); ++j) { const int k = kbase | j; cpx gk, gm; rfft_untangle(lds, tw2, k, gk, gm); f32x4 g4; g4[0] = gk.x; g4[1] = gk.y; g4[2] = gm.x; g4[3] = gm.y; *(f32x4*)(Gs + (size_t)(j * 512 + tid) * 4) = g4; }
    __syncthreads();
#pragma unroll
    for (int i = 0; i < 16; ++i) { if (pv & 512) break; const int m4 = tid + 512 * i; f32x4 v = {0.f, 0.f, 0.f, 0.f}; if (m4 < SEQ / 4) { const u32x2 r = *(const u32x2*)(VX + m4 * 4); v[0] = bflo(r.x); v[1] = bfhi(r.x); v[2] = bflo(r.y); v[3] = bfhi(r.y); } *(LAS f32x4*)(lds + m4 * 4) = v; }
    __syncthreads();
    if (!(pv & 128)) { FftTw T; fft_load_tw(T, tw, tid);
    fft_fwd_pass<4096>(lds, T, tw, tid); LDS_BAR(); fft_fwd_pass<1024>(lds, T, tw, tid); LDS_BAR(); fft_fwd_pass<256>(lds, T, tw, tid); LDS_BAR(); fft_fwd_pass<64>(lds, T, tw, tid); LDS_BAR();
    fft_fwd_pass<16>(lds, T, tw, tid); LDS_BAR(); fft_fwd_pass<4>(lds, T, tw, tid); LDS_BAR(); fft_fwd_pass<1>(lds, T, tw, tid); LDS_BAR(); }
#pragma unroll 8
    for (int j = 0; j < ((pv & 1024) ? 0 : 16); ++j) { const int k = kbase | j; const f32x4 g4 = *(const f32x4*)(Gs + (size_t)(j * 512 + tid) * 4); cpx gk, gm; gk.x = g4[0]; gk.y = g4[1]; gm.x = g4[2]; gm.y = g4[3]; rfft_mul_retangle(lds, tw2, k, gk, gm); }
    __syncthreads();
    if (!(pv & 128)) { FftTw T; fft_load_tw(T, tw, tid);
    fft_inv_pass<1>(lds, T, tw, tid); LDS_BAR(); fft_inv_pass<4>(lds, T, tw, tid); LDS_BAR(); fft_inv_pass<16>(lds, T, tw, tid); LDS_BAR(); fft_inv_pass<64>(lds, T, tw, tid); LDS_BAR();
    fft_inv_pass<256>(lds, T, tw, tid); LDS_BAR(); fft_inv_pass<1024>(lds, T, tw, tid); LDS_BAR(); fft_inv_pass<4096>(lds, T, tw, tid); LDS_BAR(); }
#pragma unroll
    for (int i = 0; i < 8; ++i) { if (pv & 2048) break; const int m4 = tid + 512 * i; const f32x4 v = *(const LAS f32x4*)(lds + m4 * 4) * (1.0f / FFT_M); u32x2 o; o.x = pk_bf16(v[0], v[1]); o.y = pk_bf16(v[2], v[3]); *(u32x2*)(VO + m4 * 4) = o; }
    __syncthreads();
}
DI void hycctx_item(const Args& a, int l, int it, LAS unsigned char* ldsb) {
    const int tid = otid(), c0 = it * 4;
    LAS float* sv = (LAS float*)ldsb;
    LAS float* sf = sv + 4 * 256;
    LAS float* sb = sf + 4 * 256;
    const float* hyc = (const float*)(wsp(a) + WS_HYC); const bf16* VXT = (const bf16*)(wsp(a) + WS_U); bf16* CVO = (bf16*)(wsp(a) + WS_CVO);
    for (int i = tid; i < 4 * 256; i += NTHR) { const int ch = i >> 8, t = i & 255; sv[i] = bf2f(VXT[(size_t)(c0 + ch) * MT + SEQ + t]); sf[i] = hyc[(size_t)(c0 + ch) * 256 + t]; sb[i] = hyc[(size_t)(1024 + c0 + ch) * 256 + t]; }
    __syncthreads();
    const int ch = tid >> 7, tq = tid & 127; const float g0 = sf[ch * 256] + sb[ch * 256] + ain(a, I_HYSKIP)[l * 1024 + c0 + ch];
    float acc0 = 0.f, acc1 = 0.f; const int t0 = tq * 2;
    for (int s = 0; s < 256; ++s) { const float vv = sv[ch * 256 + s]; const int d0 = t0 - s, d1 = d0 + 1;
        const float ga = d0 > 0 ? sf[ch * 256 + d0] : (d0 < 0 ? sb[ch * 256 - d0] : g0), gb = d1 > 0 ? sf[ch * 256 + d1] : (d1 < 0 ? sb[ch * 256 - d1] : g0);
        acc0 += ga * vv; acc1 += gb * vv; }
    *(unsigned*)(CVO + (size_t)(c0 + ch) * MT + SEQ + t0) = pk_bf16(acc0, acc1);
    __syncthreads();
}

struct EpiHF {
    static constexpr bool PERM = true, AFTER_DRAIN = false; bf16* O;
    DI void operator()(const f32x4 (&acc)[2][2][4][2], const pg8::Unit& u, int wr, int wc, int fr, int fq) const {
        const int row0 = u.pm * 256 + wr * 64 + fr, col0 = u.pn * 256 + wc * 32 + 8 * fq;
#pragma unroll
        for (int ai = 0; ai < 2; ++ai)
#pragma unroll
            for (int m = 0; m < 4; ++m) { bf16* rowp = O + (size_t)(row0 + ai * 128 + m * 16) * SEQ + col0;
#pragma unroll
                for (int bj = 0; bj < 2; ++bj) { const f32x4 v0 = acc[ai][bj][m][0], v1 = acc[ai][bj][m][1];
                    u32x4 w; w.x = pk_bf16(v0[0], v0[1]); w.y = pk_bf16(v0[2], v0[3]); w.z = pk_bf16(v1[0], v1[1]); w.w = pk_bf16(v1[2], v1[3]);
                    *(u32x4*)(rowp + bj * 128) = w; } }
    }
};
struct EpiZ {
    static constexpr bool PERM = true, AFTER_DRAIN = false; bf16* O; const float* bias;
    DI void operator()(const f32x4 (&acc)[2][2][4][2], const pg8::Unit& u, int wr, int wc, int fr, int fq) const {
        const int row0 = u.pm * 256 + wr * 64 + fr, col0 = u.pn * 256 + wc * 32 + 8 * fq;
        f32x4 bv[2][2];
#pragma unroll
        for (int bj = 0; bj < 2; ++bj)
#pragma unroll
            for (int n = 0; n < 2; ++n) bv[bj][n] = *(const f32x4*)(bias + col0 + bj * 128 + 4 * n);
#pragma unroll
        for (int ai = 0; ai < 2; ++ai)
#pragma unroll
            for (int m = 0; m < 4; ++m) { bf16* rowp = O + (size_t)(row0 + ai * 128 + m * 16) * ZC + col0;
#pragma unroll
                for (int bj = 0; bj < 2; ++bj) { const f32x4 v0 = acc[ai][bj][m][0] + bv[bj][0], v1 = acc[ai][bj][m][1] + bv[bj][1];
                    u32x4 w; w.x = pk_bf16(v0[0], v0[1]); w.y = pk_bf16(v0[2], v0[3]); w.z = pk_bf16(v1[0], v1[1]); w.w = pk_bf16(v1[2], v1[3]);
                    *(u32x4*)(rowp + bj * 128) = w; } }
    }
};
template <int BR> struct EpiBr {
    static constexpr bool PERM = true, AFTER_DRAIN = false; bf16* Mg; const bf16* Zg;
    DI void operator()(const f32x4 (&acc)[2][2][4][2], const pg8::Unit& u, int wr, int wc, int fr, int fq) const {
        const int row0 = u.pm * 256 + wr * 64 + fr, col0 = u.pn * 256 + wc * 32 + 8 * fq;
#pragma unroll
        for (int ai = 0; ai < 2; ++ai)
#pragma unroll
            for (int m = 0; m < 4; ++m) { const size_t row = (size_t)(row0 + ai * 128 + m * 16);
#pragma unroll
                for (int bj = 0; bj < 2; ++bj) { const int col = col0 + bj * 128;
                    const u32x4 g = *(const u32x4*)(Zg + row * ZC + col);
                    f32x4 v0 = acc[ai][bj][m][0], v1 = acc[ai][bj][m][1];
                    v0[0] *= sigmoidf_(bflo(g.x)); v0[1] *= sigmoidf_(bfhi(g.x)); v0[2] *= sigmoidf_(bflo(g.y)); v0[3] *= sigmoidf_(bfhi(g.y));
                    v1[0] *= sigmoidf_(bflo(g.z)); v1[1] *= sigmoidf_(bfhi(g.z)); v1[2] *= sigmoidf_(bflo(g.w)); v1[3] *= sigmoidf_(bfhi(g.w));
                    if (BR > 0) { const u32x4 p = *(const u32x4*)(Mg + row * D + col);
                        v0[0] += bflo(p.x); v0[1] += bfhi(p.x); v0[2] += bflo(p.y); v0[3] += bfhi(p.y); v1[0] += bflo(p.z); v1[1] += bfhi(p.z); v1[2] += bflo(p.w); v1[3] += bfhi(p.w); }
                    u32x4 w; w.x = pk_bf16(v0[0], v0[1]); w.y = pk_bf16(v0[2], v0[3]); w.z = pk_bf16(v1[0], v1[1]); w.w = pk_bf16(v1[2], v1[3]);
                    *(u32x4*)(Mg + row * D + col) = w; } }
    }
};
struct EpiOut {
    static constexpr bool PERM = false, AFTER_DRAIN = false; const float* hin_main; const float* hin_ctx; float* hout; const float* gt1;
    DI void operator()(const f32x4 (&acc)[2][2][4][2], const pg8::Unit& u, int wr, int wc, int fr, int fq) const {
        const int row0 = u.pm * 256 + wr * 64 + fr, col0 = u.pn * 256 + wc * 32 + 4 * fq; const bool isctx = u.pm >= SEQ / 256;
        const float* g = gt1 + (isctx ? 12288 : 0);
        f32x4 gv[2][2];
#pragma unroll
        for (int bj = 0; bj < 2; ++bj)
#pragma unroll
            for (int n = 0; n < 2; ++n) gv[bj][n] = *(const f32x4*)(g + col0 + bj * 128 + n * 16);
#pragma unroll
        for (int ai = 0; ai < 2; ++ai)
#pragma unroll
            for (int m = 0; m < 4; ++m) { const int row = row0 + ai * 128 + m * 16;
                const float* ip = (isctx ? hin_ctx + (size_t)(row - SEQ) * D : hin_main + (size_t)row * D) + col0; float* op = hout + (size_t)row * D + col0;
#pragma unroll
                for (int bj = 0; bj < 2; ++bj)
#pragma unroll
                    for (int n = 0; n < 2; ++n) { const f32x4 b = *(const f32x4*)(ip + bj * 128 + n * 16); *(f32x4*)(op + bj * 128 + n * 16) = b + gv[bj][n] * acc[ai][bj][m][n]; } }
    }
};
struct EpiGU {
    static constexpr bool PERM = true, AFTER_DRAIN = false; bf16* Hm;
    DI void operator()(const f32x4 (&acc)[2][2][4][2], const pg8::Unit& u, int wr, int wc, int fr, int fq) const {
        const int row0 = u.pm * 256 + wr * 64 + fr, col0 = (u.pn & 3) * 128 + wc * 32 + 8 * fq;
#pragma unroll
        for (int ai = 0; ai < 2; ++ai)
#pragma unroll
            for (int m = 0; m < 4; ++m) { const f32x4 g0 = acc[ai][0][m][0], g1 = acc[ai][0][m][1], u0 = acc[ai][1][m][0], u1 = acc[ai][1][m][1];
                u32x4 w; w.x = pk_bf16(siluf_(g0[0]) * u0[0], siluf_(g0[1]) * u0[1]); w.y = pk_bf16(siluf_(g0[2]) * u0[2], siluf_(g0[3]) * u0[3]);
                w.z = pk_bf16(siluf_(g1[0]) * u1[0], siluf_(g1[1]) * u1[1]); w.w = pk_bf16(siluf_(g1[2]) * u1[2], siluf_(g1[3]) * u1[3]);
                *(u32x4*)(Hm + (size_t)(row0 + ai * 128 + m * 16) * DFF + col0) = w; }
    }
};
struct EpiDn {
    static constexpr bool PERM = true, AFTER_DRAIN = false; bf16* Y; const float* roww;
    DI void operator()(const f32x4 (&acc)[2][2][4][2], const pg8::Unit& u, int wr, int wc, int fr, int fq) const {
        const int row0 = u.pm * 256 + wr * 64 + fr, col0 = (u.pn & 7) * 256 + wc * 32 + 8 * fq;
#pragma unroll
        for (int ai = 0; ai < 2; ++ai)
#pragma unroll
            for (int m = 0; m < 4; ++m) { const int row = row0 + ai * 128 + m * 16; const float rw = roww[row];
#pragma unroll
                for (int bj = 0; bj < 2; ++bj) { const f32x4 v0 = acc[ai][bj][m][0] * rw, v1 = acc[ai][bj][m][1] * rw;
                    u32x4 w; w.x = pk_bf16(v0[0], v0[1]); w.y = pk_bf16(v0[2], v0[3]); w.z = pk_bf16(v1[0], v1[1]); w.w = pk_bf16(v1[2], v1[3]);
                    *(u32x4*)(Y + (size_t)row * D + col0 + bj * 128) = w; } }
    }
};
struct MoeOrder {
    const int* tile_e; int ntiles, nsub, G, c;
    DI bool next(int i, pg8::Unit& u) const { const int j = i * G + c; if (j >= ntiles * nsub) return false; const int ti = j / nsub; u.pm = ti; u.pn = tile_e[ti] * nsub + (j - ti * nsub); return true; }
    DI void a_ready(const pg8::Unit&) const {}
    DI void done(const pg8::Unit&) const {}
};
constexpr int NPH_LAYER = 13, PH_FINAL = 1 + NPH_LAYER * DEPTH, NPHASES = PH_FINAL + 1;
struct KArgs { Args a; int li, pad; };
__global__ void __launch_bounds__(NTHR, 2) fwd_kernel(KArgs ka) {
    const Args& a = ka.a;
#define tid ((int)otid())
#define bid ((int)obid())
#define G ((int)ogdim())
    if (tid == 0) { ((LAS unsigned*)(ldsbase() + LDS_BARW))[0] = 0u; ((LAS unsigned*)(ldsbase() + LDS_BARW))[1] = 0u;
        LAS unsigned long long* ptab = (LAS unsigned long long*)(ldsbase() + LDS_PTAB);
#pragma unroll
        for (int i = 0; i < N_IN; ++i) ptab[i] = (unsigned long long)ka.a.in[i]; }
    __syncthreads();
#ifdef PROBE_SEL
    if (tid < 64) ((LAS unsigned long long*)(ldsbase() + LDS_TIM))[tid] = 0ull;
    __syncthreads();
    const unsigned long long tkern_ = __builtin_amdgcn_s_memrealtime();
#endif
    XcdBarrier bar = xcd_barrier_post((unsigned*)(wsp(a) + WS_CTL) + CW_BAR + ka.li * XCD_BAR_WORDS, (volatile LAS unsigned*)(ldsbase() + LDS_BARW));
    const int lo = a.ph_lo, hi = a.ph_hi;
#ifndef PHMASK
#define PHMASK 0xFFFF
#endif
#define EN(i) (((PHMASK) >> (i)) & 1)
#ifndef REPMASK
#define REPMASK 0
#endif
#define REP(i) (((REPMASK) >> (i)) & 1)
#define RUN(i, cond, ...) do { _Pragma("unroll 1") for (int rep_ = 0; rep_ < ((REP(i) && (cond)) ? REPN : 1); ++rep_) { if (rep_) __syncthreads(); __VA_ARGS__; } } while (0)
#ifndef REPN
#define REPN 2
#endif
#define IN(k) (opq(lo) <= (k) && (k) < opq(hi))
#define SEAM(k) do { if (IN(k) && IN((k) + 1)) { TIC(); xcd_barrier(bar); TOC(30); } } while (0)
#define ws wsp(a)
#define lds ldsbase()
#define ldsf ((LAS float*)ldsbase())
#define U ((bf16*)(wsp(a) + WS_U))
#define Z ((bf16*)(wsp(a) + WS_Z))
#define H ((float*)(wsp(a) + WS_H))
#define modall ((const float*)(wsp(a) + WS_MOD))

    { TIC();
    if (EN(0) && IN(0)) {
        RUN(0, true, prologue_small(a);
        for (int it = bid; it < 256; it += G) mod_item(a, it, ldsf);
        __syncthreads(); h2_rows(a, ldsf); __syncthreads());
    }
    TOC(31); } SEAM(0);
    for (int l = 0; l < DEPTH; ++l) {
        const int pb = 1 + NPH_LAYER * l;
        const int nrows = (l == 0) ? MT : SEQ;
        { TIC();
        if (EN(1) && IN(pb + 0)) {
            RUN(1, l == 0, norm_phase<0>(a, l, MT, ldsf));
            RUN(16, true, if (l == 0) hyc_filters(a, 0));
            __syncthreads(); RUN(2, true, cvt_stream<false>(a, l, ldsf)); __syncthreads();
        }
        TOC(1); } SEAM(pb + 0); { TIC();
        if (EN(2) && IN(pb + 1)) {
            pg8::Gemm g{U, (const bf16*)(ws + WS_WIN), MT, ZC, D}; pg8::StaticOrder S; S.init(MT, ZC, G, bid);
            EpiZ E{Z, (const float*)(ws + WS_ZBIAS) + (size_t)l * ZC};
            RUN(3, true, pg8::gemm_phase<EpiZ, pg8::StaticOrder, true, true>(lds, g, S, E));
        }
        TOC(2); } SEAM(pb + 1); { TIC();
        if (EN(3) && IN(pb + 2)) { const int nit = (nrows / 64) * 16; { const int g_ = G, w0_ = __builtin_amdgcn_readfirstlane(tid >> 6) * g_ + bid, n_ = (nrows / 64) * 128; RUN(4, true, for (int it = w0_; it < n_; it += 8 * g_) hyprep_witem(a, l, it)); }
            __syncthreads();
            pg8::Gemm g{(const bf16*)(ws + WS_W3T) + (size_t)l * 2048 * 256, (const bf16*)(ws + WS_H2B) + (size_t)l * SEQ * 256, 2048, SEQ, opq(256)  }; pg8::StaticOrder S; S.init(2048, SEQ, G, bid);
            EpiHF E{(bf16*)(ws + WS_HF)};
            RUN(18, true, pg8::gemm_phase<EpiHF, pg8::StaticOrder, true, true>(lds, g, S, E)); }
        TOC(3); } SEAM(pb + 2); { TIC();
        if (EN(4) && IN(pb + 3)) {
            if (!(ka.pad & 8)) { RUN(5, true, for (int it = bid; it < SCAN_ITEMS; it += G) scan_item2<false>(a, l, it, lds)); }
            if (!(ka.pad & 16)) { RUN(6, true, for (int c = bid; c < 1024; c += G) hyconv_item(a, l, c, lds, ka.pad)); }
            if (!(ka.pad & 32)) { RUN(15, true, if (l == 0) for (int it = bid; it < 256; it += G) hycctx_item(a, l, it, lds)); }
        }
        TOC(4); } SEAM(pb + 3); { TIC();
        if (EN(13) && IN(pb + 4)) { scan_prop(a); if (REP(20)) { xcd_barrier(bar); xcd_barrier(bar); xcd_barrier(bar); xcd_barrier(bar); xcd_barrier(bar); } }
        TOC(5); } SEAM(pb + 4); { TIC();
        if (EN(14) && IN(pb + 5)) { RUN(17, true, for (int it = bid; it < SCAN_ITEMS; it += G) scan_item2<true>(a, l, it, lds, ka.pad)); }
        TOC(6); } SEAM(pb + 5); { TIC();
        if (EN(5) && IN(pb + 6)) {
            const int nit = (nrows / 64) * 16;
            { const int g_ = G, w0_ = __builtin_amdgcn_readfirstlane(tid >> 6) * g_ + bid, n_ = (nrows / 64) * 128; RUN(7, true, scancomb_rows(a, l, nrows); for (int it = w0_; it < n_; it += 8 * g_) hycomb_witem(a, l, it)); }
        }
        TOC(7); } SEAM(pb + 6); { TIC();
        if (EN(6) && IN(pb + 7)) {
            const bf16* Y = (const bf16*)(ws + WS_YMIX); const bf16* WB = (const bf16*)(ws + WS_WBR);
            pg8::StaticOrder S; S.init(nrows, D, G, bid);
            RUN(8, true,
            { pg8::Gemm g{Y, WB, nrows, D, 1024}; EpiBr<0> E{U, Z + Z_MG}; pg8::gemm_phase<EpiBr<0>, pg8::StaticOrder, true, true>(lds, g, S, E); }
            __syncthreads();
            { pg8::Gemm g{Y + (size_t)MT * 1024, WB + (size_t)D * 1024, nrows, D, 1024}; EpiBr<1> E{U, Z + Z_MG + D}; pg8::gemm_phase<EpiBr<1>, pg8::StaticOrder, true, true>(lds, g, S, E); }
            __syncthreads();
            { pg8::Gemm g{Y + (size_t)2 * MT * 1024, WB + (size_t)2 * D * 1024, nrows, D, 1024}; EpiBr<2> E{U, Z + Z_MG + 2 * D}; pg8::gemm_phase<EpiBr<2>, pg8::StaticOrder, true, true>(lds, g, S, E); });
        }
        TOC(8); } SEAM(pb + 7); { TIC();
        if (EN(7) && IN(pb + 8)) {
            pg8::Gemm g{U, (const bf16*)(ws + WS_WOUT), nrows, D, D}; pg8::StaticOrder S; S.init(nrows, D, G, bid);
            EpiOut E{l == 0 ? ain(a, I_X) : H, l == 0 ? ain(a, I_CTX) : H + (size_t)SEQ * D, H, modall + (size_t)l * 2 * 12288 + 4096};
            RUN(9, l == 0, pg8::gemm_phase<EpiOut, pg8::StaticOrder, true, true>(lds, g, S, E));
        }
        TOC(9); } SEAM(pb + 8); { TIC();
        if (EN(8) && IN(pb + 9)) {
            route_phase<false>(a, l, nrows, ldsf, ka.pad);
            __syncthreads();
            if (REP(19)) { route_phase<true>(a, l, nrows, ldsf); __syncthreads(); }

        }
        TOC(10); } SEAM(pb + 9); { TIC();
        if (EN(9) && IN(pb + 10)) { RUN(11, true, permute_phase(a, l, nrows, lds)); __syncthreads(); RUN(10, true, cvt_stream<true>(a, l, ldsf)); __syncthreads(); }
        TOC(11); } SEAM(pb + 10); { TIC();
        if (EN(10) && IN(pb + 11)) {
            const int* tile_e = (const int*)(ws + WS_TILEE); const int ntiles = tile_e[200];
            pg8::Gemm g{(const bf16*)(ws + WS_XP), (const bf16*)(ws + WS_WGU), MOE_MAXROWS, NEXP * 1024, D}; MoeOrder S{tile_e, ntiles, 4, G, bid};
            EpiGU E{(bf16*)(ws + WS_HMID)};
            RUN(12, true, pg8::gemm_phase<EpiGU, MoeOrder, true, true>(lds, g, S, E));
        }
        TOC(12); } SEAM(pb + 11); { TIC();
        if (EN(11) && IN(pb + 12)) {
            const int* tile_e = (const int*)(ws + WS_TILEE); const int ntiles = tile_e[200];
            pg8::Gemm g{(const bf16*)(ws + WS_HMID), (const bf16*)(ws + WS_WD), MOE_MAXROWS, NEXP * D, DFF}; MoeOrder S{tile_e, ntiles, 8, G, bid};
            EpiDn E{(bf16*)(ws + WS_YP), (const float*)(ws + WS_ROWW)};
            RUN(13, true, pg8::gemm_phase<EpiDn, MoeOrder, true, true>(lds, g, S, E));
        }
        TOC(13); } SEAM(pb + 12); { TIC();
        (void)0; }
    }
#ifdef PROBE_SEL
    if (tid == 0) ((LAS unsigned long long*)(ldsbase() + LDS_TIM))[0] = __builtin_amdgcn_s_memrealtime() - tkern_;
    __syncthreads();
#endif
    if (EN(12) && IN(PH_FINAL)) norm_phase<2>(a, DEPTH, SEQ, ldsf);
#undef IN
#undef SEAM
#undef ws
#undef tid
#undef bid
#undef G
#undef lds
#undef ldsf
#undef U
#undef Z
#undef H
#undef modall
}

#ifndef MK_SINGLE
#define MK_SINGLE 1
#endif
extern "C" void kernel_launch(void* const* d_in, const int* in_sizes, int n_in, void* d_out, int out_size, void* d_ws, size_t ws_size, hipStream_t stream) {
    static int grid = 0;
    if (grid == 0) {
        if (n_in != N_IN || out_size != SEQ * D || ws_size < WS_END) { fprintf(stderr, "kernel_launch: unexpected problem shape (n_in %d, out %d, ws %zu < %zu)\n", n_in, out_size, ws_size, (size_t)WS_END); grid = -1; return; }
        int dev = 0, cus = 0;
        if (hipGetDevice(&dev) != hipSuccess || hipDeviceGetAttribute(&cus, hipDeviceAttributeMultiprocessorCount, dev) != hipSuccess) { grid = -1; return; }
        if (hipFuncSetAttribute((const void*)fwd_kernel, hipFuncAttributeMaxDynamicSharedMemorySize, LDS_BYTES) != hipSuccess) { fprintf(stderr, "kernel_launch: hipFuncSetAttribute failed\n"); grid = -1; return; }
        int per_cu = 0;
        if (hipOccupancyMaxActiveBlocksPerMultiprocessor(&per_cu, (const void*)fwd_kernel, NTHR, LDS_BYTES) != hipSuccess || per_cu < 1) fprintf(stderr, "kernel_launch: occupancy query says %d\n", per_cu);
        (void)hipGetLastError();
        grid = cus;
    }
    if (grid < 0) return;
    (void)hipMemsetAsync((char*)d_ws + WS_CTL, 0, CTL_BYTES, stream);
    KArgs ka{};
    for (int i = 0; i < N_IN; ++i) ka.a.in[i] = (const float*)d_in[i];
    ka.a.out = (float*)d_out; ka.a.ws = (unsigned char*)d_ws;
#if MK_SINGLE
    ka.a.ph_lo = 0; ka.a.ph_hi = NPHASES; ka.li = 0; ka.pad = 0;
    hipLaunchKernelGGL(fwd_kernel, dim3(grid), dim3(NTHR), LDS_BYTES, stream, ka);
#ifdef PROBE_K
    (void)hipMemsetAsync((char*)d_ws + WS_CTL + (size_t)CW_CNT * 4, 0, 16384, stream);
    ka.a.ph_lo = 0; ka.a.ph_hi = PROBE_K; ka.li = 1;
#ifdef PROBE_V
    ka.pad = PROBE_V;
#endif
    hipLaunchKernelGGL(fwd_kernel, dim3(grid), dim3(NTHR), LDS_BYTES, stream, ka);
#endif
#else
    for (int ph = 0; ph < NPHASES; ++ph) { ka.a.ph_lo = ph; ka.a.ph_hi = ph + 1; ka.li = 0; ka.pad = 0; hipLaunchKernelGGL(fwd_kernel, dim3(grid), dim3(NTHR), LDS_BYTES, stream, ka); }
#endif
}
```

```cpp
#include <hip/hip_runtime.h>
#include <cstdio>
#include <cstdint>
#define DI __device__ __forceinline__
#define LAS __attribute__((address_space(3)))
typedef unsigned short bf16;
typedef float f32x4 __attribute__((ext_vector_type(4)));
typedef unsigned u32x4 __attribute__((ext_vector_type(4)));
typedef unsigned u32x2 __attribute__((ext_vector_type(2)));

constexpr int D = 2048, SEQ = 16384, CTXL = 256, MT = SEQ + CTXL  , DEPTH = 2;
constexpr int NCOLS_IN = 17440;
constexpr int ZC = 17664;
constexpr int Z_HG = 0, Z_GL = 5120, Z_HY = 8192, Z_MG = 11264, Z_LR = 17408;
constexpr int NEXP = 32, DFF = 512, MOE_MAXROWS = 41472;
constexpr float NORM_EPS = 1e-6f;

constexpr size_t MiB = 1u << 20;
constexpr size_t WS_CTL = 0, CTL_BYTES = 1 * MiB;
constexpr size_t WS_SMALL = 1 * MiB;
constexpr size_t WS_MOD   = WS_SMALL;
constexpr size_t WS_ZBIAS = WS_MOD + (size_t)DEPTH * 2 * 12288 * 4;
constexpr size_t WS_LB    = WS_ZBIAS + (size_t)DEPTH * ZC * 4;
constexpr size_t WS_TW    = WS_LB + (size_t)DEPTH * 2 * 1024 * 4;
constexpr size_t WS_TW2   = WS_TW + 16384 * 8;
constexpr size_t WS_H2    = WS_TW2 + (8192 + 64) * 8;
constexpr size_t WS_ROUTE = WS_H2 + (size_t)DEPTH * MT * 64 * 4;
constexpr size_t WS_ROWW  = WS_ROUTE + (size_t)MT * 8 * 4;
constexpr size_t WS_TILEE = WS_ROWW + (size_t)MOE_MAXROWS * 4;
constexpr size_t WS_HYC   = WS_TILEE + 1024;
constexpr size_t WS_W3T   = WS_HYC + (size_t)2048 * 256 * 4;
constexpr size_t WS_H2B   = WS_W3T + (size_t)DEPTH * 2048 * 256 * 2;
constexpr size_t WS_WRT   = WS_H2B + (size_t)DEPTH * SEQ * 256 * 2;
constexpr size_t WS_SMALL_END = WS_WRT + (size_t)DEPTH * 2 * 48 * 2048 * 2;
static_assert(WS_SMALL_END <= 40 * MiB, "small tables");
constexpr size_t WS_WIN  = 40 * MiB;
constexpr size_t WS_WBR  = 109 * MiB;
constexpr size_t WS_WOUT = 121 * MiB;
constexpr size_t WS_WGU  = 129 * MiB;
constexpr size_t WS_CVO  = WS_WIN;
constexpr size_t WS_WD   = 257 * MiB;
constexpr size_t WS_H    = 321 * MiB;
constexpr size_t WS_U    = 451 * MiB;
constexpr size_t WS_Z    = 516 * MiB;
constexpr size_t WS_XP   = WS_Z;
constexpr size_t WS_HMID = WS_Z + 162 * MiB;
constexpr size_t WS_YP   = WS_Z + 203 * MiB;
constexpr size_t WS_YMIX = 1077 * MiB;
constexpr size_t WS_HF   = 1175 * MiB;
constexpr size_t WS_OSC  = 1175 * MiB;
constexpr size_t WS_END  = 1435 * MiB;
static_assert(WS_WIN + (size_t)ZC * D * 2 <= WS_WBR && WS_Z + (size_t)MT * ZC * 2 <= WS_YMIX && WS_YMIX + (size_t)3 * MT * 1024 * 2 <= WS_OSC && WS_OSC + (size_t)4 * MT * 1024 * 4 <= WS_END, "ws map");
static_assert(WS_YP + (size_t)MOE_MAXROWS * D * 2 <= WS_YMIX && WS_H + (size_t)MT * D * 4 <= WS_U && WS_U + (size_t)MT * D * 2 <= WS_Z, "ws map 2");
constexpr int CW_BAR = 4096;
constexpr int CW_CNT = 16384;

DI float bf2f(bf16 v) { return __uint_as_float(((unsigned)v) << 16); }
DI float bflo(unsigned w) { return __uint_as_float(w << 16); }
DI float bfhi(unsigned w) { return __uint_as_float(w & 0xffff0000u); }
typedef float f32x2_t __attribute__((ext_vector_type(2))); typedef __bf16 bf16x2_t __attribute__((ext_vector_type(2)));
DI unsigned pk_bf16(float lo, float hi) { f32x2_t v = {lo, hi}; bf16x2_t b = __builtin_convertvector(v, bf16x2_t); return __builtin_bit_cast(unsigned, b); }
DI bf16 f2bf(float f) { return (bf16)(pk_bf16(f, 0.f) & 0xffffu); }
DI float sigmoidf_(float x) { return __builtin_amdgcn_rcpf(1.0f + __expf(-x)); }
DI float siluf_(float x) { return x * __builtin_amdgcn_rcpf(1.0f + __expf(-x)); }
DI float wave_sum(float v) {
#pragma unroll
    for (int o = 32; o >= 1; o >>= 1) v += __shfl_xor(v, o);
    return v;
}
DI int otid() { int t = __builtin_amdgcn_workitem_id_x(); asm volatile("" : "+v"(t)); return t; }
DI int ogdim() { int g = __builtin_amdgcn_workgroup_id_x(); g = (int)gridDim.x; asm volatile("" : "+s"(g)); return g; }
DI int obid() { int b = __builtin_amdgcn_workgroup_id_x(); asm volatile("" : "+s"(b)); return b; }
#define AIN_DECL 1
DI LAS f32x2_t* fft_vec2_(LAS float* p) { return (LAS f32x2_t*)p; }
DI const f32x2_t* fft_vec2_(const float* p) { return (const f32x2_t*)p; }
DI f32x2_t* fft_vec2_(float* p) { return (f32x2_t*)p; }
namespace pg8 {
#define PG8_LAS __attribute__((address_space(3)))
typedef unsigned short bf16_t;
typedef short bf16x8 __attribute__((ext_vector_type(8)));
typedef float f32x4 __attribute__((ext_vector_type(4)));
typedef unsigned u32x4 __attribute__((ext_vector_type(4)));
constexpr int BM = 256, BK = 64, HALF = 128, HTB = HALF * BK * 2  , STAGE_BYTES = 8 * HTB, NXCD = 8, WGM = 8;

__host__ __device__ __forceinline__ int lds_byte(int r, int c) { const int st = (r >> 4) * 2 + (c >> 5), rr = r & 15, cc = c & 31, ob = rr * 64 + cc * 2; return st * 1024 + (ob ^ (((ob >> 9) & 1) << 5)); }
__host__ __device__ __forceinline__ void stage_rc(int b, int& R, int& C) { const int st = b / 1024, sb = b % 1024, swz = sb ^ (((sb >> 9) & 1) << 5); R = (st >> 1) * 16 + swz / 64; C = (st & 1) * 32 + (swz % 64) / 2; }
__host__ __device__ __forceinline__ int perm32(int rho) { const int n = rho >> 4, i = rho & 15; return 8 * (i >> 2) + 4 * n + (i & 3); }

struct Unit { int pm, pn; };
struct Gemm { const bf16_t* A; const bf16_t* Bt; int M, N, K; };

struct StaticOrder {
    int nM, nN, nwg, G, c;
    __host__ __device__ void init(int M, int N, int G_, int c_) { nM = M / BM; nN = N / BM; nwg = nM * nN; G = G_; c = c_; }
    __host__ __device__ bool next(int i, Unit& u) const {
        const long L = (long)i * G + c; if (L >= nwg) return false;
        int wgid = (int)L; { const int q = nwg / NXCD, r = nwg % NXCD, xcd = wgid % NXCD, off = wgid / NXCD; wgid = (xcd < r ? xcd * (q + 1) : r * (q + 1) + (xcd - r) * q) + off; }
        const int nig = WGM * nN, gid = wgid / nig, fm = gid * WGM, gsz = (nM - fm) < WGM ? (nM - fm) : WGM;
        u.pm = fm + ((wgid % nig) % gsz); u.pn = (wgid % nig) / gsz; return true;
    }
    __device__ __forceinline__ void a_ready(const Unit&) const {}
    __device__ __forceinline__ void done(const Unit&) const {}
};

template <class Epi, class Sched, bool ALIGN_EPI = false, bool SP2 = false>
__device__ __forceinline__ void gemm_phase(PG8_LAS unsigned char* lds, const Gemm g, const Sched& S, const Epi& E) {
    const int tid = otid(), wid = __builtin_amdgcn_readfirstlane(tid >> 6), lane = tid & 63, wr = wid >> 2, wc = wid & 3, fr = lane & 15, fq = lane >> 4;
    const int K = g.K, nt = K / BK;
    unsigned voffA[2], voffB[2];
#pragma unroll
    for (int i = 0; i < 2; ++i) { int R, C; stage_rc(tid * 16 + i * 8192, R, C); const int Rb = Epi::PERM2 ? ((R >> 5) * 64 + perm32(R & 31)) : Epi::PERM ? ((R & ~31) + perm32(R & 31)) : R;
        voffA[i] = (unsigned)(R * K + C) * 2u; voffB[i] = (unsigned)(Rb * K + C) * 2u; }
    const size_t kstep = (size_t)(BK * 2);
    const size_t hstep = (size_t)HALF * K * 2;
    const size_t hstepB = Epi::PERM2 ? (size_t)32 * K * 2 : hstep;
    const size_t tstep = 2 * hstep;
    const unsigned ldsw = (unsigned)wid * 1024u;
    const int aoff = lds_byte(wr * 64 + fr, fq * 8), boff = lds_byte(wc * 32 + fr, fq * 8);
#define PG8_SA(b, h) (((b) * 2 + (h)) * HTB)
#define PG8_SB(b, h) ((4 + (b) * 2 + (h)) * HTB)
#define PG8_STAGE(bufoff, gbase, voff) do { _Pragma("unroll") for (int _i = 0; _i < 2; ++_i) \
        __builtin_amdgcn_global_load_lds((const unsigned*)((const char*)(gbase) + (voff)[_i]), (PG8_LAS unsigned*)(lds + (bufoff) + ldsw + _i * 8192), 16, 0, 0); } while (0)
#define PG8_LDA(dst, b, h) do { _Pragma("unroll") for (int m = 0; m < 4; ++m) _Pragma("unroll") for (int k = 0; k < 2; ++k) dst[m][k] = *(const PG8_LAS bf16x8*)(lds + PG8_SA(b, h) + aoff + m * 2048 + k * 1024); } while (0)
#define PG8_LDB(dst, b, h) do { _Pragma("unroll") for (int n = 0; n < 2; ++n) _Pragma("unroll") for (int k = 0; k < 2; ++k) dst[n][k] = *(const PG8_LAS bf16x8*)(lds + PG8_SB(b, h) + boff + n * 2048 + k * 1024); } while (0)
#define PG8_MMA(ai, bj, At, Bt) do { __builtin_amdgcn_s_setprio(1); _Pragma("unroll") for (int m = 0; m < 4; ++m) _Pragma("unroll") for (int n = 0; n < 2; ++n) _Pragma("unroll") for (int k = 0; k < 2; ++k) \
        acc[ai][bj][m][n] = __builtin_amdgcn_mfma_f32_16x16x32_bf16(Bt[n][k], At[m][k], acc[ai][bj][m][n], 0, 0, 0); __builtin_amdgcn_s_setprio(0); } while (0)
#define PG8_WAIT_V(n) asm volatile("s_waitcnt vmcnt(" #n ")" ::: "memory")
#define PG8_WAIT_L(n) asm volatile("s_waitcnt lgkmcnt(" #n ")" ::: "memory")
#define PG8_BAR __builtin_amdgcn_s_barrier()
#define PG8_SCHED __builtin_amdgcn_sched_barrier(0)
    Unit cur, nxt; int ui = 0;
    if (!S.next(0, cur)) return;
    f32x4 acc[2][2][4][2];
#pragma unroll
    for (int a = 0; a < 2; ++a)
#pragma unroll
        for (int b = 0; b < 2; ++b)
#pragma unroll
            for (int m = 0; m < 4; ++m)
#pragma unroll
                for (int n = 0; n < 2; ++n) acc[a][b][m][n] = (f32x4){0.f, 0.f, 0.f, 0.f};
    bf16x8 At[4][2], B0[2][2], B1[2][2];
    const char* cA = (const char*)g.A + (size_t)cur.pm * tstep; const char* cB = (const char*)g.Bt + (size_t)cur.pn * tstep;
    S.a_ready(cur);
    if constexpr (SP2) {
        PG8_STAGE(PG8_SB(0, 0), cB, voffB); PG8_STAGE(PG8_SB(0, 1), cB + hstepB, voffB); PG8_STAGE(PG8_SA(0, 0), cA, voffA); PG8_STAGE(PG8_SA(0, 1), cA + hstep, voffA);
        if (wr == 1) PG8_BAR;
        PG8_WAIT_V(2); PG8_BAR;
        PG8_STAGE(PG8_SB(1, 0), cB + kstep, voffB); PG8_STAGE(PG8_SA(1, 0), cA + kstep, voffA); PG8_STAGE(PG8_SB(1, 1), cB + hstepB + kstep, voffB);
        PG8_WAIT_V(6); PG8_BAR;
    } else {
        PG8_STAGE(PG8_SB(0, 0), cB, voffB); PG8_STAGE(PG8_SA(0, 0), cA, voffA); PG8_STAGE(PG8_SB(0, 1), cB + hstepB, voffB); PG8_STAGE(PG8_SA(0, 1), cA + hstep, voffA);
        if (wr == 1) PG8_BAR;
        PG8_WAIT_V(4); PG8_BAR;
        PG8_STAGE(PG8_SB(1, 0), cB + kstep, voffB); PG8_STAGE(PG8_SA(1, 0), cA + kstep, voffA); PG8_STAGE(PG8_SB(1, 1), cB + hstepB + kstep, voffB);
        PG8_WAIT_V(6); PG8_BAR;
    }
    for (;;) {
        const bool has_next = S.next(ui + 1, nxt);
        const char* nA = has_next ? (const char*)g.A + (size_t)nxt.pm * tstep : cA; const char* nB = has_next ? (const char*)g.Bt + (size_t)nxt.pn * tstep : cB;
        for (int t = 0; t < nt; t += 2) {
            const bool last = (t == nt - 2);
            const char* a1 = cA + (size_t)(t + 1) * kstep;
            const char* a2 = last ? nA : cA + (size_t)(t + 2) * kstep; const char* b2 = last ? nB : cB + (size_t)(t + 2) * kstep;
            const char* a3 = a2 + kstep; const char* b3 = b2 + kstep;
            if (last && has_next) S.a_ready(nxt);
            if constexpr (SP2) {
            PG8_LDB(B0, 0, 0); PG8_LDB(B1, 0, 1); PG8_SCHED; PG8_LDA(At, 0, 0); PG8_STAGE(PG8_SA(1, 1), a1 + hstep, voffA);
            PG8_WAIT_V(8); PG8_WAIT_L(0); PG8_BAR; PG8_MMA(0, 0, At, B0); PG8_MMA(0, 1, At, B1); PG8_BAR; PG8_SCHED;
            PG8_LDA(At, 0, 1); PG8_STAGE(PG8_SB(0, 0), b2, voffB); PG8_STAGE(PG8_SB(0, 1), b2 + hstepB, voffB); PG8_STAGE(PG8_SA(0, 0), a2, voffA);
            PG8_WAIT_V(8); PG8_WAIT_L(0); PG8_BAR; PG8_MMA(1, 0, At, B0); PG8_MMA(1, 1, At, B1); PG8_BAR; PG8_SCHED;
            PG8_LDB(B0, 1, 0); PG8_LDB(B1, 1, 1); PG8_SCHED; PG8_LDA(At, 1, 0); PG8_STAGE(PG8_SA(0, 1), a2 + hstep, voffA);
            PG8_WAIT_V(8); PG8_WAIT_L(0); PG8_BAR; PG8_MMA(0, 0, At, B0); PG8_MMA(0, 1, At, B1); PG8_BAR; PG8_SCHED;
            PG8_LDA(At, 1, 1); PG8_STAGE(PG8_SB(1, 0), b3, voffB); PG8_STAGE(PG8_SB(1, 1), b3 + hstepB, voffB); PG8_STAGE(PG8_SA(1, 0), a3, voffA);
            PG8_WAIT_V(8); PG8_WAIT_L(0); PG8_BAR; PG8_MMA(1, 0, At, B0); PG8_MMA(1, 1, At, B1); PG8_BAR; PG8_SCHED;
            } else {
            PG8_LDB(B0, 0, 0); PG8_SCHED; PG8_LDA(At, 0, 0); PG8_STAGE(PG8_SA(1, 1), a1 + hstep, voffA);
            PG8_WAIT_L(8); PG8_BAR; PG8_WAIT_L(0); PG8_MMA(0, 0, At, B0); PG8_BAR; PG8_SCHED;
            PG8_LDB(B1, 0, 1); PG8_STAGE(PG8_SB(0, 0), b2, voffB);
            PG8_BAR; PG8_WAIT_L(0); PG8_MMA(0, 1, At, B1); PG8_BAR;
            PG8_LDA(At, 0, 1); PG8_STAGE(PG8_SA(0, 0), a2, voffA);
            PG8_BAR; PG8_WAIT_L(0); PG8_MMA(1, 0, At, B0); PG8_BAR; PG8_SCHED;
            PG8_STAGE(PG8_SB(0, 1), b2 + hstepB, voffB);
            PG8_WAIT_V(6); PG8_BAR; PG8_MMA(1, 1, At, B1); PG8_BAR;
            PG8_LDB(B0, 1, 0); PG8_SCHED; PG8_LDA(At, 1, 0); PG8_STAGE(PG8_SA(0, 1), a2 + hstep, voffA);
            PG8_WAIT_L(8); PG8_BAR; PG8_WAIT_L(0); PG8_MMA(0, 0, At, B0); PG8_BAR; PG8_SCHED;
            PG8_LDB(B1, 1, 1); PG8_STAGE(PG8_SB(1, 0), b3, voffB);
            PG8_BAR; PG8_WAIT_L(0); PG8_MMA(0, 1, At, B1); PG8_BAR;
            PG8_LDA(At, 1, 1); PG8_STAGE(PG8_SA(1, 0), a3, voffA);
            PG8_BAR; PG8_WAIT_L(0); PG8_MMA(1, 0, At, B0); PG8_BAR; PG8_SCHED;
            PG8_STAGE(PG8_SB(1, 1), b3 + hstepB, voffB);
            PG8_WAIT_V(6); PG8_BAR; PG8_MMA(1, 1, At, B1); PG8_BAR;
            }
        }
        if constexpr (ALIGN_EPI) { if (wr == 0) PG8_BAR; }
        if constexpr (Epi::CHAIN) { E.chain(acc, cur, wr, wc, fr, fq); S.done(cur); }
        else if constexpr (!Epi::AFTER_DRAIN) { E(acc, cur, wr, wc, fr, fq); S.done(cur); }
        if (!has_next) break;
        bool keep_acc = false; if constexpr (Epi::CHAIN) keep_acc = E.keep(cur);
        if (!keep_acc) {
#pragma unroll
        for (int a = 0; a < 2; ++a)
#pragma unroll
            for (int b = 0; b < 2; ++b)
#pragma unroll
                for (int m = 0; m < 4; ++m)
#pragma unroll
                    for (int n = 0; n < 2; ++n) acc[a][b][m][n] = (f32x4){0.f, 0.f, 0.f, 0.f};
        }
        cur = nxt; cA = nA; cB = nB; ++ui;
        if constexpr (ALIGN_EPI) { if (wr == 1) PG8_BAR; }
    }
    PG8_WAIT_V(0);
    if constexpr (!ALIGN_EPI) { if (wr == 0) PG8_BAR; }
    PG8_BAR;
    if constexpr (Epi::AFTER_DRAIN) { E.fused(acc, cur, wr, wc, fr, fq, lds, wid, lane); S.done(cur); }
#undef PG8_SA
#undef PG8_SB
#undef PG8_STAGE
#undef PG8_LDA
#undef PG8_LDB
#undef PG8_MMA
#undef PG8_WAIT_V
#undef PG8_WAIT_L
#undef PG8_BAR
#undef PG8_SCHED
}
}
#define XB_TMO      128
#define XB_XCNT(j)  (256  + 64 * (j))
#define XB_XSUB(j)  (1280 + 64 * (j))
#define XB_XGEN(j)  (2304 + 64 * (j))
#define XB_TOP      3328
#define XB_TOPGEN   3392
#define XCD_BAR_WORDS 3456
#define XB_SPIN_CAP (1u << 18)

__device__ __forceinline__ unsigned xb_ld(unsigned* p)              { return __hip_atomic_load(p, __ATOMIC_RELAXED, __HIP_MEMORY_SCOPE_AGENT); }
__device__ __forceinline__ unsigned xb_add(unsigned* p, unsigned v) { return __hip_atomic_fetch_add(p, v, __ATOMIC_RELAXED, __HIP_MEMORY_SCOPE_AGENT); }
__device__ __forceinline__ unsigned xb_xcc_id() { return (unsigned)__builtin_amdgcn_s_getreg((3 << 11) | 20) & 0xFu; }
#define XB_SPIN(cond, bar) do { unsigned _sp = 0; while (cond) { __builtin_amdgcn_s_sleep(1); \
    if ((++_sp & 255u) == 0u) { if (xb_ld(&(bar)[XB_TMO])) break; if (_sp > XB_SPIN_CAP) { atomicAdd(&(bar)[XB_TMO], 1u); break; } } } } while (0)

struct XcdBarrier {
    unsigned* bar; unsigned x;
    volatile LAS unsigned* st;
};

__device__ __forceinline__ XcdBarrier xcd_barrier_post(unsigned* bar, volatile LAS unsigned* st) {
    XcdBarrier b; b.bar = bar; b.x = xb_xcc_id(); b.st = st;
    if (otid() == 0) (void)xb_add(&bar[XB_XCNT(b.x)], 1u);
    return b;
}
__device__ __forceinline__ void xcd_barrier_complete(unsigned* bar, unsigned x, unsigned& nloc, unsigned& nx) {
    asm volatile("" : "+s"(x));
    const unsigned G = ogdim();
    unsigned sum, cnt, mine, sp = 0u;
    for (;;) {
        sum = 0u; cnt = 0u; mine = 0u;
#pragma unroll
        for (unsigned j = 0; j < 16; ++j) { const unsigned c = xb_ld(&bar[XB_XCNT(j)]); sum += c; cnt += (c > 0u) ? 1u : 0u; mine = (j == x) ? c : mine; }
        if (sum == G) break;
        __builtin_amdgcn_s_sleep(1);
        if ((++sp & 255u) == 0u) { if (xb_ld(&bar[XB_TMO])) break; if (sp > XB_SPIN_CAP) { atomicAdd(&bar[XB_TMO], 1u); break; } }
    }
    nloc = mine > 0u ? mine : 1u; nx = cnt > 0u ? cnt : 1u;
}

__device__ __forceinline__ void xcd_barrier(const XcdBarrier& b) {
    asm volatile("s_waitcnt vmcnt(0)" ::: "memory");
    __syncthreads();
    if (otid() == 0) {
        unsigned* bar = b.bar;
        __builtin_amdgcn_s_waitcnt(0);
        unsigned nloc = b.st[0], nx = b.st[1];
        if (nloc == 0u) { xcd_barrier_complete(bar, b.x, nloc, nx); b.st[0] = nloc; b.st[1] = nx; }
        const unsigned old = xb_add(&bar[XB_XSUB(b.x)], 1u);
        const unsigned gen = old / nloc;
        if (old + 1u == (gen + 1u) * nloc) {
            __builtin_amdgcn_fence(__ATOMIC_RELEASE, "agent");
            asm volatile("s_waitcnt vmcnt(0)" ::: "memory");
            const unsigned og = xb_add(&bar[XB_TOP], 1u);
            const unsigned tg = og / nx;
            if (og + 1u == (tg + 1u) * nx) xb_add(&bar[XB_TOPGEN], 1u);
            else XB_SPIN(xb_ld(&bar[XB_TOPGEN]) == tg, bar);
            __builtin_amdgcn_fence(__ATOMIC_ACQUIRE, "agent");
            xb_add(&bar[XB_XGEN(b.x)], 1u);
            asm volatile("s_waitcnt vmcnt(0)" ::: "memory");
        } else {
            XB_SPIN(xb_ld(&bar[XB_XGEN(b.x)]) == gen, bar);
            __builtin_amdgcn_fence(__ATOMIC_ACQUIRE, "agent");
            asm volatile("s_waitcnt vmcnt(0)" ::: "memory");
        }
    }
    __syncthreads();
}

#define FFT_DI DI
struct cpx; template <class P> DI cpx fft_ldc_(P p, int i); template <class P> DI void fft_stc_(P p, int i, const cpx& v);
#define FFT_LDC(p, i) fft_ldc_((p), (i))
#define FFT_STC(p, i, v) fft_stc_((p), (i), (v))
#define FFT_M 16384
#define FFT_NT 512
struct cpx { float x, y; };
#ifdef FFT_LDC
template <class P> FFT_DI cpx fft_ldc_(P p, int i) { const f32x2_t v = *(const decltype(fft_vec2_(p)))(p + 2 * i); cpx r; r.x = v[0]; r.y = v[1]; return r; }
template <class P> FFT_DI void fft_stc_(P p, int i, const cpx& v) { f32x2_t w = {v.x, v.y}; *(decltype(fft_vec2_(p)))(p + 2 * i) = w; }
#endif
#ifndef FFT_LDC
#define FFT_LDC(p, i) ([&]{ cpx r_; r_.x = (p)[2 * (i)]; r_.y = (p)[2 * (i) + 1]; return r_; }())
#define FFT_STC(p, i, v) do { (p)[2 * (i)] = (v).x; (p)[2 * (i) + 1] = (v).y; } while (0)
#endif
FFT_DI cpx cmul(cpx a, cpx b) { cpx r; r.x = a.x * b.x - a.y * b.y; r.y = a.x * b.y + a.y * b.x; return r; }
FFT_DI cpx cmulc(cpx a, cpx b) { cpx r; r.x = a.x * b.x + a.y * b.y; r.y = a.y * b.x - a.x * b.y; return r; }
FFT_DI int rev4_14(int k) {
    int r = 0;
#pragma unroll
    for (int d = 0; d < 7; ++d) { r = (r << 2) | (k & 3); k >>= 2; }
    return r;
}
struct FftTw { cpx c256[3], c64[3], c16[3], c4[3]; };
template <class TP> FFT_DI void fft_load_tw(FftTw& T, TP tw, int tid) {
#pragma unroll
    for (int q = 0; q < 3; ++q) { T.c256[q] = FFT_LDC(tw, (q + 1) * (tid & 255) * 16); T.c64[q] = FFT_LDC(tw, (q + 1) * (tid & 63) * 64); T.c16[q] = FFT_LDC(tw, (q + 1) * (tid & 15) * 256); T.c4[q] = FFT_LDC(tw, (q + 1) * (tid & 3) * 1024); }
}
template <int s, class TP> FFT_DI void fft_pick_tw(const FftTw& T, TP tw, int pos, int j, cpx& w1, cpx& w2, cpx& w3) {
    if (s == 4096) { w1 = FFT_LDC(tw, pos); w2 = FFT_LDC(tw, 2 * pos); w3 = FFT_LDC(tw, 3 * pos); }
    else if (s == 1024) { w1 = FFT_LDC(tw, 4 * pos); w2 = FFT_LDC(tw, 8 * pos); w3 = FFT_LDC(tw, 12 * pos); }
    else if (s == 256) { w1 = T.c256[0]; w2 = T.c256[1]; w3 = T.c256[2]; }
    else if (s == 64) { w1 = T.c64[0]; w2 = T.c64[1]; w3 = T.c64[2]; }
    else if (s == 16) { w1 = T.c16[0]; w2 = T.c16[1]; w3 = T.c16[2]; }
    else if (s == 4) { w1 = T.c4[0]; w2 = T.c4[1]; w3 = T.c4[2]; }
}
template <int s, class LP, class TP> FFT_DI void fft_fwd_pass(LP lds, const FftTw& T, TP tw, int tid) {
    cpx w1, w2, w3;
#pragma unroll 4
    for (int jj = 0; jj < FFT_M / 4 / FFT_NT; ++jj) { const int b = tid + FFT_NT * jj;
        const int pos = b & (s - 1), base = ((b & ~(s - 1)) << 2) + pos;
        const cpx a0 = FFT_LDC(lds, base), a1 = FFT_LDC(lds, base + s), a2 = FFT_LDC(lds, base + 2 * s), a3 = FFT_LDC(lds, base + 3 * s);
        cpx t0, t1, t2, t3;
        t0.x = a0.x + a2.x; t0.y = a0.y + a2.y;
        t1.x = a0.x - a2.x; t1.y = a0.y - a2.y;
        t2.x = a1.x + a3.x; t2.y = a1.y + a3.y;
        t3.x = a1.x - a3.x; t3.y = a1.y - a3.y;
        cpx y0, y1, y2, y3;
        y0.x = t0.x + t2.x; y0.y = t0.y + t2.y;
        y2.x = t0.x - t2.x; y2.y = t0.y - t2.y;
        y1.x = t1.x + t3.y; y1.y = t1.y - t3.x;
        y3.x = t1.x - t3.y; y3.y = t1.y + t3.x;
        if (s > 1) {
            fft_pick_tw<s>(T, tw, pos, jj, w1, w2, w3);
            y1 = cmul(y1, w1); y2 = cmul(y2, w2); y3 = cmul(y3, w3);
        }
        FFT_STC(lds, base, y0); FFT_STC(lds, base + s, y1); FFT_STC(lds, base + 2 * s, y2); FFT_STC(lds, base + 3 * s, y3);
    }
}
template <int s, class LP, class TP> FFT_DI void fft_inv_pass(LP lds, const FftTw& T, TP tw, int tid) {
    cpx w1, w2, w3;
#pragma unroll 4
    for (int jj = 0; jj < FFT_M / 4 / FFT_NT; ++jj) { const int b = tid + FFT_NT * jj;
        const int pos = b & (s - 1), base = ((b & ~(s - 1)) << 2) + pos;
        const cpx b0 = FFT_LDC(lds, base); cpx c1 = FFT_LDC(lds, base + s), c2 = FFT_LDC(lds, base + 2 * s), c3 = FFT_LDC(lds, base + 3 * s);
        if (s > 1) {
            fft_pick_tw<s>(T, tw, pos, jj, w1, w2, w3);
            c1 = cmulc(c1, w1); c2 = cmulc(c2, w2); c3 = cmulc(c3, w3);
        }
        cpx t0, t1, t2, t3;
        t0.x = b0.x + c2.x; t0.y = b0.y + c2.y;
        t1.x = b0.x - c2.x; t1.y = b0.y - c2.y;
        t2.x = c1.x + c3.x; t2.y = c1.y + c3.y;
        t3.x = c1.x - c3.x; t3.y = c1.y - c3.y;
        cpx x0, x1, x2, x3;
        x0.x = t0.x + t2.x; x0.y = t0.y + t2.y;
        x2.x = t0.x - t2.x; x2.y = t0.y - t2.y;
        x1.x = t1.x - t3.y; x1.y = t1.y + t3.x;
        x3.x = t1.x + t3.y; x3.y = t1.y - t3.x;
        FFT_STC(lds, base, x0); FFT_STC(lds, base + s, x1); FFT_STC(lds, base + 2 * s, x2); FFT_STC(lds, base + 3 * s, x3);
    }
}
template <class LP, class TP> FFT_DI void rfft_untangle(LP lds, TP tw2, int k, cpx& Xk, cpx& Xm) {
    if (k == 0) {
        const float zr = lds[0], zi = lds[1];
        Xk.x = zr + zi; Xk.y = zr - zi;
        const int p = rev4_14(FFT_M / 2);
        Xm.x = lds[2 * p]; Xm.y = -lds[2 * p + 1];
        return;
    }
    const int pk = rev4_14(k), pm = rev4_14(FFT_M - k);
    cpx Zk, Zm; Zk.x = lds[2 * pk]; Zk.y = lds[2 * pk + 1]; Zm.x = lds[2 * pm]; Zm.y = lds[2 * pm + 1];
    cpx E, O, W, WO;
    E.x = 0.5f * (Zk.x + Zm.x); E.y = 0.5f * (Zk.y - Zm.y);
    O.x = 0.5f * (Zk.y + Zm.y); O.y = -0.5f * (Zk.x - Zm.x);
    W.x = tw2[2 * k]; W.y = tw2[2 * k + 1];
    WO = cmul(W, O);
    Xk.x = E.x + WO.x; Xk.y = E.y + WO.y;
    Xm.x = E.x - WO.x; Xm.y = -(E.y - WO.y);
}
template <class LP, class TP> FFT_DI void rfft_mul_retangle(LP lds, TP tw2, int k, cpx Gk, cpx Gm) {
    cpx Xk, Xm; rfft_untangle(lds, tw2, k, Xk, Xm);
    if (k == 0) {
        const float y0 = Xk.x * Gk.x, yM = Xk.y * Gk.y;
        lds[0] = 0.5f * (y0 + yM); lds[1] = 0.5f * (y0 - yM);
        const cpx Y = cmul(Xm, Gm);
        const int p = rev4_14(FFT_M / 2);
        lds[2 * p] = Y.x; lds[2 * p + 1] = -Y.y;
        return;
    }
    const cpx Yk = cmul(Xk, Gk), Ym = cmul(Xm, Gm);
    cpx W; W.x = tw2[2 * k]; W.y = tw2[2 * k + 1];
    cpx A, D, T;
    A.x = 0.5f * (Yk.x + Ym.x); A.y = 0.5f * (Yk.y - Ym.y);
    D.x = 0.5f * (Yk.x - Ym.x); D.y = 0.5f * (Yk.y + Ym.y);
    T = cmulc(D, W);
    const int pk = rev4_14(k), pm = rev4_14(FFT_M - k);
    lds[2 * pk] = A.x - T.y; lds[2 * pk + 1] = A.y + T.x;
    cpx Dc; Dc.x = -D.x; Dc.y = D.y;
    const cpx T2 = cmul(W, Dc);
    lds[2 * pm] = A.x + T2.y; lds[2 * pm + 1] = -A.y - T2.x;
}
enum { I_X = 0, I_C, I_CTX, I_CCTX, I_WMOD, I_BMOD, I_NMIXW, I_NFFNW, I_WIN, I_BIN, I_HYCW, I_HYCB, I_HYW1, I_HYB1, I_HYW2, I_HYB2, I_HYW3, I_HYB3, I_HYFREQ, I_HYSKIP,
       I_HGLB, I_HGNW, I_GLWA2, I_GLBA, I_GLNW, I_WBR, I_WOUT, I_WRG, I_BRG, I_WRE, I_BRE, I_WGATE, I_WUP, I_WDOWN, I_FNW, N_IN };
struct Args { const float* in[N_IN]; float* out; unsigned char* ws; int ph_lo, ph_hi; };
#define GAS __attribute__((address_space(1)))
extern __shared__ __attribute__((aligned(16))) unsigned char lds_raw[];
constexpr int LDS_PTAB = 150 * 1024 - 64 - 320;
DI LAS unsigned char* ldsbase() { unsigned p = (unsigned)(unsigned long long)(LAS unsigned char*)lds_raw; asm volatile("" : "+s"(p)); return (LAS unsigned char*)(unsigned long long)p; }
DI const float* ain(const Args&, int i) { const unsigned long long v = ((LAS unsigned long long*)(ldsbase() + LDS_PTAB))[i];
    const unsigned lo = __builtin_amdgcn_readfirstlane((unsigned)v), hi = __builtin_amdgcn_readfirstlane((unsigned)(v >> 32)); return (const float*)(GAS const float*)(((unsigned long long)hi << 32) | lo); }
DI unsigned char* wsp(const Args& a) { unsigned long long p = (unsigned long long)(a).ws; asm volatile("" : "+s"(p)); return (unsigned char*)(GAS unsigned char*)p; }
DI int opq(int x) { asm volatile("" : "+s"(x)); return x; }
#ifdef PROBE_SEL
constexpr int LDS_TIM = 150 * 1024 - 64 - 320 - 512;
#define TIC() const unsigned long long tic_ = __builtin_amdgcn_s_memrealtime()
#define TOC(i) do { if (otid() == 0) ((LAS unsigned long long*)(ldsbase() + LDS_TIM))[i] += __builtin_amdgcn_s_memrealtime() - tic_; } while (0)
#else
#define TIC() do {} while (0)
#define TOC(i) do {} while (0)
#endif
#define LDS_BAR() do { asm volatile("s_waitcnt lgkmcnt(0)" ::: "memory"); __builtin_amdgcn_s_barrier(); asm volatile("" ::: "memory"); } while (0)
constexpr int NTHR = 512;
constexpr int LDS_BYTES = 150 * 1024;
constexpr int LDS_X = 131072;
constexpr int LDS_BARW = LDS_BYTES - 64;

DI int z_srccol(int zc) { return zc < 8192 ? zc : (zc < Z_LR ? zc + 32 : (zc < Z_LR + 32 ? zc - Z_LR + 8192 : -1)); }

template <bool RDONLY = false> DI void cvt_wtile(const float* __restrict__ src, size_t ld, int sc, bf16* __restrict__ dst, int K, int row0, int kb, LAS float* t  ) {
    const int nn = otid() & 63;
    float v[64];
    if (sc >= 0) {
#pragma unroll
        for (int p = 0; p < 64; ++p) v[p] = __builtin_nontemporal_load(src + (size_t)(kb * 64 + p) * ld + sc);
    } else {
#pragma unroll
        for (int p = 0; p < 64; ++p) v[p] = 0.f;
    }
    if (RDONLY) { float s = 0.f;
#pragma unroll
        for (int p = 0; p < 64; ++p) s += v[p];
        asm volatile("" :: "v"(s)); return; }
#pragma unroll
    for (int p = 0; p < 64; ++p) t[p * 65 + nn] = v[p];
    asm volatile("s_waitcnt lgkmcnt(0)" ::: "memory");
    const int rsub = nn >> 3, kp = nn & 7;
#pragma unroll
    for (int q = 0; q < 8; ++q) { const int row = q * 8 + rsub; float w[8];
#pragma unroll
        for (int j = 0; j < 8; ++j) w[j] = t[(kp * 8 + j) * 65 + row];
        u32x4 o; o.x = pk_bf16(w[0], w[1]); o.y = pk_bf16(w[2], w[3]); o.z = pk_bf16(w[4], w[5]); o.w = pk_bf16(w[6], w[7]);
        *(u32x4*)(dst + (size_t)(row0 + row) * K + kb * 64 + kp * 8) = o; }
    asm volatile("s_waitcnt lgkmcnt(0)" ::: "memory");
}
constexpr int CVT_MIX_TILES = 276 * 32 + 3 * 32 * 16 + 32 * 32;
DI void cvt_mix_wtile(const Args& a, int l, int it, LAS float* t) {
    const int nn = otid() & 63;
    if (it < 276 * 32) { const int nb = it >> 5, kb = it & 31; cvt_wtile(ain(a, I_WIN) + (size_t)l * D * NCOLS_IN, NCOLS_IN, z_srccol(nb * 64 + nn), (bf16*)(wsp(a) + WS_WIN), D, nb * 64, kb, t); return; }
    it -= 276 * 32;
    if (it < 3 * 32 * 16) { const int br = it / 512, r = it % 512, nb = r >> 4, kb = r & 15;
        cvt_wtile(ain(a, I_WBR) + ((size_t)l * 3 + br) * 1024 * D, D, nb * 64 + nn, (bf16*)(wsp(a) + WS_WBR) + (size_t)br * D * 1024, 1024, nb * 64, kb, t); return; }
    it -= 3 * 32 * 16;
    { const int nb = it >> 5, kb = it & 31; cvt_wtile(ain(a, I_WOUT) + (size_t)l * D * D, D, nb * 64 + nn, (bf16*)(wsp(a) + WS_WOUT), D, nb * 64, kb, t); }
}
constexpr int CVT_MOE_TILES = 32 * 16 * 32 + 32 * 32 * 8;
template <bool RDONLY = false> DI void cvt_moe_wtile(const Args& a, int l, int it, LAS float* t) {
    const int nn = otid() & 63;
    if (it < 32 * 16 * 32) { const int e = it >> 9, r = it & 511, nb = r >> 5, kb = r & 31, nt = nb >> 2, sub = nb & 3;
        const float* src = (sub < 2 ? ain(a, I_WGATE) : ain(a, I_WUP)) + ((size_t)l * NEXP + e) * D * DFF;
        cvt_wtile<RDONLY>(src, DFF, nt * 128 + (sub & 1) * 64 + nn, (bf16*)(wsp(a) + WS_WGU) + (size_t)e * 1024 * D, D, nb * 64, kb, t); return; }
    it -= 32 * 16 * 32;
    { const int e = it >> 8, r = it & 255, nb = r >> 3, kb = r & 7;
      cvt_wtile<RDONLY>(ain(a, I_WDOWN) + ((size_t)l * NEXP + e) * DFF * D, D, nb * 64 + nn, (bf16*)(wsp(a) + WS_WD) + (size_t)e * D * DFF, DFF, nb * 64, kb, t); }
}
template <bool MOE, bool RDONLY = false> DI void cvt_stream(const Args& a, int l, LAS float* ldsf) {
    const int wave = __builtin_amdgcn_readfirstlane(otid() >> 6), n = MOE ? CVT_MOE_TILES : CVT_MIX_TILES, g_ = ogdim(), nw = g_ * 8;
    LAS float* t = ldsf + wave * (64 * 65);
    for (int it = wave * g_ + (int)obid(); it < n; it += nw) { if (MOE) cvt_moe_wtile<RDONLY>(a, l, it, t); else cvt_mix_wtile(a, l, it, t); }
}

DI void mod_item(const Args& a, int j, LAS float* lds) {
    const int tid = otid(), l = j >> 7, col0 = (j & 127) * 96;
    LAS float* sil = lds;
    LAS float* red = lds + 4096;
    for (int k = tid; k < 2 * D; k += NTHR) { const float c = (k < D) ? ain(a, I_C)[k] : ain(a, I_CCTX)[k - D]; sil[k] = siluf_(c); }
    __syncthreads();
    const int cg = tid % 24, rg = tid / 24;
    f32x4 a0 = {0.f, 0.f, 0.f, 0.f}, a1 = {0.f, 0.f, 0.f, 0.f};
    if (rg < 21) {
        const float* w = ain(a, I_WMOD) + (size_t)l * D * 12288 + col0 + cg * 4;
        for (int k = rg; k < D; k += 21) { const f32x4 wv = *(const f32x4*)(w + (size_t)k * 12288); a0 += wv * sil[k]; a1 += wv * sil[D + k]; }
#pragma unroll
        for (int q = 0; q < 4; ++q) { red[(rg * 2 + 0) * 96 + cg * 4 + q] = a0[q]; red[(rg * 2 + 1) * 96 + cg * 4 + q] = a1[q]; }
    }
    __syncthreads();
    if (tid < 192) { const int set = tid / 96, c = tid % 96; float s = 0.f;
        for (int r = 0; r < 21; ++r) s += red[(r * 2 + set) * 96 + c];
        ((float*)(wsp(a) + WS_MOD))[((size_t)l * 2 + set) * 12288 + col0 + c] = s + ain(a, I_BMOD)[(size_t)l * 12288 + col0 + c]; }
    __syncthreads();
}
DI void h2_rows(const Args& a, LAS float* ldsf) {
    const int lane = otid() & 63, wave = __builtin_amdgcn_readfirstlane(otid() >> 6), g_ = ogdim(), nw = g_ * 8, gw = wave * g_ + (int)obid();
    const int l = gw >= nw / 2 ? 1 : 0, w0 = gw - l * (nw / 2), wstep = nw / 2;
    LAS float* fe = ldsf + wave * 128; LAS float* h1 = fe + 64;
    float w1c[33], w2c[64];
    { const float* w1 = ain(a, I_HYW1) + (size_t)l * 33 * 64; const float* w2 = ain(a, I_HYW2) + (size_t)l * 64 * 64;
#pragma unroll
      for (int i = 0; i < 33; ++i) w1c[i] = w1[i * 64 + lane];
#pragma unroll
      for (int i = 0; i < 64; ++i) w2c[i] = w2[i * 64 + lane]; }
    const float b1 = ain(a, I_HYB1)[l * 64 + lane], b2 = ain(a, I_HYB2)[l * 64 + lane], fq_ = ain(a, I_HYFREQ)[l * 64 + lane];
    float* H2 = (float*)(wsp(a) + WS_H2) + (size_t)l * MT * 64; bf16* H2B = (bf16*)(wsp(a) + WS_H2B) + (size_t)l * SEQ * 256;
    for (int r = w0; r < MT; r += wstep) {
        const int Lq = r < SEQ ? SEQ : CTXL, t = r < SEQ ? r : r - SEQ;
        if (lane < 33) { float f;
            if (lane == 0) f = (float)t / (float)(Lq - 1);
            else { const int bi = (lane - 1) & 15; const float band = 1e-4f + (float)bi * ((15.0f - 1e-4f) / 15.0f); const float rev2 = 2.0f * band * (float)t / (float)Lq;
                f = (lane <= 16) ? cospif(rev2) : -sinpif(rev2); }
            fe[lane] = f; }
        asm volatile("s_waitcnt lgkmcnt(0)" ::: "memory");
        float s = b1;
#pragma unroll
        for (int i = 0; i < 33; ++i) s += fe[i] * w1c[i];
        h1[lane] = sinf(fq_ * s);
        asm volatile("s_waitcnt lgkmcnt(0)" ::: "memory");
        float s2 = b2;
#pragma unroll
        for (int i = 0; i < 64; ++i) s2 += h1[i] * w2c[i];
        const float hv = sinf(fq_ * s2);
        H2[(size_t)r * 64 + lane] = hv;
        if (r < SEQ) { bf16* hb = H2B + (size_t)r * 256; hb[lane] = f2bf(hv); hb[64 + lane] = 0; hb[128 + lane] = 0; hb[192 + lane] = 0; }
        asm volatile("s_waitcnt lgkmcnt(0)" ::: "memory");
    }
}
DI void prologue_small(const Args& a) {
    const size_t gt = (size_t)obid() * NTHR + otid(), gs = (size_t)ogdim() * NTHR;
    float* zb = (float*)(wsp(a) + WS_ZBIAS);
    for (size_t i = gt; i < (size_t)DEPTH * ZC; i += gs) { const int l = (int)(i / ZC), zc = (int)(i % ZC), sc = z_srccol(zc); zb[i] = sc >= 0 ? ain(a, I_BIN)[(size_t)l * NCOLS_IN + sc] : 0.f; }
    float* lb = (float*)(wsp(a) + WS_LB);
    for (size_t i = gt; i < (size_t)DEPTH * 2048; i += gs) { const int l = (int)(i / 2048), j = (int)(i % 2048);
        float v = 0.f; if (l == 1) { const float r0 = ain(a, I_HGLB)[j], r1 = ain(a, I_HGLB)[2048 + j]; v = 1.0f / (1.0f + expf(r0 - r1)); }
        lb[i] = v; }
    bf16* w3t = (bf16*)(wsp(a) + WS_W3T);
    for (size_t i = gt; i < (size_t)DEPTH * 2048 * 256; i += gs) { const int l = (int)(i >> 19), fc = (int)((i >> 8) & 2047), j = (int)(i & 255); w3t[i] = j < 64 ? f2bf(ain(a, I_HYW3)[((size_t)l * 64 + j) * 2048 + fc]) : (bf16)0; }
    bf16* wrt = (bf16*)(wsp(a) + WS_WRT);
    for (size_t i = gt; i < (size_t)DEPTH * 48 * 2048; i += gs) { const int l = (int)(i / (48 * 2048)), c = (int)((i / 2048) % 48), k = (int)(i & 2047);
        const float w = c < 4 ? ain(a, I_WRG)[((size_t)l * D + k) * 4 + c] : (c < 36 ? ain(a, I_WRE)[((size_t)l * D + k) * 32 + (c - 4)] : 0.f);
        const bf16 hi = f2bf(w); wrt[((size_t)l * 2 + 0) * 48 * 2048 + (size_t)c * 2048 + k] = hi; wrt[((size_t)l * 2 + 1) * 48 * 2048 + (size_t)c * 2048 + k] = f2bf(w - bf2f(hi)); }
    float* tw = (float*)(wsp(a) + WS_TW);
    for (size_t i = gt; i < 16384; i += gs) { float s, c; sincospif(-2.0f * (float)i / 16384.0f, &s, &c); tw[2 * i] = c; tw[2 * i + 1] = s; }
    float* tw2 = (float*)(wsp(a) + WS_TW2);
    for (size_t i = gt; i <= 8192; i += gs) { float s, c; sincospif(-(float)i / 16384.0f, &s, &c); tw2[2 * i] = c; tw2[2 * i + 1] = s; }
}
DI void hyc_filters(const Args& a, int l) {
    const int lane = otid() & 63, wave = otid() >> 6;
    const float* h2 = (const float*)(wsp(a) + WS_H2) + ((size_t)l * MT + SEQ) * 64;
    const float* w3 = ain(a, I_HYW3) + (size_t)l * 64 * 2048;
    float* hyc = (float*)(wsp(a) + WS_HYC);
    const float a0 = -4.605170186f / 1.5f, a1 = -4.605170186f / 0.3f;
    for (int fc = obid() * 8 + wave; fc < 2048; fc += ogdim() * 8) {
        const int c = fc & 1023; const float delta = fabsf(a0 + (float)c * ((a1 - a0) / 1023.0f)); const float b3 = ain(a, I_HYB3)[l * 2048 + fc];
        float hv[4], ssum = 0.f;
#pragma unroll
        for (int i = 0; i < 4; ++i) { const int t = lane + 64 * i; float s = b3;
            for (int j = 0; j < 64; ++j) s += h2[t * 64 + j] * w3[j * 2048 + fc];
            const float tl = (float)t / 255.0f; hv[i] = s * (expf(-tl * delta) + 0.05f); ssum += fabsf(hv[i]); }
        ssum = wave_sum(ssum); const float inv = 1.0f / ssum;
#pragma unroll
        for (int i = 0; i < 4; ++i) hyc[(size_t)fc * 256 + lane + 64 * i] = hv[i] * inv;
    }
}
template <int MODE, bool DRY = false> DI void norm_phase(const Args& a, int l, int nrows, LAS float* ldsf) {
    const int lane = otid() & 63, wave = otid() >> 6;
    float* H = (float*)(wsp(a) + WS_H); bf16* U = (bf16*)(wsp(a) + WS_U);
    const float* modall = (const float*)(wsp(a) + WS_MOD);
    int* route = (int*)(wsp(a) + WS_ROUTE);
    const bf16* YP = (const bf16*)(wsp(a) + WS_YP);
    const bool combine = (MODE == 0 && l > 0) || MODE == 2;
    for (int r = obid() * 8 + wave; r < nrows; r += ogdim() * 8) {
        const int set = r >= SEQ ? 1 : 0;
        const float* src = (MODE == 0 && l == 0) ? (set ? ain(a, I_CTX) + (size_t)(r - SEQ) * D : ain(a, I_X) + (size_t)r * D) : H + (size_t)r * D;
        f32x4 v[8];
#pragma unroll
        for (int j = 0; j < 8; ++j) v[j] = *(const f32x4*)(src + j * 256 + lane * 4);
        if (combine) {
            const float* gt2 = modall + ((size_t)(l - 1) * 2 + set) * 12288 + 10240;
            const int p0 = route[r * 8 + 6], p1 = route[r * 8 + 7];
#pragma unroll
            for (int j = 0; j < 8; ++j) { const int col = j * 256 + lane * 4;
                const u32x2 y0 = *(const u32x2*)(YP + (size_t)p0 * D + col), y1 = *(const u32x2*)(YP + (size_t)p1 * D + col); const f32x4 g = *(const f32x4*)(gt2 + col);
                v[j][0] += g[0] * (bflo(y0.x) + bflo(y1.x)); v[j][1] += g[1] * (bfhi(y0.x) + bfhi(y1.x)); v[j][2] += g[2] * (bflo(y0.y) + bflo(y1.y)); v[j][3] += g[3] * (bfhi(y0.y) + bfhi(y1.y)); }
            if (MODE == 0) {
#pragma unroll
                for (int j = 0; j < 8; ++j) *(f32x4*)(H + (size_t)r * D + j * 256 + lane * 4) = v[j];
            }
        }
        float ss = 0.f;
#pragma unroll
        for (int j = 0; j < 8; ++j) ss += (v[j][0] * v[j][0] + v[j][1] * v[j][1]) + (v[j][2] * v[j][2] + v[j][3] * v[j][3]);
        ss = wave_sum(ss);
        const float rstd = rsqrtf(ss * (1.0f / D) + NORM_EPS);
        if (MODE == 2) {
            const float* fw = ain(a, I_FNW);
#ifdef PROBE_SEL
            const float pscale = 1.0f + 0.5f * (float)((LAS unsigned long long*)(ldsbase() + LDS_TIM))[PROBE_SEL] / (float)((LAS unsigned long long*)(ldsbase() + LDS_TIM))[0];
#else
            const float pscale = 1.0f;
#endif
            f32x4 wq[8];
#pragma unroll
            for (int j = 0; j < 8; ++j) wq[j] = *(const f32x4*)(fw + j * 256 + lane * 4);
#pragma unroll
            for (int j = 0; j < 8; ++j) { const int col = j * 256 + lane * 4; *(f32x4*)(a.out + (size_t)r * D + col) = v[j] * rstd * wq[j] * pscale; }
        } else {
            const float* nw = (MODE == 0 ? ain(a, I_NMIXW) : ain(a, I_NFFNW)) + (size_t)l * D;
            const float* md = modall + ((size_t)l * 2 + set) * 12288 + (MODE == 0 ? 0 : 6144);
#pragma unroll
            for (int j = 0; j < 8; ++j) { const int col = j * 256 + lane * 4; const f32x4 w = *(const f32x4*)(nw + col), sh = *(const f32x4*)(md + col), sc = *(const f32x4*)(md + 2048 + col);
                v[j] = (v[j] * rstd * w) * (sc + 1.0f) + sh;
                u32x2 o; o.x = pk_bf16(v[j][0], v[j][1]); o.y = pk_bf16(v[j][2], v[j][3]); *(u32x2*)(U + (size_t)r * D + col) = o; }
            if (MODE == 1) {
                const float* wrg = ain(a, I_WRG) + (size_t)l * D * 4; const float* wre = ain(a, I_WRE) + (size_t)l * D * 32;
                float lg[36];
#pragma unroll
                for (int i = 0; i < 36; ++i) lg[i] = 0.f;
                LAS float* wu = ldsf + wave * 2048;
#pragma unroll
                for (int j = 0; j < 8; ++j) *(LAS f32x4*)(wu + j * 256 + lane * 4) = v[j];
                asm volatile("s_waitcnt lgkmcnt(0)" ::: "memory");
#pragma unroll 2
                for (int cc = 0; cc < 32; ++cc) { const int col = cc * 64 + lane; const float uv = wu[col];
                    const f32x4 g = *(const f32x4*)(wrg + (size_t)col * 4);
                    lg[0] += uv * g[0]; lg[1] += uv * g[1]; lg[2] += uv * g[2]; lg[3] += uv * g[3];
#pragma unroll
                    for (int e4 = 0; e4 < 8; ++e4) { const f32x4 w = *(const f32x4*)(wre + (size_t)col * 32 + e4 * 4);
                        lg[4 + e4 * 4 + 0] += uv * w[0]; lg[4 + e4 * 4 + 1] += uv * w[1]; lg[4 + e4 * 4 + 2] += uv * w[2]; lg[4 + e4 * 4 + 3] += uv * w[3]; } }
                asm volatile("s_waitcnt lgkmcnt(0)" ::: "memory");
#pragma unroll
                for (int i = 0; i < 36; ++i) lg[i] = wave_sum(lg[i]);
                float gl[4]; int grp = 0; float gmax;
#pragma unroll
                for (int g = 0; g < 4; ++g) gl[g] = lg[g] + ain(a, I_BRG)[l * 4 + g];
                gmax = gl[0];
#pragma unroll
                for (int g = 1; g < 4; ++g) if (gl[g] > gmax) { gmax = gl[g]; grp = g; }
                float gden = 0.f;
#pragma unroll
                for (int g = 0; g < 4; ++g) gden += expf(gl[g] - gmax);
                const float ptop = 1.0f / gden;
                float le[8];
#pragma unroll
                for (int i = 0; i < 8; ++i) { float x = lg[4 + i];
#pragma unroll
                    for (int g = 1; g < 4; ++g) x = (grp == g) ? lg[4 + g * 8 + i] : x;
                    le[i] = x + ain(a, I_BRE)[l * 32 + grp * 8 + i]; }
                int i0 = 0; float m0 = le[0];
#pragma unroll
                for (int i = 1; i < 8; ++i) if (le[i] > m0) { m0 = le[i]; i0 = i; }
                int i1 = -1; float m1 = -3.0e38f;
#pragma unroll
                for (int i = 0; i < 8; ++i) if (i != i0 && le[i] > m1) { m1 = le[i]; i1 = i; }
                const float e1v = expf(m1 - m0);
                const float w0 = ptop / (1.0f + e1v), w1 = ptop * e1v / (1.0f + e1v);
                if (DRY) { asm volatile("" :: "v"(w0), "v"(w1), "v"(i0), "v"(i1), "v"(grp)); }
                else if (lane == 0) {
                    unsigned* cnt = (unsigned*)(wsp(a) + WS_CTL) + CW_CNT + l * 2048;
                    const int ex0 = grp * 8 + i0, ex1 = grp * 8 + i1;
                    const unsigned s0 = atomicAdd(cnt + ex0 * 64, 1u), s1 = atomicAdd(cnt + ex1 * 64, 1u);
                    route[r * 8 + 0] = ex0; route[r * 8 + 1] = ex1; route[r * 8 + 2] = (int)s0; route[r * 8 + 3] = (int)s1;
                    route[r * 8 + 4] = __float_as_int(w0); route[r * 8 + 5] = __float_as_int(w1);
                }
            }
        }
    }
}
typedef short bf16x8r_t __attribute__((ext_vector_type(8)));
template <bool DRY> DI void route_phase(const Args& a, int l, int nrows, LAS float* ldsf, int pv = 0) {
    const int lane = otid() & 63, wave = __builtin_amdgcn_readfirstlane(otid() >> 6), fr = lane & 15, fq = lane >> 4;
    const float* H = (const float*)(wsp(a) + WS_H); bf16* U = (bf16*)(wsp(a) + WS_U); int* route = (int*)(wsp(a) + WS_ROUTE);
    const float* nw = ain(a, I_NFFNW) + (size_t)l * D;
    const bf16* Wh = (const bf16*)(wsp(a) + WS_WRT) + (size_t)l * 2 * 48 * 2048; const bf16* Wl = Wh + 48 * 2048;
    LAS bf16* ub = (LAS bf16*)ldsf;
    LAS float* lt = ldsf + 16448 + wave * 768;
    LAS float* lfin = ldsf + 16448 + 8 * 768;
    const int G = ogdim(), bidv = obid(), ntile = nrows / 16;
    for (int tile = bidv; tile < ntile; tile += G) {
#pragma unroll
        for (int rr = 0; rr < 2; ++rr) { const int lr = wave * 2 + rr, r = tile * 16 + lr, set = r >= SEQ ? 1 : 0;
            const float* md = (const float*)(wsp(a) + WS_MOD) + ((size_t)l * 2 + set) * 12288 + 6144;
            f32x4 v[8];
#pragma unroll
            for (int j = 0; j < 8; ++j) v[j] = *(const f32x4*)(H + (size_t)r * D + j * 256 + lane * 4);
            float ss = 0.f;
#pragma unroll
            for (int j = 0; j < 8; ++j) ss += (v[j][0] * v[j][0] + v[j][1] * v[j][1]) + (v[j][2] * v[j][2] + v[j][3] * v[j][3]);
            ss = wave_sum(ss);
            const float rstd = rsqrtf(ss * (1.0f / D) + NORM_EPS);
#pragma unroll
            for (int j = 0; j < 8; ++j) { const int col = j * 256 + lane * 4; const f32x4 w = *(const f32x4*)(nw + col), sh = *(const f32x4*)(md + col), sc = *(const f32x4*)(md + 2048 + col);
                const f32x4 u = (v[j] * rstd * w) * (sc + 1.0f) + sh; u32x2 o; o.x = pk_bf16(u[0], u[1]); o.y = pk_bf16(u[2], u[3]);
                *(u32x2*)(U + (size_t)r * D + col) = o; *(LAS u32x2*)(ub + lr * 2056 + col) = o; } }
        LDS_BAR();
        f32x4 acc[3];
#pragma unroll
        for (int cb = 0; cb < 3; ++cb) acc[cb] = (f32x4){0.f, 0.f, 0.f, 0.f};
#pragma unroll
        for (int ks = 0; ks < 8; ++ks) { const int c0 = wave * 256 + ks * 32;
            const bf16x8r_t ah = *(const LAS bf16x8r_t*)(ub + fr * 2056 + c0 + fq * 8);
#pragma unroll
            for (int cb = 0; cb < 3; ++cb) { const bf16x8r_t bh = *(const bf16x8r_t*)(Wh + (size_t)(cb * 16 + fr) * 2048 + c0 + fq * 8), bl = *(const bf16x8r_t*)(Wl + (size_t)(cb * 16 + fr) * 2048 + c0 + fq * 8);
                acc[cb] = __builtin_amdgcn_mfma_f32_16x16x32_bf16(ah, bh, acc[cb], 0, 0, 0); acc[cb] = __builtin_amdgcn_mfma_f32_16x16x32_bf16(ah, bl, acc[cb], 0, 0, 0); } }
#pragma unroll
        for (int cb = 0; cb < 3; ++cb)
#pragma unroll
            for (int j = 0; j < 4; ++j) lt[(fq * 4 + j) * 48 + cb * 16 + fr] = acc[cb][j];
        LDS_BAR();
        for (int e = otid(); e < 768; e += NTHR) { float s = 0.f;
#pragma unroll
            for (int w = 0; w < 8; ++w) s += ldsf[16448 + w * 768 + e];
            lfin[e] = s; }
        LDS_BAR();
        const int half = wave, slot = 0; (void)slot;
        if (half == 0 && lane < 16) {
            const int r = tile * 16 + lane; float lg[36];
#pragma unroll
            for (int i = 0; i < 36; ++i) lg[i] = lfin[lane * 48 + i];
            float gl[4]; int grp = 0; float gmax;
#pragma unroll
            for (int g = 0; g < 4; ++g) gl[g] = lg[g] + ain(a, I_BRG)[l * 4 + g];
            gmax = gl[0];
#pragma unroll
            for (int g = 1; g < 4; ++g) if (gl[g] > gmax) { gmax = gl[g]; grp = g; }
            float gden = 0.f;
#pragma unroll
            for (int g = 0; g < 4; ++g) gden += expf(gl[g] - gmax);
            const float ptop = 1.0f / gden;
            float le[8];
#pragma unroll
            for (int i = 0; i < 8; ++i) { float x = lg[4 + i];
#pragma unroll
                for (int g = 1; g < 4; ++g) x = (grp == g) ? lg[4 + g * 8 + i] : x;
                le[i] = x + ain(a, I_BRE)[l * 32 + grp * 8 + i]; }
            int i0 = 0; float m0 = le[0];
#pragma unroll
            for (int i = 1; i < 8; ++i) if (le[i] > m0) { m0 = le[i]; i0 = i; }
            int i1 = -1; float m1 = -3.0e38f;
#pragma unroll
            for (int i = 0; i < 8; ++i) if (i != i0 && le[i] > m1) { m1 = le[i]; i1 = i; }
            const float e1v = expf(m1 - m0);
            const float w0 = ptop / (1.0f + e1v), w1 = ptop * e1v / (1.0f + e1v);
            if (DRY || (pv & 1)) { asm volatile("" :: "v"(w0), "v"(w1), "v"(i0), "v"(i1), "v"(grp)); }
            else { unsigned* cnt = (unsigned*)(wsp(a) + WS_CTL) + CW_CNT + l * 2048; const int ex0 = grp * 8 + i0, ex1 = grp * 8 + i1;
                const unsigned s0 = atomicAdd(cnt + ex0 * 64, 1u), s1 = atomicAdd(cnt + ex1 * 64, 1u);
                route[r * 8 + 0] = ex0; route[r * 8 + 1] = ex1; route[r * 8 + 2] = (int)s0; route[r * 8 + 3] = (int)s1; route[r * 8 + 4] = __float_as_int(w0); route[r * 8 + 5] = __float_as_int(w1); }
        }
        LDS_BAR();
    }
}
DI void permute_phase(const Args& a, int l, int nrows, LAS unsigned char* ldsb) {
    LAS int* poff = (LAS int*)ldsb;
    const int tid = otid(), lane = tid & 63, wave = tid >> 6;
    const unsigned* cnt = (const unsigned*)(wsp(a) + WS_CTL) + CW_CNT + l * 2048;
    if (tid == 0) { int off = 0; for (int e = 0; e < NEXP; ++e) { poff[e] = off; off += (int)((cnt[e * 64] + 255u) / 256u) * 256; } poff[32] = off; }
    __syncthreads();
    if (obid() == 0) { int* tile_e = (int*)(wsp(a) + WS_TILEE); const int nt = poff[32] >> 8;
        if (tid < 200) { int e = -1; if (tid < nt) { for (int q = 0; q < NEXP; ++q) if (poff[q] <= tid * 256) e = q; } tile_e[tid] = e < 0 ? 0 : e; }
        if (tid == 0) tile_e[200] = nt; }
    int* route = (int*)(wsp(a) + WS_ROUTE); float* roww = (float*)(wsp(a) + WS_ROWW);
    const bf16* U = (const bf16*)(wsp(a) + WS_U); bf16* XP = (bf16*)(wsp(a) + WS_XP);
    for (int r = obid() * 8 + wave; r < nrows; r += ogdim() * 8) {
        const int e0 = route[r * 8 + 0], e1 = route[r * 8 + 1], s0 = route[r * 8 + 2], s1 = route[r * 8 + 3];
        const int p0 = poff[e0] + s0, p1 = poff[e1] + s1;
        u32x4 x[4];
#pragma unroll
        for (int i = 0; i < 4; ++i) x[i] = *(const u32x4*)(U + (size_t)r * D + (i * 64 + lane) * 8);
#pragma unroll
        for (int i = 0; i < 4; ++i) { *(u32x4*)(XP + (size_t)p0 * D + (i * 64 + lane) * 8) = x[i]; *(u32x4*)(XP + (size_t)p1 * D + (i * 64 + lane) * 8) = x[i]; }
        if (lane == 0) { route[r * 8 + 6] = p0; route[r * 8 + 7] = p1; roww[p0] = __int_as_float(route[r * 8 + 4]); roww[p1] = __int_as_float(route[r * 8 + 5]); }
    }
}
DI int stream_row(int p, int dir) { return dir == 0 ? (p < CTXL ? SEQ + p : p - CTXL) : (p < CTXL ? SEQ + (CTXL - 1 - p) : (SEQ - 1) - (p - CTXL)); }

DI void unpack8(const u32x4& p, float (&v)[8]) { v[0] = bflo(p.x); v[1] = bfhi(p.x); v[2] = bflo(p.y); v[3] = bfhi(p.y); v[4] = bflo(p.z); v[5] = bfhi(p.z); v[6] = bflo(p.w); v[7] = bfhi(p.w); }
DI void shortconv_w8(const bf16* Z, const float* cw, const float* cb, int l, int seg, int c0, int r0, int lo, int hi, int lane, float (&out)[8]) {
    const int col = Z_HY + seg * 1024 + c0; float zc[8], zp[8], zn[8];
    unpack8(*(const u32x4*)(Z + (size_t)(r0 + lane) * ZC + col), zc);
    float ep[8], en[8];
    if (r0 - 1 >= lo) unpack8(*(const u32x4*)(Z + (size_t)(r0 - 1) * ZC + col), ep); else {
#pragma unroll
        for (int q = 0; q < 8; ++q) ep[q] = 0.f; }
    if (r0 + 64 < hi) unpack8(*(const u32x4*)(Z + (size_t)(r0 + 64) * ZC + col), en); else {
#pragma unroll
        for (int q = 0; q < 8; ++q) en[q] = 0.f; }
#pragma unroll
    for (int q = 0; q < 8; ++q) { const float up = __shfl_up(zc[q], 1), dn = __shfl_down(zc[q], 1); zp[q] = lane == 0 ? ep[q] : up; zn[q] = lane == 63 ? en[q] : dn; }
    const float* w = cw + (size_t)l * 3 * 3072 + seg * 1024 + c0; const float* bb = cb + (size_t)l * 3072 + seg * 1024 + c0;
    const f32x4 w0a = *(const f32x4*)w, w0b = *(const f32x4*)(w + 4), w1a = *(const f32x4*)(w + 3072), w1b = *(const f32x4*)(w + 3072 + 4), w2a = *(const f32x4*)(w + 6144), w2b = *(const f32x4*)(w + 6144 + 4), ba = *(const f32x4*)bb, b4 = *(const f32x4*)(bb + 4);
#pragma unroll
    for (int q = 0; q < 4; ++q) { out[q] = w0a[q] * zp[q] + w1a[q] * zc[q] + w2a[q] * zn[q] + ba[q]; out[4 + q] = w0b[q] * zp[4 + q] + w1b[q] * zc[4 + q] + w2b[q] * zn[4 + q] + b4[q]; }
}
DI void hyprep_witem(const Args& a, int l, int it) {
    const int lane = otid() & 63, tb = it >> 7, c0 = (it & 127) * 8, r0 = tb * 64, lo = r0 < SEQ ? 0 : SEQ, hi = r0 < SEQ ? SEQ : MT;
    const bf16* Z = (const bf16*)(wsp(a) + WS_Z); bf16* VXT = (bf16*)(wsp(a) + WS_U);
    float x1[8], vv[8];
    shortconv_w8(Z, ain(a, I_HYCW), ain(a, I_HYCB), l, 1, c0, r0, lo, hi, lane, x1); shortconv_w8(Z, ain(a, I_HYCW), ain(a, I_HYCB), l, 2, c0, r0, lo, hi, lane, vv);
#pragma unroll
    for (int q = 0; q < 8; ++q) VXT[(size_t)(c0 + q) * MT + r0 + lane] = f2bf(vv[q] * x1[q]);
}
DI void hycomb_witem(const Args& a, int l, int it) {
    const int lane = otid() & 63, tb = it >> 7, c0 = (it & 127) * 8, r0 = tb * 64, lo = r0 < SEQ ? 0 : SEQ, hi = r0 < SEQ ? SEQ : MT;
    const bf16* Z = (const bf16*)(wsp(a) + WS_Z); const bf16* CV = (const bf16*)(wsp(a) + WS_CVO); bf16* Y0 = (bf16*)(wsp(a) + WS_YMIX);
    float x0[8], y[8];
#pragma unroll
    for (int q = 0; q < 8; ++q) y[q] = bf2f(CV[(size_t)(c0 + q) * MT + r0 + lane]);
    shortconv_w8(Z, ain(a, I_HYCW), ain(a, I_HYCB), l, 0, c0, r0, lo, hi, lane, x0);
    u32x4 w; w.x = pk_bf16(y[0] * x0[0], y[1] * x0[1]); w.y = pk_bf16(y[2] * x0[2], y[3] * x0[3]); w.z = pk_bf16(y[4] * x0[4], y[5] * x0[5]); w.w = pk_bf16(y[6] * x0[6], y[7] * x0[7]);
    *(u32x4*)(Y0 + (size_t)(r0 + lane) * 1024 + c0) = w;
}
DI void scancomb_rows(const Args& a, int l, int nrows) {
    const int lane = otid() & 63, wave = otid() >> 6;
    const bf16* Z = (const bf16*)(wsp(a) + WS_Z); const bf16* O = (const bf16*)(wsp(a) + WS_OSC);
    bf16* Y1 = (bf16*)(wsp(a) + WS_YMIX) + (size_t)MT * 1024; bf16* Y2 = Y1 + (size_t)MT * 1024;
    const float* hnw = ain(a, I_HGNW) + (size_t)l * 128; const float* gnw = ain(a, I_GLNW) + (size_t)l * 256;
    for (int r = obid() * 8 + wave; r < nrows; r += ogdim() * 8) {
#pragma unroll
        for (int i = 0; i < 2; ++i) { const int col = i * 512 + lane * 8;
            { float of[8], ob[8], g[8], o[8]; unpack8(__builtin_nontemporal_load((const u32x4*)(O + (size_t)r * 1024 + col)), of); unpack8(__builtin_nontemporal_load((const u32x4*)(O + ((size_t)MT + r) * 1024 + col)), ob); unpack8(__builtin_nontemporal_load((const u32x4*)(Z + (size_t)r * ZC + Z_HG + 4096 + col)), g);
              float ss = 0.f;
#pragma unroll
              for (int q = 0; q < 8; ++q) { o[q] = of[q] + ob[q]; ss += o[q] * o[q]; }
              ss += __shfl_xor(ss, 8); ss += __shfl_xor(ss, 4); ss += __shfl_xor(ss, 2); ss += __shfl_xor(ss, 1);
              const float rstd = rsqrtf(ss * (1.0f / 128.0f) + NORM_EPS);
              const f32x4 n0 = *(const f32x4*)(hnw + (col & 127)), n1 = *(const f32x4*)(hnw + (col & 127) + 4);
              u32x4 w; w.x = pk_bf16(o[0] * rstd * n0[0] * sigmoidf_(g[0]), o[1] * rstd * n0[1] * sigmoidf_(g[1])); w.y = pk_bf16(o[2] * rstd * n0[2] * sigmoidf_(g[2]), o[3] * rstd * n0[3] * sigmoidf_(g[3]));
              w.z = pk_bf16(o[4] * rstd * n1[0] * sigmoidf_(g[4]), o[5] * rstd * n1[1] * sigmoidf_(g[5])); w.w = pk_bf16(o[6] * rstd * n1[2] * sigmoidf_(g[6]), o[7] * rstd * n1[3] * sigmoidf_(g[7]));
              *(u32x4*)(Y1 + (size_t)r * 1024 + col) = w; }
            { float of[8], ob[8], g[8], o[8]; unpack8(__builtin_nontemporal_load((const u32x4*)(O + ((size_t)2 * MT + r) * 1024 + col)), of); unpack8(__builtin_nontemporal_load((const u32x4*)(O + ((size_t)3 * MT + r) * 1024 + col)), ob); unpack8(__builtin_nontemporal_load((const u32x4*)(Z + (size_t)r * ZC + Z_GL + 2048 + col)), g);
              float ss = 0.f;
#pragma unroll
              for (int q = 0; q < 8; ++q) { o[q] = of[q] + ob[q]; ss += o[q] * o[q]; }
              ss += __shfl_xor(ss, 16); ss += __shfl_xor(ss, 8); ss += __shfl_xor(ss, 4); ss += __shfl_xor(ss, 2); ss += __shfl_xor(ss, 1);
              const float rstd = rsqrtf(ss * (1.0f / 256.0f) + NORM_EPS);
              const f32x4 n0 = *(const f32x4*)(gnw + (col & 255)), n1 = *(const f32x4*)(gnw + (col & 255) + 4);
              u32x4 w; w.x = pk_bf16(o[0] * rstd * n0[0] * siluf_(g[0]), o[1] * rstd * n0[1] * siluf_(g[1])); w.y = pk_bf16(o[2] * rstd * n0[2] * siluf_(g[2]), o[3] * rstd * n0[3] * siluf_(g[3]));
              w.z = pk_bf16(o[4] * rstd * n1[0] * siluf_(g[4]), o[5] * rstd * n1[1] * siluf_(g[5])); w.w = pk_bf16(o[6] * rstd * n1[2] * siluf_(g[6]), o[7] * rstd * n1[3] * siluf_(g[7]));
              *(u32x4*)(Y2 + (size_t)r * 1024 + col) = w; }
        }
    }
}
typedef short bf16x8_t __attribute__((ext_vector_type(8)));
constexpr int SC_N = 65;
constexpr size_t KVS_GL_OFF = (size_t)16 * SC_N * 16384;
constexpr size_t WS_KVS = WS_WGU;
constexpr size_t WS_KD  = WS_WGU + 130 * MiB;
constexpr int SL_QM = 0, SL_KM = 17408, SL_Q0 = 34816, SL_KE = 52224, SL_VT = 70656, SL_PP = 107520, SL_TOT = 116736, SL_DD = 118784, SL_AFB = 119296, SL_EB = 121344, SL_BUF2 = SL_VT + 18432;
static_assert(SL_EB + 512 <= 131072 && WS_KD + (size_t)24 * SC_N * 128 * 4 <= WS_H, "scan maps");
DI bf16x8_t lds_frag16(LAS unsigned char* p) { return *(LAS bf16x8_t*)p; }
DI bf16x8_t pack_bf16x8(const f32x4& lo, const f32x4& hi) { u32x4 w; w.x = pk_bf16(lo[0], lo[1]); w.y = pk_bf16(lo[2], lo[3]); w.z = pk_bf16(hi[0], hi[1]); w.w = pk_bf16(hi[2], hi[3]); return __builtin_bit_cast(bf16x8_t, w); }

template <bool GLA, bool OUT> DI void scan_walk(const Args& a, int l, int head, int dir, int sc, int dvh, LAS unsigned char* lds, int pv = 0) {
    constexpr int NB = 1, DV = GLA ? 256 : 128;
    const int tid = otid(), lane = tid & 63, wave = tid >> 6, fr = lane & 15, fq = lane >> 4, nbase = dvh * 8 + wave;
    const bf16* Z = (const bf16*)(wsp(a) + WS_Z);
    const int stream = GLA ? 16 + head * 2 + dir : head * 2 + dir;
    float* kvs = (float*)(wsp(a) + WS_KVS) + (GLA ? KVS_GL_OFF + ((size_t)(stream - 16) * SC_N + sc) * 32768 : ((size_t)stream * SC_N + sc) * 16384);
    float* kd = (float*)(wsp(a) + WS_KD) + ((size_t)stream * SC_N + sc) * 128;
    LAS bf16* QM = (LAS bf16*)(lds + SL_QM); LAS bf16* KM = (LAS bf16*)(lds + SL_KM); LAS float* EB = (LAS float*)(lds + SL_EB); LAS bf16* XG = (LAS bf16*)(lds + SL_Q0);
    LAS bf16* KE = (LAS bf16*)(lds + SL_KE); LAS bf16* VT = (LAS bf16*)(lds + SL_VT); LAS bf16* PP = (LAS bf16*)(lds + SL_PP);
    LAS float* TOT = (LAS float*)(lds + SL_TOT); LAS float* DD = (LAS float*)(lds + SL_DD); LAS bf16* AFB = (LAS bf16*)(lds + SL_AFB);
    const int k = wave * 16 + fr, seg = fq;
    float lbv = 0.f, bag = 0.f; bf16x8_t Bg = {0, 0, 0, 0, 0, 0, 0, 0};
    if (!GLA) lbv = ((const float*)(wsp(a) + WS_LB))[((size_t)l * 2 + dir) * 1024 + head * 128 + k];
    else {
        bag = ain(a, I_GLBA)[((size_t)l * 2 + dir) * 512 + head * 128 + wave * 16 + fr];
        if (fq < 2) { const float* wp = ain(a, I_GLWA2) + (((size_t)l * 2 + dir) * 16 + fq * 8) * 512 + head * 128 + wave * 16 + fr; float w8[8];
#pragma unroll
            for (int j = 0; j < 8; ++j) w8[j] = wp[(size_t)j * 512];
            u32x4 pw; pw.x = pk_bf16(w8[0], w8[1]); pw.y = pk_bf16(w8[2], w8[3]); pw.z = pk_bf16(w8[4], w8[5]); pw.w = pk_bf16(w8[6], w8[7]); Bg = __builtin_bit_cast(bf16x8_t, pw); } }
    f32x4 S[NB][8];
#pragma unroll
    for (int nb = 0; nb < NB; ++nb)
#pragma unroll
        for (int mb = 0; mb < 8; ++mb) { if (OUT) S[nb][mb] = *(const f32x4*)(kvs + ((size_t)((nbase + nb) * 8 + mb) * 64 + lane) * 4); else S[nb][mb] = (f32x4){0.f, 0.f, 0.f, 0.f}; }
    float dlog = 0.f;
    const int which = (GLA ? 2 : 0) + dir;
    bf16* Odir = (bf16*)(wsp(a) + WS_OSC) + (size_t)which * MT * 1024;
    const int srow = tid >> 3, spc = (tid & 7) * 16;
    const int vcol = (GLA ? Z_GL + 1024 + head * 256 + dvh * 128 : Z_HG + 3072 + head * 128) + spc;
    const int fcol = (GLA ? Z_GL + 512 + head * 128 : Z_HG + 1024 * (1 + dir) + head * 128) + spc, qcol = (GLA ? Z_GL + head * 128 : Z_HG + head * 128) + spc;
    u32x4 pv0, pv1, pf0, pf1, pq0 = {0u, 0u, 0u, 0u}, pq1 = {0u, 0u, 0u, 0u}, pa = {0u, 0u, 0u, 0u};
#define SCAN_ISSUE(cidx) do { const int r0n_ = dir ? stream_row((cidx) * 64 + 63, 1) : stream_row((cidx) * 64, 0); \
        const bf16* zr_ = Z + (size_t)(r0n_ + srow) * ZC; pv0 = *(const u32x4*)(zr_ + vcol); pv1 = *(const u32x4*)(zr_ + vcol + 8); \
        pf0 = *(const u32x4*)(zr_ + fcol); pf1 = *(const u32x4*)(zr_ + fcol + 8); \
        if (OUT) { pq0 = *(const u32x4*)(zr_ + qcol); pq1 = *(const u32x4*)(zr_ + qcol + 8); } \
        if (GLA && tid < 128) pa = *(const u32x4*)(Z + (size_t)(r0n_ + (tid >> 1)) * ZC + Z_LR + dir * 16 + (tid & 1) * 8); } while (0)
    SCAN_ISSUE(sc * 4);
    for (int cc = 0; cc < 4; ++cc) {
        const int qmoff = (OUT && (cc & 1)) ? SL_BUF2 : SL_QM, vtoff = (!OUT && (cc & 1)) ? SL_BUF2 : SL_VT;
        LAS bf16* QMc = (LAS bf16*)(lds + qmoff); LAS bf16* VTc = (LAS bf16*)(lds + vtoff);
        const int c = sc * 4 + cc; const int r0 = dir ? stream_row(c * 64 + 63, 1) : stream_row(c * 64, 0);
        {
          *(LAS u32x4*)(VTc + srow * 136 + spc) = pv0; *(LAS u32x4*)(VTc + srow * 136 + spc + 8) = pv1;
          *(LAS u32x4*)(KM + srow * 136 + spc) = pf0; *(LAS u32x4*)(KM + srow * 136 + spc + 8) = pf1;
          if (OUT) { *(LAS u32x4*)(QMc + srow * 136 + spc) = pq0; *(LAS u32x4*)(QMc + srow * 136 + spc + 8) = pq1; }
          if (GLA && tid < 128) *(LAS u32x4*)(AFB + (tid >> 1) * 16 + (tid & 1) * 8) = pa;
          if (cc < 3) SCAN_ISSUE(c + 1); }
        LDS_BAR();
        if (GLA) {
#pragma unroll
            for (int tb = 0; tb < 4; ++tb) { bf16x8_t Ag = {0, 0, 0, 0, 0, 0, 0, 0}; if (fq < 2) Ag = lds_frag16(lds + SL_AFB + ((tb * 16 + fr) * 16 + fq * 8) * 2);
                f32x4 xg = {bag, bag, bag, bag}; xg = __builtin_amdgcn_mfma_f32_16x16x32_bf16(Ag, Bg, xg, 0, 0, 0);
#pragma unroll
                for (int j = 0; j < 4; ++j) XG[(tb * 16 + fq * 4 + j) * 136 + wave * 16 + fr] = f2bf(xg[j]); }
            asm volatile("s_waitcnt lgkmcnt(0)" ::: "memory");
        }
        const int tstart = dir ? 63 - seg * 16 : seg * 16, tstep = dir ? -1 : 1;
        float cs[16], kkv[GLA ? 1 : 16]; float run = 0.f;
#ifdef REPMASK
        _Pragma("unroll 1") for (int rp1 = 0; rp1 < (((REPMASK) >> 24) & 1 ? 3 : 1); ++rp1) { run = 0.f;
#else
        {
#endif
#pragma unroll
        for (int i = 0; i < 16; ++i) { const int t = tstart + i * tstep; float la;
            if (!GLA) { const float zf = bf2f(KM[t * 136 + k]); const float sg = sigmoidf_(zf); la = __logf(lbv + (1.0f - lbv) * sg); kkv[i] = (1.0f - lbv) * (1.0f - sg); }
            else { const float x = bf2f(XG[t * 136 + k]); la = (fminf(x, 0.f) - __logf(1.0f + __expf(-fabsf(x)))) * 0.0625f; }
            run += la; cs[i] = run; }
        }
        { const float t0 = __shfl(run, fr), t1 = __shfl(run, 16 + fr), t2 = __shfl(run, 32 + fr), t3 = __shfl(run, 48 + fr);
          const float off = seg == 0 ? 0.f : (seg == 1 ? t0 : (seg == 2 ? t0 + t1 : t0 + t1 + t2)), blast = (t0 + t1) + (t2 + t3), bref = t0 + t1;
          float ke[16]; const float ebl = __expf(blast - bref);
#pragma unroll
          for (int i = 0; i < 16; ++i) { const int t = tstart + i * tstep; const float b = off + cs[i];
              float kk; if (GLA) kk = bf2f(KM[t * 136 + k]); else kk = kkv[i];
              const float e1 = __expf(fminf(fmaxf(b - bref, -80.0f), 80.0f)), r1 = __builtin_amdgcn_rcpf(e1), kr = kk * r1;
              if (OUT) { const float qr = bf2f(QMc[t * 136 + k]); const float qv = GLA ? qr * 0.08838834764831845f : siluf_(qr);
                  QMc[t * 136 + k] = f2bf(qv * e1); KM[t * 136 + k] = f2bf(kr); }
              ke[i] = kr * ebl; }
          if (OUT && seg == 0) EB[k] = __expf(bref);
          const int tb0 = dir ? 48 - seg * 16 : seg * 16; u32x4 w0, w1;
          if (dir) { w0.x = pk_bf16(ke[15], ke[14]); w0.y = pk_bf16(ke[13], ke[12]); w0.z = pk_bf16(ke[11], ke[10]); w0.w = pk_bf16(ke[9], ke[8]); w1.x = pk_bf16(ke[7], ke[6]); w1.y = pk_bf16(ke[5], ke[4]); w1.z = pk_bf16(ke[3], ke[2]); w1.w = pk_bf16(ke[1], ke[0]); }
          else     { w0.x = pk_bf16(ke[0], ke[1]); w0.y = pk_bf16(ke[2], ke[3]); w0.z = pk_bf16(ke[4], ke[5]); w0.w = pk_bf16(ke[6], ke[7]); w1.x = pk_bf16(ke[8], ke[9]); w1.y = pk_bf16(ke[10], ke[11]); w1.z = pk_bf16(ke[12], ke[13]); w1.w = pk_bf16(ke[14], ke[15]); }
          *(LAS u32x4*)(KE + k * 72 + tb0) = w0; *(LAS u32x4*)(KE + k * 72 + tb0 + 8) = w1;
          if (seg == 0) DD[k] = __expf(blast);
          dlog += blast; }
        LDS_BAR();
        bf16x8_t Bv[NB][2];
#pragma unroll
        for (int nb = 0; nb < NB; ++nb)
#pragma unroll
            for (int ks = 0; ks < 2; ++ks) { const LAS bf16* vp = VTc + (ks * 32 + fq * 8) * 136 + wave * 16 + fr; u32x4 w;
                w.x = (unsigned)vp[0] | ((unsigned)vp[136] << 16); w.y = (unsigned)vp[2 * 136] | ((unsigned)vp[3 * 136] << 16); w.z = (unsigned)vp[4 * 136] | ((unsigned)vp[5 * 136] << 16); w.w = (unsigned)vp[6 * 136] | ((unsigned)vp[7 * 136] << 16);
                Bv[nb][ks] = __builtin_bit_cast(bf16x8_t, w); }
        if (OUT) {
#ifdef REPMASK
          _Pragma("unroll 1") for (int rp2 = 0; rp2 < (((REPMASK) >> 25) & 1 ? 3 : 1); ++rp2) { if (rp2) LDS_BAR();
#else
          {
#endif
            { const int tb = wave >> 1;
#pragma unroll
              for (int sbi = 0; sbi < 2; ++sbi) { const int sb = (wave & 1) * 2 + sbi; f32x4 acc = {0.f, 0.f, 0.f, 0.f};
#pragma unroll
                  for (int ks = 0; ks < 4; ++ks) acc = __builtin_amdgcn_mfma_f32_16x16x32_bf16(lds_frag16(lds + qmoff + ((tb * 16 + fr) * 136 + ks * 32 + fq * 8) * 2), lds_frag16(lds + SL_KM + ((sb * 16 + fr) * 136 + ks * 32 + fq * 8) * 2), acc, 0, 0, 0);
#pragma unroll
                  for (int j = 0; j < 4; ++j) { const int t = tb * 16 + fq * 4 + j, s = sb * 16 + fr; const bool keep = dir ? (s >= t) : (s <= t); PP[t * 72 + s] = keep ? f2bf(acc[j]) : (bf16)0; } } }
            LDS_BAR();
#pragma unroll
            for (int nb = 0; nb < NB; ++nb) {
                bf16x8_t Bs[4];
#pragma unroll
                for (int ks = 0; ks < 4; ++ks) { const f32x4 e0 = *(LAS f32x4*)(EB + (2 * ks) * 16 + fq * 4), e1 = *(LAS f32x4*)(EB + (2 * ks + 1) * 16 + fq * 4); Bs[ks] = pack_bf16x8(S[nb][2 * ks] * e0, S[nb][2 * ks + 1] * e1); }
#pragma unroll
                for (int mb = 0; mb < 4; ++mb) {
                    f32x4 O = {0.f, 0.f, 0.f, 0.f};
#pragma unroll
                    for (int ks = 0; ks < 2; ++ks) O = __builtin_amdgcn_mfma_f32_16x16x32_bf16(lds_frag16(lds + SL_PP + ((mb * 16 + fr) * 72 + ks * 32 + fq * 8) * 2), Bv[nb][ks], O, 0, 0, 0);
#pragma unroll
                    for (int ks = 0; ks < 4; ++ks) { u32x4 aw; const u32x2 lo = *(LAS u32x2*)(lds + qmoff + ((mb * 16 + fr) * 136 + (2 * ks) * 16 + fq * 4) * 2), hi = *(LAS u32x2*)(lds + qmoff + ((mb * 16 + fr) * 136 + (2 * ks + 1) * 16 + fq * 4) * 2);
                        aw.x = lo.x; aw.y = lo.y; aw.z = hi.x; aw.w = hi.y;
                        O = __builtin_amdgcn_mfma_f32_16x16x32_bf16(__builtin_bit_cast(bf16x8_t, aw), Bs[ks], O, 0, 0, 0); }
#pragma unroll
                    for (int j = 0; j < 4; ++j) Odir[(size_t)(r0 + mb * 16 + fq * 4 + j) * 1024 + head * DV + (nbase + nb) * 16 + fr] = f2bf(O[j]);
                    asm volatile("" ::: "memory");
                }
            }
          }
        }
        if (!OUT || cc < 3) {
#pragma unroll
            for (int mb = 0; mb < 8; ++mb) { const f32x4 dd = *(LAS f32x4*)(DD + mb * 16 + fq * 4);
                const bf16x8_t A0 = lds_frag16(lds + SL_KE + ((mb * 16 + fr) * 72 + fq * 8) * 2), A1 = lds_frag16(lds + SL_KE + ((mb * 16 + fr) * 72 + 32 + fq * 8) * 2);
#pragma unroll
                for (int nb = 0; nb < NB; ++nb) { S[nb][mb] = S[nb][mb] * dd; S[nb][mb] = __builtin_amdgcn_mfma_f32_16x16x32_bf16(A0, Bv[nb][0], S[nb][mb], 0, 0, 0); S[nb][mb] = __builtin_amdgcn_mfma_f32_16x16x32_bf16(A1, Bv[nb][1], S[nb][mb], 0, 0, 0); }
                asm volatile("" ::: "memory"); }
        }
    }
    LDS_BAR();
    if (!OUT) {
#pragma unroll
        for (int nb = 0; nb < NB; ++nb)
#pragma unroll
            for (int mb = 0; mb < 8; ++mb) *(f32x4*)(kvs + ((size_t)((nbase + nb) * 8 + mb) * 64 + lane) * 4) = S[nb][mb];
        if (seg == 0) kd[k] = __expf(dlog);
    }
}
#undef SCAN_ISSUE
DI void scan_prop(const Args& a) {
    float* kvs = (float*)(wsp(a) + WS_KVS); const float* kd = (const float*)(wsp(a) + WS_KD);
    for (int g = obid() * NTHR + otid(); g < 131072; g += ogdim() * NTHR) {
        float* p; size_t stride; const float* dp;
        if (g < 65536) { const int stream = g >> 12, e = g & 4095; p = kvs + (size_t)stream * SC_N * 16384 + (size_t)e * 4; stride = 16384; dp = kd + (size_t)stream * SC_N * 128 + (((e >> 6) & 7) * 4 + ((e & 63) >> 4)) * 4; }
        else { const int q = g - 65536, stream = q >> 13, e = q & 8191; p = kvs + KVS_GL_OFF + (size_t)stream * SC_N * 32768 + (size_t)e * 4; stride = 32768; dp = kd + (size_t)(16 + stream) * SC_N * 128 + (((e >> 6) & 7) * 4 + ((e & 63) >> 4)) * 4; }
        f32x4 S = {0.f, 0.f, 0.f, 0.f};
        static_assert(SC_N % 13 == 0, "batches of 13 super-chunks");
        for (int sb = 0; sb < SC_N; sb += 13) {
            f32x4 kv[13], d[13];
#pragma unroll
            for (int u = 0; u < 13; ++u) { kv[u] = *(const f32x4*)(p + (size_t)(sb + u) * stride); d[u] = *(const f32x4*)(dp + (sb + u) * 128); }
#pragma unroll
            for (int u = 0; u < 13; ++u) { *(f32x4*)(p + (size_t)(sb + u) * stride) = S; S = d[u] * S + kv[u]; }
        }
    }
}
constexpr int SCAN_ITEMS = 32 * SC_N;
template <bool OUT> DI void scan_item2(const Args& a, int l, int it, LAS unsigned char* lds, int pv = 0) {
    if (it < 16 * SC_N) { const int s = it / SC_N, sc = it % SC_N; if (OUT && l == DEPTH - 1 && sc == 0) return; scan_walk<true, OUT>(a, l, s >> 2, (s >> 1) & 1, sc, s & 1, lds, pv); }
    else { const int j = it - 16 * SC_N, s = j / SC_N, sc = j % SC_N; if (OUT && l == DEPTH - 1 && sc == 0) return; scan_walk<false, OUT>(a, l, s >> 1, s & 1, sc, 0, lds, pv); }
}
DI void hyconv_item(const Args& a, int l, int c, LAS unsigned char* ldsb, int pv = 0) {
    const int tid = otid();
    LAS float* lds = (LAS float*)ldsb;
    LAS float* xs = (LAS float*)(ldsb + LDS_X);
    const float* tw = (const float*)(wsp(a) + WS_TW); const float* tw2 = (const float*)(wsp(a) + WS_TW2);
    const float* h2 = (const float*)(wsp(a) + WS_H2) + (size_t)l * MT * 64;
    const bf16* VX = (const bf16*)(wsp(a) + WS_U) + (size_t)c * MT; bf16* VO = (bf16*)(wsp(a) + WS_CVO) + (size_t)c * MT;
#ifdef REPMASK
    _Pragma("unroll 1") for (int rpa = 0; rpa < (((REPMASK) >> 21) & 1 ? 2 : 1); ++rpa) { if (rpa) __syncthreads();
#else
    if (!(pv & 64)) {
#endif
    const bf16* HFf = (const bf16*)(wsp(a) + WS_HF) + (size_t)c * SEQ; const bf16* HFb = HFf + (size_t)1024 * SEQ;
    const float a0 = -4.605170186f / 1.5f, a1 = -4.605170186f / 0.3f;
    const float nd = -fabsf(a0 + (float)c * ((a1 - a0) / 1023.0f)) * (1.0f / (float)(SEQ - 1));
    const float b3f = ain(a, I_HYB3)[l * 2048 + c], b3b = ain(a, I_HYB3)[l * 2048 + 1024 + c];
    float sf = 0.f, sb = 0.f; f32x4 hfv[8], hbv[8];
#pragma unroll
    for (int i = 0; i < 8; ++i) { const int t4 = (tid + 512 * i) * 4; const u32x2 rf = __builtin_nontemporal_load((const u32x2*)(HFf + t4)), rb = __builtin_nontemporal_load((const u32x2*)(HFb + t4));
        f32x4 hf, hb; hf[0] = bflo(rf.x); hf[1] = bfhi(rf.x); hf[2] = bflo(rf.y); hf[3] = bfhi(rf.y); hb[0] = bflo(rb.x); hb[1] = bfhi(rb.x); hb[2] = bflo(rb.y); hb[3] = bfhi(rb.y);
#pragma unroll
        for (int q = 0; q < 4; ++q) { const float dec = __expf(nd * (float)(t4 + q)) + 0.05f; hf[q] = (hf[q] + b3f) * dec; hb[q] = (hb[q] + b3b) * dec; }
        sf += (fabsf(hf[0]) + fabsf(hf[1])) + (fabsf(hf[2]) + fabsf(hf[3])); sb += (fabsf(hb[0]) + fabsf(hb[1])) + (fabsf(hb[2]) + fabsf(hb[3]));
        hfv[i] = hf; hbv[i] = hb; }
    sf = wave_sum(sf); sb = wave_sum(sb);
    if ((tid & 63) == 0) { xs[128 + (tid >> 6)] = sf; xs[136 + (tid >> 6)] = sb; }
    __syncthreads();
    float tf = 0.f, tb = 0.f;
#pragma unroll
    for (int w = 0; w < 8; ++w) { tf += xs[128 + w]; tb += xs[136 + w]; }
    const float inf_ = 1.0f / tf, inb_ = 1.0f / tb; const float skipv = ain(a, I_HYSKIP)[l * 1024 + c];
#pragma unroll
    for (int i = 0; i < 8; ++i) { const int t4 = (tid + 512 * i) * 4; f32x4 hf = hfv[i] * inf_; const f32x4 hb = hbv[i] * inb_;
        if (t4 == 0) hf[0] += hb[0] + skipv;
        *(LAS f32x4*)(lds + t4) = hf;
#pragma unroll
        for (int q = 0; q < 4; ++q) { const int t = t4 + q; if (t > 0) lds[32768 - t] = hb[q]; } }
    if (tid == 0) lds[SEQ] = 0.f;
    __syncthreads();
    }
    if (!(pv & 128)) { FftTw T; fft_load_tw(T, tw, tid);
    fft_fwd_pass<4096>(lds, T, tw, tid); LDS_BAR(); fft_fwd_pass<1024>(lds, T, tw, tid); LDS_BAR(); fft_fwd_pass<256>(lds, T, tw, tid); LDS_BAR(); fft_fwd_pass<64>(lds, T, tw, tid); LDS_BAR();
    fft_fwd_pass<16>(lds, T, tw, tid); LDS_BAR(); fft_fwd_pass<4>(lds, T, tw, tid); LDS_BAR(); fft_fwd_pass<1>(lds, T, tw, tid); LDS_BAR(); }
#ifdef REPMASK
    if (((REPMASK) >> 22) & 1) { FftTw T; fft_load_tw(T, tw, tid);
        fft_inv_pass<1>(lds, T, tw, tid); LDS_BAR(); fft_inv_pass<4>(lds, T, tw, tid); LDS_BAR(); fft_inv_pass<16>(lds, T, tw, tid); LDS_BAR(); fft_inv_pass<64>(lds, T, tw, tid); LDS_BAR();
        fft_inv_pass<256>(lds, T, tw, tid); LDS_BAR(); fft_inv_pass<1024>(lds, T, tw, tid); LDS_BAR(); fft_inv_pass<4096>(lds, T, tw, tid); LDS_BAR();
        for (int i = 0; i < 64; ++i) lds[tid + 512 * i] *= (1.0f / FFT_M);
        LDS_BAR();
        fft_fwd_pass<4096>(lds, T, tw, tid); LDS_BAR(); fft_fwd_pass<1024>(lds, T, tw, tid); LDS_BAR(); fft_fwd_pass<256>(lds, T, tw, tid); LDS_BAR(); fft_fwd_pass<64>(lds, T, tw, tid); LDS_BAR();
        fft_fwd_pass<16>(lds, T, tw, tid); LDS_BAR(); fft_fwd_pass<4>(lds, T, tw, tid); LDS_BAR(); fft_fwd_pass<1>(lds, T, tw, tid); LDS_BAR(); }
#endif

    float* Gs = (float*)(wsp(a) + WS_YMIX) + (size_t)obid() * 32768;
    const int kbase = ((tid & 63) << 7) | ((tid >> 6) << 4);
#ifdef REPMASK
    _Pragma("unroll 1") for (int rpc = 0; rpc < (((REPMASK) >> 23) & 1 ? 2 : 1); ++rpc)
#endif
#pragma unroll 4
    for (int j = 0; j < ((pv & 256) ? 0 : 16); ++j) { const int k = kbase | j; cpx gk, gm; rfft_untangle(lds, tw2, k, gk, gm); f32x4 g4; g4[0] = gk.x; g4[1] = gk.y; g4[2] = gm.x; g4[3] = gm.y; *(f32x4*)(Gs + (size_t)(j * 512 + tid) * 4) = g4; }
    __syncthreads();
#pragma unroll
    for (int i = 0; i < 16; ++i) { if (pv & 512) break; const int m4 = tid + 512 * i; f32x4 v = {0.f, 0.f, 0.f, 0.f}; if (m4 < SEQ / 4) { const u32x2 r = __builtin_nontemporal_load((const u32x2*)(VX + m4 * 4)); v[0] = bflo(r.x); v[1] = bfhi(r.x); v[2] = bflo(r.y); v[3] = bfhi(r.y); } *(LAS f32x4*)(lds + m4 * 4) = v; }
    __syncthreads();
    if (!(pv & 128)) { FftTw T; fft_load_tw(T, tw, tid);
    fft_fwd_pass<4096>(lds, T, tw, tid); LDS_BAR(); fft_fwd_pass<1024>(lds, T, tw, tid); LDS_BAR(); fft_fwd_pass<256>(lds, T, tw, tid); LDS_BAR(); fft_fwd_pass<64>(lds, T, tw, tid); LDS_BAR();
    fft_fwd_pass<16>(lds, T, tw, tid); LDS_BAR(); fft_fwd_pass<4>(lds, T, tw, tid); LDS_BAR(); fft_fwd_pass<1>(lds, T, tw, tid); LDS_BAR(); }
#pragma unroll 8
    for (int j = 0; j < ((pv & 1024) ? 0 : 16); ++j) { const int k = kbase | j; const f32x4 g4 = *(const f32x4*)(Gs + (size_t)(j * 512 + tid) * 4); cpx gk, gm; gk.x = g4[0]; gk.y = g4[1]; gm.x = g4[2]; gm.y = g4[3]; rfft_mul_retangle(lds, tw2, k, gk, gm); }
    __syncthreads();
    if (!(pv & 128)) { FftTw T; fft_load_tw(T, tw, tid);
    fft_inv_pass<1>(lds, T, tw, tid); LDS_BAR(); fft_inv_pass<4>(lds, T, tw, tid); LDS_BAR(); fft_inv_pass<16>(lds, T, tw, tid); LDS_BAR(); fft_inv_pass<64>(lds, T, tw, tid); LDS_BAR();
    fft_inv_pass<256>(lds, T, tw, tid); LDS_BAR(); fft_inv_pass<1024>(lds, T, tw, tid); LDS_BAR(); fft_inv_pass<4096>(lds, T, tw, tid); LDS_BAR(); }
#pragma unroll
    for (int i = 0; i < 8; ++i) { if (pv & 2048) break; const int m4 = tid + 512 * i; const f32x4 v = *(const LAS f32x4*)(lds + m4 * 4) * (1.0f / FFT_M); u32x2 o; o.x = pk_bf16(v[0], v[1]); o.y = pk_bf16(v[2], v[3]); __builtin_nontemporal_store(o, (u32x2*)(VO + m4 * 4)); }
    __syncthreads();
}
DI void hycctx_item(const Args& a, int l, int it, LAS unsigned char* ldsb) {
    const int tid = otid(), c0 = it * 4;
    LAS float* sv = (LAS float*)ldsb;
    LAS float* sf = sv + 4 * 256;
    LAS float* sb = sf + 4 * 256;
    const float* hyc = (const float*)(wsp(a) + WS_HYC); const bf16* VXT = (const bf16*)(wsp(a) + WS_U); bf16* CVO = (bf16*)(wsp(a) + WS_CVO);
    for (int i = tid; i < 4 * 256; i += NTHR) { const int ch = i >> 8, t = i & 255; sv[i] = bf2f(VXT[(size_t)(c0 + ch) * MT + SEQ + t]); sf[i] = hyc[(size_t)(c0 + ch) * 256 + t]; sb[i] = hyc[(size_t)(1024 + c0 + ch) * 256 + t]; }
    __syncthreads();
    const int ch = tid >> 7, tq = tid & 127; const float g0 = sf[ch * 256] + sb[ch * 256] + ain(a, I_HYSKIP)[l * 1024 + c0 + ch];
    float acc0 = 0.f, acc1 = 0.f; const int t0 = tq * 2;
    for (int s = 0; s < 256; ++s) { const float vv = sv[ch * 256 + s]; const int d0 = t0 - s, d1 = d0 + 1;
        const float ga = d0 > 0 ? sf[ch * 256 + d0] : (d0 < 0 ? sb[ch * 256 - d0] : g0), gb = d1 > 0 ? sf[ch * 256 + d1] : (d1 < 0 ? sb[ch * 256 - d1] : g0);
        acc0 += ga * vv; acc1 += gb * vv; }
    *(unsigned*)(CVO + (size_t)(c0 + ch) * MT + SEQ + t0) = pk_bf16(acc0, acc1);
    __syncthreads();
}

struct EpiHF {
    static constexpr bool PERM2 = true, CHAIN = false, PERM = true, AFTER_DRAIN = false; bf16* O;
    DI void operator()(const f32x4 (&acc)[2][2][4][2], const pg8::Unit& u, int wr, int wc, int fr, int fq) const {
        const int row0 = u.pm * 256 + wr * 64 + fr, col0 = u.pn * 256 + wc * 64 + 8 * fq;
#pragma unroll
        for (int ai = 0; ai < 2; ++ai)
#pragma unroll
            for (int m = 0; m < 4; ++m) { bf16* rowp = O + (size_t)(row0 + ai * 128 + m * 16) * SEQ + col0;
#pragma unroll
                for (int bj = 0; bj < 2; ++bj) { const f32x4 v0 = acc[ai][bj][m][0], v1 = acc[ai][bj][m][1];
                    u32x4 w; w.x = pk_bf16(v0[0], v0[1]); w.y = pk_bf16(v0[2], v0[3]); w.z = pk_bf16(v1[0], v1[1]); w.w = pk_bf16(v1[2], v1[3]);
                    *(u32x4*)(rowp + bj * 32) = w; } }
    }
};
struct EpiZ {
    static constexpr bool PERM2 = true, CHAIN = false, PERM = true, AFTER_DRAIN = false; bf16* O; const float* bias;
    DI void operator()(const f32x4 (&acc)[2][2][4][2], const pg8::Unit& u, int wr, int wc, int fr, int fq) const {
        const int row0 = u.pm * 256 + wr * 64 + fr, col0 = u.pn * 256 + wc * 64 + 8 * fq;
        f32x4 bv[2][2];
#pragma unroll
        for (int bj = 0; bj < 2; ++bj)
#pragma unroll
            for (int n = 0; n < 2; ++n) bv[bj][n] = *(const f32x4*)(bias + col0 + bj * 32 + 4 * n);
#pragma unroll
        for (int ai = 0; ai < 2; ++ai)
#pragma unroll
            for (int m = 0; m < 4; ++m) { bf16* rowp = O + (size_t)(row0 + ai * 128 + m * 16) * ZC + col0;
#pragma unroll
                for (int bj = 0; bj < 2; ++bj) { const f32x4 v0 = acc[ai][bj][m][0] + bv[bj][0], v1 = acc[ai][bj][m][1] + bv[bj][1];
                    u32x4 w; w.x = pk_bf16(v0[0], v0[1]); w.y = pk_bf16(v0[2], v0[3]); w.z = pk_bf16(v1[0], v1[1]); w.w = pk_bf16(v1[2], v1[3]);
                    __builtin_nontemporal_store(w, (u32x4*)(rowp + bj * 32)); } }
    }
};
template <int BR> struct EpiBr {
    static constexpr bool PERM2 = false, CHAIN = false, PERM = true, AFTER_DRAIN = false; bf16* Mg; const bf16* Zg;
    DI void operator()(const f32x4 (&acc)[2][2][4][2], const pg8::Unit& u, int wr, int wc, int fr, int fq) const {
        const int row0 = u.pm * 256 + wr * 64 + fr, col0 = u.pn * 256 + wc * 32 + 8 * fq;
#pragma unroll
        for (int ai = 0; ai < 2; ++ai) {
            u32x4 gq[4][2], pq[4][2];
#pragma unroll
            for (int m = 0; m < 4; ++m) { const size_t row = (size_t)(row0 + ai * 128 + m * 16);
#pragma unroll
                for (int bj = 0; bj < 2; ++bj) { const int col = col0 + bj * 128;
                    gq[m][bj] = *(const u32x4*)(Zg + row * ZC + col);
                    if (BR > 0) pq[m][bj] = *(const u32x4*)(Mg + row * D + col); } }
#pragma unroll
            for (int m = 0; m < 4; ++m) { const size_t row = (size_t)(row0 + ai * 128 + m * 16);
#pragma unroll
                for (int bj = 0; bj < 2; ++bj) { const int col = col0 + bj * 128;
                    const u32x4 g = gq[m][bj];
                    f32x4 v0 = acc[ai][bj][m][0], v1 = acc[ai][bj][m][1];
                    v0[0] *= sigmoidf_(bflo(g.x)); v0[1] *= sigmoidf_(bfhi(g.x)); v0[2] *= sigmoidf_(bflo(g.y)); v0[3] *= sigmoidf_(bfhi(g.y));
                    v1[0] *= sigmoidf_(bflo(g.z)); v1[1] *= sigmoidf_(bfhi(g.z)); v1[2] *= sigmoidf_(bflo(g.w)); v1[3] *= sigmoidf_(bfhi(g.w));
                    if (BR > 0) { const u32x4 p = pq[m][bj];
                        v0[0] += bflo(p.x); v0[1] += bfhi(p.x); v0[2] += bflo(p.y); v0[3] += bfhi(p.y); v1[0] += bflo(p.z); v1[1] += bfhi(p.z); v1[2] += bflo(p.w); v1[3] += bfhi(p.w); }
                    u32x4 w; w.x = pk_bf16(v0[0], v0[1]); w.y = pk_bf16(v0[2], v0[3]); w.z = pk_bf16(v1[0], v1[1]); w.w = pk_bf16(v1[2], v1[3]);
                    *(u32x4*)(Mg + row * D + col) = w; } }
        }
    }
};
struct BrOrder {
    pg8::StaticOrder S0; int nctx, G, c, ntc;
    DI void init(bool l0, int G_, int c_) { S0.init(SEQ, D, 1, 0); nctx = l0 ? 24 : 0; G = G_; c = c_; ntc = c_ < 512 ? (512 - c_ + G_ - 1) / G_ : 0; }
    DI bool next(int i, pg8::Unit& u) const {
        if (i < 3 * ntc) { const int k = i / 3, br = i - 3 * k, t = c + k * G; pg8::Unit q; S0.next(t, q); u.pm = br * 65 + q.pm; u.pn = br * 8 + q.pn; return true; }
        const int q = c + (i - 3 * ntc) * G; if (q >= nctx) return false;
        const int br = q >> 3; u.pm = br * 65 + 64; u.pn = br * 8 + (q & 7); return true; }
    DI void a_ready(const pg8::Unit&) const {}
    DI void done(const pg8::Unit&) const {}
};
struct EpiBrU {
    static constexpr bool PERM2 = true, CHAIN = true, PERM = true, AFTER_DRAIN = false; bf16* Mg; const bf16* Zg0; bf16* P; unsigned* cnt;
    DI static void gate8(const u32x4 g, f32x4& v0, f32x4& v1) {
        v0[0] *= sigmoidf_(bflo(g.x)); v0[1] *= sigmoidf_(bfhi(g.x)); v0[2] *= sigmoidf_(bflo(g.y)); v0[3] *= sigmoidf_(bfhi(g.y));
        v1[0] *= sigmoidf_(bflo(g.z)); v1[1] *= sigmoidf_(bfhi(g.z)); v1[2] *= sigmoidf_(bflo(g.w)); v1[3] *= sigmoidf_(bfhi(g.w)); }
    DI static void add8(const u32x4 p, f32x4& v0, f32x4& v1) {
        v0[0] += bflo(p.x); v0[1] += bfhi(p.x); v0[2] += bflo(p.y); v0[3] += bfhi(p.y); v1[0] += bflo(p.z); v1[1] += bfhi(p.z); v1[2] += bflo(p.w); v1[3] += bfhi(p.w); }
    DI static u32x4 pack8(const f32x4 v0, const f32x4 v1) { u32x4 w; w.x = pk_bf16(v0[0], v0[1]); w.y = pk_bf16(v0[2], v0[3]); w.z = pk_bf16(v1[0], v1[1]); w.w = pk_bf16(v1[2], v1[3]); return w; }
    DI static float egate(float z) { return 1.0f + __builtin_amdgcn_exp2f(fminf(fmaxf(z, -50.f), 50.f) * -1.44269504f); }
    DI static void ratio8(const u32x4 ga, const u32x4 gb, f32x4& v0, f32x4& v1) {
        v0[0] *= egate(bflo(gb.x)) * __builtin_amdgcn_rcpf(egate(bflo(ga.x))); v0[1] *= egate(bfhi(gb.x)) * __builtin_amdgcn_rcpf(egate(bfhi(ga.x)));
        v0[2] *= egate(bflo(gb.y)) * __builtin_amdgcn_rcpf(egate(bflo(ga.y))); v0[3] *= egate(bfhi(gb.y)) * __builtin_amdgcn_rcpf(egate(bfhi(ga.y)));
        v1[0] *= egate(bflo(gb.z)) * __builtin_amdgcn_rcpf(egate(bflo(ga.z))); v1[1] *= egate(bfhi(gb.z)) * __builtin_amdgcn_rcpf(egate(bfhi(ga.z)));
        v1[2] *= egate(bflo(gb.w)) * __builtin_amdgcn_rcpf(egate(bflo(ga.w))); v1[3] *= egate(bfhi(gb.w)) * __builtin_amdgcn_rcpf(egate(bfhi(ga.w))); }
    DI static void fin8(const u32x4 g, f32x4& v0, f32x4& v1) {
        v0[0] *= __builtin_amdgcn_rcpf(egate(bflo(g.x))); v0[1] *= __builtin_amdgcn_rcpf(egate(bfhi(g.x))); v0[2] *= __builtin_amdgcn_rcpf(egate(bflo(g.y))); v0[3] *= __builtin_amdgcn_rcpf(egate(bfhi(g.y)));
        v1[0] *= __builtin_amdgcn_rcpf(egate(bflo(g.z))); v1[1] *= __builtin_amdgcn_rcpf(egate(bfhi(g.z))); v1[2] *= __builtin_amdgcn_rcpf(egate(bflo(g.w))); v1[3] *= __builtin_amdgcn_rcpf(egate(bfhi(g.w))); }
    DI bool keep(const pg8::Unit& u) const { const int br = u.pm / 65; return (u.pm - br * 65) < 64 && br < 2; }
    DI void chain(f32x4 (&acc)[2][2][4][2], const pg8::Unit& u, int wr, int wc, int fr, int fq) const {
        const int br = u.pm / 65, pm = u.pm - br * 65, pn = u.pn & 7;
        const int rloc = wr * 64 + fr, col0 = pn * 256 + wc * 64 + 8 * fq;
        const bf16* Zg = Zg0 + (size_t)(pm * 256 + rloc) * ZC + br * D + col0;
        if (pm < 64) {
            if (br < 2) {
#pragma unroll
                for (int ah = 0; ah < 4; ++ah) {
                    u32x4 ga[2][2], gb[2][2];
#pragma unroll
                    for (int m = 0; m < 2; ++m)
#pragma unroll
                        for (int bj = 0; bj < 2; ++bj) { const bf16* zp = Zg + (size_t)((ah >> 1) * 128 + (ah & 1) * 32 + m * 16) * ZC + bj * 32;
                            ga[m][bj] = *(const u32x4*)zp; gb[m][bj] = *(const u32x4*)(zp + D); }
#pragma unroll
                    for (int m = 0; m < 2; ++m)
#pragma unroll
                        for (int bj = 0; bj < 2; ++bj) ratio8(ga[m][bj], gb[m][bj], acc[ah >> 1][bj][(ah & 1) * 2 + m][0], acc[ah >> 1][bj][(ah & 1) * 2 + m][1]);
                }
            } else {
                bf16* Mp = Mg + (size_t)(pm * 256 + rloc) * D + col0;
#pragma unroll
                for (int ah = 0; ah < 4; ++ah) {
                    u32x4 gq[2][2];
#pragma unroll
                    for (int m = 0; m < 2; ++m)
#pragma unroll
                        for (int bj = 0; bj < 2; ++bj) gq[m][bj] = *(const u32x4*)(Zg + (size_t)((ah >> 1) * 128 + (ah & 1) * 32 + m * 16) * ZC + bj * 32);
#pragma unroll
                    for (int m = 0; m < 2; ++m)
#pragma unroll
                        for (int bj = 0; bj < 2; ++bj) { f32x4 v0 = acc[ah >> 1][bj][(ah & 1) * 2 + m][0], v1 = acc[ah >> 1][bj][(ah & 1) * 2 + m][1];
                            fin8(gq[m][bj], v0, v1);
                            *(u32x4*)(Mp + (size_t)((ah >> 1) * 128 + (ah & 1) * 32 + m * 16) * D + bj * 32) = pack8(v0, v1); }
                }
            }
        } else {
            bf16* Pb = P + ((size_t)br * 256 + rloc) * D + col0;
#pragma unroll
            for (int ai = 0; ai < 2; ++ai) {
                u32x4 gq[4][2];
#pragma unroll
                for (int m = 0; m < 4; ++m)
#pragma unroll
                    for (int bj = 0; bj < 2; ++bj) gq[m][bj] = *(const u32x4*)(Zg + (size_t)(ai * 128 + m * 16) * ZC + bj * 32);
#pragma unroll
                for (int m = 0; m < 4; ++m)
#pragma unroll
                    for (int bj = 0; bj < 2; ++bj) { f32x4 v0 = acc[ai][bj][m][0], v1 = acc[ai][bj][m][1];
                        gate8(gq[m][bj], v0, v1);
                        *(u32x4*)(Pb + (size_t)(ai * 128 + m * 16) * D + bj * 32) = pack8(v0, v1); }
            }
            asm volatile("s_waitcnt vmcnt(0)" ::: "memory");
            __syncthreads();
            volatile LAS unsigned* lw = (volatile LAS unsigned*)(ldsbase() + LDS_BARW + 16);
            if (otid() == 0) {
                __builtin_amdgcn_fence(__ATOMIC_RELEASE, "agent");
                asm volatile("s_waitcnt vmcnt(0)" ::: "memory");
                *lw = xb_add(&cnt[pn * 64], 1u);
            }
            __syncthreads();
            const unsigned old = *lw;
            if (old == 2u) {
                __builtin_amdgcn_fence(__ATOMIC_ACQUIRE, "agent");
                asm volatile("s_waitcnt vmcnt(0)" ::: "memory");
                const bf16* P0 = P + (size_t)rloc * D + col0; bf16* Mp = Mg + (size_t)(64 * 256 + rloc) * D + col0;
#pragma unroll
                for (int am = 0; am < 8; ++am) {
                    u32x4 q[3][2];
#pragma unroll
                    for (int b = 0; b < 3; ++b)
#pragma unroll
                        for (int bj = 0; bj < 2; ++bj) q[b][bj] = *(const u32x4*)(P0 + ((size_t)b * 256 + am * 16) * D + bj * 32);
#pragma unroll
                    for (int bj = 0; bj < 2; ++bj) { f32x4 v0 = {0.f, 0.f, 0.f, 0.f}, v1 = {0.f, 0.f, 0.f, 0.f};
                        add8(q[0][bj], v0, v1); add8(q[1][bj], v0, v1); add8(q[2][bj], v0, v1);
                        *(u32x4*)(Mp + (size_t)(am * 16) * D + bj * 32) = pack8(v0, v1); }
                }
            }
        }
    }
};
struct EpiOut {
    static constexpr bool PERM2 = false, CHAIN = false, PERM = false, AFTER_DRAIN = false; const float* hin_main; const float* hin_ctx; float* hout; const float* gt1;
    DI void operator()(const f32x4 (&acc)[2][2][4][2], const pg8::Unit& u, int wr, int wc, int fr, int fq) const {
        const int row0 = u.pm * 256 + wr * 64 + fr, col0 = u.pn * 256 + wc * 32 + 4 * fq; const bool isctx = u.pm >= SEQ / 256;
        const float* g = gt1 + (isctx ? 12288 : 0);
        f32x4 gv[2][2];
#pragma unroll
        for (int bj = 0; bj < 2; ++bj)
#pragma unroll
            for (int n = 0; n < 2; ++n) gv[bj][n] = *(const f32x4*)(g + col0 + bj * 128 + n * 16);
#pragma unroll
        for (int ai = 0; ai < 2; ++ai) {
            f32x4 bq[4][2][2];
#pragma unroll
            for (int m = 0; m < 4; ++m) { const int row = row0 + ai * 128 + m * 16;
                const float* ip = (isctx ? hin_ctx + (size_t)(row - SEQ) * D : hin_main + (size_t)row * D) + col0;
#pragma unroll
                for (int bj = 0; bj < 2; ++bj)
#pragma unroll
                    for (int n = 0; n < 2; ++n) bq[m][bj][n] = *(const f32x4*)(ip + bj * 128 + n * 16); }
#pragma unroll
            for (int m = 0; m < 4; ++m) { const int row = row0 + ai * 128 + m * 16; float* op = hout + (size_t)row * D + col0;
#pragma unroll
                for (int bj = 0; bj < 2; ++bj)
#pragma unroll
                    for (int n = 0; n < 2; ++n) *(f32x4*)(op + bj * 128 + n * 16) = bq[m][bj][n] + gv[bj][n] * acc[ai][bj][m][n]; }
        }
    }
};
struct EpiGU {
    static constexpr bool PERM2 = false, CHAIN = false, PERM = true, AFTER_DRAIN = false; bf16* Hm;
    DI void operator()(const f32x4 (&acc)[2][2][4][2], const pg8::Unit& u, int wr, int wc, int fr, int fq) const {
        const int row0 = u.pm * 256 + wr * 64 + fr, col0 = (u.pn & 3) * 128 + wc * 32 + 8 * fq;
#pragma unroll
        for (int ai = 0; ai < 2; ++ai)
#pragma unroll
            for (int m = 0; m < 4; ++m) { const f32x4 g0 = acc[ai][0][m][0], g1 = acc[ai][0][m][1], u0 = acc[ai][1][m][0], u1 = acc[ai][1][m][1];
                u32x4 w; w.x = pk_bf16(siluf_(g0[0]) * u0[0], siluf_(g0[1]) * u0[1]); w.y = pk_bf16(siluf_(g0[2]) * u0[2], siluf_(g0[3]) * u0[3]);
                w.z = pk_bf16(siluf_(g1[0]) * u1[0], siluf_(g1[1]) * u1[1]); w.w = pk_bf16(siluf_(g1[2]) * u1[2], siluf_(g1[3]) * u1[3]);
                *(u32x4*)(Hm + (size_t)(row0 + ai * 128 + m * 16) * DFF + col0) = w; }
    }
};
struct EpiDn {
    static constexpr bool PERM2 = true, CHAIN = false, PERM = true, AFTER_DRAIN = false; bf16* Y; const float* roww;
    DI void operator()(const f32x4 (&acc)[2][2][4][2], const pg8::Unit& u, int wr, int wc, int fr, int fq) const {
        const int row0 = u.pm * 256 + wr * 64 + fr, col0 = (u.pn & 7) * 256 + wc * 64 + 8 * fq;
        float rwq[2][4];
#pragma unroll
        for (int ai = 0; ai < 2; ++ai)
#pragma unroll
            for (int m = 0; m < 4; ++m) rwq[ai][m] = roww[row0 + ai * 128 + m * 16];
#pragma unroll
        for (int ai = 0; ai < 2; ++ai)
#pragma unroll
            for (int m = 0; m < 4; ++m) { const int row = row0 + ai * 128 + m * 16; const float rw = rwq[ai][m];
#pragma unroll
                for (int bj = 0; bj < 2; ++bj) { const f32x4 v0 = acc[ai][bj][m][0] * rw, v1 = acc[ai][bj][m][1] * rw;
                    u32x4 w; w.x = pk_bf16(v0[0], v0[1]); w.y = pk_bf16(v0[2], v0[3]); w.z = pk_bf16(v1[0], v1[1]); w.w = pk_bf16(v1[2], v1[3]);
                    *(u32x4*)(Y + (size_t)row * D + col0 + bj * 32) = w; } }
    }
};
struct MoeOrder {
    const int* tile_e; int ntiles, nsub, G, c;
    DI bool next(int i, pg8::Unit& u) const { const int j = i * G + c; if (j >= ntiles * nsub) return false; const int ti = j / nsub; u.pm = ti; u.pn = tile_e[ti] * nsub + (j - ti * nsub); return true; }
    DI void a_ready(const pg8::Unit&) const {}
    DI void done(const pg8::Unit&) const {}
};
constexpr int NPH_LAYER = 13, PH_FINAL = 1 + NPH_LAYER * DEPTH, NPHASES = PH_FINAL + 1;
struct KArgs { Args a; int li, pad; };
__global__ void __launch_bounds__(NTHR, 2) fwd_kernel(KArgs ka) {
    const Args& a = ka.a;
#define tid ((int)otid())
#define bid ((int)obid())
#define G ((int)ogdim())
    if (tid == 0) { ((LAS unsigned*)(ldsbase() + LDS_BARW))[0] = 0u; ((LAS unsigned*)(ldsbase() + LDS_BARW))[1] = 0u;
        LAS unsigned long long* ptab = (LAS unsigned long long*)(ldsbase() + LDS_PTAB);
#pragma unroll
        for (int i = 0; i < N_IN; ++i) ptab[i] = (unsigned long long)ka.a.in[i]; }
    __syncthreads();
#ifdef PROBE_SEL
    if (tid < 64) ((LAS unsigned long long*)(ldsbase() + LDS_TIM))[tid] = 0ull;
    __syncthreads();
    const unsigned long long tkern_ = __builtin_amdgcn_s_memrealtime();
#endif
    XcdBarrier bar = xcd_barrier_post((unsigned*)(wsp(a) + WS_CTL) + CW_BAR + ka.li * XCD_BAR_WORDS, (volatile LAS unsigned*)(ldsbase() + LDS_BARW));
    const int lo = a.ph_lo, hi = a.ph_hi;
#ifndef PHMASK
#define PHMASK 0xFFFF
#endif
#define EN(i) (((PHMASK) >> (i)) & 1)
#ifndef REPMASK
#define REPMASK 0
#endif
#define REP(i) (((REPMASK) >> (i)) & 1)
#define RUN(i, cond, ...) do { _Pragma("unroll 1") for (int rep_ = 0; rep_ < ((REP(i) && (cond)) ? REPN : 1); ++rep_) { if (rep_) __syncthreads(); __VA_ARGS__; } } while (0)
#ifndef REPN
#define REPN 2
#endif
#define IN(k) (opq(lo) <= (k) && (k) < opq(hi))
#define SEAM(k) do { if (IN(k) && IN((k) + 1)) { TIC(); xcd_barrier(bar); TOC(30); } } while (0)
#define ws wsp(a)
#define lds ldsbase()
#define ldsf ((LAS float*)ldsbase())
#define U ((bf16*)(wsp(a) + WS_U))
#define Z ((bf16*)(wsp(a) + WS_Z))
#define H ((float*)(wsp(a) + WS_H))
#define modall ((const float*)(wsp(a) + WS_MOD))

    { TIC();
    if (EN(0) && IN(0)) {
        RUN(0, true, prologue_small(a);
        for (int it = bid; it < 256; it += G) mod_item(a, it, ldsf);
        __syncthreads(); h2_rows(a, ldsf); __syncthreads());
    }
    TOC(31); } SEAM(0);
    for (int l = 0; l < DEPTH; ++l) {
        const int pb = 1 + NPH_LAYER * l;
        const int nrows = (l == 0) ? MT : SEQ;
        { TIC();
        if (EN(1) && IN(pb + 0)) {
            RUN(1, l == 0, norm_phase<0>(a, l, MT, ldsf));
            RUN(16, true, if (l == 0) hyc_filters(a, 0));
            __syncthreads(); RUN(2, true, cvt_stream<false>(a, l, ldsf)); __syncthreads();
        }
        TOC(1); } SEAM(pb + 0); { TIC();
        if (EN(2) && IN(pb + 1)) {
            pg8::Gemm g{U, (const bf16*)(ws + WS_WIN), MT, ZC, D}; pg8::StaticOrder S; S.init(MT, ZC, G, bid);
            EpiZ E{Z, (const float*)(ws + WS_ZBIAS) + (size_t)l * ZC};
            RUN(3, true, pg8::gemm_phase<EpiZ, pg8::StaticOrder, true, true>(lds, g, S, E));
        }
        TOC(2); } SEAM(pb + 1); { TIC();
        if (EN(3) && IN(pb + 2)) { const int nit = (nrows / 64) * 16; { const int g_ = G, wv_ = __builtin_amdgcn_readfirstlane(tid >> 6), n_ = (nrows / 64) * 128; RUN(4, true, for (int u_ = bid; u_ < n_ / 8; u_ += g_) hyprep_witem(a, l, (u_ >> 4) * 128 + (u_ & 15) * 8 + wv_)); }
            __syncthreads();
            pg8::Gemm g{(const bf16*)(ws + WS_W3T) + (size_t)l * 2048 * 256, (const bf16*)(ws + WS_H2B) + (size_t)l * SEQ * 256, 2048, SEQ, opq(256)  }; pg8::StaticOrder S; S.init(2048, SEQ, G, bid);
            EpiHF E{(bf16*)(ws + WS_HF)};
            RUN(18, true, pg8::gemm_phase<EpiHF, pg8::StaticOrder, true, true>(lds, g, S, E)); }
        TOC(3); } SEAM(pb + 2); { TIC();
        if (EN(4) && IN(pb + 3)) {
            if (!(ka.pad & 8)) { RUN(5, true, for (int ix = bid; ix < 32 * (SC_N - 1); ix += G) scan_item2<false>(a, l, (ix / (SC_N - 1)) * SC_N + ix % (SC_N - 1), lds)); }
            if (!(ka.pad & 16)) { RUN(6, true, for (int c = bid; c < 1024; c += G) hyconv_item(a, l, c, lds, ka.pad)); }
            if (!(ka.pad & 32)) { RUN(15, true, if (l == 0) for (int it = bid; it < 256; it += G) hycctx_item(a, l, it, lds)); }
        }
        TOC(4); } SEAM(pb + 3); { TIC();
        if (EN(13) && IN(pb + 4)) { scan_prop(a); if (REP(20)) { xcd_barrier(bar); xcd_barrier(bar); xcd_barrier(bar); xcd_barrier(bar); xcd_barrier(bar); } }
        TOC(5); } SEAM(pb + 4); { TIC();
        if (EN(14) && IN(pb + 5)) {
            { const bool lastl = (l == DEPTH - 1); const int nscan = lastl ? 32 * (SC_N - 1) : SCAN_ITEMS;
              RUN(17, true, for (int ix = bid; ix < nscan; ix += G) scan_item2<true>(a, l, lastl ? (ix / (SC_N - 1)) * SC_N + 1 + ix % (SC_N - 1) : ix, lds, ka.pad)); } }
        TOC(6); } SEAM(pb + 5); { TIC();
        if (EN(5) && IN(pb + 6)) {
            const int nit = (nrows / 64) * 16;
            { const int g_ = G, wv_ = __builtin_amdgcn_readfirstlane(tid >> 6), n_ = (nrows / 64) * 128; RUN(7, true, scancomb_rows(a, l, nrows); for (int u_ = bid; u_ < n_ / 8; u_ += g_) hycomb_witem(a, l, (u_ >> 4) * 128 + (u_ & 15) * 8 + wv_)); }
        }
        TOC(7); } SEAM(pb + 6); { TIC();
        if (EN(6) && IN(pb + 7)) {
            const bf16* Y = (const bf16*)(ws + WS_YMIX); const bf16* WB = (const bf16*)(ws + WS_WBR);
            BrOrder S; S.init(l == 0, G, bid);
            pg8::Gemm g{Y, WB, nrows, D, 1024}; EpiBrU E{U, Z + Z_MG, (bf16*)(ws + WS_OSC), (unsigned*)(ws + WS_CTL) + CW_CNT + 8192};
            RUN(8, true, (pg8::gemm_phase<EpiBrU, BrOrder, true, true>(lds, g, S, E)));
        }
        TOC(8); } SEAM(pb + 7); { TIC();
        if (EN(7) && IN(pb + 8)) {
            pg8::Gemm g{U, (const bf16*)(ws + WS_WOUT), nrows, D, D}; pg8::StaticOrder S; S.init(nrows, D, G, bid);
            EpiOut E{l == 0 ? ain(a, I_X) : H, l == 0 ? ain(a, I_CTX) : H + (size_t)SEQ * D, H, modall + (size_t)l * 2 * 12288 + 4096};
            RUN(9, l == 0, pg8::gemm_phase<EpiOut, pg8::StaticOrder, true, true>(lds, g, S, E));
        }
        TOC(9); } SEAM(pb + 8); { TIC();
        if (EN(8) && IN(pb + 9)) {
            route_phase<false>(a, l, nrows, ldsf, ka.pad);
            __syncthreads();
            if (REP(19)) { route_phase<true>(a, l, nrows, ldsf); __syncthreads(); }

        }
        TOC(10); } SEAM(pb + 9); { TIC();
        if (EN(9) && IN(pb + 10)) { RUN(11, true, permute_phase(a, l, nrows, lds)); __syncthreads(); RUN(10, true, cvt_stream<true>(a, l, ldsf)); __syncthreads(); }
        TOC(11); } SEAM(pb + 10); { TIC();
        if (EN(10) && IN(pb + 11)) {
            const int* tile_e = (const int*)(ws + WS_TILEE); const int ntiles = tile_e[200];
            pg8::Gemm g{(const bf16*)(ws + WS_XP), (const bf16*)(ws + WS_WGU), MOE_MAXROWS, NEXP * 1024, D}; MoeOrder S{tile_e, ntiles, 4, G, bid};
            EpiGU E{(bf16*)(ws + WS_HMID)};
            RUN(12, true, pg8::gemm_phase<EpiGU, MoeOrder, true, true>(lds, g, S, E));
        }
        TOC(12); } SEAM(pb + 11); { TIC();
        if (EN(11) && IN(pb + 12)) {
            const int* tile_e = (const int*)(ws + WS_TILEE); const int ntiles = tile_e[200];
            pg8::Gemm g{(const bf16*)(ws + WS_HMID), (const bf16*)(ws + WS_WD), MOE_MAXROWS, NEXP * D, DFF}; MoeOrder S{tile_e, ntiles, 8, G, bid};
            EpiDn E{(bf16*)(ws + WS_YP), (const float*)(ws + WS_ROWW)};
            RUN(13, true, pg8::gemm_phase<EpiDn, MoeOrder, true, true>(lds, g, S, E));
        }
        TOC(13); } SEAM(pb + 12); { TIC();
        (void)0; }
    }
#ifdef PROBE_SEL
    if (tid == 0) ((LAS unsigned long long*)(ldsbase() + LDS_TIM))[0] = __builtin_amdgcn_s_memrealtime() - tkern_;
    __syncthreads();
#endif
    if (EN(12) && IN(PH_FINAL)) norm_phase<2>(a, DEPTH, SEQ, ldsf);
#undef IN
#undef SEAM
#undef ws
#undef tid
#undef bid
#undef G
#undef lds
#undef ldsf
#undef U
#undef Z
#undef H
#undef modall
}

#ifndef MK_SINGLE
#define MK_SINGLE 1
#endif
extern "C" void kernel_launch(void* const* d_in, const int* in_sizes, int n_in, void* d_out, int out_size, void* d_ws, size_t ws_size, hipStream_t stream) {
    static int grid = 0;
    if (grid == 0) {
        if (n_in != N_IN || out_size != SEQ * D || ws_size < WS_END) { fprintf(stderr, "kernel_launch: unexpected problem shape (n_in %d, out %d, ws %zu < %zu)\n", n_in, out_size, ws_size, (size_t)WS_END); grid = -1; return; }
        int dev = 0, cus = 0;
        if (hipGetDevice(&dev) != hipSuccess || hipDeviceGetAttribute(&cus, hipDeviceAttributeMultiprocessorCount, dev) != hipSuccess) { grid = -1; return; }
        if (hipFuncSetAttribute((const void*)fwd_kernel, hipFuncAttributeMaxDynamicSharedMemorySize, LDS_BYTES) != hipSuccess) { fprintf(stderr, "kernel_launch: hipFuncSetAttribute failed\n"); grid = -1; return; }
        int per_cu = 0;
        if (hipOccupancyMaxActiveBlocksPerMultiprocessor(&per_cu, (const void*)fwd_kernel, NTHR, LDS_BYTES) != hipSuccess || per_cu < 1) fprintf(stderr, "kernel_launch: occupancy query says %d\n", per_cu);
        (void)hipGetLastError();
        grid = cus;
    }
    if (grid < 0) return;
    (void)hipMemsetAsync((char*)d_ws + WS_CTL, 0, CTL_BYTES, stream);
    KArgs ka{};
    for (int i = 0; i < N_IN; ++i) ka.a.in[i] = (const float*)d_in[i];
    ka.a.out = (float*)d_out; ka.a.ws = (unsigned char*)d_ws;
#if MK_SINGLE
    ka.a.ph_lo = 0; ka.a.ph_hi = NPHASES; ka.li = 0; ka.pad = 0;
    hipLaunchKernelGGL(fwd_kernel, dim3(grid), dim3(NTHR), LDS_BYTES, stream, ka);
#ifdef PROBE_K
    (void)hipMemsetAsync((char*)d_ws + WS_CTL + (size_t)CW_CNT * 4, 0, 16384, stream);
    ka.a.ph_lo = 0; ka.a.ph_hi = PROBE_K; ka.li = 1;
#ifdef PROBE_V
    ka.pad = PROBE_V;
#endif
    hipLaunchKernelGGL(fwd_kernel, dim3(grid), dim3(NTHR), LDS_BYTES, stream, ka);
#endif
#else
    for (int ph = 0; ph < NPHASES; ++ph) { ka.a.ph_lo = ph; ka.a.ph_hi = ph + 1; ka.li = 0; ka.pad = 0; hipLaunchKernelGGL(fwd_kernel, dim3(grid), dim3(NTHR), LDS_BYTES, stream, ka); }
#endif
}
```
